# Optimizing an MI355X kernel written in HIP

```python
import math
import jax
import jax.numpy as jnp
from jax import lax
import numpy as np

D_MODEL = 1024
BATCH = 8
SEQ = 4096
DEPTH = 2

CTX_LEN = 256
GRID_W = 64
ROPE_BASE = 10000.0
F32 = jnp.float32
NEG_INF = -1e30
LN_EPS = 1e-6

HY_W = 256
HY_ORDER = 2
HY_DIRS = 2
HY_EMB = 33
HY_FFN = 64
HY_MIN_DECAY = math.log(1e-2) / 1.5
HY_MAX_DECAY = math.log(1e-2) / 0.3

SWA_HEADS = 4
SWA_KV = 2
SWA_HD = 64
SWA_WIN = 128
SWA_BLOCK = 128

RW_HEADS = 4
RW_HD = 64
RW_W = RW_HEADS * RW_HD
RW_DECAY_R = 64
RW_AAA_R = 64
RW_GATE_R = 128
RW_GN_EPS = 64e-5

DF_HEADS = 4
DF_HD = 32
DF_VD = 2 * DF_HD
DF_W = DF_HEADS * DF_VD
DF_BLOCK = 128

N_BRANCH = 4
BR_W = 256
D_FF = 2816
DN_ALPHA = (2 * DEPTH) ** 0.25
DN_BETA = (8 * DEPTH) ** -0.25

SWA_SIZES = (SWA_HEADS * SWA_HD, SWA_KV * SWA_HD, SWA_KV * SWA_HD)
RW_SIZES = (RW_W, RW_W, RW_W, RW_DECAY_R, RW_DECAY_R, RW_AAA_R, RW_GATE_R, RW_GATE_R)
DF_SIZES = (DF_W, DF_W, DF_W)
IN_SIZES = (3 * HY_W, sum(SWA_SIZES), sum(RW_SIZES), sum(DF_SIZES), N_BRANCH * D_MODEL)
IN_COLS = sum(IN_SIZES)

kernel_name = 'hybrid_hyena_swa_rwkv7_diffattn_block'


def split_at(t, sizes):
    return jnp.split(t, np.cumsum(sizes)[:-1].tolist(), axis=-1)


def layer_norm(x, g=None, b=None):
    xf = x.astype(F32)
    mu = jnp.mean(xf, -1, keepdims=True)
    var = jnp.mean(jnp.square(xf - mu), -1, keepdims=True)
    y = (xf - mu) * lax.rsqrt(var + LN_EPS)
    if g is not None:
        y = y * g + b
    return y.astype(x.dtype)


def modulate(x, shift, scale):
    return layer_norm(x) * (1 + scale) + shift


def dwconv3(x, w, b):
    xp = jnp.pad(x, ((0, 0), (1, 1), (0, 0)))
    return xp[:, :-2] * w[0] + x * w[1] + xp[:, 2:] * w[2] + b


def axial_rope(x):
    L, d = x.shape[1], x.shape[-1]
    rows = L // GRID_W
    row = jnp.repeat(jnp.arange(rows), GRID_W)
    col = jnp.tile(jnp.arange(GRID_W), rows)
    nf = d // 4
    inv = ROPE_BASE ** (-jnp.arange(nf, dtype=F32) / nf)
    bshape = (L,) + (1,) * (x.ndim - 3) + (nf,)
    xf = x.astype(F32)
    out = []
    for half, pos in enumerate((row, col)):
        ang = (pos.astype(F32)[:, None] * inv[None, :]).reshape(bshape)
        cos, sin = jnp.cos(ang), jnp.sin(ang)
        xh = xf[..., half * 2 * nf:(half + 1) * 2 * nf]
        x1, x2 = xh[..., :nf], xh[..., nf:]
        out += [x1 * cos - x2 * sin, x1 * sin + x2 * cos]
    return jnp.concatenate(out, -1).astype(x.dtype)


def sink_softmax(logit_list, sink_b):
    lead = logit_list[0].shape[:-1]
    z = jnp.concatenate([t.astype(F32) for t in logit_list]
                        + [jnp.broadcast_to(sink_b.astype(F32), lead + (1,))], -1)
    return jax.nn.softmax(z, -1)[..., :-1]


def hyena_spectrum(L, w1, b1, w2, b2, w3, freq):
    t = jnp.linspace(0.0, 1.0, L, dtype=F32)[:, None]
    bands = (HY_EMB - 1) // 2
    w = 2.0 * math.pi * jnp.arange(L, dtype=F32) / L
    fb = jnp.linspace(1e-4, bands - 1, bands, dtype=F32)
    ang = w[:, None] * fb[None, :]
    z = jnp.concatenate([t, jnp.cos(ang), -jnp.sin(ang)], -1)
    fr = freq.astype(F32)
    hdn = jnp.sin(fr * (z @ w1.astype(F32) + b1.astype(F32)))
    hdn = jnp.sin(fr * (hdn @ w2.astype(F32) + b2.astype(F32)))
    filt = (hdn @ w3.astype(F32)).reshape(L, HY_ORDER, HY_DIRS, HY_W)
    deltas = jnp.abs(jnp.linspace(HY_MIN_DECAY, HY_MAX_DECAY, HY_W, dtype=F32))
    filt = filt * jnp.exp(-t * deltas[None, :])[:, None, None, :]
    filt = filt / jnp.sum(jnp.abs(filt), axis=(0, 2), keepdims=True)
    fwd, bwd = filt[:, :, 0], filt[:, :, 1]
    kern = jnp.concatenate([fwd, jnp.zeros_like(fwd[:1]), bwd[:0:-1]], axis=0)
    return jnp.fft.rfft(kern, axis=0)


def fft_longconv(z, kf, bias):
    L = z.shape[1]
    zf = jnp.fft.rfft(z.astype(F32), n=2 * L, axis=1)
    y = jnp.fft.irfft(zf * kf[None], n=2 * L, axis=1)[:, :L]
    return (y + z * bias).astype(z.dtype)


def hyena_mix(p, conv_w, conv_b, kf, bias):
    v, x1, x2 = jnp.split(dwconv3(p, conv_w, conv_b), 3, -1)
    zz = x1 * fft_longconv(v, kf[:, 0], bias[0])
    return x2 * fft_longconv(zz, kf[:, 1], bias[1])


def hyena_branch(p, pc, need_ctx, conv_w, conv_b, fw1, fb1, fw2, fb2, fw3, ffreq, bias):
    kf = hyena_spectrum(p.shape[1], fw1, fb1, fw2, fb2, fw3, ffreq)
    y = hyena_mix(p, conv_w, conv_b, kf, bias)
    yc = None
    if need_ctx:
        kfc = hyena_spectrum(pc.shape[1], fw1, fb1, fw2, fb2, fw3, ffreq)
        yc = hyena_mix(pc, conv_w, conv_b, kfc, bias)
    return y, yc


def swa_latent(q, k, v, kc, vc, sink):
    B, L = q.shape[:2]
    nb = L // SWA_BLOCK
    G = SWA_HEADS // SWA_KV
    scale = SWA_HD ** -0.5
    qb = q.reshape(B, nb, SWA_BLOCK, SWA_KV, G, SWA_HD)

    def band(t):
        tp = jnp.pad(t, ((0, 0), (SWA_BLOCK, SWA_BLOCK), (0, 0), (0, 0)))
        tp = tp.reshape(B, nb + 2, SWA_BLOCK, SWA_KV, SWA_HD)
        return jnp.concatenate([tp[:, :-2], tp[:, 1:-1], tp[:, 2:]], axis=2)

    kb, vb = band(k), band(v)
    s_loc = jnp.einsum('bnqkgd,bnskd->bnkgqs', qb, kb).astype(F32) * scale
    s_ctx = jnp.einsum('bnqkgd,bckd->bnkgqc', qb, kc).astype(F32) * scale
    blk = jnp.arange(nb)[:, None, None]
    qpos = blk * SWA_BLOCK + jnp.arange(SWA_BLOCK)[None, :, None]
    kpos = (blk - 1) * SWA_BLOCK + jnp.arange(3 * SWA_BLOCK)[None, None, :]
    valid = (jnp.abs(kpos - qpos) <= SWA_WIN) & (kpos >= 0) & (kpos < L)
    s_loc = jnp.where(valid[None, :, None, None], s_loc, NEG_INF)
    p = sink_softmax([s_loc, s_ctx], sink.reshape(SWA_KV, G)[:, :, None, None])
    nl = 3 * SWA_BLOCK
    o = (jnp.einsum('bnkgqs,bnskd->bnqkgd', p[..., :nl].astype(v.dtype), vb)
         + jnp.einsum('bnkgqc,bckd->bnqkgd', p[..., nl:].astype(v.dtype), vc))
    return o.reshape(B, L, SWA_HEADS * SWA_HD)


def swa_context(qc, kc, vc, sink):
    B, C = qc.shape[:2]
    G = SWA_HEADS // SWA_KV
    qg = qc.reshape(B, C, SWA_KV, G, SWA_HD)
    s = jnp.einsum('bqkgd,bckd->bkgqc', qg, kc).astype(F32) * SWA_HD ** -0.5
    p = sink_softmax([s], sink.reshape(SWA_KV, G)[:, :, None, None])
    o = jnp.einsum('bkgqc,bckd->bqkgd', p.astype(vc.dtype), vc)
    return o.reshape(B, C, SWA_HEADS * SWA_HD)


def swa_branch(p, pc, need_ctx, sink):
    B, L = p.shape[:2]
    C = pc.shape[1]
    q, k, v = split_at(p, SWA_SIZES)
    qc, kc, vc = split_at(pc, SWA_SIZES)
    q = axial_rope(q.reshape(B, L, SWA_HEADS, SWA_HD))
    k = axial_rope(k.reshape(B, L, SWA_KV, SWA_HD))
    v = v.reshape(B, L, SWA_KV, SWA_HD)
    kc = kc.reshape(B, C, SWA_KV, SWA_HD)
    vc = vc.reshape(B, C, SWA_KV, SWA_HD)
    y = swa_latent(q, k, v, kc, vc, sink)
    yc = swa_context(qc.reshape(B, C, SWA_HEADS, SWA_HD), kc, vc, sink) if need_ctx else None
    return y, yc


def rwkv_streams(p, mu, w0, w2, a0, a2, g2, k_k, k_a):
    B, L = p.shape[:2]
    pp = jnp.pad(p, ((0, 0), (1, 1), (0, 0)))
    p = p + (0.5 * (pp[:, :-2] + pp[:, 2:]) - p) * mu
    r, k, v, wd_f, wd_b, ad, gd_f, gd_b = split_at(p, RW_SIZES)

    def heads(t):
        return t.reshape(B, L, RW_HEADS, RW_HD)

    def decay(wd, w0d, w2d):
        wlog = -jax.nn.softplus(-(w0d + jnp.tanh(wd) @ w2d)) - 0.5
        return jnp.exp(-jnp.exp(wlog.astype(F32)))

    a = jax.nn.sigmoid(a0 + ad @ a2)
    kk = heads(k * k_k).astype(F32)
    kk = kk / jnp.maximum(jnp.sqrt(jnp.sum(kk * kk, -1, keepdims=True)), 1e-12)
    k = k * (1 + (a - 1) * k_a)
    g_f = jax.nn.sigmoid(gd_f) @ g2[0]
    g_b = jax.nn.sigmoid(gd_b) @ g2[1]
    return (heads(r), heads(k), heads(v), kk, heads(a),
            heads(decay(wd_f, w0[0], w2[0])), heads(decay(wd_b, w0[1], w2[1])),
            heads(g_f), heads(g_b))


def rwkv_scan(state0, r, dec, k, v, kk, a, reverse, emit):
    xs = tuple(jnp.moveaxis(t.astype(F32), 1, 0) for t in (r, dec, k, v, kk, a))

    def step(S, inp):
        r_t, w_t, k_t, v_t, kk_t, a_t = inp
        sa = jnp.einsum('bhvk,bhk->bhv', S, -kk_t)
        S = (S * w_t[:, :, None, :] + sa[..., None] * (kk_t * a_t)[:, :, None, :]
             + v_t[..., None] * k_t[:, :, None, :])
        return S, (jnp.einsum('bhvk,bhk->bhv', S, r_t) if emit else None)

    S, out = lax.scan(step, state0, xs, reverse=reverse)
    return S, (jnp.moveaxis(out, 0, 1) if emit else None)


def rwkv_out(o_f, o_b, r, k, v, g_f, g_b, r_k, lnx_g, lnx_b):
    B, L = r.shape[:2]
    gam = lnx_g.reshape(RW_HEADS, RW_HD)
    bet = lnx_b.reshape(RW_HEADS, RW_HD)

    def gn(o):
        mu = jnp.mean(o, -1, keepdims=True)
        var = jnp.mean(jnp.square(o - mu), -1, keepdims=True)
        return (o - mu) * lax.rsqrt(var + RW_GN_EPS) * gam + bet

    bonus = jnp.sum(r * k * r_k, -1, keepdims=True) * v
    y = (gn(o_f) + bonus) * g_f + (gn(o_b) + bonus) * g_b
    return y.reshape(B, L, RW_W).astype(v.dtype)


def rwkv_branch(p, pc, need_ctx, mu, w0, w2, a0, a2, g2, k_k, k_a, r_k, lnx_g, lnx_b):
    r, k, v, kk, a, d_f, d_b, g_f, g_b = rwkv_streams(p, mu, w0, w2, a0, a2, g2, k_k, k_a)
    rc, kc, vc, kkc, ac, dc_f, dc_b, gc_f, gc_b = rwkv_streams(pc, mu, w0, w2, a0, a2, g2, k_k, k_a)
    S0 = jnp.zeros((p.shape[0], RW_HEADS, RW_HD, RW_HD), F32)
    Sf, oc_f = rwkv_scan(S0, rc, dc_f, kc, vc, kkc, ac, False, need_ctx)
    Sb, oc_b = rwkv_scan(S0, rc, dc_b, kc, vc, kkc, ac, True, need_ctx)
    _, o_f = rwkv_scan(Sf, r, d_f, k, v, kk, a, False, True)
    _, o_b = rwkv_scan(Sb, r, d_b, k, v, kk, a, True, True)
    y = rwkv_out(o_f, o_b, r, k, v, g_f, g_b, r_k, lnx_g, lnx_b)
    yc = rwkv_out(oc_f, oc_b, rc, kc, vc, gc_f, gc_b, r_k, lnx_g, lnx_b) if need_ctx else None
    return y, yc


def diff_attend(q, k, v, lam, lam_init, subln_g):
    B, Lq = q.shape[:2]
    nb = Lq // DF_BLOCK
    qb = jnp.moveaxis(q.reshape(B, nb, DF_BLOCK, DF_HEADS, 2, DF_HD), 1, 0)
    scale = DF_HD ** -0.5

    def block(qblk):
        s = jnp.einsum('bqhcd,bshcd->bhcqs', qblk, k).astype(F32) * scale
        pr = jax.nn.softmax(s, -1)
        wgt = pr[:, :, 0] - lam * pr[:, :, 1]
        return jnp.einsum('bhqs,bshe->bqhe', wgt.astype(v.dtype), v)

    o = lax.map(block, qb)
    o = jnp.moveaxis(o, 0, 1).reshape(B, Lq, DF_HEADS, DF_VD).astype(F32)
    o = o * lax.rsqrt(jnp.mean(o * o, -1, keepdims=True) + 1e-5) * subln_g * (1.0 - lam_init)
    return o.reshape(B, Lq, DF_W).astype(v.dtype)


def diff_branch(p, pc, need_ctx, lq1, lk1, lq2, lk2, subln_g, lam_init):
    q, k, v = split_at(p, DF_SIZES)
    qc, kc, vc = split_at(pc, DF_SIZES)

    def qk(t):
        return t.reshape(t.shape[0], t.shape[1], DF_HEADS, 2, DF_HD)

    def vs(t):
        return t.reshape(t.shape[0], t.shape[1], DF_HEADS, DF_VD)

    lam = (jnp.exp(jnp.sum(lq1.astype(F32) * lk1.astype(F32)))
           - jnp.exp(jnp.sum(lq2.astype(F32) * lk2.astype(F32))) + lam_init)
    k_all = jnp.concatenate([axial_rope(qk(k)), qk(kc)], axis=1)
    v_all = jnp.concatenate([vs(v), vs(vc)], axis=1)
    y = diff_attend(axial_rope(qk(q)), k_all, v_all, lam, lam_init, subln_g)
    yc = diff_attend(qk(qc), qk(kc), vs(vc), lam, lam_init, subln_g) if need_ctx else None
    return y, yc


def merge_branches(ys, p_gate, w_br, w_o):
    gates = jnp.split(p_gate, N_BRANCH, -1)
    acc = None
    for j in range(N_BRANCH):
        term = jax.nn.sigmoid(gates[j]) * (ys[j] @ w_br[j])
        acc = term if acc is None else acc + term
    return acc @ w_o


def conv_ffn(u, w_up, conv_w, conv_b, w_down):
    hdn = dwconv3(u @ w_up, conv_w, conv_b)
    a, b = jnp.split(hdn, 2, -1)
    return (jax.nn.silu(a) * b) @ w_down


def setup_inputs(seed: int = 0) -> dict:
    key = jax.random.key(seed)
    ks = iter(jax.random.split(key, 64))
    D = D_MODEL

    def nrm(shape, scale):
        return jax.random.normal(next(ks), shape, F32) * scale

    def near_one(shape):
        return 1.0 + nrm(shape, 0.02)

    return {
        'x': nrm((BATCH, SEQ, D), 1.0),
        'c': nrm((BATCH, D), 1.0),
        'ctx': nrm((BATCH, CTX_LEN, D), 1.0),
        'c_ctx': nrm((D,), 1.0),
        'ada_w': nrm((DEPTH, D, 6 * D), D ** -0.5),
        'ada_b': nrm((DEPTH, 6 * D), 0.02),
        'w_in': nrm((DEPTH, D, IN_COLS), D ** -0.5),
        'hy_conv_w': nrm((DEPTH, 3, 3 * HY_W), 3 ** -0.5),
        'hy_conv_b': nrm((DEPTH, 3 * HY_W), 0.02),
        'hy_f_w1': nrm((DEPTH, HY_EMB, HY_FFN), HY_EMB ** -0.5),
        'hy_f_b1': nrm((DEPTH, HY_FFN), 0.02),
        'hy_f_w2': nrm((DEPTH, HY_FFN, HY_FFN), HY_FFN ** -0.5),
        'hy_f_b2': nrm((DEPTH, HY_FFN), 0.02),
        'hy_f_w3': nrm((DEPTH, HY_FFN, HY_ORDER * HY_DIRS * HY_W), HY_FFN ** -0.5),
        'hy_f_freq': near_one((DEPTH, HY_FFN)),
        'hy_bias': nrm((DEPTH, HY_ORDER, HY_W), 1.0),
        'swa_sink': nrm((DEPTH, SWA_HEADS), 0.5),
        'rwkv_mu': jax.random.uniform(next(ks), (DEPTH, sum(RW_SIZES)), F32),
        'rwkv_w0': jnp.linspace(-6.5, -1.5, RW_W, dtype=F32)[None, None, :] + nrm((DEPTH, 2, RW_W), 0.1),
        'rwkv_w2': nrm((DEPTH, 2, RW_DECAY_R, RW_W), 0.5 * RW_DECAY_R ** -0.5),
        'rwkv_a0': nrm((DEPTH, RW_W), 0.1),
        'rwkv_a2': nrm((DEPTH, RW_AAA_R, RW_W), 0.5 * RW_AAA_R ** -0.5),
        'rwkv_g2': nrm((DEPTH, 2, RW_GATE_R, RW_W), RW_GATE_R ** -0.5),
        'rwkv_kk': 0.85 + nrm((DEPTH, RW_W), 0.02),
        'rwkv_ka': near_one((DEPTH, RW_W)),
        'rwkv_rk': nrm((DEPTH, RW_HEADS, RW_HD), 0.1),
        'rwkv_lnx_g': near_one((DEPTH, RW_W)),
        'rwkv_lnx_b': nrm((DEPTH, RW_W), 0.02),
        'diff_lq1': nrm((DEPTH, DF_HD), 0.1),
        'diff_lk1': nrm((DEPTH, DF_HD), 0.1),
        'diff_lq2': nrm((DEPTH, DF_HD), 0.1),
        'diff_lk2': nrm((DEPTH, DF_HD), 0.1),
        'diff_subln_g': near_one((DEPTH, DF_VD)),
        'w_branch': nrm((DEPTH, N_BRANCH, BR_W, D), DN_BETA * BR_W ** -0.5),
        'w_out': nrm((DEPTH, D, D), DN_BETA * D ** -0.5),
        'ln1_g': near_one((DEPTH, D)),
        'ln1_b': nrm((DEPTH, D), 0.02),
        'ffn_w_up': nrm((DEPTH, D, 2 * D_FF), D ** -0.5),
        'ffn_conv_w': nrm((DEPTH, 3, 2 * D_FF), 3 ** -0.5),
        'ffn_conv_b': nrm((DEPTH, 2 * D_FF), 0.02),
        'ffn_w_down': nrm((DEPTH, D_FF, D), DN_BETA * D_FF ** -0.5),
        'ln2_g': near_one((DEPTH, D)),
        'ln2_b': nrm((DEPTH, D), 0.02),
    }


def reference(x, c, ctx, c_ctx, ada_w, ada_b, w_in, hy_conv_w, hy_conv_b, hy_f_w1, hy_f_b1,
              hy_f_w2, hy_f_b2, hy_f_w3, hy_f_freq, hy_bias, swa_sink, rwkv_mu, rwkv_w0, rwkv_w2,
              rwkv_a0, rwkv_a2, rwkv_g2, rwkv_kk, rwkv_ka, rwkv_rk, rwkv_lnx_g, rwkv_lnx_b,
              diff_lq1, diff_lk1, diff_lq2, diff_lk2, diff_subln_g, w_branch, w_out, ln1_g, ln1_b,
              ffn_w_up, ffn_conv_w, ffn_conv_b, ffn_w_down, ln2_g, ln2_b):
    h, hc = x, ctx
    s_lat = jax.nn.silu(c)
    s_ctx = jax.nn.silu(c_ctx)
    for i in range(DEPTH):
        need_ctx = i < DEPTH - 1
        mod = (s_lat @ ada_w[i] + ada_b[i])[:, None, :]
        mod_c = s_ctx @ ada_w[i] + ada_b[i]
        sh1, sc1, g1, sh2, sc2, g2 = jnp.split(mod, 6, -1)
        csh1, csc1, cg1, csh2, csc2, cg2 = jnp.split(mod_c, 6, -1)

        u = modulate(h, sh1, sc1)
        uc = modulate(hc, csh1, csc1)
        p_hy, p_sw, p_rw, p_df, p_gt = split_at(u @ w_in[i], IN_SIZES)
        pc_hy, pc_sw, pc_rw, pc_df, pc_gt = split_at(uc @ w_in[i], IN_SIZES)

        y_hy, yc_hy = hyena_branch(p_hy, pc_hy, need_ctx, hy_conv_w[i], hy_conv_b[i], hy_f_w1[i],
                                   hy_f_b1[i], hy_f_w2[i], hy_f_b2[i], hy_f_w3[i], hy_f_freq[i],
                                   hy_bias[i])
        y_sw, yc_sw = swa_branch(p_sw, pc_sw, need_ctx, swa_sink[i])
        y_rw, yc_rw = rwkv_branch(p_rw, pc_rw, need_ctx, rwkv_mu[i], rwkv_w0[i], rwkv_w2[i],
                                  rwkv_a0[i], rwkv_a2[i], rwkv_g2[i], rwkv_kk[i], rwkv_ka[i],
                                  rwkv_rk[i], rwkv_lnx_g[i], rwkv_lnx_b[i])
        lam_init = 0.8 - 0.6 * math.exp(-0.3 * i)
        y_df, yc_df = diff_branch(p_df, pc_df, need_ctx, diff_lq1[i], diff_lk1[i], diff_lq2[i],
                                  diff_lk2[i], diff_subln_g[i], lam_init)

        mix = merge_branches((y_hy, y_sw, y_rw, y_df), p_gt, w_branch[i], w_out[i])
        h = layer_norm(DN_ALPHA * h + g1 * mix, ln1_g[i], ln1_b[i])
        f = conv_ffn(modulate(h, sh2, sc2), ffn_w_up[i], ffn_conv_w[i], ffn_conv_b[i], ffn_w_down[i])
        h = layer_norm(DN_ALPHA * h + g2 * f, ln2_g[i], ln2_b[i])

        if need_ctx:
            mix_c = merge_branches((yc_hy, yc_sw, yc_rw, yc_df), pc_gt, w_branch[i], w_out[i])
            hc = layer_norm(DN_ALPHA * hc + cg1 * mix_c, ln1_g[i], ln1_b[i])
            fc = conv_ffn(modulate(hc, csh2, csc2), ffn_w_up[i], ffn_conv_w[i], ffn_conv_b[i],
                          ffn_w_down[i])
            hc = layer_norm(DN_ALPHA * hc + cg2 * fc, ln2_g[i], ln2_b[i])
    return h
```

```cpp
#include <hip/hip_runtime.h>
#include <hip/hip_cooperative_groups.h>
#include <cstdio>
#include <cstdint>
namespace cg = cooperative_groups;

#define DI __device__ __forceinline__
typedef unsigned short bf16_t;
typedef short bf16x8 __attribute__((ext_vector_type(8)));
typedef float f32x4 __attribute__((ext_vector_type(4)));

constexpr int D = 1024, NB = 8, SL = 4096, CL = 256;
constexpr int ML = NB * SL, MC = NB * CL, MT = ML + MC;
constexpr int KEYS = SL + CL;
constexpr int NTHR = 512;
constexpr float DN_ALPHA = 1.41421356237f;
constexpr size_t UNIT = (size_t)MT * 512;

constexpr size_t WB_IN = 0;
constexpr size_t WB_GATE = WB_IN + (size_t)3328 * 1024 * 2;
constexpr size_t WB_BR = WB_GATE + (size_t)4096 * 1024 * 2;
constexpr size_t WB_OUT = WB_BR + (size_t)4 * 1024 * 256 * 2;
constexpr size_t WB_UP = WB_OUT + (size_t)1024 * 1024 * 2;
constexpr size_t WB_DOWN = WB_UP + (size_t)5632 * 1024 * 2;
constexpr size_t WB_END = WB_DOWN + (size_t)1024 * 2816 * 2;
constexpr size_t OFF_KF = WB_END;
constexpr size_t OFF_HC = OFF_KF + (size_t)512 * 8192 * 8;
constexpr size_t OFF_MISC = OFF_HC + (size_t)MC * D * 4;
constexpr size_t MISC_MOD = OFF_MISC;
constexpr size_t MISC_TW = MISC_MOD + (size_t)2 * 9 * 6144 * 4;
constexpr size_t MISC_RAWC = MISC_TW + 4096 * 8;
constexpr size_t MISC_GCTX = MISC_RAWC + (size_t)256 * 1024 * 4;
constexpr size_t OFF_R = OFF_MISC + (size_t)4 * 1024 * 1024;
constexpr size_t R_YHY = OFF_R, R_YSW = OFF_R + UNIT, R_YDF = OFF_R + 2 * UNIT;
constexpr size_t R_PHY = OFF_R + 3 * UNIT;
constexpr size_t R_PSW = OFF_R + 6 * UNIT;
constexpr size_t R_VTSW = R_PSW + (size_t)MT * 384 * 2;
constexpr size_t R_PDF = OFF_R + 8 * UNIT;
constexpr size_t R_VTDF = OFF_R + 10 * UNIT;
constexpr size_t R_PRW = OFF_R + 11 * UNIT;
constexpr size_t R_STR = R_PRW + (size_t)MT * 1216 * 2;
constexpr size_t R_G = R_STR + 7 * UNIT;
constexpr size_t R_END = R_G + 2 * UNIT;
constexpr size_t R_RAWF = OFF_R;
constexpr size_t R_OF = R_PHY, R_OB = R_PHY + UNIT;
constexpr size_t R_URE = R_PSW;
constexpr size_t R_YRW = R_VTDF;
constexpr size_t R_ACC = R_PRW;
constexpr size_t R_U = R_STR;
constexpr size_t R_HID = OFF_R;
static_assert(R_END <= (size_t)512 * 1024 * 1024, "ws overflow");
static_assert((size_t)MT * 2816 * 2 <= 11 * UNIT, "hid");

constexpr int SMEM_BYTES = 136 * 1024;

struct Params {
  const float* in[43];
  float* out;
  char* ws;
};

DI int my_tid() { int t = (int)__builtin_amdgcn_workitem_id_x(); asm volatile("" : "+v"(t)); return t; }
DI unsigned f2bf(float f) { unsigned u = __float_as_uint(f); u += 0x7fffu + ((u >> 16) & 1u); return u >> 16; }
DI float bf2f(unsigned h) { return __uint_as_float(h << 16); }
DI unsigned pack2(float lo, float hi) { return f2bf(lo) | (f2bf(hi) << 16); }
DI float bflo(unsigned w) { return __uint_as_float(w << 16); }
DI float bfhi(unsigned w) { return __uint_as_float(w & 0xffff0000u); }
DI float sigmoidf_(float x) { return 1.f / (1.f + __expf(-x)); }
DI float siluf_(float x) { return x / (1.f + __expf(-x)); }
DI float wave_sum(float v) {
#pragma unroll
  for (int o = 32; o >= 1; o >>= 1) v += __shfl_xor(v, o);
  return v;
}
DI float sum16(float v) {
  v += __shfl_xor(v, 1); v += __shfl_xor(v, 2); v += __shfl_xor(v, 4); v += __shfl_xor(v, 8);
  return v;
}
DI int mod_idx(int row) { return row < ML ? (row >> 12) : 8; }

template <int NTW, class RowFn>
DI void gemm_main(f32x4 (&acc)[4][NTW], const bf16_t* __restrict__ A, int lda, RowFn rowfn,
                  const bf16_t* __restrict__ Bt, int ldb, int K, char* smem) {
  constexpr int BN = NTW * 32;
  constexpr int A_BYTES = 256 * 144, B_BYTES = BN * 144, STAGE = A_BYTES + B_BYTES;
  constexpr int NBL = BN / 64;
  const int tid = my_tid(), lane = tid & 63, wid = tid >> 6, wm = wid >> 1, wn = wid & 1, g = lane >> 4, r16 = lane & 15;
  const int chunk = tid & 7, lrow = tid >> 3;
  long a0 = rowfn(lrow), a1 = rowfn(lrow + 64), a2 = rowfn(lrow + 128), a3 = rowfn(lrow + 192);
  const uint4 zero4 = make_uint4(0, 0, 0, 0);
  const long c0 = a0 < 0 ? 0 : a0, c1 = a1 < 0 ? 0 : a1, c2 = a2 < 0 ? 0 : a2, c3 = a3 < 0 ? 0 : a3;
  uint4 ra0, ra1, ra2, ra3, rb0, rb1 = zero4;
  const bf16_t* Bp = Bt + (long)lrow * ldb + chunk * 8;
  auto GLOAD = [&](int k0) {
    ra0 = *(const uint4*)(A + c0 * lda + k0 + chunk * 8);
    ra1 = *(const uint4*)(A + c1 * lda + k0 + chunk * 8);
    ra2 = *(const uint4*)(A + c2 * lda + k0 + chunk * 8);
    ra3 = *(const uint4*)(A + c3 * lda + k0 + chunk * 8);
    if (a0 < 0) ra0 = zero4;
    if (a1 < 0) ra1 = zero4;
    if (a2 < 0) ra2 = zero4;
    if (a3 < 0) ra3 = zero4;
    rb0 = *(const uint4*)(Bp + k0);
    if constexpr (NBL > 1) rb1 = *(const uint4*)(Bp + (long)64 * ldb + k0);
  };
  auto SSTORE = [&](int st) {
    char* base = smem + st * STAGE + lrow * 144 + chunk * 16;
    *(uint4*)(base) = ra0; *(uint4*)(base + 64 * 144) = ra1; *(uint4*)(base + 128 * 144) = ra2;
    *(uint4*)(base + 192 * 144) = ra3;
    *(uint4*)(base + A_BYTES) = rb0;
    if constexpr (NBL > 1) *(uint4*)(base + A_BYTES + 64 * 144) = rb1;
  };
  __syncthreads();
  GLOAD(0);
  SSTORE(0);
  __syncthreads();
  const int nk = K >> 6;
  for (int kt = 0; kt < nk; ++kt) {
    const int st = kt & 1;
    if (kt + 1 < nk) GLOAD((kt + 1) * 64);
    const char* As = smem + st * STAGE + (wm * 64 + r16) * 144 + g * 16;
    const char* Bs = smem + st * STAGE + A_BYTES + (wn * (NTW * 16) + r16) * 144 + g * 16;
#pragma unroll
    for (int kk = 0; kk < 2; ++kk) {
      bf16x8 af[4], bfr[NTW];
#pragma unroll
      for (int mt = 0; mt < 4; ++mt) af[mt] = *(const bf16x8*)(As + mt * 16 * 144 + kk * 64);
#pragma unroll
      for (int nt = 0; nt < NTW; ++nt) bfr[nt] = *(const bf16x8*)(Bs + nt * 16 * 144 + kk * 64);
#pragma unroll
      for (int mt = 0; mt < 4; ++mt)
#pragma unroll
        for (int nt = 0; nt < NTW; ++nt)
          acc[mt][nt] = __builtin_amdgcn_mfma_f32_16x16x32_bf16(af[mt], bfr[nt], acc[mt][nt], 0, 0, 0);
    }
    if (kt + 1 < nk) SSTORE(st ^ 1);
    __syncthreads();
  }
}

struct RowPlain { long base; DI long operator()(int r) const { return base + r; } };
struct RowHalo { long rowbase; int t0; int len; DI long operator()(int r) const { int t = t0 + r; return (t >= 0 && t < len) ? rowbase + t : -1; } };

template <int NTW> DI void zero_acc(f32x4 (&acc)[4][NTW]) {
#pragma unroll
  for (int i = 0; i < 4; ++i)
#pragma unroll
    for (int j = 0; j < NTW; ++j) acc[i][j] = (f32x4){0.f, 0.f, 0.f, 0.f};
}

DI void cvt_unit(const float* __restrict__ src, int ldsrc, int srccol0, int k0, bf16_t* __restrict__ dst, int K, int n0, char* smem) {
  float* T = (float*)smem;
  const int tid = my_tid();
  __syncthreads();
  if (srccol0 >= 0) {
#pragma unroll
    for (int i = 0; i < 8; ++i) {
      int idx = tid + i * 512; int k = idx >> 6, n = idx & 63;
      T[k * 65 + n] = src[(long)(k0 + k) * ldsrc + srccol0 + n];
    }
  }
  __syncthreads();
  int n = tid >> 3, kc = (tid & 7) * 8;
  uint4 o = make_uint4(0, 0, 0, 0);
  if (srccol0 >= 0) {
    o.x = pack2(T[(kc + 0) * 65 + n], T[(kc + 1) * 65 + n]);
    o.y = pack2(T[(kc + 2) * 65 + n], T[(kc + 3) * 65 + n]);
    o.z = pack2(T[(kc + 4) * 65 + n], T[(kc + 5) * 65 + n]);
    o.w = pack2(T[(kc + 6) * 65 + n], T[(kc + 7) * 65 + n]);
  }
  *(uint4*)(dst + (long)(n0 + n) * K + k0 + kc) = o;
}

DI void ph_convert(const Params& p, int l, char* smem) {
  for (int u = blockIdx.x; u < 4480; u += gridDim.x) {
    if (u < 832) {
      int gI = u >> 4, kt = u & 15; int n0 = gI * 64; int sc;
      if (n0 < 1280) sc = n0; else if (n0 < 2048) sc = 2496 + (n0 - 1280); else if (n0 < 3264) sc = 1280 + (n0 - 2048); else sc = -1;
      cvt_unit(p.in[6] + (size_t)l * 1024 * 7360, 7360, sc, kt * 64, (bf16_t*)(p.ws + WB_IN), 1024, n0, smem);
    } else if (u < 1856) {
      int v = u - 832; int gI = v >> 4, kt = v & 15;
      cvt_unit(p.in[6] + (size_t)l * 1024 * 7360, 7360, 3264 + gI * 64, kt * 64, (bf16_t*)(p.ws + WB_GATE), 1024, gI * 64, smem);
    } else if (u < 2112) {
      int v = u - 1856; int gI = v >> 2, kt = v & 3; int j = gI >> 4, gg = gI & 15;
      cvt_unit(p.in[33] + ((size_t)l * 4 + j) * 256 * 1024, 1024, gg * 64, kt * 64, (bf16_t*)(p.ws + WB_BR) + (size_t)j * 1024 * 256, 256, gg * 64, smem);
    } else if (u < 2368) {
      int v = u - 2112; int gI = v >> 4, kt = v & 15;
      cvt_unit(p.in[34] + (size_t)l * 1024 * 1024, 1024, gI * 64, kt * 64, (bf16_t*)(p.ws + WB_OUT), 1024, gI * 64, smem);
    } else if (u < 3776) {
      int v = u - 2368; int gI = v >> 4, kt = v & 15; int nt = gI >> 1, hb = gI & 1;
      cvt_unit(p.in[37] + (size_t)l * 1024 * 5632, 5632, hb * 2816 + nt * 64, kt * 64, (bf16_t*)(p.ws + WB_UP), 1024, gI * 64, smem);
    } else {
      int v = u - 3776; int gI = v / 44, kt = v % 44;
      cvt_unit(p.in[40] + (size_t)l * 2816 * 1024, 1024, gI * 64, kt * 64, (bf16_t*)(p.ws + WB_DOWN), 2816, gI * 64, smem);
    }
  }
}

DI void ph_ada(const Params& p, char* smem) {
  float* S = (float*)smem;
  float* R = S + 9 * 1024;
  const int tid = my_tid();
  bool loaded = false;
  for (int u = blockIdx.x; u < 192; u += gridDim.x) {
    if (!loaded) {
      __syncthreads();
      for (int i = tid; i < 9 * 1024; i += NTHR) { float c = i < 8192 ? p.in[1][i] : p.in[3][i - 8192]; S[i] = siluf_(c); }
      loaded = true;
    }
    __syncthreads();
    int l = u / 96, n0 = (u % 96) * 64;
    int col = tid & 63, ks = tid >> 6;
    const float* W = p.in[4] + (size_t)l * 1024 * 6144 + n0 + col;
    float a[9];
#pragma unroll
    for (int b = 0; b < 9; ++b) a[b] = 0.f;
    for (int k = ks * 128; k < ks * 128 + 128; ++k) {
      float w = W[(size_t)k * 6144];
#pragma unroll
      for (int b = 0; b < 9; ++b) a[b] += S[b * 1024 + k] * w;
    }
#pragma unroll
    for (int b = 0; b < 9; ++b) R[(ks * 9 + b) * 64 + col] = a[b];
    __syncthreads();
    for (int i = tid; i < 9 * 64; i += NTHR) {
      int b = i >> 6, c = i & 63; float s = 0.f;
#pragma unroll
      for (int k2 = 0; k2 < 8; ++k2) s += R[(k2 * 9 + b) * 64 + c];
      s += p.in[5][(size_t)l * 6144 + n0 + c];
      ((float*)(p.ws + MISC_MOD))[((size_t)l * 9 + b) * 6144 + n0 + c] = s;
    }
  }
  for (int i = blockIdx.x * NTHR + tid; i < 4096; i += gridDim.x * NTHR) {
    float s, c; sincospif(-(float)i / 4096.f, &s, &c);
    ((float2*)(p.ws + MISC_TW))[i] = make_float2(c, s);
  }
}

DI void hy_rawfilter(const Params& p, int l, int Lf, float* __restrict__ dst, char* smem) {
  float* W1 = (float*)smem;
  float* W2 = W1 + 33 * 64;
  float* Z = W2 + 64 * 64;
  float* H1 = Z + 16 * 36;
  float* H2 = H1 + 16 * 64;
  const int tid = my_tid();
  const float* w1 = p.in[9] + (size_t)l * 33 * 64; const float* b1 = p.in[10] + l * 64;
  const float* w2 = p.in[11] + (size_t)l * 64 * 64; const float* b2 = p.in[12] + l * 64;
  const float* w3 = p.in[13] + (size_t)l * 64 * 1024; const float* fr = p.in[14] + l * 64;
  const int nunits = Lf / 16;
  bool loaded = false;
  for (int u = blockIdx.x; u < nunits; u += gridDim.x) {
    __syncthreads();
    if (!loaded) {
      for (int i = tid; i < 33 * 64; i += NTHR) W1[i] = w1[i];
      for (int i = tid; i < 64 * 64; i += NTHR) W2[i] = w2[i];
      loaded = true;
    }
    const int t0 = u * 16;
    for (int i = tid; i < 16 * 33; i += NTHR) {
      int tt = i / 33, f = i % 33; int t = t0 + tt; float v;
      if (f == 0) v = (float)t / (float)(Lf - 1);
      else {
        int bi = (f - 1) & 15;
        float wv = 6.283185307179586f * (float)t / (float)Lf;
        float fb = 1e-4f + (15.f - 1e-4f) * (float)bi / 15.f;
        float ang = wv * fb;
        v = (f <= 16) ? cosf(ang) : -sinf(ang);
      }
      Z[tt * 36 + f] = v;
    }
    __syncthreads();
    for (int i = tid; i < 16 * 64; i += NTHR) {
      int tt = i >> 6, f = i & 63; float s = b1[f];
      for (int k = 0; k < 33; ++k) s += Z[tt * 36 + k] * W1[k * 64 + f];
      H1[tt * 64 + f] = sinf(fr[f] * s);
    }
    __syncthreads();
    for (int i = tid; i < 16 * 64; i += NTHR) {
      int tt = i >> 6, f = i & 63; float s = b2[f];
      for (int k = 0; k < 64; ++k) s += H1[tt * 64 + k] * W2[k * 64 + f];
      H2[tt * 64 + f] = sinf(fr[f] * s);
    }
    __syncthreads();
    float a0[16], a1[16];
#pragma unroll
    for (int i = 0; i < 16; ++i) { a0[i] = 0.f; a1[i] = 0.f; }
    for (int k = 0; k < 64; ++k) {
      float wa = w3[k * 1024 + tid], wb = w3[k * 1024 + 512 + tid];
#pragma unroll
      for (int i = 0; i < 16; ++i) { float h = H2[i * 64 + k]; a0[i] += h * wa; a1[i] += h * wb; }
    }
    {
      int w = tid & 255;
      float delta = fabsf(-3.0701134573253944f + (-15.350567286626972f + 3.0701134573253944f) * (float)w / 255.f);
#pragma unroll
      for (int i = 0; i < 16; ++i) {
        float tn = (float)(t0 + i) / (float)(Lf - 1);
        float dec = expf(-tn * delta);
        dst[(size_t)(t0 + i) * 1024 + tid] = a0[i] * dec;
        dst[(size_t)(t0 + i) * 1024 + 512 + tid] = a1[i] * dec;
      }
    }
  }
}

DI float2 cmul(float2 a, float2 b) { return make_float2(a.x * b.x - a.y * b.y, a.x * b.y + a.y * b.x); }
DI float2 cmulc(float2 a, float2 b) { return make_float2(a.x * b.x + a.y * b.y, a.y * b.x - a.x * b.y); }
DI void fft_dif(float2* X, const float2* W) {
  const int tid = my_tid();
  for (int ls = 12; ls >= 0; --ls) {
    const int span = 1 << ls;
    __syncthreads();
#pragma unroll
    for (int i = 0; i < 8; ++i) {
      int bf = tid + i * 512; int pos = bf & (span - 1); int i0 = ((bf >> ls) << (ls + 1)) + pos; int i1 = i0 + span;
      float2 a = X[i0], b = X[i1]; float2 w = W[pos << (12 - ls)];
      X[i0] = make_float2(a.x + b.x, a.y + b.y);
      X[i1] = cmul(make_float2(a.x - b.x, a.y - b.y), w);
    }
  }
  __syncthreads();
}
DI void fft_dit_inv(float2* X, const float2* W) {
  const int tid = my_tid();
  for (int ls = 0; ls <= 12; ++ls) {
    const int span = 1 << ls;
    __syncthreads();
#pragma unroll
    for (int i = 0; i < 8; ++i) {
      int bf = tid + i * 512; int pos = bf & (span - 1); int i0 = ((bf >> ls) << (ls + 1)) + pos; int i1 = i0 + span;
      float2 a = X[i0], b = X[i1]; float2 w = W[pos << (12 - ls)];
      float2 t = cmulc(b, w);
      X[i0] = make_float2(a.x + t.x, a.y + t.y);
      X[i1] = make_float2(a.x - t.x, a.y - t.y);
    }
  }
  __syncthreads();
}
DI void load_twiddles(const Params& p, float2* W) {
  const float2* tw = (const float2*)(p.ws + MISC_TW);
  for (int i = my_tid(); i < 4096; i += NTHR) W[i] = tw[i];
}

DI void ph_kf(const Params& p, int l, char* smem) {
  float2* X = (float2*)smem; float2* W = X + 8192; float* red = (float*)(W + 4096);
  const int tid = my_tid(), lane = tid & 63, wid = tid >> 6;
  const float* rawf = (const float*)(p.ws + R_RAWF);
  float2* kf = (float2*)(p.ws + OFF_KF);
  bool tw = false;
  for (int u = blockIdx.x; u < 256; u += gridDim.x) {
    if (!tw) { load_twiddles(p, W); tw = true; }
    const int o = u >> 7, c = (u & 127) * 2;
    float2 fw[8], bw[8]; float sa = 0.f, sb = 0.f;
#pragma unroll
    for (int i = 0; i < 8; ++i) {
      int t = tid + i * 512;
      fw[i] = *(const float2*)(rawf + (size_t)t * 1024 + o * 512 + c);
      bw[i] = *(const float2*)(rawf + (size_t)t * 1024 + o * 512 + 256 + c);
      sa += fabsf(fw[i].x) + fabsf(bw[i].x); sb += fabsf(fw[i].y) + fabsf(bw[i].y);
    }
    sa = wave_sum(sa); sb = wave_sum(sb);
    __syncthreads();
    if (lane == 0) { red[wid * 2] = sa; red[wid * 2 + 1] = sb; }
    __syncthreads();
    float ta = 0.f, tb = 0.f;
#pragma unroll
    for (int w = 0; w < 8; ++w) { ta += red[w * 2]; tb += red[w * 2 + 1]; }
    const float ia = 1.f / ta, ib = 1.f / tb;
#pragma unroll
    for (int i = 0; i < 8; ++i) {
      int t = tid + i * 512;
      X[t] = make_float2(fw[i].x * ia, fw[i].y * ib);
      if (t >= 1) X[8192 - t] = make_float2(bw[i].x * ia, bw[i].y * ib);
      else X[4096] = make_float2(0.f, 0.f);
    }
    fft_dif(X, W);
    float2* ka = kf + (size_t)(o * 256 + c) * 8192; float2* kb = ka + 8192;
#pragma unroll 4
    for (int i = 0; i < 16; ++i) {
      int pidx = tid + i * 512;
      int k = (int)(__brev((unsigned)pidx) >> 19);
      int k2 = (8192 - k) & 8191;
      int p2 = (int)(__brev((unsigned)k2) >> 19);
      float2 c1 = X[pidx], c2 = X[p2];
      float2 A = make_float2(0.5f * (c1.x + c2.x), 0.5f * (c1.y - c2.y));
      float2 Bv = make_float2(0.5f * (c1.y + c2.y), -0.5f * (c1.x - c2.x));
      ka[pidx] = A; kb[pidx] = Bv;
    }
    __syncthreads();
  }
  if (l == 0) {
    const float* rawc = (const float*)(p.ws + MISC_RAWC);
    float* G = (float*)(p.ws + MISC_GCTX);
    for (int u = blockIdx.x * 8 + wid; u < 512; u += gridDim.x * 8) {
      int o = u >> 8, c = u & 255; float f[4], b[4]; float s = 0.f;
#pragma unroll
      for (int i = 0; i < 4; ++i) {
        int t = lane + i * 64;
        f[i] = rawc[(size_t)t * 1024 + o * 512 + c]; b[i] = rawc[(size_t)t * 1024 + o * 512 + 256 + c];
        s += fabsf(f[i]) + fabsf(b[i]);
      }
      s = wave_sum(s); float inv = 1.f / s;
#pragma unroll
      for (int i = 0; i < 4; ++i) {
        int t = lane + i * 64;
        G[(size_t)u * 512 + 256 + t] = f[i] * inv;
        if (t >= 1) G[(size_t)u * 512 + 256 - t] = b[i] * inv;
      }
      if (lane == 0) G[(size_t)u * 512] = 0.f;
    }
  }
}

DI void ph_ln(const float* __restrict__ src_lat, const float* __restrict__ src_ctx, float* dst_lat, float* dst_ctx,
              const float* __restrict__ ag, const float* __restrict__ ab, bf16_t* U, const float* __restrict__ mod, int sh_off, int nrows) {
  const int lane = my_tid() & 63, wid = my_tid() >> 6;
  for (int row = blockIdx.x * 8 + wid; row < nrows; row += gridDim.x * 8) {
    const float* src = row < ML ? src_lat + (size_t)row * D : src_ctx + (size_t)(row - ML) * D;
    float4 v[4];
#pragma unroll
    for (int i = 0; i < 4; ++i) v[i] = *(const float4*)(src + i * 256 + lane * 4);
    float s = 0.f;
#pragma unroll
    for (int i = 0; i < 4; ++i) s += v[i].x + v[i].y + v[i].z + v[i].w;
    float mu = wave_sum(s) * (1.f / 1024.f);
    float q = 0.f;
#pragma unroll
    for (int i = 0; i < 4; ++i) { v[i].x -= mu; v[i].y -= mu; v[i].z -= mu; v[i].w -= mu; q += v[i].x * v[i].x + v[i].y * v[i].y + v[i].z * v[i].z + v[i].w * v[i].w; }
    float rs = rsqrtf(wave_sum(q) * (1.f / 1024.f) + 1e-6f);
#pragma unroll
    for (int i = 0; i < 4; ++i) { v[i].x *= rs; v[i].y *= rs; v[i].z *= rs; v[i].w *= rs; }
    if (ag) {
      float* dst = row < ML ? dst_lat + (size_t)row * D : dst_ctx + (size_t)(row - ML) * D;
#pragma unroll
      for (int i = 0; i < 4; ++i) {
        float4 gg = *(const float4*)(ag + i * 256 + lane * 4), bb = *(const float4*)(ab + i * 256 + lane * 4);
        v[i].x = v[i].x * gg.x + bb.x; v[i].y = v[i].y * gg.y + bb.y; v[i].z = v[i].z * gg.z + bb.z; v[i].w = v[i].w * gg.w + bb.w;
        *(float4*)(dst + i * 256 + lane * 4) = v[i];
      }
      if (U) {
        s = 0.f;
#pragma unroll
        for (int i = 0; i < 4; ++i) s += v[i].x + v[i].y + v[i].z + v[i].w;
        mu = wave_sum(s) * (1.f / 1024.f); q = 0.f;
#pragma unroll
        for (int i = 0; i < 4; ++i) { v[i].x -= mu; v[i].y -= mu; v[i].z -= mu; v[i].w -= mu; q += v[i].x * v[i].x + v[i].y * v[i].y + v[i].z * v[i].z + v[i].w * v[i].w; }
        rs = rsqrtf(wave_sum(q) * (1.f / 1024.f) + 1e-6f);
#pragma unroll
        for (int i = 0; i < 4; ++i) { v[i].x *= rs; v[i].y *= rs; v[i].z *= rs; v[i].w *= rs; }
      }
    }
    if (U) {
      const float* m = mod + (size_t)mod_idx(row) * 6144 + sh_off;
#pragma unroll
      for (int i = 0; i < 4; ++i) {
        float4 sh = *(const float4*)(m + i * 256 + lane * 4), sc = *(const float4*)(m + 1024 + i * 256 + lane * 4);
        uint2 o; o.x = pack2(v[i].x * (1.f + sc.x) + sh.x, v[i].y * (1.f + sc.y) + sh.y);
        o.y = pack2(v[i].z * (1.f + sc.z) + sh.z, v[i].w * (1.f + sc.w) + sh.w);
        *(uint2*)(U + (size_t)row * D + i * 256 + lane * 4) = o;
      }
    }
  }
}

DI void ph_inproj(const Params& p, char* smem) {
  const bf16_t* U = (const bf16_t*)(p.ws + R_U);
  const bf16_t* Bt = (const bf16_t*)(p.ws + WB_IN);
  const int lane = my_tid() & 63, wid = my_tid() >> 6, wm = wid >> 1, wn = wid & 1, g = lane >> 4, r16 = lane & 15;
  const int ntiles = 136 * 26;
  for (int t = blockIdx.x; t < ntiles; t += gridDim.x) {
    const int mtile = t / 26, ntile = t % 26;
    f32x4 acc[4][4]; zero_acc<4>(acc);
    gemm_main<4>(acc, U, 1024, RowPlain{(long)mtile * 256}, Bt + (size_t)ntile * 128 * 1024, 1024, 1024, smem);
    int b, key0;
    if (mtile < 128) { b = mtile >> 4; key0 = (mtile & 15) * 256; } else { b = mtile - 128; key0 = SL; }
    bf16_t* tbase = nullptr; int tcols = 0, tcol0 = 0;
    if (ntile < 6) { tbase = (bf16_t*)(p.ws + R_PHY); tcols = 768; tcol0 = ntile * 128; }
    else if (ntile == 9) { tbase = (bf16_t*)(p.ws + R_VTSW); tcols = 128; tcol0 = 0; }
    else if (ntile == 14 || ntile == 15) { tbase = (bf16_t*)(p.ws + R_VTDF); tcols = 256; tcol0 = (ntile - 14) * 128; }
    if (tbase) {
#pragma unroll
      for (int mt = 0; mt < 4; ++mt)
#pragma unroll
        for (int nt = 0; nt < 4; ++nt) {
          int col = tcol0 + wn * 64 + nt * 16 + r16;
          int key = key0 + wm * 64 + mt * 16 + g * 4;
          uint2 o; o.x = pack2(acc[mt][nt][0], acc[mt][nt][1]); o.y = pack2(acc[mt][nt][2], acc[mt][nt][3]);
          *(uint2*)(tbase + ((size_t)b * tcols + col) * KEYS + key) = o;
        }
    } else {
      bf16_t* rb; int ld, c0, cmax;
      if (ntile < 9) { rb = (bf16_t*)(p.ws + R_PSW); ld = 384; c0 = (ntile - 6) * 128; cmax = 384; }
      else if (ntile < 14) { rb = (bf16_t*)(p.ws + R_PDF); ld = 512; c0 = (ntile - 10) * 128; cmax = 512; }
      else { rb = (bf16_t*)(p.ws + R_PRW); ld = 1216; c0 = (ntile - 16) * 128; cmax = 1216; }
#pragma unroll
      for (int mt = 0; mt < 4; ++mt)
#pragma unroll
        for (int nt = 0; nt < 4; ++nt) {
          int col = c0 + wn * 64 + nt * 16 + r16;
          if (col < cmax) {
#pragma unroll
            for (int j = 0; j < 4; ++j) {
              size_t row = (size_t)mtile * 256 + wm * 64 + mt * 16 + g * 4 + j;
              rb[row * ld + col] = (bf16_t)f2bf(acc[mt][nt][j]);
            }
          }
        }
    }
  }
}

DI float hy_conv3(const bf16_t* __restrict__ P, int t, int len, float w0, float w1, float w2, float bias) {
  float a = t >= 1 ? bf2f(P[t - 1]) : 0.f, b = bf2f(P[t]), c = (t + 1 < len) ? bf2f(P[t + 1]) : 0.f;
  return w0 * a + w1 * b + w2 * c + bias;
}
DI void ph_hyena(const Params& p, int l, char* smem) {
  float2* X = (float2*)smem; float2* W = X + 8192;
  const int tid = my_tid();
  const bf16_t* PT = (const bf16_t*)(p.ws + R_PHY);
  const float2* kf = (const float2*)(p.ws + OFF_KF);
  const float* cw = p.in[7] + (size_t)l * 3 * 768; const float* cb = p.in[8] + (size_t)l * 768;
  const float* hb = p.in[15] + (size_t)l * 512;
  bf16_t* Y = (bf16_t*)(p.ws + R_YHY);
  bool tw = false;
  for (int u = blockIdx.x; u < 1024; u += gridDim.x) {
    if (!tw) { load_twiddles(p, W); tw = true; }
    const int bp = u >> 8, c = u & 255; const int b0 = bp * 2, b1 = b0 + 1;
    const bf16_t* P0 = PT + ((size_t)b0 * 768) * KEYS; const bf16_t* P1 = PT + ((size_t)b1 * 768) * KEYS;
    float wv0 = cw[c], wv1 = cw[768 + c], wv2 = cw[1536 + c], bv = cb[c];
    float wa0 = cw[256 + c], wa1 = cw[768 + 256 + c], wa2 = cw[1536 + 256 + c], ba = cb[256 + c];
    float wb0 = cw[512 + c], wb1 = cw[768 + 512 + c], wb2 = cw[1536 + 512 + c], bb = cb[512 + c];
    const float bias0 = hb[c], bias1 = hb[256 + c];
    float2 vv[8];
    __syncthreads();
#pragma unroll
    for (int i = 0; i < 8; ++i) {
      int t = tid + i * 512;
      vv[i].x = hy_conv3(P0 + (size_t)c * KEYS, t, SL, wv0, wv1, wv2, bv);
      vv[i].y = hy_conv3(P1 + (size_t)c * KEYS, t, SL, wv0, wv1, wv2, bv);
      X[t] = vv[i]; X[t + 4096] = make_float2(0.f, 0.f);
    }
    fft_dif(X, W);
    {
      const float2* H = kf + (size_t)c * 8192;
#pragma unroll 4
      for (int i = 0; i < 16; ++i) { int q = tid + i * 512; X[q] = cmul(X[q], H[q]); }
    }
    fft_dit_inv(X, W);
    float2 zz[8];
#pragma unroll
    for (int i = 0; i < 8; ++i) {
      int t = tid + i * 512;
      float2 y = X[t];
      float x1a = hy_conv3(P0 + (size_t)(256 + c) * KEYS, t, SL, wa0, wa1, wa2, ba);
      float x1b = hy_conv3(P1 + (size_t)(256 + c) * KEYS, t, SL, wa0, wa1, wa2, ba);
      zz[i].x = x1a * (y.x * (1.f / 8192.f) + bias0 * vv[i].x);
      zz[i].y = x1b * (y.y * (1.f / 8192.f) + bias0 * vv[i].y);
    }
    __syncthreads();
#pragma unroll
    for (int i = 0; i < 8; ++i) { int t = tid + i * 512; X[t] = zz[i]; X[t + 4096] = make_float2(0.f, 0.f); }
    fft_dif(X, W);
    {
      const float2* H = kf + (size_t)(256 + c) * 8192;
#pragma unroll 4
      for (int i = 0; i < 16; ++i) { int q = tid + i * 512; X[q] = cmul(X[q], H[q]); }
    }
    fft_dit_inv(X, W);
#pragma unroll
    for (int i = 0; i < 8; ++i) {
      int t = tid + i * 512;
      float2 y = X[t];
      float x2a = hy_conv3(P0 + (size_t)(512 + c) * KEYS, t, SL, wb0, wb1, wb2, bb);
      float x2b = hy_conv3(P1 + (size_t)(512 + c) * KEYS, t, SL, wb0, wb1, wb2, bb);
      float oa = x2a * (y.x * (1.f / 8192.f) + bias1 * zz[i].x);
      float ob = x2b * (y.y * (1.f / 8192.f) + bias1 * zz[i].y);
      Y[((size_t)b0 * SL + t) * 256 + c] = (bf16_t)f2bf(oa);
      Y[((size_t)b1 * SL + t) * 256 + c] = (bf16_t)f2bf(ob);
    }
  }
}

DI void ph_hyena_ctx(const Params& p, int l, char* smem) {
  const int tid = my_tid(), lane = tid & 63, wid = tid >> 6;
  float* Zb = (float*)smem + wid * 1024;
  float* Gb = Zb + 256;
  const bf16_t* PT = (const bf16_t*)(p.ws + R_PHY);
  const float* G = (const float*)(p.ws + MISC_GCTX);
  const float* cw = p.in[7] + (size_t)l * 3 * 768; const float* cb = p.in[8] + (size_t)l * 768;
  const float* hb = p.in[15] + (size_t)l * 512;
  bf16_t* Y = (bf16_t*)(p.ws + R_YHY);
  for (int base = blockIdx.x * 8; base < 2048; base += gridDim.x * 8) {
    const int u = base + wid; const int b = u >> 8, c = u & 255;
    const bf16_t* Pb = PT + ((size_t)b * 768) * KEYS + SL;
    float v[4], x1[4], x2[4], zz[4];
#pragma unroll
    for (int i = 0; i < 4; ++i) {
      int t = lane + i * 64;
      v[i] = hy_conv3(Pb + (size_t)c * KEYS, t, CL, cw[c], cw[768 + c], cw[1536 + c], cb[c]);
      x1[i] = hy_conv3(Pb + (size_t)(256 + c) * KEYS, t, CL, cw[256 + c], cw[768 + 256 + c], cw[1536 + 256 + c], cb[256 + c]);
      x2[i] = hy_conv3(Pb + (size_t)(512 + c) * KEYS, t, CL, cw[512 + c], cw[768 + 512 + c], cw[1536 + 512 + c], cb[512 + c]);
    }
    __syncthreads();
#pragma unroll
    for (int i = 0; i < 4; ++i) Zb[lane + i * 64] = v[i];
    for (int i = lane; i < 512; i += 64) Gb[i] = G[(size_t)c * 512 + i];
    __syncthreads();
#pragma unroll
    for (int i = 0; i < 4; ++i) {
      int t = lane + i * 64; float s = 0.f;
      for (int s2 = 0; s2 < 256; ++s2) s += Gb[256 + t - s2] * Zb[s2];
      zz[i] = x1[i] * (s + hb[c] * v[i]);
    }
    __syncthreads();
#pragma unroll
    for (int i = 0; i < 4; ++i) Zb[lane + i * 64] = zz[i];
    for (int i = lane; i < 512; i += 64) Gb[i] = G[(size_t)(256 + c) * 512 + i];
    __syncthreads();
#pragma unroll
    for (int i = 0; i < 4; ++i) {
      int t = lane + i * 64; float s = 0.f;
      for (int s2 = 0; s2 < 256; ++s2) s += Gb[256 + t - s2] * Zb[s2];
      float o = x2[i] * (s + hb[256 + c] * zz[i]);
      Y[((size_t)ML + b * CL + t) * 256 + c] = (bf16_t)f2bf(o);
    }
  }
}

DI void ph_rope(const Params& p, char* smem) {
  float2* T16 = (float2*)smem;
  float2* T8 = T16 + 64 * 16;
  const int tid = my_tid(), lane = tid & 63, wid = tid >> 6;
  __syncthreads();
  for (int i = tid; i < 64 * 16; i += NTHR) {
    int pos = i >> 4, f = i & 15; float inv = powf(10000.f, -(float)f / 16.f); float s, c; sincosf((float)pos * inv, &s, &c);
    T16[i] = make_float2(c, s);
  }
  for (int i = tid; i < 64 * 8; i += NTHR) {
    int pos = i >> 3, f = i & 7; float inv = powf(10000.f, -(float)f / 8.f); float s, c; sincosf((float)pos * inv, &s, &c);
    T8[i] = make_float2(c, s);
  }
  __syncthreads();
  bf16_t* Psw = (bf16_t*)(p.ws + R_PSW); bf16_t* Pdf = (bf16_t*)(p.ws + R_PDF);
  for (int row = blockIdx.x * 8 + wid; row < ML; row += gridDim.x * 8) {
    const int t = row & (SL - 1); const int pr = t >> 6, pc = t & 63;
    bf16_t* q = Psw + (size_t)row * 384;
#pragma unroll
    for (int i = 0; i < 3; ++i) {
      int pi = lane + i * 64; int hd = pi >> 5, pp = pi & 31; int half = pp >> 4, f = pp & 15;
      int base = hd * 64 + half * 32; float2 cs = T16[(half ? pc : pr) * 16 + f];
      float x1 = bf2f(q[base + f]), x2 = bf2f(q[base + 16 + f]);
      q[base + f] = (bf16_t)f2bf(x1 * cs.x - x2 * cs.y); q[base + 16 + f] = (bf16_t)f2bf(x1 * cs.y + x2 * cs.x);
    }
    bf16_t* d = Pdf + (size_t)row * 512;
#pragma unroll
    for (int i = 0; i < 4; ++i) {
      int pi = lane + i * 64; int gi = pi >> 4, pp = pi & 15; int half = pp >> 3, f = pp & 7;
      int base = gi * 32 + half * 16; float2 cs = T8[(half ? pc : pr) * 8 + f];
      float x1 = bf2f(d[base + f]), x2 = bf2f(d[base + 8 + f]);
      d[base + f] = (bf16_t)f2bf(x1 * cs.x - x2 * cs.y); d[base + 8 + f] = (bf16_t)f2bf(x1 * cs.y + x2 * cs.x);
    }
  }
}

DI float rw_shift(const bf16_t* __restrict__ P, int row, int t, int len, int col, float mu) {
  float c = bf2f(P[(size_t)row * 1216 + col]);
  float a = t >= 1 ? bf2f(P[(size_t)(row - 1) * 1216 + col]) : 0.f;
  float b = t + 1 < len ? bf2f(P[(size_t)(row + 1) * 1216 + col]) : 0.f;
  return c + (0.5f * (a + b) - c) * mu;
}
DI void ph_rwprep(const Params& p, int l, char* smem) {
  float* ACT = (float*)smem;
  const int tid = my_tid(), lane = tid & 63;
  const bf16_t* P = (const bf16_t*)(p.ws + R_PRW);
  const float* mu = p.in[17] + (size_t)l * 1216;
  const float* w0 = p.in[18] + (size_t)l * 512; const float* w2 = p.in[19] + (size_t)l * 2 * 64 * 256;
  const float* a0 = p.in[20] + (size_t)l * 256; const float* a2 = p.in[21] + (size_t)l * 64 * 256;
  const float* g2 = p.in[22] + (size_t)l * 2 * 128 * 256;
  const float* kkw = p.in[23] + (size_t)l * 256; const float* kaw = p.in[24] + (size_t)l * 256;
  bf16_t* S = (bf16_t*)(p.ws + R_STR); bf16_t* Gs = (bf16_t*)(p.ws + R_G);
  const size_t SU = (size_t)MT * 256;
  for (int u = blockIdx.x; u < MT / 16; u += gridDim.x) {
    const int row0 = u * 16; int t0, len;
    if (row0 < ML) { t0 = row0 & (SL - 1); len = SL; } else { t0 = (row0 - ML) & (CL - 1); len = CL; }
    __syncthreads();
    for (int i = tid; i < 448 * 16; i += NTHR) {
      int col = i % 448, tk = i / 448;
      float v = rw_shift(P, row0 + tk, t0 + tk, len, 768 + col, mu[768 + col]);
      if (col < 128) v = tanhf(v); else if (col >= 192) v = sigmoidf_(v);
      ACT[col * 16 + tk] = v;
    }
    __syncthreads();
    const int c = tid & 255, th = tid >> 8;
    float df[8], db[8], aa[8], gf[8], gb[8];
#pragma unroll
    for (int i = 0; i < 8; ++i) { df[i] = 0.f; db[i] = 0.f; aa[i] = 0.f; gf[i] = 0.f; gb[i] = 0.f; }
    for (int k = 0; k < 64; ++k) {
      float wf = w2[k * 256 + c], wb = w2[64 * 256 + k * 256 + c], wa = a2[k * 256 + c];
      const float4* pf = (const float4*)(ACT + k * 16 + th * 8);
      const float4* pb = (const float4*)(ACT + (64 + k) * 16 + th * 8);
      const float4* pa = (const float4*)(ACT + (128 + k) * 16 + th * 8);
      float4 f0 = pf[0], f1 = pf[1], b0 = pb[0], b1 = pb[1], x0 = pa[0], x1 = pa[1];
      df[0] += f0.x * wf; df[1] += f0.y * wf; df[2] += f0.z * wf; df[3] += f0.w * wf; df[4] += f1.x * wf; df[5] += f1.y * wf; df[6] += f1.z * wf; df[7] += f1.w * wf;
      db[0] += b0.x * wb; db[1] += b0.y * wb; db[2] += b0.z * wb; db[3] += b0.w * wb; db[4] += b1.x * wb; db[5] += b1.y * wb; db[6] += b1.z * wb; db[7] += b1.w * wb;
      aa[0] += x0.x * wa; aa[1] += x0.y * wa; aa[2] += x0.z * wa; aa[3] += x0.w * wa; aa[4] += x1.x * wa; aa[5] += x1.y * wa; aa[6] += x1.z * wa; aa[7] += x1.w * wa;
    }
    for (int k = 0; k < 128; ++k) {
      float wf = g2[k * 256 + c], wb = g2[128 * 256 + k * 256 + c];
      const float4* pf = (const float4*)(ACT + (192 + k) * 16 + th * 8);
      const float4* pb = (const float4*)(ACT + (320 + k) * 16 + th * 8);
      float4 f0 = pf[0], f1 = pf[1], b0 = pb[0], b1 = pb[1];
      gf[0] += f0.x * wf; gf[1] += f0.y * wf; gf[2] += f0.z * wf; gf[3] += f0.w * wf; gf[4] += f1.x * wf; gf[5] += f1.y * wf; gf[6] += f1.z * wf; gf[7] += f1.w * wf;
      gb[0] += b0.x * wb; gb[1] += b0.y * wb; gb[2] += b0.z * wb; gb[3] += b0.w * wb; gb[4] += b1.x * wb; gb[5] += b1.y * wb; gb[6] += b1.z * wb; gb[7] += b1.w * wb;
    }
    const float w0f = w0[c], w0b = w0[256 + c], a0c = a0[c], kkc = kkw[c], kac = kaw[c];
    const float mur = mu[c], muk = mu[256 + c], muv = mu[512 + c];
#pragma unroll
    for (int i = 0; i < 8; ++i) {
      const int tk = th * 8 + i; const int row = row0 + tk, t = t0 + tk;
      float r = rw_shift(P, row, t, len, c, mur), k = rw_shift(P, row, t, len, 256 + c, muk), v = rw_shift(P, row, t, len, 512 + c, muv);
      float a = sigmoidf_(a0c + aa[i]);
      float kk = k * kkc; float n2 = wave_sum(kk * kk); kk = kk / fmaxf(sqrtf(n2), 1e-12f);
      float kp = k * (1.f + (a - 1.f) * kac);
      float bq = kk * a;
      float xf = -(w0f + df[i]); float spf = fmaxf(xf, 0.f) + log1pf(__expf(-fabsf(xf)));
      float xb = -(w0b + db[i]); float spb = fmaxf(xb, 0.f) + log1pf(__expf(-fabsf(xb)));
      float ef = __expf(-spf - 0.5f), eb = __expf(-spb - 0.5f);
      float d_f = -expm1f(-ef), d_b = -expm1f(-eb);
      size_t o = (size_t)row * 256 + c;
      S[o] = (bf16_t)f2bf(r); S[SU + o] = (bf16_t)f2bf(kp); S[2 * SU + o] = (bf16_t)f2bf(v); S[3 * SU + o] = (bf16_t)f2bf(kk);
      S[4 * SU + o] = (bf16_t)f2bf(bq); S[5 * SU + o] = (bf16_t)f2bf(d_f); S[6 * SU + o] = (bf16_t)f2bf(d_b);
      Gs[o] = (bf16_t)f2bf(gf[i]); Gs[SU + o] = (bf16_t)f2bf(gb[i]);
    }
  }
}

DI long scan_row(int b, int dir, int s) {
  if (s < CL) return (long)ML + b * CL + (dir ? (CL - 1 - s) : s);
  int t = s - CL; return (long)b * SL + (dir ? (SL - 1 - t) : t);
}
DI void ph_scan(const Params& p, char* smem) {
  const int tid = my_tid(), lane = tid & 63, wid = tid >> 6;
  const bf16_t* S = (const bf16_t*)(p.ws + R_STR);
  const size_t SU = (size_t)MT * 256;
  constexpr int NSTEP = CL + SL, NCH = NSTEP / 64;
  for (int u = blockIdx.x; u < 256; u += gridDim.x) {
    const int chain = u >> 2, rg = u & 3; const int dir = chain & 1, bh = chain >> 1, b = bh >> 2, h = bh & 3;
    bf16_t* O = (bf16_t*)(p.ws + (dir ? R_OB : R_OF));
    uint4 q0, q1, q2, q3, q4, q5;
    auto SC_GLOAD = [&](int ci) {
#pragma unroll
      for (int j = 0; j < 6; ++j) {
        int idx = tid + j * 512; int s = (idx & 511) >> 3, ck = idx & 7;
        long row = scan_row(b, dir, ci * 64 + s);
        int sid = j < 5 ? j : 5 + dir;
        uint4 v = *(const uint4*)(S + sid * SU + row * 256 + h * 64 + ck * 8);
        if (j == 0) q0 = v; else if (j == 1) q1 = v; else if (j == 2) q2 = v; else if (j == 3) q3 = v; else if (j == 4) q4 = v; else q5 = v;
      }
    };
    auto SC_SSTORE = [&](int buf) {
      char* base = smem + buf * 49152 + tid * 16;
      *(uint4*)(base) = q0; *(uint4*)(base + 8192) = q1; *(uint4*)(base + 2 * 8192) = q2;
      *(uint4*)(base + 3 * 8192) = q3; *(uint4*)(base + 4 * 8192) = q4; *(uint4*)(base + 5 * 8192) = q5;
    };
    __syncthreads();
    SC_GLOAD(0);
    SC_SSTORE(0);
    __syncthreads();
    float s0 = 0.f, s1 = 0.f, s2 = 0.f, s3 = 0.f;
    const int rsub = lane >> 4, ks = lane & 15;
    const int vrow = rg * 16 + wid * 4 + rsub;
    for (int ci = 0; ci < NCH; ++ci) {
      if (ci + 1 < NCH) { SC_GLOAD(ci + 1); }
      if (wid < 4) {
        const char* B = smem + (ci & 1) * 49152;
#pragma unroll 4
        for (int s = 0; s < 64; ++s) {
          uint2 ur = *(const uint2*)(B + 0 * 8192 + s * 128 + ks * 8);
          uint2 uk = *(const uint2*)(B + 1 * 8192 + s * 128 + ks * 8);
          unsigned short uv = *(const unsigned short*)(B + 2 * 8192 + s * 128 + vrow * 2);
          uint2 ukk = *(const uint2*)(B + 3 * 8192 + s * 128 + ks * 8);
          uint2 ub = *(const uint2*)(B + 4 * 8192 + s * 128 + ks * 8);
          uint2 ud = *(const uint2*)(B + 5 * 8192 + s * 128 + ks * 8);
          float kk0 = bflo(ukk.x), kk1 = bfhi(ukk.x), kk2 = bflo(ukk.y), kk3 = bfhi(ukk.y);
          float sa = -((s0 * kk0 + s1 * kk1) + (s2 * kk2 + s3 * kk3));
          sa = sum16(sa);
          float v = bf2f(uv);
          float w0_ = 1.f - bflo(ud.x), w1_ = 1.f - bfhi(ud.x), w2_ = 1.f - bflo(ud.y), w3_ = 1.f - bfhi(ud.y);
          s0 = s0 * w0_ + sa * bflo(ub.x) + v * bflo(uk.x);
          s1 = s1 * w1_ + sa * bfhi(ub.x) + v * bfhi(uk.x);
          s2 = s2 * w2_ + sa * bflo(ub.y) + v * bflo(uk.y);
          s3 = s3 * w3_ + sa * bfhi(ub.y) + v * bfhi(uk.y);
          float o = (s0 * bflo(ur.x) + s1 * bfhi(ur.x)) + (s2 * bflo(ur.y) + s3 * bfhi(ur.y));
          o = sum16(o);
          if (ks == 0) {
            long row = scan_row(b, dir, ci * 64 + s);
            O[row * 256 + h * 64 + vrow] = (bf16_t)f2bf(o);
          }
        }
      }
      if (ci + 1 < NCH) { SC_SSTORE((ci + 1) & 1); }
      __syncthreads();
    }
  }
}

template <bool DIFF>
DI void attn_unit(const Params& p, int l, int b, int h, int qrow0, int qpos0, int kb_lo, int kb_hi, int kc_lo, char* smem) {
  const int tid = my_tid(), lane = tid & 63, wid = tid >> 6, g = lane >> 4, r16 = lane & 15;
  const bf16_t* QK = (const bf16_t*)(p.ws + (DIFF ? R_PDF : R_PSW));
  const int ldq = DIFF ? 512 : 384;
  const int qc0 = h * 64;
  const int kc0 = 256 + (DIFF ? h * 64 : (h >> 1) * 64);
  const bf16_t* VT = DIFF ? (const bf16_t*)(p.ws + R_VTDF) + ((size_t)b * 256 + h * 64) * KEYS
                          : (const bf16_t*)(p.ws + R_VTSW) + ((size_t)b * 128 + (h >> 1) * 64) * KEYS;
  const int nblk = (kb_hi - kb_lo) + (68 - kc_lo);
  const float sc = (DIFF ? 0.17677669529663687f : 0.125f) * 1.4426950408889634f;
  bf16x8 qf[2];
  {
    const bf16_t* qp = QK + (size_t)(qrow0 + wid * 16 + r16) * ldq + qc0 + g * 8;
    qf[0] = *(const bf16x8*)(qp); qf[1] = *(const bf16x8*)(qp + 32);
  }
  constexpr int NC = DIFF ? 2 : 1;
  float m[NC], lsum[NC];
  f32x4 O[NC][4];
#pragma unroll
  for (int c = 0; c < NC; ++c) {
    if (DIFF) { m[c] = -1e30f; lsum[c] = 0.f; }
    else { m[c] = p.in[16][l * 4 + h] * 1.4426950408889634f; lsum[c] = (g == 0) ? 1.f : 0.f; }
#pragma unroll
    for (int dt = 0; dt < 4; ++dt) O[c][dt] = (f32x4){0.f, 0.f, 0.f, 0.f};
  }
  const int lr = tid >> 3, lc = tid & 7;
  uint4 rk, rv;
#define AT_GLOAD(i)                                                                                   \
  do {                                                                                                \
    int kb = (i) < (kb_hi - kb_lo) ? kb_lo + (i) : kc_lo + ((i) - (kb_hi - kb_lo));                    \
    long krow = kb < 64 ? (long)b * SL + kb * 64 + lr : (long)ML + b * CL + (kb - 64) * 64 + lr;       \
    rk = *(const uint4*)(QK + krow * ldq + kc0 + lc * 8);                                             \
    rv = *(const uint4*)(VT + (size_t)lr * KEYS + kb * 64 + lc * 8);                                  \
  } while (0)
#define AT_SSTORE(buf)                                                                                \
  do {                                                                                                \
    *(uint4*)(smem + (buf) * 18432 + lr * 144 + lc * 16) = rk;                                        \
    *(uint4*)(smem + (buf) * 18432 + 9216 + lr * 144 + lc * 16) = rv;                                 \
  } while (0)
  __syncthreads();
  AT_GLOAD(0);
  AT_SSTORE(0);
  __syncthreads();
  const int qpos = qpos0 + wid * 16 + r16;
  for (int i = 0; i < nblk; ++i) {
    if (i + 1 < nblk) AT_GLOAD(i + 1);
    const int kb = i < (kb_hi - kb_lo) ? kb_lo + i : kc_lo + (i - (kb_hi - kb_lo));
    const bool masked = (!DIFF) && (kb < 64);
    const char* Kt = smem + (i & 1) * 18432; const char* Vt = Kt + 9216;
    f32x4 S[NC][4];
#pragma unroll
    for (int kt = 0; kt < 4; ++kt) {
      bf16x8 k0 = *(const bf16x8*)(Kt + (kt * 16 + r16) * 144 + g * 16);
      bf16x8 k1 = *(const bf16x8*)(Kt + (kt * 16 + r16) * 144 + 64 + g * 16);
      if (DIFF) {
        S[0][kt] = __builtin_amdgcn_mfma_f32_16x16x32_bf16(k0, qf[0], (f32x4){0.f, 0.f, 0.f, 0.f}, 0, 0, 0);
        S[NC - 1][kt] = __builtin_amdgcn_mfma_f32_16x16x32_bf16(k1, qf[1], (f32x4){0.f, 0.f, 0.f, 0.f}, 0, 0, 0);
      } else {
        f32x4 t = __builtin_amdgcn_mfma_f32_16x16x32_bf16(k0, qf[0], (f32x4){0.f, 0.f, 0.f, 0.f}, 0, 0, 0);
        S[0][kt] = __builtin_amdgcn_mfma_f32_16x16x32_bf16(k1, qf[1], t, 0, 0, 0);
      }
    }
    bf16x8 pf[NC][2];
#pragma unroll
    for (int c = 0; c < NC; ++c) {
      float mx = -1e30f;
#pragma unroll
      for (int kt = 0; kt < 4; ++kt)
#pragma unroll
        for (int j = 0; j < 4; ++j) {
          float v = S[c][kt][j] * sc;
          if (masked) { int kpos = kb * 64 + kt * 16 + g * 4 + j; int dd = kpos - qpos; if (dd > 128 || dd < -128) v = -1e30f; }
          S[c][kt][j] = v; mx = fmaxf(mx, v);
        }
      mx = fmaxf(mx, __shfl_xor(mx, 16)); mx = fmaxf(mx, __shfl_xor(mx, 32));
      float mn = fmaxf(m[c], mx);
      float alpha = exp2f(m[c] - mn);
      m[c] = mn;
      float ps = 0.f;
      unsigned pk[8];
#pragma unroll
      for (int kt = 0; kt < 4; ++kt) {
        float e0 = exp2f(S[c][kt][0] - mn), e1 = exp2f(S[c][kt][1] - mn), e2 = exp2f(S[c][kt][2] - mn), e3 = exp2f(S[c][kt][3] - mn);
        ps += (e0 + e1) + (e2 + e3);
        pk[kt * 2] = pack2(e0, e1); pk[kt * 2 + 1] = pack2(e2, e3);
      }
      lsum[c] = lsum[c] * alpha + ps;
#pragma unroll
      for (int dt = 0; dt < 4; ++dt) { O[c][dt][0] *= alpha; O[c][dt][1] *= alpha; O[c][dt][2] *= alpha; O[c][dt][3] *= alpha; }
      union { unsigned u[4]; bf16x8 v; } cv;
      cv.u[0] = pk[0]; cv.u[1] = pk[1]; cv.u[2] = pk[2]; cv.u[3] = pk[3]; pf[c][0] = cv.v;
      cv.u[0] = pk[4]; cv.u[1] = pk[5]; cv.u[2] = pk[6]; cv.u[3] = pk[7]; pf[c][1] = cv.v;
    }
#pragma unroll
    for (int dt = 0; dt < 4; ++dt)
#pragma unroll
      for (int s2 = 0; s2 < 2; ++s2) {
        union { uint2 u[2]; bf16x8 v; } vf;
        vf.u[0] = *(const uint2*)(Vt + (dt * 16 + r16) * 144 + (2 * s2) * 32 + g * 8);
        vf.u[1] = *(const uint2*)(Vt + (dt * 16 + r16) * 144 + (2 * s2 + 1) * 32 + g * 8);
#pragma unroll
        for (int c = 0; c < NC; ++c) O[c][dt] = __builtin_amdgcn_mfma_f32_16x16x32_bf16(vf.v, pf[c][s2], O[c][dt], 0, 0, 0);
      }
    if (i + 1 < nblk) AT_SSTORE((i + 1) & 1);
    __syncthreads();
  }
#undef AT_GLOAD
#undef AT_SSTORE
  float linv[NC];
#pragma unroll
  for (int c = 0; c < NC; ++c) { float t = lsum[c]; t += __shfl_xor(t, 16); t += __shfl_xor(t, 32); linv[c] = 1.f / t; }
  const size_t orow = (size_t)(qrow0 + wid * 16 + r16);
  if (!DIFF) {
    bf16_t* Y = (bf16_t*)(p.ws + R_YSW);
#pragma unroll
    for (int dt = 0; dt < 4; ++dt) {
      uint2 o; o.x = pack2(O[0][dt][0] * linv[0], O[0][dt][1] * linv[0]); o.y = pack2(O[0][dt][2] * linv[0], O[0][dt][3] * linv[0]);
      *(uint2*)(Y + orow * 256 + h * 64 + dt * 16 + g * 4) = o;
    }
  } else {
    const float lam_init = 0.8f - 0.6f * __expf(-0.3f * (float)l);
    float d1 = 0.f, d2 = 0.f;
    if (lane < 32) { d1 = p.in[28][l * 32 + lane] * p.in[29][l * 32 + lane]; d2 = p.in[30][l * 32 + lane] * p.in[31][l * 32 + lane]; }
    d1 = wave_sum(d1); d2 = wave_sum(d2);
    const float lam = expf(d1) - expf(d2) + lam_init;
    float ov[4][4]; float ss = 0.f;
#pragma unroll
    for (int dt = 0; dt < 4; ++dt)
#pragma unroll
      for (int j = 0; j < 4; ++j) { float v = O[0][dt][j] * linv[0] - lam * O[NC - 1][dt][j] * linv[NC - 1]; ov[dt][j] = v; ss += v * v; }
    ss += __shfl_xor(ss, 16); ss += __shfl_xor(ss, 32);
    const float rms = rsqrtf(ss * (1.f / 64.f) + 1e-5f) * (1.f - lam_init);
    const float* sg = p.in[32] + l * 64;
    bf16_t* Y = (bf16_t*)(p.ws + R_YDF);
#pragma unroll
    for (int dt = 0; dt < 4; ++dt) {
      const int d0 = dt * 16 + g * 4;
      uint2 o; o.x = pack2(ov[dt][0] * rms * sg[d0], ov[dt][1] * rms * sg[d0 + 1]); o.y = pack2(ov[dt][2] * rms * sg[d0 + 2], ov[dt][3] * rms * sg[d0 + 3]);
      *(uint2*)(Y + orow * 256 + h * 64 + d0) = o;
    }
  }
}

DI void ph_attn(const Params& p, int l, char* smem) {
  const bool need_ctx = (l == 0);
  const int n_sw = 1024 + (need_ctx ? 64 : 0);
  const int n_df = 1024 + (need_ctx ? 64 : 0);
  for (int u = blockIdx.x; u < n_sw + n_df; u += gridDim.x) {
    if (u < n_df) {
      if (u < 1024) { int b = u >> 7, h = (u >> 5) & 3, n = u & 31; attn_unit<true>(p, l, b, h, b * SL + n * 128, n * 128, 0, 64, 64, smem); }
      else { int v = u - 1024; int b = v >> 3, h = (v >> 1) & 3, n = v & 1; attn_unit<true>(p, l, b, h, ML + b * CL + n * 128, 0, 0, 0, 64, smem); }
    } else {
      int w = u - n_df;
      if (w < 1024) {
        int b = w >> 7, h = (w >> 5) & 3, n = w & 31;
        int lo = (n - 1) * 2; if (lo < 0) lo = 0; int hi = (n + 2) * 2; if (hi > 64) hi = 64;
        attn_unit<false>(p, l, b, h, b * SL + n * 128, n * 128, lo, hi, 64, smem);
      } else { int v = w - 1024; int b = v >> 3, h = (v >> 1) & 3, n = v & 1; attn_unit<false>(p, l, b, h, ML + b * CL + n * 128, 0, 0, 0, 64, smem); }
    }
  }
}

DI void ph_rwout(const Params& p, int l) {
  const int lane = my_tid() & 63, wid = my_tid() >> 6;
  const bf16_t* S = (const bf16_t*)(p.ws + R_STR); const bf16_t* Gs = (const bf16_t*)(p.ws + R_G);
  const bf16_t* OF = (const bf16_t*)(p.ws + R_OF); const bf16_t* OB = (const bf16_t*)(p.ws + R_OB);
  bf16_t* Y = (bf16_t*)(p.ws + R_YRW);
  const size_t SU = (size_t)MT * 256;
  const float4 rk = *(const float4*)(p.in[25] + (size_t)l * 256 + lane * 4);
  const float4 gam = *(const float4*)(p.in[26] + (size_t)l * 256 + lane * 4);
  const float4 bet = *(const float4*)(p.in[27] + (size_t)l * 256 + lane * 4);
  const int nrows = (l == 0) ? MT : ML;
  for (int row = blockIdx.x * 8 + wid; row < nrows; row += gridDim.x * 8) {
    const size_t o = (size_t)row * 256 + lane * 4;
    uint2 ur = *(const uint2*)(S + o), uk = *(const uint2*)(S + SU + o), uv = *(const uint2*)(S + 2 * SU + o);
    uint2 uf = *(const uint2*)(OF + o), ub = *(const uint2*)(OB + o), ugf = *(const uint2*)(Gs + o), ugb = *(const uint2*)(Gs + SU + o);
    float r[4] = {bflo(ur.x), bfhi(ur.x), bflo(ur.y), bfhi(ur.y)};
    float k[4] = {bflo(uk.x), bfhi(uk.x), bflo(uk.y), bfhi(uk.y)};
    float v[4] = {bflo(uv.x), bfhi(uv.x), bflo(uv.y), bfhi(uv.y)};
    float f[4] = {bflo(uf.x), bfhi(uf.x), bflo(uf.y), bfhi(uf.y)};
    float bb[4] = {bflo(ub.x), bfhi(ub.x), bflo(ub.y), bfhi(ub.y)};
    float gf[4] = {bflo(ugf.x), bfhi(ugf.x), bflo(ugf.y), bfhi(ugf.y)};
    float gb[4] = {bflo(ugb.x), bfhi(ugb.x), bflo(ugb.y), bfhi(ugb.y)};
    const float rkv[4] = {rk.x, rk.y, rk.z, rk.w}; const float ga[4] = {gam.x, gam.y, gam.z, gam.w}; const float be[4] = {bet.x, bet.y, bet.z, bet.w};
    float bon = 0.f, sf = 0.f, sb = 0.f;
#pragma unroll
    for (int i = 0; i < 4; ++i) { bon += r[i] * k[i] * rkv[i]; sf += f[i]; sb += bb[i]; }
    bon = sum16(bon); float muf = sum16(sf) * (1.f / 64.f), mub = sum16(sb) * (1.f / 64.f);
    float qf = 0.f, qb = 0.f;
#pragma unroll
    for (int i = 0; i < 4; ++i) { f[i] -= muf; bb[i] -= mub; qf += f[i] * f[i]; qb += bb[i] * bb[i]; }
    float rsf = rsqrtf(sum16(qf) * (1.f / 64.f) + 64e-5f), rsb = rsqrtf(sum16(qb) * (1.f / 64.f) + 64e-5f);
    float y[4];
#pragma unroll
    for (int i = 0; i < 4; ++i) {
      float bn = bon * v[i];
      y[i] = (f[i] * rsf * ga[i] + be[i] + bn) * gf[i] + (bb[i] * rsb * ga[i] + be[i] + bn) * gb[i];
    }
    uint2 oo; oo.x = pack2(y[0], y[1]); oo.y = pack2(y[2], y[3]);
    *(uint2*)(Y + o) = oo;
  }
}

DI void ph_merge(const Params& p, int l, char* smem) {
  const bf16_t* U = (const bf16_t*)(p.ws + R_URE);
  const int lane = my_tid() & 63, wid = my_tid() >> 6, wm = wid >> 1, wn = wid & 1, g = lane >> 4, r16 = lane & 15;
  const int mtiles = (l == 0) ? 136 : 128;
  bf16_t* ACC = (bf16_t*)(p.ws + R_ACC);
  for (int t = blockIdx.x; t < mtiles * 16; t += gridDim.x) {
    const int mtile = t >> 4, ntile = t & 15;
    f32x4 accS[4][2]; zero_acc<2>(accS);
    for (int j = 0; j < 4; ++j) {
      f32x4 accG[4][2], accB[4][2]; zero_acc<2>(accG); zero_acc<2>(accB);
      gemm_main<2>(accG, U, 1024, RowPlain{(long)mtile * 256}, (const bf16_t*)(p.ws + WB_GATE) + ((size_t)j * 1024 + ntile * 64) * 1024, 1024, 1024, smem);
      const size_t yoff = (j == 0) ? R_YHY : (j == 1) ? R_YSW : (j == 2) ? R_YRW : R_YDF;
      gemm_main<2>(accB, (const bf16_t*)(p.ws + yoff), 256, RowPlain{(long)mtile * 256}, (const bf16_t*)(p.ws + WB_BR) + ((size_t)j * 1024 + ntile * 64) * 256, 256, 256, smem);
#pragma unroll
      for (int mt = 0; mt < 4; ++mt)
#pragma unroll
        for (int nt = 0; nt < 2; ++nt)
#pragma unroll
          for (int e = 0; e < 4; ++e) accS[mt][nt][e] += sigmoidf_(accG[mt][nt][e]) * accB[mt][nt][e];
    }
#pragma unroll
    for (int mt = 0; mt < 4; ++mt)
#pragma unroll
      for (int nt = 0; nt < 2; ++nt)
#pragma unroll
        for (int e = 0; e < 4; ++e) {
          size_t row = (size_t)mtile * 256 + wm * 64 + mt * 16 + g * 4 + e; int col = ntile * 64 + wn * 32 + nt * 16 + r16;
          ACC[row * 1024 + col] = (bf16_t)f2bf(accS[mt][nt][e]);
        }
  }
}

DI void ph_resgemm(const Params& p, int l, const bf16_t* A, int K, const bf16_t* Bt, const float* hsrc_lat, const float* hsrc_ctx, int gate_off, char* smem) {
  const int lane = my_tid() & 63, wid = my_tid() >> 6, wm = wid >> 1, wn = wid & 1, g = lane >> 4, r16 = lane & 15;
  const int mtiles = (l == 0) ? 136 : 128;
  const float* mod = (const float*)(p.ws + MISC_MOD) + (size_t)l * 9 * 6144;
  float* hc = (float*)(p.ws + OFF_HC);
  for (int t = blockIdx.x; t < mtiles * 8; t += gridDim.x) {
    const int mtile = t >> 3, ntile = t & 7;
    f32x4 acc[4][4]; zero_acc<4>(acc);
    gemm_main<4>(acc, A, K, RowPlain{(long)mtile * 256}, Bt + (size_t)ntile * 128 * K, K, K, smem);
    const int b = mtile < 128 ? (mtile >> 4) : 8;
    const float* gt = mod + (size_t)b * 6144 + gate_off;
#pragma unroll
    for (int mt = 0; mt < 4; ++mt)
#pragma unroll
      for (int nt = 0; nt < 4; ++nt) {
        const int col = ntile * 128 + wn * 64 + nt * 16 + r16; const float gv = gt[col];
#pragma unroll
        for (int e = 0; e < 4; ++e) {
          const int row = mtile * 256 + wm * 64 + mt * 16 + g * 4 + e;
          if (row < ML) { size_t o = (size_t)row * D + col; p.out[o] = DN_ALPHA * hsrc_lat[o] + gv * acc[mt][nt][e]; }
          else { size_t o = (size_t)(row - ML) * D + col; hc[o] = DN_ALPHA * hsrc_ctx[o] + gv * acc[mt][nt][e]; }
        }
      }
  }
}

DI void ph_ffnup(const Params& p, int l, char* smem) {
  const bf16_t* U = (const bf16_t*)(p.ws + R_U);
  const bf16_t* Bt = (const bf16_t*)(p.ws + WB_UP);
  bf16_t* HID = (bf16_t*)(p.ws + R_HID);
  const float* cw = p.in[38] + (size_t)l * 3 * 5632; const float* cb = p.in[39] + (size_t)l * 5632;
  const int tid = my_tid(), lane = tid & 63, wid = tid >> 6, wm = wid >> 1, wn = wid & 1, g = lane >> 4, r16 = lane & 15;
  const int mtiles = (l == 0) ? 152 : 136;
  float* T = (float*)smem;
  for (int t = blockIdx.x; t < mtiles * 44; t += gridDim.x) {
    const int mtile = t / 44, ntile = t % 44;
    long rowbase; int tt, len;
    if (mtile < 136) { int b = mtile / 17; tt = mtile % 17; len = SL; rowbase = (long)b * SL; }
    else { int v = mtile - 136; int b = v >> 1; tt = v & 1; len = CL; rowbase = (long)ML + b * CL; }
    f32x4 acc[4][4]; zero_acc<4>(acc);
    gemm_main<4>(acc, U, 1024, RowHalo{rowbase, tt * 254 - 1, len}, Bt + (size_t)ntile * 128 * 1024, 1024, 1024, smem);
#pragma unroll
    for (int mt = 0; mt < 4; ++mt)
#pragma unroll
      for (int nt = 0; nt < 4; ++nt)
#pragma unroll
        for (int e = 0; e < 4; ++e) T[(wm * 64 + mt * 16 + g * 4 + e) * 132 + wn * 64 + nt * 16 + r16] = acc[mt][nt][e];
    __syncthreads();
    {
      const int ch = tid & 63, rgp = tid >> 6; const int ca = ntile * 64 + ch, cbx = 2816 + ca;
      const float a0 = cw[ca], a1 = cw[5632 + ca], a2 = cw[2 * 5632 + ca], ab = cb[ca];
      const float b0 = cw[cbx], b1 = cw[5632 + cbx], b2 = cw[2 * 5632 + cbx], bb = cb[cbx];
      for (int r = 1 + rgp; r <= 254; r += 8) {
        int tok = tt * 254 - 1 + r;
        if (tok < len) {
          float av = a0 * T[(r - 1) * 132 + ch] + a1 * T[r * 132 + ch] + a2 * T[(r + 1) * 132 + ch] + ab;
          float bv = b0 * T[(r - 1) * 132 + 64 + ch] + b1 * T[r * 132 + 64 + ch] + b2 * T[(r + 1) * 132 + 64 + ch] + bb;
          HID[(size_t)(rowbase + tok) * 2816 + ca] = (bf16_t)f2bf(siluf_(av) * bv);
        }
      }
    }
  }
}

#ifndef PH_END
#define PH_END 24
#endif
#define SYNC_OR_RET(idx) do { if ((idx) + 1 >= PH_END) return; grid.sync(); } while (0)
template <int l>
DI void run_layer(const Params& p, cg::grid_group& grid, char* smem) {
  const float* mod = (const float*)(p.ws + MISC_MOD) + (size_t)l * 9 * 6144;
  float* hc = (float*)(p.ws + OFF_HC);
  const float* hl_src = (l == 0) ? p.in[0] : p.out;
  const float* hc_src = (l == 0) ? p.in[2] : hc;
  constexpr int B0 = l * 12;
  ph_convert(p, l, smem);
  if (l == 0) ph_ada(p, smem);
  hy_rawfilter(p, l, SL, (float*)(p.ws + R_RAWF), smem);
  if (l == 0) hy_rawfilter(p, l, CL, (float*)(p.ws + MISC_RAWC), smem);
  SYNC_OR_RET(B0 + 0);
  ph_kf(p, l, smem);
  ph_ln(hl_src, hc_src, nullptr, nullptr, nullptr, nullptr, (bf16_t*)(p.ws + R_U), mod, 0, MT);
  SYNC_OR_RET(B0 + 1);
  ph_inproj(p, smem);
  SYNC_OR_RET(B0 + 2);
  ph_hyena(p, l, smem);
  if (l == 0) ph_hyena_ctx(p, l, smem);
  ph_rope(p, smem);
  ph_rwprep(p, l, smem);
  SYNC_OR_RET(B0 + 3);
  ph_scan(p, smem);
  ph_attn(p, l, smem);
  SYNC_OR_RET(B0 + 4);
  ph_rwout(p, l);
  ph_ln(hl_src, hc_src, nullptr, nullptr, nullptr, nullptr, (bf16_t*)(p.ws + R_URE), mod, 0, l == 0 ? MT : ML);
  SYNC_OR_RET(B0 + 5);
  ph_merge(p, l, smem);
  SYNC_OR_RET(B0 + 6);
  ph_resgemm(p, l, (const bf16_t*)(p.ws + R_ACC), 1024, (const bf16_t*)(p.ws + WB_OUT), hl_src, hc_src, 2048, smem);
  SYNC_OR_RET(B0 + 7);
  ph_ln(p.out, hc, p.out, hc, p.in[35] + (size_t)l * D, p.in[36] + (size_t)l * D, (bf16_t*)(p.ws + R_U), mod, 3072, l == 0 ? MT : ML);
  SYNC_OR_RET(B0 + 8);
  ph_ffnup(p, l, smem);
  SYNC_OR_RET(B0 + 9);
  ph_resgemm(p, l, (const bf16_t*)(p.ws + R_HID), 2816, (const bf16_t*)(p.ws + WB_DOWN), p.out, hc, 5120, smem);
  SYNC_OR_RET(B0 + 10);
  ph_ln(p.out, hc, p.out, hc, p.in[41] + (size_t)l * D, p.in[42] + (size_t)l * D, nullptr, mod, 0, l == 0 ? MT : ML);
  SYNC_OR_RET(B0 + 11);
}

__global__ void __launch_bounds__(NTHR) mega(Params p) {
  extern __shared__ __attribute__((aligned(16))) char smem[];
  cg::grid_group grid = cg::this_grid();
  run_layer<0>(p, grid, smem);
  if (PH_END > 12) run_layer<1>(p, grid, smem);
}

extern "C" void kernel_launch(void* const* d_in, const int* in_sizes, int n_in, void* d_out, int out_size,
                              void* d_ws, size_t ws_size, hipStream_t stream) {
  static int grid_blocks = 0;
  if (!grid_blocks) {
    int dev = 0, cus = 0, per_cu = 0;
    (void)hipGetDevice(&dev);
    (void)hipDeviceGetAttribute(&cus, hipDeviceAttributeMultiprocessorCount, dev);
    (void)hipFuncSetAttribute((const void*)mega, hipFuncAttributeMaxDynamicSharedMemorySize, SMEM_BYTES);
    (void)hipOccupancyMaxActiveBlocksPerMultiprocessor(&per_cu, mega, NTHR, SMEM_BYTES);
    if (per_cu < 1) per_cu = 1;
    if (per_cu > 1) per_cu = 1;
    grid_blocks = cus * per_cu;
  }
  Params p{};
  for (int i = 0; i < 43; ++i) p.in[i] = (const float*)d_in[i];
  p.out = (float*)d_out; p.ws = (char*)d_ws;
  void* args[] = {&p};
  hipError_t e = hipLaunchCooperativeKernel((void*)mega, dim3(grid_blocks), dim3(NTHR), args, SMEM_BYTES, stream);
  if (e != hipSuccess) fprintf(stderr, "cooperative launch failed: %s (grid %d)\n", hipGetErrorString(e), grid_blocks);
}
```

```cpp
#include <hip/hip_runtime.h>
#include <hip/hip_cooperative_groups.h>
#include <cstdio>
#include <cstdint>
namespace cg = cooperative_groups;

#define DI __device__ __forceinline__
typedef unsigned short bf16_t;
typedef short bf16x8 __attribute__((ext_vector_type(8)));
typedef float f32x4 __attribute__((ext_vector_type(4)));

constexpr int D = 1024, NB = 8, SL = 4096, CL = 256;
constexpr int ML = NB * SL, MC = NB * CL, MT = ML + MC;
constexpr int KEYS = SL + CL;
constexpr int NTHR = 512;
constexpr float DN_ALPHA = 1.41421356237f;
constexpr size_t UNIT = (size_t)MT * 512;

constexpr size_t WB_IN = 0;
constexpr size_t WB_GATE = WB_IN + (size_t)3328 * 1024 * 2;
constexpr size_t WB_BR = WB_GATE + (size_t)4096 * 1024 * 2;
constexpr size_t WB_OUT = WB_BR + (size_t)4 * 1024 * 256 * 2;
constexpr size_t WB_UP = WB_OUT + (size_t)1024 * 1024 * 2;
constexpr size_t WB_DOWN = WB_UP + (size_t)5632 * 1024 * 2;
constexpr size_t WB_END = WB_DOWN + (size_t)1024 * 2816 * 2;
constexpr size_t OFF_KF = WB_END;
constexpr size_t OFF_HC = OFF_KF + (size_t)512 * 8192 * 8;
constexpr size_t OFF_MISC = OFF_HC + (size_t)MC * D * 4;
constexpr size_t MISC_MOD = OFF_MISC;
constexpr size_t MISC_TW = MISC_MOD + (size_t)2 * 9 * 6144 * 4;
constexpr size_t MISC_RAWC = MISC_TW + 4096 * 8;
constexpr size_t MISC_GCTX = MISC_RAWC + (size_t)256 * 1024 * 4;
constexpr size_t OFF_R = OFF_MISC + (size_t)4 * 1024 * 1024;
constexpr size_t R_YHY = OFF_R, R_YSW = OFF_R + UNIT, R_YDF = OFF_R + 2 * UNIT;
constexpr size_t R_PHY = OFF_R + 3 * UNIT;
constexpr size_t R_PSW = OFF_R + 6 * UNIT;
constexpr size_t R_VTSW = R_PSW + (size_t)MT * 384 * 2;
constexpr size_t R_PDF = OFF_R + 8 * UNIT;
constexpr size_t R_VTDF = OFF_R + 10 * UNIT;
constexpr size_t R_PRW = OFF_R + 11 * UNIT;
constexpr size_t R_STR = R_PRW + (size_t)MT * 1216 * 2;
constexpr size_t R_G = R_STR + 7 * UNIT;
constexpr size_t R_END = R_G + 2 * UNIT;
constexpr size_t R_RAWF = OFF_R;
constexpr size_t R_OF = R_PHY, R_OB = R_PHY + UNIT;
constexpr size_t R_URE = R_PSW;
constexpr size_t R_YRW = R_VTDF;
constexpr size_t R_ACC = R_PRW;
constexpr size_t R_U = R_STR;
constexpr size_t R_HID = OFF_R;
static_assert(R_END <= (size_t)512 * 1024 * 1024, "ws overflow");
static_assert((size_t)MT * 2816 * 2 <= 11 * UNIT, "hid");

constexpr int SMEM_BYTES = 136 * 1024;

struct Params {
  const float* in[43];
  float* out;
  char* ws;
};

DI int my_tid() { int t = (int)__builtin_amdgcn_workitem_id_x(); asm volatile("" : "+v"(t)); return t; }
DI unsigned f2bf(float f) { unsigned u = __float_as_uint(f); u += 0x7fffu + ((u >> 16) & 1u); return u >> 16; }
DI float bf2f(unsigned h) { return __uint_as_float(h << 16); }
DI unsigned pack2(float lo, float hi) { unsigned r; asm("v_cvt_pk_bf16_f32 %0, %1, %2" : "=v"(r) : "v"(lo), "v"(hi)); return r; }

DI float bflo(unsigned w) { return __uint_as_float(w << 16); }
DI float bfhi(unsigned w) { return __uint_as_float(w & 0xffff0000u); }
DI float sigmoidf_(float x) { return 1.f / (1.f + __expf(-x)); }
DI float siluf_(float x) { return x / (1.f + __expf(-x)); }
DI float wave_sum(float v) {
#pragma unroll
  for (int o = 32; o >= 1; o >>= 1) v += __shfl_xor(v, o);
  return v;
}
template <int CTRL> DI float dpp_mov(float v) {
  return __int_as_float(__builtin_amdgcn_update_dpp(0, __float_as_int(v), CTRL, 0xf, 0xf, false));
}
DI float sum16(float v) {
  v += dpp_mov<0xB1>(v);
  v += dpp_mov<0x4E>(v);
  v += dpp_mov<0x141>(v);
  v += dpp_mov<0x140>(v);
  return v;
}
DI int mod_idx(int row) { return row < ML ? (row >> 12) : 8; }

template <int NTW, class RowFn>
DI void gemm_main(f32x4 (&acc)[4][NTW], const bf16_t* __restrict__ A, int lda, RowFn rowfn,
                  const bf16_t* __restrict__ Bt, int ldb, int K, char* smem) {
  constexpr int BN = NTW * 32;
  constexpr int A_BYTES = 256 * 144, B_BYTES = BN * 144, STAGE = A_BYTES + B_BYTES;
  constexpr int NBL = BN / 64;
  const int tid = my_tid(), lane = tid & 63, wid = tid >> 6, wm = wid >> 1, wn = wid & 1, g = lane >> 4, r16 = lane & 15;
  const int chunk = tid & 7, lrow = tid >> 3;
  long a0 = rowfn(lrow), a1 = rowfn(lrow + 64), a2 = rowfn(lrow + 128), a3 = rowfn(lrow + 192);
  const uint4 zero4 = make_uint4(0, 0, 0, 0);
  const long c0 = a0 < 0 ? 0 : a0, c1 = a1 < 0 ? 0 : a1, c2 = a2 < 0 ? 0 : a2, c3 = a3 < 0 ? 0 : a3;
  uint4 ra0, ra1, ra2, ra3, rb0, rb1 = zero4;
  const bf16_t* Bp = Bt + (long)lrow * ldb + chunk * 8;
  auto GLOAD = [&](int k0) {
    ra0 = *(const uint4*)(A + c0 * lda + k0 + chunk * 8);
    ra1 = *(const uint4*)(A + c1 * lda + k0 + chunk * 8);
    ra2 = *(const uint4*)(A + c2 * lda + k0 + chunk * 8);
    ra3 = *(const uint4*)(A + c3 * lda + k0 + chunk * 8);
    if (a0 < 0) ra0 = zero4;
    if (a1 < 0) ra1 = zero4;
    if (a2 < 0) ra2 = zero4;
    if (a3 < 0) ra3 = zero4;
    rb0 = *(const uint4*)(Bp + k0);
    if constexpr (NBL > 1) rb1 = *(const uint4*)(Bp + (long)64 * ldb + k0);
  };
  auto SSTORE = [&](int st) {
    char* base = smem + st * STAGE + lrow * 144 + chunk * 16;
    *(uint4*)(base) = ra0; *(uint4*)(base + 64 * 144) = ra1; *(uint4*)(base + 128 * 144) = ra2;
    *(uint4*)(base + 192 * 144) = ra3;
    *(uint4*)(base + A_BYTES) = rb0;
    if constexpr (NBL > 1) *(uint4*)(base + A_BYTES + 64 * 144) = rb1;
  };
  __syncthreads();
  GLOAD(0);
  SSTORE(0);
  __syncthreads();
  const int nk = K >> 6;
  for (int kt = 0; kt < nk; ++kt) {
    const int st = kt & 1;
    if (kt + 1 < nk) GLOAD((kt + 1) * 64);
    const char* As = smem + st * STAGE + (wm * 64 + r16) * 144 + g * 16;
    const char* Bs = smem + st * STAGE + A_BYTES + (wn * (NTW * 16) + r16) * 144 + g * 16;
#pragma unroll
    for (int kk = 0; kk < 2; ++kk) {
      bf16x8 af[4], bfr[NTW];
#pragma unroll
      for (int mt = 0; mt < 4; ++mt) af[mt] = *(const bf16x8*)(As + mt * 16 * 144 + kk * 64);
#pragma unroll
      for (int nt = 0; nt < NTW; ++nt) bfr[nt] = *(const bf16x8*)(Bs + nt * 16 * 144 + kk * 64);
#pragma unroll
      for (int mt = 0; mt < 4; ++mt)
#pragma unroll
        for (int nt = 0; nt < NTW; ++nt)
          acc[mt][nt] = __builtin_amdgcn_mfma_f32_16x16x32_bf16(af[mt], bfr[nt], acc[mt][nt], 0, 0, 0);
    }
    if (kt + 1 < nk) SSTORE(st ^ 1);
    __syncthreads();
  }
}

struct RowPlain { long base; DI long operator()(int r) const { return base + r; } };
struct RowHalo { long rowbase; int t0; int len; DI long operator()(int r) const { int t = t0 + r; return (t >= 0 && t < len) ? rowbase + t : -1; } };

template <int NTW> DI void zero_acc(f32x4 (&acc)[4][NTW]) {
#pragma unroll
  for (int i = 0; i < 4; ++i)
#pragma unroll
    for (int j = 0; j < NTW; ++j) acc[i][j] = (f32x4){0.f, 0.f, 0.f, 0.f};
}

DI void cvt_unit(const float* __restrict__ src, int ldsrc, int srccol0, int k0, bf16_t* __restrict__ dst, int K, int n0, char* smem) {
  float* T = (float*)smem;
  const int tid = my_tid();
  __syncthreads();
  if (srccol0 >= 0) {
#pragma unroll
    for (int i = 0; i < 8; ++i) {
      int idx = tid + i * 512; int k = idx >> 6, n = idx & 63;
      T[k * 65 + n] = src[(long)(k0 + k) * ldsrc + srccol0 + n];
    }
  }
  __syncthreads();
  int n = tid >> 3, kc = (tid & 7) * 8;
  uint4 o = make_uint4(0, 0, 0, 0);
  if (srccol0 >= 0) {
    o.x = pack2(T[(kc + 0) * 65 + n], T[(kc + 1) * 65 + n]);
    o.y = pack2(T[(kc + 2) * 65 + n], T[(kc + 3) * 65 + n]);
    o.z = pack2(T[(kc + 4) * 65 + n], T[(kc + 5) * 65 + n]);
    o.w = pack2(T[(kc + 6) * 65 + n], T[(kc + 7) * 65 + n]);
  }
  *(uint4*)(dst + (long)(n0 + n) * K + k0 + kc) = o;
}

DI void ph_convert(const Params& p, int l, char* smem) {
  for (int u = blockIdx.x; u < 4480; u += gridDim.x) {
    if (u < 832) {
      int gI = u >> 4, kt = u & 15; int n0 = gI * 64; int sc;
      if (n0 < 1280) sc = n0; else if (n0 < 2048) sc = 2496 + (n0 - 1280); else if (n0 < 3264) sc = 1280 + (n0 - 2048); else sc = -1;
      cvt_unit(p.in[6] + (size_t)l * 1024 * 7360, 7360, sc, kt * 64, (bf16_t*)(p.ws + WB_IN), 1024, n0, smem);
    } else if (u < 1856) {
      int v = u - 832; int gI = v >> 4, kt = v & 15;
      cvt_unit(p.in[6] + (size_t)l * 1024 * 7360, 7360, 3264 + gI * 64, kt * 64, (bf16_t*)(p.ws + WB_GATE), 1024, gI * 64, smem);
    } else if (u < 2112) {
      int v = u - 1856; int gI = v >> 2, kt = v & 3; int j = gI >> 4, gg = gI & 15;
      cvt_unit(p.in[33] + ((size_t)l * 4 + j) * 256 * 1024, 1024, gg * 64, kt * 64, (bf16_t*)(p.ws + WB_BR) + (size_t)j * 1024 * 256, 256, gg * 64, smem);
    } else if (u < 2368) {
      int v = u - 2112; int gI = v >> 4, kt = v & 15;
      cvt_unit(p.in[34] + (size_t)l * 1024 * 1024, 1024, gI * 64, kt * 64, (bf16_t*)(p.ws + WB_OUT), 1024, gI * 64, smem);
    } else if (u < 3776) {
      int v = u - 2368; int gI = v >> 4, kt = v & 15; int nt = gI >> 1, hb = gI & 1;
      cvt_unit(p.in[37] + (size_t)l * 1024 * 5632, 5632, hb * 2816 + nt * 64, kt * 64, (bf16_t*)(p.ws + WB_UP), 1024, gI * 64, smem);
    } else {
      int v = u - 3776; int gI = v / 44, kt = v % 44;
      cvt_unit(p.in[40] + (size_t)l * 2816 * 1024, 1024, gI * 64, kt * 64, (bf16_t*)(p.ws + WB_DOWN), 2816, gI * 64, smem);
    }
  }
}

DI void ph_ada(const Params& p, char* smem) {
  float* S = (float*)smem;
  float* R = S + 9 * 1024;
  const int tid = my_tid();
  bool loaded = false;
  for (int u = blockIdx.x; u < 192; u += gridDim.x) {
    if (!loaded) {
      __syncthreads();
      for (int i = tid; i < 9 * 1024; i += NTHR) { float c = i < 8192 ? p.in[1][i] : p.in[3][i - 8192]; S[i] = siluf_(c); }
      loaded = true;
    }
    __syncthreads();
    int l = u / 96, n0 = (u % 96) * 64;
    int col = tid & 63, ks = tid >> 6;
    const float* W = p.in[4] + (size_t)l * 1024 * 6144 + n0 + col;
    float a[9];
#pragma unroll
    for (int b = 0; b < 9; ++b) a[b] = 0.f;
    for (int k = ks * 128; k < ks * 128 + 128; ++k) {
      float w = W[(size_t)k * 6144];
#pragma unroll
      for (int b = 0; b < 9; ++b) a[b] += S[b * 1024 + k] * w;
    }
#pragma unroll
    for (int b = 0; b < 9; ++b) R[(ks * 9 + b) * 64 + col] = a[b];
    __syncthreads();
    for (int i = tid; i < 9 * 64; i += NTHR) {
      int b = i >> 6, c = i & 63; float s = 0.f;
#pragma unroll
      for (int k2 = 0; k2 < 8; ++k2) s += R[(k2 * 9 + b) * 64 + c];
      s += p.in[5][(size_t)l * 6144 + n0 + c];
      ((float*)(p.ws + MISC_MOD))[((size_t)l * 9 + b) * 6144 + n0 + c] = s;
    }
  }
  for (int i = blockIdx.x * NTHR + tid; i < 4096; i += gridDim.x * NTHR) {
    float s, c; sincospif(-(float)i / 4096.f, &s, &c);
    ((float2*)(p.ws + MISC_TW))[i] = make_float2(c, s);
  }
}

DI void hy_rawfilter(const Params& p, int l, int Lf, float* __restrict__ dst, char* smem) {
  float* W1 = (float*)smem;
  float* W2 = W1 + 33 * 64;
  float* Z = W2 + 64 * 64;
  float* H1 = Z + 16 * 36;
  float* H2 = H1 + 16 * 64;
  const int tid = my_tid();
  const float* w1 = p.in[9] + (size_t)l * 33 * 64; const float* b1 = p.in[10] + l * 64;
  const float* w2 = p.in[11] + (size_t)l * 64 * 64; const float* b2 = p.in[12] + l * 64;
  const float* w3 = p.in[13] + (size_t)l * 64 * 1024; const float* fr = p.in[14] + l * 64;
  const int nunits = Lf / 16;
  bool loaded = false;
  for (int u = blockIdx.x; u < nunits; u += gridDim.x) {
    __syncthreads();
    if (!loaded) {
      for (int i = tid; i < 33 * 64; i += NTHR) W1[i] = w1[i];
      for (int i = tid; i < 64 * 64; i += NTHR) W2[i] = w2[i];
      loaded = true;
    }
    const int t0 = u * 16;
    for (int i = tid; i < 16 * 33; i += NTHR) {
      int tt = i / 33, f = i % 33; int t = t0 + tt; float v;
      if (f == 0) v = (float)t / (float)(Lf - 1);
      else {
        int bi = (f - 1) & 15;
        float wv = 6.283185307179586f * (float)t / (float)Lf;
        float fb = 1e-4f + (15.f - 1e-4f) * (float)bi / 15.f;
        float ang = wv * fb;
        v = (f <= 16) ? cosf(ang) : -sinf(ang);
      }
      Z[tt * 36 + f] = v;
    }
    __syncthreads();
    for (int i = tid; i < 16 * 64; i += NTHR) {
      int tt = i >> 6, f = i & 63; float s = b1[f];
      for (int k = 0; k < 33; ++k) s += Z[tt * 36 + k] * W1[k * 64 + f];
      H1[tt * 64 + f] = sinf(fr[f] * s);
    }
    __syncthreads();
    for (int i = tid; i < 16 * 64; i += NTHR) {
      int tt = i >> 6, f = i & 63; float s = b2[f];
      for (int k = 0; k < 64; ++k) s += H1[tt * 64 + k] * W2[k * 64 + f];
      H2[tt * 64 + f] = sinf(fr[f] * s);
    }
    __syncthreads();
    float a0[16], a1[16];
#pragma unroll
    for (int i = 0; i < 16; ++i) { a0[i] = 0.f; a1[i] = 0.f; }
    for (int k = 0; k < 64; ++k) {
      float wa = w3[k * 1024 + tid], wb = w3[k * 1024 + 512 + tid];
#pragma unroll
      for (int i = 0; i < 16; ++i) { float h = H2[i * 64 + k]; a0[i] += h * wa; a1[i] += h * wb; }
    }
    {
      int w = tid & 255;
      float delta = fabsf(-3.0701134573253944f + (-15.350567286626972f + 3.0701134573253944f) * (float)w / 255.f);
#pragma unroll
      for (int i = 0; i < 16; ++i) {
        float tn = (float)(t0 + i) / (float)(Lf - 1);
        float dec = expf(-tn * delta);
        dst[(size_t)(t0 + i) * 1024 + tid] = a0[i] * dec;
        dst[(size_t)(t0 + i) * 1024 + 512 + tid] = a1[i] * dec;
      }
    }
  }
}

DI float2 cmul(float2 a, float2 b) { return make_float2(a.x * b.x - a.y * b.y, a.x * b.y + a.y * b.x); }
DI float2 cmulc(float2 a, float2 b) { return make_float2(a.x * b.x + a.y * b.y, a.y * b.x - a.x * b.y); }
DI void fft_dif(float2* X, const float2* W) {
  const int tid = my_tid();
  for (int ls = 12; ls >= 0; --ls) {
    const int span = 1 << ls;
    __syncthreads();
#pragma unroll
    for (int i = 0; i < 8; ++i) {
      int bf = tid + i * 512; int pos = bf & (span - 1); int i0 = ((bf >> ls) << (ls + 1)) + pos; int i1 = i0 + span;
      float2 a = X[i0], b = X[i1]; float2 w = W[pos << (12 - ls)];
      X[i0] = make_float2(a.x + b.x, a.y + b.y);
      X[i1] = cmul(make_float2(a.x - b.x, a.y - b.y), w);
    }
  }
  __syncthreads();
}
DI void fft_dit_inv(float2* X, const float2* W) {
  const int tid = my_tid();
  for (int ls = 0; ls <= 12; ++ls) {
    const int span = 1 << ls;
    __syncthreads();
#pragma unroll
    for (int i = 0; i < 8; ++i) {
      int bf = tid + i * 512; int pos = bf & (span - 1); int i0 = ((bf >> ls) << (ls + 1)) + pos; int i1 = i0 + span;
      float2 a = X[i0], b = X[i1]; float2 w = W[pos << (12 - ls)];
      float2 t = cmulc(b, w);
      X[i0] = make_float2(a.x + t.x, a.y + t.y);
      X[i1] = make_float2(a.x - t.x, a.y - t.y);
    }
  }
  __syncthreads();
}
DI void load_twiddles(const Params& p, float2* W) {
  const float2* tw = (const float2*)(p.ws + MISC_TW);
  for (int i = my_tid(); i < 4096; i += NTHR) W[i] = tw[i];
}

DI void ph_kf(const Params& p, int l, char* smem) {
  float2* X = (float2*)smem; float2* W = X + 8192; float* red = (float*)(W + 4096);
  const int tid = my_tid(), lane = tid & 63, wid = tid >> 6;
  const float* rawf = (const float*)(p.ws + R_RAWF);
  float2* kf = (float2*)(p.ws + OFF_KF);
  bool tw = false;
  for (int u = blockIdx.x; u < 256; u += gridDim.x) {
    if (!tw) { load_twiddles(p, W); tw = true; }
    const int o = u >> 7, c = (u & 127) * 2;
    float2 fw[8], bw[8]; float sa = 0.f, sb = 0.f;
#pragma unroll
    for (int i = 0; i < 8; ++i) {
      int t = tid + i * 512;
      fw[i] = *(const float2*)(rawf + (size_t)t * 1024 + o * 512 + c);
      bw[i] = *(const float2*)(rawf + (size_t)t * 1024 + o * 512 + 256 + c);
      sa += fabsf(fw[i].x) + fabsf(bw[i].x); sb += fabsf(fw[i].y) + fabsf(bw[i].y);
    }
    sa = wave_sum(sa); sb = wave_sum(sb);
    __syncthreads();
    if (lane == 0) { red[wid * 2] = sa; red[wid * 2 + 1] = sb; }
    __syncthreads();
    float ta = 0.f, tb = 0.f;
#pragma unroll
    for (int w = 0; w < 8; ++w) { ta += red[w * 2]; tb += red[w * 2 + 1]; }
    const float ia = 1.f / ta, ib = 1.f / tb;
#pragma unroll
    for (int i = 0; i < 8; ++i) {
      int t = tid + i * 512;
      X[t] = make_float2(fw[i].x * ia, fw[i].y * ib);
      if (t >= 1) X[8192 - t] = make_float2(bw[i].x * ia, bw[i].y * ib);
      else X[4096] = make_float2(0.f, 0.f);
    }
    fft_dif(X, W);
    float2* ka = kf + (size_t)(o * 256 + c) * 8192; float2* kb = ka + 8192;
#pragma unroll 4
    for (int i = 0; i < 16; ++i) {
      int pidx = tid + i * 512;
      int k = (int)(__brev((unsigned)pidx) >> 19);
      int k2 = (8192 - k) & 8191;
      int p2 = (int)(__brev((unsigned)k2) >> 19);
      float2 c1 = X[pidx], c2 = X[p2];
      float2 A = make_float2(0.5f * (c1.x + c2.x), 0.5f * (c1.y - c2.y));
      float2 Bv = make_float2(0.5f * (c1.y + c2.y), -0.5f * (c1.x - c2.x));
      ka[pidx] = A; kb[pidx] = Bv;
    }
    __syncthreads();
  }
  if (l == 0) {
    const float* rawc = (const float*)(p.ws + MISC_RAWC);
    float* G = (float*)(p.ws + MISC_GCTX);
    for (int u = blockIdx.x * 8 + wid; u < 512; u += gridDim.x * 8) {
      int o = u >> 8, c = u & 255; float f[4], b[4]; float s = 0.f;
#pragma unroll
      for (int i = 0; i < 4; ++i) {
        int t = lane + i * 64;
        f[i] = rawc[(size_t)t * 1024 + o * 512 + c]; b[i] = rawc[(size_t)t * 1024 + o * 512 + 256 + c];
        s += fabsf(f[i]) + fabsf(b[i]);
      }
      s = wave_sum(s); float inv = 1.f / s;
#pragma unroll
      for (int i = 0; i < 4; ++i) {
        int t = lane + i * 64;
        G[(size_t)u * 512 + 256 + t] = f[i] * inv;
        if (t >= 1) G[(size_t)u * 512 + 256 - t] = b[i] * inv;
      }
      if (lane == 0) G[(size_t)u * 512] = 0.f;
    }
  }
}

DI void ph_ln(const float* __restrict__ src_lat, const float* __restrict__ src_ctx, float* dst_lat, float* dst_ctx,
              const float* __restrict__ ag, const float* __restrict__ ab, bf16_t* U, const float* __restrict__ mod, int sh_off, int nrows) {
  const int lane = my_tid() & 63, wid = my_tid() >> 6;
  for (int row = blockIdx.x * 8 + wid; row < nrows; row += gridDim.x * 8) {
    const float* src = row < ML ? src_lat + (size_t)row * D : src_ctx + (size_t)(row - ML) * D;
    float4 v[4];
#pragma unroll
    for (int i = 0; i < 4; ++i) v[i] = *(const float4*)(src + i * 256 + lane * 4);
    float s = 0.f;
#pragma unroll
    for (int i = 0; i < 4; ++i) s += v[i].x + v[i].y + v[i].z + v[i].w;
    float mu = wave_sum(s) * (1.f / 1024.f);
    float q = 0.f;
#pragma unroll
    for (int i = 0; i < 4; ++i) { v[i].x -= mu; v[i].y -= mu; v[i].z -= mu; v[i].w -= mu; q += v[i].x * v[i].x + v[i].y * v[i].y + v[i].z * v[i].z + v[i].w * v[i].w; }
    float rs = rsqrtf(wave_sum(q) * (1.f / 1024.f) + 1e-6f);
#pragma unroll
    for (int i = 0; i < 4; ++i) { v[i].x *= rs; v[i].y *= rs; v[i].z *= rs; v[i].w *= rs; }
    if (ag) {
      float* dst = row < ML ? dst_lat + (size_t)row * D : dst_ctx + (size_t)(row - ML) * D;
#pragma unroll
      for (int i = 0; i < 4; ++i) {
        float4 gg = *(const float4*)(ag + i * 256 + lane * 4), bb = *(const float4*)(ab + i * 256 + lane * 4);
        v[i].x = v[i].x * gg.x + bb.x; v[i].y = v[i].y * gg.y + bb.y; v[i].z = v[i].z * gg.z + bb.z; v[i].w = v[i].w * gg.w + bb.w;
        *(float4*)(dst + i * 256 + lane * 4) = v[i];
      }
      if (U) {
        s = 0.f;
#pragma unroll
        for (int i = 0; i < 4; ++i) s += v[i].x + v[i].y + v[i].z + v[i].w;
        mu = wave_sum(s) * (1.f / 1024.f); q = 0.f;
#pragma unroll
        for (int i = 0; i < 4; ++i) { v[i].x -= mu; v[i].y -= mu; v[i].z -= mu; v[i].w -= mu; q += v[i].x * v[i].x + v[i].y * v[i].y + v[i].z * v[i].z + v[i].w * v[i].w; }
        rs = rsqrtf(wave_sum(q) * (1.f / 1024.f) + 1e-6f);
#pragma unroll
        for (int i = 0; i < 4; ++i) { v[i].x *= rs; v[i].y *= rs; v[i].z *= rs; v[i].w *= rs; }
      }
    }
    if (U) {
      const float* m = mod + (size_t)mod_idx(row) * 6144 + sh_off;
#pragma unroll
      for (int i = 0; i < 4; ++i) {
        float4 sh = *(const float4*)(m + i * 256 + lane * 4), sc = *(const float4*)(m + 1024 + i * 256 + lane * 4);
        uint2 o; o.x = pack2(v[i].x * (1.f + sc.x) + sh.x, v[i].y * (1.f + sc.y) + sh.y);
        o.y = pack2(v[i].z * (1.f + sc.z) + sh.z, v[i].w * (1.f + sc.w) + sh.w);
        *(uint2*)(U + (size_t)row * D + i * 256 + lane * 4) = o;
      }
    }
  }
}

DI void ph_inproj(const Params& p, char* smem) {
  const bf16_t* U = (const bf16_t*)(p.ws + R_U);
  const bf16_t* Bt = (const bf16_t*)(p.ws + WB_IN);
  const int lane = my_tid() & 63, wid = my_tid() >> 6, wm = wid >> 1, wn = wid & 1, g = lane >> 4, r16 = lane & 15;
  const int ntiles = 136 * 26;
  for (int t = blockIdx.x; t < ntiles; t += gridDim.x) {
    const int mtile = t / 26, ntile = t % 26;
    f32x4 acc[4][4]; zero_acc<4>(acc);
    gemm_main<4>(acc, U, 1024, RowPlain{(long)mtile * 256}, Bt + (size_t)ntile * 128 * 1024, 1024, 1024, smem);
    int b, key0;
    if (mtile < 128) { b = mtile >> 4; key0 = (mtile & 15) * 256; } else { b = mtile - 128; key0 = SL; }
    bf16_t* tbase = nullptr; int tcols = 0, tcol0 = 0;
    if (ntile < 6) { tbase = (bf16_t*)(p.ws + R_PHY); tcols = 768; tcol0 = ntile * 128; }
    else if (ntile == 9) { tbase = (bf16_t*)(p.ws + R_VTSW); tcols = 128; tcol0 = 0; }
    else if (ntile == 14 || ntile == 15) { tbase = (bf16_t*)(p.ws + R_VTDF); tcols = 256; tcol0 = (ntile - 14) * 128; }
    if (tbase) {
#pragma unroll
      for (int mt = 0; mt < 4; ++mt)
#pragma unroll
        for (int nt = 0; nt < 4; ++nt) {
          int col = tcol0 + wn * 64 + nt * 16 + r16;
          int key = key0 + wm * 64 + mt * 16 + g * 4;
          uint2 o; o.x = pack2(acc[mt][nt][0], acc[mt][nt][1]); o.y = pack2(acc[mt][nt][2], acc[mt][nt][3]);
          *(uint2*)(tbase + ((size_t)b * tcols + col) * KEYS + key) = o;
        }
    } else {
      bf16_t* rb; int ld, c0, cmax;
      if (ntile < 9) { rb = (bf16_t*)(p.ws + R_PSW); ld = 384; c0 = (ntile - 6) * 128; cmax = 384; }
      else if (ntile < 14) { rb = (bf16_t*)(p.ws + R_PDF); ld = 512; c0 = (ntile - 10) * 128; cmax = 512; }
      else { rb = (bf16_t*)(p.ws + R_PRW); ld = 1216; c0 = (ntile - 16) * 128; cmax = 1216; }
#pragma unroll
      for (int mt = 0; mt < 4; ++mt)
#pragma unroll
        for (int nt = 0; nt < 4; ++nt) {
          int col = c0 + wn * 64 + nt * 16 + r16;
          if (col < cmax) {
#pragma unroll
            for (int j = 0; j < 4; ++j) {
              size_t row = (size_t)mtile * 256 + wm * 64 + mt * 16 + g * 4 + j;
              rb[row * ld + col] = (bf16_t)f2bf(acc[mt][nt][j]);
            }
          }
        }
    }
  }
}

DI float hy_conv3(const bf16_t* __restrict__ P, int t, int len, float w0, float w1, float w2, float bias) {
  float a = t >= 1 ? bf2f(P[t - 1]) : 0.f, b = bf2f(P[t]), c = (t + 1 < len) ? bf2f(P[t + 1]) : 0.f;
  return w0 * a + w1 * b + w2 * c + bias;
}
DI void ph_hyena(const Params& p, int l, char* smem) {
  float2* X = (float2*)smem; float2* W = X + 8192;
  const int tid = my_tid();
  const bf16_t* PT = (const bf16_t*)(p.ws + R_PHY);
  const float2* kf = (const float2*)(p.ws + OFF_KF);
  const float* cw = p.in[7] + (size_t)l * 3 * 768; const float* cb = p.in[8] + (size_t)l * 768;
  const float* hb = p.in[15] + (size_t)l * 512;
  bf16_t* Y = (bf16_t*)(p.ws + R_YHY);
  bool tw = false;
  for (int u = blockIdx.x; u < 1024; u += gridDim.x) {
    if (!tw) { load_twiddles(p, W); tw = true; }
    const int bp = u >> 8, c = u & 255; const int b0 = bp * 2, b1 = b0 + 1;
    const bf16_t* P0 = PT + ((size_t)b0 * 768) * KEYS; const bf16_t* P1 = PT + ((size_t)b1 * 768) * KEYS;
    float wv0 = cw[c], wv1 = cw[768 + c], wv2 = cw[1536 + c], bv = cb[c];
    float wa0 = cw[256 + c], wa1 = cw[768 + 256 + c], wa2 = cw[1536 + 256 + c], ba = cb[256 + c];
    float wb0 = cw[512 + c], wb1 = cw[768 + 512 + c], wb2 = cw[1536 + 512 + c], bb = cb[512 + c];
    const float bias0 = hb[c], bias1 = hb[256 + c];
    float2 vv[8];
    __syncthreads();
#pragma unroll
    for (int i = 0; i < 8; ++i) {
      int t = tid + i * 512;
      vv[i].x = hy_conv3(P0 + (size_t)c * KEYS, t, SL, wv0, wv1, wv2, bv);
      vv[i].y = hy_conv3(P1 + (size_t)c * KEYS, t, SL, wv0, wv1, wv2, bv);
      X[t] = vv[i]; X[t + 4096] = make_float2(0.f, 0.f);
    }
    fft_dif(X, W);
    {
      const float2* H = kf + (size_t)c * 8192;
#pragma unroll 4
      for (int i = 0; i < 16; ++i) { int q = tid + i * 512; X[q] = cmul(X[q], H[q]); }
    }
    fft_dit_inv(X, W);
    float2 zz[8];
#pragma unroll
    for (int i = 0; i < 8; ++i) {
      int t = tid + i * 512;
      float2 y = X[t];
      float x1a = hy_conv3(P0 + (size_t)(256 + c) * KEYS, t, SL, wa0, wa1, wa2, ba);
      float x1b = hy_conv3(P1 + (size_t)(256 + c) * KEYS, t, SL, wa0, wa1, wa2, ba);
      zz[i].x = x1a * (y.x * (1.f / 8192.f) + bias0 * vv[i].x);
      zz[i].y = x1b * (y.y * (1.f / 8192.f) + bias0 * vv[i].y);
    }
    __syncthreads();
#pragma unroll
    for (int i = 0; i < 8; ++i) { int t = tid + i * 512; X[t] = zz[i]; X[t + 4096] = make_float2(0.f, 0.f); }
    fft_dif(X, W);
    {
      const float2* H = kf + (size_t)(256 + c) * 8192;
#pragma unroll 4
      for (int i = 0; i < 16; ++i) { int q = tid + i * 512; X[q] = cmul(X[q], H[q]); }
    }
    fft_dit_inv(X, W);
#pragma unroll
    for (int i = 0; i < 8; ++i) {
      int t = tid + i * 512;
      float2 y = X[t];
      float x2a = hy_conv3(P0 + (size_t)(512 + c) * KEYS, t, SL, wb0, wb1, wb2, bb);
      float x2b = hy_conv3(P1 + (size_t)(512 + c) * KEYS, t, SL, wb0, wb1, wb2, bb);
      float oa = x2a * (y.x * (1.f / 8192.f) + bias1 * zz[i].x);
      float ob = x2b * (y.y * (1.f / 8192.f) + bias1 * zz[i].y);
      Y[((size_t)b0 * SL + t) * 256 + c] = (bf16_t)f2bf(oa);
      Y[((size_t)b1 * SL + t) * 256 + c] = (bf16_t)f2bf(ob);
    }
  }
}

DI void ph_hyena_ctx(const Params& p, int l, char* smem) {
  const int tid = my_tid(), lane = tid & 63, wid = tid >> 6;
  float* Zb = (float*)smem + wid * 1024;
  float* Gb = Zb + 256;
  const bf16_t* PT = (const bf16_t*)(p.ws + R_PHY);
  const float* G = (const float*)(p.ws + MISC_GCTX);
  const float* cw = p.in[7] + (size_t)l * 3 * 768; const float* cb = p.in[8] + (size_t)l * 768;
  const float* hb = p.in[15] + (size_t)l * 512;
  bf16_t* Y = (bf16_t*)(p.ws + R_YHY);
  for (int base = blockIdx.x * 8; base < 2048; base += gridDim.x * 8) {
    const int u = base + wid; const int b = u >> 8, c = u & 255;
    const bf16_t* Pb = PT + ((size_t)b * 768) * KEYS + SL;
    float v[4], x1[4], x2[4], zz[4];
#pragma unroll
    for (int i = 0; i < 4; ++i) {
      int t = lane + i * 64;
      v[i] = hy_conv3(Pb + (size_t)c * KEYS, t, CL, cw[c], cw[768 + c], cw[1536 + c], cb[c]);
      x1[i] = hy_conv3(Pb + (size_t)(256 + c) * KEYS, t, CL, cw[256 + c], cw[768 + 256 + c], cw[1536 + 256 + c], cb[256 + c]);
      x2[i] = hy_conv3(Pb + (size_t)(512 + c) * KEYS, t, CL, cw[512 + c], cw[768 + 512 + c], cw[1536 + 512 + c], cb[512 + c]);
    }
    __syncthreads();
#pragma unroll
    for (int i = 0; i < 4; ++i) Zb[lane + i * 64] = v[i];
    for (int i = lane; i < 512; i += 64) Gb[i] = G[(size_t)c * 512 + i];
    __syncthreads();
#pragma unroll
    for (int i = 0; i < 4; ++i) {
      int t = lane + i * 64; float s = 0.f;
      for (int s2 = 0; s2 < 256; ++s2) s += Gb[256 + t - s2] * Zb[s2];
      zz[i] = x1[i] * (s + hb[c] * v[i]);
    }
    __syncthreads();
#pragma unroll
    for (int i = 0; i < 4; ++i) Zb[lane + i * 64] = zz[i];
    for (int i = lane; i < 512; i += 64) Gb[i] = G[(size_t)(256 + c) * 512 + i];
    __syncthreads();
#pragma unroll
    for (int i = 0; i < 4; ++i) {
      int t = lane + i * 64; float s = 0.f;
      for (int s2 = 0; s2 < 256; ++s2) s += Gb[256 + t - s2] * Zb[s2];
      float o = x2[i] * (s + hb[256 + c] * zz[i]);
      Y[((size_t)ML + b * CL + t) * 256 + c] = (bf16_t)f2bf(o);
    }
  }
}

DI void ph_rope(const Params& p, char* smem) {
  float2* T16 = (float2*)smem;
  float2* T8 = T16 + 64 * 16;
  const int tid = my_tid(), lane = tid & 63, wid = tid >> 6;
  __syncthreads();
  for (int i = tid; i < 64 * 16; i += NTHR) {
    int pos = i >> 4, f = i & 15; float inv = powf(10000.f, -(float)f / 16.f); float s, c; sincosf((float)pos * inv, &s, &c);
    T16[i] = make_float2(c, s);
  }
  for (int i = tid; i < 64 * 8; i += NTHR) {
    int pos = i >> 3, f = i & 7; float inv = powf(10000.f, -(float)f / 8.f); float s, c; sincosf((float)pos * inv, &s, &c);
    T8[i] = make_float2(c, s);
  }
  __syncthreads();
  bf16_t* Psw = (bf16_t*)(p.ws + R_PSW); bf16_t* Pdf = (bf16_t*)(p.ws + R_PDF);
  for (int row = blockIdx.x * 8 + wid; row < ML; row += gridDim.x * 8) {
    const int t = row & (SL - 1); const int pr = t >> 6, pc = t & 63;
    bf16_t* q = Psw + (size_t)row * 384;
#pragma unroll
    for (int i = 0; i < 3; ++i) {
      int pi = lane + i * 64; int hd = pi >> 5, pp = pi & 31; int half = pp >> 4, f = pp & 15;
      int base = hd * 64 + half * 32; float2 cs = T16[(half ? pc : pr) * 16 + f];
      float x1 = bf2f(q[base + f]), x2 = bf2f(q[base + 16 + f]);
      q[base + f] = (bf16_t)f2bf(x1 * cs.x - x2 * cs.y); q[base + 16 + f] = (bf16_t)f2bf(x1 * cs.y + x2 * cs.x);
    }
    bf16_t* d = Pdf + (size_t)row * 512;
#pragma unroll
    for (int i = 0; i < 4; ++i) {
      int pi = lane + i * 64; int gi = pi >> 4, pp = pi & 15; int half = pp >> 3, f = pp & 7;
      int base = gi * 32 + half * 16; float2 cs = T8[(half ? pc : pr) * 8 + f];
      float x1 = bf2f(d[base + f]), x2 = bf2f(d[base + 8 + f]);
      d[base + f] = (bf16_t)f2bf(x1 * cs.x - x2 * cs.y); d[base + 8 + f] = (bf16_t)f2bf(x1 * cs.y + x2 * cs.x);
    }
  }
}

DI float rw_shift(const bf16_t* __restrict__ P, int row, int t, int len, int col, float mu) {
  float c = bf2f(P[(size_t)row * 1216 + col]);
  float a = t >= 1 ? bf2f(P[(size_t)(row - 1) * 1216 + col]) : 0.f;
  float b = t + 1 < len ? bf2f(P[(size_t)(row + 1) * 1216 + col]) : 0.f;
  return c + (0.5f * (a + b) - c) * mu;
}
DI void ph_rwprep(const Params& p, int l, char* smem) {
  float* ACT = (float*)smem;
  const int tid = my_tid(), lane = tid & 63;
  const bf16_t* P = (const bf16_t*)(p.ws + R_PRW);
  const float* mu = p.in[17] + (size_t)l * 1216;
  const float* w0 = p.in[18] + (size_t)l * 512; const float* w2 = p.in[19] + (size_t)l * 2 * 64 * 256;
  const float* a0 = p.in[20] + (size_t)l * 256; const float* a2 = p.in[21] + (size_t)l * 64 * 256;
  const float* g2 = p.in[22] + (size_t)l * 2 * 128 * 256;
  const float* kkw = p.in[23] + (size_t)l * 256; const float* kaw = p.in[24] + (size_t)l * 256;
  bf16_t* S = (bf16_t*)(p.ws + R_STR); bf16_t* Gs = (bf16_t*)(p.ws + R_G);
  const size_t SU = (size_t)MT * 256;
  for (int u = blockIdx.x; u < MT / 16; u += gridDim.x) {
    const int row0 = u * 16; int t0, len;
    if (row0 < ML) { t0 = row0 & (SL - 1); len = SL; } else { t0 = (row0 - ML) & (CL - 1); len = CL; }
    __syncthreads();
    for (int i = tid; i < 448 * 16; i += NTHR) {
      int col = i % 448, tk = i / 448;
      float v = rw_shift(P, row0 + tk, t0 + tk, len, 768 + col, mu[768 + col]);
      if (col < 128) v = tanhf(v); else if (col >= 192) v = sigmoidf_(v);
      ACT[col * 16 + tk] = v;
    }
    __syncthreads();
    const int c = tid & 255, th = tid >> 8;
    float df[8], db[8], aa[8], gf[8], gb[8];
#pragma unroll
    for (int i = 0; i < 8; ++i) { df[i] = 0.f; db[i] = 0.f; aa[i] = 0.f; gf[i] = 0.f; gb[i] = 0.f; }
    for (int k = 0; k < 64; ++k) {
      float wf = w2[k * 256 + c], wb = w2[64 * 256 + k * 256 + c], wa = a2[k * 256 + c];
      const float4* pf = (const float4*)(ACT + k * 16 + th * 8);
      const float4* pb = (const float4*)(ACT + (64 + k) * 16 + th * 8);
      const float4* pa = (const float4*)(ACT + (128 + k) * 16 + th * 8);
      float4 f0 = pf[0], f1 = pf[1], b0 = pb[0], b1 = pb[1], x0 = pa[0], x1 = pa[1];
      df[0] += f0.x * wf; df[1] += f0.y * wf; df[2] += f0.z * wf; df[3] += f0.w * wf; df[4] += f1.x * wf; df[5] += f1.y * wf; df[6] += f1.z * wf; df[7] += f1.w * wf;
      db[0] += b0.x * wb; db[1] += b0.y * wb; db[2] += b0.z * wb; db[3] += b0.w * wb; db[4] += b1.x * wb; db[5] += b1.y * wb; db[6] += b1.z * wb; db[7] += b1.w * wb;
      aa[0] += x0.x * wa; aa[1] += x0.y * wa; aa[2] += x0.z * wa; aa[3] += x0.w * wa; aa[4] += x1.x * wa; aa[5] += x1.y * wa; aa[6] += x1.z * wa; aa[7] += x1.w * wa;
    }
    for (int k = 0; k < 128; ++k) {
      float wf = g2[k * 256 + c], wb = g2[128 * 256 + k * 256 + c];
      const float4* pf = (const float4*)(ACT + (192 + k) * 16 + th * 8);
      const float4* pb = (const float4*)(ACT + (320 + k) * 16 + th * 8);
      float4 f0 = pf[0], f1 = pf[1], b0 = pb[0], b1 = pb[1];
      gf[0] += f0.x * wf; gf[1] += f0.y * wf; gf[2] += f0.z * wf; gf[3] += f0.w * wf; gf[4] += f1.x * wf; gf[5] += f1.y * wf; gf[6] += f1.z * wf; gf[7] += f1.w * wf;
      gb[0] += b0.x * wb; gb[1] += b0.y * wb; gb[2] += b0.z * wb; gb[3] += b0.w * wb; gb[4] += b1.x * wb; gb[5] += b1.y * wb; gb[6] += b1.z * wb; gb[7] += b1.w * wb;
    }
    const float w0f = w0[c], w0b = w0[256 + c], a0c = a0[c], kkc = kkw[c], kac = kaw[c];
    const float mur = mu[c], muk = mu[256 + c], muv = mu[512 + c];
#pragma unroll
    for (int i = 0; i < 8; ++i) {
      const int tk = th * 8 + i; const int row = row0 + tk, t = t0 + tk;
      float r = rw_shift(P, row, t, len, c, mur), k = rw_shift(P, row, t, len, 256 + c, muk), v = rw_shift(P, row, t, len, 512 + c, muv);
      float a = sigmoidf_(a0c + aa[i]);
      float kk = k * kkc; float n2 = wave_sum(kk * kk); kk = kk / fmaxf(sqrtf(n2), 1e-12f);
      float kp = k * (1.f + (a - 1.f) * kac);
      float bq = kk * a;
      float xf = -(w0f + df[i]); float spf = fmaxf(xf, 0.f) + log1pf(__expf(-fabsf(xf)));
      float xb = -(w0b + db[i]); float spb = fmaxf(xb, 0.f) + log1pf(__expf(-fabsf(xb)));
      float ef = __expf(-spf - 0.5f), eb = __expf(-spb - 0.5f);
      float d_f = -expm1f(-ef), d_b = -expm1f(-eb);
      size_t o = (size_t)row * 256 + c;
      S[o] = (bf16_t)f2bf(r); S[SU + o] = (bf16_t)f2bf(kp); S[2 * SU + o] = (bf16_t)f2bf(v); S[3 * SU + o] = (bf16_t)f2bf(kk);
      S[4 * SU + o] = (bf16_t)f2bf(bq); S[5 * SU + o] = (bf16_t)f2bf(d_f); S[6 * SU + o] = (bf16_t)f2bf(d_b);
      Gs[o] = (bf16_t)f2bf(gf[i]); Gs[SU + o] = (bf16_t)f2bf(gb[i]);
    }
  }
}

DI long scan_row(int b, int dir, int s) {
  if (s < CL) return (long)ML + b * CL + (dir ? (CL - 1 - s) : s);
  int t = s - CL; return (long)b * SL + (dir ? (SL - 1 - t) : t);
}
DI void ph_scan(const Params& p, char* smem) {
  const int tid = my_tid(), lane = tid & 63, wid = tid >> 6;
  const bf16_t* S = (const bf16_t*)(p.ws + R_STR);
  const size_t SU = (size_t)MT * 256;
  constexpr int NSTEP = CL + SL, NCH = NSTEP / 64;
  for (int u = blockIdx.x; u < 256; u += gridDim.x) {
    const int chain = u >> 2, rg = u & 3; const int dir = chain & 1, bh = chain >> 1, b = bh >> 2, h = bh & 3;
    bf16_t* O = (bf16_t*)(p.ws + (dir ? R_OB : R_OF));
    uint4 q0, q1, q2, q3, q4, q5;
    auto SC_GLOAD = [&](int ci) {
#pragma unroll
      for (int j = 0; j < 6; ++j) {
        int idx = tid + j * 512; int s = (idx & 511) >> 3, ck = idx & 7;
        long row = scan_row(b, dir, ci * 64 + s);
        int sid = j < 5 ? j : 5 + dir;
        uint4 v = *(const uint4*)(S + sid * SU + row * 256 + h * 64 + ck * 8);
        if (j == 0) q0 = v; else if (j == 1) q1 = v; else if (j == 2) q2 = v; else if (j == 3) q3 = v; else if (j == 4) q4 = v; else q5 = v;
      }
    };
    auto SC_SSTORE = [&](int buf) {
      char* base = smem + buf * 49152 + tid * 16;
      *(uint4*)(base) = q0; *(uint4*)(base + 8192) = q1; *(uint4*)(base + 2 * 8192) = q2;
      *(uint4*)(base + 3 * 8192) = q3; *(uint4*)(base + 4 * 8192) = q4; *(uint4*)(base + 5 * 8192) = q5;
    };
    __syncthreads();
    SC_GLOAD(0);
    SC_SSTORE(0);
    __syncthreads();
    float s0 = 0.f, s1 = 0.f, s2 = 0.f, s3 = 0.f;
    const int rsub = lane >> 4, ks = lane & 15;
    const int vrow = rg * 16 + wid * 4 + rsub;
    for (int ci = 0; ci < NCH; ++ci) {
      if (ci + 1 < NCH) { SC_GLOAD(ci + 1); }
      if (wid < 4) {
        const char* B = smem + (ci & 1) * 49152;
#pragma unroll 4
        for (int s = 0; s < 64; ++s) {
          uint2 ur = *(const uint2*)(B + 0 * 8192 + s * 128 + ks * 8);
          uint2 uk = *(const uint2*)(B + 1 * 8192 + s * 128 + ks * 8);
          unsigned short uv = *(const unsigned short*)(B + 2 * 8192 + s * 128 + vrow * 2);
          uint2 ukk = *(const uint2*)(B + 3 * 8192 + s * 128 + ks * 8);
          uint2 ub = *(const uint2*)(B + 4 * 8192 + s * 128 + ks * 8);
          uint2 ud = *(const uint2*)(B + 5 * 8192 + s * 128 + ks * 8);
          float kk0 = bflo(ukk.x), kk1 = bfhi(ukk.x), kk2 = bflo(ukk.y), kk3 = bfhi(ukk.y);
          float sa = -((s0 * kk0 + s1 * kk1) + (s2 * kk2 + s3 * kk3));
          sa = sum16(sa);
          float v = bf2f(uv);
          float w0_ = 1.f - bflo(ud.x), w1_ = 1.f - bfhi(ud.x), w2_ = 1.f - bflo(ud.y), w3_ = 1.f - bfhi(ud.y);
          s0 = s0 * w0_ + sa * bflo(ub.x) + v * bflo(uk.x);
          s1 = s1 * w1_ + sa * bfhi(ub.x) + v * bfhi(uk.x);
          s2 = s2 * w2_ + sa * bflo(ub.y) + v * bflo(uk.y);
          s3 = s3 * w3_ + sa * bfhi(ub.y) + v * bfhi(uk.y);
          float o = (s0 * bflo(ur.x) + s1 * bfhi(ur.x)) + (s2 * bflo(ur.y) + s3 * bfhi(ur.y));
          o = sum16(o);
          if (ks == 0) {
            long row = scan_row(b, dir, ci * 64 + s);
            O[row * 256 + h * 64 + vrow] = (bf16_t)f2bf(o);
          }
        }
      }
      if (ci + 1 < NCH) { SC_SSTORE((ci + 1) & 1); }
      __syncthreads();
    }
  }
}

template <bool DIFF>
DI void attn_unit(const Params& p, int l, int b, int h, int qrow0, int qpos0, int kb_lo, int kb_hi, int kc_lo, char* smem) {
  const int tid = my_tid(), lane = tid & 63, wid = tid >> 6, g = lane >> 4, r16 = lane & 15;
  const bf16_t* QK = (const bf16_t*)(p.ws + (DIFF ? R_PDF : R_PSW));
  const int ldq = DIFF ? 512 : 384;
  const int qc0 = h * 64;
  const int kc0 = 256 + (DIFF ? h * 64 : (h >> 1) * 64);
  const bf16_t* VT = DIFF ? (const bf16_t*)(p.ws + R_VTDF) + ((size_t)b * 256 + h * 64) * KEYS
                          : (const bf16_t*)(p.ws + R_VTSW) + ((size_t)b * 128 + (h >> 1) * 64) * KEYS;
  const int nblk = (kb_hi - kb_lo) + (68 - kc_lo);
  const float sc = (DIFF ? 0.17677669529663687f : 0.125f) * 1.4426950408889634f;
  bf16x8 qf[2];
  {
    const bf16_t* qp = QK + (size_t)(qrow0 + wid * 16 + r16) * ldq + qc0 + g * 8;
    qf[0] = *(const bf16x8*)(qp); qf[1] = *(const bf16x8*)(qp + 32);
  }
  constexpr int NC = DIFF ? 2 : 1;
  float m[NC], lsum[NC];
  f32x4 O[NC][4];
#pragma unroll
  for (int c = 0; c < NC; ++c) {
    if (DIFF) { m[c] = -1e30f; lsum[c] = 0.f; }
    else { m[c] = p.in[16][l * 4 + h] * 1.4426950408889634f; lsum[c] = (g == 0) ? 1.f : 0.f; }
#pragma unroll
    for (int dt = 0; dt < 4; ++dt) O[c][dt] = (f32x4){0.f, 0.f, 0.f, 0.f};
  }
  const int lr = tid >> 3, lc = tid & 7;
  uint4 rk, rv;
#define AT_GLOAD(i)                                                                                   \
  do {                                                                                                \
    int kb = (i) < (kb_hi - kb_lo) ? kb_lo + (i) : kc_lo + ((i) - (kb_hi - kb_lo));                    \
    long krow = kb < 64 ? (long)b * SL + kb * 64 + lr : (long)ML + b * CL + (kb - 64) * 64 + lr;       \
    rk = *(const uint4*)(QK + krow * ldq + kc0 + lc * 8);                                             \
    rv = *(const uint4*)(VT + (size_t)lr * KEYS + kb * 64 + lc * 8);                                  \
  } while (0)
#define AT_SSTORE(buf)                                                                                \
  do {                                                                                                \
    *(uint4*)(smem + (buf) * 18432 + lr * 144 + lc * 16) = rk;                                        \
    *(uint4*)(smem + (buf) * 18432 + 9216 + lr * 144 + lc * 16) = rv;                                 \
  } while (0)
  __syncthreads();
  AT_GLOAD(0);
  AT_SSTORE(0);
  __syncthreads();
  const int qpos = qpos0 + wid * 16 + r16;
  for (int i = 0; i < nblk; ++i) {
    if (i + 1 < nblk) AT_GLOAD(i + 1);
    const int kb = i < (kb_hi - kb_lo) ? kb_lo + i : kc_lo + (i - (kb_hi - kb_lo));
    const bool masked = (!DIFF) && (kb < 64);
    const char* Kt = smem + (i & 1) * 18432; const char* Vt = Kt + 9216;
    f32x4 S[NC][4];
#pragma unroll
    for (int kt = 0; kt < 4; ++kt) {
      bf16x8 k0 = *(const bf16x8*)(Kt + (kt * 16 + r16) * 144 + g * 16);
      bf16x8 k1 = *(const bf16x8*)(Kt + (kt * 16 + r16) * 144 + 64 + g * 16);
      if (DIFF) {
        S[0][kt] = __builtin_amdgcn_mfma_f32_16x16x32_bf16(k0, qf[0], (f32x4){0.f, 0.f, 0.f, 0.f}, 0, 0, 0);
        S[NC - 1][kt] = __builtin_amdgcn_mfma_f32_16x16x32_bf16(k1, qf[1], (f32x4){0.f, 0.f, 0.f, 0.f}, 0, 0, 0);
      } else {
        f32x4 t = __builtin_amdgcn_mfma_f32_16x16x32_bf16(k0, qf[0], (f32x4){0.f, 0.f, 0.f, 0.f}, 0, 0, 0);
        S[0][kt] = __builtin_amdgcn_mfma_f32_16x16x32_bf16(k1, qf[1], t, 0, 0, 0);
      }
    }
    bf16x8 pf[NC][2];
#pragma unroll
    for (int c = 0; c < NC; ++c) {
      float mx = -1e30f;
#pragma unroll
      for (int kt = 0; kt < 4; ++kt)
#pragma unroll
        for (int j = 0; j < 4; ++j) {
          float v = S[c][kt][j] * sc;
          if (masked) { int kpos = kb * 64 + kt * 16 + g * 4 + j; int dd = kpos - qpos; if (dd > 128 || dd < -128) v = -1e30f; }
          S[c][kt][j] = v; mx = fmaxf(mx, v);
        }
      mx = fmaxf(mx, __shfl_xor(mx, 16)); mx = fmaxf(mx, __shfl_xor(mx, 32));
      float mn = fmaxf(m[c], mx);
      float alpha = __builtin_amdgcn_exp2f(m[c] - mn);
      m[c] = mn;
      float ps = 0.f;
      unsigned pk[8];
#pragma unroll
      for (int kt = 0; kt < 4; ++kt) {
        float e0 = __builtin_amdgcn_exp2f(S[c][kt][0] - mn), e1 = __builtin_amdgcn_exp2f(S[c][kt][1] - mn), e2 = __builtin_amdgcn_exp2f(S[c][kt][2] - mn), e3 = __builtin_amdgcn_exp2f(S[c][kt][3] - mn);
        ps += (e0 + e1) + (e2 + e3);
        pk[kt * 2] = pack2(e0, e1); pk[kt * 2 + 1] = pack2(e2, e3);
      }
      lsum[c] = lsum[c] * alpha + ps;
#pragma unroll
      for (int dt = 0; dt < 4; ++dt) { O[c][dt][0] *= alpha; O[c][dt][1] *= alpha; O[c][dt][2] *= alpha; O[c][dt][3] *= alpha; }
      union { unsigned u[4]; bf16x8 v; } cv;
      cv.u[0] = pk[0]; cv.u[1] = pk[1]; cv.u[2] = pk[2]; cv.u[3] = pk[3]; pf[c][0] = cv.v;
      cv.u[0] = pk[4]; cv.u[1] = pk[5]; cv.u[2] = pk[6]; cv.u[3] = pk[7]; pf[c][1] = cv.v;
    }
#pragma unroll
    for (int dt = 0; dt < 4; ++dt)
#pragma unroll
      for (int s2 = 0; s2 < 2; ++s2) {
        union { uint2 u[2]; bf16x8 v; } vf;
        vf.u[0] = *(const uint2*)(Vt + (dt * 16 + r16) * 144 + (2 * s2) * 32 + g * 8);
        vf.u[1] = *(const uint2*)(Vt + (dt * 16 + r16) * 144 + (2 * s2 + 1) * 32 + g * 8);
#pragma unroll
        for (int c = 0; c < NC; ++c) O[c][dt] = __builtin_amdgcn_mfma_f32_16x16x32_bf16(vf.v, pf[c][s2], O[c][dt], 0, 0, 0);
      }
    if (i + 1 < nblk) AT_SSTORE((i + 1) & 1);
    __syncthreads();
  }
#undef AT_GLOAD
#undef AT_SSTORE
  float linv[NC];
#pragma unroll
  for (int c = 0; c < NC; ++c) { float t = lsum[c]; t += __shfl_xor(t, 16); t += __shfl_xor(t, 32); linv[c] = 1.f / t; }
  const size_t orow = (size_t)(qrow0 + wid * 16 + r16);
  if (!DIFF) {
    bf16_t* Y = (bf16_t*)(p.ws + R_YSW);
#pragma unroll
    for (int dt = 0; dt < 4; ++dt) {
      uint2 o; o.x = pack2(O[0][dt][0] * linv[0], O[0][dt][1] * linv[0]); o.y = pack2(O[0][dt][2] * linv[0], O[0][dt][3] * linv[0]);
      *(uint2*)(Y + orow * 256 + h * 64 + dt * 16 + g * 4) = o;
    }
  } else {
    const float lam_init = 0.8f - 0.6f * __expf(-0.3f * (float)l);
    float d1 = 0.f, d2 = 0.f;
    if (lane < 32) { d1 = p.in[28][l * 32 + lane] * p.in[29][l * 32 + lane]; d2 = p.in[30][l * 32 + lane] * p.in[31][l * 32 + lane]; }
    d1 = wave_sum(d1); d2 = wave_sum(d2);
    const float lam = expf(d1) - expf(d2) + lam_init;
    float ov[4][4]; float ss = 0.f;
#pragma unroll
    for (int dt = 0; dt < 4; ++dt)
#pragma unroll
      for (int j = 0; j < 4; ++j) { float v = O[0][dt][j] * linv[0] - lam * O[NC - 1][dt][j] * linv[NC - 1]; ov[dt][j] = v; ss += v * v; }
    ss += __shfl_xor(ss, 16); ss += __shfl_xor(ss, 32);
    const float rms = rsqrtf(ss * (1.f / 64.f) + 1e-5f) * (1.f - lam_init);
    const float* sg = p.in[32] + l * 64;
    bf16_t* Y = (bf16_t*)(p.ws + R_YDF);
#pragma unroll
    for (int dt = 0; dt < 4; ++dt) {
      const int d0 = dt * 16 + g * 4;
      uint2 o; o.x = pack2(ov[dt][0] * rms * sg[d0], ov[dt][1] * rms * sg[d0 + 1]); o.y = pack2(ov[dt][2] * rms * sg[d0 + 2], ov[dt][3] * rms * sg[d0 + 3]);
      *(uint2*)(Y + orow * 256 + h * 64 + d0) = o;
    }
  }
}

DI void ph_attn(const Params& p, int l, char* smem) {
  const bool need_ctx = (l == 0);
  const int n_sw = 1024 + (need_ctx ? 64 : 0);
  const int n_df = 1024 + (need_ctx ? 64 : 0);
  for (int u = blockIdx.x; u < n_sw + n_df; u += gridDim.x) {
    if (u < n_df) {
      if (u < 1024) { int b = u >> 7, h = (u >> 5) & 3, n = u & 31; attn_unit<true>(p, l, b, h, b * SL + n * 128, n * 128, 0, 64, 64, smem); }
      else { int v = u - 1024; int b = v >> 3, h = (v >> 1) & 3, n = v & 1; attn_unit<true>(p, l, b, h, ML + b * CL + n * 128, 0, 0, 0, 64, smem); }
    } else {
      int w = u - n_df;
      if (w < 1024) {
        int b = w >> 7, h = (w >> 5) & 3, n = w & 31;
        int lo = (n - 1) * 2; if (lo < 0) lo = 0; int hi = (n + 2) * 2; if (hi > 64) hi = 64;
        attn_unit<false>(p, l, b, h, b * SL + n * 128, n * 128, lo, hi, 64, smem);
      } else { int v = w - 1024; int b = v >> 3, h = (v >> 1) & 3, n = v & 1; attn_unit<false>(p, l, b, h, ML + b * CL + n * 128, 0, 0, 0, 64, smem); }
    }
  }
}

DI void ph_rwout(const Params& p, int l) {
  const int lane = my_tid() & 63, wid = my_tid() >> 6;
  const bf16_t* S = (const bf16_t*)(p.ws + R_STR); const bf16_t* Gs = (const bf16_t*)(p.ws + R_G);
  const bf16_t* OF = (const bf16_t*)(p.ws + R_OF); const bf16_t* OB = (const bf16_t*)(p.ws + R_OB);
  bf16_t* Y = (bf16_t*)(p.ws + R_YRW);
  const size_t SU = (size_t)MT * 256;
  const float4 rk = *(const float4*)(p.in[25] + (size_t)l * 256 + lane * 4);
  const float4 gam = *(const float4*)(p.in[26] + (size_t)l * 256 + lane * 4);
  const float4 bet = *(const float4*)(p.in[27] + (size_t)l * 256 + lane * 4);
  const int nrows = (l == 0) ? MT : ML;
  for (int row = blockIdx.x * 8 + wid; row < nrows; row += gridDim.x * 8) {
    const size_t o = (size_t)row * 256 + lane * 4;
    uint2 ur = *(const uint2*)(S + o), uk = *(const uint2*)(S + SU + o), uv = *(const uint2*)(S + 2 * SU + o);
    uint2 uf = *(const uint2*)(OF + o), ub = *(const uint2*)(OB + o), ugf = *(const uint2*)(Gs + o), ugb = *(const uint2*)(Gs + SU + o);
    float r[4] = {bflo(ur.x), bfhi(ur.x), bflo(ur.y), bfhi(ur.y)};
    float k[4] = {bflo(uk.x), bfhi(uk.x), bflo(uk.y), bfhi(uk.y)};
    float v[4] = {bflo(uv.x), bfhi(uv.x), bflo(uv.y), bfhi(uv.y)};
    float f[4] = {bflo(uf.x), bfhi(uf.x), bflo(uf.y), bfhi(uf.y)};
    float bb[4] = {bflo(ub.x), bfhi(ub.x), bflo(ub.y), bfhi(ub.y)};
    float gf[4] = {bflo(ugf.x), bfhi(ugf.x), bflo(ugf.y), bfhi(ugf.y)};
    float gb[4] = {bflo(ugb.x), bfhi(ugb.x), bflo(ugb.y), bfhi(ugb.y)};
    const float rkv[4] = {rk.x, rk.y, rk.z, rk.w}; const float ga[4] = {gam.x, gam.y, gam.z, gam.w}; const float be[4] = {bet.x, bet.y, bet.z, bet.w};
    float bon = 0.f, sf = 0.f, sb = 0.f;
#pragma unroll
    for (int i = 0; i < 4; ++i) { bon += r[i] * k[i] * rkv[i]; sf += f[i]; sb += bb[i]; }
    bon = sum16(bon); float muf = sum16(sf) * (1.f / 64.f), mub = sum16(sb) * (1.f / 64.f);
    float qf = 0.f, qb = 0.f;
#pragma unroll
    for (int i = 0; i < 4; ++i) { f[i] -= muf; bb[i] -= mub; qf += f[i] * f[i]; qb += bb[i] * bb[i]; }
    float rsf = rsqrtf(sum16(qf) * (1.f / 64.f) + 64e-5f), rsb = rsqrtf(sum16(qb) * (1.f / 64.f) + 64e-5f);
    float y[4];
#pragma unroll
    for (int i = 0; i < 4; ++i) {
      float bn = bon * v[i];
      y[i] = (f[i] * rsf * ga[i] + be[i] + bn) * gf[i] + (bb[i] * rsb * ga[i] + be[i] + bn) * gb[i];
    }
    uint2 oo; oo.x = pack2(y[0], y[1]); oo.y = pack2(y[2], y[3]);
    *(uint2*)(Y + o) = oo;
  }
}

DI void ph_merge(const Params& p, int l, char* smem) {
  const bf16_t* U = (const bf16_t*)(p.ws + R_URE);
  const int lane = my_tid() & 63, wid = my_tid() >> 6, wm = wid >> 1, wn = wid & 1, g = lane >> 4, r16 = lane & 15;
  const int mtiles = (l == 0) ? 136 : 128;
  bf16_t* ACC = (bf16_t*)(p.ws + R_ACC);
  for (int t = blockIdx.x; t < mtiles * 16; t += gridDim.x) {
    const int mtile = t >> 4, ntile = t & 15;
    f32x4 accS[4][2]; zero_acc<2>(accS);
    for (int j = 0; j < 4; ++j) {
      f32x4 accG[4][2], accB[4][2]; zero_acc<2>(accG); zero_acc<2>(accB);
      gemm_main<2>(accG, U, 1024, RowPlain{(long)mtile * 256}, (const bf16_t*)(p.ws + WB_GATE) + ((size_t)j * 1024 + ntile * 64) * 1024, 1024, 1024, smem);
      const size_t yoff = (j == 0) ? R_YHY : (j == 1) ? R_YSW : (j == 2) ? R_YRW : R_YDF;
      gemm_main<2>(accB, (const bf16_t*)(p.ws + yoff), 256, RowPlain{(long)mtile * 256}, (const bf16_t*)(p.ws + WB_BR) + ((size_t)j * 1024 + ntile * 64) * 256, 256, 256, smem);
#pragma unroll
      for (int mt = 0; mt < 4; ++mt)
#pragma unroll
        for (int nt = 0; nt < 2; ++nt)
#pragma unroll
          for (int e = 0; e < 4; ++e) accS[mt][nt][e] += sigmoidf_(accG[mt][nt][e]) * accB[mt][nt][e];
    }
#pragma unroll
    for (int mt = 0; mt < 4; ++mt)
#pragma unroll
      for (int nt = 0; nt < 2; ++nt)
#pragma unroll
        for (int e = 0; e < 4; ++e) {
          size_t row = (size_t)mtile * 256 + wm * 64 + mt * 16 + g * 4 + e; int col = ntile * 64 + wn * 32 + nt * 16 + r16;
          ACC[row * 1024 + col] = (bf16_t)f2bf(accS[mt][nt][e]);
        }
  }
}

DI void ph_resgemm(const Params& p, int l, const bf16_t* A, int K, const bf16_t* Bt, const float* hsrc_lat, const float* hsrc_ctx, int gate_off, char* smem) {
  const int lane = my_tid() & 63, wid = my_tid() >> 6, wm = wid >> 1, wn = wid & 1, g = lane >> 4, r16 = lane & 15;
  const int mtiles = (l == 0) ? 136 : 128;
  const float* mod = (const float*)(p.ws + MISC_MOD) + (size_t)l * 9 * 6144;
  float* hc = (float*)(p.ws + OFF_HC);
  for (int t = blockIdx.x; t < mtiles * 8; t += gridDim.x) {
    const int mtile = t >> 3, ntile = t & 7;
    f32x4 acc[4][4]; zero_acc<4>(acc);
    gemm_main<4>(acc, A, K, RowPlain{(long)mtile * 256}, Bt + (size_t)ntile * 128 * K, K, K, smem);
    const int b = mtile < 128 ? (mtile >> 4) : 8;
    const float* gt = mod + (size_t)b * 6144 + gate_off;
#pragma unroll
    for (int mt = 0; mt < 4; ++mt)
#pragma unroll
      for (int nt = 0; nt < 4; ++nt) {
        const int col = ntile * 128 + wn * 64 + nt * 16 + r16; const float gv = gt[col];
#pragma unroll
        for (int e = 0; e < 4; ++e) {
          const int row = mtile * 256 + wm * 64 + mt * 16 + g * 4 + e;
          if (row < ML) { size_t o = (size_t)row * D + col; p.out[o] = DN_ALPHA * hsrc_lat[o] + gv * acc[mt][nt][e]; }
          else { size_t o = (size_t)(row - ML) * D + col; hc[o] = DN_ALPHA * hsrc_ctx[o] + gv * acc[mt][nt][e]; }
        }
      }
  }
}

DI void ph_ffnup(const Params& p, int l, char* smem) {
  const bf16_t* U = (const bf16_t*)(p.ws + R_U);
  const bf16_t* Bt = (const bf16_t*)(p.ws + WB_UP);
  bf16_t* HID = (bf16_t*)(p.ws + R_HID);
  const float* cw = p.in[38] + (size_t)l * 3 * 5632; const float* cb = p.in[39] + (size_t)l * 5632;
  const int tid = my_tid(), lane = tid & 63, wid = tid >> 6, wm = wid >> 1, wn = wid & 1, g = lane >> 4, r16 = lane & 15;
  const int mtiles = (l == 0) ? 152 : 136;
  float* T = (float*)smem;
  for (int t = blockIdx.x; t < mtiles * 44; t += gridDim.x) {
    const int mtile = t / 44, ntile = t % 44;
    long rowbase; int tt, len;
    if (mtile < 136) { int b = mtile / 17; tt = mtile % 17; len = SL; rowbase = (long)b * SL; }
    else { int v = mtile - 136; int b = v >> 1; tt = v & 1; len = CL; rowbase = (long)ML + b * CL; }
    f32x4 acc[4][4]; zero_acc<4>(acc);
    gemm_main<4>(acc, U, 1024, RowHalo{rowbase, tt * 254 - 1, len}, Bt + (size_t)ntile * 128 * 1024, 1024, 1024, smem);
#pragma unroll
    for (int mt = 0; mt < 4; ++mt)
#pragma unroll
      for (int nt = 0; nt < 4; ++nt)
#pragma unroll
        for (int e = 0; e < 4; ++e) T[(wm * 64 + mt * 16 + g * 4 + e) * 132 + wn * 64 + nt * 16 + r16] = acc[mt][nt][e];
    __syncthreads();
    {
      const int ch = tid & 63, rgp = tid >> 6; const int ca = ntile * 64 + ch, cbx = 2816 + ca;
      const float a0 = cw[ca], a1 = cw[5632 + ca], a2 = cw[2 * 5632 + ca], ab = cb[ca];
      const float b0 = cw[cbx], b1 = cw[5632 + cbx], b2 = cw[2 * 5632 + cbx], bb = cb[cbx];
      for (int r = 1 + rgp; r <= 254; r += 8) {
        int tok = tt * 254 - 1 + r;
        if (tok < len) {
          float av = a0 * T[(r - 1) * 132 + ch] + a1 * T[r * 132 + ch] + a2 * T[(r + 1) * 132 + ch] + ab;
          float bv = b0 * T[(r - 1) * 132 + 64 + ch] + b1 * T[r * 132 + 64 + ch] + b2 * T[(r + 1) * 132 + 64 + ch] + bb;
          HID[(size_t)(rowbase + tok) * 2816 + ca] = (bf16_t)f2bf(siluf_(av) * bv);
        }
      }
    }
  }
}

#ifndef REP_PREP
#define REP_PREP 1
#endif
#ifndef REP_GEMM
#define REP_GEMM 1
#endif
#ifndef REP_HY
#define REP_HY 1
#endif
#ifndef REP_RWP
#define REP_RWP 1
#endif
#ifndef REP_SCAN
#define REP_SCAN 1
#endif
#ifndef REP_ATTN
#define REP_ATTN 1
#endif
#ifndef PH_END
#define PH_END 24
#endif
#define SYNC_OR_RET(idx) do { if ((idx) + 1 >= PH_END) return; grid.sync(); } while (0)
template <int l>
DI void run_layer(const Params& p, cg::grid_group& grid, char* smem) {
  const float* mod = (const float*)(p.ws + MISC_MOD) + (size_t)l * 9 * 6144;
  float* hc = (float*)(p.ws + OFF_HC);
  const float* hl_src = (l == 0) ? p.in[0] : p.out;
  const float* hc_src = (l == 0) ? p.in[2] : hc;
  constexpr int B0 = l * 12;
  for (int rep = 0; rep < REP_PREP; ++rep) {
  ph_convert(p, l, smem);
  if (l == 0) ph_ada(p, smem);
  hy_rawfilter(p, l, SL, (float*)(p.ws + R_RAWF), smem);
  if (l == 0) hy_rawfilter(p, l, CL, (float*)(p.ws + MISC_RAWC), smem);
  }
  SYNC_OR_RET(B0 + 0);
  for (int rep = 0; rep < REP_PREP; ++rep) ph_kf(p, l, smem);
  ph_ln(hl_src, hc_src, nullptr, nullptr, nullptr, nullptr, (bf16_t*)(p.ws + R_U), mod, 0, MT);
  SYNC_OR_RET(B0 + 1);
  for (int rep = 0; rep < REP_GEMM; ++rep) ph_inproj(p, smem);
  SYNC_OR_RET(B0 + 2);
  for (int rep = 0; rep < REP_HY; ++rep) {
  ph_hyena(p, l, smem);
  if (l == 0) ph_hyena_ctx(p, l, smem);
  }
  ph_rope(p, smem);
  for (int rep = 0; rep < REP_RWP; ++rep) ph_rwprep(p, l, smem);
  SYNC_OR_RET(B0 + 3);
  for (int rep = 0; rep < REP_SCAN; ++rep) ph_scan(p, smem);
  for (int rep = 0; rep < REP_ATTN; ++rep) ph_attn(p, l, smem);
  SYNC_OR_RET(B0 + 4);
  ph_rwout(p, l);
  ph_ln(hl_src, hc_src, nullptr, nullptr, nullptr, nullptr, (bf16_t*)(p.ws + R_URE), mod, 0, l == 0 ? MT : ML);
  SYNC_OR_RET(B0 + 5);
  for (int rep = 0; rep < REP_GEMM; ++rep) ph_merge(p, l, smem);
  SYNC_OR_RET(B0 + 6);
  ph_resgemm(p, l, (const bf16_t*)(p.ws + R_ACC), 1024, (const bf16_t*)(p.ws + WB_OUT), hl_src, hc_src, 2048, smem);
  SYNC_OR_RET(B0 + 7);
  ph_ln(p.out, hc, p.out, hc, p.in[35] + (size_t)l * D, p.in[36] + (size_t)l * D, (bf16_t*)(p.ws + R_U), mod, 3072, l == 0 ? MT : ML);
  SYNC_OR_RET(B0 + 8);
  for (int rep = 0; rep < REP_GEMM; ++rep) ph_ffnup(p, l, smem);
  SYNC_OR_RET(B0 + 9);
  ph_resgemm(p, l, (const bf16_t*)(p.ws + R_HID), 2816, (const bf16_t*)(p.ws + WB_DOWN), p.out, hc, 5120, smem);
  SYNC_OR_RET(B0 + 10);
  ph_ln(p.out, hc, p.out, hc, p.in[41] + (size_t)l * D, p.in[42] + (size_t)l * D, nullptr, mod, 0, l == 0 ? MT : ML);
  SYNC_OR_RET(B0 + 11);
}

__global__ void __launch_bounds__(NTHR) mega(Params p) {
  extern __shared__ __attribute__((aligned(16))) char smem[];
  cg::grid_group grid = cg::this_grid();
  run_layer<0>(p, grid, smem);
  if (PH_END > 12) run_layer<1>(p, grid, smem);
}

extern "C" void kernel_launch(void* const* d_in, const int* in_sizes, int n_in, void* d_out, int out_size,
                              void* d_ws, size_t ws_size, hipStream_t stream) {
  static int grid_blocks = 0;
  if (!grid_blocks) {
    int dev = 0, cus = 0, per_cu = 0;
    (void)hipGetDevice(&dev);
    (void)hipDeviceGetAttribute(&cus, hipDeviceAttributeMultiprocessorCount, dev);
    (void)hipFuncSetAttribute((const void*)mega, hipFuncAttributeMaxDynamicSharedMemorySize, SMEM_BYTES);
    (void)hipOccupancyMaxActiveBlocksPerMultiprocessor(&per_cu, mega, NTHR, SMEM_BYTES);
    if (per_cu < 1) per_cu = 1;
    if (per_cu > 1) per_cu = 1;
    grid_blocks = cus * per_cu;
  }
  Params p{};
  for (int i = 0; i < 43; ++i) p.in[i] = (const float*)d_in[i];
  p.out = (float*)d_out; p.ws = (char*)d_ws;
  void* args[] = {&p};
  hipError_t e = hipLaunchCooperativeKernel((void*)mega, dim3(grid_blocks), dim3(NTHR), args, SMEM_BYTES, stream);
  if (e != hipSuccess) fprintf(stderr, "cooperative launch failed: %s (grid %d)\n", hipGetErrorString(e), grid_blocks);
}
```

```cpp
#include <hip/hip_runtime.h>
#include <hip/hip_cooperative_groups.h>
#include <cstdio>
#include <cstdint>
namespace cg = cooperative_groups;

#define DI __device__ __forceinline__
typedef unsigned short bf16_t;
typedef short bf16x8 __attribute__((ext_vector_type(8)));
typedef float f32x4 __attribute__((ext_vector_type(4)));

constexpr int D = 1024, NB = 8, SL = 4096, CL = 256;
constexpr int ML = NB * SL, MC = NB * CL, MT = ML + MC;
constexpr int KEYS = SL + CL;
constexpr int NTHR = 512;
constexpr float DN_ALPHA = 1.41421356237f;
constexpr size_t UNIT = (size_t)MT * 512;

constexpr size_t WB_IN = 0;
constexpr size_t WB_GATE = WB_IN + (size_t)3328 * 1024 * 2;
constexpr size_t WB_BR = WB_GATE + (size_t)4096 * 1024 * 2;
constexpr size_t WB_OUT = WB_BR + (size_t)4 * 1024 * 256 * 2;
constexpr size_t WB_UP = WB_OUT + (size_t)1024 * 1024 * 2;
constexpr size_t WB_DOWN = WB_UP + (size_t)5632 * 1024 * 2;
constexpr size_t WB_END = WB_DOWN + (size_t)1024 * 2816 * 2;
constexpr size_t OFF_KF = WB_END;
constexpr size_t OFF_HC = OFF_KF + (size_t)512 * 8192 * 8;
constexpr size_t OFF_MISC = OFF_HC + (size_t)MC * D * 4;
constexpr size_t MISC_MOD = OFF_MISC;
constexpr size_t MISC_TW = MISC_MOD + (size_t)2 * 9 * 6144 * 4;
constexpr size_t MISC_RAWC = MISC_TW + 4096 * 8;
constexpr size_t MISC_GCTX = MISC_RAWC + (size_t)256 * 1024 * 4;
constexpr size_t OFF_R = OFF_MISC + (size_t)4 * 1024 * 1024;
constexpr size_t R_YHY = OFF_R, R_YSW = OFF_R + UNIT, R_YDF = OFF_R + 2 * UNIT;
constexpr size_t R_PHY = OFF_R + 3 * UNIT;
constexpr size_t R_PSW = OFF_R + 6 * UNIT;
constexpr size_t R_VTSW = R_PSW + (size_t)MT * 384 * 2;
constexpr size_t R_PDF = OFF_R + 8 * UNIT;
constexpr size_t R_VTDF = OFF_R + 10 * UNIT;
constexpr size_t R_PRW = OFF_R + 11 * UNIT;
constexpr size_t R_STR = R_PRW + (size_t)MT * 1216 * 2;
constexpr size_t R_G = R_STR + 7 * UNIT;
constexpr size_t R_END = R_G + 2 * UNIT;
constexpr size_t R_RAWF = OFF_R;
constexpr size_t R_OF = R_PHY, R_OB = R_PHY + UNIT;
constexpr size_t R_URE = R_PSW;
constexpr size_t R_YRW = R_VTDF;
constexpr size_t R_ACC = R_PRW;
constexpr size_t R_U = R_STR;
constexpr size_t R_HID = OFF_R;
static_assert(R_END <= (size_t)512 * 1024 * 1024, "ws overflow");
static_assert((size_t)MT * 2816 * 2 <= 11 * UNIT, "hid");

constexpr int SMEM_BYTES = 136 * 1024;

struct Params {
  const float* in[43];
  float* out;
  char* ws;
};

DI int my_tid() { int t = (int)__builtin_amdgcn_workitem_id_x(); asm volatile("" : "+v"(t)); return t; }
DI unsigned f2bf(float f) { unsigned u = __float_as_uint(f); u += 0x7fffu + ((u >> 16) & 1u); return u >> 16; }
DI float bf2f(unsigned h) { return __uint_as_float(h << 16); }
typedef __bf16 bf16v2_t __attribute__((ext_vector_type(2)));
typedef float f32v2_t __attribute__((ext_vector_type(2)));
DI unsigned pack2(float lo, float hi) { f32v2_t v = {lo, hi}; bf16v2_t b = __builtin_convertvector(v, bf16v2_t); return __builtin_bit_cast(unsigned, b); }

DI float bflo(unsigned w) { return __uint_as_float(w << 16); }
DI float bfhi(unsigned w) { return __uint_as_float(w & 0xffff0000u); }
DI float sigmoidf_(float x) { return 1.f / (1.f + __expf(-x)); }
DI float siluf_(float x) { return x / (1.f + __expf(-x)); }
DI float wave_sum(float v) {
#pragma unroll
  for (int o = 32; o >= 1; o >>= 1) v += __shfl_xor(v, o);
  return v;
}
template <int CTRL> DI float dpp_mov(float v) {
  return __int_as_float(__builtin_amdgcn_update_dpp(0, __float_as_int(v), CTRL, 0xf, 0xf, false));
}
DI float sum16(float v) {
  v += dpp_mov<0xB1>(v);
  v += dpp_mov<0x4E>(v);
  v += dpp_mov<0x141>(v);
  v += dpp_mov<0x140>(v);
  return v;
}
DI void lds_barrier() { asm volatile("s_waitcnt lgkmcnt(0)" ::: "memory"); __builtin_amdgcn_s_barrier(); asm volatile("" ::: "memory"); }
DI uint4 sel4(bool z, uint4 v) { return make_uint4(z ? 0u : v.x, z ? 0u : v.y, z ? 0u : v.z, z ? 0u : v.w); }
DI int mod_idx(int row) { return row < ML ? (row >> 12) : 8; }

template <int NTW, class RowFn>
DI void gemm_main(f32x4 (&acc)[4][NTW], const bf16_t* __restrict__ A, int lda, RowFn rowfn,
                  const bf16_t* __restrict__ Bt, int ldb, int K, char* smem) {
  constexpr int BN = NTW * 32;
  constexpr int A_BYTES = 256 * 144, B_BYTES = BN * 144, STAGE = A_BYTES + B_BYTES;
  constexpr int NBL = BN / 64;
  const int tid = my_tid(), lane = tid & 63, wid = tid >> 6, wm = wid >> 1, wn = wid & 1, g = lane >> 4, r16 = lane & 15;
  const int chunk = tid & 7, lrow = tid >> 3;
  long a0 = rowfn(lrow), a1 = rowfn(lrow + 64), a2 = rowfn(lrow + 128), a3 = rowfn(lrow + 192);
  const uint4 zero4 = make_uint4(0, 0, 0, 0);
  const long c0 = a0 < 0 ? 0 : a0, c1 = a1 < 0 ? 0 : a1, c2 = a2 < 0 ? 0 : a2, c3 = a3 < 0 ? 0 : a3;
  uint4 ra0, ra1, ra2, ra3, rb0, rb1 = zero4;
  const bf16_t* Bp = Bt + (long)lrow * ldb + chunk * 8;
  auto GLOAD = [&](int k0) {
    ra0 = *(const uint4*)(A + c0 * lda + k0 + chunk * 8);
    ra1 = *(const uint4*)(A + c1 * lda + k0 + chunk * 8);
    ra2 = *(const uint4*)(A + c2 * lda + k0 + chunk * 8);
    ra3 = *(const uint4*)(A + c3 * lda + k0 + chunk * 8);
    rb0 = *(const uint4*)(Bp + k0);
    if constexpr (NBL > 1) rb1 = *(const uint4*)(Bp + (long)64 * ldb + k0);
  };
  auto SSTORE = [&](int st) {
    char* base = smem + st * STAGE + lrow * 144 + chunk * 16;
    *(uint4*)(base) = sel4(a0 < 0, ra0); *(uint4*)(base + 64 * 144) = sel4(a1 < 0, ra1);
    *(uint4*)(base + 128 * 144) = sel4(a2 < 0, ra2); *(uint4*)(base + 192 * 144) = sel4(a3 < 0, ra3);
    *(uint4*)(base + A_BYTES) = rb0;
    if constexpr (NBL > 1) *(uint4*)(base + A_BYTES + 64 * 144) = rb1;
  };
  __syncthreads();
  GLOAD(0);
  SSTORE(0);
  lds_barrier();
  const int nk = K >> 6;
  for (int kt = 0; kt < nk; ++kt) {
    const int st = kt & 1;
    if (kt + 1 < nk) GLOAD((kt + 1) * 64);
    const char* As = smem + st * STAGE + (wm * 64 + r16) * 144 + g * 16;
    const char* Bs = smem + st * STAGE + A_BYTES + (wn * (NTW * 16) + r16) * 144 + g * 16;
#pragma unroll
    for (int kk = 0; kk < 2; ++kk) {
      bf16x8 af[4], bfr[NTW];
#pragma unroll
      for (int mt = 0; mt < 4; ++mt) af[mt] = *(const bf16x8*)(As + mt * 16 * 144 + kk * 64);
#pragma unroll
      for (int nt = 0; nt < NTW; ++nt) bfr[nt] = *(const bf16x8*)(Bs + nt * 16 * 144 + kk * 64);
#pragma unroll
      for (int mt = 0; mt < 4; ++mt)
#pragma unroll
        for (int nt = 0; nt < NTW; ++nt)
          acc[mt][nt] = __builtin_amdgcn_mfma_f32_16x16x32_bf16(af[mt], bfr[nt], acc[mt][nt], 0, 0, 0);
    }
    if (kt + 1 < nk) SSTORE(st ^ 1);
    lds_barrier();
  }
}

DI bool next_tile(int i, int MTILES, int NTILES, int& mt, int& nt) {
  const int xcd = blockIdx.x & 7, slot = blockIdx.x >> 3, nslot = gridDim.x >> 3;
  const int m_lo = (MTILES * xcd) >> 3, m_hi = (MTILES * (xcd + 1)) >> 3, Mloc = m_hi - m_lo;
  const int q = i * nslot + slot;
  if (q >= Mloc * NTILES) return false;
  const int gidx = q / (4 * NTILES), m0 = gidx * 4;
  const int rows = (Mloc - m0) < 4 ? (Mloc - m0) : 4;
  const int within = q - gidx * 4 * NTILES;
  nt = within / rows; mt = m_lo + m0 + within % rows;
  return true;
}

struct RowPlain { long base; DI long operator()(int r) const { return base + r; } };
struct RowHalo { long rowbase; int t0; int len; DI long operator()(int r) const { int t = t0 + r; return (t >= 0 && t < len) ? rowbase + t : -1; } };

template <int NTW> DI void zero_acc(f32x4 (&acc)[4][NTW]) {
#pragma unroll
  for (int i = 0; i < 4; ++i)
#pragma unroll
    for (int j = 0; j < NTW; ++j) acc[i][j] = (f32x4){0.f, 0.f, 0.f, 0.f};
}

DI void cvt_unit(const float* __restrict__ src, int ldsrc, int srccol0, int k0, bf16_t* __restrict__ dst, int K, int n0, char* smem) {
  float* T = (float*)smem;
  const int tid = my_tid();
  __syncthreads();
  if (srccol0 >= 0) {
#pragma unroll
    for (int i = 0; i < 8; ++i) {
      int idx = tid + i * 512; int k = idx >> 6, n = idx & 63;
      T[k * 65 + n] = src[(long)(k0 + k) * ldsrc + srccol0 + n];
    }
  }
  __syncthreads();
  int n = tid >> 3, kc = (tid & 7) * 8;
  uint4 o = make_uint4(0, 0, 0, 0);
  if (srccol0 >= 0) {
    o.x = pack2(T[(kc + 0) * 65 + n], T[(kc + 1) * 65 + n]);
    o.y = pack2(T[(kc + 2) * 65 + n], T[(kc + 3) * 65 + n]);
    o.z = pack2(T[(kc + 4) * 65 + n], T[(kc + 5) * 65 + n]);
    o.w = pack2(T[(kc + 6) * 65 + n], T[(kc + 7) * 65 + n]);
  }
  *(uint4*)(dst + (long)(n0 + n) * K + k0 + kc) = o;
}

DI void ph_convert(const Params& p, int l, char* smem) {
  for (int u = blockIdx.x; u < 4480; u += gridDim.x) {
    if (u < 832) {
      int gI = u >> 4, kt = u & 15; int n0 = gI * 64; int sc;
      if (n0 < 1280) sc = n0; else if (n0 < 2048) sc = 2496 + (n0 - 1280); else if (n0 < 3264) sc = 1280 + (n0 - 2048); else sc = -1;
      cvt_unit(p.in[6] + (size_t)l * 1024 * 7360, 7360, sc, kt * 64, (bf16_t*)(p.ws + WB_IN), 1024, n0, smem);
    } else if (u < 1856) {
      int v = u - 832; int gI = v >> 4, kt = v & 15;
      cvt_unit(p.in[6] + (size_t)l * 1024 * 7360, 7360, 3264 + gI * 64, kt * 64, (bf16_t*)(p.ws + WB_GATE), 1024, gI * 64, smem);
    } else if (u < 2112) {
      int v = u - 1856; int gI = v >> 2, kt = v & 3; int j = gI >> 4, gg = gI & 15;
      cvt_unit(p.in[33] + ((size_t)l * 4 + j) * 256 * 1024, 1024, gg * 64, kt * 64, (bf16_t*)(p.ws + WB_BR) + (size_t)j * 1024 * 256, 256, gg * 64, smem);
    } else if (u < 2368) {
      int v = u - 2112; int gI = v >> 4, kt = v & 15;
      cvt_unit(p.in[34] + (size_t)l * 1024 * 1024, 1024, gI * 64, kt * 64, (bf16_t*)(p.ws + WB_OUT), 1024, gI * 64, smem);
    } else if (u < 3776) {
      int v = u - 2368; int gI = v >> 4, kt = v & 15; int nt = gI >> 1, hb = gI & 1;
      cvt_unit(p.in[37] + (size_t)l * 1024 * 5632, 5632, hb * 2816 + nt * 64, kt * 64, (bf16_t*)(p.ws + WB_UP), 1024, gI * 64, smem);
    } else {
      int v = u - 3776; int gI = v / 44, kt = v % 44;
      cvt_unit(p.in[40] + (size_t)l * 2816 * 1024, 1024, gI * 64, kt * 64, (bf16_t*)(p.ws + WB_DOWN), 2816, gI * 64, smem);
    }
  }
}

DI void ph_ada(const Params& p, char* smem) {
  float* S = (float*)smem;
  float* R = S + 9 * 1024;
  const int tid = my_tid();
  bool loaded = false;
  for (int u = blockIdx.x; u < 192; u += gridDim.x) {
    if (!loaded) {
      __syncthreads();
      for (int i = tid; i < 9 * 1024; i += NTHR) { float c = i < 8192 ? p.in[1][i] : p.in[3][i - 8192]; S[i] = siluf_(c); }
      loaded = true;
    }
    __syncthreads();
    int l = u / 96, n0 = (u % 96) * 64;
    int col = tid & 63, ks = tid >> 6;
    const float* W = p.in[4] + (size_t)l * 1024 * 6144 + n0 + col;
    float a[9];
#pragma unroll
    for (int b = 0; b < 9; ++b) a[b] = 0.f;
    for (int k = ks * 128; k < ks * 128 + 128; ++k) {
      float w = W[(size_t)k * 6144];
#pragma unroll
      for (int b = 0; b < 9; ++b) a[b] += S[b * 1024 + k] * w;
    }
#pragma unroll
    for (int b = 0; b < 9; ++b) R[(ks * 9 + b) * 64 + col] = a[b];
    __syncthreads();
    for (int i = tid; i < 9 * 64; i += NTHR) {
      int b = i >> 6, c = i & 63; float s = 0.f;
#pragma unroll
      for (int k2 = 0; k2 < 8; ++k2) s += R[(k2 * 9 + b) * 64 + c];
      s += p.in[5][(size_t)l * 6144 + n0 + c];
      ((float*)(p.ws + MISC_MOD))[((size_t)l * 9 + b) * 6144 + n0 + c] = s;
    }
  }
  for (int i = blockIdx.x * NTHR + tid; i < 4096; i += gridDim.x * NTHR) {
    float s, c; sincospif(-(float)i / 4096.f, &s, &c);
    ((float2*)(p.ws + MISC_TW))[i] = make_float2(c, s);
  }
}

DI void hy_rawfilter(const Params& p, int l, int Lf, float* __restrict__ dst, char* smem) {
  float* W1 = (float*)smem;
  float* W2 = W1 + 33 * 64;
  float* Z = W2 + 64 * 64;
  float* H1 = Z + 16 * 36;
  float* H2 = H1 + 16 * 64;
  const int tid = my_tid();
  const float* w1 = p.in[9] + (size_t)l * 33 * 64; const float* b1 = p.in[10] + l * 64;
  const float* w2 = p.in[11] + (size_t)l * 64 * 64; const float* b2 = p.in[12] + l * 64;
  const float* w3 = p.in[13] + (size_t)l * 64 * 1024; const float* fr = p.in[14] + l * 64;
  const int nunits = Lf / 16;
  bool loaded = false;
  for (int u = blockIdx.x; u < nunits; u += gridDim.x) {
    __syncthreads();
    if (!loaded) {
      for (int i = tid; i < 33 * 64; i += NTHR) W1[i] = w1[i];
      for (int i = tid; i < 64 * 64; i += NTHR) W2[i] = w2[i];
      loaded = true;
    }
    const int t0 = u * 16;
    for (int i = tid; i < 16 * 33; i += NTHR) {
      int tt = i / 33, f = i % 33; int t = t0 + tt; float v;
      if (f == 0) v = (float)t / (float)(Lf - 1);
      else {
        int bi = (f - 1) & 15;
        float wv = 6.283185307179586f * (float)t / (float)Lf;
        float fb = 1e-4f + (15.f - 1e-4f) * (float)bi / 15.f;
        float ang = wv * fb;
        v = (f <= 16) ? cosf(ang) : -sinf(ang);
      }
      Z[tt * 36 + f] = v;
    }
    __syncthreads();
    for (int i = tid; i < 16 * 64; i += NTHR) {
      int tt = i >> 6, f = i & 63; float s = b1[f];
      for (int k = 0; k < 33; ++k) s += Z[tt * 36 + k] * W1[k * 64 + f];
      H1[tt * 64 + f] = sinf(fr[f] * s);
    }
    __syncthreads();
    for (int i = tid; i < 16 * 64; i += NTHR) {
      int tt = i >> 6, f = i & 63; float s = b2[f];
      for (int k = 0; k < 64; ++k) s += H1[tt * 64 + k] * W2[k * 64 + f];
      H2[tt * 64 + f] = sinf(fr[f] * s);
    }
    __syncthreads();
    float a0[16], a1[16];
#pragma unroll
    for (int i = 0; i < 16; ++i) { a0[i] = 0.f; a1[i] = 0.f; }
    for (int k = 0; k < 64; ++k) {
      float wa = w3[k * 1024 + tid], wb = w3[k * 1024 + 512 + tid];
#pragma unroll
      for (int i = 0; i < 16; ++i) { float h = H2[i * 64 + k]; a0[i] += h * wa; a1[i] += h * wb; }
    }
    {
      int w = tid & 255;
      float delta = fabsf(-3.0701134573253944f + (-15.350567286626972f + 3.0701134573253944f) * (float)w / 255.f);
#pragma unroll
      for (int i = 0; i < 16; ++i) {
        float tn = (float)(t0 + i) / (float)(Lf - 1);
        float dec = expf(-tn * delta);
        dst[(size_t)(t0 + i) * 1024 + tid] = a0[i] * dec;
        dst[(size_t)(t0 + i) * 1024 + 512 + tid] = a1[i] * dec;
      }
    }
  }
}

DI float2 cmul(float2 a, float2 b) { return make_float2(a.x * b.x - a.y * b.y, a.x * b.y + a.y * b.x); }
DI float2 cmulc(float2 a, float2 b) { return make_float2(a.x * b.x + a.y * b.y, a.y * b.x - a.x * b.y); }
DI void fft_dif(float2* X, const float2* W) {
  const int tid = my_tid();
  for (int ls = 12; ls >= 0; --ls) {
    const int span = 1 << ls;
    __syncthreads();
#pragma unroll
    for (int i = 0; i < 8; ++i) {
      int bf = tid + i * 512; int pos = bf & (span - 1); int i0 = ((bf >> ls) << (ls + 1)) + pos; int i1 = i0 + span;
      float2 a = X[i0], b = X[i1]; float2 w = W[pos << (12 - ls)];
      X[i0] = make_float2(a.x + b.x, a.y + b.y);
      X[i1] = cmul(make_float2(a.x - b.x, a.y - b.y), w);
    }
  }
  __syncthreads();
}
DI void fft_dit_inv(float2* X, const float2* W) {
  const int tid = my_tid();
  for (int ls = 0; ls <= 12; ++ls) {
    const int span = 1 << ls;
    __syncthreads();
#pragma unroll
    for (int i = 0; i < 8; ++i) {
      int bf = tid + i * 512; int pos = bf & (span - 1); int i0 = ((bf >> ls) << (ls + 1)) + pos; int i1 = i0 + span;
      float2 a = X[i0], b = X[i1]; float2 w = W[pos << (12 - ls)];
      float2 t = cmulc(b, w);
      X[i0] = make_float2(a.x + t.x, a.y + t.y);
      X[i1] = make_float2(a.x - t.x, a.y - t.y);
    }
  }
  __syncthreads();
}
DI void load_twiddles(const Params& p, float2* W) {
  const float2* tw = (const float2*)(p.ws + MISC_TW);
  for (int i = my_tid(); i < 4096; i += NTHR) W[i] = tw[i];
}

DI void ph_kf(const Params& p, int l, char* smem) {
  float2* X = (float2*)smem; float2* W = X + 8192; float* red = (float*)(W + 4096);
  const int tid = my_tid(), lane = tid & 63, wid = tid >> 6;
  const float* rawf = (const float*)(p.ws + R_RAWF);
  float2* kf = (float2*)(p.ws + OFF_KF);
  bool tw = false;
  for (int u = blockIdx.x; u < 256; u += gridDim.x) {
    if (!tw) { load_twiddles(p, W); tw = true; }
    const int o = u >> 7, c = (u & 127) * 2;
    float2 fw[8], bw[8]; float sa = 0.f, sb = 0.f;
#pragma unroll
    for (int i = 0; i < 8; ++i) {
      int t = tid + i * 512;
      fw[i] = *(const float2*)(rawf + (size_t)t * 1024 + o * 512 + c);
      bw[i] = *(const float2*)(rawf + (size_t)t * 1024 + o * 512 + 256 + c);
      sa += fabsf(fw[i].x) + fabsf(bw[i].x); sb += fabsf(fw[i].y) + fabsf(bw[i].y);
    }
    sa = wave_sum(sa); sb = wave_sum(sb);
    __syncthreads();
    if (lane == 0) { red[wid * 2] = sa; red[wid * 2 + 1] = sb; }
    __syncthreads();
    float ta = 0.f, tb = 0.f;
#pragma unroll
    for (int w = 0; w < 8; ++w) { ta += red[w * 2]; tb += red[w * 2 + 1]; }
    const float ia = 1.f / ta, ib = 1.f / tb;
#pragma unroll
    for (int i = 0; i < 8; ++i) {
      int t = tid + i * 512;
      X[t] = make_float2(fw[i].x * ia, fw[i].y * ib);
      if (t >= 1) X[8192 - t] = make_float2(bw[i].x * ia, bw[i].y * ib);
      else X[4096] = make_float2(0.f, 0.f);
    }
    fft_dif(X, W);
    float2* ka = kf + (size_t)(o * 256 + c) * 8192; float2* kb = ka + 8192;
#pragma unroll 4
    for (int i = 0; i < 16; ++i) {
      int pidx = tid + i * 512;
      int k = (int)(__brev((unsigned)pidx) >> 19);
      int k2 = (8192 - k) & 8191;
      int p2 = (int)(__brev((unsigned)k2) >> 19);
      float2 c1 = X[pidx], c2 = X[p2];
      float2 A = make_float2(0.5f * (c1.x + c2.x), 0.5f * (c1.y - c2.y));
      float2 Bv = make_float2(0.5f * (c1.y + c2.y), -0.5f * (c1.x - c2.x));
      ka[pidx] = A; kb[pidx] = Bv;
    }
    __syncthreads();
  }
  if (l == 0) {
    const float* rawc = (const float*)(p.ws + MISC_RAWC);
    float* G = (float*)(p.ws + MISC_GCTX);
    for (int u = blockIdx.x * 8 + wid; u < 512; u += gridDim.x * 8) {
      int o = u >> 8, c = u & 255; float f[4], b[4]; float s = 0.f;
#pragma unroll
      for (int i = 0; i < 4; ++i) {
        int t = lane + i * 64;
        f[i] = rawc[(size_t)t * 1024 + o * 512 + c]; b[i] = rawc[(size_t)t * 1024 + o * 512 + 256 + c];
        s += fabsf(f[i]) + fabsf(b[i]);
      }
      s = wave_sum(s); float inv = 1.f / s;
#pragma unroll
      for (int i = 0; i < 4; ++i) {
        int t = lane + i * 64;
        G[(size_t)u * 512 + 256 + t] = f[i] * inv;
        if (t >= 1) G[(size_t)u * 512 + 256 - t] = b[i] * inv;
      }
      if (lane == 0) G[(size_t)u * 512] = 0.f;
    }
  }
}

DI void ph_ln(const float* __restrict__ src_lat, const float* __restrict__ src_ctx, float* dst_lat, float* dst_ctx,
              const float* __restrict__ ag, const float* __restrict__ ab, bf16_t* U, const float* __restrict__ mod, int sh_off, int nrows) {
  const int lane = my_tid() & 63, wid = my_tid() >> 6;
  for (int row = blockIdx.x * 8 + wid; row < nrows; row += gridDim.x * 8) {
    const float* src = row < ML ? src_lat + (size_t)row * D : src_ctx + (size_t)(row - ML) * D;
    float4 v[4];
#pragma unroll
    for (int i = 0; i < 4; ++i) v[i] = *(const float4*)(src + i * 256 + lane * 4);
    float s = 0.f;
#pragma unroll
    for (int i = 0; i < 4; ++i) s += v[i].x + v[i].y + v[i].z + v[i].w;
    float mu = wave_sum(s) * (1.f / 1024.f);
    float q = 0.f;
#pragma unroll
    for (int i = 0; i < 4; ++i) { v[i].x -= mu; v[i].y -= mu; v[i].z -= mu; v[i].w -= mu; q += v[i].x * v[i].x + v[i].y * v[i].y + v[i].z * v[i].z + v[i].w * v[i].w; }
    float rs = rsqrtf(wave_sum(q) * (1.f / 1024.f) + 1e-6f);
#pragma unroll
    for (int i = 0; i < 4; ++i) { v[i].x *= rs; v[i].y *= rs; v[i].z *= rs; v[i].w *= rs; }
    if (ag) {
      float* dst = row < ML ? dst_lat + (size_t)row * D : dst_ctx + (size_t)(row - ML) * D;
#pragma unroll
      for (int i = 0; i < 4; ++i) {
        float4 gg = *(const float4*)(ag + i * 256 + lane * 4), bb = *(const float4*)(ab + i * 256 + lane * 4);
        v[i].x = v[i].x * gg.x + bb.x; v[i].y = v[i].y * gg.y + bb.y; v[i].z = v[i].z * gg.z + bb.z; v[i].w = v[i].w * gg.w + bb.w;
        *(float4*)(dst + i * 256 + lane * 4) = v[i];
      }
      if (U) {
        s = 0.f;
#pragma unroll
        for (int i = 0; i < 4; ++i) s += v[i].x + v[i].y + v[i].z + v[i].w;
        mu = wave_sum(s) * (1.f / 1024.f); q = 0.f;
#pragma unroll
        for (int i = 0; i < 4; ++i) { v[i].x -= mu; v[i].y -= mu; v[i].z -= mu; v[i].w -= mu; q += v[i].x * v[i].x + v[i].y * v[i].y + v[i].z * v[i].z + v[i].w * v[i].w; }
        rs = rsqrtf(wave_sum(q) * (1.f / 1024.f) + 1e-6f);
#pragma unroll
        for (int i = 0; i < 4; ++i) { v[i].x *= rs; v[i].y *= rs; v[i].z *= rs; v[i].w *= rs; }
      }
    }
    if (U) {
      const float* m = mod + (size_t)mod_idx(row) * 6144 + sh_off;
#pragma unroll
      for (int i = 0; i < 4; ++i) {
        float4 sh = *(const float4*)(m + i * 256 + lane * 4), sc = *(const float4*)(m + 1024 + i * 256 + lane * 4);
        uint2 o; o.x = pack2(v[i].x * (1.f + sc.x) + sh.x, v[i].y * (1.f + sc.y) + sh.y);
        o.y = pack2(v[i].z * (1.f + sc.z) + sh.z, v[i].w * (1.f + sc.w) + sh.w);
        *(uint2*)(U + (size_t)row * D + i * 256 + lane * 4) = o;
      }
    }
  }
}

DI void ph_inproj(const Params& p, char* smem) {
  const bf16_t* U = (const bf16_t*)(p.ws + R_U);
  const bf16_t* Bt = (const bf16_t*)(p.ws + WB_IN);
  const int lane = my_tid() & 63, wid = my_tid() >> 6, wm = wid >> 1, wn = wid & 1, g = lane >> 4, r16 = lane & 15;
  for (int it = 0;; ++it) {
    int mtile, ntile;
    if (!next_tile(it, 136, 26, mtile, ntile)) break;
    f32x4 acc[4][4]; zero_acc<4>(acc);
    gemm_main<4>(acc, U, 1024, RowPlain{(long)mtile * 256}, Bt + (size_t)ntile * 128 * 1024, 1024, 1024, smem);
    int b, key0;
    if (mtile < 128) { b = mtile >> 4; key0 = (mtile & 15) * 256; } else { b = mtile - 128; key0 = SL; }
    bf16_t* tbase = nullptr; int tcols = 0, tcol0 = 0;
    if (ntile < 6) { tbase = (bf16_t*)(p.ws + R_PHY); tcols = 768; tcol0 = ntile * 128; }
    else if (ntile == 9) { tbase = (bf16_t*)(p.ws + R_VTSW); tcols = 128; tcol0 = 0; }
    else if (ntile == 14 || ntile == 15) { tbase = (bf16_t*)(p.ws + R_VTDF); tcols = 256; tcol0 = (ntile - 14) * 128; }
    if (tbase) {
#pragma unroll
      for (int mt = 0; mt < 4; ++mt)
#pragma unroll
        for (int nt = 0; nt < 4; ++nt) {
          int col = tcol0 + wn * 64 + nt * 16 + r16;
          int key = key0 + wm * 64 + mt * 16 + g * 4;
          uint2 o; o.x = pack2(acc[mt][nt][0], acc[mt][nt][1]); o.y = pack2(acc[mt][nt][2], acc[mt][nt][3]);
          *(uint2*)(tbase + ((size_t)b * tcols + col) * KEYS + key) = o;
        }
    } else {
      bf16_t* rb; int ld, c0, cmax;
      if (ntile < 9) { rb = (bf16_t*)(p.ws + R_PSW); ld = 384; c0 = (ntile - 6) * 128; cmax = 384; }
      else if (ntile < 14) { rb = (bf16_t*)(p.ws + R_PDF); ld = 512; c0 = (ntile - 10) * 128; cmax = 512; }
      else { rb = (bf16_t*)(p.ws + R_PRW); ld = 1216; c0 = (ntile - 16) * 128; cmax = 1216; }
#pragma unroll
      for (int mt = 0; mt < 4; ++mt)
#pragma unroll
        for (int nt = 0; nt < 4; ++nt) {
          int col = c0 + wn * 64 + nt * 16 + r16;
          if (col < cmax) {
#pragma unroll
            for (int j = 0; j < 4; ++j) {
              size_t row = (size_t)mtile * 256 + wm * 64 + mt * 16 + g * 4 + j;
              rb[row * ld + col] = (bf16_t)f2bf(acc[mt][nt][j]);
            }
          }
        }
    }
  }
}

DI float hy_conv3(const bf16_t* __restrict__ P, int t, int len, float w0, float w1, float w2, float bias) {
  float a = t >= 1 ? bf2f(P[t - 1]) : 0.f, b = bf2f(P[t]), c = (t + 1 < len) ? bf2f(P[t + 1]) : 0.f;
  return w0 * a + w1 * b + w2 * c + bias;
}
DI void ph_hyena(const Params& p, int l, char* smem) {
  float2* X = (float2*)smem; float2* W = X + 8192;
  const int tid = my_tid();
  const bf16_t* PT = (const bf16_t*)(p.ws + R_PHY);
  const float2* kf = (const float2*)(p.ws + OFF_KF);
  const float* cw = p.in[7] + (size_t)l * 3 * 768; const float* cb = p.in[8] + (size_t)l * 768;
  const float* hb = p.in[15] + (size_t)l * 512;
  bf16_t* Y = (bf16_t*)(p.ws + R_YHY);
  bool tw = false;
  for (int u = blockIdx.x; u < 1024; u += gridDim.x) {
    if (!tw) { load_twiddles(p, W); tw = true; }
    const int bp = u >> 8, c = u & 255; const int b0 = bp * 2, b1 = b0 + 1;
    const bf16_t* P0 = PT + ((size_t)b0 * 768) * KEYS; const bf16_t* P1 = PT + ((size_t)b1 * 768) * KEYS;
    float wv0 = cw[c], wv1 = cw[768 + c], wv2 = cw[1536 + c], bv = cb[c];
    float wa0 = cw[256 + c], wa1 = cw[768 + 256 + c], wa2 = cw[1536 + 256 + c], ba = cb[256 + c];
    float wb0 = cw[512 + c], wb1 = cw[768 + 512 + c], wb2 = cw[1536 + 512 + c], bb = cb[512 + c];
    const float bias0 = hb[c], bias1 = hb[256 + c];
    float2 vv[8];
    __syncthreads();
#pragma unroll
    for (int i = 0; i < 8; ++i) {
      int t = tid + i * 512;
      vv[i].x = hy_conv3(P0 + (size_t)c * KEYS, t, SL, wv0, wv1, wv2, bv);
      vv[i].y = hy_conv3(P1 + (size_t)c * KEYS, t, SL, wv0, wv1, wv2, bv);
      X[t] = vv[i]; X[t + 4096] = make_float2(0.f, 0.f);
    }
    fft_dif(X, W);
    {
      const float2* H = kf + (size_t)c * 8192;
#pragma unroll 4
      for (int i = 0; i < 16; ++i) { int q = tid + i * 512; X[q] = cmul(X[q], H[q]); }
    }
    fft_dit_inv(X, W);
    float2 zz[8];
#pragma unroll
    for (int i = 0; i < 8; ++i) {
      int t = tid + i * 512;
      float2 y = X[t];
      float x1a = hy_conv3(P0 + (size_t)(256 + c) * KEYS, t, SL, wa0, wa1, wa2, ba);
      float x1b = hy_conv3(P1 + (size_t)(256 + c) * KEYS, t, SL, wa0, wa1, wa2, ba);
      zz[i].x = x1a * (y.x * (1.f / 8192.f) + bias0 * vv[i].x);
      zz[i].y = x1b * (y.y * (1.f / 8192.f) + bias0 * vv[i].y);
    }
    __syncthreads();
#pragma unroll
    for (int i = 0; i < 8; ++i) { int t = tid + i * 512; X[t] = zz[i]; X[t + 4096] = make_float2(0.f, 0.f); }
    fft_dif(X, W);
    {
      const float2* H = kf + (size_t)(256 + c) * 8192;
#pragma unroll 4
      for (int i = 0; i < 16; ++i) { int q = tid + i * 512; X[q] = cmul(X[q], H[q]); }
    }
    fft_dit_inv(X, W);
#pragma unroll
    for (int i = 0; i < 8; ++i) {
      int t = tid + i * 512;
      float2 y = X[t];
      float x2a = hy_conv3(P0 + (size_t)(512 + c) * KEYS, t, SL, wb0, wb1, wb2, bb);
      float x2b = hy_conv3(P1 + (size_t)(512 + c) * KEYS, t, SL, wb0, wb1, wb2, bb);
      float oa = x2a * (y.x * (1.f / 8192.f) + bias1 * zz[i].x);
      float ob = x2b * (y.y * (1.f / 8192.f) + bias1 * zz[i].y);
      Y[((size_t)b0 * SL + t) * 256 + c] = (bf16_t)f2bf(oa);
      Y[((size_t)b1 * SL + t) * 256 + c] = (bf16_t)f2bf(ob);
    }
  }
}

DI void ph_hyena_ctx(const Params& p, int l, char* smem) {
  const int tid = my_tid(), lane = tid & 63, wid = tid >> 6;
  float* Zb = (float*)smem + wid * 1024;
  float* Gb = Zb + 256;
  const bf16_t* PT = (const bf16_t*)(p.ws + R_PHY);
  const float* G = (const float*)(p.ws + MISC_GCTX);
  const float* cw = p.in[7] + (size_t)l * 3 * 768; const float* cb = p.in[8] + (size_t)l * 768;
  const float* hb = p.in[15] + (size_t)l * 512;
  bf16_t* Y = (bf16_t*)(p.ws + R_YHY);
  for (int base = blockIdx.x * 8; base < 2048; base += gridDim.x * 8) {
    const int u = base + wid; const int b = u >> 8, c = u & 255;
    const bf16_t* Pb = PT + ((size_t)b * 768) * KEYS + SL;
    float v[4], x1[4], x2[4], zz[4];
#pragma unroll
    for (int i = 0; i < 4; ++i) {
      int t = lane + i * 64;
      v[i] = hy_conv3(Pb + (size_t)c * KEYS, t, CL, cw[c], cw[768 + c], cw[1536 + c], cb[c]);
      x1[i] = hy_conv3(Pb + (size_t)(256 + c) * KEYS, t, CL, cw[256 + c], cw[768 + 256 + c], cw[1536 + 256 + c], cb[256 + c]);
      x2[i] = hy_conv3(Pb + (size_t)(512 + c) * KEYS, t, CL, cw[512 + c], cw[768 + 512 + c], cw[1536 + 512 + c], cb[512 + c]);
    }
    __syncthreads();
#pragma unroll
    for (int i = 0; i < 4; ++i) Zb[lane + i * 64] = v[i];
    for (int i = lane; i < 512; i += 64) Gb[i] = G[(size_t)c * 512 + i];
    __syncthreads();
#pragma unroll
    for (int i = 0; i < 4; ++i) {
      int t = lane + i * 64; float s = 0.f;
      for (int s2 = 0; s2 < 256; ++s2) s += Gb[256 + t - s2] * Zb[s2];
      zz[i] = x1[i] * (s + hb[c] * v[i]);
    }
    __syncthreads();
#pragma unroll
    for (int i = 0; i < 4; ++i) Zb[lane + i * 64] = zz[i];
    for (int i = lane; i < 512; i += 64) Gb[i] = G[(size_t)(256 + c) * 512 + i];
    __syncthreads();
#pragma unroll
    for (int i = 0; i < 4; ++i) {
      int t = lane + i * 64; float s = 0.f;
      for (int s2 = 0; s2 < 256; ++s2) s += Gb[256 + t - s2] * Zb[s2];
      float o = x2[i] * (s + hb[256 + c] * zz[i]);
      Y[((size_t)ML + b * CL + t) * 256 + c] = (bf16_t)f2bf(o);
    }
  }
}

DI void ph_rope(const Params& p, char* smem) {
  float2* T16 = (float2*)smem;
  float2* T8 = T16 + 64 * 16;
  const int tid = my_tid(), lane = tid & 63, wid = tid >> 6;
  __syncthreads();
  for (int i = tid; i < 64 * 16; i += NTHR) {
    int pos = i >> 4, f = i & 15; float inv = powf(10000.f, -(float)f / 16.f); float s, c; sincosf((float)pos * inv, &s, &c);
    T16[i] = make_float2(c, s);
  }
  for (int i = tid; i < 64 * 8; i += NTHR) {
    int pos = i >> 3, f = i & 7; float inv = powf(10000.f, -(float)f / 8.f); float s, c; sincosf((float)pos * inv, &s, &c);
    T8[i] = make_float2(c, s);
  }
  __syncthreads();
  bf16_t* Psw = (bf16_t*)(p.ws + R_PSW); bf16_t* Pdf = (bf16_t*)(p.ws + R_PDF);
  for (int row = blockIdx.x * 8 + wid; row < ML; row += gridDim.x * 8) {
    const int t = row & (SL - 1); const int pr = t >> 6, pc = t & 63;
    bf16_t* q = Psw + (size_t)row * 384;
#pragma unroll
    for (int i = 0; i < 3; ++i) {
      int pi = lane + i * 64; int hd = pi >> 5, pp = pi & 31; int half = pp >> 4, f = pp & 15;
      int base = hd * 64 + half * 32; float2 cs = T16[(half ? pc : pr) * 16 + f];
      float x1 = bf2f(q[base + f]), x2 = bf2f(q[base + 16 + f]);
      q[base + f] = (bf16_t)f2bf(x1 * cs.x - x2 * cs.y); q[base + 16 + f] = (bf16_t)f2bf(x1 * cs.y + x2 * cs.x);
    }
    bf16_t* d = Pdf + (size_t)row * 512;
#pragma unroll
    for (int i = 0; i < 4; ++i) {
      int pi = lane + i * 64; int gi = pi >> 4, pp = pi & 15; int half = pp >> 3, f = pp & 7;
      int base = gi * 32 + half * 16; float2 cs = T8[(half ? pc : pr) * 8 + f];
      float x1 = bf2f(d[base + f]), x2 = bf2f(d[base + 8 + f]);
      d[base + f] = (bf16_t)f2bf(x1 * cs.x - x2 * cs.y); d[base + 8 + f] = (bf16_t)f2bf(x1 * cs.y + x2 * cs.x);
    }
  }
}

DI float rw_shift(const bf16_t* __restrict__ P, int row, int t, int len, int col, float mu) {
  float c = bf2f(P[(size_t)row * 1216 + col]);
  float a = t >= 1 ? bf2f(P[(size_t)(row - 1) * 1216 + col]) : 0.f;
  float b = t + 1 < len ? bf2f(P[(size_t)(row + 1) * 1216 + col]) : 0.f;
  return c + (0.5f * (a + b) - c) * mu;
}
DI void ph_rwprep(const Params& p, int l, char* smem) {
  float* ACT = (float*)smem;
  const int tid = my_tid(), lane = tid & 63;
  const bf16_t* P = (const bf16_t*)(p.ws + R_PRW);
  const float* mu = p.in[17] + (size_t)l * 1216;
  const float* w0 = p.in[18] + (size_t)l * 512; const float* w2 = p.in[19] + (size_t)l * 2 * 64 * 256;
  const float* a0 = p.in[20] + (size_t)l * 256; const float* a2 = p.in[21] + (size_t)l * 64 * 256;
  const float* g2 = p.in[22] + (size_t)l * 2 * 128 * 256;
  const float* kkw = p.in[23] + (size_t)l * 256; const float* kaw = p.in[24] + (size_t)l * 256;
  bf16_t* S = (bf16_t*)(p.ws + R_STR); bf16_t* Gs = (bf16_t*)(p.ws + R_G);
  const size_t SU = (size_t)MT * 256;
  for (int u = blockIdx.x; u < MT / 16; u += gridDim.x) {
    const int row0 = u * 16; int t0, len;
    if (row0 < ML) { t0 = row0 & (SL - 1); len = SL; } else { t0 = (row0 - ML) & (CL - 1); len = CL; }
    __syncthreads();
    for (int i = tid; i < 448 * 16; i += NTHR) {
      int col = i % 448, tk = i / 448;
      float v = rw_shift(P, row0 + tk, t0 + tk, len, 768 + col, mu[768 + col]);
      if (col < 128) v = tanhf(v); else if (col >= 192) v = sigmoidf_(v);
      ACT[col * 16 + tk] = v;
    }
    __syncthreads();
    const int c = tid & 255, th = tid >> 8;
    float df[8], db[8], aa[8], gf[8], gb[8];
#pragma unroll
    for (int i = 0; i < 8; ++i) { df[i] = 0.f; db[i] = 0.f; aa[i] = 0.f; gf[i] = 0.f; gb[i] = 0.f; }
    for (int k = 0; k < 64; ++k) {
      float wf = w2[k * 256 + c], wb = w2[64 * 256 + k * 256 + c], wa = a2[k * 256 + c];
      const float4* pf = (const float4*)(ACT + k * 16 + th * 8);
      const float4* pb = (const float4*)(ACT + (64 + k) * 16 + th * 8);
      const float4* pa = (const float4*)(ACT + (128 + k) * 16 + th * 8);
      float4 f0 = pf[0], f1 = pf[1], b0 = pb[0], b1 = pb[1], x0 = pa[0], x1 = pa[1];
      df[0] += f0.x * wf; df[1] += f0.y * wf; df[2] += f0.z * wf; df[3] += f0.w * wf; df[4] += f1.x * wf; df[5] += f1.y * wf; df[6] += f1.z * wf; df[7] += f1.w * wf;
      db[0] += b0.x * wb; db[1] += b0.y * wb; db[2] += b0.z * wb; db[3] += b0.w * wb; db[4] += b1.x * wb; db[5] += b1.y * wb; db[6] += b1.z * wb; db[7] += b1.w * wb;
      aa[0] += x0.x * wa; aa[1] += x0.y * wa; aa[2] += x0.z * wa; aa[3] += x0.w * wa; aa[4] += x1.x * wa; aa[5] += x1.y * wa; aa[6] += x1.z * wa; aa[7] += x1.w * wa;
    }
    for (int k = 0; k < 128; ++k) {
      float wf = g2[k * 256 + c], wb = g2[128 * 256 + k * 256 + c];
      const float4* pf = (const float4*)(ACT + (192 + k) * 16 + th * 8);
      const float4* pb = (const float4*)(ACT + (320 + k) * 16 + th * 8);
      float4 f0 = pf[0], f1 = pf[1], b0 = pb[0], b1 = pb[1];
      gf[0] += f0.x * wf; gf[1] += f0.y * wf; gf[2] += f0.z * wf; gf[3] += f0.w * wf; gf[4] += f1.x * wf; gf[5] += f1.y * wf; gf[6] += f1.z * wf; gf[7] += f1.w * wf;
      gb[0] += b0.x * wb; gb[1] += b0.y * wb; gb[2] += b0.z * wb; gb[3] += b0.w * wb; gb[4] += b1.x * wb; gb[5] += b1.y * wb; gb[6] += b1.z * wb; gb[7] += b1.w * wb;
    }
    const float w0f = w0[c], w0b = w0[256 + c], a0c = a0[c], kkc = kkw[c], kac = kaw[c];
    const float mur = mu[c], muk = mu[256 + c], muv = mu[512 + c];
#pragma unroll
    for (int i = 0; i < 8; ++i) {
      const int tk = th * 8 + i; const int row = row0 + tk, t = t0 + tk;
      float r = rw_shift(P, row, t, len, c, mur), k = rw_shift(P, row, t, len, 256 + c, muk), v = rw_shift(P, row, t, len, 512 + c, muv);
      float a = sigmoidf_(a0c + aa[i]);
      float kk = k * kkc; float n2 = wave_sum(kk * kk); kk = kk / fmaxf(sqrtf(n2), 1e-12f);
      float kp = k * (1.f + (a - 1.f) * kac);
      float bq = kk * a;
      float xf = -(w0f + df[i]); float spf = fmaxf(xf, 0.f) + log1pf(__expf(-fabsf(xf)));
      float xb = -(w0b + db[i]); float spb = fmaxf(xb, 0.f) + log1pf(__expf(-fabsf(xb)));
      float ef = __expf(-spf - 0.5f), eb = __expf(-spb - 0.5f);
      float d_f = -expm1f(-ef), d_b = -expm1f(-eb);
      size_t o = (size_t)row * 256 + c;
      S[o] = (bf16_t)f2bf(r); S[SU + o] = (bf16_t)f2bf(kp); S[2 * SU + o] = (bf16_t)f2bf(v); S[3 * SU + o] = (bf16_t)f2bf(kk);
      S[4 * SU + o] = (bf16_t)f2bf(bq); S[5 * SU + o] = (bf16_t)f2bf(d_f); S[6 * SU + o] = (bf16_t)f2bf(d_b);
      Gs[o] = (bf16_t)f2bf(gf[i]); Gs[SU + o] = (bf16_t)f2bf(gb[i]);
    }
  }
}

DI long scan_row(int b, int dir, int s) {
  if (s < CL) return (long)ML + b * CL + (dir ? (CL - 1 - s) : s);
  int t = s - CL; return (long)b * SL + (dir ? (SL - 1 - t) : t);
}
DI void ph_scan(const Params& p, char* smem) {
  const int tid = my_tid(), lane = tid & 63, wid = tid >> 6;
  const bf16_t* S = (const bf16_t*)(p.ws + R_STR);
  const size_t SU = (size_t)MT * 256;
  constexpr int T = 32, NSTEP = CL + SL, NCH = NSTEP / T;
  for (int u = blockIdx.x; u < 256; u += gridDim.x) {
    const int chain = u >> 2, rg = u & 3; const int dir = chain & 1, bh = chain >> 1, b = bh >> 2, h = bh & 3;
    bf16_t* O = (bf16_t*)(p.ws + (dir ? R_OB : R_OF));
    uint4 q0, q1, q2;
    auto SC_GLOAD = [&](int ci) {
#pragma unroll
      for (int j = 0; j < 3; ++j) {
        int idx = tid + j * 512; int st = idx >> 8, s = (idx & 255) >> 3, ck = idx & 7;
        long row = scan_row(b, dir, ci * T + s);
        int sid = st < 5 ? st : 5 + dir;
        uint4 v = *(const uint4*)(S + sid * SU + row * 256 + h * 64 + ck * 8);
        if (j == 0) q0 = v; else if (j == 1) q1 = v; else q2 = v;
      }
    };
    auto SC_SSTORE = [&](int buf) {
#pragma unroll
      for (int j = 0; j < 3; ++j) {
        int idx = tid + j * 512; int st = idx >> 8;
        uint4 v = j == 0 ? q0 : (j == 1 ? q1 : q2);
        float4 lo = make_float4(bflo(v.x), bfhi(v.x), bflo(v.y), bfhi(v.y));
        float4 hi = make_float4(bflo(v.z), bfhi(v.z), bflo(v.w), bfhi(v.w));
        if (st == 5) { lo.x = 1.f - lo.x; lo.y = 1.f - lo.y; lo.z = 1.f - lo.z; lo.w = 1.f - lo.w; hi.x = 1.f - hi.x; hi.y = 1.f - hi.y; hi.z = 1.f - hi.z; hi.w = 1.f - hi.w; }
        char* base = smem + buf * 49152 + idx * 32;
        *(float4*)(base) = lo; *(float4*)(base + 16) = hi;
      }
    };
    auto FLUSH = [&](int ci) {
      int j = tid - 256; int s = j >> 3, part = j & 7;
      unsigned v = *(const unsigned*)(smem + 98304 + (ci & 1) * 1024 + s * 32 + part * 4);
      long row = scan_row(b, dir, ci * T + s);
      *(unsigned*)(O + row * 256 + h * 64 + rg * 16 + part * 2) = v;
    };
    __syncthreads();
    SC_GLOAD(0);
    SC_SSTORE(0);
    __syncthreads();
    float s0 = 0.f, s1 = 0.f, s2 = 0.f, s3 = 0.f;
    const int rsub = lane >> 4, ks = lane & 15;
    const int lrow = (wid & 3) * 4 + rsub;
    const int vrow = rg * 16 + lrow;
    for (int ci = 0; ci < NCH; ++ci) {
      if (ci + 1 < NCH) { SC_GLOAD(ci + 1); }
      if (wid < 4) {
        const char* B = smem + (ci & 1) * 49152;
        bf16_t* ob = (bf16_t*)(smem + 98304 + (ci & 1) * 1024);
        float4 nr = *(const float4*)(B + (0 * T + 0) * 256 + ks * 16);
        float4 nk = *(const float4*)(B + (1 * T + 0) * 256 + ks * 16);
        float nv = *(const float*)(B + (2 * T + 0) * 256 + vrow * 4);
        float4 nkk = *(const float4*)(B + (3 * T + 0) * 256 + ks * 16);
        float4 nb = *(const float4*)(B + (4 * T + 0) * 256 + ks * 16);
        float4 nw = *(const float4*)(B + (5 * T + 0) * 256 + ks * 16);
#pragma unroll 2
        for (int s = 0; s < T; ++s) {
          const float4 cr = nr, ck = nk, ckk = nkk, cb = nb, cw = nw; const float cv = nv;
          const int sn = (s + 1 < T) ? s + 1 : s;
          nr = *(const float4*)(B + (0 * T + sn) * 256 + ks * 16);
          nk = *(const float4*)(B + (1 * T + sn) * 256 + ks * 16);
          nv = *(const float*)(B + (2 * T + sn) * 256 + vrow * 4);
          nkk = *(const float4*)(B + (3 * T + sn) * 256 + ks * 16);
          nb = *(const float4*)(B + (4 * T + sn) * 256 + ks * 16);
          nw = *(const float4*)(B + (5 * T + sn) * 256 + ks * 16);
          float sa = -((s0 * ckk.x + s1 * ckk.y) + (s2 * ckk.z + s3 * ckk.w));
          sa = sum16(sa);
          s0 = s0 * cw.x + sa * cb.x + cv * ck.x;
          s1 = s1 * cw.y + sa * cb.y + cv * ck.y;
          s2 = s2 * cw.z + sa * cb.z + cv * ck.z;
          s3 = s3 * cw.w + sa * cb.w + cv * ck.w;
          float o = (s0 * cr.x + s1 * cr.y) + (s2 * cr.z + s3 * cr.w);
          o = sum16(o);
          if (ks == 0) ob[s * 16 + lrow] = (bf16_t)f2bf(o);
        }
      } else if (ci > 0) {
        FLUSH(ci - 1);
      }
      if (ci + 1 < NCH) { SC_SSTORE((ci + 1) & 1); }
      __syncthreads();
    }
    if (wid >= 4) FLUSH(NCH - 1);
  }
}

template <bool DIFF>
DI void attn_unit(const Params& p, int l, int b, int h, int qrow0, int qpos0, int kb_lo, int kb_hi, int kc_lo, char* smem) {
  const int tid = my_tid(), lane = tid & 63, wid = tid >> 6, g = lane >> 4, r16 = lane & 15;
  const bf16_t* QK = (const bf16_t*)(p.ws + (DIFF ? R_PDF : R_PSW));
  const int ldq = DIFF ? 512 : 384;
  const int qc0 = h * 64;
  const int kc0 = 256 + (DIFF ? h * 64 : (h >> 1) * 64);
  const bf16_t* VT = DIFF ? (const bf16_t*)(p.ws + R_VTDF) + ((size_t)b * 256 + h * 64) * KEYS
                          : (const bf16_t*)(p.ws + R_VTSW) + ((size_t)b * 128 + (h >> 1) * 64) * KEYS;
  const int nblk = (kb_hi - kb_lo) + (68 - kc_lo);
  const float sc = (DIFF ? 0.17677669529663687f : 0.125f) * 1.4426950408889634f;
  bf16x8 qf[2];
  {
    const bf16_t* qp = QK + (size_t)(qrow0 + wid * 16 + r16) * ldq + qc0 + g * 8;
    qf[0] = *(const bf16x8*)(qp); qf[1] = *(const bf16x8*)(qp + 32);
  }
  constexpr int NC = DIFF ? 2 : 1;
  float m[NC], lsum[NC];
  f32x4 O[NC][4];
#pragma unroll
  for (int c = 0; c < NC; ++c) {
    if (DIFF) { m[c] = -1e30f; lsum[c] = 0.f; }
    else { m[c] = p.in[16][l * 4 + h] * 1.4426950408889634f; lsum[c] = (g == 0) ? 1.f : 0.f; }
#pragma unroll
    for (int dt = 0; dt < 4; ++dt) O[c][dt] = (f32x4){0.f, 0.f, 0.f, 0.f};
  }
  const int lr = tid >> 3, lc = tid & 7;
  uint4 rk, rv;
#define AT_GLOAD(i)                                                                                   \
  do {                                                                                                \
    int kb = (i) < (kb_hi - kb_lo) ? kb_lo + (i) : kc_lo + ((i) - (kb_hi - kb_lo));                    \
    long krow = kb < 64 ? (long)b * SL + kb * 64 + lr : (long)ML + b * CL + (kb - 64) * 64 + lr;       \
    rk = *(const uint4*)(QK + krow * ldq + kc0 + lc * 8);                                             \
    rv = *(const uint4*)(VT + (size_t)lr * KEYS + kb * 64 + lc * 8);                                  \
  } while (0)
#define AT_SSTORE(buf)                                                                                \
  do {                                                                                                \
    *(uint4*)(smem + (buf) * 18432 + lr * 144 + lc * 16) = rk;                                        \
    *(uint4*)(smem + (buf) * 18432 + 9216 + lr * 144 + lc * 16) = rv;                                 \
  } while (0)
  __syncthreads();
  AT_GLOAD(0);
  AT_SSTORE(0);
  __syncthreads();
  const int qpos = qpos0 + wid * 16 + r16;
  for (int i = 0; i < nblk; ++i) {
    if (i + 1 < nblk) AT_GLOAD(i + 1);
    const int kb = i < (kb_hi - kb_lo) ? kb_lo + i : kc_lo + (i - (kb_hi - kb_lo));
    const bool masked = (!DIFF) && (kb < 64);
    const char* Kt = smem + (i & 1) * 18432; const char* Vt = Kt + 9216;
    f32x4 S[NC][4];
#pragma unroll
    for (int kt = 0; kt < 4; ++kt) {
      bf16x8 k0 = *(const bf16x8*)(Kt + (kt * 16 + r16) * 144 + g * 16);
      bf16x8 k1 = *(const bf16x8*)(Kt + (kt * 16 + r16) * 144 + 64 + g * 16);
      if (DIFF) {
        S[0][kt] = __builtin_amdgcn_mfma_f32_16x16x32_bf16(k0, qf[0], (f32x4){0.f, 0.f, 0.f, 0.f}, 0, 0, 0);
        S[NC - 1][kt] = __builtin_amdgcn_mfma_f32_16x16x32_bf16(k1, qf[1], (f32x4){0.f, 0.f, 0.f, 0.f}, 0, 0, 0);
      } else {
        f32x4 t = __builtin_amdgcn_mfma_f32_16x16x32_bf16(k0, qf[0], (f32x4){0.f, 0.f, 0.f, 0.f}, 0, 0, 0);
        S[0][kt] = __builtin_amdgcn_mfma_f32_16x16x32_bf16(k1, qf[1], t, 0, 0, 0);
      }
    }
    bf16x8 pf[NC][2];
#pragma unroll
    for (int c = 0; c < NC; ++c) {
      float mx = -1e30f;
#pragma unroll
      for (int kt = 0; kt < 4; ++kt)
#pragma unroll
        for (int j = 0; j < 4; ++j) {
          float v = S[c][kt][j] * sc;
          if (masked) { int kpos = kb * 64 + kt * 16 + g * 4 + j; int dd = kpos - qpos; if (dd > 128 || dd < -128) v = -1e30f; }
          S[c][kt][j] = v; mx = fmaxf(mx, v);
        }
      mx = fmaxf(mx, __shfl_xor(mx, 16)); mx = fmaxf(mx, __shfl_xor(mx, 32));
      float mn = fmaxf(m[c], mx);
      float alpha = __builtin_amdgcn_exp2f(m[c] - mn);
      m[c] = mn;
      float ps = 0.f;
      unsigned pk[8];
#pragma unroll
      for (int kt = 0; kt < 4; ++kt) {
        float e0 = __builtin_amdgcn_exp2f(S[c][kt][0] - mn), e1 = __builtin_amdgcn_exp2f(S[c][kt][1] - mn), e2 = __builtin_amdgcn_exp2f(S[c][kt][2] - mn), e3 = __builtin_amdgcn_exp2f(S[c][kt][3] - mn);
        ps += (e0 + e1) + (e2 + e3);
        pk[kt * 2] = pack2(e0, e1); pk[kt * 2 + 1] = pack2(e2, e3);
      }
      lsum[c] = lsum[c] * alpha + ps;
#pragma unroll
      for (int dt = 0; dt < 4; ++dt) { O[c][dt][0] *= alpha; O[c][dt][1] *= alpha; O[c][dt][2] *= alpha; O[c][dt][3] *= alpha; }
      union { unsigned u[4]; bf16x8 v; } cv;
      cv.u[0] = pk[0]; cv.u[1] = pk[1]; cv.u[2] = pk[2]; cv.u[3] = pk[3]; pf[c][0] = cv.v;
      cv.u[0] = pk[4]; cv.u[1] = pk[5]; cv.u[2] = pk[6]; cv.u[3] = pk[7]; pf[c][1] = cv.v;
    }
#pragma unroll
    for (int dt = 0; dt < 4; ++dt)
#pragma unroll
      for (int s2 = 0; s2 < 2; ++s2) {
        union { uint2 u[2]; bf16x8 v; } vf;
        vf.u[0] = *(const uint2*)(Vt + (dt * 16 + r16) * 144 + (2 * s2) * 32 + g * 8);
        vf.u[1] = *(const uint2*)(Vt + (dt * 16 + r16) * 144 + (2 * s2 + 1) * 32 + g * 8);
#pragma unroll
        for (int c = 0; c < NC; ++c) O[c][dt] = __builtin_amdgcn_mfma_f32_16x16x32_bf16(vf.v, pf[c][s2], O[c][dt], 0, 0, 0);
      }
    if (i + 1 < nblk) AT_SSTORE((i + 1) & 1);
    __syncthreads();
  }
#undef AT_GLOAD
#undef AT_SSTORE
  float linv[NC];
#pragma unroll
  for (int c = 0; c < NC; ++c) { float t = lsum[c]; t += __shfl_xor(t, 16); t += __shfl_xor(t, 32); linv[c] = 1.f / t; }
  const size_t orow = (size_t)(qrow0 + wid * 16 + r16);
  if (!DIFF) {
    bf16_t* Y = (bf16_t*)(p.ws + R_YSW);
#pragma unroll
    for (int dt = 0; dt < 4; ++dt) {
      uint2 o; o.x = pack2(O[0][dt][0] * linv[0], O[0][dt][1] * linv[0]); o.y = pack2(O[0][dt][2] * linv[0], O[0][dt][3] * linv[0]);
      *(uint2*)(Y + orow * 256 + h * 64 + dt * 16 + g * 4) = o;
    }
  } else {
    const float lam_init = 0.8f - 0.6f * __expf(-0.3f * (float)l);
    float d1 = 0.f, d2 = 0.f;
    if (lane < 32) { d1 = p.in[28][l * 32 + lane] * p.in[29][l * 32 + lane]; d2 = p.in[30][l * 32 + lane] * p.in[31][l * 32 + lane]; }
    d1 = wave_sum(d1); d2 = wave_sum(d2);
    const float lam = expf(d1) - expf(d2) + lam_init;
    float ov[4][4]; float ss = 0.f;
#pragma unroll
    for (int dt = 0; dt < 4; ++dt)
#pragma unroll
      for (int j = 0; j < 4; ++j) { float v = O[0][dt][j] * linv[0] - lam * O[NC - 1][dt][j] * linv[NC - 1]; ov[dt][j] = v; ss += v * v; }
    ss += __shfl_xor(ss, 16); ss += __shfl_xor(ss, 32);
    const float rms = rsqrtf(ss * (1.f / 64.f) + 1e-5f) * (1.f - lam_init);
    const float* sg = p.in[32] + l * 64;
    bf16_t* Y = (bf16_t*)(p.ws + R_YDF);
#pragma unroll
    for (int dt = 0; dt < 4; ++dt) {
      const int d0 = dt * 16 + g * 4;
      uint2 o; o.x = pack2(ov[dt][0] * rms * sg[d0], ov[dt][1] * rms * sg[d0 + 1]); o.y = pack2(ov[dt][2] * rms * sg[d0 + 2], ov[dt][3] * rms * sg[d0 + 3]);
      *(uint2*)(Y + orow * 256 + h * 64 + d0) = o;
    }
  }
}

DI void ph_attn(const Params& p, int l, char* smem) {
  const bool need_ctx = (l == 0);
  const int n_sw = 1024 + (need_ctx ? 64 : 0);
  const int n_df = 1024 + (need_ctx ? 64 : 0);
  for (int u = blockIdx.x; u < n_sw + n_df; u += gridDim.x) {
    if (u < n_df) {
      if (u < 1024) { int b = u >> 7, h = (u >> 5) & 3, n = u & 31; attn_unit<true>(p, l, b, h, b * SL + n * 128, n * 128, 0, 64, 64, smem); }
      else { int v = u - 1024; int b = v >> 3, h = (v >> 1) & 3, n = v & 1; attn_unit<true>(p, l, b, h, ML + b * CL + n * 128, 0, 0, 0, 64, smem); }
    } else {
      int w = u - n_df;
      if (w < 1024) {
        int b = w >> 7, h = (w >> 5) & 3, n = w & 31;
        int lo = (n - 1) * 2; if (lo < 0) lo = 0; int hi = (n + 2) * 2; if (hi > 64) hi = 64;
        attn_unit<false>(p, l, b, h, b * SL + n * 128, n * 128, lo, hi, 64, smem);
      } else { int v = w - 1024; int b = v >> 3, h = (v >> 1) & 3, n = v & 1; attn_unit<false>(p, l, b, h, ML + b * CL + n * 128, 0, 0, 0, 64, smem); }
    }
  }
}

DI void ph_rwout(const Params& p, int l) {
  const int lane = my_tid() & 63, wid = my_tid() >> 6;
  const bf16_t* S = (const bf16_t*)(p.ws + R_STR); const bf16_t* Gs = (const bf16_t*)(p.ws + R_G);
  const bf16_t* OF = (const bf16_t*)(p.ws + R_OF); const bf16_t* OB = (const bf16_t*)(p.ws + R_OB);
  bf16_t* Y = (bf16_t*)(p.ws + R_YRW);
  const size_t SU = (size_t)MT * 256;
  const float4 rk = *(const float4*)(p.in[25] + (size_t)l * 256 + lane * 4);
  const float4 gam = *(const float4*)(p.in[26] + (size_t)l * 256 + lane * 4);
  const float4 bet = *(const float4*)(p.in[27] + (size_t)l * 256 + lane * 4);
  const int nrows = (l == 0) ? MT : ML;
  for (int row = blockIdx.x * 8 + wid; row < nrows; row += gridDim.x * 8) {
    const size_t o = (size_t)row * 256 + lane * 4;
    uint2 ur = *(const uint2*)(S + o), uk = *(const uint2*)(S + SU + o), uv = *(const uint2*)(S + 2 * SU + o);
    uint2 uf = *(const uint2*)(OF + o), ub = *(const uint2*)(OB + o), ugf = *(const uint2*)(Gs + o), ugb = *(const uint2*)(Gs + SU + o);
    float r[4] = {bflo(ur.x), bfhi(ur.x), bflo(ur.y), bfhi(ur.y)};
    float k[4] = {bflo(uk.x), bfhi(uk.x), bflo(uk.y), bfhi(uk.y)};
    float v[4] = {bflo(uv.x), bfhi(uv.x), bflo(uv.y), bfhi(uv.y)};
    float f[4] = {bflo(uf.x), bfhi(uf.x), bflo(uf.y), bfhi(uf.y)};
    float bb[4] = {bflo(ub.x), bfhi(ub.x), bflo(ub.y), bfhi(ub.y)};
    float gf[4] = {bflo(ugf.x), bfhi(ugf.x), bflo(ugf.y), bfhi(ugf.y)};
    float gb[4] = {bflo(ugb.x), bfhi(ugb.x), bflo(ugb.y), bfhi(ugb.y)};
    const float rkv[4] = {rk.x, rk.y, rk.z, rk.w}; const float ga[4] = {gam.x, gam.y, gam.z, gam.w}; const float be[4] = {bet.x, bet.y, bet.z, bet.w};
    float bon = 0.f, sf = 0.f, sb = 0.f;
#pragma unroll
    for (int i = 0; i < 4; ++i) { bon += r[i] * k[i] * rkv[i]; sf += f[i]; sb += bb[i]; }
    bon = sum16(bon); float muf = sum16(sf) * (1.f / 64.f), mub = sum16(sb) * (1.f / 64.f);
    float qf = 0.f, qb = 0.f;
#pragma unroll
    for (int i = 0; i < 4; ++i) { f[i] -= muf; bb[i] -= mub; qf += f[i] * f[i]; qb += bb[i] * bb[i]; }
    float rsf = rsqrtf(sum16(qf) * (1.f / 64.f) + 64e-5f), rsb = rsqrtf(sum16(qb) * (1.f / 64.f) + 64e-5f);
    float y[4];
#pragma unroll
    for (int i = 0; i < 4; ++i) {
      float bn = bon * v[i];
      y[i] = (f[i] * rsf * ga[i] + be[i] + bn) * gf[i] + (bb[i] * rsb * ga[i] + be[i] + bn) * gb[i];
    }
    uint2 oo; oo.x = pack2(y[0], y[1]); oo.y = pack2(y[2], y[3]);
    *(uint2*)(Y + o) = oo;
  }
}

DI void ph_merge(const Params& p, int l, char* smem) {
  const bf16_t* U = (const bf16_t*)(p.ws + R_URE);
  const int lane = my_tid() & 63, wid = my_tid() >> 6, wm = wid >> 1, wn = wid & 1, g = lane >> 4, r16 = lane & 15;
  const int mtiles = (l == 0) ? 136 : 128;
  bf16_t* ACC = (bf16_t*)(p.ws + R_ACC);
  for (int it = 0;; ++it) {
    int mtile, ntile;
    if (!next_tile(it, mtiles, 8, mtile, ntile)) break;
    uint2 accS[4][4];
#pragma unroll
    for (int mt = 0; mt < 4; ++mt)
#pragma unroll
      for (int nt = 0; nt < 4; ++nt) accS[mt][nt] = make_uint2(0u, 0u);
    for (int j = 0; j < 4; ++j) {
      uint2 pb[4][4];
      {
        f32x4 accB[4][4]; zero_acc<4>(accB);
        const size_t yoff = (j == 0) ? R_YHY : (j == 1) ? R_YSW : (j == 2) ? R_YRW : R_YDF;
        gemm_main<4>(accB, (const bf16_t*)(p.ws + yoff), 256, RowPlain{(long)mtile * 256}, (const bf16_t*)(p.ws + WB_BR) + ((size_t)j * 1024 + ntile * 128) * 256, 256, 256, smem);
#pragma unroll
        for (int mt = 0; mt < 4; ++mt)
#pragma unroll
          for (int nt = 0; nt < 4; ++nt) { pb[mt][nt].x = pack2(accB[mt][nt][0], accB[mt][nt][1]); pb[mt][nt].y = pack2(accB[mt][nt][2], accB[mt][nt][3]); }
      }
      f32x4 accG[4][4]; zero_acc<4>(accG);
      gemm_main<4>(accG, U, 1024, RowPlain{(long)mtile * 256}, (const bf16_t*)(p.ws + WB_GATE) + ((size_t)j * 1024 + ntile * 128) * 1024, 1024, 1024, smem);
#pragma unroll
      for (int mt = 0; mt < 4; ++mt)
#pragma unroll
        for (int nt = 0; nt < 4; ++nt) {
          float v0 = bflo(accS[mt][nt].x) + sigmoidf_(accG[mt][nt][0]) * bflo(pb[mt][nt].x);
          float v1 = bfhi(accS[mt][nt].x) + sigmoidf_(accG[mt][nt][1]) * bfhi(pb[mt][nt].x);
          float v2 = bflo(accS[mt][nt].y) + sigmoidf_(accG[mt][nt][2]) * bflo(pb[mt][nt].y);
          float v3 = bfhi(accS[mt][nt].y) + sigmoidf_(accG[mt][nt][3]) * bfhi(pb[mt][nt].y);
          accS[mt][nt].x = pack2(v0, v1); accS[mt][nt].y = pack2(v2, v3);
        }
    }
#pragma unroll
    for (int mt = 0; mt < 4; ++mt)
#pragma unroll
      for (int nt = 0; nt < 4; ++nt) {
        const int col = ntile * 128 + wn * 64 + nt * 16 + r16;
        const size_t row = (size_t)mtile * 256 + wm * 64 + mt * 16 + g * 4;
        ACC[(row + 0) * 1024 + col] = (bf16_t)(accS[mt][nt].x & 0xffffu);
        ACC[(row + 1) * 1024 + col] = (bf16_t)(accS[mt][nt].x >> 16);
        ACC[(row + 2) * 1024 + col] = (bf16_t)(accS[mt][nt].y & 0xffffu);
        ACC[(row + 3) * 1024 + col] = (bf16_t)(accS[mt][nt].y >> 16);
      }
  }
}

DI void ph_resgemm(const Params& p, int l, const bf16_t* A, int K, const bf16_t* Bt, const float* hsrc_lat, const float* hsrc_ctx, int gate_off, char* smem) {
  const int lane = my_tid() & 63, wid = my_tid() >> 6, wm = wid >> 1, wn = wid & 1, g = lane >> 4, r16 = lane & 15;
  const int mtiles = (l == 0) ? 136 : 128;
  const float* mod = (const float*)(p.ws + MISC_MOD) + (size_t)l * 9 * 6144;
  float* hc = (float*)(p.ws + OFF_HC);
  for (int it = 0;; ++it) {
    int mtile, ntile;
    if (!next_tile(it, mtiles, 8, mtile, ntile)) break;
    f32x4 acc[4][4]; zero_acc<4>(acc);
    gemm_main<4>(acc, A, K, RowPlain{(long)mtile * 256}, Bt + (size_t)ntile * 128 * K, K, K, smem);
    const int b = mtile < 128 ? (mtile >> 4) : 8;
    const float* gt = mod + (size_t)b * 6144 + gate_off;
#pragma unroll
    for (int mt = 0; mt < 4; ++mt)
#pragma unroll
      for (int nt = 0; nt < 4; ++nt) {
        const int col = ntile * 128 + wn * 64 + nt * 16 + r16; const float gv = gt[col];
#pragma unroll
        for (int e = 0; e < 4; ++e) {
          const int row = mtile * 256 + wm * 64 + mt * 16 + g * 4 + e;
          if (row < ML) { size_t o = (size_t)row * D + col; p.out[o] = DN_ALPHA * hsrc_lat[o] + gv * acc[mt][nt][e]; }
          else { size_t o = (size_t)(row - ML) * D + col; hc[o] = DN_ALPHA * hsrc_ctx[o] + gv * acc[mt][nt][e]; }
        }
      }
  }
}

DI void ph_ffnup(const Params& p, int l, char* smem) {
  const bf16_t* U = (const bf16_t*)(p.ws + R_U);
  const bf16_t* Bt = (const bf16_t*)(p.ws + WB_UP);
  bf16_t* HID = (bf16_t*)(p.ws + R_HID);
  const float* cw = p.in[38] + (size_t)l * 3 * 5632; const float* cb = p.in[39] + (size_t)l * 5632;
  const int tid = my_tid(), lane = tid & 63, wid = tid >> 6, wm = wid >> 1, wn = wid & 1, g = lane >> 4, r16 = lane & 15;
  const int mtiles = (l == 0) ? 152 : 136;
  float* T = (float*)smem;
  for (int it = 0;; ++it) {
    int mtile, ntile;
    if (!next_tile(it, mtiles, 44, mtile, ntile)) break;
    long rowbase; int tt, len;
    if (mtile < 136) { int b = mtile / 17; tt = mtile % 17; len = SL; rowbase = (long)b * SL; }
    else { int v = mtile - 136; int b = v >> 1; tt = v & 1; len = CL; rowbase = (long)ML + b * CL; }
    f32x4 acc[4][4]; zero_acc<4>(acc);
    gemm_main<4>(acc, U, 1024, RowHalo{rowbase, tt * 254 - 1, len}, Bt + (size_t)ntile * 128 * 1024, 1024, 1024, smem);
#pragma unroll
    for (int mt = 0; mt < 4; ++mt)
#pragma unroll
      for (int nt = 0; nt < 4; ++nt)
#pragma unroll
        for (int e = 0; e < 4; ++e) T[(wm * 64 + mt * 16 + g * 4 + e) * 132 + wn * 64 + nt * 16 + r16] = acc[mt][nt][e];
    __syncthreads();
    {
      const int ch = tid & 63, rgp = tid >> 6; const int ca = ntile * 64 + ch, cbx = 2816 + ca;
      const float a0 = cw[ca], a1 = cw[5632 + ca], a2 = cw[2 * 5632 + ca], ab = cb[ca];
      const float b0 = cw[cbx], b1 = cw[5632 + cbx], b2 = cw[2 * 5632 + cbx], bb = cb[cbx];
      for (int r = 1 + rgp; r <= 254; r += 8) {
        int tok = tt * 254 - 1 + r;
        if (tok < len) {
          float av = a0 * T[(r - 1) * 132 + ch] + a1 * T[r * 132 + ch] + a2 * T[(r + 1) * 132 + ch] + ab;
          float bv = b0 * T[(r - 1) * 132 + 64 + ch] + b1 * T[r * 132 + 64 + ch] + b2 * T[(r + 1) * 132 + 64 + ch] + bb;
          HID[(size_t)(rowbase + tok) * 2816 + ca] = (bf16_t)f2bf(siluf_(av) * bv);
        }
      }
    }
  }
}

#ifndef REP_PREP
#define REP_PREP 1
#endif
#ifndef REP_GEMM
#define REP_GEMM 1
#endif
#ifndef REP_HY
#define REP_HY 1
#endif
#ifndef REP_RWP
#define REP_RWP 1
#endif
#ifndef REP_SCAN
#define REP_SCAN 1
#endif
#ifndef REP_ATTN
#define REP_ATTN 1
#endif
#ifndef PH_END
#define PH_END 24
#endif
#define SYNC_OR_RET(idx) do { if ((idx) + 1 >= PH_END) return; grid.sync(); } while (0)
template <int l>
DI void run_layer(const Params& p, cg::grid_group& grid, char* smem) {
  const float* mod = (const float*)(p.ws + MISC_MOD) + (size_t)l * 9 * 6144;
  float* hc = (float*)(p.ws + OFF_HC);
  const float* hl_src = (l == 0) ? p.in[0] : p.out;
  const float* hc_src = (l == 0) ? p.in[2] : hc;
  constexpr int B0 = l * 12;
  for (int rep = 0; rep < REP_PREP; ++rep) {
  ph_convert(p, l, smem);
  if (l == 0) ph_ada(p, smem);
  hy_rawfilter(p, l, SL, (float*)(p.ws + R_RAWF), smem);
  if (l == 0) hy_rawfilter(p, l, CL, (float*)(p.ws + MISC_RAWC), smem);
  }
  SYNC_OR_RET(B0 + 0);
  for (int rep = 0; rep < REP_PREP; ++rep) ph_kf(p, l, smem);
  ph_ln(hl_src, hc_src, nullptr, nullptr, nullptr, nullptr, (bf16_t*)(p.ws + R_U), mod, 0, MT);
  SYNC_OR_RET(B0 + 1);
  for (int rep = 0; rep < REP_GEMM; ++rep) ph_inproj(p, smem);
  SYNC_OR_RET(B0 + 2);
  for (int rep = 0; rep < REP_HY; ++rep) {
  ph_hyena(p, l, smem);
  if (l == 0) ph_hyena_ctx(p, l, smem);
  }
  ph_rope(p, smem);
  for (int rep = 0; rep < REP_RWP; ++rep) ph_rwprep(p, l, smem);
  SYNC_OR_RET(B0 + 3);
  for (int rep = 0; rep < REP_SCAN; ++rep) ph_scan(p, smem);
  for (int rep = 0; rep < REP_ATTN; ++rep) ph_attn(p, l, smem);
  SYNC_OR_RET(B0 + 4);
  ph_rwout(p, l);
  ph_ln(hl_src, hc_src, nullptr, nullptr, nullptr, nullptr, (bf16_t*)(p.ws + R_URE), mod, 0, l == 0 ? MT : ML);
  SYNC_OR_RET(B0 + 5);
  for (int rep = 0; rep < REP_GEMM; ++rep) ph_merge(p, l, smem);
  SYNC_OR_RET(B0 + 6);
  ph_resgemm(p, l, (const bf16_t*)(p.ws + R_ACC), 1024, (const bf16_t*)(p.ws + WB_OUT), hl_src, hc_src, 2048, smem);
  SYNC_OR_RET(B0 + 7);
  ph_ln(p.out, hc, p.out, hc, p.in[35] + (size_t)l * D, p.in[36] + (size_t)l * D, (bf16_t*)(p.ws + R_U), mod, 3072, l == 0 ? MT : ML);
  SYNC_OR_RET(B0 + 8);
  for (int rep = 0; rep < REP_GEMM; ++rep) ph_ffnup(p, l, smem);
  SYNC_OR_RET(B0 + 9);
  ph_resgemm(p, l, (const bf16_t*)(p.ws + R_HID), 2816, (const bf16_t*)(p.ws + WB_DOWN), p.out, hc, 5120, smem);
  SYNC_OR_RET(B0 + 10);
  ph_ln(p.out, hc, p.out, hc, p.in[41] + (size_t)l * D, p.in[42] + (size_t)l * D, nullptr, mod, 0, l == 0 ? MT : ML);
  SYNC_OR_RET(B0 + 11);
}

__global__ void __launch_bounds__(NTHR) mega(Params p) {
  extern __shared__ __attribute__((aligned(16))) char smem[];
  cg::grid_group grid = cg::this_grid();
  run_layer<0>(p, grid, smem);
  if (PH_END > 12) run_layer<1>(p, grid, smem);
}

extern "C" void kernel_launch(void* const* d_in, const int* in_sizes, int n_in, void* d_out, int out_size,
                              void* d_ws, size_t ws_size, hipStream_t stream) {
  static int grid_blocks = 0;
  if (!grid_blocks) {
    int dev = 0, cus = 0, per_cu = 0;
    (void)hipGetDevice(&dev);
    (void)hipDeviceGetAttribute(&cus, hipDeviceAttributeMultiprocessorCount, dev);
    (void)hipFuncSetAttribute((const void*)mega, hipFuncAttributeMaxDynamicSharedMemorySize, SMEM_BYTES);
    (void)hipOccupancyMaxActiveBlocksPerMultiprocessor(&per_cu, mega, NTHR, SMEM_BYTES);
    if (per_cu < 1) per_cu = 1;
    if (per_cu > 1) per_cu = 1;
    grid_blocks = cus * per_cu;
  }
  Params p{};
  for (int i = 0; i < 43; ++i) p.in[i] = (const float*)d_in[i];
  p.out = (float*)d_out; p.ws = (char*)d_ws;
  void* args[] = {&p};
  hipError_t e = hipLaunchCooperativeKernel((void*)mega, dim3(grid_blocks), dim3(NTHR), args, SMEM_BYTES, stream);
  if (e != hipSuccess) fprintf(stderr, "cooperative launch failed: %s (grid %d)\n", hipGetErrorString(e), grid_blocks);
}
```

```cpp
#include <hip/hip_runtime.h>
#include <hip/hip_cooperative_groups.h>
#include <cstdio>
#include <cstdint>
namespace cg = cooperative_groups;

#define DI __device__ __forceinline__
typedef unsigned short bf16_t;
typedef short bf16x8 __attribute__((ext_vector_type(8)));
typedef float f32x4 __attribute__((ext_vector_type(4)));

constexpr int D = 1024, NB = 8, SL = 4096, CL = 256;
constexpr int ML = NB * SL, MC = NB * CL, MT = ML + MC;
constexpr int KEYS = SL + CL;
constexpr int NTHR = 512;
constexpr float DN_ALPHA = 1.41421356237f;
constexpr size_t UNIT = (size_t)MT * 512;

constexpr size_t WB_IN = 0;
constexpr size_t WB_GATE = WB_IN + (size_t)3328 * 1024 * 2;
constexpr size_t WB_BR = WB_GATE + (size_t)4096 * 1024 * 2;
constexpr size_t WB_OUT = WB_BR + (size_t)4 * 1024 * 256 * 2;
constexpr size_t WB_UP = WB_OUT + (size_t)1024 * 1024 * 2;
constexpr size_t WB_DOWN = WB_UP + (size_t)5632 * 1024 * 2;
constexpr size_t WB_END = WB_DOWN + (size_t)1024 * 2816 * 2;
constexpr size_t OFF_KF = WB_END;
constexpr size_t OFF_HC = OFF_KF + (size_t)512 * 8192 * 8;
constexpr size_t OFF_MISC = OFF_HC + (size_t)MC * D * 4;
constexpr size_t MISC_MOD = OFF_MISC;
constexpr size_t MISC_TW = MISC_MOD + (size_t)2 * 9 * 6144 * 4;
constexpr size_t MISC_RAWC = MISC_TW + 4096 * 8;
constexpr size_t MISC_GCTX = MISC_RAWC + (size_t)256 * 1024 * 4;
constexpr size_t MISC_RWW = MISC_GCTX + (size_t)512 * 512 * 4;
constexpr size_t RWW_F = MISC_RWW, RWW_B = RWW_F + 256 * 64 * 2, RWW_A = RWW_B + 256 * 64 * 2, RWW_GF = RWW_A + 256 * 64 * 2, RWW_GB = RWW_GF + 256 * 128 * 2;
constexpr size_t OFF_R = OFF_MISC + (size_t)4 * 1024 * 1024;
static_assert(RWW_GB + 256 * 128 * 2 <= OFF_R, "misc overflow");
constexpr size_t R_YHY = OFF_R, R_YSW = OFF_R + UNIT, R_YDF = OFF_R + 2 * UNIT;
constexpr size_t R_PHY = OFF_R + 3 * UNIT;
constexpr size_t R_PSW = OFF_R + 6 * UNIT;
constexpr size_t R_VTSW = R_PSW + (size_t)MT * 384 * 2;
constexpr size_t R_PDF = OFF_R + 8 * UNIT;
constexpr size_t R_VTDF = OFF_R + 10 * UNIT;
constexpr size_t R_PRW = OFF_R + 11 * UNIT;
constexpr size_t R_STR = R_PRW + (size_t)MT * 1216 * 2;
constexpr size_t R_G = R_STR + 7 * UNIT;
constexpr size_t R_END = R_G + 2 * UNIT;
constexpr size_t R_RAWF = OFF_R;
constexpr size_t R_OF = R_PHY, R_OB = R_PHY + UNIT;
constexpr size_t R_URE = R_PSW;
constexpr size_t R_YRW = R_VTDF;
constexpr size_t R_ACC = R_PRW;
constexpr size_t R_U = R_STR;
constexpr size_t R_HID = OFF_R;
static_assert(R_END <= (size_t)512 * 1024 * 1024, "ws overflow");
static_assert((size_t)MT * 2816 * 2 <= 11 * UNIT, "hid");

constexpr int SMEM_BYTES = 136 * 1024;

struct Params {
  const float* in[43];
  float* out;
  char* ws;
};

DI int my_tid() { int t = (int)__builtin_amdgcn_workitem_id_x(); asm volatile("" : "+v"(t)); return t; }
DI unsigned f2bf(float f) { unsigned u = __float_as_uint(f); u += 0x7fffu + ((u >> 16) & 1u); return u >> 16; }
DI float bf2f(unsigned h) { return __uint_as_float(h << 16); }
typedef __bf16 bf16v2_t __attribute__((ext_vector_type(2)));
typedef float f32v2_t __attribute__((ext_vector_type(2)));
DI unsigned pack2(float lo, float hi) { f32v2_t v = {lo, hi}; bf16v2_t b = __builtin_convertvector(v, bf16v2_t); return __builtin_bit_cast(unsigned, b); }

DI float bflo(unsigned w) { return __uint_as_float(w << 16); }
DI float bfhi(unsigned w) { return __uint_as_float(w & 0xffff0000u); }
DI float sigmoidf_(float x) { return 1.f / (1.f + __expf(-x)); }
DI float siluf_(float x) { return x / (1.f + __expf(-x)); }
DI float wave_sum(float v) {
#pragma unroll
  for (int o = 32; o >= 1; o >>= 1) v += __shfl_xor(v, o);
  return v;
}
template <int CTRL> DI float dpp_mov(float v) {
  return __int_as_float(__builtin_amdgcn_update_dpp(0, __float_as_int(v), CTRL, 0xf, 0xf, false));
}
DI float sum16(float v) {
  v += dpp_mov<0xB1>(v);
  v += dpp_mov<0x4E>(v);
  v += dpp_mov<0x141>(v);
  v += dpp_mov<0x140>(v);
  return v;
}
DI void lds_barrier() { asm volatile("s_waitcnt lgkmcnt(0)" ::: "memory"); __builtin_amdgcn_s_barrier(); asm volatile("" ::: "memory"); }
DI uint4 sel4(bool z, uint4 v) { return make_uint4(z ? 0u : v.x, z ? 0u : v.y, z ? 0u : v.z, z ? 0u : v.w); }
DI int mod_idx(int row) { return row < ML ? (row >> 12) : 8; }

template <int NTW, bool DEEP, class RowFn>
DI void gemm_main(f32x4 (&acc)[4][NTW], const bf16_t* __restrict__ A, int lda, RowFn rowfn,
                  const bf16_t* __restrict__ Bt, int ldb, int K, char* smem) {
  constexpr int BN = NTW * 32;
  constexpr int A_BYTES = 256 * 144, B_BYTES = BN * 144, STAGE = A_BYTES + B_BYTES;
  constexpr int NBL = BN / 64;
  const int tid = my_tid(), lane = tid & 63, wid = tid >> 6, wm = wid >> 1, wn = wid & 1, g = lane >> 4, r16 = lane & 15;
  const int chunk = tid & 7, lrow = tid >> 3;
  long a0 = rowfn(lrow), a1 = rowfn(lrow + 64), a2 = rowfn(lrow + 128), a3 = rowfn(lrow + 192);
  const long c0 = a0 < 0 ? 0 : a0, c1 = a1 < 0 ? 0 : a1, c2 = a2 < 0 ? 0 : a2, c3 = a3 < 0 ? 0 : a3;
  const bf16_t* Bp = Bt + (long)lrow * ldb + chunk * 8;
  const bf16_t* Ap0 = A + c0 * lda + chunk * 8; const bf16_t* Ap1 = A + c1 * lda + chunk * 8;
  const bf16_t* Ap2 = A + c2 * lda + chunk * 8; const bf16_t* Ap3 = A + c3 * lda + chunk * 8;
  struct Regs { uint4 a0, a1, a2, a3, b0, b1; };
  Regs R0, R1;
  R0.b1 = make_uint4(0, 0, 0, 0); R1.b1 = make_uint4(0, 0, 0, 0);
  auto GLOAD = [&](Regs& R, int k0) {
    R.a0 = *(const uint4*)(Ap0 + k0); R.a1 = *(const uint4*)(Ap1 + k0);
    R.a2 = *(const uint4*)(Ap2 + k0); R.a3 = *(const uint4*)(Ap3 + k0);
    R.b0 = *(const uint4*)(Bp + k0);
    if constexpr (NBL > 1) R.b1 = *(const uint4*)(Bp + (long)64 * ldb + k0);
  };
  auto SSTORE = [&](const Regs& R, int st) {
    char* base = smem + st * STAGE + lrow * 144 + chunk * 16;
    *(uint4*)(base) = sel4(a0 < 0, R.a0); *(uint4*)(base + 64 * 144) = sel4(a1 < 0, R.a1);
    *(uint4*)(base + 128 * 144) = sel4(a2 < 0, R.a2); *(uint4*)(base + 192 * 144) = sel4(a3 < 0, R.a3);
    *(uint4*)(base + A_BYTES) = R.b0;
    if constexpr (NBL > 1) *(uint4*)(base + A_BYTES + 64 * 144) = R.b1;
  };
  auto COMPUTE = [&](int st) {
    const char* As = smem + st * STAGE + (wm * 64 + r16) * 144 + g * 16;
    const char* Bs = smem + st * STAGE + A_BYTES + (wn * (NTW * 16) + r16) * 144 + g * 16;
#pragma unroll
    for (int kk = 0; kk < 2; ++kk) {
      bf16x8 af[4], bfr[NTW];
#pragma unroll
      for (int mt = 0; mt < 4; ++mt) af[mt] = *(const bf16x8*)(As + mt * 16 * 144 + kk * 64);
#pragma unroll
      for (int nt = 0; nt < NTW; ++nt) bfr[nt] = *(const bf16x8*)(Bs + nt * 16 * 144 + kk * 64);
#pragma unroll
      for (int mt = 0; mt < 4; ++mt)
#pragma unroll
        for (int nt = 0; nt < NTW; ++nt)
          acc[mt][nt] = __builtin_amdgcn_mfma_f32_16x16x32_bf16(af[mt], bfr[nt], acc[mt][nt], 0, 0, 0);
    }
  };
  const int nk = K >> 6;
  __syncthreads();
  GLOAD(R0, 0);
  SSTORE(R0, 0);
  if constexpr (DEEP) {
    GLOAD(R0, 64);
    if (nk > 2) GLOAD(R1, 128);
    lds_barrier();
    for (int kt = 0; kt < nk; kt += 2) {
      COMPUTE(0);
      SSTORE(R0, 1);
      if (kt + 3 < nk) GLOAD(R0, (kt + 3) * 64);
      lds_barrier();
      COMPUTE(1);
      if (kt + 2 < nk) SSTORE(R1, 0);
      if (kt + 4 < nk) GLOAD(R1, (kt + 4) * 64);
      lds_barrier();
    }
  } else {
    lds_barrier();
    for (int kt = 0; kt < nk; ++kt) {
      const int st = kt & 1;
      if (kt + 1 < nk) GLOAD(R0, (kt + 1) * 64);
      COMPUTE(st);
      if (kt + 1 < nk) SSTORE(R0, st ^ 1);
      lds_barrier();
    }
  }
}

DI bool next_tile(int i, int MTILES, int NTILES, int& mt, int& nt) {
  const int xcd = blockIdx.x & 7, slot = blockIdx.x >> 3, nslot = gridDim.x >> 3;
  const int m_lo = (MTILES * xcd) >> 3, m_hi = (MTILES * (xcd + 1)) >> 3, Mloc = m_hi - m_lo;
  const int q = i * nslot + slot;
  if (q >= Mloc * NTILES) return false;
  const int gidx = q / (4 * NTILES), m0 = gidx * 4;
  const int rows = (Mloc - m0) < 4 ? (Mloc - m0) : 4;
  const int within = q - gidx * 4 * NTILES;
  nt = within / rows; mt = m_lo + m0 + within % rows;
  return true;
}

struct RowPlain { long base; DI long operator()(int r) const { return base + r; } };
struct RowHalo { long rowbase; int t0; int len; DI long operator()(int r) const { int t = t0 + r; return (t >= 0 && t < len) ? rowbase + t : -1; } };

template <int NTW> DI void zero_acc(f32x4 (&acc)[4][NTW]) {
#pragma unroll
  for (int i = 0; i < 4; ++i)
#pragma unroll
    for (int j = 0; j < NTW; ++j) acc[i][j] = (f32x4){0.f, 0.f, 0.f, 0.f};
}

DI void cvt_unit(const float* __restrict__ src, int ldsrc, int srccol0, int k0, bf16_t* __restrict__ dst, int K, int n0, char* smem) {
  float* T = (float*)smem;
  const int tid = my_tid();
  __syncthreads();
  if (srccol0 >= 0) {
#pragma unroll
    for (int i = 0; i < 8; ++i) {
      int idx = tid + i * 512; int k = idx >> 6, n = idx & 63;
      T[k * 65 + n] = src[(long)(k0 + k) * ldsrc + srccol0 + n];
    }
  }
  __syncthreads();
  int n = tid >> 3, kc = (tid & 7) * 8;
  uint4 o = make_uint4(0, 0, 0, 0);
  if (srccol0 >= 0) {
    o.x = pack2(T[(kc + 0) * 65 + n], T[(kc + 1) * 65 + n]);
    o.y = pack2(T[(kc + 2) * 65 + n], T[(kc + 3) * 65 + n]);
    o.z = pack2(T[(kc + 4) * 65 + n], T[(kc + 5) * 65 + n]);
    o.w = pack2(T[(kc + 6) * 65 + n], T[(kc + 7) * 65 + n]);
  }
  *(uint4*)(dst + (long)(n0 + n) * K + k0 + kc) = o;
}

DI void ph_convert(const Params& p, int l, char* smem) {
  for (int u = blockIdx.x; u < 4508; u += gridDim.x) {
    if (u < 832) {
      int gI = u >> 4, kt = u & 15; int n0 = gI * 64; int sc;
      if (n0 < 1280) sc = n0; else if (n0 < 2048) sc = 2496 + (n0 - 1280); else if (n0 < 3264) sc = 1280 + (n0 - 2048); else sc = -1;
      cvt_unit(p.in[6] + (size_t)l * 1024 * 7360, 7360, sc, kt * 64, (bf16_t*)(p.ws + WB_IN), 1024, n0, smem);
    } else if (u < 1856) {
      int v = u - 832; int gI = v >> 4, kt = v & 15;
      cvt_unit(p.in[6] + (size_t)l * 1024 * 7360, 7360, 3264 + gI * 64, kt * 64, (bf16_t*)(p.ws + WB_GATE), 1024, gI * 64, smem);
    } else if (u < 2112) {
      int v = u - 1856; int gI = v >> 2, kt = v & 3; int j = gI >> 4, gg = gI & 15;
      cvt_unit(p.in[33] + ((size_t)l * 4 + j) * 256 * 1024, 1024, gg * 64, kt * 64, (bf16_t*)(p.ws + WB_BR) + (size_t)j * 1024 * 256, 256, gg * 64, smem);
    } else if (u < 2368) {
      int v = u - 2112; int gI = v >> 4, kt = v & 15;
      cvt_unit(p.in[34] + (size_t)l * 1024 * 1024, 1024, gI * 64, kt * 64, (bf16_t*)(p.ws + WB_OUT), 1024, gI * 64, smem);
    } else if (u < 3776) {
      int v = u - 2368; int gI = v >> 4, kt = v & 15; int nt = gI >> 1, hb = gI & 1;
      cvt_unit(p.in[37] + (size_t)l * 1024 * 5632, 5632, hb * 2816 + nt * 64, kt * 64, (bf16_t*)(p.ws + WB_UP), 1024, gI * 64, smem);
    } else if (u < 4480) {
      int v = u - 3776; int gI = v / 44, kt = v % 44;
      cvt_unit(p.in[40] + (size_t)l * 2816 * 1024, 1024, gI * 64, kt * 64, (bf16_t*)(p.ws + WB_DOWN), 2816, gI * 64, smem);
    } else {
      int v = u - 4480;
      if (v < 4) cvt_unit(p.in[19] + (size_t)l * 2 * 64 * 256, 256, v * 64, 0, (bf16_t*)(p.ws + RWW_F), 64, v * 64, smem);
      else if (v < 8) cvt_unit(p.in[19] + (size_t)l * 2 * 64 * 256 + 64 * 256, 256, (v - 4) * 64, 0, (bf16_t*)(p.ws + RWW_B), 64, (v - 4) * 64, smem);
      else if (v < 12) cvt_unit(p.in[21] + (size_t)l * 64 * 256, 256, (v - 8) * 64, 0, (bf16_t*)(p.ws + RWW_A), 64, (v - 8) * 64, smem);
      else if (v < 20) { int w = v - 12; cvt_unit(p.in[22] + (size_t)l * 2 * 128 * 256, 256, (w >> 1) * 64, (w & 1) * 64, (bf16_t*)(p.ws + RWW_GF), 128, (w >> 1) * 64, smem); }
      else { int w = v - 20; cvt_unit(p.in[22] + (size_t)l * 2 * 128 * 256 + 128 * 256, 256, (w >> 1) * 64, (w & 1) * 64, (bf16_t*)(p.ws + RWW_GB), 128, (w >> 1) * 64, smem); }
    }
  }
}

DI void ph_ada(const Params& p, char* smem) {
  float* S = (float*)smem;
  float* R = S + 9 * 1024;
  const int tid = my_tid();
  bool loaded = false;
  for (int u = blockIdx.x; u < 192; u += gridDim.x) {
    if (!loaded) {
      __syncthreads();
      for (int i = tid; i < 9 * 1024; i += NTHR) { float c = i < 8192 ? p.in[1][i] : p.in[3][i - 8192]; S[i] = siluf_(c); }
      loaded = true;
    }
    __syncthreads();
    int l = u / 96, n0 = (u % 96) * 64;
    int col = tid & 63, ks = tid >> 6;
    const float* W = p.in[4] + (size_t)l * 1024 * 6144 + n0 + col;
    float a[9];
#pragma unroll
    for (int b = 0; b < 9; ++b) a[b] = 0.f;
    for (int k = ks * 128; k < ks * 128 + 128; ++k) {
      float w = W[(size_t)k * 6144];
#pragma unroll
      for (int b = 0; b < 9; ++b) a[b] += S[b * 1024 + k] * w;
    }
#pragma unroll
    for (int b = 0; b < 9; ++b) R[(ks * 9 + b) * 64 + col] = a[b];
    __syncthreads();
    for (int i = tid; i < 9 * 64; i += NTHR) {
      int b = i >> 6, c = i & 63; float s = 0.f;
#pragma unroll
      for (int k2 = 0; k2 < 8; ++k2) s += R[(k2 * 9 + b) * 64 + c];
      s += p.in[5][(size_t)l * 6144 + n0 + c];
      ((float*)(p.ws + MISC_MOD))[((size_t)l * 9 + b) * 6144 + n0 + c] = s;
    }
  }
  for (int i = blockIdx.x * NTHR + tid; i < 4096; i += gridDim.x * NTHR) {
    float s, c; sincospif(-(float)i / 4096.f, &s, &c);
    ((float2*)(p.ws + MISC_TW))[i] = make_float2(c, s);
  }
}

DI void hy_rawfilter(const Params& p, int l, int Lf, float* __restrict__ dst, char* smem) {
  float* W1 = (float*)smem;
  float* W2 = W1 + 33 * 64;
  float* Z = W2 + 64 * 64;
  float* H1 = Z + 16 * 36;
  float* H2 = H1 + 16 * 64;
  const int tid = my_tid();
  const float* w1 = p.in[9] + (size_t)l * 33 * 64; const float* b1 = p.in[10] + l * 64;
  const float* w2 = p.in[11] + (size_t)l * 64 * 64; const float* b2 = p.in[12] + l * 64;
  const float* w3 = p.in[13] + (size_t)l * 64 * 1024; const float* fr = p.in[14] + l * 64;
  const int nunits = Lf / 16;
  bool loaded = false;
  for (int u = blockIdx.x; u < nunits; u += gridDim.x) {
    __syncthreads();
    if (!loaded) {
      for (int i = tid; i < 33 * 64; i += NTHR) W1[i] = w1[i];
      for (int i = tid; i < 64 * 64; i += NTHR) W2[i] = w2[i];
      loaded = true;
    }
    const int t0 = u * 16;
    for (int i = tid; i < 16 * 33; i += NTHR) {
      int tt = i / 33, f = i % 33; int t = t0 + tt; float v;
      if (f == 0) v = (float)t / (float)(Lf - 1);
      else {
        int bi = (f - 1) & 15;
        float wv = 6.283185307179586f * (float)t / (float)Lf;
        float fb = 1e-4f + (15.f - 1e-4f) * (float)bi / 15.f;
        float ang = wv * fb;
        v = (f <= 16) ? cosf(ang) : -sinf(ang);
      }
      Z[tt * 36 + f] = v;
    }
    __syncthreads();
    for (int i = tid; i < 16 * 64; i += NTHR) {
      int tt = i >> 6, f = i & 63; float s = b1[f];
      for (int k = 0; k < 33; ++k) s += Z[tt * 36 + k] * W1[k * 64 + f];
      H1[tt * 64 + f] = sinf(fr[f] * s);
    }
    __syncthreads();
    for (int i = tid; i < 16 * 64; i += NTHR) {
      int tt = i >> 6, f = i & 63; float s = b2[f];
      for (int k = 0; k < 64; ++k) s += H1[tt * 64 + k] * W2[k * 64 + f];
      H2[tt * 64 + f] = sinf(fr[f] * s);
    }
    __syncthreads();
    float a0[16], a1[16];
#pragma unroll
    for (int i = 0; i < 16; ++i) { a0[i] = 0.f; a1[i] = 0.f; }
    for (int k = 0; k < 64; ++k) {
      float wa = w3[k * 1024 + tid], wb = w3[k * 1024 + 512 + tid];
#pragma unroll
      for (int i = 0; i < 16; ++i) { float h = H2[i * 64 + k]; a0[i] += h * wa; a1[i] += h * wb; }
    }
    {
      int w = tid & 255;
      float delta = fabsf(-3.0701134573253944f + (-15.350567286626972f + 3.0701134573253944f) * (float)w / 255.f);
#pragma unroll
      for (int i = 0; i < 16; ++i) {
        float tn = (float)(t0 + i) / (float)(Lf - 1);
        float dec = expf(-tn * delta);
        dst[(size_t)(t0 + i) * 1024 + tid] = a0[i] * dec;
        dst[(size_t)(t0 + i) * 1024 + 512 + tid] = a1[i] * dec;
      }
    }
  }
}

DI float2 cmul(float2 a, float2 b) { return make_float2(a.x * b.x - a.y * b.y, a.x * b.y + a.y * b.x); }
DI float2 cmulc(float2 a, float2 b) { return make_float2(a.x * b.x + a.y * b.y, a.y * b.x - a.x * b.y); }
DI void fft_dif(float2* X, const float2* W) {
  const int tid = my_tid();
  for (int ls = 12; ls >= 0; --ls) {
    const int span = 1 << ls;
    __syncthreads();
#pragma unroll
    for (int i = 0; i < 8; ++i) {
      int bf = tid + i * 512; int pos = bf & (span - 1); int i0 = ((bf >> ls) << (ls + 1)) + pos; int i1 = i0 + span;
      float2 a = X[i0], b = X[i1]; float2 w = W[pos << (12 - ls)];
      X[i0] = make_float2(a.x + b.x, a.y + b.y);
      X[i1] = cmul(make_float2(a.x - b.x, a.y - b.y), w);
    }
  }
  __syncthreads();
}
DI void fft_dit_inv(float2* X, const float2* W) {
  const int tid = my_tid();
  for (int ls = 0; ls <= 12; ++ls) {
    const int span = 1 << ls;
    __syncthreads();
#pragma unroll
    for (int i = 0; i < 8; ++i) {
      int bf = tid + i * 512; int pos = bf & (span - 1); int i0 = ((bf >> ls) << (ls + 1)) + pos; int i1 = i0 + span;
      float2 a = X[i0], b = X[i1]; float2 w = W[pos << (12 - ls)];
      float2 t = cmulc(b, w);
      X[i0] = make_float2(a.x + t.x, a.y + t.y);
      X[i1] = make_float2(a.x - t.x, a.y - t.y);
    }
  }
  __syncthreads();
}
DI void load_twiddles(const Params& p, float2* W) {
  const float2* tw = (const float2*)(p.ws + MISC_TW);
  for (int i = my_tid(); i < 4096; i += NTHR) W[i] = tw[i];
}

DI void ph_kf(const Params& p, int l, char* smem) {
  float2* X = (float2*)smem; float2* W = X + 8192; float* red = (float*)(W + 4096);
  const int tid = my_tid(), lane = tid & 63, wid = tid >> 6;
  const float* rawf = (const float*)(p.ws + R_RAWF);
  float2* kf = (float2*)(p.ws + OFF_KF);
  bool tw = false;
  for (int u = blockIdx.x; u < 256; u += gridDim.x) {
    if (!tw) { load_twiddles(p, W); tw = true; }
    const int o = u >> 7, c = (u & 127) * 2;
    float2 fw[8], bw[8]; float sa = 0.f, sb = 0.f;
#pragma unroll
    for (int i = 0; i < 8; ++i) {
      int t = tid + i * 512;
      fw[i] = *(const float2*)(rawf + (size_t)t * 1024 + o * 512 + c);
      bw[i] = *(const float2*)(rawf + (size_t)t * 1024 + o * 512 + 256 + c);
      sa += fabsf(fw[i].x) + fabsf(bw[i].x); sb += fabsf(fw[i].y) + fabsf(bw[i].y);
    }
    sa = wave_sum(sa); sb = wave_sum(sb);
    __syncthreads();
    if (lane == 0) { red[wid * 2] = sa; red[wid * 2 + 1] = sb; }
    __syncthreads();
    float ta = 0.f, tb = 0.f;
#pragma unroll
    for (int w = 0; w < 8; ++w) { ta += red[w * 2]; tb += red[w * 2 + 1]; }
    const float ia = 1.f / ta, ib = 1.f / tb;
#pragma unroll
    for (int i = 0; i < 8; ++i) {
      int t = tid + i * 512;
      X[t] = make_float2(fw[i].x * ia, fw[i].y * ib);
      if (t >= 1) X[8192 - t] = make_float2(bw[i].x * ia, bw[i].y * ib);
      else X[4096] = make_float2(0.f, 0.f);
    }
    fft_dif(X, W);
    float2* ka = kf + (size_t)(o * 256 + c) * 8192; float2* kb = ka + 8192;
#pragma unroll 4
    for (int i = 0; i < 16; ++i) {
      int pidx = tid + i * 512;
      int k = (int)(__brev((unsigned)pidx) >> 19);
      int k2 = (8192 - k) & 8191;
      int p2 = (int)(__brev((unsigned)k2) >> 19);
      float2 c1 = X[pidx], c2 = X[p2];
      float2 A = make_float2(0.5f * (c1.x + c2.x), 0.5f * (c1.y - c2.y));
      float2 Bv = make_float2(0.5f * (c1.y + c2.y), -0.5f * (c1.x - c2.x));
      ka[pidx] = A; kb[pidx] = Bv;
    }
    __syncthreads();
  }
  if (l == 0) {
    const float* rawc = (const float*)(p.ws + MISC_RAWC);
    float* G = (float*)(p.ws + MISC_GCTX);
    for (int u = blockIdx.x * 8 + wid; u < 512; u += gridDim.x * 8) {
      int o = u >> 8, c = u & 255; float f[4], b[4]; float s = 0.f;
#pragma unroll
      for (int i = 0; i < 4; ++i) {
        int t = lane + i * 64;
        f[i] = rawc[(size_t)t * 1024 + o * 512 + c]; b[i] = rawc[(size_t)t * 1024 + o * 512 + 256 + c];
        s += fabsf(f[i]) + fabsf(b[i]);
      }
      s = wave_sum(s); float inv = 1.f / s;
#pragma unroll
      for (int i = 0; i < 4; ++i) {
        int t = lane + i * 64;
        G[(size_t)u * 512 + 256 + t] = f[i] * inv;
        if (t >= 1) G[(size_t)u * 512 + 256 - t] = b[i] * inv;
      }
      if (lane == 0) G[(size_t)u * 512] = 0.f;
    }
  }
}

DI void ph_ln(const float* __restrict__ src_lat, const float* __restrict__ src_ctx, float* dst_lat, float* dst_ctx,
              const float* __restrict__ ag, const float* __restrict__ ab, bf16_t* U, const float* __restrict__ mod, int sh_off, int nrows) {
  const int lane = my_tid() & 63, wid = my_tid() >> 6;
  for (int row = blockIdx.x * 8 + wid; row < nrows; row += gridDim.x * 8) {
    const float* src = row < ML ? src_lat + (size_t)row * D : src_ctx + (size_t)(row - ML) * D;
    float4 v[4];
#pragma unroll
    for (int i = 0; i < 4; ++i) v[i] = *(const float4*)(src + i * 256 + lane * 4);
    float s = 0.f;
#pragma unroll
    for (int i = 0; i < 4; ++i) s += v[i].x + v[i].y + v[i].z + v[i].w;
    float mu = wave_sum(s) * (1.f / 1024.f);
    float q = 0.f;
#pragma unroll
    for (int i = 0; i < 4; ++i) { v[i].x -= mu; v[i].y -= mu; v[i].z -= mu; v[i].w -= mu; q += v[i].x * v[i].x + v[i].y * v[i].y + v[i].z * v[i].z + v[i].w * v[i].w; }
    float rs = rsqrtf(wave_sum(q) * (1.f / 1024.f) + 1e-6f);
#pragma unroll
    for (int i = 0; i < 4; ++i) { v[i].x *= rs; v[i].y *= rs; v[i].z *= rs; v[i].w *= rs; }
    if (ag) {
      float* dst = row < ML ? dst_lat + (size_t)row * D : dst_ctx + (size_t)(row - ML) * D;
#pragma unroll
      for (int i = 0; i < 4; ++i) {
        float4 gg = *(const float4*)(ag + i * 256 + lane * 4), bb = *(const float4*)(ab + i * 256 + lane * 4);
        v[i].x = v[i].x * gg.x + bb.x; v[i].y = v[i].y * gg.y + bb.y; v[i].z = v[i].z * gg.z + bb.z; v[i].w = v[i].w * gg.w + bb.w;
        *(float4*)(dst + i * 256 + lane * 4) = v[i];
      }
      if (U) {
        s = 0.f;
#pragma unroll
        for (int i = 0; i < 4; ++i) s += v[i].x + v[i].y + v[i].z + v[i].w;
        mu = wave_sum(s) * (1.f / 1024.f); q = 0.f;
#pragma unroll
        for (int i = 0; i < 4; ++i) { v[i].x -= mu; v[i].y -= mu; v[i].z -= mu; v[i].w -= mu; q += v[i].x * v[i].x + v[i].y * v[i].y + v[i].z * v[i].z + v[i].w * v[i].w; }
        rs = rsqrtf(wave_sum(q) * (1.f / 1024.f) + 1e-6f);
#pragma unroll
        for (int i = 0; i < 4; ++i) { v[i].x *= rs; v[i].y *= rs; v[i].z *= rs; v[i].w *= rs; }
      }
    }
    if (U) {
      const float* m = mod + (size_t)mod_idx(row) * 6144 + sh_off;
#pragma unroll
      for (int i = 0; i < 4; ++i) {
        float4 sh = *(const float4*)(m + i * 256 + lane * 4), sc = *(const float4*)(m + 1024 + i * 256 + lane * 4);
        uint2 o; o.x = pack2(v[i].x * (1.f + sc.x) + sh.x, v[i].y * (1.f + sc.y) + sh.y);
        o.y = pack2(v[i].z * (1.f + sc.z) + sh.z, v[i].w * (1.f + sc.w) + sh.w);
        *(uint2*)(U + (size_t)row * D + i * 256 + lane * 4) = o;
      }
    }
  }
}

DI void ph_inproj(const Params& p, char* smem) {
  const bf16_t* U = (const bf16_t*)(p.ws + R_U);
  const bf16_t* Bt = (const bf16_t*)(p.ws + WB_IN);
  const int lane = my_tid() & 63, wid = my_tid() >> 6, wm = wid >> 1, wn = wid & 1, g = lane >> 4, r16 = lane & 15;
  for (int it = 0;; ++it) {
    int mtile, ntile;
    if (!next_tile(it, 136, 26, mtile, ntile)) break;
    f32x4 acc[4][4]; zero_acc<4>(acc);
    gemm_main<4, true>(acc, U, 1024, RowPlain{(long)mtile * 256}, Bt + (size_t)ntile * 128 * 1024, 1024, 1024, smem);
    int b, key0;
    if (mtile < 128) { b = mtile >> 4; key0 = (mtile & 15) * 256; } else { b = mtile - 128; key0 = SL; }
    bf16_t* tbase = nullptr; int tcols = 0, tcol0 = 0;
    if (ntile < 6) { tbase = (bf16_t*)(p.ws + R_PHY); tcols = 768; tcol0 = ntile * 128; }
    else if (ntile == 9) { tbase = (bf16_t*)(p.ws + R_VTSW); tcols = 128; tcol0 = 0; }
    else if (ntile == 14 || ntile == 15) { tbase = (bf16_t*)(p.ws + R_VTDF); tcols = 256; tcol0 = (ntile - 14) * 128; }
    if (tbase) {
#pragma unroll
      for (int mt = 0; mt < 4; ++mt)
#pragma unroll
        for (int nt = 0; nt < 4; ++nt) {
          int col = tcol0 + wn * 64 + nt * 16 + r16;
          int key = key0 + wm * 64 + mt * 16 + g * 4;
          uint2 o; o.x = pack2(acc[mt][nt][0], acc[mt][nt][1]); o.y = pack2(acc[mt][nt][2], acc[mt][nt][3]);
          *(uint2*)(tbase + ((size_t)b * tcols + col) * KEYS + key) = o;
        }
    } else {
      bf16_t* rb; int ld, c0, cmax;
      if (ntile < 9) { rb = (bf16_t*)(p.ws + R_PSW); ld = 384; c0 = (ntile - 6) * 128; cmax = 384; }
      else if (ntile < 14) { rb = (bf16_t*)(p.ws + R_PDF); ld = 512; c0 = (ntile - 10) * 128; cmax = 512; }
      else { rb = (bf16_t*)(p.ws + R_PRW); ld = 1216; c0 = (ntile - 16) * 128; cmax = 1216; }
#pragma unroll
      for (int mt = 0; mt < 4; ++mt)
#pragma unroll
        for (int nt = 0; nt < 4; ++nt) {
          int col = c0 + wn * 64 + nt * 16 + r16;
          if (col < cmax) {
#pragma unroll
            for (int j = 0; j < 4; ++j) {
              size_t row = (size_t)mtile * 256 + wm * 64 + mt * 16 + g * 4 + j;
              rb[row * ld + col] = (bf16_t)f2bf(acc[mt][nt][j]);
            }
          }
        }
    }
  }
}

DI float hy_conv3(const bf16_t* __restrict__ P, int t, int len, float w0, float w1, float w2, float bias) {
  float a = t >= 1 ? bf2f(P[t - 1]) : 0.f, b = bf2f(P[t]), c = (t + 1 < len) ? bf2f(P[t + 1]) : 0.f;
  return w0 * a + w1 * b + w2 * c + bias;
}
DI void ph_hyena(const Params& p, int l, char* smem) {
  float2* X = (float2*)smem; float2* W = X + 8192;
  const int tid = my_tid();
  const bf16_t* PT = (const bf16_t*)(p.ws + R_PHY);
  const float2* kf = (const float2*)(p.ws + OFF_KF);
  const float* cw = p.in[7] + (size_t)l * 3 * 768; const float* cb = p.in[8] + (size_t)l * 768;
  const float* hb = p.in[15] + (size_t)l * 512;
  bf16_t* Y = (bf16_t*)(p.ws + R_YHY);
  bool tw = false;
  for (int u = blockIdx.x; u < 1024; u += gridDim.x) {
    if (!tw) { load_twiddles(p, W); tw = true; }
    const int bp = u >> 8, c = u & 255; const int b0 = bp * 2, b1 = b0 + 1;
    const bf16_t* P0 = PT + ((size_t)b0 * 768) * KEYS; const bf16_t* P1 = PT + ((size_t)b1 * 768) * KEYS;
    float wv0 = cw[c], wv1 = cw[768 + c], wv2 = cw[1536 + c], bv = cb[c];
    float wa0 = cw[256 + c], wa1 = cw[768 + 256 + c], wa2 = cw[1536 + 256 + c], ba = cb[256 + c];
    float wb0 = cw[512 + c], wb1 = cw[768 + 512 + c], wb2 = cw[1536 + 512 + c], bb = cb[512 + c];
    const float bias0 = hb[c], bias1 = hb[256 + c];
    float2 vv[8];
    __syncthreads();
#pragma unroll
    for (int i = 0; i < 8; ++i) {
      int t = tid + i * 512;
      vv[i].x = hy_conv3(P0 + (size_t)c * KEYS, t, SL, wv0, wv1, wv2, bv);
      vv[i].y = hy_conv3(P1 + (size_t)c * KEYS, t, SL, wv0, wv1, wv2, bv);
      X[t] = vv[i]; X[t + 4096] = make_float2(0.f, 0.f);
    }
    fft_dif(X, W);
    {
      const float2* H = kf + (size_t)c * 8192;
#pragma unroll 4
      for (int i = 0; i < 16; ++i) { int q = tid + i * 512; X[q] = cmul(X[q], H[q]); }
    }
    fft_dit_inv(X, W);
    float2 zz[8];
#pragma unroll
    for (int i = 0; i < 8; ++i) {
      int t = tid + i * 512;
      float2 y = X[t];
      float x1a = hy_conv3(P0 + (size_t)(256 + c) * KEYS, t, SL, wa0, wa1, wa2, ba);
      float x1b = hy_conv3(P1 + (size_t)(256 + c) * KEYS, t, SL, wa0, wa1, wa2, ba);
      zz[i].x = x1a * (y.x * (1.f / 8192.f) + bias0 * vv[i].x);
      zz[i].y = x1b * (y.y * (1.f / 8192.f) + bias0 * vv[i].y);
    }
    __syncthreads();
#pragma unroll
    for (int i = 0; i < 8; ++i) { int t = tid + i * 512; X[t] = zz[i]; X[t + 4096] = make_float2(0.f, 0.f); }
    fft_dif(X, W);
    {
      const float2* H = kf + (size_t)(256 + c) * 8192;
#pragma unroll 4
      for (int i = 0; i < 16; ++i) { int q = tid + i * 512; X[q] = cmul(X[q], H[q]); }
    }
    fft_dit_inv(X, W);
#pragma unroll
    for (int i = 0; i < 8; ++i) {
      int t = tid + i * 512;
      float2 y = X[t];
      float x2a = hy_conv3(P0 + (size_t)(512 + c) * KEYS, t, SL, wb0, wb1, wb2, bb);
      float x2b = hy_conv3(P1 + (size_t)(512 + c) * KEYS, t, SL, wb0, wb1, wb2, bb);
      float oa = x2a * (y.x * (1.f / 8192.f) + bias1 * zz[i].x);
      float ob = x2b * (y.y * (1.f / 8192.f) + bias1 * zz[i].y);
      Y[((size_t)b0 * SL + t) * 256 + c] = (bf16_t)f2bf(oa);
      Y[((size_t)b1 * SL + t) * 256 + c] = (bf16_t)f2bf(ob);
    }
  }
}

DI void ph_hyena_ctx(const Params& p, int l, char* smem) {
  const int tid = my_tid(), lane = tid & 63, wid = tid >> 6;
  float* Zb = (float*)smem + wid * 1024;
  float* Gb = Zb + 256;
  const bf16_t* PT = (const bf16_t*)(p.ws + R_PHY);
  const float* G = (const float*)(p.ws + MISC_GCTX);
  const float* cw = p.in[7] + (size_t)l * 3 * 768; const float* cb = p.in[8] + (size_t)l * 768;
  const float* hb = p.in[15] + (size_t)l * 512;
  bf16_t* Y = (bf16_t*)(p.ws + R_YHY);
  for (int base = blockIdx.x * 8; base < 2048; base += gridDim.x * 8) {
    const int u = base + wid; const int b = u >> 8, c = u & 255;
    const bf16_t* Pb = PT + ((size_t)b * 768) * KEYS + SL;
    float v[4], x1[4], x2[4], zz[4];
#pragma unroll
    for (int i = 0; i < 4; ++i) {
      int t = lane + i * 64;
      v[i] = hy_conv3(Pb + (size_t)c * KEYS, t, CL, cw[c], cw[768 + c], cw[1536 + c], cb[c]);
      x1[i] = hy_conv3(Pb + (size_t)(256 + c) * KEYS, t, CL, cw[256 + c], cw[768 + 256 + c], cw[1536 + 256 + c], cb[256 + c]);
      x2[i] = hy_conv3(Pb + (size_t)(512 + c) * KEYS, t, CL, cw[512 + c], cw[768 + 512 + c], cw[1536 + 512 + c], cb[512 + c]);
    }
    __syncthreads();
#pragma unroll
    for (int i = 0; i < 4; ++i) Zb[lane + i * 64] = v[i];
    for (int i = lane; i < 512; i += 64) Gb[i] = G[(size_t)c * 512 + i];
    __syncthreads();
#pragma unroll
    for (int i = 0; i < 4; ++i) {
      int t = lane + i * 64; float s = 0.f;
      for (int s2 = 0; s2 < 256; ++s2) s += Gb[256 + t - s2] * Zb[s2];
      zz[i] = x1[i] * (s + hb[c] * v[i]);
    }
    __syncthreads();
#pragma unroll
    for (int i = 0; i < 4; ++i) Zb[lane + i * 64] = zz[i];
    for (int i = lane; i < 512; i += 64) Gb[i] = G[(size_t)(256 + c) * 512 + i];
    __syncthreads();
#pragma unroll
    for (int i = 0; i < 4; ++i) {
      int t = lane + i * 64; float s = 0.f;
      for (int s2 = 0; s2 < 256; ++s2) s += Gb[256 + t - s2] * Zb[s2];
      float o = x2[i] * (s + hb[256 + c] * zz[i]);
      Y[((size_t)ML + b * CL + t) * 256 + c] = (bf16_t)f2bf(o);
    }
  }
}

DI void ph_rope(const Params& p, char* smem) {
  float2* T16 = (float2*)smem;
  float2* T8 = T16 + 64 * 16;
  const int tid = my_tid(), lane = tid & 63, wid = tid >> 6;
  __syncthreads();
  for (int i = tid; i < 64 * 16; i += NTHR) {
    int pos = i >> 4, f = i & 15; float inv = powf(10000.f, -(float)f / 16.f); float s, c; sincosf((float)pos * inv, &s, &c);
    T16[i] = make_float2(c, s);
  }
  for (int i = tid; i < 64 * 8; i += NTHR) {
    int pos = i >> 3, f = i & 7; float inv = powf(10000.f, -(float)f / 8.f); float s, c; sincosf((float)pos * inv, &s, &c);
    T8[i] = make_float2(c, s);
  }
  __syncthreads();
  bf16_t* Psw = (bf16_t*)(p.ws + R_PSW); bf16_t* Pdf = (bf16_t*)(p.ws + R_PDF);
  for (int row = blockIdx.x * 8 + wid; row < ML; row += gridDim.x * 8) {
    const int t = row & (SL - 1); const int pr = t >> 6, pc = t & 63;
    bf16_t* q = Psw + (size_t)row * 384;
#pragma unroll
    for (int i = 0; i < 3; ++i) {
      int pi = lane + i * 64; int hd = pi >> 5, pp = pi & 31; int half = pp >> 4, f = pp & 15;
      int base = hd * 64 + half * 32; float2 cs = T16[(half ? pc : pr) * 16 + f];
      float x1 = bf2f(q[base + f]), x2 = bf2f(q[base + 16 + f]);
      q[base + f] = (bf16_t)f2bf(x1 * cs.x - x2 * cs.y); q[base + 16 + f] = (bf16_t)f2bf(x1 * cs.y + x2 * cs.x);
    }
    bf16_t* d = Pdf + (size_t)row * 512;
#pragma unroll
    for (int i = 0; i < 4; ++i) {
      int pi = lane + i * 64; int gi = pi >> 4, pp = pi & 15; int half = pp >> 3, f = pp & 7;
      int base = gi * 32 + half * 16; float2 cs = T8[(half ? pc : pr) * 8 + f];
      float x1 = bf2f(d[base + f]), x2 = bf2f(d[base + 8 + f]);
      d[base + f] = (bf16_t)f2bf(x1 * cs.x - x2 * cs.y); d[base + 8 + f] = (bf16_t)f2bf(x1 * cs.y + x2 * cs.x);
    }
  }
}

DI float rw_shift(const bf16_t* __restrict__ P, int row, int t, int len, int col, float mu) {
  float c = bf2f(P[(size_t)row * 1216 + col]);
  float a = t >= 1 ? bf2f(P[(size_t)(row - 1) * 1216 + col]) : 0.f;
  float b = t + 1 < len ? bf2f(P[(size_t)(row + 1) * 1216 + col]) : 0.f;
  return c + (0.5f * (a + b) - c) * mu;
}
DI void ph_rwprep(const Params& p, int l, char* smem) {
  constexpr int AST = 912, RST = 1552, ROFF = 32 * AST;
  const int tid = my_tid(), lane = tid & 63, wid = tid >> 6, g = lane >> 4, r16 = lane & 15;
  const int tg = wid >> 2, hd = wid & 3;
  const bf16_t* P = (const bf16_t*)(p.ws + R_PRW);
  const float* mu = p.in[17] + (size_t)l * 1216;
  const float* w0 = p.in[18] + (size_t)l * 512; const float* a0 = p.in[20] + (size_t)l * 256;
  const float* kkw = p.in[23] + (size_t)l * 256; const float* kaw = p.in[24] + (size_t)l * 256;
  bf16_t* S = (bf16_t*)(p.ws + R_STR); bf16_t* Gs = (bf16_t*)(p.ws + R_G);
  const size_t SU = (size_t)MT * 256;
  float w0f[4], w0b[4], a0c[4], kkc[4], kac[4];
#pragma unroll
  for (int nt = 0; nt < 4; ++nt) { int c = hd * 64 + nt * 16 + r16; w0f[nt] = w0[c]; w0b[nt] = w0[256 + c]; a0c[nt] = a0[c]; kkc[nt] = kkw[c]; kac[nt] = kaw[c]; }
  for (int u = blockIdx.x; u < MT / 32; u += gridDim.x) {
    const int row0 = u * 32; int t0, len;
    if (row0 < ML) { t0 = row0 & (SL - 1); len = SL; } else { t0 = (row0 - ML) & (CL - 1); len = CL; }
    __syncthreads();
    for (int item = tid; item < 32 * 152; item += NTHR) {
      const int tk = item / 152, c8 = item - tk * 152; const int row = row0 + tk, t = t0 + tk;
      const uint4 uc = *(const uint4*)(P + (size_t)row * 1216 + c8 * 8);
      uint4 ua = make_uint4(0, 0, 0, 0), ub = make_uint4(0, 0, 0, 0);
      if (t >= 1) ua = *(const uint4*)(P + (size_t)(row - 1) * 1216 + c8 * 8);
      if (t + 1 < len) ub = *(const uint4*)(P + (size_t)(row + 1) * 1216 + c8 * 8);
      const float4 m0 = *(const float4*)(mu + c8 * 8), m1 = *(const float4*)(mu + c8 * 8 + 4);
      float o[8];
      {
        const unsigned wc[4] = {uc.x, uc.y, uc.z, uc.w}, wa[4] = {ua.x, ua.y, ua.z, ua.w}, wb[4] = {ub.x, ub.y, ub.z, ub.w};
        const float mm[8] = {m0.x, m0.y, m0.z, m0.w, m1.x, m1.y, m1.z, m1.w};
#pragma unroll
        for (int i = 0; i < 4; ++i) {
          float c_lo = bflo(wc[i]), c_hi = bfhi(wc[i]);
          o[2 * i] = c_lo + (0.5f * (bflo(wa[i]) + bflo(wb[i])) - c_lo) * mm[2 * i];
          o[2 * i + 1] = c_hi + (0.5f * (bfhi(wa[i]) + bfhi(wb[i])) - c_hi) * mm[2 * i + 1];
        }
      }
      char* dst;
      if (c8 < 96) dst = smem + ROFF + tk * RST + c8 * 16;
      else {
        const int cc = c8 * 8 - 768;
        if (cc < 128) {
#pragma unroll
          for (int i = 0; i < 8; ++i) o[i] = tanhf(o[i]);
        } else if (cc >= 192) {
#pragma unroll
          for (int i = 0; i < 8; ++i) o[i] = sigmoidf_(o[i]);
        }
        dst = smem + tk * AST + cc * 2;
      }
      uint4 ov; ov.x = pack2(o[0], o[1]); ov.y = pack2(o[2], o[3]); ov.z = pack2(o[4], o[5]); ov.w = pack2(o[6], o[7]);
      *(uint4*)dst = ov;
    }
    __syncthreads();
    f32x4 acc[5][4];
#pragma unroll
    for (int o5 = 0; o5 < 5; ++o5)
#pragma unroll
      for (int nt = 0; nt < 4; ++nt) acc[o5][nt] = (f32x4){0.f, 0.f, 0.f, 0.f};
    const char* Arow = smem + (tg * 16 + r16) * AST + g * 16;
#pragma unroll
    for (int o5 = 0; o5 < 5; ++o5) {
      const int kbase = o5 < 3 ? o5 * 64 : (o5 == 3 ? 192 : 320);
      const int KK = o5 < 3 ? 64 : 128;
      const bf16_t* Wt = (const bf16_t*)(p.ws + (o5 == 0 ? RWW_F : o5 == 1 ? RWW_B : o5 == 2 ? RWW_A : o5 == 3 ? RWW_GF : RWW_GB));
#pragma unroll
      for (int ks = 0; ks < KK / 32; ++ks) {
        const bf16x8 af = *(const bf16x8*)(Arow + (kbase + ks * 32) * 2);
#pragma unroll
        for (int nt = 0; nt < 4; ++nt) {
          const bf16x8 bf = *(const bf16x8*)(Wt + (size_t)(hd * 64 + nt * 16 + r16) * KK + ks * 32 + g * 8);
          acc[o5][nt] = __builtin_amdgcn_mfma_f32_16x16x32_bf16(af, bf, acc[o5][nt], 0, 0, 0);
        }
        if (ks & 1) asm volatile("" ::: "memory");
      }
    }
#pragma unroll
    for (int j = 0; j < 4; ++j) {
      const int tk = tg * 16 + g * 4 + j; const size_t row = (size_t)row0 + tk;
      const char* rk = smem + ROFF + tk * RST;
      float kv[4], n2 = 0.f;
#pragma unroll
      for (int nt = 0; nt < 4; ++nt) { int c = hd * 64 + nt * 16 + r16; kv[nt] = bf2f(*(const unsigned short*)(rk + (256 + c) * 2)); float q = kv[nt] * kkc[nt]; n2 += q * q; }
      n2 = sum16(n2);
      const float inv = 1.f / fmaxf(sqrtf(n2), 1e-12f);
#pragma unroll
      for (int nt = 0; nt < 4; ++nt) {
        const int c = hd * 64 + nt * 16 + r16;
        const float r = bf2f(*(const unsigned short*)(rk + c * 2)), v = bf2f(*(const unsigned short*)(rk + (512 + c) * 2)), k = kv[nt];
        const float a = sigmoidf_(a0c[nt] + acc[2][nt][j]);
        const float kk = k * kkc[nt] * inv;
        const float kp = k * (1.f + (a - 1.f) * kac[nt]);
        const float bq = kk * a;
        const float xf = -(w0f[nt] + acc[0][nt][j]); const float spf = fmaxf(xf, 0.f) + log1pf(__expf(-fabsf(xf)));
        const float xb = -(w0b[nt] + acc[1][nt][j]); const float spb = fmaxf(xb, 0.f) + log1pf(__expf(-fabsf(xb)));
        const float ef = __expf(-spf - 0.5f), eb = __expf(-spb - 0.5f);
        const float d_f = -expm1f(-ef), d_b = -expm1f(-eb);
        const size_t o = row * 256 + c;
        S[o] = (bf16_t)f2bf(r); S[SU + o] = (bf16_t)f2bf(kp); S[2 * SU + o] = (bf16_t)f2bf(v); S[3 * SU + o] = (bf16_t)f2bf(kk);
        S[4 * SU + o] = (bf16_t)f2bf(bq); S[5 * SU + o] = (bf16_t)f2bf(d_f); S[6 * SU + o] = (bf16_t)f2bf(d_b);
        Gs[o] = (bf16_t)f2bf(acc[3][nt][j]); Gs[SU + o] = (bf16_t)f2bf(acc[4][nt][j]);
      }
    }
  }
}

DI long scan_row(int b, int dir, int s) {
  if (s < CL) return (long)ML + b * CL + (dir ? (CL - 1 - s) : s);
  int t = s - CL; return (long)b * SL + (dir ? (SL - 1 - t) : t);
}
DI void ph_scan(const Params& p, char* smem) {
  const int tid = my_tid(), lane = tid & 63, wid = tid >> 6;
  const bf16_t* S = (const bf16_t*)(p.ws + R_STR);
  const size_t SU = (size_t)MT * 256;
  constexpr int T = 32, NSTEP = CL + SL, NCH = NSTEP / T;
  for (int u = blockIdx.x; u < 256; u += gridDim.x) {
    const int chain = u >> 2, rg = u & 3; const int dir = chain & 1, bh = chain >> 1, b = bh >> 2, h = bh & 3;
    bf16_t* O = (bf16_t*)(p.ws + (dir ? R_OB : R_OF));
    uint4 q0, q1, q2;
    auto SC_GLOAD = [&](int ci) {
#pragma unroll
      for (int j = 0; j < 3; ++j) {
        int idx = tid + j * 512; int st = idx >> 8, s = (idx & 255) >> 3, ck = idx & 7;
        long row = scan_row(b, dir, ci * T + s);
        int sid = st < 5 ? st : 5 + dir;
        uint4 v = *(const uint4*)(S + sid * SU + row * 256 + h * 64 + ck * 8);
        if (j == 0) q0 = v; else if (j == 1) q1 = v; else q2 = v;
      }
    };
    auto SC_SSTORE = [&](int buf) {
#pragma unroll
      for (int j = 0; j < 3; ++j) {
        int idx = tid + j * 512; int st = idx >> 8;
        uint4 v = j == 0 ? q0 : (j == 1 ? q1 : q2);
        float4 lo = make_float4(bflo(v.x), bfhi(v.x), bflo(v.y), bfhi(v.y));
        float4 hi = make_float4(bflo(v.z), bfhi(v.z), bflo(v.w), bfhi(v.w));
        if (st == 5) { lo.x = 1.f - lo.x; lo.y = 1.f - lo.y; lo.z = 1.f - lo.z; lo.w = 1.f - lo.w; hi.x = 1.f - hi.x; hi.y = 1.f - hi.y; hi.z = 1.f - hi.z; hi.w = 1.f - hi.w; }
        char* base = smem + buf * 49152 + idx * 32;
        *(float4*)(base) = lo; *(float4*)(base + 16) = hi;
      }
    };
    auto FLUSH = [&](int ci) {
      int j = tid - 256; int s = j >> 3, part = j & 7;
      unsigned v = *(const unsigned*)(smem + 98304 + (ci & 1) * 1024 + s * 32 + part * 4);
      long row = scan_row(b, dir, ci * T + s);
      *(unsigned*)(O + row * 256 + h * 64 + rg * 16 + part * 2) = v;
    };
    __syncthreads();
    SC_GLOAD(0);
    SC_SSTORE(0);
    __syncthreads();
    float s0 = 0.f, s1 = 0.f, s2 = 0.f, s3 = 0.f;
    const int rsub = lane >> 4, ks = lane & 15;
    const int lrow = (wid & 3) * 4 + rsub;
    const int vrow = rg * 16 + lrow;
    for (int ci = 0; ci < NCH; ++ci) {
      if (ci + 1 < NCH) { SC_GLOAD(ci + 1); }
      if (wid < 4) {
        const char* B = smem + (ci & 1) * 49152;
        bf16_t* ob = (bf16_t*)(smem + 98304 + (ci & 1) * 1024);
        float4 nr = *(const float4*)(B + (0 * T + 0) * 256 + ks * 16);
        float4 nk = *(const float4*)(B + (1 * T + 0) * 256 + ks * 16);
        float nv = *(const float*)(B + (2 * T + 0) * 256 + vrow * 4);
        float4 nkk = *(const float4*)(B + (3 * T + 0) * 256 + ks * 16);
        float4 nb = *(const float4*)(B + (4 * T + 0) * 256 + ks * 16);
        float4 nw = *(const float4*)(B + (5 * T + 0) * 256 + ks * 16);
#pragma unroll 2
        for (int s = 0; s < T; ++s) {
          const float4 cr = nr, ck = nk, ckk = nkk, cb = nb, cw = nw; const float cv = nv;
          const int sn = (s + 1 < T) ? s + 1 : s;
          nr = *(const float4*)(B + (0 * T + sn) * 256 + ks * 16);
          nk = *(const float4*)(B + (1 * T + sn) * 256 + ks * 16);
          nv = *(const float*)(B + (2 * T + sn) * 256 + vrow * 4);
          nkk = *(const float4*)(B + (3 * T + sn) * 256 + ks * 16);
          nb = *(const float4*)(B + (4 * T + sn) * 256 + ks * 16);
          nw = *(const float4*)(B + (5 * T + sn) * 256 + ks * 16);
          float sa = -((s0 * ckk.x + s1 * ckk.y) + (s2 * ckk.z + s3 * ckk.w));
          sa = sum16(sa);
          s0 = s0 * cw.x + sa * cb.x + cv * ck.x;
          s1 = s1 * cw.y + sa * cb.y + cv * ck.y;
          s2 = s2 * cw.z + sa * cb.z + cv * ck.z;
          s3 = s3 * cw.w + sa * cb.w + cv * ck.w;
          float o = (s0 * cr.x + s1 * cr.y) + (s2 * cr.z + s3 * cr.w);
          o = sum16(o);
          if (ks == 0) ob[s * 16 + lrow] = (bf16_t)f2bf(o);
        }
      } else if (ci > 0) {
        FLUSH(ci - 1);
      }
      if (ci + 1 < NCH) { SC_SSTORE((ci + 1) & 1); }
      __syncthreads();
    }
    if (wid >= 4) FLUSH(NCH - 1);
  }
}

template <bool DIFF>
DI void attn_unit(const Params& p, int l, int b, int h, int qrow0, int qpos0, int kb_lo, int kb_hi, int kc_lo, char* smem) {
  const int tid = my_tid(), lane = tid & 63, wid = tid >> 6, g = lane >> 4, r16 = lane & 15;
  const bf16_t* QK = (const bf16_t*)(p.ws + (DIFF ? R_PDF : R_PSW));
  const int ldq = DIFF ? 512 : 384;
  const int qc0 = h * 64;
  const int kc0 = 256 + (DIFF ? h * 64 : (h >> 1) * 64);
  const bf16_t* VT = DIFF ? (const bf16_t*)(p.ws + R_VTDF) + ((size_t)b * 256 + h * 64) * KEYS
                          : (const bf16_t*)(p.ws + R_VTSW) + ((size_t)b * 128 + (h >> 1) * 64) * KEYS;
  const int nblk = (kb_hi - kb_lo) + (68 - kc_lo);
  const float sc = (DIFF ? 0.17677669529663687f : 0.125f) * 1.4426950408889634f;
  bf16x8 qf[2];
  {
    const bf16_t* qp = QK + (size_t)(qrow0 + wid * 16 + r16) * ldq + qc0 + g * 8;
    qf[0] = *(const bf16x8*)(qp); qf[1] = *(const bf16x8*)(qp + 32);
  }
  constexpr int NC = DIFF ? 2 : 1;
  float m[NC], lsum[NC];
  f32x4 O[NC][4];
#pragma unroll
  for (int c = 0; c < NC; ++c) {
    if (DIFF) { m[c] = -1e30f; lsum[c] = 0.f; }
    else { m[c] = p.in[16][l * 4 + h] * 1.4426950408889634f; lsum[c] = (g == 0) ? 1.f : 0.f; }
#pragma unroll
    for (int dt = 0; dt < 4; ++dt) O[c][dt] = (f32x4){0.f, 0.f, 0.f, 0.f};
  }
  const int lr = tid >> 3, lc = tid & 7;
  uint4 rk, rv;
#define AT_GLOAD(i)                                                                                   \
  do {                                                                                                \
    int kb = (i) < (kb_hi - kb_lo) ? kb_lo + (i) : kc_lo + ((i) - (kb_hi - kb_lo));                    \
    long krow = kb < 64 ? (long)b * SL + kb * 64 + lr : (long)ML + b * CL + (kb - 64) * 64 + lr;       \
    rk = *(const uint4*)(QK + krow * ldq + kc0 + lc * 8);                                             \
    rv = *(const uint4*)(VT + (size_t)lr * KEYS + kb * 64 + lc * 8);                                  \
  } while (0)
#define AT_SSTORE(buf)                                                                                \
  do {                                                                                                \
    *(uint4*)(smem + (buf) * 18432 + lr * 144 + lc * 16) = rk;                                        \
    *(uint4*)(smem + (buf) * 18432 + 9216 + lr * 144 + lc * 16) = rv;                                 \
  } while (0)
  __syncthreads();
  AT_GLOAD(0);
  AT_SSTORE(0);
  __syncthreads();
  const int qpos = qpos0 + wid * 16 + r16;
  for (int i = 0; i < nblk; ++i) {
    if (i + 1 < nblk) AT_GLOAD(i + 1);
    const int kb = i < (kb_hi - kb_lo) ? kb_lo + i : kc_lo + (i - (kb_hi - kb_lo));
    const bool masked = (!DIFF) && (kb < 64);
    const char* Kt = smem + (i & 1) * 18432; const char* Vt = Kt + 9216;
    f32x4 S[NC][4];
#pragma unroll
    for (int kt = 0; kt < 4; ++kt) {
      bf16x8 k0 = *(const bf16x8*)(Kt + (kt * 16 + r16) * 144 + g * 16);
      bf16x8 k1 = *(const bf16x8*)(Kt + (kt * 16 + r16) * 144 + 64 + g * 16);
      if (DIFF) {
        S[0][kt] = __builtin_amdgcn_mfma_f32_16x16x32_bf16(k0, qf[0], (f32x4){0.f, 0.f, 0.f, 0.f}, 0, 0, 0);
        S[NC - 1][kt] = __builtin_amdgcn_mfma_f32_16x16x32_bf16(k1, qf[1], (f32x4){0.f, 0.f, 0.f, 0.f}, 0, 0, 0);
      } else {
        f32x4 t = __builtin_amdgcn_mfma_f32_16x16x32_bf16(k0, qf[0], (f32x4){0.f, 0.f, 0.f, 0.f}, 0, 0, 0);
        S[0][kt] = __builtin_amdgcn_mfma_f32_16x16x32_bf16(k1, qf[1], t, 0, 0, 0);
      }
    }
    bf16x8 pf[NC][2];
#pragma unroll
    for (int c = 0; c < NC; ++c) {
      float mx = -1e30f;
#pragma unroll
      for (int kt = 0; kt < 4; ++kt)
#pragma unroll
        for (int j = 0; j < 4; ++j) {
          float v = S[c][kt][j] * sc;
          if (masked) { int kpos = kb * 64 + kt * 16 + g * 4 + j; int dd = kpos - qpos; if (dd > 128 || dd < -128) v = -1e30f; }
          S[c][kt][j] = v; mx = fmaxf(mx, v);
        }
      mx = fmaxf(mx, __shfl_xor(mx, 16)); mx = fmaxf(mx, __shfl_xor(mx, 32));
      float mn = fmaxf(m[c], mx);
      float alpha = __builtin_amdgcn_exp2f(m[c] - mn);
      m[c] = mn;
      float ps = 0.f;
      unsigned pk[8];
#pragma unroll
      for (int kt = 0; kt < 4; ++kt) {
        float e0 = __builtin_amdgcn_exp2f(S[c][kt][0] - mn), e1 = __builtin_amdgcn_exp2f(S[c][kt][1] - mn), e2 = __builtin_amdgcn_exp2f(S[c][kt][2] - mn), e3 = __builtin_amdgcn_exp2f(S[c][kt][3] - mn);
        ps += (e0 + e1) + (e2 + e3);
        pk[kt * 2] = pack2(e0, e1); pk[kt * 2 + 1] = pack2(e2, e3);
      }
      lsum[c] = lsum[c] * alpha + ps;
#pragma unroll
      for (int dt = 0; dt < 4; ++dt) { O[c][dt][0] *= alpha; O[c][dt][1] *= alpha; O[c][dt][2] *= alpha; O[c][dt][3] *= alpha; }
      union { unsigned u[4]; bf16x8 v; } cv;
      cv.u[0] = pk[0]; cv.u[1] = pk[1]; cv.u[2] = pk[2]; cv.u[3] = pk[3]; pf[c][0] = cv.v;
      cv.u[0] = pk[4]; cv.u[1] = pk[5]; cv.u[2] = pk[6]; cv.u[3] = pk[7]; pf[c][1] = cv.v;
    }
#pragma unroll
    for (int dt = 0; dt < 4; ++dt)
#pragma unroll
      for (int s2 = 0; s2 < 2; ++s2) {
        union { uint2 u[2]; bf16x8 v; } vf;
        vf.u[0] = *(const uint2*)(Vt + (dt * 16 + r16) * 144 + (2 * s2) * 32 + g * 8);
        vf.u[1] = *(const uint2*)(Vt + (dt * 16 + r16) * 144 + (2 * s2 + 1) * 32 + g * 8);
#pragma unroll
        for (int c = 0; c < NC; ++c) O[c][dt] = __builtin_amdgcn_mfma_f32_16x16x32_bf16(vf.v, pf[c][s2], O[c][dt], 0, 0, 0);
      }
    if (i + 1 < nblk) AT_SSTORE((i + 1) & 1);
    __syncthreads();
  }
#undef AT_GLOAD
#undef AT_SSTORE
  float linv[NC];
#pragma unroll
  for (int c = 0; c < NC; ++c) { float t = lsum[c]; t += __shfl_xor(t, 16); t += __shfl_xor(t, 32); linv[c] = 1.f / t; }
  const size_t orow = (size_t)(qrow0 + wid * 16 + r16);
  if (!DIFF) {
    bf16_t* Y = (bf16_t*)(p.ws + R_YSW);
#pragma unroll
    for (int dt = 0; dt < 4; ++dt) {
      uint2 o; o.x = pack2(O[0][dt][0] * linv[0], O[0][dt][1] * linv[0]); o.y = pack2(O[0][dt][2] * linv[0], O[0][dt][3] * linv[0]);
      *(uint2*)(Y + orow * 256 + h * 64 + dt * 16 + g * 4) = o;
    }
  } else {
    const float lam_init = 0.8f - 0.6f * __expf(-0.3f * (float)l);
    float d1 = 0.f, d2 = 0.f;
    if (lane < 32) { d1 = p.in[28][l * 32 + lane] * p.in[29][l * 32 + lane]; d2 = p.in[30][l * 32 + lane] * p.in[31][l * 32 + lane]; }
    d1 = wave_sum(d1); d2 = wave_sum(d2);
    const float lam = expf(d1) - expf(d2) + lam_init;
    float ov[4][4]; float ss = 0.f;
#pragma unroll
    for (int dt = 0; dt < 4; ++dt)
#pragma unroll
      for (int j = 0; j < 4; ++j) { float v = O[0][dt][j] * linv[0] - lam * O[NC - 1][dt][j] * linv[NC - 1]; ov[dt][j] = v; ss += v * v; }
    ss += __shfl_xor(ss, 16); ss += __shfl_xor(ss, 32);
    const float rms = rsqrtf(ss * (1.f / 64.f) + 1e-5f) * (1.f - lam_init);
    const float* sg = p.in[32] + l * 64;
    bf16_t* Y = (bf16_t*)(p.ws + R_YDF);
#pragma unroll
    for (int dt = 0; dt < 4; ++dt) {
      const int d0 = dt * 16 + g * 4;
      uint2 o; o.x = pack2(ov[dt][0] * rms * sg[d0], ov[dt][1] * rms * sg[d0 + 1]); o.y = pack2(ov[dt][2] * rms * sg[d0 + 2], ov[dt][3] * rms * sg[d0 + 3]);
      *(uint2*)(Y + orow * 256 + h * 64 + d0) = o;
    }
  }
}

DI void ph_attn(const Params& p, int l, char* smem) {
  const bool need_ctx = (l == 0);
  const int n_sw = 1024 + (need_ctx ? 64 : 0);
  const int n_df = 1024 + (need_ctx ? 64 : 0);
  for (int u = blockIdx.x; u < n_sw + n_df; u += gridDim.x) {
    if (u < n_df) {
      if (u < 1024) { int b = u >> 7, h = (u >> 5) & 3, n = u & 31; attn_unit<true>(p, l, b, h, b * SL + n * 128, n * 128, 0, 64, 64, smem); }
      else { int v = u - 1024; int b = v >> 3, h = (v >> 1) & 3, n = v & 1; attn_unit<true>(p, l, b, h, ML + b * CL + n * 128, 0, 0, 0, 64, smem); }
    } else {
      int w = u - n_df;
      if (w < 1024) {
        int b = w >> 7, h = (w >> 5) & 3, n = w & 31;
        int lo = (n - 1) * 2; if (lo < 0) lo = 0; int hi = (n + 2) * 2; if (hi > 64) hi = 64;
        attn_unit<false>(p, l, b, h, b * SL + n * 128, n * 128, lo, hi, 64, smem);
      } else { int v = w - 1024; int b = v >> 3, h = (v >> 1) & 3, n = v & 1; attn_unit<false>(p, l, b, h, ML + b * CL + n * 128, 0, 0, 0, 64, smem); }
    }
  }
}

DI void ph_rwout(const Params& p, int l) {
  const int lane = my_tid() & 63, wid = my_tid() >> 6;
  const bf16_t* S = (const bf16_t*)(p.ws + R_STR); const bf16_t* Gs = (const bf16_t*)(p.ws + R_G);
  const bf16_t* OF = (const bf16_t*)(p.ws + R_OF); const bf16_t* OB = (const bf16_t*)(p.ws + R_OB);
  bf16_t* Y = (bf16_t*)(p.ws + R_YRW);
  const size_t SU = (size_t)MT * 256;
  const float4 rk = *(const float4*)(p.in[25] + (size_t)l * 256 + lane * 4);
  const float4 gam = *(const float4*)(p.in[26] + (size_t)l * 256 + lane * 4);
  const float4 bet = *(const float4*)(p.in[27] + (size_t)l * 256 + lane * 4);
  const int nrows = (l == 0) ? MT : ML;
  for (int row = blockIdx.x * 8 + wid; row < nrows; row += gridDim.x * 8) {
    const size_t o = (size_t)row * 256 + lane * 4;
    uint2 ur = *(const uint2*)(S + o), uk = *(const uint2*)(S + SU + o), uv = *(const uint2*)(S + 2 * SU + o);
    uint2 uf = *(const uint2*)(OF + o), ub = *(const uint2*)(OB + o), ugf = *(const uint2*)(Gs + o), ugb = *(const uint2*)(Gs + SU + o);
    float r[4] = {bflo(ur.x), bfhi(ur.x), bflo(ur.y), bfhi(ur.y)};
    float k[4] = {bflo(uk.x), bfhi(uk.x), bflo(uk.y), bfhi(uk.y)};
    float v[4] = {bflo(uv.x), bfhi(uv.x), bflo(uv.y), bfhi(uv.y)};
    float f[4] = {bflo(uf.x), bfhi(uf.x), bflo(uf.y), bfhi(uf.y)};
    float bb[4] = {bflo(ub.x), bfhi(ub.x), bflo(ub.y), bfhi(ub.y)};
    float gf[4] = {bflo(ugf.x), bfhi(ugf.x), bflo(ugf.y), bfhi(ugf.y)};
    float gb[4] = {bflo(ugb.x), bfhi(ugb.x), bflo(ugb.y), bfhi(ugb.y)};
    const float rkv[4] = {rk.x, rk.y, rk.z, rk.w}; const float ga[4] = {gam.x, gam.y, gam.z, gam.w}; const float be[4] = {bet.x, bet.y, bet.z, bet.w};
    float bon = 0.f, sf = 0.f, sb = 0.f;
#pragma unroll
    for (int i = 0; i < 4; ++i) { bon += r[i] * k[i] * rkv[i]; sf += f[i]; sb += bb[i]; }
    bon = sum16(bon); float muf = sum16(sf) * (1.f / 64.f), mub = sum16(sb) * (1.f / 64.f);
    float qf = 0.f, qb = 0.f;
#pragma unroll
    for (int i = 0; i < 4; ++i) { f[i] -= muf; bb[i] -= mub; qf += f[i] * f[i]; qb += bb[i] * bb[i]; }
    float rsf = rsqrtf(sum16(qf) * (1.f / 64.f) + 64e-5f), rsb = rsqrtf(sum16(qb) * (1.f / 64.f) + 64e-5f);
    float y[4];
#pragma unroll
    for (int i = 0; i < 4; ++i) {
      float bn = bon * v[i];
      y[i] = (f[i] * rsf * ga[i] + be[i] + bn) * gf[i] + (bb[i] * rsb * ga[i] + be[i] + bn) * gb[i];
    }
    uint2 oo; oo.x = pack2(y[0], y[1]); oo.y = pack2(y[2], y[3]);
    *(uint2*)(Y + o) = oo;
  }
}

DI void ph_merge(const Params& p, int l, char* smem) {
  const bf16_t* U = (const bf16_t*)(p.ws + R_URE);
  const int lane = my_tid() & 63, wid = my_tid() >> 6, wm = wid >> 1, wn = wid & 1, g = lane >> 4, r16 = lane & 15;
  const int mtiles = (l == 0) ? 136 : 128;
  bf16_t* ACC = (bf16_t*)(p.ws + R_ACC);
  for (int it = 0;; ++it) {
    int mtile, ntile;
    if (!next_tile(it, mtiles, 8, mtile, ntile)) break;
    uint2 accS[4][4];
#pragma unroll
    for (int mt = 0; mt < 4; ++mt)
#pragma unroll
      for (int nt = 0; nt < 4; ++nt) accS[mt][nt] = make_uint2(0u, 0u);
    for (int j = 0; j < 4; ++j) {
      uint2 pb[4][4];
      {
        f32x4 accB[4][4]; zero_acc<4>(accB);
        const size_t yoff = (j == 0) ? R_YHY : (j == 1) ? R_YSW : (j == 2) ? R_YRW : R_YDF;
        gemm_main<4, false>(accB, (const bf16_t*)(p.ws + yoff), 256, RowPlain{(long)mtile * 256}, (const bf16_t*)(p.ws + WB_BR) + ((size_t)j * 1024 + ntile * 128) * 256, 256, 256, smem);
#pragma unroll
        for (int mt = 0; mt < 4; ++mt)
#pragma unroll
          for (int nt = 0; nt < 4; ++nt) { pb[mt][nt].x = pack2(accB[mt][nt][0], accB[mt][nt][1]); pb[mt][nt].y = pack2(accB[mt][nt][2], accB[mt][nt][3]); }
      }
      f32x4 accG[4][4]; zero_acc<4>(accG);
      gemm_main<4, false>(accG, U, 1024, RowPlain{(long)mtile * 256}, (const bf16_t*)(p.ws + WB_GATE) + ((size_t)j * 1024 + ntile * 128) * 1024, 1024, 1024, smem);
#pragma unroll
      for (int mt = 0; mt < 4; ++mt)
#pragma unroll
        for (int nt = 0; nt < 4; ++nt) {
          float v0 = bflo(accS[mt][nt].x) + sigmoidf_(accG[mt][nt][0]) * bflo(pb[mt][nt].x);
          float v1 = bfhi(accS[mt][nt].x) + sigmoidf_(accG[mt][nt][1]) * bfhi(pb[mt][nt].x);
          float v2 = bflo(accS[mt][nt].y) + sigmoidf_(accG[mt][nt][2]) * bflo(pb[mt][nt].y);
          float v3 = bfhi(accS[mt][nt].y) + sigmoidf_(accG[mt][nt][3]) * bfhi(pb[mt][nt].y);
          accS[mt][nt].x = pack2(v0, v1); accS[mt][nt].y = pack2(v2, v3);
        }
    }
#pragma unroll
    for (int mt = 0; mt < 4; ++mt)
#pragma unroll
      for (int nt = 0; nt < 4; ++nt) {
        const int col = ntile * 128 + wn * 64 + nt * 16 + r16;
        const size_t row = (size_t)mtile * 256 + wm * 64 + mt * 16 + g * 4;
        ACC[(row + 0) * 1024 + col] = (bf16_t)(accS[mt][nt].x & 0xffffu);
        ACC[(row + 1) * 1024 + col] = (bf16_t)(accS[mt][nt].x >> 16);
        ACC[(row + 2) * 1024 + col] = (bf16_t)(accS[mt][nt].y & 0xffffu);
        ACC[(row + 3) * 1024 + col] = (bf16_t)(accS[mt][nt].y >> 16);
      }
  }
}

DI void ph_resgemm(const Params& p, int l, const bf16_t* A, int K, const bf16_t* Bt, const float* hsrc_lat, const float* hsrc_ctx, int gate_off, char* smem) {
  const int lane = my_tid() & 63, wid = my_tid() >> 6, wm = wid >> 1, wn = wid & 1, g = lane >> 4, r16 = lane & 15;
  const int mtiles = (l == 0) ? 136 : 128;
  const float* mod = (const float*)(p.ws + MISC_MOD) + (size_t)l * 9 * 6144;
  float* hc = (float*)(p.ws + OFF_HC);
  for (int it = 0;; ++it) {
    int mtile, ntile;
    if (!next_tile(it, mtiles, 8, mtile, ntile)) break;
    f32x4 acc[4][4]; zero_acc<4>(acc);
    gemm_main<4, true>(acc, A, K, RowPlain{(long)mtile * 256}, Bt + (size_t)ntile * 128 * K, K, K, smem);
    const int b = mtile < 128 ? (mtile >> 4) : 8;
    const float* gt = mod + (size_t)b * 6144 + gate_off;
#pragma unroll
    for (int mt = 0; mt < 4; ++mt)
#pragma unroll
      for (int nt = 0; nt < 4; ++nt) {
        const int col = ntile * 128 + wn * 64 + nt * 16 + r16; const float gv = gt[col];
#pragma unroll
        for (int e = 0; e < 4; ++e) {
          const int row = mtile * 256 + wm * 64 + mt * 16 + g * 4 + e;
          if (row < ML) { size_t o = (size_t)row * D + col; p.out[o] = DN_ALPHA * hsrc_lat[o] + gv * acc[mt][nt][e]; }
          else { size_t o = (size_t)(row - ML) * D + col; hc[o] = DN_ALPHA * hsrc_ctx[o] + gv * acc[mt][nt][e]; }
        }
      }
  }
}

DI void ph_ffnup(const Params& p, int l, char* smem) {
  const bf16_t* U = (const bf16_t*)(p.ws + R_U);
  const bf16_t* Bt = (const bf16_t*)(p.ws + WB_UP);
  bf16_t* HID = (bf16_t*)(p.ws + R_HID);
  const float* cw = p.in[38] + (size_t)l * 3 * 5632; const float* cb = p.in[39] + (size_t)l * 5632;
  const int tid = my_tid(), lane = tid & 63, wid = tid >> 6, wm = wid >> 1, wn = wid & 1, g = lane >> 4, r16 = lane & 15;
  const int mtiles = (l == 0) ? 152 : 136;
  float* T = (float*)smem;
  for (int it = 0;; ++it) {
    int mtile, ntile;
    if (!next_tile(it, mtiles, 44, mtile, ntile)) break;
    long rowbase; int tt, len;
    if (mtile < 136) { int b = mtile / 17; tt = mtile % 17; len = SL; rowbase = (long)b * SL; }
    else { int v = mtile - 136; int b = v >> 1; tt = v & 1; len = CL; rowbase = (long)ML + b * CL; }
    f32x4 acc[4][4]; zero_acc<4>(acc);
    gemm_main<4, true>(acc, U, 1024, RowHalo{rowbase, tt * 254 - 1, len}, Bt + (size_t)ntile * 128 * 1024, 1024, 1024, smem);
#pragma unroll
    for (int mt = 0; mt < 4; ++mt)
#pragma unroll
      for (int nt = 0; nt < 4; ++nt)
#pragma unroll
        for (int e = 0; e < 4; ++e) T[(wm * 64 + mt * 16 + g * 4 + e) * 132 + wn * 64 + nt * 16 + r16] = acc[mt][nt][e];
    __syncthreads();
    {
      const int ch = tid & 63, rgp = tid >> 6; const int ca = ntile * 64 + ch, cbx = 2816 + ca;
      const float a0 = cw[ca], a1 = cw[5632 + ca], a2 = cw[2 * 5632 + ca], ab = cb[ca];
      const float b0 = cw[cbx], b1 = cw[5632 + cbx], b2 = cw[2 * 5632 + cbx], bb = cb[cbx];
      for (int r = 1 + rgp; r <= 254; r += 8) {
        int tok = tt * 254 - 1 + r;
        if (tok < len) {
          float av = a0 * T[(r - 1) * 132 + ch] + a1 * T[r * 132 + ch] + a2 * T[(r + 1) * 132 + ch] + ab;
          float bv = b0 * T[(r - 1) * 132 + 64 + ch] + b1 * T[r * 132 + 64 + ch] + b2 * T[(r + 1) * 132 + 64 + ch] + bb;
          HID[(size_t)(rowbase + tok) * 2816 + ca] = (bf16_t)f2bf(siluf_(av) * bv);
        }
      }
    }
  }
}

#ifndef REP_PREP
#define REP_PREP 1
#endif
#ifndef REP_GEMM
#define REP_GEMM 1
#endif
#ifndef REP_HY
#define REP_HY 1
#endif
#ifndef REP_RWP
#define REP_RWP 1
#endif
#ifndef REP_SCAN
#define REP_SCAN 1
#endif
#ifndef REP_ATTN
#define REP_ATTN 1
#endif
#ifndef PH_END
#define PH_END 24
#endif
#define SYNC_OR_RET(idx) do { if ((idx) + 1 >= PH_END) return; grid.sync(); } while (0)
template <int l>
DI void run_layer(const Params& p, cg::grid_group& grid, char* smem) {
  const float* mod = (const float*)(p.ws + MISC_MOD) + (size_t)l * 9 * 6144;
  float* hc = (float*)(p.ws + OFF_HC);
  const float* hl_src = (l == 0) ? p.in[0] : p.out;
  const float* hc_src = (l == 0) ? p.in[2] : hc;
  constexpr int B0 = l * 12;
  for (int rep = 0; rep < REP_PREP; ++rep) {
  ph_convert(p, l, smem);
  if (l == 0) ph_ada(p, smem);
  hy_rawfilter(p, l, SL, (float*)(p.ws + R_RAWF), smem);
  if (l == 0) hy_rawfilter(p, l, CL, (float*)(p.ws + MISC_RAWC), smem);
  }
  SYNC_OR_RET(B0 + 0);
  for (int rep = 0; rep < REP_PREP; ++rep) ph_kf(p, l, smem);
  ph_ln(hl_src, hc_src, nullptr, nullptr, nullptr, nullptr, (bf16_t*)(p.ws + R_U), mod, 0, MT);
  SYNC_OR_RET(B0 + 1);
  for (int rep = 0; rep < REP_GEMM; ++rep) ph_inproj(p, smem);
  SYNC_OR_RET(B0 + 2);
  for (int rep = 0; rep < REP_HY; ++rep) {
  ph_hyena(p, l, smem);
  if (l == 0) ph_hyena_ctx(p, l, smem);
  }
  ph_rope(p, smem);
  for (int rep = 0; rep < REP_RWP; ++rep) ph_rwprep(p, l, smem);
  SYNC_OR_RET(B0 + 3);
  for (int rep = 0; rep < REP_SCAN; ++rep) ph_scan(p, smem);
  for (int rep = 0; rep < REP_ATTN; ++rep) ph_attn(p, l, smem);
  SYNC_OR_RET(B0 + 4);
  ph_rwout(p, l);
  ph_ln(hl_src, hc_src, nullptr, nullptr, nullptr, nullptr, (bf16_t*)(p.ws + R_URE), mod, 0, l == 0 ? MT : ML);
  SYNC_OR_RET(B0 + 5);
  for (int rep = 0; rep < REP_GEMM; ++rep) ph_merge(p, l, smem);
  SYNC_OR_RET(B0 + 6);
  ph_resgemm(p, l, (const bf16_t*)(p.ws + R_ACC), 1024, (const bf16_t*)(p.ws + WB_OUT), hl_src, hc_src, 2048, smem);
  SYNC_OR_RET(B0 + 7);
  ph_ln(p.out, hc, p.out, hc, p.in[35] + (size_t)l * D, p.in[36] + (size_t)l * D, (bf16_t*)(p.ws + R_U), mod, 3072, l == 0 ? MT : ML);
  SYNC_OR_RET(B0 + 8);
  for (int rep = 0; rep < REP_GEMM; ++rep) ph_ffnup(p, l, smem);
  SYNC_OR_RET(B0 + 9);
  ph_resgemm(p, l, (const bf16_t*)(p.ws + R_HID), 2816, (const bf16_t*)(p.ws + WB_DOWN), p.out, hc, 5120, smem);
  SYNC_OR_RET(B0 + 10);
  ph_ln(p.out, hc, p.out, hc, p.in[41] + (size_t)l * D, p.in[42] + (size_t)l * D, nullptr, mod, 0, l == 0 ? MT : ML);
  SYNC_OR_RET(B0 + 11);
}

__global__ void __launch_bounds__(NTHR) mega(Params p) {
  extern __shared__ __attribute__((aligned(16))) char smem[];
  cg::grid_group grid = cg::this_grid();
  run_layer<0>(p, grid, smem);
  if (PH_END > 12) run_layer<1>(p, grid, smem);
}

extern "C" void kernel_launch(void* const* d_in, const int* in_sizes, int n_in, void* d_out, int out_size,
                              void* d_ws, size_t ws_size, hipStream_t stream) {
  static int grid_blocks = 0;
  if (!grid_blocks) {
    int dev = 0, cus = 0, per_cu = 0;
    (void)hipGetDevice(&dev);
    (void)hipDeviceGetAttribute(&cus, hipDeviceAttributeMultiprocessorCount, dev);
    (void)hipFuncSetAttribute((const void*)mega, hipFuncAttributeMaxDynamicSharedMemorySize, SMEM_BYTES);
    (void)hipOccupancyMaxActiveBlocksPerMultiprocessor(&per_cu, mega, NTHR, SMEM_BYTES);
    if (per_cu < 1) per_cu = 1;
    if (per_cu > 1) per_cu = 1;
    grid_blocks = cus * per_cu;
  }
  Params p{};
  for (int i = 0; i < 43; ++i) p.in[i] = (const float*)d_in[i];
  p.out = (float*)d_out; p.ws = (char*)d_ws;
  void* args[] = {&p};
  hipError_t e = hipLaunchCooperativeKernel((void*)mega, dim3(grid_blocks), dim3(NTHR), args, SMEM_BYTES, stream);
  if (e != hipSuccess) fprintf(stderr, "cooperative launch failed: %s (grid %d)\n", hipGetErrorString(e), grid_blocks);
}
```

```cpp
#include <hip/hip_runtime.h>
#include <hip/hip_cooperative_groups.h>
#include <cstdio>
#include <cstdint>
namespace cg = cooperative_groups;

#define DI __device__ __forceinline__
typedef unsigned short bf16_t;
typedef short bf16x8 __attribute__((ext_vector_type(8)));
typedef float f32x4 __attribute__((ext_vector_type(4)));

constexpr int D = 1024, NB = 8, SL = 4096, CL = 256;
constexpr int ML = NB * SL, MC = NB * CL, MT = ML + MC;
constexpr int KEYS = SL + CL;
constexpr int NTHR = 512;
constexpr float DN_ALPHA = 1.41421356237f;
constexpr size_t UNIT = (size_t)MT * 512;

constexpr size_t WB_IN = 0;
constexpr size_t WB_GATE = WB_IN + (size_t)3328 * 1024 * 2;
constexpr size_t WB_BR = WB_GATE + (size_t)4096 * 1024 * 2;
constexpr size_t WB_OUT = WB_BR + (size_t)4 * 1024 * 256 * 2;
constexpr size_t WB_UP = WB_OUT + (size_t)1024 * 1024 * 2;
constexpr size_t WB_DOWN = WB_UP + (size_t)5632 * 1024 * 2;
constexpr size_t WB_END = WB_DOWN + (size_t)1024 * 2816 * 2;
constexpr size_t OFF_KF = WB_END;
constexpr size_t OFF_HC = OFF_KF + (size_t)512 * 8192 * 8;
constexpr size_t OFF_MISC = OFF_HC + (size_t)MC * D * 4;
constexpr size_t MISC_MOD = OFF_MISC;
constexpr size_t MISC_TW = MISC_MOD + (size_t)2 * 9 * 6144 * 4;
constexpr size_t MISC_RAWC = MISC_TW + 4096 * 8;
constexpr size_t MISC_GCTX = MISC_RAWC + (size_t)256 * 1024 * 4;
constexpr size_t MISC_RWW = MISC_GCTX + (size_t)512 * 512 * 4;
constexpr size_t RWW_F = MISC_RWW, RWW_B = RWW_F + 256 * 64 * 2, RWW_A = RWW_B + 256 * 64 * 2, RWW_GF = RWW_A + 256 * 64 * 2, RWW_GB = RWW_GF + 256 * 128 * 2;
constexpr size_t OFF_R = OFF_MISC + (size_t)4 * 1024 * 1024;
static_assert(RWW_GB + 256 * 128 * 2 <= OFF_R, "misc overflow");
constexpr size_t R_YHY = OFF_R, R_YSW = OFF_R + UNIT, R_YDF = OFF_R + 2 * UNIT;
constexpr size_t R_PHY = OFF_R + 3 * UNIT;
constexpr size_t R_PSW = OFF_R + 6 * UNIT;
constexpr size_t R_VTSW = R_PSW + (size_t)MT * 384 * 2;
constexpr size_t R_PDF = OFF_R + 8 * UNIT;
constexpr size_t R_VTDF = OFF_R + 10 * UNIT;
constexpr size_t R_PRW = OFF_R + 11 * UNIT;
constexpr size_t R_STR = R_PRW + (size_t)MT * 1216 * 2;
constexpr size_t R_G = R_STR + 7 * UNIT;
constexpr size_t R_END = R_G + 2 * UNIT;
constexpr size_t R_RAWF = OFF_R;
constexpr size_t R_OF = R_PHY, R_OB = R_PHY + UNIT;
constexpr size_t R_URE = R_PSW;
constexpr size_t R_YRW = R_VTDF;
constexpr size_t R_ACC = R_PRW;
constexpr size_t R_U = R_STR;
constexpr size_t R_HID = OFF_R;
static_assert(R_END <= (size_t)512 * 1024 * 1024, "ws overflow");
static_assert((size_t)MT * 2816 * 2 <= 11 * UNIT, "hid");

constexpr int SMEM_BYTES = 136 * 1024;

struct Params {
  const float* in[43];
  float* out;
  char* ws;
};

DI int my_tid() { int t = (int)__builtin_amdgcn_workitem_id_x(); asm volatile("" : "+v"(t)); return t; }
DI unsigned f2bf(float f) { unsigned u = __float_as_uint(f); u += 0x7fffu + ((u >> 16) & 1u); return u >> 16; }
DI float bf2f(unsigned h) { return __uint_as_float(h << 16); }
typedef __bf16 bf16v2_t __attribute__((ext_vector_type(2)));
typedef float f32v2_t __attribute__((ext_vector_type(2)));
DI unsigned pack2(float lo, float hi) { f32v2_t v = {lo, hi}; bf16v2_t b = __builtin_convertvector(v, bf16v2_t); return __builtin_bit_cast(unsigned, b); }

DI float bflo(unsigned w) { return __uint_as_float(w << 16); }
DI float bfhi(unsigned w) { return __uint_as_float(w & 0xffff0000u); }
DI float sigmoidf_(float x) { return 1.f / (1.f + __expf(-x)); }
DI float siluf_(float x) { return x / (1.f + __expf(-x)); }
DI float wave_sum(float v) {
#pragma unroll
  for (int o = 32; o >= 1; o >>= 1) v += __shfl_xor(v, o);
  return v;
}
template <int CTRL> DI float dpp_mov(float v) {
  return __int_as_float(__builtin_amdgcn_update_dpp(0, __float_as_int(v), CTRL, 0xf, 0xf, false));
}
DI float sum16(float v) {
  v += dpp_mov<0xB1>(v);
  v += dpp_mov<0x4E>(v);
  v += dpp_mov<0x141>(v);
  v += dpp_mov<0x140>(v);
  return v;
}
DI void lds_barrier() { asm volatile("s_waitcnt lgkmcnt(0)" ::: "memory"); __builtin_amdgcn_s_barrier(); asm volatile("" ::: "memory"); }
DI uint4 sel4(bool z, uint4 v) { return make_uint4(z ? 0u : v.x, z ? 0u : v.y, z ? 0u : v.z, z ? 0u : v.w); }
DI int mod_idx(int row) { return row < ML ? (row >> 12) : 8; }

template <int NTW, bool DEEP, class RowFn>
DI void gemm_main(f32x4 (&acc)[4][NTW], const bf16_t* __restrict__ A, int lda, RowFn rowfn,
                  const bf16_t* __restrict__ Bt, int ldb, int K, char* smem) {
  constexpr int BN = NTW * 32;
  constexpr int A_BYTES = 256 * 144, B_BYTES = BN * 144, STAGE = A_BYTES + B_BYTES;
  constexpr int NBL = BN / 64;
  const int tid = my_tid(), lane = tid & 63, wid = tid >> 6, wm = wid >> 1, wn = wid & 1, g = lane >> 4, r16 = lane & 15;
  const int chunk = tid & 7, lrow = tid >> 3;
  long a0 = rowfn(lrow), a1 = rowfn(lrow + 64), a2 = rowfn(lrow + 128), a3 = rowfn(lrow + 192);
  const long c0 = a0 < 0 ? 0 : a0, c1 = a1 < 0 ? 0 : a1, c2 = a2 < 0 ? 0 : a2, c3 = a3 < 0 ? 0 : a3;
  const bf16_t* Bp = Bt + (long)lrow * ldb + chunk * 8;
  const bf16_t* Ap0 = A + c0 * lda + chunk * 8; const bf16_t* Ap1 = A + c1 * lda + chunk * 8;
  const bf16_t* Ap2 = A + c2 * lda + chunk * 8; const bf16_t* Ap3 = A + c3 * lda + chunk * 8;
  struct Regs { uint4 a0, a1, a2, a3, b0, b1; };
  Regs R0, R1;
  R0.b1 = make_uint4(0, 0, 0, 0); R1.b1 = make_uint4(0, 0, 0, 0);
  auto GLOAD = [&](Regs& R, int k0) {
    R.a0 = *(const uint4*)(Ap0 + k0); R.a1 = *(const uint4*)(Ap1 + k0);
    R.a2 = *(const uint4*)(Ap2 + k0); R.a3 = *(const uint4*)(Ap3 + k0);
    R.b0 = *(const uint4*)(Bp + k0);
    if constexpr (NBL > 1) R.b1 = *(const uint4*)(Bp + (long)64 * ldb + k0);
  };
  auto SSTORE = [&](const Regs& R, int st) {
    char* base = smem + st * STAGE + lrow * 144 + chunk * 16;
    *(uint4*)(base) = sel4(a0 < 0, R.a0); *(uint4*)(base + 64 * 144) = sel4(a1 < 0, R.a1);
    *(uint4*)(base + 128 * 144) = sel4(a2 < 0, R.a2); *(uint4*)(base + 192 * 144) = sel4(a3 < 0, R.a3);
    *(uint4*)(base + A_BYTES) = R.b0;
    if constexpr (NBL > 1) *(uint4*)(base + A_BYTES + 64 * 144) = R.b1;
  };
  auto COMPUTE = [&](int st) {
    const char* As = smem + st * STAGE + (wm * 64 + r16) * 144 + g * 16;
    const char* Bs = smem + st * STAGE + A_BYTES + (wn * (NTW * 16) + r16) * 144 + g * 16;
#pragma unroll
    for (int kk = 0; kk < 2; ++kk) {
      bf16x8 af[4], bfr[NTW];
#pragma unroll
      for (int mt = 0; mt < 4; ++mt) af[mt] = *(const bf16x8*)(As + mt * 16 * 144 + kk * 64);
#pragma unroll
      for (int nt = 0; nt < NTW; ++nt) bfr[nt] = *(const bf16x8*)(Bs + nt * 16 * 144 + kk * 64);
#pragma unroll
      for (int mt = 0; mt < 4; ++mt)
#pragma unroll
        for (int nt = 0; nt < NTW; ++nt)
          acc[mt][nt] = __builtin_amdgcn_mfma_f32_16x16x32_bf16(af[mt], bfr[nt], acc[mt][nt], 0, 0, 0);
    }
  };
  const int nk = K >> 6;
  __syncthreads();
  GLOAD(R0, 0);
  SSTORE(R0, 0);
  if constexpr (DEEP) {
    GLOAD(R0, 64);
    if (nk > 2) GLOAD(R1, 128);
    lds_barrier();
    for (int kt = 0; kt < nk; kt += 2) {
      COMPUTE(0);
      __builtin_amdgcn_sched_barrier(0);
      SSTORE(R0, 1);
      if (kt + 3 < nk) GLOAD(R0, (kt + 3) * 64);
      lds_barrier();
      COMPUTE(1);
      __builtin_amdgcn_sched_barrier(0);
      if (kt + 2 < nk) SSTORE(R1, 0);
      if (kt + 4 < nk) GLOAD(R1, (kt + 4) * 64);
      lds_barrier();
    }
  } else {
    lds_barrier();
    for (int kt = 0; kt < nk; ++kt) {
      const int st = kt & 1;
      if (kt + 1 < nk) GLOAD(R0, (kt + 1) * 64);
      __builtin_amdgcn_sched_barrier(0);
      COMPUTE(st);
      __builtin_amdgcn_sched_barrier(0);
      if (kt + 1 < nk) SSTORE(R0, st ^ 1);
      lds_barrier();
    }
  }
}

DI bool next_tile(int i, int MTILES, int NTILES, int& mt, int& nt) {
  const int xcd = blockIdx.x & 7, slot = blockIdx.x >> 3, nslot = gridDim.x >> 3;
  const int m_lo = (MTILES * xcd) >> 3, m_hi = (MTILES * (xcd + 1)) >> 3, Mloc = m_hi - m_lo;
  const int q = i * nslot + slot;
  if (q >= Mloc * NTILES) return false;
  const int gidx = q / (4 * NTILES), m0 = gidx * 4;
  const int rows = (Mloc - m0) < 4 ? (Mloc - m0) : 4;
  const int within = q - gidx * 4 * NTILES;
  nt = within / rows; mt = m_lo + m0 + within % rows;
  return true;
}

struct RowPlain { long base; DI long operator()(int r) const { return base + r; } };
struct RowHalo { long rowbase; int t0; int len; DI long operator()(int r) const { int t = t0 + r; return (t >= 0 && t < len) ? rowbase + t : -1; } };

template <int NTW> DI void zero_acc(f32x4 (&acc)[4][NTW]) {
#pragma unroll
  for (int i = 0; i < 4; ++i)
#pragma unroll
    for (int j = 0; j < NTW; ++j) acc[i][j] = (f32x4){0.f, 0.f, 0.f, 0.f};
}

DI void cvt_unit(const float* __restrict__ src, int ldsrc, int srccol0, int k0, bf16_t* __restrict__ dst, int K, int n0, char* smem, bool perm = true) {
  float* T = (float*)smem;
  const int tid = my_tid();
  __syncthreads();
  if (srccol0 >= 0) {
#pragma unroll
    for (int i = 0; i < 8; ++i) {
      int idx = tid + i * 512; int k = idx >> 6, n = idx & 63;
      T[k * 65 + n] = src[(long)(k0 + k) * ldsrc + srccol0 + n];
    }
  }
  __syncthreads();
  int nd = tid >> 3, kc = (tid & 7) * 8; int n = perm ? ((nd & 15) * 4 + (nd >> 4)) : nd;
  uint4 o = make_uint4(0, 0, 0, 0);
  if (srccol0 >= 0) {
    o.x = pack2(T[(kc + 0) * 65 + n], T[(kc + 1) * 65 + n]);
    o.y = pack2(T[(kc + 2) * 65 + n], T[(kc + 3) * 65 + n]);
    o.z = pack2(T[(kc + 4) * 65 + n], T[(kc + 5) * 65 + n]);
    o.w = pack2(T[(kc + 6) * 65 + n], T[(kc + 7) * 65 + n]);
  }
  *(uint4*)(dst + (long)(n0 + nd) * K + k0 + kc) = o;
}

DI void ph_convert(const Params& p, int l, char* smem) {
  for (int u = blockIdx.x; u < 4508; u += gridDim.x) {
    if (u < 832) {
      int gI = u >> 4, kt = u & 15; int n0 = gI * 64; int sc;
      if (n0 < 1280) sc = n0; else if (n0 < 2048) sc = 2496 + (n0 - 1280); else if (n0 < 3264) sc = 1280 + (n0 - 2048); else sc = -1;
      cvt_unit(p.in[6] + (size_t)l * 1024 * 7360, 7360, sc, kt * 64, (bf16_t*)(p.ws + WB_IN), 1024, n0, smem);
    } else if (u < 1856) {
      int v = u - 832; int gI = v >> 4, kt = v & 15;
      cvt_unit(p.in[6] + (size_t)l * 1024 * 7360, 7360, 3264 + gI * 64, kt * 64, (bf16_t*)(p.ws + WB_GATE), 1024, gI * 64, smem);
    } else if (u < 2112) {
      int v = u - 1856; int gI = v >> 2, kt = v & 3; int j = gI >> 4, gg = gI & 15;
      cvt_unit(p.in[33] + ((size_t)l * 4 + j) * 256 * 1024, 1024, gg * 64, kt * 64, (bf16_t*)(p.ws + WB_BR) + (size_t)j * 1024 * 256, 256, gg * 64, smem);
    } else if (u < 2368) {
      int v = u - 2112; int gI = v >> 4, kt = v & 15;
      cvt_unit(p.in[34] + (size_t)l * 1024 * 1024, 1024, gI * 64, kt * 64, (bf16_t*)(p.ws + WB_OUT), 1024, gI * 64, smem);
    } else if (u < 3776) {
      int v = u - 2368; int gI = v >> 4, kt = v & 15; int nt = gI >> 1, hb = gI & 1;
      cvt_unit(p.in[37] + (size_t)l * 1024 * 5632, 5632, hb * 2816 + nt * 64, kt * 64, (bf16_t*)(p.ws + WB_UP), 1024, gI * 64, smem);
    } else if (u < 4480) {
      int v = u - 3776; int gI = v / 44, kt = v % 44;
      cvt_unit(p.in[40] + (size_t)l * 2816 * 1024, 1024, gI * 64, kt * 64, (bf16_t*)(p.ws + WB_DOWN), 2816, gI * 64, smem);
    } else {
      int v = u - 4480;
      if (v < 4) cvt_unit(p.in[19] + (size_t)l * 2 * 64 * 256, 256, v * 64, 0, (bf16_t*)(p.ws + RWW_F), 64, v * 64, smem, false);
      else if (v < 8) cvt_unit(p.in[19] + (size_t)l * 2 * 64 * 256 + 64 * 256, 256, (v - 4) * 64, 0, (bf16_t*)(p.ws + RWW_B), 64, (v - 4) * 64, smem, false);
      else if (v < 12) cvt_unit(p.in[21] + (size_t)l * 64 * 256, 256, (v - 8) * 64, 0, (bf16_t*)(p.ws + RWW_A), 64, (v - 8) * 64, smem, false);
      else if (v < 20) { int w = v - 12; cvt_unit(p.in[22] + (size_t)l * 2 * 128 * 256, 256, (w >> 1) * 64, (w & 1) * 64, (bf16_t*)(p.ws + RWW_GF), 128, (w >> 1) * 64, smem, false); }
      else { int w = v - 20; cvt_unit(p.in[22] + (size_t)l * 2 * 128 * 256 + 128 * 256, 256, (w >> 1) * 64, (w & 1) * 64, (bf16_t*)(p.ws + RWW_GB), 128, (w >> 1) * 64, smem, false); }
    }
  }
}

DI void ph_ada(const Params& p, char* smem) {
  float* S = (float*)smem;
  float* R = S + 9 * 1024;
  const int tid = my_tid();
  bool loaded = false;
  for (int u = blockIdx.x; u < 192; u += gridDim.x) {
    if (!loaded) {
      __syncthreads();
      for (int i = tid; i < 9 * 1024; i += NTHR) { float c = i < 8192 ? p.in[1][i] : p.in[3][i - 8192]; S[i] = siluf_(c); }
      loaded = true;
    }
    __syncthreads();
    int l = u / 96, n0 = (u % 96) * 64;
    int col = tid & 63, ks = tid >> 6;
    const float* W = p.in[4] + (size_t)l * 1024 * 6144 + n0 + col;
    float a[9];
#pragma unroll
    for (int b = 0; b < 9; ++b) a[b] = 0.f;
    for (int k = ks * 128; k < ks * 128 + 128; ++k) {
      float w = W[(size_t)k * 6144];
#pragma unroll
      for (int b = 0; b < 9; ++b) a[b] += S[b * 1024 + k] * w;
    }
#pragma unroll
    for (int b = 0; b < 9; ++b) R[(ks * 9 + b) * 64 + col] = a[b];
    __syncthreads();
    for (int i = tid; i < 9 * 64; i += NTHR) {
      int b = i >> 6, c = i & 63; float s = 0.f;
#pragma unroll
      for (int k2 = 0; k2 < 8; ++k2) s += R[(k2 * 9 + b) * 64 + c];
      s += p.in[5][(size_t)l * 6144 + n0 + c];
      ((float*)(p.ws + MISC_MOD))[((size_t)l * 9 + b) * 6144 + n0 + c] = s;
    }
  }
  for (int i = blockIdx.x * NTHR + tid; i < 4096; i += gridDim.x * NTHR) {
    float s, c; sincospif(-(float)i / 4096.f, &s, &c);
    ((float2*)(p.ws + MISC_TW))[i] = make_float2(c, s);
  }
}

DI void hy_rawfilter(const Params& p, int l, int Lf, float* __restrict__ dst, char* smem) {
  float* W1 = (float*)smem;
  float* W2 = W1 + 33 * 64;
  float* Z = W2 + 64 * 64;
  float* H1 = Z + 16 * 36;
  float* H2 = H1 + 16 * 64;
  const int tid = my_tid();
  const float* w1 = p.in[9] + (size_t)l * 33 * 64; const float* b1 = p.in[10] + l * 64;
  const float* w2 = p.in[11] + (size_t)l * 64 * 64; const float* b2 = p.in[12] + l * 64;
  const float* w3 = p.in[13] + (size_t)l * 64 * 1024; const float* fr = p.in[14] + l * 64;
  const int nunits = Lf / 16;
  bool loaded = false;
  for (int u = blockIdx.x; u < nunits; u += gridDim.x) {
    __syncthreads();
    if (!loaded) {
      for (int i = tid; i < 33 * 64; i += NTHR) W1[i] = w1[i];
      for (int i = tid; i < 64 * 64; i += NTHR) W2[i] = w2[i];
      loaded = true;
    }
    const int t0 = u * 16;
    for (int i = tid; i < 16 * 33; i += NTHR) {
      int tt = i / 33, f = i % 33; int t = t0 + tt; float v;
      if (f == 0) v = (float)t / (float)(Lf - 1);
      else {
        int bi = (f - 1) & 15;
        float wv = 6.283185307179586f * (float)t / (float)Lf;
        float fb = 1e-4f + (15.f - 1e-4f) * (float)bi / 15.f;
        float ang = wv * fb;
        v = (f <= 16) ? cosf(ang) : -sinf(ang);
      }
      Z[tt * 36 + f] = v;
    }
    __syncthreads();
    for (int i = tid; i < 16 * 64; i += NTHR) {
      int tt = i >> 6, f = i & 63; float s = b1[f];
      for (int k = 0; k < 33; ++k) s += Z[tt * 36 + k] * W1[k * 64 + f];
      H1[tt * 64 + f] = sinf(fr[f] * s);
    }
    __syncthreads();
    for (int i = tid; i < 16 * 64; i += NTHR) {
      int tt = i >> 6, f = i & 63; float s = b2[f];
      for (int k = 0; k < 64; ++k) s += H1[tt * 64 + k] * W2[k * 64 + f];
      H2[tt * 64 + f] = sinf(fr[f] * s);
    }
    __syncthreads();
    float a0[16], a1[16];
#pragma unroll
    for (int i = 0; i < 16; ++i) { a0[i] = 0.f; a1[i] = 0.f; }
    for (int k = 0; k < 64; ++k) {
      float wa = w3[k * 1024 + tid], wb = w3[k * 1024 + 512 + tid];
#pragma unroll
      for (int i = 0; i < 16; ++i) { float h = H2[i * 64 + k]; a0[i] += h * wa; a1[i] += h * wb; }
    }
    {
      int w = tid & 255;
      float delta = fabsf(-3.0701134573253944f + (-15.350567286626972f + 3.0701134573253944f) * (float)w / 255.f);
#pragma unroll
      for (int i = 0; i < 16; ++i) {
        float tn = (float)(t0 + i) / (float)(Lf - 1);
        float dec = expf(-tn * delta);
        dst[(size_t)(t0 + i) * 1024 + tid] = a0[i] * dec;
        dst[(size_t)(t0 + i) * 1024 + 512 + tid] = a1[i] * dec;
      }
    }
  }
}

DI float2 cmul(float2 a, float2 b) { return make_float2(a.x * b.x - a.y * b.y, a.x * b.y + a.y * b.x); }
DI float2 cmulc(float2 a, float2 b) { return make_float2(a.x * b.x + a.y * b.y, a.y * b.x - a.x * b.y); }
DI void fft_dif(float2* X, const float2* W) {
  const int tid = my_tid();
  for (int ls = 12; ls >= 0; --ls) {
    const int span = 1 << ls;
    __syncthreads();
#pragma unroll
    for (int i = 0; i < 8; ++i) {
      int bf = tid + i * 512; int pos = bf & (span - 1); int i0 = ((bf >> ls) << (ls + 1)) + pos; int i1 = i0 + span;
      float2 a = X[i0], b = X[i1]; float2 w = W[pos << (12 - ls)];
      X[i0] = make_float2(a.x + b.x, a.y + b.y);
      X[i1] = cmul(make_float2(a.x - b.x, a.y - b.y), w);
    }
  }
  __syncthreads();
}
DI void fft_dit_inv(float2* X, const float2* W) {
  const int tid = my_tid();
  for (int ls = 0; ls <= 12; ++ls) {
    const int span = 1 << ls;
    __syncthreads();
#pragma unroll
    for (int i = 0; i < 8; ++i) {
      int bf = tid + i * 512; int pos = bf & (span - 1); int i0 = ((bf >> ls) << (ls + 1)) + pos; int i1 = i0 + span;
      float2 a = X[i0], b = X[i1]; float2 w = W[pos << (12 - ls)];
      float2 t = cmulc(b, w);
      X[i0] = make_float2(a.x + t.x, a.y + t.y);
      X[i1] = make_float2(a.x - t.x, a.y - t.y);
    }
  }
  __syncthreads();
}
DI void load_twiddles(const Params& p, float2* W) {
  const float2* tw = (const float2*)(p.ws + MISC_TW);
  for (int i = my_tid(); i < 4096; i += NTHR) W[i] = tw[i];
}

DI void ph_kf(const Params& p, int l, char* smem) {
  float2* X = (float2*)smem; float2* W = X + 8192; float* red = (float*)(W + 4096);
  const int tid = my_tid(), lane = tid & 63, wid = tid >> 6;
  const float* rawf = (const float*)(p.ws + R_RAWF);
  float2* kf = (float2*)(p.ws + OFF_KF);
  bool tw = false;
  for (int u = blockIdx.x; u < 256; u += gridDim.x) {
    if (!tw) { load_twiddles(p, W); tw = true; }
    const int o = u >> 7, c = (u & 127) * 2;
    float2 fw[8], bw[8]; float sa = 0.f, sb = 0.f;
#pragma unroll
    for (int i = 0; i < 8; ++i) {
      int t = tid + i * 512;
      fw[i] = *(const float2*)(rawf + (size_t)t * 1024 + o * 512 + c);
      bw[i] = *(const float2*)(rawf + (size_t)t * 1024 + o * 512 + 256 + c);
      sa += fabsf(fw[i].x) + fabsf(bw[i].x); sb += fabsf(fw[i].y) + fabsf(bw[i].y);
    }
    sa = wave_sum(sa); sb = wave_sum(sb);
    __syncthreads();
    if (lane == 0) { red[wid * 2] = sa; red[wid * 2 + 1] = sb; }
    __syncthreads();
    float ta = 0.f, tb = 0.f;
#pragma unroll
    for (int w = 0; w < 8; ++w) { ta += red[w * 2]; tb += red[w * 2 + 1]; }
    const float ia = 1.f / ta, ib = 1.f / tb;
#pragma unroll
    for (int i = 0; i < 8; ++i) {
      int t = tid + i * 512;
      X[t] = make_float2(fw[i].x * ia, fw[i].y * ib);
      if (t >= 1) X[8192 - t] = make_float2(bw[i].x * ia, bw[i].y * ib);
      else X[4096] = make_float2(0.f, 0.f);
    }
    fft_dif(X, W);
    float2* ka = kf + (size_t)(o * 256 + c) * 8192; float2* kb = ka + 8192;
#pragma unroll 4
    for (int i = 0; i < 16; ++i) {
      int pidx = tid + i * 512;
      int k = (int)(__brev((unsigned)pidx) >> 19);
      int k2 = (8192 - k) & 8191;
      int p2 = (int)(__brev((unsigned)k2) >> 19);
      float2 c1 = X[pidx], c2 = X[p2];
      float2 A = make_float2(0.5f * (c1.x + c2.x), 0.5f * (c1.y - c2.y));
      float2 Bv = make_float2(0.5f * (c1.y + c2.y), -0.5f * (c1.x - c2.x));
      ka[pidx] = A; kb[pidx] = Bv;
    }
    __syncthreads();
  }
  if (l == 0) {
    const float* rawc = (const float*)(p.ws + MISC_RAWC);
    float* G = (float*)(p.ws + MISC_GCTX);
    for (int u = blockIdx.x * 8 + wid; u < 512; u += gridDim.x * 8) {
      int o = u >> 8, c = u & 255; float f[4], b[4]; float s = 0.f;
#pragma unroll
      for (int i = 0; i < 4; ++i) {
        int t = lane + i * 64;
        f[i] = rawc[(size_t)t * 1024 + o * 512 + c]; b[i] = rawc[(size_t)t * 1024 + o * 512 + 256 + c];
        s += fabsf(f[i]) + fabsf(b[i]);
      }
      s = wave_sum(s); float inv = 1.f / s;
#pragma unroll
      for (int i = 0; i < 4; ++i) {
        int t = lane + i * 64;
        G[(size_t)u * 512 + 256 + t] = f[i] * inv;
        if (t >= 1) G[(size_t)u * 512 + 256 - t] = b[i] * inv;
      }
      if (lane == 0) G[(size_t)u * 512] = 0.f;
    }
  }
}

DI void ph_ln(const float* __restrict__ src_lat, const float* __restrict__ src_ctx, float* dst_lat, float* dst_ctx,
              const float* __restrict__ ag, const float* __restrict__ ab, bf16_t* U, const float* __restrict__ mod, int sh_off, int nrows) {
  const int lane = my_tid() & 63, wid = my_tid() >> 6;
  for (int row = blockIdx.x * 8 + wid; row < nrows; row += gridDim.x * 8) {
    const float* src = row < ML ? src_lat + (size_t)row * D : src_ctx + (size_t)(row - ML) * D;
    float4 v[4];
#pragma unroll
    for (int i = 0; i < 4; ++i) v[i] = *(const float4*)(src + i * 256 + lane * 4);
    float s = 0.f;
#pragma unroll
    for (int i = 0; i < 4; ++i) s += v[i].x + v[i].y + v[i].z + v[i].w;
    float mu = wave_sum(s) * (1.f / 1024.f);
    float q = 0.f;
#pragma unroll
    for (int i = 0; i < 4; ++i) { v[i].x -= mu; v[i].y -= mu; v[i].z -= mu; v[i].w -= mu; q += v[i].x * v[i].x + v[i].y * v[i].y + v[i].z * v[i].z + v[i].w * v[i].w; }
    float rs = rsqrtf(wave_sum(q) * (1.f / 1024.f) + 1e-6f);
#pragma unroll
    for (int i = 0; i < 4; ++i) { v[i].x *= rs; v[i].y *= rs; v[i].z *= rs; v[i].w *= rs; }
    if (ag) {
      float* dst = row < ML ? dst_lat + (size_t)row * D : dst_ctx + (size_t)(row - ML) * D;
#pragma unroll
      for (int i = 0; i < 4; ++i) {
        float4 gg = *(const float4*)(ag + i * 256 + lane * 4), bb = *(const float4*)(ab + i * 256 + lane * 4);
        v[i].x = v[i].x * gg.x + bb.x; v[i].y = v[i].y * gg.y + bb.y; v[i].z = v[i].z * gg.z + bb.z; v[i].w = v[i].w * gg.w + bb.w;
        *(float4*)(dst + i * 256 + lane * 4) = v[i];
      }
      if (U) {
        s = 0.f;
#pragma unroll
        for (int i = 0; i < 4; ++i) s += v[i].x + v[i].y + v[i].z + v[i].w;
        mu = wave_sum(s) * (1.f / 1024.f); q = 0.f;
#pragma unroll
        for (int i = 0; i < 4; ++i) { v[i].x -= mu; v[i].y -= mu; v[i].z -= mu; v[i].w -= mu; q += v[i].x * v[i].x + v[i].y * v[i].y + v[i].z * v[i].z + v[i].w * v[i].w; }
        rs = rsqrtf(wave_sum(q) * (1.f / 1024.f) + 1e-6f);
#pragma unroll
        for (int i = 0; i < 4; ++i) { v[i].x *= rs; v[i].y *= rs; v[i].z *= rs; v[i].w *= rs; }
      }
    }
    if (U) {
      const float* m = mod + (size_t)mod_idx(row) * 6144 + sh_off;
#pragma unroll
      for (int i = 0; i < 4; ++i) {
        float4 sh = *(const float4*)(m + i * 256 + lane * 4), sc = *(const float4*)(m + 1024 + i * 256 + lane * 4);
        uint2 o; o.x = pack2(v[i].x * (1.f + sc.x) + sh.x, v[i].y * (1.f + sc.y) + sh.y);
        o.y = pack2(v[i].z * (1.f + sc.z) + sh.z, v[i].w * (1.f + sc.w) + sh.w);
        *(uint2*)(U + (size_t)row * D + i * 256 + lane * 4) = o;
      }
    }
  }
}

DI void ph_inproj(const Params& p, char* smem) {
  const bf16_t* U = (const bf16_t*)(p.ws + R_U);
  const bf16_t* Bt = (const bf16_t*)(p.ws + WB_IN);
  const int lane = my_tid() & 63, wid = my_tid() >> 6, wm = wid >> 1, wn = wid & 1, g = lane >> 4, r16 = lane & 15;
  for (int it = 0;; ++it) {
    int mtile, ntile;
    if (!next_tile(it, 136, 26, mtile, ntile)) break;
    f32x4 acc[4][4]; zero_acc<4>(acc);
    gemm_main<4, true>(acc, U, 1024, RowPlain{(long)mtile * 256}, Bt + (size_t)ntile * 128 * 1024, 1024, 1024, smem);
    int b, key0;
    if (mtile < 128) { b = mtile >> 4; key0 = (mtile & 15) * 256; } else { b = mtile - 128; key0 = SL; }
    bf16_t* tbase = nullptr; int tcols = 0, tcol0 = 0;
    if (ntile < 6) { tbase = (bf16_t*)(p.ws + R_PHY); tcols = 768; tcol0 = ntile * 128; }
    else if (ntile == 9) { tbase = (bf16_t*)(p.ws + R_VTSW); tcols = 128; tcol0 = 0; }
    else if (ntile == 14 || ntile == 15) { tbase = (bf16_t*)(p.ws + R_VTDF); tcols = 256; tcol0 = (ntile - 14) * 128; }
    if (tbase) {
#pragma unroll
      for (int mt = 0; mt < 4; ++mt)
#pragma unroll
        for (int nt = 0; nt < 4; ++nt) {
          int col = tcol0 + wn * 64 + r16 * 4 + nt;
          int key = key0 + wm * 64 + mt * 16 + g * 4;
          uint2 o; o.x = pack2(acc[mt][nt][0], acc[mt][nt][1]); o.y = pack2(acc[mt][nt][2], acc[mt][nt][3]);
          *(uint2*)(tbase + ((size_t)b * tcols + col) * KEYS + key) = o;
        }
    } else {
      bf16_t* rb; int ld, c0, cmax;
      if (ntile < 9) { rb = (bf16_t*)(p.ws + R_PSW); ld = 384; c0 = (ntile - 6) * 128; cmax = 384; }
      else if (ntile < 14) { rb = (bf16_t*)(p.ws + R_PDF); ld = 512; c0 = (ntile - 10) * 128; cmax = 512; }
      else { rb = (bf16_t*)(p.ws + R_PRW); ld = 1216; c0 = (ntile - 16) * 128; cmax = 1216; }
      const int col = c0 + wn * 64 + r16 * 4;
      if (col < cmax) {
#pragma unroll
        for (int mt = 0; mt < 4; ++mt)
#pragma unroll
          for (int j = 0; j < 4; ++j) {
            size_t row = (size_t)mtile * 256 + wm * 64 + mt * 16 + g * 4 + j;
            uint2 o; o.x = pack2(acc[mt][0][j], acc[mt][1][j]); o.y = pack2(acc[mt][2][j], acc[mt][3][j]);
            *(uint2*)(rb + row * ld + col) = o;
          }
      }
    }
  }
}

DI float hy_conv3(const bf16_t* __restrict__ P, int t, int len, float w0, float w1, float w2, float bias) {
  float a = t >= 1 ? bf2f(P[t - 1]) : 0.f, b = bf2f(P[t]), c = (t + 1 < len) ? bf2f(P[t + 1]) : 0.f;
  return w0 * a + w1 * b + w2 * c + bias;
}
DI void ph_hyena(const Params& p, int l, char* smem) {
  float2* X = (float2*)smem; float2* W = X + 8192;
  const int tid = my_tid();
  const bf16_t* PT = (const bf16_t*)(p.ws + R_PHY);
  const float2* kf = (const float2*)(p.ws + OFF_KF);
  const float* cw = p.in[7] + (size_t)l * 3 * 768; const float* cb = p.in[8] + (size_t)l * 768;
  const float* hb = p.in[15] + (size_t)l * 512;
  bf16_t* Y = (bf16_t*)(p.ws + R_YHY);
  bool tw = false;
  for (int u = blockIdx.x; u < 1024; u += gridDim.x) {
    if (!tw) { load_twiddles(p, W); tw = true; }
    const int bp = u >> 8, c = u & 255; const int b0 = bp * 2, b1 = b0 + 1;
    const bf16_t* P0 = PT + ((size_t)b0 * 768) * KEYS; const bf16_t* P1 = PT + ((size_t)b1 * 768) * KEYS;
    float wv0 = cw[c], wv1 = cw[768 + c], wv2 = cw[1536 + c], bv = cb[c];
    float wa0 = cw[256 + c], wa1 = cw[768 + 256 + c], wa2 = cw[1536 + 256 + c], ba = cb[256 + c];
    float wb0 = cw[512 + c], wb1 = cw[768 + 512 + c], wb2 = cw[1536 + 512 + c], bb = cb[512 + c];
    const float bias0 = hb[c], bias1 = hb[256 + c];
    float2 vv[8];
    __syncthreads();
#pragma unroll
    for (int i = 0; i < 8; ++i) {
      int t = tid + i * 512;
      vv[i].x = hy_conv3(P0 + (size_t)c * KEYS, t, SL, wv0, wv1, wv2, bv);
      vv[i].y = hy_conv3(P1 + (size_t)c * KEYS, t, SL, wv0, wv1, wv2, bv);
      X[t] = vv[i]; X[t + 4096] = make_float2(0.f, 0.f);
    }
    fft_dif(X, W);
    {
      const float2* H = kf + (size_t)c * 8192;
#pragma unroll 4
      for (int i = 0; i < 16; ++i) { int q = tid + i * 512; X[q] = cmul(X[q], H[q]); }
    }
    fft_dit_inv(X, W);
    float2 zz[8];
#pragma unroll
    for (int i = 0; i < 8; ++i) {
      int t = tid + i * 512;
      float2 y = X[t];
      float x1a = hy_conv3(P0 + (size_t)(256 + c) * KEYS, t, SL, wa0, wa1, wa2, ba);
      float x1b = hy_conv3(P1 + (size_t)(256 + c) * KEYS, t, SL, wa0, wa1, wa2, ba);
      zz[i].x = x1a * (y.x * (1.f / 8192.f) + bias0 * vv[i].x);
      zz[i].y = x1b * (y.y * (1.f / 8192.f) + bias0 * vv[i].y);
    }
    __syncthreads();
#pragma unroll
    for (int i = 0; i < 8; ++i) { int t = tid + i * 512; X[t] = zz[i]; X[t + 4096] = make_float2(0.f, 0.f); }
    fft_dif(X, W);
    {
      const float2* H = kf + (size_t)(256 + c) * 8192;
#pragma unroll 4
      for (int i = 0; i < 16; ++i) { int q = tid + i * 512; X[q] = cmul(X[q], H[q]); }
    }
    fft_dit_inv(X, W);
#pragma unroll
    for (int i = 0; i < 8; ++i) {
      int t = tid + i * 512;
      float2 y = X[t];
      float x2a = hy_conv3(P0 + (size_t)(512 + c) * KEYS, t, SL, wb0, wb1, wb2, bb);
      float x2b = hy_conv3(P1 + (size_t)(512 + c) * KEYS, t, SL, wb0, wb1, wb2, bb);
      float oa = x2a * (y.x * (1.f / 8192.f) + bias1 * zz[i].x);
      float ob = x2b * (y.y * (1.f / 8192.f) + bias1 * zz[i].y);
      Y[((size_t)b0 * SL + t) * 256 + c] = (bf16_t)f2bf(oa);
      Y[((size_t)b1 * SL + t) * 256 + c] = (bf16_t)f2bf(ob);
    }
  }
}

DI void ph_hyena_ctx(const Params& p, int l, char* smem) {
  const int tid = my_tid(), lane = tid & 63, wid = tid >> 6;
  float* Zb = (float*)smem + wid * 1024;
  float* Gb = Zb + 256;
  const bf16_t* PT = (const bf16_t*)(p.ws + R_PHY);
  const float* G = (const float*)(p.ws + MISC_GCTX);
  const float* cw = p.in[7] + (size_t)l * 3 * 768; const float* cb = p.in[8] + (size_t)l * 768;
  const float* hb = p.in[15] + (size_t)l * 512;
  bf16_t* Y = (bf16_t*)(p.ws + R_YHY);
  for (int base = blockIdx.x * 8; base < 2048; base += gridDim.x * 8) {
    const int u = base + wid; const int b = u >> 8, c = u & 255;
    const bf16_t* Pb = PT + ((size_t)b * 768) * KEYS + SL;
    float v[4], x1[4], x2[4], zz[4];
#pragma unroll
    for (int i = 0; i < 4; ++i) {
      int t = lane + i * 64;
      v[i] = hy_conv3(Pb + (size_t)c * KEYS, t, CL, cw[c], cw[768 + c], cw[1536 + c], cb[c]);
      x1[i] = hy_conv3(Pb + (size_t)(256 + c) * KEYS, t, CL, cw[256 + c], cw[768 + 256 + c], cw[1536 + 256 + c], cb[256 + c]);
      x2[i] = hy_conv3(Pb + (size_t)(512 + c) * KEYS, t, CL, cw[512 + c], cw[768 + 512 + c], cw[1536 + 512 + c], cb[512 + c]);
    }
    __syncthreads();
#pragma unroll
    for (int i = 0; i < 4; ++i) Zb[lane + i * 64] = v[i];
    for (int i = lane; i < 512; i += 64) Gb[i] = G[(size_t)c * 512 + i];
    __syncthreads();
#pragma unroll
    for (int i = 0; i < 4; ++i) {
      int t = lane + i * 64; float s = 0.f;
      for (int s2 = 0; s2 < 256; ++s2) s += Gb[256 + t - s2] * Zb[s2];
      zz[i] = x1[i] * (s + hb[c] * v[i]);
    }
    __syncthreads();
#pragma unroll
    for (int i = 0; i < 4; ++i) Zb[lane + i * 64] = zz[i];
    for (int i = lane; i < 512; i += 64) Gb[i] = G[(size_t)(256 + c) * 512 + i];
    __syncthreads();
#pragma unroll
    for (int i = 0; i < 4; ++i) {
      int t = lane + i * 64; float s = 0.f;
      for (int s2 = 0; s2 < 256; ++s2) s += Gb[256 + t - s2] * Zb[s2];
      float o = x2[i] * (s + hb[256 + c] * zz[i]);
      Y[((size_t)ML + b * CL + t) * 256 + c] = (bf16_t)f2bf(o);
    }
  }
}

DI void ph_rope(const Params& p, char* smem) {
  float2* T16 = (float2*)smem;
  float2* T8 = T16 + 64 * 16;
  const int tid = my_tid(), lane = tid & 63, wid = tid >> 6;
  __syncthreads();
  for (int i = tid; i < 64 * 16; i += NTHR) {
    int pos = i >> 4, f = i & 15; float inv = powf(10000.f, -(float)f / 16.f); float s, c; sincosf((float)pos * inv, &s, &c);
    T16[i] = make_float2(c, s);
  }
  for (int i = tid; i < 64 * 8; i += NTHR) {
    int pos = i >> 3, f = i & 7; float inv = powf(10000.f, -(float)f / 8.f); float s, c; sincosf((float)pos * inv, &s, &c);
    T8[i] = make_float2(c, s);
  }
  __syncthreads();
  bf16_t* Psw = (bf16_t*)(p.ws + R_PSW); bf16_t* Pdf = (bf16_t*)(p.ws + R_PDF);
  for (int row = blockIdx.x * 8 + wid; row < ML; row += gridDim.x * 8) {
    const int t = row & (SL - 1); const int pr = t >> 6, pc = t & 63;
    bf16_t* q = Psw + (size_t)row * 384;
#pragma unroll
    for (int i = 0; i < 3; ++i) {
      int pi = lane + i * 64; int hd = pi >> 5, pp = pi & 31; int half = pp >> 4, f = pp & 15;
      int base = hd * 64 + half * 32; float2 cs = T16[(half ? pc : pr) * 16 + f];
      float x1 = bf2f(q[base + f]), x2 = bf2f(q[base + 16 + f]);
      q[base + f] = (bf16_t)f2bf(x1 * cs.x - x2 * cs.y); q[base + 16 + f] = (bf16_t)f2bf(x1 * cs.y + x2 * cs.x);
    }
    bf16_t* d = Pdf + (size_t)row * 512;
#pragma unroll
    for (int i = 0; i < 4; ++i) {
      int pi = lane + i * 64; int gi = pi >> 4, pp = pi & 15; int half = pp >> 3, f = pp & 7;
      int base = gi * 32 + half * 16; float2 cs = T8[(half ? pc : pr) * 8 + f];
      float x1 = bf2f(d[base + f]), x2 = bf2f(d[base + 8 + f]);
      d[base + f] = (bf16_t)f2bf(x1 * cs.x - x2 * cs.y); d[base + 8 + f] = (bf16_t)f2bf(x1 * cs.y + x2 * cs.x);
    }
  }
}

DI float rw_shift(const bf16_t* __restrict__ P, int row, int t, int len, int col, float mu) {
  float c = bf2f(P[(size_t)row * 1216 + col]);
  float a = t >= 1 ? bf2f(P[(size_t)(row - 1) * 1216 + col]) : 0.f;
  float b = t + 1 < len ? bf2f(P[(size_t)(row + 1) * 1216 + col]) : 0.f;
  return c + (0.5f * (a + b) - c) * mu;
}
DI void ph_rwprep(const Params& p, int l, char* smem) {
  constexpr int AST = 912, RST = 1552, ROFF = 32 * AST;
  const int tid = my_tid(), lane = tid & 63, wid = tid >> 6, g = lane >> 4, r16 = lane & 15;
  const int tg = wid >> 2, hd = wid & 3;
  const bf16_t* P = (const bf16_t*)(p.ws + R_PRW);
  const float* mu = p.in[17] + (size_t)l * 1216;
  const float* w0 = p.in[18] + (size_t)l * 512; const float* a0 = p.in[20] + (size_t)l * 256;
  const float* kkw = p.in[23] + (size_t)l * 256; const float* kaw = p.in[24] + (size_t)l * 256;
  bf16_t* S = (bf16_t*)(p.ws + R_STR); bf16_t* Gs = (bf16_t*)(p.ws + R_G);
  const size_t SU = (size_t)MT * 256;
  float w0f[4], w0b[4], a0c[4], kkc[4], kac[4];
#pragma unroll
  for (int nt = 0; nt < 4; ++nt) { int c = hd * 64 + nt * 16 + r16; w0f[nt] = w0[c]; w0b[nt] = w0[256 + c]; a0c[nt] = a0[c]; kkc[nt] = kkw[c]; kac[nt] = kaw[c]; }
  for (int u = blockIdx.x; u < MT / 32; u += gridDim.x) {
    const int row0 = u * 32; int t0, len;
    if (row0 < ML) { t0 = row0 & (SL - 1); len = SL; } else { t0 = (row0 - ML) & (CL - 1); len = CL; }
    __syncthreads();
    for (int item = tid; item < 32 * 152; item += NTHR) {
      const int tk = item / 152, c8 = item - tk * 152; const int row = row0 + tk, t = t0 + tk;
      const uint4 uc = *(const uint4*)(P + (size_t)row * 1216 + c8 * 8);
      uint4 ua = make_uint4(0, 0, 0, 0), ub = make_uint4(0, 0, 0, 0);
      if (t >= 1) ua = *(const uint4*)(P + (size_t)(row - 1) * 1216 + c8 * 8);
      if (t + 1 < len) ub = *(const uint4*)(P + (size_t)(row + 1) * 1216 + c8 * 8);
      const float4 m0 = *(const float4*)(mu + c8 * 8), m1 = *(const float4*)(mu + c8 * 8 + 4);
      float o[8];
      {
        const unsigned wc[4] = {uc.x, uc.y, uc.z, uc.w}, wa[4] = {ua.x, ua.y, ua.z, ua.w}, wb[4] = {ub.x, ub.y, ub.z, ub.w};
        const float mm[8] = {m0.x, m0.y, m0.z, m0.w, m1.x, m1.y, m1.z, m1.w};
#pragma unroll
        for (int i = 0; i < 4; ++i) {
          float c_lo = bflo(wc[i]), c_hi = bfhi(wc[i]);
          o[2 * i] = c_lo + (0.5f * (bflo(wa[i]) + bflo(wb[i])) - c_lo) * mm[2 * i];
          o[2 * i + 1] = c_hi + (0.5f * (bfhi(wa[i]) + bfhi(wb[i])) - c_hi) * mm[2 * i + 1];
        }
      }
      char* dst;
      if (c8 < 96) dst = smem + ROFF + tk * RST + c8 * 16;
      else {
        const int cc = c8 * 8 - 768;
        if (cc < 128) {
#pragma unroll
          for (int i = 0; i < 8; ++i) o[i] = tanhf(o[i]);
        } else if (cc >= 192) {
#pragma unroll
          for (int i = 0; i < 8; ++i) o[i] = sigmoidf_(o[i]);
        }
        dst = smem + tk * AST + cc * 2;
      }
      uint4 ov; ov.x = pack2(o[0], o[1]); ov.y = pack2(o[2], o[3]); ov.z = pack2(o[4], o[5]); ov.w = pack2(o[6], o[7]);
      *(uint4*)dst = ov;
    }
    __syncthreads();
    f32x4 acc[5][4];
#pragma unroll
    for (int o5 = 0; o5 < 5; ++o5)
#pragma unroll
      for (int nt = 0; nt < 4; ++nt) acc[o5][nt] = (f32x4){0.f, 0.f, 0.f, 0.f};
    const char* Arow = smem + (tg * 16 + r16) * AST + g * 16;
#pragma unroll
    for (int o5 = 0; o5 < 5; ++o5) {
      const int kbase = o5 < 3 ? o5 * 64 : (o5 == 3 ? 192 : 320);
      const int KK = o5 < 3 ? 64 : 128;
      const bf16_t* Wt = (const bf16_t*)(p.ws + (o5 == 0 ? RWW_F : o5 == 1 ? RWW_B : o5 == 2 ? RWW_A : o5 == 3 ? RWW_GF : RWW_GB));
#pragma unroll
      for (int ks = 0; ks < KK / 32; ++ks) {
        const bf16x8 af = *(const bf16x8*)(Arow + (kbase + ks * 32) * 2);
#pragma unroll
        for (int nt = 0; nt < 4; ++nt) {
          const bf16x8 bf = *(const bf16x8*)(Wt + (size_t)(hd * 64 + nt * 16 + r16) * KK + ks * 32 + g * 8);
          acc[o5][nt] = __builtin_amdgcn_mfma_f32_16x16x32_bf16(af, bf, acc[o5][nt], 0, 0, 0);
        }
        if (ks & 1) asm volatile("" ::: "memory");
      }
    }
#pragma unroll
    for (int j = 0; j < 4; ++j) {
      const int tk = tg * 16 + g * 4 + j; const size_t row = (size_t)row0 + tk;
      const char* rk = smem + ROFF + tk * RST;
      float kv[4], n2 = 0.f;
#pragma unroll
      for (int nt = 0; nt < 4; ++nt) { int c = hd * 64 + nt * 16 + r16; kv[nt] = bf2f(*(const unsigned short*)(rk + (256 + c) * 2)); float q = kv[nt] * kkc[nt]; n2 += q * q; }
      n2 = sum16(n2);
      const float inv = 1.f / fmaxf(sqrtf(n2), 1e-12f);
#pragma unroll
      for (int nt = 0; nt < 4; ++nt) {
        const int c = hd * 64 + nt * 16 + r16;
        const float r = bf2f(*(const unsigned short*)(rk + c * 2)), v = bf2f(*(const unsigned short*)(rk + (512 + c) * 2)), k = kv[nt];
        const float a = sigmoidf_(a0c[nt] + acc[2][nt][j]);
        const float kk = k * kkc[nt] * inv;
        const float kp = k * (1.f + (a - 1.f) * kac[nt]);
        const float bq = kk * a;
        const float xf = -(w0f[nt] + acc[0][nt][j]); const float spf = fmaxf(xf, 0.f) + log1pf(__expf(-fabsf(xf)));
        const float xb = -(w0b[nt] + acc[1][nt][j]); const float spb = fmaxf(xb, 0.f) + log1pf(__expf(-fabsf(xb)));
        const float ef = __expf(-spf - 0.5f), eb = __expf(-spb - 0.5f);
        const float d_f = -expm1f(-ef), d_b = -expm1f(-eb);
        const size_t o = row * 256 + c;
        S[o] = (bf16_t)f2bf(r); S[SU + o] = (bf16_t)f2bf(kp); S[2 * SU + o] = (bf16_t)f2bf(v); S[3 * SU + o] = (bf16_t)f2bf(kk);
        S[4 * SU + o] = (bf16_t)f2bf(bq); S[5 * SU + o] = (bf16_t)f2bf(d_f); S[6 * SU + o] = (bf16_t)f2bf(d_b);
        Gs[o] = (bf16_t)f2bf(acc[3][nt][j]); Gs[SU + o] = (bf16_t)f2bf(acc[4][nt][j]);
      }
    }
  }
}

DI long scan_row(int b, int dir, int s) {
  if (s < CL) return (long)ML + b * CL + (dir ? (CL - 1 - s) : s);
  int t = s - CL; return (long)b * SL + (dir ? (SL - 1 - t) : t);
}
DI void ph_scan(const Params& p, char* smem) {
  const int tid = my_tid(), lane = tid & 63, wid = tid >> 6;
  const bf16_t* S = (const bf16_t*)(p.ws + R_STR);
  const size_t SU = (size_t)MT * 256;
  constexpr int T = 32, NSTEP = CL + SL, NCH = NSTEP / T;
  for (int u = blockIdx.x; u < 256; u += gridDim.x) {
    const int chain = u >> 2, rg = u & 3; const int dir = chain & 1, bh = chain >> 1, b = bh >> 2, h = bh & 3;
    bf16_t* O = (bf16_t*)(p.ws + (dir ? R_OB : R_OF));
    uint4 q0, q1, q2;
    auto SC_GLOAD = [&](int ci) {
#pragma unroll
      for (int j = 0; j < 3; ++j) {
        int idx = tid + j * 512; int st = idx >> 8, s = (idx & 255) >> 3, ck = idx & 7;
        long row = scan_row(b, dir, ci * T + s);
        int sid = st < 5 ? st : 5 + dir;
        uint4 v = *(const uint4*)(S + sid * SU + row * 256 + h * 64 + ck * 8);
        if (j == 0) q0 = v; else if (j == 1) q1 = v; else q2 = v;
      }
    };
    auto SC_SSTORE = [&](int buf) {
#pragma unroll
      for (int j = 0; j < 3; ++j) {
        int idx = tid + j * 512; int st = idx >> 8;
        uint4 v = j == 0 ? q0 : (j == 1 ? q1 : q2);
        float4 lo = make_float4(bflo(v.x), bfhi(v.x), bflo(v.y), bfhi(v.y));
        float4 hi = make_float4(bflo(v.z), bfhi(v.z), bflo(v.w), bfhi(v.w));
        if (st == 5) { lo.x = 1.f - lo.x; lo.y = 1.f - lo.y; lo.z = 1.f - lo.z; lo.w = 1.f - lo.w; hi.x = 1.f - hi.x; hi.y = 1.f - hi.y; hi.z = 1.f - hi.z; hi.w = 1.f - hi.w; }
        char* base = smem + buf * 49152 + idx * 32;
        *(float4*)(base) = lo; *(float4*)(base + 16) = hi;
      }
    };
    auto FLUSH = [&](int ci) {
      int j = tid - 256; int s = j >> 3, part = j & 7;
      unsigned v = *(const unsigned*)(smem + 98304 + (ci & 1) * 1024 + s * 32 + part * 4);
      long row = scan_row(b, dir, ci * T + s);
      *(unsigned*)(O + row * 256 + h * 64 + rg * 16 + part * 2) = v;
    };
    __syncthreads();
    SC_GLOAD(0);
    SC_SSTORE(0);
    __syncthreads();
    float s0 = 0.f, s1 = 0.f, s2 = 0.f, s3 = 0.f;
    const int rsub = lane >> 4, ks = lane & 15;
    const int lrow = (wid & 3) * 4 + rsub;
    const int vrow = rg * 16 + lrow;
    for (int ci = 0; ci < NCH; ++ci) {
      if (ci + 1 < NCH) { SC_GLOAD(ci + 1); }
      if (wid < 4) {
        const char* B = smem + (ci & 1) * 49152;
        bf16_t* ob = (bf16_t*)(smem + 98304 + (ci & 1) * 1024);
        float4 nr = *(const float4*)(B + (0 * T + 0) * 256 + ks * 16);
        float4 nk = *(const float4*)(B + (1 * T + 0) * 256 + ks * 16);
        float nv = *(const float*)(B + (2 * T + 0) * 256 + vrow * 4);
        float4 nkk = *(const float4*)(B + (3 * T + 0) * 256 + ks * 16);
        float4 nb = *(const float4*)(B + (4 * T + 0) * 256 + ks * 16);
        float4 nw = *(const float4*)(B + (5 * T + 0) * 256 + ks * 16);
#pragma unroll 2
        for (int s = 0; s < T; ++s) {
          const float4 cr = nr, ck = nk, ckk = nkk, cb = nb, cw = nw; const float cv = nv;
          const int sn = (s + 1 < T) ? s + 1 : s;
          nr = *(const float4*)(B + (0 * T + sn) * 256 + ks * 16);
          nk = *(const float4*)(B + (1 * T + sn) * 256 + ks * 16);
          nv = *(const float*)(B + (2 * T + sn) * 256 + vrow * 4);
          nkk = *(const float4*)(B + (3 * T + sn) * 256 + ks * 16);
          nb = *(const float4*)(B + (4 * T + sn) * 256 + ks * 16);
          nw = *(const float4*)(B + (5 * T + sn) * 256 + ks * 16);
          float sa = -((s0 * ckk.x + s1 * ckk.y) + (s2 * ckk.z + s3 * ckk.w));
          sa = sum16(sa);
          s0 = s0 * cw.x + sa * cb.x + cv * ck.x;
          s1 = s1 * cw.y + sa * cb.y + cv * ck.y;
          s2 = s2 * cw.z + sa * cb.z + cv * ck.z;
          s3 = s3 * cw.w + sa * cb.w + cv * ck.w;
          float o = (s0 * cr.x + s1 * cr.y) + (s2 * cr.z + s3 * cr.w);
          o = sum16(o);
          if (ks == 0) ob[s * 16 + lrow] = (bf16_t)f2bf(o);
        }
      } else if (ci > 0) {
        FLUSH(ci - 1);
      }
      if (ci + 1 < NCH) { SC_SSTORE((ci + 1) & 1); }
      __syncthreads();
    }
    if (wid >= 4) FLUSH(NCH - 1);
  }
}

template <bool DIFF>
DI void attn_unit(const Params& p, int l, int b, int h, int qrow0, int qpos0, int kb_lo, int kb_hi, int kc_lo, char* smem) {
  const int tid = my_tid(), lane = tid & 63, wid = tid >> 6, g = lane >> 4, r16 = lane & 15;
  const bf16_t* QK = (const bf16_t*)(p.ws + (DIFF ? R_PDF : R_PSW));
  const int ldq = DIFF ? 512 : 384;
  const int qc0 = h * 64;
  const int kc0 = 256 + (DIFF ? h * 64 : (h >> 1) * 64);
  const bf16_t* VT = DIFF ? (const bf16_t*)(p.ws + R_VTDF) + ((size_t)b * 256 + h * 64) * KEYS
                          : (const bf16_t*)(p.ws + R_VTSW) + ((size_t)b * 128 + (h >> 1) * 64) * KEYS;
  const int nblk = (kb_hi - kb_lo) + (68 - kc_lo);
  const float sc = (DIFF ? 0.17677669529663687f : 0.125f) * 1.4426950408889634f;
  bf16x8 qf[2];
  {
    const bf16_t* qp = QK + (size_t)(qrow0 + wid * 16 + r16) * ldq + qc0 + g * 8;
    qf[0] = *(const bf16x8*)(qp); qf[1] = *(const bf16x8*)(qp + 32);
  }
  constexpr int NC = DIFF ? 2 : 1;
  float m[NC], lsum[NC];
  f32x4 O[NC][4];
#pragma unroll
  for (int c = 0; c < NC; ++c) {
    if (DIFF) { m[c] = -1e30f; lsum[c] = 0.f; }
    else { m[c] = p.in[16][l * 4 + h] * 1.4426950408889634f; lsum[c] = (g == 0) ? 1.f : 0.f; }
#pragma unroll
    for (int dt = 0; dt < 4; ++dt) O[c][dt] = (f32x4){0.f, 0.f, 0.f, 0.f};
  }
  const int lr = tid >> 3, lc = tid & 7;
  uint4 rk, rv;
#define AT_GLOAD(i)                                                                                   \
  do {                                                                                                \
    int kb = (i) < (kb_hi - kb_lo) ? kb_lo + (i) : kc_lo + ((i) - (kb_hi - kb_lo));                    \
    long krow = kb < 64 ? (long)b * SL + kb * 64 + lr : (long)ML + b * CL + (kb - 64) * 64 + lr;       \
    rk = *(const uint4*)(QK + krow * ldq + kc0 + lc * 8);                                             \
    rv = *(const uint4*)(VT + (size_t)lr * KEYS + kb * 64 + lc * 8);                                  \
  } while (0)
#define AT_SSTORE(buf)                                                                                \
  do {                                                                                                \
    *(uint4*)(smem + (buf) * 18432 + lr * 144 + lc * 16) = rk;                                        \
    *(uint4*)(smem + (buf) * 18432 + 9216 + lr * 144 + lc * 16) = rv;                                 \
  } while (0)
  __syncthreads();
  AT_GLOAD(0);
  AT_SSTORE(0);
  __syncthreads();
  const int qpos = qpos0 + wid * 16 + r16;
  for (int i = 0; i < nblk; ++i) {
    if (i + 1 < nblk) AT_GLOAD(i + 1);
    const int kb = i < (kb_hi - kb_lo) ? kb_lo + i : kc_lo + (i - (kb_hi - kb_lo));
    const bool masked = (!DIFF) && (kb < 64);
    const char* Kt = smem + (i & 1) * 18432; const char* Vt = Kt + 9216;
    f32x4 S[NC][4];
#pragma unroll
    for (int kt = 0; kt < 4; ++kt) {
      bf16x8 k0 = *(const bf16x8*)(Kt + (kt * 16 + r16) * 144 + g * 16);
      bf16x8 k1 = *(const bf16x8*)(Kt + (kt * 16 + r16) * 144 + 64 + g * 16);
      if (DIFF) {
        S[0][kt] = __builtin_amdgcn_mfma_f32_16x16x32_bf16(k0, qf[0], (f32x4){0.f, 0.f, 0.f, 0.f}, 0, 0, 0);
        S[NC - 1][kt] = __builtin_amdgcn_mfma_f32_16x16x32_bf16(k1, qf[1], (f32x4){0.f, 0.f, 0.f, 0.f}, 0, 0, 0);
      } else {
        f32x4 t = __builtin_amdgcn_mfma_f32_16x16x32_bf16(k0, qf[0], (f32x4){0.f, 0.f, 0.f, 0.f}, 0, 0, 0);
        S[0][kt] = __builtin_amdgcn_mfma_f32_16x16x32_bf16(k1, qf[1], t, 0, 0, 0);
      }
    }
    bf16x8 pf[NC][2];
#pragma unroll
    for (int c = 0; c < NC; ++c) {
      float mx = -1e30f;
#pragma unroll
      for (int kt = 0; kt < 4; ++kt)
#pragma unroll
        for (int j = 0; j < 4; ++j) {
          float v = S[c][kt][j] * sc;
          if (masked) { int kpos = kb * 64 + kt * 16 + g * 4 + j; int dd = kpos - qpos; if (dd > 128 || dd < -128) v = -1e30f; }
          S[c][kt][j] = v; mx = fmaxf(mx, v);
        }
      mx = fmaxf(mx, __shfl_xor(mx, 16)); mx = fmaxf(mx, __shfl_xor(mx, 32));
      float mn = fmaxf(m[c], mx);
      float alpha = __builtin_amdgcn_exp2f(m[c] - mn);
      m[c] = mn;
      float ps = 0.f;
      unsigned pk[8];
#pragma unroll
      for (int kt = 0; kt < 4; ++kt) {
        float e0 = __builtin_amdgcn_exp2f(S[c][kt][0] - mn), e1 = __builtin_amdgcn_exp2f(S[c][kt][1] - mn), e2 = __builtin_amdgcn_exp2f(S[c][kt][2] - mn), e3 = __builtin_amdgcn_exp2f(S[c][kt][3] - mn);
        ps += (e0 + e1) + (e2 + e3);
        pk[kt * 2] = pack2(e0, e1); pk[kt * 2 + 1] = pack2(e2, e3);
      }
      lsum[c] = lsum[c] * alpha + ps;
#pragma unroll
      for (int dt = 0; dt < 4; ++dt) { O[c][dt][0] *= alpha; O[c][dt][1] *= alpha; O[c][dt][2] *= alpha; O[c][dt][3] *= alpha; }
      union { unsigned u[4]; bf16x8 v; } cv;
      cv.u[0] = pk[0]; cv.u[1] = pk[1]; cv.u[2] = pk[2]; cv.u[3] = pk[3]; pf[c][0] = cv.v;
      cv.u[0] = pk[4]; cv.u[1] = pk[5]; cv.u[2] = pk[6]; cv.u[3] = pk[7]; pf[c][1] = cv.v;
    }
#pragma unroll
    for (int dt = 0; dt < 4; ++dt)
#pragma unroll
      for (int s2 = 0; s2 < 2; ++s2) {
        union { uint2 u[2]; bf16x8 v; } vf;
        vf.u[0] = *(const uint2*)(Vt + (dt * 16 + r16) * 144 + (2 * s2) * 32 + g * 8);
        vf.u[1] = *(const uint2*)(Vt + (dt * 16 + r16) * 144 + (2 * s2 + 1) * 32 + g * 8);
#pragma unroll
        for (int c = 0; c < NC; ++c) O[c][dt] = __builtin_amdgcn_mfma_f32_16x16x32_bf16(vf.v, pf[c][s2], O[c][dt], 0, 0, 0);
      }
    if (i + 1 < nblk) AT_SSTORE((i + 1) & 1);
    __syncthreads();
  }
#undef AT_GLOAD
#undef AT_SSTORE
  float linv[NC];
#pragma unroll
  for (int c = 0; c < NC; ++c) { float t = lsum[c]; t += __shfl_xor(t, 16); t += __shfl_xor(t, 32); linv[c] = 1.f / t; }
  const size_t orow = (size_t)(qrow0 + wid * 16 + r16);
  if (!DIFF) {
    bf16_t* Y = (bf16_t*)(p.ws + R_YSW);
#pragma unroll
    for (int dt = 0; dt < 4; ++dt) {
      uint2 o; o.x = pack2(O[0][dt][0] * linv[0], O[0][dt][1] * linv[0]); o.y = pack2(O[0][dt][2] * linv[0], O[0][dt][3] * linv[0]);
      *(uint2*)(Y + orow * 256 + h * 64 + dt * 16 + g * 4) = o;
    }
  } else {
    const float lam_init = 0.8f - 0.6f * __expf(-0.3f * (float)l);
    float d1 = 0.f, d2 = 0.f;
    if (lane < 32) { d1 = p.in[28][l * 32 + lane] * p.in[29][l * 32 + lane]; d2 = p.in[30][l * 32 + lane] * p.in[31][l * 32 + lane]; }
    d1 = wave_sum(d1); d2 = wave_sum(d2);
    const float lam = expf(d1) - expf(d2) + lam_init;
    float ov[4][4]; float ss = 0.f;
#pragma unroll
    for (int dt = 0; dt < 4; ++dt)
#pragma unroll
      for (int j = 0; j < 4; ++j) { float v = O[0][dt][j] * linv[0] - lam * O[NC - 1][dt][j] * linv[NC - 1]; ov[dt][j] = v; ss += v * v; }
    ss += __shfl_xor(ss, 16); ss += __shfl_xor(ss, 32);
    const float rms = rsqrtf(ss * (1.f / 64.f) + 1e-5f) * (1.f - lam_init);
    const float* sg = p.in[32] + l * 64;
    bf16_t* Y = (bf16_t*)(p.ws + R_YDF);
#pragma unroll
    for (int dt = 0; dt < 4; ++dt) {
      const int d0 = dt * 16 + g * 4;
      uint2 o; o.x = pack2(ov[dt][0] * rms * sg[d0], ov[dt][1] * rms * sg[d0 + 1]); o.y = pack2(ov[dt][2] * rms * sg[d0 + 2], ov[dt][3] * rms * sg[d0 + 3]);
      *(uint2*)(Y + orow * 256 + h * 64 + d0) = o;
    }
  }
}

DI void ph_attn(const Params& p, int l, char* smem) {
  const bool need_ctx = (l == 0);
  const int n_sw = 1024 + (need_ctx ? 64 : 0);
  const int n_df = 1024 + (need_ctx ? 64 : 0);
  for (int u = blockIdx.x; u < n_sw + n_df; u += gridDim.x) {
    if (u < n_df) {
      if (u < 1024) { int b = u >> 7, h = (u >> 5) & 3, n = u & 31; attn_unit<true>(p, l, b, h, b * SL + n * 128, n * 128, 0, 64, 64, smem); }
      else { int v = u - 1024; int b = v >> 3, h = (v >> 1) & 3, n = v & 1; attn_unit<true>(p, l, b, h, ML + b * CL + n * 128, 0, 0, 0, 64, smem); }
    } else {
      int w = u - n_df;
      if (w < 1024) {
        int b = w >> 7, h = (w >> 5) & 3, n = w & 31;
        int lo = (n - 1) * 2; if (lo < 0) lo = 0; int hi = (n + 2) * 2; if (hi > 64) hi = 64;
        attn_unit<false>(p, l, b, h, b * SL + n * 128, n * 128, lo, hi, 64, smem);
      } else { int v = w - 1024; int b = v >> 3, h = (v >> 1) & 3, n = v & 1; attn_unit<false>(p, l, b, h, ML + b * CL + n * 128, 0, 0, 0, 64, smem); }
    }
  }
}

DI void ph_rwout(const Params& p, int l) {
  const int lane = my_tid() & 63, wid = my_tid() >> 6;
  const bf16_t* S = (const bf16_t*)(p.ws + R_STR); const bf16_t* Gs = (const bf16_t*)(p.ws + R_G);
  const bf16_t* OF = (const bf16_t*)(p.ws + R_OF); const bf16_t* OB = (const bf16_t*)(p.ws + R_OB);
  bf16_t* Y = (bf16_t*)(p.ws + R_YRW);
  const size_t SU = (size_t)MT * 256;
  const float4 rk = *(const float4*)(p.in[25] + (size_t)l * 256 + lane * 4);
  const float4 gam = *(const float4*)(p.in[26] + (size_t)l * 256 + lane * 4);
  const float4 bet = *(const float4*)(p.in[27] + (size_t)l * 256 + lane * 4);
  const int nrows = (l == 0) ? MT : ML;
  for (int row = blockIdx.x * 8 + wid; row < nrows; row += gridDim.x * 8) {
    const size_t o = (size_t)row * 256 + lane * 4;
    uint2 ur = *(const uint2*)(S + o), uk = *(const uint2*)(S + SU + o), uv = *(const uint2*)(S + 2 * SU + o);
    uint2 uf = *(const uint2*)(OF + o), ub = *(const uint2*)(OB + o), ugf = *(const uint2*)(Gs + o), ugb = *(const uint2*)(Gs + SU + o);
    float r[4] = {bflo(ur.x), bfhi(ur.x), bflo(ur.y), bfhi(ur.y)};
    float k[4] = {bflo(uk.x), bfhi(uk.x), bflo(uk.y), bfhi(uk.y)};
    float v[4] = {bflo(uv.x), bfhi(uv.x), bflo(uv.y), bfhi(uv.y)};
    float f[4] = {bflo(uf.x), bfhi(uf.x), bflo(uf.y), bfhi(uf.y)};
    float bb[4] = {bflo(ub.x), bfhi(ub.x), bflo(ub.y), bfhi(ub.y)};
    float gf[4] = {bflo(ugf.x), bfhi(ugf.x), bflo(ugf.y), bfhi(ugf.y)};
    float gb[4] = {bflo(ugb.x), bfhi(ugb.x), bflo(ugb.y), bfhi(ugb.y)};
    const float rkv[4] = {rk.x, rk.y, rk.z, rk.w}; const float ga[4] = {gam.x, gam.y, gam.z, gam.w}; const float be[4] = {bet.x, bet.y, bet.z, bet.w};
    float bon = 0.f, sf = 0.f, sb = 0.f;
#pragma unroll
    for (int i = 0; i < 4; ++i) { bon += r[i] * k[i] * rkv[i]; sf += f[i]; sb += bb[i]; }
    bon = sum16(bon); float muf = sum16(sf) * (1.f / 64.f), mub = sum16(sb) * (1.f / 64.f);
    float qf = 0.f, qb = 0.f;
#pragma unroll
    for (int i = 0; i < 4; ++i) { f[i] -= muf; bb[i] -= mub; qf += f[i] * f[i]; qb += bb[i] * bb[i]; }
    float rsf = rsqrtf(sum16(qf) * (1.f / 64.f) + 64e-5f), rsb = rsqrtf(sum16(qb) * (1.f / 64.f) + 64e-5f);
    float y[4];
#pragma unroll
    for (int i = 0; i < 4; ++i) {
      float bn = bon * v[i];
      y[i] = (f[i] * rsf * ga[i] + be[i] + bn) * gf[i] + (bb[i] * rsb * ga[i] + be[i] + bn) * gb[i];
    }
    uint2 oo; oo.x = pack2(y[0], y[1]); oo.y = pack2(y[2], y[3]);
    *(uint2*)(Y + o) = oo;
  }
}

DI void ph_merge(const Params& p, int l, char* smem) {
  const bf16_t* U = (const bf16_t*)(p.ws + R_URE);
  const int lane = my_tid() & 63, wid = my_tid() >> 6, wm = wid >> 1, wn = wid & 1, g = lane >> 4, r16 = lane & 15;
  const int mtiles = (l == 0) ? 136 : 128;
  bf16_t* ACC = (bf16_t*)(p.ws + R_ACC);
  for (int it = 0;; ++it) {
    int mtile, ntile;
    if (!next_tile(it, mtiles, 8, mtile, ntile)) break;
    uint2 accS[4][4];
#pragma unroll
    for (int mt = 0; mt < 4; ++mt)
#pragma unroll
      for (int nt = 0; nt < 4; ++nt) accS[mt][nt] = make_uint2(0u, 0u);
    for (int j = 0; j < 4; ++j) {
      uint2 pb[4][4];
      {
        f32x4 accB[4][4]; zero_acc<4>(accB);
        const size_t yoff = (j == 0) ? R_YHY : (j == 1) ? R_YSW : (j == 2) ? R_YRW : R_YDF;
        gemm_main<4, false>(accB, (const bf16_t*)(p.ws + yoff), 256, RowPlain{(long)mtile * 256}, (const bf16_t*)(p.ws + WB_BR) + ((size_t)j * 1024 + ntile * 128) * 256, 256, 256, smem);
#pragma unroll
        for (int mt = 0; mt < 4; ++mt)
#pragma unroll
          for (int nt = 0; nt < 4; ++nt) { pb[mt][nt].x = pack2(accB[mt][nt][0], accB[mt][nt][1]); pb[mt][nt].y = pack2(accB[mt][nt][2], accB[mt][nt][3]); }
      }
      f32x4 accG[4][4]; zero_acc<4>(accG);
      gemm_main<4, false>(accG, U, 1024, RowPlain{(long)mtile * 256}, (const bf16_t*)(p.ws + WB_GATE) + ((size_t)j * 1024 + ntile * 128) * 1024, 1024, 1024, smem);
#pragma unroll
      for (int mt = 0; mt < 4; ++mt)
#pragma unroll
        for (int nt = 0; nt < 4; ++nt) {
          float v0 = bflo(accS[mt][nt].x) + sigmoidf_(accG[mt][nt][0]) * bflo(pb[mt][nt].x);
          float v1 = bfhi(accS[mt][nt].x) + sigmoidf_(accG[mt][nt][1]) * bfhi(pb[mt][nt].x);
          float v2 = bflo(accS[mt][nt].y) + sigmoidf_(accG[mt][nt][2]) * bflo(pb[mt][nt].y);
          float v3 = bfhi(accS[mt][nt].y) + sigmoidf_(accG[mt][nt][3]) * bfhi(pb[mt][nt].y);
          accS[mt][nt].x = pack2(v0, v1); accS[mt][nt].y = pack2(v2, v3);
        }
    }
#pragma unroll
    for (int mt = 0; mt < 4; ++mt) {
      const int col = ntile * 128 + wn * 64 + r16 * 4;
      const size_t row = (size_t)mtile * 256 + wm * 64 + mt * 16 + g * 4;
      uint2 o;
      o.x = (accS[mt][0].x & 0xffffu) | (accS[mt][1].x << 16); o.y = (accS[mt][2].x & 0xffffu) | (accS[mt][3].x << 16);
      *(uint2*)(ACC + (row + 0) * 1024 + col) = o;
      o.x = (accS[mt][0].x >> 16) | (accS[mt][1].x & 0xffff0000u); o.y = (accS[mt][2].x >> 16) | (accS[mt][3].x & 0xffff0000u);
      *(uint2*)(ACC + (row + 1) * 1024 + col) = o;
      o.x = (accS[mt][0].y & 0xffffu) | (accS[mt][1].y << 16); o.y = (accS[mt][2].y & 0xffffu) | (accS[mt][3].y << 16);
      *(uint2*)(ACC + (row + 2) * 1024 + col) = o;
      o.x = (accS[mt][0].y >> 16) | (accS[mt][1].y & 0xffff0000u); o.y = (accS[mt][2].y >> 16) | (accS[mt][3].y & 0xffff0000u);
      *(uint2*)(ACC + (row + 3) * 1024 + col) = o;
    }
  }
}

DI void ph_resgemm(const Params& p, int l, const bf16_t* A, int K, const bf16_t* Bt, const float* hsrc_lat, const float* hsrc_ctx, int gate_off, char* smem) {
  const int lane = my_tid() & 63, wid = my_tid() >> 6, wm = wid >> 1, wn = wid & 1, g = lane >> 4, r16 = lane & 15;
  const int mtiles = (l == 0) ? 136 : 128;
  const float* mod = (const float*)(p.ws + MISC_MOD) + (size_t)l * 9 * 6144;
  float* hc = (float*)(p.ws + OFF_HC);
  for (int it = 0;; ++it) {
    int mtile, ntile;
    if (!next_tile(it, mtiles, 8, mtile, ntile)) break;
    f32x4 acc[4][4]; zero_acc<4>(acc);
    gemm_main<4, true>(acc, A, K, RowPlain{(long)mtile * 256}, Bt + (size_t)ntile * 128 * K, K, K, smem);
    const int b = mtile < 128 ? (mtile >> 4) : 8;
    const float* gt = mod + (size_t)b * 6144 + gate_off;
    const int col = ntile * 128 + wn * 64 + r16 * 4;
    const float4 gv = *(const float4*)(gt + col);
#pragma unroll
    for (int mt = 0; mt < 4; ++mt)
#pragma unroll
      for (int e = 0; e < 4; ++e) {
        const int row = mtile * 256 + wm * 64 + mt * 16 + g * 4 + e;
        const float* hs; float* hd;
        if (row < ML) { size_t o = (size_t)row * D + col; hs = hsrc_lat + o; hd = p.out + o; }
        else { size_t o = (size_t)(row - ML) * D + col; hs = hsrc_ctx + o; hd = hc + o; }
        const float4 h = *(const float4*)hs;
        float4 r;
        r.x = DN_ALPHA * h.x + gv.x * acc[mt][0][e]; r.y = DN_ALPHA * h.y + gv.y * acc[mt][1][e];
        r.z = DN_ALPHA * h.z + gv.z * acc[mt][2][e]; r.w = DN_ALPHA * h.w + gv.w * acc[mt][3][e];
        *(float4*)hd = r;
      }
  }
}

DI void ph_ffnup(const Params& p, int l, char* smem) {
  const bf16_t* U = (const bf16_t*)(p.ws + R_U);
  const bf16_t* Bt = (const bf16_t*)(p.ws + WB_UP);
  bf16_t* HID = (bf16_t*)(p.ws + R_HID);
  const float* cw = p.in[38] + (size_t)l * 3 * 5632; const float* cb = p.in[39] + (size_t)l * 5632;
  const int tid = my_tid(), lane = tid & 63, wid = tid >> 6, wm = wid >> 1, wn = wid & 1, g = lane >> 4, r16 = lane & 15;
  const int mtiles = (l == 0) ? 152 : 136;
  float* T = (float*)smem;
  for (int it = 0;; ++it) {
    int mtile, ntile;
    if (!next_tile(it, mtiles, 44, mtile, ntile)) break;
    long rowbase; int tt, len;
    if (mtile < 136) { int b = mtile / 17; tt = mtile % 17; len = SL; rowbase = (long)b * SL; }
    else { int v = mtile - 136; int b = v >> 1; tt = v & 1; len = CL; rowbase = (long)ML + b * CL; }
    f32x4 acc[4][4]; zero_acc<4>(acc);
    gemm_main<4, true>(acc, U, 1024, RowHalo{rowbase, tt * 254 - 1, len}, Bt + (size_t)ntile * 128 * 1024, 1024, 1024, smem);
#pragma unroll
    for (int mt = 0; mt < 4; ++mt)
#pragma unroll
      for (int e = 0; e < 4; ++e)
        *(float4*)(T + (wm * 64 + mt * 16 + g * 4 + e) * 132 + wn * 64 + r16 * 4) = make_float4(acc[mt][0][e], acc[mt][1][e], acc[mt][2][e], acc[mt][3][e]);
    __syncthreads();
    {
      const int ch = tid & 63, rgp = tid >> 6; const int ca = ntile * 64 + ch, cbx = 2816 + ca;
      const float a0 = cw[ca], a1 = cw[5632 + ca], a2 = cw[2 * 5632 + ca], ab = cb[ca];
      const float b0 = cw[cbx], b1 = cw[5632 + cbx], b2 = cw[2 * 5632 + cbx], bb = cb[cbx];
      for (int r = 1 + rgp; r <= 254; r += 8) {
        int tok = tt * 254 - 1 + r;
        if (tok < len) {
          float av = a0 * T[(r - 1) * 132 + ch] + a1 * T[r * 132 + ch] + a2 * T[(r + 1) * 132 + ch] + ab;
          float bv = b0 * T[(r - 1) * 132 + 64 + ch] + b1 * T[r * 132 + 64 + ch] + b2 * T[(r + 1) * 132 + 64 + ch] + bb;
          HID[(size_t)(rowbase + tok) * 2816 + ca] = (bf16_t)f2bf(siluf_(av) * bv);
        }
      }
    }
  }
}

#ifndef REP_PREP
#define REP_PREP 1
#endif
#ifndef REP_GEMM
#define REP_GEMM 1
#endif
#ifndef REP_HY
#define REP_HY 1
#endif
#ifndef REP_RWP
#define REP_RWP 1
#endif
#ifndef REP_SCAN
#define REP_SCAN 1
#endif
#ifndef REP_ATTN
#define REP_ATTN 1
#endif
#ifndef PH_END
#define PH_END 24
#endif
#define SYNC_OR_RET(idx) do { if ((idx) + 1 >= PH_END) return; grid.sync(); } while (0)
template <int l>
DI void run_layer(const Params& p, cg::grid_group& grid, char* smem) {
  const float* mod = (const float*)(p.ws + MISC_MOD) + (size_t)l * 9 * 6144;
  float* hc = (float*)(p.ws + OFF_HC);
  const float* hl_src = (l == 0) ? p.in[0] : p.out;
  const float* hc_src = (l == 0) ? p.in[2] : hc;
  constexpr int B0 = l * 12;
  for (int rep = 0; rep < REP_PREP; ++rep) {
  ph_convert(p, l, smem);
  if (l == 0) ph_ada(p, smem);
  hy_rawfilter(p, l, SL, (float*)(p.ws + R_RAWF), smem);
  if (l == 0) hy_rawfilter(p, l, CL, (float*)(p.ws + MISC_RAWC), smem);
  }
  SYNC_OR_RET(B0 + 0);
  for (int rep = 0; rep < REP_PREP; ++rep) ph_kf(p, l, smem);
  ph_ln(hl_src, hc_src, nullptr, nullptr, nullptr, nullptr, (bf16_t*)(p.ws + R_U), mod, 0, MT);
  SYNC_OR_RET(B0 + 1);
  for (int rep = 0; rep < REP_GEMM; ++rep) ph_inproj(p, smem);
  SYNC_OR_RET(B0 + 2);
  for (int rep = 0; rep < REP_HY; ++rep) {
  ph_hyena(p, l, smem);
  if (l == 0) ph_hyena_ctx(p, l, smem);
  }
  ph_rope(p, smem);
  for (int rep = 0; rep < REP_RWP; ++rep) ph_rwprep(p, l, smem);
  SYNC_OR_RET(B0 + 3);
  for (int rep = 0; rep < REP_SCAN; ++rep) ph_scan(p, smem);
  for (int rep = 0; rep < REP_ATTN; ++rep) ph_attn(p, l, smem);
  SYNC_OR_RET(B0 + 4);
  ph_rwout(p, l);
  ph_ln(hl_src, hc_src, nullptr, nullptr, nullptr, nullptr, (bf16_t*)(p.ws + R_URE), mod, 0, l == 0 ? MT : ML);
  SYNC_OR_RET(B0 + 5);
  for (int rep = 0; rep < REP_GEMM; ++rep) ph_merge(p, l, smem);
  SYNC_OR_RET(B0 + 6);
  ph_resgemm(p, l, (const bf16_t*)(p.ws + R_ACC), 1024, (const bf16_t*)(p.ws + WB_OUT), hl_src, hc_src, 2048, smem);
  SYNC_OR_RET(B0 + 7);
  ph_ln(p.out, hc, p.out, hc, p.in[35] + (size_t)l * D, p.in[36] + (size_t)l * D, (bf16_t*)(p.ws + R_U), mod, 3072, l == 0 ? MT : ML);
  SYNC_OR_RET(B0 + 8);
  for (int rep = 0; rep < REP_GEMM; ++rep) ph_ffnup(p, l, smem);
  SYNC_OR_RET(B0 + 9);
  ph_resgemm(p, l, (const bf16_t*)(p.ws + R_HID), 2816, (const bf16_t*)(p.ws + WB_DOWN), p.out, hc, 5120, smem);
  SYNC_OR_RET(B0 + 10);
  ph_ln(p.out, hc, p.out, hc, p.in[41] + (size_t)l * D, p.in[42] + (size_t)l * D, nullptr, mod, 0, l == 0 ? MT : ML);
  SYNC_OR_RET(B0 + 11);
}

__global__ void __launch_bounds__(NTHR) mega(Params p) {
  extern __shared__ __attribute__((aligned(16))) char smem[];
  cg::grid_group grid = cg::this_grid();
  run_layer<0>(p, grid, smem);
  if (PH_END > 12) run_layer<1>(p, grid, smem);
}

extern "C" void kernel_launch(void* const* d_in, const int* in_sizes, int n_in, void* d_out, int out_size,
                              void* d_ws, size_t ws_size, hipStream_t stream) {
  static int grid_blocks = 0;
  if (!grid_blocks) {
    int dev = 0, cus = 0, per_cu = 0;
    (void)hipGetDevice(&dev);
    (void)hipDeviceGetAttribute(&cus, hipDeviceAttributeMultiprocessorCount, dev);
    (void)hipFuncSetAttribute((const void*)mega, hipFuncAttributeMaxDynamicSharedMemorySize, SMEM_BYTES);
    (void)hipOccupancyMaxActiveBlocksPerMultiprocessor(&per_cu, mega, NTHR, SMEM_BYTES);
    if (per_cu < 1) per_cu = 1;
    if (per_cu > 1) per_cu = 1;
    grid_blocks = cus * per_cu;
  }
  Params p{};
  for (int i = 0; i < 43; ++i) p.in[i] = (const float*)d_in[i];
  p.out = (float*)d_out; p.ws = (char*)d_ws;
  void* args[] = {&p};
  hipError_t e = hipLaunchCooperativeKernel((void*)mega, dim3(grid_blocks), dim3(NTHR), args, SMEM_BYTES, stream);
  if (e != hipSuccess) fprintf(stderr, "cooperative launch failed: %s (grid %d)\n", hipGetErrorString(e), grid_blocks);
}
```

```cpp
#include <hip/hip_runtime.h>
#include <hip/hip_cooperative_groups.h>
#include <cstdio>
#include <cstdint>
namespace cg = cooperative_groups;

#define DI __device__ __forceinline__
typedef unsigned short bf16_t;
typedef short bf16x8 __attribute__((ext_vector_type(8)));
typedef float f32x4 __attribute__((ext_vector_type(4)));

constexpr int D = 1024, NB = 8, SL = 4096, CL = 256;
constexpr int ML = NB * SL, MC = NB * CL, MT = ML + MC;
constexpr int KEYS = SL + CL;
constexpr int NTHR = 512;
constexpr float DN_ALPHA = 1.41421356237f;
constexpr size_t UNIT = (size_t)MT * 512;

constexpr size_t WB_IN = 0;
constexpr size_t WB_GATE = WB_IN + (size_t)3328 * 1024 * 2;
constexpr size_t WB_BR = WB_GATE + (size_t)4096 * 1024 * 2;
constexpr size_t WB_OUT = WB_BR + (size_t)4 * 1024 * 256 * 2;
constexpr size_t WB_UP = WB_OUT + (size_t)1024 * 1024 * 2;
constexpr size_t WB_DOWN = WB_UP + (size_t)5632 * 1024 * 2;
constexpr size_t WB_END = WB_DOWN + (size_t)1024 * 2816 * 2;
constexpr size_t OFF_KF = WB_END;
constexpr size_t OFF_HC = OFF_KF + (size_t)512 * 8192 * 8;
constexpr size_t OFF_MISC = OFF_HC + (size_t)MC * D * 4;
constexpr size_t MISC_MOD = OFF_MISC;
constexpr size_t MISC_TW = MISC_MOD + (size_t)2 * 9 * 6144 * 4;
constexpr size_t MISC_RAWC = MISC_TW + 4096 * 8;
constexpr size_t MISC_GCTX = MISC_RAWC + (size_t)256 * 1024 * 4;
constexpr size_t MISC_RWW = MISC_GCTX + (size_t)512 * 512 * 4;
constexpr size_t RWW_F = MISC_RWW, RWW_B = RWW_F + 256 * 64 * 2, RWW_A = RWW_B + 256 * 64 * 2, RWW_GF = RWW_A + 256 * 64 * 2, RWW_GB = RWW_GF + 256 * 128 * 2;
constexpr size_t OFF_R = OFF_MISC + (size_t)4 * 1024 * 1024;
constexpr size_t MISC_BAR = OFF_R - 256;
static_assert(RWW_GB + 256 * 128 * 2 <= MISC_BAR, "misc overflow");
constexpr size_t R_YHY = OFF_R, R_YSW = OFF_R + UNIT, R_YDF = OFF_R + 2 * UNIT;
constexpr size_t R_PHY = OFF_R + 3 * UNIT;
constexpr size_t R_PSW = OFF_R + 6 * UNIT;
constexpr size_t R_VTSW = R_PSW + (size_t)MT * 384 * 2;
constexpr size_t R_PDF = OFF_R + 8 * UNIT;
constexpr size_t R_VTDF = OFF_R + 10 * UNIT;
constexpr size_t R_PRW = OFF_R + 11 * UNIT;
constexpr size_t R_STR = R_PRW + (size_t)MT * 1216 * 2;
constexpr size_t R_G = R_STR + 7 * UNIT;
constexpr size_t R_END = R_G + 2 * UNIT;
constexpr size_t R_RAWF = OFF_R;
constexpr size_t R_OF = R_PHY, R_OB = R_PHY + UNIT;
constexpr size_t R_URE = R_PSW;
constexpr size_t R_YRW = R_VTDF;
constexpr size_t R_ACC = R_PRW;
constexpr size_t R_U = R_STR;
constexpr size_t R_HID = OFF_R;
static_assert(R_END <= (size_t)512 * 1024 * 1024, "ws overflow");
static_assert((size_t)MT * 2816 * 2 <= 11 * UNIT, "hid");

constexpr int SMEM_BYTES = 136 * 1024;

struct Params {
  const float* in[43];
  float* out;
  char* ws;
};

DI int my_tid() { int t = (int)__builtin_amdgcn_workitem_id_x(); asm volatile("" : "+v"(t)); return t; }
DI unsigned f2bf(float f) { unsigned u = __float_as_uint(f); u += 0x7fffu + ((u >> 16) & 1u); return u >> 16; }
DI float bf2f(unsigned h) { return __uint_as_float(h << 16); }
typedef __bf16 bf16v2_t __attribute__((ext_vector_type(2)));
typedef float f32v2_t __attribute__((ext_vector_type(2)));
DI unsigned pack2(float lo, float hi) { f32v2_t v = {lo, hi}; bf16v2_t b = __builtin_convertvector(v, bf16v2_t); return __builtin_bit_cast(unsigned, b); }

DI float bflo(unsigned w) { return __uint_as_float(w << 16); }
DI float bfhi(unsigned w) { return __uint_as_float(w & 0xffff0000u); }
DI float sigmoidf_(float x) { return 1.f / (1.f + __expf(-x)); }
DI float siluf_(float x) { return x / (1.f + __expf(-x)); }
DI float wave_sum(float v) {
#pragma unroll
  for (int o = 32; o >= 1; o >>= 1) v += __shfl_xor(v, o);
  return v;
}
template <int CTRL> DI float dpp_mov(float v) {
  return __int_as_float(__builtin_amdgcn_update_dpp(0, __float_as_int(v), CTRL, 0xf, 0xf, false));
}
DI float sum16(float v) {
  v += dpp_mov<0xB1>(v);
  v += dpp_mov<0x4E>(v);
  v += dpp_mov<0x141>(v);
  v += dpp_mov<0x140>(v);
  return v;
}
DI void lds_barrier() { asm volatile("s_waitcnt lgkmcnt(0)" ::: "memory"); __builtin_amdgcn_s_barrier(); asm volatile("" ::: "memory"); }
DI uint4 sel4(bool z, uint4 v) { return make_uint4(z ? 0u : v.x, z ? 0u : v.y, z ? 0u : v.z, z ? 0u : v.w); }
DI int mod_idx(int row) { return row < ML ? (row >> 12) : 8; }

template <int NTW, bool DEEP, class RowFn>
DI void gemm_main(f32x4 (&acc)[4][NTW], const bf16_t* __restrict__ A, int lda, RowFn rowfn,
                  const bf16_t* __restrict__ Bt, int ldb, int K, char* smem) {
  constexpr int BN = NTW * 32;
  constexpr int A_BYTES = 256 * 144, B_BYTES = BN * 144, STAGE = A_BYTES + B_BYTES;
  constexpr int NBL = BN / 64;
  const int tid = my_tid(), lane = tid & 63, wid = tid >> 6, wm = wid >> 1, wn = wid & 1, g = lane >> 4, r16 = lane & 15;
  const int chunk = tid & 7, lrow = tid >> 3;
  long a0 = rowfn(lrow), a1 = rowfn(lrow + 64), a2 = rowfn(lrow + 128), a3 = rowfn(lrow + 192);
  const long c0 = a0 < 0 ? 0 : a0, c1 = a1 < 0 ? 0 : a1, c2 = a2 < 0 ? 0 : a2, c3 = a3 < 0 ? 0 : a3;
  const bf16_t* Bp = Bt + (long)lrow * ldb + chunk * 8;
  const bf16_t* Ap0 = A + c0 * lda + chunk * 8; const bf16_t* Ap1 = A + c1 * lda + chunk * 8;
  const bf16_t* Ap2 = A + c2 * lda + chunk * 8; const bf16_t* Ap3 = A + c3 * lda + chunk * 8;
  struct Regs { uint4 a0, a1, a2, a3, b0, b1; };
  Regs R0, R1;
  R0.b1 = make_uint4(0, 0, 0, 0); R1.b1 = make_uint4(0, 0, 0, 0);
  auto GLOAD = [&](Regs& R, int k0) {
    R.a0 = *(const uint4*)(Ap0 + k0); R.a1 = *(const uint4*)(Ap1 + k0);
    R.a2 = *(const uint4*)(Ap2 + k0); R.a3 = *(const uint4*)(Ap3 + k0);
    R.b0 = *(const uint4*)(Bp + k0);
    if constexpr (NBL > 1) R.b1 = *(const uint4*)(Bp + (long)64 * ldb + k0);
  };
  auto SSTORE = [&](const Regs& R, int st) {
    char* base = smem + st * STAGE + lrow * 144 + chunk * 16;
    *(uint4*)(base) = sel4(a0 < 0, R.a0); *(uint4*)(base + 64 * 144) = sel4(a1 < 0, R.a1);
    *(uint4*)(base + 128 * 144) = sel4(a2 < 0, R.a2); *(uint4*)(base + 192 * 144) = sel4(a3 < 0, R.a3);
    *(uint4*)(base + A_BYTES) = R.b0;
    if constexpr (NBL > 1) *(uint4*)(base + A_BYTES + 64 * 144) = R.b1;
  };
  auto COMPUTE = [&](int st) {
    const char* As = smem + st * STAGE + (wm * 64 + r16) * 144 + g * 16;
    const char* Bs = smem + st * STAGE + A_BYTES + (wn * (NTW * 16) + r16) * 144 + g * 16;
#pragma unroll
    for (int kk = 0; kk < 2; ++kk) {
      bf16x8 af[4], bfr[NTW];
#pragma unroll
      for (int mt = 0; mt < 4; ++mt) af[mt] = *(const bf16x8*)(As + mt * 16 * 144 + kk * 64);
#pragma unroll
      for (int nt = 0; nt < NTW; ++nt) bfr[nt] = *(const bf16x8*)(Bs + nt * 16 * 144 + kk * 64);
#pragma unroll
      for (int mt = 0; mt < 4; ++mt)
#pragma unroll
        for (int nt = 0; nt < NTW; ++nt)
          acc[mt][nt] = __builtin_amdgcn_mfma_f32_16x16x32_bf16(af[mt], bfr[nt], acc[mt][nt], 0, 0, 0);
    }
  };
  const int nk = K >> 6;
  __syncthreads();
  GLOAD(R0, 0);
  SSTORE(R0, 0);
  if constexpr (DEEP) {
    GLOAD(R0, 64);
    if (nk > 2) GLOAD(R1, 128);
    lds_barrier();
    for (int kt = 0; kt < nk; kt += 2) {
      COMPUTE(0);
      __builtin_amdgcn_sched_barrier(0);
      SSTORE(R0, 1);
      if (kt + 3 < nk) GLOAD(R0, (kt + 3) * 64);
      lds_barrier();
      COMPUTE(1);
      __builtin_amdgcn_sched_barrier(0);
      if (kt + 2 < nk) SSTORE(R1, 0);
      if (kt + 4 < nk) GLOAD(R1, (kt + 4) * 64);
      lds_barrier();
    }
  } else {
    lds_barrier();
    for (int kt = 0; kt < nk; ++kt) {
      const int st = kt & 1;
      if (kt + 1 < nk) GLOAD(R0, (kt + 1) * 64);
      __builtin_amdgcn_sched_barrier(0);
      COMPUTE(st);
      __builtin_amdgcn_sched_barrier(0);
      if (kt + 1 < nk) SSTORE(R0, st ^ 1);
      lds_barrier();
    }
  }
}

DI bool next_tile(int i, int MTILES, int NTILES, int& mt, int& nt) {
  const int xcd = blockIdx.x & 7, slot = blockIdx.x >> 3, nslot = gridDim.x >> 3;
  const int m_lo = (MTILES * xcd) >> 3, m_hi = (MTILES * (xcd + 1)) >> 3, Mloc = m_hi - m_lo;
  const int q = i * nslot + slot;
  if (q >= Mloc * NTILES) return false;
  const int gidx = q / (4 * NTILES), m0 = gidx * 4;
  const int rows = (Mloc - m0) < 4 ? (Mloc - m0) : 4;
  const int within = q - gidx * 4 * NTILES;
  nt = within / rows; mt = m_lo + m0 + within % rows;
  return true;
}

struct RowPlain { long base; DI long operator()(int r) const { return base + r; } };
struct RowHalo { long rowbase; int t0; int len; DI long operator()(int r) const { int t = t0 + r; return (t >= 0 && t < len) ? rowbase + t : -1; } };

template <int NTW> DI void zero_acc(f32x4 (&acc)[4][NTW]) {
#pragma unroll
  for (int i = 0; i < 4; ++i)
#pragma unroll
    for (int j = 0; j < NTW; ++j) acc[i][j] = (f32x4){0.f, 0.f, 0.f, 0.f};
}

DI void cvt_unit(const float* __restrict__ src, int ldsrc, int srccol0, int k0, bf16_t* __restrict__ dst, int K, int n0, char* smem, bool perm = true) {
  float* T = (float*)smem;
  const int tid = my_tid();
  __syncthreads();
  if (srccol0 >= 0) {
#pragma unroll
    for (int i = 0; i < 8; ++i) {
      int idx = tid + i * 512; int k = idx >> 6, n = idx & 63;
      T[k * 65 + n] = src[(long)(k0 + k) * ldsrc + srccol0 + n];
    }
  }
  __syncthreads();
  int nd = tid >> 3, kc = (tid & 7) * 8; int n = perm ? ((nd & 15) * 4 + (nd >> 4)) : nd;
  uint4 o = make_uint4(0, 0, 0, 0);
  if (srccol0 >= 0) {
    o.x = pack2(T[(kc + 0) * 65 + n], T[(kc + 1) * 65 + n]);
    o.y = pack2(T[(kc + 2) * 65 + n], T[(kc + 3) * 65 + n]);
    o.z = pack2(T[(kc + 4) * 65 + n], T[(kc + 5) * 65 + n]);
    o.w = pack2(T[(kc + 6) * 65 + n], T[(kc + 7) * 65 + n]);
  }
  *(uint4*)(dst + (long)(n0 + nd) * K + k0 + kc) = o;
}

DI void ph_convert(const Params& p, int l, char* smem) {
  for (int u = blockIdx.x; u < 4508; u += gridDim.x) {
    if (u < 832) {
      int gI = u >> 4, kt = u & 15; int n0 = gI * 64; int sc;
      if (n0 < 1280) sc = n0; else if (n0 < 2048) sc = 2496 + (n0 - 1280); else if (n0 < 3264) sc = 1280 + (n0 - 2048); else sc = -1;
      cvt_unit(p.in[6] + (size_t)l * 1024 * 7360, 7360, sc, kt * 64, (bf16_t*)(p.ws + WB_IN), 1024, n0, smem);
    } else if (u < 1856) {
      int v = u - 832; int gI = v >> 4, kt = v & 15;
      cvt_unit(p.in[6] + (size_t)l * 1024 * 7360, 7360, 3264 + gI * 64, kt * 64, (bf16_t*)(p.ws + WB_GATE), 1024, gI * 64, smem);
    } else if (u < 2112) {
      int v = u - 1856; int gI = v >> 2, kt = v & 3; int j = gI >> 4, gg = gI & 15;
      cvt_unit(p.in[33] + ((size_t)l * 4 + j) * 256 * 1024, 1024, gg * 64, kt * 64, (bf16_t*)(p.ws + WB_BR) + (size_t)j * 1024 * 256, 256, gg * 64, smem);
    } else if (u < 2368) {
      int v = u - 2112; int gI = v >> 4, kt = v & 15;
      cvt_unit(p.in[34] + (size_t)l * 1024 * 1024, 1024, gI * 64, kt * 64, (bf16_t*)(p.ws + WB_OUT), 1024, gI * 64, smem);
    } else if (u < 3776) {
      int v = u - 2368; int gI = v >> 4, kt = v & 15; int nt = gI >> 1, hb = gI & 1;
      cvt_unit(p.in[37] + (size_t)l * 1024 * 5632, 5632, hb * 2816 + nt * 64, kt * 64, (bf16_t*)(p.ws + WB_UP), 1024, gI * 64, smem);
    } else if (u < 4480) {
      int v = u - 3776; int gI = v / 44, kt = v % 44;
      cvt_unit(p.in[40] + (size_t)l * 2816 * 1024, 1024, gI * 64, kt * 64, (bf16_t*)(p.ws + WB_DOWN), 2816, gI * 64, smem);
    } else {
      int v = u - 4480;
      if (v < 4) cvt_unit(p.in[19] + (size_t)l * 2 * 64 * 256, 256, v * 64, 0, (bf16_t*)(p.ws + RWW_F), 64, v * 64, smem, false);
      else if (v < 8) cvt_unit(p.in[19] + (size_t)l * 2 * 64 * 256 + 64 * 256, 256, (v - 4) * 64, 0, (bf16_t*)(p.ws + RWW_B), 64, (v - 4) * 64, smem, false);
      else if (v < 12) cvt_unit(p.in[21] + (size_t)l * 64 * 256, 256, (v - 8) * 64, 0, (bf16_t*)(p.ws + RWW_A), 64, (v - 8) * 64, smem, false);
      else if (v < 20) { int w = v - 12; cvt_unit(p.in[22] + (size_t)l * 2 * 128 * 256, 256, (w >> 1) * 64, (w & 1) * 64, (bf16_t*)(p.ws + RWW_GF), 128, (w >> 1) * 64, smem, false); }
      else { int w = v - 20; cvt_unit(p.in[22] + (size_t)l * 2 * 128 * 256 + 128 * 256, 256, (w >> 1) * 64, (w & 1) * 64, (bf16_t*)(p.ws + RWW_GB), 128, (w >> 1) * 64, smem, false); }
    }
  }
}

DI void ph_ada(const Params& p, char* smem) {
  float* S = (float*)smem;
  float* R = S + 9 * 1024;
  const int tid = my_tid();
  bool loaded = false;
  for (int u = blockIdx.x; u < 192; u += gridDim.x) {
    if (!loaded) {
      __syncthreads();
      for (int i = tid; i < 9 * 1024; i += NTHR) { float c = i < 8192 ? p.in[1][i] : p.in[3][i - 8192]; S[i] = siluf_(c); }
      loaded = true;
    }
    __syncthreads();
    int l = u / 96, n0 = (u % 96) * 64;
    int col = tid & 63, ks = tid >> 6;
    const float* W = p.in[4] + (size_t)l * 1024 * 6144 + n0 + col;
    float a[9];
#pragma unroll
    for (int b = 0; b < 9; ++b) a[b] = 0.f;
    for (int k = ks * 128; k < ks * 128 + 128; ++k) {
      float w = W[(size_t)k * 6144];
#pragma unroll
      for (int b = 0; b < 9; ++b) a[b] += S[b * 1024 + k] * w;
    }
#pragma unroll
    for (int b = 0; b < 9; ++b) R[(ks * 9 + b) * 64 + col] = a[b];
    __syncthreads();
    for (int i = tid; i < 9 * 64; i += NTHR) {
      int b = i >> 6, c = i & 63; float s = 0.f;
#pragma unroll
      for (int k2 = 0; k2 < 8; ++k2) s += R[(k2 * 9 + b) * 64 + c];
      s += p.in[5][(size_t)l * 6144 + n0 + c];
      ((float*)(p.ws + MISC_MOD))[((size_t)l * 9 + b) * 6144 + n0 + c] = s;
    }
  }
  for (int i = blockIdx.x * NTHR + tid; i < 4096; i += gridDim.x * NTHR) {
    float s, c; sincospif(-(float)i / 4096.f, &s, &c);
    ((float2*)(p.ws + MISC_TW))[i] = make_float2(c, s);
  }
}

DI void hy_rawfilter(const Params& p, int l, int Lf, float* __restrict__ dst, char* smem) {
  float* W1 = (float*)smem;
  float* W2 = W1 + 33 * 64;
  float* Z = W2 + 64 * 64;
  float* H1 = Z + 16 * 36;
  float* H2 = H1 + 16 * 64;
  const int tid = my_tid();
  const float* w1 = p.in[9] + (size_t)l * 33 * 64; const float* b1 = p.in[10] + l * 64;
  const float* w2 = p.in[11] + (size_t)l * 64 * 64; const float* b2 = p.in[12] + l * 64;
  const float* w3 = p.in[13] + (size_t)l * 64 * 1024; const float* fr = p.in[14] + l * 64;
  const int nunits = Lf / 16;
  bool loaded = false;
  for (int u = blockIdx.x; u < nunits; u += gridDim.x) {
    __syncthreads();
    if (!loaded) {
      for (int i = tid; i < 33 * 64; i += NTHR) W1[i] = w1[i];
      for (int i = tid; i < 64 * 64; i += NTHR) W2[i] = w2[i];
      loaded = true;
    }
    const int t0 = u * 16;
    for (int i = tid; i < 16 * 33; i += NTHR) {
      int tt = i / 33, f = i % 33; int t = t0 + tt; float v;
      if (f == 0) v = (float)t / (float)(Lf - 1);
      else {
        int bi = (f - 1) & 15;
        float wv = 6.283185307179586f * (float)t / (float)Lf;
        float fb = 1e-4f + (15.f - 1e-4f) * (float)bi / 15.f;
        float ang = wv * fb;
        v = (f <= 16) ? cosf(ang) : -sinf(ang);
      }
      Z[tt * 36 + f] = v;
    }
    __syncthreads();
    for (int i = tid; i < 16 * 64; i += NTHR) {
      int tt = i >> 6, f = i & 63; float s = b1[f];
      for (int k = 0; k < 33; ++k) s += Z[tt * 36 + k] * W1[k * 64 + f];
      H1[tt * 64 + f] = sinf(fr[f] * s);
    }
    __syncthreads();
    for (int i = tid; i < 16 * 64; i += NTHR) {
      int tt = i >> 6, f = i & 63; float s = b2[f];
      for (int k = 0; k < 64; ++k) s += H1[tt * 64 + k] * W2[k * 64 + f];
      H2[tt * 64 + f] = sinf(fr[f] * s);
    }
    __syncthreads();
    float a0[16], a1[16];
#pragma unroll
    for (int i = 0; i < 16; ++i) { a0[i] = 0.f; a1[i] = 0.f; }
    for (int k = 0; k < 64; ++k) {
      float wa = w3[k * 1024 + tid], wb = w3[k * 1024 + 512 + tid];
#pragma unroll
      for (int i = 0; i < 16; ++i) { float h = H2[i * 64 + k]; a0[i] += h * wa; a1[i] += h * wb; }
    }
    {
      int w = tid & 255;
      float delta = fabsf(-3.0701134573253944f + (-15.350567286626972f + 3.0701134573253944f) * (float)w / 255.f);
#pragma unroll
      for (int i = 0; i < 16; ++i) {
        float tn = (float)(t0 + i) / (float)(Lf - 1);
        float dec = expf(-tn * delta);
        dst[(size_t)(t0 + i) * 1024 + tid] = a0[i] * dec;
        dst[(size_t)(t0 + i) * 1024 + 512 + tid] = a1[i] * dec;
      }
    }
  }
}

DI float2 cmul(float2 a, float2 b) { return make_float2(a.x * b.x - a.y * b.y, a.x * b.y + a.y * b.x); }
DI float2 cmulc(float2 a, float2 b) { return make_float2(a.x * b.x + a.y * b.y, a.y * b.x - a.x * b.y); }
DI void fft_dif(float2* X, const float2* W) {
  const int tid = my_tid();
  for (int ls = 12; ls >= 0; --ls) {
    const int span = 1 << ls;
    __syncthreads();
#pragma unroll
    for (int i = 0; i < 8; ++i) {
      int bf = tid + i * 512; int pos = bf & (span - 1); int i0 = ((bf >> ls) << (ls + 1)) + pos; int i1 = i0 + span;
      float2 a = X[i0], b = X[i1]; float2 w = W[span - 1 + pos];
      X[i0] = make_float2(a.x + b.x, a.y + b.y);
      X[i1] = cmul(make_float2(a.x - b.x, a.y - b.y), w);
    }
  }
  __syncthreads();
}
DI void fft_dit_inv(float2* X, const float2* W) {
  const int tid = my_tid();
  for (int ls = 0; ls <= 12; ++ls) {
    const int span = 1 << ls;
    __syncthreads();
#pragma unroll
    for (int i = 0; i < 8; ++i) {
      int bf = tid + i * 512; int pos = bf & (span - 1); int i0 = ((bf >> ls) << (ls + 1)) + pos; int i1 = i0 + span;
      float2 a = X[i0], b = X[i1]; float2 w = W[span - 1 + pos];
      float2 t = cmulc(b, w);
      X[i0] = make_float2(a.x + t.x, a.y + t.y);
      X[i1] = make_float2(a.x - t.x, a.y - t.y);
    }
  }
  __syncthreads();
}
DI void load_twiddles(const Params& p, float2* W) {
  const float2* tw = (const float2*)(p.ws + MISC_TW);
  for (int i = my_tid(); i < 8191; i += NTHR) {
    const int ls = 31 - __clz(i + 1); const int pos = i + 1 - (1 << ls);
    W[i] = tw[pos << (12 - ls)];
  }
}

DI void ph_kf(const Params& p, int l, char* smem) {
  float2* X = (float2*)smem; float2* W = X + 8192; float* red = (float*)(W + 8192);
  const int tid = my_tid(), lane = tid & 63, wid = tid >> 6;
  const float* rawf = (const float*)(p.ws + R_RAWF);
  float2* kf = (float2*)(p.ws + OFF_KF);
  bool tw = false;
  for (int u = blockIdx.x; u < 256; u += gridDim.x) {
    if (!tw) { load_twiddles(p, W); tw = true; }
    const int o = u >> 7, c = (u & 127) * 2;
    float2 fw[8], bw[8]; float sa = 0.f, sb = 0.f;
#pragma unroll
    for (int i = 0; i < 8; ++i) {
      int t = tid + i * 512;
      fw[i] = *(const float2*)(rawf + (size_t)t * 1024 + o * 512 + c);
      bw[i] = *(const float2*)(rawf + (size_t)t * 1024 + o * 512 + 256 + c);
      sa += fabsf(fw[i].x) + fabsf(bw[i].x); sb += fabsf(fw[i].y) + fabsf(bw[i].y);
    }
    sa = wave_sum(sa); sb = wave_sum(sb);
    __syncthreads();
    if (lane == 0) { red[wid * 2] = sa; red[wid * 2 + 1] = sb; }
    __syncthreads();
    float ta = 0.f, tb = 0.f;
#pragma unroll
    for (int w = 0; w < 8; ++w) { ta += red[w * 2]; tb += red[w * 2 + 1]; }
    const float ia = 1.f / ta, ib = 1.f / tb;
#pragma unroll
    for (int i = 0; i < 8; ++i) {
      int t = tid + i * 512;
      X[t] = make_float2(fw[i].x * ia, fw[i].y * ib);
      if (t >= 1) X[8192 - t] = make_float2(bw[i].x * ia, bw[i].y * ib);
      else X[4096] = make_float2(0.f, 0.f);
    }
    fft_dif(X, W);
    float2* ka = kf + (size_t)(o * 256 + c) * 8192; float2* kb = ka + 8192;
#pragma unroll 4
    for (int i = 0; i < 16; ++i) {
      int pidx = tid + i * 512;
      int k = (int)(__brev((unsigned)pidx) >> 19);
      int k2 = (8192 - k) & 8191;
      int p2 = (int)(__brev((unsigned)k2) >> 19);
      float2 c1 = X[pidx], c2 = X[p2];
      float2 A = make_float2(0.5f * (c1.x + c2.x), 0.5f * (c1.y - c2.y));
      float2 Bv = make_float2(0.5f * (c1.y + c2.y), -0.5f * (c1.x - c2.x));
      ka[pidx] = A; kb[pidx] = Bv;
    }
    __syncthreads();
  }
  if (l == 0) {
    const float* rawc = (const float*)(p.ws + MISC_RAWC);
    float* G = (float*)(p.ws + MISC_GCTX);
    for (int u = blockIdx.x * 8 + wid; u < 512; u += gridDim.x * 8) {
      int o = u >> 8, c = u & 255; float f[4], b[4]; float s = 0.f;
#pragma unroll
      for (int i = 0; i < 4; ++i) {
        int t = lane + i * 64;
        f[i] = rawc[(size_t)t * 1024 + o * 512 + c]; b[i] = rawc[(size_t)t * 1024 + o * 512 + 256 + c];
        s += fabsf(f[i]) + fabsf(b[i]);
      }
      s = wave_sum(s); float inv = 1.f / s;
#pragma unroll
      for (int i = 0; i < 4; ++i) {
        int t = lane + i * 64;
        G[(size_t)u * 512 + 256 + t] = f[i] * inv;
        if (t >= 1) G[(size_t)u * 512 + 256 - t] = b[i] * inv;
      }
      if (lane == 0) G[(size_t)u * 512] = 0.f;
    }
  }
}

DI void ph_ln(const float* __restrict__ src_lat, const float* __restrict__ src_ctx, float* dst_lat, float* dst_ctx,
              const float* __restrict__ ag, const float* __restrict__ ab, bf16_t* U, const float* __restrict__ mod, int sh_off, int nrows) {
  const int lane = my_tid() & 63, wid = my_tid() >> 6;
  for (int row = blockIdx.x * 8 + wid; row < nrows; row += gridDim.x * 8) {
    const float* src = row < ML ? src_lat + (size_t)row * D : src_ctx + (size_t)(row - ML) * D;
    float4 v[4];
#pragma unroll
    for (int i = 0; i < 4; ++i) v[i] = *(const float4*)(src + i * 256 + lane * 4);
    float s = 0.f;
#pragma unroll
    for (int i = 0; i < 4; ++i) s += v[i].x + v[i].y + v[i].z + v[i].w;
    float mu = wave_sum(s) * (1.f / 1024.f);
    float q = 0.f;
#pragma unroll
    for (int i = 0; i < 4; ++i) { v[i].x -= mu; v[i].y -= mu; v[i].z -= mu; v[i].w -= mu; q += v[i].x * v[i].x + v[i].y * v[i].y + v[i].z * v[i].z + v[i].w * v[i].w; }
    float rs = rsqrtf(wave_sum(q) * (1.f / 1024.f) + 1e-6f);
#pragma unroll
    for (int i = 0; i < 4; ++i) { v[i].x *= rs; v[i].y *= rs; v[i].z *= rs; v[i].w *= rs; }
    if (ag) {
      float* dst = row < ML ? dst_lat + (size_t)row * D : dst_ctx + (size_t)(row - ML) * D;
#pragma unroll
      for (int i = 0; i < 4; ++i) {
        float4 gg = *(const float4*)(ag + i * 256 + lane * 4), bb = *(const float4*)(ab + i * 256 + lane * 4);
        v[i].x = v[i].x * gg.x + bb.x; v[i].y = v[i].y * gg.y + bb.y; v[i].z = v[i].z * gg.z + bb.z; v[i].w = v[i].w * gg.w + bb.w;
        *(float4*)(dst + i * 256 + lane * 4) = v[i];
      }
      if (U) {
        s = 0.f;
#pragma unroll
        for (int i = 0; i < 4; ++i) s += v[i].x + v[i].y + v[i].z + v[i].w;
        mu = wave_sum(s) * (1.f / 1024.f); q = 0.f;
#pragma unroll
        for (int i = 0; i < 4; ++i) { v[i].x -= mu; v[i].y -= mu; v[i].z -= mu; v[i].w -= mu; q += v[i].x * v[i].x + v[i].y * v[i].y + v[i].z * v[i].z + v[i].w * v[i].w; }
        rs = rsqrtf(wave_sum(q) * (1.f / 1024.f) + 1e-6f);
#pragma unroll
        for (int i = 0; i < 4; ++i) { v[i].x *= rs; v[i].y *= rs; v[i].z *= rs; v[i].w *= rs; }
      }
    }
    if (U) {
      const float* m = mod + (size_t)mod_idx(row) * 6144 + sh_off;
#pragma unroll
      for (int i = 0; i < 4; ++i) {
        float4 sh = *(const float4*)(m + i * 256 + lane * 4), sc = *(const float4*)(m + 1024 + i * 256 + lane * 4);
        uint2 o; o.x = pack2(v[i].x * (1.f + sc.x) + sh.x, v[i].y * (1.f + sc.y) + sh.y);
        o.y = pack2(v[i].z * (1.f + sc.z) + sh.z, v[i].w * (1.f + sc.w) + sh.w);
        *(uint2*)(U + (size_t)row * D + i * 256 + lane * 4) = o;
      }
    }
  }
}

DI void ph_inproj(const Params& p, char* smem) {
  const bf16_t* U = (const bf16_t*)(p.ws + R_U);
  const bf16_t* Bt = (const bf16_t*)(p.ws + WB_IN);
  const int lane = my_tid() & 63, wid = my_tid() >> 6, wm = wid >> 1, wn = wid & 1, g = lane >> 4, r16 = lane & 15;
  for (int it = 0;; ++it) {
    int mtile, ntile;
    if (!next_tile(it, 136, 26, mtile, ntile)) break;
    f32x4 acc[4][4]; zero_acc<4>(acc);
    gemm_main<4, true>(acc, U, 1024, RowPlain{(long)mtile * 256}, Bt + (size_t)ntile * 128 * 1024, 1024, 1024, smem);
    int b, key0;
    if (mtile < 128) { b = mtile >> 4; key0 = (mtile & 15) * 256; } else { b = mtile - 128; key0 = SL; }
    bf16_t* tbase = nullptr; int tcols = 0, tcol0 = 0;
    if (ntile < 6) { tbase = (bf16_t*)(p.ws + R_PHY); tcols = 768; tcol0 = ntile * 128; }
    else if (ntile == 9) { tbase = (bf16_t*)(p.ws + R_VTSW); tcols = 128; tcol0 = 0; }
    else if (ntile == 14 || ntile == 15) { tbase = (bf16_t*)(p.ws + R_VTDF); tcols = 256; tcol0 = (ntile - 14) * 128; }
    if (tbase) {
#pragma unroll
      for (int mt = 0; mt < 4; ++mt)
#pragma unroll
        for (int nt = 0; nt < 4; ++nt) {
          int col = tcol0 + wn * 64 + r16 * 4 + nt;
          int key = key0 + wm * 64 + mt * 16 + g * 4;
          uint2 o; o.x = pack2(acc[mt][nt][0], acc[mt][nt][1]); o.y = pack2(acc[mt][nt][2], acc[mt][nt][3]);
          *(uint2*)(tbase + ((size_t)b * tcols + col) * KEYS + key) = o;
        }
    } else {
      bf16_t* rb; int ld, c0, cmax;
      if (ntile < 9) { rb = (bf16_t*)(p.ws + R_PSW); ld = 384; c0 = (ntile - 6) * 128; cmax = 384; }
      else if (ntile < 14) { rb = (bf16_t*)(p.ws + R_PDF); ld = 512; c0 = (ntile - 10) * 128; cmax = 512; }
      else { rb = (bf16_t*)(p.ws + R_PRW); ld = 1216; c0 = (ntile - 16) * 128; cmax = 1216; }
      const int col = c0 + wn * 64 + r16 * 4;
      if (col < cmax) {
#pragma unroll
        for (int mt = 0; mt < 4; ++mt)
#pragma unroll
          for (int j = 0; j < 4; ++j) {
            size_t row = (size_t)mtile * 256 + wm * 64 + mt * 16 + g * 4 + j;
            uint2 o; o.x = pack2(acc[mt][0][j], acc[mt][1][j]); o.y = pack2(acc[mt][2][j], acc[mt][3][j]);
            *(uint2*)(rb + row * ld + col) = o;
          }
      }
    }
  }
}

DI float hy_conv3(const bf16_t* __restrict__ P, int t, int len, float w0, float w1, float w2, float bias) {
  float a = t >= 1 ? bf2f(P[t - 1]) : 0.f, b = bf2f(P[t]), c = (t + 1 < len) ? bf2f(P[t + 1]) : 0.f;
  return w0 * a + w1 * b + w2 * c + bias;
}
DI void ph_hyena(const Params& p, int l, char* smem) {
  float2* X = (float2*)smem; float2* W = X + 8192;
  const int tid = my_tid();
  const bf16_t* PT = (const bf16_t*)(p.ws + R_PHY);
  const float2* kf = (const float2*)(p.ws + OFF_KF);
  const float* cw = p.in[7] + (size_t)l * 3 * 768; const float* cb = p.in[8] + (size_t)l * 768;
  const float* hb = p.in[15] + (size_t)l * 512;
  bf16_t* Y = (bf16_t*)(p.ws + R_YHY);
  bool tw = false;
  for (int u = blockIdx.x; u < 1024; u += gridDim.x) {
    if (!tw) { load_twiddles(p, W); tw = true; }
    const int bp = u >> 8, c = u & 255; const int b0 = bp * 2, b1 = b0 + 1;
    const bf16_t* P0 = PT + ((size_t)b0 * 768) * KEYS; const bf16_t* P1 = PT + ((size_t)b1 * 768) * KEYS;
    float wv0 = cw[c], wv1 = cw[768 + c], wv2 = cw[1536 + c], bv = cb[c];
    float wa0 = cw[256 + c], wa1 = cw[768 + 256 + c], wa2 = cw[1536 + 256 + c], ba = cb[256 + c];
    float wb0 = cw[512 + c], wb1 = cw[768 + 512 + c], wb2 = cw[1536 + 512 + c], bb = cb[512 + c];
    const float bias0 = hb[c], bias1 = hb[256 + c];
    float2 vv[8];
    __syncthreads();
#pragma unroll
    for (int i = 0; i < 8; ++i) {
      int t = tid + i * 512;
      vv[i].x = hy_conv3(P0 + (size_t)c * KEYS, t, SL, wv0, wv1, wv2, bv);
      vv[i].y = hy_conv3(P1 + (size_t)c * KEYS, t, SL, wv0, wv1, wv2, bv);
      X[t] = vv[i]; X[t + 4096] = make_float2(0.f, 0.f);
    }
    fft_dif(X, W);
    {
      const float2* H = kf + (size_t)c * 8192;
#pragma unroll 4
      for (int i = 0; i < 16; ++i) { int q = tid + i * 512; X[q] = cmul(X[q], H[q]); }
    }
    fft_dit_inv(X, W);
    float2 zz[8];
#pragma unroll
    for (int i = 0; i < 8; ++i) {
      int t = tid + i * 512;
      float2 y = X[t];
      float x1a = hy_conv3(P0 + (size_t)(256 + c) * KEYS, t, SL, wa0, wa1, wa2, ba);
      float x1b = hy_conv3(P1 + (size_t)(256 + c) * KEYS, t, SL, wa0, wa1, wa2, ba);
      zz[i].x = x1a * (y.x * (1.f / 8192.f) + bias0 * vv[i].x);
      zz[i].y = x1b * (y.y * (1.f / 8192.f) + bias0 * vv[i].y);
    }
    __syncthreads();
#pragma unroll
    for (int i = 0; i < 8; ++i) { int t = tid + i * 512; X[t] = zz[i]; X[t + 4096] = make_float2(0.f, 0.f); }
    fft_dif(X, W);
    {
      const float2* H = kf + (size_t)(256 + c) * 8192;
#pragma unroll 4
      for (int i = 0; i < 16; ++i) { int q = tid + i * 512; X[q] = cmul(X[q], H[q]); }
    }
    fft_dit_inv(X, W);
#pragma unroll
    for (int i = 0; i < 8; ++i) {
      int t = tid + i * 512;
      float2 y = X[t];
      float x2a = hy_conv3(P0 + (size_t)(512 + c) * KEYS, t, SL, wb0, wb1, wb2, bb);
      float x2b = hy_conv3(P1 + (size_t)(512 + c) * KEYS, t, SL, wb0, wb1, wb2, bb);
      float oa = x2a * (y.x * (1.f / 8192.f) + bias1 * zz[i].x);
      float ob = x2b * (y.y * (1.f / 8192.f) + bias1 * zz[i].y);
      Y[((size_t)b0 * SL + t) * 256 + c] = (bf16_t)f2bf(oa);
      Y[((size_t)b1 * SL + t) * 256 + c] = (bf16_t)f2bf(ob);
    }
  }
}

DI void ph_hyena_ctx(const Params& p, int l, char* smem) {
  const int tid = my_tid(), lane = tid & 63, wid = tid >> 6;
  float* Zb = (float*)smem + wid * 1024;
  float* Gb = Zb + 256;
  const bf16_t* PT = (const bf16_t*)(p.ws + R_PHY);
  const float* G = (const float*)(p.ws + MISC_GCTX);
  const float* cw = p.in[7] + (size_t)l * 3 * 768; const float* cb = p.in[8] + (size_t)l * 768;
  const float* hb = p.in[15] + (size_t)l * 512;
  bf16_t* Y = (bf16_t*)(p.ws + R_YHY);
  for (int base = blockIdx.x * 8; base < 2048; base += gridDim.x * 8) {
    const int u = base + wid; const int b = u >> 8, c = u & 255;
    const bf16_t* Pb = PT + ((size_t)b * 768) * KEYS + SL;
    float v[4], x1[4], x2[4], zz[4];
#pragma unroll
    for (int i = 0; i < 4; ++i) {
      int t = lane + i * 64;
      v[i] = hy_conv3(Pb + (size_t)c * KEYS, t, CL, cw[c], cw[768 + c], cw[1536 + c], cb[c]);
      x1[i] = hy_conv3(Pb + (size_t)(256 + c) * KEYS, t, CL, cw[256 + c], cw[768 + 256 + c], cw[1536 + 256 + c], cb[256 + c]);
      x2[i] = hy_conv3(Pb + (size_t)(512 + c) * KEYS, t, CL, cw[512 + c], cw[768 + 512 + c], cw[1536 + 512 + c], cb[512 + c]);
    }
    __syncthreads();
#pragma unroll
    for (int i = 0; i < 4; ++i) Zb[lane + i * 64] = v[i];
    for (int i = lane; i < 512; i += 64) Gb[i] = G[(size_t)c * 512 + i];
    __syncthreads();
#pragma unroll
    for (int i = 0; i < 4; ++i) {
      int t = lane + i * 64; float s = 0.f;
      for (int s2 = 0; s2 < 256; ++s2) s += Gb[256 + t - s2] * Zb[s2];
      zz[i] = x1[i] * (s + hb[c] * v[i]);
    }
    __syncthreads();
#pragma unroll
    for (int i = 0; i < 4; ++i) Zb[lane + i * 64] = zz[i];
    for (int i = lane; i < 512; i += 64) Gb[i] = G[(size_t)(256 + c) * 512 + i];
    __syncthreads();
#pragma unroll
    for (int i = 0; i < 4; ++i) {
      int t = lane + i * 64; float s = 0.f;
      for (int s2 = 0; s2 < 256; ++s2) s += Gb[256 + t - s2] * Zb[s2];
      float o = x2[i] * (s + hb[256 + c] * zz[i]);
      Y[((size_t)ML + b * CL + t) * 256 + c] = (bf16_t)f2bf(o);
    }
  }
}

DI void ph_rope(const Params& p, char* smem) {
  float2* T16 = (float2*)smem;
  float2* T8 = T16 + 64 * 16;
  const int tid = my_tid(), lane = tid & 63, wid = tid >> 6;
  __syncthreads();
  for (int i = tid; i < 64 * 16; i += NTHR) {
    int pos = i >> 4, f = i & 15; float inv = powf(10000.f, -(float)f / 16.f); float s, c; sincosf((float)pos * inv, &s, &c);
    T16[i] = make_float2(c, s);
  }
  for (int i = tid; i < 64 * 8; i += NTHR) {
    int pos = i >> 3, f = i & 7; float inv = powf(10000.f, -(float)f / 8.f); float s, c; sincosf((float)pos * inv, &s, &c);
    T8[i] = make_float2(c, s);
  }
  __syncthreads();
  bf16_t* Psw = (bf16_t*)(p.ws + R_PSW); bf16_t* Pdf = (bf16_t*)(p.ws + R_PDF);
  for (int row = blockIdx.x * 8 + wid; row < ML; row += gridDim.x * 8) {
    const int t = row & (SL - 1); const int pr = t >> 6, pc = t & 63;
    bf16_t* q = Psw + (size_t)row * 384;
#pragma unroll
    for (int i = 0; i < 3; ++i) {
      int pi = lane + i * 64; int hd = pi >> 5, pp = pi & 31; int half = pp >> 4, f = pp & 15;
      int base = hd * 64 + half * 32; float2 cs = T16[(half ? pc : pr) * 16 + f];
      float x1 = bf2f(q[base + f]), x2 = bf2f(q[base + 16 + f]);
      q[base + f] = (bf16_t)f2bf(x1 * cs.x - x2 * cs.y); q[base + 16 + f] = (bf16_t)f2bf(x1 * cs.y + x2 * cs.x);
    }
    bf16_t* d = Pdf + (size_t)row * 512;
#pragma unroll
    for (int i = 0; i < 4; ++i) {
      int pi = lane + i * 64; int gi = pi >> 4, pp = pi & 15; int half = pp >> 3, f = pp & 7;
      int base = gi * 32 + half * 16; float2 cs = T8[(half ? pc : pr) * 8 + f];
      float x1 = bf2f(d[base + f]), x2 = bf2f(d[base + 8 + f]);
      d[base + f] = (bf16_t)f2bf(x1 * cs.x - x2 * cs.y); d[base + 8 + f] = (bf16_t)f2bf(x1 * cs.y + x2 * cs.x);
    }
  }
}

DI float rw_shift(const bf16_t* __restrict__ P, int row, int t, int len, int col, float mu) {
  float c = bf2f(P[(size_t)row * 1216 + col]);
  float a = t >= 1 ? bf2f(P[(size_t)(row - 1) * 1216 + col]) : 0.f;
  float b = t + 1 < len ? bf2f(P[(size_t)(row + 1) * 1216 + col]) : 0.f;
  return c + (0.5f * (a + b) - c) * mu;
}
DI void ph_rwprep(const Params& p, int l, char* smem) {
  constexpr int AST = 912, RST = 1552, ROFF = 32 * AST;
  const int tid = my_tid(), lane = tid & 63, wid = tid >> 6, g = lane >> 4, r16 = lane & 15;
  const int tg = wid >> 2, hd = wid & 3;
  const bf16_t* P = (const bf16_t*)(p.ws + R_PRW);
  const float* mu = p.in[17] + (size_t)l * 1216;
  const float* w0 = p.in[18] + (size_t)l * 512; const float* a0 = p.in[20] + (size_t)l * 256;
  const float* kkw = p.in[23] + (size_t)l * 256; const float* kaw = p.in[24] + (size_t)l * 256;
  bf16_t* S = (bf16_t*)(p.ws + R_STR); bf16_t* Gs = (bf16_t*)(p.ws + R_G);
  const size_t SU = (size_t)MT * 256;
  float w0f[4], w0b[4], a0c[4], kkc[4], kac[4];
#pragma unroll
  for (int nt = 0; nt < 4; ++nt) { int c = hd * 64 + nt * 16 + r16; w0f[nt] = w0[c]; w0b[nt] = w0[256 + c]; a0c[nt] = a0[c]; kkc[nt] = kkw[c]; kac[nt] = kaw[c]; }
  for (int u = blockIdx.x; u < MT / 32; u += gridDim.x) {
    const int row0 = u * 32; int t0, len;
    if (row0 < ML) { t0 = row0 & (SL - 1); len = SL; } else { t0 = (row0 - ML) & (CL - 1); len = CL; }
    __syncthreads();
    for (int item = tid; item < 32 * 152; item += NTHR) {
      const int tk = item / 152, c8 = item - tk * 152; const int row = row0 + tk, t = t0 + tk;
      const uint4 uc = *(const uint4*)(P + (size_t)row * 1216 + c8 * 8);
      uint4 ua = make_uint4(0, 0, 0, 0), ub = make_uint4(0, 0, 0, 0);
      if (t >= 1) ua = *(const uint4*)(P + (size_t)(row - 1) * 1216 + c8 * 8);
      if (t + 1 < len) ub = *(const uint4*)(P + (size_t)(row + 1) * 1216 + c8 * 8);
      const float4 m0 = *(const float4*)(mu + c8 * 8), m1 = *(const float4*)(mu + c8 * 8 + 4);
      float o[8];
      {
        const unsigned wc[4] = {uc.x, uc.y, uc.z, uc.w}, wa[4] = {ua.x, ua.y, ua.z, ua.w}, wb[4] = {ub.x, ub.y, ub.z, ub.w};
        const float mm[8] = {m0.x, m0.y, m0.z, m0.w, m1.x, m1.y, m1.z, m1.w};
#pragma unroll
        for (int i = 0; i < 4; ++i) {
          float c_lo = bflo(wc[i]), c_hi = bfhi(wc[i]);
          o[2 * i] = c_lo + (0.5f * (bflo(wa[i]) + bflo(wb[i])) - c_lo) * mm[2 * i];
          o[2 * i + 1] = c_hi + (0.5f * (bfhi(wa[i]) + bfhi(wb[i])) - c_hi) * mm[2 * i + 1];
        }
      }
      char* dst;
      if (c8 < 96) dst = smem + ROFF + tk * RST + c8 * 16;
      else {
        const int cc = c8 * 8 - 768;
        if (cc < 128) {
#pragma unroll
          for (int i = 0; i < 8; ++i) o[i] = tanhf(o[i]);
        } else if (cc >= 192) {
#pragma unroll
          for (int i = 0; i < 8; ++i) o[i] = sigmoidf_(o[i]);
        }
        dst = smem + tk * AST + cc * 2;
      }
      uint4 ov; ov.x = pack2(o[0], o[1]); ov.y = pack2(o[2], o[3]); ov.z = pack2(o[4], o[5]); ov.w = pack2(o[6], o[7]);
      *(uint4*)dst = ov;
    }
    __syncthreads();
    f32x4 acc[5][4];
#pragma unroll
    for (int o5 = 0; o5 < 5; ++o5)
#pragma unroll
      for (int nt = 0; nt < 4; ++nt) acc[o5][nt] = (f32x4){0.f, 0.f, 0.f, 0.f};
    const char* Arow = smem + (tg * 16 + r16) * AST + g * 16;
#pragma unroll
    for (int o5 = 0; o5 < 5; ++o5) {
      const int kbase = o5 < 3 ? o5 * 64 : (o5 == 3 ? 192 : 320);
      const int KK = o5 < 3 ? 64 : 128;
      const bf16_t* Wt = (const bf16_t*)(p.ws + (o5 == 0 ? RWW_F : o5 == 1 ? RWW_B : o5 == 2 ? RWW_A : o5 == 3 ? RWW_GF : RWW_GB));
#pragma unroll
      for (int ks = 0; ks < KK / 32; ++ks) {
        const bf16x8 af = *(const bf16x8*)(Arow + (kbase + ks * 32) * 2);
#pragma unroll
        for (int nt = 0; nt < 4; ++nt) {
          const bf16x8 bf = *(const bf16x8*)(Wt + (size_t)(hd * 64 + nt * 16 + r16) * KK + ks * 32 + g * 8);
          acc[o5][nt] = __builtin_amdgcn_mfma_f32_16x16x32_bf16(af, bf, acc[o5][nt], 0, 0, 0);
        }
        if (ks & 1) asm volatile("" ::: "memory");
      }
    }
#pragma unroll
    for (int j = 0; j < 4; ++j) {
      const int tk = tg * 16 + g * 4 + j; const size_t row = (size_t)row0 + tk;
      const char* rk = smem + ROFF + tk * RST;
      float kv[4], n2 = 0.f;
#pragma unroll
      for (int nt = 0; nt < 4; ++nt) { int c = hd * 64 + nt * 16 + r16; kv[nt] = bf2f(*(const unsigned short*)(rk + (256 + c) * 2)); float q = kv[nt] * kkc[nt]; n2 += q * q; }
      n2 = sum16(n2);
      const float inv = 1.f / fmaxf(sqrtf(n2), 1e-12f);
#pragma unroll
      for (int nt = 0; nt < 4; ++nt) {
        const int c = hd * 64 + nt * 16 + r16;
        const float r = bf2f(*(const unsigned short*)(rk + c * 2)), v = bf2f(*(const unsigned short*)(rk + (512 + c) * 2)), k = kv[nt];
        const float a = sigmoidf_(a0c[nt] + acc[2][nt][j]);
        const float kk = k * kkc[nt] * inv;
        const float kp = k * (1.f + (a - 1.f) * kac[nt]);
        const float bq = kk * a;
        const float xf = -(w0f[nt] + acc[0][nt][j]); const float spf = fmaxf(xf, 0.f) + log1pf(__expf(-fabsf(xf)));
        const float xb = -(w0b[nt] + acc[1][nt][j]); const float spb = fmaxf(xb, 0.f) + log1pf(__expf(-fabsf(xb)));
        const float ef = __expf(-spf - 0.5f), eb = __expf(-spb - 0.5f);
        const float d_f = -expm1f(-ef), d_b = -expm1f(-eb);
        const size_t o = row * 256 + c;
        S[o] = (bf16_t)f2bf(r); S[SU + o] = (bf16_t)f2bf(kp); S[2 * SU + o] = (bf16_t)f2bf(v); S[3 * SU + o] = (bf16_t)f2bf(kk);
        S[4 * SU + o] = (bf16_t)f2bf(bq); S[5 * SU + o] = (bf16_t)f2bf(d_f); S[6 * SU + o] = (bf16_t)f2bf(d_b);
        Gs[o] = (bf16_t)f2bf(acc[3][nt][j]); Gs[SU + o] = (bf16_t)f2bf(acc[4][nt][j]);
      }
    }
  }
}

DI long scan_row(int b, int dir, int s) {
  if (s < CL) return (long)ML + b * CL + (dir ? (CL - 1 - s) : s);
  int t = s - CL; return (long)b * SL + (dir ? (SL - 1 - t) : t);
}
DI void ph_scan(const Params& p, char* smem) {
  const int tid = my_tid(), lane = tid & 63, wid = tid >> 6;
  const bf16_t* S = (const bf16_t*)(p.ws + R_STR);
  const size_t SU = (size_t)MT * 256;
  constexpr int T = 32, NSTEP = CL + SL, NCH = NSTEP / T;
  for (int u = blockIdx.x; u < 128; u += gridDim.x) {
    const int chain = u >> 1, rg = u & 1; const int dir = chain & 1, bh = chain >> 1, b = bh >> 2, h = bh & 3;
    bf16_t* O = (bf16_t*)(p.ws + (dir ? R_OB : R_OF));
    uint4 q0, q1, q2;
    auto SC_GLOAD = [&](int ci) {
#pragma unroll
      for (int j = 0; j < 3; ++j) {
        int idx = tid + j * 512; int st = idx >> 8, s = (idx & 255) >> 3, ck = idx & 7;
        long row = scan_row(b, dir, ci * T + s);
        int sid = st < 5 ? st : 5 + dir;
        uint4 v = *(const uint4*)(S + sid * SU + row * 256 + h * 64 + ck * 8);
        if (j == 0) q0 = v; else if (j == 1) q1 = v; else q2 = v;
      }
    };
    auto SC_SSTORE = [&](int buf) {
#pragma unroll
      for (int j = 0; j < 3; ++j) {
        int idx = tid + j * 512; int st = idx >> 8;
        uint4 v = j == 0 ? q0 : (j == 1 ? q1 : q2);
        float4 lo = make_float4(bflo(v.x), bfhi(v.x), bflo(v.y), bfhi(v.y));
        float4 hi = make_float4(bflo(v.z), bfhi(v.z), bflo(v.w), bfhi(v.w));
        if (st == 5) { lo.x = 1.f - lo.x; lo.y = 1.f - lo.y; lo.z = 1.f - lo.z; lo.w = 1.f - lo.w; hi.x = 1.f - hi.x; hi.y = 1.f - hi.y; hi.z = 1.f - hi.z; hi.w = 1.f - hi.w; }
        char* base = smem + buf * 49152 + idx * 32;
        *(float4*)(base) = lo; *(float4*)(base + 16) = hi;
      }
    };
    auto FLUSH = [&](int ci) {
      const int s = tid >> 4, part = tid & 15;
      unsigned v = *(const unsigned*)(smem + 98304 + (ci & 1) * 2048 + s * 64 + part * 4);
      long row = scan_row(b, dir, ci * T + s);
      *(unsigned*)(O + row * 256 + h * 64 + rg * 32 + part * 2) = v;
    };
    __syncthreads();
    SC_GLOAD(0);
    SC_SSTORE(0);
    __syncthreads();
    float s0 = 0.f, s1 = 0.f, s2 = 0.f, s3 = 0.f;
    const int rsub = lane >> 4, ks = lane & 15;
    const int lrow = wid * 4 + rsub;
    const int vrow = rg * 32 + lrow;
    for (int ci = 0; ci < NCH; ++ci) {
      if (ci + 1 < NCH) { SC_GLOAD(ci + 1); }
      if (ci > 0) FLUSH(ci - 1);
      {
        const char* B = smem + (ci & 1) * 49152;
        bf16_t* ob = (bf16_t*)(smem + 98304 + (ci & 1) * 2048);
        float4 nr = *(const float4*)(B + (0 * T + 0) * 256 + ks * 16);
        float4 nk = *(const float4*)(B + (1 * T + 0) * 256 + ks * 16);
        float nv = *(const float*)(B + (2 * T + 0) * 256 + vrow * 4);
        float4 nkk = *(const float4*)(B + (3 * T + 0) * 256 + ks * 16);
        float4 nb = *(const float4*)(B + (4 * T + 0) * 256 + ks * 16);
        float4 nw = *(const float4*)(B + (5 * T + 0) * 256 + ks * 16);
#pragma unroll 2
        for (int s = 0; s < T; ++s) {
          const float4 cr = nr, ck = nk, ckk = nkk, cb = nb, cw = nw; const float cv = nv;
          const int sn = (s + 1 < T) ? s + 1 : s;
          nr = *(const float4*)(B + (0 * T + sn) * 256 + ks * 16);
          nk = *(const float4*)(B + (1 * T + sn) * 256 + ks * 16);
          nv = *(const float*)(B + (2 * T + sn) * 256 + vrow * 4);
          nkk = *(const float4*)(B + (3 * T + sn) * 256 + ks * 16);
          nb = *(const float4*)(B + (4 * T + sn) * 256 + ks * 16);
          nw = *(const float4*)(B + (5 * T + sn) * 256 + ks * 16);
          float sa = -((s0 * ckk.x + s1 * ckk.y) + (s2 * ckk.z + s3 * ckk.w));
          sa = sum16(sa);
          s0 = s0 * cw.x + sa * cb.x + cv * ck.x;
          s1 = s1 * cw.y + sa * cb.y + cv * ck.y;
          s2 = s2 * cw.z + sa * cb.z + cv * ck.z;
          s3 = s3 * cw.w + sa * cb.w + cv * ck.w;
          float o = (s0 * cr.x + s1 * cr.y) + (s2 * cr.z + s3 * cr.w);
          o = sum16(o);
          if (ks == 0) ob[s * 32 + lrow] = (bf16_t)f2bf(o);
        }
      }
      if (ci + 1 < NCH) { SC_SSTORE((ci + 1) & 1); }
      __syncthreads();
    }
    FLUSH(NCH - 1);
  }
}

template <bool DIFF>
DI void attn_unit(const Params& p, int l, int b, int h, int qrow0, int qpos0, int kb_lo, int kb_hi, int kc_lo, char* smem) {
  const int tid = my_tid(), lane = tid & 63, wid = tid >> 6, g = lane >> 4, r16 = lane & 15;
  const bf16_t* QK = (const bf16_t*)(p.ws + (DIFF ? R_PDF : R_PSW));
  const int ldq = DIFF ? 512 : 384;
  const int qc0 = h * 64;
  const int kc0 = 256 + (DIFF ? h * 64 : (h >> 1) * 64);
  const bf16_t* VT = DIFF ? (const bf16_t*)(p.ws + R_VTDF) + ((size_t)b * 256 + h * 64) * KEYS
                          : (const bf16_t*)(p.ws + R_VTSW) + ((size_t)b * 128 + (h >> 1) * 64) * KEYS;
  const int nblk = (kb_hi - kb_lo) + (68 - kc_lo);
  const float sc = (DIFF ? 0.17677669529663687f : 0.125f) * 1.4426950408889634f;
  bf16x8 qf[2];
  {
    const bf16_t* qp = QK + (size_t)(qrow0 + wid * 16 + r16) * ldq + qc0 + g * 8;
    qf[0] = *(const bf16x8*)(qp); qf[1] = *(const bf16x8*)(qp + 32);
  }
  constexpr int NC = DIFF ? 2 : 1;
  float m[NC], lsum[NC];
  f32x4 O[NC][4];
#pragma unroll
  for (int c = 0; c < NC; ++c) {
    if (DIFF) { m[c] = -1e30f; lsum[c] = 0.f; }
    else { m[c] = p.in[16][l * 4 + h] * 1.4426950408889634f; lsum[c] = (g == 0) ? 1.f : 0.f; }
#pragma unroll
    for (int dt = 0; dt < 4; ++dt) O[c][dt] = (f32x4){0.f, 0.f, 0.f, 0.f};
  }
  const int lr = tid >> 3, lc = tid & 7;
  uint4 rk, rv;
#define AT_GLOAD(i)                                                                                   \
  do {                                                                                                \
    int kb = (i) < (kb_hi - kb_lo) ? kb_lo + (i) : kc_lo + ((i) - (kb_hi - kb_lo));                    \
    long krow = kb < 64 ? (long)b * SL + kb * 64 + lr : (long)ML + b * CL + (kb - 64) * 64 + lr;       \
    rk = *(const uint4*)(QK + krow * ldq + kc0 + lc * 8);                                             \
    rv = *(const uint4*)(VT + (size_t)lr * KEYS + kb * 64 + lc * 8);                                  \
  } while (0)
#define AT_SSTORE(buf)                                                                                \
  do {                                                                                                \
    *(uint4*)(smem + (buf) * 18432 + lr * 144 + lc * 16) = rk;                                        \
    *(uint4*)(smem + (buf) * 18432 + 9216 + lr * 144 + lc * 16) = rv;                                 \
  } while (0)
  __syncthreads();
  AT_GLOAD(0);
  AT_SSTORE(0);
  __syncthreads();
  const int qpos = qpos0 + wid * 16 + r16;
  for (int i = 0; i < nblk; ++i) {
    if (i + 1 < nblk) AT_GLOAD(i + 1);
    const int kb = i < (kb_hi - kb_lo) ? kb_lo + i : kc_lo + (i - (kb_hi - kb_lo));
    const bool masked = (!DIFF) && (kb < 64);
    const char* Kt = smem + (i & 1) * 18432; const char* Vt = Kt + 9216;
    f32x4 S[NC][4];
#pragma unroll
    for (int kt = 0; kt < 4; ++kt) {
      bf16x8 k0 = *(const bf16x8*)(Kt + (kt * 16 + r16) * 144 + g * 16);
      bf16x8 k1 = *(const bf16x8*)(Kt + (kt * 16 + r16) * 144 + 64 + g * 16);
      if (DIFF) {
        S[0][kt] = __builtin_amdgcn_mfma_f32_16x16x32_bf16(k0, qf[0], (f32x4){0.f, 0.f, 0.f, 0.f}, 0, 0, 0);
        S[NC - 1][kt] = __builtin_amdgcn_mfma_f32_16x16x32_bf16(k1, qf[1], (f32x4){0.f, 0.f, 0.f, 0.f}, 0, 0, 0);
      } else {
        f32x4 t = __builtin_amdgcn_mfma_f32_16x16x32_bf16(k0, qf[0], (f32x4){0.f, 0.f, 0.f, 0.f}, 0, 0, 0);
        S[0][kt] = __builtin_amdgcn_mfma_f32_16x16x32_bf16(k1, qf[1], t, 0, 0, 0);
      }
    }
    bf16x8 pf[NC][2];
#pragma unroll
    for (int c = 0; c < NC; ++c) {
      float mx = -1e30f;
#pragma unroll
      for (int kt = 0; kt < 4; ++kt)
#pragma unroll
        for (int j = 0; j < 4; ++j) {
          float v = S[c][kt][j] * sc;
          if (masked) { int kpos = kb * 64 + kt * 16 + g * 4 + j; int dd = kpos - qpos; if (dd > 128 || dd < -128) v = -1e30f; }
          S[c][kt][j] = v; mx = fmaxf(mx, v);
        }
      mx = fmaxf(mx, __shfl_xor(mx, 16)); mx = fmaxf(mx, __shfl_xor(mx, 32));
      float mn = fmaxf(m[c], mx);
      float alpha = __builtin_amdgcn_exp2f(m[c] - mn);
      m[c] = mn;
      float ps = 0.f;
      unsigned pk[8];
#pragma unroll
      for (int kt = 0; kt < 4; ++kt) {
        float e0 = __builtin_amdgcn_exp2f(S[c][kt][0] - mn), e1 = __builtin_amdgcn_exp2f(S[c][kt][1] - mn), e2 = __builtin_amdgcn_exp2f(S[c][kt][2] - mn), e3 = __builtin_amdgcn_exp2f(S[c][kt][3] - mn);
        ps += (e0 + e1) + (e2 + e3);
        pk[kt * 2] = pack2(e0, e1); pk[kt * 2 + 1] = pack2(e2, e3);
      }
      lsum[c] = lsum[c] * alpha + ps;
#pragma unroll
      for (int dt = 0; dt < 4; ++dt) { O[c][dt][0] *= alpha; O[c][dt][1] *= alpha; O[c][dt][2] *= alpha; O[c][dt][3] *= alpha; }
      union { unsigned u[4]; bf16x8 v; } cv;
      cv.u[0] = pk[0]; cv.u[1] = pk[1]; cv.u[2] = pk[2]; cv.u[3] = pk[3]; pf[c][0] = cv.v;
      cv.u[0] = pk[4]; cv.u[1] = pk[5]; cv.u[2] = pk[6]; cv.u[3] = pk[7]; pf[c][1] = cv.v;
    }
#pragma unroll
    for (int dt = 0; dt < 4; ++dt)
#pragma unroll
      for (int s2 = 0; s2 < 2; ++s2) {
        union { uint2 u[2]; bf16x8 v; } vf;
        vf.u[0] = *(const uint2*)(Vt + (dt * 16 + r16) * 144 + (2 * s2) * 32 + g * 8);
        vf.u[1] = *(const uint2*)(Vt + (dt * 16 + r16) * 144 + (2 * s2 + 1) * 32 + g * 8);
#pragma unroll
        for (int c = 0; c < NC; ++c) O[c][dt] = __builtin_amdgcn_mfma_f32_16x16x32_bf16(vf.v, pf[c][s2], O[c][dt], 0, 0, 0);
      }
    if (i + 1 < nblk) AT_SSTORE((i + 1) & 1);
    __syncthreads();
  }
#undef AT_GLOAD
#undef AT_SSTORE
  float linv[NC];
#pragma unroll
  for (int c = 0; c < NC; ++c) { float t = lsum[c]; t += __shfl_xor(t, 16); t += __shfl_xor(t, 32); linv[c] = 1.f / t; }
  const size_t orow = (size_t)(qrow0 + wid * 16 + r16);
  if (!DIFF) {
    bf16_t* Y = (bf16_t*)(p.ws + R_YSW);
#pragma unroll
    for (int dt = 0; dt < 4; ++dt) {
      uint2 o; o.x = pack2(O[0][dt][0] * linv[0], O[0][dt][1] * linv[0]); o.y = pack2(O[0][dt][2] * linv[0], O[0][dt][3] * linv[0]);
      *(uint2*)(Y + orow * 256 + h * 64 + dt * 16 + g * 4) = o;
    }
  } else {
    const float lam_init = 0.8f - 0.6f * __expf(-0.3f * (float)l);
    float d1 = 0.f, d2 = 0.f;
    if (lane < 32) { d1 = p.in[28][l * 32 + lane] * p.in[29][l * 32 + lane]; d2 = p.in[30][l * 32 + lane] * p.in[31][l * 32 + lane]; }
    d1 = wave_sum(d1); d2 = wave_sum(d2);
    const float lam = expf(d1) - expf(d2) + lam_init;
    float ov[4][4]; float ss = 0.f;
#pragma unroll
    for (int dt = 0; dt < 4; ++dt)
#pragma unroll
      for (int j = 0; j < 4; ++j) { float v = O[0][dt][j] * linv[0] - lam * O[NC - 1][dt][j] * linv[NC - 1]; ov[dt][j] = v; ss += v * v; }
    ss += __shfl_xor(ss, 16); ss += __shfl_xor(ss, 32);
    const float rms = rsqrtf(ss * (1.f / 64.f) + 1e-5f) * (1.f - lam_init);
    const float* sg = p.in[32] + l * 64;
    bf16_t* Y = (bf16_t*)(p.ws + R_YDF);
#pragma unroll
    for (int dt = 0; dt < 4; ++dt) {
      const int d0 = dt * 16 + g * 4;
      uint2 o; o.x = pack2(ov[dt][0] * rms * sg[d0], ov[dt][1] * rms * sg[d0 + 1]); o.y = pack2(ov[dt][2] * rms * sg[d0 + 2], ov[dt][3] * rms * sg[d0 + 3]);
      *(uint2*)(Y + orow * 256 + h * 64 + d0) = o;
    }
  }
}

DI void ph_attn(const Params& p, int l, char* smem) {
  const bool need_ctx = (l == 0);
  const int n_sw = 1024 + (need_ctx ? 64 : 0);
  const int n_df = 1024 + (need_ctx ? 64 : 0);
  unsigned* ctr = (unsigned*)(p.ws + MISC_BAR + 64 + 64 * l);
  volatile int* slot = (volatile int*)(smem + 40960);
  for (;;) {
    __syncthreads();
    if (my_tid() == 0) *slot = (int)__hip_atomic_fetch_add(ctr, 1u, __ATOMIC_RELAXED, __HIP_MEMORY_SCOPE_AGENT);
    __syncthreads();
    const int u = *slot;
    if (u >= n_sw + n_df) break;
    if (u < n_df) {
      if (u < 1024) { int b = u >> 7, h = (u >> 5) & 3, n = u & 31; attn_unit<true>(p, l, b, h, b * SL + n * 128, n * 128, 0, 64, 64, smem); }
      else { int v = u - 1024; int b = v >> 3, h = (v >> 1) & 3, n = v & 1; attn_unit<true>(p, l, b, h, ML + b * CL + n * 128, 0, 0, 0, 64, smem); }
    } else {
      int w = u - n_df;
      if (w < 1024) {
        int b = w >> 7, h = (w >> 5) & 3, n = w & 31;
        int lo = (n - 1) * 2; if (lo < 0) lo = 0; int hi = (n + 2) * 2; if (hi > 64) hi = 64;
        attn_unit<false>(p, l, b, h, b * SL + n * 128, n * 128, lo, hi, 64, smem);
      } else { int v = w - 1024; int b = v >> 3, h = (v >> 1) & 3, n = v & 1; attn_unit<false>(p, l, b, h, ML + b * CL + n * 128, 0, 0, 0, 64, smem); }
    }
  }
}

DI void ph_rwout(const Params& p, int l) {
  const int lane = my_tid() & 63, wid = my_tid() >> 6;
  const bf16_t* S = (const bf16_t*)(p.ws + R_STR); const bf16_t* Gs = (const bf16_t*)(p.ws + R_G);
  const bf16_t* OF = (const bf16_t*)(p.ws + R_OF); const bf16_t* OB = (const bf16_t*)(p.ws + R_OB);
  bf16_t* Y = (bf16_t*)(p.ws + R_YRW);
  const size_t SU = (size_t)MT * 256;
  const float4 rk = *(const float4*)(p.in[25] + (size_t)l * 256 + lane * 4);
  const float4 gam = *(const float4*)(p.in[26] + (size_t)l * 256 + lane * 4);
  const float4 bet = *(const float4*)(p.in[27] + (size_t)l * 256 + lane * 4);
  const int nrows = (l == 0) ? MT : ML;
  for (int row = blockIdx.x * 8 + wid; row < nrows; row += gridDim.x * 8) {
    const size_t o = (size_t)row * 256 + lane * 4;
    uint2 ur = *(const uint2*)(S + o), uk = *(const uint2*)(S + SU + o), uv = *(const uint2*)(S + 2 * SU + o);
    uint2 uf = *(const uint2*)(OF + o), ub = *(const uint2*)(OB + o), ugf = *(const uint2*)(Gs + o), ugb = *(const uint2*)(Gs + SU + o);
    float r[4] = {bflo(ur.x), bfhi(ur.x), bflo(ur.y), bfhi(ur.y)};
    float k[4] = {bflo(uk.x), bfhi(uk.x), bflo(uk.y), bfhi(uk.y)};
    float v[4] = {bflo(uv.x), bfhi(uv.x), bflo(uv.y), bfhi(uv.y)};
    float f[4] = {bflo(uf.x), bfhi(uf.x), bflo(uf.y), bfhi(uf.y)};
    float bb[4] = {bflo(ub.x), bfhi(ub.x), bflo(ub.y), bfhi(ub.y)};
    float gf[4] = {bflo(ugf.x), bfhi(ugf.x), bflo(ugf.y), bfhi(ugf.y)};
    float gb[4] = {bflo(ugb.x), bfhi(ugb.x), bflo(ugb.y), bfhi(ugb.y)};
    const float rkv[4] = {rk.x, rk.y, rk.z, rk.w}; const float ga[4] = {gam.x, gam.y, gam.z, gam.w}; const float be[4] = {bet.x, bet.y, bet.z, bet.w};
    float bon = 0.f, sf = 0.f, sb = 0.f;
#pragma unroll
    for (int i = 0; i < 4; ++i) { bon += r[i] * k[i] * rkv[i]; sf += f[i]; sb += bb[i]; }
    bon = sum16(bon); float muf = sum16(sf) * (1.f / 64.f), mub = sum16(sb) * (1.f / 64.f);
    float qf = 0.f, qb = 0.f;
#pragma unroll
    for (int i = 0; i < 4; ++i) { f[i] -= muf; bb[i] -= mub; qf += f[i] * f[i]; qb += bb[i] * bb[i]; }
    float rsf = rsqrtf(sum16(qf) * (1.f / 64.f) + 64e-5f), rsb = rsqrtf(sum16(qb) * (1.f / 64.f) + 64e-5f);
    float y[4];
#pragma unroll
    for (int i = 0; i < 4; ++i) {
      float bn = bon * v[i];
      y[i] = (f[i] * rsf * ga[i] + be[i] + bn) * gf[i] + (bb[i] * rsb * ga[i] + be[i] + bn) * gb[i];
    }
    uint2 oo; oo.x = pack2(y[0], y[1]); oo.y = pack2(y[2], y[3]);
    *(uint2*)(Y + o) = oo;
  }
}

DI void ph_merge(const Params& p, int l, char* smem) {
  const bf16_t* U = (const bf16_t*)(p.ws + R_URE);
  const int lane = my_tid() & 63, wid = my_tid() >> 6, wm = wid >> 1, wn = wid & 1, g = lane >> 4, r16 = lane & 15;
  const int mtiles = (l == 0) ? 136 : 128;
  bf16_t* ACC = (bf16_t*)(p.ws + R_ACC);
  for (int it = 0;; ++it) {
    int mtile, ntile;
    if (!next_tile(it, mtiles, 8, mtile, ntile)) break;
    uint2 accS[4][4];
#pragma unroll
    for (int mt = 0; mt < 4; ++mt)
#pragma unroll
      for (int nt = 0; nt < 4; ++nt) accS[mt][nt] = make_uint2(0u, 0u);
    for (int j = 0; j < 4; ++j) {
      uint2 pb[4][4];
      {
        f32x4 accB[4][4]; zero_acc<4>(accB);
        const size_t yoff = (j == 0) ? R_YHY : (j == 1) ? R_YSW : (j == 2) ? R_YRW : R_YDF;
        gemm_main<4, false>(accB, (const bf16_t*)(p.ws + yoff), 256, RowPlain{(long)mtile * 256}, (const bf16_t*)(p.ws + WB_BR) + ((size_t)j * 1024 + ntile * 128) * 256, 256, 256, smem);
#pragma unroll
        for (int mt = 0; mt < 4; ++mt)
#pragma unroll
          for (int nt = 0; nt < 4; ++nt) { pb[mt][nt].x = pack2(accB[mt][nt][0], accB[mt][nt][1]); pb[mt][nt].y = pack2(accB[mt][nt][2], accB[mt][nt][3]); }
      }
      f32x4 accG[4][4]; zero_acc<4>(accG);
      gemm_main<4, false>(accG, U, 1024, RowPlain{(long)mtile * 256}, (const bf16_t*)(p.ws + WB_GATE) + ((size_t)j * 1024 + ntile * 128) * 1024, 1024, 1024, smem);
#pragma unroll
      for (int mt = 0; mt < 4; ++mt)
#pragma unroll
        for (int nt = 0; nt < 4; ++nt) {
          float v0 = bflo(accS[mt][nt].x) + sigmoidf_(accG[mt][nt][0]) * bflo(pb[mt][nt].x);
          float v1 = bfhi(accS[mt][nt].x) + sigmoidf_(accG[mt][nt][1]) * bfhi(pb[mt][nt].x);
          float v2 = bflo(accS[mt][nt].y) + sigmoidf_(accG[mt][nt][2]) * bflo(pb[mt][nt].y);
          float v3 = bfhi(accS[mt][nt].y) + sigmoidf_(accG[mt][nt][3]) * bfhi(pb[mt][nt].y);
          accS[mt][nt].x = pack2(v0, v1); accS[mt][nt].y = pack2(v2, v3);
        }
    }
#pragma unroll
    for (int mt = 0; mt < 4; ++mt) {
      const int col = ntile * 128 + wn * 64 + r16 * 4;
      const size_t row = (size_t)mtile * 256 + wm * 64 + mt * 16 + g * 4;
      uint2 o;
      o.x = (accS[mt][0].x & 0xffffu) | (accS[mt][1].x << 16); o.y = (accS[mt][2].x & 0xffffu) | (accS[mt][3].x << 16);
      *(uint2*)(ACC + (row + 0) * 1024 + col) = o;
      o.x = (accS[mt][0].x >> 16) | (accS[mt][1].x & 0xffff0000u); o.y = (accS[mt][2].x >> 16) | (accS[mt][3].x & 0xffff0000u);
      *(uint2*)(ACC + (row + 1) * 1024 + col) = o;
      o.x = (accS[mt][0].y & 0xffffu) | (accS[mt][1].y << 16); o.y = (accS[mt][2].y & 0xffffu) | (accS[mt][3].y << 16);
      *(uint2*)(ACC + (row + 2) * 1024 + col) = o;
      o.x = (accS[mt][0].y >> 16) | (accS[mt][1].y & 0xffff0000u); o.y = (accS[mt][2].y >> 16) | (accS[mt][3].y & 0xffff0000u);
      *(uint2*)(ACC + (row + 3) * 1024 + col) = o;
    }
  }
}

DI void ph_resgemm(const Params& p, int l, const bf16_t* A, int K, const bf16_t* Bt, const float* hsrc_lat, const float* hsrc_ctx, int gate_off, char* smem) {
  const int lane = my_tid() & 63, wid = my_tid() >> 6, wm = wid >> 1, wn = wid & 1, g = lane >> 4, r16 = lane & 15;
  const int mtiles = (l == 0) ? 136 : 128;
  const float* mod = (const float*)(p.ws + MISC_MOD) + (size_t)l * 9 * 6144;
  float* hc = (float*)(p.ws + OFF_HC);
  for (int it = 0;; ++it) {
    int mtile, ntile;
    if (!next_tile(it, mtiles, 8, mtile, ntile)) break;
    f32x4 acc[4][4]; zero_acc<4>(acc);
    gemm_main<4, true>(acc, A, K, RowPlain{(long)mtile * 256}, Bt + (size_t)ntile * 128 * K, K, K, smem);
    const int b = mtile < 128 ? (mtile >> 4) : 8;
    const float* gt = mod + (size_t)b * 6144 + gate_off;
    const int col = ntile * 128 + wn * 64 + r16 * 4;
    const float4 gv = *(const float4*)(gt + col);
#pragma unroll
    for (int mt = 0; mt < 4; ++mt)
#pragma unroll
      for (int e = 0; e < 4; ++e) {
        const int row = mtile * 256 + wm * 64 + mt * 16 + g * 4 + e;
        const float* hs; float* hd;
        if (row < ML) { size_t o = (size_t)row * D + col; hs = hsrc_lat + o; hd = p.out + o; }
        else { size_t o = (size_t)(row - ML) * D + col; hs = hsrc_ctx + o; hd = hc + o; }
        const float4 h = *(const float4*)hs;
        float4 r;
        r.x = DN_ALPHA * h.x + gv.x * acc[mt][0][e]; r.y = DN_ALPHA * h.y + gv.y * acc[mt][1][e];
        r.z = DN_ALPHA * h.z + gv.z * acc[mt][2][e]; r.w = DN_ALPHA * h.w + gv.w * acc[mt][3][e];
        *(float4*)hd = r;
      }
  }
}

DI void ph_ffnup(const Params& p, int l, char* smem) {
  const bf16_t* U = (const bf16_t*)(p.ws + R_U);
  const bf16_t* Bt = (const bf16_t*)(p.ws + WB_UP);
  bf16_t* HID = (bf16_t*)(p.ws + R_HID);
  const float* cw = p.in[38] + (size_t)l * 3 * 5632; const float* cb = p.in[39] + (size_t)l * 5632;
  const int tid = my_tid(), lane = tid & 63, wid = tid >> 6, wm = wid >> 1, wn = wid & 1, g = lane >> 4, r16 = lane & 15;
  const int mtiles = (l == 0) ? 152 : 136;
  float* T = (float*)smem;
  for (int it = 0;; ++it) {
    int mtile, ntile;
    if (!next_tile(it, mtiles, 44, mtile, ntile)) break;
    long rowbase; int tt, len;
    if (mtile < 136) { int b = mtile / 17; tt = mtile % 17; len = SL; rowbase = (long)b * SL; }
    else { int v = mtile - 136; int b = v >> 1; tt = v & 1; len = CL; rowbase = (long)ML + b * CL; }
    f32x4 acc[4][4]; zero_acc<4>(acc);
    gemm_main<4, true>(acc, U, 1024, RowHalo{rowbase, tt * 254 - 1, len}, Bt + (size_t)ntile * 128 * 1024, 1024, 1024, smem);
#pragma unroll
    for (int mt = 0; mt < 4; ++mt)
#pragma unroll
      for (int e = 0; e < 4; ++e)
        *(float4*)(T + (wm * 64 + mt * 16 + g * 4 + e) * 132 + wn * 64 + r16 * 4) = make_float4(acc[mt][0][e], acc[mt][1][e], acc[mt][2][e], acc[mt][3][e]);
    __syncthreads();
    {
      const int ch = tid & 63, rgp = tid >> 6; const int ca = ntile * 64 + ch, cbx = 2816 + ca;
      const float a0 = cw[ca], a1 = cw[5632 + ca], a2 = cw[2 * 5632 + ca], ab = cb[ca];
      const float b0 = cw[cbx], b1 = cw[5632 + cbx], b2 = cw[2 * 5632 + cbx], bb = cb[cbx];
      for (int r = 1 + rgp; r <= 254; r += 8) {
        int tok = tt * 254 - 1 + r;
        if (tok < len) {
          float av = a0 * T[(r - 1) * 132 + ch] + a1 * T[r * 132 + ch] + a2 * T[(r + 1) * 132 + ch] + ab;
          float bv = b0 * T[(r - 1) * 132 + 64 + ch] + b1 * T[r * 132 + 64 + ch] + b2 * T[(r + 1) * 132 + 64 + ch] + bb;
          HID[(size_t)(rowbase + tok) * 2816 + ca] = (bf16_t)f2bf(siluf_(av) * bv);
        }
      }
    }
  }
}

#ifndef REP_PREP
#define REP_PREP 1
#endif
#ifndef REP_GEMM
#define REP_GEMM 1
#endif
#ifndef REP_HY
#define REP_HY 1
#endif
#ifndef REP_RWP
#define REP_RWP 1
#endif
#ifndef REP_SCAN
#define REP_SCAN 1
#endif
#ifndef REP_ATTN
#define REP_ATTN 1
#endif
#ifndef PH_END
#define PH_END 24
#endif
DI void grid_barrier(unsigned* bar, unsigned& epoch) {
  __syncthreads();
  epoch += 1;
  if (my_tid() == 0) {
    __threadfence();
    const unsigned target = epoch * gridDim.x;
    __hip_atomic_fetch_add(bar, 1u, __ATOMIC_RELAXED, __HIP_MEMORY_SCOPE_AGENT);
    while (__hip_atomic_load(bar, __ATOMIC_RELAXED, __HIP_MEMORY_SCOPE_AGENT) < target) __builtin_amdgcn_s_sleep(1);
    __threadfence();
  }
  __syncthreads();
}
#define SYNC_OR_RET(idx) do { if ((idx) + 1 >= PH_END) return; if ((idx) == 0) grid.sync(); else grid_barrier((unsigned*)(p.ws + MISC_BAR), epoch); } while (0)
template <int l>
DI void run_layer(const Params& p, cg::grid_group& grid, char* smem, unsigned& epoch) {
  const float* mod = (const float*)(p.ws + MISC_MOD) + (size_t)l * 9 * 6144;
  float* hc = (float*)(p.ws + OFF_HC);
  const float* hl_src = (l == 0) ? p.in[0] : p.out;
  const float* hc_src = (l == 0) ? p.in[2] : hc;
  constexpr int B0 = l * 12;
  for (int rep = 0; rep < REP_PREP; ++rep) {
  ph_convert(p, l, smem);
  if (l == 0) ph_ada(p, smem);
  hy_rawfilter(p, l, SL, (float*)(p.ws + R_RAWF), smem);
  if (l == 0) hy_rawfilter(p, l, CL, (float*)(p.ws + MISC_RAWC), smem);
  }
  SYNC_OR_RET(B0 + 0);
  for (int rep = 0; rep < REP_PREP; ++rep) ph_kf(p, l, smem);
  ph_ln(hl_src, hc_src, nullptr, nullptr, nullptr, nullptr, (bf16_t*)(p.ws + R_U), mod, 0, MT);
  SYNC_OR_RET(B0 + 1);
  for (int rep = 0; rep < REP_GEMM; ++rep) ph_inproj(p, smem);
  SYNC_OR_RET(B0 + 2);
  for (int rep = 0; rep < REP_HY; ++rep) {
  if (blockIdx.x == 0 && my_tid() == 0) *(unsigned*)(p.ws + MISC_BAR + 64 + 64 * l) = 0u;
  ph_hyena(p, l, smem);
  if (l == 0) ph_hyena_ctx(p, l, smem);
  }
  ph_rope(p, smem);
  for (int rep = 0; rep < REP_RWP; ++rep) ph_rwprep(p, l, smem);
  SYNC_OR_RET(B0 + 3);
  for (int rep = 0; rep < REP_SCAN; ++rep) ph_scan(p, smem);
  for (int rep = 0; rep < REP_ATTN; ++rep) ph_attn(p, l, smem);
  SYNC_OR_RET(B0 + 4);
  ph_rwout(p, l);
  ph_ln(hl_src, hc_src, nullptr, nullptr, nullptr, nullptr, (bf16_t*)(p.ws + R_URE), mod, 0, l == 0 ? MT : ML);
  SYNC_OR_RET(B0 + 5);
  for (int rep = 0; rep < REP_GEMM; ++rep) ph_merge(p, l, smem);
  SYNC_OR_RET(B0 + 6);
  ph_resgemm(p, l, (const bf16_t*)(p.ws + R_ACC), 1024, (const bf16_t*)(p.ws + WB_OUT), hl_src, hc_src, 2048, smem);
  SYNC_OR_RET(B0 + 7);
  ph_ln(p.out, hc, p.out, hc, p.in[35] + (size_t)l * D, p.in[36] + (size_t)l * D, (bf16_t*)(p.ws + R_U), mod, 3072, l == 0 ? MT : ML);
  SYNC_OR_RET(B0 + 8);
  for (int rep = 0; rep < REP_GEMM; ++rep) ph_ffnup(p, l, smem);
  SYNC_OR_RET(B0 + 9);
  ph_resgemm(p, l, (const bf16_t*)(p.ws + R_HID), 2816, (const bf16_t*)(p.ws + WB_DOWN), p.out, hc, 5120, smem);
  SYNC_OR_RET(B0 + 10);
  ph_ln(p.out, hc, p.out, hc, p.in[41] + (size_t)l * D, p.in[42] + (size_t)l * D, nullptr, mod, 0, l == 0 ? MT : ML);
  SYNC_OR_RET(B0 + 11);
}

__global__ void __launch_bounds__(NTHR) mega(Params p) {
  extern __shared__ __attribute__((aligned(16))) char smem[];
  cg::grid_group grid = cg::this_grid();
  unsigned epoch = 0;
  if (blockIdx.x == 0 && my_tid() == 0) *(unsigned*)(p.ws + MISC_BAR) = 0u;
  run_layer<0>(p, grid, smem, epoch);
  if (PH_END > 12) run_layer<1>(p, grid, smem, epoch);
}

extern "C" void kernel_launch(void* const* d_in, const int* in_sizes, int n_in, void* d_out, int out_size,
                              void* d_ws, size_t ws_size, hipStream_t stream) {
  static int grid_blocks = 0;
  if (!grid_blocks) {
    int dev = 0, cus = 0, per_cu = 0;
    (void)hipGetDevice(&dev);
    (void)hipDeviceGetAttribute(&cus, hipDeviceAttributeMultiprocessorCount, dev);
    (void)hipFuncSetAttribute((const void*)mega, hipFuncAttributeMaxDynamicSharedMemorySize, SMEM_BYTES);
    (void)hipOccupancyMaxActiveBlocksPerMultiprocessor(&per_cu, mega, NTHR, SMEM_BYTES);
    if (per_cu < 1) per_cu = 1;
    if (per_cu > 1) per_cu = 1;
    grid_blocks = cus * per_cu;
  }
  Params p{};
  for (int i = 0; i < 43; ++i) p.in[i] = (const float*)d_in[i];
  p.out = (float*)d_out; p.ws = (char*)d_ws;
  void* args[] = {&p};
  hipError_t e = hipLaunchCooperativeKernel((void*)mega, dim3(grid_blocks), dim3(NTHR), args, SMEM_BYTES, stream);
  if (e != hipSuccess) fprintf(stderr, "cooperative launch failed: %s (grid %d)\n", hipGetErrorString(e), grid_blocks);
}
```

```cpp
#include <hip/hip_runtime.h>
#include <hip/hip_cooperative_groups.h>
#include <cstdio>
#include <cstdint>
namespace cg = cooperative_groups;

#define DI __device__ __forceinline__
typedef unsigned short bf16_t;
typedef short bf16x8 __attribute__((ext_vector_type(8)));
typedef float f32x4 __attribute__((ext_vector_type(4)));

constexpr int D = 1024, NB = 8, SL = 4096, CL = 256;
constexpr int ML = NB * SL, MC = NB * CL, MT = ML + MC;
constexpr int KEYS = SL + CL;
constexpr int NTHR = 512;
constexpr float DN_ALPHA = 1.41421356237f;
constexpr size_t UNIT = (size_t)MT * 512;

constexpr size_t WB_IN = 0;
constexpr size_t WB_GATE = WB_IN + (size_t)3328 * 1024 * 2;
constexpr size_t WB_BR = WB_GATE + (size_t)4096 * 1024 * 2;
constexpr size_t WB_OUT = WB_BR + (size_t)4 * 1024 * 256 * 2;
constexpr size_t WB_UP = WB_OUT + (size_t)1024 * 1024 * 2;
constexpr size_t WB_DOWN = WB_UP + (size_t)5632 * 1024 * 2;
constexpr size_t WB_END = WB_DOWN + (size_t)1024 * 2816 * 2;
constexpr size_t OFF_KF = WB_END;
constexpr size_t OFF_HC = OFF_KF + (size_t)512 * 8192 * 8;
constexpr size_t OFF_MISC = OFF_HC + (size_t)MC * D * 4;
constexpr size_t MISC_MOD = OFF_MISC;
constexpr size_t MISC_TW = MISC_MOD + (size_t)2 * 9 * 6144 * 4;
constexpr size_t MISC_RAWC = MISC_TW + 4096 * 8;
constexpr size_t MISC_GCTX = MISC_RAWC + (size_t)256 * 1024 * 4;
constexpr size_t MISC_RWW = MISC_GCTX + (size_t)512 * 512 * 4;
constexpr size_t RWW_F = MISC_RWW, RWW_B = RWW_F + 256 * 64 * 2, RWW_A = RWW_B + 256 * 64 * 2, RWW_GF = RWW_A + 256 * 64 * 2, RWW_GB = RWW_GF + 256 * 128 * 2;
constexpr size_t OFF_R = OFF_MISC + (size_t)4 * 1024 * 1024;
constexpr size_t MISC_BAR = OFF_R - 256;
static_assert(RWW_GB + 256 * 128 * 2 <= MISC_BAR, "misc overflow");
constexpr size_t R_YHY = OFF_R, R_YSW = OFF_R + UNIT, R_YDF = OFF_R + 2 * UNIT;
constexpr size_t R_PHY = OFF_R + 3 * UNIT;
constexpr size_t R_PSW = OFF_R + 6 * UNIT;
constexpr size_t R_VTSW = R_PSW + (size_t)MT * 384 * 2;
constexpr size_t R_PDF = OFF_R + 8 * UNIT;
constexpr size_t R_VTDF = OFF_R + 10 * UNIT;
constexpr size_t R_PRW = OFF_R + 11 * UNIT;
constexpr size_t R_STR = R_PRW + (size_t)MT * 1216 * 2;
constexpr size_t R_G = R_STR + 7 * UNIT;
constexpr size_t R_END = R_G + 2 * UNIT;
constexpr size_t R_RAWF = OFF_R;
constexpr size_t R_OF = R_PHY, R_OB = R_PHY + UNIT;
constexpr size_t R_URE = R_PSW;
constexpr size_t R_YRW = R_VTDF;
constexpr size_t R_ACC = R_PRW;
constexpr size_t R_U = R_STR;
constexpr size_t R_HID = OFF_R;
static_assert(R_END <= (size_t)512 * 1024 * 1024, "ws overflow");
static_assert((size_t)MT * 2816 * 2 <= 11 * UNIT, "hid");

constexpr int SMEM_BYTES = 136 * 1024;

struct Params {
  const float* in[43];
  float* out;
  char* ws;
};

DI int my_tid() { int t = (int)__builtin_amdgcn_workitem_id_x(); asm volatile("" : "+v"(t)); return t; }
DI unsigned f2bf(float f) { unsigned u = __float_as_uint(f); u += 0x7fffu + ((u >> 16) & 1u); return u >> 16; }
DI float bf2f(unsigned h) { return __uint_as_float(h << 16); }
typedef __bf16 bf16v2_t __attribute__((ext_vector_type(2)));
typedef float f32v2_t __attribute__((ext_vector_type(2)));
DI unsigned pack2(float lo, float hi) { f32v2_t v = {lo, hi}; bf16v2_t b = __builtin_convertvector(v, bf16v2_t); return __builtin_bit_cast(unsigned, b); }

DI float bflo(unsigned w) { return __uint_as_float(w << 16); }
DI float bfhi(unsigned w) { return __uint_as_float(w & 0xffff0000u); }
DI float sigmoidf_(float x) { return 1.f / (1.f + __expf(-x)); }
DI float siluf_(float x) { return x / (1.f + __expf(-x)); }
DI float wave_sum(float v) {
#pragma unroll
  for (int o = 32; o >= 1; o >>= 1) v += __shfl_xor(v, o);
  return v;
}
template <int CTRL> DI float dpp_mov(float v) {
  return __int_as_float(__builtin_amdgcn_update_dpp(0, __float_as_int(v), CTRL, 0xf, 0xf, false));
}
DI float sum16(float v) {
  v += dpp_mov<0xB1>(v);
  v += dpp_mov<0x4E>(v);
  v += dpp_mov<0x141>(v);
  v += dpp_mov<0x140>(v);
  return v;
}
DI void lds_barrier() { asm volatile("s_waitcnt lgkmcnt(0)" ::: "memory"); __builtin_amdgcn_s_barrier(); asm volatile("" ::: "memory"); }
DI uint4 sel4(bool z, uint4 v) { return make_uint4(z ? 0u : v.x, z ? 0u : v.y, z ? 0u : v.z, z ? 0u : v.w); }
DI int mod_idx(int row) { return row < ML ? (row >> 12) : 8; }

template <int NTW, bool DEEP, class RowFn>
DI void gemm_main(f32x4 (&acc)[4][NTW], const bf16_t* __restrict__ A, int lda, RowFn rowfn,
                  const bf16_t* __restrict__ Bt, int ldb, int K, char* smem) {
  constexpr int BN = NTW * 32;
  constexpr int A_BYTES = 256 * 128, B_BYTES = BN * 128, STAGE = A_BYTES + B_BYTES;
  constexpr int NBL = BN / 64;
  const int tid = my_tid(), lane = tid & 63, wid = tid >> 6, wm = wid >> 1, wn = wid & 1, g = lane >> 4, r16 = lane & 15;
  const int chunk = tid & 7, lrow = tid >> 3;
  long a0 = rowfn(lrow), a1 = rowfn(lrow + 64), a2 = rowfn(lrow + 128), a3 = rowfn(lrow + 192);
  const long c0 = a0 < 0 ? 0 : a0, c1 = a1 < 0 ? 0 : a1, c2 = a2 < 0 ? 0 : a2, c3 = a3 < 0 ? 0 : a3;
  const bf16_t* Bp = Bt + (long)lrow * ldb + chunk * 8;
  const bf16_t* Ap0 = A + c0 * lda + chunk * 8; const bf16_t* Ap1 = A + c1 * lda + chunk * 8;
  const bf16_t* Ap2 = A + c2 * lda + chunk * 8; const bf16_t* Ap3 = A + c3 * lda + chunk * 8;
  struct Regs { uint4 a0, a1, a2, a3, b0, b1; };
  Regs R0, R1;
  R0.b1 = make_uint4(0, 0, 0, 0); R1.b1 = make_uint4(0, 0, 0, 0);
  auto GLOAD = [&](Regs& R, int k0) {
    R.a0 = *(const uint4*)(Ap0 + k0); R.a1 = *(const uint4*)(Ap1 + k0);
    R.a2 = *(const uint4*)(Ap2 + k0); R.a3 = *(const uint4*)(Ap3 + k0);
    R.b0 = *(const uint4*)(Bp + k0);
    if constexpr (NBL > 1) R.b1 = *(const uint4*)(Bp + (long)64 * ldb + k0);
  };
  auto SSTORE = [&](const Regs& R, int st) {
    char* base = smem + st * STAGE + lrow * 128 + ((chunk ^ (lrow & 7)) << 4);
    *(uint4*)(base) = sel4(a0 < 0, R.a0); *(uint4*)(base + 64 * 128) = sel4(a1 < 0, R.a1);
    *(uint4*)(base + 128 * 128) = sel4(a2 < 0, R.a2); *(uint4*)(base + 192 * 128) = sel4(a3 < 0, R.a3);
    *(uint4*)(base + A_BYTES) = R.b0;
    if constexpr (NBL > 1) *(uint4*)(base + A_BYTES + 64 * 128) = R.b1;
  };
  auto COMPUTE = [&](int st) {
    const char* As = smem + st * STAGE + (wm * 64 + r16) * 128;
    const char* Bs = smem + st * STAGE + A_BYTES + (wn * (NTW * 16) + r16) * 128;
#pragma unroll
    for (int kk = 0; kk < 2; ++kk) {
      const int sw = ((kk * 4 + g) ^ (r16 & 7)) << 4;
      bf16x8 af[4], bfr[NTW];
#pragma unroll
      for (int mt = 0; mt < 4; ++mt) af[mt] = *(const bf16x8*)(As + mt * 16 * 128 + sw);
#pragma unroll
      for (int nt = 0; nt < NTW; ++nt) bfr[nt] = *(const bf16x8*)(Bs + nt * 16 * 128 + sw);
#pragma unroll
      for (int mt = 0; mt < 4; ++mt)
#pragma unroll
        for (int nt = 0; nt < NTW; ++nt)
          acc[mt][nt] = __builtin_amdgcn_mfma_f32_16x16x32_bf16(af[mt], bfr[nt], acc[mt][nt], 0, 0, 0);
    }
  };
  const int nk = K >> 6;
  __syncthreads();
  GLOAD(R0, 0);
  SSTORE(R0, 0);
  if constexpr (DEEP) {
    GLOAD(R0, 64);
    if (nk > 2) GLOAD(R1, 128);
    lds_barrier();
    bf16x8 fa0[4], fb0[NTW], fa1[4], fb1[NTW];
    auto READF = [&](bf16x8 (&fa)[4], bf16x8 (&fb)[NTW], int st, int kk) {
      const int sw = ((kk * 4 + g) ^ (r16 & 7)) << 4;
      const char* As = smem + st * STAGE + (wm * 64 + r16) * 128 + sw;
      const char* Bs = smem + st * STAGE + A_BYTES + (wn * (NTW * 16) + r16) * 128 + sw;
#pragma unroll
      for (int mt = 0; mt < 4; ++mt) fa[mt] = *(const bf16x8*)(As + mt * 16 * 128);
#pragma unroll
      for (int nt = 0; nt < NTW; ++nt) fb[nt] = *(const bf16x8*)(Bs + nt * 16 * 128);
    };
    auto MMA = [&](const bf16x8 (&fa)[4], const bf16x8 (&fb)[NTW]) {
#pragma unroll
      for (int mt = 0; mt < 4; ++mt)
#pragma unroll
        for (int nt = 0; nt < NTW; ++nt)
          acc[mt][nt] = __builtin_amdgcn_mfma_f32_16x16x32_bf16(fa[mt], fb[nt], acc[mt][nt], 0, 0, 0);
    };
    READF(fa0, fb0, 0, 0);
    for (int kt = 0; kt < nk; kt += 2) {
      READF(fa1, fb1, 0, 1);
      MMA(fa0, fb0);
#pragma unroll
      for (int i = 0; i < 4 + NTW; ++i) { __builtin_amdgcn_sched_group_barrier(0x100, 1, 0); __builtin_amdgcn_sched_group_barrier(0x008, 2, 0); }
      __builtin_amdgcn_sched_barrier(0);
      SSTORE(R0, 1);
      if (kt + 3 < nk) GLOAD(R0, (kt + 3) * 64);
      MMA(fa1, fb1);
#pragma unroll
      for (int i = 0; i < 6; ++i) { __builtin_amdgcn_sched_group_barrier(0x200, 1, 0); __builtin_amdgcn_sched_group_barrier(0x020, 1, 0); __builtin_amdgcn_sched_group_barrier(0x008, 2, 0); }
      __builtin_amdgcn_sched_barrier(0);
      lds_barrier();
      READF(fa0, fb0, 1, 0);
      READF(fa1, fb1, 1, 1);
      MMA(fa0, fb0);
#pragma unroll
      for (int i = 0; i < 4 + NTW; ++i) { __builtin_amdgcn_sched_group_barrier(0x100, 1, 0); __builtin_amdgcn_sched_group_barrier(0x008, 2, 0); }
      __builtin_amdgcn_sched_barrier(0);
      if (kt + 2 < nk) SSTORE(R1, 0);
      if (kt + 4 < nk) GLOAD(R1, (kt + 4) * 64);
      MMA(fa1, fb1);
#pragma unroll
      for (int i = 0; i < 6; ++i) { __builtin_amdgcn_sched_group_barrier(0x200, 1, 0); __builtin_amdgcn_sched_group_barrier(0x020, 1, 0); __builtin_amdgcn_sched_group_barrier(0x008, 2, 0); }
      __builtin_amdgcn_sched_barrier(0);
      lds_barrier();
      if (kt + 2 < nk) READF(fa0, fb0, 0, 0);
    }
  } else {
    lds_barrier();
    for (int kt = 0; kt < nk; ++kt) {
      const int st = kt & 1;
      if (kt + 1 < nk) GLOAD(R0, (kt + 1) * 64);
      __builtin_amdgcn_sched_barrier(0);
      COMPUTE(st);
      __builtin_amdgcn_sched_barrier(0);
      if (kt + 1 < nk) SSTORE(R0, st ^ 1);
      lds_barrier();
    }
  }
}

DI bool next_tile(int i, int MTILES, int NTILES, int& mt, int& nt) {
  const int xcd = blockIdx.x & 7, slot = blockIdx.x >> 3, nslot = gridDim.x >> 3;
  const int m_lo = (MTILES * xcd) >> 3, m_hi = (MTILES * (xcd + 1)) >> 3, Mloc = m_hi - m_lo;
  const int q = i * nslot + slot;
  if (q >= Mloc * NTILES) return false;
  const int gidx = q / (4 * NTILES), m0 = gidx * 4;
  const int rows = (Mloc - m0) < 4 ? (Mloc - m0) : 4;
  const int within = q - gidx * 4 * NTILES;
  nt = within / rows; mt = m_lo + m0 + within % rows;
  return true;
}

struct RowPlain { long base; DI long operator()(int r) const { return base + r; } };
struct RowHalo { long rowbase; int t0; int len; DI long operator()(int r) const { int t = t0 + r; return (t >= 0 && t < len) ? rowbase + t : -1; } };

template <int NTW> DI void zero_acc(f32x4 (&acc)[4][NTW]) {
#pragma unroll
  for (int i = 0; i < 4; ++i)
#pragma unroll
    for (int j = 0; j < NTW; ++j) acc[i][j] = (f32x4){0.f, 0.f, 0.f, 0.f};
}

DI void cvt_unit(const float* __restrict__ src, int ldsrc, int srccol0, int k0, bf16_t* __restrict__ dst, int K, int n0, char* smem, bool perm = true) {
  float* T = (float*)smem;
  const int tid = my_tid();
  __syncthreads();
  if (srccol0 >= 0) {
#pragma unroll
    for (int i = 0; i < 8; ++i) {
      int idx = tid + i * 512; int k = idx >> 6, n = idx & 63;
      T[k * 65 + n] = src[(long)(k0 + k) * ldsrc + srccol0 + n];
    }
  }
  __syncthreads();
  int nd = tid >> 3, kc = (tid & 7) * 8; int n = perm ? ((nd & 15) * 4 + (nd >> 4)) : nd;
  uint4 o = make_uint4(0, 0, 0, 0);
  if (srccol0 >= 0) {
    o.x = pack2(T[(kc + 0) * 65 + n], T[(kc + 1) * 65 + n]);
    o.y = pack2(T[(kc + 2) * 65 + n], T[(kc + 3) * 65 + n]);
    o.z = pack2(T[(kc + 4) * 65 + n], T[(kc + 5) * 65 + n]);
    o.w = pack2(T[(kc + 6) * 65 + n], T[(kc + 7) * 65 + n]);
  }
  *(uint4*)(dst + (long)(n0 + nd) * K + k0 + kc) = o;
}

DI void ph_convert(const Params& p, int l, char* smem) {
  for (int u = blockIdx.x; u < 4508; u += gridDim.x) {
    if (u < 832) {
      int gI = u >> 4, kt = u & 15; int n0 = gI * 64; int sc;
      if (n0 < 1280) sc = n0; else if (n0 < 2048) sc = 2496 + (n0 - 1280); else if (n0 < 3264) sc = 1280 + (n0 - 2048); else sc = -1;
      cvt_unit(p.in[6] + (size_t)l * 1024 * 7360, 7360, sc, kt * 64, (bf16_t*)(p.ws + WB_IN), 1024, n0, smem);
    } else if (u < 1856) {
      int v = u - 832; int gI = v >> 4, kt = v & 15;
      cvt_unit(p.in[6] + (size_t)l * 1024 * 7360, 7360, 3264 + gI * 64, kt * 64, (bf16_t*)(p.ws + WB_GATE), 1024, gI * 64, smem);
    } else if (u < 2112) {
      int v = u - 1856; int gI = v >> 2, kt = v & 3; int j = gI >> 4, gg = gI & 15;
      cvt_unit(p.in[33] + ((size_t)l * 4 + j) * 256 * 1024, 1024, gg * 64, kt * 64, (bf16_t*)(p.ws + WB_BR) + (size_t)j * 1024 * 256, 256, gg * 64, smem);
    } else if (u < 2368) {
      int v = u - 2112; int gI = v >> 4, kt = v & 15;
      cvt_unit(p.in[34] + (size_t)l * 1024 * 1024, 1024, gI * 64, kt * 64, (bf16_t*)(p.ws + WB_OUT), 1024, gI * 64, smem);
    } else if (u < 3776) {
      int v = u - 2368; int gI = v >> 4, kt = v & 15; int nt = gI >> 1, hb = gI & 1;
      cvt_unit(p.in[37] + (size_t)l * 1024 * 5632, 5632, hb * 2816 + nt * 64, kt * 64, (bf16_t*)(p.ws + WB_UP), 1024, gI * 64, smem);
    } else if (u < 4480) {
      int v = u - 3776; int gI = v / 44, kt = v % 44;
      cvt_unit(p.in[40] + (size_t)l * 2816 * 1024, 1024, gI * 64, kt * 64, (bf16_t*)(p.ws + WB_DOWN), 2816, gI * 64, smem);
    } else {
      int v = u - 4480;
      if (v < 4) cvt_unit(p.in[19] + (size_t)l * 2 * 64 * 256, 256, v * 64, 0, (bf16_t*)(p.ws + RWW_F), 64, v * 64, smem, false);
      else if (v < 8) cvt_unit(p.in[19] + (size_t)l * 2 * 64 * 256 + 64 * 256, 256, (v - 4) * 64, 0, (bf16_t*)(p.ws + RWW_B), 64, (v - 4) * 64, smem, false);
      else if (v < 12) cvt_unit(p.in[21] + (size_t)l * 64 * 256, 256, (v - 8) * 64, 0, (bf16_t*)(p.ws + RWW_A), 64, (v - 8) * 64, smem, false);
      else if (v < 20) { int w = v - 12; cvt_unit(p.in[22] + (size_t)l * 2 * 128 * 256, 256, (w >> 1) * 64, (w & 1) * 64, (bf16_t*)(p.ws + RWW_GF), 128, (w >> 1) * 64, smem, false); }
      else { int w = v - 20; cvt_unit(p.in[22] + (size_t)l * 2 * 128 * 256 + 128 * 256, 256, (w >> 1) * 64, (w & 1) * 64, (bf16_t*)(p.ws + RWW_GB), 128, (w >> 1) * 64, smem, false); }
    }
  }
}

DI void ph_ada(const Params& p, char* smem) {
  float* S = (float*)smem;
  float* R = S + 9 * 1024;
  const int tid = my_tid();
  bool loaded = false;
  for (int u = blockIdx.x; u < 192; u += gridDim.x) {
    if (!loaded) {
      __syncthreads();
      for (int i = tid; i < 9 * 1024; i += NTHR) { float c = i < 8192 ? p.in[1][i] : p.in[3][i - 8192]; S[i] = siluf_(c); }
      loaded = true;
    }
    __syncthreads();
    int l = u / 96, n0 = (u % 96) * 64;
    int col = tid & 63, ks = tid >> 6;
    const float* W = p.in[4] + (size_t)l * 1024 * 6144 + n0 + col;
    float a[9];
#pragma unroll
    for (int b = 0; b < 9; ++b) a[b] = 0.f;
    for (int k = ks * 128; k < ks * 128 + 128; ++k) {
      float w = W[(size_t)k * 6144];
#pragma unroll
      for (int b = 0; b < 9; ++b) a[b] += S[b * 1024 + k] * w;
    }
#pragma unroll
    for (int b = 0; b < 9; ++b) R[(ks * 9 + b) * 64 + col] = a[b];
    __syncthreads();
    for (int i = tid; i < 9 * 64; i += NTHR) {
      int b = i >> 6, c = i & 63; float s = 0.f;
#pragma unroll
      for (int k2 = 0; k2 < 8; ++k2) s += R[(k2 * 9 + b) * 64 + c];
      s += p.in[5][(size_t)l * 6144 + n0 + c];
      ((float*)(p.ws + MISC_MOD))[((size_t)l * 9 + b) * 6144 + n0 + c] = s;
    }
  }
  for (int i = blockIdx.x * NTHR + tid; i < 4096; i += gridDim.x * NTHR) {
    float s, c; sincospif(-(float)i / 4096.f, &s, &c);
    ((float2*)(p.ws + MISC_TW))[i] = make_float2(c, s);
  }
}

DI void hy_rawfilter(const Params& p, int l, int Lf, float* __restrict__ dst, char* smem) {
  float* W1 = (float*)smem;
  float* W2 = W1 + 33 * 64;
  float* Z = W2 + 64 * 64;
  float* H1 = Z + 16 * 36;
  float* H2 = H1 + 16 * 64;
  const int tid = my_tid();
  const float* w1 = p.in[9] + (size_t)l * 33 * 64; const float* b1 = p.in[10] + l * 64;
  const float* w2 = p.in[11] + (size_t)l * 64 * 64; const float* b2 = p.in[12] + l * 64;
  const float* w3 = p.in[13] + (size_t)l * 64 * 1024; const float* fr = p.in[14] + l * 64;
  const int nunits = Lf / 16;
  bool loaded = false;
  for (int u = blockIdx.x; u < nunits; u += gridDim.x) {
    __syncthreads();
    if (!loaded) {
      for (int i = tid; i < 33 * 64; i += NTHR) W1[i] = w1[i];
      for (int i = tid; i < 64 * 64; i += NTHR) W2[i] = w2[i];
      loaded = true;
    }
    const int t0 = u * 16;
    for (int i = tid; i < 16 * 33; i += NTHR) {
      int tt = i / 33, f = i % 33; int t = t0 + tt; float v;
      if (f == 0) v = (float)t / (float)(Lf - 1);
      else {
        int bi = (f - 1) & 15;
        float wv = 6.283185307179586f * (float)t / (float)Lf;
        float fb = 1e-4f + (15.f - 1e-4f) * (float)bi / 15.f;
        float ang = wv * fb;
        v = (f <= 16) ? cosf(ang) : -sinf(ang);
      }
      Z[tt * 36 + f] = v;
    }
    __syncthreads();
    for (int i = tid; i < 16 * 64; i += NTHR) {
      int tt = i >> 6, f = i & 63; float s = b1[f];
      for (int k = 0; k < 33; ++k) s += Z[tt * 36 + k] * W1[k * 64 + f];
      H1[tt * 64 + f] = sinf(fr[f] * s);
    }
    __syncthreads();
    for (int i = tid; i < 16 * 64; i += NTHR) {
      int tt = i >> 6, f = i & 63; float s = b2[f];
      for (int k = 0; k < 64; ++k) s += H1[tt * 64 + k] * W2[k * 64 + f];
      H2[tt * 64 + f] = sinf(fr[f] * s);
    }
    __syncthreads();
    float a0[16], a1[16];
#pragma unroll
    for (int i = 0; i < 16; ++i) { a0[i] = 0.f; a1[i] = 0.f; }
    for (int k = 0; k < 64; ++k) {
      float wa = w3[k * 1024 + tid], wb = w3[k * 1024 + 512 + tid];
#pragma unroll
      for (int i = 0; i < 16; ++i) { float h = H2[i * 64 + k]; a0[i] += h * wa; a1[i] += h * wb; }
    }
    {
      int w = tid & 255;
      float delta = fabsf(-3.0701134573253944f + (-15.350567286626972f + 3.0701134573253944f) * (float)w / 255.f);
#pragma unroll
      for (int i = 0; i < 16; ++i) {
        float tn = (float)(t0 + i) / (float)(Lf - 1);
        float dec = expf(-tn * delta);
        dst[(size_t)(t0 + i) * 1024 + tid] = a0[i] * dec;
        dst[(size_t)(t0 + i) * 1024 + 512 + tid] = a1[i] * dec;
      }
    }
  }
}

DI float2 cmul(float2 a, float2 b) { return make_float2(a.x * b.x - a.y * b.y, a.x * b.y + a.y * b.x); }
DI float2 cmulc(float2 a, float2 b) { return make_float2(a.x * b.x + a.y * b.y, a.y * b.x - a.x * b.y); }
DI void fft_dif(float2* X, const float2* W) {
  const int tid = my_tid();
  for (int ls = 12; ls >= 0; --ls) {
    const int span = 1 << ls;
    __syncthreads();
#pragma unroll
    for (int i = 0; i < 8; ++i) {
      int bf = tid + i * 512; int pos = bf & (span - 1); int i0 = ((bf >> ls) << (ls + 1)) + pos; int i1 = i0 + span;
      float2 a = X[i0], b = X[i1]; float2 w = W[span - 1 + pos];
      X[i0] = make_float2(a.x + b.x, a.y + b.y);
      X[i1] = cmul(make_float2(a.x - b.x, a.y - b.y), w);
    }
  }
  __syncthreads();
}
DI void fft_dit_inv(float2* X, const float2* W) {
  const int tid = my_tid();
  for (int ls = 0; ls <= 12; ++ls) {
    const int span = 1 << ls;
    __syncthreads();
#pragma unroll
    for (int i = 0; i < 8; ++i) {
      int bf = tid + i * 512; int pos = bf & (span - 1); int i0 = ((bf >> ls) << (ls + 1)) + pos; int i1 = i0 + span;
      float2 a = X[i0], b = X[i1]; float2 w = W[span - 1 + pos];
      float2 t = cmulc(b, w);
      X[i0] = make_float2(a.x + t.x, a.y + t.y);
      X[i1] = make_float2(a.x - t.x, a.y - t.y);
    }
  }
  __syncthreads();
}
DI void load_twiddles(const Params& p, float2* W) {
  const float2* tw = (const float2*)(p.ws + MISC_TW);
  for (int i = my_tid(); i < 8191; i += NTHR) {
    const int ls = 31 - __clz(i + 1); const int pos = i + 1 - (1 << ls);
    W[i] = tw[pos << (12 - ls)];
  }
}

DI void ph_kf(const Params& p, int l, char* smem) {
  float2* X = (float2*)smem; float2* W = X + 8192; float* red = (float*)(W + 8192);
  const int tid = my_tid(), lane = tid & 63, wid = tid >> 6;
  const float* rawf = (const float*)(p.ws + R_RAWF);
  float2* kf = (float2*)(p.ws + OFF_KF);
  bool tw = false;
  for (int u = blockIdx.x; u < 256; u += gridDim.x) {
    if (!tw) { load_twiddles(p, W); tw = true; }
    const int o = u >> 7, c = (u & 127) * 2;
    float2 fw[8], bw[8]; float sa = 0.f, sb = 0.f;
#pragma unroll
    for (int i = 0; i < 8; ++i) {
      int t = tid + i * 512;
      fw[i] = *(const float2*)(rawf + (size_t)t * 1024 + o * 512 + c);
      bw[i] = *(const float2*)(rawf + (size_t)t * 1024 + o * 512 + 256 + c);
      sa += fabsf(fw[i].x) + fabsf(bw[i].x); sb += fabsf(fw[i].y) + fabsf(bw[i].y);
    }
    sa = wave_sum(sa); sb = wave_sum(sb);
    __syncthreads();
    if (lane == 0) { red[wid * 2] = sa; red[wid * 2 + 1] = sb; }
    __syncthreads();
    float ta = 0.f, tb = 0.f;
#pragma unroll
    for (int w = 0; w < 8; ++w) { ta += red[w * 2]; tb += red[w * 2 + 1]; }
    const float ia = 1.f / ta, ib = 1.f / tb;
#pragma unroll
    for (int i = 0; i < 8; ++i) {
      int t = tid + i * 512;
      X[t] = make_float2(fw[i].x * ia, fw[i].y * ib);
      if (t >= 1) X[8192 - t] = make_float2(bw[i].x * ia, bw[i].y * ib);
      else X[4096] = make_float2(0.f, 0.f);
    }
    fft_dif(X, W);
    float2* ka = kf + (size_t)(o * 256 + c) * 8192; float2* kb = ka + 8192;
#pragma unroll 4
    for (int i = 0; i < 16; ++i) {
      int pidx = tid + i * 512;
      int k = (int)(__brev((unsigned)pidx) >> 19);
      int k2 = (8192 - k) & 8191;
      int p2 = (int)(__brev((unsigned)k2) >> 19);
      float2 c1 = X[pidx], c2 = X[p2];
      float2 A = make_float2(0.5f * (c1.x + c2.x), 0.5f * (c1.y - c2.y));
      float2 Bv = make_float2(0.5f * (c1.y + c2.y), -0.5f * (c1.x - c2.x));
      ka[pidx] = A; kb[pidx] = Bv;
    }
    __syncthreads();
  }
  if (l == 0) {
    const float* rawc = (const float*)(p.ws + MISC_RAWC);
    float* G = (float*)(p.ws + MISC_GCTX);
    for (int u = blockIdx.x * 8 + wid; u < 512; u += gridDim.x * 8) {
      int o = u >> 8, c = u & 255; float f[4], b[4]; float s = 0.f;
#pragma unroll
      for (int i = 0; i < 4; ++i) {
        int t = lane + i * 64;
        f[i] = rawc[(size_t)t * 1024 + o * 512 + c]; b[i] = rawc[(size_t)t * 1024 + o * 512 + 256 + c];
        s += fabsf(f[i]) + fabsf(b[i]);
      }
      s = wave_sum(s); float inv = 1.f / s;
#pragma unroll
      for (int i = 0; i < 4; ++i) {
        int t = lane + i * 64;
        G[(size_t)u * 512 + 256 + t] = f[i] * inv;
        if (t >= 1) G[(size_t)u * 512 + 256 - t] = b[i] * inv;
      }
      if (lane == 0) G[(size_t)u * 512] = 0.f;
    }
  }
}

DI void ph_ln(const float* __restrict__ src_lat, const float* __restrict__ src_ctx, float* dst_lat, float* dst_ctx,
              const float* __restrict__ ag, const float* __restrict__ ab, bf16_t* U, const float* __restrict__ mod, int sh_off, int nrows) {
  const int lane = my_tid() & 63, wid = my_tid() >> 6;
  for (int row = blockIdx.x * 8 + wid; row < nrows; row += gridDim.x * 8) {
    const float* src = row < ML ? src_lat + (size_t)row * D : src_ctx + (size_t)(row - ML) * D;
    float4 v[4];
#pragma unroll
    for (int i = 0; i < 4; ++i) v[i] = *(const float4*)(src + i * 256 + lane * 4);
    float s = 0.f;
#pragma unroll
    for (int i = 0; i < 4; ++i) s += v[i].x + v[i].y + v[i].z + v[i].w;
    float mu = wave_sum(s) * (1.f / 1024.f);
    float q = 0.f;
#pragma unroll
    for (int i = 0; i < 4; ++i) { v[i].x -= mu; v[i].y -= mu; v[i].z -= mu; v[i].w -= mu; q += v[i].x * v[i].x + v[i].y * v[i].y + v[i].z * v[i].z + v[i].w * v[i].w; }
    float rs = rsqrtf(wave_sum(q) * (1.f / 1024.f) + 1e-6f);
#pragma unroll
    for (int i = 0; i < 4; ++i) { v[i].x *= rs; v[i].y *= rs; v[i].z *= rs; v[i].w *= rs; }
    if (ag) {
      float* dst = row < ML ? dst_lat + (size_t)row * D : dst_ctx + (size_t)(row - ML) * D;
#pragma unroll
      for (int i = 0; i < 4; ++i) {
        float4 gg = *(const float4*)(ag + i * 256 + lane * 4), bb = *(const float4*)(ab + i * 256 + lane * 4);
        v[i].x = v[i].x * gg.x + bb.x; v[i].y = v[i].y * gg.y + bb.y; v[i].z = v[i].z * gg.z + bb.z; v[i].w = v[i].w * gg.w + bb.w;
        *(float4*)(dst + i * 256 + lane * 4) = v[i];
      }
      if (U) {
        s = 0.f;
#pragma unroll
        for (int i = 0; i < 4; ++i) s += v[i].x + v[i].y + v[i].z + v[i].w;
        mu = wave_sum(s) * (1.f / 1024.f); q = 0.f;
#pragma unroll
        for (int i = 0; i < 4; ++i) { v[i].x -= mu; v[i].y -= mu; v[i].z -= mu; v[i].w -= mu; q += v[i].x * v[i].x + v[i].y * v[i].y + v[i].z * v[i].z + v[i].w * v[i].w; }
        rs = rsqrtf(wave_sum(q) * (1.f / 1024.f) + 1e-6f);
#pragma unroll
        for (int i = 0; i < 4; ++i) { v[i].x *= rs; v[i].y *= rs; v[i].z *= rs; v[i].w *= rs; }
      }
    }
    if (U) {
      const float* m = mod + (size_t)mod_idx(row) * 6144 + sh_off;
#pragma unroll
      for (int i = 0; i < 4; ++i) {
        float4 sh = *(const float4*)(m + i * 256 + lane * 4), sc = *(const float4*)(m + 1024 + i * 256 + lane * 4);
        uint2 o; o.x = pack2(v[i].x * (1.f + sc.x) + sh.x, v[i].y * (1.f + sc.y) + sh.y);
        o.y = pack2(v[i].z * (1.f + sc.z) + sh.z, v[i].w * (1.f + sc.w) + sh.w);
        *(uint2*)(U + (size_t)row * D + i * 256 + lane * 4) = o;
      }
    }
  }
}

DI void ph_inproj(const Params& p, char* smem) {
  const bf16_t* U = (const bf16_t*)(p.ws + R_U);
  const bf16_t* Bt = (const bf16_t*)(p.ws + WB_IN);
  const int lane = my_tid() & 63, wid = my_tid() >> 6, wm = wid >> 1, wn = wid & 1, g = lane >> 4, r16 = lane & 15;
  for (int it = 0;; ++it) {
    int mtile, ntile;
    if (!next_tile(it, 136, 26, mtile, ntile)) break;
    f32x4 acc[4][4]; zero_acc<4>(acc);
    gemm_main<4, true>(acc, U, 1024, RowPlain{(long)mtile * 256}, Bt + (size_t)ntile * 128 * 1024, 1024, 1024, smem);
    int b, key0;
    if (mtile < 128) { b = mtile >> 4; key0 = (mtile & 15) * 256; } else { b = mtile - 128; key0 = SL; }
    bf16_t* tbase = nullptr; int tcols = 0, tcol0 = 0;
    if (ntile < 6) { tbase = (bf16_t*)(p.ws + R_PHY); tcols = 768; tcol0 = ntile * 128; }
    else if (ntile == 9) { tbase = (bf16_t*)(p.ws + R_VTSW); tcols = 128; tcol0 = 0; }
    else if (ntile == 14 || ntile == 15) { tbase = (bf16_t*)(p.ws + R_VTDF); tcols = 256; tcol0 = (ntile - 14) * 128; }
    if (tbase) {
#pragma unroll
      for (int mt = 0; mt < 4; ++mt)
#pragma unroll
        for (int nt = 0; nt < 4; ++nt) {
          int col = tcol0 + wn * 64 + r16 * 4 + nt;
          int key = key0 + wm * 64 + mt * 16 + g * 4;
          uint2 o; o.x = pack2(acc[mt][nt][0], acc[mt][nt][1]); o.y = pack2(acc[mt][nt][2], acc[mt][nt][3]);
          *(uint2*)(tbase + ((size_t)b * tcols + col) * KEYS + key) = o;
        }
    } else {
      bf16_t* rb; int ld, c0, cmax;
      if (ntile < 9) { rb = (bf16_t*)(p.ws + R_PSW); ld = 384; c0 = (ntile - 6) * 128; cmax = 384; }
      else if (ntile < 14) { rb = (bf16_t*)(p.ws + R_PDF); ld = 512; c0 = (ntile - 10) * 128; cmax = 512; }
      else { rb = (bf16_t*)(p.ws + R_PRW); ld = 1216; c0 = (ntile - 16) * 128; cmax = 1216; }
      const int col = c0 + wn * 64 + r16 * 4;
      if (col < cmax) {
#pragma unroll
        for (int mt = 0; mt < 4; ++mt)
#pragma unroll
          for (int j = 0; j < 4; ++j) {
            size_t row = (size_t)mtile * 256 + wm * 64 + mt * 16 + g * 4 + j;
            uint2 o; o.x = pack2(acc[mt][0][j], acc[mt][1][j]); o.y = pack2(acc[mt][2][j], acc[mt][3][j]);
            *(uint2*)(rb + row * ld + col) = o;
          }
      }
    }
  }
}

DI float hy_conv3(const bf16_t* __restrict__ P, int t, int len, float w0, float w1, float w2, float bias) {
  float a = t >= 1 ? bf2f(P[t - 1]) : 0.f, b = bf2f(P[t]), c = (t + 1 < len) ? bf2f(P[t + 1]) : 0.f;
  return w0 * a + w1 * b + w2 * c + bias;
}
DI void ph_hyena(const Params& p, int l, char* smem) {
  float2* X = (float2*)smem; float2* W = X + 8192;
  const int tid = my_tid();
  const bf16_t* PT = (const bf16_t*)(p.ws + R_PHY);
  const float2* kf = (const float2*)(p.ws + OFF_KF);
  const float* cw = p.in[7] + (size_t)l * 3 * 768; const float* cb = p.in[8] + (size_t)l * 768;
  const float* hb = p.in[15] + (size_t)l * 512;
  bf16_t* Y = (bf16_t*)(p.ws + R_YHY);
  bool tw = false;
  for (int u = blockIdx.x; u < 1024; u += gridDim.x) {
    if (!tw) { load_twiddles(p, W); tw = true; }
    const int bp = u >> 8, c = u & 255; const int b0 = bp * 2, b1 = b0 + 1;
    const bf16_t* P0 = PT + ((size_t)b0 * 768) * KEYS; const bf16_t* P1 = PT + ((size_t)b1 * 768) * KEYS;
    float wv0 = cw[c], wv1 = cw[768 + c], wv2 = cw[1536 + c], bv = cb[c];
    float wa0 = cw[256 + c], wa1 = cw[768 + 256 + c], wa2 = cw[1536 + 256 + c], ba = cb[256 + c];
    float wb0 = cw[512 + c], wb1 = cw[768 + 512 + c], wb2 = cw[1536 + 512 + c], bb = cb[512 + c];
    const float bias0 = hb[c], bias1 = hb[256 + c];
    float2 vv[8];
    __syncthreads();
#pragma unroll
    for (int i = 0; i < 8; ++i) {
      int t = tid + i * 512;
      vv[i].x = hy_conv3(P0 + (size_t)c * KEYS, t, SL, wv0, wv1, wv2, bv);
      vv[i].y = hy_conv3(P1 + (size_t)c * KEYS, t, SL, wv0, wv1, wv2, bv);
      X[t] = vv[i]; X[t + 4096] = make_float2(0.f, 0.f);
    }
    fft_dif(X, W);
    {
      const float2* H = kf + (size_t)c * 8192;
#pragma unroll 4
      for (int i = 0; i < 16; ++i) { int q = tid + i * 512; X[q] = cmul(X[q], H[q]); }
    }
    fft_dit_inv(X, W);
    float2 zz[8];
#pragma unroll
    for (int i = 0; i < 8; ++i) {
      int t = tid + i * 512;
      float2 y = X[t];
      float x1a = hy_conv3(P0 + (size_t)(256 + c) * KEYS, t, SL, wa0, wa1, wa2, ba);
      float x1b = hy_conv3(P1 + (size_t)(256 + c) * KEYS, t, SL, wa0, wa1, wa2, ba);
      zz[i].x = x1a * (y.x * (1.f / 8192.f) + bias0 * vv[i].x);
      zz[i].y = x1b * (y.y * (1.f / 8192.f) + bias0 * vv[i].y);
    }
    __syncthreads();
#pragma unroll
    for (int i = 0; i < 8; ++i) { int t = tid + i * 512; X[t] = zz[i]; X[t + 4096] = make_float2(0.f, 0.f); }
    fft_dif(X, W);
    {
      const float2* H = kf + (size_t)(256 + c) * 8192;
#pragma unroll 4
      for (int i = 0; i < 16; ++i) { int q = tid + i * 512; X[q] = cmul(X[q], H[q]); }
    }
    fft_dit_inv(X, W);
#pragma unroll
    for (int i = 0; i < 8; ++i) {
      int t = tid + i * 512;
      float2 y = X[t];
      float x2a = hy_conv3(P0 + (size_t)(512 + c) * KEYS, t, SL, wb0, wb1, wb2, bb);
      float x2b = hy_conv3(P1 + (size_t)(512 + c) * KEYS, t, SL, wb0, wb1, wb2, bb);
      float oa = x2a * (y.x * (1.f / 8192.f) + bias1 * zz[i].x);
      float ob = x2b * (y.y * (1.f / 8192.f) + bias1 * zz[i].y);
      Y[((size_t)b0 * SL + t) * 256 + c] = (bf16_t)f2bf(oa);
      Y[((size_t)b1 * SL + t) * 256 + c] = (bf16_t)f2bf(ob);
    }
  }
}

DI void ph_hyena_ctx(const Params& p, int l, char* smem) {
  const int tid = my_tid(), lane = tid & 63, wid = tid >> 6;
  float* Zb = (float*)smem + wid * 1024;
  float* Gb = Zb + 256;
  const bf16_t* PT = (const bf16_t*)(p.ws + R_PHY);
  const float* G = (const float*)(p.ws + MISC_GCTX);
  const float* cw = p.in[7] + (size_t)l * 3 * 768; const float* cb = p.in[8] + (size_t)l * 768;
  const float* hb = p.in[15] + (size_t)l * 512;
  bf16_t* Y = (bf16_t*)(p.ws + R_YHY);
  for (int base = blockIdx.x * 8; base < 2048; base += gridDim.x * 8) {
    const int u = base + wid; const int b = u >> 8, c = u & 255;
    const bf16_t* Pb = PT + ((size_t)b * 768) * KEYS + SL;
    float v[4], x1[4], x2[4], zz[4];
#pragma unroll
    for (int i = 0; i < 4; ++i) {
      int t = lane + i * 64;
      v[i] = hy_conv3(Pb + (size_t)c * KEYS, t, CL, cw[c], cw[768 + c], cw[1536 + c], cb[c]);
      x1[i] = hy_conv3(Pb + (size_t)(256 + c) * KEYS, t, CL, cw[256 + c], cw[768 + 256 + c], cw[1536 + 256 + c], cb[256 + c]);
      x2[i] = hy_conv3(Pb + (size_t)(512 + c) * KEYS, t, CL, cw[512 + c], cw[768 + 512 + c], cw[1536 + 512 + c], cb[512 + c]);
    }
    __syncthreads();
#pragma unroll
    for (int i = 0; i < 4; ++i) Zb[lane + i * 64] = v[i];
    for (int i = lane; i < 512; i += 64) Gb[i] = G[(size_t)c * 512 + i];
    __syncthreads();
#pragma unroll
    for (int i = 0; i < 4; ++i) {
      int t = lane + i * 64; float s = 0.f;
      for (int s2 = 0; s2 < 256; ++s2) s += Gb[256 + t - s2] * Zb[s2];
      zz[i] = x1[i] * (s + hb[c] * v[i]);
    }
    __syncthreads();
#pragma unroll
    for (int i = 0; i < 4; ++i) Zb[lane + i * 64] = zz[i];
    for (int i = lane; i < 512; i += 64) Gb[i] = G[(size_t)(256 + c) * 512 + i];
    __syncthreads();
#pragma unroll
    for (int i = 0; i < 4; ++i) {
      int t = lane + i * 64; float s = 0.f;
      for (int s2 = 0; s2 < 256; ++s2) s += Gb[256 + t - s2] * Zb[s2];
      float o = x2[i] * (s + hb[256 + c] * zz[i]);
      Y[((size_t)ML + b * CL + t) * 256 + c] = (bf16_t)f2bf(o);
    }
  }
}

DI void ph_rope(const Params& p, char* smem) {
  float2* T16 = (float2*)smem;
  float2* T8 = T16 + 64 * 16;
  const int tid = my_tid(), lane = tid & 63, wid = tid >> 6;
  __syncthreads();
  for (int i = tid; i < 64 * 16; i += NTHR) {
    int pos = i >> 4, f = i & 15; float inv = powf(10000.f, -(float)f / 16.f); float s, c; sincosf((float)pos * inv, &s, &c);
    T16[i] = make_float2(c, s);
  }
  for (int i = tid; i < 64 * 8; i += NTHR) {
    int pos = i >> 3, f = i & 7; float inv = powf(10000.f, -(float)f / 8.f); float s, c; sincosf((float)pos * inv, &s, &c);
    T8[i] = make_float2(c, s);
  }
  __syncthreads();
  bf16_t* Psw = (bf16_t*)(p.ws + R_PSW); bf16_t* Pdf = (bf16_t*)(p.ws + R_PDF);
  for (int row = blockIdx.x * 8 + wid; row < ML; row += gridDim.x * 8) {
    const int t = row & (SL - 1); const int pr = t >> 6, pc = t & 63;
    bf16_t* q = Psw + (size_t)row * 384;
#pragma unroll
    for (int i = 0; i < 3; ++i) {
      int pi = lane + i * 64; int hd = pi >> 5, pp = pi & 31; int half = pp >> 4, f = pp & 15;
      int base = hd * 64 + half * 32; float2 cs = T16[(half ? pc : pr) * 16 + f];
      float x1 = bf2f(q[base + f]), x2 = bf2f(q[base + 16 + f]);
      q[base + f] = (bf16_t)f2bf(x1 * cs.x - x2 * cs.y); q[base + 16 + f] = (bf16_t)f2bf(x1 * cs.y + x2 * cs.x);
    }
    bf16_t* d = Pdf + (size_t)row * 512;
#pragma unroll
    for (int i = 0; i < 4; ++i) {
      int pi = lane + i * 64; int gi = pi >> 4, pp = pi & 15; int half = pp >> 3, f = pp & 7;
      int base = gi * 32 + half * 16; float2 cs = T8[(half ? pc : pr) * 8 + f];
      float x1 = bf2f(d[base + f]), x2 = bf2f(d[base + 8 + f]);
      d[base + f] = (bf16_t)f2bf(x1 * cs.x - x2 * cs.y); d[base + 8 + f] = (bf16_t)f2bf(x1 * cs.y + x2 * cs.x);
    }
  }
}

DI float rw_shift(const bf16_t* __restrict__ P, int row, int t, int len, int col, float mu) {
  float c = bf2f(P[(size_t)row * 1216 + col]);
  float a = t >= 1 ? bf2f(P[(size_t)(row - 1) * 1216 + col]) : 0.f;
  float b = t + 1 < len ? bf2f(P[(size_t)(row + 1) * 1216 + col]) : 0.f;
  return c + (0.5f * (a + b) - c) * mu;
}
DI void ph_rwprep(const Params& p, int l, char* smem) {
  constexpr int AST = 912, RST = 1552, ROFF = 32 * AST;
  const int tid = my_tid(), lane = tid & 63, wid = tid >> 6, g = lane >> 4, r16 = lane & 15;
  const int tg = wid >> 2, hd = wid & 3;
  const bf16_t* P = (const bf16_t*)(p.ws + R_PRW);
  const float* mu = p.in[17] + (size_t)l * 1216;
  const float* w0 = p.in[18] + (size_t)l * 512; const float* a0 = p.in[20] + (size_t)l * 256;
  const float* kkw = p.in[23] + (size_t)l * 256; const float* kaw = p.in[24] + (size_t)l * 256;
  bf16_t* S = (bf16_t*)(p.ws + R_STR); bf16_t* Gs = (bf16_t*)(p.ws + R_G);
  const size_t SU = (size_t)MT * 256;
  float w0f[4], w0b[4], a0c[4], kkc[4], kac[4];
#pragma unroll
  for (int nt = 0; nt < 4; ++nt) { int c = hd * 64 + nt * 16 + r16; w0f[nt] = w0[c]; w0b[nt] = w0[256 + c]; a0c[nt] = a0[c]; kkc[nt] = kkw[c]; kac[nt] = kaw[c]; }
  for (int u = blockIdx.x; u < MT / 32; u += gridDim.x) {
    const int row0 = u * 32; int t0, len;
    if (row0 < ML) { t0 = row0 & (SL - 1); len = SL; } else { t0 = (row0 - ML) & (CL - 1); len = CL; }
    __syncthreads();
    for (int item = tid; item < 32 * 152; item += NTHR) {
      const int tk = item / 152, c8 = item - tk * 152; const int row = row0 + tk, t = t0 + tk;
      const uint4 uc = *(const uint4*)(P + (size_t)row * 1216 + c8 * 8);
      uint4 ua = make_uint4(0, 0, 0, 0), ub = make_uint4(0, 0, 0, 0);
      if (t >= 1) ua = *(const uint4*)(P + (size_t)(row - 1) * 1216 + c8 * 8);
      if (t + 1 < len) ub = *(const uint4*)(P + (size_t)(row + 1) * 1216 + c8 * 8);
      const float4 m0 = *(const float4*)(mu + c8 * 8), m1 = *(const float4*)(mu + c8 * 8 + 4);
      float o[8];
      {
        const unsigned wc[4] = {uc.x, uc.y, uc.z, uc.w}, wa[4] = {ua.x, ua.y, ua.z, ua.w}, wb[4] = {ub.x, ub.y, ub.z, ub.w};
        const float mm[8] = {m0.x, m0.y, m0.z, m0.w, m1.x, m1.y, m1.z, m1.w};
#pragma unroll
        for (int i = 0; i < 4; ++i) {
          float c_lo = bflo(wc[i]), c_hi = bfhi(wc[i]);
          o[2 * i] = c_lo + (0.5f * (bflo(wa[i]) + bflo(wb[i])) - c_lo) * mm[2 * i];
          o[2 * i + 1] = c_hi + (0.5f * (bfhi(wa[i]) + bfhi(wb[i])) - c_hi) * mm[2 * i + 1];
        }
      }
      char* dst;
      if (c8 < 96) dst = smem + ROFF + tk * RST + c8 * 16;
      else {
        const int cc = c8 * 8 - 768;
        if (cc < 128) {
#pragma unroll
          for (int i = 0; i < 8; ++i) o[i] = tanhf(o[i]);
        } else if (cc >= 192) {
#pragma unroll
          for (int i = 0; i < 8; ++i) o[i] = sigmoidf_(o[i]);
        }
        dst = smem + tk * AST + cc * 2;
      }
      uint4 ov; ov.x = pack2(o[0], o[1]); ov.y = pack2(o[2], o[3]); ov.z = pack2(o[4], o[5]); ov.w = pack2(o[6], o[7]);
      *(uint4*)dst = ov;
    }
    __syncthreads();
    f32x4 acc[5][4];
#pragma unroll
    for (int o5 = 0; o5 < 5; ++o5)
#pragma unroll
      for (int nt = 0; nt < 4; ++nt) acc[o5][nt] = (f32x4){0.f, 0.f, 0.f, 0.f};
    const char* Arow = smem + (tg * 16 + r16) * AST + g * 16;
#pragma unroll
    for (int o5 = 0; o5 < 5; ++o5) {
      const int kbase = o5 < 3 ? o5 * 64 : (o5 == 3 ? 192 : 320);
      const int KK = o5 < 3 ? 64 : 128;
      const bf16_t* Wt = (const bf16_t*)(p.ws + (o5 == 0 ? RWW_F : o5 == 1 ? RWW_B : o5 == 2 ? RWW_A : o5 == 3 ? RWW_GF : RWW_GB));
#pragma unroll
      for (int ks = 0; ks < KK / 32; ++ks) {
        const bf16x8 af = *(const bf16x8*)(Arow + (kbase + ks * 32) * 2);
#pragma unroll
        for (int nt = 0; nt < 4; ++nt) {
          const bf16x8 bf = *(const bf16x8*)(Wt + (size_t)(hd * 64 + nt * 16 + r16) * KK + ks * 32 + g * 8);
          acc[o5][nt] = __builtin_amdgcn_mfma_f32_16x16x32_bf16(af, bf, acc[o5][nt], 0, 0, 0);
        }
        if (ks & 1) asm volatile("" ::: "memory");
      }
    }
#pragma unroll
    for (int j = 0; j < 4; ++j) {
      const int tk = tg * 16 + g * 4 + j; const size_t row = (size_t)row0 + tk;
      const char* rk = smem + ROFF + tk * RST;
      float kv[4], n2 = 0.f;
#pragma unroll
      for (int nt = 0; nt < 4; ++nt) { int c = hd * 64 + nt * 16 + r16; kv[nt] = bf2f(*(const unsigned short*)(rk + (256 + c) * 2)); float q = kv[nt] * kkc[nt]; n2 += q * q; }
      n2 = sum16(n2);
      const float inv = 1.f / fmaxf(sqrtf(n2), 1e-12f);
#pragma unroll
      for (int nt = 0; nt < 4; ++nt) {
        const int c = hd * 64 + nt * 16 + r16;
        const float r = bf2f(*(const unsigned short*)(rk + c * 2)), v = bf2f(*(const unsigned short*)(rk + (512 + c) * 2)), k = kv[nt];
        const float a = sigmoidf_(a0c[nt] + acc[2][nt][j]);
        const float kk = k * kkc[nt] * inv;
        const float kp = k * (1.f + (a - 1.f) * kac[nt]);
        const float bq = kk * a;
        const float xf = -(w0f[nt] + acc[0][nt][j]); const float spf = fmaxf(xf, 0.f) + log1pf(__expf(-fabsf(xf)));
        const float xb = -(w0b[nt] + acc[1][nt][j]); const float spb = fmaxf(xb, 0.f) + log1pf(__expf(-fabsf(xb)));
        const float ef = __expf(-spf - 0.5f), eb = __expf(-spb - 0.5f);
        const float d_f = -expm1f(-ef), d_b = -expm1f(-eb);
        const size_t o = row * 256 + c;
        S[o] = (bf16_t)f2bf(r); S[SU + o] = (bf16_t)f2bf(kp); S[2 * SU + o] = (bf16_t)f2bf(v); S[3 * SU + o] = (bf16_t)f2bf(kk);
        S[4 * SU + o] = (bf16_t)f2bf(bq); S[5 * SU + o] = (bf16_t)f2bf(d_f); S[6 * SU + o] = (bf16_t)f2bf(d_b);
        Gs[o] = (bf16_t)f2bf(acc[3][nt][j]); Gs[SU + o] = (bf16_t)f2bf(acc[4][nt][j]);
      }
    }
  }
}

DI long scan_row(int b, int dir, int s) {
  if (s < CL) return (long)ML + b * CL + (dir ? (CL - 1 - s) : s);
  int t = s - CL; return (long)b * SL + (dir ? (SL - 1 - t) : t);
}
DI float sum8(float v) {
  v += dpp_mov<0xB1>(v);
  v += dpp_mov<0x4E>(v);
  v += dpp_mov<0x141>(v);
  return v;
}
DI void ph_scan(const Params& p, char* smem) {
  const int tid = my_tid(), lane = tid & 63, wid = tid >> 6;
  const bf16_t* S = (const bf16_t*)(p.ws + R_STR);
  const size_t SU = (size_t)MT * 256;
  constexpr int T = 32, NSTEP = CL + SL, NCH = NSTEP / T;
  typedef float f32x2 __attribute__((ext_vector_type(2)));
  for (int u = blockIdx.x; u < 128; u += gridDim.x) {
    const int chain = u >> 1, rg = u & 1; const int dir = chain & 1, bh = chain >> 1, b = bh >> 2, h = bh & 3;
    bf16_t* O = (bf16_t*)(p.ws + (dir ? R_OB : R_OF));
    uint4 q0, q1, q2;
    auto SC_GLOAD = [&](int ci) {
#pragma unroll
      for (int j = 0; j < 3; ++j) {
        int idx = tid + j * 512; int st = idx >> 8, s = (idx & 255) >> 3, ck = idx & 7;
        long row = scan_row(b, dir, ci * T + s);
        int sid = st < 5 ? st : 5 + dir;
        uint4 v = *(const uint4*)(S + sid * SU + row * 256 + h * 64 + ck * 8);
        if (j == 0) q0 = v; else if (j == 1) q1 = v; else q2 = v;
      }
    };
    auto SC_SSTORE = [&](int buf) {
#pragma unroll
      for (int j = 0; j < 3; ++j) {
        int idx = tid + j * 512; int st = idx >> 8;
        uint4 v = j == 0 ? q0 : (j == 1 ? q1 : q2);
        float4 lo = make_float4(bflo(v.x), bfhi(v.x), bflo(v.y), bfhi(v.y));
        float4 hi = make_float4(bflo(v.z), bfhi(v.z), bflo(v.w), bfhi(v.w));
        if (st == 5) { lo.x = 1.f - lo.x; lo.y = 1.f - lo.y; lo.z = 1.f - lo.z; lo.w = 1.f - lo.w; hi.x = 1.f - hi.x; hi.y = 1.f - hi.y; hi.z = 1.f - hi.z; hi.w = 1.f - hi.w; }
        char* base = smem + buf * 49152 + idx * 32;
        *(float4*)(base) = lo; *(float4*)(base + 16) = hi;
      }
    };
    auto FLUSH = [&](int ci) {
      const int s = tid >> 4, part = tid & 15;
      unsigned v = *(const unsigned*)(smem + 98304 + (ci & 1) * 2048 + s * 64 + part * 4);
      long row = scan_row(b, dir, ci * T + s);
      *(unsigned*)(O + row * 256 + h * 64 + rg * 32 + part * 2) = v;
    };
    __syncthreads();
    SC_GLOAD(0);
    SC_SSTORE(0);
    __syncthreads();
    f32x2 st0 = {0.f, 0.f}, st1 = {0.f, 0.f}, st2 = {0.f, 0.f}, st3 = {0.f, 0.f};
    const int rsub = lane >> 3, ks = lane & 7;
    const int lrow = (wid & 3) * 8 + rsub;
    const int vrow = rg * 32 + lrow;
    struct Step { f32x2 r[4], k[4], kk[4], b[4], w[4]; float v; };
    auto LOADSTEP = [&](Step& x, const char* B, int s) {
#pragma unroll
      for (int hh = 0; hh < 2; ++hh) {
        const float4 r = *(const float4*)(B + (0 * T + s) * 256 + ks * 32 + hh * 16);
        const float4 k = *(const float4*)(B + (1 * T + s) * 256 + ks * 32 + hh * 16);
        const float4 kk = *(const float4*)(B + (3 * T + s) * 256 + ks * 32 + hh * 16);
        const float4 bb = *(const float4*)(B + (4 * T + s) * 256 + ks * 32 + hh * 16);
        const float4 w = *(const float4*)(B + (5 * T + s) * 256 + ks * 32 + hh * 16);
        x.r[2 * hh] = (f32x2){r.x, r.y}; x.r[2 * hh + 1] = (f32x2){r.z, r.w};
        x.k[2 * hh] = (f32x2){k.x, k.y}; x.k[2 * hh + 1] = (f32x2){k.z, k.w};
        x.kk[2 * hh] = (f32x2){kk.x, kk.y}; x.kk[2 * hh + 1] = (f32x2){kk.z, kk.w};
        x.b[2 * hh] = (f32x2){bb.x, bb.y}; x.b[2 * hh + 1] = (f32x2){bb.z, bb.w};
        x.w[2 * hh] = (f32x2){w.x, w.y}; x.w[2 * hh + 1] = (f32x2){w.z, w.w};
      }
      x.v = *(const float*)(B + (2 * T + s) * 256 + vrow * 4);
    };
    for (int ci = 0; ci < NCH; ++ci) {
      if (ci + 1 < NCH) { SC_GLOAD(ci + 1); }
      if (ci > 0) FLUSH(ci - 1);
      if (wid < 4) {
        const char* B = smem + (ci & 1) * 49152;
        bf16_t* ob = (bf16_t*)(smem + 98304 + (ci & 1) * 2048);
        Step nx; LOADSTEP(nx, B, 0);
#pragma unroll 2
        for (int s = 0; s < T; ++s) {
          const Step c = nx;
          LOADSTEP(nx, B, (s + 1 < T) ? s + 1 : s);
          f32x2 pa = st0 * c.kk[0] + st1 * c.kk[1];
          f32x2 pb = st2 * c.kk[2] + st3 * c.kk[3];
          pa = pa + pb;
          float sa = -(pa.x + pa.y);
          sa = sum8(sa);
          const f32x2 sa2 = {sa, sa}; const f32x2 v2 = {c.v, c.v};
          st0 = st0 * c.w[0] + sa2 * c.b[0] + v2 * c.k[0];
          st1 = st1 * c.w[1] + sa2 * c.b[1] + v2 * c.k[1];
          st2 = st2 * c.w[2] + sa2 * c.b[2] + v2 * c.k[2];
          st3 = st3 * c.w[3] + sa2 * c.b[3] + v2 * c.k[3];
          f32x2 oa = st0 * c.r[0] + st1 * c.r[1];
          f32x2 ob2 = st2 * c.r[2] + st3 * c.r[3];
          oa = oa + ob2;
          float o = sum8(oa.x + oa.y);
          if (ks == 0) ob[s * 32 + lrow] = (bf16_t)f2bf(o);
        }
      }
      if (ci + 1 < NCH) { SC_SSTORE((ci + 1) & 1); }
      __syncthreads();
    }
    FLUSH(NCH - 1);
  }
}

template <bool DIFF>
DI void attn_unit(const Params& p, int l, int b, int h, int qrow0, int qpos0, int kb_lo, int kb_hi, int kc_lo, char* smem) {
  const int tid = my_tid(), lane = tid & 63, wid = tid >> 6, g = lane >> 4, r16 = lane & 15;
  const bf16_t* QK = (const bf16_t*)(p.ws + (DIFF ? R_PDF : R_PSW));
  const int ldq = DIFF ? 512 : 384;
  const int qc0 = h * 64;
  const int kc0 = 256 + (DIFF ? h * 64 : (h >> 1) * 64);
  const bf16_t* VT = DIFF ? (const bf16_t*)(p.ws + R_VTDF) + ((size_t)b * 256 + h * 64) * KEYS
                          : (const bf16_t*)(p.ws + R_VTSW) + ((size_t)b * 128 + (h >> 1) * 64) * KEYS;
  const int nblk = (kb_hi - kb_lo) + (68 - kc_lo);
  const float sc = (DIFF ? 0.17677669529663687f : 0.125f) * 1.4426950408889634f;
  bf16x8 qf[2];
  {
    const bf16_t* qp = QK + (size_t)(qrow0 + wid * 16 + r16) * ldq + qc0 + g * 8;
    qf[0] = *(const bf16x8*)(qp); qf[1] = *(const bf16x8*)(qp + 32);
  }
  constexpr int NC = DIFF ? 2 : 1;
  float m[NC], lsum[NC];
  f32x4 O[NC][4];
#pragma unroll
  for (int c = 0; c < NC; ++c) {
    if (DIFF) { m[c] = -1e30f; lsum[c] = 0.f; }
    else { m[c] = p.in[16][l * 4 + h] * 1.4426950408889634f; lsum[c] = (g == 0) ? 1.f : 0.f; }
#pragma unroll
    for (int dt = 0; dt < 4; ++dt) O[c][dt] = (f32x4){0.f, 0.f, 0.f, 0.f};
  }
  const int lr = tid >> 3, lc = tid & 7;
  uint4 rk, rv;
#define AT_GLOAD(i)                                                                                   \
  do {                                                                                                \
    int kb = (i) < (kb_hi - kb_lo) ? kb_lo + (i) : kc_lo + ((i) - (kb_hi - kb_lo));                    \
    long krow = kb < 64 ? (long)b * SL + kb * 64 + lr : (long)ML + b * CL + (kb - 64) * 64 + lr;       \
    rk = *(const uint4*)(QK + krow * ldq + kc0 + lc * 8);                                             \
    rv = *(const uint4*)(VT + (size_t)lr * KEYS + kb * 64 + lc * 8);                                  \
  } while (0)
#define AT_SSTORE(buf)                                                                                \
  do {                                                                                                \
    *(uint4*)(smem + (buf) * 18432 + lr * 128 + ((lc ^ (lr & 7)) << 4)) = rk;                         \
    *(uint4*)(smem + (buf) * 18432 + 9216 + lr * 144 + lc * 16) = rv;                                 \
  } while (0)
  __syncthreads();
  AT_GLOAD(0);
  AT_SSTORE(0);
  __syncthreads();
  const int qpos = qpos0 + wid * 16 + r16;
  for (int i = 0; i < nblk; ++i) {
    if (i + 1 < nblk) AT_GLOAD(i + 1);
    const int kb = i < (kb_hi - kb_lo) ? kb_lo + i : kc_lo + (i - (kb_hi - kb_lo));
    const bool masked = (!DIFF) && (kb < 64);
    const char* Kt = smem + (i & 1) * 18432; const char* Vt = Kt + 9216;
    f32x4 S[NC][4];
#pragma unroll
    for (int kt = 0; kt < 4; ++kt) {
      bf16x8 k0 = *(const bf16x8*)(Kt + (kt * 16 + r16) * 128 + ((g ^ (r16 & 7)) << 4));
      bf16x8 k1 = *(const bf16x8*)(Kt + (kt * 16 + r16) * 128 + (((4 + g) ^ (r16 & 7)) << 4));
      if (DIFF) {
        S[0][kt] = __builtin_amdgcn_mfma_f32_16x16x32_bf16(k0, qf[0], (f32x4){0.f, 0.f, 0.f, 0.f}, 0, 0, 0);
        S[NC - 1][kt] = __builtin_amdgcn_mfma_f32_16x16x32_bf16(k1, qf[1], (f32x4){0.f, 0.f, 0.f, 0.f}, 0, 0, 0);
      } else {
        f32x4 t = __builtin_amdgcn_mfma_f32_16x16x32_bf16(k0, qf[0], (f32x4){0.f, 0.f, 0.f, 0.f}, 0, 0, 0);
        S[0][kt] = __builtin_amdgcn_mfma_f32_16x16x32_bf16(k1, qf[1], t, 0, 0, 0);
      }
    }
    bf16x8 pf[NC][2];
#pragma unroll
    for (int c = 0; c < NC; ++c) {
      float mx = -1e30f;
#pragma unroll
      for (int kt = 0; kt < 4; ++kt)
#pragma unroll
        for (int j = 0; j < 4; ++j) {
          float v = S[c][kt][j] * sc;
          if (masked) { int kpos = kb * 64 + kt * 16 + g * 4 + j; int dd = kpos - qpos; if (dd > 128 || dd < -128) v = -1e30f; }
          S[c][kt][j] = v; mx = fmaxf(mx, v);
        }
      mx = fmaxf(mx, __shfl_xor(mx, 16)); mx = fmaxf(mx, __shfl_xor(mx, 32));
      float mn = fmaxf(m[c], mx);
      float alpha = __builtin_amdgcn_exp2f(m[c] - mn);
      m[c] = mn;
      float ps = 0.f;
      unsigned pk[8];
#pragma unroll
      for (int kt = 0; kt < 4; ++kt) {
        float e0 = __builtin_amdgcn_exp2f(S[c][kt][0] - mn), e1 = __builtin_amdgcn_exp2f(S[c][kt][1] - mn), e2 = __builtin_amdgcn_exp2f(S[c][kt][2] - mn), e3 = __builtin_amdgcn_exp2f(S[c][kt][3] - mn);
        ps += (e0 + e1) + (e2 + e3);
        pk[kt * 2] = pack2(e0, e1); pk[kt * 2 + 1] = pack2(e2, e3);
      }
      lsum[c] = lsum[c] * alpha + ps;
#pragma unroll
      for (int dt = 0; dt < 4; ++dt) { O[c][dt][0] *= alpha; O[c][dt][1] *= alpha; O[c][dt][2] *= alpha; O[c][dt][3] *= alpha; }
      union { unsigned u[4]; bf16x8 v; } cv;
      cv.u[0] = pk[0]; cv.u[1] = pk[1]; cv.u[2] = pk[2]; cv.u[3] = pk[3]; pf[c][0] = cv.v;
      cv.u[0] = pk[4]; cv.u[1] = pk[5]; cv.u[2] = pk[6]; cv.u[3] = pk[7]; pf[c][1] = cv.v;
    }
#pragma unroll
    for (int dt = 0; dt < 4; ++dt)
#pragma unroll
      for (int s2 = 0; s2 < 2; ++s2) {
        union { uint2 u[2]; bf16x8 v; } vf;
        vf.u[0] = *(const uint2*)(Vt + (dt * 16 + r16) * 144 + (2 * s2) * 32 + g * 8);
        vf.u[1] = *(const uint2*)(Vt + (dt * 16 + r16) * 144 + (2 * s2 + 1) * 32 + g * 8);
#pragma unroll
        for (int c = 0; c < NC; ++c) O[c][dt] = __builtin_amdgcn_mfma_f32_16x16x32_bf16(vf.v, pf[c][s2], O[c][dt], 0, 0, 0);
      }
    if (i + 1 < nblk) AT_SSTORE((i + 1) & 1);
    __syncthreads();
  }
#undef AT_GLOAD
#undef AT_SSTORE
  float linv[NC];
#pragma unroll
  for (int c = 0; c < NC; ++c) { float t = lsum[c]; t += __shfl_xor(t, 16); t += __shfl_xor(t, 32); linv[c] = 1.f / t; }
  const size_t orow = (size_t)(qrow0 + wid * 16 + r16);
  if (!DIFF) {
    bf16_t* Y = (bf16_t*)(p.ws + R_YSW);
#pragma unroll
    for (int dt = 0; dt < 4; ++dt) {
      uint2 o; o.x = pack2(O[0][dt][0] * linv[0], O[0][dt][1] * linv[0]); o.y = pack2(O[0][dt][2] * linv[0], O[0][dt][3] * linv[0]);
      *(uint2*)(Y + orow * 256 + h * 64 + dt * 16 + g * 4) = o;
    }
  } else {
    const float lam_init = 0.8f - 0.6f * __expf(-0.3f * (float)l);
    float d1 = 0.f, d2 = 0.f;
    if (lane < 32) { d1 = p.in[28][l * 32 + lane] * p.in[29][l * 32 + lane]; d2 = p.in[30][l * 32 + lane] * p.in[31][l * 32 + lane]; }
    d1 = wave_sum(d1); d2 = wave_sum(d2);
    const float lam = expf(d1) - expf(d2) + lam_init;
    float ov[4][4]; float ss = 0.f;
#pragma unroll
    for (int dt = 0; dt < 4; ++dt)
#pragma unroll
      for (int j = 0; j < 4; ++j) { float v = O[0][dt][j] * linv[0] - lam * O[NC - 1][dt][j] * linv[NC - 1]; ov[dt][j] = v; ss += v * v; }
    ss += __shfl_xor(ss, 16); ss += __shfl_xor(ss, 32);
    const float rms = rsqrtf(ss * (1.f / 64.f) + 1e-5f) * (1.f - lam_init);
    const float* sg = p.in[32] + l * 64;
    bf16_t* Y = (bf16_t*)(p.ws + R_YDF);
#pragma unroll
    for (int dt = 0; dt < 4; ++dt) {
      const int d0 = dt * 16 + g * 4;
      uint2 o; o.x = pack2(ov[dt][0] * rms * sg[d0], ov[dt][1] * rms * sg[d0 + 1]); o.y = pack2(ov[dt][2] * rms * sg[d0 + 2], ov[dt][3] * rms * sg[d0 + 3]);
      *(uint2*)(Y + orow * 256 + h * 64 + d0) = o;
    }
  }
}

DI void ph_attn(const Params& p, int l, char* smem) {
  const bool need_ctx = (l == 0);
  const int n_sw = 1024 + (need_ctx ? 64 : 0);
  const int n_df = 1024 + (need_ctx ? 64 : 0);
  unsigned* ctr = (unsigned*)(p.ws + MISC_BAR + 64 + 64 * l);
  volatile int* slot = (volatile int*)(smem + 40960);
  for (;;) {
    __syncthreads();
    if (my_tid() == 0) *slot = (int)__hip_atomic_fetch_add(ctr, 1u, __ATOMIC_RELAXED, __HIP_MEMORY_SCOPE_AGENT);
    __syncthreads();
    const int u = *slot;
    if (u >= n_sw + n_df) break;
    if (u < n_df) {
      if (u < 1024) { int b = u >> 7, h = (u >> 5) & 3, n = u & 31; attn_unit<true>(p, l, b, h, b * SL + n * 128, n * 128, 0, 64, 64, smem); }
      else { int v = u - 1024; int b = v >> 3, h = (v >> 1) & 3, n = v & 1; attn_unit<true>(p, l, b, h, ML + b * CL + n * 128, 0, 0, 0, 64, smem); }
    } else {
      int w = u - n_df;
      if (w < 1024) {
        int b = w >> 7, h = (w >> 5) & 3, n = w & 31;
        int lo = (n - 1) * 2; if (lo < 0) lo = 0; int hi = (n + 2) * 2; if (hi > 64) hi = 64;
        attn_unit<false>(p, l, b, h, b * SL + n * 128, n * 128, lo, hi, 64, smem);
      } else { int v = w - 1024; int b = v >> 3, h = (v >> 1) & 3, n = v & 1; attn_unit<false>(p, l, b, h, ML + b * CL + n * 128, 0, 0, 0, 64, smem); }
    }
  }
}

DI void ph_rwout(const Params& p, int l) {
  const int lane = my_tid() & 63, wid = my_tid() >> 6;
  const bf16_t* S = (const bf16_t*)(p.ws + R_STR); const bf16_t* Gs = (const bf16_t*)(p.ws + R_G);
  const bf16_t* OF = (const bf16_t*)(p.ws + R_OF); const bf16_t* OB = (const bf16_t*)(p.ws + R_OB);
  bf16_t* Y = (bf16_t*)(p.ws + R_YRW);
  const size_t SU = (size_t)MT * 256;
  const float4 rk = *(const float4*)(p.in[25] + (size_t)l * 256 + lane * 4);
  const float4 gam = *(const float4*)(p.in[26] + (size_t)l * 256 + lane * 4);
  const float4 bet = *(const float4*)(p.in[27] + (size_t)l * 256 + lane * 4);
  const int nrows = (l == 0) ? MT : ML;
  for (int row = blockIdx.x * 8 + wid; row < nrows; row += gridDim.x * 8) {
    const size_t o = (size_t)row * 256 + lane * 4;
    uint2 ur = *(const uint2*)(S + o), uk = *(const uint2*)(S + SU + o), uv = *(const uint2*)(S + 2 * SU + o);
    uint2 uf = *(const uint2*)(OF + o), ub = *(const uint2*)(OB + o), ugf = *(const uint2*)(Gs + o), ugb = *(const uint2*)(Gs + SU + o);
    float r[4] = {bflo(ur.x), bfhi(ur.x), bflo(ur.y), bfhi(ur.y)};
    float k[4] = {bflo(uk.x), bfhi(uk.x), bflo(uk.y), bfhi(uk.y)};
    float v[4] = {bflo(uv.x), bfhi(uv.x), bflo(uv.y), bfhi(uv.y)};
    float f[4] = {bflo(uf.x), bfhi(uf.x), bflo(uf.y), bfhi(uf.y)};
    float bb[4] = {bflo(ub.x), bfhi(ub.x), bflo(ub.y), bfhi(ub.y)};
    float gf[4] = {bflo(ugf.x), bfhi(ugf.x), bflo(ugf.y), bfhi(ugf.y)};
    float gb[4] = {bflo(ugb.x), bfhi(ugb.x), bflo(ugb.y), bfhi(ugb.y)};
    const float rkv[4] = {rk.x, rk.y, rk.z, rk.w}; const float ga[4] = {gam.x, gam.y, gam.z, gam.w}; const float be[4] = {bet.x, bet.y, bet.z, bet.w};
    float bon = 0.f, sf = 0.f, sb = 0.f;
#pragma unroll
    for (int i = 0; i < 4; ++i) { bon += r[i] * k[i] * rkv[i]; sf += f[i]; sb += bb[i]; }
    bon = sum16(bon); float muf = sum16(sf) * (1.f / 64.f), mub = sum16(sb) * (1.f / 64.f);
    float qf = 0.f, qb = 0.f;
#pragma unroll
    for (int i = 0; i < 4; ++i) { f[i] -= muf; bb[i] -= mub; qf += f[i] * f[i]; qb += bb[i] * bb[i]; }
    float rsf = rsqrtf(sum16(qf) * (1.f / 64.f) + 64e-5f), rsb = rsqrtf(sum16(qb) * (1.f / 64.f) + 64e-5f);
    float y[4];
#pragma unroll
    for (int i = 0; i < 4; ++i) {
      float bn = bon * v[i];
      y[i] = (f[i] * rsf * ga[i] + be[i] + bn) * gf[i] + (bb[i] * rsb * ga[i] + be[i] + bn) * gb[i];
    }
    uint2 oo; oo.x = pack2(y[0], y[1]); oo.y = pack2(y[2], y[3]);
    *(uint2*)(Y + o) = oo;
  }
}

DI void ph_merge(const Params& p, int l, char* smem) {
  const bf16_t* U = (const bf16_t*)(p.ws + R_URE);
  const int lane = my_tid() & 63, wid = my_tid() >> 6, wm = wid >> 1, wn = wid & 1, g = lane >> 4, r16 = lane & 15;
  const int mtiles = (l == 0) ? 136 : 128;
  bf16_t* ACC = (bf16_t*)(p.ws + R_ACC);
  for (int it = 0;; ++it) {
    int mtile, ntile;
    if (!next_tile(it, mtiles, 8, mtile, ntile)) break;
    uint2 accS[4][4];
#pragma unroll
    for (int mt = 0; mt < 4; ++mt)
#pragma unroll
      for (int nt = 0; nt < 4; ++nt) accS[mt][nt] = make_uint2(0u, 0u);
    for (int j = 0; j < 4; ++j) {
      uint2 pb[4][4];
      {
        f32x4 accB[4][4]; zero_acc<4>(accB);
        const size_t yoff = (j == 0) ? R_YHY : (j == 1) ? R_YSW : (j == 2) ? R_YRW : R_YDF;
        gemm_main<4, false>(accB, (const bf16_t*)(p.ws + yoff), 256, RowPlain{(long)mtile * 256}, (const bf16_t*)(p.ws + WB_BR) + ((size_t)j * 1024 + ntile * 128) * 256, 256, 256, smem);
#pragma unroll
        for (int mt = 0; mt < 4; ++mt)
#pragma unroll
          for (int nt = 0; nt < 4; ++nt) { pb[mt][nt].x = pack2(accB[mt][nt][0], accB[mt][nt][1]); pb[mt][nt].y = pack2(accB[mt][nt][2], accB[mt][nt][3]); }
      }
      f32x4 accG[4][4]; zero_acc<4>(accG);
      gemm_main<4, false>(accG, U, 1024, RowPlain{(long)mtile * 256}, (const bf16_t*)(p.ws + WB_GATE) + ((size_t)j * 1024 + ntile * 128) * 1024, 1024, 1024, smem);
#pragma unroll
      for (int mt = 0; mt < 4; ++mt)
#pragma unroll
        for (int nt = 0; nt < 4; ++nt) {
          float v0 = bflo(accS[mt][nt].x) + sigmoidf_(accG[mt][nt][0]) * bflo(pb[mt][nt].x);
          float v1 = bfhi(accS[mt][nt].x) + sigmoidf_(accG[mt][nt][1]) * bfhi(pb[mt][nt].x);
          float v2 = bflo(accS[mt][nt].y) + sigmoidf_(accG[mt][nt][2]) * bflo(pb[mt][nt].y);
          float v3 = bfhi(accS[mt][nt].y) + sigmoidf_(accG[mt][nt][3]) * bfhi(pb[mt][nt].y);
          accS[mt][nt].x = pack2(v0, v1); accS[mt][nt].y = pack2(v2, v3);
        }
    }
#pragma unroll
    for (int mt = 0; mt < 4; ++mt) {
      const int col = ntile * 128 + wn * 64 + r16 * 4;
      const size_t row = (size_t)mtile * 256 + wm * 64 + mt * 16 + g * 4;
      uint2 o;
      o.x = (accS[mt][0].x & 0xffffu) | (accS[mt][1].x << 16); o.y = (accS[mt][2].x & 0xffffu) | (accS[mt][3].x << 16);
      *(uint2*)(ACC + (row + 0) * 1024 + col) = o;
      o.x = (accS[mt][0].x >> 16) | (accS[mt][1].x & 0xffff0000u); o.y = (accS[mt][2].x >> 16) | (accS[mt][3].x & 0xffff0000u);
      *(uint2*)(ACC + (row + 1) * 1024 + col) = o;
      o.x = (accS[mt][0].y & 0xffffu) | (accS[mt][1].y << 16); o.y = (accS[mt][2].y & 0xffffu) | (accS[mt][3].y << 16);
      *(uint2*)(ACC + (row + 2) * 1024 + col) = o;
      o.x = (accS[mt][0].y >> 16) | (accS[mt][1].y & 0xffff0000u); o.y = (accS[mt][2].y >> 16) | (accS[mt][3].y & 0xffff0000u);
      *(uint2*)(ACC + (row + 3) * 1024 + col) = o;
    }
  }
}

DI void ph_resgemm(const Params& p, int l, const bf16_t* A, int K, const bf16_t* Bt, const float* hsrc_lat, const float* hsrc_ctx, int gate_off, char* smem) {
  const int lane = my_tid() & 63, wid = my_tid() >> 6, wm = wid >> 1, wn = wid & 1, g = lane >> 4, r16 = lane & 15;
  const int mtiles = (l == 0) ? 136 : 128;
  const float* mod = (const float*)(p.ws + MISC_MOD) + (size_t)l * 9 * 6144;
  float* hc = (float*)(p.ws + OFF_HC);
  for (int it = 0;; ++it) {
    int mtile, ntile;
    if (!next_tile(it, mtiles, 8, mtile, ntile)) break;
    f32x4 acc[4][4]; zero_acc<4>(acc);
    gemm_main<4, true>(acc, A, K, RowPlain{(long)mtile * 256}, Bt + (size_t)ntile * 128 * K, K, K, smem);
    const int b = mtile < 128 ? (mtile >> 4) : 8;
    const float* gt = mod + (size_t)b * 6144 + gate_off;
    const int col = ntile * 128 + wn * 64 + r16 * 4;
    const float4 gv = *(const float4*)(gt + col);
#pragma unroll
    for (int mt = 0; mt < 4; ++mt)
#pragma unroll
      for (int e = 0; e < 4; ++e) {
        const int row = mtile * 256 + wm * 64 + mt * 16 + g * 4 + e;
        const float* hs; float* hd;
        if (row < ML) { size_t o = (size_t)row * D + col; hs = hsrc_lat + o; hd = p.out + o; }
        else { size_t o = (size_t)(row - ML) * D + col; hs = hsrc_ctx + o; hd = hc + o; }
        const float4 h = *(const float4*)hs;
        float4 r;
        r.x = DN_ALPHA * h.x + gv.x * acc[mt][0][e]; r.y = DN_ALPHA * h.y + gv.y * acc[mt][1][e];
        r.z = DN_ALPHA * h.z + gv.z * acc[mt][2][e]; r.w = DN_ALPHA * h.w + gv.w * acc[mt][3][e];
        *(float4*)hd = r;
      }
  }
}

DI void ph_ffnup(const Params& p, int l, char* smem) {
  const bf16_t* U = (const bf16_t*)(p.ws + R_U);
  const bf16_t* Bt = (const bf16_t*)(p.ws + WB_UP);
  bf16_t* HID = (bf16_t*)(p.ws + R_HID);
  const float* cw = p.in[38] + (size_t)l * 3 * 5632; const float* cb = p.in[39] + (size_t)l * 5632;
  const int tid = my_tid(), lane = tid & 63, wid = tid >> 6, wm = wid >> 1, wn = wid & 1, g = lane >> 4, r16 = lane & 15;
  const int mtiles = (l == 0) ? 152 : 136;
  float* T = (float*)smem;
  for (int it = 0;; ++it) {
    int mtile, ntile;
    if (!next_tile(it, mtiles, 44, mtile, ntile)) break;
    long rowbase; int tt, len;
    if (mtile < 136) { int b = mtile / 17; tt = mtile % 17; len = SL; rowbase = (long)b * SL; }
    else { int v = mtile - 136; int b = v >> 1; tt = v & 1; len = CL; rowbase = (long)ML + b * CL; }
    f32x4 acc[4][4]; zero_acc<4>(acc);
    gemm_main<4, true>(acc, U, 1024, RowHalo{rowbase, tt * 254 - 1, len}, Bt + (size_t)ntile * 128 * 1024, 1024, 1024, smem);
#pragma unroll
    for (int mt = 0; mt < 4; ++mt)
#pragma unroll
      for (int e = 0; e < 4; ++e)
        *(float4*)(T + (wm * 64 + mt * 16 + g * 4 + e) * 132 + wn * 64 + r16 * 4) = make_float4(acc[mt][0][e], acc[mt][1][e], acc[mt][2][e], acc[mt][3][e]);
    __syncthreads();
    {
      const int ch = tid & 63, rgp = tid >> 6; const int ca = ntile * 64 + ch, cbx = 2816 + ca;
      const float a0 = cw[ca], a1 = cw[5632 + ca], a2 = cw[2 * 5632 + ca], ab = cb[ca];
      const float b0 = cw[cbx], b1 = cw[5632 + cbx], b2 = cw[2 * 5632 + cbx], bb = cb[cbx];
      for (int r = 1 + rgp; r <= 254; r += 8) {
        int tok = tt * 254 - 1 + r;
        if (tok < len) {
          float av = a0 * T[(r - 1) * 132 + ch] + a1 * T[r * 132 + ch] + a2 * T[(r + 1) * 132 + ch] + ab;
          float bv = b0 * T[(r - 1) * 132 + 64 + ch] + b1 * T[r * 132 + 64 + ch] + b2 * T[(r + 1) * 132 + 64 + ch] + bb;
          HID[(size_t)(rowbase + tok) * 2816 + ca] = (bf16_t)f2bf(siluf_(av) * bv);
        }
      }
    }
  }
}

#ifndef REP_PREP
#define REP_PREP 1
#endif
#ifndef REP_GEMM
#define REP_GEMM 1
#endif
#ifndef REP_HY
#define REP_HY 1
#endif
#ifndef REP_RWP
#define REP_RWP 1
#endif
#ifndef REP_SCAN
#define REP_SCAN 1
#endif
#ifndef REP_ATTN
#define REP_ATTN 1
#endif
#ifndef PH_END
#define PH_END 24
#endif
DI void grid_barrier(unsigned* bar, unsigned& epoch) {
  __syncthreads();
  epoch += 1;
  if (my_tid() == 0) {
    __threadfence();
    const unsigned target = epoch * gridDim.x;
    __hip_atomic_fetch_add(bar, 1u, __ATOMIC_RELAXED, __HIP_MEMORY_SCOPE_AGENT);
    while (__hip_atomic_load(bar, __ATOMIC_RELAXED, __HIP_MEMORY_SCOPE_AGENT) < target) __builtin_amdgcn_s_sleep(1);
    __threadfence();
  }
  __syncthreads();
}
#define SYNC_OR_RET(idx) do { if ((idx) + 1 >= PH_END) return; if ((idx) == 0) grid.sync(); else grid_barrier((unsigned*)(p.ws + MISC_BAR), epoch); } while (0)
template <int l>
DI void run_layer(const Params& p, cg::grid_group& grid, char* smem, unsigned& epoch) {
  const float* mod = (const float*)(p.ws + MISC_MOD) + (size_t)l * 9 * 6144;
  float* hc = (float*)(p.ws + OFF_HC);
  const float* hl_src = (l == 0) ? p.in[0] : p.out;
  const float* hc_src = (l == 0) ? p.in[2] : hc;
  constexpr int B0 = l * 12;
  if (l == 0) {
    ph_convert(p, 0, smem);
    ph_ada(p, smem);
    hy_rawfilter(p, 0, SL, (float*)(p.ws + R_RAWF), smem);
    hy_rawfilter(p, 0, CL, (float*)(p.ws + MISC_RAWC), smem);
    SYNC_OR_RET(B0 + 0);
    ph_kf(p, 0, smem);
    ph_ln(hl_src, hc_src, nullptr, nullptr, nullptr, nullptr, (bf16_t*)(p.ws + R_U), mod, 0, MT);
    SYNC_OR_RET(B0 + 1);
  }
  for (int rep = 0; rep < REP_GEMM; ++rep) ph_inproj(p, smem);
  SYNC_OR_RET(B0 + 2);
  for (int rep = 0; rep < REP_HY; ++rep) {
  if (blockIdx.x == 0 && my_tid() == 0) *(unsigned*)(p.ws + MISC_BAR + 64 + 64 * l) = 0u;
  ph_hyena(p, l, smem);
  if (l == 0) ph_hyena_ctx(p, l, smem);
  }
  ph_rope(p, smem);
  for (int rep = 0; rep < REP_RWP; ++rep) ph_rwprep(p, l, smem);
  SYNC_OR_RET(B0 + 3);
  for (int rep = 0; rep < REP_SCAN; ++rep) ph_scan(p, smem);
  for (int rep = 0; rep < REP_ATTN; ++rep) ph_attn(p, l, smem);
  SYNC_OR_RET(B0 + 4);
  ph_rwout(p, l);
  ph_ln(hl_src, hc_src, nullptr, nullptr, nullptr, nullptr, (bf16_t*)(p.ws + R_URE), mod, 0, l == 0 ? MT : ML);
  SYNC_OR_RET(B0 + 5);
  for (int rep = 0; rep < REP_GEMM; ++rep) ph_merge(p, l, smem);
  SYNC_OR_RET(B0 + 6);
  ph_resgemm(p, l, (const bf16_t*)(p.ws + R_ACC), 1024, (const bf16_t*)(p.ws + WB_OUT), hl_src, hc_src, 2048, smem);
  if (l == 0) hy_rawfilter(p, 1, SL, (float*)(p.ws + R_RAWF), smem);
  SYNC_OR_RET(B0 + 7);
  ph_ln(p.out, hc, p.out, hc, p.in[35] + (size_t)l * D, p.in[36] + (size_t)l * D, (bf16_t*)(p.ws + R_U), mod, 3072, l == 0 ? MT : ML);
  if (l == 0) ph_kf(p, 1, smem);
  SYNC_OR_RET(B0 + 8);
  for (int rep = 0; rep < REP_GEMM; ++rep) ph_ffnup(p, l, smem);
  SYNC_OR_RET(B0 + 9);
  ph_resgemm(p, l, (const bf16_t*)(p.ws + R_HID), 2816, (const bf16_t*)(p.ws + WB_DOWN), p.out, hc, 5120, smem);
  SYNC_OR_RET(B0 + 10);
  if (l == 0) {
    ph_ln(p.out, hc, p.out, hc, p.in[41], p.in[42], (bf16_t*)(p.ws + R_U), mod + 9 * 6144, 0, MT);
    ph_convert(p, 1, smem);
  } else {
    ph_ln(p.out, hc, p.out, hc, p.in[41] + (size_t)l * D, p.in[42] + (size_t)l * D, nullptr, mod, 0, ML);
  }
  SYNC_OR_RET(B0 + 11);
}

__global__ void __launch_bounds__(NTHR) mega(Params p) {
  extern __shared__ __attribute__((aligned(16))) char smem[];
  cg::grid_group grid = cg::this_grid();
  unsigned epoch = 0;
  if (blockIdx.x == 0 && my_tid() == 0) *(unsigned*)(p.ws + MISC_BAR) = 0u;
  run_layer<0>(p, grid, smem, epoch);
  if (PH_END > 12) run_layer<1>(p, grid, smem, epoch);
}

extern "C" void kernel_launch(void* const* d_in, const int* in_sizes, int n_in, void* d_out, int out_size,
                              void* d_ws, size_t ws_size, hipStream_t stream) {
  static int grid_blocks = 0;
  if (!grid_blocks) {
    int dev = 0, cus = 0, per_cu = 0;
    (void)hipGetDevice(&dev);
    (void)hipDeviceGetAttribute(&cus, hipDeviceAttributeMultiprocessorCount, dev);
    (void)hipFuncSetAttribute((const void*)mega, hipFuncAttributeMaxDynamicSharedMemorySize, SMEM_BYTES);
    (void)hipOccupancyMaxActiveBlocksPerMultiprocessor(&per_cu, mega, NTHR, SMEM_BYTES);
    if (per_cu < 1) per_cu = 1;
    if (per_cu > 1) per_cu = 1;
    grid_blocks = cus * per_cu;
  }
  Params p{};
  for (int i = 0; i < 43; ++i) p.in[i] = (const float*)d_in[i];
  p.out = (float*)d_out; p.ws = (char*)d_ws;
  void* args[] = {&p};
  hipError_t e = hipLaunchCooperativeKernel((void*)mega, dim3(grid_blocks), dim3(NTHR), args, SMEM_BYTES, stream);
  if (e != hipSuccess) fprintf(stderr, "cooperative launch failed: %s (grid %d)\n", hipGetErrorString(e), grid_blocks);
}
```

```cpp
#include <hip/hip_runtime.h>
#include <hip/hip_cooperative_groups.h>
#include <cstdio>
#include <cstdint>
namespace cg = cooperative_groups;

#define DI __device__ __forceinline__
typedef unsigned short bf16_t;
typedef short bf16x8 __attribute__((ext_vector_type(8)));
typedef float f32x4 __attribute__((ext_vector_type(4)));

constexpr int D = 1024, NB = 8, SL = 4096, CL = 256;
constexpr int ML = NB * SL, MC = NB * CL, MT = ML + MC;
constexpr int KEYS = SL + CL;
constexpr int NTHR = 512;
constexpr float DN_ALPHA = 1.41421356237f;
constexpr size_t UNIT = (size_t)MT * 512;

constexpr size_t WB_IN = 0;
constexpr size_t WB_GATE = WB_IN + (size_t)3328 * 1024 * 2;
constexpr size_t WB_BR = WB_GATE + (size_t)4096 * 1024 * 2;
constexpr size_t WB_OUT = WB_BR + (size_t)4 * 1024 * 256 * 2;
constexpr size_t WB_UP = WB_OUT + (size_t)1024 * 1024 * 2;
constexpr size_t WB_DOWN = WB_UP + (size_t)5632 * 1024 * 2;
constexpr size_t WB_END = WB_DOWN + (size_t)1024 * 2816 * 2;
constexpr size_t OFF_KF = WB_END;
constexpr size_t OFF_HC = OFF_KF + (size_t)512 * 8192 * 8;
constexpr size_t OFF_MISC = OFF_HC + (size_t)MC * D * 4;
constexpr size_t MISC_MOD = OFF_MISC;
constexpr size_t MISC_TW = MISC_MOD + (size_t)2 * 9 * 6144 * 4;
constexpr size_t MISC_RAWC = MISC_TW + 4096 * 8;
constexpr size_t MISC_GCTX = MISC_RAWC + (size_t)256 * 1024 * 4;
constexpr size_t MISC_RWW = MISC_GCTX + (size_t)512 * 512 * 4;
constexpr size_t RWW_F = MISC_RWW, RWW_B = RWW_F + 256 * 64 * 2, RWW_A = RWW_B + 256 * 64 * 2, RWW_GF = RWW_A + 256 * 64 * 2, RWW_GB = RWW_GF + 256 * 128 * 2;
constexpr size_t OFF_R = OFF_MISC + (size_t)4 * 1024 * 1024;
constexpr size_t MISC_BAR = OFF_R - 256;
constexpr size_t MISC_ZERO = OFF_R - 512;
static_assert(RWW_GB + 256 * 128 * 2 <= MISC_ZERO, "misc overflow");
constexpr size_t R_YHY = OFF_R, R_YSW = OFF_R + UNIT, R_YDF = OFF_R + 2 * UNIT;
constexpr size_t R_PHY = OFF_R + 3 * UNIT;
constexpr size_t R_PSW = OFF_R + 6 * UNIT;
constexpr size_t R_VTSW = R_PSW + (size_t)MT * 384 * 2;
constexpr size_t R_PDF = OFF_R + 8 * UNIT;
constexpr size_t R_VTDF = OFF_R + 10 * UNIT;
constexpr size_t R_PRW = OFF_R + 11 * UNIT;
constexpr size_t R_STR = R_PRW + (size_t)MT * 1216 * 2;
constexpr size_t R_G = R_STR + 7 * UNIT;
constexpr size_t R_END = R_G + 2 * UNIT;
constexpr size_t R_RAWF = OFF_R;
constexpr size_t R_OF = R_PHY, R_OB = R_PHY + UNIT;
constexpr size_t R_URE = R_PSW;
constexpr size_t R_YRW = R_VTDF;
constexpr size_t R_ACC = R_PRW;
constexpr size_t R_U = R_STR;
constexpr size_t R_HID = OFF_R;
static_assert(R_END <= (size_t)512 * 1024 * 1024, "ws overflow");
static_assert((size_t)MT * 2816 * 2 <= 11 * UNIT, "hid");

constexpr int SMEM_BYTES = 144 * 1024;

struct Params {
  const float* in[43];
  float* out;
  char* ws;
};

DI int my_tid() { int t = (int)__builtin_amdgcn_workitem_id_x(); asm volatile("" : "+v"(t)); return t; }
DI unsigned f2bf(float f) { unsigned u = __float_as_uint(f); u += 0x7fffu + ((u >> 16) & 1u); return u >> 16; }
DI float bf2f(unsigned h) { return __uint_as_float(h << 16); }
typedef __bf16 bf16v2_t __attribute__((ext_vector_type(2)));
typedef float f32v2_t __attribute__((ext_vector_type(2)));
DI unsigned pack2(float lo, float hi) { f32v2_t v = {lo, hi}; bf16v2_t b = __builtin_convertvector(v, bf16v2_t); return __builtin_bit_cast(unsigned, b); }

DI float bflo(unsigned w) { return __uint_as_float(w << 16); }
DI float bfhi(unsigned w) { return __uint_as_float(w & 0xffff0000u); }
DI float sigmoidf_(float x) { return 1.f / (1.f + __expf(-x)); }
DI float siluf_(float x) { return x / (1.f + __expf(-x)); }
DI float wave_sum(float v) {
#pragma unroll
  for (int o = 32; o >= 1; o >>= 1) v += __shfl_xor(v, o);
  return v;
}
template <int CTRL> DI float dpp_mov(float v) {
  return __int_as_float(__builtin_amdgcn_update_dpp(0, __float_as_int(v), CTRL, 0xf, 0xf, false));
}
DI float sum16(float v) {
  v += dpp_mov<0xB1>(v);
  v += dpp_mov<0x4E>(v);
  v += dpp_mov<0x141>(v);
  v += dpp_mov<0x140>(v);
  return v;
}
DI void lds_barrier() { asm volatile("s_waitcnt lgkmcnt(0)" ::: "memory"); __builtin_amdgcn_s_barrier(); asm volatile("" ::: "memory"); }
DI uint4 sel4(bool z, uint4 v) { return make_uint4(z ? 0u : v.x, z ? 0u : v.y, z ? 0u : v.z, z ? 0u : v.w); }
DI int mod_idx(int row) { return row < ML ? (row >> 12) : 8; }

template <int NTW, bool DEEP, class RowFn>
DI void gemm_main(f32x4 (&acc)[4][NTW], const bf16_t* __restrict__ A, int lda, RowFn rowfn,
                  const bf16_t* __restrict__ Bt, int ldb, int K, char* smem) {
  constexpr int BN = NTW * 32;
  constexpr int A_BYTES = 256 * 128, B_BYTES = BN * 128, STAGE = A_BYTES + B_BYTES;
  constexpr int NBL = BN / 64;
  const int tid = my_tid(), lane = tid & 63, wid = tid >> 6, wm = wid >> 1, wn = wid & 1, g = lane >> 4, r16 = lane & 15;
  const int chunk = tid & 7, lrow = tid >> 3;
  long a0 = rowfn(lrow), a1 = rowfn(lrow + 64), a2 = rowfn(lrow + 128), a3 = rowfn(lrow + 192);
  const long c0 = a0 < 0 ? 0 : a0, c1 = a1 < 0 ? 0 : a1, c2 = a2 < 0 ? 0 : a2, c3 = a3 < 0 ? 0 : a3;
  const bf16_t* Bp = Bt + (long)lrow * ldb + chunk * 8;
  const bf16_t* Ap0 = A + c0 * lda + chunk * 8; const bf16_t* Ap1 = A + c1 * lda + chunk * 8;
  const bf16_t* Ap2 = A + c2 * lda + chunk * 8; const bf16_t* Ap3 = A + c3 * lda + chunk * 8;
  struct Regs { uint4 a0, a1, a2, a3, b0, b1; };
  Regs R0, R1;
  R0.b1 = make_uint4(0, 0, 0, 0); R1.b1 = make_uint4(0, 0, 0, 0);
  auto GLOAD = [&](Regs& R, int k0) {
    R.a0 = *(const uint4*)(Ap0 + k0); R.a1 = *(const uint4*)(Ap1 + k0);
    R.a2 = *(const uint4*)(Ap2 + k0); R.a3 = *(const uint4*)(Ap3 + k0);
    R.b0 = *(const uint4*)(Bp + k0);
    if constexpr (NBL > 1) R.b1 = *(const uint4*)(Bp + (long)64 * ldb + k0);
  };
  auto SSTORE = [&](const Regs& R, int st) {
    char* base = smem + st * STAGE + lrow * 128 + ((chunk ^ (lrow & 7)) << 4);
    *(uint4*)(base) = sel4(a0 < 0, R.a0); *(uint4*)(base + 64 * 128) = sel4(a1 < 0, R.a1);
    *(uint4*)(base + 128 * 128) = sel4(a2 < 0, R.a2); *(uint4*)(base + 192 * 128) = sel4(a3 < 0, R.a3);
    *(uint4*)(base + A_BYTES) = R.b0;
    if constexpr (NBL > 1) *(uint4*)(base + A_BYTES + 64 * 128) = R.b1;
  };
  auto COMPUTE = [&](int st) {
    const char* As = smem + st * STAGE + (wm * 64 + r16) * 128;
    const char* Bs = smem + st * STAGE + A_BYTES + (wn * (NTW * 16) + r16) * 128;
#pragma unroll
    for (int kk = 0; kk < 2; ++kk) {
      const int sw = ((kk * 4 + g) ^ (r16 & 7)) << 4;
      bf16x8 af[4], bfr[NTW];
#pragma unroll
      for (int mt = 0; mt < 4; ++mt) af[mt] = *(const bf16x8*)(As + mt * 16 * 128 + sw);
#pragma unroll
      for (int nt = 0; nt < NTW; ++nt) bfr[nt] = *(const bf16x8*)(Bs + nt * 16 * 128 + sw);
#pragma unroll
      for (int mt = 0; mt < 4; ++mt)
#pragma unroll
        for (int nt = 0; nt < NTW; ++nt)
          acc[mt][nt] = __builtin_amdgcn_mfma_f32_16x16x32_bf16(af[mt], bfr[nt], acc[mt][nt], 0, 0, 0);
    }
  };
  const int nk = K >> 6;
  __syncthreads();
  GLOAD(R0, 0);
  SSTORE(R0, 0);
  if constexpr (DEEP) {
    GLOAD(R0, 64);
    if (nk > 2) GLOAD(R1, 128);
    lds_barrier();
    bf16x8 fa0[4], fb0[NTW], fa1[4], fb1[NTW];
    auto READF = [&](bf16x8 (&fa)[4], bf16x8 (&fb)[NTW], int st, int kk) {
      const int sw = ((kk * 4 + g) ^ (r16 & 7)) << 4;
      const char* As = smem + st * STAGE + (wm * 64 + r16) * 128 + sw;
      const char* Bs = smem + st * STAGE + A_BYTES + (wn * (NTW * 16) + r16) * 128 + sw;
#pragma unroll
      for (int mt = 0; mt < 4; ++mt) fa[mt] = *(const bf16x8*)(As + mt * 16 * 128);
#pragma unroll
      for (int nt = 0; nt < NTW; ++nt) fb[nt] = *(const bf16x8*)(Bs + nt * 16 * 128);
    };
    auto MMA = [&](const bf16x8 (&fa)[4], const bf16x8 (&fb)[NTW]) {
#pragma unroll
      for (int mt = 0; mt < 4; ++mt)
#pragma unroll
        for (int nt = 0; nt < NTW; ++nt)
          acc[mt][nt] = __builtin_amdgcn_mfma_f32_16x16x32_bf16(fa[mt], fb[nt], acc[mt][nt], 0, 0, 0);
    };
    READF(fa0, fb0, 0, 0);
    for (int kt = 0; kt < nk; kt += 2) {
      READF(fa1, fb1, 0, 1);
      MMA(fa0, fb0);
#pragma unroll
      for (int i = 0; i < 4 + NTW; ++i) { __builtin_amdgcn_sched_group_barrier(0x100, 1, 0); __builtin_amdgcn_sched_group_barrier(0x008, 2, 0); }
      __builtin_amdgcn_sched_barrier(0);
      SSTORE(R0, 1);
      if (kt + 3 < nk) GLOAD(R0, (kt + 3) * 64);
      MMA(fa1, fb1);
#pragma unroll
      for (int i = 0; i < 6; ++i) { __builtin_amdgcn_sched_group_barrier(0x200, 1, 0); __builtin_amdgcn_sched_group_barrier(0x020, 1, 0); __builtin_amdgcn_sched_group_barrier(0x008, 2, 0); }
      __builtin_amdgcn_sched_barrier(0);
      lds_barrier();
      READF(fa0, fb0, 1, 0);
      READF(fa1, fb1, 1, 1);
      MMA(fa0, fb0);
#pragma unroll
      for (int i = 0; i < 4 + NTW; ++i) { __builtin_amdgcn_sched_group_barrier(0x100, 1, 0); __builtin_amdgcn_sched_group_barrier(0x008, 2, 0); }
      __builtin_amdgcn_sched_barrier(0);
      if (kt + 2 < nk) SSTORE(R1, 0);
      if (kt + 4 < nk) GLOAD(R1, (kt + 4) * 64);
      MMA(fa1, fb1);
#pragma unroll
      for (int i = 0; i < 6; ++i) { __builtin_amdgcn_sched_group_barrier(0x200, 1, 0); __builtin_amdgcn_sched_group_barrier(0x020, 1, 0); __builtin_amdgcn_sched_group_barrier(0x008, 2, 0); }
      __builtin_amdgcn_sched_barrier(0);
      lds_barrier();
      if (kt + 2 < nk) READF(fa0, fb0, 0, 0);
    }
  } else {
    lds_barrier();
    for (int kt = 0; kt < nk; ++kt) {
      const int st = kt & 1;
      if (kt + 1 < nk) GLOAD(R0, (kt + 1) * 64);
      __builtin_amdgcn_sched_barrier(0);
      COMPUTE(st);
      __builtin_amdgcn_sched_barrier(0);
      if (kt + 1 < nk) SSTORE(R0, st ^ 1);
      lds_barrier();
    }
  }
}

#define GLDS16(gp, lp) __builtin_amdgcn_global_load_lds((const unsigned*)(gp), (unsigned*)(lp), 16, 0, 0)
template <class RowFn>
DI void gemm_glds(f32x4 (&acc)[4][4], const bf16_t* __restrict__ A, int lda, RowFn rowfn,
                  const bf16_t* __restrict__ Bt, int ldb, int K, char* smem, const bf16_t* zrow) {
  constexpr int A_BYTES = 256 * 128, STAGE = A_BYTES + 128 * 128;
  const int tid = my_tid(), lane = tid & 63, wid = tid >> 6, wm = wid >> 1, wn = wid & 1, g = lane >> 4, r16 = lane & 15;
  const int lrow = tid >> 3, c = (tid & 7) ^ (lrow & 7);
  const long a0 = rowfn(lrow), a1 = rowfn(lrow + 64), a2 = rowfn(lrow + 128), a3 = rowfn(lrow + 192);
  const bf16_t* pa0 = (a0 >= 0 ? A + a0 * lda : zrow) + c * 8; const int m0 = a0 >= 0 ? 1 : 0;
  const bf16_t* pa1 = (a1 >= 0 ? A + a1 * lda : zrow) + c * 8; const int m1 = a1 >= 0 ? 1 : 0;
  const bf16_t* pa2 = (a2 >= 0 ? A + a2 * lda : zrow) + c * 8; const int m2 = a2 >= 0 ? 1 : 0;
  const bf16_t* pa3 = (a3 >= 0 ? A + a3 * lda : zrow) + c * 8; const int m3 = a3 >= 0 ? 1 : 0;
  const bf16_t* pb0 = Bt + (long)lrow * ldb + c * 8; const bf16_t* pb1 = pb0 + (long)64 * ldb;
  auto ISSUE = [&](int kt, int bi) {
    char* d = smem + bi * STAGE + tid * 16;
    const int k0 = kt * 64;
    GLDS16(pa0 + k0 * m0, d); GLDS16(pa1 + k0 * m1, d + 8192); GLDS16(pa2 + k0 * m2, d + 16384); GLDS16(pa3 + k0 * m3, d + 24576);
    GLDS16(pb0 + k0, d + A_BYTES); GLDS16(pb1 + k0, d + A_BYTES + 8192);
  };
  auto COMPUTE = [&](int bi) {
    const char* As = smem + bi * STAGE + (wm * 64 + r16) * 128;
    const char* Bs = smem + bi * STAGE + A_BYTES + (wn * 64 + r16) * 128;
#pragma unroll
    for (int kk = 0; kk < 2; ++kk) {
      const int sw = ((kk * 4 + g) ^ (r16 & 7)) << 4;
      bf16x8 af[4], bfr[4];
#pragma unroll
      for (int mt = 0; mt < 4; ++mt) af[mt] = *(const bf16x8*)(As + mt * 16 * 128 + sw);
#pragma unroll
      for (int nt = 0; nt < 4; ++nt) bfr[nt] = *(const bf16x8*)(Bs + nt * 16 * 128 + sw);
#pragma unroll
      for (int mt = 0; mt < 4; ++mt)
#pragma unroll
        for (int nt = 0; nt < 4; ++nt)
          acc[mt][nt] = __builtin_amdgcn_mfma_f32_16x16x32_bf16(af[mt], bfr[nt], acc[mt][nt], 0, 0, 0);
    }
  };
  const int nk = K >> 6;
  __syncthreads();
  ISSUE(0, 0);
  ISSUE(1, 1);
  asm volatile("s_waitcnt vmcnt(6)" ::: "memory");
  __builtin_amdgcn_s_barrier();
  asm volatile("" ::: "memory");
  int bi = 0;
  for (int kt = 0; kt < nk; ++kt) {
    const int b2 = bi >= 1 ? bi - 1 : 2;
    if (kt + 2 < nk) ISSUE(kt + 2, b2);
    COMPUTE(bi);
    if (kt + 2 < nk) asm volatile("s_waitcnt vmcnt(6)" ::: "memory");
    else asm volatile("s_waitcnt vmcnt(0)" ::: "memory");
    asm volatile("s_waitcnt lgkmcnt(0)" ::: "memory");
    __builtin_amdgcn_s_barrier();
    asm volatile("" ::: "memory");
    bi = bi == 2 ? 0 : bi + 1;
  }
}

DI void gemm_glds256(f32x4 (&acc)[8][4], const bf16_t* __restrict__ A, int lda, long arow0,
                     const bf16_t* __restrict__ Bt, int ldb, int K, char* smem) {
  constexpr int A_BYTES = 256 * 128, STAGE = 2 * A_BYTES;
  const int tid = my_tid(), lane = tid & 63, wid = tid >> 6, wm = wid >> 2, wn = wid & 3, g = lane >> 4, r16 = lane & 15;
  const int lrow = tid >> 3, c = (tid & 7) ^ (lrow & 7);
  const bf16_t* pa = A + (arow0 + lrow) * (long)lda + c * 8;
  const bf16_t* pb = Bt + (long)lrow * ldb + c * 8;
  const long a64 = (long)64 * lda, b64 = (long)64 * ldb;
  auto ISSUE = [&](int kt, int bi) {
    char* d = smem + bi * STAGE + tid * 16;
    const int k0 = kt * 64;
    GLDS16(pa + k0, d); GLDS16(pa + a64 + k0, d + 8192); GLDS16(pa + 2 * a64 + k0, d + 16384); GLDS16(pa + 3 * a64 + k0, d + 24576);
    GLDS16(pb + k0, d + A_BYTES); GLDS16(pb + b64 + k0, d + A_BYTES + 8192); GLDS16(pb + 2 * b64 + k0, d + A_BYTES + 16384); GLDS16(pb + 3 * b64 + k0, d + A_BYTES + 24576);
  };
  auto COMPUTE = [&](int bi) {
    const char* As = smem + bi * STAGE + (wm * 128 + r16) * 128;
    const char* Bs = smem + bi * STAGE + A_BYTES + (wn * 64 + r16) * 128;
#pragma unroll
    for (int kk = 0; kk < 2; ++kk) {
      const int sw = ((kk * 4 + g) ^ (r16 & 7)) << 4;
      bf16x8 bfr[4];
#pragma unroll
      for (int nt = 0; nt < 4; ++nt) bfr[nt] = *(const bf16x8*)(Bs + nt * 16 * 128 + sw);
#pragma unroll
      for (int mt = 0; mt < 8; ++mt) {
        const bf16x8 af = *(const bf16x8*)(As + mt * 16 * 128 + sw);
#pragma unroll
        for (int nt = 0; nt < 4; ++nt)
          acc[mt][nt] = __builtin_amdgcn_mfma_f32_16x16x32_bf16(af, bfr[nt], acc[mt][nt], 0, 0, 0);
      }
    }
  };
  const int nk = K >> 6;
  __syncthreads();
  ISSUE(0, 0);
  asm volatile("s_waitcnt vmcnt(0)" ::: "memory");
  __builtin_amdgcn_s_barrier();
  asm volatile("" ::: "memory");
  int bi = 0;
  for (int kt = 0; kt < nk; ++kt) {
    if (kt + 1 < nk) ISSUE(kt + 1, bi ^ 1);
    COMPUTE(bi);
    asm volatile("s_waitcnt vmcnt(0)" ::: "memory");
    asm volatile("s_waitcnt lgkmcnt(0)" ::: "memory");
    __builtin_amdgcn_s_barrier();
    asm volatile("" ::: "memory");
    bi ^= 1;
  }
}
DI void zero_acc256(f32x4 (&acc)[8][4]) {
#pragma unroll
  for (int i = 0; i < 8; ++i)
#pragma unroll
    for (int j = 0; j < 4; ++j) acc[i][j] = (f32x4){0.f, 0.f, 0.f, 0.f};
}

DI bool next_tile(int i, int MTILES, int NTILES, int& mt, int& nt) {
  const int xcd = blockIdx.x & 7, slot = blockIdx.x >> 3, nslot = gridDim.x >> 3;
  const int m_lo = (MTILES * xcd) >> 3, m_hi = (MTILES * (xcd + 1)) >> 3, Mloc = m_hi - m_lo;
  const int q = i * nslot + slot;
  if (q >= Mloc * NTILES) return false;
  const int gidx = q / (4 * NTILES), m0 = gidx * 4;
  const int rows = (Mloc - m0) < 4 ? (Mloc - m0) : 4;
  const int within = q - gidx * 4 * NTILES;
  nt = within / rows; mt = m_lo + m0 + within % rows;
  return true;
}

struct RowPlain { long base; DI long operator()(int r) const { return base + r; } };
struct RowHalo { long rowbase; int t0; int len; DI long operator()(int r) const { int t = t0 + r; return (t >= 0 && t < len) ? rowbase + t : -1; } };

template <int NTW> DI void zero_acc(f32x4 (&acc)[4][NTW]) {
#pragma unroll
  for (int i = 0; i < 4; ++i)
#pragma unroll
    for (int j = 0; j < NTW; ++j) acc[i][j] = (f32x4){0.f, 0.f, 0.f, 0.f};
}

DI void cvt_unit(const float* __restrict__ src, int ldsrc, int srccol0, int k0, bf16_t* __restrict__ dst, int K, int n0, char* smem, bool perm = true) {
  float* T = (float*)smem;
  const int tid = my_tid();
  __syncthreads();
  if (srccol0 >= 0) {
#pragma unroll
    for (int i = 0; i < 8; ++i) {
      int idx = tid + i * 512; int k = idx >> 6, n = idx & 63;
      T[k * 65 + n] = src[(long)(k0 + k) * ldsrc + srccol0 + n];
    }
  }
  __syncthreads();
  int nd = tid >> 3, kc = (tid & 7) * 8; int n = perm ? ((nd & 15) * 4 + (nd >> 4)) : nd;
  uint4 o = make_uint4(0, 0, 0, 0);
  if (srccol0 >= 0) {
    o.x = pack2(T[(kc + 0) * 65 + n], T[(kc + 1) * 65 + n]);
    o.y = pack2(T[(kc + 2) * 65 + n], T[(kc + 3) * 65 + n]);
    o.z = pack2(T[(kc + 4) * 65 + n], T[(kc + 5) * 65 + n]);
    o.w = pack2(T[(kc + 6) * 65 + n], T[(kc + 7) * 65 + n]);
  }
  *(uint4*)(dst + (long)(n0 + nd) * K + k0 + kc) = o;
}

DI void ph_convert(const Params& p, int l, char* smem) {
  for (int u = blockIdx.x; u < 4508; u += gridDim.x) {
    if (u < 832) {
      int gI = u >> 4, kt = u & 15; int n0 = gI * 64; int sc;
      if (n0 < 1280) sc = n0; else if (n0 < 2048) sc = 2496 + (n0 - 1280); else if (n0 < 3264) sc = 1280 + (n0 - 2048); else sc = -1;
      cvt_unit(p.in[6] + (size_t)l * 1024 * 7360, 7360, sc, kt * 64, (bf16_t*)(p.ws + WB_IN), 1024, n0, smem);
    } else if (u < 1856) {
      int v = u - 832; int gI = v >> 4, kt = v & 15;
      cvt_unit(p.in[6] + (size_t)l * 1024 * 7360, 7360, 3264 + gI * 64, kt * 64, (bf16_t*)(p.ws + WB_GATE), 1024, gI * 64, smem);
    } else if (u < 2112) {
      int v = u - 1856; int gI = v >> 2, kt = v & 3; int j = gI >> 4, gg = gI & 15;
      cvt_unit(p.in[33] + ((size_t)l * 4 + j) * 256 * 1024, 1024, gg * 64, kt * 64, (bf16_t*)(p.ws + WB_BR) + (size_t)j * 1024 * 256, 256, gg * 64, smem);
    } else if (u < 2368) {
      int v = u - 2112; int gI = v >> 4, kt = v & 15;
      cvt_unit(p.in[34] + (size_t)l * 1024 * 1024, 1024, gI * 64, kt * 64, (bf16_t*)(p.ws + WB_OUT), 1024, gI * 64, smem);
    } else if (u < 3776) {
      int v = u - 2368; int gI = v >> 4, kt = v & 15; int nt = gI >> 2, q = gI & 3;
      cvt_unit(p.in[37] + (size_t)l * 1024 * 5632, 5632, (q >> 1) * 2816 + nt * 128 + (q & 1) * 64, kt * 64, (bf16_t*)(p.ws + WB_UP), 1024, gI * 64, smem);
    } else if (u < 4480) {
      int v = u - 3776; int gI = v / 44, kt = v % 44;
      cvt_unit(p.in[40] + (size_t)l * 2816 * 1024, 1024, gI * 64, kt * 64, (bf16_t*)(p.ws + WB_DOWN), 2816, gI * 64, smem);
    } else {
      int v = u - 4480;
      if (v < 4) cvt_unit(p.in[19] + (size_t)l * 2 * 64 * 256, 256, v * 64, 0, (bf16_t*)(p.ws + RWW_F), 64, v * 64, smem, false);
      else if (v < 8) cvt_unit(p.in[19] + (size_t)l * 2 * 64 * 256 + 64 * 256, 256, (v - 4) * 64, 0, (bf16_t*)(p.ws + RWW_B), 64, (v - 4) * 64, smem, false);
      else if (v < 12) cvt_unit(p.in[21] + (size_t)l * 64 * 256, 256, (v - 8) * 64, 0, (bf16_t*)(p.ws + RWW_A), 64, (v - 8) * 64, smem, false);
      else if (v < 20) { int w = v - 12; cvt_unit(p.in[22] + (size_t)l * 2 * 128 * 256, 256, (w >> 1) * 64, (w & 1) * 64, (bf16_t*)(p.ws + RWW_GF), 128, (w >> 1) * 64, smem, false); }
      else { int w = v - 20; cvt_unit(p.in[22] + (size_t)l * 2 * 128 * 256 + 128 * 256, 256, (w >> 1) * 64, (w & 1) * 64, (bf16_t*)(p.ws + RWW_GB), 128, (w >> 1) * 64, smem, false); }
    }
  }
}

DI void ph_ada(const Params& p, char* smem) {
  float* S = (float*)smem;
  float* R = S + 9 * 1024;
  const int tid = my_tid();
  bool loaded = false;
  for (int u = blockIdx.x; u < 192; u += gridDim.x) {
    if (!loaded) {
      __syncthreads();
      for (int i = tid; i < 9 * 1024; i += NTHR) { float c = i < 8192 ? p.in[1][i] : p.in[3][i - 8192]; S[i] = siluf_(c); }
      loaded = true;
    }
    __syncthreads();
    int l = u / 96, n0 = (u % 96) * 64;
    int col = tid & 63, ks = tid >> 6;
    const float* W = p.in[4] + (size_t)l * 1024 * 6144 + n0 + col;
    float a[9];
#pragma unroll
    for (int b = 0; b < 9; ++b) a[b] = 0.f;
    for (int k = ks * 128; k < ks * 128 + 128; ++k) {
      float w = W[(size_t)k * 6144];
#pragma unroll
      for (int b = 0; b < 9; ++b) a[b] += S[b * 1024 + k] * w;
    }
#pragma unroll
    for (int b = 0; b < 9; ++b) R[(ks * 9 + b) * 64 + col] = a[b];
    __syncthreads();
    for (int i = tid; i < 9 * 64; i += NTHR) {
      int b = i >> 6, c = i & 63; float s = 0.f;
#pragma unroll
      for (int k2 = 0; k2 < 8; ++k2) s += R[(k2 * 9 + b) * 64 + c];
      s += p.in[5][(size_t)l * 6144 + n0 + c];
      ((float*)(p.ws + MISC_MOD))[((size_t)l * 9 + b) * 6144 + n0 + c] = s;
    }
  }
  for (int i = blockIdx.x * NTHR + tid; i < 4096; i += gridDim.x * NTHR) {
    float s, c; sincospif(-(float)i / 4096.f, &s, &c);
    ((float2*)(p.ws + MISC_TW))[i] = make_float2(c, s);
  }
}

DI void hy_rawfilter(const Params& p, int l, int Lf, float* __restrict__ dst, char* smem) {
  float* W1 = (float*)smem;
  float* W2 = W1 + 33 * 64;
  float* Z = W2 + 64 * 64;
  float* H1 = Z + 16 * 36;
  float* H2 = H1 + 16 * 64;
  const int tid = my_tid();
  const float* w1 = p.in[9] + (size_t)l * 33 * 64; const float* b1 = p.in[10] + l * 64;
  const float* w2 = p.in[11] + (size_t)l * 64 * 64; const float* b2 = p.in[12] + l * 64;
  const float* w3 = p.in[13] + (size_t)l * 64 * 1024; const float* fr = p.in[14] + l * 64;
  const int nunits = Lf / 16;
  bool loaded = false;
  for (int u = blockIdx.x; u < nunits; u += gridDim.x) {
    __syncthreads();
    if (!loaded) {
      for (int i = tid; i < 33 * 64; i += NTHR) W1[i] = w1[i];
      for (int i = tid; i < 64 * 64; i += NTHR) W2[i] = w2[i];
      loaded = true;
    }
    const int t0 = u * 16;
    for (int i = tid; i < 16 * 33; i += NTHR) {
      int tt = i / 33, f = i % 33; int t = t0 + tt; float v;
      if (f == 0) v = (float)t / (float)(Lf - 1);
      else {
        int bi = (f - 1) & 15;
        float wv = 6.283185307179586f * (float)t / (float)Lf;
        float fb = 1e-4f + (15.f - 1e-4f) * (float)bi / 15.f;
        float ang = wv * fb;
        v = (f <= 16) ? cosf(ang) : -sinf(ang);
      }
      Z[tt * 36 + f] = v;
    }
    __syncthreads();
    for (int i = tid; i < 16 * 64; i += NTHR) {
      int tt = i >> 6, f = i & 63; float s = b1[f];
      for (int k = 0; k < 33; ++k) s += Z[tt * 36 + k] * W1[k * 64 + f];
      H1[tt * 64 + f] = sinf(fr[f] * s);
    }
    __syncthreads();
    for (int i = tid; i < 16 * 64; i += NTHR) {
      int tt = i >> 6, f = i & 63; float s = b2[f];
      for (int k = 0; k < 64; ++k) s += H1[tt * 64 + k] * W2[k * 64 + f];
      H2[tt * 64 + f] = sinf(fr[f] * s);
    }
    __syncthreads();
    float a0[16], a1[16];
#pragma unroll
    for (int i = 0; i < 16; ++i) { a0[i] = 0.f; a1[i] = 0.f; }
    for (int k = 0; k < 64; ++k) {
      float wa = w3[k * 1024 + tid], wb = w3[k * 1024 + 512 + tid];
#pragma unroll
      for (int i = 0; i < 16; ++i) { float h = H2[i * 64 + k]; a0[i] += h * wa; a1[i] += h * wb; }
    }
    {
      int w = tid & 255;
      float delta = fabsf(-3.0701134573253944f + (-15.350567286626972f + 3.0701134573253944f) * (float)w / 255.f);
#pragma unroll
      for (int i = 0; i < 16; ++i) {
        float tn = (float)(t0 + i) / (float)(Lf - 1);
        float dec = expf(-tn * delta);
        dst[(size_t)(t0 + i) * 1024 + tid] = a0[i] * dec;
        dst[(size_t)(t0 + i) * 1024 + 512 + tid] = a1[i] * dec;
      }
    }
  }
}

DI float2 cmul(float2 a, float2 b) { return make_float2(a.x * b.x - a.y * b.y, a.x * b.y + a.y * b.x); }
DI float2 cmulc(float2 a, float2 b) { return make_float2(a.x * b.x + a.y * b.y, a.y * b.x - a.x * b.y); }
DI void fft_dif(float2* X, const float2* W) {
  const int tid = my_tid();
  for (int ls = 12; ls >= 0; --ls) {
    const int span = 1 << ls;
    __syncthreads();
#pragma unroll
    for (int i = 0; i < 8; ++i) {
      int bf = tid + i * 512; int pos = bf & (span - 1); int i0 = ((bf >> ls) << (ls + 1)) + pos; int i1 = i0 + span;
      float2 a = X[i0], b = X[i1]; float2 w = W[span - 1 + pos];
      X[i0] = make_float2(a.x + b.x, a.y + b.y);
      X[i1] = cmul(make_float2(a.x - b.x, a.y - b.y), w);
    }
  }
  __syncthreads();
}
DI void fft_dit_inv(float2* X, const float2* W) {
  const int tid = my_tid();
  for (int ls = 0; ls <= 12; ++ls) {
    const int span = 1 << ls;
    __syncthreads();
#pragma unroll
    for (int i = 0; i < 8; ++i) {
      int bf = tid + i * 512; int pos = bf & (span - 1); int i0 = ((bf >> ls) << (ls + 1)) + pos; int i1 = i0 + span;
      float2 a = X[i0], b = X[i1]; float2 w = W[span - 1 + pos];
      float2 t = cmulc(b, w);
      X[i0] = make_float2(a.x + t.x, a.y + t.y);
      X[i1] = make_float2(a.x - t.x, a.y - t.y);
    }
  }
  __syncthreads();
}
DI void load_twiddles(const Params& p, float2* W) {
  const float2* tw = (const float2*)(p.ws + MISC_TW);
  for (int i = my_tid(); i < 8191; i += NTHR) {
    const int ls = 31 - __clz(i + 1); const int pos = i + 1 - (1 << ls);
    W[i] = tw[pos << (12 - ls)];
  }
}

DI void ph_kf(const Params& p, int l, char* smem) {
  float2* X = (float2*)smem; float2* W = X + 8192; float* red = (float*)(W + 8192);
  const int tid = my_tid(), lane = tid & 63, wid = tid >> 6;
  const float* rawf = (const float*)(p.ws + R_RAWF);
  float2* kf = (float2*)(p.ws + OFF_KF);
  bool tw = false;
  for (int u = blockIdx.x; u < 256; u += gridDim.x) {
    if (!tw) { load_twiddles(p, W); tw = true; }
    const int o = u >> 7, c = (u & 127) * 2;
    float2 fw[8], bw[8]; float sa = 0.f, sb = 0.f;
#pragma unroll
    for (int i = 0; i < 8; ++i) {
      int t = tid + i * 512;
      fw[i] = *(const float2*)(rawf + (size_t)t * 1024 + o * 512 + c);
      bw[i] = *(const float2*)(rawf + (size_t)t * 1024 + o * 512 + 256 + c);
      sa += fabsf(fw[i].x) + fabsf(bw[i].x); sb += fabsf(fw[i].y) + fabsf(bw[i].y);
    }
    sa = wave_sum(sa); sb = wave_sum(sb);
    __syncthreads();
    if (lane == 0) { red[wid * 2] = sa; red[wid * 2 + 1] = sb; }
    __syncthreads();
    float ta = 0.f, tb = 0.f;
#pragma unroll
    for (int w = 0; w < 8; ++w) { ta += red[w * 2]; tb += red[w * 2 + 1]; }
    const float ia = 1.f / ta, ib = 1.f / tb;
#pragma unroll
    for (int i = 0; i < 8; ++i) {
      int t = tid + i * 512;
      X[t] = make_float2(fw[i].x * ia, fw[i].y * ib);
      if (t >= 1) X[8192 - t] = make_float2(bw[i].x * ia, bw[i].y * ib);
      else X[4096] = make_float2(0.f, 0.f);
    }
    fft_dif(X, W);
    float2* ka = kf + (size_t)(o * 256 + c) * 8192; float2* kb = ka + 8192;
#pragma unroll 4
    for (int i = 0; i < 16; ++i) {
      int pidx = tid + i * 512;
      int k = (int)(__brev((unsigned)pidx) >> 19);
      int k2 = (8192 - k) & 8191;
      int p2 = (int)(__brev((unsigned)k2) >> 19);
      float2 c1 = X[pidx], c2 = X[p2];
      float2 A = make_float2(0.5f * (c1.x + c2.x), 0.5f * (c1.y - c2.y));
      float2 Bv = make_float2(0.5f * (c1.y + c2.y), -0.5f * (c1.x - c2.x));
      ka[pidx] = A; kb[pidx] = Bv;
    }
    __syncthreads();
  }
  if (l == 0) {
    const float* rawc = (const float*)(p.ws + MISC_RAWC);
    float* G = (float*)(p.ws + MISC_GCTX);
    for (int u = blockIdx.x * 8 + wid; u < 512; u += gridDim.x * 8) {
      int o = u >> 8, c = u & 255; float f[4], b[4]; float s = 0.f;
#pragma unroll
      for (int i = 0; i < 4; ++i) {
        int t = lane + i * 64;
        f[i] = rawc[(size_t)t * 1024 + o * 512 + c]; b[i] = rawc[(size_t)t * 1024 + o * 512 + 256 + c];
        s += fabsf(f[i]) + fabsf(b[i]);
      }
      s = wave_sum(s); float inv = 1.f / s;
#pragma unroll
      for (int i = 0; i < 4; ++i) {
        int t = lane + i * 64;
        G[(size_t)u * 512 + 256 + t] = f[i] * inv;
        if (t >= 1) G[(size_t)u * 512 + 256 - t] = b[i] * inv;
      }
      if (lane == 0) G[(size_t)u * 512] = 0.f;
    }
  }
}

DI void ph_ln(const float* __restrict__ src_lat, const float* __restrict__ src_ctx, float* dst_lat, float* dst_ctx,
              const float* __restrict__ ag, const float* __restrict__ ab, bf16_t* U, const float* __restrict__ mod, int sh_off, int nrows) {
  const int lane = my_tid() & 63, wid = my_tid() >> 6;
  for (int row = blockIdx.x * 8 + wid; row < nrows; row += gridDim.x * 8) {
    const float* src = row < ML ? src_lat + (size_t)row * D : src_ctx + (size_t)(row - ML) * D;
    float4 v[4];
#pragma unroll
    for (int i = 0; i < 4; ++i) v[i] = *(const float4*)(src + i * 256 + lane * 4);
    float s = 0.f;
#pragma unroll
    for (int i = 0; i < 4; ++i) s += v[i].x + v[i].y + v[i].z + v[i].w;
    float mu = wave_sum(s) * (1.f / 1024.f);
    float q = 0.f;
#pragma unroll
    for (int i = 0; i < 4; ++i) { v[i].x -= mu; v[i].y -= mu; v[i].z -= mu; v[i].w -= mu; q += v[i].x * v[i].x + v[i].y * v[i].y + v[i].z * v[i].z + v[i].w * v[i].w; }
    float rs = rsqrtf(wave_sum(q) * (1.f / 1024.f) + 1e-6f);
#pragma unroll
    for (int i = 0; i < 4; ++i) { v[i].x *= rs; v[i].y *= rs; v[i].z *= rs; v[i].w *= rs; }
    if (ag) {
      float* dst = row < ML ? dst_lat + (size_t)row * D : dst_ctx + (size_t)(row - ML) * D;
#pragma unroll
      for (int i = 0; i < 4; ++i) {
        float4 gg = *(const float4*)(ag + i * 256 + lane * 4), bb = *(const float4*)(ab + i * 256 + lane * 4);
        v[i].x = v[i].x * gg.x + bb.x; v[i].y = v[i].y * gg.y + bb.y; v[i].z = v[i].z * gg.z + bb.z; v[i].w = v[i].w * gg.w + bb.w;
        *(float4*)(dst + i * 256 + lane * 4) = v[i];
      }
      if (U) {
        s = 0.f;
#pragma unroll
        for (int i = 0; i < 4; ++i) s += v[i].x + v[i].y + v[i].z + v[i].w;
        mu = wave_sum(s) * (1.f / 1024.f); q = 0.f;
#pragma unroll
        for (int i = 0; i < 4; ++i) { v[i].x -= mu; v[i].y -= mu; v[i].z -= mu; v[i].w -= mu; q += v[i].x * v[i].x + v[i].y * v[i].y + v[i].z * v[i].z + v[i].w * v[i].w; }
        rs = rsqrtf(wave_sum(q) * (1.f / 1024.f) + 1e-6f);
#pragma unroll
        for (int i = 0; i < 4; ++i) { v[i].x *= rs; v[i].y *= rs; v[i].z *= rs; v[i].w *= rs; }
      }
    }
    if (U) {
      const float* m = mod + (size_t)mod_idx(row) * 6144 + sh_off;
#pragma unroll
      for (int i = 0; i < 4; ++i) {
        float4 sh = *(const float4*)(m + i * 256 + lane * 4), sc = *(const float4*)(m + 1024 + i * 256 + lane * 4);
        uint2 o; o.x = pack2(v[i].x * (1.f + sc.x) + sh.x, v[i].y * (1.f + sc.y) + sh.y);
        o.y = pack2(v[i].z * (1.f + sc.z) + sh.z, v[i].w * (1.f + sc.w) + sh.w);
        *(uint2*)(U + (size_t)row * D + i * 256 + lane * 4) = o;
      }
    }
  }
}

DI void ph_inproj(const Params& p, char* smem) {
  const bf16_t* U = (const bf16_t*)(p.ws + R_U);
  const bf16_t* Bt = (const bf16_t*)(p.ws + WB_IN);
  const int lane = my_tid() & 63, wid = my_tid() >> 6, wm = wid >> 2, wn = wid & 3, g = lane >> 4, r16 = lane & 15;
  for (int it = 0;; ++it) {
    int mtile, ntile;
    if (!next_tile(it, 136, 13, mtile, ntile)) break;
    f32x4 acc[8][4]; zero_acc256(acc);
    gemm_glds256(acc, U, 1024, (long)mtile * 256, Bt + (size_t)ntile * 256 * 1024, 1024, 1024, smem);
    int b, key0;
    if (mtile < 128) { b = mtile >> 4; key0 = (mtile & 15) * 256; } else { b = mtile - 128; key0 = SL; }
    const int wc0 = ntile * 256 + wn * 64;
    bf16_t* tbase = nullptr; int tcols = 0, tcol0 = 0;
    if (wc0 < 768) { tbase = (bf16_t*)(p.ws + R_PHY); tcols = 768; tcol0 = wc0; }
    else if (wc0 >= 1152 && wc0 < 1280) { tbase = (bf16_t*)(p.ws + R_VTSW); tcols = 128; tcol0 = wc0 - 1152; }
    else if (wc0 >= 1792 && wc0 < 2048) { tbase = (bf16_t*)(p.ws + R_VTDF); tcols = 256; tcol0 = wc0 - 1792; }
    if (tbase) {
#pragma unroll
      for (int mt = 0; mt < 8; ++mt)
#pragma unroll
        for (int nt = 0; nt < 4; ++nt) {
          int col = tcol0 + r16 * 4 + nt;
          int key = key0 + wm * 128 + mt * 16 + g * 4;
          uint2 o; o.x = pack2(acc[mt][nt][0], acc[mt][nt][1]); o.y = pack2(acc[mt][nt][2], acc[mt][nt][3]);
          *(uint2*)(tbase + ((size_t)b * tcols + col) * KEYS + key) = o;
        }
    } else if (wc0 < 3264) {
      bf16_t* rb; int ld, c0;
      if (wc0 < 1152) { rb = (bf16_t*)(p.ws + R_PSW); ld = 384; c0 = wc0 - 768; }
      else if (wc0 < 1792) { rb = (bf16_t*)(p.ws + R_PDF); ld = 512; c0 = wc0 - 1280; }
      else { rb = (bf16_t*)(p.ws + R_PRW); ld = 1216; c0 = wc0 - 2048; }
      const int col = c0 + r16 * 4;
#pragma unroll
      for (int mt = 0; mt < 8; ++mt)
#pragma unroll
        for (int j = 0; j < 4; ++j) {
          size_t row = (size_t)mtile * 256 + wm * 128 + mt * 16 + g * 4 + j;
          uint2 o; o.x = pack2(acc[mt][0][j], acc[mt][1][j]); o.y = pack2(acc[mt][2][j], acc[mt][3][j]);
          *(uint2*)(rb + row * ld + col) = o;
        }
    }
  }
}

DI float hy_conv3(const bf16_t* __restrict__ P, int t, int len, float w0, float w1, float w2, float bias) {
  float a = t >= 1 ? bf2f(P[t - 1]) : 0.f, b = bf2f(P[t]), c = (t + 1 < len) ? bf2f(P[t + 1]) : 0.f;
  return w0 * a + w1 * b + w2 * c + bias;
}
DI void ph_hyena(const Params& p, int l, char* smem) {
  float2* X = (float2*)smem; float2* W = X + 8192;
  const int tid = my_tid();
  const bf16_t* PT = (const bf16_t*)(p.ws + R_PHY);
  const float2* kf = (const float2*)(p.ws + OFF_KF);
  const float* cw = p.in[7] + (size_t)l * 3 * 768; const float* cb = p.in[8] + (size_t)l * 768;
  const float* hb = p.in[15] + (size_t)l * 512;
  bf16_t* Y = (bf16_t*)(p.ws + R_YHY);
  bool tw = false;
  for (int u = blockIdx.x; u < 1024; u += gridDim.x) {
    if (!tw) { load_twiddles(p, W); tw = true; }
    const int bp = u >> 8, c = u & 255; const int b0 = bp * 2, b1 = b0 + 1;
    const bf16_t* P0 = PT + ((size_t)b0 * 768) * KEYS; const bf16_t* P1 = PT + ((size_t)b1 * 768) * KEYS;
    float wv0 = cw[c], wv1 = cw[768 + c], wv2 = cw[1536 + c], bv = cb[c];
    float wa0 = cw[256 + c], wa1 = cw[768 + 256 + c], wa2 = cw[1536 + 256 + c], ba = cb[256 + c];
    float wb0 = cw[512 + c], wb1 = cw[768 + 512 + c], wb2 = cw[1536 + 512 + c], bb = cb[512 + c];
    const float bias0 = hb[c], bias1 = hb[256 + c];
    float2 vv[8];
    __syncthreads();
#pragma unroll
    for (int i = 0; i < 8; ++i) {
      int t = tid + i * 512;
      vv[i].x = hy_conv3(P0 + (size_t)c * KEYS, t, SL, wv0, wv1, wv2, bv);
      vv[i].y = hy_conv3(P1 + (size_t)c * KEYS, t, SL, wv0, wv1, wv2, bv);
      X[t] = vv[i]; X[t + 4096] = make_float2(0.f, 0.f);
    }
    fft_dif(X, W);
    {
      const float2* H = kf + (size_t)c * 8192;
#pragma unroll 4
      for (int i = 0; i < 16; ++i) { int q = tid + i * 512; X[q] = cmul(X[q], H[q]); }
    }
    fft_dit_inv(X, W);
    float2 zz[8];
#pragma unroll
    for (int i = 0; i < 8; ++i) {
      int t = tid + i * 512;
      float2 y = X[t];
      float x1a = hy_conv3(P0 + (size_t)(256 + c) * KEYS, t, SL, wa0, wa1, wa2, ba);
      float x1b = hy_conv3(P1 + (size_t)(256 + c) * KEYS, t, SL, wa0, wa1, wa2, ba);
      zz[i].x = x1a * (y.x * (1.f / 8192.f) + bias0 * vv[i].x);
      zz[i].y = x1b * (y.y * (1.f / 8192.f) + bias0 * vv[i].y);
    }
    __syncthreads();
#pragma unroll
    for (int i = 0; i < 8; ++i) { int t = tid + i * 512; X[t] = zz[i]; X[t + 4096] = make_float2(0.f, 0.f); }
    fft_dif(X, W);
    {
      const float2* H = kf + (size_t)(256 + c) * 8192;
#pragma unroll 4
      for (int i = 0; i < 16; ++i) { int q = tid + i * 512; X[q] = cmul(X[q], H[q]); }
    }
    fft_dit_inv(X, W);
#pragma unroll
    for (int i = 0; i < 8; ++i) {
      int t = tid + i * 512;
      float2 y = X[t];
      float x2a = hy_conv3(P0 + (size_t)(512 + c) * KEYS, t, SL, wb0, wb1, wb2, bb);
      float x2b = hy_conv3(P1 + (size_t)(512 + c) * KEYS, t, SL, wb0, wb1, wb2, bb);
      float oa = x2a * (y.x * (1.f / 8192.f) + bias1 * zz[i].x);
      float ob = x2b * (y.y * (1.f / 8192.f) + bias1 * zz[i].y);
      Y[((size_t)b0 * SL + t) * 256 + c] = (bf16_t)f2bf(oa);
      Y[((size_t)b1 * SL + t) * 256 + c] = (bf16_t)f2bf(ob);
    }
  }
}

DI void ph_hyena_ctx(const Params& p, int l, char* smem) {
  const int tid = my_tid(), lane = tid & 63, wid = tid >> 6;
  float* Zb = (float*)smem + wid * 1024;
  float* Gb = Zb + 256;
  const bf16_t* PT = (const bf16_t*)(p.ws + R_PHY);
  const float* G = (const float*)(p.ws + MISC_GCTX);
  const float* cw = p.in[7] + (size_t)l * 3 * 768; const float* cb = p.in[8] + (size_t)l * 768;
  const float* hb = p.in[15] + (size_t)l * 512;
  bf16_t* Y = (bf16_t*)(p.ws + R_YHY);
  for (int base = blockIdx.x * 8; base < 2048; base += gridDim.x * 8) {
    const int u = base + wid; const int b = u >> 8, c = u & 255;
    const bf16_t* Pb = PT + ((size_t)b * 768) * KEYS + SL;
    float v[4], x1[4], x2[4], zz[4];
#pragma unroll
    for (int i = 0; i < 4; ++i) {
      int t = lane + i * 64;
      v[i] = hy_conv3(Pb + (size_t)c * KEYS, t, CL, cw[c], cw[768 + c], cw[1536 + c], cb[c]);
      x1[i] = hy_conv3(Pb + (size_t)(256 + c) * KEYS, t, CL, cw[256 + c], cw[768 + 256 + c], cw[1536 + 256 + c], cb[256 + c]);
      x2[i] = hy_conv3(Pb + (size_t)(512 + c) * KEYS, t, CL, cw[512 + c], cw[768 + 512 + c], cw[1536 + 512 + c], cb[512 + c]);
    }
    __syncthreads();
#pragma unroll
    for (int i = 0; i < 4; ++i) Zb[lane + i * 64] = v[i];
    for (int i = lane; i < 512; i += 64) Gb[i] = G[(size_t)c * 512 + i];
    __syncthreads();
#pragma unroll
    for (int i = 0; i < 4; ++i) {
      int t = lane + i * 64; float s = 0.f;
      for (int s2 = 0; s2 < 256; ++s2) s += Gb[256 + t - s2] * Zb[s2];
      zz[i] = x1[i] * (s + hb[c] * v[i]);
    }
    __syncthreads();
#pragma unroll
    for (int i = 0; i < 4; ++i) Zb[lane + i * 64] = zz[i];
    for (int i = lane; i < 512; i += 64) Gb[i] = G[(size_t)(256 + c) * 512 + i];
    __syncthreads();
#pragma unroll
    for (int i = 0; i < 4; ++i) {
      int t = lane + i * 64; float s = 0.f;
      for (int s2 = 0; s2 < 256; ++s2) s += Gb[256 + t - s2] * Zb[s2];
      float o = x2[i] * (s + hb[256 + c] * zz[i]);
      Y[((size_t)ML + b * CL + t) * 256 + c] = (bf16_t)f2bf(o);
    }
  }
}

DI void ph_rope(const Params& p, char* smem) {
  float2* T16 = (float2*)smem;
  float2* T8 = T16 + 64 * 16;
  const int tid = my_tid(), lane = tid & 63, wid = tid >> 6;
  __syncthreads();
  for (int i = tid; i < 64 * 16; i += NTHR) {
    int pos = i >> 4, f = i & 15; float inv = powf(10000.f, -(float)f / 16.f); float s, c; sincosf((float)pos * inv, &s, &c);
    T16[i] = make_float2(c, s);
  }
  for (int i = tid; i < 64 * 8; i += NTHR) {
    int pos = i >> 3, f = i & 7; float inv = powf(10000.f, -(float)f / 8.f); float s, c; sincosf((float)pos * inv, &s, &c);
    T8[i] = make_float2(c, s);
  }
  __syncthreads();
  bf16_t* Psw = (bf16_t*)(p.ws + R_PSW); bf16_t* Pdf = (bf16_t*)(p.ws + R_PDF);
  for (int row = blockIdx.x * 8 + wid; row < ML; row += gridDim.x * 8) {
    const int t = row & (SL - 1); const int pr = t >> 6, pc = t & 63;
    bf16_t* q = Psw + (size_t)row * 384;
#pragma unroll
    for (int i = 0; i < 3; ++i) {
      int pi = lane + i * 64; int hd = pi >> 5, pp = pi & 31; int half = pp >> 4, f = pp & 15;
      int base = hd * 64 + half * 32; float2 cs = T16[(half ? pc : pr) * 16 + f];
      float x1 = bf2f(q[base + f]), x2 = bf2f(q[base + 16 + f]);
      q[base + f] = (bf16_t)f2bf(x1 * cs.x - x2 * cs.y); q[base + 16 + f] = (bf16_t)f2bf(x1 * cs.y + x2 * cs.x);
    }
    bf16_t* d = Pdf + (size_t)row * 512;
#pragma unroll
    for (int i = 0; i < 4; ++i) {
      int pi = lane + i * 64; int gi = pi >> 4, pp = pi & 15; int half = pp >> 3, f = pp & 7;
      int base = gi * 32 + half * 16; float2 cs = T8[(half ? pc : pr) * 8 + f];
      float x1 = bf2f(d[base + f]), x2 = bf2f(d[base + 8 + f]);
      d[base + f] = (bf16_t)f2bf(x1 * cs.x - x2 * cs.y); d[base + 8 + f] = (bf16_t)f2bf(x1 * cs.y + x2 * cs.x);
    }
  }
}

DI float rw_shift(const bf16_t* __restrict__ P, int row, int t, int len, int col, float mu) {
  float c = bf2f(P[(size_t)row * 1216 + col]);
  float a = t >= 1 ? bf2f(P[(size_t)(row - 1) * 1216 + col]) : 0.f;
  float b = t + 1 < len ? bf2f(P[(size_t)(row + 1) * 1216 + col]) : 0.f;
  return c + (0.5f * (a + b) - c) * mu;
}
DI void ph_rwprep(const Params& p, int l, char* smem) {
  constexpr int AST = 912, RST = 1552, ROFF = 32 * AST;
  const int tid = my_tid(), lane = tid & 63, wid = tid >> 6, g = lane >> 4, r16 = lane & 15;
  const int tg = wid >> 2, hd = wid & 3;
  const bf16_t* P = (const bf16_t*)(p.ws + R_PRW);
  const float* mu = p.in[17] + (size_t)l * 1216;
  const float* w0 = p.in[18] + (size_t)l * 512; const float* a0 = p.in[20] + (size_t)l * 256;
  const float* kkw = p.in[23] + (size_t)l * 256; const float* kaw = p.in[24] + (size_t)l * 256;
  bf16_t* S = (bf16_t*)(p.ws + R_STR); bf16_t* Gs = (bf16_t*)(p.ws + R_G);
  const size_t SU = (size_t)MT * 256;
  float w0f[4], w0b[4], a0c[4], kkc[4], kac[4];
#pragma unroll
  for (int nt = 0; nt < 4; ++nt) { int c = hd * 64 + nt * 16 + r16; w0f[nt] = w0[c]; w0b[nt] = w0[256 + c]; a0c[nt] = a0[c]; kkc[nt] = kkw[c]; kac[nt] = kaw[c]; }
  for (int u = blockIdx.x; u < MT / 32; u += gridDim.x) {
    const int row0 = u * 32; int t0, len;
    if (row0 < ML) { t0 = row0 & (SL - 1); len = SL; } else { t0 = (row0 - ML) & (CL - 1); len = CL; }
    __syncthreads();
    for (int item = tid; item < 32 * 152; item += NTHR) {
      const int tk = item / 152, c8 = item - tk * 152; const int row = row0 + tk, t = t0 + tk;
      const uint4 uc = *(const uint4*)(P + (size_t)row * 1216 + c8 * 8);
      uint4 ua = make_uint4(0, 0, 0, 0), ub = make_uint4(0, 0, 0, 0);
      if (t >= 1) ua = *(const uint4*)(P + (size_t)(row - 1) * 1216 + c8 * 8);
      if (t + 1 < len) ub = *(const uint4*)(P + (size_t)(row + 1) * 1216 + c8 * 8);
      const float4 m0 = *(const float4*)(mu + c8 * 8), m1 = *(const float4*)(mu + c8 * 8 + 4);
      float o[8];
      {
        const unsigned wc[4] = {uc.x, uc.y, uc.z, uc.w}, wa[4] = {ua.x, ua.y, ua.z, ua.w}, wb[4] = {ub.x, ub.y, ub.z, ub.w};
        const float mm[8] = {m0.x, m0.y, m0.z, m0.w, m1.x, m1.y, m1.z, m1.w};
#pragma unroll
        for (int i = 0; i < 4; ++i) {
          float c_lo = bflo(wc[i]), c_hi = bfhi(wc[i]);
          o[2 * i] = c_lo + (0.5f * (bflo(wa[i]) + bflo(wb[i])) - c_lo) * mm[2 * i];
          o[2 * i + 1] = c_hi + (0.5f * (bfhi(wa[i]) + bfhi(wb[i])) - c_hi) * mm[2 * i + 1];
        }
      }
      char* dst;
      if (c8 < 96) dst = smem + ROFF + tk * RST + c8 * 16;
      else {
        const int cc = c8 * 8 - 768;
        if (cc < 128) {
#pragma unroll
          for (int i = 0; i < 8; ++i) o[i] = tanhf(o[i]);
        } else if (cc >= 192) {
#pragma unroll
          for (int i = 0; i < 8; ++i) o[i] = sigmoidf_(o[i]);
        }
        dst = smem + tk * AST + cc * 2;
      }
      uint4 ov; ov.x = pack2(o[0], o[1]); ov.y = pack2(o[2], o[3]); ov.z = pack2(o[4], o[5]); ov.w = pack2(o[6], o[7]);
      *(uint4*)dst = ov;
    }
    __syncthreads();
    f32x4 acc[5][4];
#pragma unroll
    for (int o5 = 0; o5 < 5; ++o5)
#pragma unroll
      for (int nt = 0; nt < 4; ++nt) acc[o5][nt] = (f32x4){0.f, 0.f, 0.f, 0.f};
    const char* Arow = smem + (tg * 16 + r16) * AST + g * 16;
#pragma unroll
    for (int o5 = 0; o5 < 5; ++o5) {
      const int kbase = o5 < 3 ? o5 * 64 : (o5 == 3 ? 192 : 320);
      const int KK = o5 < 3 ? 64 : 128;
      const bf16_t* Wt = (const bf16_t*)(p.ws + (o5 == 0 ? RWW_F : o5 == 1 ? RWW_B : o5 == 2 ? RWW_A : o5 == 3 ? RWW_GF : RWW_GB));
#pragma unroll
      for (int ks = 0; ks < KK / 32; ++ks) {
        const bf16x8 af = *(const bf16x8*)(Arow + (kbase + ks * 32) * 2);
#pragma unroll
        for (int nt = 0; nt < 4; ++nt) {
          const bf16x8 bf = *(const bf16x8*)(Wt + (size_t)(hd * 64 + nt * 16 + r16) * KK + ks * 32 + g * 8);
          acc[o5][nt] = __builtin_amdgcn_mfma_f32_16x16x32_bf16(af, bf, acc[o5][nt], 0, 0, 0);
        }
        if (ks & 1) asm volatile("" ::: "memory");
      }
    }
#pragma unroll
    for (int j = 0; j < 4; ++j) {
      const int tk = tg * 16 + g * 4 + j; const size_t row = (size_t)row0 + tk;
      const char* rk = smem + ROFF + tk * RST;
      float kv[4], n2 = 0.f;
#pragma unroll
      for (int nt = 0; nt < 4; ++nt) { int c = hd * 64 + nt * 16 + r16; kv[nt] = bf2f(*(const unsigned short*)(rk + (256 + c) * 2)); float q = kv[nt] * kkc[nt]; n2 += q * q; }
      n2 = sum16(n2);
      const float inv = 1.f / fmaxf(sqrtf(n2), 1e-12f);
#pragma unroll
      for (int nt = 0; nt < 4; ++nt) {
        const int c = hd * 64 + nt * 16 + r16;
        const float r = bf2f(*(const unsigned short*)(rk + c * 2)), v = bf2f(*(const unsigned short*)(rk + (512 + c) * 2)), k = kv[nt];
        const float a = sigmoidf_(a0c[nt] + acc[2][nt][j]);
        const float kk = k * kkc[nt] * inv;
        const float kp = k * (1.f + (a - 1.f) * kac[nt]);
        const float bq = kk * a;
        const float xf = -(w0f[nt] + acc[0][nt][j]); const float spf = fmaxf(xf, 0.f) + log1pf(__expf(-fabsf(xf)));
        const float xb = -(w0b[nt] + acc[1][nt][j]); const float spb = fmaxf(xb, 0.f) + log1pf(__expf(-fabsf(xb)));
        const float ef = __expf(-spf - 0.5f), eb = __expf(-spb - 0.5f);
        const float d_f = -expm1f(-ef), d_b = -expm1f(-eb);
        const size_t o = row * 256 + c;
        S[o] = (bf16_t)f2bf(r); S[SU + o] = (bf16_t)f2bf(kp); S[2 * SU + o] = (bf16_t)f2bf(v); S[3 * SU + o] = (bf16_t)f2bf(kk);
        S[4 * SU + o] = (bf16_t)f2bf(bq); S[5 * SU + o] = (bf16_t)f2bf(d_f); S[6 * SU + o] = (bf16_t)f2bf(d_b);
        Gs[o] = (bf16_t)f2bf(acc[3][nt][j]); Gs[SU + o] = (bf16_t)f2bf(acc[4][nt][j]);
      }
    }
  }
}

DI long scan_row(int b, int dir, int s) {
  if (s < CL) return (long)ML + b * CL + (dir ? (CL - 1 - s) : s);
  int t = s - CL; return (long)b * SL + (dir ? (SL - 1 - t) : t);
}
DI float sum8(float v) {
  v += dpp_mov<0xB1>(v);
  v += dpp_mov<0x4E>(v);
  v += dpp_mov<0x141>(v);
  return v;
}
DI void ph_scan(const Params& p, char* smem) {
  const int tid = my_tid(), lane = tid & 63, wid = tid >> 6;
  const bf16_t* S = (const bf16_t*)(p.ws + R_STR);
  const size_t SU = (size_t)MT * 256;
  constexpr int T = 32, NSTEP = CL + SL, NCH = NSTEP / T;
  typedef float f32x2 __attribute__((ext_vector_type(2)));
  for (int u = blockIdx.x; u < 128; u += gridDim.x) {
    const int chain = u >> 1, rg = u & 1; const int dir = chain & 1, bh = chain >> 1, b = bh >> 2, h = bh & 3;
    bf16_t* O = (bf16_t*)(p.ws + (dir ? R_OB : R_OF));
    uint4 q0, q1, q2;
    auto SC_GLOAD = [&](int ci) {
#pragma unroll
      for (int j = 0; j < 3; ++j) {
        int idx = tid + j * 512; int st = idx >> 8, s = (idx & 255) >> 3, ck = idx & 7;
        long row = scan_row(b, dir, ci * T + s);
        int sid = st < 5 ? st : 5 + dir;
        uint4 v = *(const uint4*)(S + sid * SU + row * 256 + h * 64 + ck * 8);
        if (j == 0) q0 = v; else if (j == 1) q1 = v; else q2 = v;
      }
    };
    auto SC_SSTORE = [&](int buf) {
#pragma unroll
      for (int j = 0; j < 3; ++j) {
        int idx = tid + j * 512; int st = idx >> 8;
        uint4 v = j == 0 ? q0 : (j == 1 ? q1 : q2);
        float4 lo = make_float4(bflo(v.x), bfhi(v.x), bflo(v.y), bfhi(v.y));
        float4 hi = make_float4(bflo(v.z), bfhi(v.z), bflo(v.w), bfhi(v.w));
        if (st == 5) { lo.x = 1.f - lo.x; lo.y = 1.f - lo.y; lo.z = 1.f - lo.z; lo.w = 1.f - lo.w; hi.x = 1.f - hi.x; hi.y = 1.f - hi.y; hi.z = 1.f - hi.z; hi.w = 1.f - hi.w; }
        char* base = smem + buf * 49152 + idx * 32;
        *(float4*)(base) = lo; *(float4*)(base + 16) = hi;
      }
    };
    auto FLUSH = [&](int ci) {
      const int s = tid >> 4, part = tid & 15;
      unsigned v = *(const unsigned*)(smem + 98304 + (ci & 1) * 2048 + s * 64 + part * 4);
      long row = scan_row(b, dir, ci * T + s);
      *(unsigned*)(O + row * 256 + h * 64 + rg * 32 + part * 2) = v;
    };
    __syncthreads();
    SC_GLOAD(0);
    SC_SSTORE(0);
    __syncthreads();
    f32x2 st0 = {0.f, 0.f}, st1 = {0.f, 0.f}, st2 = {0.f, 0.f}, st3 = {0.f, 0.f};
    const int rsub = lane >> 3, ks = lane & 7;
    const int lrow = (wid & 3) * 8 + rsub;
    const int vrow = rg * 32 + lrow;
    struct Step { f32x2 r[4], k[4], kk[4], b[4], w[4]; float v; };
    auto LOADSTEP = [&](Step& x, const char* B, int s) {
#pragma unroll
      for (int hh = 0; hh < 2; ++hh) {
        const float4 r = *(const float4*)(B + (0 * T + s) * 256 + ks * 32 + hh * 16);
        const float4 k = *(const float4*)(B + (1 * T + s) * 256 + ks * 32 + hh * 16);
        const float4 kk = *(const float4*)(B + (3 * T + s) * 256 + ks * 32 + hh * 16);
        const float4 bb = *(const float4*)(B + (4 * T + s) * 256 + ks * 32 + hh * 16);
        const float4 w = *(const float4*)(B + (5 * T + s) * 256 + ks * 32 + hh * 16);
        x.r[2 * hh] = (f32x2){r.x, r.y}; x.r[2 * hh + 1] = (f32x2){r.z, r.w};
        x.k[2 * hh] = (f32x2){k.x, k.y}; x.k[2 * hh + 1] = (f32x2){k.z, k.w};
        x.kk[2 * hh] = (f32x2){kk.x, kk.y}; x.kk[2 * hh + 1] = (f32x2){kk.z, kk.w};
        x.b[2 * hh] = (f32x2){bb.x, bb.y}; x.b[2 * hh + 1] = (f32x2){bb.z, bb.w};
        x.w[2 * hh] = (f32x2){w.x, w.y}; x.w[2 * hh + 1] = (f32x2){w.z, w.w};
      }
      x.v = *(const float*)(B + (2 * T + s) * 256 + vrow * 4);
    };
    for (int ci = 0; ci < NCH; ++ci) {
      if (ci + 1 < NCH) { SC_GLOAD(ci + 1); }
      if (ci > 0) FLUSH(ci - 1);
      if (wid < 4) {
        const char* B = smem + (ci & 1) * 49152;
        bf16_t* ob = (bf16_t*)(smem + 98304 + (ci & 1) * 2048);
        Step nx; LOADSTEP(nx, B, 0);
#pragma unroll 2
        for (int s = 0; s < T; ++s) {
          const Step c = nx;
          LOADSTEP(nx, B, (s + 1 < T) ? s + 1 : s);
          f32x2 pa = st0 * c.kk[0] + st1 * c.kk[1];
          f32x2 pb = st2 * c.kk[2] + st3 * c.kk[3];
          pa = pa + pb;
          float sa = -(pa.x + pa.y);
          sa = sum8(sa);
          const f32x2 sa2 = {sa, sa}; const f32x2 v2 = {c.v, c.v};
          st0 = st0 * c.w[0] + sa2 * c.b[0] + v2 * c.k[0];
          st1 = st1 * c.w[1] + sa2 * c.b[1] + v2 * c.k[1];
          st2 = st2 * c.w[2] + sa2 * c.b[2] + v2 * c.k[2];
          st3 = st3 * c.w[3] + sa2 * c.b[3] + v2 * c.k[3];
          f32x2 oa = st0 * c.r[0] + st1 * c.r[1];
          f32x2 ob2 = st2 * c.r[2] + st3 * c.r[3];
          oa = oa + ob2;
          float o = sum8(oa.x + oa.y);
          if (ks == 0) ob[s * 32 + lrow] = (bf16_t)f2bf(o);
        }
      }
      if (ci + 1 < NCH) { SC_SSTORE((ci + 1) & 1); }
      __syncthreads();
    }
    FLUSH(NCH - 1);
  }
}

template <bool DIFF>
DI void attn_unit(const Params& p, int l, int b, int h, int qrow0, int qpos0, int kb_lo, int kb_hi, int kc_lo, char* smem) {
  const int tid = my_tid(), lane = tid & 63, wid = tid >> 6, g = lane >> 4, r16 = lane & 15;
  const bf16_t* QK = (const bf16_t*)(p.ws + (DIFF ? R_PDF : R_PSW));
  const int ldq = DIFF ? 512 : 384;
  const int qc0 = h * 64;
  const int kc0 = 256 + (DIFF ? h * 64 : (h >> 1) * 64);
  const bf16_t* VT = DIFF ? (const bf16_t*)(p.ws + R_VTDF) + ((size_t)b * 256 + h * 64) * KEYS
                          : (const bf16_t*)(p.ws + R_VTSW) + ((size_t)b * 128 + (h >> 1) * 64) * KEYS;
  const int nblk = (kb_hi - kb_lo) + (68 - kc_lo);
  const float sc = (DIFF ? 0.17677669529663687f : 0.125f) * 1.4426950408889634f;
  bf16x8 qf[2];
  {
    const bf16_t* qp = QK + (size_t)(qrow0 + wid * 16 + r16) * ldq + qc0 + g * 8;
    qf[0] = *(const bf16x8*)(qp); qf[1] = *(const bf16x8*)(qp + 32);
  }
  constexpr int NC = DIFF ? 2 : 1;
  float m[NC], lsum[NC];
  f32x4 O[NC][4];
#pragma unroll
  for (int c = 0; c < NC; ++c) {
    if (DIFF) { m[c] = -1e30f; lsum[c] = 0.f; }
    else { m[c] = p.in[16][l * 4 + h] * 1.4426950408889634f; lsum[c] = (g == 0) ? 1.f : 0.f; }
#pragma unroll
    for (int dt = 0; dt < 4; ++dt) O[c][dt] = (f32x4){0.f, 0.f, 0.f, 0.f};
  }
  const int lr = tid >> 3, lc = tid & 7;
  uint4 rk, rv;
#define AT_GLOAD(i)                                                                                   \
  do {                                                                                                \
    int kb = (i) < (kb_hi - kb_lo) ? kb_lo + (i) : kc_lo + ((i) - (kb_hi - kb_lo));                    \
    long krow = kb < 64 ? (long)b * SL + kb * 64 + lr : (long)ML + b * CL + (kb - 64) * 64 + lr;       \
    rk = *(const uint4*)(QK + krow * ldq + kc0 + lc * 8);                                             \
    rv = *(const uint4*)(VT + (size_t)lr * KEYS + kb * 64 + lc * 8);                                  \
  } while (0)
#define AT_SSTORE(buf)                                                                                \
  do {                                                                                                \
    *(uint4*)(smem + (buf) * 18432 + lr * 128 + ((lc ^ (lr & 7)) << 4)) = rk;                         \
    *(uint4*)(smem + (buf) * 18432 + 9216 + lr * 144 + lc * 16) = rv;                                 \
  } while (0)
  __syncthreads();
  AT_GLOAD(0);
  AT_SSTORE(0);
  __syncthreads();
  const int qpos = qpos0 + wid * 16 + r16;
  for (int i = 0; i < nblk; ++i) {
    if (i + 1 < nblk) AT_GLOAD(i + 1);
    const int kb = i < (kb_hi - kb_lo) ? kb_lo + i : kc_lo + (i - (kb_hi - kb_lo));
    const bool masked = (!DIFF) && (kb < 64);
    const char* Kt = smem + (i & 1) * 18432; const char* Vt = Kt + 9216;
    f32x4 S[NC][4];
#pragma unroll
    for (int kt = 0; kt < 4; ++kt) {
      bf16x8 k0 = *(const bf16x8*)(Kt + (kt * 16 + r16) * 128 + ((g ^ (r16 & 7)) << 4));
      bf16x8 k1 = *(const bf16x8*)(Kt + (kt * 16 + r16) * 128 + (((4 + g) ^ (r16 & 7)) << 4));
      if (DIFF) {
        S[0][kt] = __builtin_amdgcn_mfma_f32_16x16x32_bf16(k0, qf[0], (f32x4){0.f, 0.f, 0.f, 0.f}, 0, 0, 0);
        S[NC - 1][kt] = __builtin_amdgcn_mfma_f32_16x16x32_bf16(k1, qf[1], (f32x4){0.f, 0.f, 0.f, 0.f}, 0, 0, 0);
      } else {
        f32x4 t = __builtin_amdgcn_mfma_f32_16x16x32_bf16(k0, qf[0], (f32x4){0.f, 0.f, 0.f, 0.f}, 0, 0, 0);
        S[0][kt] = __builtin_amdgcn_mfma_f32_16x16x32_bf16(k1, qf[1], t, 0, 0, 0);
      }
    }
    bf16x8 pf[NC][2];
#pragma unroll
    for (int c = 0; c < NC; ++c) {
      float mx = -1e30f;
#pragma unroll
      for (int kt = 0; kt < 4; ++kt)
#pragma unroll
        for (int j = 0; j < 4; ++j) {
          float v = S[c][kt][j] * sc;
          if (masked) { int kpos = kb * 64 + kt * 16 + g * 4 + j; int dd = kpos - qpos; if (dd > 128 || dd < -128) v = -1e30f; }
          S[c][kt][j] = v; mx = fmaxf(mx, v);
        }
      mx = fmaxf(mx, __shfl_xor(mx, 16)); mx = fmaxf(mx, __shfl_xor(mx, 32));
      float mn = fmaxf(m[c], mx);
      float alpha = __builtin_amdgcn_exp2f(m[c] - mn);
      m[c] = mn;
      float ps = 0.f;
      unsigned pk[8];
#pragma unroll
      for (int kt = 0; kt < 4; ++kt) {
        float e0 = __builtin_amdgcn_exp2f(S[c][kt][0] - mn), e1 = __builtin_amdgcn_exp2f(S[c][kt][1] - mn), e2 = __builtin_amdgcn_exp2f(S[c][kt][2] - mn), e3 = __builtin_amdgcn_exp2f(S[c][kt][3] - mn);
        ps += (e0 + e1) + (e2 + e3);
        pk[kt * 2] = pack2(e0, e1); pk[kt * 2 + 1] = pack2(e2, e3);
      }
      lsum[c] = lsum[c] * alpha + ps;
#pragma unroll
      for (int dt = 0; dt < 4; ++dt) { O[c][dt][0] *= alpha; O[c][dt][1] *= alpha; O[c][dt][2] *= alpha; O[c][dt][3] *= alpha; }
      union { unsigned u[4]; bf16x8 v; } cv;
      cv.u[0] = pk[0]; cv.u[1] = pk[1]; cv.u[2] = pk[2]; cv.u[3] = pk[3]; pf[c][0] = cv.v;
      cv.u[0] = pk[4]; cv.u[1] = pk[5]; cv.u[2] = pk[6]; cv.u[3] = pk[7]; pf[c][1] = cv.v;
    }
#pragma unroll
    for (int dt = 0; dt < 4; ++dt)
#pragma unroll
      for (int s2 = 0; s2 < 2; ++s2) {
        union { uint2 u[2]; bf16x8 v; } vf;
        vf.u[0] = *(const uint2*)(Vt + (dt * 16 + r16) * 144 + (2 * s2) * 32 + g * 8);
        vf.u[1] = *(const uint2*)(Vt + (dt * 16 + r16) * 144 + (2 * s2 + 1) * 32 + g * 8);
#pragma unroll
        for (int c = 0; c < NC; ++c) O[c][dt] = __builtin_amdgcn_mfma_f32_16x16x32_bf16(vf.v, pf[c][s2], O[c][dt], 0, 0, 0);
      }
    if (i + 1 < nblk) AT_SSTORE((i + 1) & 1);
    __syncthreads();
  }
#undef AT_GLOAD
#undef AT_SSTORE
  float linv[NC];
#pragma unroll
  for (int c = 0; c < NC; ++c) { float t = lsum[c]; t += __shfl_xor(t, 16); t += __shfl_xor(t, 32); linv[c] = 1.f / t; }
  const size_t orow = (size_t)(qrow0 + wid * 16 + r16);
  if (!DIFF) {
    bf16_t* Y = (bf16_t*)(p.ws + R_YSW);
#pragma unroll
    for (int dt = 0; dt < 4; ++dt) {
      uint2 o; o.x = pack2(O[0][dt][0] * linv[0], O[0][dt][1] * linv[0]); o.y = pack2(O[0][dt][2] * linv[0], O[0][dt][3] * linv[0]);
      *(uint2*)(Y + orow * 256 + h * 64 + dt * 16 + g * 4) = o;
    }
  } else {
    const float lam_init = 0.8f - 0.6f * __expf(-0.3f * (float)l);
    float d1 = 0.f, d2 = 0.f;
    if (lane < 32) { d1 = p.in[28][l * 32 + lane] * p.in[29][l * 32 + lane]; d2 = p.in[30][l * 32 + lane] * p.in[31][l * 32 + lane]; }
    d1 = wave_sum(d1); d2 = wave_sum(d2);
    const float lam = expf(d1) - expf(d2) + lam_init;
    float ov[4][4]; float ss = 0.f;
#pragma unroll
    for (int dt = 0; dt < 4; ++dt)
#pragma unroll
      for (int j = 0; j < 4; ++j) { float v = O[0][dt][j] * linv[0] - lam * O[NC - 1][dt][j] * linv[NC - 1]; ov[dt][j] = v; ss += v * v; }
    ss += __shfl_xor(ss, 16); ss += __shfl_xor(ss, 32);
    const float rms = rsqrtf(ss * (1.f / 64.f) + 1e-5f) * (1.f - lam_init);
    const float* sg = p.in[32] + l * 64;
    bf16_t* Y = (bf16_t*)(p.ws + R_YDF);
#pragma unroll
    for (int dt = 0; dt < 4; ++dt) {
      const int d0 = dt * 16 + g * 4;
      uint2 o; o.x = pack2(ov[dt][0] * rms * sg[d0], ov[dt][1] * rms * sg[d0 + 1]); o.y = pack2(ov[dt][2] * rms * sg[d0 + 2], ov[dt][3] * rms * sg[d0 + 3]);
      *(uint2*)(Y + orow * 256 + h * 64 + d0) = o;
    }
  }
}

DI void ph_attn(const Params& p, int l, char* smem) {
  const bool need_ctx = (l == 0);
  const int n_sw = 1024 + (need_ctx ? 64 : 0);
  const int n_df = 1024 + (need_ctx ? 64 : 0);
  unsigned* ctr = (unsigned*)(p.ws + MISC_BAR + 64 + 64 * l);
  volatile int* slot = (volatile int*)(smem + 40960);
  for (;;) {
    __syncthreads();
    if (my_tid() == 0) *slot = (int)__hip_atomic_fetch_add(ctr, 1u, __ATOMIC_RELAXED, __HIP_MEMORY_SCOPE_AGENT);
    __syncthreads();
    const int u = *slot;
    if (u >= n_sw + n_df) break;
    if (u < n_df) {
      if (u < 1024) { int b = u >> 7, h = (u >> 5) & 3, n = u & 31; attn_unit<true>(p, l, b, h, b * SL + n * 128, n * 128, 0, 64, 64, smem); }
      else { int v = u - 1024; int b = v >> 3, h = (v >> 1) & 3, n = v & 1; attn_unit<true>(p, l, b, h, ML + b * CL + n * 128, 0, 0, 0, 64, smem); }
    } else {
      int w = u - n_df;
      if (w < 1024) {
        int b = w >> 7, h = (w >> 5) & 3, n = w & 31;
        int lo = (n - 1) * 2; if (lo < 0) lo = 0; int hi = (n + 2) * 2; if (hi > 64) hi = 64;
        attn_unit<false>(p, l, b, h, b * SL + n * 128, n * 128, lo, hi, 64, smem);
      } else { int v = w - 1024; int b = v >> 3, h = (v >> 1) & 3, n = v & 1; attn_unit<false>(p, l, b, h, ML + b * CL + n * 128, 0, 0, 0, 64, smem); }
    }
  }
}

DI void ph_rwout(const Params& p, int l) {
  const int lane = my_tid() & 63, wid = my_tid() >> 6;
  const bf16_t* S = (const bf16_t*)(p.ws + R_STR); const bf16_t* Gs = (const bf16_t*)(p.ws + R_G);
  const bf16_t* OF = (const bf16_t*)(p.ws + R_OF); const bf16_t* OB = (const bf16_t*)(p.ws + R_OB);
  bf16_t* Y = (bf16_t*)(p.ws + R_YRW);
  const size_t SU = (size_t)MT * 256;
  const float4 rk = *(const float4*)(p.in[25] + (size_t)l * 256 + lane * 4);
  const float4 gam = *(const float4*)(p.in[26] + (size_t)l * 256 + lane * 4);
  const float4 bet = *(const float4*)(p.in[27] + (size_t)l * 256 + lane * 4);
  const int nrows = (l == 0) ? MT : ML;
  for (int row = blockIdx.x * 8 + wid; row < nrows; row += gridDim.x * 8) {
    const size_t o = (size_t)row * 256 + lane * 4;
    uint2 ur = *(const uint2*)(S + o), uk = *(const uint2*)(S + SU + o), uv = *(const uint2*)(S + 2 * SU + o);
    uint2 uf = *(const uint2*)(OF + o), ub = *(const uint2*)(OB + o), ugf = *(const uint2*)(Gs + o), ugb = *(const uint2*)(Gs + SU + o);
    float r[4] = {bflo(ur.x), bfhi(ur.x), bflo(ur.y), bfhi(ur.y)};
    float k[4] = {bflo(uk.x), bfhi(uk.x), bflo(uk.y), bfhi(uk.y)};
    float v[4] = {bflo(uv.x), bfhi(uv.x), bflo(uv.y), bfhi(uv.y)};
    float f[4] = {bflo(uf.x), bfhi(uf.x), bflo(uf.y), bfhi(uf.y)};
    float bb[4] = {bflo(ub.x), bfhi(ub.x), bflo(ub.y), bfhi(ub.y)};
    float gf[4] = {bflo(ugf.x), bfhi(ugf.x), bflo(ugf.y), bfhi(ugf.y)};
    float gb[4] = {bflo(ugb.x), bfhi(ugb.x), bflo(ugb.y), bfhi(ugb.y)};
    const float rkv[4] = {rk.x, rk.y, rk.z, rk.w}; const float ga[4] = {gam.x, gam.y, gam.z, gam.w}; const float be[4] = {bet.x, bet.y, bet.z, bet.w};
    float bon = 0.f, sf = 0.f, sb = 0.f;
#pragma unroll
    for (int i = 0; i < 4; ++i) { bon += r[i] * k[i] * rkv[i]; sf += f[i]; sb += bb[i]; }
    bon = sum16(bon); float muf = sum16(sf) * (1.f / 64.f), mub = sum16(sb) * (1.f / 64.f);
    float qf = 0.f, qb = 0.f;
#pragma unroll
    for (int i = 0; i < 4; ++i) { f[i] -= muf; bb[i] -= mub; qf += f[i] * f[i]; qb += bb[i] * bb[i]; }
    float rsf = rsqrtf(sum16(qf) * (1.f / 64.f) + 64e-5f), rsb = rsqrtf(sum16(qb) * (1.f / 64.f) + 64e-5f);
    float y[4];
#pragma unroll
    for (int i = 0; i < 4; ++i) {
      float bn = bon * v[i];
      y[i] = (f[i] * rsf * ga[i] + be[i] + bn) * gf[i] + (bb[i] * rsb * ga[i] + be[i] + bn) * gb[i];
    }
    uint2 oo; oo.x = pack2(y[0], y[1]); oo.y = pack2(y[2], y[3]);
    *(uint2*)(Y + o) = oo;
  }
}

DI void ph_merge(const Params& p, int l, char* smem) {
  const bf16_t* U = (const bf16_t*)(p.ws + R_URE);
  const int lane = my_tid() & 63, wid = my_tid() >> 6, wm = wid >> 1, wn = wid & 1, g = lane >> 4, r16 = lane & 15;
  const int mtiles = (l == 0) ? 136 : 128;
  bf16_t* ACC = (bf16_t*)(p.ws + R_ACC);
  for (int it = 0;; ++it) {
    int mtile, ntile;
    if (!next_tile(it, mtiles, 8, mtile, ntile)) break;
    uint2 accS[4][4];
#pragma unroll
    for (int mt = 0; mt < 4; ++mt)
#pragma unroll
      for (int nt = 0; nt < 4; ++nt) accS[mt][nt] = make_uint2(0u, 0u);
    for (int j = 0; j < 4; ++j) {
      uint2 pb[4][4];
      {
        f32x4 accB[4][4]; zero_acc<4>(accB);
        const size_t yoff = (j == 0) ? R_YHY : (j == 1) ? R_YSW : (j == 2) ? R_YRW : R_YDF;
        gemm_main<4, false>(accB, (const bf16_t*)(p.ws + yoff), 256, RowPlain{(long)mtile * 256}, (const bf16_t*)(p.ws + WB_BR) + ((size_t)j * 1024 + ntile * 128) * 256, 256, 256, smem);
#pragma unroll
        for (int mt = 0; mt < 4; ++mt)
#pragma unroll
          for (int nt = 0; nt < 4; ++nt) { pb[mt][nt].x = pack2(accB[mt][nt][0], accB[mt][nt][1]); pb[mt][nt].y = pack2(accB[mt][nt][2], accB[mt][nt][3]); }
      }
      f32x4 accG[4][4]; zero_acc<4>(accG);
      gemm_main<4, false>(accG, U, 1024, RowPlain{(long)mtile * 256}, (const bf16_t*)(p.ws + WB_GATE) + ((size_t)j * 1024 + ntile * 128) * 1024, 1024, 1024, smem);
#pragma unroll
      for (int mt = 0; mt < 4; ++mt)
#pragma unroll
        for (int nt = 0; nt < 4; ++nt) {
          float v0 = bflo(accS[mt][nt].x) + sigmoidf_(accG[mt][nt][0]) * bflo(pb[mt][nt].x);
          float v1 = bfhi(accS[mt][nt].x) + sigmoidf_(accG[mt][nt][1]) * bfhi(pb[mt][nt].x);
          float v2 = bflo(accS[mt][nt].y) + sigmoidf_(accG[mt][nt][2]) * bflo(pb[mt][nt].y);
          float v3 = bfhi(accS[mt][nt].y) + sigmoidf_(accG[mt][nt][3]) * bfhi(pb[mt][nt].y);
          accS[mt][nt].x = pack2(v0, v1); accS[mt][nt].y = pack2(v2, v3);
        }
    }
#pragma unroll
    for (int mt = 0; mt < 4; ++mt) {
      const int col = ntile * 128 + wn * 64 + r16 * 4;
      const size_t row = (size_t)mtile * 256 + wm * 64 + mt * 16 + g * 4;
      uint2 o;
      o.x = (accS[mt][0].x & 0xffffu) | (accS[mt][1].x << 16); o.y = (accS[mt][2].x & 0xffffu) | (accS[mt][3].x << 16);
      *(uint2*)(ACC + (row + 0) * 1024 + col) = o;
      o.x = (accS[mt][0].x >> 16) | (accS[mt][1].x & 0xffff0000u); o.y = (accS[mt][2].x >> 16) | (accS[mt][3].x & 0xffff0000u);
      *(uint2*)(ACC + (row + 1) * 1024 + col) = o;
      o.x = (accS[mt][0].y & 0xffffu) | (accS[mt][1].y << 16); o.y = (accS[mt][2].y & 0xffffu) | (accS[mt][3].y << 16);
      *(uint2*)(ACC + (row + 2) * 1024 + col) = o;
      o.x = (accS[mt][0].y >> 16) | (accS[mt][1].y & 0xffff0000u); o.y = (accS[mt][2].y >> 16) | (accS[mt][3].y & 0xffff0000u);
      *(uint2*)(ACC + (row + 3) * 1024 + col) = o;
    }
  }
}

DI void ph_resgemm(const Params& p, int l, const bf16_t* A, int K, const bf16_t* Bt, const float* hsrc_lat, const float* hsrc_ctx, int gate_off, char* smem) {
  const int lane = my_tid() & 63, wid = my_tid() >> 6, wm = wid >> 1, wn = wid & 1, g = lane >> 4, r16 = lane & 15;
  const int mtiles = (l == 0) ? 136 : 128;
  const float* mod = (const float*)(p.ws + MISC_MOD) + (size_t)l * 9 * 6144;
  float* hc = (float*)(p.ws + OFF_HC);
  for (int it = 0;; ++it) {
    int mtile, ntile;
    if (!next_tile(it, mtiles, 8, mtile, ntile)) break;
    f32x4 acc[4][4]; zero_acc<4>(acc);
    gemm_glds(acc, A, K, RowPlain{(long)mtile * 256}, Bt + (size_t)ntile * 128 * K, K, K, smem, (const bf16_t*)(p.ws + MISC_ZERO));
    const int b = mtile < 128 ? (mtile >> 4) : 8;
    const float* gt = mod + (size_t)b * 6144 + gate_off;
    const int col = ntile * 128 + wn * 64 + r16 * 4;
    const float4 gv = *(const float4*)(gt + col);
#pragma unroll
    for (int mt = 0; mt < 4; ++mt)
#pragma unroll
      for (int e = 0; e < 4; ++e) {
        const int row = mtile * 256 + wm * 64 + mt * 16 + g * 4 + e;
        const float* hs; float* hd;
        if (row < ML) { size_t o = (size_t)row * D + col; hs = hsrc_lat + o; hd = p.out + o; }
        else { size_t o = (size_t)(row - ML) * D + col; hs = hsrc_ctx + o; hd = hc + o; }
        const float4 h = *(const float4*)hs;
        float4 r;
        r.x = DN_ALPHA * h.x + gv.x * acc[mt][0][e]; r.y = DN_ALPHA * h.y + gv.y * acc[mt][1][e];
        r.z = DN_ALPHA * h.z + gv.z * acc[mt][2][e]; r.w = DN_ALPHA * h.w + gv.w * acc[mt][3][e];
        *(float4*)hd = r;
      }
  }
}

DI void ph_ffnup(const Params& p, int l, char* smem) {
  const bf16_t* U = (const bf16_t*)(p.ws + R_U);
  const bf16_t* Bt = (const bf16_t*)(p.ws + WB_UP);
  bf16_t* HID = (bf16_t*)(p.ws + R_HID);
  const float* cw = p.in[38] + (size_t)l * 3 * 5632; const float* cb = p.in[39] + (size_t)l * 5632;
  const int tid = my_tid(), lane = tid & 63, wid = tid >> 6, wm = wid >> 2, wn = wid & 3, g = lane >> 4, r16 = lane & 15;
  const int mtiles = (l == 0) ? 152 : 136;
  constexpr int TS = 528;
  for (int it = 0;; ++it) {
    int mtile, ntile;
    if (!next_tile(it, mtiles, 22, mtile, ntile)) break;
    long rowbase; int tt, len;
    if (mtile < 136) { int b = mtile / 17; tt = mtile % 17; len = SL; rowbase = (long)b * SL; }
    else { int v = mtile - 136; int b = v >> 1; tt = v & 1; len = CL; rowbase = (long)ML + b * CL; }
    f32x4 acc[8][4]; zero_acc256(acc);
    gemm_glds256(acc, U, 1024, rowbase + tt * 254 - 1, Bt + (size_t)ntile * 256 * 1024, 1024, 1024, smem);
#pragma unroll
    for (int mt = 0; mt < 8; ++mt)
#pragma unroll
      for (int e = 0; e < 4; ++e) {
        uint2 o; o.x = pack2(acc[mt][0][e], acc[mt][1][e]); o.y = pack2(acc[mt][2][e], acc[mt][3][e]);
        *(uint2*)(smem + (wm * 128 + mt * 16 + g * 4 + e) * TS + (wn * 64 + r16 * 4) * 2) = o;
      }
    __syncthreads();
    {
      const int ch = tid & 127, rgp = tid >> 7; const int ca = ntile * 128 + ch, cbx = 2816 + ca;
      const float a0 = cw[ca], a1 = cw[5632 + ca], a2 = cw[2 * 5632 + ca], ab = cb[ca];
      const float b0 = cw[cbx], b1 = cw[5632 + cbx], b2 = cw[2 * 5632 + cbx], bb = cb[cbx];
      for (int r = 1 + rgp; r <= 254; r += 4) {
        const int tok = tt * 254 - 1 + r;
        if (tok < len) {
          const char* Tr = smem + r * TS + ch * 2;
          const float pa = tok >= 1 ? bf2f(*(const bf16_t*)(Tr - TS)) : 0.f, pb_ = tok >= 1 ? bf2f(*(const bf16_t*)(Tr - TS + 256)) : 0.f;
          const float na = tok + 1 < len ? bf2f(*(const bf16_t*)(Tr + TS)) : 0.f, nb = tok + 1 < len ? bf2f(*(const bf16_t*)(Tr + TS + 256)) : 0.f;
          const float av = a0 * pa + a1 * bf2f(*(const bf16_t*)(Tr)) + a2 * na + ab;
          const float bv = b0 * pb_ + b1 * bf2f(*(const bf16_t*)(Tr + 256)) + b2 * nb + bb;
          HID[(size_t)(rowbase + tok) * 2816 + ca] = (bf16_t)f2bf(siluf_(av) * bv);
        }
      }
    }
  }
}

#ifndef REP_PREP
#define REP_PREP 1
#endif
#ifndef REP_GEMM
#define REP_GEMM 1
#endif
#ifndef REP_HY
#define REP_HY 1
#endif
#ifndef REP_RWP
#define REP_RWP 1
#endif
#ifndef REP_SCAN
#define REP_SCAN 1
#endif
#ifndef REP_ATTN
#define REP_ATTN 1
#endif
#ifndef PH_END
#define PH_END 24
#endif
DI void grid_barrier(unsigned* bar, unsigned& epoch) {
  __syncthreads();
  epoch += 1;
  if (my_tid() == 0) {
    __threadfence();
    const unsigned target = epoch * gridDim.x;
    __hip_atomic_fetch_add(bar, 1u, __ATOMIC_RELAXED, __HIP_MEMORY_SCOPE_AGENT);
    while (__hip_atomic_load(bar, __ATOMIC_RELAXED, __HIP_MEMORY_SCOPE_AGENT) < target) __builtin_amdgcn_s_sleep(1);
    __threadfence();
  }
  __syncthreads();
}
#define SYNC_OR_RET(idx) do { if ((idx) + 1 >= PH_END) return; if ((idx) == 0) grid.sync(); else grid_barrier((unsigned*)(p.ws + MISC_BAR), epoch); } while (0)
template <int l>
DI void run_layer(const Params& p, cg::grid_group& grid, char* smem, unsigned& epoch) {
  const float* mod = (const float*)(p.ws + MISC_MOD) + (size_t)l * 9 * 6144;
  float* hc = (float*)(p.ws + OFF_HC);
  const float* hl_src = (l == 0) ? p.in[0] : p.out;
  const float* hc_src = (l == 0) ? p.in[2] : hc;
  constexpr int B0 = l * 12;
  if (l == 0) {
    ph_convert(p, 0, smem);
    ph_ada(p, smem);
    hy_rawfilter(p, 0, SL, (float*)(p.ws + R_RAWF), smem);
    hy_rawfilter(p, 0, CL, (float*)(p.ws + MISC_RAWC), smem);
    SYNC_OR_RET(B0 + 0);
    ph_kf(p, 0, smem);
    ph_ln(hl_src, hc_src, nullptr, nullptr, nullptr, nullptr, (bf16_t*)(p.ws + R_U), mod, 0, MT);
    SYNC_OR_RET(B0 + 1);
  }
  for (int rep = 0; rep < REP_GEMM; ++rep) ph_inproj(p, smem);
  SYNC_OR_RET(B0 + 2);
  for (int rep = 0; rep < REP_HY; ++rep) {
  if (blockIdx.x == 0 && my_tid() == 0) *(unsigned*)(p.ws + MISC_BAR + 64 + 64 * l) = 0u;
  ph_hyena(p, l, smem);
  if (l == 0) ph_hyena_ctx(p, l, smem);
  }
  ph_rope(p, smem);
  for (int rep = 0; rep < REP_RWP; ++rep) ph_rwprep(p, l, smem);
  SYNC_OR_RET(B0 + 3);
  for (int rep = 0; rep < REP_SCAN; ++rep) ph_scan(p, smem);
  for (int rep = 0; rep < REP_ATTN; ++rep) ph_attn(p, l, smem);
  SYNC_OR_RET(B0 + 4);
  ph_rwout(p, l);
  ph_ln(hl_src, hc_src, nullptr, nullptr, nullptr, nullptr, (bf16_t*)(p.ws + R_URE), mod, 0, l == 0 ? MT : ML);
  SYNC_OR_RET(B0 + 5);
  for (int rep = 0; rep < REP_GEMM; ++rep) ph_merge(p, l, smem);
  SYNC_OR_RET(B0 + 6);
  ph_resgemm(p, l, (const bf16_t*)(p.ws + R_ACC), 1024, (const bf16_t*)(p.ws + WB_OUT), hl_src, hc_src, 2048, smem);
  if (l == 0) hy_rawfilter(p, 1, SL, (float*)(p.ws + R_RAWF), smem);
  SYNC_OR_RET(B0 + 7);
  ph_ln(p.out, hc, p.out, hc, p.in[35] + (size_t)l * D, p.in[36] + (size_t)l * D, (bf16_t*)(p.ws + R_U), mod, 3072, l == 0 ? MT : ML);
  if (l == 0) ph_kf(p, 1, smem);
  SYNC_OR_RET(B0 + 8);
  for (int rep = 0; rep < REP_GEMM; ++rep) ph_ffnup(p, l, smem);
  SYNC_OR_RET(B0 + 9);
  ph_resgemm(p, l, (const bf16_t*)(p.ws + R_HID), 2816, (const bf16_t*)(p.ws + WB_DOWN), p.out, hc, 5120, smem);
  SYNC_OR_RET(B0 + 10);
  if (l == 0) {
    ph_ln(p.out, hc, p.out, hc, p.in[41], p.in[42], (bf16_t*)(p.ws + R_U), mod + 9 * 6144, 0, MT);
    ph_convert(p, 1, smem);
  } else {
    ph_ln(p.out, hc, p.out, hc, p.in[41] + (size_t)l * D, p.in[42] + (size_t)l * D, nullptr, mod, 0, ML);
  }
  SYNC_OR_RET(B0 + 11);
}

__global__ void __launch_bounds__(NTHR) mega(Params p) {
  extern __shared__ __attribute__((aligned(16))) char smem[];
  cg::grid_group grid = cg::this_grid();
  unsigned epoch = 0;
  if (blockIdx.x == 0 && my_tid() == 0) *(unsigned*)(p.ws + MISC_BAR) = 0u;
  if (blockIdx.x == 0 && my_tid() < 64) *(unsigned*)(p.ws + MISC_ZERO + my_tid() * 4) = 0u;
  run_layer<0>(p, grid, smem, epoch);
  if (PH_END > 12) run_layer<1>(p, grid, smem, epoch);
}

extern "C" void kernel_launch(void* const* d_in, const int* in_sizes, int n_in, void* d_out, int out_size,
                              void* d_ws, size_t ws_size, hipStream_t stream) {
  static int grid_blocks = 0;
  if (!grid_blocks) {
    int dev = 0, cus = 0, per_cu = 0;
    (void)hipGetDevice(&dev);
    (void)hipDeviceGetAttribute(&cus, hipDeviceAttributeMultiprocessorCount, dev);
    (void)hipFuncSetAttribute((const void*)mega, hipFuncAttributeMaxDynamicSharedMemorySize, SMEM_BYTES);
    (void)hipOccupancyMaxActiveBlocksPerMultiprocessor(&per_cu, mega, NTHR, SMEM_BYTES);
    if (per_cu < 1) per_cu = 1;
    if (per_cu > 1) per_cu = 1;
    grid_blocks = cus * per_cu;
  }
  Params p{};
  for (int i = 0; i < 43; ++i) p.in[i] = (const float*)d_in[i];
  p.out = (float*)d_out; p.ws = (char*)d_ws;
  void* args[] = {&p};
  hipError_t e = hipLaunchCooperativeKernel((void*)mega, dim3(grid_blocks), dim3(NTHR), args, SMEM_BYTES, stream);
  if (e != hipSuccess) fprintf(stderr, "cooperative launch failed: %s (grid %d)\n", hipGetErrorString(e), grid_blocks);
}
```

```cpp
#include <hip/hip_runtime.h>
#include <hip/hip_cooperative_groups.h>
#include <cstdio>
#include <cstdint>
namespace cg = cooperative_groups;

#define DI __device__ __forceinline__
typedef unsigned short bf16_t;
typedef short bf16x8 __attribute__((ext_vector_type(8)));
typedef float f32x4 __attribute__((ext_vector_type(4)));

constexpr int D = 1024, NB = 8, SL = 4096, CL = 256;
constexpr int ML = NB * SL, MC = NB * CL, MT = ML + MC;
constexpr int KEYS = SL + CL;
constexpr int NTHR = 512;
constexpr float DN_ALPHA = 1.41421356237f;
constexpr size_t UNIT = (size_t)MT * 512;

constexpr size_t WB_IN = 0;
constexpr size_t WB_GATE = WB_IN + (size_t)3328 * 1024 * 2;
constexpr size_t WB_BR = WB_GATE + (size_t)4096 * 1024 * 2;
constexpr size_t WB_OUT = WB_BR + (size_t)4 * 1024 * 256 * 2;
constexpr size_t WB_UP = WB_OUT + (size_t)1024 * 1024 * 2;
constexpr size_t WB_DOWN = WB_UP + (size_t)5632 * 1024 * 2;
constexpr size_t WB_END = WB_DOWN + (size_t)1024 * 2816 * 2;
constexpr size_t OFF_KF = WB_END;
constexpr size_t OFF_HC = OFF_KF + (size_t)512 * 8192 * 8;
constexpr size_t OFF_MISC = OFF_HC + (size_t)MC * D * 4;
constexpr size_t MISC_MOD = OFF_MISC;
constexpr size_t MISC_TW = MISC_MOD + (size_t)2 * 9 * 6144 * 4;
constexpr size_t MISC_RAWC = MISC_TW + 4096 * 8;
constexpr size_t MISC_GCTX = MISC_RAWC + (size_t)256 * 1024 * 4;
constexpr size_t MISC_RWW = MISC_GCTX + (size_t)512 * 512 * 4;
constexpr size_t RWW_F = MISC_RWW, RWW_B = RWW_F + 256 * 64 * 2, RWW_A = RWW_B + 256 * 64 * 2, RWW_GF = RWW_A + 256 * 64 * 2, RWW_GB = RWW_GF + 256 * 128 * 2;
constexpr size_t OFF_R = OFF_MISC + (size_t)4 * 1024 * 1024;
constexpr size_t MISC_BAR = OFF_R - 256;
constexpr size_t MISC_ZERO = OFF_R - 512;
static_assert(RWW_GB + 256 * 128 * 2 <= MISC_ZERO, "misc overflow");
constexpr size_t R_YHY = OFF_R, R_YSW = OFF_R + UNIT, R_YDF = OFF_R + 2 * UNIT;
constexpr size_t R_PHY = OFF_R + 3 * UNIT;
constexpr size_t R_PSW = OFF_R + 6 * UNIT;
constexpr size_t R_VTSW = R_PSW + (size_t)MT * 384 * 2;
constexpr size_t R_PDF = OFF_R + 8 * UNIT;
constexpr size_t R_VTDF = OFF_R + 10 * UNIT;
constexpr size_t R_PRW = OFF_R + 11 * UNIT;
constexpr size_t R_STR = R_PRW + (size_t)MT * 1216 * 2;
constexpr size_t R_G = R_STR + 7 * UNIT;
constexpr size_t R_END = R_G + 2 * UNIT;
constexpr size_t R_RAWF = OFF_R;
constexpr size_t R_OF = R_PHY, R_OB = R_PHY + UNIT;
constexpr size_t R_URE = R_PSW;
constexpr size_t R_YRW = R_VTDF;
constexpr size_t R_ACC = R_PRW;
constexpr size_t R_U = R_STR;
constexpr size_t R_HID = OFF_R;
static_assert(R_END <= (size_t)512 * 1024 * 1024, "ws overflow");
static_assert((size_t)MT * 2816 * 2 <= 11 * UNIT, "hid");

constexpr int SMEM_BYTES = 144 * 1024;

struct Params {
  const float* in[43];
  float* out;
  char* ws;
};

DI int my_tid() { int t = (int)__builtin_amdgcn_workitem_id_x(); asm volatile("" : "+v"(t)); return t; }
DI unsigned f2bf(float f) { unsigned u = __float_as_uint(f); u += 0x7fffu + ((u >> 16) & 1u); return u >> 16; }
DI float bf2f(unsigned h) { return __uint_as_float(h << 16); }
typedef __bf16 bf16v2_t __attribute__((ext_vector_type(2)));
typedef float f32v2_t __attribute__((ext_vector_type(2)));
DI unsigned pack2(float lo, float hi) { f32v2_t v = {lo, hi}; bf16v2_t b = __builtin_convertvector(v, bf16v2_t); return __builtin_bit_cast(unsigned, b); }

DI float bflo(unsigned w) { return __uint_as_float(w << 16); }
DI float bfhi(unsigned w) { return __uint_as_float(w & 0xffff0000u); }
DI float sigmoidf_(float x) { return 1.f / (1.f + __expf(-x)); }
DI float siluf_(float x) { return x / (1.f + __expf(-x)); }
DI float wave_sum(float v) {
#pragma unroll
  for (int o = 32; o >= 1; o >>= 1) v += __shfl_xor(v, o);
  return v;
}
template <int CTRL> DI float dpp_mov(float v) {
  return __int_as_float(__builtin_amdgcn_update_dpp(0, __float_as_int(v), CTRL, 0xf, 0xf, false));
}
DI float sum16(float v) {
  v += dpp_mov<0xB1>(v);
  v += dpp_mov<0x4E>(v);
  v += dpp_mov<0x141>(v);
  v += dpp_mov<0x140>(v);
  return v;
}
DI void lds_barrier() { asm volatile("s_waitcnt lgkmcnt(0)" ::: "memory"); __builtin_amdgcn_s_barrier(); asm volatile("" ::: "memory"); }
DI uint4 sel4(bool z, uint4 v) { return make_uint4(z ? 0u : v.x, z ? 0u : v.y, z ? 0u : v.z, z ? 0u : v.w); }
DI int mod_idx(int row) { return row < ML ? (row >> 12) : 8; }

template <int NTW, bool DEEP, class RowFn>
DI void gemm_main(f32x4 (&acc)[4][NTW], const bf16_t* __restrict__ A, int lda, RowFn rowfn,
                  const bf16_t* __restrict__ Bt, int ldb, int K, char* smem) {
  constexpr int BN = NTW * 32;
  constexpr int A_BYTES = 256 * 128, B_BYTES = BN * 128, STAGE = A_BYTES + B_BYTES;
  constexpr int NBL = BN / 64;
  const int tid = my_tid(), lane = tid & 63, wid = tid >> 6, wm = wid >> 1, wn = wid & 1, g = lane >> 4, r16 = lane & 15;
  const int chunk = tid & 7, lrow = tid >> 3;
  long a0 = rowfn(lrow), a1 = rowfn(lrow + 64), a2 = rowfn(lrow + 128), a3 = rowfn(lrow + 192);
  const long c0 = a0 < 0 ? 0 : a0, c1 = a1 < 0 ? 0 : a1, c2 = a2 < 0 ? 0 : a2, c3 = a3 < 0 ? 0 : a3;
  const bf16_t* Bp = Bt + (long)lrow * ldb + chunk * 8;
  const bf16_t* Ap0 = A + c0 * lda + chunk * 8; const bf16_t* Ap1 = A + c1 * lda + chunk * 8;
  const bf16_t* Ap2 = A + c2 * lda + chunk * 8; const bf16_t* Ap3 = A + c3 * lda + chunk * 8;
  struct Regs { uint4 a0, a1, a2, a3, b0, b1; };
  Regs R0, R1;
  R0.b1 = make_uint4(0, 0, 0, 0); R1.b1 = make_uint4(0, 0, 0, 0);
  auto GLOAD = [&](Regs& R, int k0) {
    R.a0 = *(const uint4*)(Ap0 + k0); R.a1 = *(const uint4*)(Ap1 + k0);
    R.a2 = *(const uint4*)(Ap2 + k0); R.a3 = *(const uint4*)(Ap3 + k0);
    R.b0 = *(const uint4*)(Bp + k0);
    if constexpr (NBL > 1) R.b1 = *(const uint4*)(Bp + (long)64 * ldb + k0);
  };
  auto SSTORE = [&](const Regs& R, int st) {
    char* base = smem + st * STAGE + lrow * 128 + ((chunk ^ (lrow & 7)) << 4);
    *(uint4*)(base) = sel4(a0 < 0, R.a0); *(uint4*)(base + 64 * 128) = sel4(a1 < 0, R.a1);
    *(uint4*)(base + 128 * 128) = sel4(a2 < 0, R.a2); *(uint4*)(base + 192 * 128) = sel4(a3 < 0, R.a3);
    *(uint4*)(base + A_BYTES) = R.b0;
    if constexpr (NBL > 1) *(uint4*)(base + A_BYTES + 64 * 128) = R.b1;
  };
  auto COMPUTE = [&](int st) {
    const char* As = smem + st * STAGE + (wm * 64 + r16) * 128;
    const char* Bs = smem + st * STAGE + A_BYTES + (wn * (NTW * 16) + r16) * 128;
#pragma unroll
    for (int kk = 0; kk < 2; ++kk) {
      const int sw = ((kk * 4 + g) ^ (r16 & 7)) << 4;
      bf16x8 af[4], bfr[NTW];
#pragma unroll
      for (int mt = 0; mt < 4; ++mt) af[mt] = *(const bf16x8*)(As + mt * 16 * 128 + sw);
#pragma unroll
      for (int nt = 0; nt < NTW; ++nt) bfr[nt] = *(const bf16x8*)(Bs + nt * 16 * 128 + sw);
#pragma unroll
      for (int mt = 0; mt < 4; ++mt)
#pragma unroll
        for (int nt = 0; nt < NTW; ++nt)
          acc[mt][nt] = __builtin_amdgcn_mfma_f32_16x16x32_bf16(af[mt], bfr[nt], acc[mt][nt], 0, 0, 0);
    }
  };
  const int nk = K >> 6;
  __syncthreads();
  GLOAD(R0, 0);
  SSTORE(R0, 0);
  if constexpr (DEEP) {
    GLOAD(R0, 64);
    if (nk > 2) GLOAD(R1, 128);
    lds_barrier();
    bf16x8 fa0[4], fb0[NTW], fa1[4], fb1[NTW];
    auto READF = [&](bf16x8 (&fa)[4], bf16x8 (&fb)[NTW], int st, int kk) {
      const int sw = ((kk * 4 + g) ^ (r16 & 7)) << 4;
      const char* As = smem + st * STAGE + (wm * 64 + r16) * 128 + sw;
      const char* Bs = smem + st * STAGE + A_BYTES + (wn * (NTW * 16) + r16) * 128 + sw;
#pragma unroll
      for (int mt = 0; mt < 4; ++mt) fa[mt] = *(const bf16x8*)(As + mt * 16 * 128);
#pragma unroll
      for (int nt = 0; nt < NTW; ++nt) fb[nt] = *(const bf16x8*)(Bs + nt * 16 * 128);
    };
    auto MMA = [&](const bf16x8 (&fa)[4], const bf16x8 (&fb)[NTW]) {
#pragma unroll
      for (int mt = 0; mt < 4; ++mt)
#pragma unroll
        for (int nt = 0; nt < NTW; ++nt)
          acc[mt][nt] = __builtin_amdgcn_mfma_f32_16x16x32_bf16(fa[mt], fb[nt], acc[mt][nt], 0, 0, 0);
    };
    READF(fa0, fb0, 0, 0);
    for (int kt = 0; kt < nk; kt += 2) {
      READF(fa1, fb1, 0, 1);
      MMA(fa0, fb0);
#pragma unroll
      for (int i = 0; i < 4 + NTW; ++i) { __builtin_amdgcn_sched_group_barrier(0x100, 1, 0); __builtin_amdgcn_sched_group_barrier(0x008, 2, 0); }
      __builtin_amdgcn_sched_barrier(0);
      SSTORE(R0, 1);
      if (kt + 3 < nk) GLOAD(R0, (kt + 3) * 64);
      MMA(fa1, fb1);
#pragma unroll
      for (int i = 0; i < 6; ++i) { __builtin_amdgcn_sched_group_barrier(0x200, 1, 0); __builtin_amdgcn_sched_group_barrier(0x020, 1, 0); __builtin_amdgcn_sched_group_barrier(0x008, 2, 0); }
      __builtin_amdgcn_sched_barrier(0);
      lds_barrier();
      READF(fa0, fb0, 1, 0);
      READF(fa1, fb1, 1, 1);
      MMA(fa0, fb0);
#pragma unroll
      for (int i = 0; i < 4 + NTW; ++i) { __builtin_amdgcn_sched_group_barrier(0x100, 1, 0); __builtin_amdgcn_sched_group_barrier(0x008, 2, 0); }
      __builtin_amdgcn_sched_barrier(0);
      if (kt + 2 < nk) SSTORE(R1, 0);
      if (kt + 4 < nk) GLOAD(R1, (kt + 4) * 64);
      MMA(fa1, fb1);
#pragma unroll
      for (int i = 0; i < 6; ++i) { __builtin_amdgcn_sched_group_barrier(0x200, 1, 0); __builtin_amdgcn_sched_group_barrier(0x020, 1, 0); __builtin_amdgcn_sched_group_barrier(0x008, 2, 0); }
      __builtin_amdgcn_sched_barrier(0);
      lds_barrier();
      if (kt + 2 < nk) READF(fa0, fb0, 0, 0);
    }
  } else {
    lds_barrier();
    for (int kt = 0; kt < nk; ++kt) {
      const int st = kt & 1;
      if (kt + 1 < nk) GLOAD(R0, (kt + 1) * 64);
      __builtin_amdgcn_sched_barrier(0);
      COMPUTE(st);
      __builtin_amdgcn_sched_barrier(0);
      if (kt + 1 < nk) SSTORE(R0, st ^ 1);
      lds_barrier();
    }
  }
}

#define GLDS16(gp, lp) __builtin_amdgcn_global_load_lds((const unsigned*)(gp), (unsigned*)(lp), 16, 0, 0)
template <class RowFn>
DI void gemm_glds(f32x4 (&acc)[4][4], const bf16_t* __restrict__ A, int lda, RowFn rowfn,
                  const bf16_t* __restrict__ Bt, int ldb, int K, char* smem, const bf16_t* zrow) {
  constexpr int A_BYTES = 256 * 128, STAGE = A_BYTES + 128 * 128;
  const int tid = my_tid(), lane = tid & 63, wid = tid >> 6, wm = wid >> 1, wn = wid & 1, g = lane >> 4, r16 = lane & 15;
  const int lrow = tid >> 3, c = (tid & 7) ^ (lrow & 7);
  const long a0 = rowfn(lrow), a1 = rowfn(lrow + 64), a2 = rowfn(lrow + 128), a3 = rowfn(lrow + 192);
  const bf16_t* pa0 = (a0 >= 0 ? A + a0 * lda : zrow) + c * 8; const int m0 = a0 >= 0 ? 1 : 0;
  const bf16_t* pa1 = (a1 >= 0 ? A + a1 * lda : zrow) + c * 8; const int m1 = a1 >= 0 ? 1 : 0;
  const bf16_t* pa2 = (a2 >= 0 ? A + a2 * lda : zrow) + c * 8; const int m2 = a2 >= 0 ? 1 : 0;
  const bf16_t* pa3 = (a3 >= 0 ? A + a3 * lda : zrow) + c * 8; const int m3 = a3 >= 0 ? 1 : 0;
  const bf16_t* pb0 = Bt + (long)lrow * ldb + c * 8; const bf16_t* pb1 = pb0 + (long)64 * ldb;
  auto ISSUE = [&](int kt, int bi) {
    char* d = smem + bi * STAGE + tid * 16;
    const int k0 = kt * 64;
    GLDS16(pa0 + k0 * m0, d); GLDS16(pa1 + k0 * m1, d + 8192); GLDS16(pa2 + k0 * m2, d + 16384); GLDS16(pa3 + k0 * m3, d + 24576);
    GLDS16(pb0 + k0, d + A_BYTES); GLDS16(pb1 + k0, d + A_BYTES + 8192);
  };
  auto COMPUTE = [&](int bi) {
    const char* As = smem + bi * STAGE + (wm * 64 + r16) * 128;
    const char* Bs = smem + bi * STAGE + A_BYTES + (wn * 64 + r16) * 128;
#pragma unroll
    for (int kk = 0; kk < 2; ++kk) {
      const int sw = ((kk * 4 + g) ^ (r16 & 7)) << 4;
      bf16x8 af[4], bfr[4];
#pragma unroll
      for (int mt = 0; mt < 4; ++mt) af[mt] = *(const bf16x8*)(As + mt * 16 * 128 + sw);
#pragma unroll
      for (int nt = 0; nt < 4; ++nt) bfr[nt] = *(const bf16x8*)(Bs + nt * 16 * 128 + sw);
#pragma unroll
      for (int mt = 0; mt < 4; ++mt)
#pragma unroll
        for (int nt = 0; nt < 4; ++nt)
          acc[mt][nt] = __builtin_amdgcn_mfma_f32_16x16x32_bf16(af[mt], bfr[nt], acc[mt][nt], 0, 0, 0);
    }
  };
  const int nk = K >> 6;
  __syncthreads();
  ISSUE(0, 0);
  ISSUE(1, 1);
  asm volatile("s_waitcnt vmcnt(6)" ::: "memory");
  __builtin_amdgcn_s_barrier();
  asm volatile("" ::: "memory");
  int bi = 0;
  for (int kt = 0; kt < nk; ++kt) {
    const int b2 = bi >= 1 ? bi - 1 : 2;
    if (kt + 2 < nk) ISSUE(kt + 2, b2);
    COMPUTE(bi);
    if (kt + 2 < nk) asm volatile("s_waitcnt vmcnt(6)" ::: "memory");
    else asm volatile("s_waitcnt vmcnt(0)" ::: "memory");
    asm volatile("s_waitcnt lgkmcnt(0)" ::: "memory");
    __builtin_amdgcn_s_barrier();
    asm volatile("" ::: "memory");
    bi = bi == 2 ? 0 : bi + 1;
  }
}

DI void gemm_glds256(f32x4 (&acc)[8][4], const bf16_t* __restrict__ A, int lda, long arow0,
                     const bf16_t* __restrict__ Bt, int ldb, int K, char* smem) {
  constexpr int A_BYTES = 256 * 128, STAGE = 2 * A_BYTES;
  const int tid = my_tid(), lane = tid & 63, wid = tid >> 6, wm = wid >> 2, wn = wid & 3, g = lane >> 4, r16 = lane & 15;
  const int lrow = tid >> 3, c = (tid & 7) ^ (lrow & 7);
  const bf16_t* pa = A + (arow0 + lrow) * (long)lda + c * 8;
  const bf16_t* pb = Bt + (long)lrow * ldb + c * 8;
  const long a64 = (long)64 * lda, b64 = (long)64 * ldb;
  auto ISSUE = [&](int kt, int bi) {
    char* d = smem + bi * STAGE + tid * 16;
    const int k0 = kt * 64;
    GLDS16(pa + k0, d); GLDS16(pa + a64 + k0, d + 8192); GLDS16(pa + 2 * a64 + k0, d + 16384); GLDS16(pa + 3 * a64 + k0, d + 24576);
    GLDS16(pb + k0, d + A_BYTES); GLDS16(pb + b64 + k0, d + A_BYTES + 8192); GLDS16(pb + 2 * b64 + k0, d + A_BYTES + 16384); GLDS16(pb + 3 * b64 + k0, d + A_BYTES + 24576);
  };
  auto COMPUTE = [&](int bi) {
    const char* As = smem + bi * STAGE + (wm * 128 + r16) * 128;
    const char* Bs = smem + bi * STAGE + A_BYTES + (wn * 64 + r16) * 128;
#pragma unroll
    for (int kk = 0; kk < 2; ++kk) {
      const int sw = ((kk * 4 + g) ^ (r16 & 7)) << 4;
      bf16x8 bfr[4];
#pragma unroll
      for (int nt = 0; nt < 4; ++nt) bfr[nt] = *(const bf16x8*)(Bs + nt * 16 * 128 + sw);
#pragma unroll
      for (int mt = 0; mt < 8; ++mt) {
        const bf16x8 af = *(const bf16x8*)(As + mt * 16 * 128 + sw);
#pragma unroll
        for (int nt = 0; nt < 4; ++nt)
          acc[mt][nt] = __builtin_amdgcn_mfma_f32_16x16x32_bf16(af, bfr[nt], acc[mt][nt], 0, 0, 0);
      }
    }
  };
  const int nk = K >> 6;
  __syncthreads();
  ISSUE(0, 0);
  asm volatile("s_waitcnt vmcnt(0)" ::: "memory");
  __builtin_amdgcn_s_barrier();
  asm volatile("" ::: "memory");
  int bi = 0;
  for (int kt = 0; kt < nk; ++kt) {
    if (kt + 1 < nk) ISSUE(kt + 1, bi ^ 1);
    COMPUTE(bi);
    asm volatile("s_waitcnt vmcnt(0)" ::: "memory");
    asm volatile("s_waitcnt lgkmcnt(0)" ::: "memory");
    __builtin_amdgcn_s_barrier();
    asm volatile("" ::: "memory");
    bi ^= 1;
  }
}
DI void zero_acc256(f32x4 (&acc)[8][4]) {
#pragma unroll
  for (int i = 0; i < 8; ++i)
#pragma unroll
    for (int j = 0; j < 4; ++j) acc[i][j] = (f32x4){0.f, 0.f, 0.f, 0.f};
}

DI bool next_tile(int i, int MTILES, int NTILES, int& mt, int& nt) {
  const int xcd = blockIdx.x & 7, slot = blockIdx.x >> 3, nslot = gridDim.x >> 3;
  const int m_lo = (MTILES * xcd) >> 3, m_hi = (MTILES * (xcd + 1)) >> 3, Mloc = m_hi - m_lo;
  const int q = i * nslot + slot;
  if (q >= Mloc * NTILES) return false;
  const int gidx = q / (4 * NTILES), m0 = gidx * 4;
  const int rows = (Mloc - m0) < 4 ? (Mloc - m0) : 4;
  const int within = q - gidx * 4 * NTILES;
  nt = within / rows; mt = m_lo + m0 + within % rows;
  return true;
}

struct RowPlain { long base; DI long operator()(int r) const { return base + r; } };
struct RowHalo { long rowbase; int t0; int len; DI long operator()(int r) const { int t = t0 + r; return (t >= 0 && t < len) ? rowbase + t : -1; } };

template <int NTW> DI void zero_acc(f32x4 (&acc)[4][NTW]) {
#pragma unroll
  for (int i = 0; i < 4; ++i)
#pragma unroll
    for (int j = 0; j < NTW; ++j) acc[i][j] = (f32x4){0.f, 0.f, 0.f, 0.f};
}

DI void cvt_unit(const float* __restrict__ src, int ldsrc, int srccol0, int k0, bf16_t* __restrict__ dst, int K, int n0, char* smem, bool perm = true) {
  float* T = (float*)smem;
  const int tid = my_tid();
  __syncthreads();
  if (srccol0 >= 0) {
#pragma unroll
    for (int i = 0; i < 8; ++i) {
      int idx = tid + i * 512; int k = idx >> 6, n = idx & 63;
      T[k * 65 + n] = src[(long)(k0 + k) * ldsrc + srccol0 + n];
    }
  }
  __syncthreads();
  int nd = tid >> 3, kc = (tid & 7) * 8; int n = perm ? ((nd & 15) * 4 + (nd >> 4)) : nd;
  uint4 o = make_uint4(0, 0, 0, 0);
  if (srccol0 >= 0) {
    o.x = pack2(T[(kc + 0) * 65 + n], T[(kc + 1) * 65 + n]);
    o.y = pack2(T[(kc + 2) * 65 + n], T[(kc + 3) * 65 + n]);
    o.z = pack2(T[(kc + 4) * 65 + n], T[(kc + 5) * 65 + n]);
    o.w = pack2(T[(kc + 6) * 65 + n], T[(kc + 7) * 65 + n]);
  }
  *(uint4*)(dst + (long)(n0 + nd) * K + k0 + kc) = o;
}

DI void ph_convert(const Params& p, int l, char* smem) {
  for (int u = blockIdx.x; u < 4508; u += gridDim.x) {
    if (u < 832) {
      int gI = u >> 4, kt = u & 15; int n0 = gI * 64; int sc;
      if (n0 < 1280) sc = n0; else if (n0 < 2048) sc = 2496 + (n0 - 1280); else if (n0 < 3264) sc = 1280 + (n0 - 2048); else sc = -1;
      cvt_unit(p.in[6] + (size_t)l * 1024 * 7360, 7360, sc, kt * 64, (bf16_t*)(p.ws + WB_IN), 1024, n0, smem);
    } else if (u < 1856) {
      int v = u - 832; int gI = v >> 4, kt = v & 15;
      cvt_unit(p.in[6] + (size_t)l * 1024 * 7360, 7360, 3264 + gI * 64, kt * 64, (bf16_t*)(p.ws + WB_GATE), 1024, gI * 64, smem);
    } else if (u < 2112) {
      int v = u - 1856; int gI = v >> 2, kt = v & 3; int j = gI >> 4, gg = gI & 15;
      cvt_unit(p.in[33] + ((size_t)l * 4 + j) * 256 * 1024, 1024, gg * 64, kt * 64, (bf16_t*)(p.ws + WB_BR) + (size_t)j * 1024 * 256, 256, gg * 64, smem);
    } else if (u < 2368) {
      int v = u - 2112; int gI = v >> 4, kt = v & 15;
      cvt_unit(p.in[34] + (size_t)l * 1024 * 1024, 1024, gI * 64, kt * 64, (bf16_t*)(p.ws + WB_OUT), 1024, gI * 64, smem);
    } else if (u < 3776) {
      int v = u - 2368; int gI = v >> 4, kt = v & 15; int nt = gI >> 2, q = gI & 3;
      cvt_unit(p.in[37] + (size_t)l * 1024 * 5632, 5632, (q >> 1) * 2816 + nt * 128 + (q & 1) * 64, kt * 64, (bf16_t*)(p.ws + WB_UP), 1024, gI * 64, smem);
    } else if (u < 4480) {
      int v = u - 3776; int gI = v / 44, kt = v % 44;
      cvt_unit(p.in[40] + (size_t)l * 2816 * 1024, 1024, gI * 64, kt * 64, (bf16_t*)(p.ws + WB_DOWN), 2816, gI * 64, smem);
    } else {
      int v = u - 4480;
      if (v < 4) cvt_unit(p.in[19] + (size_t)l * 2 * 64 * 256, 256, v * 64, 0, (bf16_t*)(p.ws + RWW_F), 64, v * 64, smem, false);
      else if (v < 8) cvt_unit(p.in[19] + (size_t)l * 2 * 64 * 256 + 64 * 256, 256, (v - 4) * 64, 0, (bf16_t*)(p.ws + RWW_B), 64, (v - 4) * 64, smem, false);
      else if (v < 12) cvt_unit(p.in[21] + (size_t)l * 64 * 256, 256, (v - 8) * 64, 0, (bf16_t*)(p.ws + RWW_A), 64, (v - 8) * 64, smem, false);
      else if (v < 20) { int w = v - 12; cvt_unit(p.in[22] + (size_t)l * 2 * 128 * 256, 256, (w >> 1) * 64, (w & 1) * 64, (bf16_t*)(p.ws + RWW_GF), 128, (w >> 1) * 64, smem, false); }
      else { int w = v - 20; cvt_unit(p.in[22] + (size_t)l * 2 * 128 * 256 + 128 * 256, 256, (w >> 1) * 64, (w & 1) * 64, (bf16_t*)(p.ws + RWW_GB), 128, (w >> 1) * 64, smem, false); }
    }
  }
}

DI void ph_ada(const Params& p, char* smem) {
  float* S = (float*)smem;
  float* R = S + 9 * 1024;
  const int tid = my_tid();
  bool loaded = false;
  for (int u = blockIdx.x; u < 192; u += gridDim.x) {
    if (!loaded) {
      __syncthreads();
      for (int i = tid; i < 9 * 1024; i += NTHR) { float c = i < 8192 ? p.in[1][i] : p.in[3][i - 8192]; S[i] = siluf_(c); }
      loaded = true;
    }
    __syncthreads();
    int l = u / 96, n0 = (u % 96) * 64;
    int col = tid & 63, ks = tid >> 6;
    const float* W = p.in[4] + (size_t)l * 1024 * 6144 + n0 + col;
    float a[9];
#pragma unroll
    for (int b = 0; b < 9; ++b) a[b] = 0.f;
    for (int k = ks * 128; k < ks * 128 + 128; ++k) {
      float w = W[(size_t)k * 6144];
#pragma unroll
      for (int b = 0; b < 9; ++b) a[b] += S[b * 1024 + k] * w;
    }
#pragma unroll
    for (int b = 0; b < 9; ++b) R[(ks * 9 + b) * 64 + col] = a[b];
    __syncthreads();
    for (int i = tid; i < 9 * 64; i += NTHR) {
      int b = i >> 6, c = i & 63; float s = 0.f;
#pragma unroll
      for (int k2 = 0; k2 < 8; ++k2) s += R[(k2 * 9 + b) * 64 + c];
      s += p.in[5][(size_t)l * 6144 + n0 + c];
      ((float*)(p.ws + MISC_MOD))[((size_t)l * 9 + b) * 6144 + n0 + c] = s;
    }
  }
  for (int i = blockIdx.x * NTHR + tid; i < 4096; i += gridDim.x * NTHR) {
    float s, c; sincospif(-(float)i / 4096.f, &s, &c);
    ((float2*)(p.ws + MISC_TW))[i] = make_float2(c, s);
  }
}

DI void hy_rawfilter(const Params& p, int l, int Lf, float* __restrict__ dst, char* smem) {
  float* W1 = (float*)smem;
  float* W2 = W1 + 33 * 64;
  float* Z = W2 + 64 * 64;
  float* H1 = Z + 16 * 36;
  float* H2 = H1 + 16 * 64;
  const int tid = my_tid();
  const float* w1 = p.in[9] + (size_t)l * 33 * 64; const float* b1 = p.in[10] + l * 64;
  const float* w2 = p.in[11] + (size_t)l * 64 * 64; const float* b2 = p.in[12] + l * 64;
  const float* w3 = p.in[13] + (size_t)l * 64 * 1024; const float* fr = p.in[14] + l * 64;
  const int nunits = Lf / 16;
  bool loaded = false;
  for (int u = blockIdx.x; u < nunits; u += gridDim.x) {
    __syncthreads();
    if (!loaded) {
      for (int i = tid; i < 33 * 64; i += NTHR) W1[i] = w1[i];
      for (int i = tid; i < 64 * 64; i += NTHR) W2[i] = w2[i];
      loaded = true;
    }
    const int t0 = u * 16;
    for (int i = tid; i < 16 * 33; i += NTHR) {
      int tt = i / 33, f = i % 33; int t = t0 + tt; float v;
      if (f == 0) v = (float)t / (float)(Lf - 1);
      else {
        int bi = (f - 1) & 15;
        float wv = 6.283185307179586f * (float)t / (float)Lf;
        float fb = 1e-4f + (15.f - 1e-4f) * (float)bi / 15.f;
        float ang = wv * fb;
        v = (f <= 16) ? cosf(ang) : -sinf(ang);
      }
      Z[tt * 36 + f] = v;
    }
    __syncthreads();
    for (int i = tid; i < 16 * 64; i += NTHR) {
      int tt = i >> 6, f = i & 63; float s = b1[f];
      for (int k = 0; k < 33; ++k) s += Z[tt * 36 + k] * W1[k * 64 + f];
      H1[tt * 64 + f] = sinf(fr[f] * s);
    }
    __syncthreads();
    for (int i = tid; i < 16 * 64; i += NTHR) {
      int tt = i >> 6, f = i & 63; float s = b2[f];
      for (int k = 0; k < 64; ++k) s += H1[tt * 64 + k] * W2[k * 64 + f];
      H2[tt * 64 + f] = sinf(fr[f] * s);
    }
    __syncthreads();
    float a0[16], a1[16];
#pragma unroll
    for (int i = 0; i < 16; ++i) { a0[i] = 0.f; a1[i] = 0.f; }
    for (int k = 0; k < 64; ++k) {
      float wa = w3[k * 1024 + tid], wb = w3[k * 1024 + 512 + tid];
#pragma unroll
      for (int i = 0; i < 16; ++i) { float h = H2[i * 64 + k]; a0[i] += h * wa; a1[i] += h * wb; }
    }
    {
      int w = tid & 255;
      float delta = fabsf(-3.0701134573253944f + (-15.350567286626972f + 3.0701134573253944f) * (float)w / 255.f);
#pragma unroll
      for (int i = 0; i < 16; ++i) {
        float tn = (float)(t0 + i) / (float)(Lf - 1);
        float dec = expf(-tn * delta);
        dst[(size_t)(t0 + i) * 1024 + tid] = a0[i] * dec;
        dst[(size_t)(t0 + i) * 1024 + 512 + tid] = a1[i] * dec;
      }
    }
  }
}

DI float2 cmul(float2 a, float2 b) { return make_float2(a.x * b.x - a.y * b.y, a.x * b.y + a.y * b.x); }
DI float2 cmulc(float2 a, float2 b) { return make_float2(a.x * b.x + a.y * b.y, a.y * b.x - a.x * b.y); }
DI void fft_dif(float2* X, const float2* W) {
  const int tid = my_tid();
  for (int ls = 12; ls >= 0; --ls) {
    const int span = 1 << ls;
    __syncthreads();
#pragma unroll
    for (int i = 0; i < 8; ++i) {
      int bf = tid + i * 512; int pos = bf & (span - 1); int i0 = ((bf >> ls) << (ls + 1)) + pos; int i1 = i0 + span;
      float2 a = X[i0], b = X[i1]; float2 w = W[span - 1 + pos];
      X[i0] = make_float2(a.x + b.x, a.y + b.y);
      X[i1] = cmul(make_float2(a.x - b.x, a.y - b.y), w);
    }
  }
  __syncthreads();
}
DI void fft_dit_inv(float2* X, const float2* W) {
  const int tid = my_tid();
  for (int ls = 0; ls <= 12; ++ls) {
    const int span = 1 << ls;
    __syncthreads();
#pragma unroll
    for (int i = 0; i < 8; ++i) {
      int bf = tid + i * 512; int pos = bf & (span - 1); int i0 = ((bf >> ls) << (ls + 1)) + pos; int i1 = i0 + span;
      float2 a = X[i0], b = X[i1]; float2 w = W[span - 1 + pos];
      float2 t = cmulc(b, w);
      X[i0] = make_float2(a.x + t.x, a.y + t.y);
      X[i1] = make_float2(a.x - t.x, a.y - t.y);
    }
  }
  __syncthreads();
}
DI void load_twiddles(const Params& p, float2* W) {
  const float2* tw = (const float2*)(p.ws + MISC_TW);
  for (int i = my_tid(); i < 8191; i += NTHR) {
    const int ls = 31 - __clz(i + 1); const int pos = i + 1 - (1 << ls);
    W[i] = tw[pos << (12 - ls)];
  }
}

DI void ph_kf(const Params& p, int l, char* smem) {
  float2* X = (float2*)smem; float2* W = X + 8192; float* red = (float*)(W + 8192);
  const int tid = my_tid(), lane = tid & 63, wid = tid >> 6;
  const float* rawf = (const float*)(p.ws + R_RAWF);
  float2* kf = (float2*)(p.ws + OFF_KF);
  bool tw = false;
  for (int u = blockIdx.x; u < 256; u += gridDim.x) {
    if (!tw) { load_twiddles(p, W); tw = true; }
    const int o = u >> 7, c = (u & 127) * 2;
    float2 fw[8], bw[8]; float sa = 0.f, sb = 0.f;
#pragma unroll
    for (int i = 0; i < 8; ++i) {
      int t = tid + i * 512;
      fw[i] = *(const float2*)(rawf + (size_t)t * 1024 + o * 512 + c);
      bw[i] = *(const float2*)(rawf + (size_t)t * 1024 + o * 512 + 256 + c);
      sa += fabsf(fw[i].x) + fabsf(bw[i].x); sb += fabsf(fw[i].y) + fabsf(bw[i].y);
    }
    sa = wave_sum(sa); sb = wave_sum(sb);
    __syncthreads();
    if (lane == 0) { red[wid * 2] = sa; red[wid * 2 + 1] = sb; }
    __syncthreads();
    float ta = 0.f, tb = 0.f;
#pragma unroll
    for (int w = 0; w < 8; ++w) { ta += red[w * 2]; tb += red[w * 2 + 1]; }
    const float ia = 1.f / ta, ib = 1.f / tb;
#pragma unroll
    for (int i = 0; i < 8; ++i) {
      int t = tid + i * 512;
      X[t] = make_float2(fw[i].x * ia, fw[i].y * ib);
      if (t >= 1) X[8192 - t] = make_float2(bw[i].x * ia, bw[i].y * ib);
      else X[4096] = make_float2(0.f, 0.f);
    }
    fft_dif(X, W);
    float2* ka = kf + (size_t)(o * 256 + c) * 8192; float2* kb = ka + 8192;
#pragma unroll 4
    for (int i = 0; i < 16; ++i) {
      int pidx = tid + i * 512;
      int k = (int)(__brev((unsigned)pidx) >> 19);
      int k2 = (8192 - k) & 8191;
      int p2 = (int)(__brev((unsigned)k2) >> 19);
      float2 c1 = X[pidx], c2 = X[p2];
      float2 A = make_float2(0.5f * (c1.x + c2.x), 0.5f * (c1.y - c2.y));
      float2 Bv = make_float2(0.5f * (c1.y + c2.y), -0.5f * (c1.x - c2.x));
      ka[pidx] = A; kb[pidx] = Bv;
    }
    __syncthreads();
  }
  if (l == 0) {
    const float* rawc = (const float*)(p.ws + MISC_RAWC);
    float* G = (float*)(p.ws + MISC_GCTX);
    for (int u = blockIdx.x * 8 + wid; u < 512; u += gridDim.x * 8) {
      int o = u >> 8, c = u & 255; float f[4], b[4]; float s = 0.f;
#pragma unroll
      for (int i = 0; i < 4; ++i) {
        int t = lane + i * 64;
        f[i] = rawc[(size_t)t * 1024 + o * 512 + c]; b[i] = rawc[(size_t)t * 1024 + o * 512 + 256 + c];
        s += fabsf(f[i]) + fabsf(b[i]);
      }
      s = wave_sum(s); float inv = 1.f / s;
#pragma unroll
      for (int i = 0; i < 4; ++i) {
        int t = lane + i * 64;
        G[(size_t)u * 512 + 256 + t] = f[i] * inv;
        if (t >= 1) G[(size_t)u * 512 + 256 - t] = b[i] * inv;
      }
      if (lane == 0) G[(size_t)u * 512] = 0.f;
    }
  }
}

DI void ph_ln(const float* __restrict__ src_lat, const float* __restrict__ src_ctx, float* dst_lat, float* dst_ctx,
              const float* __restrict__ ag, const float* __restrict__ ab, bf16_t* U, const float* __restrict__ mod, int sh_off, int nrows) {
  const int lane = my_tid() & 63, wid = my_tid() >> 6;
  const int stride = gridDim.x * 8;
  float4 nv[4];
  {
    const int row = blockIdx.x * 8 + wid;
    if (row < nrows) {
      const float* src = row < ML ? src_lat + (size_t)row * D : src_ctx + (size_t)(row - ML) * D;
#pragma unroll
      for (int i = 0; i < 4; ++i) nv[i] = *(const float4*)(src + i * 256 + lane * 4);
    }
  }
  for (int row = blockIdx.x * 8 + wid; row < nrows; row += stride) {
    float4 v[4];
#pragma unroll
    for (int i = 0; i < 4; ++i) v[i] = nv[i];
    if (row + stride < nrows) {
      const int r2 = row + stride;
      const float* src2 = r2 < ML ? src_lat + (size_t)r2 * D : src_ctx + (size_t)(r2 - ML) * D;
#pragma unroll
      for (int i = 0; i < 4; ++i) nv[i] = *(const float4*)(src2 + i * 256 + lane * 4);
    }
    float s = 0.f;
#pragma unroll
    for (int i = 0; i < 4; ++i) s += v[i].x + v[i].y + v[i].z + v[i].w;
    float mu = wave_sum(s) * (1.f / 1024.f);
    float q = 0.f;
#pragma unroll
    for (int i = 0; i < 4; ++i) { v[i].x -= mu; v[i].y -= mu; v[i].z -= mu; v[i].w -= mu; q += v[i].x * v[i].x + v[i].y * v[i].y + v[i].z * v[i].z + v[i].w * v[i].w; }
    float rs = rsqrtf(wave_sum(q) * (1.f / 1024.f) + 1e-6f);
#pragma unroll
    for (int i = 0; i < 4; ++i) { v[i].x *= rs; v[i].y *= rs; v[i].z *= rs; v[i].w *= rs; }
    if (ag) {
      float* dst = row < ML ? dst_lat + (size_t)row * D : dst_ctx + (size_t)(row - ML) * D;
#pragma unroll
      for (int i = 0; i < 4; ++i) {
        float4 gg = *(const float4*)(ag + i * 256 + lane * 4), bb = *(const float4*)(ab + i * 256 + lane * 4);
        v[i].x = v[i].x * gg.x + bb.x; v[i].y = v[i].y * gg.y + bb.y; v[i].z = v[i].z * gg.z + bb.z; v[i].w = v[i].w * gg.w + bb.w;
        *(float4*)(dst + i * 256 + lane * 4) = v[i];
      }
      if (U) {
        s = 0.f;
#pragma unroll
        for (int i = 0; i < 4; ++i) s += v[i].x + v[i].y + v[i].z + v[i].w;
        mu = wave_sum(s) * (1.f / 1024.f); q = 0.f;
#pragma unroll
        for (int i = 0; i < 4; ++i) { v[i].x -= mu; v[i].y -= mu; v[i].z -= mu; v[i].w -= mu; q += v[i].x * v[i].x + v[i].y * v[i].y + v[i].z * v[i].z + v[i].w * v[i].w; }
        rs = rsqrtf(wave_sum(q) * (1.f / 1024.f) + 1e-6f);
#pragma unroll
        for (int i = 0; i < 4; ++i) { v[i].x *= rs; v[i].y *= rs; v[i].z *= rs; v[i].w *= rs; }
      }
    }
    if (U) {
      const float* m = mod + (size_t)mod_idx(row) * 6144 + sh_off;
#pragma unroll
      for (int i = 0; i < 4; ++i) {
        float4 sh = *(const float4*)(m + i * 256 + lane * 4), sc = *(const float4*)(m + 1024 + i * 256 + lane * 4);
        uint2 o; o.x = pack2(v[i].x * (1.f + sc.x) + sh.x, v[i].y * (1.f + sc.y) + sh.y);
        o.y = pack2(v[i].z * (1.f + sc.z) + sh.z, v[i].w * (1.f + sc.w) + sh.w);
        *(uint2*)(U + (size_t)row * D + i * 256 + lane * 4) = o;
      }
    }
  }
}

DI void ph_inproj(const Params& p, char* smem) {
  const bf16_t* U = (const bf16_t*)(p.ws + R_U);
  const bf16_t* Bt = (const bf16_t*)(p.ws + WB_IN);
  const int lane = my_tid() & 63, wid = my_tid() >> 6, wm = wid >> 2, wn = wid & 3, g = lane >> 4, r16 = lane & 15;
  for (int it = 0;; ++it) {
    int mtile, ntile;
    if (!next_tile(it, 136, 13, mtile, ntile)) break;
    f32x4 acc[8][4]; zero_acc256(acc);
    gemm_glds256(acc, U, 1024, (long)mtile * 256, Bt + (size_t)ntile * 256 * 1024, 1024, 1024, smem);
    int b, key0;
    if (mtile < 128) { b = mtile >> 4; key0 = (mtile & 15) * 256; } else { b = mtile - 128; key0 = SL; }
    const int wc0 = ntile * 256 + wn * 64;
    bf16_t* tbase = nullptr; int tcols = 0, tcol0 = 0;
    if (wc0 < 768) { tbase = (bf16_t*)(p.ws + R_PHY); tcols = 768; tcol0 = wc0; }
    else if (wc0 >= 1152 && wc0 < 1280) { tbase = (bf16_t*)(p.ws + R_VTSW); tcols = 128; tcol0 = wc0 - 1152; }
    else if (wc0 >= 1792 && wc0 < 2048) { tbase = (bf16_t*)(p.ws + R_VTDF); tcols = 256; tcol0 = wc0 - 1792; }
    if (tbase) {
#pragma unroll
      for (int mt = 0; mt < 8; ++mt)
#pragma unroll
        for (int nt = 0; nt < 4; ++nt) {
          int col = tcol0 + r16 * 4 + nt;
          int key = key0 + wm * 128 + mt * 16 + g * 4;
          uint2 o; o.x = pack2(acc[mt][nt][0], acc[mt][nt][1]); o.y = pack2(acc[mt][nt][2], acc[mt][nt][3]);
          *(uint2*)(tbase + ((size_t)b * tcols + col) * KEYS + key) = o;
        }
    } else if (wc0 < 3264) {
      bf16_t* rb; int ld, c0;
      if (wc0 < 1152) { rb = (bf16_t*)(p.ws + R_PSW); ld = 384; c0 = wc0 - 768; }
      else if (wc0 < 1792) { rb = (bf16_t*)(p.ws + R_PDF); ld = 512; c0 = wc0 - 1280; }
      else { rb = (bf16_t*)(p.ws + R_PRW); ld = 1216; c0 = wc0 - 2048; }
      const int col = c0 + r16 * 4;
#pragma unroll
      for (int mt = 0; mt < 8; ++mt)
#pragma unroll
        for (int j = 0; j < 4; ++j) {
          size_t row = (size_t)mtile * 256 + wm * 128 + mt * 16 + g * 4 + j;
          uint2 o; o.x = pack2(acc[mt][0][j], acc[mt][1][j]); o.y = pack2(acc[mt][2][j], acc[mt][3][j]);
          *(uint2*)(rb + row * ld + col) = o;
        }
    }
  }
}

DI float hy_conv3(const bf16_t* __restrict__ P, int t, int len, float w0, float w1, float w2, float bias) {
  float a = t >= 1 ? bf2f(P[t - 1]) : 0.f, b = bf2f(P[t]), c = (t + 1 < len) ? bf2f(P[t + 1]) : 0.f;
  return w0 * a + w1 * b + w2 * c + bias;
}
DI void ph_hyena(const Params& p, int l, char* smem) {
  float2* X = (float2*)smem; float2* W = X + 8192;
  const int tid = my_tid();
  const bf16_t* PT = (const bf16_t*)(p.ws + R_PHY);
  const float2* kf = (const float2*)(p.ws + OFF_KF);
  const float* cw = p.in[7] + (size_t)l * 3 * 768; const float* cb = p.in[8] + (size_t)l * 768;
  const float* hb = p.in[15] + (size_t)l * 512;
  bf16_t* Y = (bf16_t*)(p.ws + R_YHY);
  bool tw = false;
  for (int u = blockIdx.x; u < 1024; u += gridDim.x) {
    if (!tw) { load_twiddles(p, W); tw = true; }
    const int bp = u >> 8, c = u & 255; const int b0 = bp * 2, b1 = b0 + 1;
    const bf16_t* P0 = PT + ((size_t)b0 * 768) * KEYS; const bf16_t* P1 = PT + ((size_t)b1 * 768) * KEYS;
    float wv0 = cw[c], wv1 = cw[768 + c], wv2 = cw[1536 + c], bv = cb[c];
    float wa0 = cw[256 + c], wa1 = cw[768 + 256 + c], wa2 = cw[1536 + 256 + c], ba = cb[256 + c];
    float wb0 = cw[512 + c], wb1 = cw[768 + 512 + c], wb2 = cw[1536 + 512 + c], bb = cb[512 + c];
    const float bias0 = hb[c], bias1 = hb[256 + c];
    float2 vv[8];
    __syncthreads();
#pragma unroll
    for (int i = 0; i < 8; ++i) {
      int t = tid + i * 512;
      vv[i].x = hy_conv3(P0 + (size_t)c * KEYS, t, SL, wv0, wv1, wv2, bv);
      vv[i].y = hy_conv3(P1 + (size_t)c * KEYS, t, SL, wv0, wv1, wv2, bv);
      X[t] = vv[i]; X[t + 4096] = make_float2(0.f, 0.f);
    }
    fft_dif(X, W);
    {
      const float2* H = kf + (size_t)c * 8192;
#pragma unroll 4
      for (int i = 0; i < 16; ++i) { int q = tid + i * 512; X[q] = cmul(X[q], H[q]); }
    }
    fft_dit_inv(X, W);
    float2 zz[8];
#pragma unroll
    for (int i = 0; i < 8; ++i) {
      int t = tid + i * 512;
      float2 y = X[t];
      float x1a = hy_conv3(P0 + (size_t)(256 + c) * KEYS, t, SL, wa0, wa1, wa2, ba);
      float x1b = hy_conv3(P1 + (size_t)(256 + c) * KEYS, t, SL, wa0, wa1, wa2, ba);
      zz[i].x = x1a * (y.x * (1.f / 8192.f) + bias0 * vv[i].x);
      zz[i].y = x1b * (y.y * (1.f / 8192.f) + bias0 * vv[i].y);
    }
    __syncthreads();
#pragma unroll
    for (int i = 0; i < 8; ++i) { int t = tid + i * 512; X[t] = zz[i]; X[t + 4096] = make_float2(0.f, 0.f); }
    fft_dif(X, W);
    {
      const float2* H = kf + (size_t)(256 + c) * 8192;
#pragma unroll 4
      for (int i = 0; i < 16; ++i) { int q = tid + i * 512; X[q] = cmul(X[q], H[q]); }
    }
    fft_dit_inv(X, W);
#pragma unroll
    for (int i = 0; i < 8; ++i) {
      int t = tid + i * 512;
      float2 y = X[t];
      float x2a = hy_conv3(P0 + (size_t)(512 + c) * KEYS, t, SL, wb0, wb1, wb2, bb);
      float x2b = hy_conv3(P1 + (size_t)(512 + c) * KEYS, t, SL, wb0, wb1, wb2, bb);
      float oa = x2a * (y.x * (1.f / 8192.f) + bias1 * zz[i].x);
      float ob = x2b * (y.y * (1.f / 8192.f) + bias1 * zz[i].y);
      Y[((size_t)b0 * SL + t) * 256 + c] = (bf16_t)f2bf(oa);
      Y[((size_t)b1 * SL + t) * 256 + c] = (bf16_t)f2bf(ob);
    }
  }
}

DI void ph_hyena_ctx(const Params& p, int l, char* smem) {
  const int tid = my_tid(), lane = tid & 63, wid = tid >> 6;
  float* Zb = (float*)smem + wid * 1024;
  float* Gb = Zb + 256;
  const bf16_t* PT = (const bf16_t*)(p.ws + R_PHY);
  const float* G = (const float*)(p.ws + MISC_GCTX);
  const float* cw = p.in[7] + (size_t)l * 3 * 768; const float* cb = p.in[8] + (size_t)l * 768;
  const float* hb = p.in[15] + (size_t)l * 512;
  bf16_t* Y = (bf16_t*)(p.ws + R_YHY);
  for (int base = blockIdx.x * 8; base < 2048; base += gridDim.x * 8) {
    const int u = base + wid; const int b = u >> 8, c = u & 255;
    const bf16_t* Pb = PT + ((size_t)b * 768) * KEYS + SL;
    float v[4], x1[4], x2[4], zz[4];
#pragma unroll
    for (int i = 0; i < 4; ++i) {
      int t = lane + i * 64;
      v[i] = hy_conv3(Pb + (size_t)c * KEYS, t, CL, cw[c], cw[768 + c], cw[1536 + c], cb[c]);
      x1[i] = hy_conv3(Pb + (size_t)(256 + c) * KEYS, t, CL, cw[256 + c], cw[768 + 256 + c], cw[1536 + 256 + c], cb[256 + c]);
      x2[i] = hy_conv3(Pb + (size_t)(512 + c) * KEYS, t, CL, cw[512 + c], cw[768 + 512 + c], cw[1536 + 512 + c], cb[512 + c]);
    }
    __syncthreads();
#pragma unroll
    for (int i = 0; i < 4; ++i) Zb[lane + i * 64] = v[i];
    for (int i = lane; i < 512; i += 64) Gb[i] = G[(size_t)c * 512 + i];
    __syncthreads();
#pragma unroll
    for (int i = 0; i < 4; ++i) {
      int t = lane + i * 64; float s = 0.f;
      for (int s2 = 0; s2 < 256; ++s2) s += Gb[256 + t - s2] * Zb[s2];
      zz[i] = x1[i] * (s + hb[c] * v[i]);
    }
    __syncthreads();
#pragma unroll
    for (int i = 0; i < 4; ++i) Zb[lane + i * 64] = zz[i];
    for (int i = lane; i < 512; i += 64) Gb[i] = G[(size_t)(256 + c) * 512 + i];
    __syncthreads();
#pragma unroll
    for (int i = 0; i < 4; ++i) {
      int t = lane + i * 64; float s = 0.f;
      for (int s2 = 0; s2 < 256; ++s2) s += Gb[256 + t - s2] * Zb[s2];
      float o = x2[i] * (s + hb[256 + c] * zz[i]);
      Y[((size_t)ML + b * CL + t) * 256 + c] = (bf16_t)f2bf(o);
    }
  }
}

DI void ph_rope(const Params& p, char* smem) {
  float2* T16 = (float2*)smem;
  float2* T8 = T16 + 64 * 16;
  const int tid = my_tid(), lane = tid & 63, wid = tid >> 6;
  __syncthreads();
  for (int i = tid; i < 64 * 16; i += NTHR) {
    int pos = i >> 4, f = i & 15; float inv = powf(10000.f, -(float)f / 16.f); float s, c; sincosf((float)pos * inv, &s, &c);
    T16[i] = make_float2(c, s);
  }
  for (int i = tid; i < 64 * 8; i += NTHR) {
    int pos = i >> 3, f = i & 7; float inv = powf(10000.f, -(float)f / 8.f); float s, c; sincosf((float)pos * inv, &s, &c);
    T8[i] = make_float2(c, s);
  }
  __syncthreads();
  bf16_t* Psw = (bf16_t*)(p.ws + R_PSW); bf16_t* Pdf = (bf16_t*)(p.ws + R_PDF);
  for (int row = blockIdx.x * 8 + wid; row < ML; row += gridDim.x * 8) {
    const int t = row & (SL - 1); const int pr = t >> 6, pc = t & 63;
    bf16_t* q = Psw + (size_t)row * 384;
#pragma unroll
    for (int i = 0; i < 3; ++i) {
      int pi = lane + i * 64; int hd = pi >> 5, pp = pi & 31; int half = pp >> 4, f = pp & 15;
      int base = hd * 64 + half * 32; float2 cs = T16[(half ? pc : pr) * 16 + f];
      float x1 = bf2f(q[base + f]), x2 = bf2f(q[base + 16 + f]);
      q[base + f] = (bf16_t)f2bf(x1 * cs.x - x2 * cs.y); q[base + 16 + f] = (bf16_t)f2bf(x1 * cs.y + x2 * cs.x);
    }
    bf16_t* d = Pdf + (size_t)row * 512;
#pragma unroll
    for (int i = 0; i < 4; ++i) {
      int pi = lane + i * 64; int gi = pi >> 4, pp = pi & 15; int half = pp >> 3, f = pp & 7;
      int base = gi * 32 + half * 16; float2 cs = T8[(half ? pc : pr) * 8 + f];
      float x1 = bf2f(d[base + f]), x2 = bf2f(d[base + 8 + f]);
      d[base + f] = (bf16_t)f2bf(x1 * cs.x - x2 * cs.y); d[base + 8 + f] = (bf16_t)f2bf(x1 * cs.y + x2 * cs.x);
    }
  }
}

DI float rw_shift(const bf16_t* __restrict__ P, int row, int t, int len, int col, float mu) {
  float c = bf2f(P[(size_t)row * 1216 + col]);
  float a = t >= 1 ? bf2f(P[(size_t)(row - 1) * 1216 + col]) : 0.f;
  float b = t + 1 < len ? bf2f(P[(size_t)(row + 1) * 1216 + col]) : 0.f;
  return c + (0.5f * (a + b) - c) * mu;
}
DI void ph_rwprep(const Params& p, int l, char* smem) {
  constexpr int AST = 912, RST = 1552, ROFF = 32 * AST;
  const int tid = my_tid(), lane = tid & 63, wid = tid >> 6, g = lane >> 4, r16 = lane & 15;
  const int tg = wid >> 2, hd = wid & 3;
  const bf16_t* P = (const bf16_t*)(p.ws + R_PRW);
  const float* mu = p.in[17] + (size_t)l * 1216;
  const float* w0 = p.in[18] + (size_t)l * 512; const float* a0 = p.in[20] + (size_t)l * 256;
  const float* kkw = p.in[23] + (size_t)l * 256; const float* kaw = p.in[24] + (size_t)l * 256;
  bf16_t* S = (bf16_t*)(p.ws + R_STR); bf16_t* Gs = (bf16_t*)(p.ws + R_G);
  const size_t SU = (size_t)MT * 256;
  float w0f[4], w0b[4], a0c[4], kkc[4], kac[4];
#pragma unroll
  for (int nt = 0; nt < 4; ++nt) { int c = hd * 64 + nt * 16 + r16; w0f[nt] = w0[c]; w0b[nt] = w0[256 + c]; a0c[nt] = a0[c]; kkc[nt] = kkw[c]; kac[nt] = kaw[c]; }
  for (int u = blockIdx.x; u < MT / 32; u += gridDim.x) {
    const int row0 = u * 32; int t0, len;
    if (row0 < ML) { t0 = row0 & (SL - 1); len = SL; } else { t0 = (row0 - ML) & (CL - 1); len = CL; }
    __syncthreads();
    for (int item = tid; item < 32 * 152; item += NTHR) {
      const int tk = item / 152, c8 = item - tk * 152; const int row = row0 + tk, t = t0 + tk;
      const uint4 uc = *(const uint4*)(P + (size_t)row * 1216 + c8 * 8);
      uint4 ua = make_uint4(0, 0, 0, 0), ub = make_uint4(0, 0, 0, 0);
      if (t >= 1) ua = *(const uint4*)(P + (size_t)(row - 1) * 1216 + c8 * 8);
      if (t + 1 < len) ub = *(const uint4*)(P + (size_t)(row + 1) * 1216 + c8 * 8);
      const float4 m0 = *(const float4*)(mu + c8 * 8), m1 = *(const float4*)(mu + c8 * 8 + 4);
      float o[8];
      {
        const unsigned wc[4] = {uc.x, uc.y, uc.z, uc.w}, wa[4] = {ua.x, ua.y, ua.z, ua.w}, wb[4] = {ub.x, ub.y, ub.z, ub.w};
        const float mm[8] = {m0.x, m0.y, m0.z, m0.w, m1.x, m1.y, m1.z, m1.w};
#pragma unroll
        for (int i = 0; i < 4; ++i) {
          float c_lo = bflo(wc[i]), c_hi = bfhi(wc[i]);
          o[2 * i] = c_lo + (0.5f * (bflo(wa[i]) + bflo(wb[i])) - c_lo) * mm[2 * i];
          o[2 * i + 1] = c_hi + (0.5f * (bfhi(wa[i]) + bfhi(wb[i])) - c_hi) * mm[2 * i + 1];
        }
      }
      char* dst;
      if (c8 < 96) dst = smem + ROFF + tk * RST + c8 * 16;
      else {
        const int cc = c8 * 8 - 768;
        if (cc < 128) {
#pragma unroll
          for (int i = 0; i < 8; ++i) o[i] = tanhf(o[i]);
        } else if (cc >= 192) {
#pragma unroll
          for (int i = 0; i < 8; ++i) o[i] = sigmoidf_(o[i]);
        }
        dst = smem + tk * AST + cc * 2;
      }
      uint4 ov; ov.x = pack2(o[0], o[1]); ov.y = pack2(o[2], o[3]); ov.z = pack2(o[4], o[5]); ov.w = pack2(o[6], o[7]);
      *(uint4*)dst = ov;
    }
    __syncthreads();
    f32x4 acc[5][4];
#pragma unroll
    for (int o5 = 0; o5 < 5; ++o5)
#pragma unroll
      for (int nt = 0; nt < 4; ++nt) acc[o5][nt] = (f32x4){0.f, 0.f, 0.f, 0.f};
    const char* Arow = smem + (tg * 16 + r16) * AST + g * 16;
#pragma unroll
    for (int o5 = 0; o5 < 5; ++o5) {
      const int kbase = o5 < 3 ? o5 * 64 : (o5 == 3 ? 192 : 320);
      const int KK = o5 < 3 ? 64 : 128;
      const bf16_t* Wt = (const bf16_t*)(p.ws + (o5 == 0 ? RWW_F : o5 == 1 ? RWW_B : o5 == 2 ? RWW_A : o5 == 3 ? RWW_GF : RWW_GB));
#pragma unroll
      for (int ks = 0; ks < KK / 32; ++ks) {
        const bf16x8 af = *(const bf16x8*)(Arow + (kbase + ks * 32) * 2);
#pragma unroll
        for (int nt = 0; nt < 4; ++nt) {
          const bf16x8 bf = *(const bf16x8*)(Wt + (size_t)(hd * 64 + nt * 16 + r16) * KK + ks * 32 + g * 8);
          acc[o5][nt] = __builtin_amdgcn_mfma_f32_16x16x32_bf16(af, bf, acc[o5][nt], 0, 0, 0);
        }
        if (ks & 1) asm volatile("" ::: "memory");
      }
    }
#pragma unroll
    for (int j = 0; j < 4; ++j) {
      const int tk = tg * 16 + g * 4 + j; const size_t row = (size_t)row0 + tk;
      const char* rk = smem + ROFF + tk * RST;
      float kv[4], n2 = 0.f;
#pragma unroll
      for (int nt = 0; nt < 4; ++nt) { int c = hd * 64 + nt * 16 + r16; kv[nt] = bf2f(*(const unsigned short*)(rk + (256 + c) * 2)); float q = kv[nt] * kkc[nt]; n2 += q * q; }
      n2 = sum16(n2);
      const float inv = 1.f / fmaxf(sqrtf(n2), 1e-12f);
#pragma unroll
      for (int nt = 0; nt < 4; ++nt) {
        const int c = hd * 64 + nt * 16 + r16;
        const float r = bf2f(*(const unsigned short*)(rk + c * 2)), v = bf2f(*(const unsigned short*)(rk + (512 + c) * 2)), k = kv[nt];
        const float a = sigmoidf_(a0c[nt] + acc[2][nt][j]);
        const float kk = k * kkc[nt] * inv;
        const float kp = k * (1.f + (a - 1.f) * kac[nt]);
        const float bq = kk * a;
        const float xf = -(w0f[nt] + acc[0][nt][j]); const float spf = fmaxf(xf, 0.f) + log1pf(__expf(-fabsf(xf)));
        const float xb = -(w0b[nt] + acc[1][nt][j]); const float spb = fmaxf(xb, 0.f) + log1pf(__expf(-fabsf(xb)));
        const float ef = __expf(-spf - 0.5f), eb = __expf(-spb - 0.5f);
        const float d_f = -expm1f(-ef), d_b = -expm1f(-eb);
        const size_t o = row * 256 + c;
        S[o] = (bf16_t)f2bf(r); S[SU + o] = (bf16_t)f2bf(kp); S[2 * SU + o] = (bf16_t)f2bf(v); S[3 * SU + o] = (bf16_t)f2bf(kk);
        S[4 * SU + o] = (bf16_t)f2bf(bq); S[5 * SU + o] = (bf16_t)f2bf(d_f); S[6 * SU + o] = (bf16_t)f2bf(d_b);
        Gs[o] = (bf16_t)f2bf(acc[3][nt][j]); Gs[SU + o] = (bf16_t)f2bf(acc[4][nt][j]);
      }
    }
  }
}

DI long scan_row(int b, int dir, int s) {
  if (s < CL) return (long)ML + b * CL + (dir ? (CL - 1 - s) : s);
  int t = s - CL; return (long)b * SL + (dir ? (SL - 1 - t) : t);
}
DI float sum8(float v) {
  v += dpp_mov<0xB1>(v);
  v += dpp_mov<0x4E>(v);
  v += dpp_mov<0x141>(v);
  return v;
}
DI void ph_scan(const Params& p, char* smem) {
  const int tid = my_tid(), lane = tid & 63, wid = tid >> 6;
  const bf16_t* S = (const bf16_t*)(p.ws + R_STR);
  const size_t SU = (size_t)MT * 256;
  constexpr int T = 32, NSTEP = CL + SL, NCH = NSTEP / T;
  typedef float f32x2 __attribute__((ext_vector_type(2)));
  for (int u = blockIdx.x; u < 128; u += gridDim.x) {
    const int chain = u >> 1, rg = u & 1; const int dir = chain & 1, bh = chain >> 1, b = bh >> 2, h = bh & 3;
    bf16_t* O = (bf16_t*)(p.ws + (dir ? R_OB : R_OF));
    uint4 q0, q1, q2;
    auto SC_GLOAD = [&](int ci) {
#pragma unroll
      for (int j = 0; j < 3; ++j) {
        int idx = tid + j * 512; int st = idx >> 8, s = (idx & 255) >> 3, ck = idx & 7;
        long row = scan_row(b, dir, ci * T + s);
        int sid = st < 5 ? st : 5 + dir;
        uint4 v = *(const uint4*)(S + sid * SU + row * 256 + h * 64 + ck * 8);
        if (j == 0) q0 = v; else if (j == 1) q1 = v; else q2 = v;
      }
    };
    auto SC_SSTORE = [&](int buf) {
#pragma unroll
      for (int j = 0; j < 3; ++j) {
        int idx = tid + j * 512; int st = idx >> 8;
        uint4 v = j == 0 ? q0 : (j == 1 ? q1 : q2);
        float4 lo = make_float4(bflo(v.x), bfhi(v.x), bflo(v.y), bfhi(v.y));
        float4 hi = make_float4(bflo(v.z), bfhi(v.z), bflo(v.w), bfhi(v.w));
        if (st == 5) { lo.x = 1.f - lo.x; lo.y = 1.f - lo.y; lo.z = 1.f - lo.z; lo.w = 1.f - lo.w; hi.x = 1.f - hi.x; hi.y = 1.f - hi.y; hi.z = 1.f - hi.z; hi.w = 1.f - hi.w; }
        char* base = smem + buf * 49152 + idx * 32;
        *(float4*)(base) = lo; *(float4*)(base + 16) = hi;
      }
    };
    auto FLUSH = [&](int ci) {
      const int s = tid >> 4, part = tid & 15;
      unsigned v = *(const unsigned*)(smem + 98304 + (ci & 1) * 2048 + s * 64 + part * 4);
      long row = scan_row(b, dir, ci * T + s);
      *(unsigned*)(O + row * 256 + h * 64 + rg * 32 + part * 2) = v;
    };
    __syncthreads();
    SC_GLOAD(0);
    SC_SSTORE(0);
    __syncthreads();
    f32x2 st0 = {0.f, 0.f}, st1 = {0.f, 0.f}, st2 = {0.f, 0.f}, st3 = {0.f, 0.f};
    const int rsub = lane >> 3, ks = lane & 7;
    const int lrow = (wid & 3) * 8 + rsub;
    const int vrow = rg * 32 + lrow;
    struct Step { f32x2 r[4], k[4], kk[4], b[4], w[4]; float v; };
    auto LOADSTEP = [&](Step& x, const char* B, int s) {
#pragma unroll
      for (int hh = 0; hh < 2; ++hh) {
        const float4 r = *(const float4*)(B + (0 * T + s) * 256 + ks * 32 + hh * 16);
        const float4 k = *(const float4*)(B + (1 * T + s) * 256 + ks * 32 + hh * 16);
        const float4 kk = *(const float4*)(B + (3 * T + s) * 256 + ks * 32 + hh * 16);
        const float4 bb = *(const float4*)(B + (4 * T + s) * 256 + ks * 32 + hh * 16);
        const float4 w = *(const float4*)(B + (5 * T + s) * 256 + ks * 32 + hh * 16);
        x.r[2 * hh] = (f32x2){r.x, r.y}; x.r[2 * hh + 1] = (f32x2){r.z, r.w};
        x.k[2 * hh] = (f32x2){k.x, k.y}; x.k[2 * hh + 1] = (f32x2){k.z, k.w};
        x.kk[2 * hh] = (f32x2){kk.x, kk.y}; x.kk[2 * hh + 1] = (f32x2){kk.z, kk.w};
        x.b[2 * hh] = (f32x2){bb.x, bb.y}; x.b[2 * hh + 1] = (f32x2){bb.z, bb.w};
        x.w[2 * hh] = (f32x2){w.x, w.y}; x.w[2 * hh + 1] = (f32x2){w.z, w.w};
      }
      x.v = *(const float*)(B + (2 * T + s) * 256 + vrow * 4);
    };
    for (int ci = 0; ci < NCH; ++ci) {
      if (ci + 1 < NCH) { SC_GLOAD(ci + 1); }
      if (ci > 0) FLUSH(ci - 1);
      if (wid < 4) {
        const char* B = smem + (ci & 1) * 49152;
        bf16_t* ob = (bf16_t*)(smem + 98304 + (ci & 1) * 2048);
        Step nx; LOADSTEP(nx, B, 0);
#pragma unroll 2
        for (int s = 0; s < T; ++s) {
          const Step c = nx;
          LOADSTEP(nx, B, (s + 1 < T) ? s + 1 : s);
          f32x2 pa = st0 * c.kk[0] + st1 * c.kk[1];
          f32x2 pb = st2 * c.kk[2] + st3 * c.kk[3];
          pa = pa + pb;
          float sa = -(pa.x + pa.y);
          sa = sum8(sa);
          const f32x2 sa2 = {sa, sa}; const f32x2 v2 = {c.v, c.v};
          st0 = st0 * c.w[0] + sa2 * c.b[0] + v2 * c.k[0];
          st1 = st1 * c.w[1] + sa2 * c.b[1] + v2 * c.k[1];
          st2 = st2 * c.w[2] + sa2 * c.b[2] + v2 * c.k[2];
          st3 = st3 * c.w[3] + sa2 * c.b[3] + v2 * c.k[3];
          f32x2 oa = st0 * c.r[0] + st1 * c.r[1];
          f32x2 ob2 = st2 * c.r[2] + st3 * c.r[3];
          oa = oa + ob2;
          float o = sum8(oa.x + oa.y);
          if (ks == 0) ob[s * 32 + lrow] = (bf16_t)f2bf(o);
        }
      }
      if (ci + 1 < NCH) { SC_SSTORE((ci + 1) & 1); }
      __syncthreads();
    }
    FLUSH(NCH - 1);
  }
}

template <bool DIFF>
DI void attn_unit(const Params& p, int l, int b, int h, int qrow0, int qpos0, int kb_lo, int kb_hi, int kc_lo, char* smem) {
  const int tid = my_tid(), lane = tid & 63, wid = tid >> 6, g = lane >> 4, r16 = lane & 15;
  const bf16_t* QK = (const bf16_t*)(p.ws + (DIFF ? R_PDF : R_PSW));
  const int ldq = DIFF ? 512 : 384;
  const int qc0 = h * 64;
  const int kc0 = 256 + (DIFF ? h * 64 : (h >> 1) * 64);
  const bf16_t* VT = DIFF ? (const bf16_t*)(p.ws + R_VTDF) + ((size_t)b * 256 + h * 64) * KEYS
                          : (const bf16_t*)(p.ws + R_VTSW) + ((size_t)b * 128 + (h >> 1) * 64) * KEYS;
  const int nblk = (kb_hi - kb_lo) + (68 - kc_lo);
  const float sc = (DIFF ? 0.17677669529663687f : 0.125f) * 1.4426950408889634f;
  bf16x8 qf[2];
  {
    const bf16_t* qp = QK + (size_t)(qrow0 + wid * 16 + r16) * ldq + qc0 + g * 8;
    qf[0] = *(const bf16x8*)(qp); qf[1] = *(const bf16x8*)(qp + 32);
  }
  constexpr int NC = DIFF ? 2 : 1;
  float m[NC], lsum[NC];
  f32x4 O[NC][4];
#pragma unroll
  for (int c = 0; c < NC; ++c) {
    if (DIFF) { m[c] = -1e30f; lsum[c] = 0.f; }
    else { m[c] = p.in[16][l * 4 + h] * 1.4426950408889634f; lsum[c] = (g == 0) ? 1.f : 0.f; }
#pragma unroll
    for (int dt = 0; dt < 4; ++dt) O[c][dt] = (f32x4){0.f, 0.f, 0.f, 0.f};
  }
  const int lr = tid >> 3, lc = tid & 7;
  uint4 rk, rv;
#define AT_GLOAD(i)                                                                                   \
  do {                                                                                                \
    int kb = (i) < (kb_hi - kb_lo) ? kb_lo + (i) : kc_lo + ((i) - (kb_hi - kb_lo));                    \
    long krow = kb < 64 ? (long)b * SL + kb * 64 + lr : (long)ML + b * CL + (kb - 64) * 64 + lr;       \
    rk = *(const uint4*)(QK + krow * ldq + kc0 + lc * 8);                                             \
    rv = *(const uint4*)(VT + (size_t)lr * KEYS + kb * 64 + lc * 8);                                  \
  } while (0)
#define AT_SSTORE(buf)                                                                                \
  do {                                                                                                \
    *(uint4*)(smem + (buf) * 18432 + lr * 128 + ((lc ^ (lr & 7)) << 4)) = rk;                         \
    *(uint4*)(smem + (buf) * 18432 + 9216 + lr * 144 + lc * 16) = rv;                                 \
  } while (0)
  __syncthreads();
  AT_GLOAD(0);
  AT_SSTORE(0);
  __syncthreads();
  const int qpos = qpos0 + wid * 16 + r16;
  for (int i = 0; i < nblk; ++i) {
    if (i + 1 < nblk) AT_GLOAD(i + 1);
    const int kb = i < (kb_hi - kb_lo) ? kb_lo + i : kc_lo + (i - (kb_hi - kb_lo));
    const bool masked = (!DIFF) && (kb < 64);
    const char* Kt = smem + (i & 1) * 18432; const char* Vt = Kt + 9216;
    f32x4 S[NC][4];
#pragma unroll
    for (int kt = 0; kt < 4; ++kt) {
      bf16x8 k0 = *(const bf16x8*)(Kt + (kt * 16 + r16) * 128 + ((g ^ (r16 & 7)) << 4));
      bf16x8 k1 = *(const bf16x8*)(Kt + (kt * 16 + r16) * 128 + (((4 + g) ^ (r16 & 7)) << 4));
      if (DIFF) {
        S[0][kt] = __builtin_amdgcn_mfma_f32_16x16x32_bf16(k0, qf[0], (f32x4){0.f, 0.f, 0.f, 0.f}, 0, 0, 0);
        S[NC - 1][kt] = __builtin_amdgcn_mfma_f32_16x16x32_bf16(k1, qf[1], (f32x4){0.f, 0.f, 0.f, 0.f}, 0, 0, 0);
      } else {
        f32x4 t = __builtin_amdgcn_mfma_f32_16x16x32_bf16(k0, qf[0], (f32x4){0.f, 0.f, 0.f, 0.f}, 0, 0, 0);
        S[0][kt] = __builtin_amdgcn_mfma_f32_16x16x32_bf16(k1, qf[1], t, 0, 0, 0);
      }
    }
    bf16x8 pf[NC][2];
#pragma unroll
    for (int c = 0; c < NC; ++c) {
      float mx = -1e30f;
#pragma unroll
      for (int kt = 0; kt < 4; ++kt)
#pragma unroll
        for (int j = 0; j < 4; ++j) {
          float v = S[c][kt][j];
          if (masked) { int kpos = kb * 64 + kt * 16 + g * 4 + j; int dd = kpos - qpos; if (dd > 128 || dd < -128) v = -3e38f; S[c][kt][j] = v; }
          mx = fmaxf(mx, v);
        }
      mx *= sc;
      mx = fmaxf(mx, __shfl_xor(mx, 16)); mx = fmaxf(mx, __shfl_xor(mx, 32));
      const float mn = fmaxf(m[c], mx);
      const bool grow = mn > m[c];
      float ps = 0.f;
      unsigned pk[8];
#pragma unroll
      for (int kt = 0; kt < 4; ++kt) {
        float e0 = __builtin_amdgcn_exp2f(fmaf(S[c][kt][0], sc, -mn)), e1 = __builtin_amdgcn_exp2f(fmaf(S[c][kt][1], sc, -mn));
        float e2 = __builtin_amdgcn_exp2f(fmaf(S[c][kt][2], sc, -mn)), e3 = __builtin_amdgcn_exp2f(fmaf(S[c][kt][3], sc, -mn));
        ps += (e0 + e1) + (e2 + e3);
        pk[kt * 2] = pack2(e0, e1); pk[kt * 2 + 1] = pack2(e2, e3);
      }
      if (__builtin_amdgcn_ballot_w64(grow) != 0ull) {
        const float alpha = __builtin_amdgcn_exp2f(m[c] - mn);
        m[c] = mn;
        lsum[c] *= alpha;
#pragma unroll
        for (int dt = 0; dt < 4; ++dt) { O[c][dt][0] *= alpha; O[c][dt][1] *= alpha; O[c][dt][2] *= alpha; O[c][dt][3] *= alpha; }
      }
      lsum[c] += ps;
      union { unsigned u[4]; bf16x8 v; } cv;
      cv.u[0] = pk[0]; cv.u[1] = pk[1]; cv.u[2] = pk[2]; cv.u[3] = pk[3]; pf[c][0] = cv.v;
      cv.u[0] = pk[4]; cv.u[1] = pk[5]; cv.u[2] = pk[6]; cv.u[3] = pk[7]; pf[c][1] = cv.v;
    }
#pragma unroll
    for (int dt = 0; dt < 4; ++dt)
#pragma unroll
      for (int s2 = 0; s2 < 2; ++s2) {
        union { uint2 u[2]; bf16x8 v; } vf;
        vf.u[0] = *(const uint2*)(Vt + (dt * 16 + r16) * 144 + (2 * s2) * 32 + g * 8);
        vf.u[1] = *(const uint2*)(Vt + (dt * 16 + r16) * 144 + (2 * s2 + 1) * 32 + g * 8);
#pragma unroll
        for (int c = 0; c < NC; ++c) O[c][dt] = __builtin_amdgcn_mfma_f32_16x16x32_bf16(vf.v, pf[c][s2], O[c][dt], 0, 0, 0);
      }
    if (i + 1 < nblk) AT_SSTORE((i + 1) & 1);
    __syncthreads();
  }
#undef AT_GLOAD
#undef AT_SSTORE
  float linv[NC];
#pragma unroll
  for (int c = 0; c < NC; ++c) { float t = lsum[c]; t += __shfl_xor(t, 16); t += __shfl_xor(t, 32); linv[c] = 1.f / t; }
  const size_t orow = (size_t)(qrow0 + wid * 16 + r16);
  if (!DIFF) {
    bf16_t* Y = (bf16_t*)(p.ws + R_YSW);
#pragma unroll
    for (int dt = 0; dt < 4; ++dt) {
      uint2 o; o.x = pack2(O[0][dt][0] * linv[0], O[0][dt][1] * linv[0]); o.y = pack2(O[0][dt][2] * linv[0], O[0][dt][3] * linv[0]);
      *(uint2*)(Y + orow * 256 + h * 64 + dt * 16 + g * 4) = o;
    }
  } else {
    const float lam_init = 0.8f - 0.6f * __expf(-0.3f * (float)l);
    float d1 = 0.f, d2 = 0.f;
    if (lane < 32) { d1 = p.in[28][l * 32 + lane] * p.in[29][l * 32 + lane]; d2 = p.in[30][l * 32 + lane] * p.in[31][l * 32 + lane]; }
    d1 = wave_sum(d1); d2 = wave_sum(d2);
    const float lam = expf(d1) - expf(d2) + lam_init;
    float ov[4][4]; float ss = 0.f;
#pragma unroll
    for (int dt = 0; dt < 4; ++dt)
#pragma unroll
      for (int j = 0; j < 4; ++j) { float v = O[0][dt][j] * linv[0] - lam * O[NC - 1][dt][j] * linv[NC - 1]; ov[dt][j] = v; ss += v * v; }
    ss += __shfl_xor(ss, 16); ss += __shfl_xor(ss, 32);
    const float rms = rsqrtf(ss * (1.f / 64.f) + 1e-5f) * (1.f - lam_init);
    const float* sg = p.in[32] + l * 64;
    bf16_t* Y = (bf16_t*)(p.ws + R_YDF);
#pragma unroll
    for (int dt = 0; dt < 4; ++dt) {
      const int d0 = dt * 16 + g * 4;
      uint2 o; o.x = pack2(ov[dt][0] * rms * sg[d0], ov[dt][1] * rms * sg[d0 + 1]); o.y = pack2(ov[dt][2] * rms * sg[d0 + 2], ov[dt][3] * rms * sg[d0 + 3]);
      *(uint2*)(Y + orow * 256 + h * 64 + d0) = o;
    }
  }
}

DI void ph_attn(const Params& p, int l, char* smem) {
  const bool need_ctx = (l == 0);
  const int n_sw = 1024 + (need_ctx ? 64 : 0);
  const int n_df = 1024 + (need_ctx ? 64 : 0);
  unsigned* ctr = (unsigned*)(p.ws + MISC_BAR + 64 + 64 * l);
  volatile int* slot = (volatile int*)(smem + 40960);
  for (;;) {
    __syncthreads();
    if (my_tid() == 0) *slot = (int)__hip_atomic_fetch_add(ctr, 1u, __ATOMIC_RELAXED, __HIP_MEMORY_SCOPE_AGENT);
    __syncthreads();
    const int u = *slot;
    if (u >= n_sw + n_df) break;
    if (u < n_df) {
      if (u < 1024) { int b = u >> 7, h = (u >> 5) & 3, n = u & 31; attn_unit<true>(p, l, b, h, b * SL + n * 128, n * 128, 0, 64, 64, smem); }
      else { int v = u - 1024; int b = v >> 3, h = (v >> 1) & 3, n = v & 1; attn_unit<true>(p, l, b, h, ML + b * CL + n * 128, 0, 0, 0, 64, smem); }
    } else {
      int w = u - n_df;
      if (w < 1024) {
        int b = w >> 7, h = (w >> 5) & 3, n = w & 31;
        int lo = (n - 1) * 2; if (lo < 0) lo = 0; int hi = (n + 2) * 2; if (hi > 64) hi = 64;
        attn_unit<false>(p, l, b, h, b * SL + n * 128, n * 128, lo, hi, 64, smem);
      } else { int v = w - 1024; int b = v >> 3, h = (v >> 1) & 3, n = v & 1; attn_unit<false>(p, l, b, h, ML + b * CL + n * 128, 0, 0, 0, 64, smem); }
    }
  }
}

DI void ph_rwout(const Params& p, int l) {
  const int lane = my_tid() & 63, wid = my_tid() >> 6;
  const bf16_t* S = (const bf16_t*)(p.ws + R_STR); const bf16_t* Gs = (const bf16_t*)(p.ws + R_G);
  const bf16_t* OF = (const bf16_t*)(p.ws + R_OF); const bf16_t* OB = (const bf16_t*)(p.ws + R_OB);
  bf16_t* Y = (bf16_t*)(p.ws + R_YRW);
  const size_t SU = (size_t)MT * 256;
  const float4 rk = *(const float4*)(p.in[25] + (size_t)l * 256 + lane * 4);
  const float4 gam = *(const float4*)(p.in[26] + (size_t)l * 256 + lane * 4);
  const float4 bet = *(const float4*)(p.in[27] + (size_t)l * 256 + lane * 4);
  const int nrows = (l == 0) ? MT : ML;
  for (int row = blockIdx.x * 8 + wid; row < nrows; row += gridDim.x * 8) {
    const size_t o = (size_t)row * 256 + lane * 4;
    uint2 ur = *(const uint2*)(S + o), uk = *(const uint2*)(S + SU + o), uv = *(const uint2*)(S + 2 * SU + o);
    uint2 uf = *(const uint2*)(OF + o), ub = *(const uint2*)(OB + o), ugf = *(const uint2*)(Gs + o), ugb = *(const uint2*)(Gs + SU + o);
    float r[4] = {bflo(ur.x), bfhi(ur.x), bflo(ur.y), bfhi(ur.y)};
    float k[4] = {bflo(uk.x), bfhi(uk.x), bflo(uk.y), bfhi(uk.y)};
    float v[4] = {bflo(uv.x), bfhi(uv.x), bflo(uv.y), bfhi(uv.y)};
    float f[4] = {bflo(uf.x), bfhi(uf.x), bflo(uf.y), bfhi(uf.y)};
    float bb[4] = {bflo(ub.x), bfhi(ub.x), bflo(ub.y), bfhi(ub.y)};
    float gf[4] = {bflo(ugf.x), bfhi(ugf.x), bflo(ugf.y), bfhi(ugf.y)};
    float gb[4] = {bflo(ugb.x), bfhi(ugb.x), bflo(ugb.y), bfhi(ugb.y)};
    const float rkv[4] = {rk.x, rk.y, rk.z, rk.w}; const float ga[4] = {gam.x, gam.y, gam.z, gam.w}; const float be[4] = {bet.x, bet.y, bet.z, bet.w};
    float bon = 0.f, sf = 0.f, sb = 0.f;
#pragma unroll
    for (int i = 0; i < 4; ++i) { bon += r[i] * k[i] * rkv[i]; sf += f[i]; sb += bb[i]; }
    bon = sum16(bon); float muf = sum16(sf) * (1.f / 64.f), mub = sum16(sb) * (1.f / 64.f);
    float qf = 0.f, qb = 0.f;
#pragma unroll
    for (int i = 0; i < 4; ++i) { f[i] -= muf; bb[i] -= mub; qf += f[i] * f[i]; qb += bb[i] * bb[i]; }
    float rsf = rsqrtf(sum16(qf) * (1.f / 64.f) + 64e-5f), rsb = rsqrtf(sum16(qb) * (1.f / 64.f) + 64e-5f);
    float y[4];
#pragma unroll
    for (int i = 0; i < 4; ++i) {
      float bn = bon * v[i];
      y[i] = (f[i] * rsf * ga[i] + be[i] + bn) * gf[i] + (bb[i] * rsb * ga[i] + be[i] + bn) * gb[i];
    }
    uint2 oo; oo.x = pack2(y[0], y[1]); oo.y = pack2(y[2], y[3]);
    *(uint2*)(Y + o) = oo;
  }
}

DI void ph_merge(const Params& p, int l, char* smem) {
  const bf16_t* U = (const bf16_t*)(p.ws + R_URE);
  const int lane = my_tid() & 63, wid = my_tid() >> 6, wm = wid >> 1, wn = wid & 1, g = lane >> 4, r16 = lane & 15;
  const int mtiles = (l == 0) ? 136 : 128;
  bf16_t* ACC = (bf16_t*)(p.ws + R_ACC);
  for (int it = 0;; ++it) {
    int mtile, ntile;
    if (!next_tile(it, mtiles, 8, mtile, ntile)) break;
    uint2 accS[4][4];
#pragma unroll
    for (int mt = 0; mt < 4; ++mt)
#pragma unroll
      for (int nt = 0; nt < 4; ++nt) accS[mt][nt] = make_uint2(0u, 0u);
    for (int j = 0; j < 4; ++j) {
      uint2 pb[4][4];
      {
        f32x4 accB[4][4]; zero_acc<4>(accB);
        const size_t yoff = (j == 0) ? R_YHY : (j == 1) ? R_YSW : (j == 2) ? R_YRW : R_YDF;
        gemm_glds(accB, (const bf16_t*)(p.ws + yoff), 256, RowPlain{(long)mtile * 256}, (const bf16_t*)(p.ws + WB_BR) + ((size_t)j * 1024 + ntile * 128) * 256, 256, 256, smem, (const bf16_t*)(p.ws + MISC_ZERO));
#pragma unroll
        for (int mt = 0; mt < 4; ++mt)
#pragma unroll
          for (int nt = 0; nt < 4; ++nt) { pb[mt][nt].x = pack2(accB[mt][nt][0], accB[mt][nt][1]); pb[mt][nt].y = pack2(accB[mt][nt][2], accB[mt][nt][3]); }
      }
      f32x4 accG[4][4]; zero_acc<4>(accG);
      gemm_glds(accG, U, 1024, RowPlain{(long)mtile * 256}, (const bf16_t*)(p.ws + WB_GATE) + ((size_t)j * 1024 + ntile * 128) * 1024, 1024, 1024, smem, (const bf16_t*)(p.ws + MISC_ZERO));
#pragma unroll
      for (int mt = 0; mt < 4; ++mt)
#pragma unroll
        for (int nt = 0; nt < 4; ++nt) {
          float v0 = bflo(accS[mt][nt].x) + sigmoidf_(accG[mt][nt][0]) * bflo(pb[mt][nt].x);
          float v1 = bfhi(accS[mt][nt].x) + sigmoidf_(accG[mt][nt][1]) * bfhi(pb[mt][nt].x);
          float v2 = bflo(accS[mt][nt].y) + sigmoidf_(accG[mt][nt][2]) * bflo(pb[mt][nt].y);
          float v3 = bfhi(accS[mt][nt].y) + sigmoidf_(accG[mt][nt][3]) * bfhi(pb[mt][nt].y);
          accS[mt][nt].x = pack2(v0, v1); accS[mt][nt].y = pack2(v2, v3);
        }
    }
#pragma unroll
    for (int mt = 0; mt < 4; ++mt) {
      const int col = ntile * 128 + wn * 64 + r16 * 4;
      const size_t row = (size_t)mtile * 256 + wm * 64 + mt * 16 + g * 4;
      uint2 o;
      o.x = (accS[mt][0].x & 0xffffu) | (accS[mt][1].x << 16); o.y = (accS[mt][2].x & 0xffffu) | (accS[mt][3].x << 16);
      *(uint2*)(ACC + (row + 0) * 1024 + col) = o;
      o.x = (accS[mt][0].x >> 16) | (accS[mt][1].x & 0xffff0000u); o.y = (accS[mt][2].x >> 16) | (accS[mt][3].x & 0xffff0000u);
      *(uint2*)(ACC + (row + 1) * 1024 + col) = o;
      o.x = (accS[mt][0].y & 0xffffu) | (accS[mt][1].y << 16); o.y = (accS[mt][2].y & 0xffffu) | (accS[mt][3].y << 16);
      *(uint2*)(ACC + (row + 2) * 1024 + col) = o;
      o.x = (accS[mt][0].y >> 16) | (accS[mt][1].y & 0xffff0000u); o.y = (accS[mt][2].y >> 16) | (accS[mt][3].y & 0xffff0000u);
      *(uint2*)(ACC + (row + 3) * 1024 + col) = o;
    }
  }
}

DI void ph_resgemm(const Params& p, int l, const bf16_t* A, int K, const bf16_t* Bt, const float* hsrc_lat, const float* hsrc_ctx, int gate_off, char* smem) {
  const int lane = my_tid() & 63, wid = my_tid() >> 6, wm = wid >> 1, wn = wid & 1, g = lane >> 4, r16 = lane & 15;
  const int mtiles = (l == 0) ? 136 : 128;
  const float* mod = (const float*)(p.ws + MISC_MOD) + (size_t)l * 9 * 6144;
  float* hc = (float*)(p.ws + OFF_HC);
  for (int it = 0;; ++it) {
    int mtile, ntile;
    if (!next_tile(it, mtiles, 8, mtile, ntile)) break;
    f32x4 acc[4][4]; zero_acc<4>(acc);
    gemm_glds(acc, A, K, RowPlain{(long)mtile * 256}, Bt + (size_t)ntile * 128 * K, K, K, smem, (const bf16_t*)(p.ws + MISC_ZERO));
    const int b = mtile < 128 ? (mtile >> 4) : 8;
    const float* gt = mod + (size_t)b * 6144 + gate_off;
    const int col = ntile * 128 + wn * 64 + r16 * 4;
    const float4 gv = *(const float4*)(gt + col);
#pragma unroll
    for (int mt = 0; mt < 4; ++mt)
#pragma unroll
      for (int e = 0; e < 4; ++e) {
        const int row = mtile * 256 + wm * 64 + mt * 16 + g * 4 + e;
        const float* hs; float* hd;
        if (row < ML) { size_t o = (size_t)row * D + col; hs = hsrc_lat + o; hd = p.out + o; }
        else { size_t o = (size_t)(row - ML) * D + col; hs = hsrc_ctx + o; hd = hc + o; }
        const float4 h = *(const float4*)hs;
        float4 r;
        r.x = DN_ALPHA * h.x + gv.x * acc[mt][0][e]; r.y = DN_ALPHA * h.y + gv.y * acc[mt][1][e];
        r.z = DN_ALPHA * h.z + gv.z * acc[mt][2][e]; r.w = DN_ALPHA * h.w + gv.w * acc[mt][3][e];
        *(float4*)hd = r;
      }
  }
}

DI void ph_ffnup(const Params& p, int l, char* smem) {
  const bf16_t* U = (const bf16_t*)(p.ws + R_U);
  const bf16_t* Bt = (const bf16_t*)(p.ws + WB_UP);
  bf16_t* HID = (bf16_t*)(p.ws + R_HID);
  const float* cw = p.in[38] + (size_t)l * 3 * 5632; const float* cb = p.in[39] + (size_t)l * 5632;
  const int tid = my_tid(), lane = tid & 63, wid = tid >> 6, wm = wid >> 2, wn = wid & 3, g = lane >> 4, r16 = lane & 15;
  const int mtiles = (l == 0) ? 152 : 136;
  constexpr int TS = 528;
  for (int it = 0;; ++it) {
    int mtile, ntile;
    if (!next_tile(it, mtiles, 22, mtile, ntile)) break;
    long rowbase; int tt, len;
    if (mtile < 136) { int b = mtile / 17; tt = mtile % 17; len = SL; rowbase = (long)b * SL; }
    else { int v = mtile - 136; int b = v >> 1; tt = v & 1; len = CL; rowbase = (long)ML + b * CL; }
    f32x4 acc[8][4]; zero_acc256(acc);
    gemm_glds256(acc, U, 1024, rowbase + tt * 254 - 1, Bt + (size_t)ntile * 256 * 1024, 1024, 1024, smem);
#pragma unroll
    for (int mt = 0; mt < 8; ++mt)
#pragma unroll
      for (int e = 0; e < 4; ++e) {
        uint2 o; o.x = pack2(acc[mt][0][e], acc[mt][1][e]); o.y = pack2(acc[mt][2][e], acc[mt][3][e]);
        *(uint2*)(smem + (wm * 128 + mt * 16 + g * 4 + e) * TS + (wn * 64 + r16 * 4) * 2) = o;
      }
    __syncthreads();
    {
      const int ch = tid & 127, rgp = tid >> 7; const int ca = ntile * 128 + ch, cbx = 2816 + ca;
      const float a0 = cw[ca], a1 = cw[5632 + ca], a2 = cw[2 * 5632 + ca], ab = cb[ca];
      const float b0 = cw[cbx], b1 = cw[5632 + cbx], b2 = cw[2 * 5632 + cbx], bb = cb[cbx];
      for (int r = 1 + rgp; r <= 254; r += 4) {
        const int tok = tt * 254 - 1 + r;
        if (tok < len) {
          const char* Tr = smem + r * TS + ch * 2;
          const float pa = tok >= 1 ? bf2f(*(const bf16_t*)(Tr - TS)) : 0.f, pb_ = tok >= 1 ? bf2f(*(const bf16_t*)(Tr - TS + 256)) : 0.f;
          const float na = tok + 1 < len ? bf2f(*(const bf16_t*)(Tr + TS)) : 0.f, nb = tok + 1 < len ? bf2f(*(const bf16_t*)(Tr + TS + 256)) : 0.f;
          const float av = a0 * pa + a1 * bf2f(*(const bf16_t*)(Tr)) + a2 * na + ab;
          const float bv = b0 * pb_ + b1 * bf2f(*(const bf16_t*)(Tr + 256)) + b2 * nb + bb;
          HID[(size_t)(rowbase + tok) * 2816 + ca] = (bf16_t)f2bf(siluf_(av) * bv);
        }
      }
    }
  }
}

#ifndef REP_PREP
#define REP_PREP 1
#endif
#ifndef REP_GEMM
#define REP_GEMM 1
#endif
#ifndef REP_HY
#define REP_HY 1
#endif
#ifndef REP_RWP
#define REP_RWP 1
#endif
#ifndef REP_SCAN
#define REP_SCAN 1
#endif
#ifndef REP_ATTN
#define REP_ATTN 1
#endif
#ifndef PH_END
#define PH_END 24
#endif
DI void grid_barrier(unsigned* bar, unsigned& epoch) {
  __syncthreads();
  epoch += 1;
  if (my_tid() == 0) {
    __threadfence();
    const unsigned target = epoch * gridDim.x;
    __hip_atomic_fetch_add(bar, 1u, __ATOMIC_RELAXED, __HIP_MEMORY_SCOPE_AGENT);
    while (__hip_atomic_load(bar, __ATOMIC_RELAXED, __HIP_MEMORY_SCOPE_AGENT) < target) __builtin_amdgcn_s_sleep(1);
    __threadfence();
  }
  __syncthreads();
}
#define SYNC_OR_RET(idx) do { if ((idx) + 1 >= PH_END) return; if ((idx) == 0) grid.sync(); else grid_barrier((unsigned*)(p.ws + MISC_BAR), epoch); } while (0)
template <int l>
DI void run_layer(const Params& p, cg::grid_group& grid, char* smem, unsigned& epoch) {
  const float* mod = (const float*)(p.ws + MISC_MOD) + (size_t)l * 9 * 6144;
  float* hc = (float*)(p.ws + OFF_HC);
  const float* hl_src = (l == 0) ? p.in[0] : p.out;
  const float* hc_src = (l == 0) ? p.in[2] : hc;
  constexpr int B0 = l * 12;
  if (l == 0) {
    ph_convert(p, 0, smem);
    ph_ada(p, smem);
    hy_rawfilter(p, 0, SL, (float*)(p.ws + R_RAWF), smem);
    hy_rawfilter(p, 0, CL, (float*)(p.ws + MISC_RAWC), smem);
    SYNC_OR_RET(B0 + 0);
    ph_kf(p, 0, smem);
    ph_ln(hl_src, hc_src, nullptr, nullptr, nullptr, nullptr, (bf16_t*)(p.ws + R_U), mod, 0, MT);
    SYNC_OR_RET(B0 + 1);
  }
  for (int rep = 0; rep < REP_GEMM; ++rep) ph_inproj(p, smem);
  SYNC_OR_RET(B0 + 2);
  for (int rep = 0; rep < REP_HY; ++rep) {
  if (blockIdx.x == 0 && my_tid() == 0) *(unsigned*)(p.ws + MISC_BAR + 64 + 64 * l) = 0u;
  ph_hyena(p, l, smem);
  if (l == 0) ph_hyena_ctx(p, l, smem);
  }
  ph_rope(p, smem);
  for (int rep = 0; rep < REP_RWP; ++rep) ph_rwprep(p, l, smem);
  SYNC_OR_RET(B0 + 3);
  for (int rep = 0; rep < REP_SCAN; ++rep) ph_scan(p, smem);
  for (int rep = 0; rep < REP_ATTN; ++rep) ph_attn(p, l, smem);
  SYNC_OR_RET(B0 + 4);
  ph_rwout(p, l);
  ph_ln(hl_src, hc_src, nullptr, nullptr, nullptr, nullptr, (bf16_t*)(p.ws + R_URE), mod, 0, l == 0 ? MT : ML);
  SYNC_OR_RET(B0 + 5);
  for (int rep = 0; rep < REP_GEMM; ++rep) ph_merge(p, l, smem);
  SYNC_OR_RET(B0 + 6);
  ph_resgemm(p, l, (const bf16_t*)(p.ws + R_ACC), 1024, (const bf16_t*)(p.ws + WB_OUT), hl_src, hc_src, 2048, smem);
  if (l == 0) hy_rawfilter(p, 1, SL, (float*)(p.ws + R_RAWF), smem);
  SYNC_OR_RET(B0 + 7);
  ph_ln(p.out, hc, p.out, hc, p.in[35] + (size_t)l * D, p.in[36] + (size_t)l * D, (bf16_t*)(p.ws + R_U), mod, 3072, l == 0 ? MT : ML);
  if (l == 0) ph_kf(p, 1, smem);
  SYNC_OR_RET(B0 + 8);
  for (int rep = 0; rep < REP_GEMM; ++rep) ph_ffnup(p, l, smem);
  SYNC_OR_RET(B0 + 9);
  ph_resgemm(p, l, (const bf16_t*)(p.ws + R_HID), 2816, (const bf16_t*)(p.ws + WB_DOWN), p.out, hc, 5120, smem);
  SYNC_OR_RET(B0 + 10);
  if (l == 0) {
    ph_ln(p.out, hc, p.out, hc, p.in[41], p.in[42], (bf16_t*)(p.ws + R_U), mod + 9 * 6144, 0, MT);
    ph_convert(p, 1, smem);
  } else {
    ph_ln(p.out, hc, p.out, hc, p.in[41] + (size_t)l * D, p.in[42] + (size_t)l * D, nullptr, mod, 0, ML);
  }
  SYNC_OR_RET(B0 + 11);
}

__global__ void __launch_bounds__(NTHR) mega(Params p) {
  extern __shared__ __attribute__((aligned(16))) char smem[];
  cg::grid_group grid = cg::this_grid();
  unsigned epoch = 0;
  if (blockIdx.x == 0 && my_tid() == 0) *(unsigned*)(p.ws + MISC_BAR) = 0u;
  if (blockIdx.x == 0 && my_tid() < 64) *(unsigned*)(p.ws + MISC_ZERO + my_tid() * 4) = 0u;
  run_layer<0>(p, grid, smem, epoch);
  if (PH_END > 12) run_layer<1>(p, grid, smem, epoch);
}

extern "C" void kernel_launch(void* const* d_in, const int* in_sizes, int n_in, void* d_out, int out_size,
                              void* d_ws, size_t ws_size, hipStream_t stream) {
  static int grid_blocks = 0;
  if (!grid_blocks) {
    int dev = 0, cus = 0, per_cu = 0;
    (void)hipGetDevice(&dev);
    (void)hipDeviceGetAttribute(&cus, hipDeviceAttributeMultiprocessorCount, dev);
    (void)hipFuncSetAttribute((const void*)mega, hipFuncAttributeMaxDynamicSharedMemorySize, SMEM_BYTES);
    (void)hipOccupancyMaxActiveBlocksPerMultiprocessor(&per_cu, mega, NTHR, SMEM_BYTES);
    if (per_cu < 1) per_cu = 1;
    if (per_cu > 1) per_cu = 1;
    grid_blocks = cus * per_cu;
  }
  Params p{};
  for (int i = 0; i < 43; ++i) p.in[i] = (const float*)d_in[i];
  p.out = (float*)d_out; p.ws = (char*)d_ws;
  void* args[] = {&p};
  hipError_t e = hipLaunchCooperativeKernel((void*)mega, dim3(grid_blocks), dim3(NTHR), args, SMEM_BYTES, stream);
  if (e != hipSuccess) fprintf(stderr, "cooperative launch failed: %s (grid %d)\n", hipGetErrorString(e), grid_blocks);
}
```

```cpp
#include <hip/hip_runtime.h>
#include <hip/hip_cooperative_groups.h>
#include <cstdio>
#include <cstdint>
namespace cg = cooperative_groups;

#define DI __device__ __forceinline__
typedef unsigned short bf16_t;
typedef short bf16x8 __attribute__((ext_vector_type(8)));
typedef float f32x4 __attribute__((ext_vector_type(4)));

constexpr int D = 1024, NB = 8, SL = 4096, CL = 256;
constexpr int ML = NB * SL, MC = NB * CL, MT = ML + MC;
constexpr int KEYS = SL + CL;
constexpr int NTHR = 512;
constexpr float DN_ALPHA = 1.41421356237f;
constexpr size_t UNIT = (size_t)MT * 512;

constexpr size_t WB_IN = 0;
constexpr size_t WB_GATE = WB_IN + (size_t)3328 * 1024 * 2;
constexpr size_t WB_BR = WB_GATE + (size_t)4096 * 1024 * 2;
constexpr size_t WB_OUT = WB_BR + (size_t)4 * 1024 * 256 * 2;
constexpr size_t WB_UP = WB_OUT + (size_t)1024 * 1024 * 2;
constexpr size_t WB_DOWN = WB_UP + (size_t)5632 * 1024 * 2;
constexpr size_t WB_END = WB_DOWN + (size_t)1024 * 2816 * 2;
constexpr size_t OFF_KF = WB_END;
constexpr size_t OFF_HC = OFF_KF + (size_t)512 * 8192 * 8;
constexpr size_t OFF_MISC = OFF_HC + (size_t)MC * D * 4;
constexpr size_t MISC_MOD = OFF_MISC;
constexpr size_t MISC_TW = MISC_MOD + (size_t)2 * 9 * 6144 * 4;
constexpr size_t MISC_RAWC = MISC_TW + 4096 * 8;
constexpr size_t MISC_GCTX = MISC_RAWC + (size_t)256 * 1024 * 4;
constexpr size_t MISC_RWW = MISC_GCTX + (size_t)512 * 512 * 4;
constexpr size_t RWW_F = MISC_RWW, RWW_B = RWW_F + 256 * 64 * 2, RWW_A = RWW_B + 256 * 64 * 2, RWW_GF = RWW_A + 256 * 64 * 2, RWW_GB = RWW_GF + 256 * 128 * 2;
constexpr size_t OFF_R = OFF_MISC + (size_t)4 * 1024 * 1024;
constexpr size_t MISC_BAR = OFF_R - 256;
constexpr size_t MISC_ZERO = OFF_R - 512;
static_assert(RWW_GB + 256 * 128 * 2 <= MISC_ZERO, "misc overflow");
constexpr size_t R_YHY = OFF_R, R_YSW = OFF_R + UNIT, R_YDF = OFF_R + 2 * UNIT;
constexpr size_t R_PHY = OFF_R + 3 * UNIT;
constexpr size_t R_PSW = OFF_R + 6 * UNIT;
constexpr size_t R_VTSW = R_PSW + (size_t)MT * 384 * 2;
constexpr size_t R_PDF = OFF_R + 8 * UNIT;
constexpr size_t R_VTDF = OFF_R + 10 * UNIT;
constexpr size_t R_PRW = OFF_R + 11 * UNIT;
constexpr size_t R_STR = R_PRW + (size_t)MT * 1216 * 2;
constexpr size_t R_G = R_STR + 7 * UNIT;
constexpr size_t R_END = R_G + 2 * UNIT;
constexpr size_t R_RAWF = OFF_R;
constexpr size_t R_OF = R_PHY, R_OB = R_PHY + UNIT;
constexpr size_t R_URE = R_PSW;
constexpr size_t R_YRW = R_VTDF;
constexpr size_t R_ACC = R_PRW;
constexpr size_t R_U = R_STR;
constexpr size_t R_HID = OFF_R;
static_assert(R_END <= (size_t)512 * 1024 * 1024, "ws overflow");
static_assert((size_t)MT * 2816 * 2 <= 11 * UNIT, "hid");

constexpr int SMEM_BYTES = 144 * 1024;

struct Params {
  const float* in[43];
  float* out;
  char* ws;
};

DI int my_tid() { int t = (int)__builtin_amdgcn_workitem_id_x(); asm volatile("" : "+v"(t)); return t; }
DI unsigned f2bf(float f) { unsigned u = __float_as_uint(f); u += 0x7fffu + ((u >> 16) & 1u); return u >> 16; }
DI float bf2f(unsigned h) { return __uint_as_float(h << 16); }
typedef __bf16 bf16v2_t __attribute__((ext_vector_type(2)));
typedef float f32v2_t __attribute__((ext_vector_type(2)));
DI unsigned pack2(float lo, float hi) { f32v2_t v = {lo, hi}; bf16v2_t b = __builtin_convertvector(v, bf16v2_t); return __builtin_bit_cast(unsigned, b); }

DI float bflo(unsigned w) { return __uint_as_float(w << 16); }
DI float bfhi(unsigned w) { return __uint_as_float(w & 0xffff0000u); }
DI float sigmoidf_(float x) { return 1.f / (1.f + __expf(-x)); }
DI float siluf_(float x) { return x / (1.f + __expf(-x)); }
DI float wave_sum(float v) {
#pragma unroll
  for (int o = 32; o >= 1; o >>= 1) v += __shfl_xor(v, o);
  return v;
}
template <int CTRL> DI float dpp_mov(float v) {
  return __int_as_float(__builtin_amdgcn_update_dpp(0, __float_as_int(v), CTRL, 0xf, 0xf, false));
}
DI float sum16(float v) {
  v += dpp_mov<0xB1>(v);
  v += dpp_mov<0x4E>(v);
  v += dpp_mov<0x141>(v);
  v += dpp_mov<0x140>(v);
  return v;
}
DI void lds_barrier() { asm volatile("s_waitcnt lgkmcnt(0)" ::: "memory"); __builtin_amdgcn_s_barrier(); asm volatile("" ::: "memory"); }
DI uint4 sel4(bool z, uint4 v) { return make_uint4(z ? 0u : v.x, z ? 0u : v.y, z ? 0u : v.z, z ? 0u : v.w); }
DI int mod_idx(int row) { return row < ML ? (row >> 12) : 8; }

template <int NTW, bool DEEP, class RowFn>
DI void gemm_main(f32x4 (&acc)[4][NTW], const bf16_t* __restrict__ A, int lda, RowFn rowfn,
                  const bf16_t* __restrict__ Bt, int ldb, int K, char* smem) {
  constexpr int BN = NTW * 32;
  constexpr int A_BYTES = 256 * 128, B_BYTES = BN * 128, STAGE = A_BYTES + B_BYTES;
  constexpr int NBL = BN / 64;
  const int tid = my_tid(), lane = tid & 63, wid = tid >> 6, wm = wid >> 1, wn = wid & 1, g = lane >> 4, r16 = lane & 15;
  const int chunk = tid & 7, lrow = tid >> 3;
  long a0 = rowfn(lrow), a1 = rowfn(lrow + 64), a2 = rowfn(lrow + 128), a3 = rowfn(lrow + 192);
  const long c0 = a0 < 0 ? 0 : a0, c1 = a1 < 0 ? 0 : a1, c2 = a2 < 0 ? 0 : a2, c3 = a3 < 0 ? 0 : a3;
  const bf16_t* Bp = Bt + (long)lrow * ldb + chunk * 8;
  const bf16_t* Ap0 = A + c0 * lda + chunk * 8; const bf16_t* Ap1 = A + c1 * lda + chunk * 8;
  const bf16_t* Ap2 = A + c2 * lda + chunk * 8; const bf16_t* Ap3 = A + c3 * lda + chunk * 8;
  struct Regs { uint4 a0, a1, a2, a3, b0, b1; };
  Regs R0, R1;
  R0.b1 = make_uint4(0, 0, 0, 0); R1.b1 = make_uint4(0, 0, 0, 0);
  auto GLOAD = [&](Regs& R, int k0) {
    R.a0 = *(const uint4*)(Ap0 + k0); R.a1 = *(const uint4*)(Ap1 + k0);
    R.a2 = *(const uint4*)(Ap2 + k0); R.a3 = *(const uint4*)(Ap3 + k0);
    R.b0 = *(const uint4*)(Bp + k0);
    if constexpr (NBL > 1) R.b1 = *(const uint4*)(Bp + (long)64 * ldb + k0);
  };
  auto SSTORE = [&](const Regs& R, int st) {
    char* base = smem + st * STAGE + lrow * 128 + ((chunk ^ (lrow & 7)) << 4);
    *(uint4*)(base) = sel4(a0 < 0, R.a0); *(uint4*)(base + 64 * 128) = sel4(a1 < 0, R.a1);
    *(uint4*)(base + 128 * 128) = sel4(a2 < 0, R.a2); *(uint4*)(base + 192 * 128) = sel4(a3 < 0, R.a3);
    *(uint4*)(base + A_BYTES) = R.b0;
    if constexpr (NBL > 1) *(uint4*)(base + A_BYTES + 64 * 128) = R.b1;
  };
  auto COMPUTE = [&](int st) {
    const char* As = smem + st * STAGE + (wm * 64 + r16) * 128;
    const char* Bs = smem + st * STAGE + A_BYTES + (wn * (NTW * 16) + r16) * 128;
#pragma unroll
    for (int kk = 0; kk < 2; ++kk) {
      const int sw = ((kk * 4 + g) ^ (r16 & 7)) << 4;
      bf16x8 af[4], bfr[NTW];
#pragma unroll
      for (int mt = 0; mt < 4; ++mt) af[mt] = *(const bf16x8*)(As + mt * 16 * 128 + sw);
#pragma unroll
      for (int nt = 0; nt < NTW; ++nt) bfr[nt] = *(const bf16x8*)(Bs + nt * 16 * 128 + sw);
#pragma unroll
      for (int mt = 0; mt < 4; ++mt)
#pragma unroll
        for (int nt = 0; nt < NTW; ++nt)
          acc[mt][nt] = __builtin_amdgcn_mfma_f32_16x16x32_bf16(af[mt], bfr[nt], acc[mt][nt], 0, 0, 0);
    }
  };
  const int nk = K >> 6;
  __syncthreads();
  GLOAD(R0, 0);
  SSTORE(R0, 0);
  if constexpr (DEEP) {
    GLOAD(R0, 64);
    if (nk > 2) GLOAD(R1, 128);
    lds_barrier();
    bf16x8 fa0[4], fb0[NTW], fa1[4], fb1[NTW];
    auto READF = [&](bf16x8 (&fa)[4], bf16x8 (&fb)[NTW], int st, int kk) {
      const int sw = ((kk * 4 + g) ^ (r16 & 7)) << 4;
      const char* As = smem + st * STAGE + (wm * 64 + r16) * 128 + sw;
      const char* Bs = smem + st * STAGE + A_BYTES + (wn * (NTW * 16) + r16) * 128 + sw;
#pragma unroll
      for (int mt = 0; mt < 4; ++mt) fa[mt] = *(const bf16x8*)(As + mt * 16 * 128);
#pragma unroll
      for (int nt = 0; nt < NTW; ++nt) fb[nt] = *(const bf16x8*)(Bs + nt * 16 * 128);
    };
    auto MMA = [&](const bf16x8 (&fa)[4], const bf16x8 (&fb)[NTW]) {
#pragma unroll
      for (int mt = 0; mt < 4; ++mt)
#pragma unroll
        for (int nt = 0; nt < NTW; ++nt)
          acc[mt][nt] = __builtin_amdgcn_mfma_f32_16x16x32_bf16(fa[mt], fb[nt], acc[mt][nt], 0, 0, 0);
    };
    READF(fa0, fb0, 0, 0);
    for (int kt = 0; kt < nk; kt += 2) {
      READF(fa1, fb1, 0, 1);
      MMA(fa0, fb0);
#pragma unroll
      for (int i = 0; i < 4 + NTW; ++i) { __builtin_amdgcn_sched_group_barrier(0x100, 1, 0); __builtin_amdgcn_sched_group_barrier(0x008, 2, 0); }
      __builtin_amdgcn_sched_barrier(0);
      SSTORE(R0, 1);
      if (kt + 3 < nk) GLOAD(R0, (kt + 3) * 64);
      MMA(fa1, fb1);
#pragma unroll
      for (int i = 0; i < 6; ++i) { __builtin_amdgcn_sched_group_barrier(0x200, 1, 0); __builtin_amdgcn_sched_group_barrier(0x020, 1, 0); __builtin_amdgcn_sched_group_barrier(0x008, 2, 0); }
      __builtin_amdgcn_sched_barrier(0);
      lds_barrier();
      READF(fa0, fb0, 1, 0);
      READF(fa1, fb1, 1, 1);
      MMA(fa0, fb0);
#pragma unroll
      for (int i = 0; i < 4 + NTW; ++i) { __builtin_amdgcn_sched_group_barrier(0x100, 1, 0); __builtin_amdgcn_sched_group_barrier(0x008, 2, 0); }
      __builtin_amdgcn_sched_barrier(0);
      if (kt + 2 < nk) SSTORE(R1, 0);
      if (kt + 4 < nk) GLOAD(R1, (kt + 4) * 64);
      MMA(fa1, fb1);
#pragma unroll
      for (int i = 0; i < 6; ++i) { __builtin_amdgcn_sched_group_barrier(0x200, 1, 0); __builtin_amdgcn_sched_group_barrier(0x020, 1, 0); __builtin_amdgcn_sched_group_barrier(0x008, 2, 0); }
      __builtin_amdgcn_sched_barrier(0);
      lds_barrier();
      if (kt + 2 < nk) READF(fa0, fb0, 0, 0);
    }
  } else {
    lds_barrier();
    for (int kt = 0; kt < nk; ++kt) {
      const int st = kt & 1;
      if (kt + 1 < nk) GLOAD(R0, (kt + 1) * 64);
      __builtin_amdgcn_sched_barrier(0);
      COMPUTE(st);
      __builtin_amdgcn_sched_barrier(0);
      if (kt + 1 < nk) SSTORE(R0, st ^ 1);
      lds_barrier();
    }
  }
}

#define GLDS16(gp, lp) __builtin_amdgcn_global_load_lds((const unsigned*)(gp), (unsigned*)(lp), 16, 0, 0)
template <class RowFn>
DI void gemm_glds(f32x4 (&acc)[4][4], const bf16_t* __restrict__ A, int lda, RowFn rowfn,
                  const bf16_t* __restrict__ Bt, int ldb, int K, char* smem, const bf16_t* zrow) {
  constexpr int A_BYTES = 256 * 128, STAGE = A_BYTES + 128 * 128;
  const int tid = my_tid(), lane = tid & 63, wid = tid >> 6, wm = wid >> 1, wn = wid & 1, g = lane >> 4, r16 = lane & 15;
  const int lrow = tid >> 3, c = (tid & 7) ^ (lrow & 7);
  const long a0 = rowfn(lrow), a1 = rowfn(lrow + 64), a2 = rowfn(lrow + 128), a3 = rowfn(lrow + 192);
  const bf16_t* pa0 = (a0 >= 0 ? A + a0 * lda : zrow) + c * 8; const int m0 = a0 >= 0 ? 1 : 0;
  const bf16_t* pa1 = (a1 >= 0 ? A + a1 * lda : zrow) + c * 8; const int m1 = a1 >= 0 ? 1 : 0;
  const bf16_t* pa2 = (a2 >= 0 ? A + a2 * lda : zrow) + c * 8; const int m2 = a2 >= 0 ? 1 : 0;
  const bf16_t* pa3 = (a3 >= 0 ? A + a3 * lda : zrow) + c * 8; const int m3 = a3 >= 0 ? 1 : 0;
  const bf16_t* pb0 = Bt + (long)lrow * ldb + c * 8; const bf16_t* pb1 = pb0 + (long)64 * ldb;
  auto ISSUE = [&](int kt, int bi) {
    char* d = smem + bi * STAGE + tid * 16;
    const int k0 = kt * 64;
    GLDS16(pa0 + k0 * m0, d); GLDS16(pa1 + k0 * m1, d + 8192); GLDS16(pa2 + k0 * m2, d + 16384); GLDS16(pa3 + k0 * m3, d + 24576);
    GLDS16(pb0 + k0, d + A_BYTES); GLDS16(pb1 + k0, d + A_BYTES + 8192);
  };
  auto COMPUTE = [&](int bi) {
    const char* As = smem + bi * STAGE + (wm * 64 + r16) * 128;
    const char* Bs = smem + bi * STAGE + A_BYTES + (wn * 64 + r16) * 128;
#pragma unroll
    for (int kk = 0; kk < 2; ++kk) {
      const int sw = ((kk * 4 + g) ^ (r16 & 7)) << 4;
      bf16x8 af[4], bfr[4];
#pragma unroll
      for (int mt = 0; mt < 4; ++mt) af[mt] = *(const bf16x8*)(As + mt * 16 * 128 + sw);
#pragma unroll
      for (int nt = 0; nt < 4; ++nt) bfr[nt] = *(const bf16x8*)(Bs + nt * 16 * 128 + sw);
#pragma unroll
      for (int mt = 0; mt < 4; ++mt)
#pragma unroll
        for (int nt = 0; nt < 4; ++nt)
          acc[mt][nt] = __builtin_amdgcn_mfma_f32_16x16x32_bf16(af[mt], bfr[nt], acc[mt][nt], 0, 0, 0);
    }
  };
  const int nk = K >> 6;
  __syncthreads();
  ISSUE(0, 0);
  ISSUE(1, 1);
  asm volatile("s_waitcnt vmcnt(6)" ::: "memory");
  __builtin_amdgcn_s_barrier();
  asm volatile("" ::: "memory");
  int bi = 0;
  for (int kt = 0; kt < nk; ++kt) {
    const int b2 = bi >= 1 ? bi - 1 : 2;
    if (kt + 2 < nk) ISSUE(kt + 2, b2);
    COMPUTE(bi);
    if (kt + 2 < nk) asm volatile("s_waitcnt vmcnt(6)" ::: "memory");
    else asm volatile("s_waitcnt vmcnt(0)" ::: "memory");
    asm volatile("s_waitcnt lgkmcnt(0)" ::: "memory");
    __builtin_amdgcn_s_barrier();
    asm volatile("" ::: "memory");
    bi = bi == 2 ? 0 : bi + 1;
  }
}

DI void gemm_glds256(f32x4 (&acc)[8][4], const bf16_t* __restrict__ A, int lda, long arow0,
                     const bf16_t* __restrict__ Bt, int ldb, int K, char* smem) {
  constexpr int A_BYTES = 256 * 128, STAGE = 2 * A_BYTES;
  const int tid = my_tid(), lane = tid & 63, wid = tid >> 6, wm = wid >> 2, wn = wid & 3, g = lane >> 4, r16 = lane & 15;
  const int lrow = tid >> 3, c = (tid & 7) ^ (lrow & 7);
  const bf16_t* pa = A + (arow0 + lrow) * (long)lda + c * 8;
  const bf16_t* pb = Bt + (long)lrow * ldb + c * 8;
  const long a64 = (long)64 * lda, b64 = (long)64 * ldb;
  auto ISSUE = [&](int kt, int bi) {
    char* d = smem + bi * STAGE + tid * 16;
    const int k0 = kt * 64;
    GLDS16(pa + k0, d); GLDS16(pa + a64 + k0, d + 8192); GLDS16(pa + 2 * a64 + k0, d + 16384); GLDS16(pa + 3 * a64 + k0, d + 24576);
    GLDS16(pb + k0, d + A_BYTES); GLDS16(pb + b64 + k0, d + A_BYTES + 8192); GLDS16(pb + 2 * b64 + k0, d + A_BYTES + 16384); GLDS16(pb + 3 * b64 + k0, d + A_BYTES + 24576);
  };
  auto COMPUTE = [&](int bi) {
    const char* As = smem + bi * STAGE + (wm * 128 + r16) * 128;
    const char* Bs = smem + bi * STAGE + A_BYTES + (wn * 64 + r16) * 128;
#pragma unroll
    for (int kk = 0; kk < 2; ++kk) {
      const int sw = ((kk * 4 + g) ^ (r16 & 7)) << 4;
      bf16x8 bfr[4];
#pragma unroll
      for (int nt = 0; nt < 4; ++nt) bfr[nt] = *(const bf16x8*)(Bs + nt * 16 * 128 + sw);
#pragma unroll
      for (int mt = 0; mt < 8; ++mt) {
        const bf16x8 af = *(const bf16x8*)(As + mt * 16 * 128 + sw);
#pragma unroll
        for (int nt = 0; nt < 4; ++nt)
          acc[mt][nt] = __builtin_amdgcn_mfma_f32_16x16x32_bf16(af, bfr[nt], acc[mt][nt], 0, 0, 0);
      }
    }
  };
  const int nk = K >> 6;
  __syncthreads();
  ISSUE(0, 0);
  asm volatile("s_waitcnt vmcnt(0)" ::: "memory");
  __builtin_amdgcn_s_barrier();
  asm volatile("" ::: "memory");
  int bi = 0;
  for (int kt = 0; kt < nk; ++kt) {
    if (kt + 1 < nk) ISSUE(kt + 1, bi ^ 1);
    COMPUTE(bi);
    asm volatile("s_waitcnt vmcnt(0)" ::: "memory");
    asm volatile("s_waitcnt lgkmcnt(0)" ::: "memory");
    __builtin_amdgcn_s_barrier();
    asm volatile("" ::: "memory");
    bi ^= 1;
  }
}
DI void zero_acc256(f32x4 (&acc)[8][4]) {
#pragma unroll
  for (int i = 0; i < 8; ++i)
#pragma unroll
    for (int j = 0; j < 4; ++j) acc[i][j] = (f32x4){0.f, 0.f, 0.f, 0.f};
}

DI bool next_tile(int i, int MTILES, int NTILES, int& mt, int& nt) {
  const int xcd = blockIdx.x & 7, slot = blockIdx.x >> 3, nslot = gridDim.x >> 3;
  const int m_lo = (MTILES * xcd) >> 3, m_hi = (MTILES * (xcd + 1)) >> 3, Mloc = m_hi - m_lo;
  const int q = i * nslot + slot;
  if (q >= Mloc * NTILES) return false;
  const int gidx = q / (4 * NTILES), m0 = gidx * 4;
  const int rows = (Mloc - m0) < 4 ? (Mloc - m0) : 4;
  const int within = q - gidx * 4 * NTILES;
  nt = within / rows; mt = m_lo + m0 + within % rows;
  return true;
}

struct RowPlain { long base; DI long operator()(int r) const { return base + r; } };
struct RowHalo { long rowbase; int t0; int len; DI long operator()(int r) const { int t = t0 + r; return (t >= 0 && t < len) ? rowbase + t : -1; } };

template <int NTW> DI void zero_acc(f32x4 (&acc)[4][NTW]) {
#pragma unroll
  for (int i = 0; i < 4; ++i)
#pragma unroll
    for (int j = 0; j < NTW; ++j) acc[i][j] = (f32x4){0.f, 0.f, 0.f, 0.f};
}

DI void cvt_unit(const float* __restrict__ src, int ldsrc, int srccol0, int k0, bf16_t* __restrict__ dst, int K, int n0, char* smem, bool perm = true) {
  float* T = (float*)smem;
  const int tid = my_tid();
  __syncthreads();
  if (srccol0 >= 0) {
#pragma unroll
    for (int i = 0; i < 8; ++i) {
      int idx = tid + i * 512; int k = idx >> 6, n = idx & 63;
      T[k * 65 + n] = src[(long)(k0 + k) * ldsrc + srccol0 + n];
    }
  }
  __syncthreads();
  int nd = tid >> 3, kc = (tid & 7) * 8; int n = perm ? ((nd & 15) * 4 + (nd >> 4)) : nd;
  uint4 o = make_uint4(0, 0, 0, 0);
  if (srccol0 >= 0) {
    o.x = pack2(T[(kc + 0) * 65 + n], T[(kc + 1) * 65 + n]);
    o.y = pack2(T[(kc + 2) * 65 + n], T[(kc + 3) * 65 + n]);
    o.z = pack2(T[(kc + 4) * 65 + n], T[(kc + 5) * 65 + n]);
    o.w = pack2(T[(kc + 6) * 65 + n], T[(kc + 7) * 65 + n]);
  }
  *(uint4*)(dst + (long)(n0 + nd) * K + k0 + kc) = o;
}

DI void ph_convert(const Params& p, int l, char* smem) {
  for (int u = blockIdx.x; u < 4508; u += gridDim.x) {
    if (u < 832) {
      int gI = u >> 4, kt = u & 15; int n0 = gI * 64; int sc;
      if (n0 < 1280) sc = n0; else if (n0 < 2048) sc = 2496 + (n0 - 1280); else if (n0 < 3264) sc = 1280 + (n0 - 2048); else sc = -1;
      cvt_unit(p.in[6] + (size_t)l * 1024 * 7360, 7360, sc, kt * 64, (bf16_t*)(p.ws + WB_IN), 1024, n0, smem);
    } else if (u < 1856) {
      int v = u - 832; int gI = v >> 4, kt = v & 15;
      cvt_unit(p.in[6] + (size_t)l * 1024 * 7360, 7360, 3264 + gI * 64, kt * 64, (bf16_t*)(p.ws + WB_GATE), 1024, gI * 64, smem);
    } else if (u < 2112) {
      int v = u - 1856; int gI = v >> 2, kt = v & 3; int j = gI >> 4, gg = gI & 15;
      cvt_unit(p.in[33] + ((size_t)l * 4 + j) * 256 * 1024, 1024, gg * 64, kt * 64, (bf16_t*)(p.ws + WB_BR) + (size_t)j * 1024 * 256, 256, gg * 64, smem);
    } else if (u < 2368) {
      int v = u - 2112; int gI = v >> 4, kt = v & 15;
      cvt_unit(p.in[34] + (size_t)l * 1024 * 1024, 1024, gI * 64, kt * 64, (bf16_t*)(p.ws + WB_OUT), 1024, gI * 64, smem);
    } else if (u < 3776) {
      int v = u - 2368; int gI = v >> 4, kt = v & 15; int nt = gI >> 2, q = gI & 3;
      cvt_unit(p.in[37] + (size_t)l * 1024 * 5632, 5632, (q >> 1) * 2816 + nt * 128 + (q & 1) * 64, kt * 64, (bf16_t*)(p.ws + WB_UP), 1024, gI * 64, smem);
    } else if (u < 4480) {
      int v = u - 3776; int gI = v / 44, kt = v % 44;
      cvt_unit(p.in[40] + (size_t)l * 2816 * 1024, 1024, gI * 64, kt * 64, (bf16_t*)(p.ws + WB_DOWN), 2816, gI * 64, smem);
    } else {
      int v = u - 4480;
      if (v < 4) cvt_unit(p.in[19] + (size_t)l * 2 * 64 * 256, 256, v * 64, 0, (bf16_t*)(p.ws + RWW_F), 64, v * 64, smem);
      else if (v < 8) cvt_unit(p.in[19] + (size_t)l * 2 * 64 * 256 + 64 * 256, 256, (v - 4) * 64, 0, (bf16_t*)(p.ws + RWW_B), 64, (v - 4) * 64, smem);
      else if (v < 12) cvt_unit(p.in[21] + (size_t)l * 64 * 256, 256, (v - 8) * 64, 0, (bf16_t*)(p.ws + RWW_A), 64, (v - 8) * 64, smem);
      else if (v < 20) { int w = v - 12; cvt_unit(p.in[22] + (size_t)l * 2 * 128 * 256, 256, (w >> 1) * 64, (w & 1) * 64, (bf16_t*)(p.ws + RWW_GF), 128, (w >> 1) * 64, smem); }
      else { int w = v - 20; cvt_unit(p.in[22] + (size_t)l * 2 * 128 * 256 + 128 * 256, 256, (w >> 1) * 64, (w & 1) * 64, (bf16_t*)(p.ws + RWW_GB), 128, (w >> 1) * 64, smem); }
    }
  }
}

DI void ph_ada(const Params& p, char* smem) {
  float* S = (float*)smem;
  float* R = S + 9 * 1024;
  const int tid = my_tid();
  bool loaded = false;
  for (int u = blockIdx.x; u < 192; u += gridDim.x) {
    if (!loaded) {
      __syncthreads();
      for (int i = tid; i < 9 * 1024; i += NTHR) { float c = i < 8192 ? p.in[1][i] : p.in[3][i - 8192]; S[i] = siluf_(c); }
      loaded = true;
    }
    __syncthreads();
    int l = u / 96, n0 = (u % 96) * 64;
    int col = tid & 63, ks = tid >> 6;
    const float* W = p.in[4] + (size_t)l * 1024 * 6144 + n0 + col;
    float a[9];
#pragma unroll
    for (int b = 0; b < 9; ++b) a[b] = 0.f;
    for (int k = ks * 128; k < ks * 128 + 128; ++k) {
      float w = W[(size_t)k * 6144];
#pragma unroll
      for (int b = 0; b < 9; ++b) a[b] += S[b * 1024 + k] * w;
    }
#pragma unroll
    for (int b = 0; b < 9; ++b) R[(ks * 9 + b) * 64 + col] = a[b];
    __syncthreads();
    for (int i = tid; i < 9 * 64; i += NTHR) {
      int b = i >> 6, c = i & 63; float s = 0.f;
#pragma unroll
      for (int k2 = 0; k2 < 8; ++k2) s += R[(k2 * 9 + b) * 64 + c];
      s += p.in[5][(size_t)l * 6144 + n0 + c];
      ((float*)(p.ws + MISC_MOD))[((size_t)l * 9 + b) * 6144 + n0 + c] = s;
    }
  }
  for (int i = blockIdx.x * NTHR + tid; i < 4096; i += gridDim.x * NTHR) {
    float s, c; sincospif(-(float)i / 4096.f, &s, &c);
    ((float2*)(p.ws + MISC_TW))[i] = make_float2(c, s);
  }
}

DI void hy_rawfilter(const Params& p, int l, int Lf, float* __restrict__ dst, char* smem) {
  float* W1 = (float*)smem;
  float* W2 = W1 + 33 * 64;
  float* Z = W2 + 64 * 64;
  float* H1 = Z + 16 * 36;
  float* H2 = H1 + 16 * 64;
  const int tid = my_tid();
  const float* w1 = p.in[9] + (size_t)l * 33 * 64; const float* b1 = p.in[10] + l * 64;
  const float* w2 = p.in[11] + (size_t)l * 64 * 64; const float* b2 = p.in[12] + l * 64;
  const float* w3 = p.in[13] + (size_t)l * 64 * 1024; const float* fr = p.in[14] + l * 64;
  const int nunits = Lf / 16;
  bool loaded = false;
  for (int u = blockIdx.x; u < nunits; u += gridDim.x) {
    __syncthreads();
    if (!loaded) {
      for (int i = tid; i < 33 * 64; i += NTHR) W1[i] = w1[i];
      for (int i = tid; i < 64 * 64; i += NTHR) W2[i] = w2[i];
      loaded = true;
    }
    const int t0 = u * 16;
    for (int i = tid; i < 16 * 33; i += NTHR) {
      int tt = i / 33, f = i % 33; int t = t0 + tt; float v;
      if (f == 0) v = (float)t / (float)(Lf - 1);
      else {
        int bi = (f - 1) & 15;
        float wv = 6.283185307179586f * (float)t / (float)Lf;
        float fb = 1e-4f + (15.f - 1e-4f) * (float)bi / 15.f;
        float ang = wv * fb;
        v = (f <= 16) ? cosf(ang) : -sinf(ang);
      }
      Z[tt * 36 + f] = v;
    }
    __syncthreads();
    for (int i = tid; i < 16 * 64; i += NTHR) {
      int tt = i >> 6, f = i & 63; float s = b1[f];
      for (int k = 0; k < 33; ++k) s += Z[tt * 36 + k] * W1[k * 64 + f];
      H1[tt * 64 + f] = sinf(fr[f] * s);
    }
    __syncthreads();
    for (int i = tid; i < 16 * 64; i += NTHR) {
      int tt = i >> 6, f = i & 63; float s = b2[f];
      for (int k = 0; k < 64; ++k) s += H1[tt * 64 + k] * W2[k * 64 + f];
      H2[tt * 64 + f] = sinf(fr[f] * s);
    }
    __syncthreads();
    float a0[16], a1[16];
#pragma unroll
    for (int i = 0; i < 16; ++i) { a0[i] = 0.f; a1[i] = 0.f; }
    for (int k = 0; k < 64; ++k) {
      float wa = w3[k * 1024 + tid], wb = w3[k * 1024 + 512 + tid];
#pragma unroll
      for (int i = 0; i < 16; ++i) { float h = H2[i * 64 + k]; a0[i] += h * wa; a1[i] += h * wb; }
    }
    {
      int w = tid & 255;
      float delta = fabsf(-3.0701134573253944f + (-15.350567286626972f + 3.0701134573253944f) * (float)w / 255.f);
#pragma unroll
      for (int i = 0; i < 16; ++i) {
        float tn = (float)(t0 + i) / (float)(Lf - 1);
        float dec = expf(-tn * delta);
        dst[(size_t)(t0 + i) * 1024 + tid] = a0[i] * dec;
        dst[(size_t)(t0 + i) * 1024 + 512 + tid] = a1[i] * dec;
      }
    }
  }
}

DI float2 cmul(float2 a, float2 b) { return make_float2(a.x * b.x - a.y * b.y, a.x * b.y + a.y * b.x); }
DI float2 cmulc(float2 a, float2 b) { return make_float2(a.x * b.x + a.y * b.y, a.y * b.x - a.x * b.y); }
DI float2 cadd(float2 a, float2 b) { return make_float2(a.x + b.x, a.y + b.y); }
DI float2 csub(float2 a, float2 b) { return make_float2(a.x - b.x, a.y - b.y); }
DI void fft_dif(float2* X, const float2* W) {
  const int tid = my_tid();
  for (int ls = 12; ls >= 2; ls -= 2) {
    const int s = 1 << ls, h = s >> 1;
    __syncthreads();
#pragma unroll
    for (int i = 0; i < 4; ++i) {
      const int bf = tid + i * 512; const int j = bf & (h - 1); const int base = ((bf >> (ls - 1)) << (ls + 1)) + j;
      const float2 x0 = X[base], x1 = X[base + h], x2 = X[base + s], x3 = X[base + s + h];
      const float2 w1 = W[s - 1 + j], w2 = W[h - 1 + j];
      const float2 y0 = cadd(x0, x2), y2 = cmul(csub(x0, x2), w1), y1 = cadd(x1, x3);
      const float2 t = cmul(csub(x1, x3), w1); const float2 y3 = make_float2(t.y, -t.x);
      X[base] = cadd(y0, y1); X[base + h] = cmul(csub(y0, y1), w2);
      X[base + s] = cadd(y2, y3); X[base + s + h] = cmul(csub(y2, y3), w2);
    }
  }
  __syncthreads();
#pragma unroll
  for (int i = 0; i < 4; ++i) {
    const int q = tid + i * 512;
    float4 a = *(float4*)(X + 4 * q), b = *(float4*)(X + 4 * q + 2);
    *(float4*)(X + 4 * q) = make_float4(a.x + a.z, a.y + a.w, a.x - a.z, a.y - a.w);
    *(float4*)(X + 4 * q + 2) = make_float4(b.x + b.z, b.y + b.w, b.x - b.z, b.y - b.w);
  }
  __syncthreads();
}
DI void fft_dit_inv(float2* X, const float2* W) {
  const int tid = my_tid();
  __syncthreads();
#pragma unroll
  for (int i = 0; i < 4; ++i) {
    const int q = tid + i * 512;
    float4 a = *(float4*)(X + 4 * q), b = *(float4*)(X + 4 * q + 2);
    *(float4*)(X + 4 * q) = make_float4(a.x + a.z, a.y + a.w, a.x - a.z, a.y - a.w);
    *(float4*)(X + 4 * q + 2) = make_float4(b.x + b.z, b.y + b.w, b.x - b.z, b.y - b.w);
  }
  for (int ls = 2; ls <= 12; ls += 2) {
    const int s = 1 << ls, h = s >> 1;
    __syncthreads();
#pragma unroll
    for (int i = 0; i < 4; ++i) {
      const int bf = tid + i * 512; const int j = bf & (h - 1); const int base = ((bf >> (ls - 1)) << (ls + 1)) + j;
      const float2 e0 = X[base], e1 = X[base + h], e2 = X[base + s], e3 = X[base + s + h];
      const float2 w1 = W[s - 1 + j], w2 = W[h - 1 + j];
      const float2 t1 = cmulc(e1, w2), t3 = cmulc(e3, w2);
      const float2 u0 = cadd(e0, t1), u1 = csub(e0, t1), u2 = cadd(e2, t3), u3 = csub(e2, t3);
      const float2 a2 = cmulc(u2, w1); const float2 q3 = cmulc(u3, w1); const float2 a3 = make_float2(-q3.y, q3.x);
      X[base] = cadd(u0, a2); X[base + s] = csub(u0, a2);
      X[base + h] = cadd(u1, a3); X[base + s + h] = csub(u1, a3);
    }
  }
  __syncthreads();
}
DI void load_twiddles(const Params& p, float2* W) {
  const float2* tw = (const float2*)(p.ws + MISC_TW);
  for (int i = my_tid(); i < 8191; i += NTHR) {
    const int ls = 31 - __clz(i + 1); const int pos = i + 1 - (1 << ls);
    W[i] = tw[pos << (12 - ls)];
  }
}

DI void ph_kf(const Params& p, int l, char* smem) {
  float2* X = (float2*)smem; float2* W = X + 8192; float* red = (float*)(W + 8192);
  const int tid = my_tid(), lane = tid & 63, wid = tid >> 6;
  const float* rawf = (const float*)(p.ws + R_RAWF);
  float2* kf = (float2*)(p.ws + OFF_KF);
  bool tw = false;
  for (int u = blockIdx.x; u < 256; u += gridDim.x) {
    if (!tw) { load_twiddles(p, W); tw = true; }
    const int o = u >> 7, c = (u & 127) * 2;
    float2 fw[8], bw[8]; float sa = 0.f, sb = 0.f;
#pragma unroll
    for (int i = 0; i < 8; ++i) {
      int t = tid + i * 512;
      fw[i] = *(const float2*)(rawf + (size_t)t * 1024 + o * 512 + c);
      bw[i] = *(const float2*)(rawf + (size_t)t * 1024 + o * 512 + 256 + c);
      sa += fabsf(fw[i].x) + fabsf(bw[i].x); sb += fabsf(fw[i].y) + fabsf(bw[i].y);
    }
    sa = wave_sum(sa); sb = wave_sum(sb);
    __syncthreads();
    if (lane == 0) { red[wid * 2] = sa; red[wid * 2 + 1] = sb; }
    __syncthreads();
    float ta = 0.f, tb = 0.f;
#pragma unroll
    for (int w = 0; w < 8; ++w) { ta += red[w * 2]; tb += red[w * 2 + 1]; }
    const float ia = 1.f / ta, ib = 1.f / tb;
#pragma unroll
    for (int i = 0; i < 8; ++i) {
      int t = tid + i * 512;
      X[t] = make_float2(fw[i].x * ia, fw[i].y * ib);
      if (t >= 1) X[8192 - t] = make_float2(bw[i].x * ia, bw[i].y * ib);
      else X[4096] = make_float2(0.f, 0.f);
    }
    fft_dif(X, W);
    float2* ka = kf + (size_t)(o * 256 + c) * 8192; float2* kb = ka + 8192;
#pragma unroll 4
    for (int i = 0; i < 16; ++i) {
      int pidx = tid + i * 512;
      int k = (int)(__brev((unsigned)pidx) >> 19);
      int k2 = (8192 - k) & 8191;
      int p2 = (int)(__brev((unsigned)k2) >> 19);
      float2 c1 = X[pidx], c2 = X[p2];
      float2 A = make_float2(0.5f * (c1.x + c2.x), 0.5f * (c1.y - c2.y));
      float2 Bv = make_float2(0.5f * (c1.y + c2.y), -0.5f * (c1.x - c2.x));
      ka[pidx] = A; kb[pidx] = Bv;
    }
    __syncthreads();
  }
  if (l == 0) {
    const float* rawc = (const float*)(p.ws + MISC_RAWC);
    float* G = (float*)(p.ws + MISC_GCTX);
    for (int u = blockIdx.x * 8 + wid; u < 512; u += gridDim.x * 8) {
      int o = u >> 8, c = u & 255; float f[4], b[4]; float s = 0.f;
#pragma unroll
      for (int i = 0; i < 4; ++i) {
        int t = lane + i * 64;
        f[i] = rawc[(size_t)t * 1024 + o * 512 + c]; b[i] = rawc[(size_t)t * 1024 + o * 512 + 256 + c];
        s += fabsf(f[i]) + fabsf(b[i]);
      }
      s = wave_sum(s); float inv = 1.f / s;
#pragma unroll
      for (int i = 0; i < 4; ++i) {
        int t = lane + i * 64;
        G[(size_t)u * 512 + 256 + t] = f[i] * inv;
        if (t >= 1) G[(size_t)u * 512 + 256 - t] = b[i] * inv;
      }
      if (lane == 0) G[(size_t)u * 512] = 0.f;
    }
  }
}

DI void ph_ln(const float* __restrict__ src_lat, const float* __restrict__ src_ctx, float* dst_lat, float* dst_ctx,
              const float* __restrict__ ag, const float* __restrict__ ab, bf16_t* U, const float* __restrict__ mod, int sh_off, int nrows) {
  const int lane = my_tid() & 63, wid = my_tid() >> 6;
  const int stride = gridDim.x * 8;
  float4 nv[4];
  {
    const int row = blockIdx.x * 8 + wid;
    if (row < nrows) {
      const float* src = row < ML ? src_lat + (size_t)row * D : src_ctx + (size_t)(row - ML) * D;
#pragma unroll
      for (int i = 0; i < 4; ++i) nv[i] = *(const float4*)(src + i * 256 + lane * 4);
    }
  }
  for (int row = blockIdx.x * 8 + wid; row < nrows; row += stride) {
    float4 v[4];
#pragma unroll
    for (int i = 0; i < 4; ++i) v[i] = nv[i];
    if (row + stride < nrows) {
      const int r2 = row + stride;
      const float* src2 = r2 < ML ? src_lat + (size_t)r2 * D : src_ctx + (size_t)(r2 - ML) * D;
#pragma unroll
      for (int i = 0; i < 4; ++i) nv[i] = *(const float4*)(src2 + i * 256 + lane * 4);
    }
    float s = 0.f;
#pragma unroll
    for (int i = 0; i < 4; ++i) s += v[i].x + v[i].y + v[i].z + v[i].w;
    float mu = wave_sum(s) * (1.f / 1024.f);
    float q = 0.f;
#pragma unroll
    for (int i = 0; i < 4; ++i) { v[i].x -= mu; v[i].y -= mu; v[i].z -= mu; v[i].w -= mu; q += v[i].x * v[i].x + v[i].y * v[i].y + v[i].z * v[i].z + v[i].w * v[i].w; }
    float rs = rsqrtf(wave_sum(q) * (1.f / 1024.f) + 1e-6f);
#pragma unroll
    for (int i = 0; i < 4; ++i) { v[i].x *= rs; v[i].y *= rs; v[i].z *= rs; v[i].w *= rs; }
    if (ag) {
      float* dst = row < ML ? dst_lat + (size_t)row * D : dst_ctx + (size_t)(row - ML) * D;
#pragma unroll
      for (int i = 0; i < 4; ++i) {
        float4 gg = *(const float4*)(ag + i * 256 + lane * 4), bb = *(const float4*)(ab + i * 256 + lane * 4);
        v[i].x = v[i].x * gg.x + bb.x; v[i].y = v[i].y * gg.y + bb.y; v[i].z = v[i].z * gg.z + bb.z; v[i].w = v[i].w * gg.w + bb.w;
        *(float4*)(dst + i * 256 + lane * 4) = v[i];
      }
      if (U) {
        s = 0.f;
#pragma unroll
        for (int i = 0; i < 4; ++i) s += v[i].x + v[i].y + v[i].z + v[i].w;
        mu = wave_sum(s) * (1.f / 1024.f); q = 0.f;
#pragma unroll
        for (int i = 0; i < 4; ++i) { v[i].x -= mu; v[i].y -= mu; v[i].z -= mu; v[i].w -= mu; q += v[i].x * v[i].x + v[i].y * v[i].y + v[i].z * v[i].z + v[i].w * v[i].w; }
        rs = rsqrtf(wave_sum(q) * (1.f / 1024.f) + 1e-6f);
#pragma unroll
        for (int i = 0; i < 4; ++i) { v[i].x *= rs; v[i].y *= rs; v[i].z *= rs; v[i].w *= rs; }
      }
    }
    if (U) {
      const float* m = mod + (size_t)mod_idx(row) * 6144 + sh_off;
#pragma unroll
      for (int i = 0; i < 4; ++i) {
        float4 sh = *(const float4*)(m + i * 256 + lane * 4), sc = *(const float4*)(m + 1024 + i * 256 + lane * 4);
        uint2 o; o.x = pack2(v[i].x * (1.f + sc.x) + sh.x, v[i].y * (1.f + sc.y) + sh.y);
        o.y = pack2(v[i].z * (1.f + sc.z) + sh.z, v[i].w * (1.f + sc.w) + sh.w);
        *(uint2*)(U + (size_t)row * D + i * 256 + lane * 4) = o;
      }
    }
  }
}

DI void ph_inproj(const Params& p, const bf16_t* U, char* smem) {
  const bf16_t* Bt = (const bf16_t*)(p.ws + WB_IN);
  const int lane = my_tid() & 63, wid = my_tid() >> 6, wm = wid >> 2, wn = wid & 3, g = lane >> 4, r16 = lane & 15;
  for (int it = 0;; ++it) {
    int mtile, ntile;
    if (!next_tile(it, 136, 13, mtile, ntile)) break;
    f32x4 acc[8][4]; zero_acc256(acc);
    gemm_glds256(acc, U, 1024, (long)mtile * 256, Bt + (size_t)ntile * 256 * 1024, 1024, 1024, smem);
    int b, key0;
    if (mtile < 128) { b = mtile >> 4; key0 = (mtile & 15) * 256; } else { b = mtile - 128; key0 = SL; }
    const int wc0 = ntile * 256 + wn * 64;
    bf16_t* tbase = nullptr; int tcols = 0, tcol0 = 0;
    if (wc0 < 768) { tbase = (bf16_t*)(p.ws + R_PHY); tcols = 768; tcol0 = wc0; }
    else if (wc0 >= 1152 && wc0 < 1280) { tbase = (bf16_t*)(p.ws + R_VTSW); tcols = 128; tcol0 = wc0 - 1152; }
    else if (wc0 >= 1792 && wc0 < 2048) { tbase = (bf16_t*)(p.ws + R_VTDF); tcols = 256; tcol0 = wc0 - 1792; }
    if (tbase) {
#pragma unroll
      for (int mt = 0; mt < 8; ++mt)
#pragma unroll
        for (int nt = 0; nt < 4; ++nt) {
          int col = tcol0 + r16 * 4 + nt;
          int key = key0 + wm * 128 + mt * 16 + g * 4;
          uint2 o; o.x = pack2(acc[mt][nt][0], acc[mt][nt][1]); o.y = pack2(acc[mt][nt][2], acc[mt][nt][3]);
          *(uint2*)(tbase + ((size_t)b * tcols + col) * KEYS + key) = o;
        }
    } else if (wc0 < 3264) {
      bf16_t* rb; int ld, c0;
      if (wc0 < 1152) { rb = (bf16_t*)(p.ws + R_PSW); ld = 384; c0 = wc0 - 768; }
      else if (wc0 < 1792) { rb = (bf16_t*)(p.ws + R_PDF); ld = 512; c0 = wc0 - 1280; }
      else { rb = (bf16_t*)(p.ws + R_PRW); ld = 1216; c0 = wc0 - 2048; }
      const int col = c0 + r16 * 4;
#pragma unroll
      for (int mt = 0; mt < 8; ++mt)
#pragma unroll
        for (int j = 0; j < 4; ++j) {
          size_t row = (size_t)mtile * 256 + wm * 128 + mt * 16 + g * 4 + j;
          uint2 o; o.x = pack2(acc[mt][0][j], acc[mt][1][j]); o.y = pack2(acc[mt][2][j], acc[mt][3][j]);
          *(uint2*)(rb + row * ld + col) = o;
        }
    }
  }
}

DI float hy_conv3(const bf16_t* __restrict__ P, int t, int len, float w0, float w1, float w2, float bias) {
  float a = t >= 1 ? bf2f(P[t - 1]) : 0.f, b = bf2f(P[t]), c = (t + 1 < len) ? bf2f(P[t + 1]) : 0.f;
  return w0 * a + w1 * b + w2 * c + bias;
}
DI void ph_hyena(const Params& p, int l, char* smem) {
  float2* X = (float2*)smem; float2* W = X + 8192;
  const int tid = my_tid();
  const bf16_t* PT = (const bf16_t*)(p.ws + R_PHY);
  const float2* kf = (const float2*)(p.ws + OFF_KF);
  const float* cw = p.in[7] + (size_t)l * 3 * 768; const float* cb = p.in[8] + (size_t)l * 768;
  const float* hb = p.in[15] + (size_t)l * 512;
  bf16_t* Y = (bf16_t*)(p.ws + R_YHY);
  bool tw = false;
  for (int u = blockIdx.x; u < 1024; u += gridDim.x) {
    if (!tw) { load_twiddles(p, W); tw = true; }
    const int bp = u >> 8, c = u & 255; const int b0 = bp * 2, b1 = b0 + 1;
    const bf16_t* P0 = PT + ((size_t)b0 * 768) * KEYS; const bf16_t* P1 = PT + ((size_t)b1 * 768) * KEYS;
    float wv0 = cw[c], wv1 = cw[768 + c], wv2 = cw[1536 + c], bv = cb[c];
    float wa0 = cw[256 + c], wa1 = cw[768 + 256 + c], wa2 = cw[1536 + 256 + c], ba = cb[256 + c];
    float wb0 = cw[512 + c], wb1 = cw[768 + 512 + c], wb2 = cw[1536 + 512 + c], bb = cb[512 + c];
    const float bias0 = hb[c], bias1 = hb[256 + c];
    float2 vv[8];
    __syncthreads();
#pragma unroll
    for (int i = 0; i < 8; ++i) {
      int t = tid + i * 512;
      vv[i].x = hy_conv3(P0 + (size_t)c * KEYS, t, SL, wv0, wv1, wv2, bv);
      vv[i].y = hy_conv3(P1 + (size_t)c * KEYS, t, SL, wv0, wv1, wv2, bv);
      X[t] = vv[i]; X[t + 4096] = make_float2(0.f, 0.f);
    }
    fft_dif(X, W);
    {
      const float2* H = kf + (size_t)c * 8192;
#pragma unroll 4
      for (int i = 0; i < 16; ++i) { int q = tid + i * 512; X[q] = cmul(X[q], H[q]); }
    }
    fft_dit_inv(X, W);
    float2 zz[8];
#pragma unroll
    for (int i = 0; i < 8; ++i) {
      int t = tid + i * 512;
      float2 y = X[t];
      float x1a = hy_conv3(P0 + (size_t)(256 + c) * KEYS, t, SL, wa0, wa1, wa2, ba);
      float x1b = hy_conv3(P1 + (size_t)(256 + c) * KEYS, t, SL, wa0, wa1, wa2, ba);
      zz[i].x = x1a * (y.x * (1.f / 8192.f) + bias0 * vv[i].x);
      zz[i].y = x1b * (y.y * (1.f / 8192.f) + bias0 * vv[i].y);
    }
    __syncthreads();
#pragma unroll
    for (int i = 0; i < 8; ++i) { int t = tid + i * 512; X[t] = zz[i]; X[t + 4096] = make_float2(0.f, 0.f); }
    fft_dif(X, W);
    {
      const float2* H = kf + (size_t)(256 + c) * 8192;
#pragma unroll 4
      for (int i = 0; i < 16; ++i) { int q = tid + i * 512; X[q] = cmul(X[q], H[q]); }
    }
    fft_dit_inv(X, W);
#pragma unroll
    for (int i = 0; i < 8; ++i) {
      int t = tid + i * 512;
      float2 y = X[t];
      float x2a = hy_conv3(P0 + (size_t)(512 + c) * KEYS, t, SL, wb0, wb1, wb2, bb);
      float x2b = hy_conv3(P1 + (size_t)(512 + c) * KEYS, t, SL, wb0, wb1, wb2, bb);
      float oa = x2a * (y.x * (1.f / 8192.f) + bias1 * zz[i].x);
      float ob = x2b * (y.y * (1.f / 8192.f) + bias1 * zz[i].y);
      Y[((size_t)b0 * SL + t) * 256 + c] = (bf16_t)f2bf(oa);
      Y[((size_t)b1 * SL + t) * 256 + c] = (bf16_t)f2bf(ob);
    }
  }
}

DI void ph_hyena_ctx(const Params& p, int l, char* smem) {
  const int tid = my_tid(), lane = tid & 63, wid = tid >> 6;
  float* Zb = (float*)smem + wid * 1024;
  float* Gb = Zb + 256;
  const bf16_t* PT = (const bf16_t*)(p.ws + R_PHY);
  const float* G = (const float*)(p.ws + MISC_GCTX);
  const float* cw = p.in[7] + (size_t)l * 3 * 768; const float* cb = p.in[8] + (size_t)l * 768;
  const float* hb = p.in[15] + (size_t)l * 512;
  bf16_t* Y = (bf16_t*)(p.ws + R_YHY);
  for (int base = blockIdx.x * 8; base < 2048; base += gridDim.x * 8) {
    const int u = base + wid; const int b = u >> 8, c = u & 255;
    const bf16_t* Pb = PT + ((size_t)b * 768) * KEYS + SL;
    float v[4], x1[4], x2[4], zz[4];
#pragma unroll
    for (int i = 0; i < 4; ++i) {
      int t = lane + i * 64;
      v[i] = hy_conv3(Pb + (size_t)c * KEYS, t, CL, cw[c], cw[768 + c], cw[1536 + c], cb[c]);
      x1[i] = hy_conv3(Pb + (size_t)(256 + c) * KEYS, t, CL, cw[256 + c], cw[768 + 256 + c], cw[1536 + 256 + c], cb[256 + c]);
      x2[i] = hy_conv3(Pb + (size_t)(512 + c) * KEYS, t, CL, cw[512 + c], cw[768 + 512 + c], cw[1536 + 512 + c], cb[512 + c]);
    }
    __syncthreads();
#pragma unroll
    for (int i = 0; i < 4; ++i) Zb[lane + i * 64] = v[i];
    for (int i = lane; i < 512; i += 64) Gb[i] = G[(size_t)c * 512 + i];
    __syncthreads();
#pragma unroll
    for (int i = 0; i < 4; ++i) {
      int t = lane + i * 64; float s = 0.f;
      for (int s2 = 0; s2 < 256; ++s2) s += Gb[256 + t - s2] * Zb[s2];
      zz[i] = x1[i] * (s + hb[c] * v[i]);
    }
    __syncthreads();
#pragma unroll
    for (int i = 0; i < 4; ++i) Zb[lane + i * 64] = zz[i];
    for (int i = lane; i < 512; i += 64) Gb[i] = G[(size_t)(256 + c) * 512 + i];
    __syncthreads();
#pragma unroll
    for (int i = 0; i < 4; ++i) {
      int t = lane + i * 64; float s = 0.f;
      for (int s2 = 0; s2 < 256; ++s2) s += Gb[256 + t - s2] * Zb[s2];
      float o = x2[i] * (s + hb[256 + c] * zz[i]);
      Y[((size_t)ML + b * CL + t) * 256 + c] = (bf16_t)f2bf(o);
    }
  }
}

DI void ph_rope(const Params& p, char* smem) {
  float2* T16 = (float2*)smem;
  float2* T8 = T16 + 64 * 16;
  const int tid = my_tid(), lane = tid & 63, wid = tid >> 6;
  __syncthreads();
  for (int i = tid; i < 64 * 16; i += NTHR) {
    int pos = i >> 4, f = i & 15; float inv = powf(10000.f, -(float)f / 16.f); float s, c; sincosf((float)pos * inv, &s, &c);
    T16[i] = make_float2(c, s);
  }
  for (int i = tid; i < 64 * 8; i += NTHR) {
    int pos = i >> 3, f = i & 7; float inv = powf(10000.f, -(float)f / 8.f); float s, c; sincosf((float)pos * inv, &s, &c);
    T8[i] = make_float2(c, s);
  }
  __syncthreads();
  bf16_t* Psw = (bf16_t*)(p.ws + R_PSW); bf16_t* Pdf = (bf16_t*)(p.ws + R_PDF);
  for (int row = blockIdx.x * 8 + wid; row < ML; row += gridDim.x * 8) {
    const int t = row & (SL - 1); const int pr = t >> 6, pc = t & 63;
    bf16_t* q = Psw + (size_t)row * 384;
#pragma unroll
    for (int i = 0; i < 3; ++i) {
      int pi = lane + i * 64; int hd = pi >> 5, pp = pi & 31; int half = pp >> 4, f = pp & 15;
      int base = hd * 64 + half * 32; float2 cs = T16[(half ? pc : pr) * 16 + f];
      float x1 = bf2f(q[base + f]), x2 = bf2f(q[base + 16 + f]);
      q[base + f] = (bf16_t)f2bf(x1 * cs.x - x2 * cs.y); q[base + 16 + f] = (bf16_t)f2bf(x1 * cs.y + x2 * cs.x);
    }
    bf16_t* d = Pdf + (size_t)row * 512;
#pragma unroll
    for (int i = 0; i < 4; ++i) {
      int pi = lane + i * 64; int gi = pi >> 4, pp = pi & 15; int half = pp >> 3, f = pp & 7;
      int base = gi * 32 + half * 16; float2 cs = T8[(half ? pc : pr) * 8 + f];
      float x1 = bf2f(d[base + f]), x2 = bf2f(d[base + 8 + f]);
      d[base + f] = (bf16_t)f2bf(x1 * cs.x - x2 * cs.y); d[base + 8 + f] = (bf16_t)f2bf(x1 * cs.y + x2 * cs.x);
    }
  }
}

DI float rw_shift(const bf16_t* __restrict__ P, int row, int t, int len, int col, float mu) {
  float c = bf2f(P[(size_t)row * 1216 + col]);
  float a = t >= 1 ? bf2f(P[(size_t)(row - 1) * 1216 + col]) : 0.f;
  float b = t + 1 < len ? bf2f(P[(size_t)(row + 1) * 1216 + col]) : 0.f;
  return c + (0.5f * (a + b) - c) * mu;
}
DI void ph_rwprep(const Params& p, int l, char* smem) {
  constexpr int AST = 912, RST = 1552, ROFF = 32 * AST;
  const int tid = my_tid(), lane = tid & 63, wid = tid >> 6, g = lane >> 4, r16 = lane & 15;
  const int tg = wid >> 2, hd = wid & 3;
  const bf16_t* P = (const bf16_t*)(p.ws + R_PRW);
  const float* mu = p.in[17] + (size_t)l * 1216;
  const float* w0 = p.in[18] + (size_t)l * 512; const float* a0 = p.in[20] + (size_t)l * 256;
  const float* kkw = p.in[23] + (size_t)l * 256; const float* kaw = p.in[24] + (size_t)l * 256;
  bf16_t* S = (bf16_t*)(p.ws + R_STR); bf16_t* Gs = (bf16_t*)(p.ws + R_G);
  const size_t SU = (size_t)MT * 256;
  float w0f[4], w0b[4], a0c[4], kkc[4], kac[4];
#pragma unroll
  for (int nt = 0; nt < 4; ++nt) { int c = hd * 64 + r16 * 4 + nt; w0f[nt] = w0[c]; w0b[nt] = w0[256 + c]; a0c[nt] = a0[c]; kkc[nt] = kkw[c]; kac[nt] = kaw[c]; }
  for (int u = blockIdx.x; u < MT / 32; u += gridDim.x) {
    const int row0 = u * 32; int t0, len;
    if (row0 < ML) { t0 = row0 & (SL - 1); len = SL; } else { t0 = (row0 - ML) & (CL - 1); len = CL; }
    __syncthreads();
    for (int item = tid; item < 32 * 152; item += NTHR) {
      const int tk = item / 152, c8 = item - tk * 152; const int row = row0 + tk, t = t0 + tk;
      const uint4 uc = *(const uint4*)(P + (size_t)row * 1216 + c8 * 8);
      uint4 ua = make_uint4(0, 0, 0, 0), ub = make_uint4(0, 0, 0, 0);
      if (t >= 1) ua = *(const uint4*)(P + (size_t)(row - 1) * 1216 + c8 * 8);
      if (t + 1 < len) ub = *(const uint4*)(P + (size_t)(row + 1) * 1216 + c8 * 8);
      const float4 m0 = *(const float4*)(mu + c8 * 8), m1 = *(const float4*)(mu + c8 * 8 + 4);
      float o[8];
      {
        const unsigned wc[4] = {uc.x, uc.y, uc.z, uc.w}, wa[4] = {ua.x, ua.y, ua.z, ua.w}, wb[4] = {ub.x, ub.y, ub.z, ub.w};
        const float mm[8] = {m0.x, m0.y, m0.z, m0.w, m1.x, m1.y, m1.z, m1.w};
#pragma unroll
        for (int i = 0; i < 4; ++i) {
          float c_lo = bflo(wc[i]), c_hi = bfhi(wc[i]);
          o[2 * i] = c_lo + (0.5f * (bflo(wa[i]) + bflo(wb[i])) - c_lo) * mm[2 * i];
          o[2 * i + 1] = c_hi + (0.5f * (bfhi(wa[i]) + bfhi(wb[i])) - c_hi) * mm[2 * i + 1];
        }
      }
      char* dst;
      if (c8 < 96) dst = smem + ROFF + tk * RST + c8 * 16;
      else {
        const int cc = c8 * 8 - 768;
        if (cc < 128) {
#pragma unroll
          for (int i = 0; i < 8; ++i) o[i] = tanhf(o[i]);
        } else if (cc >= 192) {
#pragma unroll
          for (int i = 0; i < 8; ++i) o[i] = sigmoidf_(o[i]);
        }
        dst = smem + tk * AST + cc * 2;
      }
      uint4 ov; ov.x = pack2(o[0], o[1]); ov.y = pack2(o[2], o[3]); ov.z = pack2(o[4], o[5]); ov.w = pack2(o[6], o[7]);
      *(uint4*)dst = ov;
    }
    __syncthreads();
    f32x4 acc[5][4];
#pragma unroll
    for (int o5 = 0; o5 < 5; ++o5)
#pragma unroll
      for (int nt = 0; nt < 4; ++nt) acc[o5][nt] = (f32x4){0.f, 0.f, 0.f, 0.f};
    const char* Arow = smem + (tg * 16 + r16) * AST + g * 16;
#pragma unroll
    for (int o5 = 0; o5 < 5; ++o5) {
      const int kbase = o5 < 3 ? o5 * 64 : (o5 == 3 ? 192 : 320);
      const int KK = o5 < 3 ? 64 : 128;
      const bf16_t* Wt = (const bf16_t*)(p.ws + (o5 == 0 ? RWW_F : o5 == 1 ? RWW_B : o5 == 2 ? RWW_A : o5 == 3 ? RWW_GF : RWW_GB));
#pragma unroll
      for (int ks = 0; ks < KK / 32; ++ks) {
        const bf16x8 af = *(const bf16x8*)(Arow + (kbase + ks * 32) * 2);
#pragma unroll
        for (int nt = 0; nt < 4; ++nt) {
          const bf16x8 bf = *(const bf16x8*)(Wt + (size_t)(hd * 64 + nt * 16 + r16) * KK + ks * 32 + g * 8);
          acc[o5][nt] = __builtin_amdgcn_mfma_f32_16x16x32_bf16(af, bf, acc[o5][nt], 0, 0, 0);
        }
        if (ks & 1) asm volatile("" ::: "memory");
      }
    }
#pragma unroll
    for (int j = 0; j < 4; ++j) {
      const int tk = tg * 16 + g * 4 + j; const size_t row = (size_t)row0 + tk;
      const char* rk = smem + ROFF + tk * RST;
      const int c0 = hd * 64 + r16 * 4;
      const uint2 ur = *(const uint2*)(rk + c0 * 2), uk = *(const uint2*)(rk + (256 + c0) * 2), uv = *(const uint2*)(rk + (512 + c0) * 2);
      const float rv[4] = {bflo(ur.x), bfhi(ur.x), bflo(ur.y), bfhi(ur.y)};
      const float kv[4] = {bflo(uk.x), bfhi(uk.x), bflo(uk.y), bfhi(uk.y)};
      const float vv[4] = {bflo(uv.x), bfhi(uv.x), bflo(uv.y), bfhi(uv.y)};
      float n2 = 0.f;
#pragma unroll
      for (int nt = 0; nt < 4; ++nt) { float q = kv[nt] * kkc[nt]; n2 += q * q; }
      n2 = sum16(n2);
      const float inv = 1.f / fmaxf(sqrtf(n2), 1e-12f);
      float o_kp[4], o_kk[4], o_b[4], o_df[4], o_db[4];
#pragma unroll
      for (int nt = 0; nt < 4; ++nt) {
        const float k = kv[nt];
        const float a = sigmoidf_(a0c[nt] + acc[2][nt][j]);
        const float kk = k * kkc[nt] * inv;
        o_kp[nt] = k * (1.f + (a - 1.f) * kac[nt]);
        o_kk[nt] = kk; o_b[nt] = kk * a;
        const float xf = -(w0f[nt] + acc[0][nt][j]); const float spf = fmaxf(xf, 0.f) + log1pf(__expf(-fabsf(xf)));
        const float xb = -(w0b[nt] + acc[1][nt][j]); const float spb = fmaxf(xb, 0.f) + log1pf(__expf(-fabsf(xb)));
        const float ef = __expf(-spf - 0.5f), eb = __expf(-spb - 0.5f);
        o_df[nt] = -expm1f(-ef); o_db[nt] = -expm1f(-eb);
      }
      const size_t o = row * 256 + c0;
      uint2 w;
      w.x = pack2(rv[0], rv[1]); w.y = pack2(rv[2], rv[3]); *(uint2*)(S + o) = w;
      w.x = pack2(o_kp[0], o_kp[1]); w.y = pack2(o_kp[2], o_kp[3]); *(uint2*)(S + SU + o) = w;
      w.x = pack2(vv[0], vv[1]); w.y = pack2(vv[2], vv[3]); *(uint2*)(S + 2 * SU + o) = w;
      w.x = pack2(o_kk[0], o_kk[1]); w.y = pack2(o_kk[2], o_kk[3]); *(uint2*)(S + 3 * SU + o) = w;
      w.x = pack2(o_b[0], o_b[1]); w.y = pack2(o_b[2], o_b[3]); *(uint2*)(S + 4 * SU + o) = w;
      w.x = pack2(o_df[0], o_df[1]); w.y = pack2(o_df[2], o_df[3]); *(uint2*)(S + 5 * SU + o) = w;
      w.x = pack2(o_db[0], o_db[1]); w.y = pack2(o_db[2], o_db[3]); *(uint2*)(S + 6 * SU + o) = w;
      w.x = pack2(acc[3][0][j], acc[3][1][j]); w.y = pack2(acc[3][2][j], acc[3][3][j]); *(uint2*)(Gs + o) = w;
      w.x = pack2(acc[4][0][j], acc[4][1][j]); w.y = pack2(acc[4][2][j], acc[4][3][j]); *(uint2*)(Gs + SU + o) = w;
    }
  }
}

DI long scan_row(int b, int dir, int s) {
  if (s < CL) return (long)ML + b * CL + (dir ? (CL - 1 - s) : s);
  int t = s - CL; return (long)b * SL + (dir ? (SL - 1 - t) : t);
}
DI float sum8(float v) {
  v += dpp_mov<0xB1>(v);
  v += dpp_mov<0x4E>(v);
  v += dpp_mov<0x141>(v);
  return v;
}
DI void ph_scan(const Params& p, char* smem) {
  const int tid = my_tid(), lane = tid & 63, wid = tid >> 6;
  const bf16_t* S = (const bf16_t*)(p.ws + R_STR);
  const size_t SU = (size_t)MT * 256;
  constexpr int T = 32, NSTEP = CL + SL, NCH = NSTEP / T;
  typedef float f32x2 __attribute__((ext_vector_type(2)));
  for (int u = blockIdx.x; u < 128; u += gridDim.x) {
    const int chain = u >> 1, rg = u & 1; const int dir = chain & 1, bh = chain >> 1, b = bh >> 2, h = bh & 3;
    bf16_t* O = (bf16_t*)(p.ws + (dir ? R_OB : R_OF));
    uint4 q0, q1, q2;
    auto SC_GLOAD = [&](int ci) {
#pragma unroll
      for (int j = 0; j < 3; ++j) {
        int idx = tid + j * 512; int st = idx >> 8, s = (idx & 255) >> 3, ck = idx & 7;
        long row = scan_row(b, dir, ci * T + s);
        int sid = st < 5 ? st : 5 + dir;
        uint4 v = *(const uint4*)(S + sid * SU + row * 256 + h * 64 + ck * 8);
        if (j == 0) q0 = v; else if (j == 1) q1 = v; else q2 = v;
      }
    };
    auto SC_SSTORE = [&](int buf) {
#pragma unroll
      for (int j = 0; j < 3; ++j) {
        int idx = tid + j * 512; int st = idx >> 8;
        uint4 v = j == 0 ? q0 : (j == 1 ? q1 : q2);
        float4 lo = make_float4(bflo(v.x), bfhi(v.x), bflo(v.y), bfhi(v.y));
        float4 hi = make_float4(bflo(v.z), bfhi(v.z), bflo(v.w), bfhi(v.w));
        if (st == 5) { lo.x = 1.f - lo.x; lo.y = 1.f - lo.y; lo.z = 1.f - lo.z; lo.w = 1.f - lo.w; hi.x = 1.f - hi.x; hi.y = 1.f - hi.y; hi.z = 1.f - hi.z; hi.w = 1.f - hi.w; }
        char* base = smem + buf * 49152 + idx * 32;
        *(float4*)(base) = lo; *(float4*)(base + 16) = hi;
      }
    };
    auto FLUSH = [&](int ci) {
      const int s = tid >> 4, part = tid & 15;
      unsigned v = *(const unsigned*)(smem + 98304 + (ci & 1) * 2048 + s * 64 + part * 4);
      long row = scan_row(b, dir, ci * T + s);
      *(unsigned*)(O + row * 256 + h * 64 + rg * 32 + part * 2) = v;
    };
    __syncthreads();
    SC_GLOAD(0);
    SC_SSTORE(0);
    __syncthreads();
    f32x2 st0 = {0.f, 0.f}, st1 = {0.f, 0.f}, st2 = {0.f, 0.f}, st3 = {0.f, 0.f};
    const int rsub = lane >> 3, ks = lane & 7;
    const int lrow = (wid & 3) * 8 + rsub;
    const int vrow = rg * 32 + lrow;
    struct Step { f32x2 r[4], k[4], kk[4], b[4], w[4]; float v; };
    auto LOADSTEP = [&](Step& x, const char* B, int s) {
#pragma unroll
      for (int hh = 0; hh < 2; ++hh) {
        const float4 r = *(const float4*)(B + (0 * T + s) * 256 + ks * 32 + hh * 16);
        const float4 k = *(const float4*)(B + (1 * T + s) * 256 + ks * 32 + hh * 16);
        const float4 kk = *(const float4*)(B + (3 * T + s) * 256 + ks * 32 + hh * 16);
        const float4 bb = *(const float4*)(B + (4 * T + s) * 256 + ks * 32 + hh * 16);
        const float4 w = *(const float4*)(B + (5 * T + s) * 256 + ks * 32 + hh * 16);
        x.r[2 * hh] = (f32x2){r.x, r.y}; x.r[2 * hh + 1] = (f32x2){r.z, r.w};
        x.k[2 * hh] = (f32x2){k.x, k.y}; x.k[2 * hh + 1] = (f32x2){k.z, k.w};
        x.kk[2 * hh] = (f32x2){kk.x, kk.y}; x.kk[2 * hh + 1] = (f32x2){kk.z, kk.w};
        x.b[2 * hh] = (f32x2){bb.x, bb.y}; x.b[2 * hh + 1] = (f32x2){bb.z, bb.w};
        x.w[2 * hh] = (f32x2){w.x, w.y}; x.w[2 * hh + 1] = (f32x2){w.z, w.w};
      }
      x.v = *(const float*)(B + (2 * T + s) * 256 + vrow * 4);
    };
    for (int ci = 0; ci < NCH; ++ci) {
      if (ci + 1 < NCH) { SC_GLOAD(ci + 1); }
      if (ci > 0) FLUSH(ci - 1);
      if (wid < 4) {
        const char* B = smem + (ci & 1) * 49152;
        bf16_t* ob = (bf16_t*)(smem + 98304 + (ci & 1) * 2048);
        Step nx; LOADSTEP(nx, B, 0);
#pragma unroll 2
        for (int s = 0; s < T; ++s) {
          const Step c = nx;
          LOADSTEP(nx, B, (s + 1 < T) ? s + 1 : s);
          f32x2 pa = st0 * c.kk[0] + st1 * c.kk[1];
          f32x2 pb = st2 * c.kk[2] + st3 * c.kk[3];
          pa = pa + pb;
          float sa = -(pa.x + pa.y);
          sa = sum8(sa);
          const f32x2 sa2 = {sa, sa}; const f32x2 v2 = {c.v, c.v};
          st0 = st0 * c.w[0] + sa2 * c.b[0] + v2 * c.k[0];
          st1 = st1 * c.w[1] + sa2 * c.b[1] + v2 * c.k[1];
          st2 = st2 * c.w[2] + sa2 * c.b[2] + v2 * c.k[2];
          st3 = st3 * c.w[3] + sa2 * c.b[3] + v2 * c.k[3];
          f32x2 oa = st0 * c.r[0] + st1 * c.r[1];
          f32x2 ob2 = st2 * c.r[2] + st3 * c.r[3];
          oa = oa + ob2;
          float o = sum8(oa.x + oa.y);
          if (ks == 0) ob[s * 32 + lrow] = (bf16_t)f2bf(o);
        }
      }
      if (ci + 1 < NCH) { SC_SSTORE((ci + 1) & 1); }
      __syncthreads();
    }
    FLUSH(NCH - 1);
  }
}

template <bool DIFF>
DI void attn_unit(const Params& p, int l, int b, int h, int qrow0, int qpos0, int kb_lo, int kb_hi, int kc_lo, char* smem) {
  const int tid = my_tid(), lane = tid & 63, wid = tid >> 6, g = lane >> 4, r16 = lane & 15;
  const bf16_t* QK = (const bf16_t*)(p.ws + (DIFF ? R_PDF : R_PSW));
  const int ldq = DIFF ? 512 : 384;
  const int qc0 = h * 64;
  const int kc0 = 256 + (DIFF ? h * 64 : (h >> 1) * 64);
  const bf16_t* VT = DIFF ? (const bf16_t*)(p.ws + R_VTDF) + ((size_t)b * 256 + h * 64) * KEYS
                          : (const bf16_t*)(p.ws + R_VTSW) + ((size_t)b * 128 + (h >> 1) * 64) * KEYS;
  const int nblk = (kb_hi - kb_lo) + (68 - kc_lo);
  const float sc = (DIFF ? 0.17677669529663687f : 0.125f) * 1.4426950408889634f;
  bf16x8 qf[2];
  {
    const bf16_t* qp = QK + (size_t)(qrow0 + wid * 16 + r16) * ldq + qc0 + g * 8;
    qf[0] = *(const bf16x8*)(qp); qf[1] = *(const bf16x8*)(qp + 32);
  }
  constexpr int NC = DIFF ? 2 : 1;
  float m[NC], lsum[NC];
  f32x4 O[NC][4];
#pragma unroll
  for (int c = 0; c < NC; ++c) {
    if (DIFF) { m[c] = -1e30f; lsum[c] = 0.f; }
    else { m[c] = p.in[16][l * 4 + h] * 1.4426950408889634f; lsum[c] = (g == 0) ? 1.f : 0.f; }
#pragma unroll
    for (int dt = 0; dt < 4; ++dt) O[c][dt] = (f32x4){0.f, 0.f, 0.f, 0.f};
  }
  const int lr = tid >> 3, lc = tid & 7;
  uint4 rk, rv;
#define AT_GLOAD(i)                                                                                   \
  do {                                                                                                \
    int kb = (i) < (kb_hi - kb_lo) ? kb_lo + (i) : kc_lo + ((i) - (kb_hi - kb_lo));                    \
    long krow = kb < 64 ? (long)b * SL + kb * 64 + lr : (long)ML + b * CL + (kb - 64) * 64 + lr;       \
    rk = *(const uint4*)(QK + krow * ldq + kc0 + lc * 8);                                             \
    rv = *(const uint4*)(VT + (size_t)lr * KEYS + kb * 64 + lc * 8);                                  \
  } while (0)
#define AT_SSTORE(buf)                                                                                \
  do {                                                                                                \
    *(uint4*)(smem + (buf) * 18432 + lr * 128 + ((lc ^ (lr & 7)) << 4)) = rk;                         \
    *(uint4*)(smem + (buf) * 18432 + 9216 + lr * 144 + lc * 16) = rv;                                 \
  } while (0)
  __syncthreads();
  AT_GLOAD(0);
  AT_SSTORE(0);
  __syncthreads();
  const int qpos = qpos0 + wid * 16 + r16;
  for (int i = 0; i < nblk; ++i) {
    if (i + 1 < nblk) AT_GLOAD(i + 1);
    const int kb = i < (kb_hi - kb_lo) ? kb_lo + i : kc_lo + (i - (kb_hi - kb_lo));
    const bool masked = (!DIFF) && (kb < 64);
    const char* Kt = smem + (i & 1) * 18432; const char* Vt = Kt + 9216;
    f32x4 S[NC][4];
#pragma unroll
    for (int kt = 0; kt < 4; ++kt) {
      bf16x8 k0 = *(const bf16x8*)(Kt + (kt * 16 + r16) * 128 + ((g ^ (r16 & 7)) << 4));
      bf16x8 k1 = *(const bf16x8*)(Kt + (kt * 16 + r16) * 128 + (((4 + g) ^ (r16 & 7)) << 4));
      if (DIFF) {
        S[0][kt] = __builtin_amdgcn_mfma_f32_16x16x32_bf16(k0, qf[0], (f32x4){0.f, 0.f, 0.f, 0.f}, 0, 0, 0);
        S[NC - 1][kt] = __builtin_amdgcn_mfma_f32_16x16x32_bf16(k1, qf[1], (f32x4){0.f, 0.f, 0.f, 0.f}, 0, 0, 0);
      } else {
        f32x4 t = __builtin_amdgcn_mfma_f32_16x16x32_bf16(k0, qf[0], (f32x4){0.f, 0.f, 0.f, 0.f}, 0, 0, 0);
        S[0][kt] = __builtin_amdgcn_mfma_f32_16x16x32_bf16(k1, qf[1], t, 0, 0, 0);
      }
    }
    bf16x8 pf[NC][2];
#pragma unroll
    for (int c = 0; c < NC; ++c) {
      float mx = -1e30f;
#pragma unroll
      for (int kt = 0; kt < 4; ++kt)
#pragma unroll
        for (int j = 0; j < 4; ++j) {
          float v = S[c][kt][j];
          if (masked) { int kpos = kb * 64 + kt * 16 + g * 4 + j; int dd = kpos - qpos; if (dd > 128 || dd < -128) v = -3e38f; S[c][kt][j] = v; }
          mx = fmaxf(mx, v);
        }
      mx *= sc;
      mx = fmaxf(mx, __shfl_xor(mx, 16)); mx = fmaxf(mx, __shfl_xor(mx, 32));
      const float mn = fmaxf(m[c], mx);
      const bool grow = mn > m[c];
      float ps = 0.f;
      unsigned pk[8];
#pragma unroll
      for (int kt = 0; kt < 4; ++kt) {
        float e0 = __builtin_amdgcn_exp2f(fmaf(S[c][kt][0], sc, -mn)), e1 = __builtin_amdgcn_exp2f(fmaf(S[c][kt][1], sc, -mn));
        float e2 = __builtin_amdgcn_exp2f(fmaf(S[c][kt][2], sc, -mn)), e3 = __builtin_amdgcn_exp2f(fmaf(S[c][kt][3], sc, -mn));
        ps += (e0 + e1) + (e2 + e3);
        pk[kt * 2] = pack2(e0, e1); pk[kt * 2 + 1] = pack2(e2, e3);
      }
      if (__builtin_amdgcn_ballot_w64(grow) != 0ull) {
        const float alpha = __builtin_amdgcn_exp2f(m[c] - mn);
        m[c] = mn;
        lsum[c] *= alpha;
#pragma unroll
        for (int dt = 0; dt < 4; ++dt) { O[c][dt][0] *= alpha; O[c][dt][1] *= alpha; O[c][dt][2] *= alpha; O[c][dt][3] *= alpha; }
      }
      lsum[c] += ps;
      union { unsigned u[4]; bf16x8 v; } cv;
      cv.u[0] = pk[0]; cv.u[1] = pk[1]; cv.u[2] = pk[2]; cv.u[3] = pk[3]; pf[c][0] = cv.v;
      cv.u[0] = pk[4]; cv.u[1] = pk[5]; cv.u[2] = pk[6]; cv.u[3] = pk[7]; pf[c][1] = cv.v;
    }
#pragma unroll
    for (int dt = 0; dt < 4; ++dt)
#pragma unroll
      for (int s2 = 0; s2 < 2; ++s2) {
        union { uint2 u[2]; bf16x8 v; } vf;
        vf.u[0] = *(const uint2*)(Vt + (dt * 16 + r16) * 144 + (2 * s2) * 32 + g * 8);
        vf.u[1] = *(const uint2*)(Vt + (dt * 16 + r16) * 144 + (2 * s2 + 1) * 32 + g * 8);
#pragma unroll
        for (int c = 0; c < NC; ++c) O[c][dt] = __builtin_amdgcn_mfma_f32_16x16x32_bf16(vf.v, pf[c][s2], O[c][dt], 0, 0, 0);
      }
    if (i + 1 < nblk) AT_SSTORE((i + 1) & 1);
    __syncthreads();
  }
#undef AT_GLOAD
#undef AT_SSTORE
  float linv[NC];
#pragma unroll
  for (int c = 0; c < NC; ++c) { float t = lsum[c]; t += __shfl_xor(t, 16); t += __shfl_xor(t, 32); linv[c] = 1.f / t; }
  const size_t orow = (size_t)(qrow0 + wid * 16 + r16);
  if (!DIFF) {
    bf16_t* Y = (bf16_t*)(p.ws + R_YSW);
#pragma unroll
    for (int dt = 0; dt < 4; ++dt) {
      uint2 o; o.x = pack2(O[0][dt][0] * linv[0], O[0][dt][1] * linv[0]); o.y = pack2(O[0][dt][2] * linv[0], O[0][dt][3] * linv[0]);
      *(uint2*)(Y + orow * 256 + h * 64 + dt * 16 + g * 4) = o;
    }
  } else {
    const float lam_init = 0.8f - 0.6f * __expf(-0.3f * (float)l);
    float d1 = 0.f, d2 = 0.f;
    if (lane < 32) { d1 = p.in[28][l * 32 + lane] * p.in[29][l * 32 + lane]; d2 = p.in[30][l * 32 + lane] * p.in[31][l * 32 + lane]; }
    d1 = wave_sum(d1); d2 = wave_sum(d2);
    const float lam = expf(d1) - expf(d2) + lam_init;
    float ov[4][4]; float ss = 0.f;
#pragma unroll
    for (int dt = 0; dt < 4; ++dt)
#pragma unroll
      for (int j = 0; j < 4; ++j) { float v = O[0][dt][j] * linv[0] - lam * O[NC - 1][dt][j] * linv[NC - 1]; ov[dt][j] = v; ss += v * v; }
    ss += __shfl_xor(ss, 16); ss += __shfl_xor(ss, 32);
    const float rms = rsqrtf(ss * (1.f / 64.f) + 1e-5f) * (1.f - lam_init);
    const float* sg = p.in[32] + l * 64;
    bf16_t* Y = (bf16_t*)(p.ws + R_YDF);
#pragma unroll
    for (int dt = 0; dt < 4; ++dt) {
      const int d0 = dt * 16 + g * 4;
      uint2 o; o.x = pack2(ov[dt][0] * rms * sg[d0], ov[dt][1] * rms * sg[d0 + 1]); o.y = pack2(ov[dt][2] * rms * sg[d0 + 2], ov[dt][3] * rms * sg[d0 + 3]);
      *(uint2*)(Y + orow * 256 + h * 64 + d0) = o;
    }
  }
}

DI void ph_attn(const Params& p, int l, char* smem) {
  const bool need_ctx = (l == 0);
  const int n_sw = 1024 + (need_ctx ? 64 : 0);
  const int n_df = 1024 + (need_ctx ? 64 : 0);
  unsigned* ctr = (unsigned*)(p.ws + MISC_BAR + 64 + 64 * l);
  volatile int* slot = (volatile int*)(smem + 40960);
  for (;;) {
    __syncthreads();
    if (my_tid() == 0) *slot = (int)__hip_atomic_fetch_add(ctr, 1u, __ATOMIC_RELAXED, __HIP_MEMORY_SCOPE_AGENT);
    __syncthreads();
    const int u = *slot;
    if (u >= n_sw + n_df) break;
    if (u < n_df) {
      if (u < 1024) { int b = u >> 7, h = (u >> 5) & 3, n = u & 31; attn_unit<true>(p, l, b, h, b * SL + n * 128, n * 128, 0, 64, 64, smem); }
      else { int v = u - 1024; int b = v >> 3, h = (v >> 1) & 3, n = v & 1; attn_unit<true>(p, l, b, h, ML + b * CL + n * 128, 0, 0, 0, 64, smem); }
    } else {
      int w = u - n_df;
      if (w < 1024) {
        int b = w >> 7, h = (w >> 5) & 3, n = w & 31;
        int lo = (n - 1) * 2; if (lo < 0) lo = 0; int hi = (n + 2) * 2; if (hi > 64) hi = 64;
        attn_unit<false>(p, l, b, h, b * SL + n * 128, n * 128, lo, hi, 64, smem);
      } else { int v = w - 1024; int b = v >> 3, h = (v >> 1) & 3, n = v & 1; attn_unit<false>(p, l, b, h, ML + b * CL + n * 128, 0, 0, 0, 64, smem); }
    }
  }
}

DI void ph_rwout(const Params& p, int l) {
  const int lane = my_tid() & 63, wid = my_tid() >> 6;
  const bf16_t* S = (const bf16_t*)(p.ws + R_STR); const bf16_t* Gs = (const bf16_t*)(p.ws + R_G);
  const bf16_t* OF = (const bf16_t*)(p.ws + R_OF); const bf16_t* OB = (const bf16_t*)(p.ws + R_OB);
  bf16_t* Y = (bf16_t*)(p.ws + R_YRW);
  const size_t SU = (size_t)MT * 256;
  const float4 rk = *(const float4*)(p.in[25] + (size_t)l * 256 + lane * 4);
  const float4 gam = *(const float4*)(p.in[26] + (size_t)l * 256 + lane * 4);
  const float4 bet = *(const float4*)(p.in[27] + (size_t)l * 256 + lane * 4);
  const int nrows = (l == 0) ? MT : ML;
  for (int row = blockIdx.x * 8 + wid; row < nrows; row += gridDim.x * 8) {
    const size_t o = (size_t)row * 256 + lane * 4;
    uint2 ur = *(const uint2*)(S + o), uk = *(const uint2*)(S + SU + o), uv = *(const uint2*)(S + 2 * SU + o);
    uint2 uf = *(const uint2*)(OF + o), ub = *(const uint2*)(OB + o), ugf = *(const uint2*)(Gs + o), ugb = *(const uint2*)(Gs + SU + o);
    float r[4] = {bflo(ur.x), bfhi(ur.x), bflo(ur.y), bfhi(ur.y)};
    float k[4] = {bflo(uk.x), bfhi(uk.x), bflo(uk.y), bfhi(uk.y)};
    float v[4] = {bflo(uv.x), bfhi(uv.x), bflo(uv.y), bfhi(uv.y)};
    float f[4] = {bflo(uf.x), bfhi(uf.x), bflo(uf.y), bfhi(uf.y)};
    float bb[4] = {bflo(ub.x), bfhi(ub.x), bflo(ub.y), bfhi(ub.y)};
    float gf[4] = {bflo(ugf.x), bfhi(ugf.x), bflo(ugf.y), bfhi(ugf.y)};
    float gb[4] = {bflo(ugb.x), bfhi(ugb.x), bflo(ugb.y), bfhi(ugb.y)};
    const float rkv[4] = {rk.x, rk.y, rk.z, rk.w}; const float ga[4] = {gam.x, gam.y, gam.z, gam.w}; const float be[4] = {bet.x, bet.y, bet.z, bet.w};
    float bon = 0.f, sf = 0.f, sb = 0.f;
#pragma unroll
    for (int i = 0; i < 4; ++i) { bon += r[i] * k[i] * rkv[i]; sf += f[i]; sb += bb[i]; }
    bon = sum16(bon); float muf = sum16(sf) * (1.f / 64.f), mub = sum16(sb) * (1.f / 64.f);
    float qf = 0.f, qb = 0.f;
#pragma unroll
    for (int i = 0; i < 4; ++i) { f[i] -= muf; bb[i] -= mub; qf += f[i] * f[i]; qb += bb[i] * bb[i]; }
    float rsf = rsqrtf(sum16(qf) * (1.f / 64.f) + 64e-5f), rsb = rsqrtf(sum16(qb) * (1.f / 64.f) + 64e-5f);
    float y[4];
#pragma unroll
    for (int i = 0; i < 4; ++i) {
      float bn = bon * v[i];
      y[i] = (f[i] * rsf * ga[i] + be[i] + bn) * gf[i] + (bb[i] * rsb * ga[i] + be[i] + bn) * gb[i];
    }
    uint2 oo; oo.x = pack2(y[0], y[1]); oo.y = pack2(y[2], y[3]);
    *(uint2*)(Y + o) = oo;
  }
}

DI void ph_merge(const Params& p, int l, const bf16_t* U, char* smem) {
  const int lane = my_tid() & 63, wid = my_tid() >> 6, wm = wid >> 1, wn = wid & 1, g = lane >> 4, r16 = lane & 15;
  const int mtiles = (l == 0) ? 136 : 128;
  bf16_t* ACC = (bf16_t*)(p.ws + R_ACC);
  for (int it = 0;; ++it) {
    int mtile, ntile;
    if (!next_tile(it, mtiles, 8, mtile, ntile)) break;
    uint2 accS[4][4];
#pragma unroll
    for (int mt = 0; mt < 4; ++mt)
#pragma unroll
      for (int nt = 0; nt < 4; ++nt) accS[mt][nt] = make_uint2(0u, 0u);
    for (int j = 0; j < 4; ++j) {
      uint2 pb[4][4];
      {
        f32x4 accB[4][4]; zero_acc<4>(accB);
        const size_t yoff = (j == 0) ? R_YHY : (j == 1) ? R_YSW : (j == 2) ? R_YRW : R_YDF;
        gemm_glds(accB, (const bf16_t*)(p.ws + yoff), 256, RowPlain{(long)mtile * 256}, (const bf16_t*)(p.ws + WB_BR) + ((size_t)j * 1024 + ntile * 128) * 256, 256, 256, smem, (const bf16_t*)(p.ws + MISC_ZERO));
#pragma unroll
        for (int mt = 0; mt < 4; ++mt)
#pragma unroll
          for (int nt = 0; nt < 4; ++nt) { pb[mt][nt].x = pack2(accB[mt][nt][0], accB[mt][nt][1]); pb[mt][nt].y = pack2(accB[mt][nt][2], accB[mt][nt][3]); }
      }
      f32x4 accG[4][4]; zero_acc<4>(accG);
      gemm_glds(accG, U, 1024, RowPlain{(long)mtile * 256}, (const bf16_t*)(p.ws + WB_GATE) + ((size_t)j * 1024 + ntile * 128) * 1024, 1024, 1024, smem, (const bf16_t*)(p.ws + MISC_ZERO));
#pragma unroll
      for (int mt = 0; mt < 4; ++mt)
#pragma unroll
        for (int nt = 0; nt < 4; ++nt) {
          float v0 = bflo(accS[mt][nt].x) + sigmoidf_(accG[mt][nt][0]) * bflo(pb[mt][nt].x);
          float v1 = bfhi(accS[mt][nt].x) + sigmoidf_(accG[mt][nt][1]) * bfhi(pb[mt][nt].x);
          float v2 = bflo(accS[mt][nt].y) + sigmoidf_(accG[mt][nt][2]) * bflo(pb[mt][nt].y);
          float v3 = bfhi(accS[mt][nt].y) + sigmoidf_(accG[mt][nt][3]) * bfhi(pb[mt][nt].y);
          accS[mt][nt].x = pack2(v0, v1); accS[mt][nt].y = pack2(v2, v3);
        }
    }
#pragma unroll
    for (int mt = 0; mt < 4; ++mt) {
      const int col = ntile * 128 + wn * 64 + r16 * 4;
      const size_t row = (size_t)mtile * 256 + wm * 64 + mt * 16 + g * 4;
      uint2 o;
      o.x = (accS[mt][0].x & 0xffffu) | (accS[mt][1].x << 16); o.y = (accS[mt][2].x & 0xffffu) | (accS[mt][3].x << 16);
      *(uint2*)(ACC + (row + 0) * 1024 + col) = o;
      o.x = (accS[mt][0].x >> 16) | (accS[mt][1].x & 0xffff0000u); o.y = (accS[mt][2].x >> 16) | (accS[mt][3].x & 0xffff0000u);
      *(uint2*)(ACC + (row + 1) * 1024 + col) = o;
      o.x = (accS[mt][0].y & 0xffffu) | (accS[mt][1].y << 16); o.y = (accS[mt][2].y & 0xffffu) | (accS[mt][3].y << 16);
      *(uint2*)(ACC + (row + 2) * 1024 + col) = o;
      o.x = (accS[mt][0].y >> 16) | (accS[mt][1].y & 0xffff0000u); o.y = (accS[mt][2].y >> 16) | (accS[mt][3].y & 0xffff0000u);
      *(uint2*)(ACC + (row + 3) * 1024 + col) = o;
    }
  }
}

DI void ph_resgemm(const Params& p, int l, const bf16_t* A, int K, const bf16_t* Bt, const float* hsrc_lat, const float* hsrc_ctx, int gate_off, char* smem) {
  const int lane = my_tid() & 63, wid = my_tid() >> 6, wm = wid >> 1, wn = wid & 1, g = lane >> 4, r16 = lane & 15;
  const int mtiles = (l == 0) ? 136 : 128;
  const float* mod = (const float*)(p.ws + MISC_MOD) + (size_t)l * 9 * 6144;
  float* hc = (float*)(p.ws + OFF_HC);
  for (int it = 0;; ++it) {
    int mtile, ntile;
    if (!next_tile(it, mtiles, 8, mtile, ntile)) break;
    f32x4 acc[4][4]; zero_acc<4>(acc);
    gemm_glds(acc, A, K, RowPlain{(long)mtile * 256}, Bt + (size_t)ntile * 128 * K, K, K, smem, (const bf16_t*)(p.ws + MISC_ZERO));
    const int b = mtile < 128 ? (mtile >> 4) : 8;
    const float* gt = mod + (size_t)b * 6144 + gate_off;
    const int col = ntile * 128 + wn * 64 + r16 * 4;
    const float4 gv = *(const float4*)(gt + col);
#pragma unroll
    for (int mt = 0; mt < 4; ++mt)
#pragma unroll
      for (int e = 0; e < 4; ++e) {
        const int row = mtile * 256 + wm * 64 + mt * 16 + g * 4 + e;
        const float* hs; float* hd;
        if (row < ML) { size_t o = (size_t)row * D + col; hs = hsrc_lat + o; hd = p.out + o; }
        else { size_t o = (size_t)(row - ML) * D + col; hs = hsrc_ctx + o; hd = hc + o; }
        const float4 h = *(const float4*)hs;
        float4 r;
        r.x = DN_ALPHA * h.x + gv.x * acc[mt][0][e]; r.y = DN_ALPHA * h.y + gv.y * acc[mt][1][e];
        r.z = DN_ALPHA * h.z + gv.z * acc[mt][2][e]; r.w = DN_ALPHA * h.w + gv.w * acc[mt][3][e];
        *(float4*)hd = r;
      }
  }
}

DI void ph_ffnup(const Params& p, int l, char* smem) {
  const bf16_t* U = (const bf16_t*)(p.ws + R_U);
  const bf16_t* Bt = (const bf16_t*)(p.ws + WB_UP);
  bf16_t* HID = (bf16_t*)(p.ws + R_HID);
  const float* cw = p.in[38] + (size_t)l * 3 * 5632; const float* cb = p.in[39] + (size_t)l * 5632;
  const int tid = my_tid(), lane = tid & 63, wid = tid >> 6, wm = wid >> 2, wn = wid & 3, g = lane >> 4, r16 = lane & 15;
  const int mtiles = (l == 0) ? 152 : 136;
  constexpr int TS = 528;
  for (int it = 0;; ++it) {
    int mtile, ntile;
    if (!next_tile(it, mtiles, 22, mtile, ntile)) break;
    long rowbase; int tt, len;
    if (mtile < 136) { int b = mtile / 17; tt = mtile % 17; len = SL; rowbase = (long)b * SL; }
    else { int v = mtile - 136; int b = v >> 1; tt = v & 1; len = CL; rowbase = (long)ML + b * CL; }
    f32x4 acc[8][4]; zero_acc256(acc);
    gemm_glds256(acc, U, 1024, rowbase + tt * 254 - 1, Bt + (size_t)ntile * 256 * 1024, 1024, 1024, smem);
#pragma unroll
    for (int mt = 0; mt < 8; ++mt)
#pragma unroll
      for (int e = 0; e < 4; ++e) {
        uint2 o; o.x = pack2(acc[mt][0][e], acc[mt][1][e]); o.y = pack2(acc[mt][2][e], acc[mt][3][e]);
        *(uint2*)(smem + (wm * 128 + mt * 16 + g * 4 + e) * TS + (wn * 64 + r16 * 4) * 2) = o;
      }
    __syncthreads();
    {
      const int ch = tid & 127, rgp = tid >> 7; const int ca = ntile * 128 + ch, cbx = 2816 + ca;
      const float a0 = cw[ca], a1 = cw[5632 + ca], a2 = cw[2 * 5632 + ca], ab = cb[ca];
      const float b0 = cw[cbx], b1 = cw[5632 + cbx], b2 = cw[2 * 5632 + cbx], bb = cb[cbx];
      for (int r = 1 + rgp; r <= 254; r += 4) {
        const int tok = tt * 254 - 1 + r;
        if (tok < len) {
          const char* Tr = smem + r * TS + ch * 2;
          const float pa = tok >= 1 ? bf2f(*(const bf16_t*)(Tr - TS)) : 0.f, pb_ = tok >= 1 ? bf2f(*(const bf16_t*)(Tr - TS + 256)) : 0.f;
          const float na = tok + 1 < len ? bf2f(*(const bf16_t*)(Tr + TS)) : 0.f, nb = tok + 1 < len ? bf2f(*(const bf16_t*)(Tr + TS + 256)) : 0.f;
          const float av = a0 * pa + a1 * bf2f(*(const bf16_t*)(Tr)) + a2 * na + ab;
          const float bv = b0 * pb_ + b1 * bf2f(*(const bf16_t*)(Tr + 256)) + b2 * nb + bb;
          HID[(size_t)(rowbase + tok) * 2816 + ca] = (bf16_t)f2bf(siluf_(av) * bv);
        }
      }
    }
  }
}

#ifndef REP_PREP
#define REP_PREP 1
#endif
#ifndef REP_GEMM
#define REP_GEMM 1
#endif
#ifndef REP_HY
#define REP_HY 1
#endif
#ifndef REP_RWP
#define REP_RWP 1
#endif
#ifndef REP_SCAN
#define REP_SCAN 1
#endif
#ifndef REP_ATTN
#define REP_ATTN 1
#endif
#ifndef PH_END
#define PH_END 24
#endif
DI void grid_barrier(unsigned* bar, unsigned& epoch) {
  __syncthreads();
  epoch += 1;
  if (my_tid() == 0) {
    __threadfence();
    const unsigned target = epoch * gridDim.x;
    __hip_atomic_fetch_add(bar, 1u, __ATOMIC_RELAXED, __HIP_MEMORY_SCOPE_AGENT);
    while (__hip_atomic_load(bar, __ATOMIC_RELAXED, __HIP_MEMORY_SCOPE_AGENT) < target) __builtin_amdgcn_s_sleep(1);
    __threadfence();
  }
  __syncthreads();
}
#define SYNC_OR_RET(idx) do { if ((idx) + 1 >= PH_END) return; if ((idx) == 0) grid.sync(); else grid_barrier((unsigned*)(p.ws + MISC_BAR), epoch); } while (0)
template <int l>
DI void run_layer(const Params& p, cg::grid_group& grid, char* smem, unsigned& epoch) {
  const float* mod = (const float*)(p.ws + MISC_MOD) + (size_t)l * 9 * 6144;
  float* hc = (float*)(p.ws + OFF_HC);
  const float* hl_src = (l == 0) ? p.in[0] : p.out;
  const float* hc_src = (l == 0) ? p.in[2] : hc;
  constexpr int B0 = l * 12;
  if (l == 0) {
    ph_convert(p, 0, smem);
    ph_ada(p, smem);
    hy_rawfilter(p, 0, SL, (float*)(p.ws + R_RAWF), smem);
    hy_rawfilter(p, 0, CL, (float*)(p.ws + MISC_RAWC), smem);
    SYNC_OR_RET(B0 + 0);
    ph_kf(p, 0, smem);
    ph_ln(hl_src, hc_src, nullptr, nullptr, nullptr, nullptr, (bf16_t*)p.out, mod, 0, MT);
    SYNC_OR_RET(B0 + 1);
  }
  for (int rep = 0; rep < REP_GEMM; ++rep) ph_inproj(p, l == 0 ? (const bf16_t*)p.out : (const bf16_t*)(p.ws + R_U), smem);
  SYNC_OR_RET(B0 + 2);
  for (int rep = 0; rep < REP_HY; ++rep) {
  if (blockIdx.x == 0 && my_tid() == 0) *(unsigned*)(p.ws + MISC_BAR + 64 + 64 * l) = 0u;
  ph_hyena(p, l, smem);
  if (l == 0) ph_hyena_ctx(p, l, smem);
  }
  ph_rope(p, smem);
  for (int rep = 0; rep < REP_RWP; ++rep) ph_rwprep(p, l, smem);
  SYNC_OR_RET(B0 + 3);
  for (int rep = 0; rep < REP_SCAN; ++rep) ph_scan(p, smem);
  for (int rep = 0; rep < REP_ATTN; ++rep) ph_attn(p, l, smem);
  SYNC_OR_RET(B0 + 4);
  ph_rwout(p, l);
  if (l != 0) ph_ln(hl_src, hc_src, nullptr, nullptr, nullptr, nullptr, (bf16_t*)(p.ws + R_URE), mod, 0, ML);
  SYNC_OR_RET(B0 + 5);
  for (int rep = 0; rep < REP_GEMM; ++rep) ph_merge(p, l, l == 0 ? (const bf16_t*)p.out : (const bf16_t*)(p.ws + R_URE), smem);
  SYNC_OR_RET(B0 + 6);
  ph_resgemm(p, l, (const bf16_t*)(p.ws + R_ACC), 1024, (const bf16_t*)(p.ws + WB_OUT), hl_src, hc_src, 2048, smem);
  if (l == 0) hy_rawfilter(p, 1, SL, (float*)(p.ws + R_RAWF), smem);
  SYNC_OR_RET(B0 + 7);
  ph_ln(p.out, hc, p.out, hc, p.in[35] + (size_t)l * D, p.in[36] + (size_t)l * D, (bf16_t*)(p.ws + R_U), mod, 3072, l == 0 ? MT : ML);
  if (l == 0) ph_kf(p, 1, smem);
  SYNC_OR_RET(B0 + 8);
  for (int rep = 0; rep < REP_GEMM; ++rep) ph_ffnup(p, l, smem);
  SYNC_OR_RET(B0 + 9);
  ph_resgemm(p, l, (const bf16_t*)(p.ws + R_HID), 2816, (const bf16_t*)(p.ws + WB_DOWN), p.out, hc, 5120, smem);
  SYNC_OR_RET(B0 + 10);
  if (l == 0) {
    ph_ln(p.out, hc, p.out, hc, p.in[41], p.in[42], (bf16_t*)(p.ws + R_U), mod + 9 * 6144, 0, MT);
    ph_convert(p, 1, smem);
  } else {
    ph_ln(p.out, hc, p.out, hc, p.in[41] + (size_t)l * D, p.in[42] + (size_t)l * D, nullptr, mod, 0, ML);
  }
  SYNC_OR_RET(B0 + 11);
}

__global__ void __launch_bounds__(NTHR) mega(Params p) {
  extern __shared__ __attribute__((aligned(16))) char smem[];
  cg::grid_group grid = cg::this_grid();
  unsigned epoch = 0;
  if (blockIdx.x == 0 && my_tid() == 0) *(unsigned*)(p.ws + MISC_BAR) = 0u;
  if (blockIdx.x == 0 && my_tid() < 64) *(unsigned*)(p.ws + MISC_ZERO + my_tid() * 4) = 0u;
  run_layer<0>(p, grid, smem, epoch);
  if (PH_END > 12) run_layer<1>(p, grid, smem, epoch);
}

extern "C" void kernel_launch(void* const* d_in, const int* in_sizes, int n_in, void* d_out, int out_size,
                              void* d_ws, size_t ws_size, hipStream_t stream) {
  static int grid_blocks = 0;
  if (!grid_blocks) {
    int dev = 0, cus = 0, per_cu = 0;
    (void)hipGetDevice(&dev);
    (void)hipDeviceGetAttribute(&cus, hipDeviceAttributeMultiprocessorCount, dev);
    (void)hipFuncSetAttribute((const void*)mega, hipFuncAttributeMaxDynamicSharedMemorySize, SMEM_BYTES);
    (void)hipOccupancyMaxActiveBlocksPerMultiprocessor(&per_cu, mega, NTHR, SMEM_BYTES);
    if (per_cu < 1) per_cu = 1;
    if (per_cu > 1) per_cu = 1;
    grid_blocks = cus * per_cu;
  }
  Params p{};
  for (int i = 0; i < 43; ++i) p.in[i] = (const float*)d_in[i];
  p.out = (float*)d_out; p.ws = (char*)d_ws;
  void* args[] = {&p};
  hipError_t e = hipLaunchCooperativeKernel((void*)mega, dim3(grid_blocks), dim3(NTHR), args, SMEM_BYTES, stream);
  if (e != hipSuccess) fprintf(stderr, "cooperative launch failed: %s (grid %d)\n", hipGetErrorString(e), grid_blocks);
}
```

```cpp
#include <hip/hip_runtime.h>
#include <hip/hip_cooperative_groups.h>
#include <cstdio>
#include <cstdint>
namespace cg = cooperative_groups;

#define DI __device__ __forceinline__
typedef unsigned short bf16_t;
typedef short bf16x8 __attribute__((ext_vector_type(8)));
typedef float f32x4 __attribute__((ext_vector_type(4)));

constexpr int D = 1024, NB = 8, SL = 4096, CL = 256;
constexpr int ML = NB * SL, MC = NB * CL, MT = ML + MC;
constexpr int KEYS = SL + CL;
constexpr int NTHR = 512;
constexpr float DN_ALPHA = 1.41421356237f;
constexpr size_t UNIT = (size_t)MT * 512;

constexpr size_t WB_IN = 0;
constexpr size_t WB_GATE = WB_IN + (size_t)3328 * 1024 * 2;
constexpr size_t WB_BR = WB_GATE + (size_t)4096 * 1024 * 2;
constexpr size_t WB_OUT = WB_BR + (size_t)4 * 1024 * 256 * 2;
constexpr size_t WB_UP = WB_OUT + (size_t)1024 * 1024 * 2;
constexpr size_t WB_DOWN = WB_UP + (size_t)5632 * 1024 * 2;
constexpr size_t WB_END = WB_DOWN + (size_t)1024 * 2816 * 2;
constexpr size_t OFF_KF = WB_END;
constexpr size_t OFF_HC = OFF_KF + (size_t)512 * 8192 * 8;
constexpr size_t OFF_MISC = OFF_HC + (size_t)MC * D * 4;
constexpr size_t MISC_MOD = OFF_MISC;
constexpr size_t MISC_TW = MISC_MOD + (size_t)2 * 9 * 6144 * 4;
constexpr size_t MISC_RAWC = MISC_TW + 4096 * 8;
constexpr size_t MISC_GCTX = MISC_RAWC + (size_t)256 * 1024 * 4;
constexpr size_t MISC_RWW = MISC_GCTX + (size_t)512 * 512 * 4;
constexpr size_t RWW_F = MISC_RWW, RWW_B = RWW_F + 256 * 64 * 2, RWW_A = RWW_B + 256 * 64 * 2, RWW_GF = RWW_A + 256 * 64 * 2, RWW_GB = RWW_GF + 256 * 128 * 2;
constexpr size_t MISC_XBAR = OFF_MISC + (size_t)3 * 1024 * 1024;
constexpr size_t OFF_R = OFF_MISC + (size_t)4 * 1024 * 1024;
constexpr size_t MISC_BAR = OFF_R - 256;
constexpr size_t MISC_ZERO = OFF_R - 512;
static_assert(RWW_GB + 256 * 128 * 2 <= MISC_ZERO, "misc overflow");
constexpr size_t R_YHY = OFF_R, R_YSW = OFF_R + UNIT, R_YDF = OFF_R + 2 * UNIT;
constexpr size_t R_PHY = OFF_R + 3 * UNIT;
constexpr size_t R_PSW = OFF_R + 6 * UNIT;
constexpr size_t R_VTSW = R_PSW + (size_t)MT * 384 * 2;
constexpr size_t R_PDF = OFF_R + 8 * UNIT;
constexpr size_t R_VTDF = OFF_R + 10 * UNIT;
constexpr size_t R_PRW = OFF_R + 11 * UNIT;
constexpr size_t R_STR = R_PRW + (size_t)MT * 1216 * 2;
constexpr size_t R_G = R_STR + 7 * UNIT;
constexpr size_t R_END = R_G + 2 * UNIT;
constexpr size_t R_RAWF = OFF_R;
constexpr size_t R_OF = R_PHY, R_OB = R_PHY + UNIT;
constexpr size_t R_URE = R_PSW;
constexpr size_t R_YRW = R_VTDF;
constexpr size_t R_ACC = R_PRW;
constexpr size_t R_U = R_STR;
constexpr size_t R_HID = OFF_R;
static_assert(R_END <= (size_t)512 * 1024 * 1024, "ws overflow");
static_assert((size_t)MT * 2816 * 2 <= 11 * UNIT, "hid");

constexpr int SMEM_BYTES = 144 * 1024 + 64;

struct Params {
  const float* in[43];
  float* out;
  char* ws;
};

DI int my_tid() { int t = (int)__builtin_amdgcn_workitem_id_x(); asm volatile("" : "+v"(t)); return t; }
DI unsigned f2bf(float f) { unsigned u = __float_as_uint(f); u += 0x7fffu + ((u >> 16) & 1u); return u >> 16; }
DI float bf2f(unsigned h) { return __uint_as_float(h << 16); }
typedef __bf16 bf16v2_t __attribute__((ext_vector_type(2)));
typedef float f32v2_t __attribute__((ext_vector_type(2)));
DI unsigned pack2(float lo, float hi) { f32v2_t v = {lo, hi}; bf16v2_t b = __builtin_convertvector(v, bf16v2_t); return __builtin_bit_cast(unsigned, b); }

DI float bflo(unsigned w) { return __uint_as_float(w << 16); }
DI float bfhi(unsigned w) { return __uint_as_float(w & 0xffff0000u); }
DI float sigmoidf_(float x) { return 1.f / (1.f + __expf(-x)); }
DI float siluf_(float x) { return x / (1.f + __expf(-x)); }
DI float wave_sum(float v) {
#pragma unroll
  for (int o = 32; o >= 1; o >>= 1) v += __shfl_xor(v, o);
  return v;
}
template <int CTRL> DI float dpp_mov(float v) {
  return __int_as_float(__builtin_amdgcn_update_dpp(0, __float_as_int(v), CTRL, 0xf, 0xf, false));
}
DI float sum16(float v) {
  v += dpp_mov<0xB1>(v);
  v += dpp_mov<0x4E>(v);
  v += dpp_mov<0x141>(v);
  v += dpp_mov<0x140>(v);
  return v;
}
DI void lds_barrier() { asm volatile("s_waitcnt lgkmcnt(0)" ::: "memory"); __builtin_amdgcn_s_barrier(); asm volatile("" ::: "memory"); }
DI uint4 sel4(bool z, uint4 v) { return make_uint4(z ? 0u : v.x, z ? 0u : v.y, z ? 0u : v.z, z ? 0u : v.w); }
DI int mod_idx(int row) { return row < ML ? (row >> 12) : 8; }

template <int NTW, bool DEEP, class RowFn>
DI void gemm_main(f32x4 (&acc)[4][NTW], const bf16_t* __restrict__ A, int lda, RowFn rowfn,
                  const bf16_t* __restrict__ Bt, int ldb, int K, char* smem) {
  constexpr int BN = NTW * 32;
  constexpr int A_BYTES = 256 * 128, B_BYTES = BN * 128, STAGE = A_BYTES + B_BYTES;
  constexpr int NBL = BN / 64;
  const int tid = my_tid(), lane = tid & 63, wid = tid >> 6, wm = wid >> 1, wn = wid & 1, g = lane >> 4, r16 = lane & 15;
  const int chunk = tid & 7, lrow = tid >> 3;
  long a0 = rowfn(lrow), a1 = rowfn(lrow + 64), a2 = rowfn(lrow + 128), a3 = rowfn(lrow + 192);
  const long c0 = a0 < 0 ? 0 : a0, c1 = a1 < 0 ? 0 : a1, c2 = a2 < 0 ? 0 : a2, c3 = a3 < 0 ? 0 : a3;
  const bf16_t* Bp = Bt + (long)lrow * ldb + chunk * 8;
  const bf16_t* Ap0 = A + c0 * lda + chunk * 8; const bf16_t* Ap1 = A + c1 * lda + chunk * 8;
  const bf16_t* Ap2 = A + c2 * lda + chunk * 8; const bf16_t* Ap3 = A + c3 * lda + chunk * 8;
  struct Regs { uint4 a0, a1, a2, a3, b0, b1; };
  Regs R0, R1;
  R0.b1 = make_uint4(0, 0, 0, 0); R1.b1 = make_uint4(0, 0, 0, 0);
  auto GLOAD = [&](Regs& R, int k0) {
    R.a0 = *(const uint4*)(Ap0 + k0); R.a1 = *(const uint4*)(Ap1 + k0);
    R.a2 = *(const uint4*)(Ap2 + k0); R.a3 = *(const uint4*)(Ap3 + k0);
    R.b0 = *(const uint4*)(Bp + k0);
    if constexpr (NBL > 1) R.b1 = *(const uint4*)(Bp + (long)64 * ldb + k0);
  };
  auto SSTORE = [&](const Regs& R, int st) {
    char* base = smem + st * STAGE + lrow * 128 + ((chunk ^ (lrow & 7)) << 4);
    *(uint4*)(base) = sel4(a0 < 0, R.a0); *(uint4*)(base + 64 * 128) = sel4(a1 < 0, R.a1);
    *(uint4*)(base + 128 * 128) = sel4(a2 < 0, R.a2); *(uint4*)(base + 192 * 128) = sel4(a3 < 0, R.a3);
    *(uint4*)(base + A_BYTES) = R.b0;
    if constexpr (NBL > 1) *(uint4*)(base + A_BYTES + 64 * 128) = R.b1;
  };
  auto COMPUTE = [&](int st) {
    const char* As = smem + st * STAGE + (wm * 64 + r16) * 128;
    const char* Bs = smem + st * STAGE + A_BYTES + (wn * (NTW * 16) + r16) * 128;
#pragma unroll
    for (int kk = 0; kk < 2; ++kk) {
      const int sw = ((kk * 4 + g) ^ (r16 & 7)) << 4;
      bf16x8 af[4], bfr[NTW];
#pragma unroll
      for (int mt = 0; mt < 4; ++mt) af[mt] = *(const bf16x8*)(As + mt * 16 * 128 + sw);
#pragma unroll
      for (int nt = 0; nt < NTW; ++nt) bfr[nt] = *(const bf16x8*)(Bs + nt * 16 * 128 + sw);
#pragma unroll
      for (int mt = 0; mt < 4; ++mt)
#pragma unroll
        for (int nt = 0; nt < NTW; ++nt)
          acc[mt][nt] = __builtin_amdgcn_mfma_f32_16x16x32_bf16(af[mt], bfr[nt], acc[mt][nt], 0, 0, 0);
    }
  };
  const int nk = K >> 6;
  __syncthreads();
  GLOAD(R0, 0);
  SSTORE(R0, 0);
  if constexpr (DEEP) {
    GLOAD(R0, 64);
    if (nk > 2) GLOAD(R1, 128);
    lds_barrier();
    bf16x8 fa0[4], fb0[NTW], fa1[4], fb1[NTW];
    auto READF = [&](bf16x8 (&fa)[4], bf16x8 (&fb)[NTW], int st, int kk) {
      const int sw = ((kk * 4 + g) ^ (r16 & 7)) << 4;
      const char* As = smem + st * STAGE + (wm * 64 + r16) * 128 + sw;
      const char* Bs = smem + st * STAGE + A_BYTES + (wn * (NTW * 16) + r16) * 128 + sw;
#pragma unroll
      for (int mt = 0; mt < 4; ++mt) fa[mt] = *(const bf16x8*)(As + mt * 16 * 128);
#pragma unroll
      for (int nt = 0; nt < NTW; ++nt) fb[nt] = *(const bf16x8*)(Bs + nt * 16 * 128);
    };
    auto MMA = [&](const bf16x8 (&fa)[4], const bf16x8 (&fb)[NTW]) {
#pragma unroll
      for (int mt = 0; mt < 4; ++mt)
#pragma unroll
        for (int nt = 0; nt < NTW; ++nt)
          acc[mt][nt] = __builtin_amdgcn_mfma_f32_16x16x32_bf16(fa[mt], fb[nt], acc[mt][nt], 0, 0, 0);
    };
    READF(fa0, fb0, 0, 0);
    for (int kt = 0; kt < nk; kt += 2) {
      READF(fa1, fb1, 0, 1);
      MMA(fa0, fb0);
#pragma unroll
      for (int i = 0; i < 4 + NTW; ++i) { __builtin_amdgcn_sched_group_barrier(0x100, 1, 0); __builtin_amdgcn_sched_group_barrier(0x008, 2, 0); }
      __builtin_amdgcn_sched_barrier(0);
      SSTORE(R0, 1);
      if (kt + 3 < nk) GLOAD(R0, (kt + 3) * 64);
      MMA(fa1, fb1);
#pragma unroll
      for (int i = 0; i < 6; ++i) { __builtin_amdgcn_sched_group_barrier(0x200, 1, 0); __builtin_amdgcn_sched_group_barrier(0x020, 1, 0); __builtin_amdgcn_sched_group_barrier(0x008, 2, 0); }
      __builtin_amdgcn_sched_barrier(0);
      lds_barrier();
      READF(fa0, fb0, 1, 0);
      READF(fa1, fb1, 1, 1);
      MMA(fa0, fb0);
#pragma unroll
      for (int i = 0; i < 4 + NTW; ++i) { __builtin_amdgcn_sched_group_barrier(0x100, 1, 0); __builtin_amdgcn_sched_group_barrier(0x008, 2, 0); }
      __builtin_amdgcn_sched_barrier(0);
      if (kt + 2 < nk) SSTORE(R1, 0);
      if (kt + 4 < nk) GLOAD(R1, (kt + 4) * 64);
      MMA(fa1, fb1);
#pragma unroll
      for (int i = 0; i < 6; ++i) { __builtin_amdgcn_sched_group_barrier(0x200, 1, 0); __builtin_amdgcn_sched_group_barrier(0x020, 1, 0); __builtin_amdgcn_sched_group_barrier(0x008, 2, 0); }
      __builtin_amdgcn_sched_barrier(0);
      lds_barrier();
      if (kt + 2 < nk) READF(fa0, fb0, 0, 0);
    }
  } else {
    lds_barrier();
    for (int kt = 0; kt < nk; ++kt) {
      const int st = kt & 1;
      if (kt + 1 < nk) GLOAD(R0, (kt + 1) * 64);
      __builtin_amdgcn_sched_barrier(0);
      COMPUTE(st);
      __builtin_amdgcn_sched_barrier(0);
      if (kt + 1 < nk) SSTORE(R0, st ^ 1);
      lds_barrier();
    }
  }
}

#define GLDS16(gp, lp) __builtin_amdgcn_global_load_lds((const unsigned*)(gp), (unsigned*)(lp), 16, 0, 0)
template <class RowFn>
DI void gemm_glds(f32x4 (&acc)[4][4], const bf16_t* __restrict__ A, int lda, RowFn rowfn,
                  const bf16_t* __restrict__ Bt, int ldb, int K, char* smem, const bf16_t* zrow) {
  constexpr int A_BYTES = 256 * 128, STAGE = A_BYTES + 128 * 128;
  const int tid = my_tid(), lane = tid & 63, wid = tid >> 6, wm = wid >> 1, wn = wid & 1, g = lane >> 4, r16 = lane & 15;
  const int lrow = tid >> 3, c = (tid & 7) ^ (lrow & 7);
  const long a0 = rowfn(lrow), a1 = rowfn(lrow + 64), a2 = rowfn(lrow + 128), a3 = rowfn(lrow + 192);
  const bf16_t* pa0 = (a0 >= 0 ? A + a0 * lda : zrow) + c * 8; const int m0 = a0 >= 0 ? 1 : 0;
  const bf16_t* pa1 = (a1 >= 0 ? A + a1 * lda : zrow) + c * 8; const int m1 = a1 >= 0 ? 1 : 0;
  const bf16_t* pa2 = (a2 >= 0 ? A + a2 * lda : zrow) + c * 8; const int m2 = a2 >= 0 ? 1 : 0;
  const bf16_t* pa3 = (a3 >= 0 ? A + a3 * lda : zrow) + c * 8; const int m3 = a3 >= 0 ? 1 : 0;
  const bf16_t* pb0 = Bt + (long)lrow * ldb + c * 8; const bf16_t* pb1 = pb0 + (long)64 * ldb;
  auto ISSUE = [&](int kt, int bi) {
    char* d = smem + bi * STAGE + tid * 16;
    const int k0 = kt * 64;
    GLDS16(pa0 + k0 * m0, d); GLDS16(pa1 + k0 * m1, d + 8192); GLDS16(pa2 + k0 * m2, d + 16384); GLDS16(pa3 + k0 * m3, d + 24576);
    GLDS16(pb0 + k0, d + A_BYTES); GLDS16(pb1 + k0, d + A_BYTES + 8192);
  };
  auto COMPUTE = [&](int bi) {
    const char* As = smem + bi * STAGE + (wm * 64 + r16) * 128;
    const char* Bs = smem + bi * STAGE + A_BYTES + (wn * 64 + r16) * 128;
#pragma unroll
    for (int kk = 0; kk < 2; ++kk) {
      const int sw = ((kk * 4 + g) ^ (r16 & 7)) << 4;
      bf16x8 af[4], bfr[4];
#pragma unroll
      for (int mt = 0; mt < 4; ++mt) af[mt] = *(const bf16x8*)(As + mt * 16 * 128 + sw);
#pragma unroll
      for (int nt = 0; nt < 4; ++nt) bfr[nt] = *(const bf16x8*)(Bs + nt * 16 * 128 + sw);
#pragma unroll
      for (int mt = 0; mt < 4; ++mt)
#pragma unroll
        for (int nt = 0; nt < 4; ++nt)
          acc[mt][nt] = __builtin_amdgcn_mfma_f32_16x16x32_bf16(af[mt], bfr[nt], acc[mt][nt], 0, 0, 0);
    }
  };
  const int nk = K >> 6;
  __syncthreads();
  ISSUE(0, 0);
  ISSUE(1, 1);
  asm volatile("s_waitcnt vmcnt(6)" ::: "memory");
  __builtin_amdgcn_s_barrier();
  asm volatile("" ::: "memory");
  int bi = 0;
  for (int kt = 0; kt < nk; ++kt) {
    const int b2 = bi >= 1 ? bi - 1 : 2;
    if (kt + 2 < nk) ISSUE(kt + 2, b2);
    COMPUTE(bi);
    if (kt + 2 < nk) asm volatile("s_waitcnt vmcnt(6)" ::: "memory");
    else asm volatile("s_waitcnt vmcnt(0)" ::: "memory");
    asm volatile("s_waitcnt lgkmcnt(0)" ::: "memory");
    __builtin_amdgcn_s_barrier();
    asm volatile("" ::: "memory");
    bi = bi == 2 ? 0 : bi + 1;
  }
}

DI void gemm_glds256(f32x4 (&acc)[8][4], const bf16_t* __restrict__ A, int lda, long arow0,
                     const bf16_t* __restrict__ Bt, int ldb, int K, char* smem) {
  constexpr int A_BYTES = 256 * 128, STAGE = 2 * A_BYTES;
  const int tid = my_tid(), lane = tid & 63, wid = tid >> 6, wm = wid >> 2, wn = wid & 3, g = lane >> 4, r16 = lane & 15;
  const int lrow = tid >> 3, c = (tid & 7) ^ (lrow & 7);
  const bf16_t* pa = A + (arow0 + lrow) * (long)lda + c * 8;
  const bf16_t* pb = Bt + (long)lrow * ldb + c * 8;
  const long a64 = (long)64 * lda, b64 = (long)64 * ldb;
  auto ISSUE = [&](int kt, int bi) {
    char* d = smem + bi * STAGE + tid * 16;
    const int k0 = kt * 64;
    GLDS16(pa + k0, d); GLDS16(pa + a64 + k0, d + 8192); GLDS16(pa + 2 * a64 + k0, d + 16384); GLDS16(pa + 3 * a64 + k0, d + 24576);
    GLDS16(pb + k0, d + A_BYTES); GLDS16(pb + b64 + k0, d + A_BYTES + 8192); GLDS16(pb + 2 * b64 + k0, d + A_BYTES + 16384); GLDS16(pb + 3 * b64 + k0, d + A_BYTES + 24576);
  };
  auto COMPUTE = [&](int bi) {
    const char* As = smem + bi * STAGE + (wm * 128 + r16) * 128;
    const char* Bs = smem + bi * STAGE + A_BYTES + (wn * 64 + r16) * 128;
#pragma unroll
    for (int kk = 0; kk < 2; ++kk) {
      const int sw = ((kk * 4 + g) ^ (r16 & 7)) << 4;
      bf16x8 bfr[4];
#pragma unroll
      for (int nt = 0; nt < 4; ++nt) bfr[nt] = *(const bf16x8*)(Bs + nt * 16 * 128 + sw);
#pragma unroll
      for (int mt = 0; mt < 8; ++mt) {
        const bf16x8 af = *(const bf16x8*)(As + mt * 16 * 128 + sw);
#pragma unroll
        for (int nt = 0; nt < 4; ++nt)
          acc[mt][nt] = __builtin_amdgcn_mfma_f32_16x16x32_bf16(af, bfr[nt], acc[mt][nt], 0, 0, 0);
      }
    }
  };
  const int nk = K >> 6;
  __syncthreads();
  ISSUE(0, 0);
  asm volatile("s_waitcnt vmcnt(0)" ::: "memory");
  __builtin_amdgcn_s_barrier();
  asm volatile("" ::: "memory");
  int bi = 0;
  for (int kt = 0; kt < nk; ++kt) {
    if (kt + 1 < nk) ISSUE(kt + 1, bi ^ 1);
    COMPUTE(bi);
    asm volatile("s_waitcnt vmcnt(0)" ::: "memory");
    asm volatile("s_waitcnt lgkmcnt(0)" ::: "memory");
    __builtin_amdgcn_s_barrier();
    asm volatile("" ::: "memory");
    bi ^= 1;
  }
}
DI void zero_acc256(f32x4 (&acc)[8][4]) {
#pragma unroll
  for (int i = 0; i < 8; ++i)
#pragma unroll
    for (int j = 0; j < 4; ++j) acc[i][j] = (f32x4){0.f, 0.f, 0.f, 0.f};
}

DI bool next_tile(int i, int MTILES, int NTILES, int& mt, int& nt) {
  const int xcd = blockIdx.x & 7, slot = blockIdx.x >> 3, nslot = gridDim.x >> 3;
  const int m_lo = (MTILES * xcd) >> 3, m_hi = (MTILES * (xcd + 1)) >> 3, Mloc = m_hi - m_lo;
  const int q = i * nslot + slot;
  if (q >= Mloc * NTILES) return false;
  const int gidx = q / (4 * NTILES), m0 = gidx * 4;
  const int rows = (Mloc - m0) < 4 ? (Mloc - m0) : 4;
  const int within = q - gidx * 4 * NTILES;
  nt = within / rows; mt = m_lo + m0 + within % rows;
  return true;
}

struct RowPlain { long base; DI long operator()(int r) const { return base + r; } };
struct RowHalo { long rowbase; int t0; int len; DI long operator()(int r) const { int t = t0 + r; return (t >= 0 && t < len) ? rowbase + t : -1; } };

template <int NTW> DI void zero_acc(f32x4 (&acc)[4][NTW]) {
#pragma unroll
  for (int i = 0; i < 4; ++i)
#pragma unroll
    for (int j = 0; j < NTW; ++j) acc[i][j] = (f32x4){0.f, 0.f, 0.f, 0.f};
}

DI void cvt_unit(const float* __restrict__ src, int ldsrc, int srccol0, int k0, bf16_t* __restrict__ dst, int K, int n0, char* smem, bool perm = true) {
  float* T = (float*)smem;
  const int tid = my_tid();
  __syncthreads();
  if (srccol0 >= 0) {
#pragma unroll
    for (int i = 0; i < 8; ++i) {
      int idx = tid + i * 512; int k = idx >> 6, n = idx & 63;
      T[k * 65 + n] = src[(long)(k0 + k) * ldsrc + srccol0 + n];
    }
  }
  __syncthreads();
  int nd = tid >> 3, kc = (tid & 7) * 8; int n = perm ? ((nd & 15) * 4 + (nd >> 4)) : nd;
  uint4 o = make_uint4(0, 0, 0, 0);
  if (srccol0 >= 0) {
    o.x = pack2(T[(kc + 0) * 65 + n], T[(kc + 1) * 65 + n]);
    o.y = pack2(T[(kc + 2) * 65 + n], T[(kc + 3) * 65 + n]);
    o.z = pack2(T[(kc + 4) * 65 + n], T[(kc + 5) * 65 + n]);
    o.w = pack2(T[(kc + 6) * 65 + n], T[(kc + 7) * 65 + n]);
  }
  *(uint4*)(dst + (long)(n0 + nd) * K + k0 + kc) = o;
}

DI void ph_convert(const Params& p, int l, char* smem) {
  for (int u = blockIdx.x; u < 4508; u += gridDim.x) {
    if (u < 832) {
      int gI = u >> 4, kt = u & 15; int n0 = gI * 64; int sc;
      if (n0 < 1280) sc = n0; else if (n0 < 2048) sc = 2496 + (n0 - 1280); else if (n0 < 3264) sc = 1280 + (n0 - 2048); else sc = -1;
      cvt_unit(p.in[6] + (size_t)l * 1024 * 7360, 7360, sc, kt * 64, (bf16_t*)(p.ws + WB_IN), 1024, n0, smem);
    } else if (u < 1856) {
      int v = u - 832; int gI = v >> 4, kt = v & 15;
      cvt_unit(p.in[6] + (size_t)l * 1024 * 7360, 7360, 3264 + gI * 64, kt * 64, (bf16_t*)(p.ws + WB_GATE), 1024, gI * 64, smem);
    } else if (u < 2112) {
      int v = u - 1856; int gI = v >> 2, kt = v & 3; int j = gI >> 4, gg = gI & 15;
      cvt_unit(p.in[33] + ((size_t)l * 4 + j) * 256 * 1024, 1024, gg * 64, kt * 64, (bf16_t*)(p.ws + WB_BR) + (size_t)j * 1024 * 256, 256, gg * 64, smem);
    } else if (u < 2368) {
      int v = u - 2112; int gI = v >> 4, kt = v & 15;
      cvt_unit(p.in[34] + (size_t)l * 1024 * 1024, 1024, gI * 64, kt * 64, (bf16_t*)(p.ws + WB_OUT), 1024, gI * 64, smem);
    } else if (u < 3776) {
      int v = u - 2368; int gI = v >> 4, kt = v & 15; int nt = gI >> 2, q = gI & 3;
      cvt_unit(p.in[37] + (size_t)l * 1024 * 5632, 5632, (q >> 1) * 2816 + nt * 128 + (q & 1) * 64, kt * 64, (bf16_t*)(p.ws + WB_UP), 1024, gI * 64, smem);
    } else if (u < 4480) {
      int v = u - 3776; int gI = v / 44, kt = v % 44;
      cvt_unit(p.in[40] + (size_t)l * 2816 * 1024, 1024, gI * 64, kt * 64, (bf16_t*)(p.ws + WB_DOWN), 2816, gI * 64, smem);
    } else {
      int v = u - 4480;
      if (v < 4) cvt_unit(p.in[19] + (size_t)l * 2 * 64 * 256, 256, v * 64, 0, (bf16_t*)(p.ws + RWW_F), 64, v * 64, smem);
      else if (v < 8) cvt_unit(p.in[19] + (size_t)l * 2 * 64 * 256 + 64 * 256, 256, (v - 4) * 64, 0, (bf16_t*)(p.ws + RWW_B), 64, (v - 4) * 64, smem);
      else if (v < 12) cvt_unit(p.in[21] + (size_t)l * 64 * 256, 256, (v - 8) * 64, 0, (bf16_t*)(p.ws + RWW_A), 64, (v - 8) * 64, smem);
      else if (v < 20) { int w = v - 12; cvt_unit(p.in[22] + (size_t)l * 2 * 128 * 256, 256, (w >> 1) * 64, (w & 1) * 64, (bf16_t*)(p.ws + RWW_GF), 128, (w >> 1) * 64, smem); }
      else { int w = v - 20; cvt_unit(p.in[22] + (size_t)l * 2 * 128 * 256 + 128 * 256, 256, (w >> 1) * 64, (w & 1) * 64, (bf16_t*)(p.ws + RWW_GB), 128, (w >> 1) * 64, smem); }
    }
  }
}

DI void ph_ada(const Params& p, char* smem) {
  float* S = (float*)smem;
  float* R = S + 9 * 1024;
  const int tid = my_tid();
  bool loaded = false;
  for (int u = blockIdx.x; u < 192; u += gridDim.x) {
    if (!loaded) {
      __syncthreads();
      for (int i = tid; i < 9 * 1024; i += NTHR) { float c = i < 8192 ? p.in[1][i] : p.in[3][i - 8192]; S[i] = siluf_(c); }
      loaded = true;
    }
    __syncthreads();
    int l = u / 96, n0 = (u % 96) * 64;
    int col = tid & 63, ks = tid >> 6;
    const float* W = p.in[4] + (size_t)l * 1024 * 6144 + n0 + col;
    float a[9];
#pragma unroll
    for (int b = 0; b < 9; ++b) a[b] = 0.f;
    for (int k = ks * 128; k < ks * 128 + 128; ++k) {
      float w = W[(size_t)k * 6144];
#pragma unroll
      for (int b = 0; b < 9; ++b) a[b] += S[b * 1024 + k] * w;
    }
#pragma unroll
    for (int b = 0; b < 9; ++b) R[(ks * 9 + b) * 64 + col] = a[b];
    __syncthreads();
    for (int i = tid; i < 9 * 64; i += NTHR) {
      int b = i >> 6, c = i & 63; float s = 0.f;
#pragma unroll
      for (int k2 = 0; k2 < 8; ++k2) s += R[(k2 * 9 + b) * 64 + c];
      s += p.in[5][(size_t)l * 6144 + n0 + c];
      ((float*)(p.ws + MISC_MOD))[((size_t)l * 9 + b) * 6144 + n0 + c] = s;
    }
  }
  for (int i = blockIdx.x * NTHR + tid; i < 4096; i += gridDim.x * NTHR) {
    float s, c; sincospif(-(float)i / 4096.f, &s, &c);
    ((float2*)(p.ws + MISC_TW))[i] = make_float2(c, s);
  }
}

DI void hy_rawfilter(const Params& p, int l, int Lf, float* __restrict__ dst, char* smem) {
  float* W1 = (float*)smem;
  float* W2 = W1 + 33 * 64;
  float* Z = W2 + 64 * 64;
  float* H1 = Z + 16 * 36;
  float* H2 = H1 + 16 * 64;
  const int tid = my_tid();
  const float* w1 = p.in[9] + (size_t)l * 33 * 64; const float* b1 = p.in[10] + l * 64;
  const float* w2 = p.in[11] + (size_t)l * 64 * 64; const float* b2 = p.in[12] + l * 64;
  const float* w3 = p.in[13] + (size_t)l * 64 * 1024; const float* fr = p.in[14] + l * 64;
  const int nunits = Lf / 16;
  bool loaded = false;
  for (int u = blockIdx.x; u < nunits; u += gridDim.x) {
    __syncthreads();
    if (!loaded) {
      for (int i = tid; i < 33 * 64; i += NTHR) W1[i] = w1[i];
      for (int i = tid; i < 64 * 64; i += NTHR) W2[i] = w2[i];
      loaded = true;
    }
    const int t0 = u * 16;
    for (int i = tid; i < 16 * 33; i += NTHR) {
      int tt = i / 33, f = i % 33; int t = t0 + tt; float v;
      if (f == 0) v = (float)t / (float)(Lf - 1);
      else {
        int bi = (f - 1) & 15;
        float wv = 6.283185307179586f * (float)t / (float)Lf;
        float fb = 1e-4f + (15.f - 1e-4f) * (float)bi / 15.f;
        float ang = wv * fb;
        v = (f <= 16) ? cosf(ang) : -sinf(ang);
      }
      Z[tt * 36 + f] = v;
    }
    __syncthreads();
    for (int i = tid; i < 16 * 64; i += NTHR) {
      int tt = i >> 6, f = i & 63; float s = b1[f];
      for (int k = 0; k < 33; ++k) s += Z[tt * 36 + k] * W1[k * 64 + f];
      H1[tt * 64 + f] = sinf(fr[f] * s);
    }
    __syncthreads();
    for (int i = tid; i < 16 * 64; i += NTHR) {
      int tt = i >> 6, f = i & 63; float s = b2[f];
      for (int k = 0; k < 64; ++k) s += H1[tt * 64 + k] * W2[k * 64 + f];
      H2[tt * 64 + f] = sinf(fr[f] * s);
    }
    __syncthreads();
    float a0[16], a1[16];
#pragma unroll
    for (int i = 0; i < 16; ++i) { a0[i] = 0.f; a1[i] = 0.f; }
    for (int k = 0; k < 64; ++k) {
      float wa = w3[k * 1024 + tid], wb = w3[k * 1024 + 512 + tid];
#pragma unroll
      for (int i = 0; i < 16; ++i) { float h = H2[i * 64 + k]; a0[i] += h * wa; a1[i] += h * wb; }
    }
    {
      int w = tid & 255;
      float delta = fabsf(-3.0701134573253944f + (-15.350567286626972f + 3.0701134573253944f) * (float)w / 255.f);
#pragma unroll
      for (int i = 0; i < 16; ++i) {
        float tn = (float)(t0 + i) / (float)(Lf - 1);
        float dec = expf(-tn * delta);
        dst[(size_t)(t0 + i) * 1024 + tid] = a0[i] * dec;
        dst[(size_t)(t0 + i) * 1024 + 512 + tid] = a1[i] * dec;
      }
    }
  }
}

DI float2 cmul(float2 a, float2 b) { return make_float2(a.x * b.x - a.y * b.y, a.x * b.y + a.y * b.x); }
DI float2 cmulc(float2 a, float2 b) { return make_float2(a.x * b.x + a.y * b.y, a.y * b.x - a.x * b.y); }
DI float2 cadd(float2 a, float2 b) { return make_float2(a.x + b.x, a.y + b.y); }
DI float2 csub(float2 a, float2 b) { return make_float2(a.x - b.x, a.y - b.y); }
DI void fft_dif(float2* X, const float2* W) {
  const int tid = my_tid();
  for (int ls = 12; ls >= 2; ls -= 2) {
    const int s = 1 << ls, h = s >> 1;
    __syncthreads();
#pragma unroll
    for (int i = 0; i < 4; ++i) {
      const int bf = tid + i * 512; const int j = bf & (h - 1); const int base = ((bf >> (ls - 1)) << (ls + 1)) + j;
      const float2 x0 = X[base], x1 = X[base + h], x2 = X[base + s], x3 = X[base + s + h];
      const float2 w1 = W[s - 1 + j], w2 = W[h - 1 + j];
      const float2 y0 = cadd(x0, x2), y2 = cmul(csub(x0, x2), w1), y1 = cadd(x1, x3);
      const float2 t = cmul(csub(x1, x3), w1); const float2 y3 = make_float2(t.y, -t.x);
      X[base] = cadd(y0, y1); X[base + h] = cmul(csub(y0, y1), w2);
      X[base + s] = cadd(y2, y3); X[base + s + h] = cmul(csub(y2, y3), w2);
    }
  }
  __syncthreads();
#pragma unroll
  for (int i = 0; i < 4; ++i) {
    const int q = tid + i * 512;
    float4 a = *(float4*)(X + 4 * q), b = *(float4*)(X + 4 * q + 2);
    *(float4*)(X + 4 * q) = make_float4(a.x + a.z, a.y + a.w, a.x - a.z, a.y - a.w);
    *(float4*)(X + 4 * q + 2) = make_float4(b.x + b.z, b.y + b.w, b.x - b.z, b.y - b.w);
  }
  __syncthreads();
}
DI void fft_dit_inv(float2* X, const float2* W) {
  const int tid = my_tid();
  __syncthreads();
#pragma unroll
  for (int i = 0; i < 4; ++i) {
    const int q = tid + i * 512;
    float4 a = *(float4*)(X + 4 * q), b = *(float4*)(X + 4 * q + 2);
    *(float4*)(X + 4 * q) = make_float4(a.x + a.z, a.y + a.w, a.x - a.z, a.y - a.w);
    *(float4*)(X + 4 * q + 2) = make_float4(b.x + b.z, b.y + b.w, b.x - b.z, b.y - b.w);
  }
  for (int ls = 2; ls <= 12; ls += 2) {
    const int s = 1 << ls, h = s >> 1;
    __syncthreads();
#pragma unroll
    for (int i = 0; i < 4; ++i) {
      const int bf = tid + i * 512; const int j = bf & (h - 1); const int base = ((bf >> (ls - 1)) << (ls + 1)) + j;
      const float2 e0 = X[base], e1 = X[base + h], e2 = X[base + s], e3 = X[base + s + h];
      const float2 w1 = W[s - 1 + j], w2 = W[h - 1 + j];
      const float2 t1 = cmulc(e1, w2), t3 = cmulc(e3, w2);
      const float2 u0 = cadd(e0, t1), u1 = csub(e0, t1), u2 = cadd(e2, t3), u3 = csub(e2, t3);
      const float2 a2 = cmulc(u2, w1); const float2 q3 = cmulc(u3, w1); const float2 a3 = make_float2(-q3.y, q3.x);
      X[base] = cadd(u0, a2); X[base + s] = csub(u0, a2);
      X[base + h] = cadd(u1, a3); X[base + s + h] = csub(u1, a3);
    }
  }
  __syncthreads();
}
DI void load_twiddles(const Params& p, float2* W) {
  const float2* tw = (const float2*)(p.ws + MISC_TW);
  for (int i = my_tid(); i < 8191; i += NTHR) {
    const int ls = 31 - __clz(i + 1); const int pos = i + 1 - (1 << ls);
    W[i] = tw[pos << (12 - ls)];
  }
}

DI void ph_kf(const Params& p, int l, char* smem) {
  float2* X = (float2*)smem; float2* W = X + 8192; float* red = (float*)(W + 8192);
  const int tid = my_tid(), lane = tid & 63, wid = tid >> 6;
  const float* rawf = (const float*)(p.ws + R_RAWF);
  float2* kf = (float2*)(p.ws + OFF_KF);
  bool tw = false;
  for (int u = blockIdx.x; u < 256; u += gridDim.x) {
    if (!tw) { load_twiddles(p, W); tw = true; }
    const int o = u >> 7, c = (u & 127) * 2;
    float2 fw[8], bw[8]; float sa = 0.f, sb = 0.f;
#pragma unroll
    for (int i = 0; i < 8; ++i) {
      int t = tid + i * 512;
      fw[i] = *(const float2*)(rawf + (size_t)t * 1024 + o * 512 + c);
      bw[i] = *(const float2*)(rawf + (size_t)t * 1024 + o * 512 + 256 + c);
      sa += fabsf(fw[i].x) + fabsf(bw[i].x); sb += fabsf(fw[i].y) + fabsf(bw[i].y);
    }
    sa = wave_sum(sa); sb = wave_sum(sb);
    __syncthreads();
    if (lane == 0) { red[wid * 2] = sa; red[wid * 2 + 1] = sb; }
    __syncthreads();
    float ta = 0.f, tb = 0.f;
#pragma unroll
    for (int w = 0; w < 8; ++w) { ta += red[w * 2]; tb += red[w * 2 + 1]; }
    const float ia = 1.f / ta, ib = 1.f / tb;
#pragma unroll
    for (int i = 0; i < 8; ++i) {
      int t = tid + i * 512;
      X[t] = make_float2(fw[i].x * ia, fw[i].y * ib);
      if (t >= 1) X[8192 - t] = make_float2(bw[i].x * ia, bw[i].y * ib);
      else X[4096] = make_float2(0.f, 0.f);
    }
    fft_dif(X, W);
    float2* ka = kf + (size_t)(o * 256 + c) * 8192; float2* kb = ka + 8192;
#pragma unroll 4
    for (int i = 0; i < 16; ++i) {
      int pidx = tid + i * 512;
      int k = (int)(__brev((unsigned)pidx) >> 19);
      int k2 = (8192 - k) & 8191;
      int p2 = (int)(__brev((unsigned)k2) >> 19);
      float2 c1 = X[pidx], c2 = X[p2];
      float2 A = make_float2(0.5f * (c1.x + c2.x), 0.5f * (c1.y - c2.y));
      float2 Bv = make_float2(0.5f * (c1.y + c2.y), -0.5f * (c1.x - c2.x));
      ka[pidx] = A; kb[pidx] = Bv;
    }
    __syncthreads();
  }
  if (l == 0) {
    const float* rawc = (const float*)(p.ws + MISC_RAWC);
    float* G = (float*)(p.ws + MISC_GCTX);
    for (int u = blockIdx.x * 8 + wid; u < 512; u += gridDim.x * 8) {
      int o = u >> 8, c = u & 255; float f[4], b[4]; float s = 0.f;
#pragma unroll
      for (int i = 0; i < 4; ++i) {
        int t = lane + i * 64;
        f[i] = rawc[(size_t)t * 1024 + o * 512 + c]; b[i] = rawc[(size_t)t * 1024 + o * 512 + 256 + c];
        s += fabsf(f[i]) + fabsf(b[i]);
      }
      s = wave_sum(s); float inv = 1.f / s;
#pragma unroll
      for (int i = 0; i < 4; ++i) {
        int t = lane + i * 64;
        G[(size_t)u * 512 + 256 + t] = f[i] * inv;
        if (t >= 1) G[(size_t)u * 512 + 256 - t] = b[i] * inv;
      }
      if (lane == 0) G[(size_t)u * 512] = 0.f;
    }
  }
}

DI void ph_ln(const float* __restrict__ src_lat, const float* __restrict__ src_ctx, float* dst_lat, float* dst_ctx,
              const float* __restrict__ ag, const float* __restrict__ ab, bf16_t* U, const float* __restrict__ mod, int sh_off, int nrows) {
  const int lane = my_tid() & 63, wid = my_tid() >> 6;
  const int stride = gridDim.x * 8;
  float4 nv[4];
  {
    const int row = blockIdx.x * 8 + wid;
    if (row < nrows) {
      const float* src = row < ML ? src_lat + (size_t)row * D : src_ctx + (size_t)(row - ML) * D;
#pragma unroll
      for (int i = 0; i < 4; ++i) nv[i] = *(const float4*)(src + i * 256 + lane * 4);
    }
  }
  for (int row = blockIdx.x * 8 + wid; row < nrows; row += stride) {
    float4 v[4];
#pragma unroll
    for (int i = 0; i < 4; ++i) v[i] = nv[i];
    if (row + stride < nrows) {
      const int r2 = row + stride;
      const float* src2 = r2 < ML ? src_lat + (size_t)r2 * D : src_ctx + (size_t)(r2 - ML) * D;
#pragma unroll
      for (int i = 0; i < 4; ++i) nv[i] = *(const float4*)(src2 + i * 256 + lane * 4);
    }
    float s = 0.f;
#pragma unroll
    for (int i = 0; i < 4; ++i) s += v[i].x + v[i].y + v[i].z + v[i].w;
    float mu = wave_sum(s) * (1.f / 1024.f);
    float q = 0.f;
#pragma unroll
    for (int i = 0; i < 4; ++i) { v[i].x -= mu; v[i].y -= mu; v[i].z -= mu; v[i].w -= mu; q += v[i].x * v[i].x + v[i].y * v[i].y + v[i].z * v[i].z + v[i].w * v[i].w; }
    float rs = rsqrtf(wave_sum(q) * (1.f / 1024.f) + 1e-6f);
#pragma unroll
    for (int i = 0; i < 4; ++i) { v[i].x *= rs; v[i].y *= rs; v[i].z *= rs; v[i].w *= rs; }
    if (ag) {
      float* dst = row < ML ? dst_lat + (size_t)row * D : dst_ctx + (size_t)(row - ML) * D;
#pragma unroll
      for (int i = 0; i < 4; ++i) {
        float4 gg = *(const float4*)(ag + i * 256 + lane * 4), bb = *(const float4*)(ab + i * 256 + lane * 4);
        v[i].x = v[i].x * gg.x + bb.x; v[i].y = v[i].y * gg.y + bb.y; v[i].z = v[i].z * gg.z + bb.z; v[i].w = v[i].w * gg.w + bb.w;
        *(float4*)(dst + i * 256 + lane * 4) = v[i];
      }
      if (U) {
        s = 0.f;
#pragma unroll
        for (int i = 0; i < 4; ++i) s += v[i].x + v[i].y + v[i].z + v[i].w;
        mu = wave_sum(s) * (1.f / 1024.f); q = 0.f;
#pragma unroll
        for (int i = 0; i < 4; ++i) { v[i].x -= mu; v[i].y -= mu; v[i].z -= mu; v[i].w -= mu; q += v[i].x * v[i].x + v[i].y * v[i].y + v[i].z * v[i].z + v[i].w * v[i].w; }
        rs = rsqrtf(wave_sum(q) * (1.f / 1024.f) + 1e-6f);
#pragma unroll
        for (int i = 0; i < 4; ++i) { v[i].x *= rs; v[i].y *= rs; v[i].z *= rs; v[i].w *= rs; }
      }
    }
    if (U) {
      const float* m = mod + (size_t)mod_idx(row) * 6144 + sh_off;
#pragma unroll
      for (int i = 0; i < 4; ++i) {
        float4 sh = *(const float4*)(m + i * 256 + lane * 4), sc = *(const float4*)(m + 1024 + i * 256 + lane * 4);
        uint2 o; o.x = pack2(v[i].x * (1.f + sc.x) + sh.x, v[i].y * (1.f + sc.y) + sh.y);
        o.y = pack2(v[i].z * (1.f + sc.z) + sh.z, v[i].w * (1.f + sc.w) + sh.w);
        *(uint2*)(U + (size_t)row * D + i * 256 + lane * 4) = o;
      }
    }
  }
}

DI void ph_inproj(const Params& p, const bf16_t* U, char* smem) {
  const bf16_t* Bt = (const bf16_t*)(p.ws + WB_IN);
  const int lane = my_tid() & 63, wid = my_tid() >> 6, wm = wid >> 2, wn = wid & 3, g = lane >> 4, r16 = lane & 15;
  for (int it = 0;; ++it) {
    int mtile, ntile;
    if (!next_tile(it, 136, 13, mtile, ntile)) break;
    f32x4 acc[8][4]; zero_acc256(acc);
    gemm_glds256(acc, U, 1024, (long)mtile * 256, Bt + (size_t)ntile * 256 * 1024, 1024, 1024, smem);
    int b, key0;
    if (mtile < 128) { b = mtile >> 4; key0 = (mtile & 15) * 256; } else { b = mtile - 128; key0 = SL; }
    const int wc0 = ntile * 256 + wn * 64;
    bf16_t* tbase = nullptr; int tcols = 0, tcol0 = 0;
    if (wc0 < 768) { tbase = (bf16_t*)(p.ws + R_PHY); tcols = 768; tcol0 = wc0; }
    else if (wc0 >= 1152 && wc0 < 1280) { tbase = (bf16_t*)(p.ws + R_VTSW); tcols = 128; tcol0 = wc0 - 1152; }
    else if (wc0 >= 1792 && wc0 < 2048) { tbase = (bf16_t*)(p.ws + R_VTDF); tcols = 256; tcol0 = wc0 - 1792; }
    if (tbase) {
#pragma unroll
      for (int mt = 0; mt < 8; ++mt)
#pragma unroll
        for (int nt = 0; nt < 4; ++nt) {
          int col = tcol0 + r16 * 4 + nt;
          int key = key0 + wm * 128 + mt * 16 + g * 4;
          uint2 o; o.x = pack2(acc[mt][nt][0], acc[mt][nt][1]); o.y = pack2(acc[mt][nt][2], acc[mt][nt][3]);
          *(uint2*)(tbase + ((size_t)b * tcols + col) * KEYS + key) = o;
        }
    } else if (wc0 < 3264) {
      bf16_t* rb; int ld, c0;
      if (wc0 < 1152) { rb = (bf16_t*)(p.ws + R_PSW); ld = 384; c0 = wc0 - 768; }
      else if (wc0 < 1792) { rb = (bf16_t*)(p.ws + R_PDF); ld = 512; c0 = wc0 - 1280; }
      else { rb = (bf16_t*)(p.ws + R_PRW); ld = 1216; c0 = wc0 - 2048; }
      const int col = c0 + r16 * 4;
#pragma unroll
      for (int mt = 0; mt < 8; ++mt)
#pragma unroll
        for (int j = 0; j < 4; ++j) {
          size_t row = (size_t)mtile * 256 + wm * 128 + mt * 16 + g * 4 + j;
          uint2 o; o.x = pack2(acc[mt][0][j], acc[mt][1][j]); o.y = pack2(acc[mt][2][j], acc[mt][3][j]);
          *(uint2*)(rb + row * ld + col) = o;
        }
    }
  }
}

DI float hy_conv3(const bf16_t* __restrict__ P, int t, int len, float w0, float w1, float w2, float bias) {
  float a = t >= 1 ? bf2f(P[t - 1]) : 0.f, b = bf2f(P[t]), c = (t + 1 < len) ? bf2f(P[t + 1]) : 0.f;
  return w0 * a + w1 * b + w2 * c + bias;
}
DI void ph_hyena(const Params& p, int l, char* smem) {
  float2* X = (float2*)smem; float2* W = X + 8192;
  const int tid = my_tid();
  const bf16_t* PT = (const bf16_t*)(p.ws + R_PHY);
  const float2* kf = (const float2*)(p.ws + OFF_KF);
  const float* cw = p.in[7] + (size_t)l * 3 * 768; const float* cb = p.in[8] + (size_t)l * 768;
  const float* hb = p.in[15] + (size_t)l * 512;
  bf16_t* Y = (bf16_t*)(p.ws + R_YHY);
  bool tw = false;
  for (int u = blockIdx.x; u < 1024; u += gridDim.x) {
    if (!tw) { load_twiddles(p, W); tw = true; }
    const int bp = u >> 8, c = u & 255; const int b0 = bp * 2, b1 = b0 + 1;
    const bf16_t* P0 = PT + ((size_t)b0 * 768) * KEYS; const bf16_t* P1 = PT + ((size_t)b1 * 768) * KEYS;
    float wv0 = cw[c], wv1 = cw[768 + c], wv2 = cw[1536 + c], bv = cb[c];
    float wa0 = cw[256 + c], wa1 = cw[768 + 256 + c], wa2 = cw[1536 + 256 + c], ba = cb[256 + c];
    float wb0 = cw[512 + c], wb1 = cw[768 + 512 + c], wb2 = cw[1536 + 512 + c], bb = cb[512 + c];
    const float bias0 = hb[c], bias1 = hb[256 + c];
    float2 vv[8];
    __syncthreads();
#pragma unroll
    for (int i = 0; i < 8; ++i) {
      int t = tid + i * 512;
      vv[i].x = hy_conv3(P0 + (size_t)c * KEYS, t, SL, wv0, wv1, wv2, bv);
      vv[i].y = hy_conv3(P1 + (size_t)c * KEYS, t, SL, wv0, wv1, wv2, bv);
      X[t] = vv[i]; X[t + 4096] = make_float2(0.f, 0.f);
    }
    fft_dif(X, W);
    {
      const float2* H = kf + (size_t)c * 8192;
#pragma unroll 4
      for (int i = 0; i < 16; ++i) { int q = tid + i * 512; X[q] = cmul(X[q], H[q]); }
    }
    fft_dit_inv(X, W);
    float2 zz[8];
#pragma unroll
    for (int i = 0; i < 8; ++i) {
      int t = tid + i * 512;
      float2 y = X[t];
      float x1a = hy_conv3(P0 + (size_t)(256 + c) * KEYS, t, SL, wa0, wa1, wa2, ba);
      float x1b = hy_conv3(P1 + (size_t)(256 + c) * KEYS, t, SL, wa0, wa1, wa2, ba);
      zz[i].x = x1a * (y.x * (1.f / 8192.f) + bias0 * vv[i].x);
      zz[i].y = x1b * (y.y * (1.f / 8192.f) + bias0 * vv[i].y);
    }
    __syncthreads();
#pragma unroll
    for (int i = 0; i < 8; ++i) { int t = tid + i * 512; X[t] = zz[i]; X[t + 4096] = make_float2(0.f, 0.f); }
    fft_dif(X, W);
    {
      const float2* H = kf + (size_t)(256 + c) * 8192;
#pragma unroll 4
      for (int i = 0; i < 16; ++i) { int q = tid + i * 512; X[q] = cmul(X[q], H[q]); }
    }
    fft_dit_inv(X, W);
#pragma unroll
    for (int i = 0; i < 8; ++i) {
      int t = tid + i * 512;
      float2 y = X[t];
      float x2a = hy_conv3(P0 + (size_t)(512 + c) * KEYS, t, SL, wb0, wb1, wb2, bb);
      float x2b = hy_conv3(P1 + (size_t)(512 + c) * KEYS, t, SL, wb0, wb1, wb2, bb);
      float oa = x2a * (y.x * (1.f / 8192.f) + bias1 * zz[i].x);
      float ob = x2b * (y.y * (1.f / 8192.f) + bias1 * zz[i].y);
      Y[((size_t)b0 * SL + t) * 256 + c] = (bf16_t)f2bf(oa);
      Y[((size_t)b1 * SL + t) * 256 + c] = (bf16_t)f2bf(ob);
    }
  }
}

DI void ph_hyena_ctx(const Params& p, int l, char* smem) {
  const int tid = my_tid(), lane = tid & 63, wid = tid >> 6;
  float* Zb = (float*)smem + wid * 1024;
  float* Gb = Zb + 256;
  const bf16_t* PT = (const bf16_t*)(p.ws + R_PHY);
  const float* G = (const float*)(p.ws + MISC_GCTX);
  const float* cw = p.in[7] + (size_t)l * 3 * 768; const float* cb = p.in[8] + (size_t)l * 768;
  const float* hb = p.in[15] + (size_t)l * 512;
  bf16_t* Y = (bf16_t*)(p.ws + R_YHY);
  for (int base = blockIdx.x * 8; base < 2048; base += gridDim.x * 8) {
    const int u = base + wid; const int b = u >> 8, c = u & 255;
    const bf16_t* Pb = PT + ((size_t)b * 768) * KEYS + SL;
    float v[4], x1[4], x2[4], zz[4];
#pragma unroll
    for (int i = 0; i < 4; ++i) {
      int t = lane + i * 64;
      v[i] = hy_conv3(Pb + (size_t)c * KEYS, t, CL, cw[c], cw[768 + c], cw[1536 + c], cb[c]);
      x1[i] = hy_conv3(Pb + (size_t)(256 + c) * KEYS, t, CL, cw[256 + c], cw[768 + 256 + c], cw[1536 + 256 + c], cb[256 + c]);
      x2[i] = hy_conv3(Pb + (size_t)(512 + c) * KEYS, t, CL, cw[512 + c], cw[768 + 512 + c], cw[1536 + 512 + c], cb[512 + c]);
    }
    __syncthreads();
#pragma unroll
    for (int i = 0; i < 4; ++i) Zb[lane + i * 64] = v[i];
    for (int i = lane; i < 512; i += 64) Gb[i] = G[(size_t)c * 512 + i];
    __syncthreads();
#pragma unroll
    for (int i = 0; i < 4; ++i) {
      int t = lane + i * 64; float s = 0.f;
      for (int s2 = 0; s2 < 256; ++s2) s += Gb[256 + t - s2] * Zb[s2];
      zz[i] = x1[i] * (s + hb[c] * v[i]);
    }
    __syncthreads();
#pragma unroll
    for (int i = 0; i < 4; ++i) Zb[lane + i * 64] = zz[i];
    for (int i = lane; i < 512; i += 64) Gb[i] = G[(size_t)(256 + c) * 512 + i];
    __syncthreads();
#pragma unroll
    for (int i = 0; i < 4; ++i) {
      int t = lane + i * 64; float s = 0.f;
      for (int s2 = 0; s2 < 256; ++s2) s += Gb[256 + t - s2] * Zb[s2];
      float o = x2[i] * (s + hb[256 + c] * zz[i]);
      Y[((size_t)ML + b * CL + t) * 256 + c] = (bf16_t)f2bf(o);
    }
  }
}

DI void ph_rope(const Params& p, char* smem) {
  float2* T16 = (float2*)smem;
  float2* T8 = T16 + 64 * 16;
  const int tid = my_tid(), lane = tid & 63, wid = tid >> 6;
  __syncthreads();
  for (int i = tid; i < 64 * 16; i += NTHR) {
    int pos = i >> 4, f = i & 15; float inv = powf(10000.f, -(float)f / 16.f); float s, c; sincosf((float)pos * inv, &s, &c);
    T16[i] = make_float2(c, s);
  }
  for (int i = tid; i < 64 * 8; i += NTHR) {
    int pos = i >> 3, f = i & 7; float inv = powf(10000.f, -(float)f / 8.f); float s, c; sincosf((float)pos * inv, &s, &c);
    T8[i] = make_float2(c, s);
  }
  __syncthreads();
  bf16_t* Psw = (bf16_t*)(p.ws + R_PSW); bf16_t* Pdf = (bf16_t*)(p.ws + R_PDF);
  for (int row = blockIdx.x * 8 + wid; row < ML; row += gridDim.x * 8) {
    const int t = row & (SL - 1); const int pr = t >> 6, pc = t & 63;
    bf16_t* q = Psw + (size_t)row * 384;
#pragma unroll
    for (int i = 0; i < 3; ++i) {
      int pi = lane + i * 64; int hd = pi >> 5, pp = pi & 31; int half = pp >> 4, f = pp & 15;
      int base = hd * 64 + half * 32; float2 cs = T16[(half ? pc : pr) * 16 + f];
      float x1 = bf2f(q[base + f]), x2 = bf2f(q[base + 16 + f]);
      q[base + f] = (bf16_t)f2bf(x1 * cs.x - x2 * cs.y); q[base + 16 + f] = (bf16_t)f2bf(x1 * cs.y + x2 * cs.x);
    }
    bf16_t* d = Pdf + (size_t)row * 512;
#pragma unroll
    for (int i = 0; i < 4; ++i) {
      int pi = lane + i * 64; int gi = pi >> 4, pp = pi & 15; int half = pp >> 3, f = pp & 7;
      int base = gi * 32 + half * 16; float2 cs = T8[(half ? pc : pr) * 8 + f];
      float x1 = bf2f(d[base + f]), x2 = bf2f(d[base + 8 + f]);
      d[base + f] = (bf16_t)f2bf(x1 * cs.x - x2 * cs.y); d[base + 8 + f] = (bf16_t)f2bf(x1 * cs.y + x2 * cs.x);
    }
  }
}

DI float rw_shift(const bf16_t* __restrict__ P, int row, int t, int len, int col, float mu) {
  float c = bf2f(P[(size_t)row * 1216 + col]);
  float a = t >= 1 ? bf2f(P[(size_t)(row - 1) * 1216 + col]) : 0.f;
  float b = t + 1 < len ? bf2f(P[(size_t)(row + 1) * 1216 + col]) : 0.f;
  return c + (0.5f * (a + b) - c) * mu;
}
DI void ph_rwprep(const Params& p, int l, char* smem) {
  constexpr int AST = 912, RST = 1552, ROFF = 32 * AST;
  const int tid = my_tid(), lane = tid & 63, wid = tid >> 6, g = lane >> 4, r16 = lane & 15;
  const int tg = wid >> 2, hd = wid & 3;
  const bf16_t* P = (const bf16_t*)(p.ws + R_PRW);
  const float* mu = p.in[17] + (size_t)l * 1216;
  const float* w0 = p.in[18] + (size_t)l * 512; const float* a0 = p.in[20] + (size_t)l * 256;
  const float* kkw = p.in[23] + (size_t)l * 256; const float* kaw = p.in[24] + (size_t)l * 256;
  bf16_t* S = (bf16_t*)(p.ws + R_STR); bf16_t* Gs = (bf16_t*)(p.ws + R_G);
  const size_t SU = (size_t)MT * 256;
  float w0f[4], w0b[4], a0c[4], kkc[4], kac[4];
#pragma unroll
  for (int nt = 0; nt < 4; ++nt) { int c = hd * 64 + r16 * 4 + nt; w0f[nt] = w0[c]; w0b[nt] = w0[256 + c]; a0c[nt] = a0[c]; kkc[nt] = kkw[c]; kac[nt] = kaw[c]; }
  for (int u = blockIdx.x; u < MT / 32; u += gridDim.x) {
    const int row0 = u * 32; int t0, len;
    if (row0 < ML) { t0 = row0 & (SL - 1); len = SL; } else { t0 = (row0 - ML) & (CL - 1); len = CL; }
    __syncthreads();
    for (int item = tid; item < 32 * 152; item += NTHR) {
      const int tk = item / 152, c8 = item - tk * 152; const int row = row0 + tk, t = t0 + tk;
      const uint4 uc = *(const uint4*)(P + (size_t)row * 1216 + c8 * 8);
      uint4 ua = make_uint4(0, 0, 0, 0), ub = make_uint4(0, 0, 0, 0);
      if (t >= 1) ua = *(const uint4*)(P + (size_t)(row - 1) * 1216 + c8 * 8);
      if (t + 1 < len) ub = *(const uint4*)(P + (size_t)(row + 1) * 1216 + c8 * 8);
      const float4 m0 = *(const float4*)(mu + c8 * 8), m1 = *(const float4*)(mu + c8 * 8 + 4);
      float o[8];
      {
        const unsigned wc[4] = {uc.x, uc.y, uc.z, uc.w}, wa[4] = {ua.x, ua.y, ua.z, ua.w}, wb[4] = {ub.x, ub.y, ub.z, ub.w};
        const float mm[8] = {m0.x, m0.y, m0.z, m0.w, m1.x, m1.y, m1.z, m1.w};
#pragma unroll
        for (int i = 0; i < 4; ++i) {
          float c_lo = bflo(wc[i]), c_hi = bfhi(wc[i]);
          o[2 * i] = c_lo + (0.5f * (bflo(wa[i]) + bflo(wb[i])) - c_lo) * mm[2 * i];
          o[2 * i + 1] = c_hi + (0.5f * (bfhi(wa[i]) + bfhi(wb[i])) - c_hi) * mm[2 * i + 1];
        }
      }
      char* dst;
      if (c8 < 96) dst = smem + ROFF + tk * RST + c8 * 16;
      else {
        const int cc = c8 * 8 - 768;
        if (cc < 128) {
#pragma unroll
          for (int i = 0; i < 8; ++i) o[i] = tanhf(o[i]);
        } else if (cc >= 192) {
#pragma unroll
          for (int i = 0; i < 8; ++i) o[i] = sigmoidf_(o[i]);
        }
        dst = smem + tk * AST + cc * 2;
      }
      uint4 ov; ov.x = pack2(o[0], o[1]); ov.y = pack2(o[2], o[3]); ov.z = pack2(o[4], o[5]); ov.w = pack2(o[6], o[7]);
      *(uint4*)dst = ov;
    }
    __syncthreads();
    f32x4 acc[5][4];
#pragma unroll
    for (int o5 = 0; o5 < 5; ++o5)
#pragma unroll
      for (int nt = 0; nt < 4; ++nt) acc[o5][nt] = (f32x4){0.f, 0.f, 0.f, 0.f};
    const char* Arow = smem + (tg * 16 + r16) * AST + g * 16;
#pragma unroll
    for (int o5 = 0; o5 < 5; ++o5) {
      const int kbase = o5 < 3 ? o5 * 64 : (o5 == 3 ? 192 : 320);
      const int KK = o5 < 3 ? 64 : 128;
      const bf16_t* Wt = (const bf16_t*)(p.ws + (o5 == 0 ? RWW_F : o5 == 1 ? RWW_B : o5 == 2 ? RWW_A : o5 == 3 ? RWW_GF : RWW_GB));
#pragma unroll
      for (int ks = 0; ks < KK / 32; ++ks) {
        const bf16x8 af = *(const bf16x8*)(Arow + (kbase + ks * 32) * 2);
#pragma unroll
        for (int nt = 0; nt < 4; ++nt) {
          const bf16x8 bf = *(const bf16x8*)(Wt + (size_t)(hd * 64 + nt * 16 + r16) * KK + ks * 32 + g * 8);
          acc[o5][nt] = __builtin_amdgcn_mfma_f32_16x16x32_bf16(af, bf, acc[o5][nt], 0, 0, 0);
        }
        if (ks & 1) asm volatile("" ::: "memory");
      }
    }
#pragma unroll
    for (int j = 0; j < 4; ++j) {
      const int tk = tg * 16 + g * 4 + j; const size_t row = (size_t)row0 + tk;
      const char* rk = smem + ROFF + tk * RST;
      const int c0 = hd * 64 + r16 * 4;
      const uint2 ur = *(const uint2*)(rk + c0 * 2), uk = *(const uint2*)(rk + (256 + c0) * 2), uv = *(const uint2*)(rk + (512 + c0) * 2);
      const float rv[4] = {bflo(ur.x), bfhi(ur.x), bflo(ur.y), bfhi(ur.y)};
      const float kv[4] = {bflo(uk.x), bfhi(uk.x), bflo(uk.y), bfhi(uk.y)};
      const float vv[4] = {bflo(uv.x), bfhi(uv.x), bflo(uv.y), bfhi(uv.y)};
      float n2 = 0.f;
#pragma unroll
      for (int nt = 0; nt < 4; ++nt) { float q = kv[nt] * kkc[nt]; n2 += q * q; }
      n2 = sum16(n2);
      const float inv = 1.f / fmaxf(sqrtf(n2), 1e-12f);
      float o_kp[4], o_kk[4], o_b[4], o_df[4], o_db[4];
#pragma unroll
      for (int nt = 0; nt < 4; ++nt) {
        const float k = kv[nt];
        const float a = sigmoidf_(a0c[nt] + acc[2][nt][j]);
        const float kk = k * kkc[nt] * inv;
        o_kp[nt] = k * (1.f + (a - 1.f) * kac[nt]);
        o_kk[nt] = kk; o_b[nt] = kk * a;
        const float xf = -(w0f[nt] + acc[0][nt][j]); const float spf = fmaxf(xf, 0.f) + log1pf(__expf(-fabsf(xf)));
        const float xb = -(w0b[nt] + acc[1][nt][j]); const float spb = fmaxf(xb, 0.f) + log1pf(__expf(-fabsf(xb)));
        const float ef = __expf(-spf - 0.5f), eb = __expf(-spb - 0.5f);
        o_df[nt] = -expm1f(-ef); o_db[nt] = -expm1f(-eb);
      }
      const size_t o = row * 256 + c0;
      uint2 w;
      w.x = pack2(rv[0], rv[1]); w.y = pack2(rv[2], rv[3]); *(uint2*)(S + o) = w;
      w.x = pack2(o_kp[0], o_kp[1]); w.y = pack2(o_kp[2], o_kp[3]); *(uint2*)(S + SU + o) = w;
      w.x = pack2(vv[0], vv[1]); w.y = pack2(vv[2], vv[3]); *(uint2*)(S + 2 * SU + o) = w;
      w.x = pack2(o_kk[0], o_kk[1]); w.y = pack2(o_kk[2], o_kk[3]); *(uint2*)(S + 3 * SU + o) = w;
      w.x = pack2(o_b[0], o_b[1]); w.y = pack2(o_b[2], o_b[3]); *(uint2*)(S + 4 * SU + o) = w;
      w.x = pack2(o_df[0], o_df[1]); w.y = pack2(o_df[2], o_df[3]); *(uint2*)(S + 5 * SU + o) = w;
      w.x = pack2(o_db[0], o_db[1]); w.y = pack2(o_db[2], o_db[3]); *(uint2*)(S + 6 * SU + o) = w;
      w.x = pack2(acc[3][0][j], acc[3][1][j]); w.y = pack2(acc[3][2][j], acc[3][3][j]); *(uint2*)(Gs + o) = w;
      w.x = pack2(acc[4][0][j], acc[4][1][j]); w.y = pack2(acc[4][2][j], acc[4][3][j]); *(uint2*)(Gs + SU + o) = w;
    }
  }
}

DI long scan_row(int b, int dir, int s) {
  if (s < CL) return (long)ML + b * CL + (dir ? (CL - 1 - s) : s);
  int t = s - CL; return (long)b * SL + (dir ? (SL - 1 - t) : t);
}
DI float sum8(float v) {
  v += dpp_mov<0xB1>(v);
  v += dpp_mov<0x4E>(v);
  v += dpp_mov<0x141>(v);
  return v;
}
DI void ph_scan(const Params& p, char* smem) {
  const int tid = my_tid(), lane = tid & 63, wid = tid >> 6;
  const bf16_t* S = (const bf16_t*)(p.ws + R_STR);
  const size_t SU = (size_t)MT * 256;
  constexpr int T = 32, NSTEP = CL + SL, NCH = NSTEP / T;
  typedef float f32x2 __attribute__((ext_vector_type(2)));
  for (int u = blockIdx.x; u < 128; u += gridDim.x) {
    const int chain = u >> 1, rg = u & 1; const int dir = chain & 1, bh = chain >> 1, b = bh >> 2, h = bh & 3;
    bf16_t* O = (bf16_t*)(p.ws + (dir ? R_OB : R_OF));
    uint4 q0, q1, q2;
    auto SC_GLOAD = [&](int ci) {
#pragma unroll
      for (int j = 0; j < 3; ++j) {
        int idx = tid + j * 512; int st = idx >> 8, s = (idx & 255) >> 3, ck = idx & 7;
        long row = scan_row(b, dir, ci * T + s);
        int sid = st < 5 ? st : 5 + dir;
        uint4 v = *(const uint4*)(S + sid * SU + row * 256 + h * 64 + ck * 8);
        if (j == 0) q0 = v; else if (j == 1) q1 = v; else q2 = v;
      }
    };
    auto SC_SSTORE = [&](int buf) {
#pragma unroll
      for (int j = 0; j < 3; ++j) {
        int idx = tid + j * 512; int st = idx >> 8;
        uint4 v = j == 0 ? q0 : (j == 1 ? q1 : q2);
        float4 lo = make_float4(bflo(v.x), bfhi(v.x), bflo(v.y), bfhi(v.y));
        float4 hi = make_float4(bflo(v.z), bfhi(v.z), bflo(v.w), bfhi(v.w));
        if (st == 5) { lo.x = 1.f - lo.x; lo.y = 1.f - lo.y; lo.z = 1.f - lo.z; lo.w = 1.f - lo.w; hi.x = 1.f - hi.x; hi.y = 1.f - hi.y; hi.z = 1.f - hi.z; hi.w = 1.f - hi.w; }
        char* base = smem + buf * 49152 + idx * 32;
        *(float4*)(base) = lo; *(float4*)(base + 16) = hi;
      }
    };
    auto FLUSH = [&](int ci) {
      const int s = tid >> 4, part = tid & 15;
      unsigned v = *(const unsigned*)(smem + 98304 + (ci & 1) * 2048 + s * 64 + part * 4);
      long row = scan_row(b, dir, ci * T + s);
      *(unsigned*)(O + row * 256 + h * 64 + rg * 32 + part * 2) = v;
    };
    __syncthreads();
    SC_GLOAD(0);
    SC_SSTORE(0);
    __syncthreads();
    f32x2 st0 = {0.f, 0.f}, st1 = {0.f, 0.f}, st2 = {0.f, 0.f}, st3 = {0.f, 0.f};
    const int rsub = lane >> 3, ks = lane & 7;
    const int lrow = (wid & 3) * 8 + rsub;
    const int vrow = rg * 32 + lrow;
    struct Step { f32x2 r[4], k[4], kk[4], b[4], w[4]; float v; };
    auto LOADSTEP = [&](Step& x, const char* B, int s) {
#pragma unroll
      for (int hh = 0; hh < 2; ++hh) {
        const float4 r = *(const float4*)(B + (0 * T + s) * 256 + ks * 32 + hh * 16);
        const float4 k = *(const float4*)(B + (1 * T + s) * 256 + ks * 32 + hh * 16);
        const float4 kk = *(const float4*)(B + (3 * T + s) * 256 + ks * 32 + hh * 16);
        const float4 bb = *(const float4*)(B + (4 * T + s) * 256 + ks * 32 + hh * 16);
        const float4 w = *(const float4*)(B + (5 * T + s) * 256 + ks * 32 + hh * 16);
        x.r[2 * hh] = (f32x2){r.x, r.y}; x.r[2 * hh + 1] = (f32x2){r.z, r.w};
        x.k[2 * hh] = (f32x2){k.x, k.y}; x.k[2 * hh + 1] = (f32x2){k.z, k.w};
        x.kk[2 * hh] = (f32x2){kk.x, kk.y}; x.kk[2 * hh + 1] = (f32x2){kk.z, kk.w};
        x.b[2 * hh] = (f32x2){bb.x, bb.y}; x.b[2 * hh + 1] = (f32x2){bb.z, bb.w};
        x.w[2 * hh] = (f32x2){w.x, w.y}; x.w[2 * hh + 1] = (f32x2){w.z, w.w};
      }
      x.v = *(const float*)(B + (2 * T + s) * 256 + vrow * 4);
    };
    for (int ci = 0; ci < NCH; ++ci) {
      if (ci + 1 < NCH) { SC_GLOAD(ci + 1); }
      if (ci > 0) FLUSH(ci - 1);
      if (wid < 4) {
        const char* B = smem + (ci & 1) * 49152;
        bf16_t* ob = (bf16_t*)(smem + 98304 + (ci & 1) * 2048);
        Step nx; LOADSTEP(nx, B, 0);
#pragma unroll 2
        for (int s = 0; s < T; ++s) {
          const Step c = nx;
          LOADSTEP(nx, B, (s + 1 < T) ? s + 1 : s);
          f32x2 pa = st0 * c.kk[0] + st1 * c.kk[1];
          f32x2 pb = st2 * c.kk[2] + st3 * c.kk[3];
          pa = pa + pb;
          float sa = -(pa.x + pa.y);
          sa = sum8(sa);
          const f32x2 sa2 = {sa, sa}; const f32x2 v2 = {c.v, c.v};
          st0 = st0 * c.w[0] + sa2 * c.b[0] + v2 * c.k[0];
          st1 = st1 * c.w[1] + sa2 * c.b[1] + v2 * c.k[1];
          st2 = st2 * c.w[2] + sa2 * c.b[2] + v2 * c.k[2];
          st3 = st3 * c.w[3] + sa2 * c.b[3] + v2 * c.k[3];
          f32x2 oa = st0 * c.r[0] + st1 * c.r[1];
          f32x2 ob2 = st2 * c.r[2] + st3 * c.r[3];
          oa = oa + ob2;
          float o = sum8(oa.x + oa.y);
          if (ks == 0) ob[s * 32 + lrow] = (bf16_t)f2bf(o);
        }
      }
      if (ci + 1 < NCH) { SC_SSTORE((ci + 1) & 1); }
      __syncthreads();
    }
    FLUSH(NCH - 1);
  }
}

template <bool DIFF>
DI void attn_unit(const Params& p, int l, int b, int h, int qrow0, int qpos0, int kb_lo, int kb_hi, int kc_lo, char* smem) {
  const int tid = my_tid(), lane = tid & 63, wid = tid >> 6, g = lane >> 4, r16 = lane & 15;
  const bf16_t* QK = (const bf16_t*)(p.ws + (DIFF ? R_PDF : R_PSW));
  const int ldq = DIFF ? 512 : 384;
  const int qc0 = h * 64;
  const int kc0 = 256 + (DIFF ? h * 64 : (h >> 1) * 64);
  const bf16_t* VT = DIFF ? (const bf16_t*)(p.ws + R_VTDF) + ((size_t)b * 256 + h * 64) * KEYS
                          : (const bf16_t*)(p.ws + R_VTSW) + ((size_t)b * 128 + (h >> 1) * 64) * KEYS;
  const int nblk = (kb_hi - kb_lo) + (68 - kc_lo);
  const float sc = (DIFF ? 0.17677669529663687f : 0.125f) * 1.4426950408889634f;
  bf16x8 qf[2];
  {
    const bf16_t* qp = QK + (size_t)(qrow0 + wid * 16 + r16) * ldq + qc0 + g * 8;
    qf[0] = *(const bf16x8*)(qp); qf[1] = *(const bf16x8*)(qp + 32);
  }
  constexpr int NC = DIFF ? 2 : 1;
  float m[NC], lsum[NC];
  f32x4 O[NC][4];
#pragma unroll
  for (int c = 0; c < NC; ++c) {
    if (DIFF) { m[c] = -1e30f; lsum[c] = 0.f; }
    else { m[c] = p.in[16][l * 4 + h] * 1.4426950408889634f; lsum[c] = (g == 0) ? 1.f : 0.f; }
#pragma unroll
    for (int dt = 0; dt < 4; ++dt) O[c][dt] = (f32x4){0.f, 0.f, 0.f, 0.f};
  }
  const int lr = tid >> 3, lc = tid & 7;
  uint4 rkA, rvA, rkB, rvB;
  rkA = make_uint4(0, 0, 0, 0); rvA = rkA; rkB = rkA; rvB = rkA;
  auto AT_GLOAD = [&](int i, uint4& rk, uint4& rv) {
    int kb = i < (kb_hi - kb_lo) ? kb_lo + i : kc_lo + (i - (kb_hi - kb_lo));
    long krow = kb < 64 ? (long)b * SL + kb * 64 + lr : (long)ML + b * CL + (kb - 64) * 64 + lr;
    rk = *(const uint4*)(QK + krow * ldq + kc0 + lc * 8);
    rv = *(const uint4*)(VT + (size_t)lr * KEYS + kb * 64 + lc * 8);
  };
  auto AT_SSTORE = [&](int buf, const uint4& rk, const uint4& rv) {
    *(uint4*)(smem + buf * 18432 + lr * 128 + ((lc ^ (lr & 7)) << 4)) = rk;
    *(uint4*)(smem + buf * 18432 + 9216 + lr * 144 + lc * 16) = rv;
  };
  __syncthreads();
  AT_GLOAD(0, rkA, rvA);
  AT_SSTORE(0, rkA, rvA);
  if (1 < nblk) AT_GLOAD(1, rkA, rvA);
  if (2 < nblk) AT_GLOAD(2, rkB, rvB);
  lds_barrier();
  const int qpos = qpos0 + wid * 16 + r16;
  for (int i = 0; i < nblk; ++i) {
    const int kb = i < (kb_hi - kb_lo) ? kb_lo + i : kc_lo + (i - (kb_hi - kb_lo));
    const bool masked = (!DIFF) && (kb < 64);
    const char* Kt = smem + (i & 1) * 18432; const char* Vt = Kt + 9216;
    f32x4 S[NC][4];
#pragma unroll
    for (int kt = 0; kt < 4; ++kt) {
      bf16x8 k0 = *(const bf16x8*)(Kt + (kt * 16 + r16) * 128 + ((g ^ (r16 & 7)) << 4));
      bf16x8 k1 = *(const bf16x8*)(Kt + (kt * 16 + r16) * 128 + (((4 + g) ^ (r16 & 7)) << 4));
      if (DIFF) {
        S[0][kt] = __builtin_amdgcn_mfma_f32_16x16x32_bf16(k0, qf[0], (f32x4){0.f, 0.f, 0.f, 0.f}, 0, 0, 0);
        S[NC - 1][kt] = __builtin_amdgcn_mfma_f32_16x16x32_bf16(k1, qf[1], (f32x4){0.f, 0.f, 0.f, 0.f}, 0, 0, 0);
      } else {
        f32x4 t = __builtin_amdgcn_mfma_f32_16x16x32_bf16(k0, qf[0], (f32x4){0.f, 0.f, 0.f, 0.f}, 0, 0, 0);
        S[0][kt] = __builtin_amdgcn_mfma_f32_16x16x32_bf16(k1, qf[1], t, 0, 0, 0);
      }
    }
    bf16x8 pf[NC][2];
#pragma unroll
    for (int c = 0; c < NC; ++c) {
      float mx = -1e30f;
#pragma unroll
      for (int kt = 0; kt < 4; ++kt)
#pragma unroll
        for (int j = 0; j < 4; ++j) {
          float v = S[c][kt][j];
          if (masked) { int kpos = kb * 64 + kt * 16 + g * 4 + j; int dd = kpos - qpos; if (dd > 128 || dd < -128) v = -3e38f; S[c][kt][j] = v; }
          mx = fmaxf(mx, v);
        }
      mx *= sc;
      mx = fmaxf(mx, __shfl_xor(mx, 16)); mx = fmaxf(mx, __shfl_xor(mx, 32));
      const float mn = fmaxf(m[c], mx);
      const bool grow = mn > m[c];
      float ps = 0.f;
      unsigned pk[8];
#pragma unroll
      for (int kt = 0; kt < 4; ++kt) {
        float e0 = __builtin_amdgcn_exp2f(fmaf(S[c][kt][0], sc, -mn)), e1 = __builtin_amdgcn_exp2f(fmaf(S[c][kt][1], sc, -mn));
        float e2 = __builtin_amdgcn_exp2f(fmaf(S[c][kt][2], sc, -mn)), e3 = __builtin_amdgcn_exp2f(fmaf(S[c][kt][3], sc, -mn));
        ps += (e0 + e1) + (e2 + e3);
        pk[kt * 2] = pack2(e0, e1); pk[kt * 2 + 1] = pack2(e2, e3);
      }
      if (__builtin_amdgcn_ballot_w64(grow) != 0ull) {
        const float alpha = __builtin_amdgcn_exp2f(m[c] - mn);
        m[c] = mn;
        lsum[c] *= alpha;
#pragma unroll
        for (int dt = 0; dt < 4; ++dt) { O[c][dt][0] *= alpha; O[c][dt][1] *= alpha; O[c][dt][2] *= alpha; O[c][dt][3] *= alpha; }
      }
      lsum[c] += ps;
      union { unsigned u[4]; bf16x8 v; } cv;
      cv.u[0] = pk[0]; cv.u[1] = pk[1]; cv.u[2] = pk[2]; cv.u[3] = pk[3]; pf[c][0] = cv.v;
      cv.u[0] = pk[4]; cv.u[1] = pk[5]; cv.u[2] = pk[6]; cv.u[3] = pk[7]; pf[c][1] = cv.v;
    }
#pragma unroll
    for (int dt = 0; dt < 4; ++dt)
#pragma unroll
      for (int s2 = 0; s2 < 2; ++s2) {
        union { uint2 u[2]; bf16x8 v; } vf;
        vf.u[0] = *(const uint2*)(Vt + (dt * 16 + r16) * 144 + (2 * s2) * 32 + g * 8);
        vf.u[1] = *(const uint2*)(Vt + (dt * 16 + r16) * 144 + (2 * s2 + 1) * 32 + g * 8);
#pragma unroll
        for (int c = 0; c < NC; ++c) O[c][dt] = __builtin_amdgcn_mfma_f32_16x16x32_bf16(vf.v, pf[c][s2], O[c][dt], 0, 0, 0);
      }
    if (i + 1 < nblk) AT_SSTORE((i + 1) & 1, rkA, rvA);
    rkA = rkB; rvA = rvB;
    if (i + 3 < nblk) AT_GLOAD(i + 3, rkB, rvB);
    lds_barrier();
  }
  float linv[NC];
#pragma unroll
  for (int c = 0; c < NC; ++c) { float t = lsum[c]; t += __shfl_xor(t, 16); t += __shfl_xor(t, 32); linv[c] = 1.f / t; }
  const size_t orow = (size_t)(qrow0 + wid * 16 + r16);
  if (!DIFF) {
    bf16_t* Y = (bf16_t*)(p.ws + R_YSW);
#pragma unroll
    for (int dt = 0; dt < 4; ++dt) {
      uint2 o; o.x = pack2(O[0][dt][0] * linv[0], O[0][dt][1] * linv[0]); o.y = pack2(O[0][dt][2] * linv[0], O[0][dt][3] * linv[0]);
      *(uint2*)(Y + orow * 256 + h * 64 + dt * 16 + g * 4) = o;
    }
  } else {
    const float lam_init = 0.8f - 0.6f * __expf(-0.3f * (float)l);
    float d1 = 0.f, d2 = 0.f;
    if (lane < 32) { d1 = p.in[28][l * 32 + lane] * p.in[29][l * 32 + lane]; d2 = p.in[30][l * 32 + lane] * p.in[31][l * 32 + lane]; }
    d1 = wave_sum(d1); d2 = wave_sum(d2);
    const float lam = expf(d1) - expf(d2) + lam_init;
    float ov[4][4]; float ss = 0.f;
#pragma unroll
    for (int dt = 0; dt < 4; ++dt)
#pragma unroll
      for (int j = 0; j < 4; ++j) { float v = O[0][dt][j] * linv[0] - lam * O[NC - 1][dt][j] * linv[NC - 1]; ov[dt][j] = v; ss += v * v; }
    ss += __shfl_xor(ss, 16); ss += __shfl_xor(ss, 32);
    const float rms = rsqrtf(ss * (1.f / 64.f) + 1e-5f) * (1.f - lam_init);
    const float* sg = p.in[32] + l * 64;
    bf16_t* Y = (bf16_t*)(p.ws + R_YDF);
#pragma unroll
    for (int dt = 0; dt < 4; ++dt) {
      const int d0 = dt * 16 + g * 4;
      uint2 o; o.x = pack2(ov[dt][0] * rms * sg[d0], ov[dt][1] * rms * sg[d0 + 1]); o.y = pack2(ov[dt][2] * rms * sg[d0 + 2], ov[dt][3] * rms * sg[d0 + 3]);
      *(uint2*)(Y + orow * 256 + h * 64 + d0) = o;
    }
  }
}

DI void ph_attn(const Params& p, int l, char* smem) {
  const bool need_ctx = (l == 0);
  const int n_sw = 1024 + (need_ctx ? 64 : 0);
  const int n_df = 1024 + (need_ctx ? 64 : 0);
  unsigned* ctr = (unsigned*)(p.ws + MISC_BAR + 64 + 64 * l);
  volatile int* slot = (volatile int*)(smem + 40960);
  for (;;) {
    __syncthreads();
    if (my_tid() == 0) *slot = (int)__hip_atomic_fetch_add(ctr, 1u, __ATOMIC_RELAXED, __HIP_MEMORY_SCOPE_AGENT);
    __syncthreads();
    const int u = *slot;
    if (u >= n_sw + n_df) break;
    if (u < n_df) {
      if (u < 1024) { int b = u >> 7, h = (u >> 5) & 3, n = u & 31; attn_unit<true>(p, l, b, h, b * SL + n * 128, n * 128, 0, 64, 64, smem); }
      else { int v = u - 1024; int b = v >> 3, h = (v >> 1) & 3, n = v & 1; attn_unit<true>(p, l, b, h, ML + b * CL + n * 128, 0, 0, 0, 64, smem); }
    } else {
      int w = u - n_df;
      if (w < 1024) {
        int b = w >> 7, h = (w >> 5) & 3, n = w & 31;
        int lo = (n - 1) * 2; if (lo < 0) lo = 0; int hi = (n + 2) * 2; if (hi > 64) hi = 64;
        attn_unit<false>(p, l, b, h, b * SL + n * 128, n * 128, lo, hi, 64, smem);
      } else { int v = w - 1024; int b = v >> 3, h = (v >> 1) & 3, n = v & 1; attn_unit<false>(p, l, b, h, ML + b * CL + n * 128, 0, 0, 0, 64, smem); }
    }
  }
}

DI void ph_rwout(const Params& p, int l) {
  const int lane = my_tid() & 63, wid = my_tid() >> 6;
  const bf16_t* S = (const bf16_t*)(p.ws + R_STR); const bf16_t* Gs = (const bf16_t*)(p.ws + R_G);
  const bf16_t* OF = (const bf16_t*)(p.ws + R_OF); const bf16_t* OB = (const bf16_t*)(p.ws + R_OB);
  bf16_t* Y = (bf16_t*)(p.ws + R_YRW);
  const size_t SU = (size_t)MT * 256;
  const float4 rk = *(const float4*)(p.in[25] + (size_t)l * 256 + lane * 4);
  const float4 gam = *(const float4*)(p.in[26] + (size_t)l * 256 + lane * 4);
  const float4 bet = *(const float4*)(p.in[27] + (size_t)l * 256 + lane * 4);
  const int nrows = (l == 0) ? MT : ML;
  for (int row = blockIdx.x * 8 + wid; row < nrows; row += gridDim.x * 8) {
    const size_t o = (size_t)row * 256 + lane * 4;
    uint2 ur = *(const uint2*)(S + o), uk = *(const uint2*)(S + SU + o), uv = *(const uint2*)(S + 2 * SU + o);
    uint2 uf = *(const uint2*)(OF + o), ub = *(const uint2*)(OB + o), ugf = *(const uint2*)(Gs + o), ugb = *(const uint2*)(Gs + SU + o);
    float r[4] = {bflo(ur.x), bfhi(ur.x), bflo(ur.y), bfhi(ur.y)};
    float k[4] = {bflo(uk.x), bfhi(uk.x), bflo(uk.y), bfhi(uk.y)};
    float v[4] = {bflo(uv.x), bfhi(uv.x), bflo(uv.y), bfhi(uv.y)};
    float f[4] = {bflo(uf.x), bfhi(uf.x), bflo(uf.y), bfhi(uf.y)};
    float bb[4] = {bflo(ub.x), bfhi(ub.x), bflo(ub.y), bfhi(ub.y)};
    float gf[4] = {bflo(ugf.x), bfhi(ugf.x), bflo(ugf.y), bfhi(ugf.y)};
    float gb[4] = {bflo(ugb.x), bfhi(ugb.x), bflo(ugb.y), bfhi(ugb.y)};
    const float rkv[4] = {rk.x, rk.y, rk.z, rk.w}; const float ga[4] = {gam.x, gam.y, gam.z, gam.w}; const float be[4] = {bet.x, bet.y, bet.z, bet.w};
    float bon = 0.f, sf = 0.f, sb = 0.f;
#pragma unroll
    for (int i = 0; i < 4; ++i) { bon += r[i] * k[i] * rkv[i]; sf += f[i]; sb += bb[i]; }
    bon = sum16(bon); float muf = sum16(sf) * (1.f / 64.f), mub = sum16(sb) * (1.f / 64.f);
    float qf = 0.f, qb = 0.f;
#pragma unroll
    for (int i = 0; i < 4; ++i) { f[i] -= muf; bb[i] -= mub; qf += f[i] * f[i]; qb += bb[i] * bb[i]; }
    float rsf = rsqrtf(sum16(qf) * (1.f / 64.f) + 64e-5f), rsb = rsqrtf(sum16(qb) * (1.f / 64.f) + 64e-5f);
    float y[4];
#pragma unroll
    for (int i = 0; i < 4; ++i) {
      float bn = bon * v[i];
      y[i] = (f[i] * rsf * ga[i] + be[i] + bn) * gf[i] + (bb[i] * rsb * ga[i] + be[i] + bn) * gb[i];
    }
    uint2 oo; oo.x = pack2(y[0], y[1]); oo.y = pack2(y[2], y[3]);
    *(uint2*)(Y + o) = oo;
  }
}

DI void ph_merge(const Params& p, int l, const bf16_t* U, char* smem) {
  const int lane = my_tid() & 63, wid = my_tid() >> 6, wm = wid >> 1, wn = wid & 1, g = lane >> 4, r16 = lane & 15;
  const int mtiles = (l == 0) ? 136 : 128;
  bf16_t* ACC = (bf16_t*)(p.ws + R_ACC);
  for (int it = 0;; ++it) {
    int mtile, ntile;
    if (!next_tile(it, mtiles, 8, mtile, ntile)) break;
    uint2 accS[4][4];
#pragma unroll
    for (int mt = 0; mt < 4; ++mt)
#pragma unroll
      for (int nt = 0; nt < 4; ++nt) accS[mt][nt] = make_uint2(0u, 0u);
    for (int j = 0; j < 4; ++j) {
      uint2 pb[4][4];
      {
        f32x4 accB[4][4]; zero_acc<4>(accB);
        const size_t yoff = (j == 0) ? R_YHY : (j == 1) ? R_YSW : (j == 2) ? R_YRW : R_YDF;
        gemm_glds(accB, (const bf16_t*)(p.ws + yoff), 256, RowPlain{(long)mtile * 256}, (const bf16_t*)(p.ws + WB_BR) + ((size_t)j * 1024 + ntile * 128) * 256, 256, 256, smem, (const bf16_t*)(p.ws + MISC_ZERO));
#pragma unroll
        for (int mt = 0; mt < 4; ++mt)
#pragma unroll
          for (int nt = 0; nt < 4; ++nt) { pb[mt][nt].x = pack2(accB[mt][nt][0], accB[mt][nt][1]); pb[mt][nt].y = pack2(accB[mt][nt][2], accB[mt][nt][3]); }
      }
      f32x4 accG[4][4]; zero_acc<4>(accG);
      gemm_glds(accG, U, 1024, RowPlain{(long)mtile * 256}, (const bf16_t*)(p.ws + WB_GATE) + ((size_t)j * 1024 + ntile * 128) * 1024, 1024, 1024, smem, (const bf16_t*)(p.ws + MISC_ZERO));
#pragma unroll
      for (int mt = 0; mt < 4; ++mt)
#pragma unroll
        for (int nt = 0; nt < 4; ++nt) {
          float v0 = bflo(accS[mt][nt].x) + sigmoidf_(accG[mt][nt][0]) * bflo(pb[mt][nt].x);
          float v1 = bfhi(accS[mt][nt].x) + sigmoidf_(accG[mt][nt][1]) * bfhi(pb[mt][nt].x);
          float v2 = bflo(accS[mt][nt].y) + sigmoidf_(accG[mt][nt][2]) * bflo(pb[mt][nt].y);
          float v3 = bfhi(accS[mt][nt].y) + sigmoidf_(accG[mt][nt][3]) * bfhi(pb[mt][nt].y);
          accS[mt][nt].x = pack2(v0, v1); accS[mt][nt].y = pack2(v2, v3);
        }
    }
#pragma unroll
    for (int mt = 0; mt < 4; ++mt) {
      const int col = ntile * 128 + wn * 64 + r16 * 4;
      const size_t row = (size_t)mtile * 256 + wm * 64 + mt * 16 + g * 4;
      uint2 o;
      o.x = (accS[mt][0].x & 0xffffu) | (accS[mt][1].x << 16); o.y = (accS[mt][2].x & 0xffffu) | (accS[mt][3].x << 16);
      *(uint2*)(ACC + (row + 0) * 1024 + col) = o;
      o.x = (accS[mt][0].x >> 16) | (accS[mt][1].x & 0xffff0000u); o.y = (accS[mt][2].x >> 16) | (accS[mt][3].x & 0xffff0000u);
      *(uint2*)(ACC + (row + 1) * 1024 + col) = o;
      o.x = (accS[mt][0].y & 0xffffu) | (accS[mt][1].y << 16); o.y = (accS[mt][2].y & 0xffffu) | (accS[mt][3].y << 16);
      *(uint2*)(ACC + (row + 2) * 1024 + col) = o;
      o.x = (accS[mt][0].y >> 16) | (accS[mt][1].y & 0xffff0000u); o.y = (accS[mt][2].y >> 16) | (accS[mt][3].y & 0xffff0000u);
      *(uint2*)(ACC + (row + 3) * 1024 + col) = o;
    }
  }
}

DI void ph_resgemm(const Params& p, int l, const bf16_t* A, int K, const bf16_t* Bt, const float* hsrc_lat, const float* hsrc_ctx, int gate_off, char* smem) {
  const int lane = my_tid() & 63, wid = my_tid() >> 6, wm = wid >> 1, wn = wid & 1, g = lane >> 4, r16 = lane & 15;
  const int mtiles = (l == 0) ? 136 : 128;
  const float* mod = (const float*)(p.ws + MISC_MOD) + (size_t)l * 9 * 6144;
  float* hc = (float*)(p.ws + OFF_HC);
  for (int it = 0;; ++it) {
    int mtile, ntile;
    if (!next_tile(it, mtiles, 8, mtile, ntile)) break;
    f32x4 acc[4][4]; zero_acc<4>(acc);
    gemm_glds(acc, A, K, RowPlain{(long)mtile * 256}, Bt + (size_t)ntile * 128 * K, K, K, smem, (const bf16_t*)(p.ws + MISC_ZERO));
    const int b = mtile < 128 ? (mtile >> 4) : 8;
    const float* gt = mod + (size_t)b * 6144 + gate_off;
    const int col = ntile * 128 + wn * 64 + r16 * 4;
    const float4 gv = *(const float4*)(gt + col);
#pragma unroll
    for (int mt = 0; mt < 4; ++mt)
#pragma unroll
      for (int e = 0; e < 4; ++e) {
        const int row = mtile * 256 + wm * 64 + mt * 16 + g * 4 + e;
        const float* hs; float* hd;
        if (row < ML) { size_t o = (size_t)row * D + col; hs = hsrc_lat + o; hd = p.out + o; }
        else { size_t o = (size_t)(row - ML) * D + col; hs = hsrc_ctx + o; hd = hc + o; }
        const float4 h = *(const float4*)hs;
        float4 r;
        r.x = DN_ALPHA * h.x + gv.x * acc[mt][0][e]; r.y = DN_ALPHA * h.y + gv.y * acc[mt][1][e];
        r.z = DN_ALPHA * h.z + gv.z * acc[mt][2][e]; r.w = DN_ALPHA * h.w + gv.w * acc[mt][3][e];
        *(float4*)hd = r;
      }
  }
}

DI void ph_ffnup(const Params& p, int l, char* smem) {
  const bf16_t* U = (const bf16_t*)(p.ws + R_U);
  const bf16_t* Bt = (const bf16_t*)(p.ws + WB_UP);
  bf16_t* HID = (bf16_t*)(p.ws + R_HID);
  const float* cw = p.in[38] + (size_t)l * 3 * 5632; const float* cb = p.in[39] + (size_t)l * 5632;
  const int tid = my_tid(), lane = tid & 63, wid = tid >> 6, wm = wid >> 2, wn = wid & 3, g = lane >> 4, r16 = lane & 15;
  const int mtiles = (l == 0) ? 152 : 136;
  constexpr int TS = 528;
  for (int it = 0;; ++it) {
    int mtile, ntile;
    if (!next_tile(it, mtiles, 22, mtile, ntile)) break;
    long rowbase; int tt, len;
    if (mtile < 136) { int b = mtile / 17; tt = mtile % 17; len = SL; rowbase = (long)b * SL; }
    else { int v = mtile - 136; int b = v >> 1; tt = v & 1; len = CL; rowbase = (long)ML + b * CL; }
    f32x4 acc[8][4]; zero_acc256(acc);
    gemm_glds256(acc, U, 1024, rowbase + tt * 254 - 1, Bt + (size_t)ntile * 256 * 1024, 1024, 1024, smem);
#pragma unroll
    for (int mt = 0; mt < 8; ++mt)
#pragma unroll
      for (int e = 0; e < 4; ++e) {
        uint2 o; o.x = pack2(acc[mt][0][e], acc[mt][1][e]); o.y = pack2(acc[mt][2][e], acc[mt][3][e]);
        *(uint2*)(smem + (wm * 128 + mt * 16 + g * 4 + e) * TS + (wn * 64 + r16 * 4) * 2) = o;
      }
    __syncthreads();
    {
      const int ch = tid & 127, rgp = tid >> 7; const int ca = ntile * 128 + ch, cbx = 2816 + ca;
      const float a0 = cw[ca], a1 = cw[5632 + ca], a2 = cw[2 * 5632 + ca], ab = cb[ca];
      const float b0 = cw[cbx], b1 = cw[5632 + cbx], b2 = cw[2 * 5632 + cbx], bb = cb[cbx];
      for (int r = 1 + rgp; r <= 254; r += 4) {
        const int tok = tt * 254 - 1 + r;
        if (tok < len) {
          const char* Tr = smem + r * TS + ch * 2;
          const float pa = tok >= 1 ? bf2f(*(const bf16_t*)(Tr - TS)) : 0.f, pb_ = tok >= 1 ? bf2f(*(const bf16_t*)(Tr - TS + 256)) : 0.f;
          const float na = tok + 1 < len ? bf2f(*(const bf16_t*)(Tr + TS)) : 0.f, nb = tok + 1 < len ? bf2f(*(const bf16_t*)(Tr + TS + 256)) : 0.f;
          const float av = a0 * pa + a1 * bf2f(*(const bf16_t*)(Tr)) + a2 * na + ab;
          const float bv = b0 * pb_ + b1 * bf2f(*(const bf16_t*)(Tr + 256)) + b2 * nb + bb;
          HID[(size_t)(rowbase + tok) * 2816 + ca] = (bf16_t)f2bf(siluf_(av) * bv);
        }
      }
    }
  }
}

#ifndef REP_PREP
#define REP_PREP 1
#endif
#ifndef REP_GEMM
#define REP_GEMM 1
#endif
#ifndef REP_HY
#define REP_HY 1
#endif
#ifndef REP_RWP
#define REP_RWP 1
#endif
#ifndef REP_SCAN
#define REP_SCAN 1
#endif
#ifndef REP_ATTN
#define REP_ATTN 1
#endif
#ifndef PH_END
#define PH_END 24
#endif
#define XB_TMO      128
#define XB_XCNT(j)  (256  + 64 * (j))
#define XB_XSUB(j)  (1280 + 64 * (j))
#define XB_XGEN(j)  (2304 + 64 * (j))
#define XB_TOP      3328
#define XB_TOPGEN   3392
#define XCD_BAR_WORDS 3456
#define XB_SPIN_CAP (1u << 22)
DI unsigned xb_ld(unsigned* p) { return __hip_atomic_load(p, __ATOMIC_RELAXED, __HIP_MEMORY_SCOPE_AGENT); }
DI unsigned xb_add(unsigned* p, unsigned v) { return __hip_atomic_fetch_add(p, v, __ATOMIC_RELAXED, __HIP_MEMORY_SCOPE_AGENT); }
DI unsigned xb_xcc_id() { return (unsigned)__builtin_amdgcn_s_getreg((3 << 11) | 20) & 0xFu; }
#define XB_SPIN(cond, bar) do { unsigned _sp = 0; while (cond) { __builtin_amdgcn_s_sleep(1); \
    if ((++_sp & 255u) == 0u) { if (xb_ld(&(bar)[XB_TMO])) break; if (_sp > XB_SPIN_CAP) { atomicAdd(&(bar)[XB_TMO], 1u); break; } } } } while (0)
DI void xcd_barrier_complete(unsigned* bar, unsigned x, unsigned& nloc, unsigned& nx) {
  const unsigned G = gridDim.x;
  unsigned sum, cnt, mine, sp = 0u;
  for (;;) {
    sum = 0u; cnt = 0u; mine = 0u;
#pragma unroll
    for (unsigned j = 0; j < 16; ++j) { const unsigned c = xb_ld(&bar[XB_XCNT(j)]); sum += c; cnt += (c > 0u) ? 1u : 0u; mine = (j == x) ? c : mine; }
    if (sum == G) break;
    __builtin_amdgcn_s_sleep(1);
    if ((++sp & 255u) == 0u) { if (xb_ld(&bar[XB_TMO])) break; if (sp > XB_SPIN_CAP) { atomicAdd(&bar[XB_TMO], 1u); break; } }
  }
  nloc = mine > 0u ? mine : 1u; nx = cnt > 0u ? cnt : 1u;
}
DI void grid_barrier(unsigned* bar, volatile unsigned* st) {
  asm volatile("s_waitcnt vmcnt(0)" ::: "memory");
  __syncthreads();
  if (my_tid() == 0) {
    const unsigned x = xb_xcc_id();
    __builtin_amdgcn_s_waitcnt(0);
    unsigned nloc = st[0], nx = st[1];
    if (nloc == 0u) { xcd_barrier_complete(bar, x, nloc, nx); st[0] = nloc; st[1] = nx; }
    const unsigned old = xb_add(&bar[XB_XSUB(x)], 1u);
    const unsigned gen = old / nloc;
    if (old + 1u == (gen + 1u) * nloc) {
      __builtin_amdgcn_fence(__ATOMIC_RELEASE, "agent");
      asm volatile("s_waitcnt vmcnt(0)" ::: "memory");
      const unsigned og = xb_add(&bar[XB_TOP], 1u);
      const unsigned tg = og / nx;
      if (og + 1u == (tg + 1u) * nx) xb_add(&bar[XB_TOPGEN], 1u);
      else XB_SPIN(xb_ld(&bar[XB_TOPGEN]) == tg, bar);
      __builtin_amdgcn_fence(__ATOMIC_ACQUIRE, "agent");
      xb_add(&bar[XB_XGEN(x)], 1u);
      asm volatile("s_waitcnt vmcnt(0)" ::: "memory");
    } else {
      XB_SPIN(xb_ld(&bar[XB_XGEN(x)]) == gen, bar);
      __builtin_amdgcn_fence(__ATOMIC_ACQUIRE, "agent");
      asm volatile("s_waitcnt vmcnt(0)" ::: "memory");
    }
  }
  __syncthreads();
}
#define SYNC_OR_RET(idx) do { if ((idx) + 1 >= PH_END) return; if ((idx) == 0) { grid.sync(); if (my_tid() == 0) (void)xb_add(&((unsigned*)(p.ws + MISC_XBAR))[XB_XCNT(xb_xcc_id())], 1u); } else grid_barrier((unsigned*)(p.ws + MISC_XBAR), (volatile unsigned*)(smem + 144 * 1024)); } while (0)
template <int l>
DI void run_layer(const Params& p, cg::grid_group& grid, char* smem, unsigned& epoch) {
  const float* mod = (const float*)(p.ws + MISC_MOD) + (size_t)l * 9 * 6144;
  float* hc = (float*)(p.ws + OFF_HC);
  const float* hl_src = (l == 0) ? p.in[0] : p.out;
  const float* hc_src = (l == 0) ? p.in[2] : hc;
  constexpr int B0 = l * 12;
  if (l == 0) {
    ph_convert(p, 0, smem);
    ph_ada(p, smem);
    hy_rawfilter(p, 0, SL, (float*)(p.ws + R_RAWF), smem);
    hy_rawfilter(p, 0, CL, (float*)(p.ws + MISC_RAWC), smem);
    SYNC_OR_RET(B0 + 0);
    ph_kf(p, 0, smem);
    ph_ln(hl_src, hc_src, nullptr, nullptr, nullptr, nullptr, (bf16_t*)p.out, mod, 0, MT);
    SYNC_OR_RET(B0 + 1);
  }
  for (int rep = 0; rep < REP_GEMM; ++rep) ph_inproj(p, l == 0 ? (const bf16_t*)p.out : (const bf16_t*)(p.ws + R_U), smem);
  SYNC_OR_RET(B0 + 2);
  for (int rep = 0; rep < REP_HY; ++rep) {
  if (blockIdx.x == 0 && my_tid() == 0) *(unsigned*)(p.ws + MISC_BAR + 64 + 64 * l) = 0u;
  ph_hyena(p, l, smem);
  if (l == 0) ph_hyena_ctx(p, l, smem);
  }
  ph_rope(p, smem);
  for (int rep = 0; rep < REP_RWP; ++rep) ph_rwprep(p, l, smem);
  SYNC_OR_RET(B0 + 3);
  for (int rep = 0; rep < REP_SCAN; ++rep) ph_scan(p, smem);
  for (int rep = 0; rep < REP_ATTN; ++rep) ph_attn(p, l, smem);
  SYNC_OR_RET(B0 + 4);
  ph_rwout(p, l);
  if (l != 0) ph_ln(hl_src, hc_src, nullptr, nullptr, nullptr, nullptr, (bf16_t*)(p.ws + R_URE), mod, 0, ML);
  SYNC_OR_RET(B0 + 5);
  for (int rep = 0; rep < REP_GEMM; ++rep) ph_merge(p, l, l == 0 ? (const bf16_t*)p.out : (const bf16_t*)(p.ws + R_URE), smem);
  SYNC_OR_RET(B0 + 6);
  ph_resgemm(p, l, (const bf16_t*)(p.ws + R_ACC), 1024, (const bf16_t*)(p.ws + WB_OUT), hl_src, hc_src, 2048, smem);
  if (l == 0) hy_rawfilter(p, 1, SL, (float*)(p.ws + R_RAWF), smem);
  SYNC_OR_RET(B0 + 7);
  ph_ln(p.out, hc, p.out, hc, p.in[35] + (size_t)l * D, p.in[36] + (size_t)l * D, (bf16_t*)(p.ws + R_U), mod, 3072, l == 0 ? MT : ML);
  if (l == 0) ph_kf(p, 1, smem);
  SYNC_OR_RET(B0 + 8);
  for (int rep = 0; rep < REP_GEMM; ++rep) ph_ffnup(p, l, smem);
  SYNC_OR_RET(B0 + 9);
  ph_resgemm(p, l, (const bf16_t*)(p.ws + R_HID), 2816, (const bf16_t*)(p.ws + WB_DOWN), p.out, hc, 5120, smem);
  SYNC_OR_RET(B0 + 10);
  if (l == 0) {
    ph_ln(p.out, hc, p.out, hc, p.in[41], p.in[42], (bf16_t*)(p.ws + R_U), mod + 9 * 6144, 0, MT);
    ph_convert(p, 1, smem);
  } else {
    ph_ln(p.out, hc, p.out, hc, p.in[41] + (size_t)l * D, p.in[42] + (size_t)l * D, nullptr, mod, 0, ML);
  }
  SYNC_OR_RET(B0 + 11);
}

__global__ void __launch_bounds__(NTHR) mega(Params p) {
  extern __shared__ __attribute__((aligned(16))) char smem[];
  cg::grid_group grid = cg::this_grid();
  unsigned epoch = 0;
  if (blockIdx.x == 0) for (int i = my_tid(); i < XCD_BAR_WORDS; i += NTHR) ((unsigned*)(p.ws + MISC_XBAR))[i] = 0u;
  if (my_tid() < 2) ((volatile unsigned*)(smem + 144 * 1024))[my_tid()] = 0u;
  if (blockIdx.x == 0 && my_tid() < 64) *(unsigned*)(p.ws + MISC_ZERO + my_tid() * 4) = 0u;
  run_layer<0>(p, grid, smem, epoch);
  if (PH_END > 12) run_layer<1>(p, grid, smem, epoch);
}

extern "C" void kernel_launch(void* const* d_in, const int* in_sizes, int n_in, void* d_out, int out_size,
                              void* d_ws, size_t ws_size, hipStream_t stream) {
  static int grid_blocks = 0;
  if (!grid_blocks) {
    int dev = 0, cus = 0, per_cu = 0;
    (void)hipGetDevice(&dev);
    (void)hipDeviceGetAttribute(&cus, hipDeviceAttributeMultiprocessorCount, dev);
    (void)hipFuncSetAttribute((const void*)mega, hipFuncAttributeMaxDynamicSharedMemorySize, SMEM_BYTES);
    (void)hipOccupancyMaxActiveBlocksPerMultiprocessor(&per_cu, mega, NTHR, SMEM_BYTES);
    if (per_cu < 1) per_cu = 1;
    if (per_cu > 1) per_cu = 1;
    grid_blocks = cus * per_cu;
  }
  Params p{};
  for (int i = 0; i < 43; ++i) p.in[i] = (const float*)d_in[i];
  p.out = (float*)d_out; p.ws = (char*)d_ws;
  void* args[] = {&p};
  hipError_t e = hipLaunchCooperativeKernel((void*)mega, dim3(grid_blocks), dim3(NTHR), args, SMEM_BYTES, stream);
  if (e != hipSuccess) fprintf(stderr, "cooperative launch failed: %s (grid %d)\n", hipGetErrorString(e), grid_blocks);
}
```

```cpp
#include <hip/hip_runtime.h>
#include <hip/hip_cooperative_groups.h>
#include <cstdio>
#include <cstdint>
namespace cg = cooperative_groups;

#define DI __device__ __forceinline__
typedef unsigned short bf16_t;
typedef short bf16x8 __attribute__((ext_vector_type(8)));
typedef float f32x4 __attribute__((ext_vector_type(4)));

constexpr int D = 1024, NB = 8, SL = 4096, CL = 256;
constexpr int ML = NB * SL, MC = NB * CL, MT = ML + MC;
constexpr int KEYS = SL + CL;
constexpr int NTHR = 512;
constexpr float DN_ALPHA = 1.41421356237f;
constexpr size_t UNIT = (size_t)MT * 512;

constexpr size_t WB_IN = 0;
constexpr size_t WB_GATE = WB_IN + (size_t)3328 * 1024 * 2;
constexpr size_t WB_BR = WB_GATE + (size_t)4096 * 1024 * 2;
constexpr size_t WB_OUT = WB_BR + (size_t)4 * 1024 * 256 * 2;
constexpr size_t WB_UP = WB_OUT + (size_t)1024 * 1024 * 2;
constexpr size_t WB_DOWN = WB_UP + (size_t)5632 * 1024 * 2;
constexpr size_t WB_END = WB_DOWN + (size_t)1024 * 2816 * 2;
constexpr size_t OFF_KF = WB_END;
constexpr size_t OFF_HC = OFF_KF + (size_t)512 * 8192 * 8;
constexpr size_t OFF_MISC = OFF_HC + (size_t)MC * D * 4;
constexpr size_t MISC_MOD = OFF_MISC;
constexpr size_t MISC_TW = MISC_MOD + (size_t)2 * 9 * 6144 * 4;
constexpr size_t MISC_RAWC = MISC_TW + 4096 * 8;
constexpr size_t MISC_GCTX = MISC_RAWC + (size_t)256 * 1024 * 4;
constexpr size_t MISC_RWW = MISC_GCTX + (size_t)512 * 512 * 4;
constexpr size_t RWW_F = MISC_RWW, RWW_B = RWW_F + 256 * 64 * 2, RWW_A = RWW_B + 256 * 64 * 2, RWW_GF = RWW_A + 256 * 64 * 2, RWW_GB = RWW_GF + 256 * 128 * 2;
constexpr size_t MISC_XBAR = OFF_MISC + (size_t)3 * 1024 * 1024;
constexpr size_t OFF_R = OFF_MISC + (size_t)4 * 1024 * 1024;
constexpr size_t MISC_BAR = OFF_R - 256;
constexpr size_t MISC_ZERO = OFF_R - 512;
static_assert(RWW_GB + 256 * 128 * 2 <= MISC_ZERO, "misc overflow");
constexpr size_t R_YHY = OFF_R, R_YSW = OFF_R + UNIT, R_YDF = OFF_R + 2 * UNIT;
constexpr size_t R_PHY = OFF_R + 3 * UNIT;
constexpr size_t R_PSW = OFF_R + 6 * UNIT;
constexpr size_t R_VTSW = R_PSW + (size_t)MT * 384 * 2;
constexpr size_t R_PDF = OFF_R + 8 * UNIT;
constexpr size_t R_VTDF = OFF_R + 10 * UNIT;
constexpr size_t R_PRW = OFF_R + 11 * UNIT;
constexpr size_t R_STR = R_PRW + (size_t)MT * 1216 * 2;
constexpr size_t R_G = R_STR + 7 * UNIT;
constexpr size_t R_END = R_G + 2 * UNIT;
constexpr size_t R_RAWF = OFF_R;
constexpr size_t R_OF = R_PHY, R_OB = R_PHY + UNIT;
constexpr size_t R_URE = R_PSW;
constexpr size_t R_YRW = R_VTDF;
constexpr size_t R_ACC = R_PRW;
constexpr size_t R_U = R_STR;
constexpr size_t R_HID = OFF_R;
static_assert(R_END <= (size_t)512 * 1024 * 1024, "ws overflow");
static_assert((size_t)MT * 2816 * 2 <= 11 * UNIT, "hid");

constexpr int SMEM_BYTES = 144 * 1024 + 64;

struct Params {
  const float* in[43];
  float* out;
  char* ws;
};

DI int my_tid() { int t = (int)__builtin_amdgcn_workitem_id_x(); asm volatile("" : "+v"(t)); return t; }
DI unsigned f2bf(float f) { unsigned u = __float_as_uint(f); u += 0x7fffu + ((u >> 16) & 1u); return u >> 16; }
DI float bf2f(unsigned h) { return __uint_as_float(h << 16); }
typedef __bf16 bf16v2_t __attribute__((ext_vector_type(2)));
typedef float f32v2_t __attribute__((ext_vector_type(2)));
DI unsigned pack2(float lo, float hi) { f32v2_t v = {lo, hi}; bf16v2_t b = __builtin_convertvector(v, bf16v2_t); return __builtin_bit_cast(unsigned, b); }

DI float bflo(unsigned w) { return __uint_as_float(w << 16); }
DI float bfhi(unsigned w) { return __uint_as_float(w & 0xffff0000u); }
DI float sigmoidf_(float x) { return 1.f / (1.f + __expf(-x)); }
DI float siluf_(float x) { return x / (1.f + __expf(-x)); }
DI float wave_sum(float v) {
#pragma unroll
  for (int o = 32; o >= 1; o >>= 1) v += __shfl_xor(v, o);
  return v;
}
template <int CTRL> DI float dpp_mov(float v) {
  return __int_as_float(__builtin_amdgcn_update_dpp(0, __float_as_int(v), CTRL, 0xf, 0xf, false));
}
DI float sum16(float v) {
  v += dpp_mov<0xB1>(v);
  v += dpp_mov<0x4E>(v);
  v += dpp_mov<0x141>(v);
  v += dpp_mov<0x140>(v);
  return v;
}
DI void lds_barrier() { asm volatile("s_waitcnt lgkmcnt(0)" ::: "memory"); __builtin_amdgcn_s_barrier(); asm volatile("" ::: "memory"); }
DI uint4 sel4(bool z, uint4 v) { return make_uint4(z ? 0u : v.x, z ? 0u : v.y, z ? 0u : v.z, z ? 0u : v.w); }
DI int mod_idx(int row) { return row < ML ? (row >> 12) : 8; }

template <int NTW, bool DEEP, class RowFn>
DI void gemm_main(f32x4 (&acc)[4][NTW], const bf16_t* __restrict__ A, int lda, RowFn rowfn,
                  const bf16_t* __restrict__ Bt, int ldb, int K, char* smem) {
  constexpr int BN = NTW * 32;
  constexpr int A_BYTES = 256 * 128, B_BYTES = BN * 128, STAGE = A_BYTES + B_BYTES;
  constexpr int NBL = BN / 64;
  const int tid = my_tid(), lane = tid & 63, wid = tid >> 6, wm = wid >> 1, wn = wid & 1, g = lane >> 4, r16 = lane & 15;
  const int chunk = tid & 7, lrow = tid >> 3;
  long a0 = rowfn(lrow), a1 = rowfn(lrow + 64), a2 = rowfn(lrow + 128), a3 = rowfn(lrow + 192);
  const long c0 = a0 < 0 ? 0 : a0, c1 = a1 < 0 ? 0 : a1, c2 = a2 < 0 ? 0 : a2, c3 = a3 < 0 ? 0 : a3;
  const bf16_t* Bp = Bt + (long)lrow * ldb + chunk * 8;
  const bf16_t* Ap0 = A + c0 * lda + chunk * 8; const bf16_t* Ap1 = A + c1 * lda + chunk * 8;
  const bf16_t* Ap2 = A + c2 * lda + chunk * 8; const bf16_t* Ap3 = A + c3 * lda + chunk * 8;
  struct Regs { uint4 a0, a1, a2, a3, b0, b1; };
  Regs R0, R1;
  R0.b1 = make_uint4(0, 0, 0, 0); R1.b1 = make_uint4(0, 0, 0, 0);
  auto GLOAD = [&](Regs& R, int k0) {
    R.a0 = *(const uint4*)(Ap0 + k0); R.a1 = *(const uint4*)(Ap1 + k0);
    R.a2 = *(const uint4*)(Ap2 + k0); R.a3 = *(const uint4*)(Ap3 + k0);
    R.b0 = *(const uint4*)(Bp + k0);
    if constexpr (NBL > 1) R.b1 = *(const uint4*)(Bp + (long)64 * ldb + k0);
  };
  auto SSTORE = [&](const Regs& R, int st) {
    char* base = smem + st * STAGE + lrow * 128 + ((chunk ^ (lrow & 7)) << 4);
    *(uint4*)(base) = sel4(a0 < 0, R.a0); *(uint4*)(base + 64 * 128) = sel4(a1 < 0, R.a1);
    *(uint4*)(base + 128 * 128) = sel4(a2 < 0, R.a2); *(uint4*)(base + 192 * 128) = sel4(a3 < 0, R.a3);
    *(uint4*)(base + A_BYTES) = R.b0;
    if constexpr (NBL > 1) *(uint4*)(base + A_BYTES + 64 * 128) = R.b1;
  };
  auto COMPUTE = [&](int st) {
    const char* As = smem + st * STAGE + (wm * 64 + r16) * 128;
    const char* Bs = smem + st * STAGE + A_BYTES + (wn * (NTW * 16) + r16) * 128;
#pragma unroll
    for (int kk = 0; kk < 2; ++kk) {
      const int sw = ((kk * 4 + g) ^ (r16 & 7)) << 4;
      bf16x8 af[4], bfr[NTW];
#pragma unroll
      for (int mt = 0; mt < 4; ++mt) af[mt] = *(const bf16x8*)(As + mt * 16 * 128 + sw);
#pragma unroll
      for (int nt = 0; nt < NTW; ++nt) bfr[nt] = *(const bf16x8*)(Bs + nt * 16 * 128 + sw);
#pragma unroll
      for (int mt = 0; mt < 4; ++mt)
#pragma unroll
        for (int nt = 0; nt < NTW; ++nt)
          acc[mt][nt] = __builtin_amdgcn_mfma_f32_16x16x32_bf16(af[mt], bfr[nt], acc[mt][nt], 0, 0, 0);
    }
  };
  const int nk = K >> 6;
  __syncthreads();
  GLOAD(R0, 0);
  SSTORE(R0, 0);
  if constexpr (DEEP) {
    GLOAD(R0, 64);
    if (nk > 2) GLOAD(R1, 128);
    lds_barrier();
    bf16x8 fa0[4], fb0[NTW], fa1[4], fb1[NTW];
    auto READF = [&](bf16x8 (&fa)[4], bf16x8 (&fb)[NTW], int st, int kk) {
      const int sw = ((kk * 4 + g) ^ (r16 & 7)) << 4;
      const char* As = smem + st * STAGE + (wm * 64 + r16) * 128 + sw;
      const char* Bs = smem + st * STAGE + A_BYTES + (wn * (NTW * 16) + r16) * 128 + sw;
#pragma unroll
      for (int mt = 0; mt < 4; ++mt) fa[mt] = *(const bf16x8*)(As + mt * 16 * 128);
#pragma unroll
      for (int nt = 0; nt < NTW; ++nt) fb[nt] = *(const bf16x8*)(Bs + nt * 16 * 128);
    };
    auto MMA = [&](const bf16x8 (&fa)[4], const bf16x8 (&fb)[NTW]) {
#pragma unroll
      for (int mt = 0; mt < 4; ++mt)
#pragma unroll
        for (int nt = 0; nt < NTW; ++nt)
          acc[mt][nt] = __builtin_amdgcn_mfma_f32_16x16x32_bf16(fa[mt], fb[nt], acc[mt][nt], 0, 0, 0);
    };
    READF(fa0, fb0, 0, 0);
    for (int kt = 0; kt < nk; kt += 2) {
      READF(fa1, fb1, 0, 1);
      MMA(fa0, fb0);
#pragma unroll
      for (int i = 0; i < 4 + NTW; ++i) { __builtin_amdgcn_sched_group_barrier(0x100, 1, 0); __builtin_amdgcn_sched_group_barrier(0x008, 2, 0); }
      __builtin_amdgcn_sched_barrier(0);
      SSTORE(R0, 1);
      if (kt + 3 < nk) GLOAD(R0, (kt + 3) * 64);
      MMA(fa1, fb1);
#pragma unroll
      for (int i = 0; i < 6; ++i) { __builtin_amdgcn_sched_group_barrier(0x200, 1, 0); __builtin_amdgcn_sched_group_barrier(0x020, 1, 0); __builtin_amdgcn_sched_group_barrier(0x008, 2, 0); }
      __builtin_amdgcn_sched_barrier(0);
      lds_barrier();
      READF(fa0, fb0, 1, 0);
      READF(fa1, fb1, 1, 1);
      MMA(fa0, fb0);
#pragma unroll
      for (int i = 0; i < 4 + NTW; ++i) { __builtin_amdgcn_sched_group_barrier(0x100, 1, 0); __builtin_amdgcn_sched_group_barrier(0x008, 2, 0); }
      __builtin_amdgcn_sched_barrier(0);
      if (kt + 2 < nk) SSTORE(R1, 0);
      if (kt + 4 < nk) GLOAD(R1, (kt + 4) * 64);
      MMA(fa1, fb1);
#pragma unroll
      for (int i = 0; i < 6; ++i) { __builtin_amdgcn_sched_group_barrier(0x200, 1, 0); __builtin_amdgcn_sched_group_barrier(0x020, 1, 0); __builtin_amdgcn_sched_group_barrier(0x008, 2, 0); }
      __builtin_amdgcn_sched_barrier(0);
      lds_barrier();
      if (kt + 2 < nk) READF(fa0, fb0, 0, 0);
    }
  } else {
    lds_barrier();
    for (int kt = 0; kt < nk; ++kt) {
      const int st = kt & 1;
      if (kt + 1 < nk) GLOAD(R0, (kt + 1) * 64);
      __builtin_amdgcn_sched_barrier(0);
      COMPUTE(st);
      __builtin_amdgcn_sched_barrier(0);
      if (kt + 1 < nk) SSTORE(R0, st ^ 1);
      lds_barrier();
    }
  }
}

#define GLDS16(gp, lp) __builtin_amdgcn_global_load_lds((const unsigned*)(gp), (unsigned*)(lp), 16, 0, 0)
template <class RowFn>
DI void gemm_glds(f32x4 (&acc)[4][4], const bf16_t* __restrict__ A, int lda, RowFn rowfn,
                  const bf16_t* __restrict__ Bt, int ldb, int K, char* smem, const bf16_t* zrow) {
  constexpr int A_BYTES = 256 * 128, STAGE = A_BYTES + 128 * 128;
  const int tid = my_tid(), lane = tid & 63, wid = tid >> 6, wm = wid >> 1, wn = wid & 1, g = lane >> 4, r16 = lane & 15;
  const int lrow = tid >> 3, c = (tid & 7) ^ (lrow & 7);
  const long a0 = rowfn(lrow), a1 = rowfn(lrow + 64), a2 = rowfn(lrow + 128), a3 = rowfn(lrow + 192);
  const bf16_t* pa0 = (a0 >= 0 ? A + a0 * lda : zrow) + c * 8; const int m0 = a0 >= 0 ? 1 : 0;
  const bf16_t* pa1 = (a1 >= 0 ? A + a1 * lda : zrow) + c * 8; const int m1 = a1 >= 0 ? 1 : 0;
  const bf16_t* pa2 = (a2 >= 0 ? A + a2 * lda : zrow) + c * 8; const int m2 = a2 >= 0 ? 1 : 0;
  const bf16_t* pa3 = (a3 >= 0 ? A + a3 * lda : zrow) + c * 8; const int m3 = a3 >= 0 ? 1 : 0;
  const bf16_t* pb0 = Bt + (long)lrow * ldb + c * 8; const bf16_t* pb1 = pb0 + (long)64 * ldb;
  auto ISSUE = [&](int kt, int bi) {
    char* d = smem + bi * STAGE + tid * 16;
    const int k0 = kt * 64;
    GLDS16(pa0 + k0 * m0, d); GLDS16(pa1 + k0 * m1, d + 8192); GLDS16(pa2 + k0 * m2, d + 16384); GLDS16(pa3 + k0 * m3, d + 24576);
    GLDS16(pb0 + k0, d + A_BYTES); GLDS16(pb1 + k0, d + A_BYTES + 8192);
  };
  auto COMPUTE = [&](int bi) {
    const char* As = smem + bi * STAGE + (wm * 64 + r16) * 128;
    const char* Bs = smem + bi * STAGE + A_BYTES + (wn * 64 + r16) * 128;
#pragma unroll
    for (int kk = 0; kk < 2; ++kk) {
      const int sw = ((kk * 4 + g) ^ (r16 & 7)) << 4;
      bf16x8 af[4], bfr[4];
#pragma unroll
      for (int mt = 0; mt < 4; ++mt) af[mt] = *(const bf16x8*)(As + mt * 16 * 128 + sw);
#pragma unroll
      for (int nt = 0; nt < 4; ++nt) bfr[nt] = *(const bf16x8*)(Bs + nt * 16 * 128 + sw);
      __builtin_amdgcn_s_setprio(1);
#pragma unroll
      for (int mt = 0; mt < 4; ++mt)
#pragma unroll
        for (int nt = 0; nt < 4; ++nt)
          acc[mt][nt] = __builtin_amdgcn_mfma_f32_16x16x32_bf16(af[mt], bfr[nt], acc[mt][nt], 0, 0, 0);
      __builtin_amdgcn_s_setprio(0);
    }
  };
  const int nk = K >> 6;
  __syncthreads();
  ISSUE(0, 0);
  ISSUE(1, 1);
  asm volatile("s_waitcnt vmcnt(6)" ::: "memory");
  __builtin_amdgcn_s_barrier();
  asm volatile("" ::: "memory");
  int bi = 0;
  for (int kt = 0; kt < nk; ++kt) {
    const int b2 = bi >= 1 ? bi - 1 : 2;
    if (kt + 2 < nk) ISSUE(kt + 2, b2);
    COMPUTE(bi);
    if (kt + 2 < nk) asm volatile("s_waitcnt vmcnt(6)" ::: "memory");
    else asm volatile("s_waitcnt vmcnt(0)" ::: "memory");
    asm volatile("s_waitcnt lgkmcnt(0)" ::: "memory");
    __builtin_amdgcn_s_barrier();
    asm volatile("" ::: "memory");
    bi = bi == 2 ? 0 : bi + 1;
  }
}

DI void gemm_glds256(f32x4 (&acc)[8][4], const bf16_t* __restrict__ A, int lda, long arow0,
                     const bf16_t* __restrict__ Bt, int ldb, int K, char* smem) {
  constexpr int A_BYTES = 256 * 128, STAGE = 2 * A_BYTES;
  const int tid = my_tid(), lane = tid & 63, wid = tid >> 6, wm = wid >> 2, wn = wid & 3, g = lane >> 4, r16 = lane & 15;
  const int lrow = tid >> 3, c = (tid & 7) ^ (lrow & 7);
  const bf16_t* pa = A + (arow0 + lrow) * (long)lda + c * 8;
  const bf16_t* pb = Bt + (long)lrow * ldb + c * 8;
  const long a64 = (long)64 * lda, b64 = (long)64 * ldb;
  auto ISSUE = [&](int kt, int bi) {
    char* d = smem + bi * STAGE + tid * 16;
    const int k0 = kt * 64;
    GLDS16(pa + k0, d); GLDS16(pa + a64 + k0, d + 8192); GLDS16(pa + 2 * a64 + k0, d + 16384); GLDS16(pa + 3 * a64 + k0, d + 24576);
    GLDS16(pb + k0, d + A_BYTES); GLDS16(pb + b64 + k0, d + A_BYTES + 8192); GLDS16(pb + 2 * b64 + k0, d + A_BYTES + 16384); GLDS16(pb + 3 * b64 + k0, d + A_BYTES + 24576);
  };
  auto COMPUTE = [&](int bi) {
    const char* As = smem + bi * STAGE + (wm * 128 + r16) * 128;
    const char* Bs = smem + bi * STAGE + A_BYTES + (wn * 64 + r16) * 128;
#pragma unroll
    for (int kk = 0; kk < 2; ++kk) {
      const int sw = ((kk * 4 + g) ^ (r16 & 7)) << 4;
      bf16x8 bfr[4];
#pragma unroll
      for (int nt = 0; nt < 4; ++nt) bfr[nt] = *(const bf16x8*)(Bs + nt * 16 * 128 + sw);
      __builtin_amdgcn_s_setprio(1);
#pragma unroll
      for (int mt = 0; mt < 8; ++mt) {
        const bf16x8 af = *(const bf16x8*)(As + mt * 16 * 128 + sw);
#pragma unroll
        for (int nt = 0; nt < 4; ++nt)
          acc[mt][nt] = __builtin_amdgcn_mfma_f32_16x16x32_bf16(af, bfr[nt], acc[mt][nt], 0, 0, 0);
      }
      __builtin_amdgcn_s_setprio(0);
    }
  };
  const int nk = K >> 6;
  __syncthreads();
  ISSUE(0, 0);
  asm volatile("s_waitcnt vmcnt(0)" ::: "memory");
  __builtin_amdgcn_s_barrier();
  asm volatile("" ::: "memory");
  int bi = 0;
  for (int kt = 0; kt < nk; ++kt) {
    if (kt + 1 < nk) ISSUE(kt + 1, bi ^ 1);
    COMPUTE(bi);
    asm volatile("s_waitcnt vmcnt(0)" ::: "memory");
    asm volatile("s_waitcnt lgkmcnt(0)" ::: "memory");
    __builtin_amdgcn_s_barrier();
    asm volatile("" ::: "memory");
    bi ^= 1;
  }
}
DI void zero_acc256(f32x4 (&acc)[8][4]) {
#pragma unroll
  for (int i = 0; i < 8; ++i)
#pragma unroll
    for (int j = 0; j < 4; ++j) acc[i][j] = (f32x4){0.f, 0.f, 0.f, 0.f};
}

DI bool next_tile(int i, int MTILES, int NTILES, int& mt, int& nt) {
  const int xcd = blockIdx.x & 7, slot = blockIdx.x >> 3, nslot = gridDim.x >> 3;
  const int m_lo = (MTILES * xcd) >> 3, m_hi = (MTILES * (xcd + 1)) >> 3, Mloc = m_hi - m_lo;
  const int q = i * nslot + slot;
  if (q >= Mloc * NTILES) return false;
  const int gidx = q / (4 * NTILES), m0 = gidx * 4;
  const int rows = (Mloc - m0) < 4 ? (Mloc - m0) : 4;
  const int within = q - gidx * 4 * NTILES;
  nt = within / rows; mt = m_lo + m0 + within % rows;
  return true;
}

struct RowPlain { long base; DI long operator()(int r) const { return base + r; } };
struct RowHalo { long rowbase; int t0; int len; DI long operator()(int r) const { int t = t0 + r; return (t >= 0 && t < len) ? rowbase + t : -1; } };

template <int NTW> DI void zero_acc(f32x4 (&acc)[4][NTW]) {
#pragma unroll
  for (int i = 0; i < 4; ++i)
#pragma unroll
    for (int j = 0; j < NTW; ++j) acc[i][j] = (f32x4){0.f, 0.f, 0.f, 0.f};
}

DI void cvt_unit(const float* __restrict__ src, int ldsrc, int srccol0, int k0, bf16_t* __restrict__ dst, int K, int n0, char* smem, bool perm = true) {
  float* T = (float*)smem;
  const int tid = my_tid();
  __syncthreads();
  if (srccol0 >= 0) {
#pragma unroll
    for (int i = 0; i < 8; ++i) {
      int idx = tid + i * 512; int k = idx >> 6, n = idx & 63;
      T[k * 65 + n] = src[(long)(k0 + k) * ldsrc + srccol0 + n];
    }
  }
  __syncthreads();
  int nd = tid >> 3, kc = (tid & 7) * 8; int n = perm ? ((nd & 15) * 4 + (nd >> 4)) : nd;
  uint4 o = make_uint4(0, 0, 0, 0);
  if (srccol0 >= 0) {
    o.x = pack2(T[(kc + 0) * 65 + n], T[(kc + 1) * 65 + n]);
    o.y = pack2(T[(kc + 2) * 65 + n], T[(kc + 3) * 65 + n]);
    o.z = pack2(T[(kc + 4) * 65 + n], T[(kc + 5) * 65 + n]);
    o.w = pack2(T[(kc + 6) * 65 + n], T[(kc + 7) * 65 + n]);
  }
  *(uint4*)(dst + (long)(n0 + nd) * K + k0 + kc) = o;
}

DI void ph_convert(const Params& p, int l, char* smem) {
  for (int u = blockIdx.x; u < 4508; u += gridDim.x) {
    if (u < 832) {
      int gI = u >> 4, kt = u & 15; int n0 = gI * 64; int sc;
      if (n0 < 1280) sc = n0; else if (n0 < 2048) sc = 2496 + (n0 - 1280); else if (n0 < 3264) sc = 1280 + (n0 - 2048); else sc = -1;
      cvt_unit(p.in[6] + (size_t)l * 1024 * 7360, 7360, sc, kt * 64, (bf16_t*)(p.ws + WB_IN), 1024, n0, smem);
    } else if (u < 1856) {
      int v = u - 832; int gI = v >> 4, kt = v & 15;
      cvt_unit(p.in[6] + (size_t)l * 1024 * 7360, 7360, 3264 + gI * 64, kt * 64, (bf16_t*)(p.ws + WB_GATE), 1024, gI * 64, smem);
    } else if (u < 2112) {
      int v = u - 1856; int gI = v >> 2, kt = v & 3; int j = gI >> 4, gg = gI & 15;
      cvt_unit(p.in[33] + ((size_t)l * 4 + j) * 256 * 1024, 1024, gg * 64, kt * 64, (bf16_t*)(p.ws + WB_BR) + (size_t)j * 1024 * 256, 256, gg * 64, smem);
    } else if (u < 2368) {
      int v = u - 2112; int gI = v >> 4, kt = v & 15;
      cvt_unit(p.in[34] + (size_t)l * 1024 * 1024, 1024, gI * 64, kt * 64, (bf16_t*)(p.ws + WB_OUT), 1024, gI * 64, smem);
    } else if (u < 3776) {
      int v = u - 2368; int gI = v >> 4, kt = v & 15; int nt = gI >> 2, q = gI & 3;
      cvt_unit(p.in[37] + (size_t)l * 1024 * 5632, 5632, (q >> 1) * 2816 + nt * 128 + (q & 1) * 64, kt * 64, (bf16_t*)(p.ws + WB_UP), 1024, gI * 64, smem);
    } else if (u < 4480) {
      int v = u - 3776; int gI = v / 44, kt = v % 44;
      cvt_unit(p.in[40] + (size_t)l * 2816 * 1024, 1024, gI * 64, kt * 64, (bf16_t*)(p.ws + WB_DOWN), 2816, gI * 64, smem);
    } else {
      int v = u - 4480;
      if (v < 4) cvt_unit(p.in[19] + (size_t)l * 2 * 64 * 256, 256, v * 64, 0, (bf16_t*)(p.ws + RWW_F), 64, v * 64, smem);
      else if (v < 8) cvt_unit(p.in[19] + (size_t)l * 2 * 64 * 256 + 64 * 256, 256, (v - 4) * 64, 0, (bf16_t*)(p.ws + RWW_B), 64, (v - 4) * 64, smem);
      else if (v < 12) cvt_unit(p.in[21] + (size_t)l * 64 * 256, 256, (v - 8) * 64, 0, (bf16_t*)(p.ws + RWW_A), 64, (v - 8) * 64, smem);
      else if (v < 20) { int w = v - 12; cvt_unit(p.in[22] + (size_t)l * 2 * 128 * 256, 256, (w >> 1) * 64, (w & 1) * 64, (bf16_t*)(p.ws + RWW_GF), 128, (w >> 1) * 64, smem); }
      else { int w = v - 20; cvt_unit(p.in[22] + (size_t)l * 2 * 128 * 256 + 128 * 256, 256, (w >> 1) * 64, (w & 1) * 64, (bf16_t*)(p.ws + RWW_GB), 128, (w >> 1) * 64, smem); }
    }
  }
}

DI void ph_ada(const Params& p, char* smem) {
  float* S = (float*)smem;
  float* R = S + 9 * 1024;
  const int tid = my_tid();
  bool loaded = false;
  for (int u = blockIdx.x; u < 192; u += gridDim.x) {
    if (!loaded) {
      __syncthreads();
      for (int i = tid; i < 9 * 1024; i += NTHR) { float c = i < 8192 ? p.in[1][i] : p.in[3][i - 8192]; S[i] = siluf_(c); }
      loaded = true;
    }
    __syncthreads();
    int l = u / 96, n0 = (u % 96) * 64;
    int col = tid & 63, ks = tid >> 6;
    const float* W = p.in[4] + (size_t)l * 1024 * 6144 + n0 + col;
    float a[9];
#pragma unroll
    for (int b = 0; b < 9; ++b) a[b] = 0.f;
    for (int k = ks * 128; k < ks * 128 + 128; ++k) {
      float w = W[(size_t)k * 6144];
#pragma unroll
      for (int b = 0; b < 9; ++b) a[b] += S[b * 1024 + k] * w;
    }
#pragma unroll
    for (int b = 0; b < 9; ++b) R[(ks * 9 + b) * 64 + col] = a[b];
    __syncthreads();
    for (int i = tid; i < 9 * 64; i += NTHR) {
      int b = i >> 6, c = i & 63; float s = 0.f;
#pragma unroll
      for (int k2 = 0; k2 < 8; ++k2) s += R[(k2 * 9 + b) * 64 + c];
      s += p.in[5][(size_t)l * 6144 + n0 + c];
      ((float*)(p.ws + MISC_MOD))[((size_t)l * 9 + b) * 6144 + n0 + c] = s;
    }
  }
  for (int i = blockIdx.x * NTHR + tid; i < 4096; i += gridDim.x * NTHR) {
    float s, c; sincospif(-(float)i / 4096.f, &s, &c);
    ((float2*)(p.ws + MISC_TW))[i] = make_float2(c, s);
  }
}

DI void hy_rawfilter(const Params& p, int l, int Lf, float* __restrict__ dst, char* smem) {
  float* W1 = (float*)smem;
  float* W2 = W1 + 33 * 64;
  float* Z = W2 + 64 * 64;
  float* H1 = Z + 16 * 36;
  float* H2 = H1 + 16 * 64;
  const int tid = my_tid();
  const float* w1 = p.in[9] + (size_t)l * 33 * 64; const float* b1 = p.in[10] + l * 64;
  const float* w2 = p.in[11] + (size_t)l * 64 * 64; const float* b2 = p.in[12] + l * 64;
  const float* w3 = p.in[13] + (size_t)l * 64 * 1024; const float* fr = p.in[14] + l * 64;
  const int nunits = Lf / 16;
  bool loaded = false;
  for (int u = blockIdx.x; u < nunits; u += gridDim.x) {
    __syncthreads();
    if (!loaded) {
      for (int i = tid; i < 33 * 64; i += NTHR) W1[i] = w1[i];
      for (int i = tid; i < 64 * 64; i += NTHR) W2[i] = w2[i];
      loaded = true;
    }
    const int t0 = u * 16;
    for (int i = tid; i < 16 * 33; i += NTHR) {
      int tt = i / 33, f = i % 33; int t = t0 + tt; float v;
      if (f == 0) v = (float)t / (float)(Lf - 1);
      else {
        int bi = (f - 1) & 15;
        float wv = 6.283185307179586f * (float)t / (float)Lf;
        float fb = 1e-4f + (15.f - 1e-4f) * (float)bi / 15.f;
        float ang = wv * fb;
        v = (f <= 16) ? cosf(ang) : -sinf(ang);
      }
      Z[tt * 36 + f] = v;
    }
    __syncthreads();
    for (int i = tid; i < 16 * 64; i += NTHR) {
      int tt = i >> 6, f = i & 63; float s = b1[f];
      for (int k = 0; k < 33; ++k) s += Z[tt * 36 + k] * W1[k * 64 + f];
      H1[tt * 64 + f] = sinf(fr[f] * s);
    }
    __syncthreads();
    for (int i = tid; i < 16 * 64; i += NTHR) {
      int tt = i >> 6, f = i & 63; float s = b2[f];
      for (int k = 0; k < 64; ++k) s += H1[tt * 64 + k] * W2[k * 64 + f];
      H2[tt * 64 + f] = sinf(fr[f] * s);
    }
    __syncthreads();
    float a0[16], a1[16];
#pragma unroll
    for (int i = 0; i < 16; ++i) { a0[i] = 0.f; a1[i] = 0.f; }
    for (int k = 0; k < 64; ++k) {
      float wa = w3[k * 1024 + tid], wb = w3[k * 1024 + 512 + tid];
#pragma unroll
      for (int i = 0; i < 16; ++i) { float h = H2[i * 64 + k]; a0[i] += h * wa; a1[i] += h * wb; }
    }
    {
      int w = tid & 255;
      float delta = fabsf(-3.0701134573253944f + (-15.350567286626972f + 3.0701134573253944f) * (float)w / 255.f);
#pragma unroll
      for (int i = 0; i < 16; ++i) {
        float tn = (float)(t0 + i) / (float)(Lf - 1);
        float dec = expf(-tn * delta);
        dst[(size_t)(t0 + i) * 1024 + tid] = a0[i] * dec;
        dst[(size_t)(t0 + i) * 1024 + 512 + tid] = a1[i] * dec;
      }
    }
  }
}

DI float2 cmul(float2 a, float2 b) { return make_float2(a.x * b.x - a.y * b.y, a.x * b.y + a.y * b.x); }
DI float2 cmulc(float2 a, float2 b) { return make_float2(a.x * b.x + a.y * b.y, a.y * b.x - a.x * b.y); }
DI float2 cadd(float2 a, float2 b) { return make_float2(a.x + b.x, a.y + b.y); }
DI float2 csub(float2 a, float2 b) { return make_float2(a.x - b.x, a.y - b.y); }
DI void fft_dif(float2* X, const float2* W) {
  const int tid = my_tid();
  for (int ls = 12; ls >= 2; ls -= 2) {
    const int s = 1 << ls, h = s >> 1;
    __syncthreads();
#pragma unroll
    for (int i = 0; i < 4; ++i) {
      const int bf = tid + i * 512; const int j = bf & (h - 1); const int base = ((bf >> (ls - 1)) << (ls + 1)) + j;
      const float2 x0 = X[base], x1 = X[base + h], x2 = X[base + s], x3 = X[base + s + h];
      const float2 w1 = W[s - 1 + j], w2 = W[h - 1 + j];
      const float2 y0 = cadd(x0, x2), y2 = cmul(csub(x0, x2), w1), y1 = cadd(x1, x3);
      const float2 t = cmul(csub(x1, x3), w1); const float2 y3 = make_float2(t.y, -t.x);
      X[base] = cadd(y0, y1); X[base + h] = cmul(csub(y0, y1), w2);
      X[base + s] = cadd(y2, y3); X[base + s + h] = cmul(csub(y2, y3), w2);
    }
  }
  __syncthreads();
#pragma unroll
  for (int i = 0; i < 4; ++i) {
    const int q = tid + i * 512;
    float4 a = *(float4*)(X + 4 * q), b = *(float4*)(X + 4 * q + 2);
    *(float4*)(X + 4 * q) = make_float4(a.x + a.z, a.y + a.w, a.x - a.z, a.y - a.w);
    *(float4*)(X + 4 * q + 2) = make_float4(b.x + b.z, b.y + b.w, b.x - b.z, b.y - b.w);
  }
  __syncthreads();
}
DI void fft_dit_inv(float2* X, const float2* W) {
  const int tid = my_tid();
  __syncthreads();
#pragma unroll
  for (int i = 0; i < 4; ++i) {
    const int q = tid + i * 512;
    float4 a = *(float4*)(X + 4 * q), b = *(float4*)(X + 4 * q + 2);
    *(float4*)(X + 4 * q) = make_float4(a.x + a.z, a.y + a.w, a.x - a.z, a.y - a.w);
    *(float4*)(X + 4 * q + 2) = make_float4(b.x + b.z, b.y + b.w, b.x - b.z, b.y - b.w);
  }
  for (int ls = 2; ls <= 12; ls += 2) {
    const int s = 1 << ls, h = s >> 1;
    __syncthreads();
#pragma unroll
    for (int i = 0; i < 4; ++i) {
      const int bf = tid + i * 512; const int j = bf & (h - 1); const int base = ((bf >> (ls - 1)) << (ls + 1)) + j;
      const float2 e0 = X[base], e1 = X[base + h], e2 = X[base + s], e3 = X[base + s + h];
      const float2 w1 = W[s - 1 + j], w2 = W[h - 1 + j];
      const float2 t1 = cmulc(e1, w2), t3 = cmulc(e3, w2);
      const float2 u0 = cadd(e0, t1), u1 = csub(e0, t1), u2 = cadd(e2, t3), u3 = csub(e2, t3);
      const float2 a2 = cmulc(u2, w1); const float2 q3 = cmulc(u3, w1); const float2 a3 = make_float2(-q3.y, q3.x);
      X[base] = cadd(u0, a2); X[base + s] = csub(u0, a2);
      X[base + h] = cadd(u1, a3); X[base + s + h] = csub(u1, a3);
    }
  }
  __syncthreads();
}
DI void load_twiddles(const Params& p, float2* W) {
  const float2* tw = (const float2*)(p.ws + MISC_TW);
  for (int i = my_tid(); i < 8191; i += NTHR) {
    const int ls = 31 - __clz(i + 1); const int pos = i + 1 - (1 << ls);
    W[i] = tw[pos << (12 - ls)];
  }
}

DI void ph_kf(const Params& p, int l, char* smem) {
  float2* X = (float2*)smem; float2* W = X + 8192; float* red = (float*)(W + 8192);
  const int tid = my_tid(), lane = tid & 63, wid = tid >> 6;
  const float* rawf = (const float*)(p.ws + R_RAWF);
  float2* kf = (float2*)(p.ws + OFF_KF);
  bool tw = false;
  for (int u = blockIdx.x; u < 256; u += gridDim.x) {
    if (!tw) { load_twiddles(p, W); tw = true; }
    const int o = u >> 7, c = (u & 127) * 2;
    float2 fw[8], bw[8]; float sa = 0.f, sb = 0.f;
#pragma unroll
    for (int i = 0; i < 8; ++i) {
      int t = tid + i * 512;
      fw[i] = *(const float2*)(rawf + (size_t)t * 1024 + o * 512 + c);
      bw[i] = *(const float2*)(rawf + (size_t)t * 1024 + o * 512 + 256 + c);
      sa += fabsf(fw[i].x) + fabsf(bw[i].x); sb += fabsf(fw[i].y) + fabsf(bw[i].y);
    }
    sa = wave_sum(sa); sb = wave_sum(sb);
    __syncthreads();
    if (lane == 0) { red[wid * 2] = sa; red[wid * 2 + 1] = sb; }
    __syncthreads();
    float ta = 0.f, tb = 0.f;
#pragma unroll
    for (int w = 0; w < 8; ++w) { ta += red[w * 2]; tb += red[w * 2 + 1]; }
    const float ia = 1.f / ta, ib = 1.f / tb;
#pragma unroll
    for (int i = 0; i < 8; ++i) {
      int t = tid + i * 512;
      X[t] = make_float2(fw[i].x * ia, fw[i].y * ib);
      if (t >= 1) X[8192 - t] = make_float2(bw[i].x * ia, bw[i].y * ib);
      else X[4096] = make_float2(0.f, 0.f);
    }
    fft_dif(X, W);
    float2* ka = kf + (size_t)(o * 256 + c) * 8192; float2* kb = ka + 8192;
#pragma unroll 4
    for (int i = 0; i < 16; ++i) {
      int pidx = tid + i * 512;
      int k = (int)(__brev((unsigned)pidx) >> 19);
      int k2 = (8192 - k) & 8191;
      int p2 = (int)(__brev((unsigned)k2) >> 19);
      float2 c1 = X[pidx], c2 = X[p2];
      float2 A = make_float2(0.5f * (c1.x + c2.x), 0.5f * (c1.y - c2.y));
      float2 Bv = make_float2(0.5f * (c1.y + c2.y), -0.5f * (c1.x - c2.x));
      ka[pidx] = A; kb[pidx] = Bv;
    }
    __syncthreads();
  }
  if (l == 0) {
    const float* rawc = (const float*)(p.ws + MISC_RAWC);
    float* G = (float*)(p.ws + MISC_GCTX);
    for (int u = blockIdx.x * 8 + wid; u < 512; u += gridDim.x * 8) {
      int o = u >> 8, c = u & 255; float f[4], b[4]; float s = 0.f;
#pragma unroll
      for (int i = 0; i < 4; ++i) {
        int t = lane + i * 64;
        f[i] = rawc[(size_t)t * 1024 + o * 512 + c]; b[i] = rawc[(size_t)t * 1024 + o * 512 + 256 + c];
        s += fabsf(f[i]) + fabsf(b[i]);
      }
      s = wave_sum(s); float inv = 1.f / s;
#pragma unroll
      for (int i = 0; i < 4; ++i) {
        int t = lane + i * 64;
        G[(size_t)u * 512 + 256 + t] = f[i] * inv;
        if (t >= 1) G[(size_t)u * 512 + 256 - t] = b[i] * inv;
      }
      if (lane == 0) G[(size_t)u * 512] = 0.f;
    }
  }
}

DI void ph_ln(const float* __restrict__ src_lat, const float* __restrict__ src_ctx, float* dst_lat, float* dst_ctx,
              const float* __restrict__ ag, const float* __restrict__ ab, bf16_t* U, const float* __restrict__ mod, int sh_off, int nrows) {
  const int lane = my_tid() & 63, wid = my_tid() >> 6;
  const int stride = gridDim.x * 8;
  float4 nv[4];
  {
    const int row = blockIdx.x * 8 + wid;
    if (row < nrows) {
      const float* src = row < ML ? src_lat + (size_t)row * D : src_ctx + (size_t)(row - ML) * D;
#pragma unroll
      for (int i = 0; i < 4; ++i) nv[i] = *(const float4*)(src + i * 256 + lane * 4);
    }
  }
  for (int row = blockIdx.x * 8 + wid; row < nrows; row += stride) {
    float4 v[4];
#pragma unroll
    for (int i = 0; i < 4; ++i) v[i] = nv[i];
    if (row + stride < nrows) {
      const int r2 = row + stride;
      const float* src2 = r2 < ML ? src_lat + (size_t)r2 * D : src_ctx + (size_t)(r2 - ML) * D;
#pragma unroll
      for (int i = 0; i < 4; ++i) nv[i] = *(const float4*)(src2 + i * 256 + lane * 4);
    }
    float s = 0.f;
#pragma unroll
    for (int i = 0; i < 4; ++i) s += v[i].x + v[i].y + v[i].z + v[i].w;
    float mu = wave_sum(s) * (1.f / 1024.f);
    float q = 0.f;
#pragma unroll
    for (int i = 0; i < 4; ++i) { v[i].x -= mu; v[i].y -= mu; v[i].z -= mu; v[i].w -= mu; q += v[i].x * v[i].x + v[i].y * v[i].y + v[i].z * v[i].z + v[i].w * v[i].w; }
    float rs = rsqrtf(wave_sum(q) * (1.f / 1024.f) + 1e-6f);
#pragma unroll
    for (int i = 0; i < 4; ++i) { v[i].x *= rs; v[i].y *= rs; v[i].z *= rs; v[i].w *= rs; }
    if (ag) {
      float* dst = row < ML ? dst_lat + (size_t)row * D : dst_ctx + (size_t)(row - ML) * D;
#pragma unroll
      for (int i = 0; i < 4; ++i) {
        float4 gg = *(const float4*)(ag + i * 256 + lane * 4), bb = *(const float4*)(ab + i * 256 + lane * 4);
        v[i].x = v[i].x * gg.x + bb.x; v[i].y = v[i].y * gg.y + bb.y; v[i].z = v[i].z * gg.z + bb.z; v[i].w = v[i].w * gg.w + bb.w;
        *(float4*)(dst + i * 256 + lane * 4) = v[i];
      }
      if (U) {
        s = 0.f;
#pragma unroll
        for (int i = 0; i < 4; ++i) s += v[i].x + v[i].y + v[i].z + v[i].w;
        mu = wave_sum(s) * (1.f / 1024.f); q = 0.f;
#pragma unroll
        for (int i = 0; i < 4; ++i) { v[i].x -= mu; v[i].y -= mu; v[i].z -= mu; v[i].w -= mu; q += v[i].x * v[i].x + v[i].y * v[i].y + v[i].z * v[i].z + v[i].w * v[i].w; }
        rs = rsqrtf(wave_sum(q) * (1.f / 1024.f) + 1e-6f);
#pragma unroll
        for (int i = 0; i < 4; ++i) { v[i].x *= rs; v[i].y *= rs; v[i].z *= rs; v[i].w *= rs; }
      }
    }
    if (U) {
      const float* m = mod + (size_t)mod_idx(row) * 6144 + sh_off;
#pragma unroll
      for (int i = 0; i < 4; ++i) {
        float4 sh = *(const float4*)(m + i * 256 + lane * 4), sc = *(const float4*)(m + 1024 + i * 256 + lane * 4);
        uint2 o; o.x = pack2(v[i].x * (1.f + sc.x) + sh.x, v[i].y * (1.f + sc.y) + sh.y);
        o.y = pack2(v[i].z * (1.f + sc.z) + sh.z, v[i].w * (1.f + sc.w) + sh.w);
        *(uint2*)(U + (size_t)row * D + i * 256 + lane * 4) = o;
      }
    }
  }
}

DI void ph_inproj(const Params& p, const bf16_t* U, char* smem) {
  const bf16_t* Bt = (const bf16_t*)(p.ws + WB_IN);
  const int lane = my_tid() & 63, wid = my_tid() >> 6, wm = wid >> 2, wn = wid & 3, g = lane >> 4, r16 = lane & 15;
  for (int it = 0;; ++it) {
    int mtile, ntile;
    if (!next_tile(it, 136, 13, mtile, ntile)) break;
    f32x4 acc[8][4]; zero_acc256(acc);
    gemm_glds256(acc, U, 1024, (long)mtile * 256, Bt + (size_t)ntile * 256 * 1024, 1024, 1024, smem);
    int b, key0;
    if (mtile < 128) { b = mtile >> 4; key0 = (mtile & 15) * 256; } else { b = mtile - 128; key0 = SL; }
    const int wc0 = ntile * 256 + wn * 64;
    bf16_t* tbase = nullptr; int tcols = 0, tcol0 = 0;
    if (wc0 < 768) { tbase = (bf16_t*)(p.ws + R_PHY); tcols = 768; tcol0 = wc0; }
    else if (wc0 >= 1152 && wc0 < 1280) { tbase = (bf16_t*)(p.ws + R_VTSW); tcols = 128; tcol0 = wc0 - 1152; }
    else if (wc0 >= 1792 && wc0 < 2048) { tbase = (bf16_t*)(p.ws + R_VTDF); tcols = 256; tcol0 = wc0 - 1792; }
    if (tbase) {
#pragma unroll
      for (int mt = 0; mt < 8; ++mt)
#pragma unroll
        for (int nt = 0; nt < 4; ++nt) {
          int col = tcol0 + r16 * 4 + nt;
          int key = key0 + wm * 128 + mt * 16 + g * 4;
          uint2 o; o.x = pack2(acc[mt][nt][0], acc[mt][nt][1]); o.y = pack2(acc[mt][nt][2], acc[mt][nt][3]);
          *(uint2*)(tbase + ((size_t)b * tcols + col) * KEYS + key) = o;
        }
    } else if (wc0 < 3264) {
      bf16_t* rb; int ld, c0;
      if (wc0 < 1152) { rb = (bf16_t*)(p.ws + R_PSW); ld = 384; c0 = wc0 - 768; }
      else if (wc0 < 1792) { rb = (bf16_t*)(p.ws + R_PDF); ld = 512; c0 = wc0 - 1280; }
      else { rb = (bf16_t*)(p.ws + R_PRW); ld = 1216; c0 = wc0 - 2048; }
      const int col = c0 + r16 * 4;
#pragma unroll
      for (int mt = 0; mt < 8; ++mt)
#pragma unroll
        for (int j = 0; j < 4; ++j) {
          size_t row = (size_t)mtile * 256 + wm * 128 + mt * 16 + g * 4 + j;
          uint2 o; o.x = pack2(acc[mt][0][j], acc[mt][1][j]); o.y = pack2(acc[mt][2][j], acc[mt][3][j]);
          *(uint2*)(rb + row * ld + col) = o;
        }
    }
  }
}

DI float hy_conv3(const bf16_t* __restrict__ P, int t, int len, float w0, float w1, float w2, float bias) {
  float a = t >= 1 ? bf2f(P[t - 1]) : 0.f, b = bf2f(P[t]), c = (t + 1 < len) ? bf2f(P[t + 1]) : 0.f;
  return w0 * a + w1 * b + w2 * c + bias;
}
DI void ph_hyena(const Params& p, int l, char* smem) {
  float2* X = (float2*)smem; float2* W = X + 8192;
  const int tid = my_tid();
  const bf16_t* PT = (const bf16_t*)(p.ws + R_PHY);
  const float2* kf = (const float2*)(p.ws + OFF_KF);
  const float* cw = p.in[7] + (size_t)l * 3 * 768; const float* cb = p.in[8] + (size_t)l * 768;
  const float* hb = p.in[15] + (size_t)l * 512;
  bf16_t* Y = (bf16_t*)(p.ws + R_YHY);
  bool tw = false;
  for (int u = blockIdx.x; u < 1024; u += gridDim.x) {
    if (!tw) { load_twiddles(p, W); tw = true; }
    const int bp = u >> 8, c = u & 255; const int b0 = bp * 2, b1 = b0 + 1;
    const bf16_t* P0 = PT + ((size_t)b0 * 768) * KEYS; const bf16_t* P1 = PT + ((size_t)b1 * 768) * KEYS;
    float wv0 = cw[c], wv1 = cw[768 + c], wv2 = cw[1536 + c], bv = cb[c];
    float wa0 = cw[256 + c], wa1 = cw[768 + 256 + c], wa2 = cw[1536 + 256 + c], ba = cb[256 + c];
    float wb0 = cw[512 + c], wb1 = cw[768 + 512 + c], wb2 = cw[1536 + 512 + c], bb = cb[512 + c];
    const float bias0 = hb[c], bias1 = hb[256 + c];
    float2 vv[8];
    __syncthreads();
#pragma unroll
    for (int i = 0; i < 8; ++i) {
      int t = tid + i * 512;
      vv[i].x = hy_conv3(P0 + (size_t)c * KEYS, t, SL, wv0, wv1, wv2, bv);
      vv[i].y = hy_conv3(P1 + (size_t)c * KEYS, t, SL, wv0, wv1, wv2, bv);
      X[t] = vv[i]; X[t + 4096] = make_float2(0.f, 0.f);
    }
    fft_dif(X, W);
    {
      const float2* H = kf + (size_t)c * 8192;
#pragma unroll 4
      for (int i = 0; i < 16; ++i) { int q = tid + i * 512; X[q] = cmul(X[q], H[q]); }
    }
    fft_dit_inv(X, W);
    float2 zz[8];
#pragma unroll
    for (int i = 0; i < 8; ++i) {
      int t = tid + i * 512;
      float2 y = X[t];
      float x1a = hy_conv3(P0 + (size_t)(256 + c) * KEYS, t, SL, wa0, wa1, wa2, ba);
      float x1b = hy_conv3(P1 + (size_t)(256 + c) * KEYS, t, SL, wa0, wa1, wa2, ba);
      zz[i].x = x1a * (y.x * (1.f / 8192.f) + bias0 * vv[i].x);
      zz[i].y = x1b * (y.y * (1.f / 8192.f) + bias0 * vv[i].y);
    }
    __syncthreads();
#pragma unroll
    for (int i = 0; i < 8; ++i) { int t = tid + i * 512; X[t] = zz[i]; X[t + 4096] = make_float2(0.f, 0.f); }
    fft_dif(X, W);
    {
      const float2* H = kf + (size_t)(256 + c) * 8192;
#pragma unroll 4
      for (int i = 0; i < 16; ++i) { int q = tid + i * 512; X[q] = cmul(X[q], H[q]); }
    }
    fft_dit_inv(X, W);
#pragma unroll
    for (int i = 0; i < 8; ++i) {
      int t = tid + i * 512;
      float2 y = X[t];
      float x2a = hy_conv3(P0 + (size_t)(512 + c) * KEYS, t, SL, wb0, wb1, wb2, bb);
      float x2b = hy_conv3(P1 + (size_t)(512 + c) * KEYS, t, SL, wb0, wb1, wb2, bb);
      float oa = x2a * (y.x * (1.f / 8192.f) + bias1 * zz[i].x);
      float ob = x2b * (y.y * (1.f / 8192.f) + bias1 * zz[i].y);
      Y[((size_t)b0 * SL + t) * 256 + c] = (bf16_t)f2bf(oa);
      Y[((size_t)b1 * SL + t) * 256 + c] = (bf16_t)f2bf(ob);
    }
  }
}

DI void ph_hyena_ctx(const Params& p, int l, char* smem) {
  const int tid = my_tid(), lane = tid & 63, wid = tid >> 6;
  float* Zb = (float*)smem + wid * 1024;
  float* Gb = Zb + 256;
  const bf16_t* PT = (const bf16_t*)(p.ws + R_PHY);
  const float* G = (const float*)(p.ws + MISC_GCTX);
  const float* cw = p.in[7] + (size_t)l * 3 * 768; const float* cb = p.in[8] + (size_t)l * 768;
  const float* hb = p.in[15] + (size_t)l * 512;
  bf16_t* Y = (bf16_t*)(p.ws + R_YHY);
  for (int base = blockIdx.x * 8; base < 2048; base += gridDim.x * 8) {
    const int u = base + wid; const int b = u >> 8, c = u & 255;
    const bf16_t* Pb = PT + ((size_t)b * 768) * KEYS + SL;
    float v[4], x1[4], x2[4], zz[4];
#pragma unroll
    for (int i = 0; i < 4; ++i) {
      int t = lane + i * 64;
      v[i] = hy_conv3(Pb + (size_t)c * KEYS, t, CL, cw[c], cw[768 + c], cw[1536 + c], cb[c]);
      x1[i] = hy_conv3(Pb + (size_t)(256 + c) * KEYS, t, CL, cw[256 + c], cw[768 + 256 + c], cw[1536 + 256 + c], cb[256 + c]);
      x2[i] = hy_conv3(Pb + (size_t)(512 + c) * KEYS, t, CL, cw[512 + c], cw[768 + 512 + c], cw[1536 + 512 + c], cb[512 + c]);
    }
    __syncthreads();
#pragma unroll
    for (int i = 0; i < 4; ++i) Zb[lane + i * 64] = v[i];
    for (int i = lane; i < 512; i += 64) Gb[i] = G[(size_t)c * 512 + i];
    __syncthreads();
#pragma unroll
    for (int i = 0; i < 4; ++i) {
      int t = lane + i * 64; float s = 0.f;
      for (int s2 = 0; s2 < 256; ++s2) s += Gb[256 + t - s2] * Zb[s2];
      zz[i] = x1[i] * (s + hb[c] * v[i]);
    }
    __syncthreads();
#pragma unroll
    for (int i = 0; i < 4; ++i) Zb[lane + i * 64] = zz[i];
    for (int i = lane; i < 512; i += 64) Gb[i] = G[(size_t)(256 + c) * 512 + i];
    __syncthreads();
#pragma unroll
    for (int i = 0; i < 4; ++i) {
      int t = lane + i * 64; float s = 0.f;
      for (int s2 = 0; s2 < 256; ++s2) s += Gb[256 + t - s2] * Zb[s2];
      float o = x2[i] * (s + hb[256 + c] * zz[i]);
      Y[((size_t)ML + b * CL + t) * 256 + c] = (bf16_t)f2bf(o);
    }
  }
}

DI void ph_rope(const Params& p, char* smem) {
  float2* T16 = (float2*)smem;
  float2* T8 = T16 + 64 * 16;
  const int tid = my_tid(), lane = tid & 63, wid = tid >> 6;
  __syncthreads();
  for (int i = tid; i < 64 * 16; i += NTHR) {
    int pos = i >> 4, f = i & 15; float inv = powf(10000.f, -(float)f / 16.f); float s, c; sincosf((float)pos * inv, &s, &c);
    T16[i] = make_float2(c, s);
  }
  for (int i = tid; i < 64 * 8; i += NTHR) {
    int pos = i >> 3, f = i & 7; float inv = powf(10000.f, -(float)f / 8.f); float s, c; sincosf((float)pos * inv, &s, &c);
    T8[i] = make_float2(c, s);
  }
  __syncthreads();
  bf16_t* Psw = (bf16_t*)(p.ws + R_PSW); bf16_t* Pdf = (bf16_t*)(p.ws + R_PDF);
  for (int row = blockIdx.x * 8 + wid; row < ML; row += gridDim.x * 8) {
    const int t = row & (SL - 1); const int pr = t >> 6, pc = t & 63;
    bf16_t* q = Psw + (size_t)row * 384;
#pragma unroll
    for (int i = 0; i < 3; ++i) {
      int pi = lane + i * 64; int hd = pi >> 5, pp = pi & 31; int half = pp >> 4, f = pp & 15;
      int base = hd * 64 + half * 32; float2 cs = T16[(half ? pc : pr) * 16 + f];
      float x1 = bf2f(q[base + f]), x2 = bf2f(q[base + 16 + f]);
      q[base + f] = (bf16_t)f2bf(x1 * cs.x - x2 * cs.y); q[base + 16 + f] = (bf16_t)f2bf(x1 * cs.y + x2 * cs.x);
    }
    bf16_t* d = Pdf + (size_t)row * 512;
#pragma unroll
    for (int i = 0; i < 4; ++i) {
      int pi = lane + i * 64; int gi = pi >> 4, pp = pi & 15; int half = pp >> 3, f = pp & 7;
      int base = gi * 32 + half * 16; float2 cs = T8[(half ? pc : pr) * 8 + f];
      float x1 = bf2f(d[base + f]), x2 = bf2f(d[base + 8 + f]);
      d[base + f] = (bf16_t)f2bf(x1 * cs.x - x2 * cs.y); d[base + 8 + f] = (bf16_t)f2bf(x1 * cs.y + x2 * cs.x);
    }
  }
}

DI float rw_shift(const bf16_t* __restrict__ P, int row, int t, int len, int col, float mu) {
  float c = bf2f(P[(size_t)row * 1216 + col]);
  float a = t >= 1 ? bf2f(P[(size_t)(row - 1) * 1216 + col]) : 0.f;
  float b = t + 1 < len ? bf2f(P[(size_t)(row + 1) * 1216 + col]) : 0.f;
  return c + (0.5f * (a + b) - c) * mu;
}
DI void ph_rwprep(const Params& p, int l, char* smem) {
  constexpr int AST = 912, RST = 1552, ROFF = 32 * AST;
  const int tid = my_tid(), lane = tid & 63, wid = tid >> 6, g = lane >> 4, r16 = lane & 15;
  const int tg = wid >> 2, hd = wid & 3;
  const bf16_t* P = (const bf16_t*)(p.ws + R_PRW);
  const float* mu = p.in[17] + (size_t)l * 1216;
  const float* w0 = p.in[18] + (size_t)l * 512; const float* a0 = p.in[20] + (size_t)l * 256;
  const float* kkw = p.in[23] + (size_t)l * 256; const float* kaw = p.in[24] + (size_t)l * 256;
  bf16_t* S = (bf16_t*)(p.ws + R_STR); bf16_t* Gs = (bf16_t*)(p.ws + R_G);
  const size_t SU = (size_t)MT * 256;
  float w0f[4], w0b[4], a0c[4], kkc[4], kac[4];
#pragma unroll
  for (int nt = 0; nt < 4; ++nt) { int c = hd * 64 + r16 * 4 + nt; w0f[nt] = w0[c]; w0b[nt] = w0[256 + c]; a0c[nt] = a0[c]; kkc[nt] = kkw[c]; kac[nt] = kaw[c]; }
  for (int u = blockIdx.x; u < MT / 32; u += gridDim.x) {
    const int row0 = u * 32; int t0, len;
    if (row0 < ML) { t0 = row0 & (SL - 1); len = SL; } else { t0 = (row0 - ML) & (CL - 1); len = CL; }
    __syncthreads();
    for (int item = tid; item < 32 * 152; item += NTHR) {
      const int tk = item / 152, c8 = item - tk * 152; const int row = row0 + tk, t = t0 + tk;
      const uint4 uc = *(const uint4*)(P + (size_t)row * 1216 + c8 * 8);
      uint4 ua = make_uint4(0, 0, 0, 0), ub = make_uint4(0, 0, 0, 0);
      if (t >= 1) ua = *(const uint4*)(P + (size_t)(row - 1) * 1216 + c8 * 8);
      if (t + 1 < len) ub = *(const uint4*)(P + (size_t)(row + 1) * 1216 + c8 * 8);
      const float4 m0 = *(const float4*)(mu + c8 * 8), m1 = *(const float4*)(mu + c8 * 8 + 4);
      float o[8];
      {
        const unsigned wc[4] = {uc.x, uc.y, uc.z, uc.w}, wa[4] = {ua.x, ua.y, ua.z, ua.w}, wb[4] = {ub.x, ub.y, ub.z, ub.w};
        const float mm[8] = {m0.x, m0.y, m0.z, m0.w, m1.x, m1.y, m1.z, m1.w};
#pragma unroll
        for (int i = 0; i < 4; ++i) {
          float c_lo = bflo(wc[i]), c_hi = bfhi(wc[i]);
          o[2 * i] = c_lo + (0.5f * (bflo(wa[i]) + bflo(wb[i])) - c_lo) * mm[2 * i];
          o[2 * i + 1] = c_hi + (0.5f * (bfhi(wa[i]) + bfhi(wb[i])) - c_hi) * mm[2 * i + 1];
        }
      }
      char* dst;
      if (c8 < 96) dst = smem + ROFF + tk * RST + c8 * 16;
      else {
        const int cc = c8 * 8 - 768;
        if (cc < 128) {
#pragma unroll
          for (int i = 0; i < 8; ++i) o[i] = tanhf(o[i]);
        } else if (cc >= 192) {
#pragma unroll
          for (int i = 0; i < 8; ++i) o[i] = sigmoidf_(o[i]);
        }
        dst = smem + tk * AST + cc * 2;
      }
      uint4 ov; ov.x = pack2(o[0], o[1]); ov.y = pack2(o[2], o[3]); ov.z = pack2(o[4], o[5]); ov.w = pack2(o[6], o[7]);
      *(uint4*)dst = ov;
    }
    __syncthreads();
    f32x4 acc[5][4];
#pragma unroll
    for (int o5 = 0; o5 < 5; ++o5)
#pragma unroll
      for (int nt = 0; nt < 4; ++nt) acc[o5][nt] = (f32x4){0.f, 0.f, 0.f, 0.f};
    const char* Arow = smem + (tg * 16 + r16) * AST + g * 16;
#pragma unroll
    for (int o5 = 0; o5 < 5; ++o5) {
      const int kbase = o5 < 3 ? o5 * 64 : (o5 == 3 ? 192 : 320);
      const int KK = o5 < 3 ? 64 : 128;
      const bf16_t* Wt = (const bf16_t*)(p.ws + (o5 == 0 ? RWW_F : o5 == 1 ? RWW_B : o5 == 2 ? RWW_A : o5 == 3 ? RWW_GF : RWW_GB));
#pragma unroll
      for (int ks = 0; ks < KK / 32; ++ks) {
        const bf16x8 af = *(const bf16x8*)(Arow + (kbase + ks * 32) * 2);
#pragma unroll
        for (int nt = 0; nt < 4; ++nt) {
          const bf16x8 bf = *(const bf16x8*)(Wt + (size_t)(hd * 64 + nt * 16 + r16) * KK + ks * 32 + g * 8);
          acc[o5][nt] = __builtin_amdgcn_mfma_f32_16x16x32_bf16(af, bf, acc[o5][nt], 0, 0, 0);
        }
        if (ks & 1) asm volatile("" ::: "memory");
      }
    }
#pragma unroll
    for (int j = 0; j < 4; ++j) {
      const int tk = tg * 16 + g * 4 + j; const size_t row = (size_t)row0 + tk;
      const char* rk = smem + ROFF + tk * RST;
      const int c0 = hd * 64 + r16 * 4;
      const uint2 ur = *(const uint2*)(rk + c0 * 2), uk = *(const uint2*)(rk + (256 + c0) * 2), uv = *(const uint2*)(rk + (512 + c0) * 2);
      const float rv[4] = {bflo(ur.x), bfhi(ur.x), bflo(ur.y), bfhi(ur.y)};
      const float kv[4] = {bflo(uk.x), bfhi(uk.x), bflo(uk.y), bfhi(uk.y)};
      const float vv[4] = {bflo(uv.x), bfhi(uv.x), bflo(uv.y), bfhi(uv.y)};
      float n2 = 0.f;
#pragma unroll
      for (int nt = 0; nt < 4; ++nt) { float q = kv[nt] * kkc[nt]; n2 += q * q; }
      n2 = sum16(n2);
      const float inv = 1.f / fmaxf(sqrtf(n2), 1e-12f);
      float o_kp[4], o_kk[4], o_b[4], o_df[4], o_db[4];
#pragma unroll
      for (int nt = 0; nt < 4; ++nt) {
        const float k = kv[nt];
        const float a = sigmoidf_(a0c[nt] + acc[2][nt][j]);
        const float kk = k * kkc[nt] * inv;
        o_kp[nt] = k * (1.f + (a - 1.f) * kac[nt]);
        o_kk[nt] = kk; o_b[nt] = kk * a;
        const float xf = -(w0f[nt] + acc[0][nt][j]); const float spf = fmaxf(xf, 0.f) + log1pf(__expf(-fabsf(xf)));
        const float xb = -(w0b[nt] + acc[1][nt][j]); const float spb = fmaxf(xb, 0.f) + log1pf(__expf(-fabsf(xb)));
        const float ef = __expf(-spf - 0.5f), eb = __expf(-spb - 0.5f);
        o_df[nt] = -expm1f(-ef); o_db[nt] = -expm1f(-eb);
      }
      const size_t o = row * 256 + c0;
      uint2 w;
      w.x = pack2(rv[0], rv[1]); w.y = pack2(rv[2], rv[3]); *(uint2*)(S + o) = w;
      w.x = pack2(o_kp[0], o_kp[1]); w.y = pack2(o_kp[2], o_kp[3]); *(uint2*)(S + SU + o) = w;
      w.x = pack2(vv[0], vv[1]); w.y = pack2(vv[2], vv[3]); *(uint2*)(S + 2 * SU + o) = w;
      w.x = pack2(o_kk[0], o_kk[1]); w.y = pack2(o_kk[2], o_kk[3]); *(uint2*)(S + 3 * SU + o) = w;
      w.x = pack2(o_b[0], o_b[1]); w.y = pack2(o_b[2], o_b[3]); *(uint2*)(S + 4 * SU + o) = w;
      w.x = pack2(o_df[0], o_df[1]); w.y = pack2(o_df[2], o_df[3]); *(uint2*)(S + 5 * SU + o) = w;
      w.x = pack2(o_db[0], o_db[1]); w.y = pack2(o_db[2], o_db[3]); *(uint2*)(S + 6 * SU + o) = w;
      w.x = pack2(acc[3][0][j], acc[3][1][j]); w.y = pack2(acc[3][2][j], acc[3][3][j]); *(uint2*)(Gs + o) = w;
      w.x = pack2(acc[4][0][j], acc[4][1][j]); w.y = pack2(acc[4][2][j], acc[4][3][j]); *(uint2*)(Gs + SU + o) = w;
    }
  }
}

DI long scan_row(int b, int dir, int s) {
  if (s < CL) return (long)ML + b * CL + (dir ? (CL - 1 - s) : s);
  int t = s - CL; return (long)b * SL + (dir ? (SL - 1 - t) : t);
}
DI float sum8(float v) {
  v += dpp_mov<0xB1>(v);
  v += dpp_mov<0x4E>(v);
  v += dpp_mov<0x141>(v);
  return v;
}
DI void ph_scan(const Params& p, char* smem) {
  const int tid = my_tid(), lane = tid & 63, wid = tid >> 6;
  const bf16_t* S = (const bf16_t*)(p.ws + R_STR);
  const size_t SU = (size_t)MT * 256;
  constexpr int T = 32, NSTEP = CL + SL, NCH = NSTEP / T;
  typedef float f32x2 __attribute__((ext_vector_type(2)));
  for (int u = blockIdx.x; u < 128; u += gridDim.x) {
    const int chain = u >> 1, rg = u & 1; const int dir = chain & 1, bh = chain >> 1, b = bh >> 2, h = bh & 3;
    bf16_t* O = (bf16_t*)(p.ws + (dir ? R_OB : R_OF));
    uint4 q0, q1, q2;
    auto SC_GLOAD = [&](int ci) {
#pragma unroll
      for (int j = 0; j < 3; ++j) {
        int idx = tid + j * 512; int st = idx >> 8, s = (idx & 255) >> 3, ck = idx & 7;
        long row = scan_row(b, dir, ci * T + s);
        int sid = st < 5 ? st : 5 + dir;
        uint4 v = *(const uint4*)(S + sid * SU + row * 256 + h * 64 + ck * 8);
        if (j == 0) q0 = v; else if (j == 1) q1 = v; else q2 = v;
      }
    };
    auto SC_SSTORE = [&](int buf) {
#pragma unroll
      for (int j = 0; j < 3; ++j) {
        int idx = tid + j * 512; int st = idx >> 8;
        uint4 v = j == 0 ? q0 : (j == 1 ? q1 : q2);
        float4 lo = make_float4(bflo(v.x), bfhi(v.x), bflo(v.y), bfhi(v.y));
        float4 hi = make_float4(bflo(v.z), bfhi(v.z), bflo(v.w), bfhi(v.w));
        if (st == 5) { lo.x = 1.f - lo.x; lo.y = 1.f - lo.y; lo.z = 1.f - lo.z; lo.w = 1.f - lo.w; hi.x = 1.f - hi.x; hi.y = 1.f - hi.y; hi.z = 1.f - hi.z; hi.w = 1.f - hi.w; }
        char* base = smem + buf * 49152 + idx * 32;
        *(float4*)(base) = lo; *(float4*)(base + 16) = hi;
      }
    };
    auto FLUSH = [&](int ci) {
      const int s = tid >> 4, part = tid & 15;
      unsigned v = *(const unsigned*)(smem + 98304 + (ci & 1) * 2048 + s * 64 + part * 4);
      long row = scan_row(b, dir, ci * T + s);
      *(unsigned*)(O + row * 256 + h * 64 + rg * 32 + part * 2) = v;
    };
    __syncthreads();
    SC_GLOAD(0);
    SC_SSTORE(0);
    __syncthreads();
    f32x2 st0 = {0.f, 0.f}, st1 = {0.f, 0.f}, st2 = {0.f, 0.f}, st3 = {0.f, 0.f};
    const int rsub = lane >> 3, ks = lane & 7;
    const int lrow = (wid & 3) * 8 + rsub;
    const int vrow = rg * 32 + lrow;
    struct Step { f32x2 r[4], k[4], kk[4], b[4], w[4]; float v; };
    auto LOADSTEP = [&](Step& x, const char* B, int s) {
#pragma unroll
      for (int hh = 0; hh < 2; ++hh) {
        const float4 r = *(const float4*)(B + (0 * T + s) * 256 + ks * 32 + hh * 16);
        const float4 k = *(const float4*)(B + (1 * T + s) * 256 + ks * 32 + hh * 16);
        const float4 kk = *(const float4*)(B + (3 * T + s) * 256 + ks * 32 + hh * 16);
        const float4 bb = *(const float4*)(B + (4 * T + s) * 256 + ks * 32 + hh * 16);
        const float4 w = *(const float4*)(B + (5 * T + s) * 256 + ks * 32 + hh * 16);
        x.r[2 * hh] = (f32x2){r.x, r.y}; x.r[2 * hh + 1] = (f32x2){r.z, r.w};
        x.k[2 * hh] = (f32x2){k.x, k.y}; x.k[2 * hh + 1] = (f32x2){k.z, k.w};
        x.kk[2 * hh] = (f32x2){kk.x, kk.y}; x.kk[2 * hh + 1] = (f32x2){kk.z, kk.w};
        x.b[2 * hh] = (f32x2){bb.x, bb.y}; x.b[2 * hh + 1] = (f32x2){bb.z, bb.w};
        x.w[2 * hh] = (f32x2){w.x, w.y}; x.w[2 * hh + 1] = (f32x2){w.z, w.w};
      }
      x.v = *(const float*)(B + (2 * T + s) * 256 + vrow * 4);
    };
    for (int ci = 0; ci < NCH; ++ci) {
      if (ci + 1 < NCH) { SC_GLOAD(ci + 1); }
      if (ci > 0) FLUSH(ci - 1);
      if (wid < 4) {
        const char* B = smem + (ci & 1) * 49152;
        bf16_t* ob = (bf16_t*)(smem + 98304 + (ci & 1) * 2048);
        Step nx; LOADSTEP(nx, B, 0);
#pragma unroll 2
        for (int s = 0; s < T; ++s) {
          const Step c = nx;
          LOADSTEP(nx, B, (s + 1 < T) ? s + 1 : s);
          f32x2 pa = st0 * c.kk[0] + st1 * c.kk[1];
          f32x2 pb = st2 * c.kk[2] + st3 * c.kk[3];
          pa = pa + pb;
          float sa = -(pa.x + pa.y);
          sa = sum8(sa);
          const f32x2 sa2 = {sa, sa}; const f32x2 v2 = {c.v, c.v};
          st0 = st0 * c.w[0] + sa2 * c.b[0] + v2 * c.k[0];
          st1 = st1 * c.w[1] + sa2 * c.b[1] + v2 * c.k[1];
          st2 = st2 * c.w[2] + sa2 * c.b[2] + v2 * c.k[2];
          st3 = st3 * c.w[3] + sa2 * c.b[3] + v2 * c.k[3];
          f32x2 oa = st0 * c.r[0] + st1 * c.r[1];
          f32x2 ob2 = st2 * c.r[2] + st3 * c.r[3];
          oa = oa + ob2;
          float o = sum8(oa.x + oa.y);
          if (ks == 0) ob[s * 32 + lrow] = (bf16_t)f2bf(o);
        }
      }
      if (ci + 1 < NCH) { SC_SSTORE((ci + 1) & 1); }
      __syncthreads();
    }
    FLUSH(NCH - 1);
  }
}

template <bool DIFF>
DI void attn_unit(const Params& p, int l, int b, int h, int qrow0, int qpos0, int kb_lo, int kb_hi, int kc_lo, char* smem) {
  const int tid = my_tid(), lane = tid & 63, wid = tid >> 6, g = lane >> 4, r16 = lane & 15;
  const bf16_t* QK = (const bf16_t*)(p.ws + (DIFF ? R_PDF : R_PSW));
  const int ldq = DIFF ? 512 : 384;
  const int qc0 = h * 64;
  const int kc0 = 256 + (DIFF ? h * 64 : (h >> 1) * 64);
  const bf16_t* VT = DIFF ? (const bf16_t*)(p.ws + R_VTDF) + ((size_t)b * 256 + h * 64) * KEYS
                          : (const bf16_t*)(p.ws + R_VTSW) + ((size_t)b * 128 + (h >> 1) * 64) * KEYS;
  const int nblk = (kb_hi - kb_lo) + (68 - kc_lo);
  const float sc = (DIFF ? 0.17677669529663687f : 0.125f) * 1.4426950408889634f;
  bf16x8 qf[2];
  {
    const bf16_t* qp = QK + (size_t)(qrow0 + wid * 16 + r16) * ldq + qc0 + g * 8;
    qf[0] = *(const bf16x8*)(qp); qf[1] = *(const bf16x8*)(qp + 32);
  }
  constexpr int NC = DIFF ? 2 : 1;
  float m[NC], lsum[NC];
  f32x4 O[NC][4];
#pragma unroll
  for (int c = 0; c < NC; ++c) {
    if (DIFF) { m[c] = -1e30f; lsum[c] = 0.f; }
    else { m[c] = p.in[16][l * 4 + h] * 1.4426950408889634f; lsum[c] = (g == 0) ? 1.f : 0.f; }
#pragma unroll
    for (int dt = 0; dt < 4; ++dt) O[c][dt] = (f32x4){0.f, 0.f, 0.f, 0.f};
  }
  const int lr = tid >> 3, lc = tid & 7;
  uint4 rkA, rvA, rkB, rvB;
  rkA = make_uint4(0, 0, 0, 0); rvA = rkA; rkB = rkA; rvB = rkA;
  auto AT_GLOAD = [&](int i, uint4& rk, uint4& rv) {
    int kb = i < (kb_hi - kb_lo) ? kb_lo + i : kc_lo + (i - (kb_hi - kb_lo));
    long krow = kb < 64 ? (long)b * SL + kb * 64 + lr : (long)ML + b * CL + (kb - 64) * 64 + lr;
    rk = *(const uint4*)(QK + krow * ldq + kc0 + lc * 8);
    rv = *(const uint4*)(VT + (size_t)lr * KEYS + kb * 64 + lc * 8);
  };
  auto AT_SSTORE = [&](int buf, const uint4& rk, const uint4& rv) {
    *(uint4*)(smem + buf * 18432 + lr * 128 + ((lc ^ (lr & 7)) << 4)) = rk;
    *(uint4*)(smem + buf * 18432 + 9216 + lr * 144 + lc * 16) = rv;
  };
  __syncthreads();
  AT_GLOAD(0, rkA, rvA);
  AT_SSTORE(0, rkA, rvA);
  if (1 < nblk) AT_GLOAD(1, rkA, rvA);
  if (2 < nblk) AT_GLOAD(2, rkB, rvB);
  lds_barrier();
  const int qpos = qpos0 + wid * 16 + r16;
  for (int i = 0; i < nblk; ++i) {
    const int kb = i < (kb_hi - kb_lo) ? kb_lo + i : kc_lo + (i - (kb_hi - kb_lo));
    const bool masked = (!DIFF) && (kb < 64);
    const char* Kt = smem + (i & 1) * 18432; const char* Vt = Kt + 9216;
    f32x4 S[NC][4];
#pragma unroll
    for (int kt = 0; kt < 4; ++kt) {
      bf16x8 k0 = *(const bf16x8*)(Kt + (kt * 16 + r16) * 128 + ((g ^ (r16 & 7)) << 4));
      bf16x8 k1 = *(const bf16x8*)(Kt + (kt * 16 + r16) * 128 + (((4 + g) ^ (r16 & 7)) << 4));
      if (DIFF) {
        S[0][kt] = __builtin_amdgcn_mfma_f32_16x16x32_bf16(k0, qf[0], (f32x4){0.f, 0.f, 0.f, 0.f}, 0, 0, 0);
        S[NC - 1][kt] = __builtin_amdgcn_mfma_f32_16x16x32_bf16(k1, qf[1], (f32x4){0.f, 0.f, 0.f, 0.f}, 0, 0, 0);
      } else {
        f32x4 t = __builtin_amdgcn_mfma_f32_16x16x32_bf16(k0, qf[0], (f32x4){0.f, 0.f, 0.f, 0.f}, 0, 0, 0);
        S[0][kt] = __builtin_amdgcn_mfma_f32_16x16x32_bf16(k1, qf[1], t, 0, 0, 0);
      }
    }
    bf16x8 pf[NC][2];
#pragma unroll
    for (int c = 0; c < NC; ++c) {
      float mx = -1e30f;
#pragma unroll
      for (int kt = 0; kt < 4; ++kt)
#pragma unroll
        for (int j = 0; j < 4; ++j) {
          float v = S[c][kt][j];
          if (masked) { int kpos = kb * 64 + kt * 16 + g * 4 + j; int dd = kpos - qpos; if (dd > 128 || dd < -128) v = -3e38f; S[c][kt][j] = v; }
          mx = fmaxf(mx, v);
        }
      mx *= sc;
      mx = fmaxf(mx, __shfl_xor(mx, 16)); mx = fmaxf(mx, __shfl_xor(mx, 32));
      const float mn = fmaxf(m[c], mx);
      const bool grow = mn > m[c];
      float ps = 0.f;
      unsigned pk[8];
#pragma unroll
      for (int kt = 0; kt < 4; ++kt) {
        float e0 = __builtin_amdgcn_exp2f(fmaf(S[c][kt][0], sc, -mn)), e1 = __builtin_amdgcn_exp2f(fmaf(S[c][kt][1], sc, -mn));
        float e2 = __builtin_amdgcn_exp2f(fmaf(S[c][kt][2], sc, -mn)), e3 = __builtin_amdgcn_exp2f(fmaf(S[c][kt][3], sc, -mn));
        ps += (e0 + e1) + (e2 + e3);
        pk[kt * 2] = pack2(e0, e1); pk[kt * 2 + 1] = pack2(e2, e3);
      }
      if (__builtin_amdgcn_ballot_w64(grow) != 0ull) {
        const float alpha = __builtin_amdgcn_exp2f(m[c] - mn);
        m[c] = mn;
        lsum[c] *= alpha;
#pragma unroll
        for (int dt = 0; dt < 4; ++dt) { O[c][dt][0] *= alpha; O[c][dt][1] *= alpha; O[c][dt][2] *= alpha; O[c][dt][3] *= alpha; }
      }
      lsum[c] += ps;
      union { unsigned u[4]; bf16x8 v; } cv;
      cv.u[0] = pk[0]; cv.u[1] = pk[1]; cv.u[2] = pk[2]; cv.u[3] = pk[3]; pf[c][0] = cv.v;
      cv.u[0] = pk[4]; cv.u[1] = pk[5]; cv.u[2] = pk[6]; cv.u[3] = pk[7]; pf[c][1] = cv.v;
    }
#pragma unroll
    for (int dt = 0; dt < 4; ++dt)
#pragma unroll
      for (int s2 = 0; s2 < 2; ++s2) {
        union { uint2 u[2]; bf16x8 v; } vf;
        vf.u[0] = *(const uint2*)(Vt + (dt * 16 + r16) * 144 + (2 * s2) * 32 + g * 8);
        vf.u[1] = *(const uint2*)(Vt + (dt * 16 + r16) * 144 + (2 * s2 + 1) * 32 + g * 8);
#pragma unroll
        for (int c = 0; c < NC; ++c) O[c][dt] = __builtin_amdgcn_mfma_f32_16x16x32_bf16(vf.v, pf[c][s2], O[c][dt], 0, 0, 0);
      }
    if (i + 1 < nblk) AT_SSTORE((i + 1) & 1, rkA, rvA);
    rkA = rkB; rvA = rvB;
    if (i + 3 < nblk) AT_GLOAD(i + 3, rkB, rvB);
    lds_barrier();
  }
  float linv[NC];
#pragma unroll
  for (int c = 0; c < NC; ++c) { float t = lsum[c]; t += __shfl_xor(t, 16); t += __shfl_xor(t, 32); linv[c] = 1.f / t; }
  const size_t orow = (size_t)(qrow0 + wid * 16 + r16);
  if (!DIFF) {
    bf16_t* Y = (bf16_t*)(p.ws + R_YSW);
#pragma unroll
    for (int dt = 0; dt < 4; ++dt) {
      uint2 o; o.x = pack2(O[0][dt][0] * linv[0], O[0][dt][1] * linv[0]); o.y = pack2(O[0][dt][2] * linv[0], O[0][dt][3] * linv[0]);
      *(uint2*)(Y + orow * 256 + h * 64 + dt * 16 + g * 4) = o;
    }
  } else {
    const float lam_init = 0.8f - 0.6f * __expf(-0.3f * (float)l);
    float d1 = 0.f, d2 = 0.f;
    if (lane < 32) { d1 = p.in[28][l * 32 + lane] * p.in[29][l * 32 + lane]; d2 = p.in[30][l * 32 + lane] * p.in[31][l * 32 + lane]; }
    d1 = wave_sum(d1); d2 = wave_sum(d2);
    const float lam = expf(d1) - expf(d2) + lam_init;
    float ov[4][4]; float ss = 0.f;
#pragma unroll
    for (int dt = 0; dt < 4; ++dt)
#pragma unroll
      for (int j = 0; j < 4; ++j) { float v = O[0][dt][j] * linv[0] - lam * O[NC - 1][dt][j] * linv[NC - 1]; ov[dt][j] = v; ss += v * v; }
    ss += __shfl_xor(ss, 16); ss += __shfl_xor(ss, 32);
    const float rms = rsqrtf(ss * (1.f / 64.f) + 1e-5f) * (1.f - lam_init);
    const float* sg = p.in[32] + l * 64;
    bf16_t* Y = (bf16_t*)(p.ws + R_YDF);
#pragma unroll
    for (int dt = 0; dt < 4; ++dt) {
      const int d0 = dt * 16 + g * 4;
      uint2 o; o.x = pack2(ov[dt][0] * rms * sg[d0], ov[dt][1] * rms * sg[d0 + 1]); o.y = pack2(ov[dt][2] * rms * sg[d0 + 2], ov[dt][3] * rms * sg[d0 + 3]);
      *(uint2*)(Y + orow * 256 + h * 64 + d0) = o;
    }
  }
}

DI void ph_attn(const Params& p, int l, char* smem) {
  const bool need_ctx = (l == 0);
  const int n_sw = 1024 + (need_ctx ? 64 : 0);
  const int n_df = 1024 + (need_ctx ? 64 : 0);
  unsigned* ctr = (unsigned*)(p.ws + MISC_BAR + 64 + 64 * l);
  volatile int* slot = (volatile int*)(smem + 40960);
  for (;;) {
    __syncthreads();
    if (my_tid() == 0) *slot = (int)__hip_atomic_fetch_add(ctr, 1u, __ATOMIC_RELAXED, __HIP_MEMORY_SCOPE_AGENT);
    __syncthreads();
    const int u = *slot;
    if (u >= n_sw + n_df) break;
    if (u < n_df) {
      if (u < 1024) { int b = u >> 7, h = (u >> 5) & 3, n = u & 31; attn_unit<true>(p, l, b, h, b * SL + n * 128, n * 128, 0, 64, 64, smem); }
      else { int v = u - 1024; int b = v >> 3, h = (v >> 1) & 3, n = v & 1; attn_unit<true>(p, l, b, h, ML + b * CL + n * 128, 0, 0, 0, 64, smem); }
    } else {
      int w = u - n_df;
      if (w < 1024) {
        int b = w >> 7, h = (w >> 5) & 3, n = w & 31;
        int lo = (n - 1) * 2; if (lo < 0) lo = 0; int hi = (n + 2) * 2; if (hi > 64) hi = 64;
        attn_unit<false>(p, l, b, h, b * SL + n * 128, n * 128, lo, hi, 64, smem);
      } else { int v = w - 1024; int b = v >> 3, h = (v >> 1) & 3, n = v & 1; attn_unit<false>(p, l, b, h, ML + b * CL + n * 128, 0, 0, 0, 64, smem); }
    }
  }
}

DI void ph_rwout(const Params& p, int l) {
  const int lane = my_tid() & 63, wid = my_tid() >> 6;
  const bf16_t* S = (const bf16_t*)(p.ws + R_STR); const bf16_t* Gs = (const bf16_t*)(p.ws + R_G);
  const bf16_t* OF = (const bf16_t*)(p.ws + R_OF); const bf16_t* OB = (const bf16_t*)(p.ws + R_OB);
  bf16_t* Y = (bf16_t*)(p.ws + R_YRW);
  const size_t SU = (size_t)MT * 256;
  const float4 rk = *(const float4*)(p.in[25] + (size_t)l * 256 + lane * 4);
  const float4 gam = *(const float4*)(p.in[26] + (size_t)l * 256 + lane * 4);
  const float4 bet = *(const float4*)(p.in[27] + (size_t)l * 256 + lane * 4);
  const int nrows = (l == 0) ? MT : ML;
  for (int row = blockIdx.x * 8 + wid; row < nrows; row += gridDim.x * 8) {
    const size_t o = (size_t)row * 256 + lane * 4;
    uint2 ur = *(const uint2*)(S + o), uk = *(const uint2*)(S + SU + o), uv = *(const uint2*)(S + 2 * SU + o);
    uint2 uf = *(const uint2*)(OF + o), ub = *(const uint2*)(OB + o), ugf = *(const uint2*)(Gs + o), ugb = *(const uint2*)(Gs + SU + o);
    float r[4] = {bflo(ur.x), bfhi(ur.x), bflo(ur.y), bfhi(ur.y)};
    float k[4] = {bflo(uk.x), bfhi(uk.x), bflo(uk.y), bfhi(uk.y)};
    float v[4] = {bflo(uv.x), bfhi(uv.x), bflo(uv.y), bfhi(uv.y)};
    float f[4] = {bflo(uf.x), bfhi(uf.x), bflo(uf.y), bfhi(uf.y)};
    float bb[4] = {bflo(ub.x), bfhi(ub.x), bflo(ub.y), bfhi(ub.y)};
    float gf[4] = {bflo(ugf.x), bfhi(ugf.x), bflo(ugf.y), bfhi(ugf.y)};
    float gb[4] = {bflo(ugb.x), bfhi(ugb.x), bflo(ugb.y), bfhi(ugb.y)};
    const float rkv[4] = {rk.x, rk.y, rk.z, rk.w}; const float ga[4] = {gam.x, gam.y, gam.z, gam.w}; const float be[4] = {bet.x, bet.y, bet.z, bet.w};
    float bon = 0.f, sf = 0.f, sb = 0.f;
#pragma unroll
    for (int i = 0; i < 4; ++i) { bon += r[i] * k[i] * rkv[i]; sf += f[i]; sb += bb[i]; }
    bon = sum16(bon); float muf = sum16(sf) * (1.f / 64.f), mub = sum16(sb) * (1.f / 64.f);
    float qf = 0.f, qb = 0.f;
#pragma unroll
    for (int i = 0; i < 4; ++i) { f[i] -= muf; bb[i] -= mub; qf += f[i] * f[i]; qb += bb[i] * bb[i]; }
    float rsf = rsqrtf(sum16(qf) * (1.f / 64.f) + 64e-5f), rsb = rsqrtf(sum16(qb) * (1.f / 64.f) + 64e-5f);
    float y[4];
#pragma unroll
    for (int i = 0; i < 4; ++i) {
      float bn = bon * v[i];
      y[i] = (f[i] * rsf * ga[i] + be[i] + bn) * gf[i] + (bb[i] * rsb * ga[i] + be[i] + bn) * gb[i];
    }
    uint2 oo; oo.x = pack2(y[0], y[1]); oo.y = pack2(y[2], y[3]);
    *(uint2*)(Y + o) = oo;
  }
}

DI void ph_merge(const Params& p, int l, const bf16_t* U, char* smem) {
  const int lane = my_tid() & 63, wid = my_tid() >> 6, wm = wid >> 1, wn = wid & 1, g = lane >> 4, r16 = lane & 15;
  const int mtiles = (l == 0) ? 136 : 128;
  bf16_t* ACC = (bf16_t*)(p.ws + R_ACC);
  for (int it = 0;; ++it) {
    int mtile, ntile;
    if (!next_tile(it, mtiles, 8, mtile, ntile)) break;
    uint2 accS[4][4];
#pragma unroll
    for (int mt = 0; mt < 4; ++mt)
#pragma unroll
      for (int nt = 0; nt < 4; ++nt) accS[mt][nt] = make_uint2(0u, 0u);
    for (int j = 0; j < 4; ++j) {
      uint2 pb[4][4];
      {
        f32x4 accB[4][4]; zero_acc<4>(accB);
        const size_t yoff = (j == 0) ? R_YHY : (j == 1) ? R_YSW : (j == 2) ? R_YRW : R_YDF;
        gemm_glds(accB, (const bf16_t*)(p.ws + yoff), 256, RowPlain{(long)mtile * 256}, (const bf16_t*)(p.ws + WB_BR) + ((size_t)j * 1024 + ntile * 128) * 256, 256, 256, smem, (const bf16_t*)(p.ws + MISC_ZERO));
#pragma unroll
        for (int mt = 0; mt < 4; ++mt)
#pragma unroll
          for (int nt = 0; nt < 4; ++nt) { pb[mt][nt].x = pack2(accB[mt][nt][0], accB[mt][nt][1]); pb[mt][nt].y = pack2(accB[mt][nt][2], accB[mt][nt][3]); }
      }
      f32x4 accG[4][4]; zero_acc<4>(accG);
      gemm_glds(accG, U, 1024, RowPlain{(long)mtile * 256}, (const bf16_t*)(p.ws + WB_GATE) + ((size_t)j * 1024 + ntile * 128) * 1024, 1024, 1024, smem, (const bf16_t*)(p.ws + MISC_ZERO));
#pragma unroll
      for (int mt = 0; mt < 4; ++mt)
#pragma unroll
        for (int nt = 0; nt < 4; ++nt) {
          float v0 = bflo(accS[mt][nt].x) + sigmoidf_(accG[mt][nt][0]) * bflo(pb[mt][nt].x);
          float v1 = bfhi(accS[mt][nt].x) + sigmoidf_(accG[mt][nt][1]) * bfhi(pb[mt][nt].x);
          float v2 = bflo(accS[mt][nt].y) + sigmoidf_(accG[mt][nt][2]) * bflo(pb[mt][nt].y);
          float v3 = bfhi(accS[mt][nt].y) + sigmoidf_(accG[mt][nt][3]) * bfhi(pb[mt][nt].y);
          accS[mt][nt].x = pack2(v0, v1); accS[mt][nt].y = pack2(v2, v3);
        }
    }
#pragma unroll
    for (int mt = 0; mt < 4; ++mt) {
      const int col = ntile * 128 + wn * 64 + r16 * 4;
      const size_t row = (size_t)mtile * 256 + wm * 64 + mt * 16 + g * 4;
      uint2 o;
      o.x = (accS[mt][0].x & 0xffffu) | (accS[mt][1].x << 16); o.y = (accS[mt][2].x & 0xffffu) | (accS[mt][3].x << 16);
      *(uint2*)(ACC + (row + 0) * 1024 + col) = o;
      o.x = (accS[mt][0].x >> 16) | (accS[mt][1].x & 0xffff0000u); o.y = (accS[mt][2].x >> 16) | (accS[mt][3].x & 0xffff0000u);
      *(uint2*)(ACC + (row + 1) * 1024 + col) = o;
      o.x = (accS[mt][0].y & 0xffffu) | (accS[mt][1].y << 16); o.y = (accS[mt][2].y & 0xffffu) | (accS[mt][3].y << 16);
      *(uint2*)(ACC + (row + 2) * 1024 + col) = o;
      o.x = (accS[mt][0].y >> 16) | (accS[mt][1].y & 0xffff0000u); o.y = (accS[mt][2].y >> 16) | (accS[mt][3].y & 0xffff0000u);
      *(uint2*)(ACC + (row + 3) * 1024 + col) = o;
    }
  }
}

DI void ph_resgemm(const Params& p, int l, const bf16_t* A, int K, const bf16_t* Bt, const float* hsrc_lat, const float* hsrc_ctx, int gate_off, char* smem) {
  const int lane = my_tid() & 63, wid = my_tid() >> 6, wm = wid >> 1, wn = wid & 1, g = lane >> 4, r16 = lane & 15;
  const int mtiles = (l == 0) ? 136 : 128;
  const float* mod = (const float*)(p.ws + MISC_MOD) + (size_t)l * 9 * 6144;
  float* hc = (float*)(p.ws + OFF_HC);
  for (int it = 0;; ++it) {
    int mtile, ntile;
    if (!next_tile(it, mtiles, 8, mtile, ntile)) break;
    f32x4 acc[4][4]; zero_acc<4>(acc);
    gemm_glds(acc, A, K, RowPlain{(long)mtile * 256}, Bt + (size_t)ntile * 128 * K, K, K, smem, (const bf16_t*)(p.ws + MISC_ZERO));
    const int b = mtile < 128 ? (mtile >> 4) : 8;
    const float* gt = mod + (size_t)b * 6144 + gate_off;
    const int col = ntile * 128 + wn * 64 + r16 * 4;
    const float4 gv = *(const float4*)(gt + col);
#pragma unroll
    for (int mt = 0; mt < 4; ++mt)
#pragma unroll
      for (int e = 0; e < 4; ++e) {
        const int row = mtile * 256 + wm * 64 + mt * 16 + g * 4 + e;
        const float* hs; float* hd;
        if (row < ML) { size_t o = (size_t)row * D + col; hs = hsrc_lat + o; hd = p.out + o; }
        else { size_t o = (size_t)(row - ML) * D + col; hs = hsrc_ctx + o; hd = hc + o; }
        const float4 h = *(const float4*)hs;
        float4 r;
        r.x = DN_ALPHA * h.x + gv.x * acc[mt][0][e]; r.y = DN_ALPHA * h.y + gv.y * acc[mt][1][e];
        r.z = DN_ALPHA * h.z + gv.z * acc[mt][2][e]; r.w = DN_ALPHA * h.w + gv.w * acc[mt][3][e];
        *(float4*)hd = r;
      }
  }
}

DI void ph_ffnup(const Params& p, int l, char* smem) {
  const bf16_t* U = (const bf16_t*)(p.ws + R_U);
  const bf16_t* Bt = (const bf16_t*)(p.ws + WB_UP);
  bf16_t* HID = (bf16_t*)(p.ws + R_HID);
  const float* cw = p.in[38] + (size_t)l * 3 * 5632; const float* cb = p.in[39] + (size_t)l * 5632;
  const int tid = my_tid(), lane = tid & 63, wid = tid >> 6, wm = wid >> 2, wn = wid & 3, g = lane >> 4, r16 = lane & 15;
  const int mtiles = (l == 0) ? 144 : 136;
  constexpr int TS = 528;
  for (int it = 0;; ++it) {
    int mtile, ntile;
    if (!next_tile(it, mtiles, 22, mtile, ntile)) break;
    long rowbase; int t0, len, r0, r1;
    if (mtile < 136) { int b = mtile / 17; int tt = mtile % 17; len = SL; rowbase = (long)b * SL; t0 = tt * 254 - 1; r0 = 1; r1 = 254; }
    else { int b = mtile - 136; len = CL; rowbase = (long)ML + b * CL; t0 = 0; r0 = 0; r1 = 255; }
    f32x4 acc[8][4]; zero_acc256(acc);
    gemm_glds256(acc, U, 1024, rowbase + t0, Bt + (size_t)ntile * 256 * 1024, 1024, 1024, smem);
#pragma unroll
    for (int mt = 0; mt < 8; ++mt)
#pragma unroll
      for (int e = 0; e < 4; ++e) {
        uint2 o; o.x = pack2(acc[mt][0][e], acc[mt][1][e]); o.y = pack2(acc[mt][2][e], acc[mt][3][e]);
        *(uint2*)(smem + (wm * 128 + mt * 16 + g * 4 + e) * TS + (wn * 64 + r16 * 4) * 2) = o;
      }
    __syncthreads();
    {
      const int ch = tid & 127, rgp = tid >> 7; const int ca = ntile * 128 + ch, cbx = 2816 + ca;
      const float a0 = cw[ca], a1 = cw[5632 + ca], a2 = cw[2 * 5632 + ca], ab = cb[ca];
      const float b0 = cw[cbx], b1 = cw[5632 + cbx], b2 = cw[2 * 5632 + cbx], bb = cb[cbx];
      for (int r = r0 + rgp; r <= r1; r += 4) {
        const int tok = t0 + r;
        if (tok < len) {
          const char* Tr = smem + r * TS + ch * 2;
          const float pa = tok >= 1 ? bf2f(*(const bf16_t*)(Tr - TS)) : 0.f, pb_ = tok >= 1 ? bf2f(*(const bf16_t*)(Tr - TS + 256)) : 0.f;
          const float na = tok + 1 < len ? bf2f(*(const bf16_t*)(Tr + TS)) : 0.f, nb = tok + 1 < len ? bf2f(*(const bf16_t*)(Tr + TS + 256)) : 0.f;
          const float av = a0 * pa + a1 * bf2f(*(const bf16_t*)(Tr)) + a2 * na + ab;
          const float bv = b0 * pb_ + b1 * bf2f(*(const bf16_t*)(Tr + 256)) + b2 * nb + bb;
          HID[(size_t)(rowbase + tok) * 2816 + ca] = (bf16_t)f2bf(siluf_(av) * bv);
        }
      }
    }
  }
}

#ifndef REP_PREP
#define REP_PREP 1
#endif
#ifndef REP_GEMM
#define REP_GEMM 1
#endif
#ifndef REP_HY
#define REP_HY 1
#endif
#ifndef REP_RWP
#define REP_RWP 1
#endif
#ifndef REP_SCAN
#define REP_SCAN 1
#endif
#ifndef REP_ATTN
#define REP_ATTN 1
#endif
#ifndef PH_END
#define PH_END 24
#endif
#define XB_TMO      128
#define XB_XCNT(j)  (256  + 64 * (j))
#define XB_XSUB(j)  (1280 + 64 * (j))
#define XB_XGEN(j)  (2304 + 64 * (j))
#define XB_TOP      3328
#define XB_TOPGEN   3392
#define XCD_BAR_WORDS 3456
#define XB_SPIN_CAP (1u << 22)
DI unsigned xb_ld(unsigned* p) { return __hip_atomic_load(p, __ATOMIC_RELAXED, __HIP_MEMORY_SCOPE_AGENT); }
DI unsigned xb_add(unsigned* p, unsigned v) { return __hip_atomic_fetch_add(p, v, __ATOMIC_RELAXED, __HIP_MEMORY_SCOPE_AGENT); }
DI unsigned xb_xcc_id() { return (unsigned)__builtin_amdgcn_s_getreg((3 << 11) | 20) & 0xFu; }
#define XB_SPIN(cond, bar) do { unsigned _sp = 0; while (cond) { __builtin_amdgcn_s_sleep(1); \
    if ((++_sp & 255u) == 0u) { if (xb_ld(&(bar)[XB_TMO])) break; if (_sp > XB_SPIN_CAP) { atomicAdd(&(bar)[XB_TMO], 1u); break; } } } } while (0)
DI void xcd_barrier_complete(unsigned* bar, unsigned x, unsigned& nloc, unsigned& nx) {
  const unsigned G = gridDim.x;
  unsigned sum, cnt, mine, sp = 0u;
  for (;;) {
    sum = 0u; cnt = 0u; mine = 0u;
#pragma unroll
    for (unsigned j = 0; j < 16; ++j) { const unsigned c = xb_ld(&bar[XB_XCNT(j)]); sum += c; cnt += (c > 0u) ? 1u : 0u; mine = (j == x) ? c : mine; }
    if (sum == G) break;
    __builtin_amdgcn_s_sleep(1);
    if ((++sp & 255u) == 0u) { if (xb_ld(&bar[XB_TMO])) break; if (sp > XB_SPIN_CAP) { atomicAdd(&bar[XB_TMO], 1u); break; } }
  }
  nloc = mine > 0u ? mine : 1u; nx = cnt > 0u ? cnt : 1u;
}
DI void grid_barrier(unsigned* bar, volatile unsigned* st) {
  asm volatile("s_waitcnt vmcnt(0)" ::: "memory");
  __syncthreads();
  if (my_tid() == 0) {
    const unsigned x = xb_xcc_id();
    __builtin_amdgcn_s_waitcnt(0);
    unsigned nloc = st[0], nx = st[1];
    if (nloc == 0u) { xcd_barrier_complete(bar, x, nloc, nx); st[0] = nloc; st[1] = nx; }
    const unsigned old = xb_add(&bar[XB_XSUB(x)], 1u);
    const unsigned gen = old / nloc;
    if (old + 1u == (gen + 1u) * nloc) {
      __builtin_amdgcn_fence(__ATOMIC_RELEASE, "agent");
      asm volatile("s_waitcnt vmcnt(0)" ::: "memory");
      const unsigned og = xb_add(&bar[XB_TOP], 1u);
      const unsigned tg = og / nx;
      if (og + 1u == (tg + 1u) * nx) xb_add(&bar[XB_TOPGEN], 1u);
      else XB_SPIN(xb_ld(&bar[XB_TOPGEN]) == tg, bar);
      __builtin_amdgcn_fence(__ATOMIC_ACQUIRE, "agent");
      xb_add(&bar[XB_XGEN(x)], 1u);
      asm volatile("s_waitcnt vmcnt(0)" ::: "memory");
    } else {
      XB_SPIN(xb_ld(&bar[XB_XGEN(x)]) == gen, bar);
      __builtin_amdgcn_fence(__ATOMIC_ACQUIRE, "agent");
      asm volatile("s_waitcnt vmcnt(0)" ::: "memory");
    }
  }
  __syncthreads();
}
#define SYNC_OR_RET(idx) do { if ((idx) + 1 >= PH_END) return; if ((idx) == 0) { grid.sync(); if (my_tid() == 0) (void)xb_add(&((unsigned*)(p.ws + MISC_XBAR))[XB_XCNT(xb_xcc_id())], 1u); } else grid_barrier((unsigned*)(p.ws + MISC_XBAR), (volatile unsigned*)(smem + 144 * 1024)); } while (0)
template <int l>
DI void run_layer(const Params& p, cg::grid_group& grid, char* smem, unsigned& epoch) {
  const float* mod = (const float*)(p.ws + MISC_MOD) + (size_t)l * 9 * 6144;
  float* hc = (float*)(p.ws + OFF_HC);
  const float* hl_src = (l == 0) ? p.in[0] : p.out;
  const float* hc_src = (l == 0) ? p.in[2] : hc;
  constexpr int B0 = l * 12;
  if (l == 0) {
    ph_convert(p, 0, smem);
    ph_ada(p, smem);
    hy_rawfilter(p, 0, SL, (float*)(p.ws + R_RAWF), smem);
    hy_rawfilter(p, 0, CL, (float*)(p.ws + MISC_RAWC), smem);
    SYNC_OR_RET(B0 + 0);
    ph_kf(p, 0, smem);
    ph_ln(hl_src, hc_src, nullptr, nullptr, nullptr, nullptr, (bf16_t*)p.out, mod, 0, MT);
    SYNC_OR_RET(B0 + 1);
  }
  for (int rep = 0; rep < REP_GEMM; ++rep) ph_inproj(p, l == 0 ? (const bf16_t*)p.out : (const bf16_t*)(p.ws + R_U), smem);
  SYNC_OR_RET(B0 + 2);
  for (int rep = 0; rep < REP_HY; ++rep) {
  if (blockIdx.x == 0 && my_tid() == 0) *(unsigned*)(p.ws + MISC_BAR + 64 + 64 * l) = 0u;
  ph_hyena(p, l, smem);
  if (l == 0) ph_hyena_ctx(p, l, smem);
  }
  ph_rope(p, smem);
  for (int rep = 0; rep < REP_RWP; ++rep) ph_rwprep(p, l, smem);
  SYNC_OR_RET(B0 + 3);
  for (int rep = 0; rep < REP_SCAN; ++rep) ph_scan(p, smem);
  for (int rep = 0; rep < REP_ATTN; ++rep) ph_attn(p, l, smem);
  SYNC_OR_RET(B0 + 4);
  ph_rwout(p, l);
  if (l != 0) ph_ln(hl_src, hc_src, nullptr, nullptr, nullptr, nullptr, (bf16_t*)(p.ws + R_URE), mod, 0, ML);
  SYNC_OR_RET(B0 + 5);
  for (int rep = 0; rep < REP_GEMM; ++rep) ph_merge(p, l, l == 0 ? (const bf16_t*)p.out : (const bf16_t*)(p.ws + R_URE), smem);
  SYNC_OR_RET(B0 + 6);
  ph_resgemm(p, l, (const bf16_t*)(p.ws + R_ACC), 1024, (const bf16_t*)(p.ws + WB_OUT), hl_src, hc_src, 2048, smem);
  if (l == 0) hy_rawfilter(p, 1, SL, (float*)(p.ws + R_RAWF), smem);
  SYNC_OR_RET(B0 + 7);
  ph_ln(p.out, hc, p.out, hc, p.in[35] + (size_t)l * D, p.in[36] + (size_t)l * D, (bf16_t*)(p.ws + R_U), mod, 3072, l == 0 ? MT : ML);
  if (l == 0) ph_kf(p, 1, smem);
  SYNC_OR_RET(B0 + 8);
  for (int rep = 0; rep < REP_GEMM; ++rep) ph_ffnup(p, l, smem);
  SYNC_OR_RET(B0 + 9);
  ph_resgemm(p, l, (const bf16_t*)(p.ws + R_HID), 2816, (const bf16_t*)(p.ws + WB_DOWN), p.out, hc, 5120, smem);
  SYNC_OR_RET(B0 + 10);
  if (l == 0) {
    ph_ln(p.out, hc, p.out, hc, p.in[41], p.in[42], (bf16_t*)(p.ws + R_U), mod + 9 * 6144, 0, MT);
    ph_convert(p, 1, smem);
  } else {
    ph_ln(p.out, hc, p.out, hc, p.in[41] + (size_t)l * D, p.in[42] + (size_t)l * D, nullptr, mod, 0, ML);
  }
  SYNC_OR_RET(B0 + 11);
}

__global__ void __launch_bounds__(NTHR) mega(Params p) {
  extern __shared__ __attribute__((aligned(16))) char smem[];
  cg::grid_group grid = cg::this_grid();
  unsigned epoch = 0;
  if (blockIdx.x == 0) for (int i = my_tid(); i < XCD_BAR_WORDS; i += NTHR) ((unsigned*)(p.ws + MISC_XBAR))[i] = 0u;
  if (my_tid() < 2) ((volatile unsigned*)(smem + 144 * 1024))[my_tid()] = 0u;
  if (blockIdx.x == 0 && my_tid() < 64) *(unsigned*)(p.ws + MISC_ZERO + my_tid() * 4) = 0u;
  run_layer<0>(p, grid, smem, epoch);
  if (PH_END > 12) run_layer<1>(p, grid, smem, epoch);
}

extern "C" void kernel_launch(void* const* d_in, const int* in_sizes, int n_in, void* d_out, int out_size,
                              void* d_ws, size_t ws_size, hipStream_t stream) {
  static int grid_blocks = 0;
  if (!grid_blocks) {
    int dev = 0, cus = 0, per_cu = 0;
    (void)hipGetDevice(&dev);
    (void)hipDeviceGetAttribute(&cus, hipDeviceAttributeMultiprocessorCount, dev);
    (void)hipFuncSetAttribute((const void*)mega, hipFuncAttributeMaxDynamicSharedMemorySize, SMEM_BYTES);
    (void)hipOccupancyMaxActiveBlocksPerMultiprocessor(&per_cu, mega, NTHR, SMEM_BYTES);
    if (per_cu < 1) per_cu = 1;
    if (per_cu > 1) per_cu = 1;
    grid_blocks = cus * per_cu;
  }
  Params p{};
  for (int i = 0; i < 43; ++i) p.in[i] = (const float*)d_in[i];
  p.out = (float*)d_out; p.ws = (char*)d_ws;
  void* args[] = {&p};
  hipError_t e = hipLaunchCooperativeKernel((void*)mega, dim3(grid_blocks), dim3(NTHR), args, SMEM_BYTES, stream);
  if (e != hipSuccess) fprintf(stderr, "cooperative launch failed: %s (grid %d)\n", hipGetErrorString(e), grid_blocks);
}
```

```cpp
#include <hip/hip_runtime.h>
#include <hip/hip_cooperative_groups.h>
#include <cstdio>
#include <cstdint>
namespace cg = cooperative_groups;

#define DI __device__ __forceinline__
typedef unsigned short bf16_t;
typedef short bf16x8 __attribute__((ext_vector_type(8)));
typedef float f32x4 __attribute__((ext_vector_type(4)));

constexpr int D = 1024, NB = 8, SL = 4096, CL = 256;
constexpr int ML = NB * SL, MC = NB * CL, MT = ML + MC;
constexpr int KEYS = SL + CL;
constexpr int NTHR = 512;
constexpr float DN_ALPHA = 1.41421356237f;
constexpr size_t UNIT = (size_t)MT * 512;

constexpr size_t WB_IN = 0;
constexpr size_t WB_GATE = WB_IN + (size_t)3328 * 1024 * 2;
constexpr size_t WB_BR = WB_GATE + (size_t)4096 * 1024 * 2;
constexpr size_t WB_OUT = WB_BR + (size_t)4 * 1024 * 256 * 2;
constexpr size_t WB_UP = WB_OUT + (size_t)1024 * 1024 * 2;
constexpr size_t WB_DOWN = WB_UP + (size_t)5632 * 1024 * 2;
constexpr size_t WB_END = WB_DOWN + (size_t)1024 * 2816 * 2;
constexpr size_t OFF_KF = WB_END;
constexpr size_t OFF_HC = OFF_KF + (size_t)512 * 8192 * 8;
constexpr size_t OFF_MISC = OFF_HC + (size_t)MC * D * 4;
constexpr size_t MISC_MOD = OFF_MISC;
constexpr size_t MISC_TW = MISC_MOD + (size_t)2 * 9 * 6144 * 4;
constexpr size_t MISC_RAWC = MISC_TW + 4096 * 8;
constexpr size_t MISC_GCTX = MISC_RAWC + (size_t)256 * 1024 * 4;
constexpr size_t MISC_RWW = MISC_GCTX + (size_t)512 * 512 * 4;
constexpr size_t RWW_F = MISC_RWW, RWW_B = RWW_F + 256 * 64 * 2, RWW_A = RWW_B + 256 * 64 * 2, RWW_GF = RWW_A + 256 * 64 * 2, RWW_GB = RWW_GF + 256 * 128 * 2;
constexpr size_t MISC_XBAR = OFF_MISC + (size_t)3 * 1024 * 1024;
constexpr size_t OFF_R = OFF_MISC + (size_t)4 * 1024 * 1024;
constexpr size_t MISC_BAR = OFF_R - 256;
constexpr size_t MISC_ZERO = OFF_R - 512;
static_assert(RWW_GB + 256 * 128 * 2 <= MISC_ZERO, "misc overflow");
constexpr size_t R_YHY = OFF_R, R_YSW = OFF_R + UNIT, R_YDF = OFF_R + 2 * UNIT;
constexpr size_t R_PHY = OFF_R + 3 * UNIT;
constexpr size_t R_PSW = OFF_R + 6 * UNIT;
constexpr size_t R_VTSW = R_PSW + (size_t)MT * 384 * 2;
constexpr size_t R_PDF = OFF_R + 8 * UNIT;
constexpr size_t R_VTDF = OFF_R + 10 * UNIT;
constexpr size_t R_PRW = OFF_R + 11 * UNIT;
constexpr size_t R_STR = R_PRW + (size_t)MT * 1216 * 2;
constexpr size_t R_G = R_STR + 7 * UNIT;
constexpr size_t R_END = R_G + 2 * UNIT;
constexpr size_t R_RAWF = OFF_R;
constexpr size_t R_OF = R_PHY, R_OB = R_PHY + UNIT;
constexpr size_t R_URE = R_PSW;
constexpr size_t R_YRW = R_VTDF;
constexpr size_t R_ACC = R_PRW;
constexpr size_t R_U = R_STR;
constexpr size_t R_HID = OFF_R;
static_assert(R_END <= (size_t)512 * 1024 * 1024, "ws overflow");
static_assert((size_t)MT * 2816 * 2 <= 11 * UNIT, "hid");

constexpr int SMEM_BYTES = 144 * 1024 + 64;

struct Params {
  const float* in[43];
  float* out;
  char* ws;
};

DI int my_tid() { int t = (int)__builtin_amdgcn_workitem_id_x(); asm volatile("" : "+v"(t)); return t; }
DI unsigned f2bf(float f) { unsigned u = __float_as_uint(f); u += 0x7fffu + ((u >> 16) & 1u); return u >> 16; }
DI float bf2f(unsigned h) { return __uint_as_float(h << 16); }
typedef __bf16 bf16v2_t __attribute__((ext_vector_type(2)));
typedef float f32v2_t __attribute__((ext_vector_type(2)));
DI unsigned pack2(float lo, float hi) { f32v2_t v = {lo, hi}; bf16v2_t b = __builtin_convertvector(v, bf16v2_t); return __builtin_bit_cast(unsigned, b); }

DI float bflo(unsigned w) { return __uint_as_float(w << 16); }
DI float bfhi(unsigned w) { return __uint_as_float(w & 0xffff0000u); }
DI float sigmoidf_(float x) { return 1.f / (1.f + __expf(-x)); }
DI float siluf_(float x) { return x / (1.f + __expf(-x)); }
DI float wave_sum(float v) {
#pragma unroll
  for (int o = 32; o >= 1; o >>= 1) v += __shfl_xor(v, o);
  return v;
}
template <int CTRL> DI float dpp_mov(float v) {
  return __int_as_float(__builtin_amdgcn_update_dpp(0, __float_as_int(v), CTRL, 0xf, 0xf, false));
}
DI float sum16(float v) {
  v += dpp_mov<0xB1>(v);
  v += dpp_mov<0x4E>(v);
  v += dpp_mov<0x141>(v);
  v += dpp_mov<0x140>(v);
  return v;
}
DI void lds_barrier() { asm volatile("s_waitcnt lgkmcnt(0)" ::: "memory"); __builtin_amdgcn_s_barrier(); asm volatile("" ::: "memory"); }
DI uint4 sel4(bool z, uint4 v) { return make_uint4(z ? 0u : v.x, z ? 0u : v.y, z ? 0u : v.z, z ? 0u : v.w); }
DI int mod_idx(int row) { return row < ML ? (row >> 12) : 8; }

template <int NTW, bool DEEP, class RowFn>
DI void gemm_main(f32x4 (&acc)[4][NTW], const bf16_t* __restrict__ A, int lda, RowFn rowfn,
                  const bf16_t* __restrict__ Bt, int ldb, int K, char* smem) {
  constexpr int BN = NTW * 32;
  constexpr int A_BYTES = 256 * 128, B_BYTES = BN * 128, STAGE = A_BYTES + B_BYTES;
  constexpr int NBL = BN / 64;
  const int tid = my_tid(), lane = tid & 63, wid = tid >> 6, wm = wid >> 1, wn = wid & 1, g = lane >> 4, r16 = lane & 15;
  const int chunk = tid & 7, lrow = tid >> 3;
  long a0 = rowfn(lrow), a1 = rowfn(lrow + 64), a2 = rowfn(lrow + 128), a3 = rowfn(lrow + 192);
  const long c0 = a0 < 0 ? 0 : a0, c1 = a1 < 0 ? 0 : a1, c2 = a2 < 0 ? 0 : a2, c3 = a3 < 0 ? 0 : a3;
  const bf16_t* Bp = Bt + (long)lrow * ldb + chunk * 8;
  const bf16_t* Ap0 = A + c0 * lda + chunk * 8; const bf16_t* Ap1 = A + c1 * lda + chunk * 8;
  const bf16_t* Ap2 = A + c2 * lda + chunk * 8; const bf16_t* Ap3 = A + c3 * lda + chunk * 8;
  struct Regs { uint4 a0, a1, a2, a3, b0, b1; };
  Regs R0, R1;
  R0.b1 = make_uint4(0, 0, 0, 0); R1.b1 = make_uint4(0, 0, 0, 0);
  auto GLOAD = [&](Regs& R, int k0) {
    R.a0 = *(const uint4*)(Ap0 + k0); R.a1 = *(const uint4*)(Ap1 + k0);
    R.a2 = *(const uint4*)(Ap2 + k0); R.a3 = *(const uint4*)(Ap3 + k0);
    R.b0 = *(const uint4*)(Bp + k0);
    if constexpr (NBL > 1) R.b1 = *(const uint4*)(Bp + (long)64 * ldb + k0);
  };
  auto SSTORE = [&](const Regs& R, int st) {
    char* base = smem + st * STAGE + lrow * 128 + ((chunk ^ (lrow & 7)) << 4);
    *(uint4*)(base) = sel4(a0 < 0, R.a0); *(uint4*)(base + 64 * 128) = sel4(a1 < 0, R.a1);
    *(uint4*)(base + 128 * 128) = sel4(a2 < 0, R.a2); *(uint4*)(base + 192 * 128) = sel4(a3 < 0, R.a3);
    *(uint4*)(base + A_BYTES) = R.b0;
    if constexpr (NBL > 1) *(uint4*)(base + A_BYTES + 64 * 128) = R.b1;
  };
  auto COMPUTE = [&](int st) {
    const char* As = smem + st * STAGE + (wm * 64 + r16) * 128;
    const char* Bs = smem + st * STAGE + A_BYTES + (wn * (NTW * 16) + r16) * 128;
#pragma unroll
    for (int kk = 0; kk < 2; ++kk) {
      const int sw = ((kk * 4 + g) ^ (r16 & 7)) << 4;
      bf16x8 af[4], bfr[NTW];
#pragma unroll
      for (int mt = 0; mt < 4; ++mt) af[mt] = *(const bf16x8*)(As + mt * 16 * 128 + sw);
#pragma unroll
      for (int nt = 0; nt < NTW; ++nt) bfr[nt] = *(const bf16x8*)(Bs + nt * 16 * 128 + sw);
#pragma unroll
      for (int mt = 0; mt < 4; ++mt)
#pragma unroll
        for (int nt = 0; nt < NTW; ++nt)
          acc[mt][nt] = __builtin_amdgcn_mfma_f32_16x16x32_bf16(af[mt], bfr[nt], acc[mt][nt], 0, 0, 0);
    }
  };
  const int nk = K >> 6;
  __syncthreads();
  GLOAD(R0, 0);
  SSTORE(R0, 0);
  if constexpr (DEEP) {
    GLOAD(R0, 64);
    if (nk > 2) GLOAD(R1, 128);
    lds_barrier();
    bf16x8 fa0[4], fb0[NTW], fa1[4], fb1[NTW];
    auto READF = [&](bf16x8 (&fa)[4], bf16x8 (&fb)[NTW], int st, int kk) {
      const int sw = ((kk * 4 + g) ^ (r16 & 7)) << 4;
      const char* As = smem + st * STAGE + (wm * 64 + r16) * 128 + sw;
      const char* Bs = smem + st * STAGE + A_BYTES + (wn * (NTW * 16) + r16) * 128 + sw;
#pragma unroll
      for (int mt = 0; mt < 4; ++mt) fa[mt] = *(const bf16x8*)(As + mt * 16 * 128);
#pragma unroll
      for (int nt = 0; nt < NTW; ++nt) fb[nt] = *(const bf16x8*)(Bs + nt * 16 * 128);
    };
    auto MMA = [&](const bf16x8 (&fa)[4], const bf16x8 (&fb)[NTW]) {
#pragma unroll
      for (int mt = 0; mt < 4; ++mt)
#pragma unroll
        for (int nt = 0; nt < NTW; ++nt)
          acc[mt][nt] = __builtin_amdgcn_mfma_f32_16x16x32_bf16(fa[mt], fb[nt], acc[mt][nt], 0, 0, 0);
    };
    READF(fa0, fb0, 0, 0);
    for (int kt = 0; kt < nk; kt += 2) {
      READF(fa1, fb1, 0, 1);
      MMA(fa0, fb0);
#pragma unroll
      for (int i = 0; i < 4 + NTW; ++i) { __builtin_amdgcn_sched_group_barrier(0x100, 1, 0); __builtin_amdgcn_sched_group_barrier(0x008, 2, 0); }
      __builtin_amdgcn_sched_barrier(0);
      SSTORE(R0, 1);
      if (kt + 3 < nk) GLOAD(R0, (kt + 3) * 64);
      MMA(fa1, fb1);
#pragma unroll
      for (int i = 0; i < 6; ++i) { __builtin_amdgcn_sched_group_barrier(0x200, 1, 0); __builtin_amdgcn_sched_group_barrier(0x020, 1, 0); __builtin_amdgcn_sched_group_barrier(0x008, 2, 0); }
      __builtin_amdgcn_sched_barrier(0);
      lds_barrier();
      READF(fa0, fb0, 1, 0);
      READF(fa1, fb1, 1, 1);
      MMA(fa0, fb0);
#pragma unroll
      for (int i = 0; i < 4 + NTW; ++i) { __builtin_amdgcn_sched_group_barrier(0x100, 1, 0); __builtin_amdgcn_sched_group_barrier(0x008, 2, 0); }
      __builtin_amdgcn_sched_barrier(0);
      if (kt + 2 < nk) SSTORE(R1, 0);
      if (kt + 4 < nk) GLOAD(R1, (kt + 4) * 64);
      MMA(fa1, fb1);
#pragma unroll
      for (int i = 0; i < 6; ++i) { __builtin_amdgcn_sched_group_barrier(0x200, 1, 0); __builtin_amdgcn_sched_group_barrier(0x020, 1, 0); __builtin_amdgcn_sched_group_barrier(0x008, 2, 0); }
      __builtin_amdgcn_sched_barrier(0);
      lds_barrier();
      if (kt + 2 < nk) READF(fa0, fb0, 0, 0);
    }
  } else {
    lds_barrier();
    for (int kt = 0; kt < nk; ++kt) {
      const int st = kt & 1;
      if (kt + 1 < nk) GLOAD(R0, (kt + 1) * 64);
      __builtin_amdgcn_sched_barrier(0);
      COMPUTE(st);
      __builtin_amdgcn_sched_barrier(0);
      if (kt + 1 < nk) SSTORE(R0, st ^ 1);
      lds_barrier();
    }
  }
}

#define GLDS16(gp, lp) __builtin_amdgcn_global_load_lds((const unsigned*)(gp), (unsigned*)(lp), 16, 0, 0)
template <class RowFn>
DI void gemm_glds(f32x4 (&acc)[4][4], const bf16_t* __restrict__ A, int lda, RowFn rowfn,
                  const bf16_t* __restrict__ Bt, int ldb, int K, char* smem, const bf16_t* zrow) {
  constexpr int A_BYTES = 256 * 128, STAGE = A_BYTES + 128 * 128;
  const int tid = my_tid(), lane = tid & 63, wid = tid >> 6, wm = wid >> 1, wn = wid & 1, g = lane >> 4, r16 = lane & 15;
  const int lrow = tid >> 3, c = (tid & 7) ^ (lrow & 7);
  const long a0 = rowfn(lrow), a1 = rowfn(lrow + 64), a2 = rowfn(lrow + 128), a3 = rowfn(lrow + 192);
  const bf16_t* pa0 = (a0 >= 0 ? A + a0 * lda : zrow) + c * 8; const int m0 = a0 >= 0 ? 1 : 0;
  const bf16_t* pa1 = (a1 >= 0 ? A + a1 * lda : zrow) + c * 8; const int m1 = a1 >= 0 ? 1 : 0;
  const bf16_t* pa2 = (a2 >= 0 ? A + a2 * lda : zrow) + c * 8; const int m2 = a2 >= 0 ? 1 : 0;
  const bf16_t* pa3 = (a3 >= 0 ? A + a3 * lda : zrow) + c * 8; const int m3 = a3 >= 0 ? 1 : 0;
  const bf16_t* pb0 = Bt + (long)lrow * ldb + c * 8; const bf16_t* pb1 = pb0 + (long)64 * ldb;
  auto ISSUE = [&](int kt, int bi) {
    char* d = smem + bi * STAGE + tid * 16;
    const int k0 = kt * 64;
    GLDS16(pa0 + k0 * m0, d); GLDS16(pa1 + k0 * m1, d + 8192); GLDS16(pa2 + k0 * m2, d + 16384); GLDS16(pa3 + k0 * m3, d + 24576);
    GLDS16(pb0 + k0, d + A_BYTES); GLDS16(pb1 + k0, d + A_BYTES + 8192);
  };
  auto COMPUTE = [&](int bi) {
    const char* As = smem + bi * STAGE + (wm * 64 + r16) * 128;
    const char* Bs = smem + bi * STAGE + A_BYTES + (wn * 64 + r16) * 128;
#pragma unroll
    for (int kk = 0; kk < 2; ++kk) {
      const int sw = ((kk * 4 + g) ^ (r16 & 7)) << 4;
      bf16x8 af[4], bfr[4];
#pragma unroll
      for (int mt = 0; mt < 4; ++mt) af[mt] = *(const bf16x8*)(As + mt * 16 * 128 + sw);
#pragma unroll
      for (int nt = 0; nt < 4; ++nt) bfr[nt] = *(const bf16x8*)(Bs + nt * 16 * 128 + sw);
      __builtin_amdgcn_s_setprio(1);
#pragma unroll
      for (int mt = 0; mt < 4; ++mt)
#pragma unroll
        for (int nt = 0; nt < 4; ++nt)
          acc[mt][nt] = __builtin_amdgcn_mfma_f32_16x16x32_bf16(af[mt], bfr[nt], acc[mt][nt], 0, 0, 0);
      __builtin_amdgcn_s_setprio(0);
    }
  };
  const int nk = K >> 6;
  __syncthreads();
  ISSUE(0, 0);
  ISSUE(1, 1);
  asm volatile("s_waitcnt vmcnt(6)" ::: "memory");
  __builtin_amdgcn_s_barrier();
  asm volatile("" ::: "memory");
  int bi = 0;
  for (int kt = 0; kt < nk; ++kt) {
    const int b2 = bi >= 1 ? bi - 1 : 2;
    if (kt + 2 < nk) ISSUE(kt + 2, b2);
    COMPUTE(bi);
    if (kt + 2 < nk) asm volatile("s_waitcnt vmcnt(6)" ::: "memory");
    else asm volatile("s_waitcnt vmcnt(0)" ::: "memory");
    asm volatile("s_waitcnt lgkmcnt(0)" ::: "memory");
    __builtin_amdgcn_s_barrier();
    asm volatile("" ::: "memory");
    bi = bi == 2 ? 0 : bi + 1;
  }
}

DI void gemm_glds256(f32x4 (&acc)[8][4], const bf16_t* __restrict__ A, int lda, long arow0,
                     const bf16_t* __restrict__ Bt, int ldb, int K, char* smem) {
  constexpr int A_BYTES = 256 * 128, STAGE = 2 * A_BYTES;
  const int tid = my_tid(), lane = tid & 63, wid = tid >> 6, wm = wid >> 2, wn = wid & 3, g = lane >> 4, r16 = lane & 15;
  const int lrow = tid >> 3, c = (tid & 7) ^ (lrow & 7);
  const bf16_t* pa = A + (arow0 + lrow) * (long)lda + c * 8;
  const bf16_t* pb = Bt + (long)lrow * ldb + c * 8;
  const long a64 = (long)64 * lda, b64 = (long)64 * ldb;
  auto ISSUE = [&](int kt, int bi) {
    char* d = smem + bi * STAGE + tid * 16;
    const int k0 = kt * 64;
    GLDS16(pa + k0, d); GLDS16(pa + a64 + k0, d + 8192); GLDS16(pa + 2 * a64 + k0, d + 16384); GLDS16(pa + 3 * a64 + k0, d + 24576);
    GLDS16(pb + k0, d + A_BYTES); GLDS16(pb + b64 + k0, d + A_BYTES + 8192); GLDS16(pb + 2 * b64 + k0, d + A_BYTES + 16384); GLDS16(pb + 3 * b64 + k0, d + A_BYTES + 24576);
  };
  auto COMPUTE = [&](int bi) {
    const char* As = smem + bi * STAGE + (wm * 128 + r16) * 128;
    const char* Bs = smem + bi * STAGE + A_BYTES + (wn * 64 + r16) * 128;
#pragma unroll
    for (int kk = 0; kk < 2; ++kk) {
      const int sw = ((kk * 4 + g) ^ (r16 & 7)) << 4;
      bf16x8 bfr[4];
#pragma unroll
      for (int nt = 0; nt < 4; ++nt) bfr[nt] = *(const bf16x8*)(Bs + nt * 16 * 128 + sw);
      __builtin_amdgcn_s_setprio(1);
#pragma unroll
      for (int mt = 0; mt < 8; ++mt) {
        const bf16x8 af = *(const bf16x8*)(As + mt * 16 * 128 + sw);
#pragma unroll
        for (int nt = 0; nt < 4; ++nt)
          acc[mt][nt] = __builtin_amdgcn_mfma_f32_16x16x32_bf16(af, bfr[nt], acc[mt][nt], 0, 0, 0);
      }
      __builtin_amdgcn_s_setprio(0);
    }
  };
  const int nk = K >> 6;
  __syncthreads();
  ISSUE(0, 0);
  asm volatile("s_waitcnt vmcnt(0)" ::: "memory");
  __builtin_amdgcn_s_barrier();
  asm volatile("" ::: "memory");
  int bi = 0;
  for (int kt = 0; kt < nk; ++kt) {
    if (kt + 1 < nk) ISSUE(kt + 1, bi ^ 1);
    COMPUTE(bi);
    asm volatile("s_waitcnt vmcnt(0)" ::: "memory");
    asm volatile("s_waitcnt lgkmcnt(0)" ::: "memory");
    __builtin_amdgcn_s_barrier();
    asm volatile("" ::: "memory");
    bi ^= 1;
  }
}
DI void zero_acc256(f32x4 (&acc)[8][4]) {
#pragma unroll
  for (int i = 0; i < 8; ++i)
#pragma unroll
    for (int j = 0; j < 4; ++j) acc[i][j] = (f32x4){0.f, 0.f, 0.f, 0.f};
}

DI bool next_tile(int i, int MTILES, int NTILES, int& mt, int& nt) {
  const int xcd = blockIdx.x & 7, slot = blockIdx.x >> 3, nslot = gridDim.x >> 3;
  const int m_lo = (MTILES * xcd) >> 3, m_hi = (MTILES * (xcd + 1)) >> 3, Mloc = m_hi - m_lo;
  const int q = i * nslot + slot;
  if (q >= Mloc * NTILES) return false;
  const int gidx = q / (4 * NTILES), m0 = gidx * 4;
  const int rows = (Mloc - m0) < 4 ? (Mloc - m0) : 4;
  const int within = q - gidx * 4 * NTILES;
  nt = within / rows; mt = m_lo + m0 + within % rows;
  return true;
}

struct RowPlain { long base; DI long operator()(int r) const { return base + r; } };
struct RowHalo { long rowbase; int t0; int len; DI long operator()(int r) const { int t = t0 + r; return (t >= 0 && t < len) ? rowbase + t : -1; } };

template <int NTW> DI void zero_acc(f32x4 (&acc)[4][NTW]) {
#pragma unroll
  for (int i = 0; i < 4; ++i)
#pragma unroll
    for (int j = 0; j < NTW; ++j) acc[i][j] = (f32x4){0.f, 0.f, 0.f, 0.f};
}

DI void cvt_unit(const float* __restrict__ src, int ldsrc, int srccol0, int k0, bf16_t* __restrict__ dst, int K, int n0, char* smem, bool perm = true) {
  float* T = (float*)smem;
  const int tid = my_tid();
  __syncthreads();
  if (srccol0 >= 0) {
#pragma unroll
    for (int i = 0; i < 8; ++i) {
      int idx = tid + i * 512; int k = idx >> 6, n = idx & 63;
      T[k * 65 + n] = src[(long)(k0 + k) * ldsrc + srccol0 + n];
    }
  }
  __syncthreads();
  int nd = tid >> 3, kc = (tid & 7) * 8; int n = perm ? ((nd & 15) * 4 + (nd >> 4)) : nd;
  uint4 o = make_uint4(0, 0, 0, 0);
  if (srccol0 >= 0) {
    o.x = pack2(T[(kc + 0) * 65 + n], T[(kc + 1) * 65 + n]);
    o.y = pack2(T[(kc + 2) * 65 + n], T[(kc + 3) * 65 + n]);
    o.z = pack2(T[(kc + 4) * 65 + n], T[(kc + 5) * 65 + n]);
    o.w = pack2(T[(kc + 6) * 65 + n], T[(kc + 7) * 65 + n]);
  }
  *(uint4*)(dst + (long)(n0 + nd) * K + k0 + kc) = o;
}

DI void ph_convert(const Params& p, int l, char* smem) {
  for (int u = blockIdx.x; u < 4508; u += gridDim.x) {
    if (u < 832) {
      int gI = u >> 4, kt = u & 15; int n0 = gI * 64; int sc;
      if (n0 < 1280) sc = n0; else if (n0 < 2048) sc = 2496 + (n0 - 1280); else if (n0 < 3264) sc = 1280 + (n0 - 2048); else sc = -1;
      cvt_unit(p.in[6] + (size_t)l * 1024 * 7360, 7360, sc, kt * 64, (bf16_t*)(p.ws + WB_IN), 1024, n0, smem);
    } else if (u < 1856) {
      int v = u - 832; int gI = v >> 4, kt = v & 15;
      cvt_unit(p.in[6] + (size_t)l * 1024 * 7360, 7360, 3264 + gI * 64, kt * 64, (bf16_t*)(p.ws + WB_GATE), 1024, gI * 64, smem);
    } else if (u < 2112) {
      int v = u - 1856; int gI = v >> 2, kt = v & 3; int j = gI >> 4, gg = gI & 15;
      cvt_unit(p.in[33] + ((size_t)l * 4 + j) * 256 * 1024, 1024, gg * 64, kt * 64, (bf16_t*)(p.ws + WB_BR) + (size_t)j * 1024 * 256, 256, gg * 64, smem);
    } else if (u < 2368) {
      int v = u - 2112; int gI = v >> 4, kt = v & 15;
      cvt_unit(p.in[34] + (size_t)l * 1024 * 1024, 1024, gI * 64, kt * 64, (bf16_t*)(p.ws + WB_OUT), 1024, gI * 64, smem);
    } else if (u < 3776) {
      int v = u - 2368; int gI = v >> 4, kt = v & 15; int nt = gI >> 2, q = gI & 3;
      cvt_unit(p.in[37] + (size_t)l * 1024 * 5632, 5632, (q >> 1) * 2816 + nt * 128 + (q & 1) * 64, kt * 64, (bf16_t*)(p.ws + WB_UP), 1024, gI * 64, smem);
    } else if (u < 4480) {
      int v = u - 3776; int gI = v / 44, kt = v % 44;
      cvt_unit(p.in[40] + (size_t)l * 2816 * 1024, 1024, gI * 64, kt * 64, (bf16_t*)(p.ws + WB_DOWN), 2816, gI * 64, smem);
    } else {
      int v = u - 4480;
      if (v < 4) cvt_unit(p.in[19] + (size_t)l * 2 * 64 * 256, 256, v * 64, 0, (bf16_t*)(p.ws + RWW_F), 64, v * 64, smem);
      else if (v < 8) cvt_unit(p.in[19] + (size_t)l * 2 * 64 * 256 + 64 * 256, 256, (v - 4) * 64, 0, (bf16_t*)(p.ws + RWW_B), 64, (v - 4) * 64, smem);
      else if (v < 12) cvt_unit(p.in[21] + (size_t)l * 64 * 256, 256, (v - 8) * 64, 0, (bf16_t*)(p.ws + RWW_A), 64, (v - 8) * 64, smem);
      else if (v < 20) { int w = v - 12; cvt_unit(p.in[22] + (size_t)l * 2 * 128 * 256, 256, (w >> 1) * 64, (w & 1) * 64, (bf16_t*)(p.ws + RWW_GF), 128, (w >> 1) * 64, smem); }
      else { int w = v - 20; cvt_unit(p.in[22] + (size_t)l * 2 * 128 * 256 + 128 * 256, 256, (w >> 1) * 64, (w & 1) * 64, (bf16_t*)(p.ws + RWW_GB), 128, (w >> 1) * 64, smem); }
    }
  }
}

DI void ph_ada(const Params& p, char* smem) {
  float* S = (float*)smem;
  float* R = S + 9 * 1024;
  const int tid = my_tid();
  bool loaded = false;
  for (int u = blockIdx.x; u < 192; u += gridDim.x) {
    if (!loaded) {
      __syncthreads();
      for (int i = tid; i < 9 * 1024; i += NTHR) { float c = i < 8192 ? p.in[1][i] : p.in[3][i - 8192]; S[i] = siluf_(c); }
      loaded = true;
    }
    __syncthreads();
    int l = u / 96, n0 = (u % 96) * 64;
    int col = tid & 63, ks = tid >> 6;
    const float* W = p.in[4] + (size_t)l * 1024 * 6144 + n0 + col;
    float a[9];
#pragma unroll
    for (int b = 0; b < 9; ++b) a[b] = 0.f;
    for (int k = ks * 128; k < ks * 128 + 128; ++k) {
      float w = W[(size_t)k * 6144];
#pragma unroll
      for (int b = 0; b < 9; ++b) a[b] += S[b * 1024 + k] * w;
    }
#pragma unroll
    for (int b = 0; b < 9; ++b) R[(ks * 9 + b) * 64 + col] = a[b];
    __syncthreads();
    for (int i = tid; i < 9 * 64; i += NTHR) {
      int b = i >> 6, c = i & 63; float s = 0.f;
#pragma unroll
      for (int k2 = 0; k2 < 8; ++k2) s += R[(k2 * 9 + b) * 64 + c];
      s += p.in[5][(size_t)l * 6144 + n0 + c];
      ((float*)(p.ws + MISC_MOD))[((size_t)l * 9 + b) * 6144 + n0 + c] = s;
    }
  }
  for (int i = blockIdx.x * NTHR + tid; i < 4096; i += gridDim.x * NTHR) {
    float s, c; sincospif(-(float)i / 4096.f, &s, &c);
    ((float2*)(p.ws + MISC_TW))[i] = make_float2(c, s);
  }
}

DI void hy_rawfilter(const Params& p, int l, int Lf, float* __restrict__ dst, char* smem) {
  float* W1 = (float*)smem;
  float* W2 = W1 + 33 * 64;
  float* Z = W2 + 64 * 64;
  float* H1 = Z + 16 * 36;
  float* H2 = H1 + 16 * 64;
  const int tid = my_tid();
  const float* w1 = p.in[9] + (size_t)l * 33 * 64; const float* b1 = p.in[10] + l * 64;
  const float* w2 = p.in[11] + (size_t)l * 64 * 64; const float* b2 = p.in[12] + l * 64;
  const float* w3 = p.in[13] + (size_t)l * 64 * 1024; const float* fr = p.in[14] + l * 64;
  const int nunits = Lf / 16;
  bool loaded = false;
  for (int u = blockIdx.x; u < nunits; u += gridDim.x) {
    __syncthreads();
    if (!loaded) {
      for (int i = tid; i < 33 * 64; i += NTHR) W1[i] = w1[i];
      for (int i = tid; i < 64 * 64; i += NTHR) W2[i] = w2[i];
      loaded = true;
    }
    const int t0 = u * 16;
    for (int i = tid; i < 16 * 33; i += NTHR) {
      int tt = i / 33, f = i % 33; int t = t0 + tt; float v;
      if (f == 0) v = (float)t / (float)(Lf - 1);
      else {
        int bi = (f - 1) & 15;
        float wv = 6.283185307179586f * (float)t / (float)Lf;
        float fb = 1e-4f + (15.f - 1e-4f) * (float)bi / 15.f;
        float ang = wv * fb;
        v = (f <= 16) ? cosf(ang) : -sinf(ang);
      }
      Z[tt * 36 + f] = v;
    }
    __syncthreads();
    for (int i = tid; i < 16 * 64; i += NTHR) {
      int tt = i >> 6, f = i & 63; float s = b1[f];
      for (int k = 0; k < 33; ++k) s += Z[tt * 36 + k] * W1[k * 64 + f];
      H1[tt * 64 + f] = sinf(fr[f] * s);
    }
    __syncthreads();
    for (int i = tid; i < 16 * 64; i += NTHR) {
      int tt = i >> 6, f = i & 63; float s = b2[f];
      for (int k = 0; k < 64; ++k) s += H1[tt * 64 + k] * W2[k * 64 + f];
      H2[tt * 64 + f] = sinf(fr[f] * s);
    }
    __syncthreads();
    float a0[16], a1[16];
#pragma unroll
    for (int i = 0; i < 16; ++i) { a0[i] = 0.f; a1[i] = 0.f; }
    for (int k = 0; k < 64; ++k) {
      float wa = w3[k * 1024 + tid], wb = w3[k * 1024 + 512 + tid];
#pragma unroll
      for (int i = 0; i < 16; ++i) { float h = H2[i * 64 + k]; a0[i] += h * wa; a1[i] += h * wb; }
    }
    {
      int w = tid & 255;
      float delta = fabsf(-3.0701134573253944f + (-15.350567286626972f + 3.0701134573253944f) * (float)w / 255.f);
#pragma unroll
      for (int i = 0; i < 16; ++i) {
        float tn = (float)(t0 + i) / (float)(Lf - 1);
        float dec = expf(-tn * delta);
        dst[(size_t)(t0 + i) * 1024 + tid] = a0[i] * dec;
        dst[(size_t)(t0 + i) * 1024 + 512 + tid] = a1[i] * dec;
      }
    }
  }
}

DI float2 cmul(float2 a, float2 b) { return make_float2(a.x * b.x - a.y * b.y, a.x * b.y + a.y * b.x); }
DI float2 cmulc(float2 a, float2 b) { return make_float2(a.x * b.x + a.y * b.y, a.y * b.x - a.x * b.y); }
DI float2 cadd(float2 a, float2 b) { return make_float2(a.x + b.x, a.y + b.y); }
DI float2 csub(float2 a, float2 b) { return make_float2(a.x - b.x, a.y - b.y); }
DI void fft_dif(float2* X, const float2* W) {
  const int tid = my_tid();
  for (int ls = 12; ls >= 2; ls -= 2) {
    const int s = 1 << ls, h = s >> 1;
    __syncthreads();
#pragma unroll
    for (int i = 0; i < 4; ++i) {
      const int bf = tid + i * 512; const int j = bf & (h - 1); const int base = ((bf >> (ls - 1)) << (ls + 1)) + j;
      const float2 x0 = X[base], x1 = X[base + h], x2 = X[base + s], x3 = X[base + s + h];
      const float2 w1 = W[s - 1 + j], w2 = W[h - 1 + j];
      const float2 y0 = cadd(x0, x2), y2 = cmul(csub(x0, x2), w1), y1 = cadd(x1, x3);
      const float2 t = cmul(csub(x1, x3), w1); const float2 y3 = make_float2(t.y, -t.x);
      X[base] = cadd(y0, y1); X[base + h] = cmul(csub(y0, y1), w2);
      X[base + s] = cadd(y2, y3); X[base + s + h] = cmul(csub(y2, y3), w2);
    }
  }
  __syncthreads();
#pragma unroll
  for (int i = 0; i < 4; ++i) {
    const int q = tid + i * 512;
    float4 a = *(float4*)(X + 4 * q), b = *(float4*)(X + 4 * q + 2);
    *(float4*)(X + 4 * q) = make_float4(a.x + a.z, a.y + a.w, a.x - a.z, a.y - a.w);
    *(float4*)(X + 4 * q + 2) = make_float4(b.x + b.z, b.y + b.w, b.x - b.z, b.y - b.w);
  }
  __syncthreads();
}
DI void fft_dit_inv(float2* X, const float2* W) {
  const int tid = my_tid();
  __syncthreads();
#pragma unroll
  for (int i = 0; i < 4; ++i) {
    const int q = tid + i * 512;
    float4 a = *(float4*)(X + 4 * q), b = *(float4*)(X + 4 * q + 2);
    *(float4*)(X + 4 * q) = make_float4(a.x + a.z, a.y + a.w, a.x - a.z, a.y - a.w);
    *(float4*)(X + 4 * q + 2) = make_float4(b.x + b.z, b.y + b.w, b.x - b.z, b.y - b.w);
  }
  for (int ls = 2; ls <= 12; ls += 2) {
    const int s = 1 << ls, h = s >> 1;
    __syncthreads();
#pragma unroll
    for (int i = 0; i < 4; ++i) {
      const int bf = tid + i * 512; const int j = bf & (h - 1); const int base = ((bf >> (ls - 1)) << (ls + 1)) + j;
      const float2 e0 = X[base], e1 = X[base + h], e2 = X[base + s], e3 = X[base + s + h];
      const float2 w1 = W[s - 1 + j], w2 = W[h - 1 + j];
      const float2 t1 = cmulc(e1, w2), t3 = cmulc(e3, w2);
      const float2 u0 = cadd(e0, t1), u1 = csub(e0, t1), u2 = cadd(e2, t3), u3 = csub(e2, t3);
      const float2 a2 = cmulc(u2, w1); const float2 q3 = cmulc(u3, w1); const float2 a3 = make_float2(-q3.y, q3.x);
      X[base] = cadd(u0, a2); X[base + s] = csub(u0, a2);
      X[base + h] = cadd(u1, a3); X[base + s + h] = csub(u1, a3);
    }
  }
  __syncthreads();
}
DI void load_twiddles(const Params& p, float2* W) {
  const float2* tw = (const float2*)(p.ws + MISC_TW);
  for (int i = my_tid(); i < 8191; i += NTHR) {
    const int ls = 31 - __clz(i + 1); const int pos = i + 1 - (1 << ls);
    W[i] = tw[pos << (12 - ls)];
  }
}

DI void ph_kf(const Params& p, int l, char* smem) {
  float2* X = (float2*)smem; float2* W = X + 8192; float* red = (float*)(W + 8192);
  const int tid = my_tid(), lane = tid & 63, wid = tid >> 6;
  const float* rawf = (const float*)(p.ws + R_RAWF);
  float2* kf = (float2*)(p.ws + OFF_KF);
  bool tw = false;
  for (int u = blockIdx.x; u < 256; u += gridDim.x) {
    if (!tw) { load_twiddles(p, W); tw = true; }
    const int o = u >> 7, c = (u & 127) * 2;
    float2 fw[8], bw[8]; float sa = 0.f, sb = 0.f;
#pragma unroll
    for (int i = 0; i < 8; ++i) {
      int t = tid + i * 512;
      fw[i] = *(const float2*)(rawf + (size_t)t * 1024 + o * 512 + c);
      bw[i] = *(const float2*)(rawf + (size_t)t * 1024 + o * 512 + 256 + c);
      sa += fabsf(fw[i].x) + fabsf(bw[i].x); sb += fabsf(fw[i].y) + fabsf(bw[i].y);
    }
    sa = wave_sum(sa); sb = wave_sum(sb);
    __syncthreads();
    if (lane == 0) { red[wid * 2] = sa; red[wid * 2 + 1] = sb; }
    __syncthreads();
    float ta = 0.f, tb = 0.f;
#pragma unroll
    for (int w = 0; w < 8; ++w) { ta += red[w * 2]; tb += red[w * 2 + 1]; }
    const float ia = 1.f / ta, ib = 1.f / tb;
#pragma unroll
    for (int i = 0; i < 8; ++i) {
      int t = tid + i * 512;
      X[t] = make_float2(fw[i].x * ia, fw[i].y * ib);
      if (t >= 1) X[8192 - t] = make_float2(bw[i].x * ia, bw[i].y * ib);
      else X[4096] = make_float2(0.f, 0.f);
    }
    fft_dif(X, W);
    float2* ka = kf + (size_t)(o * 256 + c) * 8192; float2* kb = ka + 8192;
#pragma unroll 4
    for (int i = 0; i < 16; ++i) {
      int pidx = tid + i * 512;
      int k = (int)(__brev((unsigned)pidx) >> 19);
      int k2 = (8192 - k) & 8191;
      int p2 = (int)(__brev((unsigned)k2) >> 19);
      float2 c1 = X[pidx], c2 = X[p2];
      float2 A = make_float2(0.5f * (c1.x + c2.x), 0.5f * (c1.y - c2.y));
      float2 Bv = make_float2(0.5f * (c1.y + c2.y), -0.5f * (c1.x - c2.x));
      ka[pidx] = A; kb[pidx] = Bv;
    }
    __syncthreads();
  }
  if (l == 0) {
    const float* rawc = (const float*)(p.ws + MISC_RAWC);
    float* G = (float*)(p.ws + MISC_GCTX);
    for (int u = blockIdx.x * 8 + wid; u < 512; u += gridDim.x * 8) {
      int o = u >> 8, c = u & 255; float f[4], b[4]; float s = 0.f;
#pragma unroll
      for (int i = 0; i < 4; ++i) {
        int t = lane + i * 64;
        f[i] = rawc[(size_t)t * 1024 + o * 512 + c]; b[i] = rawc[(size_t)t * 1024 + o * 512 + 256 + c];
        s += fabsf(f[i]) + fabsf(b[i]);
      }
      s = wave_sum(s); float inv = 1.f / s;
#pragma unroll
      for (int i = 0; i < 4; ++i) {
        int t = lane + i * 64;
        G[(size_t)u * 512 + 256 + t] = f[i] * inv;
        if (t >= 1) G[(size_t)u * 512 + 256 - t] = b[i] * inv;
      }
      if (lane == 0) G[(size_t)u * 512] = 0.f;
    }
  }
}

DI void ph_ln(const float* __restrict__ src_lat, const float* __restrict__ src_ctx, float* dst_lat, float* dst_ctx,
              const float* __restrict__ ag, const float* __restrict__ ab, bf16_t* U, const float* __restrict__ mod, int sh_off, int nrows) {
  const int lane = my_tid() & 63, wid = my_tid() >> 6;
  const int stride = gridDim.x * 8;
  float4 nv[4];
  {
    const int row = blockIdx.x * 8 + wid;
    if (row < nrows) {
      const float* src = row < ML ? src_lat + (size_t)row * D : src_ctx + (size_t)(row - ML) * D;
#pragma unroll
      for (int i = 0; i < 4; ++i) nv[i] = *(const float4*)(src + i * 256 + lane * 4);
    }
  }
  for (int row = blockIdx.x * 8 + wid; row < nrows; row += stride) {
    float4 v[4];
#pragma unroll
    for (int i = 0; i < 4; ++i) v[i] = nv[i];
    if (row + stride < nrows) {
      const int r2 = row + stride;
      const float* src2 = r2 < ML ? src_lat + (size_t)r2 * D : src_ctx + (size_t)(r2 - ML) * D;
#pragma unroll
      for (int i = 0; i < 4; ++i) nv[i] = *(const float4*)(src2 + i * 256 + lane * 4);
    }
    float s = 0.f;
#pragma unroll
    for (int i = 0; i < 4; ++i) s += v[i].x + v[i].y + v[i].z + v[i].w;
    float mu = wave_sum(s) * (1.f / 1024.f);
    float q = 0.f;
#pragma unroll
    for (int i = 0; i < 4; ++i) { v[i].x -= mu; v[i].y -= mu; v[i].z -= mu; v[i].w -= mu; q += v[i].x * v[i].x + v[i].y * v[i].y + v[i].z * v[i].z + v[i].w * v[i].w; }
    float rs = rsqrtf(wave_sum(q) * (1.f / 1024.f) + 1e-6f);
#pragma unroll
    for (int i = 0; i < 4; ++i) { v[i].x *= rs; v[i].y *= rs; v[i].z *= rs; v[i].w *= rs; }
    if (ag) {
      float* dst = row < ML ? dst_lat + (size_t)row * D : dst_ctx + (size_t)(row - ML) * D;
#pragma unroll
      for (int i = 0; i < 4; ++i) {
        float4 gg = *(const float4*)(ag + i * 256 + lane * 4), bb = *(const float4*)(ab + i * 256 + lane * 4);
        v[i].x = v[i].x * gg.x + bb.x; v[i].y = v[i].y * gg.y + bb.y; v[i].z = v[i].z * gg.z + bb.z; v[i].w = v[i].w * gg.w + bb.w;
        *(float4*)(dst + i * 256 + lane * 4) = v[i];
      }
      if (U) {
        s = 0.f;
#pragma unroll
        for (int i = 0; i < 4; ++i) s += v[i].x + v[i].y + v[i].z + v[i].w;
        mu = wave_sum(s) * (1.f / 1024.f); q = 0.f;
#pragma unroll
        for (int i = 0; i < 4; ++i) { v[i].x -= mu; v[i].y -= mu; v[i].z -= mu; v[i].w -= mu; q += v[i].x * v[i].x + v[i].y * v[i].y + v[i].z * v[i].z + v[i].w * v[i].w; }
        rs = rsqrtf(wave_sum(q) * (1.f / 1024.f) + 1e-6f);
#pragma unroll
        for (int i = 0; i < 4; ++i) { v[i].x *= rs; v[i].y *= rs; v[i].z *= rs; v[i].w *= rs; }
      }
    }
    if (U) {
      const float* m = mod + (size_t)mod_idx(row) * 6144 + sh_off;
#pragma unroll
      for (int i = 0; i < 4; ++i) {
        float4 sh = *(const float4*)(m + i * 256 + lane * 4), sc = *(const float4*)(m + 1024 + i * 256 + lane * 4);
        uint2 o; o.x = pack2(v[i].x * (1.f + sc.x) + sh.x, v[i].y * (1.f + sc.y) + sh.y);
        o.y = pack2(v[i].z * (1.f + sc.z) + sh.z, v[i].w * (1.f + sc.w) + sh.w);
        *(uint2*)(U + (size_t)row * D + i * 256 + lane * 4) = o;
      }
    }
  }
}

DI void ph_inproj(const Params& p, const bf16_t* U, char* smem) {
  const bf16_t* Bt = (const bf16_t*)(p.ws + WB_IN);
  const int lane = my_tid() & 63, wid = my_tid() >> 6, wm = wid >> 2, wn = wid & 3, g = lane >> 4, r16 = lane & 15;
  for (int it = 0;; ++it) {
    int mtile, ntile;
    if (!next_tile(it, 136, 13, mtile, ntile)) break;
    f32x4 acc[8][4]; zero_acc256(acc);
    gemm_glds256(acc, U, 1024, (long)mtile * 256, Bt + (size_t)ntile * 256 * 1024, 1024, 1024, smem);
    int b, key0;
    if (mtile < 128) { b = mtile >> 4; key0 = (mtile & 15) * 256; } else { b = mtile - 128; key0 = SL; }
    const int wc0 = ntile * 256 + wn * 64;
    bf16_t* tbase = nullptr; int tcols = 0, tcol0 = 0;
    if (wc0 < 768) { tbase = (bf16_t*)(p.ws + R_PHY); tcols = 768; tcol0 = wc0; }
    else if (wc0 >= 1152 && wc0 < 1280) { tbase = (bf16_t*)(p.ws + R_VTSW); tcols = 128; tcol0 = wc0 - 1152; }
    else if (wc0 >= 1792 && wc0 < 2048) { tbase = (bf16_t*)(p.ws + R_VTDF); tcols = 256; tcol0 = wc0 - 1792; }
    if (tbase) {
#pragma unroll
      for (int mt = 0; mt < 8; ++mt)
#pragma unroll
        for (int nt = 0; nt < 4; ++nt) {
          int col = tcol0 + r16 * 4 + nt;
          int key = key0 + wm * 128 + mt * 16 + g * 4;
          uint2 o; o.x = pack2(acc[mt][nt][0], acc[mt][nt][1]); o.y = pack2(acc[mt][nt][2], acc[mt][nt][3]);
          *(uint2*)(tbase + ((size_t)b * tcols + col) * KEYS + key) = o;
        }
    } else if (wc0 < 3264) {
      bf16_t* rb; int ld, c0;
      if (wc0 < 1152) { rb = (bf16_t*)(p.ws + R_PSW); ld = 384; c0 = wc0 - 768; }
      else if (wc0 < 1792) { rb = (bf16_t*)(p.ws + R_PDF); ld = 512; c0 = wc0 - 1280; }
      else { rb = (bf16_t*)(p.ws + R_PRW); ld = 1216; c0 = wc0 - 2048; }
      const int col = c0 + r16 * 4;
#pragma unroll
      for (int mt = 0; mt < 8; ++mt)
#pragma unroll
        for (int j = 0; j < 4; ++j) {
          size_t row = (size_t)mtile * 256 + wm * 128 + mt * 16 + g * 4 + j;
          uint2 o; o.x = pack2(acc[mt][0][j], acc[mt][1][j]); o.y = pack2(acc[mt][2][j], acc[mt][3][j]);
          *(uint2*)(rb + row * ld + col) = o;
        }
    }
  }
}

DI float hy_conv3(const bf16_t* __restrict__ P, int t, int len, float w0, float w1, float w2, float bias) {
  float a = t >= 1 ? bf2f(P[t - 1]) : 0.f, b = bf2f(P[t]), c = (t + 1 < len) ? bf2f(P[t + 1]) : 0.f;
  return w0 * a + w1 * b + w2 * c + bias;
}
DI void ph_hyena(const Params& p, int l, char* smem) {
  float2* X = (float2*)smem; float2* W = X + 8192;
  const int tid = my_tid();
  const bf16_t* PT = (const bf16_t*)(p.ws + R_PHY);
  const float2* kf = (const float2*)(p.ws + OFF_KF);
  const float* cw = p.in[7] + (size_t)l * 3 * 768; const float* cb = p.in[8] + (size_t)l * 768;
  const float* hb = p.in[15] + (size_t)l * 512;
  bf16_t* Y = (bf16_t*)(p.ws + R_YHY);
  bool tw = false;
  for (int u = blockIdx.x; u < 1024; u += gridDim.x) {
    if (!tw) { load_twiddles(p, W); tw = true; }
    const int bp = u >> 8, c = u & 255; const int b0 = bp * 2, b1 = b0 + 1;
    const bf16_t* P0 = PT + ((size_t)b0 * 768) * KEYS; const bf16_t* P1 = PT + ((size_t)b1 * 768) * KEYS;
    float wv0 = cw[c], wv1 = cw[768 + c], wv2 = cw[1536 + c], bv = cb[c];
    float wa0 = cw[256 + c], wa1 = cw[768 + 256 + c], wa2 = cw[1536 + 256 + c], ba = cb[256 + c];
    float wb0 = cw[512 + c], wb1 = cw[768 + 512 + c], wb2 = cw[1536 + 512 + c], bb = cb[512 + c];
    const float bias0 = hb[c], bias1 = hb[256 + c];
    float2 vv[8];
    __syncthreads();
#pragma unroll
    for (int i = 0; i < 8; ++i) {
      int t = tid + i * 512;
      vv[i].x = hy_conv3(P0 + (size_t)c * KEYS, t, SL, wv0, wv1, wv2, bv);
      vv[i].y = hy_conv3(P1 + (size_t)c * KEYS, t, SL, wv0, wv1, wv2, bv);
      X[t] = vv[i]; X[t + 4096] = make_float2(0.f, 0.f);
    }
    fft_dif(X, W);
    {
      const float2* H = kf + (size_t)c * 8192;
#pragma unroll 4
      for (int i = 0; i < 16; ++i) { int q = tid + i * 512; X[q] = cmul(X[q], H[q]); }
    }
    fft_dit_inv(X, W);
    float2 zz[8];
#pragma unroll
    for (int i = 0; i < 8; ++i) {
      int t = tid + i * 512;
      float2 y = X[t];
      float x1a = hy_conv3(P0 + (size_t)(256 + c) * KEYS, t, SL, wa0, wa1, wa2, ba);
      float x1b = hy_conv3(P1 + (size_t)(256 + c) * KEYS, t, SL, wa0, wa1, wa2, ba);
      zz[i].x = x1a * (y.x * (1.f / 8192.f) + bias0 * vv[i].x);
      zz[i].y = x1b * (y.y * (1.f / 8192.f) + bias0 * vv[i].y);
    }
    __syncthreads();
#pragma unroll
    for (int i = 0; i < 8; ++i) { int t = tid + i * 512; X[t] = zz[i]; X[t + 4096] = make_float2(0.f, 0.f); }
    fft_dif(X, W);
    {
      const float2* H = kf + (size_t)(256 + c) * 8192;
#pragma unroll 4
      for (int i = 0; i < 16; ++i) { int q = tid + i * 512; X[q] = cmul(X[q], H[q]); }
    }
    fft_dit_inv(X, W);
#pragma unroll
    for (int i = 0; i < 8; ++i) {
      int t = tid + i * 512;
      float2 y = X[t];
      float x2a = hy_conv3(P0 + (size_t)(512 + c) * KEYS, t, SL, wb0, wb1, wb2, bb);
      float x2b = hy_conv3(P1 + (size_t)(512 + c) * KEYS, t, SL, wb0, wb1, wb2, bb);
      float oa = x2a * (y.x * (1.f / 8192.f) + bias1 * zz[i].x);
      float ob = x2b * (y.y * (1.f / 8192.f) + bias1 * zz[i].y);
      Y[((size_t)b0 * SL + t) * 256 + c] = (bf16_t)f2bf(oa);
      Y[((size_t)b1 * SL + t) * 256 + c] = (bf16_t)f2bf(ob);
    }
  }
}

DI void ph_hyena_ctx(const Params& p, int l, char* smem) {
  const int tid = my_tid(), lane = tid & 63, wid = tid >> 6;
  float* Zb = (float*)smem + wid * 1024;
  float* Gb = Zb + 256;
  const bf16_t* PT = (const bf16_t*)(p.ws + R_PHY);
  const float* G = (const float*)(p.ws + MISC_GCTX);
  const float* cw = p.in[7] + (size_t)l * 3 * 768; const float* cb = p.in[8] + (size_t)l * 768;
  const float* hb = p.in[15] + (size_t)l * 512;
  bf16_t* Y = (bf16_t*)(p.ws + R_YHY);
  for (int base = blockIdx.x * 8; base < 2048; base += gridDim.x * 8) {
    const int u = base + wid; const int b = u >> 8, c = u & 255;
    const bf16_t* Pb = PT + ((size_t)b * 768) * KEYS + SL;
    float v[4], x1[4], x2[4], zz[4];
#pragma unroll
    for (int i = 0; i < 4; ++i) {
      int t = lane + i * 64;
      v[i] = hy_conv3(Pb + (size_t)c * KEYS, t, CL, cw[c], cw[768 + c], cw[1536 + c], cb[c]);
      x1[i] = hy_conv3(Pb + (size_t)(256 + c) * KEYS, t, CL, cw[256 + c], cw[768 + 256 + c], cw[1536 + 256 + c], cb[256 + c]);
      x2[i] = hy_conv3(Pb + (size_t)(512 + c) * KEYS, t, CL, cw[512 + c], cw[768 + 512 + c], cw[1536 + 512 + c], cb[512 + c]);
    }
    __syncthreads();
#pragma unroll
    for (int i = 0; i < 4; ++i) Zb[lane + i * 64] = v[i];
    for (int i = lane; i < 512; i += 64) Gb[i] = G[(size_t)c * 512 + i];
    __syncthreads();
#pragma unroll
    for (int i = 0; i < 4; ++i) {
      int t = lane + i * 64; float s = 0.f;
      for (int s2 = 0; s2 < 256; ++s2) s += Gb[256 + t - s2] * Zb[s2];
      zz[i] = x1[i] * (s + hb[c] * v[i]);
    }
    __syncthreads();
#pragma unroll
    for (int i = 0; i < 4; ++i) Zb[lane + i * 64] = zz[i];
    for (int i = lane; i < 512; i += 64) Gb[i] = G[(size_t)(256 + c) * 512 + i];
    __syncthreads();
#pragma unroll
    for (int i = 0; i < 4; ++i) {
      int t = lane + i * 64; float s = 0.f;
      for (int s2 = 0; s2 < 256; ++s2) s += Gb[256 + t - s2] * Zb[s2];
      float o = x2[i] * (s + hb[256 + c] * zz[i]);
      Y[((size_t)ML + b * CL + t) * 256 + c] = (bf16_t)f2bf(o);
    }
  }
}

DI void ph_rope(const Params& p, char* smem) {
  float2* T16 = (float2*)smem;
  float2* T8 = T16 + 64 * 16;
  const int tid = my_tid(), lane = tid & 63, wid = tid >> 6;
  __syncthreads();
  for (int i = tid; i < 64 * 16; i += NTHR) {
    int pos = i >> 4, f = i & 15; float inv = powf(10000.f, -(float)f / 16.f); float s, c; sincosf((float)pos * inv, &s, &c);
    T16[i] = make_float2(c, s);
  }
  for (int i = tid; i < 64 * 8; i += NTHR) {
    int pos = i >> 3, f = i & 7; float inv = powf(10000.f, -(float)f / 8.f); float s, c; sincosf((float)pos * inv, &s, &c);
    T8[i] = make_float2(c, s);
  }
  __syncthreads();
  bf16_t* Psw = (bf16_t*)(p.ws + R_PSW); bf16_t* Pdf = (bf16_t*)(p.ws + R_PDF);
  for (int row = blockIdx.x * 8 + wid; row < ML; row += gridDim.x * 8) {
    const int t = row & (SL - 1); const int pr = t >> 6, pc = t & 63;
    bf16_t* q = Psw + (size_t)row * 384;
#pragma unroll
    for (int i = 0; i < 3; ++i) {
      int pi = lane + i * 64; int hd = pi >> 5, pp = pi & 31; int half = pp >> 4, f = pp & 15;
      int base = hd * 64 + half * 32; float2 cs = T16[(half ? pc : pr) * 16 + f];
      float x1 = bf2f(q[base + f]), x2 = bf2f(q[base + 16 + f]);
      q[base + f] = (bf16_t)f2bf(x1 * cs.x - x2 * cs.y); q[base + 16 + f] = (bf16_t)f2bf(x1 * cs.y + x2 * cs.x);
    }
    bf16_t* d = Pdf + (size_t)row * 512;
#pragma unroll
    for (int i = 0; i < 4; ++i) {
      int pi = lane + i * 64; int gi = pi >> 4, pp = pi & 15; int half = pp >> 3, f = pp & 7;
      int base = gi * 32 + half * 16; float2 cs = T8[(half ? pc : pr) * 8 + f];
      float x1 = bf2f(d[base + f]), x2 = bf2f(d[base + 8 + f]);
      d[base + f] = (bf16_t)f2bf(x1 * cs.x - x2 * cs.y); d[base + 8 + f] = (bf16_t)f2bf(x1 * cs.y + x2 * cs.x);
    }
  }
}

DI float rw_shift(const bf16_t* __restrict__ P, int row, int t, int len, int col, float mu) {
  float c = bf2f(P[(size_t)row * 1216 + col]);
  float a = t >= 1 ? bf2f(P[(size_t)(row - 1) * 1216 + col]) : 0.f;
  float b = t + 1 < len ? bf2f(P[(size_t)(row + 1) * 1216 + col]) : 0.f;
  return c + (0.5f * (a + b) - c) * mu;
}
DI void ph_rwprep(const Params& p, int l, char* smem) {
  constexpr int AST = 912, RST = 1552, ROFF = 32 * AST;
  const int tid = my_tid(), lane = tid & 63, wid = tid >> 6, g = lane >> 4, r16 = lane & 15;
  const int tg = wid >> 2, hd = wid & 3;
  const bf16_t* P = (const bf16_t*)(p.ws + R_PRW);
  const float* mu = p.in[17] + (size_t)l * 1216;
  const float* w0 = p.in[18] + (size_t)l * 512; const float* a0 = p.in[20] + (size_t)l * 256;
  const float* kkw = p.in[23] + (size_t)l * 256; const float* kaw = p.in[24] + (size_t)l * 256;
  bf16_t* S = (bf16_t*)(p.ws + R_STR); bf16_t* Gs = (bf16_t*)(p.ws + R_G);
  const size_t SU = (size_t)MT * 256;
  float w0f[4], w0b[4], a0c[4], kkc[4], kac[4];
#pragma unroll
  for (int nt = 0; nt < 4; ++nt) { int c = hd * 64 + r16 * 4 + nt; w0f[nt] = w0[c]; w0b[nt] = w0[256 + c]; a0c[nt] = a0[c]; kkc[nt] = kkw[c]; kac[nt] = kaw[c]; }
  for (int u = blockIdx.x; u < MT / 32; u += gridDim.x) {
    const int row0 = u * 32; int t0, len;
    if (row0 < ML) { t0 = row0 & (SL - 1); len = SL; } else { t0 = (row0 - ML) & (CL - 1); len = CL; }
    __syncthreads();
    for (int item = tid; item < 32 * 152; item += NTHR) {
      const int tk = item / 152, c8 = item - tk * 152; const int row = row0 + tk, t = t0 + tk;
      const uint4 uc = *(const uint4*)(P + (size_t)row * 1216 + c8 * 8);
      uint4 ua = make_uint4(0, 0, 0, 0), ub = make_uint4(0, 0, 0, 0);
      if (t >= 1) ua = *(const uint4*)(P + (size_t)(row - 1) * 1216 + c8 * 8);
      if (t + 1 < len) ub = *(const uint4*)(P + (size_t)(row + 1) * 1216 + c8 * 8);
      const float4 m0 = *(const float4*)(mu + c8 * 8), m1 = *(const float4*)(mu + c8 * 8 + 4);
      float o[8];
      {
        const unsigned wc[4] = {uc.x, uc.y, uc.z, uc.w}, wa[4] = {ua.x, ua.y, ua.z, ua.w}, wb[4] = {ub.x, ub.y, ub.z, ub.w};
        const float mm[8] = {m0.x, m0.y, m0.z, m0.w, m1.x, m1.y, m1.z, m1.w};
#pragma unroll
        for (int i = 0; i < 4; ++i) {
          float c_lo = bflo(wc[i]), c_hi = bfhi(wc[i]);
          o[2 * i] = c_lo + (0.5f * (bflo(wa[i]) + bflo(wb[i])) - c_lo) * mm[2 * i];
          o[2 * i + 1] = c_hi + (0.5f * (bfhi(wa[i]) + bfhi(wb[i])) - c_hi) * mm[2 * i + 1];
        }
      }
      char* dst;
      if (c8 < 96) dst = smem + ROFF + tk * RST + c8 * 16;
      else {
        const int cc = c8 * 8 - 768;
        if (cc < 128) {
#pragma unroll
          for (int i = 0; i < 8; ++i) o[i] = tanhf(o[i]);
        } else if (cc >= 192) {
#pragma unroll
          for (int i = 0; i < 8; ++i) o[i] = sigmoidf_(o[i]);
        }
        dst = smem + tk * AST + cc * 2;
      }
      uint4 ov; ov.x = pack2(o[0], o[1]); ov.y = pack2(o[2], o[3]); ov.z = pack2(o[4], o[5]); ov.w = pack2(o[6], o[7]);
      *(uint4*)dst = ov;
    }
    __syncthreads();
    f32x4 acc[5][4];
#pragma unroll
    for (int o5 = 0; o5 < 5; ++o5)
#pragma unroll
      for (int nt = 0; nt < 4; ++nt) acc[o5][nt] = (f32x4){0.f, 0.f, 0.f, 0.f};
    const char* Arow = smem + (tg * 16 + r16) * AST + g * 16;
#pragma unroll
    for (int o5 = 0; o5 < 5; ++o5) {
      const int kbase = o5 < 3 ? o5 * 64 : (o5 == 3 ? 192 : 320);
      const int KK = o5 < 3 ? 64 : 128;
      const bf16_t* Wt = (const bf16_t*)(p.ws + (o5 == 0 ? RWW_F : o5 == 1 ? RWW_B : o5 == 2 ? RWW_A : o5 == 3 ? RWW_GF : RWW_GB));
#pragma unroll
      for (int ks = 0; ks < KK / 32; ++ks) {
        const bf16x8 af = *(const bf16x8*)(Arow + (kbase + ks * 32) * 2);
#pragma unroll
        for (int nt = 0; nt < 4; ++nt) {
          const bf16x8 bf = *(const bf16x8*)(Wt + (size_t)(hd * 64 + nt * 16 + r16) * KK + ks * 32 + g * 8);
          acc[o5][nt] = __builtin_amdgcn_mfma_f32_16x16x32_bf16(af, bf, acc[o5][nt], 0, 0, 0);
        }
        if (ks & 1) asm volatile("" ::: "memory");
      }
    }
#pragma unroll
    for (int j = 0; j < 4; ++j) {
      const int tk = tg * 16 + g * 4 + j; const size_t row = (size_t)row0 + tk;
      const char* rk = smem + ROFF + tk * RST;
      const int c0 = hd * 64 + r16 * 4;
      const uint2 ur = *(const uint2*)(rk + c0 * 2), uk = *(const uint2*)(rk + (256 + c0) * 2), uv = *(const uint2*)(rk + (512 + c0) * 2);
      const float rv[4] = {bflo(ur.x), bfhi(ur.x), bflo(ur.y), bfhi(ur.y)};
      const float kv[4] = {bflo(uk.x), bfhi(uk.x), bflo(uk.y), bfhi(uk.y)};
      const float vv[4] = {bflo(uv.x), bfhi(uv.x), bflo(uv.y), bfhi(uv.y)};
      float n2 = 0.f;
#pragma unroll
      for (int nt = 0; nt < 4; ++nt) { float q = kv[nt] * kkc[nt]; n2 += q * q; }
      n2 = sum16(n2);
      const float inv = 1.f / fmaxf(sqrtf(n2), 1e-12f);
      float o_kp[4], o_kk[4], o_b[4], o_df[4], o_db[4];
#pragma unroll
      for (int nt = 0; nt < 4; ++nt) {
        const float k = kv[nt];
        const float a = sigmoidf_(a0c[nt] + acc[2][nt][j]);
        const float kk = k * kkc[nt] * inv;
        o_kp[nt] = k * (1.f + (a - 1.f) * kac[nt]);
        o_kk[nt] = kk; o_b[nt] = kk * a;
        const float xf = -(w0f[nt] + acc[0][nt][j]); const float spf = fmaxf(xf, 0.f) + log1pf(__expf(-fabsf(xf)));
        const float xb = -(w0b[nt] + acc[1][nt][j]); const float spb = fmaxf(xb, 0.f) + log1pf(__expf(-fabsf(xb)));
        const float ef = __expf(-spf - 0.5f), eb = __expf(-spb - 0.5f);
        o_df[nt] = -expm1f(-ef); o_db[nt] = -expm1f(-eb);
      }
      const size_t o = row * 256 + c0;
      uint2 w;
      w.x = pack2(rv[0], rv[1]); w.y = pack2(rv[2], rv[3]); *(uint2*)(S + o) = w;
      w.x = pack2(o_kp[0], o_kp[1]); w.y = pack2(o_kp[2], o_kp[3]); *(uint2*)(S + SU + o) = w;
      w.x = pack2(vv[0], vv[1]); w.y = pack2(vv[2], vv[3]); *(uint2*)(S + 2 * SU + o) = w;
      w.x = pack2(o_kk[0], o_kk[1]); w.y = pack2(o_kk[2], o_kk[3]); *(uint2*)(S + 3 * SU + o) = w;
      w.x = pack2(o_b[0], o_b[1]); w.y = pack2(o_b[2], o_b[3]); *(uint2*)(S + 4 * SU + o) = w;
      w.x = pack2(o_df[0], o_df[1]); w.y = pack2(o_df[2], o_df[3]); *(uint2*)(S + 5 * SU + o) = w;
      w.x = pack2(o_db[0], o_db[1]); w.y = pack2(o_db[2], o_db[3]); *(uint2*)(S + 6 * SU + o) = w;
      w.x = pack2(acc[3][0][j], acc[3][1][j]); w.y = pack2(acc[3][2][j], acc[3][3][j]); *(uint2*)(Gs + o) = w;
      w.x = pack2(acc[4][0][j], acc[4][1][j]); w.y = pack2(acc[4][2][j], acc[4][3][j]); *(uint2*)(Gs + SU + o) = w;
    }
  }
}

DI long scan_row(int b, int dir, int s) {
  if (s < CL) return (long)ML + b * CL + (dir ? (CL - 1 - s) : s);
  int t = s - CL; return (long)b * SL + (dir ? (SL - 1 - t) : t);
}
DI float sum8(float v) {
  v += dpp_mov<0xB1>(v);
  v += dpp_mov<0x4E>(v);
  v += dpp_mov<0x141>(v);
  return v;
}
DI void ph_scan(const Params& p, char* smem) {
  const int tid = my_tid(), lane = tid & 63, wid = tid >> 6;
  const bf16_t* S = (const bf16_t*)(p.ws + R_STR);
  const size_t SU = (size_t)MT * 256;
  constexpr int T = 32, NSTEP = CL + SL, NCH = NSTEP / T;
  typedef float f32x2 __attribute__((ext_vector_type(2)));
  for (int u = blockIdx.x; u < 128; u += gridDim.x) {
    const int chain = u >> 1, rg = u & 1; const int dir = chain & 1, bh = chain >> 1, b = bh >> 2, h = bh & 3;
    bf16_t* O = (bf16_t*)(p.ws + (dir ? R_OB : R_OF));
    uint4 q0, q1, q2;
    auto SC_GLOAD = [&](int ci) {
#pragma unroll
      for (int j = 0; j < 3; ++j) {
        int idx = tid + j * 512; int st = idx >> 8, s = (idx & 255) >> 3, ck = idx & 7;
        long row = scan_row(b, dir, ci * T + s);
        int sid = st < 5 ? st : 5 + dir;
        uint4 v = *(const uint4*)(S + sid * SU + row * 256 + h * 64 + ck * 8);
        if (j == 0) q0 = v; else if (j == 1) q1 = v; else q2 = v;
      }
    };
    auto SC_SSTORE = [&](int buf) {
#pragma unroll
      for (int j = 0; j < 3; ++j) {
        int idx = tid + j * 512; int st = idx >> 8;
        uint4 v = j == 0 ? q0 : (j == 1 ? q1 : q2);
        float4 lo = make_float4(bflo(v.x), bfhi(v.x), bflo(v.y), bfhi(v.y));
        float4 hi = make_float4(bflo(v.z), bfhi(v.z), bflo(v.w), bfhi(v.w));
        if (st == 5) { lo.x = 1.f - lo.x; lo.y = 1.f - lo.y; lo.z = 1.f - lo.z; lo.w = 1.f - lo.w; hi.x = 1.f - hi.x; hi.y = 1.f - hi.y; hi.z = 1.f - hi.z; hi.w = 1.f - hi.w; }
        char* base = smem + buf * 49152 + idx * 32;
        *(float4*)(base) = lo; *(float4*)(base + 16) = hi;
      }
    };
    auto FLUSH = [&](int ci) {
      const int s = tid >> 4, part = tid & 15;
      const float2 v = *(const float2*)(smem + 98304 + (ci & 1) * 4096 + s * 128 + part * 8);
      long row = scan_row(b, dir, ci * T + s);
      *(unsigned*)(O + row * 256 + h * 64 + rg * 32 + part * 2) = pack2(v.x, v.y);
    };
    __syncthreads();
    SC_GLOAD(0);
    SC_SSTORE(0);
    __syncthreads();
    f32x2 st0 = {0.f, 0.f}, st1 = {0.f, 0.f}, st2 = {0.f, 0.f}, st3 = {0.f, 0.f};
    const int rsub = lane >> 3, ks = lane & 7;
    const int lrow = (wid & 3) * 8 + rsub;
    const int vrow = rg * 32 + lrow;
    struct Step { f32x2 r[4], k[4], kk[4], b[4], w[4]; float v; };
    auto LOADSTEP = [&](Step& x, const char* B, int s) {
#pragma unroll
      for (int hh = 0; hh < 2; ++hh) {
        const float4 r = *(const float4*)(B + (0 * T + s) * 256 + ks * 32 + hh * 16);
        const float4 k = *(const float4*)(B + (1 * T + s) * 256 + ks * 32 + hh * 16);
        const float4 kk = *(const float4*)(B + (3 * T + s) * 256 + ks * 32 + hh * 16);
        const float4 bb = *(const float4*)(B + (4 * T + s) * 256 + ks * 32 + hh * 16);
        const float4 w = *(const float4*)(B + (5 * T + s) * 256 + ks * 32 + hh * 16);
        x.r[2 * hh] = (f32x2){r.x, r.y}; x.r[2 * hh + 1] = (f32x2){r.z, r.w};
        x.k[2 * hh] = (f32x2){k.x, k.y}; x.k[2 * hh + 1] = (f32x2){k.z, k.w};
        x.kk[2 * hh] = (f32x2){kk.x, kk.y}; x.kk[2 * hh + 1] = (f32x2){kk.z, kk.w};
        x.b[2 * hh] = (f32x2){bb.x, bb.y}; x.b[2 * hh + 1] = (f32x2){bb.z, bb.w};
        x.w[2 * hh] = (f32x2){w.x, w.y}; x.w[2 * hh + 1] = (f32x2){w.z, w.w};
      }
      x.v = *(const float*)(B + (2 * T + s) * 256 + vrow * 4);
    };
    for (int ci = 0; ci < NCH; ++ci) {
      if (ci + 1 < NCH) { SC_GLOAD(ci + 1); }
      if (ci > 0) FLUSH(ci - 1);
      if (wid < 4) {
        const char* B = smem + (ci & 1) * 49152;
        float* ob = (float*)(smem + 98304 + (ci & 1) * 4096);
        Step nx; LOADSTEP(nx, B, 0);
#pragma unroll 2
        for (int s = 0; s < T; ++s) {
          const Step c = nx;
          LOADSTEP(nx, B, s + 1);
          f32x2 pa = st0 * c.kk[0] + st1 * c.kk[1];
          f32x2 pb = st2 * c.kk[2] + st3 * c.kk[3];
          pa = pa + pb;
          float sa = -(pa.x + pa.y);
          sa = sum8(sa);
          const f32x2 sa2 = {sa, sa}; const f32x2 v2 = {c.v, c.v};
          st0 = st0 * c.w[0] + sa2 * c.b[0] + v2 * c.k[0];
          st1 = st1 * c.w[1] + sa2 * c.b[1] + v2 * c.k[1];
          st2 = st2 * c.w[2] + sa2 * c.b[2] + v2 * c.k[2];
          st3 = st3 * c.w[3] + sa2 * c.b[3] + v2 * c.k[3];
          f32x2 oa = st0 * c.r[0] + st1 * c.r[1];
          f32x2 ob2 = st2 * c.r[2] + st3 * c.r[3];
          oa = oa + ob2;
          float o = sum8(oa.x + oa.y);
          if (ks == 0) ob[s * 32 + lrow] = o;
        }
      }
      if (ci + 1 < NCH) { SC_SSTORE((ci + 1) & 1); }
      __syncthreads();
    }
    FLUSH(NCH - 1);
  }
}

template <bool DIFF>
DI void attn_unit(const Params& p, int l, int b, int h, int qrow0, int qpos0, int kb_lo, int kb_hi, int kc_lo, char* smem) {
  const int tid = my_tid(), lane = tid & 63, wid = tid >> 6, g = lane >> 4, r16 = lane & 15;
  const bf16_t* QK = (const bf16_t*)(p.ws + (DIFF ? R_PDF : R_PSW));
  const int ldq = DIFF ? 512 : 384;
  const int qc0 = h * 64;
  const int kc0 = 256 + (DIFF ? h * 64 : (h >> 1) * 64);
  const bf16_t* VT = DIFF ? (const bf16_t*)(p.ws + R_VTDF) + ((size_t)b * 256 + h * 64) * KEYS
                          : (const bf16_t*)(p.ws + R_VTSW) + ((size_t)b * 128 + (h >> 1) * 64) * KEYS;
  const int nblk = (kb_hi - kb_lo) + (68 - kc_lo);
  const float sc = (DIFF ? 0.17677669529663687f : 0.125f) * 1.4426950408889634f;
  bf16x8 qf[2];
  {
    const bf16_t* qp = QK + (size_t)(qrow0 + wid * 16 + r16) * ldq + qc0 + g * 8;
    qf[0] = *(const bf16x8*)(qp); qf[1] = *(const bf16x8*)(qp + 32);
  }
  constexpr int NC = DIFF ? 2 : 1;
  float m[NC], lsum[NC];
  f32x4 O[NC][4];
#pragma unroll
  for (int c = 0; c < NC; ++c) {
    if (DIFF) { m[c] = -1e30f; lsum[c] = 0.f; }
    else { m[c] = p.in[16][l * 4 + h] * 1.4426950408889634f; lsum[c] = (g == 0) ? 1.f : 0.f; }
#pragma unroll
    for (int dt = 0; dt < 4; ++dt) O[c][dt] = (f32x4){0.f, 0.f, 0.f, 0.f};
  }
  const int lr = tid >> 3, lc = tid & 7;
  uint4 rkA, rvA, rkB, rvB;
  rkA = make_uint4(0, 0, 0, 0); rvA = rkA; rkB = rkA; rvB = rkA;
  auto AT_GLOAD = [&](int i, uint4& rk, uint4& rv) {
    int kb = i < (kb_hi - kb_lo) ? kb_lo + i : kc_lo + (i - (kb_hi - kb_lo));
    long krow = kb < 64 ? (long)b * SL + kb * 64 + lr : (long)ML + b * CL + (kb - 64) * 64 + lr;
    rk = *(const uint4*)(QK + krow * ldq + kc0 + lc * 8);
    rv = *(const uint4*)(VT + (size_t)lr * KEYS + kb * 64 + lc * 8);
  };
  auto AT_SSTORE = [&](int buf, const uint4& rk, const uint4& rv) {
    *(uint4*)(smem + buf * 18432 + lr * 128 + ((lc ^ (lr & 7)) << 4)) = rk;
    *(uint4*)(smem + buf * 18432 + 9216 + lr * 144 + lc * 16) = rv;
  };
  __syncthreads();
  AT_GLOAD(0, rkA, rvA);
  AT_SSTORE(0, rkA, rvA);
  if (1 < nblk) AT_GLOAD(1, rkA, rvA);
  if (2 < nblk) AT_GLOAD(2, rkB, rvB);
  lds_barrier();
  const int qpos = qpos0 + wid * 16 + r16;
  for (int i = 0; i < nblk; ++i) {
    const int kb = i < (kb_hi - kb_lo) ? kb_lo + i : kc_lo + (i - (kb_hi - kb_lo));
    const bool masked = (!DIFF) && (kb < 64);
    const char* Kt = smem + (i & 1) * 18432; const char* Vt = Kt + 9216;
    f32x4 S[NC][4];
#pragma unroll
    for (int kt = 0; kt < 4; ++kt) {
      bf16x8 k0 = *(const bf16x8*)(Kt + (kt * 16 + r16) * 128 + ((g ^ (r16 & 7)) << 4));
      bf16x8 k1 = *(const bf16x8*)(Kt + (kt * 16 + r16) * 128 + (((4 + g) ^ (r16 & 7)) << 4));
      if (DIFF) {
        S[0][kt] = __builtin_amdgcn_mfma_f32_16x16x32_bf16(k0, qf[0], (f32x4){0.f, 0.f, 0.f, 0.f}, 0, 0, 0);
        S[NC - 1][kt] = __builtin_amdgcn_mfma_f32_16x16x32_bf16(k1, qf[1], (f32x4){0.f, 0.f, 0.f, 0.f}, 0, 0, 0);
      } else {
        f32x4 t = __builtin_amdgcn_mfma_f32_16x16x32_bf16(k0, qf[0], (f32x4){0.f, 0.f, 0.f, 0.f}, 0, 0, 0);
        S[0][kt] = __builtin_amdgcn_mfma_f32_16x16x32_bf16(k1, qf[1], t, 0, 0, 0);
      }
    }
    bf16x8 pf[NC][2];
#pragma unroll
    for (int c = 0; c < NC; ++c) {
      float mx = -1e30f;
#pragma unroll
      for (int kt = 0; kt < 4; ++kt)
#pragma unroll
        for (int j = 0; j < 4; ++j) {
          float v = S[c][kt][j];
          if (masked) { int kpos = kb * 64 + kt * 16 + g * 4 + j; int dd = kpos - qpos; if (dd > 128 || dd < -128) v = -3e38f; S[c][kt][j] = v; }
          mx = fmaxf(mx, v);
        }
      mx *= sc;
      mx = fmaxf(mx, __shfl_xor(mx, 16)); mx = fmaxf(mx, __shfl_xor(mx, 32));
      const float mn = fmaxf(m[c], mx);
      const bool grow = mn > m[c];
      float ps = 0.f;
      unsigned pk[8];
#pragma unroll
      for (int kt = 0; kt < 4; ++kt) {
        float e0 = __builtin_amdgcn_exp2f(fmaf(S[c][kt][0], sc, -mn)), e1 = __builtin_amdgcn_exp2f(fmaf(S[c][kt][1], sc, -mn));
        float e2 = __builtin_amdgcn_exp2f(fmaf(S[c][kt][2], sc, -mn)), e3 = __builtin_amdgcn_exp2f(fmaf(S[c][kt][3], sc, -mn));
        ps += (e0 + e1) + (e2 + e3);
        pk[kt * 2] = pack2(e0, e1); pk[kt * 2 + 1] = pack2(e2, e3);
      }
      if (__builtin_amdgcn_ballot_w64(grow) != 0ull) {
        const float alpha = __builtin_amdgcn_exp2f(m[c] - mn);
        m[c] = mn;
        lsum[c] *= alpha;
#pragma unroll
        for (int dt = 0; dt < 4; ++dt) { O[c][dt][0] *= alpha; O[c][dt][1] *= alpha; O[c][dt][2] *= alpha; O[c][dt][3] *= alpha; }
      }
      lsum[c] += ps;
      union { unsigned u[4]; bf16x8 v; } cv;
      cv.u[0] = pk[0]; cv.u[1] = pk[1]; cv.u[2] = pk[2]; cv.u[3] = pk[3]; pf[c][0] = cv.v;
      cv.u[0] = pk[4]; cv.u[1] = pk[5]; cv.u[2] = pk[6]; cv.u[3] = pk[7]; pf[c][1] = cv.v;
    }
#pragma unroll
    for (int dt = 0; dt < 4; ++dt)
#pragma unroll
      for (int s2 = 0; s2 < 2; ++s2) {
        union { uint2 u[2]; bf16x8 v; } vf;
        vf.u[0] = *(const uint2*)(Vt + (dt * 16 + r16) * 144 + (2 * s2) * 32 + g * 8);
        vf.u[1] = *(const uint2*)(Vt + (dt * 16 + r16) * 144 + (2 * s2 + 1) * 32 + g * 8);
#pragma unroll
        for (int c = 0; c < NC; ++c) O[c][dt] = __builtin_amdgcn_mfma_f32_16x16x32_bf16(vf.v, pf[c][s2], O[c][dt], 0, 0, 0);
      }
    if (i + 1 < nblk) AT_SSTORE((i + 1) & 1, rkA, rvA);
    rkA = rkB; rvA = rvB;
    if (i + 3 < nblk) AT_GLOAD(i + 3, rkB, rvB);
    lds_barrier();
  }
  float linv[NC];
#pragma unroll
  for (int c = 0; c < NC; ++c) { float t = lsum[c]; t += __shfl_xor(t, 16); t += __shfl_xor(t, 32); linv[c] = 1.f / t; }
  const size_t orow = (size_t)(qrow0 + wid * 16 + r16);
  if (!DIFF) {
    bf16_t* Y = (bf16_t*)(p.ws + R_YSW);
#pragma unroll
    for (int dt = 0; dt < 4; ++dt) {
      uint2 o; o.x = pack2(O[0][dt][0] * linv[0], O[0][dt][1] * linv[0]); o.y = pack2(O[0][dt][2] * linv[0], O[0][dt][3] * linv[0]);
      *(uint2*)(Y + orow * 256 + h * 64 + dt * 16 + g * 4) = o;
    }
  } else {
    const float lam_init = 0.8f - 0.6f * __expf(-0.3f * (float)l);
    float d1 = 0.f, d2 = 0.f;
    if (lane < 32) { d1 = p.in[28][l * 32 + lane] * p.in[29][l * 32 + lane]; d2 = p.in[30][l * 32 + lane] * p.in[31][l * 32 + lane]; }
    d1 = wave_sum(d1); d2 = wave_sum(d2);
    const float lam = expf(d1) - expf(d2) + lam_init;
    float ov[4][4]; float ss = 0.f;
#pragma unroll
    for (int dt = 0; dt < 4; ++dt)
#pragma unroll
      for (int j = 0; j < 4; ++j) { float v = O[0][dt][j] * linv[0] - lam * O[NC - 1][dt][j] * linv[NC - 1]; ov[dt][j] = v; ss += v * v; }
    ss += __shfl_xor(ss, 16); ss += __shfl_xor(ss, 32);
    const float rms = rsqrtf(ss * (1.f / 64.f) + 1e-5f) * (1.f - lam_init);
    const float* sg = p.in[32] + l * 64;
    bf16_t* Y = (bf16_t*)(p.ws + R_YDF);
#pragma unroll
    for (int dt = 0; dt < 4; ++dt) {
      const int d0 = dt * 16 + g * 4;
      uint2 o; o.x = pack2(ov[dt][0] * rms * sg[d0], ov[dt][1] * rms * sg[d0 + 1]); o.y = pack2(ov[dt][2] * rms * sg[d0 + 2], ov[dt][3] * rms * sg[d0 + 3]);
      *(uint2*)(Y + orow * 256 + h * 64 + d0) = o;
    }
  }
}

DI void ph_attn(const Params& p, int l, char* smem) {
  const bool need_ctx = (l == 0);
  const int n_sw = 1024 + (need_ctx ? 64 : 0);
  const int n_df = 1024 + (need_ctx ? 64 : 0);
  unsigned* ctr = (unsigned*)(p.ws + MISC_BAR + 64 + 64 * l);
  volatile int* slot = (volatile int*)(smem + 40960);
  for (;;) {
    __syncthreads();
    if (my_tid() == 0) *slot = (int)__hip_atomic_fetch_add(ctr, 1u, __ATOMIC_RELAXED, __HIP_MEMORY_SCOPE_AGENT);
    __syncthreads();
    const int u = *slot;
    if (u >= n_sw + n_df) break;
    if (u < n_df) {
      if (u < 1024) { int b = u >> 7, h = (u >> 5) & 3, n = u & 31; attn_unit<true>(p, l, b, h, b * SL + n * 128, n * 128, 0, 64, 64, smem); }
      else { int v = u - 1024; int b = v >> 3, h = (v >> 1) & 3, n = v & 1; attn_unit<true>(p, l, b, h, ML + b * CL + n * 128, 0, 0, 0, 64, smem); }
    } else {
      int w = u - n_df;
      if (w < 1024) {
        int b = w >> 7, h = (w >> 5) & 3, n = w & 31;
        int lo = (n - 1) * 2; if (lo < 0) lo = 0; int hi = (n + 2) * 2; if (hi > 64) hi = 64;
        attn_unit<false>(p, l, b, h, b * SL + n * 128, n * 128, lo, hi, 64, smem);
      } else { int v = w - 1024; int b = v >> 3, h = (v >> 1) & 3, n = v & 1; attn_unit<false>(p, l, b, h, ML + b * CL + n * 128, 0, 0, 0, 64, smem); }
    }
  }
}

DI void ph_rwout(const Params& p, int l) {
  const int lane = my_tid() & 63, wid = my_tid() >> 6;
  const bf16_t* S = (const bf16_t*)(p.ws + R_STR); const bf16_t* Gs = (const bf16_t*)(p.ws + R_G);
  const bf16_t* OF = (const bf16_t*)(p.ws + R_OF); const bf16_t* OB = (const bf16_t*)(p.ws + R_OB);
  bf16_t* Y = (bf16_t*)(p.ws + R_YRW);
  const size_t SU = (size_t)MT * 256;
  const float4 rk = *(const float4*)(p.in[25] + (size_t)l * 256 + lane * 4);
  const float4 gam = *(const float4*)(p.in[26] + (size_t)l * 256 + lane * 4);
  const float4 bet = *(const float4*)(p.in[27] + (size_t)l * 256 + lane * 4);
  const int nrows = (l == 0) ? MT : ML;
  for (int row = blockIdx.x * 8 + wid; row < nrows; row += gridDim.x * 8) {
    const size_t o = (size_t)row * 256 + lane * 4;
    uint2 ur = *(const uint2*)(S + o), uk = *(const uint2*)(S + SU + o), uv = *(const uint2*)(S + 2 * SU + o);
    uint2 uf = *(const uint2*)(OF + o), ub = *(const uint2*)(OB + o), ugf = *(const uint2*)(Gs + o), ugb = *(const uint2*)(Gs + SU + o);
    float r[4] = {bflo(ur.x), bfhi(ur.x), bflo(ur.y), bfhi(ur.y)};
    float k[4] = {bflo(uk.x), bfhi(uk.x), bflo(uk.y), bfhi(uk.y)};
    float v[4] = {bflo(uv.x), bfhi(uv.x), bflo(uv.y), bfhi(uv.y)};
    float f[4] = {bflo(uf.x), bfhi(uf.x), bflo(uf.y), bfhi(uf.y)};
    float bb[4] = {bflo(ub.x), bfhi(ub.x), bflo(ub.y), bfhi(ub.y)};
    float gf[4] = {bflo(ugf.x), bfhi(ugf.x), bflo(ugf.y), bfhi(ugf.y)};
    float gb[4] = {bflo(ugb.x), bfhi(ugb.x), bflo(ugb.y), bfhi(ugb.y)};
    const float rkv[4] = {rk.x, rk.y, rk.z, rk.w}; const float ga[4] = {gam.x, gam.y, gam.z, gam.w}; const float be[4] = {bet.x, bet.y, bet.z, bet.w};
    float bon = 0.f, sf = 0.f, sb = 0.f;
#pragma unroll
    for (int i = 0; i < 4; ++i) { bon += r[i] * k[i] * rkv[i]; sf += f[i]; sb += bb[i]; }
    bon = sum16(bon); float muf = sum16(sf) * (1.f / 64.f), mub = sum16(sb) * (1.f / 64.f);
    float qf = 0.f, qb = 0.f;
#pragma unroll
    for (int i = 0; i < 4; ++i) { f[i] -= muf; bb[i] -= mub; qf += f[i] * f[i]; qb += bb[i] * bb[i]; }
    float rsf = rsqrtf(sum16(qf) * (1.f / 64.f) + 64e-5f), rsb = rsqrtf(sum16(qb) * (1.f / 64.f) + 64e-5f);
    float y[4];
#pragma unroll
    for (int i = 0; i < 4; ++i) {
      float bn = bon * v[i];
      y[i] = (f[i] * rsf * ga[i] + be[i] + bn) * gf[i] + (bb[i] * rsb * ga[i] + be[i] + bn) * gb[i];
    }
    uint2 oo; oo.x = pack2(y[0], y[1]); oo.y = pack2(y[2], y[3]);
    *(uint2*)(Y + o) = oo;
  }
}

DI void ph_merge(const Params& p, int l, const bf16_t* U, char* smem) {
  const int lane = my_tid() & 63, wid = my_tid() >> 6, wm = wid >> 1, wn = wid & 1, g = lane >> 4, r16 = lane & 15;
  const int mtiles = (l == 0) ? 136 : 128;
  bf16_t* ACC = (bf16_t*)(p.ws + R_ACC);
  for (int it = 0;; ++it) {
    int mtile, ntile;
    if (!next_tile(it, mtiles, 8, mtile, ntile)) break;
    uint2 accS[4][4];
#pragma unroll
    for (int mt = 0; mt < 4; ++mt)
#pragma unroll
      for (int nt = 0; nt < 4; ++nt) accS[mt][nt] = make_uint2(0u, 0u);
    for (int j = 0; j < 4; ++j) {
      uint2 pb[4][4];
      {
        f32x4 accB[4][4]; zero_acc<4>(accB);
        const size_t yoff = (j == 0) ? R_YHY : (j == 1) ? R_YSW : (j == 2) ? R_YRW : R_YDF;
        gemm_glds(accB, (const bf16_t*)(p.ws + yoff), 256, RowPlain{(long)mtile * 256}, (const bf16_t*)(p.ws + WB_BR) + ((size_t)j * 1024 + ntile * 128) * 256, 256, 256, smem, (const bf16_t*)(p.ws + MISC_ZERO));
#pragma unroll
        for (int mt = 0; mt < 4; ++mt)
#pragma unroll
          for (int nt = 0; nt < 4; ++nt) { pb[mt][nt].x = pack2(accB[mt][nt][0], accB[mt][nt][1]); pb[mt][nt].y = pack2(accB[mt][nt][2], accB[mt][nt][3]); }
      }
      f32x4 accG[4][4]; zero_acc<4>(accG);
      gemm_glds(accG, U, 1024, RowPlain{(long)mtile * 256}, (const bf16_t*)(p.ws + WB_GATE) + ((size_t)j * 1024 + ntile * 128) * 1024, 1024, 1024, smem, (const bf16_t*)(p.ws + MISC_ZERO));
#pragma unroll
      for (int mt = 0; mt < 4; ++mt)
#pragma unroll
        for (int nt = 0; nt < 4; ++nt) {
          float v0 = bflo(accS[mt][nt].x) + sigmoidf_(accG[mt][nt][0]) * bflo(pb[mt][nt].x);
          float v1 = bfhi(accS[mt][nt].x) + sigmoidf_(accG[mt][nt][1]) * bfhi(pb[mt][nt].x);
          float v2 = bflo(accS[mt][nt].y) + sigmoidf_(accG[mt][nt][2]) * bflo(pb[mt][nt].y);
          float v3 = bfhi(accS[mt][nt].y) + sigmoidf_(accG[mt][nt][3]) * bfhi(pb[mt][nt].y);
          accS[mt][nt].x = pack2(v0, v1); accS[mt][nt].y = pack2(v2, v3);
        }
    }
#pragma unroll
    for (int mt = 0; mt < 4; ++mt) {
      const int col = ntile * 128 + wn * 64 + r16 * 4;
      const size_t row = (size_t)mtile * 256 + wm * 64 + mt * 16 + g * 4;
      uint2 o;
      o.x = (accS[mt][0].x & 0xffffu) | (accS[mt][1].x << 16); o.y = (accS[mt][2].x & 0xffffu) | (accS[mt][3].x << 16);
      *(uint2*)(ACC + (row + 0) * 1024 + col) = o;
      o.x = (accS[mt][0].x >> 16) | (accS[mt][1].x & 0xffff0000u); o.y = (accS[mt][2].x >> 16) | (accS[mt][3].x & 0xffff0000u);
      *(uint2*)(ACC + (row + 1) * 1024 + col) = o;
      o.x = (accS[mt][0].y & 0xffffu) | (accS[mt][1].y << 16); o.y = (accS[mt][2].y & 0xffffu) | (accS[mt][3].y << 16);
      *(uint2*)(ACC + (row + 2) * 1024 + col) = o;
      o.x = (accS[mt][0].y >> 16) | (accS[mt][1].y & 0xffff0000u); o.y = (accS[mt][2].y >> 16) | (accS[mt][3].y & 0xffff0000u);
      *(uint2*)(ACC + (row + 3) * 1024 + col) = o;
    }
  }
}

DI void ph_resgemm(const Params& p, int l, const bf16_t* A, int K, const bf16_t* Bt, const float* hsrc_lat, const float* hsrc_ctx, int gate_off, char* smem) {
  const int lane = my_tid() & 63, wid = my_tid() >> 6, wm = wid >> 1, wn = wid & 1, g = lane >> 4, r16 = lane & 15;
  const int mtiles = (l == 0) ? 136 : 128;
  const float* mod = (const float*)(p.ws + MISC_MOD) + (size_t)l * 9 * 6144;
  float* hc = (float*)(p.ws + OFF_HC);
  for (int it = 0;; ++it) {
    int mtile, ntile;
    if (!next_tile(it, mtiles, 8, mtile, ntile)) break;
    f32x4 acc[4][4]; zero_acc<4>(acc);
    gemm_glds(acc, A, K, RowPlain{(long)mtile * 256}, Bt + (size_t)ntile * 128 * K, K, K, smem, (const bf16_t*)(p.ws + MISC_ZERO));
    const int b = mtile < 128 ? (mtile >> 4) : 8;
    const float* gt = mod + (size_t)b * 6144 + gate_off;
    const int col = ntile * 128 + wn * 64 + r16 * 4;
    const float4 gv = *(const float4*)(gt + col);
#pragma unroll
    for (int mt = 0; mt < 4; ++mt)
#pragma unroll
      for (int e = 0; e < 4; ++e) {
        const int row = mtile * 256 + wm * 64 + mt * 16 + g * 4 + e;
        const float* hs; float* hd;
        if (row < ML) { size_t o = (size_t)row * D + col; hs = hsrc_lat + o; hd = p.out + o; }
        else { size_t o = (size_t)(row - ML) * D + col; hs = hsrc_ctx + o; hd = hc + o; }
        const float4 h = *(const float4*)hs;
        float4 r;
        r.x = DN_ALPHA * h.x + gv.x * acc[mt][0][e]; r.y = DN_ALPHA * h.y + gv.y * acc[mt][1][e];
        r.z = DN_ALPHA * h.z + gv.z * acc[mt][2][e]; r.w = DN_ALPHA * h.w + gv.w * acc[mt][3][e];
        *(float4*)hd = r;
      }
  }
}

DI void ph_ffnup(const Params& p, int l, char* smem) {
  const bf16_t* U = (const bf16_t*)(p.ws + R_U);
  const bf16_t* Bt = (const bf16_t*)(p.ws + WB_UP);
  bf16_t* HID = (bf16_t*)(p.ws + R_HID);
  const float* cw = p.in[38] + (size_t)l * 3 * 5632; const float* cb = p.in[39] + (size_t)l * 5632;
  const int tid = my_tid(), lane = tid & 63, wid = tid >> 6, wm = wid >> 2, wn = wid & 3, g = lane >> 4, r16 = lane & 15;
  const int mtiles = (l == 0) ? 144 : 136;
  constexpr int TS = 528;
  for (int it = 0;; ++it) {
    int mtile, ntile;
    if (!next_tile(it, mtiles, 22, mtile, ntile)) break;
    long rowbase; int t0, len, r0, r1;
    if (mtile < 136) { int b = mtile / 17; int tt = mtile % 17; len = SL; rowbase = (long)b * SL; t0 = tt * 254 - 1; r0 = 1; r1 = 254; }
    else { int b = mtile - 136; len = CL; rowbase = (long)ML + b * CL; t0 = 0; r0 = 0; r1 = 255; }
    f32x4 acc[8][4]; zero_acc256(acc);
    gemm_glds256(acc, U, 1024, rowbase + t0, Bt + (size_t)ntile * 256 * 1024, 1024, 1024, smem);
#pragma unroll
    for (int mt = 0; mt < 8; ++mt)
#pragma unroll
      for (int e = 0; e < 4; ++e) {
        uint2 o; o.x = pack2(acc[mt][0][e], acc[mt][1][e]); o.y = pack2(acc[mt][2][e], acc[mt][3][e]);
        *(uint2*)(smem + (wm * 128 + mt * 16 + g * 4 + e) * TS + (wn * 64 + r16 * 4) * 2) = o;
      }
    __syncthreads();
    {
      const int ch = tid & 127, rgp = tid >> 7; const int ca = ntile * 128 + ch, cbx = 2816 + ca;
      const float a0 = cw[ca], a1 = cw[5632 + ca], a2 = cw[2 * 5632 + ca], ab = cb[ca];
      const float b0 = cw[cbx], b1 = cw[5632 + cbx], b2 = cw[2 * 5632 + cbx], bb = cb[cbx];
      for (int r = r0 + rgp; r <= r1; r += 4) {
        const int tok = t0 + r;
        if (tok < len) {
          const char* Tr = smem + r * TS + ch * 2;
          const float pa = tok >= 1 ? bf2f(*(const bf16_t*)(Tr - TS)) : 0.f, pb_ = tok >= 1 ? bf2f(*(const bf16_t*)(Tr - TS + 256)) : 0.f;
          const float na = tok + 1 < len ? bf2f(*(const bf16_t*)(Tr + TS)) : 0.f, nb = tok + 1 < len ? bf2f(*(const bf16_t*)(Tr + TS + 256)) : 0.f;
          const float av = a0 * pa + a1 * bf2f(*(const bf16_t*)(Tr)) + a2 * na + ab;
          const float bv = b0 * pb_ + b1 * bf2f(*(const bf16_t*)(Tr + 256)) + b2 * nb + bb;
          HID[(size_t)(rowbase + tok) * 2816 + ca] = (bf16_t)f2bf(siluf_(av) * bv);
        }
      }
    }
  }
}

#ifndef REP_PREP
#define REP_PREP 1
#endif
#ifndef REP_GEMM
#define REP_GEMM 1
#endif
#ifndef REP_HY
#define REP_HY 1
#endif
#ifndef REP_RWP
#define REP_RWP 1
#endif
#ifndef REP_SCAN
#define REP_SCAN 1
#endif
#ifndef REP_ATTN
#define REP_ATTN 1
#endif
#ifndef PH_END
#define PH_END 24
#endif
#define XB_TMO      128
#define XB_XCNT(j)  (256  + 64 * (j))
#define XB_XSUB(j)  (1280 + 64 * (j))
#define XB_XGEN(j)  (2304 + 64 * (j))
#define XB_TOP      3328
#define XB_TOPGEN   3392
#define XCD_BAR_WORDS 3456
#define XB_SPIN_CAP (1u << 22)
DI unsigned xb_ld(unsigned* p) { return __hip_atomic_load(p, __ATOMIC_RELAXED, __HIP_MEMORY_SCOPE_AGENT); }
DI unsigned xb_add(unsigned* p, unsigned v) { return __hip_atomic_fetch_add(p, v, __ATOMIC_RELAXED, __HIP_MEMORY_SCOPE_AGENT); }
DI unsigned xb_xcc_id() { return (unsigned)__builtin_amdgcn_s_getreg((3 << 11) | 20) & 0xFu; }
#define XB_SPIN(cond, bar) do { unsigned _sp = 0; while (cond) { __builtin_amdgcn_s_sleep(1); \
    if ((++_sp & 255u) == 0u) { if (xb_ld(&(bar)[XB_TMO])) break; if (_sp > XB_SPIN_CAP) { atomicAdd(&(bar)[XB_TMO], 1u); break; } } } } while (0)
DI void xcd_barrier_complete(unsigned* bar, unsigned x, unsigned& nloc, unsigned& nx) {
  const unsigned G = gridDim.x;
  unsigned sum, cnt, mine, sp = 0u;
  for (;;) {
    sum = 0u; cnt = 0u; mine = 0u;
#pragma unroll
    for (unsigned j = 0; j < 16; ++j) { const unsigned c = xb_ld(&bar[XB_XCNT(j)]); sum += c; cnt += (c > 0u) ? 1u : 0u; mine = (j == x) ? c : mine; }
    if (sum == G) break;
    __builtin_amdgcn_s_sleep(1);
    if ((++sp & 255u) == 0u) { if (xb_ld(&bar[XB_TMO])) break; if (sp > XB_SPIN_CAP) { atomicAdd(&bar[XB_TMO], 1u); break; } }
  }
  nloc = mine > 0u ? mine : 1u; nx = cnt > 0u ? cnt : 1u;
}
DI void grid_barrier(unsigned* bar, volatile unsigned* st) {
  asm volatile("s_waitcnt vmcnt(0)" ::: "memory");
  __syncthreads();
  if (my_tid() == 0) {
    const unsigned x = xb_xcc_id();
    __builtin_amdgcn_s_waitcnt(0);
    unsigned nloc = st[0], nx = st[1];
    if (nloc == 0u) { xcd_barrier_complete(bar, x, nloc, nx); st[0] = nloc; st[1] = nx; }
    const unsigned old = xb_add(&bar[XB_XSUB(x)], 1u);
    const unsigned gen = old / nloc;
    if (old + 1u == (gen + 1u) * nloc) {
      __builtin_amdgcn_fence(__ATOMIC_RELEASE, "agent");
      asm volatile("s_waitcnt vmcnt(0)" ::: "memory");
      const unsigned og = xb_add(&bar[XB_TOP], 1u);
      const unsigned tg = og / nx;
      if (og + 1u == (tg + 1u) * nx) xb_add(&bar[XB_TOPGEN], 1u);
      else XB_SPIN(xb_ld(&bar[XB_TOPGEN]) == tg, bar);
      __builtin_amdgcn_fence(__ATOMIC_ACQUIRE, "agent");
      xb_add(&bar[XB_XGEN(x)], 1u);
      asm volatile("s_waitcnt vmcnt(0)" ::: "memory");
    } else {
      XB_SPIN(xb_ld(&bar[XB_XGEN(x)]) == gen, bar);
      __builtin_amdgcn_fence(__ATOMIC_ACQUIRE, "agent");
      asm volatile("s_waitcnt vmcnt(0)" ::: "memory");
    }
  }
  __syncthreads();
}
#define SYNC_OR_RET(idx) do { if ((idx) + 1 >= PH_END) return; if ((idx) == 0) { grid.sync(); if (my_tid() == 0) (void)xb_add(&((unsigned*)(p.ws + MISC_XBAR))[XB_XCNT(xb_xcc_id())], 1u); } else grid_barrier((unsigned*)(p.ws + MISC_XBAR), (volatile unsigned*)(smem + 144 * 1024)); } while (0)
template <int l>
DI void run_layer(const Params& p, cg::grid_group& grid, char* smem, unsigned& epoch) {
  const float* mod = (const float*)(p.ws + MISC_MOD) + (size_t)l * 9 * 6144;
  float* hc = (float*)(p.ws + OFF_HC);
  const float* hl_src = (l == 0) ? p.in[0] : p.out;
  const float* hc_src = (l == 0) ? p.in[2] : hc;
  constexpr int B0 = l * 12;
  if (l == 0) {
    ph_convert(p, 0, smem);
    ph_ada(p, smem);
    hy_rawfilter(p, 0, SL, (float*)(p.ws + R_RAWF), smem);
    hy_rawfilter(p, 0, CL, (float*)(p.ws + MISC_RAWC), smem);
    SYNC_OR_RET(B0 + 0);
    ph_kf(p, 0, smem);
    ph_ln(hl_src, hc_src, nullptr, nullptr, nullptr, nullptr, (bf16_t*)p.out, mod, 0, MT);
    SYNC_OR_RET(B0 + 1);
  }
  for (int rep = 0; rep < REP_GEMM; ++rep) ph_inproj(p, l == 0 ? (const bf16_t*)p.out : (const bf16_t*)(p.ws + R_U), smem);
  SYNC_OR_RET(B0 + 2);
  for (int rep = 0; rep < REP_HY; ++rep) {
  if (blockIdx.x == 0 && my_tid() == 0) *(unsigned*)(p.ws + MISC_BAR + 64 + 64 * l) = 0u;
  ph_hyena(p, l, smem);
  if (l == 0) ph_hyena_ctx(p, l, smem);
  }
  ph_rope(p, smem);
  for (int rep = 0; rep < REP_RWP; ++rep) ph_rwprep(p, l, smem);
  SYNC_OR_RET(B0 + 3);
  for (int rep = 0; rep < REP_SCAN; ++rep) ph_scan(p, smem);
  for (int rep = 0; rep < REP_ATTN; ++rep) ph_attn(p, l, smem);
  SYNC_OR_RET(B0 + 4);
  ph_rwout(p, l);
  if (l != 0) ph_ln(hl_src, hc_src, nullptr, nullptr, nullptr, nullptr, (bf16_t*)(p.ws + R_URE), mod, 0, ML);
  SYNC_OR_RET(B0 + 5);
  for (int rep = 0; rep < REP_GEMM; ++rep) ph_merge(p, l, l == 0 ? (const bf16_t*)p.out : (const bf16_t*)(p.ws + R_URE), smem);
  SYNC_OR_RET(B0 + 6);
  ph_resgemm(p, l, (const bf16_t*)(p.ws + R_ACC), 1024, (const bf16_t*)(p.ws + WB_OUT), hl_src, hc_src, 2048, smem);
  if (l == 0) hy_rawfilter(p, 1, SL, (float*)(p.ws + R_RAWF), smem);
  SYNC_OR_RET(B0 + 7);
  ph_ln(p.out, hc, p.out, hc, p.in[35] + (size_t)l * D, p.in[36] + (size_t)l * D, (bf16_t*)(p.ws + R_U), mod, 3072, l == 0 ? MT : ML);
  if (l == 0) ph_kf(p, 1, smem);
  SYNC_OR_RET(B0 + 8);
  for (int rep = 0; rep < REP_GEMM; ++rep) ph_ffnup(p, l, smem);
  SYNC_OR_RET(B0 + 9);
  ph_resgemm(p, l, (const bf16_t*)(p.ws + R_HID), 2816, (const bf16_t*)(p.ws + WB_DOWN), p.out, hc, 5120, smem);
  SYNC_OR_RET(B0 + 10);
  if (l == 0) {
    ph_ln(p.out, hc, p.out, hc, p.in[41], p.in[42], (bf16_t*)(p.ws + R_U), mod + 9 * 6144, 0, MT);
    ph_convert(p, 1, smem);
  } else {
    ph_ln(p.out, hc, p.out, hc, p.in[41] + (size_t)l * D, p.in[42] + (size_t)l * D, nullptr, mod, 0, ML);
  }
  SYNC_OR_RET(B0 + 11);
}

__global__ void __launch_bounds__(NTHR) mega(Params p) {
  extern __shared__ __attribute__((aligned(16))) char smem[];
  cg::grid_group grid = cg::this_grid();
  unsigned epoch = 0;
  if (blockIdx.x == 0) for (int i = my_tid(); i < XCD_BAR_WORDS; i += NTHR) ((unsigned*)(p.ws + MISC_XBAR))[i] = 0u;
  if (my_tid() < 2) ((volatile unsigned*)(smem + 144 * 1024))[my_tid()] = 0u;
  if (blockIdx.x == 0 && my_tid() < 64) *(unsigned*)(p.ws + MISC_ZERO + my_tid() * 4) = 0u;
  run_layer<0>(p, grid, smem, epoch);
  if (PH_END > 12) run_layer<1>(p, grid, smem, epoch);
}

extern "C" void kernel_launch(void* const* d_in, const int* in_sizes, int n_in, void* d_out, int out_size,
                              void* d_ws, size_t ws_size, hipStream_t stream) {
  static int grid_blocks = 0;
  if (!grid_blocks) {
    int dev = 0, cus = 0, per_cu = 0;
    (void)hipGetDevice(&dev);
    (void)hipDeviceGetAttribute(&cus, hipDeviceAttributeMultiprocessorCount, dev);
    (void)hipFuncSetAttribute((const void*)mega, hipFuncAttributeMaxDynamicSharedMemorySize, SMEM_BYTES);
    (void)hipOccupancyMaxActiveBlocksPerMultiprocessor(&per_cu, mega, NTHR, SMEM_BYTES);
    if (per_cu < 1) per_cu = 1;
    if (per_cu > 1) per_cu = 1;
    grid_blocks = cus * per_cu;
  }
  Params p{};
  for (int i = 0; i < 43; ++i) p.in[i] = (const float*)d_in[i];
  p.out = (float*)d_out; p.ws = (char*)d_ws;
  void* args[] = {&p};
  hipError_t e = hipLaunchCooperativeKernel((void*)mega, dim3(grid_blocks), dim3(NTHR), args, SMEM_BYTES, stream);
  if (e != hipSuccess) fprintf(stderr, "cooperative launch failed: %s (grid %d)\n", hipGetErrorString(e), grid_blocks);
}
```

```cpp
#include <hip/hip_runtime.h>
#include <hip/hip_cooperative_groups.h>
#include <cstdio>
#include <cstdint>
namespace cg = cooperative_groups;

#define DI __device__ __forceinline__
typedef unsigned short bf16_t;
typedef short bf16x8 __attribute__((ext_vector_type(8)));
typedef float f32x4 __attribute__((ext_vector_type(4)));

constexpr int D = 1024, NB = 8, SL = 4096, CL = 256;
constexpr int ML = NB * SL, MC = NB * CL, MT = ML + MC;
constexpr int KEYS = SL + CL;
constexpr int NTHR = 512;
constexpr float DN_ALPHA = 1.41421356237f;
constexpr size_t UNIT = (size_t)MT * 512;

constexpr size_t WB_IN = 0;
constexpr size_t WB_GATE = WB_IN + (size_t)3328 * 1024 * 2;
constexpr size_t WB_BR = WB_GATE + (size_t)4096 * 1024 * 2;
constexpr size_t WB_OUT = WB_BR + (size_t)4 * 1024 * 256 * 2;
constexpr size_t WB_UP = WB_OUT + (size_t)1024 * 1024 * 2;
constexpr size_t WB_DOWN = WB_UP + (size_t)5632 * 1024 * 2;
constexpr size_t WB_END = WB_DOWN + (size_t)1024 * 2816 * 2;
constexpr size_t OFF_KF = WB_END;
constexpr size_t OFF_HC = OFF_KF + (size_t)512 * 8192 * 8;
constexpr size_t OFF_MISC = OFF_HC + (size_t)MC * D * 4;
constexpr size_t MISC_MOD = OFF_MISC;
constexpr size_t MISC_TW = MISC_MOD + (size_t)2 * 9 * 6144 * 4;
constexpr size_t MISC_RAWC = MISC_TW + 4096 * 8;
constexpr size_t MISC_GCTX = MISC_RAWC + (size_t)256 * 1024 * 4;
constexpr size_t MISC_RWW = MISC_GCTX + (size_t)512 * 512 * 4;
constexpr size_t RWW_F = MISC_RWW, RWW_B = RWW_F + 256 * 64 * 2, RWW_A = RWW_B + 256 * 64 * 2, RWW_GF = RWW_A + 256 * 64 * 2, RWW_GB = RWW_GF + 256 * 128 * 2;
constexpr size_t MISC_XBAR = OFF_MISC + (size_t)3 * 1024 * 1024;
constexpr size_t OFF_R = OFF_MISC + (size_t)4 * 1024 * 1024;
constexpr size_t MISC_BAR = OFF_R - 256;
constexpr size_t MISC_ZERO = OFF_R - 512;
static_assert(RWW_GB + 256 * 128 * 2 <= MISC_ZERO, "misc overflow");
constexpr size_t R_YHY = OFF_R, R_YSW = OFF_R + UNIT, R_YDF = OFF_R + 2 * UNIT;
constexpr size_t R_PHY = OFF_R + 3 * UNIT;
constexpr size_t R_PSW = OFF_R + 6 * UNIT;
constexpr size_t R_VTSW = R_PSW + (size_t)MT * 384 * 2;
constexpr size_t R_PDF = OFF_R + 8 * UNIT;
constexpr size_t R_VTDF = OFF_R + 10 * UNIT;
constexpr size_t R_PRW = OFF_R + 11 * UNIT;
constexpr size_t R_STR = R_PRW + (size_t)MT * 1216 * 2;
constexpr size_t R_G = R_STR + 7 * UNIT;
constexpr size_t R_END = R_G + 2 * UNIT;
constexpr size_t R_RAWF = OFF_R;
constexpr size_t R_OF = R_PHY, R_OB = R_PHY + UNIT;
constexpr size_t R_URE = R_PSW;
constexpr size_t R_YRW = R_VTDF;
constexpr size_t R_ACC = R_PRW;
constexpr size_t R_U = R_STR;
constexpr size_t R_HID = OFF_R;
static_assert(R_END <= (size_t)512 * 1024 * 1024, "ws overflow");
static_assert((size_t)MT * 2816 * 2 <= 11 * UNIT, "hid");

constexpr int SMEM_BYTES = 144 * 1024 + 64;

struct Params {
  const float* in[43];
  float* out;
  char* ws;
};

DI int my_tid() { int t = (int)__builtin_amdgcn_workitem_id_x(); asm volatile("" : "+v"(t)); return t; }
DI unsigned f2bf(float f) { unsigned u = __float_as_uint(f); u += 0x7fffu + ((u >> 16) & 1u); return u >> 16; }
DI float bf2f(unsigned h) { return __uint_as_float(h << 16); }
typedef __bf16 bf16v2_t __attribute__((ext_vector_type(2)));
typedef float f32v2_t __attribute__((ext_vector_type(2)));
DI unsigned pack2(float lo, float hi) { f32v2_t v = {lo, hi}; bf16v2_t b = __builtin_convertvector(v, bf16v2_t); return __builtin_bit_cast(unsigned, b); }

DI float bflo(unsigned w) { return __uint_as_float(w << 16); }
DI float bfhi(unsigned w) { return __uint_as_float(w & 0xffff0000u); }
DI float sigmoidf_(float x) { return __builtin_amdgcn_rcpf(1.f + __expf(-x)); }
DI float siluf_(float x) { return x * __builtin_amdgcn_rcpf(1.f + __expf(-x)); }
DI float wave_sum(float v) {
#pragma unroll
  for (int o = 32; o >= 1; o >>= 1) v += __shfl_xor(v, o);
  return v;
}
template <int CTRL> DI float dpp_mov(float v) {
  return __int_as_float(__builtin_amdgcn_update_dpp(0, __float_as_int(v), CTRL, 0xf, 0xf, false));
}
DI float sum16(float v) {
  v += dpp_mov<0xB1>(v);
  v += dpp_mov<0x4E>(v);
  v += dpp_mov<0x141>(v);
  v += dpp_mov<0x140>(v);
  return v;
}
DI void lds_barrier() { asm volatile("s_waitcnt lgkmcnt(0)" ::: "memory"); __builtin_amdgcn_s_barrier(); asm volatile("" ::: "memory"); }
DI uint4 sel4(bool z, uint4 v) { return make_uint4(z ? 0u : v.x, z ? 0u : v.y, z ? 0u : v.z, z ? 0u : v.w); }
DI int mod_idx(int row) { return row < ML ? (row >> 12) : 8; }

template <int NTW, bool DEEP, class RowFn>
DI void gemm_main(f32x4 (&acc)[4][NTW], const bf16_t* __restrict__ A, int lda, RowFn rowfn,
                  const bf16_t* __restrict__ Bt, int ldb, int K, char* smem) {
  constexpr int BN = NTW * 32;
  constexpr int A_BYTES = 256 * 128, B_BYTES = BN * 128, STAGE = A_BYTES + B_BYTES;
  constexpr int NBL = BN / 64;
  const int tid = my_tid(), lane = tid & 63, wid = tid >> 6, wm = wid >> 1, wn = wid & 1, g = lane >> 4, r16 = lane & 15;
  const int chunk = tid & 7, lrow = tid >> 3;
  long a0 = rowfn(lrow), a1 = rowfn(lrow + 64), a2 = rowfn(lrow + 128), a3 = rowfn(lrow + 192);
  const long c0 = a0 < 0 ? 0 : a0, c1 = a1 < 0 ? 0 : a1, c2 = a2 < 0 ? 0 : a2, c3 = a3 < 0 ? 0 : a3;
  const bf16_t* Bp = Bt + (long)lrow * ldb + chunk * 8;
  const bf16_t* Ap0 = A + c0 * lda + chunk * 8; const bf16_t* Ap1 = A + c1 * lda + chunk * 8;
  const bf16_t* Ap2 = A + c2 * lda + chunk * 8; const bf16_t* Ap3 = A + c3 * lda + chunk * 8;
  struct Regs { uint4 a0, a1, a2, a3, b0, b1; };
  Regs R0, R1;
  R0.b1 = make_uint4(0, 0, 0, 0); R1.b1 = make_uint4(0, 0, 0, 0);
  auto GLOAD = [&](Regs& R, int k0) {
    R.a0 = *(const uint4*)(Ap0 + k0); R.a1 = *(const uint4*)(Ap1 + k0);
    R.a2 = *(const uint4*)(Ap2 + k0); R.a3 = *(const uint4*)(Ap3 + k0);
    R.b0 = *(const uint4*)(Bp + k0);
    if constexpr (NBL > 1) R.b1 = *(const uint4*)(Bp + (long)64 * ldb + k0);
  };
  auto SSTORE = [&](const Regs& R, int st) {
    char* base = smem + st * STAGE + lrow * 128 + ((chunk ^ (lrow & 7)) << 4);
    *(uint4*)(base) = sel4(a0 < 0, R.a0); *(uint4*)(base + 64 * 128) = sel4(a1 < 0, R.a1);
    *(uint4*)(base + 128 * 128) = sel4(a2 < 0, R.a2); *(uint4*)(base + 192 * 128) = sel4(a3 < 0, R.a3);
    *(uint4*)(base + A_BYTES) = R.b0;
    if constexpr (NBL > 1) *(uint4*)(base + A_BYTES + 64 * 128) = R.b1;
  };
  auto COMPUTE = [&](int st) {
    const char* As = smem + st * STAGE + (wm * 64 + r16) * 128;
    const char* Bs = smem + st * STAGE + A_BYTES + (wn * (NTW * 16) + r16) * 128;
#pragma unroll
    for (int kk = 0; kk < 2; ++kk) {
      const int sw = ((kk * 4 + g) ^ (r16 & 7)) << 4;
      bf16x8 af[4], bfr[NTW];
#pragma unroll
      for (int mt = 0; mt < 4; ++mt) af[mt] = *(const bf16x8*)(As + mt * 16 * 128 + sw);
#pragma unroll
      for (int nt = 0; nt < NTW; ++nt) bfr[nt] = *(const bf16x8*)(Bs + nt * 16 * 128 + sw);
#pragma unroll
      for (int mt = 0; mt < 4; ++mt)
#pragma unroll
        for (int nt = 0; nt < NTW; ++nt)
          acc[mt][nt] = __builtin_amdgcn_mfma_f32_16x16x32_bf16(af[mt], bfr[nt], acc[mt][nt], 0, 0, 0);
    }
  };
  const int nk = K >> 6;
  __syncthreads();
  GLOAD(R0, 0);
  SSTORE(R0, 0);
  if constexpr (DEEP) {
    GLOAD(R0, 64);
    if (nk > 2) GLOAD(R1, 128);
    lds_barrier();
    bf16x8 fa0[4], fb0[NTW], fa1[4], fb1[NTW];
    auto READF = [&](bf16x8 (&fa)[4], bf16x8 (&fb)[NTW], int st, int kk) {
      const int sw = ((kk * 4 + g) ^ (r16 & 7)) << 4;
      const char* As = smem + st * STAGE + (wm * 64 + r16) * 128 + sw;
      const char* Bs = smem + st * STAGE + A_BYTES + (wn * (NTW * 16) + r16) * 128 + sw;
#pragma unroll
      for (int mt = 0; mt < 4; ++mt) fa[mt] = *(const bf16x8*)(As + mt * 16 * 128);
#pragma unroll
      for (int nt = 0; nt < NTW; ++nt) fb[nt] = *(const bf16x8*)(Bs + nt * 16 * 128);
    };
    auto MMA = [&](const bf16x8 (&fa)[4], const bf16x8 (&fb)[NTW]) {
#pragma unroll
      for (int mt = 0; mt < 4; ++mt)
#pragma unroll
        for (int nt = 0; nt < NTW; ++nt)
          acc[mt][nt] = __builtin_amdgcn_mfma_f32_16x16x32_bf16(fa[mt], fb[nt], acc[mt][nt], 0, 0, 0);
    };
    READF(fa0, fb0, 0, 0);
    for (int kt = 0; kt < nk; kt += 2) {
      READF(fa1, fb1, 0, 1);
      MMA(fa0, fb0);
#pragma unroll
      for (int i = 0; i < 4 + NTW; ++i) { __builtin_amdgcn_sched_group_barrier(0x100, 1, 0); __builtin_amdgcn_sched_group_barrier(0x008, 2, 0); }
      __builtin_amdgcn_sched_barrier(0);
      SSTORE(R0, 1);
      if (kt + 3 < nk) GLOAD(R0, (kt + 3) * 64);
      MMA(fa1, fb1);
#pragma unroll
      for (int i = 0; i < 6; ++i) { __builtin_amdgcn_sched_group_barrier(0x200, 1, 0); __builtin_amdgcn_sched_group_barrier(0x020, 1, 0); __builtin_amdgcn_sched_group_barrier(0x008, 2, 0); }
      __builtin_amdgcn_sched_barrier(0);
      lds_barrier();
      READF(fa0, fb0, 1, 0);
      READF(fa1, fb1, 1, 1);
      MMA(fa0, fb0);
#pragma unroll
      for (int i = 0; i < 4 + NTW; ++i) { __builtin_amdgcn_sched_group_barrier(0x100, 1, 0); __builtin_amdgcn_sched_group_barrier(0x008, 2, 0); }
      __builtin_amdgcn_sched_barrier(0);
      if (kt + 2 < nk) SSTORE(R1, 0);
      if (kt + 4 < nk) GLOAD(R1, (kt + 4) * 64);
      MMA(fa1, fb1);
#pragma unroll
      for (int i = 0; i < 6; ++i) { __builtin_amdgcn_sched_group_barrier(0x200, 1, 0); __builtin_amdgcn_sched_group_barrier(0x020, 1, 0); __builtin_amdgcn_sched_group_barrier(0x008, 2, 0); }
      __builtin_amdgcn_sched_barrier(0);
      lds_barrier();
      if (kt + 2 < nk) READF(fa0, fb0, 0, 0);
    }
  } else {
    lds_barrier();
    for (int kt = 0; kt < nk; ++kt) {
      const int st = kt & 1;
      if (kt + 1 < nk) GLOAD(R0, (kt + 1) * 64);
      __builtin_amdgcn_sched_barrier(0);
      COMPUTE(st);
      __builtin_amdgcn_sched_barrier(0);
      if (kt + 1 < nk) SSTORE(R0, st ^ 1);
      lds_barrier();
    }
  }
}

#define GLDS16(gp, lp) __builtin_amdgcn_global_load_lds((const unsigned*)(gp), (unsigned*)(lp), 16, 0, 0)
template <class RowFn>
DI void gemm_glds(f32x4 (&acc)[4][4], const bf16_t* __restrict__ A, int lda, RowFn rowfn,
                  const bf16_t* __restrict__ Bt, int ldb, int K, char* smem, const bf16_t* zrow) {
  constexpr int A_BYTES = 256 * 128, STAGE = A_BYTES + 128 * 128;
  const int tid = my_tid(), lane = tid & 63, wid = tid >> 6, wm = wid >> 1, wn = wid & 1, g = lane >> 4, r16 = lane & 15;
  const int lrow = tid >> 3, c = (tid & 7) ^ (lrow & 7);
  const long a0 = rowfn(lrow), a1 = rowfn(lrow + 64), a2 = rowfn(lrow + 128), a3 = rowfn(lrow + 192);
  const bf16_t* pa0 = (a0 >= 0 ? A + a0 * lda : zrow) + c * 8; const int m0 = a0 >= 0 ? 1 : 0;
  const bf16_t* pa1 = (a1 >= 0 ? A + a1 * lda : zrow) + c * 8; const int m1 = a1 >= 0 ? 1 : 0;
  const bf16_t* pa2 = (a2 >= 0 ? A + a2 * lda : zrow) + c * 8; const int m2 = a2 >= 0 ? 1 : 0;
  const bf16_t* pa3 = (a3 >= 0 ? A + a3 * lda : zrow) + c * 8; const int m3 = a3 >= 0 ? 1 : 0;
  const bf16_t* pb0 = Bt + (long)lrow * ldb + c * 8; const bf16_t* pb1 = pb0 + (long)64 * ldb;
  auto ISSUE = [&](int kt, int bi) {
    char* d = smem + bi * STAGE + tid * 16;
    const int k0 = kt * 64;
    GLDS16(pa0 + k0 * m0, d); GLDS16(pa1 + k0 * m1, d + 8192); GLDS16(pa2 + k0 * m2, d + 16384); GLDS16(pa3 + k0 * m3, d + 24576);
    GLDS16(pb0 + k0, d + A_BYTES); GLDS16(pb1 + k0, d + A_BYTES + 8192);
  };
  auto COMPUTE = [&](int bi) {
    const char* As = smem + bi * STAGE + (wm * 64 + r16) * 128;
    const char* Bs = smem + bi * STAGE + A_BYTES + (wn * 64 + r16) * 128;
#pragma unroll
    for (int kk = 0; kk < 2; ++kk) {
      const int sw = ((kk * 4 + g) ^ (r16 & 7)) << 4;
      bf16x8 af[4], bfr[4];
#pragma unroll
      for (int mt = 0; mt < 4; ++mt) af[mt] = *(const bf16x8*)(As + mt * 16 * 128 + sw);
#pragma unroll
      for (int nt = 0; nt < 4; ++nt) bfr[nt] = *(const bf16x8*)(Bs + nt * 16 * 128 + sw);
      __builtin_amdgcn_s_setprio(1);
#pragma unroll
      for (int mt = 0; mt < 4; ++mt)
#pragma unroll
        for (int nt = 0; nt < 4; ++nt)
          acc[mt][nt] = __builtin_amdgcn_mfma_f32_16x16x32_bf16(af[mt], bfr[nt], acc[mt][nt], 0, 0, 0);
      __builtin_amdgcn_s_setprio(0);
    }
  };
  const int nk = K >> 6;
  __syncthreads();
  ISSUE(0, 0);
  ISSUE(1, 1);
  asm volatile("s_waitcnt vmcnt(6)" ::: "memory");
  __builtin_amdgcn_s_barrier();
  asm volatile("" ::: "memory");
  int bi = 0;
  for (int kt = 0; kt < nk; ++kt) {
    const int b2 = bi >= 1 ? bi - 1 : 2;
    if (kt + 2 < nk) ISSUE(kt + 2, b2);
    COMPUTE(bi);
    if (kt + 2 < nk) asm volatile("s_waitcnt vmcnt(6)" ::: "memory");
    else asm volatile("s_waitcnt vmcnt(0)" ::: "memory");
    asm volatile("s_waitcnt lgkmcnt(0)" ::: "memory");
    __builtin_amdgcn_s_barrier();
    asm volatile("" ::: "memory");
    bi = bi == 2 ? 0 : bi + 1;
  }
}

DI void gemm_glds256(f32x4 (&acc)[8][4], const bf16_t* __restrict__ A, int lda, long arow0,
                     const bf16_t* __restrict__ Bt, int ldb, int K, char* smem) {
  constexpr int A_BYTES = 256 * 128, STAGE = 2 * A_BYTES;
  const int tid = my_tid(), lane = tid & 63, wid = tid >> 6, wm = wid >> 2, wn = wid & 3, g = lane >> 4, r16 = lane & 15;
  const int lrow = tid >> 3, c = (tid & 7) ^ (lrow & 7);
  const bf16_t* pa = A + (arow0 + lrow) * (long)lda + c * 8;
  const bf16_t* pb = Bt + (long)lrow * ldb + c * 8;
  const long a64 = (long)64 * lda, b64 = (long)64 * ldb;
  auto ISSUE = [&](int kt, int bi) {
    char* d = smem + bi * STAGE + tid * 16;
    const int k0 = kt * 64;
    GLDS16(pa + k0, d); GLDS16(pa + a64 + k0, d + 8192); GLDS16(pa + 2 * a64 + k0, d + 16384); GLDS16(pa + 3 * a64 + k0, d + 24576);
    GLDS16(pb + k0, d + A_BYTES); GLDS16(pb + b64 + k0, d + A_BYTES + 8192); GLDS16(pb + 2 * b64 + k0, d + A_BYTES + 16384); GLDS16(pb + 3 * b64 + k0, d + A_BYTES + 24576);
  };
  auto COMPUTE = [&](int bi) {
    const char* As = smem + bi * STAGE + (wm * 128 + r16) * 128;
    const char* Bs = smem + bi * STAGE + A_BYTES + (wn * 64 + r16) * 128;
#pragma unroll
    for (int kk = 0; kk < 2; ++kk) {
      const int sw = ((kk * 4 + g) ^ (r16 & 7)) << 4;
      bf16x8 bfr[4];
#pragma unroll
      for (int nt = 0; nt < 4; ++nt) bfr[nt] = *(const bf16x8*)(Bs + nt * 16 * 128 + sw);
      __builtin_amdgcn_s_setprio(1);
#pragma unroll
      for (int mt = 0; mt < 8; ++mt) {
        const bf16x8 af = *(const bf16x8*)(As + mt * 16 * 128 + sw);
#pragma unroll
        for (int nt = 0; nt < 4; ++nt)
          acc[mt][nt] = __builtin_amdgcn_mfma_f32_16x16x32_bf16(af, bfr[nt], acc[mt][nt], 0, 0, 0);
      }
      __builtin_amdgcn_s_setprio(0);
    }
  };
  const int nk = K >> 6;
  __syncthreads();
  ISSUE(0, 0);
  asm volatile("s_waitcnt vmcnt(0)" ::: "memory");
  __builtin_amdgcn_s_barrier();
  asm volatile("" ::: "memory");
  int bi = 0;
  for (int kt = 0; kt < nk; ++kt) {
    if (kt + 1 < nk) ISSUE(kt + 1, bi ^ 1);
    COMPUTE(bi);
    asm volatile("s_waitcnt vmcnt(0)" ::: "memory");
    asm volatile("s_waitcnt lgkmcnt(0)" ::: "memory");
    __builtin_amdgcn_s_barrier();
    asm volatile("" ::: "memory");
    bi ^= 1;
  }
}
DI void zero_acc256(f32x4 (&acc)[8][4]) {
#pragma unroll
  for (int i = 0; i < 8; ++i)
#pragma unroll
    for (int j = 0; j < 4; ++j) acc[i][j] = (f32x4){0.f, 0.f, 0.f, 0.f};
}

DI bool next_tile(int i, int MTILES, int NTILES, int& mt, int& nt) {
  const int xcd = blockIdx.x & 7, slot = blockIdx.x >> 3, nslot = gridDim.x >> 3;
  const int m_lo = (MTILES * xcd) >> 3, m_hi = (MTILES * (xcd + 1)) >> 3, Mloc = m_hi - m_lo;
  const int q = i * nslot + slot;
  if (q >= Mloc * NTILES) return false;
  const int gidx = q / (4 * NTILES), m0 = gidx * 4;
  const int rows = (Mloc - m0) < 4 ? (Mloc - m0) : 4;
  const int within = q - gidx * 4 * NTILES;
  nt = within / rows; mt = m_lo + m0 + within % rows;
  return true;
}

struct RowPlain { long base; DI long operator()(int r) const { return base + r; } };
struct RowHalo { long rowbase; int t0; int len; DI long operator()(int r) const { int t = t0 + r; return (t >= 0 && t < len) ? rowbase + t : -1; } };

template <int NTW> DI void zero_acc(f32x4 (&acc)[4][NTW]) {
#pragma unroll
  for (int i = 0; i < 4; ++i)
#pragma unroll
    for (int j = 0; j < NTW; ++j) acc[i][j] = (f32x4){0.f, 0.f, 0.f, 0.f};
}

DI void cvt_unit(const float* __restrict__ src, int ldsrc, int srccol0, int k0, bf16_t* __restrict__ dst, int K, int n0, char* smem, bool perm = true) {
  float* T = (float*)smem;
  const int tid = my_tid();
  __syncthreads();
  if (srccol0 >= 0) {
#pragma unroll
    for (int i = 0; i < 8; ++i) {
      int idx = tid + i * 512; int k = idx >> 6, n = idx & 63;
      T[k * 65 + n] = src[(long)(k0 + k) * ldsrc + srccol0 + n];
    }
  }
  __syncthreads();
  int nd = tid >> 3, kc = (tid & 7) * 8; int n = perm ? ((nd & 15) * 4 + (nd >> 4)) : nd;
  uint4 o = make_uint4(0, 0, 0, 0);
  if (srccol0 >= 0) {
    o.x = pack2(T[(kc + 0) * 65 + n], T[(kc + 1) * 65 + n]);
    o.y = pack2(T[(kc + 2) * 65 + n], T[(kc + 3) * 65 + n]);
    o.z = pack2(T[(kc + 4) * 65 + n], T[(kc + 5) * 65 + n]);
    o.w = pack2(T[(kc + 6) * 65 + n], T[(kc + 7) * 65 + n]);
  }
  *(uint4*)(dst + (long)(n0 + nd) * K + k0 + kc) = o;
}

DI void ph_convert(const Params& p, int l, char* smem) {
  for (int u = blockIdx.x; u < 4508; u += gridDim.x) {
    if (u < 832) {
      int gI = u >> 4, kt = u & 15; int n0 = gI * 64; int sc;
      if (n0 < 1280) sc = n0; else if (n0 < 2048) sc = 2496 + (n0 - 1280); else if (n0 < 3264) sc = 1280 + (n0 - 2048); else sc = -1;
      cvt_unit(p.in[6] + (size_t)l * 1024 * 7360, 7360, sc, kt * 64, (bf16_t*)(p.ws + WB_IN), 1024, n0, smem);
    } else if (u < 1856) {
      int v = u - 832; int gI = v >> 4, kt = v & 15;
      cvt_unit(p.in[6] + (size_t)l * 1024 * 7360, 7360, 3264 + gI * 64, kt * 64, (bf16_t*)(p.ws + WB_GATE), 1024, gI * 64, smem);
    } else if (u < 2112) {
      int v = u - 1856; int gI = v >> 2, kt = v & 3; int j = gI >> 4, gg = gI & 15;
      cvt_unit(p.in[33] + ((size_t)l * 4 + j) * 256 * 1024, 1024, gg * 64, kt * 64, (bf16_t*)(p.ws + WB_BR) + (size_t)j * 1024 * 256, 256, gg * 64, smem);
    } else if (u < 2368) {
      int v = u - 2112; int gI = v >> 4, kt = v & 15;
      cvt_unit(p.in[34] + (size_t)l * 1024 * 1024, 1024, gI * 64, kt * 64, (bf16_t*)(p.ws + WB_OUT), 1024, gI * 64, smem);
    } else if (u < 3776) {
      int v = u - 2368; int gI = v >> 4, kt = v & 15; int nt = gI >> 2, q = gI & 3;
      cvt_unit(p.in[37] + (size_t)l * 1024 * 5632, 5632, (q >> 1) * 2816 + nt * 128 + (q & 1) * 64, kt * 64, (bf16_t*)(p.ws + WB_UP), 1024, gI * 64, smem);
    } else if (u < 4480) {
      int v = u - 3776; int gI = v / 44, kt = v % 44;
      cvt_unit(p.in[40] + (size_t)l * 2816 * 1024, 1024, gI * 64, kt * 64, (bf16_t*)(p.ws + WB_DOWN), 2816, gI * 64, smem);
    } else {
      int v = u - 4480;
      if (v < 4) cvt_unit(p.in[19] + (size_t)l * 2 * 64 * 256, 256, v * 64, 0, (bf16_t*)(p.ws + RWW_F), 64, v * 64, smem);
      else if (v < 8) cvt_unit(p.in[19] + (size_t)l * 2 * 64 * 256 + 64 * 256, 256, (v - 4) * 64, 0, (bf16_t*)(p.ws + RWW_B), 64, (v - 4) * 64, smem);
      else if (v < 12) cvt_unit(p.in[21] + (size_t)l * 64 * 256, 256, (v - 8) * 64, 0, (bf16_t*)(p.ws + RWW_A), 64, (v - 8) * 64, smem);
      else if (v < 20) { int w = v - 12; cvt_unit(p.in[22] + (size_t)l * 2 * 128 * 256, 256, (w >> 1) * 64, (w & 1) * 64, (bf16_t*)(p.ws + RWW_GF), 128, (w >> 1) * 64, smem); }
      else { int w = v - 20; cvt_unit(p.in[22] + (size_t)l * 2 * 128 * 256 + 128 * 256, 256, (w >> 1) * 64, (w & 1) * 64, (bf16_t*)(p.ws + RWW_GB), 128, (w >> 1) * 64, smem); }
    }
  }
}

DI void ph_ada(const Params& p, char* smem) {
  float* S = (float*)smem;
  float* R = S + 9 * 1024;
  const int tid = my_tid();
  bool loaded = false;
  for (int u = blockIdx.x; u < 192; u += gridDim.x) {
    if (!loaded) {
      __syncthreads();
      for (int i = tid; i < 9 * 1024; i += NTHR) { float c = i < 8192 ? p.in[1][i] : p.in[3][i - 8192]; S[i] = siluf_(c); }
      loaded = true;
    }
    __syncthreads();
    int l = u / 96, n0 = (u % 96) * 64;
    int col = tid & 63, ks = tid >> 6;
    const float* W = p.in[4] + (size_t)l * 1024 * 6144 + n0 + col;
    float a[9];
#pragma unroll
    for (int b = 0; b < 9; ++b) a[b] = 0.f;
    for (int k = ks * 128; k < ks * 128 + 128; ++k) {
      float w = W[(size_t)k * 6144];
#pragma unroll
      for (int b = 0; b < 9; ++b) a[b] += S[b * 1024 + k] * w;
    }
#pragma unroll
    for (int b = 0; b < 9; ++b) R[(ks * 9 + b) * 64 + col] = a[b];
    __syncthreads();
    for (int i = tid; i < 9 * 64; i += NTHR) {
      int b = i >> 6, c = i & 63; float s = 0.f;
#pragma unroll
      for (int k2 = 0; k2 < 8; ++k2) s += R[(k2 * 9 + b) * 64 + c];
      s += p.in[5][(size_t)l * 6144 + n0 + c];
      ((float*)(p.ws + MISC_MOD))[((size_t)l * 9 + b) * 6144 + n0 + c] = s;
    }
  }
  for (int i = blockIdx.x * NTHR + tid; i < 4096; i += gridDim.x * NTHR) {
    float s, c; sincospif(-(float)i / 4096.f, &s, &c);
    ((float2*)(p.ws + MISC_TW))[i] = make_float2(c, s);
  }
}

DI void hy_rawfilter(const Params& p, int l, int Lf, float* __restrict__ dst, char* smem) {
  float* W1 = (float*)smem;
  float* W2 = W1 + 33 * 64;
  float* Z = W2 + 64 * 64;
  float* H1 = Z + 16 * 36;
  float* H2 = H1 + 16 * 64;
  const int tid = my_tid();
  const float* w1 = p.in[9] + (size_t)l * 33 * 64; const float* b1 = p.in[10] + l * 64;
  const float* w2 = p.in[11] + (size_t)l * 64 * 64; const float* b2 = p.in[12] + l * 64;
  const float* w3 = p.in[13] + (size_t)l * 64 * 1024; const float* fr = p.in[14] + l * 64;
  const int nunits = Lf / 16;
  bool loaded = false;
  for (int u = blockIdx.x; u < nunits; u += gridDim.x) {
    __syncthreads();
    if (!loaded) {
      for (int i = tid; i < 33 * 64; i += NTHR) W1[i] = w1[i];
      for (int i = tid; i < 64 * 64; i += NTHR) W2[i] = w2[i];
      loaded = true;
    }
    const int t0 = u * 16;
    for (int i = tid; i < 16 * 33; i += NTHR) {
      int tt = i / 33, f = i % 33; int t = t0 + tt; float v;
      if (f == 0) v = (float)t / (float)(Lf - 1);
      else {
        int bi = (f - 1) & 15;
        float wv = 6.283185307179586f * (float)t / (float)Lf;
        float fb = 1e-4f + (15.f - 1e-4f) * (float)bi / 15.f;
        float ang = wv * fb;
        v = (f <= 16) ? cosf(ang) : -sinf(ang);
      }
      Z[tt * 36 + f] = v;
    }
    __syncthreads();
    for (int i = tid; i < 16 * 64; i += NTHR) {
      int tt = i >> 6, f = i & 63; float s = b1[f];
      for (int k = 0; k < 33; ++k) s += Z[tt * 36 + k] * W1[k * 64 + f];
      H1[tt * 64 + f] = sinf(fr[f] * s);
    }
    __syncthreads();
    for (int i = tid; i < 16 * 64; i += NTHR) {
      int tt = i >> 6, f = i & 63; float s = b2[f];
      for (int k = 0; k < 64; ++k) s += H1[tt * 64 + k] * W2[k * 64 + f];
      H2[tt * 64 + f] = sinf(fr[f] * s);
    }
    __syncthreads();
    float a0[16], a1[16];
#pragma unroll
    for (int i = 0; i < 16; ++i) { a0[i] = 0.f; a1[i] = 0.f; }
    for (int k = 0; k < 64; ++k) {
      float wa = w3[k * 1024 + tid], wb = w3[k * 1024 + 512 + tid];
#pragma unroll
      for (int i = 0; i < 16; ++i) { float h = H2[i * 64 + k]; a0[i] += h * wa; a1[i] += h * wb; }
    }
    {
      int w = tid & 255;
      float delta = fabsf(-3.0701134573253944f + (-15.350567286626972f + 3.0701134573253944f) * (float)w / 255.f);
#pragma unroll
      for (int i = 0; i < 16; ++i) {
        float tn = (float)(t0 + i) / (float)(Lf - 1);
        float dec = expf(-tn * delta);
        dst[(size_t)(t0 + i) * 1024 + tid] = a0[i] * dec;
        dst[(size_t)(t0 + i) * 1024 + 512 + tid] = a1[i] * dec;
      }
    }
  }
}

DI float2 cmul(float2 a, float2 b) { return make_float2(a.x * b.x - a.y * b.y, a.x * b.y + a.y * b.x); }
DI float2 cmulc(float2 a, float2 b) { return make_float2(a.x * b.x + a.y * b.y, a.y * b.x - a.x * b.y); }
DI float2 cadd(float2 a, float2 b) { return make_float2(a.x + b.x, a.y + b.y); }
DI float2 csub(float2 a, float2 b) { return make_float2(a.x - b.x, a.y - b.y); }
DI void fft_dif(float2* X, const float2* W) {
  const int tid = my_tid();
  for (int ls = 12; ls >= 2; ls -= 2) {
    const int s = 1 << ls, h = s >> 1;
    __syncthreads();
#pragma unroll
    for (int i = 0; i < 4; ++i) {
      const int bf = tid + i * 512; const int j = bf & (h - 1); const int base = ((bf >> (ls - 1)) << (ls + 1)) + j;
      const float2 x0 = X[base], x1 = X[base + h], x2 = X[base + s], x3 = X[base + s + h];
      const float2 w1 = W[s - 1 + j], w2 = W[h - 1 + j];
      const float2 y0 = cadd(x0, x2), y2 = cmul(csub(x0, x2), w1), y1 = cadd(x1, x3);
      const float2 t = cmul(csub(x1, x3), w1); const float2 y3 = make_float2(t.y, -t.x);
      X[base] = cadd(y0, y1); X[base + h] = cmul(csub(y0, y1), w2);
      X[base + s] = cadd(y2, y3); X[base + s + h] = cmul(csub(y2, y3), w2);
    }
  }
  __syncthreads();
#pragma unroll
  for (int i = 0; i < 4; ++i) {
    const int q = tid + i * 512;
    float4 a = *(float4*)(X + 4 * q), b = *(float4*)(X + 4 * q + 2);
    *(float4*)(X + 4 * q) = make_float4(a.x + a.z, a.y + a.w, a.x - a.z, a.y - a.w);
    *(float4*)(X + 4 * q + 2) = make_float4(b.x + b.z, b.y + b.w, b.x - b.z, b.y - b.w);
  }
  __syncthreads();
}
DI void fft_dit_inv(float2* X, const float2* W) {
  const int tid = my_tid();
  __syncthreads();
#pragma unroll
  for (int i = 0; i < 4; ++i) {
    const int q = tid + i * 512;
    float4 a = *(float4*)(X + 4 * q), b = *(float4*)(X + 4 * q + 2);
    *(float4*)(X + 4 * q) = make_float4(a.x + a.z, a.y + a.w, a.x - a.z, a.y - a.w);
    *(float4*)(X + 4 * q + 2) = make_float4(b.x + b.z, b.y + b.w, b.x - b.z, b.y - b.w);
  }
  for (int ls = 2; ls <= 12; ls += 2) {
    const int s = 1 << ls, h = s >> 1;
    __syncthreads();
#pragma unroll
    for (int i = 0; i < 4; ++i) {
      const int bf = tid + i * 512; const int j = bf & (h - 1); const int base = ((bf >> (ls - 1)) << (ls + 1)) + j;
      const float2 e0 = X[base], e1 = X[base + h], e2 = X[base + s], e3 = X[base + s + h];
      const float2 w1 = W[s - 1 + j], w2 = W[h - 1 + j];
      const float2 t1 = cmulc(e1, w2), t3 = cmulc(e3, w2);
      const float2 u0 = cadd(e0, t1), u1 = csub(e0, t1), u2 = cadd(e2, t3), u3 = csub(e2, t3);
      const float2 a2 = cmulc(u2, w1); const float2 q3 = cmulc(u3, w1); const float2 a3 = make_float2(-q3.y, q3.x);
      X[base] = cadd(u0, a2); X[base + s] = csub(u0, a2);
      X[base + h] = cadd(u1, a3); X[base + s + h] = csub(u1, a3);
    }
  }
  __syncthreads();
}
DI void load_twiddles(const Params& p, float2* W) {
  const float2* tw = (const float2*)(p.ws + MISC_TW);
  for (int i = my_tid(); i < 8191; i += NTHR) {
    const int ls = 31 - __clz(i + 1); const int pos = i + 1 - (1 << ls);
    W[i] = tw[pos << (12 - ls)];
  }
}

DI void ph_kf(const Params& p, int l, char* smem) {
  float2* X = (float2*)smem; float2* W = X + 8192; float* red = (float*)(W + 8192);
  const int tid = my_tid(), lane = tid & 63, wid = tid >> 6;
  const float* rawf = (const float*)(p.ws + R_RAWF);
  float2* kf = (float2*)(p.ws + OFF_KF);
  bool tw = false;
  for (int u = blockIdx.x; u < 256; u += gridDim.x) {
    if (!tw) { load_twiddles(p, W); tw = true; }
    const int o = u >> 7, c = (u & 127) * 2;
    float2 fw[8], bw[8]; float sa = 0.f, sb = 0.f;
#pragma unroll
    for (int i = 0; i < 8; ++i) {
      int t = tid + i * 512;
      fw[i] = *(const float2*)(rawf + (size_t)t * 1024 + o * 512 + c);
      bw[i] = *(const float2*)(rawf + (size_t)t * 1024 + o * 512 + 256 + c);
      sa += fabsf(fw[i].x) + fabsf(bw[i].x); sb += fabsf(fw[i].y) + fabsf(bw[i].y);
    }
    sa = wave_sum(sa); sb = wave_sum(sb);
    __syncthreads();
    if (lane == 0) { red[wid * 2] = sa; red[wid * 2 + 1] = sb; }
    __syncthreads();
    float ta = 0.f, tb = 0.f;
#pragma unroll
    for (int w = 0; w < 8; ++w) { ta += red[w * 2]; tb += red[w * 2 + 1]; }
    const float ia = 1.f / ta, ib = 1.f / tb;
#pragma unroll
    for (int i = 0; i < 8; ++i) {
      int t = tid + i * 512;
      X[t] = make_float2(fw[i].x * ia, fw[i].y * ib);
      if (t >= 1) X[8192 - t] = make_float2(bw[i].x * ia, bw[i].y * ib);
      else X[4096] = make_float2(0.f, 0.f);
    }
    fft_dif(X, W);
    float2* ka = kf + (size_t)(o * 256 + c) * 8192; float2* kb = ka + 8192;
#pragma unroll 4
    for (int i = 0; i < 16; ++i) {
      int pidx = tid + i * 512;
      int k = (int)(__brev((unsigned)pidx) >> 19);
      int k2 = (8192 - k) & 8191;
      int p2 = (int)(__brev((unsigned)k2) >> 19);
      float2 c1 = X[pidx], c2 = X[p2];
      float2 A = make_float2(0.5f * (c1.x + c2.x), 0.5f * (c1.y - c2.y));
      float2 Bv = make_float2(0.5f * (c1.y + c2.y), -0.5f * (c1.x - c2.x));
      ka[pidx] = A; kb[pidx] = Bv;
    }
    __syncthreads();
  }
  if (l == 0) {
    const float* rawc = (const float*)(p.ws + MISC_RAWC);
    float* G = (float*)(p.ws + MISC_GCTX);
    for (int u = blockIdx.x * 8 + wid; u < 512; u += gridDim.x * 8) {
      int o = u >> 8, c = u & 255; float f[4], b[4]; float s = 0.f;
#pragma unroll
      for (int i = 0; i < 4; ++i) {
        int t = lane + i * 64;
        f[i] = rawc[(size_t)t * 1024 + o * 512 + c]; b[i] = rawc[(size_t)t * 1024 + o * 512 + 256 + c];
        s += fabsf(f[i]) + fabsf(b[i]);
      }
      s = wave_sum(s); float inv = 1.f / s;
#pragma unroll
      for (int i = 0; i < 4; ++i) {
        int t = lane + i * 64;
        G[(size_t)u * 512 + 256 + t] = f[i] * inv;
        if (t >= 1) G[(size_t)u * 512 + 256 - t] = b[i] * inv;
      }
      if (lane == 0) G[(size_t)u * 512] = 0.f;
    }
  }
}

DI void ph_ln(const float* __restrict__ src_lat, const float* __restrict__ src_ctx, float* dst_lat, float* dst_ctx,
              const float* __restrict__ ag, const float* __restrict__ ab, bf16_t* U, const float* __restrict__ mod, int sh_off, int nrows) {
  const int lane = my_tid() & 63, wid = my_tid() >> 6;
  const int stride = gridDim.x * 8;
  float4 nv[4];
  {
    const int row = blockIdx.x * 8 + wid;
    if (row < nrows) {
      const float* src = row < ML ? src_lat + (size_t)row * D : src_ctx + (size_t)(row - ML) * D;
#pragma unroll
      for (int i = 0; i < 4; ++i) nv[i] = *(const float4*)(src + i * 256 + lane * 4);
    }
  }
  for (int row = blockIdx.x * 8 + wid; row < nrows; row += stride) {
    float4 v[4];
#pragma unroll
    for (int i = 0; i < 4; ++i) v[i] = nv[i];
    if (row + stride < nrows) {
      const int r2 = row + stride;
      const float* src2 = r2 < ML ? src_lat + (size_t)r2 * D : src_ctx + (size_t)(r2 - ML) * D;
#pragma unroll
      for (int i = 0; i < 4; ++i) nv[i] = *(const float4*)(src2 + i * 256 + lane * 4);
    }
    float s = 0.f;
#pragma unroll
    for (int i = 0; i < 4; ++i) s += v[i].x + v[i].y + v[i].z + v[i].w;
    float mu = wave_sum(s) * (1.f / 1024.f);
    float q = 0.f;
#pragma unroll
    for (int i = 0; i < 4; ++i) { v[i].x -= mu; v[i].y -= mu; v[i].z -= mu; v[i].w -= mu; q += v[i].x * v[i].x + v[i].y * v[i].y + v[i].z * v[i].z + v[i].w * v[i].w; }
    float rs = rsqrtf(wave_sum(q) * (1.f / 1024.f) + 1e-6f);
#pragma unroll
    for (int i = 0; i < 4; ++i) { v[i].x *= rs; v[i].y *= rs; v[i].z *= rs; v[i].w *= rs; }
    if (ag) {
      float* dst = row < ML ? dst_lat + (size_t)row * D : dst_ctx + (size_t)(row - ML) * D;
#pragma unroll
      for (int i = 0; i < 4; ++i) {
        float4 gg = *(const float4*)(ag + i * 256 + lane * 4), bb = *(const float4*)(ab + i * 256 + lane * 4);
        v[i].x = v[i].x * gg.x + bb.x; v[i].y = v[i].y * gg.y + bb.y; v[i].z = v[i].z * gg.z + bb.z; v[i].w = v[i].w * gg.w + bb.w;
        *(float4*)(dst + i * 256 + lane * 4) = v[i];
      }
      if (U) {
        s = 0.f;
#pragma unroll
        for (int i = 0; i < 4; ++i) s += v[i].x + v[i].y + v[i].z + v[i].w;
        mu = wave_sum(s) * (1.f / 1024.f); q = 0.f;
#pragma unroll
        for (int i = 0; i < 4; ++i) { v[i].x -= mu; v[i].y -= mu; v[i].z -= mu; v[i].w -= mu; q += v[i].x * v[i].x + v[i].y * v[i].y + v[i].z * v[i].z + v[i].w * v[i].w; }
        rs = rsqrtf(wave_sum(q) * (1.f / 1024.f) + 1e-6f);
#pragma unroll
        for (int i = 0; i < 4; ++i) { v[i].x *= rs; v[i].y *= rs; v[i].z *= rs; v[i].w *= rs; }
      }
    }
    if (U) {
      const float* m = mod + (size_t)mod_idx(row) * 6144 + sh_off;
#pragma unroll
      for (int i = 0; i < 4; ++i) {
        float4 sh = *(const float4*)(m + i * 256 + lane * 4), sc = *(const float4*)(m + 1024 + i * 256 + lane * 4);
        uint2 o; o.x = pack2(v[i].x * (1.f + sc.x) + sh.x, v[i].y * (1.f + sc.y) + sh.y);
        o.y = pack2(v[i].z * (1.f + sc.z) + sh.z, v[i].w * (1.f + sc.w) + sh.w);
        *(uint2*)(U + (size_t)row * D + i * 256 + lane * 4) = o;
      }
    }
  }
}

DI void ph_inproj(const Params& p, const bf16_t* U, char* smem) {
  const bf16_t* Bt = (const bf16_t*)(p.ws + WB_IN);
  const int lane = my_tid() & 63, wid = my_tid() >> 6, wm = wid >> 2, wn = wid & 3, g = lane >> 4, r16 = lane & 15;
  for (int it = 0;; ++it) {
    int mtile, ntile;
    if (!next_tile(it, 136, 13, mtile, ntile)) break;
    f32x4 acc[8][4]; zero_acc256(acc);
    gemm_glds256(acc, U, 1024, (long)mtile * 256, Bt + (size_t)ntile * 256 * 1024, 1024, 1024, smem);
    int b, key0;
    if (mtile < 128) { b = mtile >> 4; key0 = (mtile & 15) * 256; } else { b = mtile - 128; key0 = SL; }
    const int wc0 = ntile * 256 + wn * 64;
    bf16_t* tbase = nullptr; int tcols = 0, tcol0 = 0;
    if (wc0 < 768) { tbase = (bf16_t*)(p.ws + R_PHY); tcols = 768; tcol0 = wc0; }
    else if (wc0 >= 1152 && wc0 < 1280) { tbase = (bf16_t*)(p.ws + R_VTSW); tcols = 128; tcol0 = wc0 - 1152; }
    else if (wc0 >= 1792 && wc0 < 2048) { tbase = (bf16_t*)(p.ws + R_VTDF); tcols = 256; tcol0 = wc0 - 1792; }
    if (tbase) {
#pragma unroll
      for (int mt = 0; mt < 8; ++mt)
#pragma unroll
        for (int nt = 0; nt < 4; ++nt) {
          int col = tcol0 + r16 * 4 + nt;
          int key = key0 + wm * 128 + mt * 16 + g * 4;
          uint2 o; o.x = pack2(acc[mt][nt][0], acc[mt][nt][1]); o.y = pack2(acc[mt][nt][2], acc[mt][nt][3]);
          *(uint2*)(tbase + ((size_t)b * tcols + col) * KEYS + key) = o;
        }
    } else if (wc0 < 3264) {
      bf16_t* rb; int ld, c0;
      if (wc0 < 1152) { rb = (bf16_t*)(p.ws + R_PSW); ld = 384; c0 = wc0 - 768; }
      else if (wc0 < 1792) { rb = (bf16_t*)(p.ws + R_PDF); ld = 512; c0 = wc0 - 1280; }
      else { rb = (bf16_t*)(p.ws + R_PRW); ld = 1216; c0 = wc0 - 2048; }
      const int col = c0 + r16 * 4;
#pragma unroll
      for (int mt = 0; mt < 8; ++mt)
#pragma unroll
        for (int j = 0; j < 4; ++j) {
          size_t row = (size_t)mtile * 256 + wm * 128 + mt * 16 + g * 4 + j;
          uint2 o; o.x = pack2(acc[mt][0][j], acc[mt][1][j]); o.y = pack2(acc[mt][2][j], acc[mt][3][j]);
          *(uint2*)(rb + row * ld + col) = o;
        }
    }
  }
}

DI float hy_conv3(const bf16_t* __restrict__ P, int t, int len, float w0, float w1, float w2, float bias) {
  float a = t >= 1 ? bf2f(P[t - 1]) : 0.f, b = bf2f(P[t]), c = (t + 1 < len) ? bf2f(P[t + 1]) : 0.f;
  return w0 * a + w1 * b + w2 * c + bias;
}
DI void ph_hyena(const Params& p, int l, char* smem) {
  float2* X = (float2*)smem; float2* W = X + 8192;
  const int tid = my_tid();
  const bf16_t* PT = (const bf16_t*)(p.ws + R_PHY);
  const float2* kf = (const float2*)(p.ws + OFF_KF);
  const float* cw = p.in[7] + (size_t)l * 3 * 768; const float* cb = p.in[8] + (size_t)l * 768;
  const float* hb = p.in[15] + (size_t)l * 512;
  bf16_t* Y = (bf16_t*)(p.ws + R_YHY);
  bool tw = false;
  for (int u = blockIdx.x; u < 1024; u += gridDim.x) {
    if (!tw) { load_twiddles(p, W); tw = true; }
    const int bp = u >> 8, c = u & 255; const int b0 = bp * 2, b1 = b0 + 1;
    const bf16_t* P0 = PT + ((size_t)b0 * 768) * KEYS; const bf16_t* P1 = PT + ((size_t)b1 * 768) * KEYS;
    float wv0 = cw[c], wv1 = cw[768 + c], wv2 = cw[1536 + c], bv = cb[c];
    float wa0 = cw[256 + c], wa1 = cw[768 + 256 + c], wa2 = cw[1536 + 256 + c], ba = cb[256 + c];
    float wb0 = cw[512 + c], wb1 = cw[768 + 512 + c], wb2 = cw[1536 + 512 + c], bb = cb[512 + c];
    const float bias0 = hb[c], bias1 = hb[256 + c];
    float2 vv[8];
    __syncthreads();
#pragma unroll
    for (int i = 0; i < 8; ++i) {
      int t = tid + i * 512;
      vv[i].x = hy_conv3(P0 + (size_t)c * KEYS, t, SL, wv0, wv1, wv2, bv);
      vv[i].y = hy_conv3(P1 + (size_t)c * KEYS, t, SL, wv0, wv1, wv2, bv);
      X[t] = vv[i]; X[t + 4096] = make_float2(0.f, 0.f);
    }
    fft_dif(X, W);
    {
      const float2* H = kf + (size_t)c * 8192;
#pragma unroll 4
      for (int i = 0; i < 16; ++i) { int q = tid + i * 512; X[q] = cmul(X[q], H[q]); }
    }
    fft_dit_inv(X, W);
    float2 zz[8];
#pragma unroll
    for (int i = 0; i < 8; ++i) {
      int t = tid + i * 512;
      float2 y = X[t];
      float x1a = hy_conv3(P0 + (size_t)(256 + c) * KEYS, t, SL, wa0, wa1, wa2, ba);
      float x1b = hy_conv3(P1 + (size_t)(256 + c) * KEYS, t, SL, wa0, wa1, wa2, ba);
      zz[i].x = x1a * (y.x * (1.f / 8192.f) + bias0 * vv[i].x);
      zz[i].y = x1b * (y.y * (1.f / 8192.f) + bias0 * vv[i].y);
    }
    __syncthreads();
#pragma unroll
    for (int i = 0; i < 8; ++i) { int t = tid + i * 512; X[t] = zz[i]; X[t + 4096] = make_float2(0.f, 0.f); }
    fft_dif(X, W);
    {
      const float2* H = kf + (size_t)(256 + c) * 8192;
#pragma unroll 4
      for (int i = 0; i < 16; ++i) { int q = tid + i * 512; X[q] = cmul(X[q], H[q]); }
    }
    fft_dit_inv(X, W);
#pragma unroll
    for (int i = 0; i < 8; ++i) {
      int t = tid + i * 512;
      float2 y = X[t];
      float x2a = hy_conv3(P0 + (size_t)(512 + c) * KEYS, t, SL, wb0, wb1, wb2, bb);
      float x2b = hy_conv3(P1 + (size_t)(512 + c) * KEYS, t, SL, wb0, wb1, wb2, bb);
      float oa = x2a * (y.x * (1.f / 8192.f) + bias1 * zz[i].x);
      float ob = x2b * (y.y * (1.f / 8192.f) + bias1 * zz[i].y);
      Y[((size_t)b0 * SL + t) * 256 + c] = (bf16_t)f2bf(oa);
      Y[((size_t)b1 * SL + t) * 256 + c] = (bf16_t)f2bf(ob);
    }
  }
}

DI void ph_hyena_ctx(const Params& p, int l, char* smem) {
  const int tid = my_tid(), lane = tid & 63, wid = tid >> 6;
  float* Zb = (float*)smem + wid * 1024;
  float* Gb = Zb + 256;
  const bf16_t* PT = (const bf16_t*)(p.ws + R_PHY);
  const float* G = (const float*)(p.ws + MISC_GCTX);
  const float* cw = p.in[7] + (size_t)l * 3 * 768; const float* cb = p.in[8] + (size_t)l * 768;
  const float* hb = p.in[15] + (size_t)l * 512;
  bf16_t* Y = (bf16_t*)(p.ws + R_YHY);
  for (int base = blockIdx.x * 8; base < 2048; base += gridDim.x * 8) {
    const int u = base + wid; const int b = u >> 8, c = u & 255;
    const bf16_t* Pb = PT + ((size_t)b * 768) * KEYS + SL;
    float v[4], x1[4], x2[4], zz[4];
#pragma unroll
    for (int i = 0; i < 4; ++i) {
      int t = lane + i * 64;
      v[i] = hy_conv3(Pb + (size_t)c * KEYS, t, CL, cw[c], cw[768 + c], cw[1536 + c], cb[c]);
      x1[i] = hy_conv3(Pb + (size_t)(256 + c) * KEYS, t, CL, cw[256 + c], cw[768 + 256 + c], cw[1536 + 256 + c], cb[256 + c]);
      x2[i] = hy_conv3(Pb + (size_t)(512 + c) * KEYS, t, CL, cw[512 + c], cw[768 + 512 + c], cw[1536 + 512 + c], cb[512 + c]);
    }
    __syncthreads();
#pragma unroll
    for (int i = 0; i < 4; ++i) Zb[lane + i * 64] = v[i];
    for (int i = lane; i < 512; i += 64) Gb[i] = G[(size_t)c * 512 + i];
    __syncthreads();
#pragma unroll
    for (int i = 0; i < 4; ++i) {
      int t = lane + i * 64; float s = 0.f;
      for (int s2 = 0; s2 < 256; ++s2) s += Gb[256 + t - s2] * Zb[s2];
      zz[i] = x1[i] * (s + hb[c] * v[i]);
    }
    __syncthreads();
#pragma unroll
    for (int i = 0; i < 4; ++i) Zb[lane + i * 64] = zz[i];
    for (int i = lane; i < 512; i += 64) Gb[i] = G[(size_t)(256 + c) * 512 + i];
    __syncthreads();
#pragma unroll
    for (int i = 0; i < 4; ++i) {
      int t = lane + i * 64; float s = 0.f;
      for (int s2 = 0; s2 < 256; ++s2) s += Gb[256 + t - s2] * Zb[s2];
      float o = x2[i] * (s + hb[256 + c] * zz[i]);
      Y[((size_t)ML + b * CL + t) * 256 + c] = (bf16_t)f2bf(o);
    }
  }
}

DI void ph_rope(const Params& p, char* smem) {
  float2* T16 = (float2*)smem;
  float2* T8 = T16 + 64 * 16;
  const int tid = my_tid(), lane = tid & 63, wid = tid >> 6;
  __syncthreads();
  for (int i = tid; i < 64 * 16; i += NTHR) {
    int pos = i >> 4, f = i & 15; float inv = powf(10000.f, -(float)f / 16.f); float s, c; sincosf((float)pos * inv, &s, &c);
    T16[i] = make_float2(c, s);
  }
  for (int i = tid; i < 64 * 8; i += NTHR) {
    int pos = i >> 3, f = i & 7; float inv = powf(10000.f, -(float)f / 8.f); float s, c; sincosf((float)pos * inv, &s, &c);
    T8[i] = make_float2(c, s);
  }
  __syncthreads();
  bf16_t* Psw = (bf16_t*)(p.ws + R_PSW); bf16_t* Pdf = (bf16_t*)(p.ws + R_PDF);
  for (int row = blockIdx.x * 8 + wid; row < ML; row += gridDim.x * 8) {
    const int t = row & (SL - 1); const int pr = t >> 6, pc = t & 63;
    bf16_t* q = Psw + (size_t)row * 384;
#pragma unroll
    for (int i = 0; i < 3; ++i) {
      int pi = lane + i * 64; int hd = pi >> 5, pp = pi & 31; int half = pp >> 4, f = pp & 15;
      int base = hd * 64 + half * 32; float2 cs = T16[(half ? pc : pr) * 16 + f];
      float x1 = bf2f(q[base + f]), x2 = bf2f(q[base + 16 + f]);
      q[base + f] = (bf16_t)f2bf(x1 * cs.x - x2 * cs.y); q[base + 16 + f] = (bf16_t)f2bf(x1 * cs.y + x2 * cs.x);
    }
    bf16_t* d = Pdf + (size_t)row * 512;
#pragma unroll
    for (int i = 0; i < 4; ++i) {
      int pi = lane + i * 64; int gi = pi >> 4, pp = pi & 15; int half = pp >> 3, f = pp & 7;
      int base = gi * 32 + half * 16; float2 cs = T8[(half ? pc : pr) * 8 + f];
      float x1 = bf2f(d[base + f]), x2 = bf2f(d[base + 8 + f]);
      d[base + f] = (bf16_t)f2bf(x1 * cs.x - x2 * cs.y); d[base + 8 + f] = (bf16_t)f2bf(x1 * cs.y + x2 * cs.x);
    }
  }
}

DI float rw_shift(const bf16_t* __restrict__ P, int row, int t, int len, int col, float mu) {
  float c = bf2f(P[(size_t)row * 1216 + col]);
  float a = t >= 1 ? bf2f(P[(size_t)(row - 1) * 1216 + col]) : 0.f;
  float b = t + 1 < len ? bf2f(P[(size_t)(row + 1) * 1216 + col]) : 0.f;
  return c + (0.5f * (a + b) - c) * mu;
}
DI void ph_rwprep(const Params& p, int l, char* smem) {
  constexpr int AST = 912, RST = 1552, ROFF = 32 * AST;
  const int tid = my_tid(), lane = tid & 63, wid = tid >> 6, g = lane >> 4, r16 = lane & 15;
  const int tg = wid >> 2, hd = wid & 3;
  const bf16_t* P = (const bf16_t*)(p.ws + R_PRW);
  const float* mu = p.in[17] + (size_t)l * 1216;
  const float* w0 = p.in[18] + (size_t)l * 512; const float* a0 = p.in[20] + (size_t)l * 256;
  const float* kkw = p.in[23] + (size_t)l * 256; const float* kaw = p.in[24] + (size_t)l * 256;
  bf16_t* S = (bf16_t*)(p.ws + R_STR); bf16_t* Gs = (bf16_t*)(p.ws + R_G);
  const size_t SU = (size_t)MT * 256;
  float w0f[4], w0b[4], a0c[4], kkc[4], kac[4];
#pragma unroll
  for (int nt = 0; nt < 4; ++nt) { int c = hd * 64 + r16 * 4 + nt; w0f[nt] = w0[c]; w0b[nt] = w0[256 + c]; a0c[nt] = a0[c]; kkc[nt] = kkw[c]; kac[nt] = kaw[c]; }
  for (int u = blockIdx.x; u < MT / 32; u += gridDim.x) {
    const int row0 = u * 32; int t0, len;
    if (row0 < ML) { t0 = row0 & (SL - 1); len = SL; } else { t0 = (row0 - ML) & (CL - 1); len = CL; }
    __syncthreads();
    for (int item = tid; item < 32 * 152; item += NTHR) {
      const int tk = item / 152, c8 = item - tk * 152; const int row = row0 + tk, t = t0 + tk;
      const uint4 uc = *(const uint4*)(P + (size_t)row * 1216 + c8 * 8);
      uint4 ua = make_uint4(0, 0, 0, 0), ub = make_uint4(0, 0, 0, 0);
      if (t >= 1) ua = *(const uint4*)(P + (size_t)(row - 1) * 1216 + c8 * 8);
      if (t + 1 < len) ub = *(const uint4*)(P + (size_t)(row + 1) * 1216 + c8 * 8);
      const float4 m0 = *(const float4*)(mu + c8 * 8), m1 = *(const float4*)(mu + c8 * 8 + 4);
      float o[8];
      {
        const unsigned wc[4] = {uc.x, uc.y, uc.z, uc.w}, wa[4] = {ua.x, ua.y, ua.z, ua.w}, wb[4] = {ub.x, ub.y, ub.z, ub.w};
        const float mm[8] = {m0.x, m0.y, m0.z, m0.w, m1.x, m1.y, m1.z, m1.w};
#pragma unroll
        for (int i = 0; i < 4; ++i) {
          float c_lo = bflo(wc[i]), c_hi = bfhi(wc[i]);
          o[2 * i] = c_lo + (0.5f * (bflo(wa[i]) + bflo(wb[i])) - c_lo) * mm[2 * i];
          o[2 * i + 1] = c_hi + (0.5f * (bfhi(wa[i]) + bfhi(wb[i])) - c_hi) * mm[2 * i + 1];
        }
      }
      char* dst;
      if (c8 < 96) dst = smem + ROFF + tk * RST + c8 * 16;
      else {
        const int cc = c8 * 8 - 768;
        if (cc < 128) {
#pragma unroll
          for (int i = 0; i < 8; ++i) o[i] = tanhf(o[i]);
        } else if (cc >= 192) {
#pragma unroll
          for (int i = 0; i < 8; ++i) o[i] = sigmoidf_(o[i]);
        }
        dst = smem + tk * AST + cc * 2;
      }
      uint4 ov; ov.x = pack2(o[0], o[1]); ov.y = pack2(o[2], o[3]); ov.z = pack2(o[4], o[5]); ov.w = pack2(o[6], o[7]);
      *(uint4*)dst = ov;
    }
    __syncthreads();
    f32x4 acc[5][4];
#pragma unroll
    for (int o5 = 0; o5 < 5; ++o5)
#pragma unroll
      for (int nt = 0; nt < 4; ++nt) acc[o5][nt] = (f32x4){0.f, 0.f, 0.f, 0.f};
    const char* Arow = smem + (tg * 16 + r16) * AST + g * 16;
#pragma unroll
    for (int o5 = 0; o5 < 5; ++o5) {
      const int kbase = o5 < 3 ? o5 * 64 : (o5 == 3 ? 192 : 320);
      const int KK = o5 < 3 ? 64 : 128;
      const bf16_t* Wt = (const bf16_t*)(p.ws + (o5 == 0 ? RWW_F : o5 == 1 ? RWW_B : o5 == 2 ? RWW_A : o5 == 3 ? RWW_GF : RWW_GB));
#pragma unroll
      for (int ks = 0; ks < KK / 32; ++ks) {
        const bf16x8 af = *(const bf16x8*)(Arow + (kbase + ks * 32) * 2);
#pragma unroll
        for (int nt = 0; nt < 4; ++nt) {
          const bf16x8 bf = *(const bf16x8*)(Wt + (size_t)(hd * 64 + nt * 16 + r16) * KK + ks * 32 + g * 8);
          acc[o5][nt] = __builtin_amdgcn_mfma_f32_16x16x32_bf16(af, bf, acc[o5][nt], 0, 0, 0);
        }
        if (ks & 1) asm volatile("" ::: "memory");
      }
    }
#pragma unroll
    for (int j = 0; j < 4; ++j) {
      const int tk = tg * 16 + g * 4 + j; const size_t row = (size_t)row0 + tk;
      const char* rk = smem + ROFF + tk * RST;
      const int c0 = hd * 64 + r16 * 4;
      const uint2 ur = *(const uint2*)(rk + c0 * 2), uk = *(const uint2*)(rk + (256 + c0) * 2), uv = *(const uint2*)(rk + (512 + c0) * 2);
      const float rv[4] = {bflo(ur.x), bfhi(ur.x), bflo(ur.y), bfhi(ur.y)};
      const float kv[4] = {bflo(uk.x), bfhi(uk.x), bflo(uk.y), bfhi(uk.y)};
      const float vv[4] = {bflo(uv.x), bfhi(uv.x), bflo(uv.y), bfhi(uv.y)};
      float n2 = 0.f;
#pragma unroll
      for (int nt = 0; nt < 4; ++nt) { float q = kv[nt] * kkc[nt]; n2 += q * q; }
      n2 = sum16(n2);
      const float inv = 1.f / fmaxf(sqrtf(n2), 1e-12f);
      float o_kp[4], o_kk[4], o_b[4], o_df[4], o_db[4];
#pragma unroll
      for (int nt = 0; nt < 4; ++nt) {
        const float k = kv[nt];
        const float a = sigmoidf_(a0c[nt] + acc[2][nt][j]);
        const float kk = k * kkc[nt] * inv;
        o_kp[nt] = k * (1.f + (a - 1.f) * kac[nt]);
        o_kk[nt] = kk; o_b[nt] = kk * a;
        const float xf = -(w0f[nt] + acc[0][nt][j]); const float spf = fmaxf(xf, 0.f) + log1pf(__expf(-fabsf(xf)));
        const float xb = -(w0b[nt] + acc[1][nt][j]); const float spb = fmaxf(xb, 0.f) + log1pf(__expf(-fabsf(xb)));
        const float ef = __expf(-spf - 0.5f), eb = __expf(-spb - 0.5f);
        o_df[nt] = -expm1f(-ef); o_db[nt] = -expm1f(-eb);
      }
      const size_t o = row * 256 + c0;
      uint2 w;
      w.x = pack2(rv[0], rv[1]); w.y = pack2(rv[2], rv[3]); *(uint2*)(S + o) = w;
      w.x = pack2(o_kp[0], o_kp[1]); w.y = pack2(o_kp[2], o_kp[3]); *(uint2*)(S + SU + o) = w;
      w.x = pack2(vv[0], vv[1]); w.y = pack2(vv[2], vv[3]); *(uint2*)(S + 2 * SU + o) = w;
      w.x = pack2(o_kk[0], o_kk[1]); w.y = pack2(o_kk[2], o_kk[3]); *(uint2*)(S + 3 * SU + o) = w;
      w.x = pack2(o_b[0], o_b[1]); w.y = pack2(o_b[2], o_b[3]); *(uint2*)(S + 4 * SU + o) = w;
      w.x = pack2(o_df[0], o_df[1]); w.y = pack2(o_df[2], o_df[3]); *(uint2*)(S + 5 * SU + o) = w;
      w.x = pack2(o_db[0], o_db[1]); w.y = pack2(o_db[2], o_db[3]); *(uint2*)(S + 6 * SU + o) = w;
      w.x = pack2(acc[3][0][j], acc[3][1][j]); w.y = pack2(acc[3][2][j], acc[3][3][j]); *(uint2*)(Gs + o) = w;
      w.x = pack2(acc[4][0][j], acc[4][1][j]); w.y = pack2(acc[4][2][j], acc[4][3][j]); *(uint2*)(Gs + SU + o) = w;
    }
  }
}

DI long scan_row(int b, int dir, int s) {
  if (s < CL) return (long)ML + b * CL + (dir ? (CL - 1 - s) : s);
  int t = s - CL; return (long)b * SL + (dir ? (SL - 1 - t) : t);
}
DI float sum8(float v) {
  v += dpp_mov<0xB1>(v);
  v += dpp_mov<0x4E>(v);
  v += dpp_mov<0x141>(v);
  return v;
}
DI void ph_scan(const Params& p, char* smem) {
  const int tid = my_tid(), lane = tid & 63, wid = tid >> 6;
  const bf16_t* S = (const bf16_t*)(p.ws + R_STR);
  const size_t SU = (size_t)MT * 256;
  constexpr int T = 32, NSTEP = CL + SL, NCH = NSTEP / T;
  typedef float f32x2 __attribute__((ext_vector_type(2)));
  for (int u = blockIdx.x; u < 128; u += gridDim.x) {
    const int chain = u >> 1, rg = u & 1; const int dir = chain & 1, bh = chain >> 1, b = bh >> 2, h = bh & 3;
    bf16_t* O = (bf16_t*)(p.ws + (dir ? R_OB : R_OF));
    uint4 q0, q1, q2;
    auto SC_GLOAD = [&](int ci) {
#pragma unroll
      for (int j = 0; j < 3; ++j) {
        int idx = tid + j * 512; int st = idx >> 8, s = (idx & 255) >> 3, ck = idx & 7;
        long row = scan_row(b, dir, ci * T + s);
        int sid = st < 5 ? st : 5 + dir;
        uint4 v = *(const uint4*)(S + sid * SU + row * 256 + h * 64 + ck * 8);
        if (j == 0) q0 = v; else if (j == 1) q1 = v; else q2 = v;
      }
    };
    auto SC_SSTORE = [&](int buf) {
#pragma unroll
      for (int j = 0; j < 3; ++j) {
        int idx = tid + j * 512; int st = idx >> 8;
        uint4 v = j == 0 ? q0 : (j == 1 ? q1 : q2);
        float4 lo = make_float4(bflo(v.x), bfhi(v.x), bflo(v.y), bfhi(v.y));
        float4 hi = make_float4(bflo(v.z), bfhi(v.z), bflo(v.w), bfhi(v.w));
        if (st == 5) { lo.x = 1.f - lo.x; lo.y = 1.f - lo.y; lo.z = 1.f - lo.z; lo.w = 1.f - lo.w; hi.x = 1.f - hi.x; hi.y = 1.f - hi.y; hi.z = 1.f - hi.z; hi.w = 1.f - hi.w; }
        char* base = smem + buf * 49152 + idx * 32;
        *(float4*)(base) = lo; *(float4*)(base + 16) = hi;
      }
    };
    auto FLUSH = [&](int ci) {
      const int s = tid >> 4, part = tid & 15;
      const float2 v = *(const float2*)(smem + 98304 + (ci & 1) * 4096 + s * 128 + part * 8);
      long row = scan_row(b, dir, ci * T + s);
      *(unsigned*)(O + row * 256 + h * 64 + rg * 32 + part * 2) = pack2(v.x, v.y);
    };
    __syncthreads();
    SC_GLOAD(0);
    SC_SSTORE(0);
    __syncthreads();
    f32x2 st0 = {0.f, 0.f}, st1 = {0.f, 0.f}, st2 = {0.f, 0.f}, st3 = {0.f, 0.f};
    const int rsub = lane >> 3, ks = lane & 7;
    const int lrow = (wid & 3) * 8 + rsub;
    const int vrow = rg * 32 + lrow;
    struct Step { f32x2 r[4], k[4], kk[4], b[4], w[4]; float v; };
    auto LOADSTEP = [&](Step& x, const char* B, int s) {
#pragma unroll
      for (int hh = 0; hh < 2; ++hh) {
        const float4 r = *(const float4*)(B + (0 * T + s) * 256 + ks * 32 + hh * 16);
        const float4 k = *(const float4*)(B + (1 * T + s) * 256 + ks * 32 + hh * 16);
        const float4 kk = *(const float4*)(B + (3 * T + s) * 256 + ks * 32 + hh * 16);
        const float4 bb = *(const float4*)(B + (4 * T + s) * 256 + ks * 32 + hh * 16);
        const float4 w = *(const float4*)(B + (5 * T + s) * 256 + ks * 32 + hh * 16);
        x.r[2 * hh] = (f32x2){r.x, r.y}; x.r[2 * hh + 1] = (f32x2){r.z, r.w};
        x.k[2 * hh] = (f32x2){k.x, k.y}; x.k[2 * hh + 1] = (f32x2){k.z, k.w};
        x.kk[2 * hh] = (f32x2){kk.x, kk.y}; x.kk[2 * hh + 1] = (f32x2){kk.z, kk.w};
        x.b[2 * hh] = (f32x2){bb.x, bb.y}; x.b[2 * hh + 1] = (f32x2){bb.z, bb.w};
        x.w[2 * hh] = (f32x2){w.x, w.y}; x.w[2 * hh + 1] = (f32x2){w.z, w.w};
      }
      x.v = *(const float*)(B + (2 * T + s) * 256 + vrow * 4);
    };
    for (int ci = 0; ci < NCH; ++ci) {
      if (ci + 1 < NCH) { SC_GLOAD(ci + 1); }
      if (ci > 0) FLUSH(ci - 1);
      if (wid < 4) {
        const char* B = smem + (ci & 1) * 49152;
        float* ob = (float*)(smem + 98304 + (ci & 1) * 4096);
        Step nx; LOADSTEP(nx, B, 0);
#pragma unroll 2
        for (int s = 0; s < T; ++s) {
          const Step c = nx;
          LOADSTEP(nx, B, s + 1);
          f32x2 pa = st0 * c.kk[0] + st1 * c.kk[1];
          f32x2 pb = st2 * c.kk[2] + st3 * c.kk[3];
          pa = pa + pb;
          float sa = -(pa.x + pa.y);
          sa = sum8(sa);
          const f32x2 sa2 = {sa, sa}; const f32x2 v2 = {c.v, c.v};
          st0 = st0 * c.w[0] + sa2 * c.b[0] + v2 * c.k[0];
          st1 = st1 * c.w[1] + sa2 * c.b[1] + v2 * c.k[1];
          st2 = st2 * c.w[2] + sa2 * c.b[2] + v2 * c.k[2];
          st3 = st3 * c.w[3] + sa2 * c.b[3] + v2 * c.k[3];
          f32x2 oa = st0 * c.r[0] + st1 * c.r[1];
          f32x2 ob2 = st2 * c.r[2] + st3 * c.r[3];
          oa = oa + ob2;
          float o = sum8(oa.x + oa.y);
          if (ks == 0) ob[s * 32 + lrow] = o;
        }
      }
      if (ci + 1 < NCH) { SC_SSTORE((ci + 1) & 1); }
      __syncthreads();
    }
    FLUSH(NCH - 1);
  }
}

template <bool DIFF>
DI void attn_unit(const Params& p, int l, int b, int h, int qrow0, int qpos0, int kb_lo, int kb_hi, int kc_lo, char* smem) {
  const int tid = my_tid(), lane = tid & 63, wid = tid >> 6, g = lane >> 4, r16 = lane & 15;
  const bf16_t* QK = (const bf16_t*)(p.ws + (DIFF ? R_PDF : R_PSW));
  const int ldq = DIFF ? 512 : 384;
  const int qc0 = h * 64;
  const int kc0 = 256 + (DIFF ? h * 64 : (h >> 1) * 64);
  const bf16_t* VT = DIFF ? (const bf16_t*)(p.ws + R_VTDF) + ((size_t)b * 256 + h * 64) * KEYS
                          : (const bf16_t*)(p.ws + R_VTSW) + ((size_t)b * 128 + (h >> 1) * 64) * KEYS;
  const int nblk = (kb_hi - kb_lo) + (68 - kc_lo);
  const float sc = (DIFF ? 0.17677669529663687f : 0.125f) * 1.4426950408889634f;
  bf16x8 qf[2];
  {
    const bf16_t* qp = QK + (size_t)(qrow0 + wid * 16 + r16) * ldq + qc0 + g * 8;
    qf[0] = *(const bf16x8*)(qp); qf[1] = *(const bf16x8*)(qp + 32);
  }
  constexpr int NC = DIFF ? 2 : 1;
  float m[NC], lsum[NC];
  f32x4 O[NC][4];
#pragma unroll
  for (int c = 0; c < NC; ++c) {
    if (DIFF) { m[c] = -1e30f; lsum[c] = 0.f; }
    else { m[c] = p.in[16][l * 4 + h] * 1.4426950408889634f; lsum[c] = (g == 0) ? 1.f : 0.f; }
#pragma unroll
    for (int dt = 0; dt < 4; ++dt) O[c][dt] = (f32x4){0.f, 0.f, 0.f, 0.f};
  }
  const int lr = tid >> 3, lc = tid & 7;
  uint4 rkA, rvA, rkB, rvB;
  rkA = make_uint4(0, 0, 0, 0); rvA = rkA; rkB = rkA; rvB = rkA;
  auto AT_GLOAD = [&](int i, uint4& rk, uint4& rv) {
    int kb = i < (kb_hi - kb_lo) ? kb_lo + i : kc_lo + (i - (kb_hi - kb_lo));
    long krow = kb < 64 ? (long)b * SL + kb * 64 + lr : (long)ML + b * CL + (kb - 64) * 64 + lr;
    rk = *(const uint4*)(QK + krow * ldq + kc0 + lc * 8);
    rv = *(const uint4*)(VT + (size_t)lr * KEYS + kb * 64 + lc * 8);
  };
  auto AT_SSTORE = [&](int buf, const uint4& rk, const uint4& rv) {
    *(uint4*)(smem + buf * 18432 + lr * 128 + ((lc ^ (lr & 7)) << 4)) = rk;
    *(uint4*)(smem + buf * 18432 + 9216 + lr * 144 + lc * 16) = rv;
  };
  __syncthreads();
  AT_GLOAD(0, rkA, rvA);
  AT_SSTORE(0, rkA, rvA);
  if (1 < nblk) AT_GLOAD(1, rkA, rvA);
  if (2 < nblk) AT_GLOAD(2, rkB, rvB);
  lds_barrier();
  const int qpos = qpos0 + wid * 16 + r16;
  for (int i = 0; i < nblk; ++i) {
    const int kb = i < (kb_hi - kb_lo) ? kb_lo + i : kc_lo + (i - (kb_hi - kb_lo));
    const bool masked = (!DIFF) && (kb < 64);
    const char* Kt = smem + (i & 1) * 18432; const char* Vt = Kt + 9216;
    f32x4 S[NC][4];
#pragma unroll
    for (int kt = 0; kt < 4; ++kt) {
      bf16x8 k0 = *(const bf16x8*)(Kt + (kt * 16 + r16) * 128 + ((g ^ (r16 & 7)) << 4));
      bf16x8 k1 = *(const bf16x8*)(Kt + (kt * 16 + r16) * 128 + (((4 + g) ^ (r16 & 7)) << 4));
      if (DIFF) {
        S[0][kt] = __builtin_amdgcn_mfma_f32_16x16x32_bf16(k0, qf[0], (f32x4){0.f, 0.f, 0.f, 0.f}, 0, 0, 0);
        S[NC - 1][kt] = __builtin_amdgcn_mfma_f32_16x16x32_bf16(k1, qf[1], (f32x4){0.f, 0.f, 0.f, 0.f}, 0, 0, 0);
      } else {
        f32x4 t = __builtin_amdgcn_mfma_f32_16x16x32_bf16(k0, qf[0], (f32x4){0.f, 0.f, 0.f, 0.f}, 0, 0, 0);
        S[0][kt] = __builtin_amdgcn_mfma_f32_16x16x32_bf16(k1, qf[1], t, 0, 0, 0);
      }
    }
    bf16x8 pf[NC][2];
#pragma unroll
    for (int c = 0; c < NC; ++c) {
      float mx = -1e30f;
#pragma unroll
      for (int kt = 0; kt < 4; ++kt)
#pragma unroll
        for (int j = 0; j < 4; ++j) {
          float v = S[c][kt][j];
          if (masked) { int kpos = kb * 64 + kt * 16 + g * 4 + j; int dd = kpos - qpos; if (dd > 128 || dd < -128) v = -3e38f; S[c][kt][j] = v; }
          mx = fmaxf(mx, v);
        }
      mx *= sc;
      mx = fmaxf(mx, __shfl_xor(mx, 16)); mx = fmaxf(mx, __shfl_xor(mx, 32));
      const float mn = fmaxf(m[c], mx);
      const bool grow = mn > m[c];
      float ps = 0.f;
      unsigned pk[8];
#pragma unroll
      for (int kt = 0; kt < 4; ++kt) {
        float e0 = __builtin_amdgcn_exp2f(fmaf(S[c][kt][0], sc, -mn)), e1 = __builtin_amdgcn_exp2f(fmaf(S[c][kt][1], sc, -mn));
        float e2 = __builtin_amdgcn_exp2f(fmaf(S[c][kt][2], sc, -mn)), e3 = __builtin_amdgcn_exp2f(fmaf(S[c][kt][3], sc, -mn));
        ps += (e0 + e1) + (e2 + e3);
        pk[kt * 2] = pack2(e0, e1); pk[kt * 2 + 1] = pack2(e2, e3);
      }
      if (__builtin_amdgcn_ballot_w64(grow) != 0ull) {
        const float alpha = __builtin_amdgcn_exp2f(m[c] - mn);
        m[c] = mn;
        lsum[c] *= alpha;
#pragma unroll
        for (int dt = 0; dt < 4; ++dt) { O[c][dt][0] *= alpha; O[c][dt][1] *= alpha; O[c][dt][2] *= alpha; O[c][dt][3] *= alpha; }
      }
      lsum[c] += ps;
      union { unsigned u[4]; bf16x8 v; } cv;
      cv.u[0] = pk[0]; cv.u[1] = pk[1]; cv.u[2] = pk[2]; cv.u[3] = pk[3]; pf[c][0] = cv.v;
      cv.u[0] = pk[4]; cv.u[1] = pk[5]; cv.u[2] = pk[6]; cv.u[3] = pk[7]; pf[c][1] = cv.v;
    }
#pragma unroll
    for (int dt = 0; dt < 4; ++dt)
#pragma unroll
      for (int s2 = 0; s2 < 2; ++s2) {
        union { uint2 u[2]; bf16x8 v; } vf;
        vf.u[0] = *(const uint2*)(Vt + (dt * 16 + r16) * 144 + (2 * s2) * 32 + g * 8);
        vf.u[1] = *(const uint2*)(Vt + (dt * 16 + r16) * 144 + (2 * s2 + 1) * 32 + g * 8);
#pragma unroll
        for (int c = 0; c < NC; ++c) O[c][dt] = __builtin_amdgcn_mfma_f32_16x16x32_bf16(vf.v, pf[c][s2], O[c][dt], 0, 0, 0);
      }
    if (i + 1 < nblk) AT_SSTORE((i + 1) & 1, rkA, rvA);
    rkA = rkB; rvA = rvB;
    if (i + 3 < nblk) AT_GLOAD(i + 3, rkB, rvB);
    lds_barrier();
  }
  float linv[NC];
#pragma unroll
  for (int c = 0; c < NC; ++c) { float t = lsum[c]; t += __shfl_xor(t, 16); t += __shfl_xor(t, 32); linv[c] = 1.f / t; }
  const size_t orow = (size_t)(qrow0 + wid * 16 + r16);
  if (!DIFF) {
    bf16_t* Y = (bf16_t*)(p.ws + R_YSW);
#pragma unroll
    for (int dt = 0; dt < 4; ++dt) {
      uint2 o; o.x = pack2(O[0][dt][0] * linv[0], O[0][dt][1] * linv[0]); o.y = pack2(O[0][dt][2] * linv[0], O[0][dt][3] * linv[0]);
      *(uint2*)(Y + orow * 256 + h * 64 + dt * 16 + g * 4) = o;
    }
  } else {
    const float lam_init = 0.8f - 0.6f * __expf(-0.3f * (float)l);
    float d1 = 0.f, d2 = 0.f;
    if (lane < 32) { d1 = p.in[28][l * 32 + lane] * p.in[29][l * 32 + lane]; d2 = p.in[30][l * 32 + lane] * p.in[31][l * 32 + lane]; }
    d1 = wave_sum(d1); d2 = wave_sum(d2);
    const float lam = expf(d1) - expf(d2) + lam_init;
    float ov[4][4]; float ss = 0.f;
#pragma unroll
    for (int dt = 0; dt < 4; ++dt)
#pragma unroll
      for (int j = 0; j < 4; ++j) { float v = O[0][dt][j] * linv[0] - lam * O[NC - 1][dt][j] * linv[NC - 1]; ov[dt][j] = v; ss += v * v; }
    ss += __shfl_xor(ss, 16); ss += __shfl_xor(ss, 32);
    const float rms = rsqrtf(ss * (1.f / 64.f) + 1e-5f) * (1.f - lam_init);
    const float* sg = p.in[32] + l * 64;
    bf16_t* Y = (bf16_t*)(p.ws + R_YDF);
#pragma unroll
    for (int dt = 0; dt < 4; ++dt) {
      const int d0 = dt * 16 + g * 4;
      uint2 o; o.x = pack2(ov[dt][0] * rms * sg[d0], ov[dt][1] * rms * sg[d0 + 1]); o.y = pack2(ov[dt][2] * rms * sg[d0 + 2], ov[dt][3] * rms * sg[d0 + 3]);
      *(uint2*)(Y + orow * 256 + h * 64 + d0) = o;
    }
  }
}

DI void ph_attn(const Params& p, int l, char* smem) {
  const bool need_ctx = (l == 0);
  const int n_sw = 1024 + (need_ctx ? 64 : 0);
  const int n_df = 1024 + (need_ctx ? 64 : 0);
  unsigned* ctr = (unsigned*)(p.ws + MISC_BAR + 64 + 64 * l);
  volatile int* slot = (volatile int*)(smem + 40960);
  for (;;) {
    __syncthreads();
    if (my_tid() == 0) *slot = (int)__hip_atomic_fetch_add(ctr, 1u, __ATOMIC_RELAXED, __HIP_MEMORY_SCOPE_AGENT);
    __syncthreads();
    const int u = *slot;
    if (u >= n_sw + n_df) break;
    if (u < n_df) {
      if (u < 1024) { int b = u >> 7, h = (u >> 5) & 3, n = u & 31; attn_unit<true>(p, l, b, h, b * SL + n * 128, n * 128, 0, 64, 64, smem); }
      else { int v = u - 1024; int b = v >> 3, h = (v >> 1) & 3, n = v & 1; attn_unit<true>(p, l, b, h, ML + b * CL + n * 128, 0, 0, 0, 64, smem); }
    } else {
      int w = u - n_df;
      if (w < 1024) {
        int b = w >> 7, h = (w >> 5) & 3, n = w & 31;
        int lo = (n - 1) * 2; if (lo < 0) lo = 0; int hi = (n + 2) * 2; if (hi > 64) hi = 64;
        attn_unit<false>(p, l, b, h, b * SL + n * 128, n * 128, lo, hi, 64, smem);
      } else { int v = w - 1024; int b = v >> 3, h = (v >> 1) & 3, n = v & 1; attn_unit<false>(p, l, b, h, ML + b * CL + n * 128, 0, 0, 0, 64, smem); }
    }
  }
}

DI void ph_rwout(const Params& p, int l) {
  const int lane = my_tid() & 63, wid = my_tid() >> 6;
  const bf16_t* S = (const bf16_t*)(p.ws + R_STR); const bf16_t* Gs = (const bf16_t*)(p.ws + R_G);
  const bf16_t* OF = (const bf16_t*)(p.ws + R_OF); const bf16_t* OB = (const bf16_t*)(p.ws + R_OB);
  bf16_t* Y = (bf16_t*)(p.ws + R_YRW);
  const size_t SU = (size_t)MT * 256;
  const float4 rk = *(const float4*)(p.in[25] + (size_t)l * 256 + lane * 4);
  const float4 gam = *(const float4*)(p.in[26] + (size_t)l * 256 + lane * 4);
  const float4 bet = *(const float4*)(p.in[27] + (size_t)l * 256 + lane * 4);
  const int nrows = (l == 0) ? MT : ML;
  for (int row = blockIdx.x * 8 + wid; row < nrows; row += gridDim.x * 8) {
    const size_t o = (size_t)row * 256 + lane * 4;
    uint2 ur = *(const uint2*)(S + o), uk = *(const uint2*)(S + SU + o), uv = *(const uint2*)(S + 2 * SU + o);
    uint2 uf = *(const uint2*)(OF + o), ub = *(const uint2*)(OB + o), ugf = *(const uint2*)(Gs + o), ugb = *(const uint2*)(Gs + SU + o);
    float r[4] = {bflo(ur.x), bfhi(ur.x), bflo(ur.y), bfhi(ur.y)};
    float k[4] = {bflo(uk.x), bfhi(uk.x), bflo(uk.y), bfhi(uk.y)};
    float v[4] = {bflo(uv.x), bfhi(uv.x), bflo(uv.y), bfhi(uv.y)};
    float f[4] = {bflo(uf.x), bfhi(uf.x), bflo(uf.y), bfhi(uf.y)};
    float bb[4] = {bflo(ub.x), bfhi(ub.x), bflo(ub.y), bfhi(ub.y)};
    float gf[4] = {bflo(ugf.x), bfhi(ugf.x), bflo(ugf.y), bfhi(ugf.y)};
    float gb[4] = {bflo(ugb.x), bfhi(ugb.x), bflo(ugb.y), bfhi(ugb.y)};
    const float rkv[4] = {rk.x, rk.y, rk.z, rk.w}; const float ga[4] = {gam.x, gam.y, gam.z, gam.w}; const float be[4] = {bet.x, bet.y, bet.z, bet.w};
    float bon = 0.f, sf = 0.f, sb = 0.f;
#pragma unroll
    for (int i = 0; i < 4; ++i) { bon += r[i] * k[i] * rkv[i]; sf += f[i]; sb += bb[i]; }
    bon = sum16(bon); float muf = sum16(sf) * (1.f / 64.f), mub = sum16(sb) * (1.f / 64.f);
    float qf = 0.f, qb = 0.f;
#pragma unroll
    for (int i = 0; i < 4; ++i) { f[i] -= muf; bb[i] -= mub; qf += f[i] * f[i]; qb += bb[i] * bb[i]; }
    float rsf = rsqrtf(sum16(qf) * (1.f / 64.f) + 64e-5f), rsb = rsqrtf(sum16(qb) * (1.f / 64.f) + 64e-5f);
    float y[4];
#pragma unroll
    for (int i = 0; i < 4; ++i) {
      float bn = bon * v[i];
      y[i] = (f[i] * rsf * ga[i] + be[i] + bn) * gf[i] + (bb[i] * rsb * ga[i] + be[i] + bn) * gb[i];
    }
    uint2 oo; oo.x = pack2(y[0], y[1]); oo.y = pack2(y[2], y[3]);
    *(uint2*)(Y + o) = oo;
  }
}

DI void ph_merge(const Params& p, int l, const bf16_t* U, char* smem) {
  const int lane = my_tid() & 63, wid = my_tid() >> 6, wm = wid >> 1, wn = wid & 1, g = lane >> 4, r16 = lane & 15;
  const int mtiles = (l == 0) ? 136 : 128;
  bf16_t* ACC = (bf16_t*)(p.ws + R_ACC);
  for (int it = 0;; ++it) {
    int mtile, ntile;
    if (!next_tile(it, mtiles, 8, mtile, ntile)) break;
    uint2 accS[4][4];
#pragma unroll
    for (int mt = 0; mt < 4; ++mt)
#pragma unroll
      for (int nt = 0; nt < 4; ++nt) accS[mt][nt] = make_uint2(0u, 0u);
    for (int j = 0; j < 4; ++j) {
      uint2 pb[4][4];
      {
        f32x4 accB[4][4]; zero_acc<4>(accB);
        const size_t yoff = (j == 0) ? R_YHY : (j == 1) ? R_YSW : (j == 2) ? R_YRW : R_YDF;
        gemm_glds(accB, (const bf16_t*)(p.ws + yoff), 256, RowPlain{(long)mtile * 256}, (const bf16_t*)(p.ws + WB_BR) + ((size_t)j * 1024 + ntile * 128) * 256, 256, 256, smem, (const bf16_t*)(p.ws + MISC_ZERO));
#pragma unroll
        for (int mt = 0; mt < 4; ++mt)
#pragma unroll
          for (int nt = 0; nt < 4; ++nt) { pb[mt][nt].x = pack2(accB[mt][nt][0], accB[mt][nt][1]); pb[mt][nt].y = pack2(accB[mt][nt][2], accB[mt][nt][3]); }
      }
      f32x4 accG[4][4]; zero_acc<4>(accG);
      gemm_glds(accG, U, 1024, RowPlain{(long)mtile * 256}, (const bf16_t*)(p.ws + WB_GATE) + ((size_t)j * 1024 + ntile * 128) * 1024, 1024, 1024, smem, (const bf16_t*)(p.ws + MISC_ZERO));
#pragma unroll
      for (int mt = 0; mt < 4; ++mt)
#pragma unroll
        for (int nt = 0; nt < 4; ++nt) {
          float v0 = bflo(accS[mt][nt].x) + sigmoidf_(accG[mt][nt][0]) * bflo(pb[mt][nt].x);
          float v1 = bfhi(accS[mt][nt].x) + sigmoidf_(accG[mt][nt][1]) * bfhi(pb[mt][nt].x);
          float v2 = bflo(accS[mt][nt].y) + sigmoidf_(accG[mt][nt][2]) * bflo(pb[mt][nt].y);
          float v3 = bfhi(accS[mt][nt].y) + sigmoidf_(accG[mt][nt][3]) * bfhi(pb[mt][nt].y);
          accS[mt][nt].x = pack2(v0, v1); accS[mt][nt].y = pack2(v2, v3);
        }
    }
#pragma unroll
    for (int mt = 0; mt < 4; ++mt) {
      const int col = ntile * 128 + wn * 64 + r16 * 4;
      const size_t row = (size_t)mtile * 256 + wm * 64 + mt * 16 + g * 4;
      uint2 o;
      o.x = (accS[mt][0].x & 0xffffu) | (accS[mt][1].x << 16); o.y = (accS[mt][2].x & 0xffffu) | (accS[mt][3].x << 16);
      *(uint2*)(ACC + (row + 0) * 1024 + col) = o;
      o.x = (accS[mt][0].x >> 16) | (accS[mt][1].x & 0xffff0000u); o.y = (accS[mt][2].x >> 16) | (accS[mt][3].x & 0xffff0000u);
      *(uint2*)(ACC + (row + 1) * 1024 + col) = o;
      o.x = (accS[mt][0].y & 0xffffu) | (accS[mt][1].y << 16); o.y = (accS[mt][2].y & 0xffffu) | (accS[mt][3].y << 16);
      *(uint2*)(ACC + (row + 2) * 1024 + col) = o;
      o.x = (accS[mt][0].y >> 16) | (accS[mt][1].y & 0xffff0000u); o.y = (accS[mt][2].y >> 16) | (accS[mt][3].y & 0xffff0000u);
      *(uint2*)(ACC + (row + 3) * 1024 + col) = o;
    }
  }
}

DI void ph_resgemm(const Params& p, int l, const bf16_t* A, int K, const bf16_t* Bt, const float* hsrc_lat, const float* hsrc_ctx, int gate_off, char* smem) {
  const int lane = my_tid() & 63, wid = my_tid() >> 6, wm = wid >> 1, wn = wid & 1, g = lane >> 4, r16 = lane & 15;
  const int mtiles = (l == 0) ? 136 : 128;
  const float* mod = (const float*)(p.ws + MISC_MOD) + (size_t)l * 9 * 6144;
  float* hc = (float*)(p.ws + OFF_HC);
  for (int it = 0;; ++it) {
    int mtile, ntile;
    if (!next_tile(it, mtiles, 8, mtile, ntile)) break;
    f32x4 acc[4][4]; zero_acc<4>(acc);
    gemm_glds(acc, A, K, RowPlain{(long)mtile * 256}, Bt + (size_t)ntile * 128 * K, K, K, smem, (const bf16_t*)(p.ws + MISC_ZERO));
    const int b = mtile < 128 ? (mtile >> 4) : 8;
    const float* gt = mod + (size_t)b * 6144 + gate_off;
    const int col = ntile * 128 + wn * 64 + r16 * 4;
    const float4 gv = *(const float4*)(gt + col);
#pragma unroll
    for (int mt = 0; mt < 4; ++mt)
#pragma unroll
      for (int e = 0; e < 4; ++e) {
        const int row = mtile * 256 + wm * 64 + mt * 16 + g * 4 + e;
        const float* hs; float* hd;
        if (row < ML) { size_t o = (size_t)row * D + col; hs = hsrc_lat + o; hd = p.out + o; }
        else { size_t o = (size_t)(row - ML) * D + col; hs = hsrc_ctx + o; hd = hc + o; }
        const float4 h = *(const float4*)hs;
        float4 r;
        r.x = DN_ALPHA * h.x + gv.x * acc[mt][0][e]; r.y = DN_ALPHA * h.y + gv.y * acc[mt][1][e];
        r.z = DN_ALPHA * h.z + gv.z * acc[mt][2][e]; r.w = DN_ALPHA * h.w + gv.w * acc[mt][3][e];
        *(float4*)hd = r;
      }
  }
}

DI void ph_ffnup(const Params& p, int l, char* smem) {
  const bf16_t* U = (const bf16_t*)(p.ws + R_U);
  const bf16_t* Bt = (const bf16_t*)(p.ws + WB_UP);
  bf16_t* HID = (bf16_t*)(p.ws + R_HID);
  const float* cw = p.in[38] + (size_t)l * 3 * 5632; const float* cb = p.in[39] + (size_t)l * 5632;
  const int tid = my_tid(), lane = tid & 63, wid = tid >> 6, wm = wid >> 2, wn = wid & 3, g = lane >> 4, r16 = lane & 15;
  const int mtiles = (l == 0) ? 144 : 136;
  constexpr int TS = 528;
  for (int it = 0;; ++it) {
    int mtile, ntile;
    if (!next_tile(it, mtiles, 22, mtile, ntile)) break;
    long rowbase; int t0, len, r0, r1;
    if (mtile < 136) { int b = mtile / 17; int tt = mtile % 17; len = SL; rowbase = (long)b * SL; t0 = tt * 254 - 1; r0 = 1; r1 = 254; }
    else { int b = mtile - 136; len = CL; rowbase = (long)ML + b * CL; t0 = 0; r0 = 0; r1 = 255; }
    f32x4 acc[8][4]; zero_acc256(acc);
    gemm_glds256(acc, U, 1024, rowbase + t0, Bt + (size_t)ntile * 256 * 1024, 1024, 1024, smem);
#pragma unroll
    for (int mt = 0; mt < 8; ++mt)
#pragma unroll
      for (int e = 0; e < 4; ++e) {
        uint2 o; o.x = pack2(acc[mt][0][e], acc[mt][1][e]); o.y = pack2(acc[mt][2][e], acc[mt][3][e]);
        *(uint2*)(smem + (wm * 128 + mt * 16 + g * 4 + e) * TS + (wn * 64 + r16 * 4) * 2) = o;
      }
    __syncthreads();
    {
      const int ch = tid & 127, rgp = tid >> 7; const int ca = ntile * 128 + ch, cbx = 2816 + ca;
      const float a0 = cw[ca], a1 = cw[5632 + ca], a2 = cw[2 * 5632 + ca], ab = cb[ca];
      const float b0 = cw[cbx], b1 = cw[5632 + cbx], b2 = cw[2 * 5632 + cbx], bb = cb[cbx];
      for (int r = r0 + rgp; r <= r1; r += 4) {
        const int tok = t0 + r;
        if (tok < len) {
          const char* Tr = smem + r * TS + ch * 2;
          const float pa = tok >= 1 ? bf2f(*(const bf16_t*)(Tr - TS)) : 0.f, pb_ = tok >= 1 ? bf2f(*(const bf16_t*)(Tr - TS + 256)) : 0.f;
          const float na = tok + 1 < len ? bf2f(*(const bf16_t*)(Tr + TS)) : 0.f, nb = tok + 1 < len ? bf2f(*(const bf16_t*)(Tr + TS + 256)) : 0.f;
          const float av = a0 * pa + a1 * bf2f(*(const bf16_t*)(Tr)) + a2 * na + ab;
          const float bv = b0 * pb_ + b1 * bf2f(*(const bf16_t*)(Tr + 256)) + b2 * nb + bb;
          HID[(size_t)(rowbase + tok) * 2816 + ca] = (bf16_t)f2bf(siluf_(av) * bv);
        }
      }
    }
  }
}

#ifndef REP_PREP
#define REP_PREP 1
#endif
#ifndef REP_GEMM
#define REP_GEMM 1
#endif
#ifndef REP_HY
#define REP_HY 1
#endif
#ifndef REP_RWP
#define REP_RWP 1
#endif
#ifndef REP_SCAN
#define REP_SCAN 1
#endif
#ifndef REP_ATTN
#define REP_ATTN 1
#endif
#ifndef PH_END
#define PH_END 24
#endif
#define XB_TMO      128
#define XB_XCNT(j)  (256  + 64 * (j))
#define XB_XSUB(j)  (1280 + 64 * (j))
#define XB_XGEN(j)  (2304 + 64 * (j))
#define XB_TOP      3328
#define XB_TOPGEN   3392
#define XCD_BAR_WORDS 3456
#define XB_SPIN_CAP (1u << 22)
DI unsigned xb_ld(unsigned* p) { return __hip_atomic_load(p, __ATOMIC_RELAXED, __HIP_MEMORY_SCOPE_AGENT); }
DI unsigned xb_add(unsigned* p, unsigned v) { return __hip_atomic_fetch_add(p, v, __ATOMIC_RELAXED, __HIP_MEMORY_SCOPE_AGENT); }
DI unsigned xb_xcc_id() { return (unsigned)__builtin_amdgcn_s_getreg((3 << 11) | 20) & 0xFu; }
#define XB_SPIN(cond, bar) do { unsigned _sp = 0; while (cond) { __builtin_amdgcn_s_sleep(1); \
    if ((++_sp & 255u) == 0u) { if (xb_ld(&(bar)[XB_TMO])) break; if (_sp > XB_SPIN_CAP) { atomicAdd(&(bar)[XB_TMO], 1u); break; } } } } while (0)
DI void xcd_barrier_complete(unsigned* bar, unsigned x, unsigned& nloc, unsigned& nx) {
  const unsigned G = gridDim.x;
  unsigned sum, cnt, mine, sp = 0u;
  for (;;) {
    sum = 0u; cnt = 0u; mine = 0u;
#pragma unroll
    for (unsigned j = 0; j < 16; ++j) { const unsigned c = xb_ld(&bar[XB_XCNT(j)]); sum += c; cnt += (c > 0u) ? 1u : 0u; mine = (j == x) ? c : mine; }
    if (sum == G) break;
    __builtin_amdgcn_s_sleep(1);
    if ((++sp & 255u) == 0u) { if (xb_ld(&bar[XB_TMO])) break; if (sp > XB_SPIN_CAP) { atomicAdd(&bar[XB_TMO], 1u); break; } }
  }
  nloc = mine > 0u ? mine : 1u; nx = cnt > 0u ? cnt : 1u;
}
DI void grid_barrier(unsigned* bar, volatile unsigned* st) {
  asm volatile("s_waitcnt vmcnt(0)" ::: "memory");
  __syncthreads();
  if (my_tid() == 0) {
    const unsigned x = xb_xcc_id();
    __builtin_amdgcn_s_waitcnt(0);
    unsigned nloc = st[0], nx = st[1];
    if (nloc == 0u) { xcd_barrier_complete(bar, x, nloc, nx); st[0] = nloc; st[1] = nx; }
    const unsigned old = xb_add(&bar[XB_XSUB(x)], 1u);
    const unsigned gen = old / nloc;
    if (old + 1u == (gen + 1u) * nloc) {
      __builtin_amdgcn_fence(__ATOMIC_RELEASE, "agent");
      asm volatile("s_waitcnt vmcnt(0)" ::: "memory");
      const unsigned og = xb_add(&bar[XB_TOP], 1u);
      const unsigned tg = og / nx;
      if (og + 1u == (tg + 1u) * nx) xb_add(&bar[XB_TOPGEN], 1u);
      else XB_SPIN(xb_ld(&bar[XB_TOPGEN]) == tg, bar);
      __builtin_amdgcn_fence(__ATOMIC_ACQUIRE, "agent");
      xb_add(&bar[XB_XGEN(x)], 1u);
      asm volatile("s_waitcnt vmcnt(0)" ::: "memory");
    } else {
      XB_SPIN(xb_ld(&bar[XB_XGEN(x)]) == gen, bar);
      __builtin_amdgcn_fence(__ATOMIC_ACQUIRE, "agent");
      asm volatile("s_waitcnt vmcnt(0)" ::: "memory");
    }
  }
  __syncthreads();
}
#define SYNC_OR_RET(idx) do { if ((idx) + 1 >= PH_END) return; if ((idx) == 0) { grid.sync(); if (my_tid() == 0) (void)xb_add(&((unsigned*)(p.ws + MISC_XBAR))[XB_XCNT(xb_xcc_id())], 1u); } else grid_barrier((unsigned*)(p.ws + MISC_XBAR), (volatile unsigned*)(smem + 144 * 1024)); } while (0)
template <int l>
DI void run_layer(const Params& p, cg::grid_group& grid, char* smem, unsigned& epoch) {
  const float* mod = (const float*)(p.ws + MISC_MOD) + (size_t)l * 9 * 6144;
  float* hc = (float*)(p.ws + OFF_HC);
  const float* hl_src = (l == 0) ? p.in[0] : p.out;
  const float* hc_src = (l == 0) ? p.in[2] : hc;
  constexpr int B0 = l * 12;
  if (l == 0) {
    ph_convert(p, 0, smem);
    ph_ada(p, smem);
    hy_rawfilter(p, 0, SL, (float*)(p.ws + R_RAWF), smem);
    hy_rawfilter(p, 0, CL, (float*)(p.ws + MISC_RAWC), smem);
    SYNC_OR_RET(B0 + 0);
    ph_kf(p, 0, smem);
    ph_ln(hl_src, hc_src, nullptr, nullptr, nullptr, nullptr, (bf16_t*)p.out, mod, 0, MT);
    SYNC_OR_RET(B0 + 1);
  }
  for (int rep = 0; rep < REP_GEMM; ++rep) ph_inproj(p, l == 0 ? (const bf16_t*)p.out : (const bf16_t*)(p.ws + R_U), smem);
  SYNC_OR_RET(B0 + 2);
  for (int rep = 0; rep < REP_HY; ++rep) {
  if (blockIdx.x == 0 && my_tid() == 0) *(unsigned*)(p.ws + MISC_BAR + 64 + 64 * l) = 0u;
  ph_hyena(p, l, smem);
  if (l == 0) ph_hyena_ctx(p, l, smem);
  }
  ph_rope(p, smem);
  for (int rep = 0; rep < REP_RWP; ++rep) ph_rwprep(p, l, smem);
  SYNC_OR_RET(B0 + 3);
  for (int rep = 0; rep < REP_SCAN; ++rep) ph_scan(p, smem);
  for (int rep = 0; rep < REP_ATTN; ++rep) ph_attn(p, l, smem);
  SYNC_OR_RET(B0 + 4);
  ph_rwout(p, l);
  if (l != 0) ph_ln(hl_src, hc_src, nullptr, nullptr, nullptr, nullptr, (bf16_t*)(p.ws + R_URE), mod, 0, ML);
  SYNC_OR_RET(B0 + 5);
  for (int rep = 0; rep < REP_GEMM; ++rep) ph_merge(p, l, l == 0 ? (const bf16_t*)p.out : (const bf16_t*)(p.ws + R_URE), smem);
  SYNC_OR_RET(B0 + 6);
  ph_resgemm(p, l, (const bf16_t*)(p.ws + R_ACC), 1024, (const bf16_t*)(p.ws + WB_OUT), hl_src, hc_src, 2048, smem);
  if (l == 0) hy_rawfilter(p, 1, SL, (float*)(p.ws + R_RAWF), smem);
  SYNC_OR_RET(B0 + 7);
  ph_ln(p.out, hc, p.out, hc, p.in[35] + (size_t)l * D, p.in[36] + (size_t)l * D, (bf16_t*)(p.ws + R_U), mod, 3072, l == 0 ? MT : ML);
  if (l == 0) ph_kf(p, 1, smem);
  SYNC_OR_RET(B0 + 8);
  for (int rep = 0; rep < REP_GEMM; ++rep) ph_ffnup(p, l, smem);
  SYNC_OR_RET(B0 + 9);
  ph_resgemm(p, l, (const bf16_t*)(p.ws + R_HID), 2816, (const bf16_t*)(p.ws + WB_DOWN), p.out, hc, 5120, smem);
  SYNC_OR_RET(B0 + 10);
  if (l == 0) {
    ph_ln(p.out, hc, p.out, hc, p.in[41], p.in[42], (bf16_t*)(p.ws + R_U), mod + 9 * 6144, 0, MT);
    ph_convert(p, 1, smem);
  } else {
    ph_ln(p.out, hc, p.out, hc, p.in[41] + (size_t)l * D, p.in[42] + (size_t)l * D, nullptr, mod, 0, ML);
  }
  SYNC_OR_RET(B0 + 11);
}

__global__ void __launch_bounds__(NTHR) mega(Params p) {
  extern __shared__ __attribute__((aligned(16))) char smem[];
  cg::grid_group grid = cg::this_grid();
  unsigned epoch = 0;
  if (blockIdx.x == 0) for (int i = my_tid(); i < XCD_BAR_WORDS; i += NTHR) ((unsigned*)(p.ws + MISC_XBAR))[i] = 0u;
  if (my_tid() < 2) ((volatile unsigned*)(smem + 144 * 1024))[my_tid()] = 0u;
  if (blockIdx.x == 0 && my_tid() < 64) *(unsigned*)(p.ws + MISC_ZERO + my_tid() * 4) = 0u;
  run_layer<0>(p, grid, smem, epoch);
  if (PH_END > 12) run_layer<1>(p, grid, smem, epoch);
}

extern "C" void kernel_launch(void* const* d_in, const int* in_sizes, int n_in, void* d_out, int out_size,
                              void* d_ws, size_t ws_size, hipStream_t stream) {
  static int grid_blocks = 0;
  if (!grid_blocks) {
    int dev = 0, cus = 0, per_cu = 0;
    (void)hipGetDevice(&dev);
    (void)hipDeviceGetAttribute(&cus, hipDeviceAttributeMultiprocessorCount, dev);
    (void)hipFuncSetAttribute((const void*)mega, hipFuncAttributeMaxDynamicSharedMemorySize, SMEM_BYTES);
    (void)hipOccupancyMaxActiveBlocksPerMultiprocessor(&per_cu, mega, NTHR, SMEM_BYTES);
    if (per_cu < 1) per_cu = 1;
    if (per_cu > 1) per_cu = 1;
    grid_blocks = cus * per_cu;
  }
  Params p{};
  for (int i = 0; i < 43; ++i) p.in[i] = (const float*)d_in[i];
  p.out = (float*)d_out; p.ws = (char*)d_ws;
  void* args[] = {&p};
  hipError_t e = hipLaunchCooperativeKernel((void*)mega, dim3(grid_blocks), dim3(NTHR), args, SMEM_BYTES, stream);
  if (e != hipSuccess) fprintf(stderr, "cooperative launch failed: %s (grid %d)\n", hipGetErrorString(e), grid_blocks);
}
```

```cpp
#include <hip/hip_runtime.h>
#include <hip/hip_cooperative_groups.h>
#include <cstdio>
#include <cstdint>
namespace cg = cooperative_groups;

#define DI __device__ __forceinline__
typedef unsigned short bf16_t;
typedef short bf16x8 __attribute__((ext_vector_type(8)));
typedef float f32x4 __attribute__((ext_vector_type(4)));

constexpr int D = 1024, NB = 8, SL = 4096, CL = 256;
constexpr int ML = NB * SL, MC = NB * CL, MT = ML + MC;
constexpr int KEYS = SL + CL;
constexpr int NTHR = 512;
constexpr float DN_ALPHA = 1.41421356237f;
constexpr size_t UNIT = (size_t)MT * 512;

constexpr size_t WB_IN = 0;
constexpr size_t WB_GATE = WB_IN + (size_t)3328 * 1024 * 2;
constexpr size_t WB_BR = WB_GATE + (size_t)4096 * 1024 * 2;
constexpr size_t WB_OUT = WB_BR + (size_t)4 * 1024 * 256 * 2;
constexpr size_t WB_UP = WB_OUT + (size_t)1024 * 1024 * 2;
constexpr size_t WB_DOWN = WB_UP + (size_t)5632 * 1024 * 2;
constexpr size_t WB_END = WB_DOWN + (size_t)1024 * 2816 * 2;
constexpr size_t OFF_KF = WB_END;
constexpr size_t OFF_HC = OFF_KF + (size_t)512 * 8192 * 8;
constexpr size_t OFF_MISC = OFF_HC + (size_t)MC * D * 4;
constexpr size_t MISC_MOD = OFF_MISC;
constexpr size_t MISC_TW = MISC_MOD + (size_t)2 * 9 * 6144 * 4;
constexpr size_t MISC_RAWC = MISC_TW + 4096 * 8;
constexpr size_t MISC_GCTX = MISC_RAWC + (size_t)256 * 1024 * 4;
constexpr size_t MISC_RWW = MISC_GCTX + (size_t)512 * 512 * 4;
constexpr size_t RWW_F = MISC_RWW, RWW_B = RWW_F + 256 * 64 * 2, RWW_A = RWW_B + 256 * 64 * 2, RWW_GF = RWW_A + 256 * 64 * 2, RWW_GB = RWW_GF + 256 * 128 * 2;
constexpr size_t MISC_XBAR = OFF_MISC + (size_t)3 * 1024 * 1024;
constexpr size_t OFF_R = OFF_MISC + (size_t)4 * 1024 * 1024;
constexpr size_t MISC_BAR = OFF_R - 256;
constexpr size_t MISC_ZERO = OFF_R - 512;
static_assert(RWW_GB + 256 * 128 * 2 <= MISC_ZERO, "misc overflow");
constexpr size_t R_YHY = OFF_R, R_YSW = OFF_R + UNIT, R_YDF = OFF_R + 2 * UNIT;
constexpr size_t R_PHY = OFF_R + 3 * UNIT;
constexpr size_t R_PSW = OFF_R + 6 * UNIT;
constexpr size_t R_VTSW = R_PSW + (size_t)MT * 384 * 2;
constexpr size_t R_PDF = OFF_R + 8 * UNIT;
constexpr size_t R_VTDF = OFF_R + 10 * UNIT;
constexpr size_t R_PRW = OFF_R + 11 * UNIT;
constexpr size_t R_STR = R_PRW + (size_t)MT * 1216 * 2;
constexpr size_t R_G = R_STR + 7 * UNIT;
constexpr size_t R_END = R_G + 2 * UNIT;
constexpr size_t R_RAWF = OFF_R;
constexpr size_t R_OF = R_PHY, R_OB = R_PHY + UNIT;
constexpr size_t R_URE = R_PSW;
constexpr size_t R_YRW = R_VTDF;
constexpr size_t R_ACC = R_PRW;
constexpr size_t R_U = R_STR;
constexpr size_t R_HID = OFF_R;
static_assert(R_END <= (size_t)512 * 1024 * 1024, "ws overflow");
static_assert((size_t)MT * 2816 * 2 <= 11 * UNIT, "hid");

constexpr int SMEM_BYTES = 144 * 1024 + 64;

struct Params {
  const float* in[43];
  float* out;
  char* ws;
};

DI int my_tid() { int t = (int)__builtin_amdgcn_workitem_id_x(); asm volatile("" : "+v"(t)); return t; }
DI unsigned f2bf(float f) { unsigned u = __float_as_uint(f); u += 0x7fffu + ((u >> 16) & 1u); return u >> 16; }
DI float bf2f(unsigned h) { return __uint_as_float(h << 16); }
typedef __bf16 bf16v2_t __attribute__((ext_vector_type(2)));
typedef float f32v2_t __attribute__((ext_vector_type(2)));
DI unsigned pack2(float lo, float hi) { f32v2_t v = {lo, hi}; bf16v2_t b = __builtin_convertvector(v, bf16v2_t); return __builtin_bit_cast(unsigned, b); }

DI float bflo(unsigned w) { return __uint_as_float(w << 16); }
DI float bfhi(unsigned w) { return __uint_as_float(w & 0xffff0000u); }
DI float sigmoidf_(float x) { return __builtin_amdgcn_rcpf(1.f + __expf(-x)); }
DI float siluf_(float x) { return x * __builtin_amdgcn_rcpf(1.f + __expf(-x)); }
DI float wave_sum(float v) {
#pragma unroll
  for (int o = 32; o >= 1; o >>= 1) v += __shfl_xor(v, o);
  return v;
}
template <int CTRL> DI float dpp_mov(float v) {
  return __int_as_float(__builtin_amdgcn_update_dpp(0, __float_as_int(v), CTRL, 0xf, 0xf, false));
}
DI float sum16(float v) {
  v += dpp_mov<0xB1>(v);
  v += dpp_mov<0x4E>(v);
  v += dpp_mov<0x141>(v);
  v += dpp_mov<0x140>(v);
  return v;
}
DI void lds_barrier() { asm volatile("s_waitcnt lgkmcnt(0)" ::: "memory"); __builtin_amdgcn_s_barrier(); asm volatile("" ::: "memory"); }
DI uint4 sel4(bool z, uint4 v) { return make_uint4(z ? 0u : v.x, z ? 0u : v.y, z ? 0u : v.z, z ? 0u : v.w); }
DI int mod_idx(int row) { return row < ML ? (row >> 12) : 8; }

template <int NTW, bool DEEP, class RowFn>
DI void gemm_main(f32x4 (&acc)[4][NTW], const bf16_t* __restrict__ A, int lda, RowFn rowfn,
                  const bf16_t* __restrict__ Bt, int ldb, int K, char* smem) {
  constexpr int BN = NTW * 32;
  constexpr int A_BYTES = 256 * 128, B_BYTES = BN * 128, STAGE = A_BYTES + B_BYTES;
  constexpr int NBL = BN / 64;
  const int tid = my_tid(), lane = tid & 63, wid = tid >> 6, wm = wid >> 1, wn = wid & 1, g = lane >> 4, r16 = lane & 15;
  const int chunk = tid & 7, lrow = tid >> 3;
  long a0 = rowfn(lrow), a1 = rowfn(lrow + 64), a2 = rowfn(lrow + 128), a3 = rowfn(lrow + 192);
  const long c0 = a0 < 0 ? 0 : a0, c1 = a1 < 0 ? 0 : a1, c2 = a2 < 0 ? 0 : a2, c3 = a3 < 0 ? 0 : a3;
  const bf16_t* Bp = Bt + (long)lrow * ldb + chunk * 8;
  const bf16_t* Ap0 = A + c0 * lda + chunk * 8; const bf16_t* Ap1 = A + c1 * lda + chunk * 8;
  const bf16_t* Ap2 = A + c2 * lda + chunk * 8; const bf16_t* Ap3 = A + c3 * lda + chunk * 8;
  struct Regs { uint4 a0, a1, a2, a3, b0, b1; };
  Regs R0, R1;
  R0.b1 = make_uint4(0, 0, 0, 0); R1.b1 = make_uint4(0, 0, 0, 0);
  auto GLOAD = [&](Regs& R, int k0) {
    R.a0 = *(const uint4*)(Ap0 + k0); R.a1 = *(const uint4*)(Ap1 + k0);
    R.a2 = *(const uint4*)(Ap2 + k0); R.a3 = *(const uint4*)(Ap3 + k0);
    R.b0 = *(const uint4*)(Bp + k0);
    if constexpr (NBL > 1) R.b1 = *(const uint4*)(Bp + (long)64 * ldb + k0);
  };
  auto SSTORE = [&](const Regs& R, int st) {
    char* base = smem + st * STAGE + lrow * 128 + ((chunk ^ (lrow & 7)) << 4);
    *(uint4*)(base) = sel4(a0 < 0, R.a0); *(uint4*)(base + 64 * 128) = sel4(a1 < 0, R.a1);
    *(uint4*)(base + 128 * 128) = sel4(a2 < 0, R.a2); *(uint4*)(base + 192 * 128) = sel4(a3 < 0, R.a3);
    *(uint4*)(base + A_BYTES) = R.b0;
    if constexpr (NBL > 1) *(uint4*)(base + A_BYTES + 64 * 128) = R.b1;
  };
  auto COMPUTE = [&](int st) {
    const char* As = smem + st * STAGE + (wm * 64 + r16) * 128;
    const char* Bs = smem + st * STAGE + A_BYTES + (wn * (NTW * 16) + r16) * 128;
#pragma unroll
    for (int kk = 0; kk < 2; ++kk) {
      const int sw = ((kk * 4 + g) ^ (r16 & 7)) << 4;
      bf16x8 af[4], bfr[NTW];
#pragma unroll
      for (int mt = 0; mt < 4; ++mt) af[mt] = *(const bf16x8*)(As + mt * 16 * 128 + sw);
#pragma unroll
      for (int nt = 0; nt < NTW; ++nt) bfr[nt] = *(const bf16x8*)(Bs + nt * 16 * 128 + sw);
#pragma unroll
      for (int mt = 0; mt < 4; ++mt)
#pragma unroll
        for (int nt = 0; nt < NTW; ++nt)
          acc[mt][nt] = __builtin_amdgcn_mfma_f32_16x16x32_bf16(af[mt], bfr[nt], acc[mt][nt], 0, 0, 0);
    }
  };
  const int nk = K >> 6;
  __syncthreads();
  GLOAD(R0, 0);
  SSTORE(R0, 0);
  if constexpr (DEEP) {
    GLOAD(R0, 64);
    if (nk > 2) GLOAD(R1, 128);
    lds_barrier();
    bf16x8 fa0[4], fb0[NTW], fa1[4], fb1[NTW];
    auto READF = [&](bf16x8 (&fa)[4], bf16x8 (&fb)[NTW], int st, int kk) {
      const int sw = ((kk * 4 + g) ^ (r16 & 7)) << 4;
      const char* As = smem + st * STAGE + (wm * 64 + r16) * 128 + sw;
      const char* Bs = smem + st * STAGE + A_BYTES + (wn * (NTW * 16) + r16) * 128 + sw;
#pragma unroll
      for (int mt = 0; mt < 4; ++mt) fa[mt] = *(const bf16x8*)(As + mt * 16 * 128);
#pragma unroll
      for (int nt = 0; nt < NTW; ++nt) fb[nt] = *(const bf16x8*)(Bs + nt * 16 * 128);
    };
    auto MMA = [&](const bf16x8 (&fa)[4], const bf16x8 (&fb)[NTW]) {
#pragma unroll
      for (int mt = 0; mt < 4; ++mt)
#pragma unroll
        for (int nt = 0; nt < NTW; ++nt)
          acc[mt][nt] = __builtin_amdgcn_mfma_f32_16x16x32_bf16(fa[mt], fb[nt], acc[mt][nt], 0, 0, 0);
    };
    READF(fa0, fb0, 0, 0);
    for (int kt = 0; kt < nk; kt += 2) {
      READF(fa1, fb1, 0, 1);
      MMA(fa0, fb0);
#pragma unroll
      for (int i = 0; i < 4 + NTW; ++i) { __builtin_amdgcn_sched_group_barrier(0x100, 1, 0); __builtin_amdgcn_sched_group_barrier(0x008, 2, 0); }
      __builtin_amdgcn_sched_barrier(0);
      SSTORE(R0, 1);
      if (kt + 3 < nk) GLOAD(R0, (kt + 3) * 64);
      MMA(fa1, fb1);
#pragma unroll
      for (int i = 0; i < 6; ++i) { __builtin_amdgcn_sched_group_barrier(0x200, 1, 0); __builtin_amdgcn_sched_group_barrier(0x020, 1, 0); __builtin_amdgcn_sched_group_barrier(0x008, 2, 0); }
      __builtin_amdgcn_sched_barrier(0);
      lds_barrier();
      READF(fa0, fb0, 1, 0);
      READF(fa1, fb1, 1, 1);
      MMA(fa0, fb0);
#pragma unroll
      for (int i = 0; i < 4 + NTW; ++i) { __builtin_amdgcn_sched_group_barrier(0x100, 1, 0); __builtin_amdgcn_sched_group_barrier(0x008, 2, 0); }
      __builtin_amdgcn_sched_barrier(0);
      if (kt + 2 < nk) SSTORE(R1, 0);
      if (kt + 4 < nk) GLOAD(R1, (kt + 4) * 64);
      MMA(fa1, fb1);
#pragma unroll
      for (int i = 0; i < 6; ++i) { __builtin_amdgcn_sched_group_barrier(0x200, 1, 0); __builtin_amdgcn_sched_group_barrier(0x020, 1, 0); __builtin_amdgcn_sched_group_barrier(0x008, 2, 0); }
      __builtin_amdgcn_sched_barrier(0);
      lds_barrier();
      if (kt + 2 < nk) READF(fa0, fb0, 0, 0);
    }
  } else {
    lds_barrier();
    for (int kt = 0; kt < nk; ++kt) {
      const int st = kt & 1;
      if (kt + 1 < nk) GLOAD(R0, (kt + 1) * 64);
      __builtin_amdgcn_sched_barrier(0);
      COMPUTE(st);
      __builtin_amdgcn_sched_barrier(0);
      if (kt + 1 < nk) SSTORE(R0, st ^ 1);
      lds_barrier();
    }
  }
}

#define GLDS16(gp, lp) __builtin_amdgcn_global_load_lds((const unsigned*)(gp), (unsigned*)(lp), 16, 0, 0)
template <class RowFn>
DI void gemm_glds(f32x4 (&acc)[4][4], const bf16_t* __restrict__ A, int lda, RowFn rowfn,
                  const bf16_t* __restrict__ Bt, int ldb, int K, char* smem, const bf16_t* zrow) {
  constexpr int A_BYTES = 256 * 128, STAGE = A_BYTES + 128 * 128;
  const int tid = my_tid(), lane = tid & 63, wid = tid >> 6, wm = wid >> 1, wn = wid & 1, g = lane >> 4, r16 = lane & 15;
  const int lrow = tid >> 3, c = (tid & 7) ^ (lrow & 7);
  const long a0 = rowfn(lrow), a1 = rowfn(lrow + 64), a2 = rowfn(lrow + 128), a3 = rowfn(lrow + 192);
  const bf16_t* pa0 = (a0 >= 0 ? A + a0 * lda : zrow) + c * 8; const int m0 = a0 >= 0 ? 1 : 0;
  const bf16_t* pa1 = (a1 >= 0 ? A + a1 * lda : zrow) + c * 8; const int m1 = a1 >= 0 ? 1 : 0;
  const bf16_t* pa2 = (a2 >= 0 ? A + a2 * lda : zrow) + c * 8; const int m2 = a2 >= 0 ? 1 : 0;
  const bf16_t* pa3 = (a3 >= 0 ? A + a3 * lda : zrow) + c * 8; const int m3 = a3 >= 0 ? 1 : 0;
  const bf16_t* pb0 = Bt + (long)lrow * ldb + c * 8; const bf16_t* pb1 = pb0 + (long)64 * ldb;
  auto ISSUE = [&](int kt, int bi) {
    char* d = smem + bi * STAGE + tid * 16;
    const int k0 = kt * 64;
    GLDS16(pa0 + k0 * m0, d); GLDS16(pa1 + k0 * m1, d + 8192); GLDS16(pa2 + k0 * m2, d + 16384); GLDS16(pa3 + k0 * m3, d + 24576);
    GLDS16(pb0 + k0, d + A_BYTES); GLDS16(pb1 + k0, d + A_BYTES + 8192);
  };
  auto COMPUTE = [&](int bi) {
    const char* As = smem + bi * STAGE + (wm * 64 + r16) * 128;
    const char* Bs = smem + bi * STAGE + A_BYTES + (wn * 64 + r16) * 128;
#pragma unroll
    for (int kk = 0; kk < 2; ++kk) {
      const int sw = ((kk * 4 + g) ^ (r16 & 7)) << 4;
      bf16x8 af[4], bfr[4];
#pragma unroll
      for (int mt = 0; mt < 4; ++mt) af[mt] = *(const bf16x8*)(As + mt * 16 * 128 + sw);
#pragma unroll
      for (int nt = 0; nt < 4; ++nt) bfr[nt] = *(const bf16x8*)(Bs + nt * 16 * 128 + sw);
      __builtin_amdgcn_s_setprio(1);
#pragma unroll
      for (int mt = 0; mt < 4; ++mt)
#pragma unroll
        for (int nt = 0; nt < 4; ++nt)
          acc[mt][nt] = __builtin_amdgcn_mfma_f32_16x16x32_bf16(af[mt], bfr[nt], acc[mt][nt], 0, 0, 0);
      __builtin_amdgcn_s_setprio(0);
    }
  };
  const int nk = K >> 6;
  __syncthreads();
  ISSUE(0, 0);
  ISSUE(1, 1);
  asm volatile("s_waitcnt vmcnt(6)" ::: "memory");
  __builtin_amdgcn_s_barrier();
  asm volatile("" ::: "memory");
  int bi = 0;
  for (int kt = 0; kt < nk; ++kt) {
    const int b2 = bi >= 1 ? bi - 1 : 2;
    if (kt + 2 < nk) ISSUE(kt + 2, b2);
    COMPUTE(bi);
    if (kt + 2 < nk) asm volatile("s_waitcnt vmcnt(6)" ::: "memory");
    else asm volatile("s_waitcnt vmcnt(0)" ::: "memory");
    asm volatile("s_waitcnt lgkmcnt(0)" ::: "memory");
    __builtin_amdgcn_s_barrier();
    asm volatile("" ::: "memory");
    bi = bi == 2 ? 0 : bi + 1;
  }
}

DI void gemm_glds256(f32x4 (&acc)[8][4], const bf16_t* __restrict__ A, int lda, long arow0,
                     const bf16_t* __restrict__ Bt, int ldb, int K, char* smem) {
  constexpr int A_BYTES = 256 * 128, STAGE = 2 * A_BYTES;
  const int tid = my_tid(), lane = tid & 63, wid = tid >> 6, wm = wid >> 2, wn = wid & 3, g = lane >> 4, r16 = lane & 15;
  const int lrow = tid >> 3, c = (tid & 7) ^ (lrow & 7);
  const bf16_t* pa = A + (arow0 + lrow) * (long)lda + c * 8;
  const bf16_t* pb = Bt + (long)lrow * ldb + c * 8;
  const long a64 = (long)64 * lda, b64 = (long)64 * ldb;
  auto ISSUE = [&](int kt, int bi) {
    char* d = smem + bi * STAGE + tid * 16;
    const int k0 = kt * 64;
    GLDS16(pa + k0, d); GLDS16(pa + a64 + k0, d + 8192); GLDS16(pa + 2 * a64 + k0, d + 16384); GLDS16(pa + 3 * a64 + k0, d + 24576);
    GLDS16(pb + k0, d + A_BYTES); GLDS16(pb + b64 + k0, d + A_BYTES + 8192); GLDS16(pb + 2 * b64 + k0, d + A_BYTES + 16384); GLDS16(pb + 3 * b64 + k0, d + A_BYTES + 24576);
  };
  auto COMPUTE = [&](int bi) {
    const char* As = smem + bi * STAGE + (wm * 128 + r16) * 128;
    const char* Bs = smem + bi * STAGE + A_BYTES + (wn * 64 + r16) * 128;
#pragma unroll
    for (int kk = 0; kk < 2; ++kk) {
      const int sw = ((kk * 4 + g) ^ (r16 & 7)) << 4;
      bf16x8 bfr[4];
#pragma unroll
      for (int nt = 0; nt < 4; ++nt) bfr[nt] = *(const bf16x8*)(Bs + nt * 16 * 128 + sw);
      __builtin_amdgcn_s_setprio(1);
#pragma unroll
      for (int mt = 0; mt < 8; ++mt) {
        const bf16x8 af = *(const bf16x8*)(As + mt * 16 * 128 + sw);
#pragma unroll
        for (int nt = 0; nt < 4; ++nt)
          acc[mt][nt] = __builtin_amdgcn_mfma_f32_16x16x32_bf16(af, bfr[nt], acc[mt][nt], 0, 0, 0);
      }
      __builtin_amdgcn_s_setprio(0);
    }
  };
  const int nk = K >> 6;
  __syncthreads();
  ISSUE(0, 0);
  asm volatile("s_waitcnt vmcnt(0)" ::: "memory");
  __builtin_amdgcn_s_barrier();
  asm volatile("" ::: "memory");
  int bi = 0;
  for (int kt = 0; kt < nk; ++kt) {
    if (kt + 1 < nk) ISSUE(kt + 1, bi ^ 1);
    COMPUTE(bi);
    asm volatile("s_waitcnt vmcnt(0)" ::: "memory");
    asm volatile("s_waitcnt lgkmcnt(0)" ::: "memory");
    __builtin_amdgcn_s_barrier();
    asm volatile("" ::: "memory");
    bi ^= 1;
  }
}
DI void zero_acc256(f32x4 (&acc)[8][4]) {
#pragma unroll
  for (int i = 0; i < 8; ++i)
#pragma unroll
    for (int j = 0; j < 4; ++j) acc[i][j] = (f32x4){0.f, 0.f, 0.f, 0.f};
}

DI bool next_tile(int i, int MTILES, int NTILES, int& mt, int& nt) {
  const int xcd = blockIdx.x & 7, slot = blockIdx.x >> 3, nslot = gridDim.x >> 3;
  const int m_lo = (MTILES * xcd) >> 3, m_hi = (MTILES * (xcd + 1)) >> 3, Mloc = m_hi - m_lo;
  const int q = i * nslot + slot;
  if (q >= Mloc * NTILES) return false;
  const int gidx = q / (4 * NTILES), m0 = gidx * 4;
  const int rows = (Mloc - m0) < 4 ? (Mloc - m0) : 4;
  const int within = q - gidx * 4 * NTILES;
  nt = within / rows; mt = m_lo + m0 + within % rows;
  return true;
}

struct RowPlain { long base; DI long operator()(int r) const { return base + r; } };
struct RowHalo { long rowbase; int t0; int len; DI long operator()(int r) const { int t = t0 + r; return (t >= 0 && t < len) ? rowbase + t : -1; } };

template <int NTW> DI void zero_acc(f32x4 (&acc)[4][NTW]) {
#pragma unroll
  for (int i = 0; i < 4; ++i)
#pragma unroll
    for (int j = 0; j < NTW; ++j) acc[i][j] = (f32x4){0.f, 0.f, 0.f, 0.f};
}

DI void cvt_unit(const float* __restrict__ src, int ldsrc, int srccol0, int k0, bf16_t* __restrict__ dst, int K, int n0, char* smem, bool perm = true) {
  float* T = (float*)smem;
  const int tid = my_tid();
  __syncthreads();
  if (srccol0 >= 0) {
#pragma unroll
    for (int i = 0; i < 8; ++i) {
      int idx = tid + i * 512; int k = idx >> 6, n = idx & 63;
      T[k * 65 + n] = src[(long)(k0 + k) * ldsrc + srccol0 + n];
    }
  }
  __syncthreads();
  int nd = tid >> 3, kc = (tid & 7) * 8; int n = perm ? ((nd & 15) * 4 + (nd >> 4)) : nd;
  uint4 o = make_uint4(0, 0, 0, 0);
  if (srccol0 >= 0) {
    o.x = pack2(T[(kc + 0) * 65 + n], T[(kc + 1) * 65 + n]);
    o.y = pack2(T[(kc + 2) * 65 + n], T[(kc + 3) * 65 + n]);
    o.z = pack2(T[(kc + 4) * 65 + n], T[(kc + 5) * 65 + n]);
    o.w = pack2(T[(kc + 6) * 65 + n], T[(kc + 7) * 65 + n]);
  }
  *(uint4*)(dst + (long)(n0 + nd) * K + k0 + kc) = o;
}

DI void ph_convert(const Params& p, int l, char* smem) {
  for (int u = blockIdx.x; u < 4508; u += gridDim.x) {
    if (u < 832) {
      int gI = u >> 4, kt = u & 15; int n0 = gI * 64; int sc;
      if (n0 < 1280) sc = n0; else if (n0 < 2048) sc = 2496 + (n0 - 1280); else if (n0 < 3264) sc = 1280 + (n0 - 2048); else sc = -1;
      cvt_unit(p.in[6] + (size_t)l * 1024 * 7360, 7360, sc, kt * 64, (bf16_t*)(p.ws + WB_IN), 1024, n0, smem);
    } else if (u < 1856) {
      int v = u - 832; int gI = v >> 4, kt = v & 15;
      cvt_unit(p.in[6] + (size_t)l * 1024 * 7360, 7360, 3264 + gI * 64, kt * 64, (bf16_t*)(p.ws + WB_GATE), 1024, gI * 64, smem);
    } else if (u < 2112) {
      int v = u - 1856; int gI = v >> 2, kt = v & 3; int j = gI >> 4, gg = gI & 15;
      cvt_unit(p.in[33] + ((size_t)l * 4 + j) * 256 * 1024, 1024, gg * 64, kt * 64, (bf16_t*)(p.ws + WB_BR) + (size_t)j * 1024 * 256, 256, gg * 64, smem);
    } else if (u < 2368) {
      int v = u - 2112; int gI = v >> 4, kt = v & 15;
      cvt_unit(p.in[34] + (size_t)l * 1024 * 1024, 1024, gI * 64, kt * 64, (bf16_t*)(p.ws + WB_OUT), 1024, gI * 64, smem);
    } else if (u < 3776) {
      int v = u - 2368; int gI = v >> 4, kt = v & 15; int nt = gI >> 2, q = gI & 3;
      cvt_unit(p.in[37] + (size_t)l * 1024 * 5632, 5632, (q >> 1) * 2816 + nt * 128 + (q & 1) * 64, kt * 64, (bf16_t*)(p.ws + WB_UP), 1024, gI * 64, smem);
    } else if (u < 4480) {
      int v = u - 3776; int gI = v / 44, kt = v % 44;
      cvt_unit(p.in[40] + (size_t)l * 2816 * 1024, 1024, gI * 64, kt * 64, (bf16_t*)(p.ws + WB_DOWN), 2816, gI * 64, smem);
    } else {
      int v = u - 4480;
      if (v < 4) cvt_unit(p.in[19] + (size_t)l * 2 * 64 * 256, 256, v * 64, 0, (bf16_t*)(p.ws + RWW_F), 64, v * 64, smem);
      else if (v < 8) cvt_unit(p.in[19] + (size_t)l * 2 * 64 * 256 + 64 * 256, 256, (v - 4) * 64, 0, (bf16_t*)(p.ws + RWW_B), 64, (v - 4) * 64, smem);
      else if (v < 12) cvt_unit(p.in[21] + (size_t)l * 64 * 256, 256, (v - 8) * 64, 0, (bf16_t*)(p.ws + RWW_A), 64, (v - 8) * 64, smem);
      else if (v < 20) { int w = v - 12; cvt_unit(p.in[22] + (size_t)l * 2 * 128 * 256, 256, (w >> 1) * 64, (w & 1) * 64, (bf16_t*)(p.ws + RWW_GF), 128, (w >> 1) * 64, smem); }
      else { int w = v - 20; cvt_unit(p.in[22] + (size_t)l * 2 * 128 * 256 + 128 * 256, 256, (w >> 1) * 64, (w & 1) * 64, (bf16_t*)(p.ws + RWW_GB), 128, (w >> 1) * 64, smem); }
    }
  }
}

DI void ph_ada(const Params& p, char* smem) {
  float* S = (float*)smem;
  float* R = S + 9 * 1024;
  const int tid = my_tid();
  bool loaded = false;
  for (int u = blockIdx.x; u < 192; u += gridDim.x) {
    if (!loaded) {
      __syncthreads();
      for (int i = tid; i < 9 * 1024; i += NTHR) { float c = i < 8192 ? p.in[1][i] : p.in[3][i - 8192]; S[i] = siluf_(c); }
      loaded = true;
    }
    __syncthreads();
    int l = u / 96, n0 = (u % 96) * 64;
    int col = tid & 63, ks = tid >> 6;
    const float* W = p.in[4] + (size_t)l * 1024 * 6144 + n0 + col;
    float a[9];
#pragma unroll
    for (int b = 0; b < 9; ++b) a[b] = 0.f;
    for (int k = ks * 128; k < ks * 128 + 128; ++k) {
      float w = W[(size_t)k * 6144];
#pragma unroll
      for (int b = 0; b < 9; ++b) a[b] += S[b * 1024 + k] * w;
    }
#pragma unroll
    for (int b = 0; b < 9; ++b) R[(ks * 9 + b) * 64 + col] = a[b];
    __syncthreads();
    for (int i = tid; i < 9 * 64; i += NTHR) {
      int b = i >> 6, c = i & 63; float s = 0.f;
#pragma unroll
      for (int k2 = 0; k2 < 8; ++k2) s += R[(k2 * 9 + b) * 64 + c];
      s += p.in[5][(size_t)l * 6144 + n0 + c];
      ((float*)(p.ws + MISC_MOD))[((size_t)l * 9 + b) * 6144 + n0 + c] = s;
    }
  }
  for (int i = blockIdx.x * NTHR + tid; i < 4096; i += gridDim.x * NTHR) {
    float s, c; sincospif(-(float)i / 4096.f, &s, &c);
    ((float2*)(p.ws + MISC_TW))[i] = make_float2(c, s);
  }
}

DI void hy_rawfilter(const Params& p, int l, int Lf, float* __restrict__ dst, char* smem) {
  float* W1 = (float*)smem;
  float* W2 = W1 + 33 * 64;
  float* Z = W2 + 64 * 64;
  float* H1 = Z + 16 * 36;
  float* H2 = H1 + 16 * 64;
  const int tid = my_tid();
  const float* w1 = p.in[9] + (size_t)l * 33 * 64; const float* b1 = p.in[10] + l * 64;
  const float* w2 = p.in[11] + (size_t)l * 64 * 64; const float* b2 = p.in[12] + l * 64;
  const float* w3 = p.in[13] + (size_t)l * 64 * 1024; const float* fr = p.in[14] + l * 64;
  const int nunits = Lf / 16;
  bool loaded = false;
  for (int u = blockIdx.x; u < nunits; u += gridDim.x) {
    __syncthreads();
    if (!loaded) {
      for (int i = tid; i < 33 * 64; i += NTHR) W1[i] = w1[i];
      for (int i = tid; i < 64 * 64; i += NTHR) W2[i] = w2[i];
      loaded = true;
    }
    const int t0 = u * 16;
    for (int i = tid; i < 16 * 33; i += NTHR) {
      int tt = i / 33, f = i % 33; int t = t0 + tt; float v;
      if (f == 0) v = (float)t / (float)(Lf - 1);
      else {
        int bi = (f - 1) & 15;
        float wv = 6.283185307179586f * (float)t / (float)Lf;
        float fb = 1e-4f + (15.f - 1e-4f) * (float)bi / 15.f;
        float ang = wv * fb;
        v = (f <= 16) ? cosf(ang) : -sinf(ang);
      }
      Z[tt * 36 + f] = v;
    }
    __syncthreads();
    for (int i = tid; i < 16 * 64; i += NTHR) {
      int tt = i >> 6, f = i & 63; float s = b1[f];
      for (int k = 0; k < 33; ++k) s += Z[tt * 36 + k] * W1[k * 64 + f];
      H1[tt * 64 + f] = sinf(fr[f] * s);
    }
    __syncthreads();
    for (int i = tid; i < 16 * 64; i += NTHR) {
      int tt = i >> 6, f = i & 63; float s = b2[f];
      for (int k = 0; k < 64; ++k) s += H1[tt * 64 + k] * W2[k * 64 + f];
      H2[tt * 64 + f] = sinf(fr[f] * s);
    }
    __syncthreads();
    float a0[16], a1[16];
#pragma unroll
    for (int i = 0; i < 16; ++i) { a0[i] = 0.f; a1[i] = 0.f; }
    for (int k = 0; k < 64; ++k) {
      float wa = w3[k * 1024 + tid], wb = w3[k * 1024 + 512 + tid];
#pragma unroll
      for (int i = 0; i < 16; ++i) { float h = H2[i * 64 + k]; a0[i] += h * wa; a1[i] += h * wb; }
    }
    {
      int w = tid & 255;
      float delta = fabsf(-3.0701134573253944f + (-15.350567286626972f + 3.0701134573253944f) * (float)w / 255.f);
#pragma unroll
      for (int i = 0; i < 16; ++i) {
        float tn = (float)(t0 + i) / (float)(Lf - 1);
        float dec = expf(-tn * delta);
        dst[(size_t)(t0 + i) * 1024 + tid] = a0[i] * dec;
        dst[(size_t)(t0 + i) * 1024 + 512 + tid] = a1[i] * dec;
      }
    }
  }
}

DI float2 cmul(float2 a, float2 b) { return make_float2(a.x * b.x - a.y * b.y, a.x * b.y + a.y * b.x); }
DI float2 cmulc(float2 a, float2 b) { return make_float2(a.x * b.x + a.y * b.y, a.y * b.x - a.x * b.y); }
DI float2 cadd(float2 a, float2 b) { return make_float2(a.x + b.x, a.y + b.y); }
DI float2 csub(float2 a, float2 b) { return make_float2(a.x - b.x, a.y - b.y); }
DI void fft_dif(float2* X, const float2* W) {
  const int tid = my_tid();
  for (int ls = 12; ls >= 2; ls -= 2) {
    const int s = 1 << ls, h = s >> 1;
    __syncthreads();
#pragma unroll
    for (int i = 0; i < 4; ++i) {
      const int bf = tid + i * 512; const int j = bf & (h - 1); const int base = ((bf >> (ls - 1)) << (ls + 1)) + j;
      const float2 x0 = X[base], x1 = X[base + h], x2 = X[base + s], x3 = X[base + s + h];
      const float2 w1 = W[s - 1 + j], w2 = W[h - 1 + j];
      const float2 y0 = cadd(x0, x2), y2 = cmul(csub(x0, x2), w1), y1 = cadd(x1, x3);
      const float2 t = cmul(csub(x1, x3), w1); const float2 y3 = make_float2(t.y, -t.x);
      X[base] = cadd(y0, y1); X[base + h] = cmul(csub(y0, y1), w2);
      X[base + s] = cadd(y2, y3); X[base + s + h] = cmul(csub(y2, y3), w2);
    }
  }
  __syncthreads();
#pragma unroll
  for (int i = 0; i < 4; ++i) {
    const int q = tid + i * 512;
    float4 a = *(float4*)(X + 4 * q), b = *(float4*)(X + 4 * q + 2);
    *(float4*)(X + 4 * q) = make_float4(a.x + a.z, a.y + a.w, a.x - a.z, a.y - a.w);
    *(float4*)(X + 4 * q + 2) = make_float4(b.x + b.z, b.y + b.w, b.x - b.z, b.y - b.w);
  }
  __syncthreads();
}
DI void fft_dit_inv(float2* X, const float2* W) {
  const int tid = my_tid();
  __syncthreads();
#pragma unroll
  for (int i = 0; i < 4; ++i) {
    const int q = tid + i * 512;
    float4 a = *(float4*)(X + 4 * q), b = *(float4*)(X + 4 * q + 2);
    *(float4*)(X + 4 * q) = make_float4(a.x + a.z, a.y + a.w, a.x - a.z, a.y - a.w);
    *(float4*)(X + 4 * q + 2) = make_float4(b.x + b.z, b.y + b.w, b.x - b.z, b.y - b.w);
  }
  for (int ls = 2; ls <= 12; ls += 2) {
    const int s = 1 << ls, h = s >> 1;
    __syncthreads();
#pragma unroll
    for (int i = 0; i < 4; ++i) {
      const int bf = tid + i * 512; const int j = bf & (h - 1); const int base = ((bf >> (ls - 1)) << (ls + 1)) + j;
      const float2 e0 = X[base], e1 = X[base + h], e2 = X[base + s], e3 = X[base + s + h];
      const float2 w1 = W[s - 1 + j], w2 = W[h - 1 + j];
      const float2 t1 = cmulc(e1, w2), t3 = cmulc(e3, w2);
      const float2 u0 = cadd(e0, t1), u1 = csub(e0, t1), u2 = cadd(e2, t3), u3 = csub(e2, t3);
      const float2 a2 = cmulc(u2, w1); const float2 q3 = cmulc(u3, w1); const float2 a3 = make_float2(-q3.y, q3.x);
      X[base] = cadd(u0, a2); X[base + s] = csub(u0, a2);
      X[base + h] = cadd(u1, a3); X[base + s + h] = csub(u1, a3);
    }
  }
  __syncthreads();
}
DI void load_twiddles(const Params& p, float2* W) {
  const float2* tw = (const float2*)(p.ws + MISC_TW);
  for (int i = my_tid(); i < 8191; i += NTHR) {
    const int ls = 31 - __clz(i + 1); const int pos = i + 1 - (1 << ls);
    W[i] = tw[pos << (12 - ls)];
  }
}

DI void ph_kf(const Params& p, int l, char* smem) {
  float2* X = (float2*)smem; float2* W = X + 8192; float* red = (float*)(W + 8192);
  const int tid = my_tid(), lane = tid & 63, wid = tid >> 6;
  const float* rawf = (const float*)(p.ws + R_RAWF);
  float2* kf = (float2*)(p.ws + OFF_KF);
  bool tw = false;
  for (int u = blockIdx.x; u < 256; u += gridDim.x) {
    if (!tw) { load_twiddles(p, W); tw = true; }
    const int o = u >> 7, c = (u & 127) * 2;
    float2 fw[8], bw[8]; float sa = 0.f, sb = 0.f;
#pragma unroll
    for (int i = 0; i < 8; ++i) {
      int t = tid + i * 512;
      fw[i] = *(const float2*)(rawf + (size_t)t * 1024 + o * 512 + c);
      bw[i] = *(const float2*)(rawf + (size_t)t * 1024 + o * 512 + 256 + c);
      sa += fabsf(fw[i].x) + fabsf(bw[i].x); sb += fabsf(fw[i].y) + fabsf(bw[i].y);
    }
    sa = wave_sum(sa); sb = wave_sum(sb);
    __syncthreads();
    if (lane == 0) { red[wid * 2] = sa; red[wid * 2 + 1] = sb; }
    __syncthreads();
    float ta = 0.f, tb = 0.f;
#pragma unroll
    for (int w = 0; w < 8; ++w) { ta += red[w * 2]; tb += red[w * 2 + 1]; }
    const float ia = 1.f / ta, ib = 1.f / tb;
#pragma unroll
    for (int i = 0; i < 8; ++i) {
      int t = tid + i * 512;
      X[t] = make_float2(fw[i].x * ia, fw[i].y * ib);
      if (t >= 1) X[8192 - t] = make_float2(bw[i].x * ia, bw[i].y * ib);
      else X[4096] = make_float2(0.f, 0.f);
    }
    fft_dif(X, W);
    float2* ka = kf + (size_t)(o * 256 + c) * 8192; float2* kb = ka + 8192;
#pragma unroll 4
    for (int i = 0; i < 16; ++i) {
      int pidx = tid + i * 512;
      int k = (int)(__brev((unsigned)pidx) >> 19);
      int k2 = (8192 - k) & 8191;
      int p2 = (int)(__brev((unsigned)k2) >> 19);
      float2 c1 = X[pidx], c2 = X[p2];
      float2 A = make_float2(0.5f * (c1.x + c2.x), 0.5f * (c1.y - c2.y));
      float2 Bv = make_float2(0.5f * (c1.y + c2.y), -0.5f * (c1.x - c2.x));
      ka[pidx] = A; kb[pidx] = Bv;
    }
    __syncthreads();
  }
  if (l == 0) {
    const float* rawc = (const float*)(p.ws + MISC_RAWC);
    float* G = (float*)(p.ws + MISC_GCTX);
    for (int u = blockIdx.x * 8 + wid; u < 512; u += gridDim.x * 8) {
      int o = u >> 8, c = u & 255; float f[4], b[4]; float s = 0.f;
#pragma unroll
      for (int i = 0; i < 4; ++i) {
        int t = lane + i * 64;
        f[i] = rawc[(size_t)t * 1024 + o * 512 + c]; b[i] = rawc[(size_t)t * 1024 + o * 512 + 256 + c];
        s += fabsf(f[i]) + fabsf(b[i]);
      }
      s = wave_sum(s); float inv = 1.f / s;
#pragma unroll
      for (int i = 0; i < 4; ++i) {
        int t = lane + i * 64;
        G[(size_t)u * 512 + 256 + t] = f[i] * inv;
        if (t >= 1) G[(size_t)u * 512 + 256 - t] = b[i] * inv;
      }
      if (lane == 0) G[(size_t)u * 512] = 0.f;
    }
  }
}

DI void ph_ln(const float* __restrict__ src_lat, const float* __restrict__ src_ctx, float* dst_lat, float* dst_ctx,
              const float* __restrict__ ag, const float* __restrict__ ab, bf16_t* U, const float* __restrict__ mod, int sh_off, int nrows) {
  const int lane = my_tid() & 63, wid = my_tid() >> 6;
  const int stride = gridDim.x * 8;
  float4 nv[4];
  {
    const int row = blockIdx.x * 8 + wid;
    if (row < nrows) {
      const float* src = row < ML ? src_lat + (size_t)row * D : src_ctx + (size_t)(row - ML) * D;
#pragma unroll
      for (int i = 0; i < 4; ++i) nv[i] = *(const float4*)(src + i * 256 + lane * 4);
    }
  }
  for (int row = blockIdx.x * 8 + wid; row < nrows; row += stride) {
    float4 v[4];
#pragma unroll
    for (int i = 0; i < 4; ++i) v[i] = nv[i];
    if (row + stride < nrows) {
      const int r2 = row + stride;
      const float* src2 = r2 < ML ? src_lat + (size_t)r2 * D : src_ctx + (size_t)(r2 - ML) * D;
#pragma unroll
      for (int i = 0; i < 4; ++i) nv[i] = *(const float4*)(src2 + i * 256 + lane * 4);
    }
    float s = 0.f;
#pragma unroll
    for (int i = 0; i < 4; ++i) s += v[i].x + v[i].y + v[i].z + v[i].w;
    float mu = wave_sum(s) * (1.f / 1024.f);
    float q = 0.f;
#pragma unroll
    for (int i = 0; i < 4; ++i) { v[i].x -= mu; v[i].y -= mu; v[i].z -= mu; v[i].w -= mu; q += v[i].x * v[i].x + v[i].y * v[i].y + v[i].z * v[i].z + v[i].w * v[i].w; }
    float rs = rsqrtf(wave_sum(q) * (1.f / 1024.f) + 1e-6f);
#pragma unroll
    for (int i = 0; i < 4; ++i) { v[i].x *= rs; v[i].y *= rs; v[i].z *= rs; v[i].w *= rs; }
    if (ag) {
      float* dst = row < ML ? dst_lat + (size_t)row * D : dst_ctx + (size_t)(row - ML) * D;
#pragma unroll
      for (int i = 0; i < 4; ++i) {
        float4 gg = *(const float4*)(ag + i * 256 + lane * 4), bb = *(const float4*)(ab + i * 256 + lane * 4);
        v[i].x = v[i].x * gg.x + bb.x; v[i].y = v[i].y * gg.y + bb.y; v[i].z = v[i].z * gg.z + bb.z; v[i].w = v[i].w * gg.w + bb.w;
        *(float4*)(dst + i * 256 + lane * 4) = v[i];
      }
      if (U) {
        s = 0.f;
#pragma unroll
        for (int i = 0; i < 4; ++i) s += v[i].x + v[i].y + v[i].z + v[i].w;
        mu = wave_sum(s) * (1.f / 1024.f); q = 0.f;
#pragma unroll
        for (int i = 0; i < 4; ++i) { v[i].x -= mu; v[i].y -= mu; v[i].z -= mu; v[i].w -= mu; q += v[i].x * v[i].x + v[i].y * v[i].y + v[i].z * v[i].z + v[i].w * v[i].w; }
        rs = rsqrtf(wave_sum(q) * (1.f / 1024.f) + 1e-6f);
#pragma unroll
        for (int i = 0; i < 4; ++i) { v[i].x *= rs; v[i].y *= rs; v[i].z *= rs; v[i].w *= rs; }
      }
    }
    if (U) {
      const float* m = mod + (size_t)mod_idx(row) * 6144 + sh_off;
#pragma unroll
      for (int i = 0; i < 4; ++i) {
        float4 sh = *(const float4*)(m + i * 256 + lane * 4), sc = *(const float4*)(m + 1024 + i * 256 + lane * 4);
        uint2 o; o.x = pack2(v[i].x * (1.f + sc.x) + sh.x, v[i].y * (1.f + sc.y) + sh.y);
        o.y = pack2(v[i].z * (1.f + sc.z) + sh.z, v[i].w * (1.f + sc.w) + sh.w);
        *(uint2*)(U + (size_t)row * D + i * 256 + lane * 4) = o;
      }
    }
  }
}

DI void ph_inproj(const Params& p, const bf16_t* U, char* smem) {
  const bf16_t* Bt = (const bf16_t*)(p.ws + WB_IN);
  const int lane = my_tid() & 63, wid = my_tid() >> 6, wm = wid >> 2, wn = wid & 3, g = lane >> 4, r16 = lane & 15;
  for (int it = 0;; ++it) {
    int mtile, ntile;
    if (!next_tile(it, 136, 13, mtile, ntile)) break;
    f32x4 acc[8][4]; zero_acc256(acc);
    gemm_glds256(acc, U, 1024, (long)mtile * 256, Bt + (size_t)ntile * 256 * 1024, 1024, 1024, smem);
    int b, key0;
    if (mtile < 128) { b = mtile >> 4; key0 = (mtile & 15) * 256; } else { b = mtile - 128; key0 = SL; }
    const int wc0 = ntile * 256 + wn * 64;
    bf16_t* tbase = nullptr; int tcols = 0, tcol0 = 0;
    if (wc0 < 768) { tbase = (bf16_t*)(p.ws + R_PHY); tcols = 768; tcol0 = wc0; }
    else if (wc0 >= 1152 && wc0 < 1280) { tbase = (bf16_t*)(p.ws + R_VTSW); tcols = 128; tcol0 = wc0 - 1152; }
    else if (wc0 >= 1792 && wc0 < 2048) { tbase = (bf16_t*)(p.ws + R_VTDF); tcols = 256; tcol0 = wc0 - 1792; }
    if (tbase) {
#pragma unroll
      for (int mt = 0; mt < 8; ++mt)
#pragma unroll
        for (int nt = 0; nt < 4; ++nt) {
          int col = tcol0 + r16 * 4 + nt;
          int key = key0 + wm * 128 + mt * 16 + g * 4;
          uint2 o; o.x = pack2(acc[mt][nt][0], acc[mt][nt][1]); o.y = pack2(acc[mt][nt][2], acc[mt][nt][3]);
          *(uint2*)(tbase + ((size_t)b * tcols + col) * KEYS + key) = o;
        }
    } else if (wc0 < 3264) {
      bf16_t* rb; int ld, c0;
      if (wc0 < 1152) { rb = (bf16_t*)(p.ws + R_PSW); ld = 384; c0 = wc0 - 768; }
      else if (wc0 < 1792) { rb = (bf16_t*)(p.ws + R_PDF); ld = 512; c0 = wc0 - 1280; }
      else { rb = (bf16_t*)(p.ws + R_PRW); ld = 1216; c0 = wc0 - 2048; }
      const int col = c0 + r16 * 4;
#pragma unroll
      for (int mt = 0; mt < 8; ++mt)
#pragma unroll
        for (int j = 0; j < 4; ++j) {
          size_t row = (size_t)mtile * 256 + wm * 128 + mt * 16 + g * 4 + j;
          uint2 o; o.x = pack2(acc[mt][0][j], acc[mt][1][j]); o.y = pack2(acc[mt][2][j], acc[mt][3][j]);
          *(uint2*)(rb + row * ld + col) = o;
        }
    }
  }
}

DI float hy_conv3(const bf16_t* __restrict__ P, int t, int len, float w0, float w1, float w2, float bias) {
  float a = t >= 1 ? bf2f(P[t - 1]) : 0.f, b = bf2f(P[t]), c = (t + 1 < len) ? bf2f(P[t + 1]) : 0.f;
  return w0 * a + w1 * b + w2 * c + bias;
}
DI void ph_hyena(const Params& p, int l, char* smem) {
  float2* X = (float2*)smem; float2* W = X + 8192;
  const int tid = my_tid();
  const bf16_t* PT = (const bf16_t*)(p.ws + R_PHY);
  const float2* kf = (const float2*)(p.ws + OFF_KF);
  const float* cw = p.in[7] + (size_t)l * 3 * 768; const float* cb = p.in[8] + (size_t)l * 768;
  const float* hb = p.in[15] + (size_t)l * 512;
  bf16_t* Y = (bf16_t*)(p.ws + R_YHY);
  bool tw = false;
  for (int u = blockIdx.x; u < 1024; u += gridDim.x) {
    if (!tw) { load_twiddles(p, W); tw = true; }
    const int bp = u >> 8, c = u & 255; const int b0 = bp * 2, b1 = b0 + 1;
    const bf16_t* P0 = PT + ((size_t)b0 * 768) * KEYS; const bf16_t* P1 = PT + ((size_t)b1 * 768) * KEYS;
    float wv0 = cw[c], wv1 = cw[768 + c], wv2 = cw[1536 + c], bv = cb[c];
    float wa0 = cw[256 + c], wa1 = cw[768 + 256 + c], wa2 = cw[1536 + 256 + c], ba = cb[256 + c];
    float wb0 = cw[512 + c], wb1 = cw[768 + 512 + c], wb2 = cw[1536 + 512 + c], bb = cb[512 + c];
    const float bias0 = hb[c], bias1 = hb[256 + c];
    float2 vv[8];
    __syncthreads();
#pragma unroll
    for (int i = 0; i < 8; ++i) {
      int t = tid + i * 512;
      vv[i].x = hy_conv3(P0 + (size_t)c * KEYS, t, SL, wv0, wv1, wv2, bv);
      vv[i].y = hy_conv3(P1 + (size_t)c * KEYS, t, SL, wv0, wv1, wv2, bv);
      X[t] = vv[i]; X[t + 4096] = make_float2(0.f, 0.f);
    }
    fft_dif(X, W);
    {
      const float2* H = kf + (size_t)c * 8192;
#pragma unroll 4
      for (int i = 0; i < 16; ++i) { int q = tid + i * 512; X[q] = cmul(X[q], H[q]); }
    }
    fft_dit_inv(X, W);
    float2 zz[8];
#pragma unroll
    for (int i = 0; i < 8; ++i) {
      int t = tid + i * 512;
      float2 y = X[t];
      float x1a = hy_conv3(P0 + (size_t)(256 + c) * KEYS, t, SL, wa0, wa1, wa2, ba);
      float x1b = hy_conv3(P1 + (size_t)(256 + c) * KEYS, t, SL, wa0, wa1, wa2, ba);
      zz[i].x = x1a * (y.x * (1.f / 8192.f) + bias0 * vv[i].x);
      zz[i].y = x1b * (y.y * (1.f / 8192.f) + bias0 * vv[i].y);
    }
    __syncthreads();
#pragma unroll
    for (int i = 0; i < 8; ++i) { int t = tid + i * 512; X[t] = zz[i]; X[t + 4096] = make_float2(0.f, 0.f); }
    fft_dif(X, W);
    {
      const float2* H = kf + (size_t)(256 + c) * 8192;
#pragma unroll 4
      for (int i = 0; i < 16; ++i) { int q = tid + i * 512; X[q] = cmul(X[q], H[q]); }
    }
    fft_dit_inv(X, W);
#pragma unroll
    for (int i = 0; i < 8; ++i) {
      int t = tid + i * 512;
      float2 y = X[t];
      float x2a = hy_conv3(P0 + (size_t)(512 + c) * KEYS, t, SL, wb0, wb1, wb2, bb);
      float x2b = hy_conv3(P1 + (size_t)(512 + c) * KEYS, t, SL, wb0, wb1, wb2, bb);
      float oa = x2a * (y.x * (1.f / 8192.f) + bias1 * zz[i].x);
      float ob = x2b * (y.y * (1.f / 8192.f) + bias1 * zz[i].y);
      Y[((size_t)b0 * SL + t) * 256 + c] = (bf16_t)f2bf(oa);
      Y[((size_t)b1 * SL + t) * 256 + c] = (bf16_t)f2bf(ob);
    }
  }
}

DI void ph_hyena_ctx(const Params& p, int l, char* smem) {
  const int tid = my_tid(), lane = tid & 63, wid = tid >> 6;
  float* Zb = (float*)smem + wid * 1024;
  float* Gb = Zb + 256;
  const bf16_t* PT = (const bf16_t*)(p.ws + R_PHY);
  const float* G = (const float*)(p.ws + MISC_GCTX);
  const float* cw = p.in[7] + (size_t)l * 3 * 768; const float* cb = p.in[8] + (size_t)l * 768;
  const float* hb = p.in[15] + (size_t)l * 512;
  bf16_t* Y = (bf16_t*)(p.ws + R_YHY);
  for (int base = blockIdx.x * 8; base < 2048; base += gridDim.x * 8) {
    const int u = base + wid; const int b = u >> 8, c = u & 255;
    const bf16_t* Pb = PT + ((size_t)b * 768) * KEYS + SL;
    float v[4], x1[4], x2[4], zz[4];
#pragma unroll
    for (int i = 0; i < 4; ++i) {
      int t = lane + i * 64;
      v[i] = hy_conv3(Pb + (size_t)c * KEYS, t, CL, cw[c], cw[768 + c], cw[1536 + c], cb[c]);
      x1[i] = hy_conv3(Pb + (size_t)(256 + c) * KEYS, t, CL, cw[256 + c], cw[768 + 256 + c], cw[1536 + 256 + c], cb[256 + c]);
      x2[i] = hy_conv3(Pb + (size_t)(512 + c) * KEYS, t, CL, cw[512 + c], cw[768 + 512 + c], cw[1536 + 512 + c], cb[512 + c]);
    }
    __syncthreads();
#pragma unroll
    for (int i = 0; i < 4; ++i) Zb[lane + i * 64] = v[i];
    for (int i = lane; i < 512; i += 64) Gb[i] = G[(size_t)c * 512 + i];
    __syncthreads();
#pragma unroll
    for (int i = 0; i < 4; ++i) {
      int t = lane + i * 64; float s = 0.f;
      for (int s2 = 0; s2 < 256; ++s2) s += Gb[256 + t - s2] * Zb[s2];
      zz[i] = x1[i] * (s + hb[c] * v[i]);
    }
    __syncthreads();
#pragma unroll
    for (int i = 0; i < 4; ++i) Zb[lane + i * 64] = zz[i];
    for (int i = lane; i < 512; i += 64) Gb[i] = G[(size_t)(256 + c) * 512 + i];
    __syncthreads();
#pragma unroll
    for (int i = 0; i < 4; ++i) {
      int t = lane + i * 64; float s = 0.f;
      for (int s2 = 0; s2 < 256; ++s2) s += Gb[256 + t - s2] * Zb[s2];
      float o = x2[i] * (s + hb[256 + c] * zz[i]);
      Y[((size_t)ML + b * CL + t) * 256 + c] = (bf16_t)f2bf(o);
    }
  }
}

DI void ph_rope(const Params& p, char* smem) {
  float2* T16 = (float2*)smem;
  float2* T8 = T16 + 64 * 16;
  const int tid = my_tid(), lane = tid & 63, wid = tid >> 6;
  __syncthreads();
  for (int i = tid; i < 64 * 16; i += NTHR) {
    int pos = i >> 4, f = i & 15; float inv = powf(10000.f, -(float)f / 16.f); float s, c; sincosf((float)pos * inv, &s, &c);
    T16[i] = make_float2(c, s);
  }
  for (int i = tid; i < 64 * 8; i += NTHR) {
    int pos = i >> 3, f = i & 7; float inv = powf(10000.f, -(float)f / 8.f); float s, c; sincosf((float)pos * inv, &s, &c);
    T8[i] = make_float2(c, s);
  }
  __syncthreads();
  bf16_t* Psw = (bf16_t*)(p.ws + R_PSW); bf16_t* Pdf = (bf16_t*)(p.ws + R_PDF);
  for (int row = blockIdx.x * 8 + wid; row < ML; row += gridDim.x * 8) {
    const int t = row & (SL - 1); const int pr = t >> 6, pc = t & 63;
    bf16_t* q = Psw + (size_t)row * 384;
#pragma unroll
    for (int i = 0; i < 3; ++i) {
      int pi = lane + i * 64; int hd = pi >> 5, pp = pi & 31; int half = pp >> 4, f = pp & 15;
      int base = hd * 64 + half * 32; float2 cs = T16[(half ? pc : pr) * 16 + f];
      float x1 = bf2f(q[base + f]), x2 = bf2f(q[base + 16 + f]);
      q[base + f] = (bf16_t)f2bf(x1 * cs.x - x2 * cs.y); q[base + 16 + f] = (bf16_t)f2bf(x1 * cs.y + x2 * cs.x);
    }
    bf16_t* d = Pdf + (size_t)row * 512;
#pragma unroll
    for (int i = 0; i < 4; ++i) {
      int pi = lane + i * 64; int gi = pi >> 4, pp = pi & 15; int half = pp >> 3, f = pp & 7;
      int base = gi * 32 + half * 16; float2 cs = T8[(half ? pc : pr) * 8 + f];
      float x1 = bf2f(d[base + f]), x2 = bf2f(d[base + 8 + f]);
      d[base + f] = (bf16_t)f2bf(x1 * cs.x - x2 * cs.y); d[base + 8 + f] = (bf16_t)f2bf(x1 * cs.y + x2 * cs.x);
    }
  }
}

DI float rw_shift(const bf16_t* __restrict__ P, int row, int t, int len, int col, float mu) {
  float c = bf2f(P[(size_t)row * 1216 + col]);
  float a = t >= 1 ? bf2f(P[(size_t)(row - 1) * 1216 + col]) : 0.f;
  float b = t + 1 < len ? bf2f(P[(size_t)(row + 1) * 1216 + col]) : 0.f;
  return c + (0.5f * (a + b) - c) * mu;
}
DI void ph_rwprep(const Params& p, int l, char* smem) {
  constexpr int AST = 912, RST = 1552, ROFF = 32 * AST;
  const int tid = my_tid(), lane = tid & 63, wid = tid >> 6, g = lane >> 4, r16 = lane & 15;
  const int tg = wid >> 2, hd = wid & 3;
  const bf16_t* P = (const bf16_t*)(p.ws + R_PRW);
  const float* mu = p.in[17] + (size_t)l * 1216;
  const float* w0 = p.in[18] + (size_t)l * 512; const float* a0 = p.in[20] + (size_t)l * 256;
  const float* kkw = p.in[23] + (size_t)l * 256; const float* kaw = p.in[24] + (size_t)l * 256;
  bf16_t* S = (bf16_t*)(p.ws + R_STR); bf16_t* Gs = (bf16_t*)(p.ws + R_G);
  const size_t SU = (size_t)MT * 256;
  float w0f[4], w0b[4], a0c[4], kkc[4], kac[4];
#pragma unroll
  for (int nt = 0; nt < 4; ++nt) { int c = hd * 64 + r16 * 4 + nt; w0f[nt] = w0[c]; w0b[nt] = w0[256 + c]; a0c[nt] = a0[c]; kkc[nt] = kkw[c]; kac[nt] = kaw[c]; }
  for (int u = blockIdx.x; u < MT / 32; u += gridDim.x) {
    const int row0 = u * 32; int t0, len;
    if (row0 < ML) { t0 = row0 & (SL - 1); len = SL; } else { t0 = (row0 - ML) & (CL - 1); len = CL; }
    __syncthreads();
    for (int item = tid; item < 32 * 152; item += NTHR) {
      const int tk = item / 152, c8 = item - tk * 152; const int row = row0 + tk, t = t0 + tk;
      const uint4 uc = *(const uint4*)(P + (size_t)row * 1216 + c8 * 8);
      uint4 ua = make_uint4(0, 0, 0, 0), ub = make_uint4(0, 0, 0, 0);
      if (t >= 1) ua = *(const uint4*)(P + (size_t)(row - 1) * 1216 + c8 * 8);
      if (t + 1 < len) ub = *(const uint4*)(P + (size_t)(row + 1) * 1216 + c8 * 8);
      const float4 m0 = *(const float4*)(mu + c8 * 8), m1 = *(const float4*)(mu + c8 * 8 + 4);
      float o[8];
      {
        const unsigned wc[4] = {uc.x, uc.y, uc.z, uc.w}, wa[4] = {ua.x, ua.y, ua.z, ua.w}, wb[4] = {ub.x, ub.y, ub.z, ub.w};
        const float mm[8] = {m0.x, m0.y, m0.z, m0.w, m1.x, m1.y, m1.z, m1.w};
#pragma unroll
        for (int i = 0; i < 4; ++i) {
          float c_lo = bflo(wc[i]), c_hi = bfhi(wc[i]);
          o[2 * i] = c_lo + (0.5f * (bflo(wa[i]) + bflo(wb[i])) - c_lo) * mm[2 * i];
          o[2 * i + 1] = c_hi + (0.5f * (bfhi(wa[i]) + bfhi(wb[i])) - c_hi) * mm[2 * i + 1];
        }
      }
      char* dst;
      if (c8 < 96) dst = smem + ROFF + tk * RST + c8 * 16;
      else {
        const int cc = c8 * 8 - 768;
        if (cc < 128) {
#pragma unroll
          for (int i = 0; i < 8; ++i) o[i] = 1.f - 2.f * __builtin_amdgcn_rcpf(1.f + __expf(2.f * o[i]));
        } else if (cc >= 192) {
#pragma unroll
          for (int i = 0; i < 8; ++i) o[i] = sigmoidf_(o[i]);
        }
        dst = smem + tk * AST + cc * 2;
      }
      uint4 ov; ov.x = pack2(o[0], o[1]); ov.y = pack2(o[2], o[3]); ov.z = pack2(o[4], o[5]); ov.w = pack2(o[6], o[7]);
      *(uint4*)dst = ov;
    }
    __syncthreads();
    f32x4 acc[5][4];
#pragma unroll
    for (int o5 = 0; o5 < 5; ++o5)
#pragma unroll
      for (int nt = 0; nt < 4; ++nt) acc[o5][nt] = (f32x4){0.f, 0.f, 0.f, 0.f};
    const char* Arow = smem + (tg * 16 + r16) * AST + g * 16;
#pragma unroll
    for (int o5 = 0; o5 < 5; ++o5) {
      const int kbase = o5 < 3 ? o5 * 64 : (o5 == 3 ? 192 : 320);
      const int KK = o5 < 3 ? 64 : 128;
      const bf16_t* Wt = (const bf16_t*)(p.ws + (o5 == 0 ? RWW_F : o5 == 1 ? RWW_B : o5 == 2 ? RWW_A : o5 == 3 ? RWW_GF : RWW_GB));
#pragma unroll
      for (int ks = 0; ks < KK / 32; ++ks) {
        const bf16x8 af = *(const bf16x8*)(Arow + (kbase + ks * 32) * 2);
#pragma unroll
        for (int nt = 0; nt < 4; ++nt) {
          const bf16x8 bf = *(const bf16x8*)(Wt + (size_t)(hd * 64 + nt * 16 + r16) * KK + ks * 32 + g * 8);
          acc[o5][nt] = __builtin_amdgcn_mfma_f32_16x16x32_bf16(af, bf, acc[o5][nt], 0, 0, 0);
        }
        if (ks & 1) asm volatile("" ::: "memory");
      }
    }
#pragma unroll
    for (int j = 0; j < 4; ++j) {
      const int tk = tg * 16 + g * 4 + j; const size_t row = (size_t)row0 + tk;
      const char* rk = smem + ROFF + tk * RST;
      const int c0 = hd * 64 + r16 * 4;
      const uint2 ur = *(const uint2*)(rk + c0 * 2), uk = *(const uint2*)(rk + (256 + c0) * 2), uv = *(const uint2*)(rk + (512 + c0) * 2);
      const float rv[4] = {bflo(ur.x), bfhi(ur.x), bflo(ur.y), bfhi(ur.y)};
      const float kv[4] = {bflo(uk.x), bfhi(uk.x), bflo(uk.y), bfhi(uk.y)};
      const float vv[4] = {bflo(uv.x), bfhi(uv.x), bflo(uv.y), bfhi(uv.y)};
      float n2 = 0.f;
#pragma unroll
      for (int nt = 0; nt < 4; ++nt) { float q = kv[nt] * kkc[nt]; n2 += q * q; }
      n2 = sum16(n2);
      const float inv = __builtin_amdgcn_rsqf(fmaxf(n2, 1e-24f));
      float o_kp[4], o_kk[4], o_b[4], o_df[4], o_db[4];
#pragma unroll
      for (int nt = 0; nt < 4; ++nt) {
        const float k = kv[nt];
        const float a = sigmoidf_(a0c[nt] + acc[2][nt][j]);
        const float kk = k * kkc[nt] * inv;
        o_kp[nt] = k * (1.f + (a - 1.f) * kac[nt]);
        o_kk[nt] = kk; o_b[nt] = kk * a;
        const float xf = -(w0f[nt] + acc[0][nt][j]); const float spf = fmaxf(xf, 0.f) + __logf(1.f + __expf(-fabsf(xf)));
        const float xb = -(w0b[nt] + acc[1][nt][j]); const float spb = fmaxf(xb, 0.f) + __logf(1.f + __expf(-fabsf(xb)));
        const float ef = __expf(-spf - 0.5f), eb = __expf(-spb - 0.5f);
        o_df[nt] = 1.f - __expf(-ef); o_db[nt] = 1.f - __expf(-eb);
      }
      const size_t o = row * 256 + c0;
      uint2 w;
      w.x = pack2(rv[0], rv[1]); w.y = pack2(rv[2], rv[3]); *(uint2*)(S + o) = w;
      w.x = pack2(o_kp[0], o_kp[1]); w.y = pack2(o_kp[2], o_kp[3]); *(uint2*)(S + SU + o) = w;
      w.x = pack2(vv[0], vv[1]); w.y = pack2(vv[2], vv[3]); *(uint2*)(S + 2 * SU + o) = w;
      w.x = pack2(o_kk[0], o_kk[1]); w.y = pack2(o_kk[2], o_kk[3]); *(uint2*)(S + 3 * SU + o) = w;
      w.x = pack2(o_b[0], o_b[1]); w.y = pack2(o_b[2], o_b[3]); *(uint2*)(S + 4 * SU + o) = w;
      w.x = pack2(o_df[0], o_df[1]); w.y = pack2(o_df[2], o_df[3]); *(uint2*)(S + 5 * SU + o) = w;
      w.x = pack2(o_db[0], o_db[1]); w.y = pack2(o_db[2], o_db[3]); *(uint2*)(S + 6 * SU + o) = w;
      w.x = pack2(acc[3][0][j], acc[3][1][j]); w.y = pack2(acc[3][2][j], acc[3][3][j]); *(uint2*)(Gs + o) = w;
      w.x = pack2(acc[4][0][j], acc[4][1][j]); w.y = pack2(acc[4][2][j], acc[4][3][j]); *(uint2*)(Gs + SU + o) = w;
    }
  }
}

DI long scan_row(int b, int dir, int s) {
  if (s < CL) return (long)ML + b * CL + (dir ? (CL - 1 - s) : s);
  int t = s - CL; return (long)b * SL + (dir ? (SL - 1 - t) : t);
}
DI float sum8(float v) {
  v += dpp_mov<0xB1>(v);
  v += dpp_mov<0x4E>(v);
  v += dpp_mov<0x141>(v);
  return v;
}
DI void ph_scan(const Params& p, char* smem) {
  const int tid = my_tid(), lane = tid & 63, wid = tid >> 6;
  const bf16_t* S = (const bf16_t*)(p.ws + R_STR);
  const size_t SU = (size_t)MT * 256;
  constexpr int T = 32, NSTEP = CL + SL, NCH = NSTEP / T;
  typedef float f32x2 __attribute__((ext_vector_type(2)));
  for (int u = blockIdx.x; u < 128; u += gridDim.x) {
    const int chain = u >> 1, rg = u & 1; const int dir = chain & 1, bh = chain >> 1, b = bh >> 2, h = bh & 3;
    bf16_t* O = (bf16_t*)(p.ws + (dir ? R_OB : R_OF));
    uint4 q0, q1, q2;
    auto SC_GLOAD = [&](int ci) {
#pragma unroll
      for (int j = 0; j < 3; ++j) {
        int idx = tid + j * 512; int st = idx >> 8, s = (idx & 255) >> 3, ck = idx & 7;
        long row = scan_row(b, dir, ci * T + s);
        int sid = st < 5 ? st : 5 + dir;
        uint4 v = *(const uint4*)(S + sid * SU + row * 256 + h * 64 + ck * 8);
        if (j == 0) q0 = v; else if (j == 1) q1 = v; else q2 = v;
      }
    };
    auto SC_SSTORE = [&](int buf) {
#pragma unroll
      for (int j = 0; j < 3; ++j) {
        int idx = tid + j * 512; int st = idx >> 8;
        uint4 v = j == 0 ? q0 : (j == 1 ? q1 : q2);
        float4 lo = make_float4(bflo(v.x), bfhi(v.x), bflo(v.y), bfhi(v.y));
        float4 hi = make_float4(bflo(v.z), bfhi(v.z), bflo(v.w), bfhi(v.w));
        if (st == 5) { lo.x = 1.f - lo.x; lo.y = 1.f - lo.y; lo.z = 1.f - lo.z; lo.w = 1.f - lo.w; hi.x = 1.f - hi.x; hi.y = 1.f - hi.y; hi.z = 1.f - hi.z; hi.w = 1.f - hi.w; }
        char* base = smem + buf * 49152 + idx * 32;
        *(float4*)(base) = lo; *(float4*)(base + 16) = hi;
      }
    };
    auto FLUSH = [&](int ci) {
      const int s = tid >> 4, part = tid & 15;
      const float2 v = *(const float2*)(smem + 98304 + (ci & 1) * 4096 + s * 128 + part * 8);
      long row = scan_row(b, dir, ci * T + s);
      *(unsigned*)(O + row * 256 + h * 64 + rg * 32 + part * 2) = pack2(v.x, v.y);
    };
    __syncthreads();
    SC_GLOAD(0);
    SC_SSTORE(0);
    __syncthreads();
    f32x2 st0 = {0.f, 0.f}, st1 = {0.f, 0.f}, st2 = {0.f, 0.f}, st3 = {0.f, 0.f};
    const int rsub = lane >> 3, ks = lane & 7;
    const int lrow = (wid & 3) * 8 + rsub;
    const int vrow = rg * 32 + lrow;
    struct Step { f32x2 r[4], k[4], kk[4], b[4], w[4]; float v; };
    auto LOADSTEP = [&](Step& x, const char* B, int s) {
#pragma unroll
      for (int hh = 0; hh < 2; ++hh) {
        const float4 r = *(const float4*)(B + (0 * T + s) * 256 + ks * 32 + hh * 16);
        const float4 k = *(const float4*)(B + (1 * T + s) * 256 + ks * 32 + hh * 16);
        const float4 kk = *(const float4*)(B + (3 * T + s) * 256 + ks * 32 + hh * 16);
        const float4 bb = *(const float4*)(B + (4 * T + s) * 256 + ks * 32 + hh * 16);
        const float4 w = *(const float4*)(B + (5 * T + s) * 256 + ks * 32 + hh * 16);
        x.r[2 * hh] = (f32x2){r.x, r.y}; x.r[2 * hh + 1] = (f32x2){r.z, r.w};
        x.k[2 * hh] = (f32x2){k.x, k.y}; x.k[2 * hh + 1] = (f32x2){k.z, k.w};
        x.kk[2 * hh] = (f32x2){kk.x, kk.y}; x.kk[2 * hh + 1] = (f32x2){kk.z, kk.w};
        x.b[2 * hh] = (f32x2){bb.x, bb.y}; x.b[2 * hh + 1] = (f32x2){bb.z, bb.w};
        x.w[2 * hh] = (f32x2){w.x, w.y}; x.w[2 * hh + 1] = (f32x2){w.z, w.w};
      }
      x.v = *(const float*)(B + (2 * T + s) * 256 + vrow * 4);
    };
    for (int ci = 0; ci < NCH; ++ci) {
      if (ci + 1 < NCH) { SC_GLOAD(ci + 1); }
      if (ci > 0) FLUSH(ci - 1);
      if (wid < 4) {
        const char* B = smem + (ci & 1) * 49152;
        float* ob = (float*)(smem + 98304 + (ci & 1) * 4096);
        Step nx; LOADSTEP(nx, B, 0);
#pragma unroll 2
        for (int s = 0; s < T; ++s) {
          const Step c = nx;
          LOADSTEP(nx, B, s + 1);
          f32x2 pa = st0 * c.kk[0] + st1 * c.kk[1];
          f32x2 pb = st2 * c.kk[2] + st3 * c.kk[3];
          pa = pa + pb;
          float sa = -(pa.x + pa.y);
          sa = sum8(sa);
          const f32x2 sa2 = {sa, sa}; const f32x2 v2 = {c.v, c.v};
          st0 = st0 * c.w[0] + sa2 * c.b[0] + v2 * c.k[0];
          st1 = st1 * c.w[1] + sa2 * c.b[1] + v2 * c.k[1];
          st2 = st2 * c.w[2] + sa2 * c.b[2] + v2 * c.k[2];
          st3 = st3 * c.w[3] + sa2 * c.b[3] + v2 * c.k[3];
          f32x2 oa = st0 * c.r[0] + st1 * c.r[1];
          f32x2 ob2 = st2 * c.r[2] + st3 * c.r[3];
          oa = oa + ob2;
          float o = sum8(oa.x + oa.y);
          if (ks == 0) ob[s * 32 + lrow] = o;
        }
      }
      if (ci + 1 < NCH) { SC_SSTORE((ci + 1) & 1); }
      __syncthreads();
    }
    FLUSH(NCH - 1);
  }
}

template <bool DIFF>
DI void attn_unit(const Params& p, int l, int b, int h, int qrow0, int qpos0, int kb_lo, int kb_hi, int kc_lo, char* smem) {
  const int tid = my_tid(), lane = tid & 63, wid = tid >> 6, g = lane >> 4, r16 = lane & 15;
  const bf16_t* QK = (const bf16_t*)(p.ws + (DIFF ? R_PDF : R_PSW));
  const int ldq = DIFF ? 512 : 384;
  const int qc0 = h * 64;
  const int kc0 = 256 + (DIFF ? h * 64 : (h >> 1) * 64);
  const bf16_t* VT = DIFF ? (const bf16_t*)(p.ws + R_VTDF) + ((size_t)b * 256 + h * 64) * KEYS
                          : (const bf16_t*)(p.ws + R_VTSW) + ((size_t)b * 128 + (h >> 1) * 64) * KEYS;
  const int nblk = (kb_hi - kb_lo) + (68 - kc_lo);
  const float sc = (DIFF ? 0.17677669529663687f : 0.125f) * 1.4426950408889634f;
  bf16x8 qf[2];
  {
    const bf16_t* qp = QK + (size_t)(qrow0 + wid * 16 + r16) * ldq + qc0 + g * 8;
    qf[0] = *(const bf16x8*)(qp); qf[1] = *(const bf16x8*)(qp + 32);
  }
  constexpr int NC = DIFF ? 2 : 1;
  float m[NC], lsum[NC];
  f32x4 O[NC][4];
#pragma unroll
  for (int c = 0; c < NC; ++c) {
    if (DIFF) { m[c] = -1e30f; lsum[c] = 0.f; }
    else { m[c] = p.in[16][l * 4 + h] * 1.4426950408889634f; lsum[c] = (g == 0) ? 1.f : 0.f; }
#pragma unroll
    for (int dt = 0; dt < 4; ++dt) O[c][dt] = (f32x4){0.f, 0.f, 0.f, 0.f};
  }
  const int lr = tid >> 3, lc = tid & 7;
  uint4 rkA, rvA, rkB, rvB;
  rkA = make_uint4(0, 0, 0, 0); rvA = rkA; rkB = rkA; rvB = rkA;
  auto AT_GLOAD = [&](int i, uint4& rk, uint4& rv) {
    int kb = i < (kb_hi - kb_lo) ? kb_lo + i : kc_lo + (i - (kb_hi - kb_lo));
    long krow = kb < 64 ? (long)b * SL + kb * 64 + lr : (long)ML + b * CL + (kb - 64) * 64 + lr;
    rk = *(const uint4*)(QK + krow * ldq + kc0 + lc * 8);
    rv = *(const uint4*)(VT + (size_t)lr * KEYS + kb * 64 + lc * 8);
  };
  auto AT_SSTORE = [&](int buf, const uint4& rk, const uint4& rv) {
    *(uint4*)(smem + buf * 18432 + lr * 128 + ((lc ^ (lr & 7)) << 4)) = rk;
    *(uint4*)(smem + buf * 18432 + 9216 + lr * 144 + lc * 16) = rv;
  };
  __syncthreads();
  AT_GLOAD(0, rkA, rvA);
  AT_SSTORE(0, rkA, rvA);
  if (1 < nblk) AT_GLOAD(1, rkA, rvA);
  if (2 < nblk) AT_GLOAD(2, rkB, rvB);
  lds_barrier();
  const int qpos = qpos0 + wid * 16 + r16;
  for (int i = 0; i < nblk; ++i) {
    const int kb = i < (kb_hi - kb_lo) ? kb_lo + i : kc_lo + (i - (kb_hi - kb_lo));
    const bool masked = (!DIFF) && (kb < 64);
    const char* Kt = smem + (i & 1) * 18432; const char* Vt = Kt + 9216;
    f32x4 S[NC][4];
#pragma unroll
    for (int kt = 0; kt < 4; ++kt) {
      bf16x8 k0 = *(const bf16x8*)(Kt + (kt * 16 + r16) * 128 + ((g ^ (r16 & 7)) << 4));
      bf16x8 k1 = *(const bf16x8*)(Kt + (kt * 16 + r16) * 128 + (((4 + g) ^ (r16 & 7)) << 4));
      if (DIFF) {
        S[0][kt] = __builtin_amdgcn_mfma_f32_16x16x32_bf16(k0, qf[0], (f32x4){0.f, 0.f, 0.f, 0.f}, 0, 0, 0);
        S[NC - 1][kt] = __builtin_amdgcn_mfma_f32_16x16x32_bf16(k1, qf[1], (f32x4){0.f, 0.f, 0.f, 0.f}, 0, 0, 0);
      } else {
        f32x4 t = __builtin_amdgcn_mfma_f32_16x16x32_bf16(k0, qf[0], (f32x4){0.f, 0.f, 0.f, 0.f}, 0, 0, 0);
        S[0][kt] = __builtin_amdgcn_mfma_f32_16x16x32_bf16(k1, qf[1], t, 0, 0, 0);
      }
    }
    bf16x8 pf[NC][2];
#pragma unroll
    for (int c = 0; c < NC; ++c) {
      float mx = -1e30f;
#pragma unroll
      for (int kt = 0; kt < 4; ++kt)
#pragma unroll
        for (int j = 0; j < 4; ++j) {
          float v = S[c][kt][j];
          if (masked) { int kpos = kb * 64 + kt * 16 + g * 4 + j; int dd = kpos - qpos; if (dd > 128 || dd < -128) v = -3e38f; S[c][kt][j] = v; }
          mx = fmaxf(mx, v);
        }
      mx *= sc;
      mx = fmaxf(mx, __shfl_xor(mx, 16)); mx = fmaxf(mx, __shfl_xor(mx, 32));
      const float mn = fmaxf(m[c], mx);
      const bool grow = mn > m[c];
      float ps = 0.f;
      unsigned pk[8];
#pragma unroll
      for (int kt = 0; kt < 4; ++kt) {
        float e0 = __builtin_amdgcn_exp2f(fmaf(S[c][kt][0], sc, -mn)), e1 = __builtin_amdgcn_exp2f(fmaf(S[c][kt][1], sc, -mn));
        float e2 = __builtin_amdgcn_exp2f(fmaf(S[c][kt][2], sc, -mn)), e3 = __builtin_amdgcn_exp2f(fmaf(S[c][kt][3], sc, -mn));
        ps += (e0 + e1) + (e2 + e3);
        pk[kt * 2] = pack2(e0, e1); pk[kt * 2 + 1] = pack2(e2, e3);
      }
      if (__builtin_amdgcn_ballot_w64(grow) != 0ull) {
        const float alpha = __builtin_amdgcn_exp2f(m[c] - mn);
        m[c] = mn;
        lsum[c] *= alpha;
#pragma unroll
        for (int dt = 0; dt < 4; ++dt) { O[c][dt][0] *= alpha; O[c][dt][1] *= alpha; O[c][dt][2] *= alpha; O[c][dt][3] *= alpha; }
      }
      lsum[c] += ps;
      union { unsigned u[4]; bf16x8 v; } cv;
      cv.u[0] = pk[0]; cv.u[1] = pk[1]; cv.u[2] = pk[2]; cv.u[3] = pk[3]; pf[c][0] = cv.v;
      cv.u[0] = pk[4]; cv.u[1] = pk[5]; cv.u[2] = pk[6]; cv.u[3] = pk[7]; pf[c][1] = cv.v;
    }
#pragma unroll
    for (int dt = 0; dt < 4; ++dt)
#pragma unroll
      for (int s2 = 0; s2 < 2; ++s2) {
        union { uint2 u[2]; bf16x8 v; } vf;
        vf.u[0] = *(const uint2*)(Vt + (dt * 16 + r16) * 144 + (2 * s2) * 32 + g * 8);
        vf.u[1] = *(const uint2*)(Vt + (dt * 16 + r16) * 144 + (2 * s2 + 1) * 32 + g * 8);
#pragma unroll
        for (int c = 0; c < NC; ++c) O[c][dt] = __builtin_amdgcn_mfma_f32_16x16x32_bf16(vf.v, pf[c][s2], O[c][dt], 0, 0, 0);
      }
    if (i + 1 < nblk) AT_SSTORE((i + 1) & 1, rkA, rvA);
    rkA = rkB; rvA = rvB;
    if (i + 3 < nblk) AT_GLOAD(i + 3, rkB, rvB);
    lds_barrier();
  }
  float linv[NC];
#pragma unroll
  for (int c = 0; c < NC; ++c) { float t = lsum[c]; t += __shfl_xor(t, 16); t += __shfl_xor(t, 32); linv[c] = 1.f / t; }
  const size_t orow = (size_t)(qrow0 + wid * 16 + r16);
  if (!DIFF) {
    bf16_t* Y = (bf16_t*)(p.ws + R_YSW);
#pragma unroll
    for (int dt = 0; dt < 4; ++dt) {
      uint2 o; o.x = pack2(O[0][dt][0] * linv[0], O[0][dt][1] * linv[0]); o.y = pack2(O[0][dt][2] * linv[0], O[0][dt][3] * linv[0]);
      *(uint2*)(Y + orow * 256 + h * 64 + dt * 16 + g * 4) = o;
    }
  } else {
    const float lam_init = 0.8f - 0.6f * __expf(-0.3f * (float)l);
    float d1 = 0.f, d2 = 0.f;
    if (lane < 32) { d1 = p.in[28][l * 32 + lane] * p.in[29][l * 32 + lane]; d2 = p.in[30][l * 32 + lane] * p.in[31][l * 32 + lane]; }
    d1 = wave_sum(d1); d2 = wave_sum(d2);
    const float lam = expf(d1) - expf(d2) + lam_init;
    float ov[4][4]; float ss = 0.f;
#pragma unroll
    for (int dt = 0; dt < 4; ++dt)
#pragma unroll
      for (int j = 0; j < 4; ++j) { float v = O[0][dt][j] * linv[0] - lam * O[NC - 1][dt][j] * linv[NC - 1]; ov[dt][j] = v; ss += v * v; }
    ss += __shfl_xor(ss, 16); ss += __shfl_xor(ss, 32);
    const float rms = rsqrtf(ss * (1.f / 64.f) + 1e-5f) * (1.f - lam_init);
    const float* sg = p.in[32] + l * 64;
    bf16_t* Y = (bf16_t*)(p.ws + R_YDF);
#pragma unroll
    for (int dt = 0; dt < 4; ++dt) {
      const int d0 = dt * 16 + g * 4;
      uint2 o; o.x = pack2(ov[dt][0] * rms * sg[d0], ov[dt][1] * rms * sg[d0 + 1]); o.y = pack2(ov[dt][2] * rms * sg[d0 + 2], ov[dt][3] * rms * sg[d0 + 3]);
      *(uint2*)(Y + orow * 256 + h * 64 + d0) = o;
    }
  }
}

DI void ph_attn(const Params& p, int l, char* smem) {
  const bool need_ctx = (l == 0);
  const int n_sw = 1024 + (need_ctx ? 64 : 0);
  const int n_df = 1024 + (need_ctx ? 64 : 0);
  unsigned* ctr = (unsigned*)(p.ws + MISC_BAR + 64 + 64 * l);
  volatile int* slot = (volatile int*)(smem + 40960);
  for (;;) {
    __syncthreads();
    if (my_tid() == 0) *slot = (int)__hip_atomic_fetch_add(ctr, 1u, __ATOMIC_RELAXED, __HIP_MEMORY_SCOPE_AGENT);
    __syncthreads();
    const int u = *slot;
    if (u >= n_sw + n_df) break;
    if (u < n_df) {
      if (u < 1024) { int b = u >> 7, h = (u >> 5) & 3, n = u & 31; attn_unit<true>(p, l, b, h, b * SL + n * 128, n * 128, 0, 64, 64, smem); }
      else { int v = u - 1024; int b = v >> 3, h = (v >> 1) & 3, n = v & 1; attn_unit<true>(p, l, b, h, ML + b * CL + n * 128, 0, 0, 0, 64, smem); }
    } else {
      int w = u - n_df;
      if (w < 1024) {
        int b = w >> 7, h = (w >> 5) & 3, n = w & 31;
        int lo = (n - 1) * 2; if (lo < 0) lo = 0; int hi = (n + 2) * 2; if (hi > 64) hi = 64;
        attn_unit<false>(p, l, b, h, b * SL + n * 128, n * 128, lo, hi, 64, smem);
      } else { int v = w - 1024; int b = v >> 3, h = (v >> 1) & 3, n = v & 1; attn_unit<false>(p, l, b, h, ML + b * CL + n * 128, 0, 0, 0, 64, smem); }
    }
  }
}

DI void ph_rwout(const Params& p, int l) {
  const int lane = my_tid() & 63, wid = my_tid() >> 6;
  const bf16_t* S = (const bf16_t*)(p.ws + R_STR); const bf16_t* Gs = (const bf16_t*)(p.ws + R_G);
  const bf16_t* OF = (const bf16_t*)(p.ws + R_OF); const bf16_t* OB = (const bf16_t*)(p.ws + R_OB);
  bf16_t* Y = (bf16_t*)(p.ws + R_YRW);
  const size_t SU = (size_t)MT * 256;
  const float4 rk = *(const float4*)(p.in[25] + (size_t)l * 256 + lane * 4);
  const float4 gam = *(const float4*)(p.in[26] + (size_t)l * 256 + lane * 4);
  const float4 bet = *(const float4*)(p.in[27] + (size_t)l * 256 + lane * 4);
  const int nrows = (l == 0) ? MT : ML;
  for (int row = blockIdx.x * 8 + wid; row < nrows; row += gridDim.x * 8) {
    const size_t o = (size_t)row * 256 + lane * 4;
    uint2 ur = *(const uint2*)(S + o), uk = *(const uint2*)(S + SU + o), uv = *(const uint2*)(S + 2 * SU + o);
    uint2 uf = *(const uint2*)(OF + o), ub = *(const uint2*)(OB + o), ugf = *(const uint2*)(Gs + o), ugb = *(const uint2*)(Gs + SU + o);
    float r[4] = {bflo(ur.x), bfhi(ur.x), bflo(ur.y), bfhi(ur.y)};
    float k[4] = {bflo(uk.x), bfhi(uk.x), bflo(uk.y), bfhi(uk.y)};
    float v[4] = {bflo(uv.x), bfhi(uv.x), bflo(uv.y), bfhi(uv.y)};
    float f[4] = {bflo(uf.x), bfhi(uf.x), bflo(uf.y), bfhi(uf.y)};
    float bb[4] = {bflo(ub.x), bfhi(ub.x), bflo(ub.y), bfhi(ub.y)};
    float gf[4] = {bflo(ugf.x), bfhi(ugf.x), bflo(ugf.y), bfhi(ugf.y)};
    float gb[4] = {bflo(ugb.x), bfhi(ugb.x), bflo(ugb.y), bfhi(ugb.y)};
    const float rkv[4] = {rk.x, rk.y, rk.z, rk.w}; const float ga[4] = {gam.x, gam.y, gam.z, gam.w}; const float be[4] = {bet.x, bet.y, bet.z, bet.w};
    float bon = 0.f, sf = 0.f, sb = 0.f;
#pragma unroll
    for (int i = 0; i < 4; ++i) { bon += r[i] * k[i] * rkv[i]; sf += f[i]; sb += bb[i]; }
    bon = sum16(bon); float muf = sum16(sf) * (1.f / 64.f), mub = sum16(sb) * (1.f / 64.f);
    float qf = 0.f, qb = 0.f;
#pragma unroll
    for (int i = 0; i < 4; ++i) { f[i] -= muf; bb[i] -= mub; qf += f[i] * f[i]; qb += bb[i] * bb[i]; }
    float rsf = rsqrtf(sum16(qf) * (1.f / 64.f) + 64e-5f), rsb = rsqrtf(sum16(qb) * (1.f / 64.f) + 64e-5f);
    float y[4];
#pragma unroll
    for (int i = 0; i < 4; ++i) {
      float bn = bon * v[i];
      y[i] = (f[i] * rsf * ga[i] + be[i] + bn) * gf[i] + (bb[i] * rsb * ga[i] + be[i] + bn) * gb[i];
    }
    uint2 oo; oo.x = pack2(y[0], y[1]); oo.y = pack2(y[2], y[3]);
    *(uint2*)(Y + o) = oo;
  }
}

DI void ph_merge(const Params& p, int l, const bf16_t* U, char* smem) {
  const int lane = my_tid() & 63, wid = my_tid() >> 6, wm = wid >> 1, wn = wid & 1, g = lane >> 4, r16 = lane & 15;
  const int mtiles = (l == 0) ? 136 : 128;
  bf16_t* ACC = (bf16_t*)(p.ws + R_ACC);
  for (int it = 0;; ++it) {
    int mtile, ntile;
    if (!next_tile(it, mtiles, 8, mtile, ntile)) break;
    uint2 accS[4][4];
#pragma unroll
    for (int mt = 0; mt < 4; ++mt)
#pragma unroll
      for (int nt = 0; nt < 4; ++nt) accS[mt][nt] = make_uint2(0u, 0u);
    for (int j = 0; j < 4; ++j) {
      uint2 pb[4][4];
      {
        f32x4 accB[4][4]; zero_acc<4>(accB);
        const size_t yoff = (j == 0) ? R_YHY : (j == 1) ? R_YSW : (j == 2) ? R_YRW : R_YDF;
        gemm_glds(accB, (const bf16_t*)(p.ws + yoff), 256, RowPlain{(long)mtile * 256}, (const bf16_t*)(p.ws + WB_BR) + ((size_t)j * 1024 + ntile * 128) * 256, 256, 256, smem, (const bf16_t*)(p.ws + MISC_ZERO));
#pragma unroll
        for (int mt = 0; mt < 4; ++mt)
#pragma unroll
          for (int nt = 0; nt < 4; ++nt) { pb[mt][nt].x = pack2(accB[mt][nt][0], accB[mt][nt][1]); pb[mt][nt].y = pack2(accB[mt][nt][2], accB[mt][nt][3]); }
      }
      f32x4 accG[4][4]; zero_acc<4>(accG);
      gemm_glds(accG, U, 1024, RowPlain{(long)mtile * 256}, (const bf16_t*)(p.ws + WB_GATE) + ((size_t)j * 1024 + ntile * 128) * 1024, 1024, 1024, smem, (const bf16_t*)(p.ws + MISC_ZERO));
#pragma unroll
      for (int mt = 0; mt < 4; ++mt)
#pragma unroll
        for (int nt = 0; nt < 4; ++nt) {
          float v0 = bflo(accS[mt][nt].x) + sigmoidf_(accG[mt][nt][0]) * bflo(pb[mt][nt].x);
          float v1 = bfhi(accS[mt][nt].x) + sigmoidf_(accG[mt][nt][1]) * bfhi(pb[mt][nt].x);
          float v2 = bflo(accS[mt][nt].y) + sigmoidf_(accG[mt][nt][2]) * bflo(pb[mt][nt].y);
          float v3 = bfhi(accS[mt][nt].y) + sigmoidf_(accG[mt][nt][3]) * bfhi(pb[mt][nt].y);
          accS[mt][nt].x = pack2(v0, v1); accS[mt][nt].y = pack2(v2, v3);
        }
    }
#pragma unroll
    for (int mt = 0; mt < 4; ++mt) {
      const int col = ntile * 128 + wn * 64 + r16 * 4;
      const size_t row = (size_t)mtile * 256 + wm * 64 + mt * 16 + g * 4;
      uint2 o;
      o.x = (accS[mt][0].x & 0xffffu) | (accS[mt][1].x << 16); o.y = (accS[mt][2].x & 0xffffu) | (accS[mt][3].x << 16);
      *(uint2*)(ACC + (row + 0) * 1024 + col) = o;
      o.x = (accS[mt][0].x >> 16) | (accS[mt][1].x & 0xffff0000u); o.y = (accS[mt][2].x >> 16) | (accS[mt][3].x & 0xffff0000u);
      *(uint2*)(ACC + (row + 1) * 1024 + col) = o;
      o.x = (accS[mt][0].y & 0xffffu) | (accS[mt][1].y << 16); o.y = (accS[mt][2].y & 0xffffu) | (accS[mt][3].y << 16);
      *(uint2*)(ACC + (row + 2) * 1024 + col) = o;
      o.x = (accS[mt][0].y >> 16) | (accS[mt][1].y & 0xffff0000u); o.y = (accS[mt][2].y >> 16) | (accS[mt][3].y & 0xffff0000u);
      *(uint2*)(ACC + (row + 3) * 1024 + col) = o;
    }
  }
}

DI void ph_resgemm(const Params& p, int l, const bf16_t* A, int K, const bf16_t* Bt, const float* hsrc_lat, const float* hsrc_ctx, int gate_off, char* smem) {
  const int lane = my_tid() & 63, wid = my_tid() >> 6, wm = wid >> 1, wn = wid & 1, g = lane >> 4, r16 = lane & 15;
  const int mtiles = (l == 0) ? 136 : 128;
  const float* mod = (const float*)(p.ws + MISC_MOD) + (size_t)l * 9 * 6144;
  float* hc = (float*)(p.ws + OFF_HC);
  for (int it = 0;; ++it) {
    int mtile, ntile;
    if (!next_tile(it, mtiles, 8, mtile, ntile)) break;
    f32x4 acc[4][4]; zero_acc<4>(acc);
    gemm_glds(acc, A, K, RowPlain{(long)mtile * 256}, Bt + (size_t)ntile * 128 * K, K, K, smem, (const bf16_t*)(p.ws + MISC_ZERO));
    const int b = mtile < 128 ? (mtile >> 4) : 8;
    const float* gt = mod + (size_t)b * 6144 + gate_off;
    const int col = ntile * 128 + wn * 64 + r16 * 4;
    const float4 gv = *(const float4*)(gt + col);
#pragma unroll
    for (int mt = 0; mt < 4; ++mt)
#pragma unroll
      for (int e = 0; e < 4; ++e) {
        const int row = mtile * 256 + wm * 64 + mt * 16 + g * 4 + e;
        const float* hs; float* hd;
        if (row < ML) { size_t o = (size_t)row * D + col; hs = hsrc_lat + o; hd = p.out + o; }
        else { size_t o = (size_t)(row - ML) * D + col; hs = hsrc_ctx + o; hd = hc + o; }
        const float4 h = *(const float4*)hs;
        float4 r;
        r.x = DN_ALPHA * h.x + gv.x * acc[mt][0][e]; r.y = DN_ALPHA * h.y + gv.y * acc[mt][1][e];
        r.z = DN_ALPHA * h.z + gv.z * acc[mt][2][e]; r.w = DN_ALPHA * h.w + gv.w * acc[mt][3][e];
        *(float4*)hd = r;
      }
  }
}

DI void ph_ffnup(const Params& p, int l, char* smem) {
  const bf16_t* U = (const bf16_t*)(p.ws + R_U);
  const bf16_t* Bt = (const bf16_t*)(p.ws + WB_UP);
  bf16_t* HID = (bf16_t*)(p.ws + R_HID);
  const float* cw = p.in[38] + (size_t)l * 3 * 5632; const float* cb = p.in[39] + (size_t)l * 5632;
  const int tid = my_tid(), lane = tid & 63, wid = tid >> 6, wm = wid >> 2, wn = wid & 3, g = lane >> 4, r16 = lane & 15;
  const int mtiles = (l == 0) ? 144 : 136;
  constexpr int TS = 528;
  for (int it = 0;; ++it) {
    int mtile, ntile;
    if (!next_tile(it, mtiles, 22, mtile, ntile)) break;
    long rowbase; int t0, len, r0, r1;
    if (mtile < 136) { int b = mtile / 17; int tt = mtile % 17; len = SL; rowbase = (long)b * SL; t0 = tt * 254 - 1; r0 = 1; r1 = 254; }
    else { int b = mtile - 136; len = CL; rowbase = (long)ML + b * CL; t0 = 0; r0 = 0; r1 = 255; }
    f32x4 acc[8][4]; zero_acc256(acc);
    gemm_glds256(acc, U, 1024, rowbase + t0, Bt + (size_t)ntile * 256 * 1024, 1024, 1024, smem);
#pragma unroll
    for (int mt = 0; mt < 8; ++mt)
#pragma unroll
      for (int e = 0; e < 4; ++e) {
        uint2 o; o.x = pack2(acc[mt][0][e], acc[mt][1][e]); o.y = pack2(acc[mt][2][e], acc[mt][3][e]);
        *(uint2*)(smem + (wm * 128 + mt * 16 + g * 4 + e) * TS + (wn * 64 + r16 * 4) * 2) = o;
      }
    __syncthreads();
    {
      const int ch = tid & 127, rgp = tid >> 7; const int ca = ntile * 128 + ch, cbx = 2816 + ca;
      const float a0 = cw[ca], a1 = cw[5632 + ca], a2 = cw[2 * 5632 + ca], ab = cb[ca];
      const float b0 = cw[cbx], b1 = cw[5632 + cbx], b2 = cw[2 * 5632 + cbx], bb = cb[cbx];
      for (int r = r0 + rgp; r <= r1; r += 4) {
        const int tok = t0 + r;
        if (tok < len) {
          const char* Tr = smem + r * TS + ch * 2;
          const float pa = tok >= 1 ? bf2f(*(const bf16_t*)(Tr - TS)) : 0.f, pb_ = tok >= 1 ? bf2f(*(const bf16_t*)(Tr - TS + 256)) : 0.f;
          const float na = tok + 1 < len ? bf2f(*(const bf16_t*)(Tr + TS)) : 0.f, nb = tok + 1 < len ? bf2f(*(const bf16_t*)(Tr + TS + 256)) : 0.f;
          const float av = a0 * pa + a1 * bf2f(*(const bf16_t*)(Tr)) + a2 * na + ab;
          const float bv = b0 * pb_ + b1 * bf2f(*(const bf16_t*)(Tr + 256)) + b2 * nb + bb;
          HID[(size_t)(rowbase + tok) * 2816 + ca] = (bf16_t)f2bf(siluf_(av) * bv);
        }
      }
    }
  }
}

#ifndef REP_PREP
#define REP_PREP 1
#endif
#ifndef REP_GEMM
#define REP_GEMM 1
#endif
#ifndef REP_HY
#define REP_HY 1
#endif
#ifndef REP_RWP
#define REP_RWP 1
#endif
#ifndef REP_SCAN
#define REP_SCAN 1
#endif
#ifndef REP_ATTN
#define REP_ATTN 1
#endif
#ifndef PH_END
#define PH_END 24
#endif
#define XB_TMO      128
#define XB_XCNT(j)  (256  + 64 * (j))
#define XB_XSUB(j)  (1280 + 64 * (j))
#define XB_XGEN(j)  (2304 + 64 * (j))
#define XB_TOP      3328
#define XB_TOPGEN   3392
#define XCD_BAR_WORDS 3456
#define XB_SPIN_CAP (1u << 22)
DI unsigned xb_ld(unsigned* p) { return __hip_atomic_load(p, __ATOMIC_RELAXED, __HIP_MEMORY_SCOPE_AGENT); }
DI unsigned xb_add(unsigned* p, unsigned v) { return __hip_atomic_fetch_add(p, v, __ATOMIC_RELAXED, __HIP_MEMORY_SCOPE_AGENT); }
DI unsigned xb_xcc_id() { return (unsigned)__builtin_amdgcn_s_getreg((3 << 11) | 20) & 0xFu; }
#define XB_SPIN(cond, bar) do { unsigned _sp = 0; while (cond) { __builtin_amdgcn_s_sleep(1); \
    if ((++_sp & 255u) == 0u) { if (xb_ld(&(bar)[XB_TMO])) break; if (_sp > XB_SPIN_CAP) { atomicAdd(&(bar)[XB_TMO], 1u); break; } } } } while (0)
DI void xcd_barrier_complete(unsigned* bar, unsigned x, unsigned& nloc, unsigned& nx) {
  const unsigned G = gridDim.x;
  unsigned sum, cnt, mine, sp = 0u;
  for (;;) {
    sum = 0u; cnt = 0u; mine = 0u;
#pragma unroll
    for (unsigned j = 0; j < 16; ++j) { const unsigned c = xb_ld(&bar[XB_XCNT(j)]); sum += c; cnt += (c > 0u) ? 1u : 0u; mine = (j == x) ? c : mine; }
    if (sum == G) break;
    __builtin_amdgcn_s_sleep(1);
    if ((++sp & 255u) == 0u) { if (xb_ld(&bar[XB_TMO])) break; if (sp > XB_SPIN_CAP) { atomicAdd(&bar[XB_TMO], 1u); break; } }
  }
  nloc = mine > 0u ? mine : 1u; nx = cnt > 0u ? cnt : 1u;
}
DI void grid_barrier(unsigned* bar, volatile unsigned* st) {
  asm volatile("s_waitcnt vmcnt(0)" ::: "memory");
  __syncthreads();
  if (my_tid() == 0) {
    const unsigned x = xb_xcc_id();
    __builtin_amdgcn_s_waitcnt(0);
    unsigned nloc = st[0], nx = st[1];
    if (nloc == 0u) { xcd_barrier_complete(bar, x, nloc, nx); st[0] = nloc; st[1] = nx; }
    const unsigned old = xb_add(&bar[XB_XSUB(x)], 1u);
    const unsigned gen = old / nloc;
    if (old + 1u == (gen + 1u) * nloc) {
      __builtin_amdgcn_fence(__ATOMIC_RELEASE, "agent");
      asm volatile("s_waitcnt vmcnt(0)" ::: "memory");
      const unsigned og = xb_add(&bar[XB_TOP], 1u);
      const unsigned tg = og / nx;
      if (og + 1u == (tg + 1u) * nx) xb_add(&bar[XB_TOPGEN], 1u);
      else XB_SPIN(xb_ld(&bar[XB_TOPGEN]) == tg, bar);
      __builtin_amdgcn_fence(__ATOMIC_ACQUIRE, "agent");
      xb_add(&bar[XB_XGEN(x)], 1u);
      asm volatile("s_waitcnt vmcnt(0)" ::: "memory");
    } else {
      XB_SPIN(xb_ld(&bar[XB_XGEN(x)]) == gen, bar);
      __builtin_amdgcn_fence(__ATOMIC_ACQUIRE, "agent");
      asm volatile("s_waitcnt vmcnt(0)" ::: "memory");
    }
  }
  __syncthreads();
}
#define SYNC_OR_RET(idx) do { if ((idx) + 1 >= PH_END) return; if ((idx) == 0) { grid.sync(); if (my_tid() == 0) (void)xb_add(&((unsigned*)(p.ws + MISC_XBAR))[XB_XCNT(xb_xcc_id())], 1u); } else grid_barrier((unsigned*)(p.ws + MISC_XBAR), (volatile unsigned*)(smem + 144 * 1024)); } while (0)
template <int l>
DI void run_layer(const Params& p, cg::grid_group& grid, char* smem, unsigned& epoch) {
  const float* mod = (const float*)(p.ws + MISC_MOD) + (size_t)l * 9 * 6144;
  float* hc = (float*)(p.ws + OFF_HC);
  const float* hl_src = (l == 0) ? p.in[0] : p.out;
  const float* hc_src = (l == 0) ? p.in[2] : hc;
  constexpr int B0 = l * 12;
  if (l == 0) {
    ph_convert(p, 0, smem);
    ph_ada(p, smem);
    hy_rawfilter(p, 0, SL, (float*)(p.ws + R_RAWF), smem);
    hy_rawfilter(p, 0, CL, (float*)(p.ws + MISC_RAWC), smem);
    SYNC_OR_RET(B0 + 0);
    ph_kf(p, 0, smem);
    ph_ln(hl_src, hc_src, nullptr, nullptr, nullptr, nullptr, (bf16_t*)p.out, mod, 0, MT);
    SYNC_OR_RET(B0 + 1);
  }
  for (int rep = 0; rep < REP_GEMM; ++rep) ph_inproj(p, l == 0 ? (const bf16_t*)p.out : (const bf16_t*)(p.ws + R_U), smem);
  SYNC_OR_RET(B0 + 2);
  for (int rep = 0; rep < REP_HY; ++rep) {
  if (blockIdx.x == 0 && my_tid() == 0) *(unsigned*)(p.ws + MISC_BAR + 64 + 64 * l) = 0u;
  ph_hyena(p, l, smem);
  if (l == 0) ph_hyena_ctx(p, l, smem);
  }
  ph_rope(p, smem);
  for (int rep = 0; rep < REP_RWP; ++rep) ph_rwprep(p, l, smem);
  SYNC_OR_RET(B0 + 3);
  for (int rep = 0; rep < REP_SCAN; ++rep) ph_scan(p, smem);
  for (int rep = 0; rep < REP_ATTN; ++rep) ph_attn(p, l, smem);
  SYNC_OR_RET(B0 + 4);
  ph_rwout(p, l);
  if (l != 0) ph_ln(hl_src, hc_src, nullptr, nullptr, nullptr, nullptr, (bf16_t*)(p.ws + R_URE), mod, 0, ML);
  SYNC_OR_RET(B0 + 5);
  for (int rep = 0; rep < REP_GEMM; ++rep) ph_merge(p, l, l == 0 ? (const bf16_t*)p.out : (const bf16_t*)(p.ws + R_URE), smem);
  SYNC_OR_RET(B0 + 6);
  ph_resgemm(p, l, (const bf16_t*)(p.ws + R_ACC), 1024, (const bf16_t*)(p.ws + WB_OUT), hl_src, hc_src, 2048, smem);
  if (l == 0) hy_rawfilter(p, 1, SL, (float*)(p.ws + R_RAWF), smem);
  SYNC_OR_RET(B0 + 7);
  ph_ln(p.out, hc, p.out, hc, p.in[35] + (size_t)l * D, p.in[36] + (size_t)l * D, (bf16_t*)(p.ws + R_U), mod, 3072, l == 0 ? MT : ML);
  if (l == 0) ph_kf(p, 1, smem);
  SYNC_OR_RET(B0 + 8);
  for (int rep = 0; rep < REP_GEMM; ++rep) ph_ffnup(p, l, smem);
  SYNC_OR_RET(B0 + 9);
  ph_resgemm(p, l, (const bf16_t*)(p.ws + R_HID), 2816, (const bf16_t*)(p.ws + WB_DOWN), p.out, hc, 5120, smem);
  SYNC_OR_RET(B0 + 10);
  if (l == 0) {
    ph_ln(p.out, hc, p.out, hc, p.in[41], p.in[42], (bf16_t*)(p.ws + R_U), mod + 9 * 6144, 0, MT);
    ph_convert(p, 1, smem);
  } else {
    ph_ln(p.out, hc, p.out, hc, p.in[41] + (size_t)l * D, p.in[42] + (size_t)l * D, nullptr, mod, 0, ML);
  }
  SYNC_OR_RET(B0 + 11);
}

__global__ void __launch_bounds__(NTHR) mega(Params p) {
  extern __shared__ __attribute__((aligned(16))) char smem[];
  cg::grid_group grid = cg::this_grid();
  unsigned epoch = 0;
  if (blockIdx.x == 0) for (int i = my_tid(); i < XCD_BAR_WORDS; i += NTHR) ((unsigned*)(p.ws + MISC_XBAR))[i] = 0u;
  if (my_tid() < 2) ((volatile unsigned*)(smem + 144 * 1024))[my_tid()] = 0u;
  if (blockIdx.x == 0 && my_tid() < 64) *(unsigned*)(p.ws + MISC_ZERO + my_tid() * 4) = 0u;
  run_layer<0>(p, grid, smem, epoch);
  if (PH_END > 12) run_layer<1>(p, grid, smem, epoch);
}

extern "C" void kernel_launch(void* const* d_in, const int* in_sizes, int n_in, void* d_out, int out_size,
                              void* d_ws, size_t ws_size, hipStream_t stream) {
  static int grid_blocks = 0;
  if (!grid_blocks) {
    int dev = 0, cus = 0, per_cu = 0;
    (void)hipGetDevice(&dev);
    (void)hipDeviceGetAttribute(&cus, hipDeviceAttributeMultiprocessorCount, dev);
    (void)hipFuncSetAttribute((const void*)mega, hipFuncAttributeMaxDynamicSharedMemorySize, SMEM_BYTES);
    (void)hipOccupancyMaxActiveBlocksPerMultiprocessor(&per_cu, mega, NTHR, SMEM_BYTES);
    if (per_cu < 1) per_cu = 1;
    if (per_cu > 1) per_cu = 1;
    grid_blocks = cus * per_cu;
  }
  Params p{};
  for (int i = 0; i < 43; ++i) p.in[i] = (const float*)d_in[i];
  p.out = (float*)d_out; p.ws = (char*)d_ws;
  void* args[] = {&p};
  hipError_t e = hipLaunchCooperativeKernel((void*)mega, dim3(grid_blocks), dim3(NTHR), args, SMEM_BYTES, stream);
  if (e != hipSuccess) fprintf(stderr, "cooperative launch failed: %s (grid %d)\n", hipGetErrorString(e), grid_blocks);
}
```

```cpp
#include <hip/hip_runtime.h>
#include <hip/hip_cooperative_groups.h>
#include <cstdio>
#include <cstdint>
namespace cg = cooperative_groups;

#define DI __device__ __forceinline__
typedef unsigned short bf16_t;
typedef short bf16x8 __attribute__((ext_vector_type(8)));
typedef float f32x4 __attribute__((ext_vector_type(4)));

constexpr int D = 1024, NB = 8, SL = 4096, CL = 256;
constexpr int ML = NB * SL, MC = NB * CL, MT = ML + MC;
constexpr int KEYS = SL + CL;
constexpr int NTHR = 512;
constexpr float DN_ALPHA = 1.41421356237f;
constexpr size_t UNIT = (size_t)MT * 512;

constexpr size_t WB_IN = 0;
constexpr size_t WB_GATE = WB_IN + (size_t)3328 * 1024 * 2;
constexpr size_t WB_BR = WB_GATE + (size_t)4096 * 1024 * 2;
constexpr size_t WB_OUT = WB_BR + (size_t)4 * 1024 * 256 * 2;
constexpr size_t WB_UP = WB_OUT + (size_t)1024 * 1024 * 2;
constexpr size_t WB_DOWN = WB_UP + (size_t)5632 * 1024 * 2;
constexpr size_t WB_END = WB_DOWN + (size_t)1024 * 2816 * 2;
constexpr size_t OFF_KF = WB_END;
constexpr size_t OFF_HC = OFF_KF + (size_t)512 * 8192 * 8;
constexpr size_t OFF_MISC = OFF_HC + (size_t)MC * D * 4;
constexpr size_t MISC_MOD = OFF_MISC;
constexpr size_t MISC_TW = MISC_MOD + (size_t)2 * 9 * 6144 * 4;
constexpr size_t MISC_RAWC = MISC_TW + 4096 * 8;
constexpr size_t MISC_GCTX = MISC_RAWC + (size_t)256 * 1024 * 4;
constexpr size_t MISC_RWW = MISC_GCTX + (size_t)512 * 512 * 4;
constexpr size_t RWW_F = MISC_RWW, RWW_B = RWW_F + 256 * 64 * 2, RWW_A = RWW_B + 256 * 64 * 2, RWW_GF = RWW_A + 256 * 64 * 2, RWW_GB = RWW_GF + 256 * 128 * 2;
constexpr size_t MISC_XBAR = OFF_MISC + (size_t)3 * 1024 * 1024;
constexpr size_t OFF_R = OFF_MISC + (size_t)4 * 1024 * 1024;
constexpr size_t MISC_BAR = OFF_R - 256;
constexpr size_t MISC_ZERO = OFF_R - 512;
static_assert(RWW_GB + 256 * 128 * 2 <= MISC_ZERO, "misc overflow");
constexpr size_t R_YHY = OFF_R, R_YSW = OFF_R + UNIT, R_YDF = OFF_R + 2 * UNIT;
constexpr size_t R_PHY = OFF_R + 3 * UNIT;
constexpr size_t R_PSW = OFF_R + 6 * UNIT;
constexpr size_t R_VTSW = R_PSW + (size_t)MT * 384 * 2;
constexpr size_t R_PDF = OFF_R + 8 * UNIT;
constexpr size_t R_VTDF = OFF_R + 10 * UNIT;
constexpr size_t R_PRW = OFF_R + 11 * UNIT;
constexpr size_t R_STR = R_PRW + (size_t)MT * 1216 * 2;
constexpr size_t R_G = R_STR + 7 * UNIT;
constexpr size_t R_END = R_G + 2 * UNIT;
constexpr size_t R_RAWF = OFF_R;
constexpr size_t R_OF = R_PHY, R_OB = R_PHY + UNIT;
constexpr size_t R_URE = R_PSW;
constexpr size_t R_YRW = R_VTDF;
constexpr size_t R_ACC = R_PRW;
constexpr size_t R_U = R_STR;
constexpr size_t R_HID = OFF_R;
static_assert(R_END <= (size_t)512 * 1024 * 1024, "ws overflow");
static_assert((size_t)MT * 2816 * 2 <= 11 * UNIT, "hid");

constexpr int SMEM_BYTES = 144 * 1024 + 64;

struct Params {
  const float* in[43];
  float* out;
  char* ws;
};

DI int my_tid() { int t = (int)__builtin_amdgcn_workitem_id_x(); asm volatile("" : "+v"(t)); return t; }
DI unsigned f2bf(float f) { unsigned u = __float_as_uint(f); u += 0x7fffu + ((u >> 16) & 1u); return u >> 16; }
DI float bf2f(unsigned h) { return __uint_as_float(h << 16); }
typedef __bf16 bf16v2_t __attribute__((ext_vector_type(2)));
typedef float f32v2_t __attribute__((ext_vector_type(2)));
DI unsigned pack2(float lo, float hi) { f32v2_t v = {lo, hi}; bf16v2_t b = __builtin_convertvector(v, bf16v2_t); return __builtin_bit_cast(unsigned, b); }

DI float bflo(unsigned w) { return __uint_as_float(w << 16); }
DI float bfhi(unsigned w) { return __uint_as_float(w & 0xffff0000u); }
DI float sigmoidf_(float x) { return __builtin_amdgcn_rcpf(1.f + __expf(-x)); }
DI float siluf_(float x) { return x * __builtin_amdgcn_rcpf(1.f + __expf(-x)); }
DI float wave_sum(float v) {
#pragma unroll
  for (int o = 32; o >= 1; o >>= 1) v += __shfl_xor(v, o);
  return v;
}
template <int CTRL> DI float dpp_mov(float v) {
  return __int_as_float(__builtin_amdgcn_update_dpp(0, __float_as_int(v), CTRL, 0xf, 0xf, false));
}
DI float sum16(float v) {
  v += dpp_mov<0xB1>(v);
  v += dpp_mov<0x4E>(v);
  v += dpp_mov<0x141>(v);
  v += dpp_mov<0x140>(v);
  return v;
}
DI void lds_barrier() { asm volatile("s_waitcnt lgkmcnt(0)" ::: "memory"); __builtin_amdgcn_s_barrier(); asm volatile("" ::: "memory"); }
DI uint4 sel4(bool z, uint4 v) { return make_uint4(z ? 0u : v.x, z ? 0u : v.y, z ? 0u : v.z, z ? 0u : v.w); }
DI int mod_idx(int row) { return row < ML ? (row >> 12) : 8; }

template <int NTW, bool DEEP, class RowFn>
DI void gemm_main(f32x4 (&acc)[4][NTW], const bf16_t* __restrict__ A, int lda, RowFn rowfn,
                  const bf16_t* __restrict__ Bt, int ldb, int K, char* smem) {
  constexpr int BN = NTW * 32;
  constexpr int A_BYTES = 256 * 128, B_BYTES = BN * 128, STAGE = A_BYTES + B_BYTES;
  constexpr int NBL = BN / 64;
  const int tid = my_tid(), lane = tid & 63, wid = tid >> 6, wm = wid >> 1, wn = wid & 1, g = lane >> 4, r16 = lane & 15;
  const int chunk = tid & 7, lrow = tid >> 3;
  long a0 = rowfn(lrow), a1 = rowfn(lrow + 64), a2 = rowfn(lrow + 128), a3 = rowfn(lrow + 192);
  const long c0 = a0 < 0 ? 0 : a0, c1 = a1 < 0 ? 0 : a1, c2 = a2 < 0 ? 0 : a2, c3 = a3 < 0 ? 0 : a3;
  const bf16_t* Bp = Bt + (long)lrow * ldb + chunk * 8;
  const bf16_t* Ap0 = A + c0 * lda + chunk * 8; const bf16_t* Ap1 = A + c1 * lda + chunk * 8;
  const bf16_t* Ap2 = A + c2 * lda + chunk * 8; const bf16_t* Ap3 = A + c3 * lda + chunk * 8;
  struct Regs { uint4 a0, a1, a2, a3, b0, b1; };
  Regs R0, R1;
  R0.b1 = make_uint4(0, 0, 0, 0); R1.b1 = make_uint4(0, 0, 0, 0);
  auto GLOAD = [&](Regs& R, int k0) {
    R.a0 = *(const uint4*)(Ap0 + k0); R.a1 = *(const uint4*)(Ap1 + k0);
    R.a2 = *(const uint4*)(Ap2 + k0); R.a3 = *(const uint4*)(Ap3 + k0);
    R.b0 = *(const uint4*)(Bp + k0);
    if constexpr (NBL > 1) R.b1 = *(const uint4*)(Bp + (long)64 * ldb + k0);
  };
  auto SSTORE = [&](const Regs& R, int st) {
    char* base = smem + st * STAGE + lrow * 128 + ((chunk ^ (lrow & 7)) << 4);
    *(uint4*)(base) = sel4(a0 < 0, R.a0); *(uint4*)(base + 64 * 128) = sel4(a1 < 0, R.a1);
    *(uint4*)(base + 128 * 128) = sel4(a2 < 0, R.a2); *(uint4*)(base + 192 * 128) = sel4(a3 < 0, R.a3);
    *(uint4*)(base + A_BYTES) = R.b0;
    if constexpr (NBL > 1) *(uint4*)(base + A_BYTES + 64 * 128) = R.b1;
  };
  auto COMPUTE = [&](int st) {
    const char* As = smem + st * STAGE + (wm * 64 + r16) * 128;
    const char* Bs = smem + st * STAGE + A_BYTES + (wn * (NTW * 16) + r16) * 128;
#pragma unroll
    for (int kk = 0; kk < 2; ++kk) {
      const int sw = ((kk * 4 + g) ^ (r16 & 7)) << 4;
      bf16x8 af[4], bfr[NTW];
#pragma unroll
      for (int mt = 0; mt < 4; ++mt) af[mt] = *(const bf16x8*)(As + mt * 16 * 128 + sw);
#pragma unroll
      for (int nt = 0; nt < NTW; ++nt) bfr[nt] = *(const bf16x8*)(Bs + nt * 16 * 128 + sw);
#pragma unroll
      for (int mt = 0; mt < 4; ++mt)
#pragma unroll
        for (int nt = 0; nt < NTW; ++nt)
          acc[mt][nt] = __builtin_amdgcn_mfma_f32_16x16x32_bf16(af[mt], bfr[nt], acc[mt][nt], 0, 0, 0);
    }
  };
  const int nk = K >> 6;
  __syncthreads();
  GLOAD(R0, 0);
  SSTORE(R0, 0);
  if constexpr (DEEP) {
    GLOAD(R0, 64);
    if (nk > 2) GLOAD(R1, 128);
    lds_barrier();
    bf16x8 fa0[4], fb0[NTW], fa1[4], fb1[NTW];
    auto READF = [&](bf16x8 (&fa)[4], bf16x8 (&fb)[NTW], int st, int kk) {
      const int sw = ((kk * 4 + g) ^ (r16 & 7)) << 4;
      const char* As = smem + st * STAGE + (wm * 64 + r16) * 128 + sw;
      const char* Bs = smem + st * STAGE + A_BYTES + (wn * (NTW * 16) + r16) * 128 + sw;
#pragma unroll
      for (int mt = 0; mt < 4; ++mt) fa[mt] = *(const bf16x8*)(As + mt * 16 * 128);
#pragma unroll
      for (int nt = 0; nt < NTW; ++nt) fb[nt] = *(const bf16x8*)(Bs + nt * 16 * 128);
    };
    auto MMA = [&](const bf16x8 (&fa)[4], const bf16x8 (&fb)[NTW]) {
#pragma unroll
      for (int mt = 0; mt < 4; ++mt)
#pragma unroll
        for (int nt = 0; nt < NTW; ++nt)
          acc[mt][nt] = __builtin_amdgcn_mfma_f32_16x16x32_bf16(fa[mt], fb[nt], acc[mt][nt], 0, 0, 0);
    };
    READF(fa0, fb0, 0, 0);
    for (int kt = 0; kt < nk; kt += 2) {
      READF(fa1, fb1, 0, 1);
      MMA(fa0, fb0);
#pragma unroll
      for (int i = 0; i < 4 + NTW; ++i) { __builtin_amdgcn_sched_group_barrier(0x100, 1, 0); __builtin_amdgcn_sched_group_barrier(0x008, 2, 0); }
      __builtin_amdgcn_sched_barrier(0);
      SSTORE(R0, 1);
      if (kt + 3 < nk) GLOAD(R0, (kt + 3) * 64);
      MMA(fa1, fb1);
#pragma unroll
      for (int i = 0; i < 6; ++i) { __builtin_amdgcn_sched_group_barrier(0x200, 1, 0); __builtin_amdgcn_sched_group_barrier(0x020, 1, 0); __builtin_amdgcn_sched_group_barrier(0x008, 2, 0); }
      __builtin_amdgcn_sched_barrier(0);
      lds_barrier();
      READF(fa0, fb0, 1, 0);
      READF(fa1, fb1, 1, 1);
      MMA(fa0, fb0);
#pragma unroll
      for (int i = 0; i < 4 + NTW; ++i) { __builtin_amdgcn_sched_group_barrier(0x100, 1, 0); __builtin_amdgcn_sched_group_barrier(0x008, 2, 0); }
      __builtin_amdgcn_sched_barrier(0);
      if (kt + 2 < nk) SSTORE(R1, 0);
      if (kt + 4 < nk) GLOAD(R1, (kt + 4) * 64);
      MMA(fa1, fb1);
#pragma unroll
      for (int i = 0; i < 6; ++i) { __builtin_amdgcn_sched_group_barrier(0x200, 1, 0); __builtin_amdgcn_sched_group_barrier(0x020, 1, 0); __builtin_amdgcn_sched_group_barrier(0x008, 2, 0); }
      __builtin_amdgcn_sched_barrier(0);
      lds_barrier();
      if (kt + 2 < nk) READF(fa0, fb0, 0, 0);
    }
  } else {
    lds_barrier();
    for (int kt = 0; kt < nk; ++kt) {
      const int st = kt & 1;
      if (kt + 1 < nk) GLOAD(R0, (kt + 1) * 64);
      __builtin_amdgcn_sched_barrier(0);
      COMPUTE(st);
      __builtin_amdgcn_sched_barrier(0);
      if (kt + 1 < nk) SSTORE(R0, st ^ 1);
      lds_barrier();
    }
  }
}

#define GLDS16(gp, lp) __builtin_amdgcn_global_load_lds((const unsigned*)(gp), (unsigned*)(lp), 16, 0, 0)
template <class RowFn>
DI void gemm_glds(f32x4 (&acc)[4][4], const bf16_t* __restrict__ A, int lda, RowFn rowfn,
                  const bf16_t* __restrict__ Bt, int ldb, int K, char* smem, const bf16_t* zrow) {
  constexpr int A_BYTES = 256 * 128, STAGE = A_BYTES + 128 * 128;
  const int tid = my_tid(), lane = tid & 63, wid = tid >> 6, wm = wid >> 1, wn = wid & 1, g = lane >> 4, r16 = lane & 15;
  const int lrow = tid >> 3, c = (tid & 7) ^ (lrow & 7);
  const long a0 = rowfn(lrow), a1 = rowfn(lrow + 64), a2 = rowfn(lrow + 128), a3 = rowfn(lrow + 192);
  const bf16_t* pa0 = (a0 >= 0 ? A + a0 * lda : zrow) + c * 8; const int m0 = a0 >= 0 ? 1 : 0;
  const bf16_t* pa1 = (a1 >= 0 ? A + a1 * lda : zrow) + c * 8; const int m1 = a1 >= 0 ? 1 : 0;
  const bf16_t* pa2 = (a2 >= 0 ? A + a2 * lda : zrow) + c * 8; const int m2 = a2 >= 0 ? 1 : 0;
  const bf16_t* pa3 = (a3 >= 0 ? A + a3 * lda : zrow) + c * 8; const int m3 = a3 >= 0 ? 1 : 0;
  const bf16_t* pb0 = Bt + (long)lrow * ldb + c * 8; const bf16_t* pb1 = pb0 + (long)64 * ldb;
  auto ISSUE = [&](int kt, int bi) {
    char* d = smem + bi * STAGE + tid * 16;
    const int k0 = kt * 64;
    GLDS16(pa0 + k0 * m0, d); GLDS16(pa1 + k0 * m1, d + 8192); GLDS16(pa2 + k0 * m2, d + 16384); GLDS16(pa3 + k0 * m3, d + 24576);
    GLDS16(pb0 + k0, d + A_BYTES); GLDS16(pb1 + k0, d + A_BYTES + 8192);
  };
  auto COMPUTE = [&](int bi) {
    const char* As = smem + bi * STAGE + (wm * 64 + r16) * 128;
    const char* Bs = smem + bi * STAGE + A_BYTES + (wn * 64 + r16) * 128;
#pragma unroll
    for (int kk = 0; kk < 2; ++kk) {
      const int sw = ((kk * 4 + g) ^ (r16 & 7)) << 4;
      bf16x8 af[4], bfr[4];
#pragma unroll
      for (int mt = 0; mt < 4; ++mt) af[mt] = *(const bf16x8*)(As + mt * 16 * 128 + sw);
#pragma unroll
      for (int nt = 0; nt < 4; ++nt) bfr[nt] = *(const bf16x8*)(Bs + nt * 16 * 128 + sw);
      __builtin_amdgcn_s_setprio(1);
#pragma unroll
      for (int mt = 0; mt < 4; ++mt)
#pragma unroll
        for (int nt = 0; nt < 4; ++nt)
          acc[mt][nt] = __builtin_amdgcn_mfma_f32_16x16x32_bf16(af[mt], bfr[nt], acc[mt][nt], 0, 0, 0);
      __builtin_amdgcn_s_setprio(0);
    }
  };
  const int nk = K >> 6;
  __syncthreads();
  ISSUE(0, 0);
  ISSUE(1, 1);
  asm volatile("s_waitcnt vmcnt(6)" ::: "memory");
  __builtin_amdgcn_s_barrier();
  asm volatile("" ::: "memory");
  int bi = 0;
  for (int kt = 0; kt < nk; ++kt) {
    const int b2 = bi >= 1 ? bi - 1 : 2;
    if (kt + 2 < nk) ISSUE(kt + 2, b2);
    COMPUTE(bi);
    if (kt + 2 < nk) asm volatile("s_waitcnt vmcnt(6)" ::: "memory");
    else asm volatile("s_waitcnt vmcnt(0)" ::: "memory");
    asm volatile("s_waitcnt lgkmcnt(0)" ::: "memory");
    __builtin_amdgcn_s_barrier();
    asm volatile("" ::: "memory");
    bi = bi == 2 ? 0 : bi + 1;
  }
}

DI void gemm_glds256(f32x4 (&acc)[8][4], const bf16_t* __restrict__ A, int lda, long arow0,
                     const bf16_t* __restrict__ Bt, int ldb, int K, char* smem) {
  constexpr int A_BYTES = 256 * 128, STAGE = 2 * A_BYTES;
  const int tid = my_tid(), lane = tid & 63, wid = tid >> 6, wm = wid >> 2, wn = wid & 3, g = lane >> 4, r16 = lane & 15;
  const int lrow = tid >> 3, c = (tid & 7) ^ (lrow & 7);
  const bf16_t* pa = A + (arow0 + lrow) * (long)lda + c * 8;
  const bf16_t* pb = Bt + (long)lrow * ldb + c * 8;
  const long a64 = (long)64 * lda, b64 = (long)64 * ldb;
  auto ISSUE = [&](int kt, int bi) {
    char* d = smem + bi * STAGE + tid * 16;
    const int k0 = kt * 64;
    GLDS16(pa + k0, d); GLDS16(pa + a64 + k0, d + 8192); GLDS16(pa + 2 * a64 + k0, d + 16384); GLDS16(pa + 3 * a64 + k0, d + 24576);
    GLDS16(pb + k0, d + A_BYTES); GLDS16(pb + b64 + k0, d + A_BYTES + 8192); GLDS16(pb + 2 * b64 + k0, d + A_BYTES + 16384); GLDS16(pb + 3 * b64 + k0, d + A_BYTES + 24576);
  };
  auto COMPUTE = [&](int bi) {
    const char* As = smem + bi * STAGE + (wm * 128 + r16) * 128;
    const char* Bs = smem + bi * STAGE + A_BYTES + (wn * 64 + r16) * 128;
#pragma unroll
    for (int kk = 0; kk < 2; ++kk) {
      const int sw = ((kk * 4 + g) ^ (r16 & 7)) << 4;
      bf16x8 bfr[4];
#pragma unroll
      for (int nt = 0; nt < 4; ++nt) bfr[nt] = *(const bf16x8*)(Bs + nt * 16 * 128 + sw);
      __builtin_amdgcn_s_setprio(1);
#pragma unroll
      for (int mt = 0; mt < 8; ++mt) {
        const bf16x8 af = *(const bf16x8*)(As + mt * 16 * 128 + sw);
#pragma unroll
        for (int nt = 0; nt < 4; ++nt)
          acc[mt][nt] = __builtin_amdgcn_mfma_f32_16x16x32_bf16(af, bfr[nt], acc[mt][nt], 0, 0, 0);
      }
      __builtin_amdgcn_s_setprio(0);
    }
  };
  const int nk = K >> 6;
  __syncthreads();
  ISSUE(0, 0);
  asm volatile("s_waitcnt vmcnt(0)" ::: "memory");
  __builtin_amdgcn_s_barrier();
  asm volatile("" ::: "memory");
  int bi = 0;
  for (int kt = 0; kt < nk; ++kt) {
    if (kt + 1 < nk) ISSUE(kt + 1, bi ^ 1);
    COMPUTE(bi);
    asm volatile("s_waitcnt vmcnt(0)" ::: "memory");
    asm volatile("s_waitcnt lgkmcnt(0)" ::: "memory");
    __builtin_amdgcn_s_barrier();
    asm volatile("" ::: "memory");
    bi ^= 1;
  }
}
DI void zero_acc256(f32x4 (&acc)[8][4]) {
#pragma unroll
  for (int i = 0; i < 8; ++i)
#pragma unroll
    for (int j = 0; j < 4; ++j) acc[i][j] = (f32x4){0.f, 0.f, 0.f, 0.f};
}

DI bool next_tile(int i, int MTILES, int NTILES, int& mt, int& nt) {
  const int xcd = blockIdx.x & 7, slot = blockIdx.x >> 3, nslot = gridDim.x >> 3;
  const int m_lo = (MTILES * xcd) >> 3, m_hi = (MTILES * (xcd + 1)) >> 3, Mloc = m_hi - m_lo;
  const int q = i * nslot + slot;
  if (q >= Mloc * NTILES) return false;
  const int gidx = q / (4 * NTILES), m0 = gidx * 4;
  const int rows = (Mloc - m0) < 4 ? (Mloc - m0) : 4;
  const int within = q - gidx * 4 * NTILES;
  nt = within / rows; mt = m_lo + m0 + within % rows;
  return true;
}

struct RowPlain { long base; DI long operator()(int r) const { return base + r; } };
struct RowHalo { long rowbase; int t0; int len; DI long operator()(int r) const { int t = t0 + r; return (t >= 0 && t < len) ? rowbase + t : -1; } };

template <int NTW> DI void zero_acc(f32x4 (&acc)[4][NTW]) {
#pragma unroll
  for (int i = 0; i < 4; ++i)
#pragma unroll
    for (int j = 0; j < NTW; ++j) acc[i][j] = (f32x4){0.f, 0.f, 0.f, 0.f};
}

DI void cvt_unit(const float* __restrict__ src, int ldsrc, int srccol0, int k0, bf16_t* __restrict__ dst, int K, int n0, char* smem, bool perm = true) {
  float* T = (float*)smem;
  const int tid = my_tid();
  __syncthreads();
  if (srccol0 >= 0) {
#pragma unroll
    for (int i = 0; i < 8; ++i) {
      int idx = tid + i * 512; int k = idx >> 6, n = idx & 63;
      T[k * 65 + n] = src[(long)(k0 + k) * ldsrc + srccol0 + n];
    }
  }
  __syncthreads();
  int nd = tid >> 3, kc = (tid & 7) * 8; int n = perm ? ((nd & 15) * 4 + (nd >> 4)) : nd;
  uint4 o = make_uint4(0, 0, 0, 0);
  if (srccol0 >= 0) {
    o.x = pack2(T[(kc + 0) * 65 + n], T[(kc + 1) * 65 + n]);
    o.y = pack2(T[(kc + 2) * 65 + n], T[(kc + 3) * 65 + n]);
    o.z = pack2(T[(kc + 4) * 65 + n], T[(kc + 5) * 65 + n]);
    o.w = pack2(T[(kc + 6) * 65 + n], T[(kc + 7) * 65 + n]);
  }
  *(uint4*)(dst + (long)(n0 + nd) * K + k0 + kc) = o;
}

DI void ph_convert(const Params& p, int l, char* smem) {
  for (int u = blockIdx.x; u < 4508; u += gridDim.x) {
    if (u < 832) {
      int gI = u >> 4, kt = u & 15; int n0 = gI * 64; int sc;
      if (n0 < 1280) sc = n0; else if (n0 < 2048) sc = 2496 + (n0 - 1280); else if (n0 < 3264) sc = 1280 + (n0 - 2048); else sc = -1;
      cvt_unit(p.in[6] + (size_t)l * 1024 * 7360, 7360, sc, kt * 64, (bf16_t*)(p.ws + WB_IN), 1024, n0, smem);
    } else if (u < 1856) {
      int v = u - 832; int gI = v >> 4, kt = v & 15;
      cvt_unit(p.in[6] + (size_t)l * 1024 * 7360, 7360, 3264 + gI * 64, kt * 64, (bf16_t*)(p.ws + WB_GATE), 1024, gI * 64, smem);
    } else if (u < 2112) {
      int v = u - 1856; int gI = v >> 2, kt = v & 3; int j = gI >> 4, gg = gI & 15;
      cvt_unit(p.in[33] + ((size_t)l * 4 + j) * 256 * 1024, 1024, gg * 64, kt * 64, (bf16_t*)(p.ws + WB_BR) + (size_t)j * 1024 * 256, 256, gg * 64, smem);
    } else if (u < 2368) {
      int v = u - 2112; int gI = v >> 4, kt = v & 15;
      cvt_unit(p.in[34] + (size_t)l * 1024 * 1024, 1024, gI * 64, kt * 64, (bf16_t*)(p.ws + WB_OUT), 1024, gI * 64, smem);
    } else if (u < 3776) {
      int v = u - 2368; int gI = v >> 4, kt = v & 15; int nt = gI >> 2, q = gI & 3;
      cvt_unit(p.in[37] + (size_t)l * 1024 * 5632, 5632, (q >> 1) * 2816 + nt * 128 + (q & 1) * 64, kt * 64, (bf16_t*)(p.ws + WB_UP), 1024, gI * 64, smem);
    } else if (u < 4480) {
      int v = u - 3776; int gI = v / 44, kt = v % 44;
      cvt_unit(p.in[40] + (size_t)l * 2816 * 1024, 1024, gI * 64, kt * 64, (bf16_t*)(p.ws + WB_DOWN), 2816, gI * 64, smem);
    } else {
      int v = u - 4480;
      if (v < 4) cvt_unit(p.in[19] + (size_t)l * 2 * 64 * 256, 256, v * 64, 0, (bf16_t*)(p.ws + RWW_F), 64, v * 64, smem);
      else if (v < 8) cvt_unit(p.in[19] + (size_t)l * 2 * 64 * 256 + 64 * 256, 256, (v - 4) * 64, 0, (bf16_t*)(p.ws + RWW_B), 64, (v - 4) * 64, smem);
      else if (v < 12) cvt_unit(p.in[21] + (size_t)l * 64 * 256, 256, (v - 8) * 64, 0, (bf16_t*)(p.ws + RWW_A), 64, (v - 8) * 64, smem);
      else if (v < 20) { int w = v - 12; cvt_unit(p.in[22] + (size_t)l * 2 * 128 * 256, 256, (w >> 1) * 64, (w & 1) * 64, (bf16_t*)(p.ws + RWW_GF), 128, (w >> 1) * 64, smem); }
      else { int w = v - 20; cvt_unit(p.in[22] + (size_t)l * 2 * 128 * 256 + 128 * 256, 256, (w >> 1) * 64, (w & 1) * 64, (bf16_t*)(p.ws + RWW_GB), 128, (w >> 1) * 64, smem); }
    }
  }
}

DI void ph_ada(const Params& p, char* smem) {
  float* S = (float*)smem;
  float* R = S + 9 * 1024;
  const int tid = my_tid();
  bool loaded = false;
  for (int u = blockIdx.x; u < 192; u += gridDim.x) {
    if (!loaded) {
      __syncthreads();
      for (int i = tid; i < 9 * 1024; i += NTHR) { float c = i < 8192 ? p.in[1][i] : p.in[3][i - 8192]; S[i] = siluf_(c); }
      loaded = true;
    }
    __syncthreads();
    int l = u / 96, n0 = (u % 96) * 64;
    int col = tid & 63, ks = tid >> 6;
    const float* W = p.in[4] + (size_t)l * 1024 * 6144 + n0 + col;
    float a[9];
#pragma unroll
    for (int b = 0; b < 9; ++b) a[b] = 0.f;
    for (int k = ks * 128; k < ks * 128 + 128; ++k) {
      float w = W[(size_t)k * 6144];
#pragma unroll
      for (int b = 0; b < 9; ++b) a[b] += S[b * 1024 + k] * w;
    }
#pragma unroll
    for (int b = 0; b < 9; ++b) R[(ks * 9 + b) * 64 + col] = a[b];
    __syncthreads();
    for (int i = tid; i < 9 * 64; i += NTHR) {
      int b = i >> 6, c = i & 63; float s = 0.f;
#pragma unroll
      for (int k2 = 0; k2 < 8; ++k2) s += R[(k2 * 9 + b) * 64 + c];
      s += p.in[5][(size_t)l * 6144 + n0 + c];
      ((float*)(p.ws + MISC_MOD))[((size_t)l * 9 + b) * 6144 + n0 + c] = s;
    }
  }
  for (int i = blockIdx.x * NTHR + tid; i < 4096; i += gridDim.x * NTHR) {
    float s, c; sincospif(-(float)i / 4096.f, &s, &c);
    ((float2*)(p.ws + MISC_TW))[i] = make_float2(c, s);
  }
}

DI void hy_rawfilter(const Params& p, int l, int Lf, float* __restrict__ dst, char* smem) {
  float* W1 = (float*)smem;
  float* W2 = W1 + 33 * 64;
  float* Z = W2 + 64 * 64;
  float* H1 = Z + 16 * 36;
  float* H2 = H1 + 16 * 64;
  const int tid = my_tid();
  const float* w1 = p.in[9] + (size_t)l * 33 * 64; const float* b1 = p.in[10] + l * 64;
  const float* w2 = p.in[11] + (size_t)l * 64 * 64; const float* b2 = p.in[12] + l * 64;
  const float* w3 = p.in[13] + (size_t)l * 64 * 1024; const float* fr = p.in[14] + l * 64;
  const int nunits = Lf / 16;
  bool loaded = false;
  for (int u = blockIdx.x; u < nunits; u += gridDim.x) {
    __syncthreads();
    if (!loaded) {
      for (int i = tid; i < 33 * 64; i += NTHR) W1[i] = w1[i];
      for (int i = tid; i < 64 * 64; i += NTHR) W2[i] = w2[i];
      loaded = true;
    }
    const int t0 = u * 16;
    for (int i = tid; i < 16 * 33; i += NTHR) {
      int tt = i / 33, f = i % 33; int t = t0 + tt; float v;
      if (f == 0) v = (float)t / (float)(Lf - 1);
      else {
        int bi = (f - 1) & 15;
        float wv = 6.283185307179586f * (float)t / (float)Lf;
        float fb = 1e-4f + (15.f - 1e-4f) * (float)bi / 15.f;
        float ang = wv * fb;
        v = (f <= 16) ? cosf(ang) : -sinf(ang);
      }
      Z[tt * 36 + f] = v;
    }
    __syncthreads();
    for (int i = tid; i < 16 * 64; i += NTHR) {
      int tt = i >> 6, f = i & 63; float s = b1[f];
      for (int k = 0; k < 33; ++k) s += Z[tt * 36 + k] * W1[k * 64 + f];
      H1[tt * 64 + f] = sinf(fr[f] * s);
    }
    __syncthreads();
    for (int i = tid; i < 16 * 64; i += NTHR) {
      int tt = i >> 6, f = i & 63; float s = b2[f];
      for (int k = 0; k < 64; ++k) s += H1[tt * 64 + k] * W2[k * 64 + f];
      H2[tt * 64 + f] = sinf(fr[f] * s);
    }
    __syncthreads();
    float a0[16], a1[16];
#pragma unroll
    for (int i = 0; i < 16; ++i) { a0[i] = 0.f; a1[i] = 0.f; }
    for (int k = 0; k < 64; ++k) {
      float wa = w3[k * 1024 + tid], wb = w3[k * 1024 + 512 + tid];
#pragma unroll
      for (int i = 0; i < 16; ++i) { float h = H2[i * 64 + k]; a0[i] += h * wa; a1[i] += h * wb; }
    }
    {
      int w = tid & 255;
      float delta = fabsf(-3.0701134573253944f + (-15.350567286626972f + 3.0701134573253944f) * (float)w / 255.f);
#pragma unroll
      for (int i = 0; i < 16; ++i) {
        float tn = (float)(t0 + i) / (float)(Lf - 1);
        float dec = expf(-tn * delta);
        dst[(size_t)(t0 + i) * 1024 + tid] = a0[i] * dec;
        dst[(size_t)(t0 + i) * 1024 + 512 + tid] = a1[i] * dec;
      }
    }
  }
}

DI float2 cmul(float2 a, float2 b) { return make_float2(a.x * b.x - a.y * b.y, a.x * b.y + a.y * b.x); }
DI float2 cmulc(float2 a, float2 b) { return make_float2(a.x * b.x + a.y * b.y, a.y * b.x - a.x * b.y); }
DI float2 cadd(float2 a, float2 b) { return make_float2(a.x + b.x, a.y + b.y); }
DI float2 csub(float2 a, float2 b) { return make_float2(a.x - b.x, a.y - b.y); }
DI void fft_dif(float2* X, const float2* W) {
  const int tid = my_tid();
  for (int ls = 12; ls >= 2; ls -= 2) {
    const int s = 1 << ls, h = s >> 1;
    __syncthreads();
#pragma unroll
    for (int i = 0; i < 4; ++i) {
      const int bf = tid + i * 512; const int j = bf & (h - 1); const int base = ((bf >> (ls - 1)) << (ls + 1)) + j;
      const float2 x0 = X[base], x1 = X[base + h], x2 = X[base + s], x3 = X[base + s + h];
      const float2 w1 = W[s - 1 + j], w2 = W[h - 1 + j];
      const float2 y0 = cadd(x0, x2), y2 = cmul(csub(x0, x2), w1), y1 = cadd(x1, x3);
      const float2 t = cmul(csub(x1, x3), w1); const float2 y3 = make_float2(t.y, -t.x);
      X[base] = cadd(y0, y1); X[base + h] = cmul(csub(y0, y1), w2);
      X[base + s] = cadd(y2, y3); X[base + s + h] = cmul(csub(y2, y3), w2);
    }
  }
  __syncthreads();
#pragma unroll
  for (int i = 0; i < 4; ++i) {
    const int q = tid + i * 512;
    float4 a = *(float4*)(X + 4 * q), b = *(float4*)(X + 4 * q + 2);
    *(float4*)(X + 4 * q) = make_float4(a.x + a.z, a.y + a.w, a.x - a.z, a.y - a.w);
    *(float4*)(X + 4 * q + 2) = make_float4(b.x + b.z, b.y + b.w, b.x - b.z, b.y - b.w);
  }
  __syncthreads();
}
DI void fft_dit_inv(float2* X, const float2* W) {
  const int tid = my_tid();
  __syncthreads();
#pragma unroll
  for (int i = 0; i < 4; ++i) {
    const int q = tid + i * 512;
    float4 a = *(float4*)(X + 4 * q), b = *(float4*)(X + 4 * q + 2);
    *(float4*)(X + 4 * q) = make_float4(a.x + a.z, a.y + a.w, a.x - a.z, a.y - a.w);
    *(float4*)(X + 4 * q + 2) = make_float4(b.x + b.z, b.y + b.w, b.x - b.z, b.y - b.w);
  }
  for (int ls = 2; ls <= 12; ls += 2) {
    const int s = 1 << ls, h = s >> 1;
    __syncthreads();
#pragma unroll
    for (int i = 0; i < 4; ++i) {
      const int bf = tid + i * 512; const int j = bf & (h - 1); const int base = ((bf >> (ls - 1)) << (ls + 1)) + j;
      const float2 e0 = X[base], e1 = X[base + h], e2 = X[base + s], e3 = X[base + s + h];
      const float2 w1 = W[s - 1 + j], w2 = W[h - 1 + j];
      const float2 t1 = cmulc(e1, w2), t3 = cmulc(e3, w2);
      const float2 u0 = cadd(e0, t1), u1 = csub(e0, t1), u2 = cadd(e2, t3), u3 = csub(e2, t3);
      const float2 a2 = cmulc(u2, w1); const float2 q3 = cmulc(u3, w1); const float2 a3 = make_float2(-q3.y, q3.x);
      X[base] = cadd(u0, a2); X[base + s] = csub(u0, a2);
      X[base + h] = cadd(u1, a3); X[base + s + h] = csub(u1, a3);
    }
  }
  __syncthreads();
}
DI void load_twiddles(const Params& p, float2* W) {
  const float2* tw = (const float2*)(p.ws + MISC_TW);
  for (int i = my_tid(); i < 8191; i += NTHR) {
    const int ls = 31 - __clz(i + 1); const int pos = i + 1 - (1 << ls);
    W[i] = tw[pos << (12 - ls)];
  }
}

DI void ph_kf(const Params& p, int l, char* smem) {
  float2* X = (float2*)smem; float2* W = X + 8192; float* red = (float*)(W + 8192);
  const int tid = my_tid(), lane = tid & 63, wid = tid >> 6;
  const float* rawf = (const float*)(p.ws + R_RAWF);
  float2* kf = (float2*)(p.ws + OFF_KF);
  bool tw = false;
  for (int u = blockIdx.x; u < 256; u += gridDim.x) {
    if (!tw) { load_twiddles(p, W); tw = true; }
    const int o = u >> 7, c = (u & 127) * 2;
    float2 fw[8], bw[8]; float sa = 0.f, sb = 0.f;
#pragma unroll
    for (int i = 0; i < 8; ++i) {
      int t = tid + i * 512;
      fw[i] = *(const float2*)(rawf + (size_t)t * 1024 + o * 512 + c);
      bw[i] = *(const float2*)(rawf + (size_t)t * 1024 + o * 512 + 256 + c);
      sa += fabsf(fw[i].x) + fabsf(bw[i].x); sb += fabsf(fw[i].y) + fabsf(bw[i].y);
    }
    sa = wave_sum(sa); sb = wave_sum(sb);
    __syncthreads();
    if (lane == 0) { red[wid * 2] = sa; red[wid * 2 + 1] = sb; }
    __syncthreads();
    float ta = 0.f, tb = 0.f;
#pragma unroll
    for (int w = 0; w < 8; ++w) { ta += red[w * 2]; tb += red[w * 2 + 1]; }
    const float ia = 1.f / ta, ib = 1.f / tb;
#pragma unroll
    for (int i = 0; i < 8; ++i) {
      int t = tid + i * 512;
      X[t] = make_float2(fw[i].x * ia, fw[i].y * ib);
      if (t >= 1) X[8192 - t] = make_float2(bw[i].x * ia, bw[i].y * ib);
      else X[4096] = make_float2(0.f, 0.f);
    }
    fft_dif(X, W);
    float2* ka = kf + (size_t)(o * 256 + c) * 8192; float2* kb = ka + 8192;
#pragma unroll 4
    for (int i = 0; i < 16; ++i) {
      int pidx = tid + i * 512;
      int k = (int)(__brev((unsigned)pidx) >> 19);
      int k2 = (8192 - k) & 8191;
      int p2 = (int)(__brev((unsigned)k2) >> 19);
      float2 c1 = X[pidx], c2 = X[p2];
      float2 A = make_float2(0.5f * (c1.x + c2.x), 0.5f * (c1.y - c2.y));
      float2 Bv = make_float2(0.5f * (c1.y + c2.y), -0.5f * (c1.x - c2.x));
      ka[pidx] = A; kb[pidx] = Bv;
    }
    __syncthreads();
  }
  if (l == 0) {
    const float* rawc = (const float*)(p.ws + MISC_RAWC);
    float* G = (float*)(p.ws + MISC_GCTX);
    for (int u = blockIdx.x * 8 + wid; u < 512; u += gridDim.x * 8) {
      int o = u >> 8, c = u & 255; float f[4], b[4]; float s = 0.f;
#pragma unroll
      for (int i = 0; i < 4; ++i) {
        int t = lane + i * 64;
        f[i] = rawc[(size_t)t * 1024 + o * 512 + c]; b[i] = rawc[(size_t)t * 1024 + o * 512 + 256 + c];
        s += fabsf(f[i]) + fabsf(b[i]);
      }
      s = wave_sum(s); float inv = 1.f / s;
#pragma unroll
      for (int i = 0; i < 4; ++i) {
        int t = lane + i * 64;
        G[(size_t)u * 512 + 256 + t] = f[i] * inv;
        if (t >= 1) G[(size_t)u * 512 + 256 - t] = b[i] * inv;
      }
      if (lane == 0) G[(size_t)u * 512] = 0.f;
    }
  }
}

DI void ph_ln(const float* __restrict__ src_lat, const float* __restrict__ src_ctx, float* dst_lat, float* dst_ctx,
              const float* __restrict__ ag, const float* __restrict__ ab, bf16_t* U, const float* __restrict__ mod, int sh_off, int nrows) {
  const int lane = my_tid() & 63, wid = my_tid() >> 6;
  const int stride = gridDim.x * 8;
  float4 nv[4];
  {
    const int row = blockIdx.x * 8 + wid;
    if (row < nrows) {
      const float* src = row < ML ? src_lat + (size_t)row * D : src_ctx + (size_t)(row - ML) * D;
#pragma unroll
      for (int i = 0; i < 4; ++i) nv[i] = *(const float4*)(src + i * 256 + lane * 4);
    }
  }
  for (int row = blockIdx.x * 8 + wid; row < nrows; row += stride) {
    float4 v[4];
#pragma unroll
    for (int i = 0; i < 4; ++i) v[i] = nv[i];
    if (row + stride < nrows) {
      const int r2 = row + stride;
      const float* src2 = r2 < ML ? src_lat + (size_t)r2 * D : src_ctx + (size_t)(r2 - ML) * D;
#pragma unroll
      for (int i = 0; i < 4; ++i) nv[i] = *(const float4*)(src2 + i * 256 + lane * 4);
    }
    float s = 0.f;
#pragma unroll
    for (int i = 0; i < 4; ++i) s += v[i].x + v[i].y + v[i].z + v[i].w;
    float mu = wave_sum(s) * (1.f / 1024.f);
    float q = 0.f;
#pragma unroll
    for (int i = 0; i < 4; ++i) { v[i].x -= mu; v[i].y -= mu; v[i].z -= mu; v[i].w -= mu; q += v[i].x * v[i].x + v[i].y * v[i].y + v[i].z * v[i].z + v[i].w * v[i].w; }
    float rs = rsqrtf(wave_sum(q) * (1.f / 1024.f) + 1e-6f);
#pragma unroll
    for (int i = 0; i < 4; ++i) { v[i].x *= rs; v[i].y *= rs; v[i].z *= rs; v[i].w *= rs; }
    if (ag) {
      float* dst = row < ML ? dst_lat + (size_t)row * D : dst_ctx + (size_t)(row - ML) * D;
#pragma unroll
      for (int i = 0; i < 4; ++i) {
        float4 gg = *(const float4*)(ag + i * 256 + lane * 4), bb = *(const float4*)(ab + i * 256 + lane * 4);
        v[i].x = v[i].x * gg.x + bb.x; v[i].y = v[i].y * gg.y + bb.y; v[i].z = v[i].z * gg.z + bb.z; v[i].w = v[i].w * gg.w + bb.w;
        *(float4*)(dst + i * 256 + lane * 4) = v[i];
      }
      if (U) {
        s = 0.f;
#pragma unroll
        for (int i = 0; i < 4; ++i) s += v[i].x + v[i].y + v[i].z + v[i].w;
        mu = wave_sum(s) * (1.f / 1024.f); q = 0.f;
#pragma unroll
        for (int i = 0; i < 4; ++i) { v[i].x -= mu; v[i].y -= mu; v[i].z -= mu; v[i].w -= mu; q += v[i].x * v[i].x + v[i].y * v[i].y + v[i].z * v[i].z + v[i].w * v[i].w; }
        rs = rsqrtf(wave_sum(q) * (1.f / 1024.f) + 1e-6f);
#pragma unroll
        for (int i = 0; i < 4; ++i) { v[i].x *= rs; v[i].y *= rs; v[i].z *= rs; v[i].w *= rs; }
      }
    }
    if (U) {
      const float* m = mod + (size_t)mod_idx(row) * 6144 + sh_off;
#pragma unroll
      for (int i = 0; i < 4; ++i) {
        float4 sh = *(const float4*)(m + i * 256 + lane * 4), sc = *(const float4*)(m + 1024 + i * 256 + lane * 4);
        uint2 o; o.x = pack2(v[i].x * (1.f + sc.x) + sh.x, v[i].y * (1.f + sc.y) + sh.y);
        o.y = pack2(v[i].z * (1.f + sc.z) + sh.z, v[i].w * (1.f + sc.w) + sh.w);
        *(uint2*)(U + (size_t)row * D + i * 256 + lane * 4) = o;
      }
    }
  }
}

DI void ph_inproj(const Params& p, const bf16_t* U, char* smem) {
  const bf16_t* Bt = (const bf16_t*)(p.ws + WB_IN);
  const int lane = my_tid() & 63, wid = my_tid() >> 6, wm = wid >> 2, wn = wid & 3, g = lane >> 4, r16 = lane & 15;
  for (int it = 0;; ++it) {
    int mtile, ntile;
    if (!next_tile(it, 136, 13, mtile, ntile)) break;
    f32x4 acc[8][4]; zero_acc256(acc);
    gemm_glds256(acc, U, 1024, (long)mtile * 256, Bt + (size_t)ntile * 256 * 1024, 1024, 1024, smem);
    int b, key0;
    if (mtile < 128) { b = mtile >> 4; key0 = (mtile & 15) * 256; } else { b = mtile - 128; key0 = SL; }
    const int wc0 = ntile * 256 + wn * 64;
    bf16_t* tbase = nullptr; int tcols = 0, tcol0 = 0;
    if (wc0 < 768) { tbase = (bf16_t*)(p.ws + R_PHY); tcols = 768; tcol0 = wc0; }
    else if (wc0 >= 1152 && wc0 < 1280) { tbase = (bf16_t*)(p.ws + R_VTSW); tcols = 128; tcol0 = wc0 - 1152; }
    else if (wc0 >= 1792 && wc0 < 2048) { tbase = (bf16_t*)(p.ws + R_VTDF); tcols = 256; tcol0 = wc0 - 1792; }
    if (tbase) {
#pragma unroll
      for (int mt = 0; mt < 8; ++mt)
#pragma unroll
        for (int nt = 0; nt < 4; ++nt) {
          int col = tcol0 + r16 * 4 + nt;
          int key = key0 + wm * 128 + mt * 16 + g * 4;
          uint2 o; o.x = pack2(acc[mt][nt][0], acc[mt][nt][1]); o.y = pack2(acc[mt][nt][2], acc[mt][nt][3]);
          *(uint2*)(tbase + ((size_t)b * tcols + col) * KEYS + key) = o;
        }
    } else if (wc0 < 3264) {
      bf16_t* rb; int ld, c0;
      if (wc0 < 1152) { rb = (bf16_t*)(p.ws + R_PSW); ld = 384; c0 = wc0 - 768; }
      else if (wc0 < 1792) { rb = (bf16_t*)(p.ws + R_PDF); ld = 512; c0 = wc0 - 1280; }
      else { rb = (bf16_t*)(p.ws + R_PRW); ld = 1216; c0 = wc0 - 2048; }
      const int col = c0 + r16 * 4;
#pragma unroll
      for (int mt = 0; mt < 8; ++mt)
#pragma unroll
        for (int j = 0; j < 4; ++j) {
          size_t row = (size_t)mtile * 256 + wm * 128 + mt * 16 + g * 4 + j;
          uint2 o; o.x = pack2(acc[mt][0][j], acc[mt][1][j]); o.y = pack2(acc[mt][2][j], acc[mt][3][j]);
          *(uint2*)(rb + row * ld + col) = o;
        }
    }
  }
}

DI float hy_conv3(const bf16_t* __restrict__ P, int t, int len, float w0, float w1, float w2, float bias) {
  float a = t >= 1 ? bf2f(P[t - 1]) : 0.f, b = bf2f(P[t]), c = (t + 1 < len) ? bf2f(P[t + 1]) : 0.f;
  return w0 * a + w1 * b + w2 * c + bias;
}
DI void ph_hyena(const Params& p, int l, char* smem) {
  float2* X = (float2*)smem; float2* W = X + 8192;
  const int tid = my_tid();
  const bf16_t* PT = (const bf16_t*)(p.ws + R_PHY);
  const float2* kf = (const float2*)(p.ws + OFF_KF);
  const float* cw = p.in[7] + (size_t)l * 3 * 768; const float* cb = p.in[8] + (size_t)l * 768;
  const float* hb = p.in[15] + (size_t)l * 512;
  bf16_t* Y = (bf16_t*)(p.ws + R_YHY);
  bool tw = false;
  for (int u = blockIdx.x; u < 1024; u += gridDim.x) {
    if (!tw) { load_twiddles(p, W); tw = true; }
    const int bp = u >> 8, c = u & 255; const int b0 = bp * 2, b1 = b0 + 1;
    const bf16_t* P0 = PT + ((size_t)b0 * 768) * KEYS; const bf16_t* P1 = PT + ((size_t)b1 * 768) * KEYS;
    float wv0 = cw[c], wv1 = cw[768 + c], wv2 = cw[1536 + c], bv = cb[c];
    float wa0 = cw[256 + c], wa1 = cw[768 + 256 + c], wa2 = cw[1536 + 256 + c], ba = cb[256 + c];
    float wb0 = cw[512 + c], wb1 = cw[768 + 512 + c], wb2 = cw[1536 + 512 + c], bb = cb[512 + c];
    const float bias0 = hb[c], bias1 = hb[256 + c];
    float2 vv[8];
    __syncthreads();
#pragma unroll
    for (int i = 0; i < 8; ++i) {
      int t = tid + i * 512;
      vv[i].x = hy_conv3(P0 + (size_t)c * KEYS, t, SL, wv0, wv1, wv2, bv);
      vv[i].y = hy_conv3(P1 + (size_t)c * KEYS, t, SL, wv0, wv1, wv2, bv);
      X[t] = vv[i]; X[t + 4096] = make_float2(0.f, 0.f);
    }
    fft_dif(X, W);
    {
      const float2* H = kf + (size_t)c * 8192;
#pragma unroll 4
      for (int i = 0; i < 16; ++i) { int q = tid + i * 512; X[q] = cmul(X[q], H[q]); }
    }
    fft_dit_inv(X, W);
    float2 zz[8];
#pragma unroll
    for (int i = 0; i < 8; ++i) {
      int t = tid + i * 512;
      float2 y = X[t];
      float x1a = hy_conv3(P0 + (size_t)(256 + c) * KEYS, t, SL, wa0, wa1, wa2, ba);
      float x1b = hy_conv3(P1 + (size_t)(256 + c) * KEYS, t, SL, wa0, wa1, wa2, ba);
      zz[i].x = x1a * (y.x * (1.f / 8192.f) + bias0 * vv[i].x);
      zz[i].y = x1b * (y.y * (1.f / 8192.f) + bias0 * vv[i].y);
    }
    __syncthreads();
#pragma unroll
    for (int i = 0; i < 8; ++i) { int t = tid + i * 512; X[t] = zz[i]; X[t + 4096] = make_float2(0.f, 0.f); }
    fft_dif(X, W);
    {
      const float2* H = kf + (size_t)(256 + c) * 8192;
#pragma unroll 4
      for (int i = 0; i < 16; ++i) { int q = tid + i * 512; X[q] = cmul(X[q], H[q]); }
    }
    fft_dit_inv(X, W);
#pragma unroll
    for (int i = 0; i < 8; ++i) {
      int t = tid + i * 512;
      float2 y = X[t];
      float x2a = hy_conv3(P0 + (size_t)(512 + c) * KEYS, t, SL, wb0, wb1, wb2, bb);
      float x2b = hy_conv3(P1 + (size_t)(512 + c) * KEYS, t, SL, wb0, wb1, wb2, bb);
      float oa = x2a * (y.x * (1.f / 8192.f) + bias1 * zz[i].x);
      float ob = x2b * (y.y * (1.f / 8192.f) + bias1 * zz[i].y);
      Y[((size_t)b0 * SL + t) * 256 + c] = (bf16_t)f2bf(oa);
      Y[((size_t)b1 * SL + t) * 256 + c] = (bf16_t)f2bf(ob);
    }
  }
}

DI void ph_hyena_ctx(const Params& p, int l, char* smem) {
  const int tid = my_tid(), lane = tid & 63, wid = tid >> 6;
  float* Zb = (float*)smem + wid * 1024;
  float* Gb = Zb + 256;
  const bf16_t* PT = (const bf16_t*)(p.ws + R_PHY);
  const float* G = (const float*)(p.ws + MISC_GCTX);
  const float* cw = p.in[7] + (size_t)l * 3 * 768; const float* cb = p.in[8] + (size_t)l * 768;
  const float* hb = p.in[15] + (size_t)l * 512;
  bf16_t* Y = (bf16_t*)(p.ws + R_YHY);
  for (int base = blockIdx.x * 8; base < 2048; base += gridDim.x * 8) {
    const int u = base + wid; const int b = u >> 8, c = u & 255;
    const bf16_t* Pb = PT + ((size_t)b * 768) * KEYS + SL;
    float v[4], x1[4], x2[4], zz[4];
#pragma unroll
    for (int i = 0; i < 4; ++i) {
      int t = lane + i * 64;
      v[i] = hy_conv3(Pb + (size_t)c * KEYS, t, CL, cw[c], cw[768 + c], cw[1536 + c], cb[c]);
      x1[i] = hy_conv3(Pb + (size_t)(256 + c) * KEYS, t, CL, cw[256 + c], cw[768 + 256 + c], cw[1536 + 256 + c], cb[256 + c]);
      x2[i] = hy_conv3(Pb + (size_t)(512 + c) * KEYS, t, CL, cw[512 + c], cw[768 + 512 + c], cw[1536 + 512 + c], cb[512 + c]);
    }
    __syncthreads();
#pragma unroll
    for (int i = 0; i < 4; ++i) Zb[lane + i * 64] = v[i];
    for (int i = lane; i < 512; i += 64) Gb[i] = G[(size_t)c * 512 + i];
    __syncthreads();
#pragma unroll
    for (int i = 0; i < 4; ++i) {
      int t = lane + i * 64; float s = 0.f;
      for (int s2 = 0; s2 < 256; ++s2) s += Gb[256 + t - s2] * Zb[s2];
      zz[i] = x1[i] * (s + hb[c] * v[i]);
    }
    __syncthreads();
#pragma unroll
    for (int i = 0; i < 4; ++i) Zb[lane + i * 64] = zz[i];
    for (int i = lane; i < 512; i += 64) Gb[i] = G[(size_t)(256 + c) * 512 + i];
    __syncthreads();
#pragma unroll
    for (int i = 0; i < 4; ++i) {
      int t = lane + i * 64; float s = 0.f;
      for (int s2 = 0; s2 < 256; ++s2) s += Gb[256 + t - s2] * Zb[s2];
      float o = x2[i] * (s + hb[256 + c] * zz[i]);
      Y[((size_t)ML + b * CL + t) * 256 + c] = (bf16_t)f2bf(o);
    }
  }
}

DI void ph_rope(const Params& p, char* smem) {
  float2* T16 = (float2*)smem;
  float2* T8 = T16 + 64 * 16;
  const int tid = my_tid(), lane = tid & 63, wid = tid >> 6;
  __syncthreads();
  for (int i = tid; i < 64 * 16; i += NTHR) {
    int pos = i >> 4, f = i & 15; float inv = powf(10000.f, -(float)f / 16.f); float s, c; sincosf((float)pos * inv, &s, &c);
    T16[i] = make_float2(c, s);
  }
  for (int i = tid; i < 64 * 8; i += NTHR) {
    int pos = i >> 3, f = i & 7; float inv = powf(10000.f, -(float)f / 8.f); float s, c; sincosf((float)pos * inv, &s, &c);
    T8[i] = make_float2(c, s);
  }
  __syncthreads();
  bf16_t* Psw = (bf16_t*)(p.ws + R_PSW); bf16_t* Pdf = (bf16_t*)(p.ws + R_PDF);
  for (int row = blockIdx.x * 8 + wid; row < ML; row += gridDim.x * 8) {
    const int t = row & (SL - 1); const int pr = t >> 6, pc = t & 63;
    bf16_t* q = Psw + (size_t)row * 384;
#pragma unroll
    for (int i = 0; i < 3; ++i) {
      int pi = lane + i * 64; int hd = pi >> 5, pp = pi & 31; int half = pp >> 4, f = pp & 15;
      int base = hd * 64 + half * 32; float2 cs = T16[(half ? pc : pr) * 16 + f];
      float x1 = bf2f(q[base + f]), x2 = bf2f(q[base + 16 + f]);
      q[base + f] = (bf16_t)f2bf(x1 * cs.x - x2 * cs.y); q[base + 16 + f] = (bf16_t)f2bf(x1 * cs.y + x2 * cs.x);
    }
    bf16_t* d = Pdf + (size_t)row * 512;
#pragma unroll
    for (int i = 0; i < 4; ++i) {
      int pi = lane + i * 64; int gi = pi >> 4, pp = pi & 15; int half = pp >> 3, f = pp & 7;
      int base = gi * 32 + half * 16; float2 cs = T8[(half ? pc : pr) * 8 + f];
      float x1 = bf2f(d[base + f]), x2 = bf2f(d[base + 8 + f]);
      d[base + f] = (bf16_t)f2bf(x1 * cs.x - x2 * cs.y); d[base + 8 + f] = (bf16_t)f2bf(x1 * cs.y + x2 * cs.x);
    }
  }
}

DI float rw_shift(const bf16_t* __restrict__ P, int row, int t, int len, int col, float mu) {
  float c = bf2f(P[(size_t)row * 1216 + col]);
  float a = t >= 1 ? bf2f(P[(size_t)(row - 1) * 1216 + col]) : 0.f;
  float b = t + 1 < len ? bf2f(P[(size_t)(row + 1) * 1216 + col]) : 0.f;
  return c + (0.5f * (a + b) - c) * mu;
}
DI void ph_rwprep(const Params& p, int l, char* smem) {
  constexpr int AST = 912, RST = 1552, ROFF = 32 * AST;
  const int tid = my_tid(), lane = tid & 63, wid = tid >> 6, g = lane >> 4, r16 = lane & 15;
  const int tg = wid >> 2, hd = wid & 3;
  const bf16_t* P = (const bf16_t*)(p.ws + R_PRW);
  const float* mu = p.in[17] + (size_t)l * 1216;
  const float* w0 = p.in[18] + (size_t)l * 512; const float* a0 = p.in[20] + (size_t)l * 256;
  const float* kkw = p.in[23] + (size_t)l * 256; const float* kaw = p.in[24] + (size_t)l * 256;
  bf16_t* S = (bf16_t*)(p.ws + R_STR); bf16_t* Gs = (bf16_t*)(p.ws + R_G);
  const size_t SU = (size_t)MT * 256;
  float w0f[4], w0b[4], a0c[4], kkc[4], kac[4];
#pragma unroll
  for (int nt = 0; nt < 4; ++nt) { int c = hd * 64 + r16 * 4 + nt; w0f[nt] = w0[c]; w0b[nt] = w0[256 + c]; a0c[nt] = a0[c]; kkc[nt] = kkw[c]; kac[nt] = kaw[c]; }
  for (int u = blockIdx.x; u < MT / 32; u += gridDim.x) {
    const int row0 = u * 32; int t0, len;
    if (row0 < ML) { t0 = row0 & (SL - 1); len = SL; } else { t0 = (row0 - ML) & (CL - 1); len = CL; }
    __syncthreads();
    for (int item = tid; item < 32 * 152; item += NTHR) {
      const int tk = item / 152, c8 = item - tk * 152; const int row = row0 + tk, t = t0 + tk;
      const uint4 uc = *(const uint4*)(P + (size_t)row * 1216 + c8 * 8);
      uint4 ua = make_uint4(0, 0, 0, 0), ub = make_uint4(0, 0, 0, 0);
      if (t >= 1) ua = *(const uint4*)(P + (size_t)(row - 1) * 1216 + c8 * 8);
      if (t + 1 < len) ub = *(const uint4*)(P + (size_t)(row + 1) * 1216 + c8 * 8);
      const float4 m0 = *(const float4*)(mu + c8 * 8), m1 = *(const float4*)(mu + c8 * 8 + 4);
      float o[8];
      {
        const unsigned wc[4] = {uc.x, uc.y, uc.z, uc.w}, wa[4] = {ua.x, ua.y, ua.z, ua.w}, wb[4] = {ub.x, ub.y, ub.z, ub.w};
        const float mm[8] = {m0.x, m0.y, m0.z, m0.w, m1.x, m1.y, m1.z, m1.w};
#pragma unroll
        for (int i = 0; i < 4; ++i) {
          float c_lo = bflo(wc[i]), c_hi = bfhi(wc[i]);
          o[2 * i] = c_lo + (0.5f * (bflo(wa[i]) + bflo(wb[i])) - c_lo) * mm[2 * i];
          o[2 * i + 1] = c_hi + (0.5f * (bfhi(wa[i]) + bfhi(wb[i])) - c_hi) * mm[2 * i + 1];
        }
      }
      char* dst;
      if (c8 < 96) dst = smem + ROFF + tk * RST + c8 * 16;
      else {
        const int cc = c8 * 8 - 768;
        if (cc < 128) {
#pragma unroll
          for (int i = 0; i < 8; ++i) o[i] = 1.f - 2.f * __builtin_amdgcn_rcpf(1.f + __expf(2.f * o[i]));
        } else if (cc >= 192) {
#pragma unroll
          for (int i = 0; i < 8; ++i) o[i] = sigmoidf_(o[i]);
        }
        dst = smem + tk * AST + cc * 2;
      }
      uint4 ov; ov.x = pack2(o[0], o[1]); ov.y = pack2(o[2], o[3]); ov.z = pack2(o[4], o[5]); ov.w = pack2(o[6], o[7]);
      *(uint4*)dst = ov;
    }
    __syncthreads();
    f32x4 acc[5][4];
#pragma unroll
    for (int o5 = 0; o5 < 5; ++o5)
#pragma unroll
      for (int nt = 0; nt < 4; ++nt) acc[o5][nt] = (f32x4){0.f, 0.f, 0.f, 0.f};
    const char* Arow = smem + (tg * 16 + r16) * AST + g * 16;
#pragma unroll
    for (int o5 = 0; o5 < 5; ++o5) {
      const int kbase = o5 < 3 ? o5 * 64 : (o5 == 3 ? 192 : 320);
      const int KK = o5 < 3 ? 64 : 128;
      const bf16_t* Wt = (const bf16_t*)(p.ws + (o5 == 0 ? RWW_F : o5 == 1 ? RWW_B : o5 == 2 ? RWW_A : o5 == 3 ? RWW_GF : RWW_GB));
#pragma unroll
      for (int ks = 0; ks < KK / 32; ++ks) {
        const bf16x8 af = *(const bf16x8*)(Arow + (kbase + ks * 32) * 2);
#pragma unroll
        for (int nt = 0; nt < 4; ++nt) {
          const bf16x8 bf = *(const bf16x8*)(Wt + (size_t)(hd * 64 + nt * 16 + r16) * KK + ks * 32 + g * 8);
          acc[o5][nt] = __builtin_amdgcn_mfma_f32_16x16x32_bf16(af, bf, acc[o5][nt], 0, 0, 0);
        }
        if (ks & 1) asm volatile("" ::: "memory");
      }
    }
#pragma unroll
    for (int j = 0; j < 4; ++j) {
      const int tk = tg * 16 + g * 4 + j; const size_t row = (size_t)row0 + tk;
      const char* rk = smem + ROFF + tk * RST;
      const int c0 = hd * 64 + r16 * 4;
      const uint2 ur = *(const uint2*)(rk + c0 * 2), uk = *(const uint2*)(rk + (256 + c0) * 2), uv = *(const uint2*)(rk + (512 + c0) * 2);
      const float rv[4] = {bflo(ur.x), bfhi(ur.x), bflo(ur.y), bfhi(ur.y)};
      const float kv[4] = {bflo(uk.x), bfhi(uk.x), bflo(uk.y), bfhi(uk.y)};
      const float vv[4] = {bflo(uv.x), bfhi(uv.x), bflo(uv.y), bfhi(uv.y)};
      float n2 = 0.f;
#pragma unroll
      for (int nt = 0; nt < 4; ++nt) { float q = kv[nt] * kkc[nt]; n2 += q * q; }
      n2 = sum16(n2);
      const float inv = __builtin_amdgcn_rsqf(fmaxf(n2, 1e-24f));
      float o_kp[4], o_kk[4], o_b[4], o_df[4], o_db[4];
#pragma unroll
      for (int nt = 0; nt < 4; ++nt) {
        const float k = kv[nt];
        const float a = sigmoidf_(a0c[nt] + acc[2][nt][j]);
        const float kk = k * kkc[nt] * inv;
        o_kp[nt] = k * (1.f + (a - 1.f) * kac[nt]);
        o_kk[nt] = kk; o_b[nt] = kk * a;
        const float xf = -(w0f[nt] + acc[0][nt][j]); const float spf = fmaxf(xf, 0.f) + __logf(1.f + __expf(-fabsf(xf)));
        const float xb = -(w0b[nt] + acc[1][nt][j]); const float spb = fmaxf(xb, 0.f) + __logf(1.f + __expf(-fabsf(xb)));
        const float ef = __expf(-spf - 0.5f), eb = __expf(-spb - 0.5f);
        o_df[nt] = 1.f - __expf(-ef); o_db[nt] = 1.f - __expf(-eb);
      }
      const size_t o = row * 256 + c0;
      uint2 w;
      w.x = pack2(rv[0], rv[1]); w.y = pack2(rv[2], rv[3]); *(uint2*)(S + o) = w;
      w.x = pack2(o_kp[0], o_kp[1]); w.y = pack2(o_kp[2], o_kp[3]); *(uint2*)(S + SU + o) = w;
      w.x = pack2(vv[0], vv[1]); w.y = pack2(vv[2], vv[3]); *(uint2*)(S + 2 * SU + o) = w;
      w.x = pack2(o_kk[0], o_kk[1]); w.y = pack2(o_kk[2], o_kk[3]); *(uint2*)(S + 3 * SU + o) = w;
      w.x = pack2(o_b[0], o_b[1]); w.y = pack2(o_b[2], o_b[3]); *(uint2*)(S + 4 * SU + o) = w;
      w.x = pack2(o_df[0], o_df[1]); w.y = pack2(o_df[2], o_df[3]); *(uint2*)(S + 5 * SU + o) = w;
      w.x = pack2(o_db[0], o_db[1]); w.y = pack2(o_db[2], o_db[3]); *(uint2*)(S + 6 * SU + o) = w;
      w.x = pack2(acc[3][0][j], acc[3][1][j]); w.y = pack2(acc[3][2][j], acc[3][3][j]); *(uint2*)(Gs + o) = w;
      w.x = pack2(acc[4][0][j], acc[4][1][j]); w.y = pack2(acc[4][2][j], acc[4][3][j]); *(uint2*)(Gs + SU + o) = w;
    }
  }
}

DI long scan_row(int b, int dir, int s) {
  if (s < CL) return (long)ML + b * CL + (dir ? (CL - 1 - s) : s);
  int t = s - CL; return (long)b * SL + (dir ? (SL - 1 - t) : t);
}
DI float sum8(float v) {
  v += dpp_mov<0xB1>(v);
  v += dpp_mov<0x4E>(v);
  v += dpp_mov<0x141>(v);
  return v;
}
DI void ph_scan(const Params& p, char* smem) {
  const int tid = my_tid(), lane = tid & 63, wid = tid >> 6;
  const bf16_t* S = (const bf16_t*)(p.ws + R_STR);
  const size_t SU = (size_t)MT * 256;
  constexpr int T = 32, NSTEP = CL + SL, NCH = NSTEP / T;
  typedef float f32x2 __attribute__((ext_vector_type(2)));
  for (int u = blockIdx.x; u < 128; u += gridDim.x) {
    const int chain = u >> 1, rg = u & 1; const int dir = chain & 1, bh = chain >> 1, b = bh >> 2, h = bh & 3;
    bf16_t* O = (bf16_t*)(p.ws + (dir ? R_OB : R_OF));
    uint4 q0, q1, q2;
    auto SC_GLOAD = [&](int ci) {
#pragma unroll
      for (int j = 0; j < 3; ++j) {
        int idx = tid + j * 512; int st = idx >> 8, s = (idx & 255) >> 3, ck = idx & 7;
        long row = scan_row(b, dir, ci * T + s);
        int sid = st < 5 ? st : 5 + dir;
        uint4 v = *(const uint4*)(S + sid * SU + row * 256 + h * 64 + ck * 8);
        if (j == 0) q0 = v; else if (j == 1) q1 = v; else q2 = v;
      }
    };
    auto SC_SSTORE = [&](int buf) {
#pragma unroll
      for (int j = 0; j < 3; ++j) {
        int idx = tid + j * 512; int st = idx >> 8;
        uint4 v = j == 0 ? q0 : (j == 1 ? q1 : q2);
        float4 lo = make_float4(bflo(v.x), bfhi(v.x), bflo(v.y), bfhi(v.y));
        float4 hi = make_float4(bflo(v.z), bfhi(v.z), bflo(v.w), bfhi(v.w));
        if (st == 5) { lo.x = 1.f - lo.x; lo.y = 1.f - lo.y; lo.z = 1.f - lo.z; lo.w = 1.f - lo.w; hi.x = 1.f - hi.x; hi.y = 1.f - hi.y; hi.z = 1.f - hi.z; hi.w = 1.f - hi.w; }
        char* base = smem + buf * 49152 + idx * 32;
        *(float4*)(base) = lo; *(float4*)(base + 16) = hi;
      }
    };
    auto FLUSH = [&](int ci) {
      const int s = tid >> 4, part = tid & 15;
      const float2 v = *(const float2*)(smem + 98304 + (ci & 1) * 4096 + s * 128 + part * 8);
      long row = scan_row(b, dir, ci * T + s);
      *(unsigned*)(O + row * 256 + h * 64 + rg * 32 + part * 2) = pack2(v.x, v.y);
    };
    __syncthreads();
    SC_GLOAD(0);
    SC_SSTORE(0);
    __syncthreads();
    f32x2 st0 = {0.f, 0.f}, st1 = {0.f, 0.f}, st2 = {0.f, 0.f}, st3 = {0.f, 0.f};
    const int rsub = lane >> 3, ks = lane & 7;
    const int lrow = (wid & 3) * 8 + rsub;
    const int vrow = rg * 32 + lrow;
    struct Step { f32x2 r[4], k[4], kk[4], b[4], w[4]; float v; };
    auto LOADSTEP = [&](Step& x, const char* B, int s) {
#pragma unroll
      for (int hh = 0; hh < 2; ++hh) {
        const float4 r = *(const float4*)(B + (0 * T + s) * 256 + ks * 32 + hh * 16);
        const float4 k = *(const float4*)(B + (1 * T + s) * 256 + ks * 32 + hh * 16);
        const float4 kk = *(const float4*)(B + (3 * T + s) * 256 + ks * 32 + hh * 16);
        const float4 bb = *(const float4*)(B + (4 * T + s) * 256 + ks * 32 + hh * 16);
        const float4 w = *(const float4*)(B + (5 * T + s) * 256 + ks * 32 + hh * 16);
        x.r[2 * hh] = (f32x2){r.x, r.y}; x.r[2 * hh + 1] = (f32x2){r.z, r.w};
        x.k[2 * hh] = (f32x2){k.x, k.y}; x.k[2 * hh + 1] = (f32x2){k.z, k.w};
        x.kk[2 * hh] = (f32x2){kk.x, kk.y}; x.kk[2 * hh + 1] = (f32x2){kk.z, kk.w};
        x.b[2 * hh] = (f32x2){bb.x, bb.y}; x.b[2 * hh + 1] = (f32x2){bb.z, bb.w};
        x.w[2 * hh] = (f32x2){w.x, w.y}; x.w[2 * hh + 1] = (f32x2){w.z, w.w};
      }
      x.v = *(const float*)(B + (2 * T + s) * 256 + vrow * 4);
    };
    for (int ci = 0; ci < NCH; ++ci) {
      if (ci + 1 < NCH) { SC_GLOAD(ci + 1); }
      if (ci > 0) FLUSH(ci - 1);
      if (wid < 4) {
        const char* B = smem + (ci & 1) * 49152;
        float* ob = (float*)(smem + 98304 + (ci & 1) * 4096);
        Step nx; LOADSTEP(nx, B, 0);
#pragma unroll 2
        for (int s = 0; s < T; ++s) {
          const Step c = nx;
          LOADSTEP(nx, B, s + 1);
          f32x2 pa = st0 * c.kk[0] + st1 * c.kk[1];
          f32x2 pb = st2 * c.kk[2] + st3 * c.kk[3];
          pa = pa + pb;
          float sa = -(pa.x + pa.y);
          sa = sum8(sa);
          const f32x2 sa2 = {sa, sa}; const f32x2 v2 = {c.v, c.v};
          st0 = st0 * c.w[0] + sa2 * c.b[0] + v2 * c.k[0];
          st1 = st1 * c.w[1] + sa2 * c.b[1] + v2 * c.k[1];
          st2 = st2 * c.w[2] + sa2 * c.b[2] + v2 * c.k[2];
          st3 = st3 * c.w[3] + sa2 * c.b[3] + v2 * c.k[3];
          f32x2 oa = st0 * c.r[0] + st1 * c.r[1];
          f32x2 ob2 = st2 * c.r[2] + st3 * c.r[3];
          oa = oa + ob2;
          float o = sum8(oa.x + oa.y);
          if (ks == 0) ob[s * 32 + lrow] = o;
        }
      }
      if (ci + 1 < NCH) { SC_SSTORE((ci + 1) & 1); }
      __syncthreads();
    }
    FLUSH(NCH - 1);
  }
}

template <bool DIFF>
DI void attn_unit(const Params& p, int l, int b, int h, int qrow0, int qpos0, int kb_lo, int kb_hi, int kc_lo, char* smem) {
  const int tid = my_tid(), lane = tid & 63, wid = tid >> 6, g = lane >> 4, r16 = lane & 15;
  const bf16_t* QK = (const bf16_t*)(p.ws + (DIFF ? R_PDF : R_PSW));
  const int ldq = DIFF ? 512 : 384;
  const int qc0 = h * 64;
  const int kc0 = 256 + (DIFF ? h * 64 : (h >> 1) * 64);
  const bf16_t* VT = DIFF ? (const bf16_t*)(p.ws + R_VTDF) + ((size_t)b * 256 + h * 64) * KEYS
                          : (const bf16_t*)(p.ws + R_VTSW) + ((size_t)b * 128 + (h >> 1) * 64) * KEYS;
  const int nblk = (kb_hi - kb_lo) + (68 - kc_lo);
  const float sc = (DIFF ? 0.17677669529663687f : 0.125f) * 1.4426950408889634f;
  bf16x8 qf[2];
  {
    const bf16_t* qp = QK + (size_t)(qrow0 + wid * 16 + r16) * ldq + qc0 + g * 8;
    qf[0] = *(const bf16x8*)(qp); qf[1] = *(const bf16x8*)(qp + 32);
  }
  constexpr int NC = DIFF ? 2 : 1;
  float m[NC], lsum[NC];
  f32x4 O[NC][4];
#pragma unroll
  for (int c = 0; c < NC; ++c) {
    if (DIFF) { m[c] = -1e30f; lsum[c] = 0.f; }
    else { m[c] = p.in[16][l * 4 + h] * 1.4426950408889634f; lsum[c] = (g == 0) ? 1.f : 0.f; }
#pragma unroll
    for (int dt = 0; dt < 4; ++dt) O[c][dt] = (f32x4){0.f, 0.f, 0.f, 0.f};
  }
  const int lr = tid >> 3, lc = tid & 7;
  uint4 rkA, rvA, rkB, rvB;
  rkA = make_uint4(0, 0, 0, 0); rvA = rkA; rkB = rkA; rvB = rkA;
  auto AT_GLOAD = [&](int i, uint4& rk, uint4& rv) {
    int kb = i < (kb_hi - kb_lo) ? kb_lo + i : kc_lo + (i - (kb_hi - kb_lo));
    long krow = kb < 64 ? (long)b * SL + kb * 64 + lr : (long)ML + b * CL + (kb - 64) * 64 + lr;
    rk = *(const uint4*)(QK + krow * ldq + kc0 + lc * 8);
    rv = *(const uint4*)(VT + (size_t)lr * KEYS + kb * 64 + lc * 8);
  };
  auto AT_SSTORE = [&](int buf, const uint4& rk, const uint4& rv) {
    *(uint4*)(smem + buf * 18432 + lr * 128 + ((lc ^ (lr & 7)) << 4)) = rk;
    *(uint4*)(smem + buf * 18432 + 9216 + lr * 144 + lc * 16) = rv;
  };
  __syncthreads();
  AT_GLOAD(0, rkA, rvA);
  AT_SSTORE(0, rkA, rvA);
  if (1 < nblk) AT_GLOAD(1, rkA, rvA);
  if (2 < nblk) AT_GLOAD(2, rkB, rvB);
  lds_barrier();
  const int qpos = qpos0 + wid * 16 + r16;
  for (int i = 0; i < nblk; ++i) {
    const int kb = i < (kb_hi - kb_lo) ? kb_lo + i : kc_lo + (i - (kb_hi - kb_lo));
    const bool masked = (!DIFF) && (kb < 64);
    const char* Kt = smem + (i & 1) * 18432; const char* Vt = Kt + 9216;
    f32x4 S[NC][4];
#pragma unroll
    for (int kt = 0; kt < 4; ++kt) {
      bf16x8 k0 = *(const bf16x8*)(Kt + (kt * 16 + r16) * 128 + ((g ^ (r16 & 7)) << 4));
      bf16x8 k1 = *(const bf16x8*)(Kt + (kt * 16 + r16) * 128 + (((4 + g) ^ (r16 & 7)) << 4));
      if (DIFF) {
        S[0][kt] = __builtin_amdgcn_mfma_f32_16x16x32_bf16(k0, qf[0], (f32x4){0.f, 0.f, 0.f, 0.f}, 0, 0, 0);
        S[NC - 1][kt] = __builtin_amdgcn_mfma_f32_16x16x32_bf16(k1, qf[1], (f32x4){0.f, 0.f, 0.f, 0.f}, 0, 0, 0);
      } else {
        f32x4 t = __builtin_amdgcn_mfma_f32_16x16x32_bf16(k0, qf[0], (f32x4){0.f, 0.f, 0.f, 0.f}, 0, 0, 0);
        S[0][kt] = __builtin_amdgcn_mfma_f32_16x16x32_bf16(k1, qf[1], t, 0, 0, 0);
      }
    }
    bf16x8 pf[NC][2];
#pragma unroll
    for (int c = 0; c < NC; ++c) {
      float mx = -1e30f;
#pragma unroll
      for (int kt = 0; kt < 4; ++kt)
#pragma unroll
        for (int j = 0; j < 4; ++j) {
          float v = S[c][kt][j];
          if (masked) { int kpos = kb * 64 + kt * 16 + g * 4 + j; int dd = kpos - qpos; if (dd > 128 || dd < -128) v = -3e38f; S[c][kt][j] = v; }
          mx = fmaxf(mx, v);
        }
      mx *= sc;
      mx = fmaxf(mx, __shfl_xor(mx, 16)); mx = fmaxf(mx, __shfl_xor(mx, 32));
      const float mn = fmaxf(m[c], mx);
      const bool grow = mn > m[c];
      float ps = 0.f;
      unsigned pk[8];
#pragma unroll
      for (int kt = 0; kt < 4; ++kt) {
        float e0 = __builtin_amdgcn_exp2f(fmaf(S[c][kt][0], sc, -mn)), e1 = __builtin_amdgcn_exp2f(fmaf(S[c][kt][1], sc, -mn));
        float e2 = __builtin_amdgcn_exp2f(fmaf(S[c][kt][2], sc, -mn)), e3 = __builtin_amdgcn_exp2f(fmaf(S[c][kt][3], sc, -mn));
        ps += (e0 + e1) + (e2 + e3);
        pk[kt * 2] = pack2(e0, e1); pk[kt * 2 + 1] = pack2(e2, e3);
      }
      if (__builtin_amdgcn_ballot_w64(grow) != 0ull) {
        const float alpha = __builtin_amdgcn_exp2f(m[c] - mn);
        m[c] = mn;
        lsum[c] *= alpha;
#pragma unroll
        for (int dt = 0; dt < 4; ++dt) { O[c][dt][0] *= alpha; O[c][dt][1] *= alpha; O[c][dt][2] *= alpha; O[c][dt][3] *= alpha; }
      }
      lsum[c] += ps;
      union { unsigned u[4]; bf16x8 v; } cv;
      cv.u[0] = pk[0]; cv.u[1] = pk[1]; cv.u[2] = pk[2]; cv.u[3] = pk[3]; pf[c][0] = cv.v;
      cv.u[0] = pk[4]; cv.u[1] = pk[5]; cv.u[2] = pk[6]; cv.u[3] = pk[7]; pf[c][1] = cv.v;
    }
#pragma unroll
    for (int dt = 0; dt < 4; ++dt)
#pragma unroll
      for (int s2 = 0; s2 < 2; ++s2) {
        union { uint2 u[2]; bf16x8 v; } vf;
        vf.u[0] = *(const uint2*)(Vt + (dt * 16 + r16) * 144 + (2 * s2) * 32 + g * 8);
        vf.u[1] = *(const uint2*)(Vt + (dt * 16 + r16) * 144 + (2 * s2 + 1) * 32 + g * 8);
#pragma unroll
        for (int c = 0; c < NC; ++c) O[c][dt] = __builtin_amdgcn_mfma_f32_16x16x32_bf16(vf.v, pf[c][s2], O[c][dt], 0, 0, 0);
      }
    if (i + 1 < nblk) AT_SSTORE((i + 1) & 1, rkA, rvA);
    rkA = rkB; rvA = rvB;
    if (i + 3 < nblk) AT_GLOAD(i + 3, rkB, rvB);
    lds_barrier();
  }
  float linv[NC];
#pragma unroll
  for (int c = 0; c < NC; ++c) { float t = lsum[c]; t += __shfl_xor(t, 16); t += __shfl_xor(t, 32); linv[c] = 1.f / t; }
  const size_t orow = (size_t)(qrow0 + wid * 16 + r16);
  if (!DIFF) {
    bf16_t* Y = (bf16_t*)(p.ws + R_YSW);
#pragma unroll
    for (int dt = 0; dt < 4; ++dt) {
      uint2 o; o.x = pack2(O[0][dt][0] * linv[0], O[0][dt][1] * linv[0]); o.y = pack2(O[0][dt][2] * linv[0], O[0][dt][3] * linv[0]);
      *(uint2*)(Y + orow * 256 + h * 64 + dt * 16 + g * 4) = o;
    }
  } else {
    const float lam_init = 0.8f - 0.6f * __expf(-0.3f * (float)l);
    float d1 = 0.f, d2 = 0.f;
    if (lane < 32) { d1 = p.in[28][l * 32 + lane] * p.in[29][l * 32 + lane]; d2 = p.in[30][l * 32 + lane] * p.in[31][l * 32 + lane]; }
    d1 = wave_sum(d1); d2 = wave_sum(d2);
    const float lam = expf(d1) - expf(d2) + lam_init;
    float ov[4][4]; float ss = 0.f;
#pragma unroll
    for (int dt = 0; dt < 4; ++dt)
#pragma unroll
      for (int j = 0; j < 4; ++j) { float v = O[0][dt][j] * linv[0] - lam * O[NC - 1][dt][j] * linv[NC - 1]; ov[dt][j] = v; ss += v * v; }
    ss += __shfl_xor(ss, 16); ss += __shfl_xor(ss, 32);
    const float rms = rsqrtf(ss * (1.f / 64.f) + 1e-5f) * (1.f - lam_init);
    const float* sg = p.in[32] + l * 64;
    bf16_t* Y = (bf16_t*)(p.ws + R_YDF);
#pragma unroll
    for (int dt = 0; dt < 4; ++dt) {
      const int d0 = dt * 16 + g * 4;
      uint2 o; o.x = pack2(ov[dt][0] * rms * sg[d0], ov[dt][1] * rms * sg[d0 + 1]); o.y = pack2(ov[dt][2] * rms * sg[d0 + 2], ov[dt][3] * rms * sg[d0 + 3]);
      *(uint2*)(Y + orow * 256 + h * 64 + d0) = o;
    }
  }
}

DI void ph_attn(const Params& p, int l, char* smem) {
  const bool need_ctx = (l == 0);
  const int n_sw = 1024 + (need_ctx ? 64 : 0);
  const int n_df = 1024 + (need_ctx ? 64 : 0);
  unsigned* ctr = (unsigned*)(p.ws + MISC_BAR + 64 + 64 * l);
  volatile int* slot = (volatile int*)(smem + 40960);
  for (;;) {
    __syncthreads();
    if (my_tid() == 0) *slot = (int)__hip_atomic_fetch_add(ctr, 1u, __ATOMIC_RELAXED, __HIP_MEMORY_SCOPE_AGENT);
    __syncthreads();
    const int u = *slot;
    if (u >= n_sw + n_df) break;
    if (u < n_df) {
      if (u < 1024) { int b = u >> 7, h = (u >> 5) & 3, n = u & 31; attn_unit<true>(p, l, b, h, b * SL + n * 128, n * 128, 0, 64, 64, smem); }
      else { int v = u - 1024; int b = v >> 3, h = (v >> 1) & 3, n = v & 1; attn_unit<true>(p, l, b, h, ML + b * CL + n * 128, 0, 0, 0, 64, smem); }
    } else {
      int w = u - n_df;
      if (w < 1024) {
        int b = w >> 7, h = (w >> 5) & 3, n = w & 31;
        int lo = (n - 1) * 2; if (lo < 0) lo = 0; int hi = (n + 2) * 2; if (hi > 64) hi = 64;
        attn_unit<false>(p, l, b, h, b * SL + n * 128, n * 128, lo, hi, 64, smem);
      } else { int v = w - 1024; int b = v >> 3, h = (v >> 1) & 3, n = v & 1; attn_unit<false>(p, l, b, h, ML + b * CL + n * 128, 0, 0, 0, 64, smem); }
    }
  }
}

DI void ph_rwout(const Params& p, int l) {
  const int lane = my_tid() & 63, wid = my_tid() >> 6;
  const bf16_t* S = (const bf16_t*)(p.ws + R_STR); const bf16_t* Gs = (const bf16_t*)(p.ws + R_G);
  const bf16_t* OF = (const bf16_t*)(p.ws + R_OF); const bf16_t* OB = (const bf16_t*)(p.ws + R_OB);
  bf16_t* Y = (bf16_t*)(p.ws + R_YRW);
  const size_t SU = (size_t)MT * 256;
  const float4 rk = *(const float4*)(p.in[25] + (size_t)l * 256 + lane * 4);
  const float4 gam = *(const float4*)(p.in[26] + (size_t)l * 256 + lane * 4);
  const float4 bet = *(const float4*)(p.in[27] + (size_t)l * 256 + lane * 4);
  const int nrows = (l == 0) ? MT : ML;
  for (int row = blockIdx.x * 8 + wid; row < nrows; row += gridDim.x * 8) {
    const size_t o = (size_t)row * 256 + lane * 4;
    uint2 ur = *(const uint2*)(S + o), uk = *(const uint2*)(S + SU + o), uv = *(const uint2*)(S + 2 * SU + o);
    uint2 uf = *(const uint2*)(OF + o), ub = *(const uint2*)(OB + o), ugf = *(const uint2*)(Gs + o), ugb = *(const uint2*)(Gs + SU + o);
    float r[4] = {bflo(ur.x), bfhi(ur.x), bflo(ur.y), bfhi(ur.y)};
    float k[4] = {bflo(uk.x), bfhi(uk.x), bflo(uk.y), bfhi(uk.y)};
    float v[4] = {bflo(uv.x), bfhi(uv.x), bflo(uv.y), bfhi(uv.y)};
    float f[4] = {bflo(uf.x), bfhi(uf.x), bflo(uf.y), bfhi(uf.y)};
    float bb[4] = {bflo(ub.x), bfhi(ub.x), bflo(ub.y), bfhi(ub.y)};
    float gf[4] = {bflo(ugf.x), bfhi(ugf.x), bflo(ugf.y), bfhi(ugf.y)};
    float gb[4] = {bflo(ugb.x), bfhi(ugb.x), bflo(ugb.y), bfhi(ugb.y)};
    const float rkv[4] = {rk.x, rk.y, rk.z, rk.w}; const float ga[4] = {gam.x, gam.y, gam.z, gam.w}; const float be[4] = {bet.x, bet.y, bet.z, bet.w};
    float bon = 0.f, sf = 0.f, sb = 0.f;
#pragma unroll
    for (int i = 0; i < 4; ++i) { bon += r[i] * k[i] * rkv[i]; sf += f[i]; sb += bb[i]; }
    bon = sum16(bon); float muf = sum16(sf) * (1.f / 64.f), mub = sum16(sb) * (1.f / 64.f);
    float qf = 0.f, qb = 0.f;
#pragma unroll
    for (int i = 0; i < 4; ++i) { f[i] -= muf; bb[i] -= mub; qf += f[i] * f[i]; qb += bb[i] * bb[i]; }
    float rsf = rsqrtf(sum16(qf) * (1.f / 64.f) + 64e-5f), rsb = rsqrtf(sum16(qb) * (1.f / 64.f) + 64e-5f);
    float y[4];
#pragma unroll
    for (int i = 0; i < 4; ++i) {
      float bn = bon * v[i];
      y[i] = (f[i] * rsf * ga[i] + be[i] + bn) * gf[i] + (bb[i] * rsb * ga[i] + be[i] + bn) * gb[i];
    }
    uint2 oo; oo.x = pack2(y[0], y[1]); oo.y = pack2(y[2], y[3]);
    *(uint2*)(Y + o) = oo;
  }
}

DI void ph_merge(const Params& p, int l, const bf16_t* U, char* smem) {
  const int lane = my_tid() & 63, wid = my_tid() >> 6, wm = wid >> 1, wn = wid & 1, g = lane >> 4, r16 = lane & 15;
  const int mtiles = (l == 0) ? 136 : 128;
  bf16_t* ACC = (bf16_t*)(p.ws + R_ACC);
  for (int it = 0;; ++it) {
    int mtile, ntile;
    if (!next_tile(it, mtiles, 8, mtile, ntile)) break;
    uint2 accS[4][4];
#pragma unroll
    for (int mt = 0; mt < 4; ++mt)
#pragma unroll
      for (int nt = 0; nt < 4; ++nt) accS[mt][nt] = make_uint2(0u, 0u);
    for (int j = 0; j < 4; ++j) {
      uint2 pb[4][4];
      {
        f32x4 accB[4][4]; zero_acc<4>(accB);
        const size_t yoff = (j == 0) ? R_YHY : (j == 1) ? R_YSW : (j == 2) ? R_YRW : R_YDF;
        gemm_glds(accB, (const bf16_t*)(p.ws + yoff), 256, RowPlain{(long)mtile * 256}, (const bf16_t*)(p.ws + WB_BR) + ((size_t)j * 1024 + ntile * 128) * 256, 256, 256, smem, (const bf16_t*)(p.ws + MISC_ZERO));
#pragma unroll
        for (int mt = 0; mt < 4; ++mt)
#pragma unroll
          for (int nt = 0; nt < 4; ++nt) { pb[mt][nt].x = pack2(accB[mt][nt][0], accB[mt][nt][1]); pb[mt][nt].y = pack2(accB[mt][nt][2], accB[mt][nt][3]); }
      }
      f32x4 accG[4][4]; zero_acc<4>(accG);
      gemm_glds(accG, U, 1024, RowPlain{(long)mtile * 256}, (const bf16_t*)(p.ws + WB_GATE) + ((size_t)j * 1024 + ntile * 128) * 1024, 1024, 1024, smem, (const bf16_t*)(p.ws + MISC_ZERO));
#pragma unroll
      for (int mt = 0; mt < 4; ++mt)
#pragma unroll
        for (int nt = 0; nt < 4; ++nt) {
          float v0 = bflo(accS[mt][nt].x) + sigmoidf_(accG[mt][nt][0]) * bflo(pb[mt][nt].x);
          float v1 = bfhi(accS[mt][nt].x) + sigmoidf_(accG[mt][nt][1]) * bfhi(pb[mt][nt].x);
          float v2 = bflo(accS[mt][nt].y) + sigmoidf_(accG[mt][nt][2]) * bflo(pb[mt][nt].y);
          float v3 = bfhi(accS[mt][nt].y) + sigmoidf_(accG[mt][nt][3]) * bfhi(pb[mt][nt].y);
          accS[mt][nt].x = pack2(v0, v1); accS[mt][nt].y = pack2(v2, v3);
        }
    }
#pragma unroll
    for (int mt = 0; mt < 4; ++mt) {
      const int col = ntile * 128 + wn * 64 + r16 * 4;
      const size_t row = (size_t)mtile * 256 + wm * 64 + mt * 16 + g * 4;
      uint2 o;
      o.x = (accS[mt][0].x & 0xffffu) | (accS[mt][1].x << 16); o.y = (accS[mt][2].x & 0xffffu) | (accS[mt][3].x << 16);
      *(uint2*)(ACC + (row + 0) * 1024 + col) = o;
      o.x = (accS[mt][0].x >> 16) | (accS[mt][1].x & 0xffff0000u); o.y = (accS[mt][2].x >> 16) | (accS[mt][3].x & 0xffff0000u);
      *(uint2*)(ACC + (row + 1) * 1024 + col) = o;
      o.x = (accS[mt][0].y & 0xffffu) | (accS[mt][1].y << 16); o.y = (accS[mt][2].y & 0xffffu) | (accS[mt][3].y << 16);
      *(uint2*)(ACC + (row + 2) * 1024 + col) = o;
      o.x = (accS[mt][0].y >> 16) | (accS[mt][1].y & 0xffff0000u); o.y = (accS[mt][2].y >> 16) | (accS[mt][3].y & 0xffff0000u);
      *(uint2*)(ACC + (row + 3) * 1024 + col) = o;
    }
  }
}

DI void ph_resgemm(const Params& p, int l, const bf16_t* A, int K, const bf16_t* Bt, const float* hsrc_lat, const float* hsrc_ctx, int gate_off, char* smem) {
  const int lane = my_tid() & 63, wid = my_tid() >> 6, wm = wid >> 1, wn = wid & 1, g = lane >> 4, r16 = lane & 15;
  const int mtiles = (l == 0) ? 136 : 128;
  const float* mod = (const float*)(p.ws + MISC_MOD) + (size_t)l * 9 * 6144;
  float* hc = (float*)(p.ws + OFF_HC);
  for (int it = 0;; ++it) {
    int mtile, ntile;
    if (!next_tile(it, mtiles, 8, mtile, ntile)) break;
    f32x4 acc[4][4]; zero_acc<4>(acc);
    gemm_glds(acc, A, K, RowPlain{(long)mtile * 256}, Bt + (size_t)ntile * 128 * K, K, K, smem, (const bf16_t*)(p.ws + MISC_ZERO));
    const int b = mtile < 128 ? (mtile >> 4) : 8;
    const float* gt = mod + (size_t)b * 6144 + gate_off;
    const int col = ntile * 128 + wn * 64 + r16 * 4;
    const float4 gv = *(const float4*)(gt + col);
#pragma unroll
    for (int mt = 0; mt < 4; ++mt)
#pragma unroll
      for (int e = 0; e < 4; ++e) {
        const int row = mtile * 256 + wm * 64 + mt * 16 + g * 4 + e;
        const float* hs; float* hd;
        if (row < ML) { size_t o = (size_t)row * D + col; hs = hsrc_lat + o; hd = p.out + o; }
        else { size_t o = (size_t)(row - ML) * D + col; hs = hsrc_ctx + o; hd = hc + o; }
        const float4 h = *(const float4*)hs;
        float4 r;
        r.x = DN_ALPHA * h.x + gv.x * acc[mt][0][e]; r.y = DN_ALPHA * h.y + gv.y * acc[mt][1][e];
        r.z = DN_ALPHA * h.z + gv.z * acc[mt][2][e]; r.w = DN_ALPHA * h.w + gv.w * acc[mt][3][e];
        *(float4*)hd = r;
      }
  }
}

DI void ph_ffnup(const Params& p, int l, char* smem) {
  const bf16_t* U = (const bf16_t*)(p.ws + R_U);
  const bf16_t* Bt = (const bf16_t*)(p.ws + WB_UP);
  bf16_t* HID = (bf16_t*)(p.ws + R_HID);
  const float* cw = p.in[38] + (size_t)l * 3 * 5632; const float* cb = p.in[39] + (size_t)l * 5632;
  const int tid = my_tid(), lane = tid & 63, wid = tid >> 6, wm = wid >> 2, wn = wid & 3, g = lane >> 4, r16 = lane & 15;
  const int mtiles = (l == 0) ? 144 : 136;
  constexpr int TS = 528;
  for (int it = 0;; ++it) {
    int mtile, ntile;
    if (!next_tile(it, mtiles, 22, mtile, ntile)) break;
    long rowbase; int t0, len, r0, r1;
    if (mtile < 136) { int b = mtile / 17; int tt = mtile % 17; len = SL; rowbase = (long)b * SL; t0 = tt * 254 - 1; r0 = 1; r1 = 254; }
    else { int b = mtile - 136; len = CL; rowbase = (long)ML + b * CL; t0 = 0; r0 = 0; r1 = 255; }
    f32x4 acc[8][4]; zero_acc256(acc);
    gemm_glds256(acc, U, 1024, rowbase + t0, Bt + (size_t)ntile * 256 * 1024, 1024, 1024, smem);
#pragma unroll
    for (int mt = 0; mt < 8; ++mt)
#pragma unroll
      for (int e = 0; e < 4; ++e) {
        uint2 o; o.x = pack2(acc[mt][0][e], acc[mt][1][e]); o.y = pack2(acc[mt][2][e], acc[mt][3][e]);
        *(uint2*)(smem + (wm * 128 + mt * 16 + g * 4 + e) * TS + (wn * 64 + r16 * 4) * 2) = o;
      }
    __syncthreads();
    {
      const int ch = (tid & 63) * 2, rgp = tid >> 6; const int ca = ntile * 128 + ch, cbx = 2816 + ca;
      const float a00 = cw[ca], a01 = cw[5632 + ca], a02 = cw[2 * 5632 + ca], a0b = cb[ca];
      const float a10 = cw[ca + 1], a11 = cw[5632 + ca + 1], a12 = cw[2 * 5632 + ca + 1], a1b = cb[ca + 1];
      const float b00 = cw[cbx], b01 = cw[5632 + cbx], b02 = cw[2 * 5632 + cbx], b0b = cb[cbx];
      const float b10 = cw[cbx + 1], b11 = cw[5632 + cbx + 1], b12 = cw[2 * 5632 + cbx + 1], b1b = cb[cbx + 1];
      for (int r = r0 + rgp; r <= r1; r += 8) {
        const int tok = t0 + r;
        if (tok < len) {
          const char* Tr = smem + r * TS + ch * 2;
          const unsigned ua = *(const unsigned*)(Tr), ub = *(const unsigned*)(Tr + 256);
          const unsigned pa = tok >= 1 ? *(const unsigned*)(Tr - TS) : 0u, pb_ = tok >= 1 ? *(const unsigned*)(Tr - TS + 256) : 0u;
          const unsigned na = tok + 1 < len ? *(const unsigned*)(Tr + TS) : 0u, nb = tok + 1 < len ? *(const unsigned*)(Tr + TS + 256) : 0u;
          const float av0 = a00 * bflo(pa) + a01 * bflo(ua) + a02 * bflo(na) + a0b;
          const float av1 = a10 * bfhi(pa) + a11 * bfhi(ua) + a12 * bfhi(na) + a1b;
          const float bv0 = b00 * bflo(pb_) + b01 * bflo(ub) + b02 * bflo(nb) + b0b;
          const float bv1 = b10 * bfhi(pb_) + b11 * bfhi(ub) + b12 * bfhi(nb) + b1b;
          *(unsigned*)(HID + (size_t)(rowbase + tok) * 2816 + ca) = pack2(siluf_(av0) * bv0, siluf_(av1) * bv1);
        }
      }
    }
  }
}

#ifndef REP_PREP
#define REP_PREP 1
#endif
#ifndef REP_GEMM
#define REP_GEMM 1
#endif
#ifndef REP_HY
#define REP_HY 1
#endif
#ifndef REP_RWP
#define REP_RWP 1
#endif
#ifndef REP_SCAN
#define REP_SCAN 1
#endif
#ifndef REP_ATTN
#define REP_ATTN 1
#endif
#ifndef PH_END
#define PH_END 24
#endif
#define XB_TMO      128
#define XB_XCNT(j)  (256  + 64 * (j))
#define XB_XSUB(j)  (1280 + 64 * (j))
#define XB_XGEN(j)  (2304 + 64 * (j))
#define XB_TOP      3328
#define XB_TOPGEN   3392
#define XCD_BAR_WORDS 3456
#define XB_SPIN_CAP (1u << 22)
DI unsigned xb_ld(unsigned* p) { return __hip_atomic_load(p, __ATOMIC_RELAXED, __HIP_MEMORY_SCOPE_AGENT); }
DI unsigned xb_add(unsigned* p, unsigned v) { return __hip_atomic_fetch_add(p, v, __ATOMIC_RELAXED, __HIP_MEMORY_SCOPE_AGENT); }
DI unsigned xb_xcc_id() { return (unsigned)__builtin_amdgcn_s_getreg((3 << 11) | 20) & 0xFu; }
#define XB_SPIN(cond, bar) do { unsigned _sp = 0; while (cond) { __builtin_amdgcn_s_sleep(1); \
    if ((++_sp & 255u) == 0u) { if (xb_ld(&(bar)[XB_TMO])) break; if (_sp > XB_SPIN_CAP) { atomicAdd(&(bar)[XB_TMO], 1u); break; } } } } while (0)
DI void xcd_barrier_complete(unsigned* bar, unsigned x, unsigned& nloc, unsigned& nx) {
  const unsigned G = gridDim.x;
  unsigned sum, cnt, mine, sp = 0u;
  for (;;) {
    sum = 0u; cnt = 0u; mine = 0u;
#pragma unroll
    for (unsigned j = 0; j < 16; ++j) { const unsigned c = xb_ld(&bar[XB_XCNT(j)]); sum += c; cnt += (c > 0u) ? 1u : 0u; mine = (j == x) ? c : mine; }
    if (sum == G) break;
    __builtin_amdgcn_s_sleep(1);
    if ((++sp & 255u) == 0u) { if (xb_ld(&bar[XB_TMO])) break; if (sp > XB_SPIN_CAP) { atomicAdd(&bar[XB_TMO], 1u); break; } }
  }
  nloc = mine > 0u ? mine : 1u; nx = cnt > 0u ? cnt : 1u;
}
DI void grid_barrier(unsigned* bar, volatile unsigned* st) {
  asm volatile("s_waitcnt vmcnt(0)" ::: "memory");
  __syncthreads();
  if (my_tid() == 0) {
    const unsigned x = xb_xcc_id();
    __builtin_amdgcn_s_waitcnt(0);
    unsigned nloc = st[0], nx = st[1];
    if (nloc == 0u) { xcd_barrier_complete(bar, x, nloc, nx); st[0] = nloc; st[1] = nx; }
    const unsigned old = xb_add(&bar[XB_XSUB(x)], 1u);
    const unsigned gen = old / nloc;
    if (old + 1u == (gen + 1u) * nloc) {
      __builtin_amdgcn_fence(__ATOMIC_RELEASE, "agent");
      asm volatile("s_waitcnt vmcnt(0)" ::: "memory");
      const unsigned og = xb_add(&bar[XB_TOP], 1u);
      const unsigned tg = og / nx;
      if (og + 1u == (tg + 1u) * nx) xb_add(&bar[XB_TOPGEN], 1u);
      else XB_SPIN(xb_ld(&bar[XB_TOPGEN]) == tg, bar);
      __builtin_amdgcn_fence(__ATOMIC_ACQUIRE, "agent");
      xb_add(&bar[XB_XGEN(x)], 1u);
      asm volatile("s_waitcnt vmcnt(0)" ::: "memory");
    } else {
      XB_SPIN(xb_ld(&bar[XB_XGEN(x)]) == gen, bar);
      __builtin_amdgcn_fence(__ATOMIC_ACQUIRE, "agent");
      asm volatile("s_waitcnt vmcnt(0)" ::: "memory");
    }
  }
  __syncthreads();
}
#define SYNC_OR_RET(idx) do { if ((idx) + 1 >= PH_END) return; if ((idx) == 0) { grid.sync(); if (my_tid() == 0) (void)xb_add(&((unsigned*)(p.ws + MISC_XBAR))[XB_XCNT(xb_xcc_id())], 1u); } else grid_barrier((unsigned*)(p.ws + MISC_XBAR), (volatile unsigned*)(smem + 144 * 1024)); } while (0)
template <int l>
DI void run_layer(const Params& p, cg::grid_group& grid, char* smem, unsigned& epoch) {
  const float* mod = (const float*)(p.ws + MISC_MOD) + (size_t)l * 9 * 6144;
  float* hc = (float*)(p.ws + OFF_HC);
  const float* hl_src = (l == 0) ? p.in[0] : p.out;
  const float* hc_src = (l == 0) ? p.in[2] : hc;
  constexpr int B0 = l * 12;
  if (l == 0) {
    ph_convert(p, 0, smem);
    ph_ada(p, smem);
    hy_rawfilter(p, 0, SL, (float*)(p.ws + R_RAWF), smem);
    hy_rawfilter(p, 0, CL, (float*)(p.ws + MISC_RAWC), smem);
    SYNC_OR_RET(B0 + 0);
    ph_kf(p, 0, smem);
    ph_ln(hl_src, hc_src, nullptr, nullptr, nullptr, nullptr, (bf16_t*)p.out, mod, 0, MT);
    SYNC_OR_RET(B0 + 1);
  }
  for (int rep = 0; rep < REP_GEMM; ++rep) ph_inproj(p, l == 0 ? (const bf16_t*)p.out : (const bf16_t*)(p.ws + R_U), smem);
  SYNC_OR_RET(B0 + 2);
  for (int rep = 0; rep < REP_HY; ++rep) {
  if (blockIdx.x == 0 && my_tid() == 0) *(unsigned*)(p.ws + MISC_BAR + 64 + 64 * l) = 0u;
  ph_hyena(p, l, smem);
  if (l == 0) ph_hyena_ctx(p, l, smem);
  }
  ph_rope(p, smem);
  for (int rep = 0; rep < REP_RWP; ++rep) ph_rwprep(p, l, smem);
  SYNC_OR_RET(B0 + 3);
  for (int rep = 0; rep < REP_SCAN; ++rep) ph_scan(p, smem);
  for (int rep = 0; rep < REP_ATTN; ++rep) ph_attn(p, l, smem);
  SYNC_OR_RET(B0 + 4);
  ph_rwout(p, l);
  if (l != 0) ph_ln(hl_src, hc_src, nullptr, nullptr, nullptr, nullptr, (bf16_t*)(p.ws + R_URE), mod, 0, ML);
  SYNC_OR_RET(B0 + 5);
  for (int rep = 0; rep < REP_GEMM; ++rep) ph_merge(p, l, l == 0 ? (const bf16_t*)p.out : (const bf16_t*)(p.ws + R_URE), smem);
  SYNC_OR_RET(B0 + 6);
  ph_resgemm(p, l, (const bf16_t*)(p.ws + R_ACC), 1024, (const bf16_t*)(p.ws + WB_OUT), hl_src, hc_src, 2048, smem);
  if (l == 0) hy_rawfilter(p, 1, SL, (float*)(p.ws + R_RAWF), smem);
  SYNC_OR_RET(B0 + 7);
  ph_ln(p.out, hc, p.out, hc, p.in[35] + (size_t)l * D, p.in[36] + (size_t)l * D, (bf16_t*)(p.ws + R_U), mod, 3072, l == 0 ? MT : ML);
  if (l == 0) ph_kf(p, 1, smem);
  SYNC_OR_RET(B0 + 8);
  for (int rep = 0; rep < REP_GEMM; ++rep) ph_ffnup(p, l, smem);
  SYNC_OR_RET(B0 + 9);
  ph_resgemm(p, l, (const bf16_t*)(p.ws + R_HID), 2816, (const bf16_t*)(p.ws + WB_DOWN), p.out, hc, 5120, smem);
  SYNC_OR_RET(B0 + 10);
  if (l == 0) {
    ph_ln(p.out, hc, p.out, hc, p.in[41], p.in[42], (bf16_t*)(p.ws + R_U), mod + 9 * 6144, 0, MT);
    ph_convert(p, 1, smem);
  } else {
    ph_ln(p.out, hc, p.out, hc, p.in[41] + (size_t)l * D, p.in[42] + (size_t)l * D, nullptr, mod, 0, ML);
  }
  SYNC_OR_RET(B0 + 11);
}

__global__ void __launch_bounds__(NTHR) mega(Params p) {
  extern __shared__ __attribute__((aligned(16))) char smem[];
  cg::grid_group grid = cg::this_grid();
  unsigned epoch = 0;
  if (blockIdx.x == 0) for (int i = my_tid(); i < XCD_BAR_WORDS; i += NTHR) ((unsigned*)(p.ws + MISC_XBAR))[i] = 0u;
  if (my_tid() < 2) ((volatile unsigned*)(smem + 144 * 1024))[my_tid()] = 0u;
  if (blockIdx.x == 0 && my_tid() < 64) *(unsigned*)(p.ws + MISC_ZERO + my_tid() * 4) = 0u;
  run_layer<0>(p, grid, smem, epoch);
  if (PH_END > 12) run_layer<1>(p, grid, smem, epoch);
}

extern "C" void kernel_launch(void* const* d_in, const int* in_sizes, int n_in, void* d_out, int out_size,
                              void* d_ws, size_t ws_size, hipStream_t stream) {
  static int grid_blocks = 0;
  if (!grid_blocks) {
    int dev = 0, cus = 0, per_cu = 0;
    (void)hipGetDevice(&dev);
    (void)hipDeviceGetAttribute(&cus, hipDeviceAttributeMultiprocessorCount, dev);
    (void)hipFuncSetAttribute((const void*)mega, hipFuncAttributeMaxDynamicSharedMemorySize, SMEM_BYTES);
    (void)hipOccupancyMaxActiveBlocksPerMultiprocessor(&per_cu, mega, NTHR, SMEM_BYTES);
    if (per_cu < 1) per_cu = 1;
    if (per_cu > 1) per_cu = 1;
    grid_blocks = cus * per_cu;
  }
  Params p{};
  for (int i = 0; i < 43; ++i) p.in[i] = (const float*)d_in[i];
  p.out = (float*)d_out; p.ws = (char*)d_ws;
  void* args[] = {&p};
  hipError_t e = hipLaunchCooperativeKernel((void*)mega, dim3(grid_blocks), dim3(NTHR), args, SMEM_BYTES, stream);
  if (e != hipSuccess) fprintf(stderr, "cooperative launch failed: %s (grid %d)\n", hipGetErrorString(e), grid_blocks);
}
```

```cpp
#include <hip/hip_runtime.h>
#include <hip/hip_cooperative_groups.h>
#include <cstdio>
#include <cstdint>
namespace cg = cooperative_groups;

#define DI __device__ __forceinline__
typedef unsigned short bf16_t;
typedef short bf16x8 __attribute__((ext_vector_type(8)));
typedef float f32x4 __attribute__((ext_vector_type(4)));

constexpr int D = 1024, NB = 8, SL = 4096, CL = 256;
constexpr int ML = NB * SL, MC = NB * CL, MT = ML + MC;
constexpr int KEYS = SL + CL;
constexpr int NTHR = 512;
constexpr float DN_ALPHA = 1.41421356237f;
constexpr size_t UNIT = (size_t)MT * 512;

constexpr size_t WB_IN = 0;
constexpr size_t WB_GATE = WB_IN + (size_t)3328 * 1024 * 2;
constexpr size_t WB_BR = WB_GATE + (size_t)4096 * 1024 * 2;
constexpr size_t WB_OUT = WB_BR + (size_t)4 * 1024 * 256 * 2;
constexpr size_t WB_UP = WB_OUT + (size_t)1024 * 1024 * 2;
constexpr size_t WB_DOWN = WB_UP + (size_t)5632 * 1024 * 2;
constexpr size_t WB_END = WB_DOWN + (size_t)1024 * 2816 * 2;
constexpr size_t OFF_KF = WB_END;
constexpr size_t OFF_HC = OFF_KF + (size_t)512 * 8192 * 8;
constexpr size_t OFF_MISC = OFF_HC + (size_t)MC * D * 4;
constexpr size_t MISC_MOD = OFF_MISC;
constexpr size_t MISC_TW = MISC_MOD + (size_t)2 * 9 * 6144 * 4;
constexpr size_t MISC_RAWC = MISC_TW + 4096 * 8;
constexpr size_t MISC_GCTX = MISC_RAWC + (size_t)256 * 1024 * 4;
constexpr size_t MISC_RWW = MISC_GCTX + (size_t)512 * 512 * 4;
constexpr size_t RWW_F = MISC_RWW, RWW_B = RWW_F + 256 * 64 * 2, RWW_A = RWW_B + 256 * 64 * 2, RWW_GF = RWW_A + 256 * 64 * 2, RWW_GB = RWW_GF + 256 * 128 * 2;
constexpr size_t MISC_XBAR = OFF_MISC + (size_t)3 * 1024 * 1024;
constexpr size_t OFF_R = OFF_MISC + (size_t)4 * 1024 * 1024;
constexpr size_t MISC_BAR = OFF_R - 256;
constexpr size_t MISC_ZERO = OFF_R - 512;
static_assert(RWW_GB + 256 * 128 * 2 <= MISC_ZERO, "misc overflow");
constexpr size_t R_YHY = OFF_R, R_YSW = OFF_R + UNIT, R_YDF = OFF_R + 2 * UNIT;
constexpr size_t R_PHY = OFF_R + 3 * UNIT;
constexpr size_t R_PSW = OFF_R + 6 * UNIT;
constexpr size_t R_VTSW = R_PSW + (size_t)MT * 384 * 2;
constexpr size_t R_PDF = OFF_R + 8 * UNIT;
constexpr size_t R_VTDF = OFF_R + 10 * UNIT;
constexpr size_t R_PRW = OFF_R + 11 * UNIT;
constexpr size_t R_STR = R_PRW + (size_t)MT * 1216 * 2;
constexpr size_t R_G = R_STR + 7 * UNIT;
constexpr size_t R_END = R_G + 2 * UNIT;
constexpr size_t R_RAWF = OFF_R;
constexpr size_t R_OF = R_PHY, R_OB = R_PHY + UNIT;
constexpr size_t R_URE = R_PSW;
constexpr size_t R_YRW = R_VTDF;
constexpr size_t R_ACC = R_PRW;
constexpr size_t R_U = R_STR;
constexpr size_t R_HID = OFF_R;
static_assert(R_END <= (size_t)512 * 1024 * 1024, "ws overflow");
static_assert((size_t)MT * 2816 * 2 <= 11 * UNIT, "hid");

constexpr int SMEM_BYTES = 144 * 1024 + 64;

struct Params {
  const float* in[43];
  float* out;
  char* ws;
};

DI int my_tid() { int t = (int)__builtin_amdgcn_workitem_id_x(); asm volatile("" : "+v"(t)); return t; }
DI unsigned f2bf(float f) { unsigned u = __float_as_uint(f); u += 0x7fffu + ((u >> 16) & 1u); return u >> 16; }
DI float bf2f(unsigned h) { return __uint_as_float(h << 16); }
typedef __bf16 bf16v2_t __attribute__((ext_vector_type(2)));
typedef float f32v2_t __attribute__((ext_vector_type(2)));
DI unsigned pack2(float lo, float hi) { f32v2_t v = {lo, hi}; bf16v2_t b = __builtin_convertvector(v, bf16v2_t); return __builtin_bit_cast(unsigned, b); }

DI float bflo(unsigned w) { return __uint_as_float(w << 16); }
DI float bfhi(unsigned w) { return __uint_as_float(w & 0xffff0000u); }
DI float sigmoidf_(float x) { return __builtin_amdgcn_rcpf(1.f + __expf(-x)); }
DI float siluf_(float x) { return x * __builtin_amdgcn_rcpf(1.f + __expf(-x)); }
DI float wave_sum(float v) {
#pragma unroll
  for (int o = 32; o >= 1; o >>= 1) v += __shfl_xor(v, o);
  return v;
}
template <int CTRL> DI float dpp_mov(float v) {
  return __int_as_float(__builtin_amdgcn_update_dpp(0, __float_as_int(v), CTRL, 0xf, 0xf, false));
}
DI float sum16(float v) {
  v += dpp_mov<0xB1>(v);
  v += dpp_mov<0x4E>(v);
  v += dpp_mov<0x141>(v);
  v += dpp_mov<0x140>(v);
  return v;
}
DI void lds_barrier() { asm volatile("s_waitcnt lgkmcnt(0)" ::: "memory"); __builtin_amdgcn_s_barrier(); asm volatile("" ::: "memory"); }
DI uint4 sel4(bool z, uint4 v) { return make_uint4(z ? 0u : v.x, z ? 0u : v.y, z ? 0u : v.z, z ? 0u : v.w); }
DI int mod_idx(int row) { return row < ML ? (row >> 12) : 8; }

template <int NTW, bool DEEP, class RowFn>
DI void gemm_main(f32x4 (&acc)[4][NTW], const bf16_t* __restrict__ A, int lda, RowFn rowfn,
                  const bf16_t* __restrict__ Bt, int ldb, int K, char* smem) {
  constexpr int BN = NTW * 32;
  constexpr int A_BYTES = 256 * 128, B_BYTES = BN * 128, STAGE = A_BYTES + B_BYTES;
  constexpr int NBL = BN / 64;
  const int tid = my_tid(), lane = tid & 63, wid = tid >> 6, wm = wid >> 1, wn = wid & 1, g = lane >> 4, r16 = lane & 15;
  const int chunk = tid & 7, lrow = tid >> 3;
  long a0 = rowfn(lrow), a1 = rowfn(lrow + 64), a2 = rowfn(lrow + 128), a3 = rowfn(lrow + 192);
  const long c0 = a0 < 0 ? 0 : a0, c1 = a1 < 0 ? 0 : a1, c2 = a2 < 0 ? 0 : a2, c3 = a3 < 0 ? 0 : a3;
  const bf16_t* Bp = Bt + (long)lrow * ldb + chunk * 8;
  const bf16_t* Ap0 = A + c0 * lda + chunk * 8; const bf16_t* Ap1 = A + c1 * lda + chunk * 8;
  const bf16_t* Ap2 = A + c2 * lda + chunk * 8; const bf16_t* Ap3 = A + c3 * lda + chunk * 8;
  struct Regs { uint4 a0, a1, a2, a3, b0, b1; };
  Regs R0, R1;
  R0.b1 = make_uint4(0, 0, 0, 0); R1.b1 = make_uint4(0, 0, 0, 0);
  auto GLOAD = [&](Regs& R, int k0) {
    R.a0 = *(const uint4*)(Ap0 + k0); R.a1 = *(const uint4*)(Ap1 + k0);
    R.a2 = *(const uint4*)(Ap2 + k0); R.a3 = *(const uint4*)(Ap3 + k0);
    R.b0 = *(const uint4*)(Bp + k0);
    if constexpr (NBL > 1) R.b1 = *(const uint4*)(Bp + (long)64 * ldb + k0);
  };
  auto SSTORE = [&](const Regs& R, int st) {
    char* base = smem + st * STAGE + lrow * 128 + ((chunk ^ (lrow & 7)) << 4);
    *(uint4*)(base) = sel4(a0 < 0, R.a0); *(uint4*)(base + 64 * 128) = sel4(a1 < 0, R.a1);
    *(uint4*)(base + 128 * 128) = sel4(a2 < 0, R.a2); *(uint4*)(base + 192 * 128) = sel4(a3 < 0, R.a3);
    *(uint4*)(base + A_BYTES) = R.b0;
    if constexpr (NBL > 1) *(uint4*)(base + A_BYTES + 64 * 128) = R.b1;
  };
  auto COMPUTE = [&](int st) {
    const char* As = smem + st * STAGE + (wm * 64 + r16) * 128;
    const char* Bs = smem + st * STAGE + A_BYTES + (wn * (NTW * 16) + r16) * 128;
#pragma unroll
    for (int kk = 0; kk < 2; ++kk) {
      const int sw = ((kk * 4 + g) ^ (r16 & 7)) << 4;
      bf16x8 af[4], bfr[NTW];
#pragma unroll
      for (int mt = 0; mt < 4; ++mt) af[mt] = *(const bf16x8*)(As + mt * 16 * 128 + sw);
#pragma unroll
      for (int nt = 0; nt < NTW; ++nt) bfr[nt] = *(const bf16x8*)(Bs + nt * 16 * 128 + sw);
#pragma unroll
      for (int mt = 0; mt < 4; ++mt)
#pragma unroll
        for (int nt = 0; nt < NTW; ++nt)
          acc[mt][nt] = __builtin_amdgcn_mfma_f32_16x16x32_bf16(af[mt], bfr[nt], acc[mt][nt], 0, 0, 0);
    }
  };
  const int nk = K >> 6;
  __syncthreads();
  GLOAD(R0, 0);
  SSTORE(R0, 0);
  if constexpr (DEEP) {
    GLOAD(R0, 64);
    if (nk > 2) GLOAD(R1, 128);
    lds_barrier();
    bf16x8 fa0[4], fb0[NTW], fa1[4], fb1[NTW];
    auto READF = [&](bf16x8 (&fa)[4], bf16x8 (&fb)[NTW], int st, int kk) {
      const int sw = ((kk * 4 + g) ^ (r16 & 7)) << 4;
      const char* As = smem + st * STAGE + (wm * 64 + r16) * 128 + sw;
      const char* Bs = smem + st * STAGE + A_BYTES + (wn * (NTW * 16) + r16) * 128 + sw;
#pragma unroll
      for (int mt = 0; mt < 4; ++mt) fa[mt] = *(const bf16x8*)(As + mt * 16 * 128);
#pragma unroll
      for (int nt = 0; nt < NTW; ++nt) fb[nt] = *(const bf16x8*)(Bs + nt * 16 * 128);
    };
    auto MMA = [&](const bf16x8 (&fa)[4], const bf16x8 (&fb)[NTW]) {
#pragma unroll
      for (int mt = 0; mt < 4; ++mt)
#pragma unroll
        for (int nt = 0; nt < NTW; ++nt)
          acc[mt][nt] = __builtin_amdgcn_mfma_f32_16x16x32_bf16(fa[mt], fb[nt], acc[mt][nt], 0, 0, 0);
    };
    READF(fa0, fb0, 0, 0);
    for (int kt = 0; kt < nk; kt += 2) {
      READF(fa1, fb1, 0, 1);
      MMA(fa0, fb0);
#pragma unroll
      for (int i = 0; i < 4 + NTW; ++i) { __builtin_amdgcn_sched_group_barrier(0x100, 1, 0); __builtin_amdgcn_sched_group_barrier(0x008, 2, 0); }
      __builtin_amdgcn_sched_barrier(0);
      SSTORE(R0, 1);
      if (kt + 3 < nk) GLOAD(R0, (kt + 3) * 64);
      MMA(fa1, fb1);
#pragma unroll
      for (int i = 0; i < 6; ++i) { __builtin_amdgcn_sched_group_barrier(0x200, 1, 0); __builtin_amdgcn_sched_group_barrier(0x020, 1, 0); __builtin_amdgcn_sched_group_barrier(0x008, 2, 0); }
      __builtin_amdgcn_sched_barrier(0);
      lds_barrier();
      READF(fa0, fb0, 1, 0);
      READF(fa1, fb1, 1, 1);
      MMA(fa0, fb0);
#pragma unroll
      for (int i = 0; i < 4 + NTW; ++i) { __builtin_amdgcn_sched_group_barrier(0x100, 1, 0); __builtin_amdgcn_sched_group_barrier(0x008, 2, 0); }
      __builtin_amdgcn_sched_barrier(0);
      if (kt + 2 < nk) SSTORE(R1, 0);
      if (kt + 4 < nk) GLOAD(R1, (kt + 4) * 64);
      MMA(fa1, fb1);
#pragma unroll
      for (int i = 0; i < 6; ++i) { __builtin_amdgcn_sched_group_barrier(0x200, 1, 0); __builtin_amdgcn_sched_group_barrier(0x020, 1, 0); __builtin_amdgcn_sched_group_barrier(0x008, 2, 0); }
      __builtin_amdgcn_sched_barrier(0);
      lds_barrier();
      if (kt + 2 < nk) READF(fa0, fb0, 0, 0);
    }
  } else {
    lds_barrier();
    for (int kt = 0; kt < nk; ++kt) {
      const int st = kt & 1;
      if (kt + 1 < nk) GLOAD(R0, (kt + 1) * 64);
      __builtin_amdgcn_sched_barrier(0);
      COMPUTE(st);
      __builtin_amdgcn_sched_barrier(0);
      if (kt + 1 < nk) SSTORE(R0, st ^ 1);
      lds_barrier();
    }
  }
}

#define GLDS16(gp, lp) __builtin_amdgcn_global_load_lds((const unsigned*)(gp), (unsigned*)(lp), 16, 0, 0)
template <class RowFn>
DI void gemm_glds(f32x4 (&acc)[4][4], const bf16_t* __restrict__ A, int lda, RowFn rowfn,
                  const bf16_t* __restrict__ Bt, int ldb, int K, char* smem, const bf16_t* zrow) {
  constexpr int A_BYTES = 256 * 128, STAGE = A_BYTES + 128 * 128;
  const int tid = my_tid(), lane = tid & 63, wid = tid >> 6, wm = wid >> 1, wn = wid & 1, g = lane >> 4, r16 = lane & 15;
  const int lrow = tid >> 3, c = (tid & 7) ^ (lrow & 7);
  const long a0 = rowfn(lrow), a1 = rowfn(lrow + 64), a2 = rowfn(lrow + 128), a3 = rowfn(lrow + 192);
  const bf16_t* pa0 = (a0 >= 0 ? A + a0 * lda : zrow) + c * 8; const int m0 = a0 >= 0 ? 1 : 0;
  const bf16_t* pa1 = (a1 >= 0 ? A + a1 * lda : zrow) + c * 8; const int m1 = a1 >= 0 ? 1 : 0;
  const bf16_t* pa2 = (a2 >= 0 ? A + a2 * lda : zrow) + c * 8; const int m2 = a2 >= 0 ? 1 : 0;
  const bf16_t* pa3 = (a3 >= 0 ? A + a3 * lda : zrow) + c * 8; const int m3 = a3 >= 0 ? 1 : 0;
  const bf16_t* pb0 = Bt + (long)lrow * ldb + c * 8; const bf16_t* pb1 = pb0 + (long)64 * ldb;
  auto ISSUE = [&](int kt, int bi) {
    char* d = smem + bi * STAGE + tid * 16;
    const int k0 = kt * 64;
    GLDS16(pa0 + k0 * m0, d); GLDS16(pa1 + k0 * m1, d + 8192); GLDS16(pa2 + k0 * m2, d + 16384); GLDS16(pa3 + k0 * m3, d + 24576);
    GLDS16(pb0 + k0, d + A_BYTES); GLDS16(pb1 + k0, d + A_BYTES + 8192);
  };
  auto COMPUTE = [&](int bi) {
    const char* As = smem + bi * STAGE + (wm * 64 + r16) * 128;
    const char* Bs = smem + bi * STAGE + A_BYTES + (wn * 64 + r16) * 128;
#pragma unroll
    for (int kk = 0; kk < 2; ++kk) {
      const int sw = ((kk * 4 + g) ^ (r16 & 7)) << 4;
      bf16x8 af[4], bfr[4];
#pragma unroll
      for (int mt = 0; mt < 4; ++mt) af[mt] = *(const bf16x8*)(As + mt * 16 * 128 + sw);
#pragma unroll
      for (int nt = 0; nt < 4; ++nt) bfr[nt] = *(const bf16x8*)(Bs + nt * 16 * 128 + sw);
      __builtin_amdgcn_s_setprio(1);
#pragma unroll
      for (int mt = 0; mt < 4; ++mt)
#pragma unroll
        for (int nt = 0; nt < 4; ++nt)
          acc[mt][nt] = __builtin_amdgcn_mfma_f32_16x16x32_bf16(af[mt], bfr[nt], acc[mt][nt], 0, 0, 0);
      __builtin_amdgcn_s_setprio(0);
    }
  };
  const int nk = K >> 6;
  __syncthreads();
  ISSUE(0, 0);
  ISSUE(1, 1);
  asm volatile("s_waitcnt vmcnt(6)" ::: "memory");
  __builtin_amdgcn_s_barrier();
  asm volatile("" ::: "memory");
  int bi = 0;
  for (int kt = 0; kt < nk; ++kt) {
    const int b2 = bi >= 1 ? bi - 1 : 2;
    if (kt + 2 < nk) ISSUE(kt + 2, b2);
    COMPUTE(bi);
    if (kt + 2 < nk) asm volatile("s_waitcnt vmcnt(6)" ::: "memory");
    else asm volatile("s_waitcnt vmcnt(0)" ::: "memory");
    asm volatile("s_waitcnt lgkmcnt(0)" ::: "memory");
    __builtin_amdgcn_s_barrier();
    asm volatile("" ::: "memory");
    bi = bi == 2 ? 0 : bi + 1;
  }
}

DI void gemm_glds256(f32x4 (&acc)[8][4], const bf16_t* __restrict__ A, int lda, long arow0,
                     const bf16_t* __restrict__ Bt, int ldb, int K, char* smem) {
  constexpr int A_BYTES = 256 * 128, STAGE = 2 * A_BYTES;
  const int tid = my_tid(), lane = tid & 63, wid = tid >> 6, wm = wid >> 2, wn = wid & 3, g = lane >> 4, r16 = lane & 15;
  const int lrow = tid >> 3, c = (tid & 7) ^ (lrow & 7);
  const bf16_t* pa = A + (arow0 + lrow) * (long)lda + c * 8;
  const bf16_t* pb = Bt + (long)lrow * ldb + c * 8;
  const long a64 = (long)64 * lda, b64 = (long)64 * ldb;
  auto ISSUE = [&](int kt, int bi) {
    char* d = smem + bi * STAGE + tid * 16;
    const int k0 = kt * 64;
    GLDS16(pa + k0, d); GLDS16(pa + a64 + k0, d + 8192); GLDS16(pa + 2 * a64 + k0, d + 16384); GLDS16(pa + 3 * a64 + k0, d + 24576);
    GLDS16(pb + k0, d + A_BYTES); GLDS16(pb + b64 + k0, d + A_BYTES + 8192); GLDS16(pb + 2 * b64 + k0, d + A_BYTES + 16384); GLDS16(pb + 3 * b64 + k0, d + A_BYTES + 24576);
  };
  auto COMPUTE = [&](int bi) {
    const char* As = smem + bi * STAGE + (wm * 128 + r16) * 128;
    const char* Bs = smem + bi * STAGE + A_BYTES + (wn * 64 + r16) * 128;
#pragma unroll
    for (int kk = 0; kk < 2; ++kk) {
      const int sw = ((kk * 4 + g) ^ (r16 & 7)) << 4;
      bf16x8 bfr[4];
#pragma unroll
      for (int nt = 0; nt < 4; ++nt) bfr[nt] = *(const bf16x8*)(Bs + nt * 16 * 128 + sw);
      __builtin_amdgcn_s_setprio(1);
#pragma unroll
      for (int mt = 0; mt < 8; ++mt) {
        const bf16x8 af = *(const bf16x8*)(As + mt * 16 * 128 + sw);
#pragma unroll
        for (int nt = 0; nt < 4; ++nt)
          acc[mt][nt] = __builtin_amdgcn_mfma_f32_16x16x32_bf16(af, bfr[nt], acc[mt][nt], 0, 0, 0);
      }
      __builtin_amdgcn_s_setprio(0);
    }
  };
  const int nk = K >> 6;
  __syncthreads();
  ISSUE(0, 0);
  asm volatile("s_waitcnt vmcnt(0)" ::: "memory");
  __builtin_amdgcn_s_barrier();
  asm volatile("" ::: "memory");
  int bi = 0;
  for (int kt = 0; kt < nk; ++kt) {
    if (kt + 1 < nk) ISSUE(kt + 1, bi ^ 1);
    COMPUTE(bi);
    asm volatile("s_waitcnt vmcnt(0)" ::: "memory");
    asm volatile("s_waitcnt lgkmcnt(0)" ::: "memory");
    __builtin_amdgcn_s_barrier();
    asm volatile("" ::: "memory");
    bi ^= 1;
  }
}
DI void zero_acc256(f32x4 (&acc)[8][4]) {
#pragma unroll
  for (int i = 0; i < 8; ++i)
#pragma unroll
    for (int j = 0; j < 4; ++j) acc[i][j] = (f32x4){0.f, 0.f, 0.f, 0.f};
}

DI bool next_tile(int i, int MTILES, int NTILES, int& mt, int& nt) {
  const int xcd = blockIdx.x & 7, slot = blockIdx.x >> 3, nslot = gridDim.x >> 3;
  const int m_lo = (MTILES * xcd) >> 3, m_hi = (MTILES * (xcd + 1)) >> 3, Mloc = m_hi - m_lo;
  const int q = i * nslot + slot;
  if (q >= Mloc * NTILES) return false;
  const int gidx = q / (4 * NTILES), m0 = gidx * 4;
  const int rows = (Mloc - m0) < 4 ? (Mloc - m0) : 4;
  const int within = q - gidx * 4 * NTILES;
  nt = within / rows; mt = m_lo + m0 + within % rows;
  return true;
}

struct RowPlain { long base; DI long operator()(int r) const { return base + r; } };
struct RowHalo { long rowbase; int t0; int len; DI long operator()(int r) const { int t = t0 + r; return (t >= 0 && t < len) ? rowbase + t : -1; } };

template <int NTW> DI void zero_acc(f32x4 (&acc)[4][NTW]) {
#pragma unroll
  for (int i = 0; i < 4; ++i)
#pragma unroll
    for (int j = 0; j < NTW; ++j) acc[i][j] = (f32x4){0.f, 0.f, 0.f, 0.f};
}

DI void cvt_unit(const float* __restrict__ src, int ldsrc, int srccol0, int k0, bf16_t* __restrict__ dst, int K, int n0, char* smem, bool perm = true) {
  float* T = (float*)smem;
  const int tid = my_tid();
  __syncthreads();
  if (srccol0 >= 0) {
#pragma unroll
    for (int i = 0; i < 8; ++i) {
      int idx = tid + i * 512; int k = idx >> 6, n = idx & 63;
      T[k * 65 + n] = src[(long)(k0 + k) * ldsrc + srccol0 + n];
    }
  }
  __syncthreads();
  int nd = tid >> 3, kc = (tid & 7) * 8; int n = perm ? ((nd & 15) * 4 + (nd >> 4)) : nd;
  uint4 o = make_uint4(0, 0, 0, 0);
  if (srccol0 >= 0) {
    o.x = pack2(T[(kc + 0) * 65 + n], T[(kc + 1) * 65 + n]);
    o.y = pack2(T[(kc + 2) * 65 + n], T[(kc + 3) * 65 + n]);
    o.z = pack2(T[(kc + 4) * 65 + n], T[(kc + 5) * 65 + n]);
    o.w = pack2(T[(kc + 6) * 65 + n], T[(kc + 7) * 65 + n]);
  }
  *(uint4*)(dst + (long)(n0 + nd) * K + k0 + kc) = o;
}

DI void ph_convert(const Params& p, int l, char* smem) {
  for (int u = blockIdx.x; u < 4508; u += gridDim.x) {
    if (u < 832) {
      int gI = u >> 4, kt = u & 15; int n0 = gI * 64; int sc;
      if (n0 < 1280) sc = n0; else if (n0 < 2048) sc = 2496 + (n0 - 1280); else if (n0 < 3264) sc = 1280 + (n0 - 2048); else sc = -1;
      cvt_unit(p.in[6] + (size_t)l * 1024 * 7360, 7360, sc, kt * 64, (bf16_t*)(p.ws + WB_IN), 1024, n0, smem);
    } else if (u < 1856) {
      int v = u - 832; int gI = v >> 4, kt = v & 15;
      cvt_unit(p.in[6] + (size_t)l * 1024 * 7360, 7360, 3264 + gI * 64, kt * 64, (bf16_t*)(p.ws + WB_GATE), 1024, gI * 64, smem);
    } else if (u < 2112) {
      int v = u - 1856; int gI = v >> 2, kt = v & 3; int j = gI >> 4, gg = gI & 15;
      cvt_unit(p.in[33] + ((size_t)l * 4 + j) * 256 * 1024, 1024, gg * 64, kt * 64, (bf16_t*)(p.ws + WB_BR) + (size_t)j * 1024 * 256, 256, gg * 64, smem);
    } else if (u < 2368) {
      int v = u - 2112; int gI = v >> 4, kt = v & 15;
      cvt_unit(p.in[34] + (size_t)l * 1024 * 1024, 1024, gI * 64, kt * 64, (bf16_t*)(p.ws + WB_OUT), 1024, gI * 64, smem);
    } else if (u < 3776) {
      int v = u - 2368; int gI = v >> 4, kt = v & 15; int nt = gI >> 2, q = gI & 3;
      cvt_unit(p.in[37] + (size_t)l * 1024 * 5632, 5632, (q >> 1) * 2816 + nt * 128 + (q & 1) * 64, kt * 64, (bf16_t*)(p.ws + WB_UP), 1024, gI * 64, smem);
    } else if (u < 4480) {
      int v = u - 3776; int gI = v / 44, kt = v % 44;
      cvt_unit(p.in[40] + (size_t)l * 2816 * 1024, 1024, gI * 64, kt * 64, (bf16_t*)(p.ws + WB_DOWN), 2816, gI * 64, smem);
    } else {
      int v = u - 4480;
      if (v < 4) cvt_unit(p.in[19] + (size_t)l * 2 * 64 * 256, 256, v * 64, 0, (bf16_t*)(p.ws + RWW_F), 64, v * 64, smem);
      else if (v < 8) cvt_unit(p.in[19] + (size_t)l * 2 * 64 * 256 + 64 * 256, 256, (v - 4) * 64, 0, (bf16_t*)(p.ws + RWW_B), 64, (v - 4) * 64, smem);
      else if (v < 12) cvt_unit(p.in[21] + (size_t)l * 64 * 256, 256, (v - 8) * 64, 0, (bf16_t*)(p.ws + RWW_A), 64, (v - 8) * 64, smem);
      else if (v < 20) { int w = v - 12; cvt_unit(p.in[22] + (size_t)l * 2 * 128 * 256, 256, (w >> 1) * 64, (w & 1) * 64, (bf16_t*)(p.ws + RWW_GF), 128, (w >> 1) * 64, smem); }
      else { int w = v - 20; cvt_unit(p.in[22] + (size_t)l * 2 * 128 * 256 + 128 * 256, 256, (w >> 1) * 64, (w & 1) * 64, (bf16_t*)(p.ws + RWW_GB), 128, (w >> 1) * 64, smem); }
    }
  }
}

DI void ph_ada(const Params& p, char* smem) {
  float* S = (float*)smem;
  float* R = S + 9 * 1024;
  const int tid = my_tid();
  bool loaded = false;
  for (int u = blockIdx.x; u < 192; u += gridDim.x) {
    if (!loaded) {
      __syncthreads();
      for (int i = tid; i < 9 * 1024; i += NTHR) { float c = i < 8192 ? p.in[1][i] : p.in[3][i - 8192]; S[i] = siluf_(c); }
      loaded = true;
    }
    __syncthreads();
    int l = u / 96, n0 = (u % 96) * 64;
    int col = tid & 63, ks = tid >> 6;
    const float* W = p.in[4] + (size_t)l * 1024 * 6144 + n0 + col;
    float a[9];
#pragma unroll
    for (int b = 0; b < 9; ++b) a[b] = 0.f;
    for (int k = ks * 128; k < ks * 128 + 128; ++k) {
      float w = W[(size_t)k * 6144];
#pragma unroll
      for (int b = 0; b < 9; ++b) a[b] += S[b * 1024 + k] * w;
    }
#pragma unroll
    for (int b = 0; b < 9; ++b) R[(ks * 9 + b) * 64 + col] = a[b];
    __syncthreads();
    for (int i = tid; i < 9 * 64; i += NTHR) {
      int b = i >> 6, c = i & 63; float s = 0.f;
#pragma unroll
      for (int k2 = 0; k2 < 8; ++k2) s += R[(k2 * 9 + b) * 64 + c];
      s += p.in[5][(size_t)l * 6144 + n0 + c];
      ((float*)(p.ws + MISC_MOD))[((size_t)l * 9 + b) * 6144 + n0 + c] = s;
    }
  }
  for (int i = blockIdx.x * NTHR + tid; i < 4096; i += gridDim.x * NTHR) {
    float s, c; sincospif(-(float)i / 4096.f, &s, &c);
    ((float2*)(p.ws + MISC_TW))[i] = make_float2(c, s);
  }
}

DI void hy_rawfilter(const Params& p, int l, int Lf, float* __restrict__ dst, char* smem) {
  float* W1 = (float*)smem;
  float* W2 = W1 + 33 * 64;
  float* Z = W2 + 64 * 64;
  float* H1 = Z + 16 * 36;
  float* H2 = H1 + 16 * 64;
  const int tid = my_tid();
  const float* w1 = p.in[9] + (size_t)l * 33 * 64; const float* b1 = p.in[10] + l * 64;
  const float* w2 = p.in[11] + (size_t)l * 64 * 64; const float* b2 = p.in[12] + l * 64;
  const float* w3 = p.in[13] + (size_t)l * 64 * 1024; const float* fr = p.in[14] + l * 64;
  const int nunits = Lf / 16;
  bool loaded = false;
  for (int u = blockIdx.x; u < nunits; u += gridDim.x) {
    __syncthreads();
    if (!loaded) {
      for (int i = tid; i < 33 * 64; i += NTHR) W1[i] = w1[i];
      for (int i = tid; i < 64 * 64; i += NTHR) W2[i] = w2[i];
      loaded = true;
    }
    const int t0 = u * 16;
    for (int i = tid; i < 16 * 33; i += NTHR) {
      int tt = i / 33, f = i % 33; int t = t0 + tt; float v;
      if (f == 0) v = (float)t / (float)(Lf - 1);
      else {
        int bi = (f - 1) & 15;
        float wv = 6.283185307179586f * (float)t / (float)Lf;
        float fb = 1e-4f + (15.f - 1e-4f) * (float)bi / 15.f;
        float ang = wv * fb;
        v = (f <= 16) ? cosf(ang) : -sinf(ang);
      }
      Z[tt * 36 + f] = v;
    }
    __syncthreads();
    for (int i = tid; i < 16 * 64; i += NTHR) {
      int tt = i >> 6, f = i & 63; float s = b1[f];
      for (int k = 0; k < 33; ++k) s += Z[tt * 36 + k] * W1[k * 64 + f];
      H1[tt * 64 + f] = sinf(fr[f] * s);
    }
    __syncthreads();
    for (int i = tid; i < 16 * 64; i += NTHR) {
      int tt = i >> 6, f = i & 63; float s = b2[f];
      for (int k = 0; k < 64; ++k) s += H1[tt * 64 + k] * W2[k * 64 + f];
      H2[tt * 64 + f] = sinf(fr[f] * s);
    }
    __syncthreads();
    float a0[16], a1[16];
#pragma unroll
    for (int i = 0; i < 16; ++i) { a0[i] = 0.f; a1[i] = 0.f; }
    for (int k = 0; k < 64; ++k) {
      float wa = w3[k * 1024 + tid], wb = w3[k * 1024 + 512 + tid];
#pragma unroll
      for (int i = 0; i < 16; ++i) { float h = H2[i * 64 + k]; a0[i] += h * wa; a1[i] += h * wb; }
    }
    {
      int w = tid & 255;
      float delta = fabsf(-3.0701134573253944f + (-15.350567286626972f + 3.0701134573253944f) * (float)w / 255.f);
#pragma unroll
      for (int i = 0; i < 16; ++i) {
        float tn = (float)(t0 + i) / (float)(Lf - 1);
        float dec = expf(-tn * delta);
        dst[(size_t)(t0 + i) * 1024 + tid] = a0[i] * dec;
        dst[(size_t)(t0 + i) * 1024 + 512 + tid] = a1[i] * dec;
      }
    }
  }
}

DI float2 cmul(float2 a, float2 b) { return make_float2(a.x * b.x - a.y * b.y, a.x * b.y + a.y * b.x); }
DI float2 cmulc(float2 a, float2 b) { return make_float2(a.x * b.x + a.y * b.y, a.y * b.x - a.x * b.y); }
DI float2 cadd(float2 a, float2 b) { return make_float2(a.x + b.x, a.y + b.y); }
DI float2 csub(float2 a, float2 b) { return make_float2(a.x - b.x, a.y - b.y); }
DI void fft_dif(float2* X, const float2* W) {
  const int tid = my_tid();
  for (int ls = 12; ls >= 2; ls -= 2) {
    const int s = 1 << ls, h = s >> 1;
    __syncthreads();
#pragma unroll
    for (int i = 0; i < 4; ++i) {
      const int bf = tid + i * 512; const int j = bf & (h - 1); const int base = ((bf >> (ls - 1)) << (ls + 1)) + j;
      const float2 x0 = X[base], x1 = X[base + h], x2 = X[base + s], x3 = X[base + s + h];
      const float2 w1 = W[s - 1 + j], w2 = W[h - 1 + j];
      const float2 y0 = cadd(x0, x2), y2 = cmul(csub(x0, x2), w1), y1 = cadd(x1, x3);
      const float2 t = cmul(csub(x1, x3), w1); const float2 y3 = make_float2(t.y, -t.x);
      X[base] = cadd(y0, y1); X[base + h] = cmul(csub(y0, y1), w2);
      X[base + s] = cadd(y2, y3); X[base + s + h] = cmul(csub(y2, y3), w2);
    }
  }
  __syncthreads();
#pragma unroll
  for (int i = 0; i < 4; ++i) {
    const int q = tid + i * 512;
    float4 a = *(float4*)(X + 4 * q), b = *(float4*)(X + 4 * q + 2);
    *(float4*)(X + 4 * q) = make_float4(a.x + a.z, a.y + a.w, a.x - a.z, a.y - a.w);
    *(float4*)(X + 4 * q + 2) = make_float4(b.x + b.z, b.y + b.w, b.x - b.z, b.y - b.w);
  }
  __syncthreads();
}
DI void fft_dit_inv(float2* X, const float2* W) {
  const int tid = my_tid();
  __syncthreads();
#pragma unroll
  for (int i = 0; i < 4; ++i) {
    const int q = tid + i * 512;
    float4 a = *(float4*)(X + 4 * q), b = *(float4*)(X + 4 * q + 2);
    *(float4*)(X + 4 * q) = make_float4(a.x + a.z, a.y + a.w, a.x - a.z, a.y - a.w);
    *(float4*)(X + 4 * q + 2) = make_float4(b.x + b.z, b.y + b.w, b.x - b.z, b.y - b.w);
  }
  for (int ls = 2; ls <= 12; ls += 2) {
    const int s = 1 << ls, h = s >> 1;
    __syncthreads();
#pragma unroll
    for (int i = 0; i < 4; ++i) {
      const int bf = tid + i * 512; const int j = bf & (h - 1); const int base = ((bf >> (ls - 1)) << (ls + 1)) + j;
      const float2 e0 = X[base], e1 = X[base + h], e2 = X[base + s], e3 = X[base + s + h];
      const float2 w1 = W[s - 1 + j], w2 = W[h - 1 + j];
      const float2 t1 = cmulc(e1, w2), t3 = cmulc(e3, w2);
      const float2 u0 = cadd(e0, t1), u1 = csub(e0, t1), u2 = cadd(e2, t3), u3 = csub(e2, t3);
      const float2 a2 = cmulc(u2, w1); const float2 q3 = cmulc(u3, w1); const float2 a3 = make_float2(-q3.y, q3.x);
      X[base] = cadd(u0, a2); X[base + s] = csub(u0, a2);
      X[base + h] = cadd(u1, a3); X[base + s + h] = csub(u1, a3);
    }
  }
  __syncthreads();
}
DI void load_twiddles(const Params& p, float2* W) {
  const float2* tw = (const float2*)(p.ws + MISC_TW);
  for (int i = my_tid(); i < 8191; i += NTHR) {
    const int ls = 31 - __clz(i + 1); const int pos = i + 1 - (1 << ls);
    W[i] = tw[pos << (12 - ls)];
  }
}

DI void ph_kf(const Params& p, int l, char* smem) {
  float2* X = (float2*)smem; float2* W = X + 8192; float* red = (float*)(W + 8192);
  const int tid = my_tid(), lane = tid & 63, wid = tid >> 6;
  const float* rawf = (const float*)(p.ws + R_RAWF);
  float2* kf = (float2*)(p.ws + OFF_KF);
  bool tw = false;
  for (int u = blockIdx.x; u < 256; u += gridDim.x) {
    if (!tw) { load_twiddles(p, W); tw = true; }
    const int o = u >> 7, c = (u & 127) * 2;
    float2 fw[8], bw[8]; float sa = 0.f, sb = 0.f;
#pragma unroll
    for (int i = 0; i < 8; ++i) {
      int t = tid + i * 512;
      fw[i] = *(const float2*)(rawf + (size_t)t * 1024 + o * 512 + c);
      bw[i] = *(const float2*)(rawf + (size_t)t * 1024 + o * 512 + 256 + c);
      sa += fabsf(fw[i].x) + fabsf(bw[i].x); sb += fabsf(fw[i].y) + fabsf(bw[i].y);
    }
    sa = wave_sum(sa); sb = wave_sum(sb);
    __syncthreads();
    if (lane == 0) { red[wid * 2] = sa; red[wid * 2 + 1] = sb; }
    __syncthreads();
    float ta = 0.f, tb = 0.f;
#pragma unroll
    for (int w = 0; w < 8; ++w) { ta += red[w * 2]; tb += red[w * 2 + 1]; }
    const float ia = 1.f / ta, ib = 1.f / tb;
#pragma unroll
    for (int i = 0; i < 8; ++i) {
      int t = tid + i * 512;
      X[t] = make_float2(fw[i].x * ia, fw[i].y * ib);
      if (t >= 1) X[8192 - t] = make_float2(bw[i].x * ia, bw[i].y * ib);
      else X[4096] = make_float2(0.f, 0.f);
    }
    fft_dif(X, W);
    float2* ka = kf + (size_t)(o * 256 + c) * 8192; float2* kb = ka + 8192;
#pragma unroll 4
    for (int i = 0; i < 16; ++i) {
      int pidx = tid + i * 512;
      int k = (int)(__brev((unsigned)pidx) >> 19);
      int k2 = (8192 - k) & 8191;
      int p2 = (int)(__brev((unsigned)k2) >> 19);
      float2 c1 = X[pidx], c2 = X[p2];
      float2 A = make_float2(0.5f * (c1.x + c2.x), 0.5f * (c1.y - c2.y));
      float2 Bv = make_float2(0.5f * (c1.y + c2.y), -0.5f * (c1.x - c2.x));
      ka[pidx] = A; kb[pidx] = Bv;
    }
    __syncthreads();
  }
  if (l == 0) {
    const float* rawc = (const float*)(p.ws + MISC_RAWC);
    float* G = (float*)(p.ws + MISC_GCTX);
    for (int u = blockIdx.x * 8 + wid; u < 512; u += gridDim.x * 8) {
      int o = u >> 8, c = u & 255; float f[4], b[4]; float s = 0.f;
#pragma unroll
      for (int i = 0; i < 4; ++i) {
        int t = lane + i * 64;
        f[i] = rawc[(size_t)t * 1024 + o * 512 + c]; b[i] = rawc[(size_t)t * 1024 + o * 512 + 256 + c];
        s += fabsf(f[i]) + fabsf(b[i]);
      }
      s = wave_sum(s); float inv = 1.f / s;
#pragma unroll
      for (int i = 0; i < 4; ++i) {
        int t = lane + i * 64;
        G[(size_t)u * 512 + 256 + t] = f[i] * inv;
        if (t >= 1) G[(size_t)u * 512 + 256 - t] = b[i] * inv;
      }
      if (lane == 0) G[(size_t)u * 512] = 0.f;
    }
  }
}

DI void ph_ln(const float* __restrict__ src_lat, const float* __restrict__ src_ctx, float* dst_lat, float* dst_ctx,
              const float* __restrict__ ag, const float* __restrict__ ab, bf16_t* U, const float* __restrict__ mod, int sh_off, int nrows) {
  const int lane = my_tid() & 63, wid = my_tid() >> 6;
  const int stride = gridDim.x * 8;
  float4 nv[4];
  {
    const int row = blockIdx.x * 8 + wid;
    if (row < nrows) {
      const float* src = row < ML ? src_lat + (size_t)row * D : src_ctx + (size_t)(row - ML) * D;
#pragma unroll
      for (int i = 0; i < 4; ++i) nv[i] = *(const float4*)(src + i * 256 + lane * 4);
    }
  }
  for (int row = blockIdx.x * 8 + wid; row < nrows; row += stride) {
    float4 v[4];
#pragma unroll
    for (int i = 0; i < 4; ++i) v[i] = nv[i];
    if (row + stride < nrows) {
      const int r2 = row + stride;
      const float* src2 = r2 < ML ? src_lat + (size_t)r2 * D : src_ctx + (size_t)(r2 - ML) * D;
#pragma unroll
      for (int i = 0; i < 4; ++i) nv[i] = *(const float4*)(src2 + i * 256 + lane * 4);
    }
    float s = 0.f;
#pragma unroll
    for (int i = 0; i < 4; ++i) s += v[i].x + v[i].y + v[i].z + v[i].w;
    float mu = wave_sum(s) * (1.f / 1024.f);
    float q = 0.f;
#pragma unroll
    for (int i = 0; i < 4; ++i) { v[i].x -= mu; v[i].y -= mu; v[i].z -= mu; v[i].w -= mu; q += v[i].x * v[i].x + v[i].y * v[i].y + v[i].z * v[i].z + v[i].w * v[i].w; }
    float rs = rsqrtf(wave_sum(q) * (1.f / 1024.f) + 1e-6f);
#pragma unroll
    for (int i = 0; i < 4; ++i) { v[i].x *= rs; v[i].y *= rs; v[i].z *= rs; v[i].w *= rs; }
    if (ag) {
      float* dst = row < ML ? dst_lat + (size_t)row * D : dst_ctx + (size_t)(row - ML) * D;
#pragma unroll
      for (int i = 0; i < 4; ++i) {
        float4 gg = *(const float4*)(ag + i * 256 + lane * 4), bb = *(const float4*)(ab + i * 256 + lane * 4);
        v[i].x = v[i].x * gg.x + bb.x; v[i].y = v[i].y * gg.y + bb.y; v[i].z = v[i].z * gg.z + bb.z; v[i].w = v[i].w * gg.w + bb.w;
        *(float4*)(dst + i * 256 + lane * 4) = v[i];
      }
      if (U) {
        s = 0.f;
#pragma unroll
        for (int i = 0; i < 4; ++i) s += v[i].x + v[i].y + v[i].z + v[i].w;
        mu = wave_sum(s) * (1.f / 1024.f); q = 0.f;
#pragma unroll
        for (int i = 0; i < 4; ++i) { v[i].x -= mu; v[i].y -= mu; v[i].z -= mu; v[i].w -= mu; q += v[i].x * v[i].x + v[i].y * v[i].y + v[i].z * v[i].z + v[i].w * v[i].w; }
        rs = rsqrtf(wave_sum(q) * (1.f / 1024.f) + 1e-6f);
#pragma unroll
        for (int i = 0; i < 4; ++i) { v[i].x *= rs; v[i].y *= rs; v[i].z *= rs; v[i].w *= rs; }
      }
    }
    if (U) {
      const float* m = mod + (size_t)mod_idx(row) * 6144 + sh_off;
#pragma unroll
      for (int i = 0; i < 4; ++i) {
        float4 sh = *(const float4*)(m + i * 256 + lane * 4), sc = *(const float4*)(m + 1024 + i * 256 + lane * 4);
        uint2 o; o.x = pack2(v[i].x * (1.f + sc.x) + sh.x, v[i].y * (1.f + sc.y) + sh.y);
        o.y = pack2(v[i].z * (1.f + sc.z) + sh.z, v[i].w * (1.f + sc.w) + sh.w);
        *(uint2*)(U + (size_t)row * D + i * 256 + lane * 4) = o;
      }
    }
  }
}

DI void ph_inproj(const Params& p, const bf16_t* U, char* smem) {
  const bf16_t* Bt = (const bf16_t*)(p.ws + WB_IN);
  const int lane = my_tid() & 63, wid = my_tid() >> 6, wm = wid >> 2, wn = wid & 3, g = lane >> 4, r16 = lane & 15;
  for (int it = 0;; ++it) {
    int mtile, ntile;
    if (!next_tile(it, 136, 13, mtile, ntile)) break;
    f32x4 acc[8][4]; zero_acc256(acc);
    gemm_glds256(acc, U, 1024, (long)mtile * 256, Bt + (size_t)ntile * 256 * 1024, 1024, 1024, smem);
    int b, key0;
    if (mtile < 128) { b = mtile >> 4; key0 = (mtile & 15) * 256; } else { b = mtile - 128; key0 = SL; }
    const int wc0 = ntile * 256 + wn * 64;
    bf16_t* tbase = nullptr; int tcols = 0, tcol0 = 0;
    if (wc0 < 768) { tbase = (bf16_t*)(p.ws + R_PHY); tcols = 768; tcol0 = wc0; }
    else if (wc0 >= 1152 && wc0 < 1280) { tbase = (bf16_t*)(p.ws + R_VTSW); tcols = 128; tcol0 = wc0 - 1152; }
    else if (wc0 >= 1792 && wc0 < 2048) { tbase = (bf16_t*)(p.ws + R_VTDF); tcols = 256; tcol0 = wc0 - 1792; }
    if (tbase) {
#pragma unroll
      for (int mt = 0; mt < 8; ++mt)
#pragma unroll
        for (int nt = 0; nt < 4; ++nt) {
          int col = tcol0 + r16 * 4 + nt;
          int key = key0 + wm * 128 + mt * 16 + g * 4;
          uint2 o; o.x = pack2(acc[mt][nt][0], acc[mt][nt][1]); o.y = pack2(acc[mt][nt][2], acc[mt][nt][3]);
          *(uint2*)(tbase + ((size_t)b * tcols + col) * KEYS + key) = o;
        }
    } else if (wc0 < 3264) {
      bf16_t* rb; int ld, c0;
      if (wc0 < 1152) { rb = (bf16_t*)(p.ws + R_PSW); ld = 384; c0 = wc0 - 768; }
      else if (wc0 < 1792) { rb = (bf16_t*)(p.ws + R_PDF); ld = 512; c0 = wc0 - 1280; }
      else { rb = (bf16_t*)(p.ws + R_PRW); ld = 1216; c0 = wc0 - 2048; }
      const int col = c0 + r16 * 4;
#pragma unroll
      for (int mt = 0; mt < 8; ++mt)
#pragma unroll
        for (int j = 0; j < 4; ++j) {
          size_t row = (size_t)mtile * 256 + wm * 128 + mt * 16 + g * 4 + j;
          uint2 o; o.x = pack2(acc[mt][0][j], acc[mt][1][j]); o.y = pack2(acc[mt][2][j], acc[mt][3][j]);
          *(uint2*)(rb + row * ld + col) = o;
        }
    }
  }
}

DI float hy_conv3(const bf16_t* __restrict__ P, int t, int len, float w0, float w1, float w2, float bias) {
  float a = t >= 1 ? bf2f(P[t - 1]) : 0.f, b = bf2f(P[t]), c = (t + 1 < len) ? bf2f(P[t + 1]) : 0.f;
  return w0 * a + w1 * b + w2 * c + bias;
}
DI void ph_hyena(const Params& p, int l, char* smem) {
  float2* X = (float2*)smem; float2* W = X + 8192;
  const int tid = my_tid();
  const bf16_t* PT = (const bf16_t*)(p.ws + R_PHY);
  const float2* kf = (const float2*)(p.ws + OFF_KF);
  const float* cw = p.in[7] + (size_t)l * 3 * 768; const float* cb = p.in[8] + (size_t)l * 768;
  const float* hb = p.in[15] + (size_t)l * 512;
  bf16_t* Y = (bf16_t*)(p.ws + R_YHY);
  bool tw = false;
  for (int u = blockIdx.x; u < 1024; u += gridDim.x) {
    if (!tw) { load_twiddles(p, W); tw = true; }
    const int bp = u >> 8, c = u & 255; const int b0 = bp * 2, b1 = b0 + 1;
    const bf16_t* P0 = PT + ((size_t)b0 * 768) * KEYS; const bf16_t* P1 = PT + ((size_t)b1 * 768) * KEYS;
    float wv0 = cw[c], wv1 = cw[768 + c], wv2 = cw[1536 + c], bv = cb[c];
    float wa0 = cw[256 + c], wa1 = cw[768 + 256 + c], wa2 = cw[1536 + 256 + c], ba = cb[256 + c];
    float wb0 = cw[512 + c], wb1 = cw[768 + 512 + c], wb2 = cw[1536 + 512 + c], bb = cb[512 + c];
    const float bias0 = hb[c], bias1 = hb[256 + c];
    float2 vv[8];
    __syncthreads();
#pragma unroll
    for (int i = 0; i < 8; ++i) {
      int t = tid + i * 512;
      vv[i].x = hy_conv3(P0 + (size_t)c * KEYS, t, SL, wv0, wv1, wv2, bv);
      vv[i].y = hy_conv3(P1 + (size_t)c * KEYS, t, SL, wv0, wv1, wv2, bv);
      X[t] = vv[i]; X[t + 4096] = make_float2(0.f, 0.f);
    }
    fft_dif(X, W);
    {
      const float2* H = kf + (size_t)c * 8192;
#pragma unroll 4
      for (int i = 0; i < 16; ++i) { int q = tid + i * 512; X[q] = cmul(X[q], H[q]); }
    }
    fft_dit_inv(X, W);
    float2 zz[8];
#pragma unroll
    for (int i = 0; i < 8; ++i) {
      int t = tid + i * 512;
      float2 y = X[t];
      float x1a = hy_conv3(P0 + (size_t)(256 + c) * KEYS, t, SL, wa0, wa1, wa2, ba);
      float x1b = hy_conv3(P1 + (size_t)(256 + c) * KEYS, t, SL, wa0, wa1, wa2, ba);
      zz[i].x = x1a * (y.x * (1.f / 8192.f) + bias0 * vv[i].x);
      zz[i].y = x1b * (y.y * (1.f / 8192.f) + bias0 * vv[i].y);
    }
    __syncthreads();
#pragma unroll
    for (int i = 0; i < 8; ++i) { int t = tid + i * 512; X[t] = zz[i]; X[t + 4096] = make_float2(0.f, 0.f); }
    fft_dif(X, W);
    {
      const float2* H = kf + (size_t)(256 + c) * 8192;
#pragma unroll 4
      for (int i = 0; i < 16; ++i) { int q = tid + i * 512; X[q] = cmul(X[q], H[q]); }
    }
    fft_dit_inv(X, W);
#pragma unroll
    for (int i = 0; i < 8; ++i) {
      int t = tid + i * 512;
      float2 y = X[t];
      float x2a = hy_conv3(P0 + (size_t)(512 + c) * KEYS, t, SL, wb0, wb1, wb2, bb);
      float x2b = hy_conv3(P1 + (size_t)(512 + c) * KEYS, t, SL, wb0, wb1, wb2, bb);
      float oa = x2a * (y.x * (1.f / 8192.f) + bias1 * zz[i].x);
      float ob = x2b * (y.y * (1.f / 8192.f) + bias1 * zz[i].y);
      Y[((size_t)b0 * SL + t) * 256 + c] = (bf16_t)f2bf(oa);
      Y[((size_t)b1 * SL + t) * 256 + c] = (bf16_t)f2bf(ob);
    }
  }
}

DI void ph_hyena_ctx(const Params& p, int l, char* smem) {
  const int tid = my_tid(), lane = tid & 63, wid = tid >> 6;
  float* Zb = (float*)smem + wid * 1024;
  float* Gb = Zb + 256;
  const bf16_t* PT = (const bf16_t*)(p.ws + R_PHY);
  const float* G = (const float*)(p.ws + MISC_GCTX);
  const float* cw = p.in[7] + (size_t)l * 3 * 768; const float* cb = p.in[8] + (size_t)l * 768;
  const float* hb = p.in[15] + (size_t)l * 512;
  bf16_t* Y = (bf16_t*)(p.ws + R_YHY);
  for (int base = blockIdx.x * 8; base < 2048; base += gridDim.x * 8) {
    const int u = base + wid; const int b = u >> 8, c = u & 255;
    const bf16_t* Pb = PT + ((size_t)b * 768) * KEYS + SL;
    float v[4], x1[4], x2[4], zz[4];
#pragma unroll
    for (int i = 0; i < 4; ++i) {
      int t = lane + i * 64;
      v[i] = hy_conv3(Pb + (size_t)c * KEYS, t, CL, cw[c], cw[768 + c], cw[1536 + c], cb[c]);
      x1[i] = hy_conv3(Pb + (size_t)(256 + c) * KEYS, t, CL, cw[256 + c], cw[768 + 256 + c], cw[1536 + 256 + c], cb[256 + c]);
      x2[i] = hy_conv3(Pb + (size_t)(512 + c) * KEYS, t, CL, cw[512 + c], cw[768 + 512 + c], cw[1536 + 512 + c], cb[512 + c]);
    }
    __syncthreads();
#pragma unroll
    for (int i = 0; i < 4; ++i) Zb[lane + i * 64] = v[i];
    for (int i = lane; i < 512; i += 64) Gb[i] = G[(size_t)c * 512 + i];
    __syncthreads();
#pragma unroll
    for (int i = 0; i < 4; ++i) {
      int t = lane + i * 64; float s = 0.f;
      for (int s2 = 0; s2 < 256; ++s2) s += Gb[256 + t - s2] * Zb[s2];
      zz[i] = x1[i] * (s + hb[c] * v[i]);
    }
    __syncthreads();
#pragma unroll
    for (int i = 0; i < 4; ++i) Zb[lane + i * 64] = zz[i];
    for (int i = lane; i < 512; i += 64) Gb[i] = G[(size_t)(256 + c) * 512 + i];
    __syncthreads();
#pragma unroll
    for (int i = 0; i < 4; ++i) {
      int t = lane + i * 64; float s = 0.f;
      for (int s2 = 0; s2 < 256; ++s2) s += Gb[256 + t - s2] * Zb[s2];
      float o = x2[i] * (s + hb[256 + c] * zz[i]);
      Y[((size_t)ML + b * CL + t) * 256 + c] = (bf16_t)f2bf(o);
    }
  }
}

DI void ph_rope(const Params& p, char* smem) {
  float2* T16 = (float2*)smem;
  float2* T8 = T16 + 64 * 16;
  const int tid = my_tid(), lane = tid & 63, wid = tid >> 6;
  __syncthreads();
  for (int i = tid; i < 64 * 16; i += NTHR) {
    int pos = i >> 4, f = i & 15; float inv = powf(10000.f, -(float)f / 16.f); float s, c; sincosf((float)pos * inv, &s, &c);
    T16[i] = make_float2(c, s);
  }
  for (int i = tid; i < 64 * 8; i += NTHR) {
    int pos = i >> 3, f = i & 7; float inv = powf(10000.f, -(float)f / 8.f); float s, c; sincosf((float)pos * inv, &s, &c);
    T8[i] = make_float2(c, s);
  }
  __syncthreads();
  bf16_t* Psw = (bf16_t*)(p.ws + R_PSW); bf16_t* Pdf = (bf16_t*)(p.ws + R_PDF);
  bf16_t* rowbase_ptr; int e1, e2, nf, f0; bool hsel; bool active = lane < 56;
  if (lane < 24) { const int hd = lane >> 2, half = (lane >> 1) & 1, cp = lane & 1; e1 = hd * 64 + half * 32 + cp * 8; e2 = e1 + 16; nf = 16; f0 = cp * 8; hsel = half; }
  else { const int j = lane - 24; const int gi = j >> 1, half = j & 1; e1 = gi * 32 + half * 16; e2 = e1 + 8; nf = 8; f0 = 0; hsel = half; }
  const float2* Tb = (lane < 24) ? T16 : T8;
  for (int row = blockIdx.x * 8 + wid; row < ML; row += gridDim.x * 8) {
    if (active) {
      const int t = row & (SL - 1); const int pos = hsel ? (t & 63) : (t >> 6);
      rowbase_ptr = (lane < 24) ? Psw + (size_t)row * 384 : Pdf + (size_t)row * 512;
      const uint4 u1 = *(const uint4*)(rowbase_ptr + e1), u2 = *(const uint4*)(rowbase_ptr + e2);
      const float4* cs = (const float4*)(Tb + pos * nf + f0);
      const float4 c0 = cs[0], c1 = cs[1], c2 = cs[2], c3 = cs[3];
      const unsigned w1[4] = {u1.x, u1.y, u1.z, u1.w}, w2[4] = {u2.x, u2.y, u2.z, u2.w};
      const float4 cc[4] = {c0, c1, c2, c3};
      unsigned o1[4], o2[4];
#pragma unroll
      for (int i = 0; i < 4; ++i) {
        const float xa = bflo(w1[i]), xb = bfhi(w1[i]), ya = bflo(w2[i]), yb = bfhi(w2[i]);
        o1[i] = pack2(xa * cc[i].x - ya * cc[i].y, xb * cc[i].z - yb * cc[i].w);
        o2[i] = pack2(xa * cc[i].y + ya * cc[i].x, xb * cc[i].w + yb * cc[i].z);
      }
      *(uint4*)(rowbase_ptr + e1) = make_uint4(o1[0], o1[1], o1[2], o1[3]);
      *(uint4*)(rowbase_ptr + e2) = make_uint4(o2[0], o2[1], o2[2], o2[3]);
    }
  }
}

DI float rw_shift(const bf16_t* __restrict__ P, int row, int t, int len, int col, float mu) {
  float c = bf2f(P[(size_t)row * 1216 + col]);
  float a = t >= 1 ? bf2f(P[(size_t)(row - 1) * 1216 + col]) : 0.f;
  float b = t + 1 < len ? bf2f(P[(size_t)(row + 1) * 1216 + col]) : 0.f;
  return c + (0.5f * (a + b) - c) * mu;
}
DI void ph_rwprep(const Params& p, int l, char* smem) {
  constexpr int AST = 912, RST = 1552, ROFF = 32 * AST;
  const int tid = my_tid(), lane = tid & 63, wid = tid >> 6, g = lane >> 4, r16 = lane & 15;
  const int tg = wid >> 2, hd = wid & 3;
  const bf16_t* P = (const bf16_t*)(p.ws + R_PRW);
  const float* mu = p.in[17] + (size_t)l * 1216;
  const float* w0 = p.in[18] + (size_t)l * 512; const float* a0 = p.in[20] + (size_t)l * 256;
  const float* kkw = p.in[23] + (size_t)l * 256; const float* kaw = p.in[24] + (size_t)l * 256;
  bf16_t* S = (bf16_t*)(p.ws + R_STR); bf16_t* Gs = (bf16_t*)(p.ws + R_G);
  const size_t SU = (size_t)MT * 256;
  float w0f[4], w0b[4], a0c[4], kkc[4], kac[4];
#pragma unroll
  for (int nt = 0; nt < 4; ++nt) { int c = hd * 64 + r16 * 4 + nt; w0f[nt] = w0[c]; w0b[nt] = w0[256 + c]; a0c[nt] = a0[c]; kkc[nt] = kkw[c]; kac[nt] = kaw[c]; }
  for (int u = blockIdx.x; u < MT / 32; u += gridDim.x) {
    const int row0 = u * 32; int t0, len;
    if (row0 < ML) { t0 = row0 & (SL - 1); len = SL; } else { t0 = (row0 - ML) & (CL - 1); len = CL; }
    __syncthreads();
    for (int item = tid; item < 32 * 152; item += NTHR) {
      const int tk = item / 152, c8 = item - tk * 152; const int row = row0 + tk, t = t0 + tk;
      const uint4 uc = *(const uint4*)(P + (size_t)row * 1216 + c8 * 8);
      uint4 ua = make_uint4(0, 0, 0, 0), ub = make_uint4(0, 0, 0, 0);
      if (t >= 1) ua = *(const uint4*)(P + (size_t)(row - 1) * 1216 + c8 * 8);
      if (t + 1 < len) ub = *(const uint4*)(P + (size_t)(row + 1) * 1216 + c8 * 8);
      const float4 m0 = *(const float4*)(mu + c8 * 8), m1 = *(const float4*)(mu + c8 * 8 + 4);
      float o[8];
      {
        const unsigned wc[4] = {uc.x, uc.y, uc.z, uc.w}, wa[4] = {ua.x, ua.y, ua.z, ua.w}, wb[4] = {ub.x, ub.y, ub.z, ub.w};
        const float mm[8] = {m0.x, m0.y, m0.z, m0.w, m1.x, m1.y, m1.z, m1.w};
#pragma unroll
        for (int i = 0; i < 4; ++i) {
          float c_lo = bflo(wc[i]), c_hi = bfhi(wc[i]);
          o[2 * i] = c_lo + (0.5f * (bflo(wa[i]) + bflo(wb[i])) - c_lo) * mm[2 * i];
          o[2 * i + 1] = c_hi + (0.5f * (bfhi(wa[i]) + bfhi(wb[i])) - c_hi) * mm[2 * i + 1];
        }
      }
      char* dst;
      if (c8 < 96) dst = smem + ROFF + tk * RST + c8 * 16;
      else {
        const int cc = c8 * 8 - 768;
        if (cc < 128) {
#pragma unroll
          for (int i = 0; i < 8; ++i) o[i] = 1.f - 2.f * __builtin_amdgcn_rcpf(1.f + __expf(2.f * o[i]));
        } else if (cc >= 192) {
#pragma unroll
          for (int i = 0; i < 8; ++i) o[i] = sigmoidf_(o[i]);
        }
        dst = smem + tk * AST + cc * 2;
      }
      uint4 ov; ov.x = pack2(o[0], o[1]); ov.y = pack2(o[2], o[3]); ov.z = pack2(o[4], o[5]); ov.w = pack2(o[6], o[7]);
      *(uint4*)dst = ov;
    }
    __syncthreads();
    f32x4 acc[5][4];
#pragma unroll
    for (int o5 = 0; o5 < 5; ++o5)
#pragma unroll
      for (int nt = 0; nt < 4; ++nt) acc[o5][nt] = (f32x4){0.f, 0.f, 0.f, 0.f};
    const char* Arow = smem + (tg * 16 + r16) * AST + g * 16;
#pragma unroll
    for (int o5 = 0; o5 < 5; ++o5) {
      const int kbase = o5 < 3 ? o5 * 64 : (o5 == 3 ? 192 : 320);
      const int KK = o5 < 3 ? 64 : 128;
      const bf16_t* Wt = (const bf16_t*)(p.ws + (o5 == 0 ? RWW_F : o5 == 1 ? RWW_B : o5 == 2 ? RWW_A : o5 == 3 ? RWW_GF : RWW_GB));
#pragma unroll
      for (int ks = 0; ks < KK / 32; ++ks) {
        const bf16x8 af = *(const bf16x8*)(Arow + (kbase + ks * 32) * 2);
#pragma unroll
        for (int nt = 0; nt < 4; ++nt) {
          const bf16x8 bf = *(const bf16x8*)(Wt + (size_t)(hd * 64 + nt * 16 + r16) * KK + ks * 32 + g * 8);
          acc[o5][nt] = __builtin_amdgcn_mfma_f32_16x16x32_bf16(af, bf, acc[o5][nt], 0, 0, 0);
        }
        if (ks & 1) asm volatile("" ::: "memory");
      }
    }
#pragma unroll
    for (int j = 0; j < 4; ++j) {
      const int tk = tg * 16 + g * 4 + j; const size_t row = (size_t)row0 + tk;
      const char* rk = smem + ROFF + tk * RST;
      const int c0 = hd * 64 + r16 * 4;
      const uint2 ur = *(const uint2*)(rk + c0 * 2), uk = *(const uint2*)(rk + (256 + c0) * 2), uv = *(const uint2*)(rk + (512 + c0) * 2);
      const float rv[4] = {bflo(ur.x), bfhi(ur.x), bflo(ur.y), bfhi(ur.y)};
      const float kv[4] = {bflo(uk.x), bfhi(uk.x), bflo(uk.y), bfhi(uk.y)};
      const float vv[4] = {bflo(uv.x), bfhi(uv.x), bflo(uv.y), bfhi(uv.y)};
      float n2 = 0.f;
#pragma unroll
      for (int nt = 0; nt < 4; ++nt) { float q = kv[nt] * kkc[nt]; n2 += q * q; }
      n2 = sum16(n2);
      const float inv = __builtin_amdgcn_rsqf(fmaxf(n2, 1e-24f));
      float o_kp[4], o_kk[4], o_b[4], o_df[4], o_db[4];
#pragma unroll
      for (int nt = 0; nt < 4; ++nt) {
        const float k = kv[nt];
        const float a = sigmoidf_(a0c[nt] + acc[2][nt][j]);
        const float kk = k * kkc[nt] * inv;
        o_kp[nt] = k * (1.f + (a - 1.f) * kac[nt]);
        o_kk[nt] = kk; o_b[nt] = kk * a;
        const float xf = -(w0f[nt] + acc[0][nt][j]); const float spf = fmaxf(xf, 0.f) + __logf(1.f + __expf(-fabsf(xf)));
        const float xb = -(w0b[nt] + acc[1][nt][j]); const float spb = fmaxf(xb, 0.f) + __logf(1.f + __expf(-fabsf(xb)));
        const float ef = __expf(-spf - 0.5f), eb = __expf(-spb - 0.5f);
        o_df[nt] = 1.f - __expf(-ef); o_db[nt] = 1.f - __expf(-eb);
      }
      const size_t o = row * 256 + c0;
      uint2 w;
      w.x = pack2(rv[0], rv[1]); w.y = pack2(rv[2], rv[3]); *(uint2*)(S + o) = w;
      w.x = pack2(o_kp[0], o_kp[1]); w.y = pack2(o_kp[2], o_kp[3]); *(uint2*)(S + SU + o) = w;
      w.x = pack2(vv[0], vv[1]); w.y = pack2(vv[2], vv[3]); *(uint2*)(S + 2 * SU + o) = w;
      w.x = pack2(o_kk[0], o_kk[1]); w.y = pack2(o_kk[2], o_kk[3]); *(uint2*)(S + 3 * SU + o) = w;
      w.x = pack2(o_b[0], o_b[1]); w.y = pack2(o_b[2], o_b[3]); *(uint2*)(S + 4 * SU + o) = w;
      w.x = pack2(o_df[0], o_df[1]); w.y = pack2(o_df[2], o_df[3]); *(uint2*)(S + 5 * SU + o) = w;
      w.x = pack2(o_db[0], o_db[1]); w.y = pack2(o_db[2], o_db[3]); *(uint2*)(S + 6 * SU + o) = w;
      w.x = pack2(acc[3][0][j], acc[3][1][j]); w.y = pack2(acc[3][2][j], acc[3][3][j]); *(uint2*)(Gs + o) = w;
      w.x = pack2(acc[4][0][j], acc[4][1][j]); w.y = pack2(acc[4][2][j], acc[4][3][j]); *(uint2*)(Gs + SU + o) = w;
    }
  }
}

DI long scan_row(int b, int dir, int s) {
  if (s < CL) return (long)ML + b * CL + (dir ? (CL - 1 - s) : s);
  int t = s - CL; return (long)b * SL + (dir ? (SL - 1 - t) : t);
}
DI float sum8(float v) {
  v += dpp_mov<0xB1>(v);
  v += dpp_mov<0x4E>(v);
  v += dpp_mov<0x141>(v);
  return v;
}
DI void ph_scan(const Params& p, char* smem) {
  const int tid = my_tid(), lane = tid & 63, wid = tid >> 6;
  const bf16_t* S = (const bf16_t*)(p.ws + R_STR);
  const size_t SU = (size_t)MT * 256;
  constexpr int T = 32, NSTEP = CL + SL, NCH = NSTEP / T;
  typedef float f32x2 __attribute__((ext_vector_type(2)));
  for (int u = blockIdx.x; u < 128; u += gridDim.x) {
    const int chain = u >> 1, rg = u & 1; const int dir = chain & 1, bh = chain >> 1, b = bh >> 2, h = bh & 3;
    bf16_t* O = (bf16_t*)(p.ws + (dir ? R_OB : R_OF));
    uint4 q0, q1, q2;
    auto SC_GLOAD = [&](int ci) {
#pragma unroll
      for (int j = 0; j < 3; ++j) {
        int idx = tid + j * 512; int st = idx >> 8, s = (idx & 255) >> 3, ck = idx & 7;
        long row = scan_row(b, dir, ci * T + s);
        int sid = st < 5 ? st : 5 + dir;
        uint4 v = *(const uint4*)(S + sid * SU + row * 256 + h * 64 + ck * 8);
        if (j == 0) q0 = v; else if (j == 1) q1 = v; else q2 = v;
      }
    };
    auto SC_SSTORE = [&](int buf) {
#pragma unroll
      for (int j = 0; j < 3; ++j) {
        int idx = tid + j * 512; int st = idx >> 8;
        uint4 v = j == 0 ? q0 : (j == 1 ? q1 : q2);
        float4 lo = make_float4(bflo(v.x), bfhi(v.x), bflo(v.y), bfhi(v.y));
        float4 hi = make_float4(bflo(v.z), bfhi(v.z), bflo(v.w), bfhi(v.w));
        if (st == 5) { lo.x = 1.f - lo.x; lo.y = 1.f - lo.y; lo.z = 1.f - lo.z; lo.w = 1.f - lo.w; hi.x = 1.f - hi.x; hi.y = 1.f - hi.y; hi.z = 1.f - hi.z; hi.w = 1.f - hi.w; }
        char* base = smem + buf * 49152 + idx * 32;
        *(float4*)(base) = lo; *(float4*)(base + 16) = hi;
      }
    };
    auto FLUSH = [&](int ci) {
      const int s = tid >> 4, part = tid & 15;
      const float2 v = *(const float2*)(smem + 98304 + (ci & 1) * 4096 + s * 128 + part * 8);
      long row = scan_row(b, dir, ci * T + s);
      *(unsigned*)(O + row * 256 + h * 64 + rg * 32 + part * 2) = pack2(v.x, v.y);
    };
    __syncthreads();
    SC_GLOAD(0);
    SC_SSTORE(0);
    __syncthreads();
    f32x2 st0 = {0.f, 0.f}, st1 = {0.f, 0.f}, st2 = {0.f, 0.f}, st3 = {0.f, 0.f};
    const int rsub = lane >> 3, ks = lane & 7;
    const int lrow = (wid & 3) * 8 + rsub;
    const int vrow = rg * 32 + lrow;
    struct Step { f32x2 r[4], k[4], kk[4], b[4], w[4]; float v; };
    auto LOADSTEP = [&](Step& x, const char* B, int s) {
#pragma unroll
      for (int hh = 0; hh < 2; ++hh) {
        const float4 r = *(const float4*)(B + (0 * T + s) * 256 + ks * 32 + hh * 16);
        const float4 k = *(const float4*)(B + (1 * T + s) * 256 + ks * 32 + hh * 16);
        const float4 kk = *(const float4*)(B + (3 * T + s) * 256 + ks * 32 + hh * 16);
        const float4 bb = *(const float4*)(B + (4 * T + s) * 256 + ks * 32 + hh * 16);
        const float4 w = *(const float4*)(B + (5 * T + s) * 256 + ks * 32 + hh * 16);
        x.r[2 * hh] = (f32x2){r.x, r.y}; x.r[2 * hh + 1] = (f32x2){r.z, r.w};
        x.k[2 * hh] = (f32x2){k.x, k.y}; x.k[2 * hh + 1] = (f32x2){k.z, k.w};
        x.kk[2 * hh] = (f32x2){kk.x, kk.y}; x.kk[2 * hh + 1] = (f32x2){kk.z, kk.w};
        x.b[2 * hh] = (f32x2){bb.x, bb.y}; x.b[2 * hh + 1] = (f32x2){bb.z, bb.w};
        x.w[2 * hh] = (f32x2){w.x, w.y}; x.w[2 * hh + 1] = (f32x2){w.z, w.w};
      }
      x.v = *(const float*)(B + (2 * T + s) * 256 + vrow * 4);
    };
    for (int ci = 0; ci < NCH; ++ci) {
      if (ci + 1 < NCH) { SC_GLOAD(ci + 1); }
      if (ci > 0) FLUSH(ci - 1);
      if (wid < 4) {
        const char* B = smem + (ci & 1) * 49152;
        float* ob = (float*)(smem + 98304 + (ci & 1) * 4096);
        Step nx; LOADSTEP(nx, B, 0);
#pragma unroll 2
        for (int s = 0; s < T; ++s) {
          const Step c = nx;
          LOADSTEP(nx, B, s + 1);
          f32x2 pa = st0 * c.kk[0] + st1 * c.kk[1];
          f32x2 pb = st2 * c.kk[2] + st3 * c.kk[3];
          pa = pa + pb;
          float sa = -(pa.x + pa.y);
          sa = sum8(sa);
          const f32x2 sa2 = {sa, sa}; const f32x2 v2 = {c.v, c.v};
          st0 = st0 * c.w[0] + sa2 * c.b[0] + v2 * c.k[0];
          st1 = st1 * c.w[1] + sa2 * c.b[1] + v2 * c.k[1];
          st2 = st2 * c.w[2] + sa2 * c.b[2] + v2 * c.k[2];
          st3 = st3 * c.w[3] + sa2 * c.b[3] + v2 * c.k[3];
          f32x2 oa = st0 * c.r[0] + st1 * c.r[1];
          f32x2 ob2 = st2 * c.r[2] + st3 * c.r[3];
          oa = oa + ob2;
          float o = sum8(oa.x + oa.y);
          if (ks == 0) ob[s * 32 + lrow] = o;
        }
      }
      if (ci + 1 < NCH) { SC_SSTORE((ci + 1) & 1); }
      __syncthreads();
    }
    FLUSH(NCH - 1);
  }
}

template <bool DIFF>
DI void attn_unit(const Params& p, int l, int b, int h, int qrow0, int qpos0, int kb_lo, int kb_hi, int kc_lo, char* smem) {
  const int tid = my_tid(), lane = tid & 63, wid = tid >> 6, g = lane >> 4, r16 = lane & 15;
  const bf16_t* QK = (const bf16_t*)(p.ws + (DIFF ? R_PDF : R_PSW));
  const int ldq = DIFF ? 512 : 384;
  const int qc0 = h * 64;
  const int kc0 = 256 + (DIFF ? h * 64 : (h >> 1) * 64);
  const bf16_t* VT = DIFF ? (const bf16_t*)(p.ws + R_VTDF) + ((size_t)b * 256 + h * 64) * KEYS
                          : (const bf16_t*)(p.ws + R_VTSW) + ((size_t)b * 128 + (h >> 1) * 64) * KEYS;
  const int nblk = (kb_hi - kb_lo) + (68 - kc_lo);
  const float sc = (DIFF ? 0.17677669529663687f : 0.125f) * 1.4426950408889634f;
  bf16x8 qf[2];
  {
    const bf16_t* qp = QK + (size_t)(qrow0 + wid * 16 + r16) * ldq + qc0 + g * 8;
    qf[0] = *(const bf16x8*)(qp); qf[1] = *(const bf16x8*)(qp + 32);
  }
  constexpr int NC = DIFF ? 2 : 1;
  float m[NC], lsum[NC];
  f32x4 O[NC][4];
#pragma unroll
  for (int c = 0; c < NC; ++c) {
    if (DIFF) { m[c] = -1e30f; lsum[c] = 0.f; }
    else { m[c] = p.in[16][l * 4 + h] * 1.4426950408889634f; lsum[c] = (g == 0) ? 1.f : 0.f; }
#pragma unroll
    for (int dt = 0; dt < 4; ++dt) O[c][dt] = (f32x4){0.f, 0.f, 0.f, 0.f};
  }
  const int lr = tid >> 3, lc = tid & 7;
  uint4 rkA, rvA, rkB, rvB;
  rkA = make_uint4(0, 0, 0, 0); rvA = rkA; rkB = rkA; rvB = rkA;
  auto AT_GLOAD = [&](int i, uint4& rk, uint4& rv) {
    int kb = i < (kb_hi - kb_lo) ? kb_lo + i : kc_lo + (i - (kb_hi - kb_lo));
    long krow = kb < 64 ? (long)b * SL + kb * 64 + lr : (long)ML + b * CL + (kb - 64) * 64 + lr;
    rk = *(const uint4*)(QK + krow * ldq + kc0 + lc * 8);
    rv = *(const uint4*)(VT + (size_t)lr * KEYS + kb * 64 + lc * 8);
  };
  auto AT_SSTORE = [&](int buf, const uint4& rk, const uint4& rv) {
    *(uint4*)(smem + buf * 18432 + lr * 128 + ((lc ^ (lr & 7)) << 4)) = rk;
    *(uint4*)(smem + buf * 18432 + 9216 + lr * 144 + lc * 16) = rv;
  };
  __syncthreads();
  AT_GLOAD(0, rkA, rvA);
  AT_SSTORE(0, rkA, rvA);
  if (1 < nblk) AT_GLOAD(1, rkA, rvA);
  if (2 < nblk) AT_GLOAD(2, rkB, rvB);
  lds_barrier();
  const int qpos = qpos0 + wid * 16 + r16;
  for (int i = 0; i < nblk; ++i) {
    const int kb = i < (kb_hi - kb_lo) ? kb_lo + i : kc_lo + (i - (kb_hi - kb_lo));
    const bool masked = (!DIFF) && (kb < 64);
    const char* Kt = smem + (i & 1) * 18432; const char* Vt = Kt + 9216;
    f32x4 S[NC][4];
#pragma unroll
    for (int kt = 0; kt < 4; ++kt) {
      bf16x8 k0 = *(const bf16x8*)(Kt + (kt * 16 + r16) * 128 + ((g ^ (r16 & 7)) << 4));
      bf16x8 k1 = *(const bf16x8*)(Kt + (kt * 16 + r16) * 128 + (((4 + g) ^ (r16 & 7)) << 4));
      if (DIFF) {
        S[0][kt] = __builtin_amdgcn_mfma_f32_16x16x32_bf16(k0, qf[0], (f32x4){0.f, 0.f, 0.f, 0.f}, 0, 0, 0);
        S[NC - 1][kt] = __builtin_amdgcn_mfma_f32_16x16x32_bf16(k1, qf[1], (f32x4){0.f, 0.f, 0.f, 0.f}, 0, 0, 0);
      } else {
        f32x4 t = __builtin_amdgcn_mfma_f32_16x16x32_bf16(k0, qf[0], (f32x4){0.f, 0.f, 0.f, 0.f}, 0, 0, 0);
        S[0][kt] = __builtin_amdgcn_mfma_f32_16x16x32_bf16(k1, qf[1], t, 0, 0, 0);
      }
    }
    bf16x8 pf[NC][2];
#pragma unroll
    for (int c = 0; c < NC; ++c) {
      float mx = -1e30f;
#pragma unroll
      for (int kt = 0; kt < 4; ++kt)
#pragma unroll
        for (int j = 0; j < 4; ++j) {
          float v = S[c][kt][j];
          if (masked) { int kpos = kb * 64 + kt * 16 + g * 4 + j; int dd = kpos - qpos; if (dd > 128 || dd < -128) v = -3e38f; S[c][kt][j] = v; }
          mx = fmaxf(mx, v);
        }
      mx *= sc;
      mx = fmaxf(mx, __shfl_xor(mx, 16)); mx = fmaxf(mx, __shfl_xor(mx, 32));
      const float mn = fmaxf(m[c], mx);
      const bool grow = mn > m[c];
      float ps = 0.f;
      unsigned pk[8];
#pragma unroll
      for (int kt = 0; kt < 4; ++kt) {
        float e0 = __builtin_amdgcn_exp2f(fmaf(S[c][kt][0], sc, -mn)), e1 = __builtin_amdgcn_exp2f(fmaf(S[c][kt][1], sc, -mn));
        float e2 = __builtin_amdgcn_exp2f(fmaf(S[c][kt][2], sc, -mn)), e3 = __builtin_amdgcn_exp2f(fmaf(S[c][kt][3], sc, -mn));
        ps += (e0 + e1) + (e2 + e3);
        pk[kt * 2] = pack2(e0, e1); pk[kt * 2 + 1] = pack2(e2, e3);
      }
      if (__builtin_amdgcn_ballot_w64(grow) != 0ull) {
        const float alpha = __builtin_amdgcn_exp2f(m[c] - mn);
        m[c] = mn;
        lsum[c] *= alpha;
#pragma unroll
        for (int dt = 0; dt < 4; ++dt) { O[c][dt][0] *= alpha; O[c][dt][1] *= alpha; O[c][dt][2] *= alpha; O[c][dt][3] *= alpha; }
      }
      lsum[c] += ps;
      union { unsigned u[4]; bf16x8 v; } cv;
      cv.u[0] = pk[0]; cv.u[1] = pk[1]; cv.u[2] = pk[2]; cv.u[3] = pk[3]; pf[c][0] = cv.v;
      cv.u[0] = pk[4]; cv.u[1] = pk[5]; cv.u[2] = pk[6]; cv.u[3] = pk[7]; pf[c][1] = cv.v;
    }
#pragma unroll
    for (int dt = 0; dt < 4; ++dt)
#pragma unroll
      for (int s2 = 0; s2 < 2; ++s2) {
        union { uint2 u[2]; bf16x8 v; } vf;
        vf.u[0] = *(const uint2*)(Vt + (dt * 16 + r16) * 144 + (2 * s2) * 32 + g * 8);
        vf.u[1] = *(const uint2*)(Vt + (dt * 16 + r16) * 144 + (2 * s2 + 1) * 32 + g * 8);
#pragma unroll
        for (int c = 0; c < NC; ++c) O[c][dt] = __builtin_amdgcn_mfma_f32_16x16x32_bf16(vf.v, pf[c][s2], O[c][dt], 0, 0, 0);
      }
    if (i + 1 < nblk) AT_SSTORE((i + 1) & 1, rkA, rvA);
    rkA = rkB; rvA = rvB;
    if (i + 3 < nblk) AT_GLOAD(i + 3, rkB, rvB);
    lds_barrier();
  }
  float linv[NC];
#pragma unroll
  for (int c = 0; c < NC; ++c) { float t = lsum[c]; t += __shfl_xor(t, 16); t += __shfl_xor(t, 32); linv[c] = 1.f / t; }
  const size_t orow = (size_t)(qrow0 + wid * 16 + r16);
  if (!DIFF) {
    bf16_t* Y = (bf16_t*)(p.ws + R_YSW);
#pragma unroll
    for (int dt = 0; dt < 4; ++dt) {
      uint2 o; o.x = pack2(O[0][dt][0] * linv[0], O[0][dt][1] * linv[0]); o.y = pack2(O[0][dt][2] * linv[0], O[0][dt][3] * linv[0]);
      *(uint2*)(Y + orow * 256 + h * 64 + dt * 16 + g * 4) = o;
    }
  } else {
    const float lam_init = 0.8f - 0.6f * __expf(-0.3f * (float)l);
    float d1 = 0.f, d2 = 0.f;
    if (lane < 32) { d1 = p.in[28][l * 32 + lane] * p.in[29][l * 32 + lane]; d2 = p.in[30][l * 32 + lane] * p.in[31][l * 32 + lane]; }
    d1 = wave_sum(d1); d2 = wave_sum(d2);
    const float lam = expf(d1) - expf(d2) + lam_init;
    float ov[4][4]; float ss = 0.f;
#pragma unroll
    for (int dt = 0; dt < 4; ++dt)
#pragma unroll
      for (int j = 0; j < 4; ++j) { float v = O[0][dt][j] * linv[0] - lam * O[NC - 1][dt][j] * linv[NC - 1]; ov[dt][j] = v; ss += v * v; }
    ss += __shfl_xor(ss, 16); ss += __shfl_xor(ss, 32);
    const float rms = rsqrtf(ss * (1.f / 64.f) + 1e-5f) * (1.f - lam_init);
    const float* sg = p.in[32] + l * 64;
    bf16_t* Y = (bf16_t*)(p.ws + R_YDF);
#pragma unroll
    for (int dt = 0; dt < 4; ++dt) {
      const int d0 = dt * 16 + g * 4;
      uint2 o; o.x = pack2(ov[dt][0] * rms * sg[d0], ov[dt][1] * rms * sg[d0 + 1]); o.y = pack2(ov[dt][2] * rms * sg[d0 + 2], ov[dt][3] * rms * sg[d0 + 3]);
      *(uint2*)(Y + orow * 256 + h * 64 + d0) = o;
    }
  }
}

DI void ph_attn(const Params& p, int l, char* smem) {
  const bool need_ctx = (l == 0);
  const int n_sw = 1024 + (need_ctx ? 64 : 0);
  const int n_df = 1024 + (need_ctx ? 64 : 0);
  unsigned* ctr = (unsigned*)(p.ws + MISC_BAR + 64 + 64 * l);
  volatile int* slot = (volatile int*)(smem + 40960);
  for (;;) {
    __syncthreads();
    if (my_tid() == 0) *slot = (int)__hip_atomic_fetch_add(ctr, 1u, __ATOMIC_RELAXED, __HIP_MEMORY_SCOPE_AGENT);
    __syncthreads();
    const int u = *slot;
    if (u >= n_sw + n_df) break;
    if (u < n_df) {
      if (u < 1024) { int b = u >> 7, h = (u >> 5) & 3, n = u & 31; attn_unit<true>(p, l, b, h, b * SL + n * 128, n * 128, 0, 64, 64, smem); }
      else { int v = u - 1024; int b = v >> 3, h = (v >> 1) & 3, n = v & 1; attn_unit<true>(p, l, b, h, ML + b * CL + n * 128, 0, 0, 0, 64, smem); }
    } else {
      int w = u - n_df;
      if (w < 1024) {
        int b = w >> 7, h = (w >> 5) & 3, n = w & 31;
        int lo = (n - 1) * 2; if (lo < 0) lo = 0; int hi = (n + 2) * 2; if (hi > 64) hi = 64;
        attn_unit<false>(p, l, b, h, b * SL + n * 128, n * 128, lo, hi, 64, smem);
      } else { int v = w - 1024; int b = v >> 3, h = (v >> 1) & 3, n = v & 1; attn_unit<false>(p, l, b, h, ML + b * CL + n * 128, 0, 0, 0, 64, smem); }
    }
  }
}

DI void ph_rwout(const Params& p, int l) {
  const int lane = my_tid() & 63, wid = my_tid() >> 6;
  const bf16_t* S = (const bf16_t*)(p.ws + R_STR); const bf16_t* Gs = (const bf16_t*)(p.ws + R_G);
  const bf16_t* OF = (const bf16_t*)(p.ws + R_OF); const bf16_t* OB = (const bf16_t*)(p.ws + R_OB);
  bf16_t* Y = (bf16_t*)(p.ws + R_YRW);
  const size_t SU = (size_t)MT * 256;
  const float4 rk = *(const float4*)(p.in[25] + (size_t)l * 256 + lane * 4);
  const float4 gam = *(const float4*)(p.in[26] + (size_t)l * 256 + lane * 4);
  const float4 bet = *(const float4*)(p.in[27] + (size_t)l * 256 + lane * 4);
  const int nrows = (l == 0) ? MT : ML;
  for (int row = blockIdx.x * 8 + wid; row < nrows; row += gridDim.x * 8) {
    const size_t o = (size_t)row * 256 + lane * 4;
    uint2 ur = *(const uint2*)(S + o), uk = *(const uint2*)(S + SU + o), uv = *(const uint2*)(S + 2 * SU + o);
    uint2 uf = *(const uint2*)(OF + o), ub = *(const uint2*)(OB + o), ugf = *(const uint2*)(Gs + o), ugb = *(const uint2*)(Gs + SU + o);
    float r[4] = {bflo(ur.x), bfhi(ur.x), bflo(ur.y), bfhi(ur.y)};
    float k[4] = {bflo(uk.x), bfhi(uk.x), bflo(uk.y), bfhi(uk.y)};
    float v[4] = {bflo(uv.x), bfhi(uv.x), bflo(uv.y), bfhi(uv.y)};
    float f[4] = {bflo(uf.x), bfhi(uf.x), bflo(uf.y), bfhi(uf.y)};
    float bb[4] = {bflo(ub.x), bfhi(ub.x), bflo(ub.y), bfhi(ub.y)};
    float gf[4] = {bflo(ugf.x), bfhi(ugf.x), bflo(ugf.y), bfhi(ugf.y)};
    float gb[4] = {bflo(ugb.x), bfhi(ugb.x), bflo(ugb.y), bfhi(ugb.y)};
    const float rkv[4] = {rk.x, rk.y, rk.z, rk.w}; const float ga[4] = {gam.x, gam.y, gam.z, gam.w}; const float be[4] = {bet.x, bet.y, bet.z, bet.w};
    float bon = 0.f, sf = 0.f, sb = 0.f;
#pragma unroll
    for (int i = 0; i < 4; ++i) { bon += r[i] * k[i] * rkv[i]; sf += f[i]; sb += bb[i]; }
    bon = sum16(bon); float muf = sum16(sf) * (1.f / 64.f), mub = sum16(sb) * (1.f / 64.f);
    float qf = 0.f, qb = 0.f;
#pragma unroll
    for (int i = 0; i < 4; ++i) { f[i] -= muf; bb[i] -= mub; qf += f[i] * f[i]; qb += bb[i] * bb[i]; }
    float rsf = rsqrtf(sum16(qf) * (1.f / 64.f) + 64e-5f), rsb = rsqrtf(sum16(qb) * (1.f / 64.f) + 64e-5f);
    float y[4];
#pragma unroll
    for (int i = 0; i < 4; ++i) {
      float bn = bon * v[i];
      y[i] = (f[i] * rsf * ga[i] + be[i] + bn) * gf[i] + (bb[i] * rsb * ga[i] + be[i] + bn) * gb[i];
    }
    uint2 oo; oo.x = pack2(y[0], y[1]); oo.y = pack2(y[2], y[3]);
    *(uint2*)(Y + o) = oo;
  }
}

DI void ph_merge(const Params& p, int l, const bf16_t* U, char* smem) {
  const int lane = my_tid() & 63, wid = my_tid() >> 6, wm = wid >> 1, wn = wid & 1, g = lane >> 4, r16 = lane & 15;
  const int mtiles = (l == 0) ? 136 : 128;
  bf16_t* ACC = (bf16_t*)(p.ws + R_ACC);
  for (int it = 0;; ++it) {
    int mtile, ntile;
    if (!next_tile(it, mtiles, 8, mtile, ntile)) break;
    uint2 accS[4][4];
#pragma unroll
    for (int mt = 0; mt < 4; ++mt)
#pragma unroll
      for (int nt = 0; nt < 4; ++nt) accS[mt][nt] = make_uint2(0u, 0u);
    for (int j = 0; j < 4; ++j) {
      uint2 pb[4][4];
      {
        f32x4 accB[4][4]; zero_acc<4>(accB);
        const size_t yoff = (j == 0) ? R_YHY : (j == 1) ? R_YSW : (j == 2) ? R_YRW : R_YDF;
        gemm_glds(accB, (const bf16_t*)(p.ws + yoff), 256, RowPlain{(long)mtile * 256}, (const bf16_t*)(p.ws + WB_BR) + ((size_t)j * 1024 + ntile * 128) * 256, 256, 256, smem, (const bf16_t*)(p.ws + MISC_ZERO));
#pragma unroll
        for (int mt = 0; mt < 4; ++mt)
#pragma unroll
          for (int nt = 0; nt < 4; ++nt) { pb[mt][nt].x = pack2(accB[mt][nt][0], accB[mt][nt][1]); pb[mt][nt].y = pack2(accB[mt][nt][2], accB[mt][nt][3]); }
      }
      f32x4 accG[4][4]; zero_acc<4>(accG);
      gemm_glds(accG, U, 1024, RowPlain{(long)mtile * 256}, (const bf16_t*)(p.ws + WB_GATE) + ((size_t)j * 1024 + ntile * 128) * 1024, 1024, 1024, smem, (const bf16_t*)(p.ws + MISC_ZERO));
#pragma unroll
      for (int mt = 0; mt < 4; ++mt)
#pragma unroll
        for (int nt = 0; nt < 4; ++nt) {
          float v0 = bflo(accS[mt][nt].x) + sigmoidf_(accG[mt][nt][0]) * bflo(pb[mt][nt].x);
          float v1 = bfhi(accS[mt][nt].x) + sigmoidf_(accG[mt][nt][1]) * bfhi(pb[mt][nt].x);
          float v2 = bflo(accS[mt][nt].y) + sigmoidf_(accG[mt][nt][2]) * bflo(pb[mt][nt].y);
          float v3 = bfhi(accS[mt][nt].y) + sigmoidf_(accG[mt][nt][3]) * bfhi(pb[mt][nt].y);
          accS[mt][nt].x = pack2(v0, v1); accS[mt][nt].y = pack2(v2, v3);
        }
    }
#pragma unroll
    for (int mt = 0; mt < 4; ++mt) {
      const int col = ntile * 128 + wn * 64 + r16 * 4;
      const size_t row = (size_t)mtile * 256 + wm * 64 + mt * 16 + g * 4;
      uint2 o;
      o.x = (accS[mt][0].x & 0xffffu) | (accS[mt][1].x << 16); o.y = (accS[mt][2].x & 0xffffu) | (accS[mt][3].x << 16);
      *(uint2*)(ACC + (row + 0) * 1024 + col) = o;
      o.x = (accS[mt][0].x >> 16) | (accS[mt][1].x & 0xffff0000u); o.y = (accS[mt][2].x >> 16) | (accS[mt][3].x & 0xffff0000u);
      *(uint2*)(ACC + (row + 1) * 1024 + col) = o;
      o.x = (accS[mt][0].y & 0xffffu) | (accS[mt][1].y << 16); o.y = (accS[mt][2].y & 0xffffu) | (accS[mt][3].y << 16);
      *(uint2*)(ACC + (row + 2) * 1024 + col) = o;
      o.x = (accS[mt][0].y >> 16) | (accS[mt][1].y & 0xffff0000u); o.y = (accS[mt][2].y >> 16) | (accS[mt][3].y & 0xffff0000u);
      *(uint2*)(ACC + (row + 3) * 1024 + col) = o;
    }
  }
}

DI void ph_resgemm(const Params& p, int l, const bf16_t* A, int K, const bf16_t* Bt, const float* hsrc_lat, const float* hsrc_ctx, int gate_off, char* smem) {
  const int lane = my_tid() & 63, wid = my_tid() >> 6, wm = wid >> 1, wn = wid & 1, g = lane >> 4, r16 = lane & 15;
  const int mtiles = (l == 0) ? 136 : 128;
  const float* mod = (const float*)(p.ws + MISC_MOD) + (size_t)l * 9 * 6144;
  float* hc = (float*)(p.ws + OFF_HC);
  for (int it = 0;; ++it) {
    int mtile, ntile;
    if (!next_tile(it, mtiles, 8, mtile, ntile)) break;
    f32x4 acc[4][4]; zero_acc<4>(acc);
    gemm_glds(acc, A, K, RowPlain{(long)mtile * 256}, Bt + (size_t)ntile * 128 * K, K, K, smem, (const bf16_t*)(p.ws + MISC_ZERO));
    const int b = mtile < 128 ? (mtile >> 4) : 8;
    const float* gt = mod + (size_t)b * 6144 + gate_off;
    const int col = ntile * 128 + wn * 64 + r16 * 4;
    const float4 gv = *(const float4*)(gt + col);
#pragma unroll
    for (int mt = 0; mt < 4; ++mt)
#pragma unroll
      for (int e = 0; e < 4; ++e) {
        const int row = mtile * 256 + wm * 64 + mt * 16 + g * 4 + e;
        const float* hs; float* hd;
        if (row < ML) { size_t o = (size_t)row * D + col; hs = hsrc_lat + o; hd = p.out + o; }
        else { size_t o = (size_t)(row - ML) * D + col; hs = hsrc_ctx + o; hd = hc + o; }
        const float4 h = *(const float4*)hs;
        float4 r;
        r.x = DN_ALPHA * h.x + gv.x * acc[mt][0][e]; r.y = DN_ALPHA * h.y + gv.y * acc[mt][1][e];
        r.z = DN_ALPHA * h.z + gv.z * acc[mt][2][e]; r.w = DN_ALPHA * h.w + gv.w * acc[mt][3][e];
        *(float4*)hd = r;
      }
  }
}

DI void ph_ffnup(const Params& p, int l, char* smem) {
  const bf16_t* U = (const bf16_t*)(p.ws + R_U);
  const bf16_t* Bt = (const bf16_t*)(p.ws + WB_UP);
  bf16_t* HID = (bf16_t*)(p.ws + R_HID);
  const float* cw = p.in[38] + (size_t)l * 3 * 5632; const float* cb = p.in[39] + (size_t)l * 5632;
  const int tid = my_tid(), lane = tid & 63, wid = tid >> 6, wm = wid >> 2, wn = wid & 3, g = lane >> 4, r16 = lane & 15;
  const int mtiles = (l == 0) ? 144 : 136;
  constexpr int TS = 528;
  for (int it = 0;; ++it) {
    int mtile, ntile;
    if (!next_tile(it, mtiles, 22, mtile, ntile)) break;
    long rowbase; int t0, len, r0, r1;
    if (mtile < 136) { int b = mtile / 17; int tt = mtile % 17; len = SL; rowbase = (long)b * SL; t0 = tt * 254 - 1; r0 = 1; r1 = 254; }
    else { int b = mtile - 136; len = CL; rowbase = (long)ML + b * CL; t0 = 0; r0 = 0; r1 = 255; }
    f32x4 acc[8][4]; zero_acc256(acc);
    gemm_glds256(acc, U, 1024, rowbase + t0, Bt + (size_t)ntile * 256 * 1024, 1024, 1024, smem);
#pragma unroll
    for (int mt = 0; mt < 8; ++mt)
#pragma unroll
      for (int e = 0; e < 4; ++e) {
        uint2 o; o.x = pack2(acc[mt][0][e], acc[mt][1][e]); o.y = pack2(acc[mt][2][e], acc[mt][3][e]);
        *(uint2*)(smem + (wm * 128 + mt * 16 + g * 4 + e) * TS + (wn * 64 + r16 * 4) * 2) = o;
      }
    __syncthreads();
    {
      const int ch = (tid & 31) * 4, rgp = tid >> 5; const int ca = ntile * 128 + ch, cbx = 2816 + ca;
      const float4 wa0 = *(const float4*)(cw + ca), wa1 = *(const float4*)(cw + 5632 + ca), wa2 = *(const float4*)(cw + 2 * 5632 + ca), wab = *(const float4*)(cb + ca);
      const float4 wb0 = *(const float4*)(cw + cbx), wb1 = *(const float4*)(cw + 5632 + cbx), wb2 = *(const float4*)(cw + 2 * 5632 + cbx), wbb = *(const float4*)(cb + cbx);
      for (int r = r0 + rgp; r <= r1; r += 16) {
        const int tok = t0 + r;
        if (tok < len) {
          const char* Tr = smem + r * TS + ch * 2;
          const uint2 z2 = make_uint2(0u, 0u);
          const uint2 ua = *(const uint2*)(Tr), ub = *(const uint2*)(Tr + 256);
          const uint2 pa = tok >= 1 ? *(const uint2*)(Tr - TS) : z2, pb_ = tok >= 1 ? *(const uint2*)(Tr - TS + 256) : z2;
          const uint2 na = tok + 1 < len ? *(const uint2*)(Tr + TS) : z2, nb = tok + 1 < len ? *(const uint2*)(Tr + TS + 256) : z2;
          const float av0 = wa0.x * bflo(pa.x) + wa1.x * bflo(ua.x) + wa2.x * bflo(na.x) + wab.x;
          const float av1 = wa0.y * bfhi(pa.x) + wa1.y * bfhi(ua.x) + wa2.y * bfhi(na.x) + wab.y;
          const float av2 = wa0.z * bflo(pa.y) + wa1.z * bflo(ua.y) + wa2.z * bflo(na.y) + wab.z;
          const float av3 = wa0.w * bfhi(pa.y) + wa1.w * bfhi(ua.y) + wa2.w * bfhi(na.y) + wab.w;
          const float bv0 = wb0.x * bflo(pb_.x) + wb1.x * bflo(ub.x) + wb2.x * bflo(nb.x) + wbb.x;
          const float bv1 = wb0.y * bfhi(pb_.x) + wb1.y * bfhi(ub.x) + wb2.y * bfhi(nb.x) + wbb.y;
          const float bv2 = wb0.z * bflo(pb_.y) + wb1.z * bflo(ub.y) + wb2.z * bflo(nb.y) + wbb.z;
          const float bv3 = wb0.w * bfhi(pb_.y) + wb1.w * bfhi(ub.y) + wb2.w * bfhi(nb.y) + wbb.w;
          uint2 o; o.x = pack2(siluf_(av0) * bv0, siluf_(av1) * bv1); o.y = pack2(siluf_(av2) * bv2, siluf_(av3) * bv3);
          *(uint2*)(HID + (size_t)(rowbase + tok) * 2816 + ca) = o;
        }
      }
    }
  }
}

#ifndef REP_PREP
#define REP_PREP 1
#endif
#ifndef REP_GEMM
#define REP_GEMM 1
#endif
#ifndef REP_HY
#define REP_HY 1
#endif
#ifndef REP_RWP
#define REP_RWP 1
#endif
#ifndef REP_SCAN
#define REP_SCAN 1
#endif
#ifndef REP_ATTN
#define REP_ATTN 1
#endif
#ifndef PH_END
#define PH_END 24
#endif
#define XB_TMO      128
#define XB_XCNT(j)  (256  + 64 * (j))
#define XB_XSUB(j)  (1280 + 64 * (j))
#define XB_XGEN(j)  (2304 + 64 * (j))
#define XB_TOP      3328
#define XB_TOPGEN   3392
#define XCD_BAR_WORDS 3456
#define XB_SPIN_CAP (1u << 22)
DI unsigned xb_ld(unsigned* p) { return __hip_atomic_load(p, __ATOMIC_RELAXED, __HIP_MEMORY_SCOPE_AGENT); }
DI unsigned xb_add(unsigned* p, unsigned v) { return __hip_atomic_fetch_add(p, v, __ATOMIC_RELAXED, __HIP_MEMORY_SCOPE_AGENT); }
DI unsigned xb_xcc_id() { return (unsigned)__builtin_amdgcn_s_getreg((3 << 11) | 20) & 0xFu; }
#define XB_SPIN(cond, bar) do { unsigned _sp = 0; while (cond) { __builtin_amdgcn_s_sleep(1); \
    if ((++_sp & 255u) == 0u) { if (xb_ld(&(bar)[XB_TMO])) break; if (_sp > XB_SPIN_CAP) { atomicAdd(&(bar)[XB_TMO], 1u); break; } } } } while (0)
DI void xcd_barrier_complete(unsigned* bar, unsigned x, unsigned& nloc, unsigned& nx) {
  const unsigned G = gridDim.x;
  unsigned sum, cnt, mine, sp = 0u;
  for (;;) {
    sum = 0u; cnt = 0u; mine = 0u;
#pragma unroll
    for (unsigned j = 0; j < 16; ++j) { const unsigned c = xb_ld(&bar[XB_XCNT(j)]); sum += c; cnt += (c > 0u) ? 1u : 0u; mine = (j == x) ? c : mine; }
    if (sum == G) break;
    __builtin_amdgcn_s_sleep(1);
    if ((++sp & 255u) == 0u) { if (xb_ld(&bar[XB_TMO])) break; if (sp > XB_SPIN_CAP) { atomicAdd(&bar[XB_TMO], 1u); break; } }
  }
  nloc = mine > 0u ? mine : 1u; nx = cnt > 0u ? cnt : 1u;
}
DI void grid_barrier(unsigned* bar, volatile unsigned* st) {
  asm volatile("s_waitcnt vmcnt(0)" ::: "memory");
  __syncthreads();
  if (my_tid() == 0) {
    const unsigned x = xb_xcc_id();
    __builtin_amdgcn_s_waitcnt(0);
    unsigned nloc = st[0], nx = st[1];
    if (nloc == 0u) { xcd_barrier_complete(bar, x, nloc, nx); st[0] = nloc; st[1] = nx; }
    const unsigned old = xb_add(&bar[XB_XSUB(x)], 1u);
    const unsigned gen = old / nloc;
    if (old + 1u == (gen + 1u) * nloc) {
      __builtin_amdgcn_fence(__ATOMIC_RELEASE, "agent");
      asm volatile("s_waitcnt vmcnt(0)" ::: "memory");
      const unsigned og = xb_add(&bar[XB_TOP], 1u);
      const unsigned tg = og / nx;
      if (og + 1u == (tg + 1u) * nx) xb_add(&bar[XB_TOPGEN], 1u);
      else XB_SPIN(xb_ld(&bar[XB_TOPGEN]) == tg, bar);
      __builtin_amdgcn_fence(__ATOMIC_ACQUIRE, "agent");
      xb_add(&bar[XB_XGEN(x)], 1u);
      asm volatile("s_waitcnt vmcnt(0)" ::: "memory");
    } else {
      XB_SPIN(xb_ld(&bar[XB_XGEN(x)]) == gen, bar);
      __builtin_amdgcn_fence(__ATOMIC_ACQUIRE, "agent");
      asm volatile("s_waitcnt vmcnt(0)" ::: "memory");
    }
  }
  __syncthreads();
}
#define SYNC_OR_RET(idx) do { if ((idx) + 1 >= PH_END) return; if ((idx) == 0) { grid.sync(); if (my_tid() == 0) (void)xb_add(&((unsigned*)(p.ws + MISC_XBAR))[XB_XCNT(xb_xcc_id())], 1u); } else grid_barrier((unsigned*)(p.ws + MISC_XBAR), (volatile unsigned*)(smem + 144 * 1024)); } while (0)
template <int l>
DI void run_layer(const Params& p, cg::grid_group& grid, char* smem, unsigned& epoch) {
  const float* mod = (const float*)(p.ws + MISC_MOD) + (size_t)l * 9 * 6144;
  float* hc = (float*)(p.ws + OFF_HC);
  const float* hl_src = (l == 0) ? p.in[0] : p.out;
  const float* hc_src = (l == 0) ? p.in[2] : hc;
  constexpr int B0 = l * 12;
  if (l == 0) {
    ph_convert(p, 0, smem);
    ph_ada(p, smem);
    hy_rawfilter(p, 0, SL, (float*)(p.ws + R_RAWF), smem);
    hy_rawfilter(p, 0, CL, (float*)(p.ws + MISC_RAWC), smem);
    SYNC_OR_RET(B0 + 0);
    ph_kf(p, 0, smem);
    ph_ln(hl_src, hc_src, nullptr, nullptr, nullptr, nullptr, (bf16_t*)p.out, mod, 0, MT);
    SYNC_OR_RET(B0 + 1);
  }
  for (int rep = 0; rep < REP_GEMM; ++rep) ph_inproj(p, l == 0 ? (const bf16_t*)p.out : (const bf16_t*)(p.ws + R_U), smem);
  SYNC_OR_RET(B0 + 2);
  for (int rep = 0; rep < REP_HY; ++rep) {
  if (blockIdx.x == 0 && my_tid() == 0) *(unsigned*)(p.ws + MISC_BAR + 64 + 64 * l) = 0u;
  ph_hyena(p, l, smem);
  if (l == 0) ph_hyena_ctx(p, l, smem);
  }
  ph_rope(p, smem);
  for (int rep = 0; rep < REP_RWP; ++rep) ph_rwprep(p, l, smem);
  SYNC_OR_RET(B0 + 3);
  for (int rep = 0; rep < REP_SCAN; ++rep) ph_scan(p, smem);
  for (int rep = 0; rep < REP_ATTN; ++rep) ph_attn(p, l, smem);
  SYNC_OR_RET(B0 + 4);
  ph_rwout(p, l);
  if (l != 0) ph_ln(hl_src, hc_src, nullptr, nullptr, nullptr, nullptr, (bf16_t*)(p.ws + R_URE), mod, 0, ML);
  SYNC_OR_RET(B0 + 5);
  for (int rep = 0; rep < REP_GEMM; ++rep) ph_merge(p, l, l == 0 ? (const bf16_t*)p.out : (const bf16_t*)(p.ws + R_URE), smem);
  SYNC_OR_RET(B0 + 6);
  ph_resgemm(p, l, (const bf16_t*)(p.ws + R_ACC), 1024, (const bf16_t*)(p.ws + WB_OUT), hl_src, hc_src, 2048, smem);
  if (l == 0) hy_rawfilter(p, 1, SL, (float*)(p.ws + R_RAWF), smem);
  SYNC_OR_RET(B0 + 7);
  ph_ln(p.out, hc, p.out, hc, p.in[35] + (size_t)l * D, p.in[36] + (size_t)l * D, (bf16_t*)(p.ws + R_U), mod, 3072, l == 0 ? MT : ML);
  if (l == 0) ph_kf(p, 1, smem);
  SYNC_OR_RET(B0 + 8);
  for (int rep = 0; rep < REP_GEMM; ++rep) ph_ffnup(p, l, smem);
  SYNC_OR_RET(B0 + 9);
  ph_resgemm(p, l, (const bf16_t*)(p.ws + R_HID), 2816, (const bf16_t*)(p.ws + WB_DOWN), p.out, hc, 5120, smem);
  SYNC_OR_RET(B0 + 10);
  if (l == 0) {
    ph_ln(p.out, hc, p.out, hc, p.in[41], p.in[42], (bf16_t*)(p.ws + R_U), mod + 9 * 6144, 0, MT);
    ph_convert(p, 1, smem);
  } else {
    ph_ln(p.out, hc, p.out, hc, p.in[41] + (size_t)l * D, p.in[42] + (size_t)l * D, nullptr, mod, 0, ML);
  }
  SYNC_OR_RET(B0 + 11);
}

__global__ void __launch_bounds__(NTHR) mega(Params p) {
  extern __shared__ __attribute__((aligned(16))) char smem[];
  cg::grid_group grid = cg::this_grid();
  unsigned epoch = 0;
  if (blockIdx.x == 0) for (int i = my_tid(); i < XCD_BAR_WORDS; i += NTHR) ((unsigned*)(p.ws + MISC_XBAR))[i] = 0u;
  if (my_tid() < 2) ((volatile unsigned*)(smem + 144 * 1024))[my_tid()] = 0u;
  if (blockIdx.x == 0 && my_tid() < 64) *(unsigned*)(p.ws + MISC_ZERO + my_tid() * 4) = 0u;
  run_layer<0>(p, grid, smem, epoch);
  if (PH_END > 12) run_layer<1>(p, grid, smem, epoch);
}

extern "C" void kernel_launch(void* const* d_in, const int* in_sizes, int n_in, void* d_out, int out_size,
                              void* d_ws, size_t ws_size, hipStream_t stream) {
  static int grid_blocks = 0;
  if (!grid_blocks) {
    int dev = 0, cus = 0, per_cu = 0;
    (void)hipGetDevice(&dev);
    (void)hipDeviceGetAttribute(&cus, hipDeviceAttributeMultiprocessorCount, dev);
    (void)hipFuncSetAttribute((const void*)mega, hipFuncAttributeMaxDynamicSharedMemorySize, SMEM_BYTES);
    (void)hipOccupancyMaxActiveBlocksPerMultiprocessor(&per_cu, mega, NTHR, SMEM_BYTES);
    if (per_cu < 1) per_cu = 1;
    if (per_cu > 1) per_cu = 1;
    grid_blocks = cus * per_cu;
  }
  Params p{};
  for (int i = 0; i < 43; ++i) p.in[i] = (const float*)d_in[i];
  p.out = (float*)d_out; p.ws = (char*)d_ws;
  void* args[] = {&p};
  hipError_t e = hipLaunchCooperativeKernel((void*)mega, dim3(grid_blocks), dim3(NTHR), args, SMEM_BYTES, stream);
  if (e != hipSuccess) fprintf(stderr, "cooperative launch failed: %s (grid %d)\n", hipGetErrorString(e), grid_blocks);
}
```

```cpp
#include <hip/hip_runtime.h>
#include <hip/hip_cooperative_groups.h>
#include <cstdio>
#include <cstdint>
namespace cg = cooperative_groups;

#define DI __device__ __forceinline__
typedef unsigned short bf16_t;
typedef short bf16x8 __attribute__((ext_vector_type(8)));
typedef float f32x4 __attribute__((ext_vector_type(4)));

constexpr int D = 1024, NB = 8, SL = 4096, CL = 256;
constexpr int ML = NB * SL, MC = NB * CL, MT = ML + MC;
constexpr int KEYS = SL + CL;
constexpr int NTHR = 512;
constexpr float DN_ALPHA = 1.41421356237f;
constexpr size_t UNIT = (size_t)MT * 512;

constexpr size_t WB_IN = 0;
constexpr size_t WB_GATE = WB_IN + (size_t)3328 * 1024 * 2;
constexpr size_t WB_BR = WB_GATE + (size_t)4096 * 1024 * 2;
constexpr size_t WB_OUT = WB_BR + (size_t)4 * 1024 * 256 * 2;
constexpr size_t WB_UP = WB_OUT + (size_t)1024 * 1024 * 2;
constexpr size_t WB_DOWN = WB_UP + (size_t)5632 * 1024 * 2;
constexpr size_t WB_END = WB_DOWN + (size_t)1024 * 2816 * 2;
constexpr size_t OFF_KF = WB_END;
constexpr size_t OFF_HC = OFF_KF + (size_t)512 * 8192 * 8;
constexpr size_t OFF_MISC = OFF_HC + (size_t)MC * D * 4;
constexpr size_t MISC_MOD = OFF_MISC;
constexpr size_t MISC_TW = MISC_MOD + (size_t)2 * 9 * 6144 * 4;
constexpr size_t MISC_RAWC = MISC_TW + 4096 * 8;
constexpr size_t MISC_GCTX = MISC_RAWC + (size_t)256 * 1024 * 4;
constexpr size_t MISC_RWW = MISC_GCTX + (size_t)512 * 512 * 4;
constexpr size_t RWW_F = MISC_RWW, RWW_B = RWW_F + 256 * 64 * 2, RWW_A = RWW_B + 256 * 64 * 2, RWW_GF = RWW_A + 256 * 64 * 2, RWW_GB = RWW_GF + 256 * 128 * 2;
constexpr size_t MISC_XBAR = OFF_MISC + (size_t)3 * 1024 * 1024;
constexpr size_t OFF_R = OFF_MISC + (size_t)4 * 1024 * 1024;
constexpr size_t MISC_BAR = OFF_R - 256;
constexpr size_t MISC_ZERO = OFF_R - 512;
static_assert(RWW_GB + 256 * 128 * 2 <= MISC_ZERO, "misc overflow");
constexpr size_t R_YHY = OFF_R, R_YSW = OFF_R + UNIT, R_YDF = OFF_R + 2 * UNIT;
constexpr size_t R_PHY = OFF_R + 3 * UNIT;
constexpr size_t R_PSW = OFF_R + 6 * UNIT;
constexpr size_t R_VTSW = R_PSW + (size_t)MT * 384 * 2;
constexpr size_t R_PDF = OFF_R + 8 * UNIT;
constexpr size_t R_VTDF = OFF_R + 10 * UNIT;
constexpr size_t R_PRW = OFF_R + 11 * UNIT;
constexpr size_t R_STR = R_PRW + (size_t)MT * 1216 * 2;
constexpr size_t R_G = R_STR + 7 * UNIT;
constexpr size_t R_END = R_G + 2 * UNIT;
constexpr size_t R_RAWF = OFF_R;
constexpr size_t R_OF = R_PHY, R_OB = R_PHY + UNIT;
constexpr size_t R_URE = R_PSW;
constexpr size_t R_YRW = R_VTDF;
constexpr size_t R_ACC = R_PRW;
constexpr size_t R_U = R_STR;
constexpr size_t R_HID = OFF_R;
static_assert(R_END <= (size_t)512 * 1024 * 1024, "ws overflow");
static_assert((size_t)MT * 2816 * 2 <= 11 * UNIT, "hid");

constexpr int SMEM_BYTES = 144 * 1024 + 64;

struct Params {
  const float* in[43];
  float* out;
  char* ws;
};

DI int my_tid() { int t = (int)__builtin_amdgcn_workitem_id_x(); asm volatile("" : "+v"(t)); return t; }
DI unsigned f2bf(float f) { unsigned u = __float_as_uint(f); u += 0x7fffu + ((u >> 16) & 1u); return u >> 16; }
DI float bf2f(unsigned h) { return __uint_as_float(h << 16); }
typedef __bf16 bf16v2_t __attribute__((ext_vector_type(2)));
typedef float f32v2_t __attribute__((ext_vector_type(2)));
DI unsigned pack2(float lo, float hi) { f32v2_t v = {lo, hi}; bf16v2_t b = __builtin_convertvector(v, bf16v2_t); return __builtin_bit_cast(unsigned, b); }

DI float bflo(unsigned w) { return __uint_as_float(w << 16); }
DI float bfhi(unsigned w) { return __uint_as_float(w & 0xffff0000u); }
DI float sigmoidf_(float x) { return __builtin_amdgcn_rcpf(1.f + __expf(-x)); }
DI float siluf_(float x) { return x * __builtin_amdgcn_rcpf(1.f + __expf(-x)); }
DI float wave_sum(float v) {
#pragma unroll
  for (int o = 32; o >= 1; o >>= 1) v += __shfl_xor(v, o);
  return v;
}
template <int CTRL> DI float dpp_mov(float v) {
  return __int_as_float(__builtin_amdgcn_update_dpp(0, __float_as_int(v), CTRL, 0xf, 0xf, false));
}
DI float sum16(float v) {
  v += dpp_mov<0xB1>(v);
  v += dpp_mov<0x4E>(v);
  v += dpp_mov<0x141>(v);
  v += dpp_mov<0x140>(v);
  return v;
}
DI void lds_barrier() { asm volatile("s_waitcnt lgkmcnt(0)" ::: "memory"); __builtin_amdgcn_s_barrier(); asm volatile("" ::: "memory"); }
DI uint4 sel4(bool z, uint4 v) { return make_uint4(z ? 0u : v.x, z ? 0u : v.y, z ? 0u : v.z, z ? 0u : v.w); }
DI int mod_idx(int row) { return row < ML ? (row >> 12) : 8; }

template <int NTW, bool DEEP, class RowFn>
DI void gemm_main(f32x4 (&acc)[4][NTW], const bf16_t* __restrict__ A, int lda, RowFn rowfn,
                  const bf16_t* __restrict__ Bt, int ldb, int K, char* smem) {
  constexpr int BN = NTW * 32;
  constexpr int A_BYTES = 256 * 128, B_BYTES = BN * 128, STAGE = A_BYTES + B_BYTES;
  constexpr int NBL = BN / 64;
  const int tid = my_tid(), lane = tid & 63, wid = tid >> 6, wm = wid >> 1, wn = wid & 1, g = lane >> 4, r16 = lane & 15;
  const int chunk = tid & 7, lrow = tid >> 3;
  long a0 = rowfn(lrow), a1 = rowfn(lrow + 64), a2 = rowfn(lrow + 128), a3 = rowfn(lrow + 192);
  const long c0 = a0 < 0 ? 0 : a0, c1 = a1 < 0 ? 0 : a1, c2 = a2 < 0 ? 0 : a2, c3 = a3 < 0 ? 0 : a3;
  const bf16_t* Bp = Bt + (long)lrow * ldb + chunk * 8;
  const bf16_t* Ap0 = A + c0 * lda + chunk * 8; const bf16_t* Ap1 = A + c1 * lda + chunk * 8;
  const bf16_t* Ap2 = A + c2 * lda + chunk * 8; const bf16_t* Ap3 = A + c3 * lda + chunk * 8;
  struct Regs { uint4 a0, a1, a2, a3, b0, b1; };
  Regs R0, R1;
  R0.b1 = make_uint4(0, 0, 0, 0); R1.b1 = make_uint4(0, 0, 0, 0);
  auto GLOAD = [&](Regs& R, int k0) {
    R.a0 = *(const uint4*)(Ap0 + k0); R.a1 = *(const uint4*)(Ap1 + k0);
    R.a2 = *(const uint4*)(Ap2 + k0); R.a3 = *(const uint4*)(Ap3 + k0);
    R.b0 = *(const uint4*)(Bp + k0);
    if constexpr (NBL > 1) R.b1 = *(const uint4*)(Bp + (long)64 * ldb + k0);
  };
  auto SSTORE = [&](const Regs& R, int st) {
    char* base = smem + st * STAGE + lrow * 128 + ((chunk ^ (lrow & 7)) << 4);
    *(uint4*)(base) = sel4(a0 < 0, R.a0); *(uint4*)(base + 64 * 128) = sel4(a1 < 0, R.a1);
    *(uint4*)(base + 128 * 128) = sel4(a2 < 0, R.a2); *(uint4*)(base + 192 * 128) = sel4(a3 < 0, R.a3);
    *(uint4*)(base + A_BYTES) = R.b0;
    if constexpr (NBL > 1) *(uint4*)(base + A_BYTES + 64 * 128) = R.b1;
  };
  auto COMPUTE = [&](int st) {
    const char* As = smem + st * STAGE + (wm * 64 + r16) * 128;
    const char* Bs = smem + st * STAGE + A_BYTES + (wn * (NTW * 16) + r16) * 128;
#pragma unroll
    for (int kk = 0; kk < 2; ++kk) {
      const int sw = ((kk * 4 + g) ^ (r16 & 7)) << 4;
      bf16x8 af[4], bfr[NTW];
#pragma unroll
      for (int mt = 0; mt < 4; ++mt) af[mt] = *(const bf16x8*)(As + mt * 16 * 128 + sw);
#pragma unroll
      for (int nt = 0; nt < NTW; ++nt) bfr[nt] = *(const bf16x8*)(Bs + nt * 16 * 128 + sw);
#pragma unroll
      for (int mt = 0; mt < 4; ++mt)
#pragma unroll
        for (int nt = 0; nt < NTW; ++nt)
          acc[mt][nt] = __builtin_amdgcn_mfma_f32_16x16x32_bf16(af[mt], bfr[nt], acc[mt][nt], 0, 0, 0);
    }
  };
  const int nk = K >> 6;
  __syncthreads();
  GLOAD(R0, 0);
  SSTORE(R0, 0);
  if constexpr (DEEP) {
    GLOAD(R0, 64);
    if (nk > 2) GLOAD(R1, 128);
    lds_barrier();
    bf16x8 fa0[4], fb0[NTW], fa1[4], fb1[NTW];
    auto READF = [&](bf16x8 (&fa)[4], bf16x8 (&fb)[NTW], int st, int kk) {
      const int sw = ((kk * 4 + g) ^ (r16 & 7)) << 4;
      const char* As = smem + st * STAGE + (wm * 64 + r16) * 128 + sw;
      const char* Bs = smem + st * STAGE + A_BYTES + (wn * (NTW * 16) + r16) * 128 + sw;
#pragma unroll
      for (int mt = 0; mt < 4; ++mt) fa[mt] = *(const bf16x8*)(As + mt * 16 * 128);
#pragma unroll
      for (int nt = 0; nt < NTW; ++nt) fb[nt] = *(const bf16x8*)(Bs + nt * 16 * 128);
    };
    auto MMA = [&](const bf16x8 (&fa)[4], const bf16x8 (&fb)[NTW]) {
#pragma unroll
      for (int mt = 0; mt < 4; ++mt)
#pragma unroll
        for (int nt = 0; nt < NTW; ++nt)
          acc[mt][nt] = __builtin_amdgcn_mfma_f32_16x16x32_bf16(fa[mt], fb[nt], acc[mt][nt], 0, 0, 0);
    };
    READF(fa0, fb0, 0, 0);
    for (int kt = 0; kt < nk; kt += 2) {
      READF(fa1, fb1, 0, 1);
      MMA(fa0, fb0);
#pragma unroll
      for (int i = 0; i < 4 + NTW; ++i) { __builtin_amdgcn_sched_group_barrier(0x100, 1, 0); __builtin_amdgcn_sched_group_barrier(0x008, 2, 0); }
      __builtin_amdgcn_sched_barrier(0);
      SSTORE(R0, 1);
      if (kt + 3 < nk) GLOAD(R0, (kt + 3) * 64);
      MMA(fa1, fb1);
#pragma unroll
      for (int i = 0; i < 6; ++i) { __builtin_amdgcn_sched_group_barrier(0x200, 1, 0); __builtin_amdgcn_sched_group_barrier(0x020, 1, 0); __builtin_amdgcn_sched_group_barrier(0x008, 2, 0); }
      __builtin_amdgcn_sched_barrier(0);
      lds_barrier();
      READF(fa0, fb0, 1, 0);
      READF(fa1, fb1, 1, 1);
      MMA(fa0, fb0);
#pragma unroll
      for (int i = 0; i < 4 + NTW; ++i) { __builtin_amdgcn_sched_group_barrier(0x100, 1, 0); __builtin_amdgcn_sched_group_barrier(0x008, 2, 0); }
      __builtin_amdgcn_sched_barrier(0);
      if (kt + 2 < nk) SSTORE(R1, 0);
      if (kt + 4 < nk) GLOAD(R1, (kt + 4) * 64);
      MMA(fa1, fb1);
#pragma unroll
      for (int i = 0; i < 6; ++i) { __builtin_amdgcn_sched_group_barrier(0x200, 1, 0); __builtin_amdgcn_sched_group_barrier(0x020, 1, 0); __builtin_amdgcn_sched_group_barrier(0x008, 2, 0); }
      __builtin_amdgcn_sched_barrier(0);
      lds_barrier();
      if (kt + 2 < nk) READF(fa0, fb0, 0, 0);
    }
  } else {
    lds_barrier();
    for (int kt = 0; kt < nk; ++kt) {
      const int st = kt & 1;
      if (kt + 1 < nk) GLOAD(R0, (kt + 1) * 64);
      __builtin_amdgcn_sched_barrier(0);
      COMPUTE(st);
      __builtin_amdgcn_sched_barrier(0);
      if (kt + 1 < nk) SSTORE(R0, st ^ 1);
      lds_barrier();
    }
  }
}

#define GLDS16(gp, lp) __builtin_amdgcn_global_load_lds((const unsigned*)(gp), (unsigned*)(lp), 16, 0, 0)
template <class RowFn>
DI void gemm_glds(f32x4 (&acc)[4][4], const bf16_t* __restrict__ A, int lda, RowFn rowfn,
                  const bf16_t* __restrict__ Bt, int ldb, int K, char* smem, const bf16_t* zrow) {
  constexpr int A_BYTES = 256 * 128, STAGE = A_BYTES + 128 * 128;
  const int tid = my_tid(), lane = tid & 63, wid = tid >> 6, wm = wid >> 1, wn = wid & 1, g = lane >> 4, r16 = lane & 15;
  const int lrow = tid >> 3, c = (tid & 7) ^ (lrow & 7);
  const long a0 = rowfn(lrow), a1 = rowfn(lrow + 64), a2 = rowfn(lrow + 128), a3 = rowfn(lrow + 192);
  const bf16_t* pa0 = (a0 >= 0 ? A + a0 * lda : zrow) + c * 8; const int m0 = a0 >= 0 ? 1 : 0;
  const bf16_t* pa1 = (a1 >= 0 ? A + a1 * lda : zrow) + c * 8; const int m1 = a1 >= 0 ? 1 : 0;
  const bf16_t* pa2 = (a2 >= 0 ? A + a2 * lda : zrow) + c * 8; const int m2 = a2 >= 0 ? 1 : 0;
  const bf16_t* pa3 = (a3 >= 0 ? A + a3 * lda : zrow) + c * 8; const int m3 = a3 >= 0 ? 1 : 0;
  const bf16_t* pb0 = Bt + (long)lrow * ldb + c * 8; const bf16_t* pb1 = pb0 + (long)64 * ldb;
  auto ISSUE = [&](int kt, int bi) {
    char* d = smem + bi * STAGE + tid * 16;
    const int k0 = kt * 64;
    GLDS16(pa0 + k0 * m0, d); GLDS16(pa1 + k0 * m1, d + 8192); GLDS16(pa2 + k0 * m2, d + 16384); GLDS16(pa3 + k0 * m3, d + 24576);
    GLDS16(pb0 + k0, d + A_BYTES); GLDS16(pb1 + k0, d + A_BYTES + 8192);
  };
  auto COMPUTE = [&](int bi) {
    const char* As = smem + bi * STAGE + (wm * 64 + r16) * 128;
    const char* Bs = smem + bi * STAGE + A_BYTES + (wn * 64 + r16) * 128;
#pragma unroll
    for (int kk = 0; kk < 2; ++kk) {
      const int sw = ((kk * 4 + g) ^ (r16 & 7)) << 4;
      bf16x8 af[4], bfr[4];
#pragma unroll
      for (int mt = 0; mt < 4; ++mt) af[mt] = *(const bf16x8*)(As + mt * 16 * 128 + sw);
#pragma unroll
      for (int nt = 0; nt < 4; ++nt) bfr[nt] = *(const bf16x8*)(Bs + nt * 16 * 128 + sw);
      __builtin_amdgcn_s_setprio(1);
#pragma unroll
      for (int mt = 0; mt < 4; ++mt)
#pragma unroll
        for (int nt = 0; nt < 4; ++nt)
          acc[mt][nt] = __builtin_amdgcn_mfma_f32_16x16x32_bf16(af[mt], bfr[nt], acc[mt][nt], 0, 0, 0);
      __builtin_amdgcn_s_setprio(0);
    }
  };
  const int nk = K >> 6;
  __syncthreads();
  ISSUE(0, 0);
  ISSUE(1, 1);
  asm volatile("s_waitcnt vmcnt(6)" ::: "memory");
  __builtin_amdgcn_s_barrier();
  asm volatile("" ::: "memory");
  int bi = 0;
  for (int kt = 0; kt < nk; ++kt) {
    const int b2 = bi >= 1 ? bi - 1 : 2;
    if (kt + 2 < nk) ISSUE(kt + 2, b2);
    COMPUTE(bi);
    if (kt + 2 < nk) asm volatile("s_waitcnt vmcnt(6)" ::: "memory");
    else asm volatile("s_waitcnt vmcnt(0)" ::: "memory");
    asm volatile("s_waitcnt lgkmcnt(0)" ::: "memory");
    __builtin_amdgcn_s_barrier();
    asm volatile("" ::: "memory");
    bi = bi == 2 ? 0 : bi + 1;
  }
}

DI void gemm_glds256(f32x4 (&acc)[8][4], const bf16_t* __restrict__ A, int lda, long arow0,
                     const bf16_t* __restrict__ Bt, int ldb, int K, char* smem) {
  constexpr int A_BYTES = 256 * 128, STAGE = 2 * A_BYTES;
  const int tid = my_tid(), lane = tid & 63, wid = tid >> 6, wm = wid >> 2, wn = wid & 3, g = lane >> 4, r16 = lane & 15;
  const int lrow = tid >> 3, c = (tid & 7) ^ (lrow & 7);
  const bf16_t* pa = A + (arow0 + lrow) * (long)lda + c * 8;
  const bf16_t* pb = Bt + (long)lrow * ldb + c * 8;
  const long a64 = (long)64 * lda, b64 = (long)64 * ldb;
  auto ISSUE = [&](int kt, int bi) {
    char* d = smem + bi * STAGE + tid * 16;
    const int k0 = kt * 64;
    GLDS16(pa + k0, d); GLDS16(pa + a64 + k0, d + 8192); GLDS16(pa + 2 * a64 + k0, d + 16384); GLDS16(pa + 3 * a64 + k0, d + 24576);
    GLDS16(pb + k0, d + A_BYTES); GLDS16(pb + b64 + k0, d + A_BYTES + 8192); GLDS16(pb + 2 * b64 + k0, d + A_BYTES + 16384); GLDS16(pb + 3 * b64 + k0, d + A_BYTES + 24576);
  };
  auto COMPUTE = [&](int bi) {
    const char* As = smem + bi * STAGE + (wm * 128 + r16) * 128;
    const char* Bs = smem + bi * STAGE + A_BYTES + (wn * 64 + r16) * 128;
#pragma unroll
    for (int kk = 0; kk < 2; ++kk) {
      const int sw = ((kk * 4 + g) ^ (r16 & 7)) << 4;
      bf16x8 bfr[4];
#pragma unroll
      for (int nt = 0; nt < 4; ++nt) bfr[nt] = *(const bf16x8*)(Bs + nt * 16 * 128 + sw);
      __builtin_amdgcn_s_setprio(1);
#pragma unroll
      for (int mt = 0; mt < 8; ++mt) {
        const bf16x8 af = *(const bf16x8*)(As + mt * 16 * 128 + sw);
#pragma unroll
        for (int nt = 0; nt < 4; ++nt)
          acc[mt][nt] = __builtin_amdgcn_mfma_f32_16x16x32_bf16(af, bfr[nt], acc[mt][nt], 0, 0, 0);
      }
      __builtin_amdgcn_s_setprio(0);
    }
  };
  const int nk = K >> 6;
  __syncthreads();
  ISSUE(0, 0);
  asm volatile("s_waitcnt vmcnt(0)" ::: "memory");
  __builtin_amdgcn_s_barrier();
  asm volatile("" ::: "memory");
  int bi = 0;
  for (int kt = 0; kt < nk; ++kt) {
    if (kt + 1 < nk) ISSUE(kt + 1, bi ^ 1);
    COMPUTE(bi);
    asm volatile("s_waitcnt vmcnt(0)" ::: "memory");
    asm volatile("s_waitcnt lgkmcnt(0)" ::: "memory");
    __builtin_amdgcn_s_barrier();
    asm volatile("" ::: "memory");
    bi ^= 1;
  }
}
DI void zero_acc256(f32x4 (&acc)[8][4]) {
#pragma unroll
  for (int i = 0; i < 8; ++i)
#pragma unroll
    for (int j = 0; j < 4; ++j) acc[i][j] = (f32x4){0.f, 0.f, 0.f, 0.f};
}

DI bool next_tile(int i, int MTILES, int NTILES, int& mt, int& nt) {
  const int xcd = blockIdx.x & 7, slot = blockIdx.x >> 3, nslot = gridDim.x >> 3;
  const int m_lo = (MTILES * xcd) >> 3, m_hi = (MTILES * (xcd + 1)) >> 3, Mloc = m_hi - m_lo;
  const int q = i * nslot + slot;
  if (q >= Mloc * NTILES) return false;
  const int gidx = q / (4 * NTILES), m0 = gidx * 4;
  const int rows = (Mloc - m0) < 4 ? (Mloc - m0) : 4;
  const int within = q - gidx * 4 * NTILES;
  nt = within / rows; mt = m_lo + m0 + within % rows;
  return true;
}

struct RowPlain { long base; DI long operator()(int r) const { return base + r; } };
struct RowHalo { long rowbase; int t0; int len; DI long operator()(int r) const { int t = t0 + r; return (t >= 0 && t < len) ? rowbase + t : -1; } };

template <int NTW> DI void zero_acc(f32x4 (&acc)[4][NTW]) {
#pragma unroll
  for (int i = 0; i < 4; ++i)
#pragma unroll
    for (int j = 0; j < NTW; ++j) acc[i][j] = (f32x4){0.f, 0.f, 0.f, 0.f};
}

DI void cvt_unit(const float* __restrict__ src, int ldsrc, int srccol0, int k0, bf16_t* __restrict__ dst, int K, int n0, char* smem, bool perm = true) {
  float* T = (float*)smem;
  const int tid = my_tid();
  __syncthreads();
  if (srccol0 >= 0) {
#pragma unroll
    for (int i = 0; i < 8; ++i) {
      int idx = tid + i * 512; int k = idx >> 6, n = idx & 63;
      T[k * 65 + n] = src[(long)(k0 + k) * ldsrc + srccol0 + n];
    }
  }
  __syncthreads();
  int nd = tid >> 3, kc = (tid & 7) * 8; int n = perm ? ((nd & 15) * 4 + (nd >> 4)) : nd;
  uint4 o = make_uint4(0, 0, 0, 0);
  if (srccol0 >= 0) {
    o.x = pack2(T[(kc + 0) * 65 + n], T[(kc + 1) * 65 + n]);
    o.y = pack2(T[(kc + 2) * 65 + n], T[(kc + 3) * 65 + n]);
    o.z = pack2(T[(kc + 4) * 65 + n], T[(kc + 5) * 65 + n]);
    o.w = pack2(T[(kc + 6) * 65 + n], T[(kc + 7) * 65 + n]);
  }
  *(uint4*)(dst + (long)(n0 + nd) * K + k0 + kc) = o;
}

DI void ph_convert(const Params& p, int l, char* smem) {
  for (int u = blockIdx.x; u < 4508; u += gridDim.x) {
    if (u < 832) {
      int gI = u >> 4, kt = u & 15; int n0 = gI * 64; int sc;
      if (n0 < 1280) sc = n0; else if (n0 < 2048) sc = 2496 + (n0 - 1280); else if (n0 < 3264) sc = 1280 + (n0 - 2048); else sc = -1;
      cvt_unit(p.in[6] + (size_t)l * 1024 * 7360, 7360, sc, kt * 64, (bf16_t*)(p.ws + WB_IN), 1024, n0, smem);
    } else if (u < 1856) {
      int v = u - 832; int gI = v >> 4, kt = v & 15;
      cvt_unit(p.in[6] + (size_t)l * 1024 * 7360, 7360, 3264 + gI * 64, kt * 64, (bf16_t*)(p.ws + WB_GATE), 1024, gI * 64, smem);
    } else if (u < 2112) {
      int v = u - 1856; int gI = v >> 2, kt = v & 3; int j = gI >> 4, gg = gI & 15;
      cvt_unit(p.in[33] + ((size_t)l * 4 + j) * 256 * 1024, 1024, gg * 64, kt * 64, (bf16_t*)(p.ws + WB_BR) + (size_t)j * 1024 * 256, 256, gg * 64, smem);
    } else if (u < 2368) {
      int v = u - 2112; int gI = v >> 4, kt = v & 15;
      cvt_unit(p.in[34] + (size_t)l * 1024 * 1024, 1024, gI * 64, kt * 64, (bf16_t*)(p.ws + WB_OUT), 1024, gI * 64, smem);
    } else if (u < 3776) {
      int v = u - 2368; int gI = v >> 4, kt = v & 15; int nt = gI >> 2, q = gI & 3;
      cvt_unit(p.in[37] + (size_t)l * 1024 * 5632, 5632, (q >> 1) * 2816 + nt * 128 + (q & 1) * 64, kt * 64, (bf16_t*)(p.ws + WB_UP), 1024, gI * 64, smem);
    } else if (u < 4480) {
      int v = u - 3776; int gI = v / 44, kt = v % 44;
      cvt_unit(p.in[40] + (size_t)l * 2816 * 1024, 1024, gI * 64, kt * 64, (bf16_t*)(p.ws + WB_DOWN), 2816, gI * 64, smem);
    } else {
      int v = u - 4480;
      if (v < 4) cvt_unit(p.in[19] + (size_t)l * 2 * 64 * 256, 256, v * 64, 0, (bf16_t*)(p.ws + RWW_F), 64, v * 64, smem);
      else if (v < 8) cvt_unit(p.in[19] + (size_t)l * 2 * 64 * 256 + 64 * 256, 256, (v - 4) * 64, 0, (bf16_t*)(p.ws + RWW_B), 64, (v - 4) * 64, smem);
      else if (v < 12) cvt_unit(p.in[21] + (size_t)l * 64 * 256, 256, (v - 8) * 64, 0, (bf16_t*)(p.ws + RWW_A), 64, (v - 8) * 64, smem);
      else if (v < 20) { int w = v - 12; cvt_unit(p.in[22] + (size_t)l * 2 * 128 * 256, 256, (w >> 1) * 64, (w & 1) * 64, (bf16_t*)(p.ws + RWW_GF), 128, (w >> 1) * 64, smem); }
      else { int w = v - 20; cvt_unit(p.in[22] + (size_t)l * 2 * 128 * 256 + 128 * 256, 256, (w >> 1) * 64, (w & 1) * 64, (bf16_t*)(p.ws + RWW_GB), 128, (w >> 1) * 64, smem); }
    }
  }
}

DI void ph_ada(const Params& p, char* smem) {
  float* S = (float*)smem;
  float* R = S + 9 * 1024;
  const int tid = my_tid();
  bool loaded = false;
  for (int u = blockIdx.x; u < 192; u += gridDim.x) {
    if (!loaded) {
      __syncthreads();
      for (int i = tid; i < 9 * 1024; i += NTHR) { float c = i < 8192 ? p.in[1][i] : p.in[3][i - 8192]; S[i] = siluf_(c); }
      loaded = true;
    }
    __syncthreads();
    int l = u / 96, n0 = (u % 96) * 64;
    int col = tid & 63, ks = tid >> 6;
    const float* W = p.in[4] + (size_t)l * 1024 * 6144 + n0 + col;
    float a[9];
#pragma unroll
    for (int b = 0; b < 9; ++b) a[b] = 0.f;
    for (int k = ks * 128; k < ks * 128 + 128; ++k) {
      float w = W[(size_t)k * 6144];
#pragma unroll
      for (int b = 0; b < 9; ++b) a[b] += S[b * 1024 + k] * w;
    }
#pragma unroll
    for (int b = 0; b < 9; ++b) R[(ks * 9 + b) * 64 + col] = a[b];
    __syncthreads();
    for (int i = tid; i < 9 * 64; i += NTHR) {
      int b = i >> 6, c = i & 63; float s = 0.f;
#pragma unroll
      for (int k2 = 0; k2 < 8; ++k2) s += R[(k2 * 9 + b) * 64 + c];
      s += p.in[5][(size_t)l * 6144 + n0 + c];
      ((float*)(p.ws + MISC_MOD))[((size_t)l * 9 + b) * 6144 + n0 + c] = s;
    }
  }
  for (int i = blockIdx.x * NTHR + tid; i < 4096; i += gridDim.x * NTHR) {
    float s, c; sincospif(-(float)i / 4096.f, &s, &c);
    ((float2*)(p.ws + MISC_TW))[i] = make_float2(c, s);
  }
}

DI void hy_rawfilter(const Params& p, int l, int Lf, float* __restrict__ dst, char* smem) {
  float* W1 = (float*)smem;
  float* W2 = W1 + 33 * 64;
  float* Z = W2 + 64 * 64;
  float* H1 = Z + 16 * 36;
  float* H2 = H1 + 16 * 64;
  const int tid = my_tid();
  const float* w1 = p.in[9] + (size_t)l * 33 * 64; const float* b1 = p.in[10] + l * 64;
  const float* w2 = p.in[11] + (size_t)l * 64 * 64; const float* b2 = p.in[12] + l * 64;
  const float* w3 = p.in[13] + (size_t)l * 64 * 1024; const float* fr = p.in[14] + l * 64;
  const int nunits = Lf / 16;
  bool loaded = false;
  for (int u = blockIdx.x; u < nunits; u += gridDim.x) {
    __syncthreads();
    if (!loaded) {
      for (int i = tid; i < 33 * 64; i += NTHR) W1[i] = w1[i];
      for (int i = tid; i < 64 * 64; i += NTHR) W2[i] = w2[i];
      loaded = true;
    }
    const int t0 = u * 16;
    for (int i = tid; i < 16 * 33; i += NTHR) {
      int tt = i / 33, f = i % 33; int t = t0 + tt; float v;
      if (f == 0) v = (float)t / (float)(Lf - 1);
      else {
        int bi = (f - 1) & 15;
        float wv = 6.283185307179586f * (float)t / (float)Lf;
        float fb = 1e-4f + (15.f - 1e-4f) * (float)bi / 15.f;
        float ang = wv * fb;
        v = (f <= 16) ? cosf(ang) : -sinf(ang);
      }
      Z[tt * 36 + f] = v;
    }
    __syncthreads();
    for (int i = tid; i < 16 * 64; i += NTHR) {
      int tt = i >> 6, f = i & 63; float s = b1[f];
      for (int k = 0; k < 33; ++k) s += Z[tt * 36 + k] * W1[k * 64 + f];
      H1[tt * 64 + f] = sinf(fr[f] * s);
    }
    __syncthreads();
    for (int i = tid; i < 16 * 64; i += NTHR) {
      int tt = i >> 6, f = i & 63; float s = b2[f];
      for (int k = 0; k < 64; ++k) s += H1[tt * 64 + k] * W2[k * 64 + f];
      H2[tt * 64 + f] = sinf(fr[f] * s);
    }
    __syncthreads();
    float a0[16], a1[16];
#pragma unroll
    for (int i = 0; i < 16; ++i) { a0[i] = 0.f; a1[i] = 0.f; }
    for (int k = 0; k < 64; ++k) {
      float wa = w3[k * 1024 + tid], wb = w3[k * 1024 + 512 + tid];
#pragma unroll
      for (int i = 0; i < 16; ++i) { float h = H2[i * 64 + k]; a0[i] += h * wa; a1[i] += h * wb; }
    }
    {
      int w = tid & 255;
      float delta = fabsf(-3.0701134573253944f + (-15.350567286626972f + 3.0701134573253944f) * (float)w / 255.f);
#pragma unroll
      for (int i = 0; i < 16; ++i) {
        float tn = (float)(t0 + i) / (float)(Lf - 1);
        float dec = expf(-tn * delta);
        dst[(size_t)(t0 + i) * 1024 + tid] = a0[i] * dec;
        dst[(size_t)(t0 + i) * 1024 + 512 + tid] = a1[i] * dec;
      }
    }
  }
}

DI float2 cmul(float2 a, float2 b) { return make_float2(a.x * b.x - a.y * b.y, a.x * b.y + a.y * b.x); }
DI float2 cmulc(float2 a, float2 b) { return make_float2(a.x * b.x + a.y * b.y, a.y * b.x - a.x * b.y); }
DI float2 cadd(float2 a, float2 b) { return make_float2(a.x + b.x, a.y + b.y); }
DI float2 csub(float2 a, float2 b) { return make_float2(a.x - b.x, a.y - b.y); }
DI void fft_dif(float2* X, const float2* W) {
  const int tid = my_tid();
  for (int ls = 12; ls >= 2; ls -= 2) {
    const int s = 1 << ls, h = s >> 1;
    __syncthreads();
#pragma unroll
    for (int i = 0; i < 4; ++i) {
      const int bf = tid + i * 512; const int j = bf & (h - 1); const int base = ((bf >> (ls - 1)) << (ls + 1)) + j;
      const float2 x0 = X[base], x1 = X[base + h], x2 = X[base + s], x3 = X[base + s + h];
      const float2 w1 = W[s - 1 + j], w2 = W[h - 1 + j];
      const float2 y0 = cadd(x0, x2), y2 = cmul(csub(x0, x2), w1), y1 = cadd(x1, x3);
      const float2 t = cmul(csub(x1, x3), w1); const float2 y3 = make_float2(t.y, -t.x);
      X[base] = cadd(y0, y1); X[base + h] = cmul(csub(y0, y1), w2);
      X[base + s] = cadd(y2, y3); X[base + s + h] = cmul(csub(y2, y3), w2);
    }
  }
  __syncthreads();
#pragma unroll
  for (int i = 0; i < 4; ++i) {
    const int q = tid + i * 512;
    float4 a = *(float4*)(X + 4 * q), b = *(float4*)(X + 4 * q + 2);
    *(float4*)(X + 4 * q) = make_float4(a.x + a.z, a.y + a.w, a.x - a.z, a.y - a.w);
    *(float4*)(X + 4 * q + 2) = make_float4(b.x + b.z, b.y + b.w, b.x - b.z, b.y - b.w);
  }
  __syncthreads();
}
DI void fft_dit_inv(float2* X, const float2* W) {
  const int tid = my_tid();
  __syncthreads();
#pragma unroll
  for (int i = 0; i < 4; ++i) {
    const int q = tid + i * 512;
    float4 a = *(float4*)(X + 4 * q), b = *(float4*)(X + 4 * q + 2);
    *(float4*)(X + 4 * q) = make_float4(a.x + a.z, a.y + a.w, a.x - a.z, a.y - a.w);
    *(float4*)(X + 4 * q + 2) = make_float4(b.x + b.z, b.y + b.w, b.x - b.z, b.y - b.w);
  }
  for (int ls = 2; ls <= 12; ls += 2) {
    const int s = 1 << ls, h = s >> 1;
    __syncthreads();
#pragma unroll
    for (int i = 0; i < 4; ++i) {
      const int bf = tid + i * 512; const int j = bf & (h - 1); const int base = ((bf >> (ls - 1)) << (ls + 1)) + j;
      const float2 e0 = X[base], e1 = X[base + h], e2 = X[base + s], e3 = X[base + s + h];
      const float2 w1 = W[s - 1 + j], w2 = W[h - 1 + j];
      const float2 t1 = cmulc(e1, w2), t3 = cmulc(e3, w2);
      const float2 u0 = cadd(e0, t1), u1 = csub(e0, t1), u2 = cadd(e2, t3), u3 = csub(e2, t3);
      const float2 a2 = cmulc(u2, w1); const float2 q3 = cmulc(u3, w1); const float2 a3 = make_float2(-q3.y, q3.x);
      X[base] = cadd(u0, a2); X[base + s] = csub(u0, a2);
      X[base + h] = cadd(u1, a3); X[base + s + h] = csub(u1, a3);
    }
  }
  __syncthreads();
}
DI void load_twiddles(const Params& p, float2* W) {
  const float2* tw = (const float2*)(p.ws + MISC_TW);
  for (int i = my_tid(); i < 8191; i += NTHR) {
    const int ls = 31 - __clz(i + 1); const int pos = i + 1 - (1 << ls);
    W[i] = tw[pos << (12 - ls)];
  }
}

DI void ph_kf(const Params& p, int l, char* smem) {
  float2* X = (float2*)smem; float2* W = X + 8192; float* red = (float*)(W + 8192);
  const int tid = my_tid(), lane = tid & 63, wid = tid >> 6;
  const float* rawf = (const float*)(p.ws + R_RAWF);
  float2* kf = (float2*)(p.ws + OFF_KF);
  bool tw = false;
  for (int u = blockIdx.x; u < 256; u += gridDim.x) {
    if (!tw) { load_twiddles(p, W); tw = true; }
    const int o = u >> 7, c = (u & 127) * 2;
    float2 fw[8], bw[8]; float sa = 0.f, sb = 0.f;
#pragma unroll
    for (int i = 0; i < 8; ++i) {
      int t = tid + i * 512;
      fw[i] = *(const float2*)(rawf + (size_t)t * 1024 + o * 512 + c);
      bw[i] = *(const float2*)(rawf + (size_t)t * 1024 + o * 512 + 256 + c);
      sa += fabsf(fw[i].x) + fabsf(bw[i].x); sb += fabsf(fw[i].y) + fabsf(bw[i].y);
    }
    sa = wave_sum(sa); sb = wave_sum(sb);
    __syncthreads();
    if (lane == 0) { red[wid * 2] = sa; red[wid * 2 + 1] = sb; }
    __syncthreads();
    float ta = 0.f, tb = 0.f;
#pragma unroll
    for (int w = 0; w < 8; ++w) { ta += red[w * 2]; tb += red[w * 2 + 1]; }
    const float ia = 1.f / ta, ib = 1.f / tb;
#pragma unroll
    for (int i = 0; i < 8; ++i) {
      int t = tid + i * 512;
      X[t] = make_float2(fw[i].x * ia, fw[i].y * ib);
      if (t >= 1) X[8192 - t] = make_float2(bw[i].x * ia, bw[i].y * ib);
      else X[4096] = make_float2(0.f, 0.f);
    }
    fft_dif(X, W);
    float2* ka = kf + (size_t)(o * 256 + c) * 8192; float2* kb = ka + 8192;
#pragma unroll 4
    for (int i = 0; i < 16; ++i) {
      int pidx = tid + i * 512;
      int k = (int)(__brev((unsigned)pidx) >> 19);
      int k2 = (8192 - k) & 8191;
      int p2 = (int)(__brev((unsigned)k2) >> 19);
      float2 c1 = X[pidx], c2 = X[p2];
      float2 A = make_float2(0.5f * (c1.x + c2.x), 0.5f * (c1.y - c2.y));
      float2 Bv = make_float2(0.5f * (c1.y + c2.y), -0.5f * (c1.x - c2.x));
      ka[pidx] = A; kb[pidx] = Bv;
    }
    __syncthreads();
  }
  if (l == 0) {
    const float* rawc = (const float*)(p.ws + MISC_RAWC);
    float* G = (float*)(p.ws + MISC_GCTX);
    for (int u = blockIdx.x * 8 + wid; u < 512; u += gridDim.x * 8) {
      int o = u >> 8, c = u & 255; float f[4], b[4]; float s = 0.f;
#pragma unroll
      for (int i = 0; i < 4; ++i) {
        int t = lane + i * 64;
        f[i] = rawc[(size_t)t * 1024 + o * 512 + c]; b[i] = rawc[(size_t)t * 1024 + o * 512 + 256 + c];
        s += fabsf(f[i]) + fabsf(b[i]);
      }
      s = wave_sum(s); float inv = 1.f / s;
#pragma unroll
      for (int i = 0; i < 4; ++i) {
        int t = lane + i * 64;
        G[(size_t)u * 512 + 256 + t] = f[i] * inv;
        if (t >= 1) G[(size_t)u * 512 + 256 - t] = b[i] * inv;
      }
      if (lane == 0) G[(size_t)u * 512] = 0.f;
    }
  }
}

DI void ph_ln(const float* __restrict__ src_lat, const float* __restrict__ src_ctx, float* dst_lat, float* dst_ctx,
              const float* __restrict__ ag, const float* __restrict__ ab, bf16_t* U, const float* __restrict__ mod, int sh_off, int nrows) {
  const int lane = my_tid() & 63, wid = my_tid() >> 6;
  const int stride = gridDim.x * 8;
  float4 nv[4];
  {
    const int row = blockIdx.x * 8 + wid;
    if (row < nrows) {
      const float* src = row < ML ? src_lat + (size_t)row * D : src_ctx + (size_t)(row - ML) * D;
#pragma unroll
      for (int i = 0; i < 4; ++i) nv[i] = *(const float4*)(src + i * 256 + lane * 4);
    }
  }
  for (int row = blockIdx.x * 8 + wid; row < nrows; row += stride) {
    float4 v[4];
#pragma unroll
    for (int i = 0; i < 4; ++i) v[i] = nv[i];
    if (row + stride < nrows) {
      const int r2 = row + stride;
      const float* src2 = r2 < ML ? src_lat + (size_t)r2 * D : src_ctx + (size_t)(r2 - ML) * D;
#pragma unroll
      for (int i = 0; i < 4; ++i) nv[i] = *(const float4*)(src2 + i * 256 + lane * 4);
    }
    float s = 0.f;
#pragma unroll
    for (int i = 0; i < 4; ++i) s += v[i].x + v[i].y + v[i].z + v[i].w;
    float mu = wave_sum(s) * (1.f / 1024.f);
    float q = 0.f;
#pragma unroll
    for (int i = 0; i < 4; ++i) { v[i].x -= mu; v[i].y -= mu; v[i].z -= mu; v[i].w -= mu; q += v[i].x * v[i].x + v[i].y * v[i].y + v[i].z * v[i].z + v[i].w * v[i].w; }
    float rs = rsqrtf(wave_sum(q) * (1.f / 1024.f) + 1e-6f);
#pragma unroll
    for (int i = 0; i < 4; ++i) { v[i].x *= rs; v[i].y *= rs; v[i].z *= rs; v[i].w *= rs; }
    if (ag) {
      float* dst = row < ML ? dst_lat + (size_t)row * D : dst_ctx + (size_t)(row - ML) * D;
#pragma unroll
      for (int i = 0; i < 4; ++i) {
        float4 gg = *(const float4*)(ag + i * 256 + lane * 4), bb = *(const float4*)(ab + i * 256 + lane * 4);
        v[i].x = v[i].x * gg.x + bb.x; v[i].y = v[i].y * gg.y + bb.y; v[i].z = v[i].z * gg.z + bb.z; v[i].w = v[i].w * gg.w + bb.w;
        *(float4*)(dst + i * 256 + lane * 4) = v[i];
      }
      if (U) {
        s = 0.f;
#pragma unroll
        for (int i = 0; i < 4; ++i) s += v[i].x + v[i].y + v[i].z + v[i].w;
        mu = wave_sum(s) * (1.f / 1024.f); q = 0.f;
#pragma unroll
        for (int i = 0; i < 4; ++i) { v[i].x -= mu; v[i].y -= mu; v[i].z -= mu; v[i].w -= mu; q += v[i].x * v[i].x + v[i].y * v[i].y + v[i].z * v[i].z + v[i].w * v[i].w; }
        rs = rsqrtf(wave_sum(q) * (1.f / 1024.f) + 1e-6f);
#pragma unroll
        for (int i = 0; i < 4; ++i) { v[i].x *= rs; v[i].y *= rs; v[i].z *= rs; v[i].w *= rs; }
      }
    }
    if (U) {
      const float* m = mod + (size_t)mod_idx(row) * 6144 + sh_off;
#pragma unroll
      for (int i = 0; i < 4; ++i) {
        float4 sh = *(const float4*)(m + i * 256 + lane * 4), sc = *(const float4*)(m + 1024 + i * 256 + lane * 4);
        uint2 o; o.x = pack2(v[i].x * (1.f + sc.x) + sh.x, v[i].y * (1.f + sc.y) + sh.y);
        o.y = pack2(v[i].z * (1.f + sc.z) + sh.z, v[i].w * (1.f + sc.w) + sh.w);
        *(uint2*)(U + (size_t)row * D + i * 256 + lane * 4) = o;
      }
    }
  }
}

DI void ph_inproj(const Params& p, const bf16_t* U, char* smem) {
  const bf16_t* Bt = (const bf16_t*)(p.ws + WB_IN);
  const int lane = my_tid() & 63, wid = my_tid() >> 6, wm = wid >> 2, wn = wid & 3, g = lane >> 4, r16 = lane & 15;
  for (int it = 0;; ++it) {
    int mtile, ntile;
    if (!next_tile(it, 136, 13, mtile, ntile)) break;
    f32x4 acc[8][4]; zero_acc256(acc);
    gemm_glds256(acc, U, 1024, (long)mtile * 256, Bt + (size_t)ntile * 256 * 1024, 1024, 1024, smem);
    int b, key0;
    if (mtile < 128) { b = mtile >> 4; key0 = (mtile & 15) * 256; } else { b = mtile - 128; key0 = SL; }
    const int wc0 = ntile * 256 + wn * 64;
    bf16_t* tbase = nullptr; int tcols = 0, tcol0 = 0;
    if (wc0 < 768) { tbase = (bf16_t*)(p.ws + R_PHY); tcols = 768; tcol0 = wc0; }
    else if (wc0 >= 1152 && wc0 < 1280) { tbase = (bf16_t*)(p.ws + R_VTSW); tcols = 128; tcol0 = wc0 - 1152; }
    else if (wc0 >= 1792 && wc0 < 2048) { tbase = (bf16_t*)(p.ws + R_VTDF); tcols = 256; tcol0 = wc0 - 1792; }
    if (tbase) {
#pragma unroll
      for (int mt = 0; mt < 8; ++mt)
#pragma unroll
        for (int nt = 0; nt < 4; ++nt) {
          int col = tcol0 + r16 * 4 + nt;
          int key = key0 + wm * 128 + mt * 16 + g * 4;
          uint2 o; o.x = pack2(acc[mt][nt][0], acc[mt][nt][1]); o.y = pack2(acc[mt][nt][2], acc[mt][nt][3]);
          *(uint2*)(tbase + ((size_t)b * tcols + col) * KEYS + key) = o;
        }
    } else if (wc0 < 3264) {
      bf16_t* rb; int ld, c0;
      if (wc0 < 1152) { rb = (bf16_t*)(p.ws + R_PSW); ld = 384; c0 = wc0 - 768; }
      else if (wc0 < 1792) { rb = (bf16_t*)(p.ws + R_PDF); ld = 512; c0 = wc0 - 1280; }
      else { rb = (bf16_t*)(p.ws + R_PRW); ld = 1216; c0 = wc0 - 2048; }
      const int col = c0 + r16 * 4;
#pragma unroll
      for (int mt = 0; mt < 8; ++mt)
#pragma unroll
        for (int j = 0; j < 4; ++j) {
          size_t row = (size_t)mtile * 256 + wm * 128 + mt * 16 + g * 4 + j;
          uint2 o; o.x = pack2(acc[mt][0][j], acc[mt][1][j]); o.y = pack2(acc[mt][2][j], acc[mt][3][j]);
          *(uint2*)(rb + row * ld + col) = o;
        }
    }
  }
}

DI float hy_conv3(const bf16_t* __restrict__ P, int t, int len, float w0, float w1, float w2, float bias) {
  float a = t >= 1 ? bf2f(P[t - 1]) : 0.f, b = bf2f(P[t]), c = (t + 1 < len) ? bf2f(P[t + 1]) : 0.f;
  return w0 * a + w1 * b + w2 * c + bias;
}
DI void hy_conv8(const bf16_t* __restrict__ P, int tb, int len, float w0, float w1, float w2, float bias, float (&out)[8]) {
  const uint4 u = *(const uint4*)(P + tb);
  float x[10];
  x[0] = tb >= 1 ? bf2f(P[tb - 1]) : 0.f;
  x[1] = bflo(u.x); x[2] = bfhi(u.x); x[3] = bflo(u.y); x[4] = bfhi(u.y); x[5] = bflo(u.z); x[6] = bfhi(u.z); x[7] = bflo(u.w); x[8] = bfhi(u.w);
  x[9] = (tb + 8 < len) ? bf2f(P[tb + 8]) : 0.f;
#pragma unroll
  for (int i = 0; i < 8; ++i) out[i] = w0 * x[i] + w1 * x[i + 1] + w2 * x[i + 2] + bias;
}
DI void ph_hyena(const Params& p, int l, char* smem) {
  float2* X = (float2*)smem; float2* W = X + 8192;
  const int tid = my_tid();
  const int tb = tid * 8;
  const bf16_t* PT = (const bf16_t*)(p.ws + R_PHY);
  const float2* kf = (const float2*)(p.ws + OFF_KF);
  const float* cw = p.in[7] + (size_t)l * 3 * 768; const float* cb = p.in[8] + (size_t)l * 768;
  const float* hb = p.in[15] + (size_t)l * 512;
  bf16_t* Y = (bf16_t*)(p.ws + R_YHY);
  bool tw = false;
  for (int u = blockIdx.x; u < 1024; u += gridDim.x) {
    if (!tw) { load_twiddles(p, W); tw = true; }
    const int bp = u >> 8, c = u & 255; const int b0 = bp * 2, b1 = b0 + 1;
    const bf16_t* P0 = PT + ((size_t)b0 * 768) * KEYS; const bf16_t* P1 = PT + ((size_t)b1 * 768) * KEYS;
    const float bias0 = hb[c], bias1 = hb[256 + c];
    float va[8], vb[8];
    hy_conv8(P0 + (size_t)c * KEYS, tb, SL, cw[c], cw[768 + c], cw[1536 + c], cb[c], va);
    hy_conv8(P1 + (size_t)c * KEYS, tb, SL, cw[c], cw[768 + c], cw[1536 + c], cb[c], vb);
    __syncthreads();
#pragma unroll
    for (int i = 0; i < 8; ++i) { X[tb + i] = make_float2(va[i], vb[i]); X[tb + i + 4096] = make_float2(0.f, 0.f); }
    fft_dif(X, W);
    {
      const float2* H = kf + (size_t)c * 8192;
#pragma unroll 4
      for (int i = 0; i < 16; ++i) { int q = tid + i * 512; X[q] = cmul(X[q], H[q]); }
    }
    fft_dit_inv(X, W);
    float za[8], zb[8];
    {
      float xa[8], xb[8];
      hy_conv8(P0 + (size_t)(256 + c) * KEYS, tb, SL, cw[256 + c], cw[768 + 256 + c], cw[1536 + 256 + c], cb[256 + c], xa);
      hy_conv8(P1 + (size_t)(256 + c) * KEYS, tb, SL, cw[256 + c], cw[768 + 256 + c], cw[1536 + 256 + c], cb[256 + c], xb);
#pragma unroll
      for (int i = 0; i < 8; ++i) {
        const float2 y = X[tb + i];
        za[i] = xa[i] * (y.x * (1.f / 8192.f) + bias0 * va[i]);
        zb[i] = xb[i] * (y.y * (1.f / 8192.f) + bias0 * vb[i]);
      }
    }
    __syncthreads();
#pragma unroll
    for (int i = 0; i < 8; ++i) { X[tb + i] = make_float2(za[i], zb[i]); X[tb + i + 4096] = make_float2(0.f, 0.f); }
    fft_dif(X, W);
    {
      const float2* H = kf + (size_t)(256 + c) * 8192;
#pragma unroll 4
      for (int i = 0; i < 16; ++i) { int q = tid + i * 512; X[q] = cmul(X[q], H[q]); }
    }
    fft_dit_inv(X, W);
    {
      float xa[8], xb[8];
      hy_conv8(P0 + (size_t)(512 + c) * KEYS, tb, SL, cw[512 + c], cw[768 + 512 + c], cw[1536 + 512 + c], cb[512 + c], xa);
      hy_conv8(P1 + (size_t)(512 + c) * KEYS, tb, SL, cw[512 + c], cw[768 + 512 + c], cw[1536 + 512 + c], cb[512 + c], xb);
#pragma unroll
      for (int i = 0; i < 8; ++i) {
        const float2 y = X[tb + i];
        const float oa = xa[i] * (y.x * (1.f / 8192.f) + bias1 * za[i]);
        const float ob = xb[i] * (y.y * (1.f / 8192.f) + bias1 * zb[i]);
        Y[((size_t)b0 * SL + tb + i) * 256 + c] = (bf16_t)f2bf(oa);
        Y[((size_t)b1 * SL + tb + i) * 256 + c] = (bf16_t)f2bf(ob);
      }
    }
  }
}

DI void ph_hyena_ctx(const Params& p, int l, char* smem) {
  const int tid = my_tid(), lane = tid & 63, wid = tid >> 6;
  float* Zb = (float*)smem + wid * 1024;
  float* Gb = Zb + 256;
  const bf16_t* PT = (const bf16_t*)(p.ws + R_PHY);
  const float* G = (const float*)(p.ws + MISC_GCTX);
  const float* cw = p.in[7] + (size_t)l * 3 * 768; const float* cb = p.in[8] + (size_t)l * 768;
  const float* hb = p.in[15] + (size_t)l * 512;
  bf16_t* Y = (bf16_t*)(p.ws + R_YHY);
  for (int base = blockIdx.x * 8; base < 2048; base += gridDim.x * 8) {
    const int u = base + wid; const int b = u >> 8, c = u & 255;
    const bf16_t* Pb = PT + ((size_t)b * 768) * KEYS + SL;
    float v[4], x1[4], x2[4], zz[4];
#pragma unroll
    for (int i = 0; i < 4; ++i) {
      int t = lane + i * 64;
      v[i] = hy_conv3(Pb + (size_t)c * KEYS, t, CL, cw[c], cw[768 + c], cw[1536 + c], cb[c]);
      x1[i] = hy_conv3(Pb + (size_t)(256 + c) * KEYS, t, CL, cw[256 + c], cw[768 + 256 + c], cw[1536 + 256 + c], cb[256 + c]);
      x2[i] = hy_conv3(Pb + (size_t)(512 + c) * KEYS, t, CL, cw[512 + c], cw[768 + 512 + c], cw[1536 + 512 + c], cb[512 + c]);
    }
    __syncthreads();
#pragma unroll
    for (int i = 0; i < 4; ++i) Zb[lane + i * 64] = v[i];
    for (int i = lane; i < 512; i += 64) Gb[i] = G[(size_t)c * 512 + i];
    __syncthreads();
#pragma unroll
    for (int i = 0; i < 4; ++i) {
      int t = lane + i * 64; float s = 0.f;
      for (int s2 = 0; s2 < 256; ++s2) s += Gb[256 + t - s2] * Zb[s2];
      zz[i] = x1[i] * (s + hb[c] * v[i]);
    }
    __syncthreads();
#pragma unroll
    for (int i = 0; i < 4; ++i) Zb[lane + i * 64] = zz[i];
    for (int i = lane; i < 512; i += 64) Gb[i] = G[(size_t)(256 + c) * 512 + i];
    __syncthreads();
#pragma unroll
    for (int i = 0; i < 4; ++i) {
      int t = lane + i * 64; float s = 0.f;
      for (int s2 = 0; s2 < 256; ++s2) s += Gb[256 + t - s2] * Zb[s2];
      float o = x2[i] * (s + hb[256 + c] * zz[i]);
      Y[((size_t)ML + b * CL + t) * 256 + c] = (bf16_t)f2bf(o);
    }
  }
}

DI void ph_rope(const Params& p, char* smem) {
  float2* T16 = (float2*)smem;
  float2* T8 = T16 + 64 * 16;
  const int tid = my_tid(), lane = tid & 63, wid = tid >> 6;
  __syncthreads();
  for (int i = tid; i < 64 * 16; i += NTHR) {
    int pos = i >> 4, f = i & 15; float inv = powf(10000.f, -(float)f / 16.f); float s, c; sincosf((float)pos * inv, &s, &c);
    T16[i] = make_float2(c, s);
  }
  for (int i = tid; i < 64 * 8; i += NTHR) {
    int pos = i >> 3, f = i & 7; float inv = powf(10000.f, -(float)f / 8.f); float s, c; sincosf((float)pos * inv, &s, &c);
    T8[i] = make_float2(c, s);
  }
  __syncthreads();
  bf16_t* Psw = (bf16_t*)(p.ws + R_PSW); bf16_t* Pdf = (bf16_t*)(p.ws + R_PDF);
  bf16_t* rowbase_ptr; int e1, e2, nf, f0; bool hsel; bool active = lane < 56;
  if (lane < 24) { const int hd = lane >> 2, half = (lane >> 1) & 1, cp = lane & 1; e1 = hd * 64 + half * 32 + cp * 8; e2 = e1 + 16; nf = 16; f0 = cp * 8; hsel = half; }
  else { const int j = lane - 24; const int gi = j >> 1, half = j & 1; e1 = gi * 32 + half * 16; e2 = e1 + 8; nf = 8; f0 = 0; hsel = half; }
  const float2* Tb = (lane < 24) ? T16 : T8;
  for (int row = blockIdx.x * 8 + wid; row < ML; row += gridDim.x * 8) {
    if (active) {
      const int t = row & (SL - 1); const int pos = hsel ? (t & 63) : (t >> 6);
      rowbase_ptr = (lane < 24) ? Psw + (size_t)row * 384 : Pdf + (size_t)row * 512;
      const uint4 u1 = *(const uint4*)(rowbase_ptr + e1), u2 = *(const uint4*)(rowbase_ptr + e2);
      const float4* cs = (const float4*)(Tb + pos * nf + f0);
      const float4 c0 = cs[0], c1 = cs[1], c2 = cs[2], c3 = cs[3];
      const unsigned w1[4] = {u1.x, u1.y, u1.z, u1.w}, w2[4] = {u2.x, u2.y, u2.z, u2.w};
      const float4 cc[4] = {c0, c1, c2, c3};
      unsigned o1[4], o2[4];
#pragma unroll
      for (int i = 0; i < 4; ++i) {
        const float xa = bflo(w1[i]), xb = bfhi(w1[i]), ya = bflo(w2[i]), yb = bfhi(w2[i]);
        o1[i] = pack2(xa * cc[i].x - ya * cc[i].y, xb * cc[i].z - yb * cc[i].w);
        o2[i] = pack2(xa * cc[i].y + ya * cc[i].x, xb * cc[i].w + yb * cc[i].z);
      }
      *(uint4*)(rowbase_ptr + e1) = make_uint4(o1[0], o1[1], o1[2], o1[3]);
      *(uint4*)(rowbase_ptr + e2) = make_uint4(o2[0], o2[1], o2[2], o2[3]);
    }
  }
}

DI float rw_shift(const bf16_t* __restrict__ P, int row, int t, int len, int col, float mu) {
  float c = bf2f(P[(size_t)row * 1216 + col]);
  float a = t >= 1 ? bf2f(P[(size_t)(row - 1) * 1216 + col]) : 0.f;
  float b = t + 1 < len ? bf2f(P[(size_t)(row + 1) * 1216 + col]) : 0.f;
  return c + (0.5f * (a + b) - c) * mu;
}
DI void ph_rwprep(const Params& p, int l, char* smem) {
  constexpr int AST = 912, RST = 1552, ROFF = 32 * AST;
  const int tid = my_tid(), lane = tid & 63, wid = tid >> 6, g = lane >> 4, r16 = lane & 15;
  const int tg = wid >> 2, hd = wid & 3;
  const bf16_t* P = (const bf16_t*)(p.ws + R_PRW);
  const float* mu = p.in[17] + (size_t)l * 1216;
  const float* w0 = p.in[18] + (size_t)l * 512; const float* a0 = p.in[20] + (size_t)l * 256;
  const float* kkw = p.in[23] + (size_t)l * 256; const float* kaw = p.in[24] + (size_t)l * 256;
  bf16_t* S = (bf16_t*)(p.ws + R_STR); bf16_t* Gs = (bf16_t*)(p.ws + R_G);
  const size_t SU = (size_t)MT * 256;
  float w0f[4], w0b[4], a0c[4], kkc[4], kac[4];
#pragma unroll
  for (int nt = 0; nt < 4; ++nt) { int c = hd * 64 + r16 * 4 + nt; w0f[nt] = w0[c]; w0b[nt] = w0[256 + c]; a0c[nt] = a0[c]; kkc[nt] = kkw[c]; kac[nt] = kaw[c]; }
  for (int u = blockIdx.x; u < MT / 32; u += gridDim.x) {
    const int row0 = u * 32; int t0, len;
    if (row0 < ML) { t0 = row0 & (SL - 1); len = SL; } else { t0 = (row0 - ML) & (CL - 1); len = CL; }
    __syncthreads();
    for (int item = tid; item < 32 * 152; item += NTHR) {
      const int tk = item / 152, c8 = item - tk * 152; const int row = row0 + tk, t = t0 + tk;
      const uint4 uc = *(const uint4*)(P + (size_t)row * 1216 + c8 * 8);
      uint4 ua = make_uint4(0, 0, 0, 0), ub = make_uint4(0, 0, 0, 0);
      if (t >= 1) ua = *(const uint4*)(P + (size_t)(row - 1) * 1216 + c8 * 8);
      if (t + 1 < len) ub = *(const uint4*)(P + (size_t)(row + 1) * 1216 + c8 * 8);
      const float4 m0 = *(const float4*)(mu + c8 * 8), m1 = *(const float4*)(mu + c8 * 8 + 4);
      float o[8];
      {
        const unsigned wc[4] = {uc.x, uc.y, uc.z, uc.w}, wa[4] = {ua.x, ua.y, ua.z, ua.w}, wb[4] = {ub.x, ub.y, ub.z, ub.w};
        const float mm[8] = {m0.x, m0.y, m0.z, m0.w, m1.x, m1.y, m1.z, m1.w};
#pragma unroll
        for (int i = 0; i < 4; ++i) {
          float c_lo = bflo(wc[i]), c_hi = bfhi(wc[i]);
          o[2 * i] = c_lo + (0.5f * (bflo(wa[i]) + bflo(wb[i])) - c_lo) * mm[2 * i];
          o[2 * i + 1] = c_hi + (0.5f * (bfhi(wa[i]) + bfhi(wb[i])) - c_hi) * mm[2 * i + 1];
        }
      }
      char* dst;
      if (c8 < 96) dst = smem + ROFF + tk * RST + c8 * 16;
      else {
        const int cc = c8 * 8 - 768;
        if (cc < 128) {
#pragma unroll
          for (int i = 0; i < 8; ++i) o[i] = 1.f - 2.f * __builtin_amdgcn_rcpf(1.f + __expf(2.f * o[i]));
        } else if (cc >= 192) {
#pragma unroll
          for (int i = 0; i < 8; ++i) o[i] = sigmoidf_(o[i]);
        }
        dst = smem + tk * AST + cc * 2;
      }
      uint4 ov; ov.x = pack2(o[0], o[1]); ov.y = pack2(o[2], o[3]); ov.z = pack2(o[4], o[5]); ov.w = pack2(o[6], o[7]);
      *(uint4*)dst = ov;
    }
    __syncthreads();
    f32x4 acc[5][4];
#pragma unroll
    for (int o5 = 0; o5 < 5; ++o5)
#pragma unroll
      for (int nt = 0; nt < 4; ++nt) acc[o5][nt] = (f32x4){0.f, 0.f, 0.f, 0.f};
    const char* Arow = smem + (tg * 16 + r16) * AST + g * 16;
#pragma unroll
    for (int o5 = 0; o5 < 5; ++o5) {
      const int kbase = o5 < 3 ? o5 * 64 : (o5 == 3 ? 192 : 320);
      const int KK = o5 < 3 ? 64 : 128;
      const bf16_t* Wt = (const bf16_t*)(p.ws + (o5 == 0 ? RWW_F : o5 == 1 ? RWW_B : o5 == 2 ? RWW_A : o5 == 3 ? RWW_GF : RWW_GB));
#pragma unroll
      for (int ks = 0; ks < KK / 32; ++ks) {
        const bf16x8 af = *(const bf16x8*)(Arow + (kbase + ks * 32) * 2);
#pragma unroll
        for (int nt = 0; nt < 4; ++nt) {
          const bf16x8 bf = *(const bf16x8*)(Wt + (size_t)(hd * 64 + nt * 16 + r16) * KK + ks * 32 + g * 8);
          acc[o5][nt] = __builtin_amdgcn_mfma_f32_16x16x32_bf16(af, bf, acc[o5][nt], 0, 0, 0);
        }
        if (ks & 1) asm volatile("" ::: "memory");
      }
    }
#pragma unroll
    for (int j = 0; j < 4; ++j) {
      const int tk = tg * 16 + g * 4 + j; const size_t row = (size_t)row0 + tk;
      const char* rk = smem + ROFF + tk * RST;
      const int c0 = hd * 64 + r16 * 4;
      const uint2 ur = *(const uint2*)(rk + c0 * 2), uk = *(const uint2*)(rk + (256 + c0) * 2), uv = *(const uint2*)(rk + (512 + c0) * 2);
      const float rv[4] = {bflo(ur.x), bfhi(ur.x), bflo(ur.y), bfhi(ur.y)};
      const float kv[4] = {bflo(uk.x), bfhi(uk.x), bflo(uk.y), bfhi(uk.y)};
      const float vv[4] = {bflo(uv.x), bfhi(uv.x), bflo(uv.y), bfhi(uv.y)};
      float n2 = 0.f;
#pragma unroll
      for (int nt = 0; nt < 4; ++nt) { float q = kv[nt] * kkc[nt]; n2 += q * q; }
      n2 = sum16(n2);
      const float inv = __builtin_amdgcn_rsqf(fmaxf(n2, 1e-24f));
      float o_kp[4], o_kk[4], o_b[4], o_df[4], o_db[4];
#pragma unroll
      for (int nt = 0; nt < 4; ++nt) {
        const float k = kv[nt];
        const float a = sigmoidf_(a0c[nt] + acc[2][nt][j]);
        const float kk = k * kkc[nt] * inv;
        o_kp[nt] = k * (1.f + (a - 1.f) * kac[nt]);
        o_kk[nt] = kk; o_b[nt] = kk * a;
        const float xf = -(w0f[nt] + acc[0][nt][j]); const float spf = fmaxf(xf, 0.f) + __logf(1.f + __expf(-fabsf(xf)));
        const float xb = -(w0b[nt] + acc[1][nt][j]); const float spb = fmaxf(xb, 0.f) + __logf(1.f + __expf(-fabsf(xb)));
        const float ef = __expf(-spf - 0.5f), eb = __expf(-spb - 0.5f);
        o_df[nt] = 1.f - __expf(-ef); o_db[nt] = 1.f - __expf(-eb);
      }
      const size_t o = row * 256 + c0;
      uint2 w;
      w.x = pack2(rv[0], rv[1]); w.y = pack2(rv[2], rv[3]); *(uint2*)(S + o) = w;
      w.x = pack2(o_kp[0], o_kp[1]); w.y = pack2(o_kp[2], o_kp[3]); *(uint2*)(S + SU + o) = w;
      w.x = pack2(vv[0], vv[1]); w.y = pack2(vv[2], vv[3]); *(uint2*)(S + 2 * SU + o) = w;
      w.x = pack2(o_kk[0], o_kk[1]); w.y = pack2(o_kk[2], o_kk[3]); *(uint2*)(S + 3 * SU + o) = w;
      w.x = pack2(o_b[0], o_b[1]); w.y = pack2(o_b[2], o_b[3]); *(uint2*)(S + 4 * SU + o) = w;
      w.x = pack2(o_df[0], o_df[1]); w.y = pack2(o_df[2], o_df[3]); *(uint2*)(S + 5 * SU + o) = w;
      w.x = pack2(o_db[0], o_db[1]); w.y = pack2(o_db[2], o_db[3]); *(uint2*)(S + 6 * SU + o) = w;
      w.x = pack2(acc[3][0][j], acc[3][1][j]); w.y = pack2(acc[3][2][j], acc[3][3][j]); *(uint2*)(Gs + o) = w;
      w.x = pack2(acc[4][0][j], acc[4][1][j]); w.y = pack2(acc[4][2][j], acc[4][3][j]); *(uint2*)(Gs + SU + o) = w;
    }
  }
}

DI long scan_row(int b, int dir, int s) {
  if (s < CL) return (long)ML + b * CL + (dir ? (CL - 1 - s) : s);
  int t = s - CL; return (long)b * SL + (dir ? (SL - 1 - t) : t);
}
DI float sum8(float v) {
  v += dpp_mov<0xB1>(v);
  v += dpp_mov<0x4E>(v);
  v += dpp_mov<0x141>(v);
  return v;
}
DI void ph_scan(const Params& p, char* smem) {
  const int tid = my_tid(), lane = tid & 63, wid = tid >> 6;
  const bf16_t* S = (const bf16_t*)(p.ws + R_STR);
  const size_t SU = (size_t)MT * 256;
  constexpr int T = 32, NSTEP = CL + SL, NCH = NSTEP / T;
  typedef float f32x2 __attribute__((ext_vector_type(2)));
  for (int u = blockIdx.x; u < 128; u += gridDim.x) {
    const int chain = u >> 1, rg = u & 1; const int dir = chain & 1, bh = chain >> 1, b = bh >> 2, h = bh & 3;
    bf16_t* O = (bf16_t*)(p.ws + (dir ? R_OB : R_OF));
    uint4 q0, q1, q2;
    auto SC_GLOAD = [&](int ci) {
#pragma unroll
      for (int j = 0; j < 3; ++j) {
        int idx = tid + j * 512; int st = idx >> 8, s = (idx & 255) >> 3, ck = idx & 7;
        long row = scan_row(b, dir, ci * T + s);
        int sid = st < 5 ? st : 5 + dir;
        uint4 v = *(const uint4*)(S + sid * SU + row * 256 + h * 64 + ck * 8);
        if (j == 0) q0 = v; else if (j == 1) q1 = v; else q2 = v;
      }
    };
    auto SC_SSTORE = [&](int buf) {
#pragma unroll
      for (int j = 0; j < 3; ++j) {
        int idx = tid + j * 512; int st = idx >> 8;
        uint4 v = j == 0 ? q0 : (j == 1 ? q1 : q2);
        float4 lo = make_float4(bflo(v.x), bfhi(v.x), bflo(v.y), bfhi(v.y));
        float4 hi = make_float4(bflo(v.z), bfhi(v.z), bflo(v.w), bfhi(v.w));
        if (st == 5) { lo.x = 1.f - lo.x; lo.y = 1.f - lo.y; lo.z = 1.f - lo.z; lo.w = 1.f - lo.w; hi.x = 1.f - hi.x; hi.y = 1.f - hi.y; hi.z = 1.f - hi.z; hi.w = 1.f - hi.w; }
        char* base = smem + buf * 49152 + idx * 32;
        *(float4*)(base) = lo; *(float4*)(base + 16) = hi;
      }
    };
    auto FLUSH = [&](int ci) {
      const int s = tid >> 4, part = tid & 15;
      const float2 v = *(const float2*)(smem + 98304 + (ci & 1) * 4096 + s * 128 + part * 8);
      long row = scan_row(b, dir, ci * T + s);
      *(unsigned*)(O + row * 256 + h * 64 + rg * 32 + part * 2) = pack2(v.x, v.y);
    };
    __syncthreads();
    SC_GLOAD(0);
    SC_SSTORE(0);
    __syncthreads();
    f32x2 st0 = {0.f, 0.f}, st1 = {0.f, 0.f}, st2 = {0.f, 0.f}, st3 = {0.f, 0.f};
    const int rsub = lane >> 3, ks = lane & 7;
    const int lrow = (wid & 3) * 8 + rsub;
    const int vrow = rg * 32 + lrow;
    struct Step { f32x2 r[4], k[4], kk[4], b[4], w[4]; float v; };
    auto LOADSTEP = [&](Step& x, const char* B, int s) {
#pragma unroll
      for (int hh = 0; hh < 2; ++hh) {
        const float4 r = *(const float4*)(B + (0 * T + s) * 256 + ks * 32 + hh * 16);
        const float4 k = *(const float4*)(B + (1 * T + s) * 256 + ks * 32 + hh * 16);
        const float4 kk = *(const float4*)(B + (3 * T + s) * 256 + ks * 32 + hh * 16);
        const float4 bb = *(const float4*)(B + (4 * T + s) * 256 + ks * 32 + hh * 16);
        const float4 w = *(const float4*)(B + (5 * T + s) * 256 + ks * 32 + hh * 16);
        x.r[2 * hh] = (f32x2){r.x, r.y}; x.r[2 * hh + 1] = (f32x2){r.z, r.w};
        x.k[2 * hh] = (f32x2){k.x, k.y}; x.k[2 * hh + 1] = (f32x2){k.z, k.w};
        x.kk[2 * hh] = (f32x2){kk.x, kk.y}; x.kk[2 * hh + 1] = (f32x2){kk.z, kk.w};
        x.b[2 * hh] = (f32x2){bb.x, bb.y}; x.b[2 * hh + 1] = (f32x2){bb.z, bb.w};
        x.w[2 * hh] = (f32x2){w.x, w.y}; x.w[2 * hh + 1] = (f32x2){w.z, w.w};
      }
      x.v = *(const float*)(B + (2 * T + s) * 256 + vrow * 4);
    };
    for (int ci = 0; ci < NCH; ++ci) {
      if (ci + 1 < NCH) { SC_GLOAD(ci + 1); }
      if (ci > 0) FLUSH(ci - 1);
      if (wid < 4) {
        const char* B = smem + (ci & 1) * 49152;
        float* ob = (float*)(smem + 98304 + (ci & 1) * 4096);
        Step nx; LOADSTEP(nx, B, 0);
#pragma unroll 2
        for (int s = 0; s < T; ++s) {
          const Step c = nx;
          LOADSTEP(nx, B, s + 1);
          f32x2 pa = st0 * c.kk[0] + st1 * c.kk[1];
          f32x2 pb = st2 * c.kk[2] + st3 * c.kk[3];
          pa = pa + pb;
          float sa = -(pa.x + pa.y);
          sa = sum8(sa);
          const f32x2 sa2 = {sa, sa}; const f32x2 v2 = {c.v, c.v};
          st0 = st0 * c.w[0] + sa2 * c.b[0] + v2 * c.k[0];
          st1 = st1 * c.w[1] + sa2 * c.b[1] + v2 * c.k[1];
          st2 = st2 * c.w[2] + sa2 * c.b[2] + v2 * c.k[2];
          st3 = st3 * c.w[3] + sa2 * c.b[3] + v2 * c.k[3];
          f32x2 oa = st0 * c.r[0] + st1 * c.r[1];
          f32x2 ob2 = st2 * c.r[2] + st3 * c.r[3];
          oa = oa + ob2;
          float o = sum8(oa.x + oa.y);
          if (ks == 0) ob[s * 32 + lrow] = o;
        }
      }
      if (ci + 1 < NCH) { SC_SSTORE((ci + 1) & 1); }
      __syncthreads();
    }
    FLUSH(NCH - 1);
  }
}

template <bool DIFF>
DI void attn_unit(const Params& p, int l, int b, int h, int qrow0, int qpos0, int kb_lo, int kb_hi, int kc_lo, char* smem) {
  const int tid = my_tid(), lane = tid & 63, wid = tid >> 6, g = lane >> 4, r16 = lane & 15;
  const bf16_t* QK = (const bf16_t*)(p.ws + (DIFF ? R_PDF : R_PSW));
  const int ldq = DIFF ? 512 : 384;
  const int qc0 = h * 64;
  const int kc0 = 256 + (DIFF ? h * 64 : (h >> 1) * 64);
  const bf16_t* VT = DIFF ? (const bf16_t*)(p.ws + R_VTDF) + ((size_t)b * 256 + h * 64) * KEYS
                          : (const bf16_t*)(p.ws + R_VTSW) + ((size_t)b * 128 + (h >> 1) * 64) * KEYS;
  const int nblk = (kb_hi - kb_lo) + (68 - kc_lo);
  const float sc = (DIFF ? 0.17677669529663687f : 0.125f) * 1.4426950408889634f;
  bf16x8 qf[2];
  {
    const bf16_t* qp = QK + (size_t)(qrow0 + wid * 16 + r16) * ldq + qc0 + g * 8;
    qf[0] = *(const bf16x8*)(qp); qf[1] = *(const bf16x8*)(qp + 32);
  }
  constexpr int NC = DIFF ? 2 : 1;
  float m[NC], lsum[NC];
  f32x4 O[NC][4];
#pragma unroll
  for (int c = 0; c < NC; ++c) {
    if (DIFF) { m[c] = -1e30f; lsum[c] = 0.f; }
    else { m[c] = p.in[16][l * 4 + h] * 1.4426950408889634f; lsum[c] = (g == 0) ? 1.f : 0.f; }
#pragma unroll
    for (int dt = 0; dt < 4; ++dt) O[c][dt] = (f32x4){0.f, 0.f, 0.f, 0.f};
  }
  const int lr = tid >> 3, lc = tid & 7;
  uint4 rkA, rvA, rkB, rvB;
  rkA = make_uint4(0, 0, 0, 0); rvA = rkA; rkB = rkA; rvB = rkA;
  auto AT_GLOAD = [&](int i, uint4& rk, uint4& rv) {
    int kb = i < (kb_hi - kb_lo) ? kb_lo + i : kc_lo + (i - (kb_hi - kb_lo));
    long krow = kb < 64 ? (long)b * SL + kb * 64 + lr : (long)ML + b * CL + (kb - 64) * 64 + lr;
    rk = *(const uint4*)(QK + krow * ldq + kc0 + lc * 8);
    rv = *(const uint4*)(VT + (size_t)lr * KEYS + kb * 64 + lc * 8);
  };
  auto AT_SSTORE = [&](int buf, const uint4& rk, const uint4& rv) {
    *(uint4*)(smem + buf * 18432 + lr * 128 + ((lc ^ (lr & 7)) << 4)) = rk;
    *(uint4*)(smem + buf * 18432 + 9216 + lr * 144 + lc * 16) = rv;
  };
  __syncthreads();
  AT_GLOAD(0, rkA, rvA);
  AT_SSTORE(0, rkA, rvA);
  if (1 < nblk) AT_GLOAD(1, rkA, rvA);
  if (2 < nblk) AT_GLOAD(2, rkB, rvB);
  lds_barrier();
  const int qpos = qpos0 + wid * 16 + r16;
  for (int i = 0; i < nblk; ++i) {
    const int kb = i < (kb_hi - kb_lo) ? kb_lo + i : kc_lo + (i - (kb_hi - kb_lo));
    const bool masked = (!DIFF) && (kb < 64);
    const char* Kt = smem + (i & 1) * 18432; const char* Vt = Kt + 9216;
    f32x4 S[NC][4];
#pragma unroll
    for (int kt = 0; kt < 4; ++kt) {
      bf16x8 k0 = *(const bf16x8*)(Kt + (kt * 16 + r16) * 128 + ((g ^ (r16 & 7)) << 4));
      bf16x8 k1 = *(const bf16x8*)(Kt + (kt * 16 + r16) * 128 + (((4 + g) ^ (r16 & 7)) << 4));
      if (DIFF) {
        S[0][kt] = __builtin_amdgcn_mfma_f32_16x16x32_bf16(k0, qf[0], (f32x4){0.f, 0.f, 0.f, 0.f}, 0, 0, 0);
        S[NC - 1][kt] = __builtin_amdgcn_mfma_f32_16x16x32_bf16(k1, qf[1], (f32x4){0.f, 0.f, 0.f, 0.f}, 0, 0, 0);
      } else {
        f32x4 t = __builtin_amdgcn_mfma_f32_16x16x32_bf16(k0, qf[0], (f32x4){0.f, 0.f, 0.f, 0.f}, 0, 0, 0);
        S[0][kt] = __builtin_amdgcn_mfma_f32_16x16x32_bf16(k1, qf[1], t, 0, 0, 0);
      }
    }
    bf16x8 pf[NC][2];
#pragma unroll
    for (int c = 0; c < NC; ++c) {
      float mx = -1e30f;
#pragma unroll
      for (int kt = 0; kt < 4; ++kt)
#pragma unroll
        for (int j = 0; j < 4; ++j) {
          float v = S[c][kt][j];
          if (masked) { int kpos = kb * 64 + kt * 16 + g * 4 + j; int dd = kpos - qpos; if (dd > 128 || dd < -128) v = -3e38f; S[c][kt][j] = v; }
          mx = fmaxf(mx, v);
        }
      mx *= sc;
      mx = fmaxf(mx, __shfl_xor(mx, 16)); mx = fmaxf(mx, __shfl_xor(mx, 32));
      const float mn = fmaxf(m[c], mx);
      const bool grow = mn > m[c];
      float ps = 0.f;
      unsigned pk[8];
#pragma unroll
      for (int kt = 0; kt < 4; ++kt) {
        float e0 = __builtin_amdgcn_exp2f(fmaf(S[c][kt][0], sc, -mn)), e1 = __builtin_amdgcn_exp2f(fmaf(S[c][kt][1], sc, -mn));
        float e2 = __builtin_amdgcn_exp2f(fmaf(S[c][kt][2], sc, -mn)), e3 = __builtin_amdgcn_exp2f(fmaf(S[c][kt][3], sc, -mn));
        ps += (e0 + e1) + (e2 + e3);
        pk[kt * 2] = pack2(e0, e1); pk[kt * 2 + 1] = pack2(e2, e3);
      }
      if (__builtin_amdgcn_ballot_w64(grow) != 0ull) {
        const float alpha = __builtin_amdgcn_exp2f(m[c] - mn);
        m[c] = mn;
        lsum[c] *= alpha;
#pragma unroll
        for (int dt = 0; dt < 4; ++dt) { O[c][dt][0] *= alpha; O[c][dt][1] *= alpha; O[c][dt][2] *= alpha; O[c][dt][3] *= alpha; }
      }
      lsum[c] += ps;
      union { unsigned u[4]; bf16x8 v; } cv;
      cv.u[0] = pk[0]; cv.u[1] = pk[1]; cv.u[2] = pk[2]; cv.u[3] = pk[3]; pf[c][0] = cv.v;
      cv.u[0] = pk[4]; cv.u[1] = pk[5]; cv.u[2] = pk[6]; cv.u[3] = pk[7]; pf[c][1] = cv.v;
    }
#pragma unroll
    for (int dt = 0; dt < 4; ++dt)
#pragma unroll
      for (int s2 = 0; s2 < 2; ++s2) {
        union { uint2 u[2]; bf16x8 v; } vf;
        vf.u[0] = *(const uint2*)(Vt + (dt * 16 + r16) * 144 + (2 * s2) * 32 + g * 8);
        vf.u[1] = *(const uint2*)(Vt + (dt * 16 + r16) * 144 + (2 * s2 + 1) * 32 + g * 8);
#pragma unroll
        for (int c = 0; c < NC; ++c) O[c][dt] = __builtin_amdgcn_mfma_f32_16x16x32_bf16(vf.v, pf[c][s2], O[c][dt], 0, 0, 0);
      }
    if (i + 1 < nblk) AT_SSTORE((i + 1) & 1, rkA, rvA);
    rkA = rkB; rvA = rvB;
    if (i + 3 < nblk) AT_GLOAD(i + 3, rkB, rvB);
    lds_barrier();
  }
  float linv[NC];
#pragma unroll
  for (int c = 0; c < NC; ++c) { float t = lsum[c]; t += __shfl_xor(t, 16); t += __shfl_xor(t, 32); linv[c] = 1.f / t; }
  const size_t orow = (size_t)(qrow0 + wid * 16 + r16);
  if (!DIFF) {
    bf16_t* Y = (bf16_t*)(p.ws + R_YSW);
#pragma unroll
    for (int dt = 0; dt < 4; ++dt) {
      uint2 o; o.x = pack2(O[0][dt][0] * linv[0], O[0][dt][1] * linv[0]); o.y = pack2(O[0][dt][2] * linv[0], O[0][dt][3] * linv[0]);
      *(uint2*)(Y + orow * 256 + h * 64 + dt * 16 + g * 4) = o;
    }
  } else {
    const float lam_init = 0.8f - 0.6f * __expf(-0.3f * (float)l);
    float d1 = 0.f, d2 = 0.f;
    if (lane < 32) { d1 = p.in[28][l * 32 + lane] * p.in[29][l * 32 + lane]; d2 = p.in[30][l * 32 + lane] * p.in[31][l * 32 + lane]; }
    d1 = wave_sum(d1); d2 = wave_sum(d2);
    const float lam = expf(d1) - expf(d2) + lam_init;
    float ov[4][4]; float ss = 0.f;
#pragma unroll
    for (int dt = 0; dt < 4; ++dt)
#pragma unroll
      for (int j = 0; j < 4; ++j) { float v = O[0][dt][j] * linv[0] - lam * O[NC - 1][dt][j] * linv[NC - 1]; ov[dt][j] = v; ss += v * v; }
    ss += __shfl_xor(ss, 16); ss += __shfl_xor(ss, 32);
    const float rms = rsqrtf(ss * (1.f / 64.f) + 1e-5f) * (1.f - lam_init);
    const float* sg = p.in[32] + l * 64;
    bf16_t* Y = (bf16_t*)(p.ws + R_YDF);
#pragma unroll
    for (int dt = 0; dt < 4; ++dt) {
      const int d0 = dt * 16 + g * 4;
      uint2 o; o.x = pack2(ov[dt][0] * rms * sg[d0], ov[dt][1] * rms * sg[d0 + 1]); o.y = pack2(ov[dt][2] * rms * sg[d0 + 2], ov[dt][3] * rms * sg[d0 + 3]);
      *(uint2*)(Y + orow * 256 + h * 64 + d0) = o;
    }
  }
}

DI void ph_attn(const Params& p, int l, char* smem) {
  const bool need_ctx = (l == 0);
  const int n_sw = 1024 + (need_ctx ? 64 : 0);
  const int n_df = 1024 + (need_ctx ? 64 : 0);
  unsigned* ctr = (unsigned*)(p.ws + MISC_BAR + 64 + 64 * l);
  volatile int* slot = (volatile int*)(smem + 40960);
  for (;;) {
    __syncthreads();
    if (my_tid() == 0) *slot = (int)__hip_atomic_fetch_add(ctr, 1u, __ATOMIC_RELAXED, __HIP_MEMORY_SCOPE_AGENT);
    __syncthreads();
    const int u = *slot;
    if (u >= n_sw + n_df) break;
    if (u < n_df) {
      if (u < 1024) { int b = u >> 7, h = (u >> 5) & 3, n = u & 31; attn_unit<true>(p, l, b, h, b * SL + n * 128, n * 128, 0, 64, 64, smem); }
      else { int v = u - 1024; int b = v >> 3, h = (v >> 1) & 3, n = v & 1; attn_unit<true>(p, l, b, h, ML + b * CL + n * 128, 0, 0, 0, 64, smem); }
    } else {
      int w = u - n_df;
      if (w < 1024) {
        int b = w >> 7, h = (w >> 5) & 3, n = w & 31;
        int lo = (n - 1) * 2; if (lo < 0) lo = 0; int hi = (n + 2) * 2; if (hi > 64) hi = 64;
        attn_unit<false>(p, l, b, h, b * SL + n * 128, n * 128, lo, hi, 64, smem);
      } else { int v = w - 1024; int b = v >> 3, h = (v >> 1) & 3, n = v & 1; attn_unit<false>(p, l, b, h, ML + b * CL + n * 128, 0, 0, 0, 64, smem); }
    }
  }
}

DI void ph_rwout(const Params& p, int l) {
  const int lane = my_tid() & 63, wid = my_tid() >> 6;
  const bf16_t* S = (const bf16_t*)(p.ws + R_STR); const bf16_t* Gs = (const bf16_t*)(p.ws + R_G);
  const bf16_t* OF = (const bf16_t*)(p.ws + R_OF); const bf16_t* OB = (const bf16_t*)(p.ws + R_OB);
  bf16_t* Y = (bf16_t*)(p.ws + R_YRW);
  const size_t SU = (size_t)MT * 256;
  const float4 rk = *(const float4*)(p.in[25] + (size_t)l * 256 + lane * 4);
  const float4 gam = *(const float4*)(p.in[26] + (size_t)l * 256 + lane * 4);
  const float4 bet = *(const float4*)(p.in[27] + (size_t)l * 256 + lane * 4);
  const int nrows = (l == 0) ? MT : ML;
  for (int row = blockIdx.x * 8 + wid; row < nrows; row += gridDim.x * 8) {
    const size_t o = (size_t)row * 256 + lane * 4;
    uint2 ur = *(const uint2*)(S + o), uk = *(const uint2*)(S + SU + o), uv = *(const uint2*)(S + 2 * SU + o);
    uint2 uf = *(const uint2*)(OF + o), ub = *(const uint2*)(OB + o), ugf = *(const uint2*)(Gs + o), ugb = *(const uint2*)(Gs + SU + o);
    float r[4] = {bflo(ur.x), bfhi(ur.x), bflo(ur.y), bfhi(ur.y)};
    float k[4] = {bflo(uk.x), bfhi(uk.x), bflo(uk.y), bfhi(uk.y)};
    float v[4] = {bflo(uv.x), bfhi(uv.x), bflo(uv.y), bfhi(uv.y)};
    float f[4] = {bflo(uf.x), bfhi(uf.x), bflo(uf.y), bfhi(uf.y)};
    float bb[4] = {bflo(ub.x), bfhi(ub.x), bflo(ub.y), bfhi(ub.y)};
    float gf[4] = {bflo(ugf.x), bfhi(ugf.x), bflo(ugf.y), bfhi(ugf.y)};
    float gb[4] = {bflo(ugb.x), bfhi(ugb.x), bflo(ugb.y), bfhi(ugb.y)};
    const float rkv[4] = {rk.x, rk.y, rk.z, rk.w}; const float ga[4] = {gam.x, gam.y, gam.z, gam.w}; const float be[4] = {bet.x, bet.y, bet.z, bet.w};
    float bon = 0.f, sf = 0.f, sb = 0.f;
#pragma unroll
    for (int i = 0; i < 4; ++i) { bon += r[i] * k[i] * rkv[i]; sf += f[i]; sb += bb[i]; }
    bon = sum16(bon); float muf = sum16(sf) * (1.f / 64.f), mub = sum16(sb) * (1.f / 64.f);
    float qf = 0.f, qb = 0.f;
#pragma unroll
    for (int i = 0; i < 4; ++i) { f[i] -= muf; bb[i] -= mub; qf += f[i] * f[i]; qb += bb[i] * bb[i]; }
    float rsf = rsqrtf(sum16(qf) * (1.f / 64.f) + 64e-5f), rsb = rsqrtf(sum16(qb) * (1.f / 64.f) + 64e-5f);
    float y[4];
#pragma unroll
    for (int i = 0; i < 4; ++i) {
      float bn = bon * v[i];
      y[i] = (f[i] * rsf * ga[i] + be[i] + bn) * gf[i] + (bb[i] * rsb * ga[i] + be[i] + bn) * gb[i];
    }
    uint2 oo; oo.x = pack2(y[0], y[1]); oo.y = pack2(y[2], y[3]);
    *(uint2*)(Y + o) = oo;
  }
}

DI void ph_merge(const Params& p, int l, const bf16_t* U, char* smem) {
  const int lane = my_tid() & 63, wid = my_tid() >> 6, wm = wid >> 1, wn = wid & 1, g = lane >> 4, r16 = lane & 15;
  const int mtiles = (l == 0) ? 136 : 128;
  bf16_t* ACC = (bf16_t*)(p.ws + R_ACC);
  for (int it = 0;; ++it) {
    int mtile, ntile;
    if (!next_tile(it, mtiles, 8, mtile, ntile)) break;
    uint2 accS[4][4];
#pragma unroll
    for (int mt = 0; mt < 4; ++mt)
#pragma unroll
      for (int nt = 0; nt < 4; ++nt) accS[mt][nt] = make_uint2(0u, 0u);
    for (int j = 0; j < 4; ++j) {
      uint2 pb[4][4];
      {
        f32x4 accB[4][4]; zero_acc<4>(accB);
        const size_t yoff = (j == 0) ? R_YHY : (j == 1) ? R_YSW : (j == 2) ? R_YRW : R_YDF;
        gemm_glds(accB, (const bf16_t*)(p.ws + yoff), 256, RowPlain{(long)mtile * 256}, (const bf16_t*)(p.ws + WB_BR) + ((size_t)j * 1024 + ntile * 128) * 256, 256, 256, smem, (const bf16_t*)(p.ws + MISC_ZERO));
#pragma unroll
        for (int mt = 0; mt < 4; ++mt)
#pragma unroll
          for (int nt = 0; nt < 4; ++nt) { pb[mt][nt].x = pack2(accB[mt][nt][0], accB[mt][nt][1]); pb[mt][nt].y = pack2(accB[mt][nt][2], accB[mt][nt][3]); }
      }
      f32x4 accG[4][4]; zero_acc<4>(accG);
      gemm_glds(accG, U, 1024, RowPlain{(long)mtile * 256}, (const bf16_t*)(p.ws + WB_GATE) + ((size_t)j * 1024 + ntile * 128) * 1024, 1024, 1024, smem, (const bf16_t*)(p.ws + MISC_ZERO));
#pragma unroll
      for (int mt = 0; mt < 4; ++mt)
#pragma unroll
        for (int nt = 0; nt < 4; ++nt) {
          float v0 = bflo(accS[mt][nt].x) + sigmoidf_(accG[mt][nt][0]) * bflo(pb[mt][nt].x);
          float v1 = bfhi(accS[mt][nt].x) + sigmoidf_(accG[mt][nt][1]) * bfhi(pb[mt][nt].x);
          float v2 = bflo(accS[mt][nt].y) + sigmoidf_(accG[mt][nt][2]) * bflo(pb[mt][nt].y);
          float v3 = bfhi(accS[mt][nt].y) + sigmoidf_(accG[mt][nt][3]) * bfhi(pb[mt][nt].y);
          accS[mt][nt].x = pack2(v0, v1); accS[mt][nt].y = pack2(v2, v3);
        }
    }
#pragma unroll
    for (int mt = 0; mt < 4; ++mt) {
      const int col = ntile * 128 + wn * 64 + r16 * 4;
      const size_t row = (size_t)mtile * 256 + wm * 64 + mt * 16 + g * 4;
      uint2 o;
      o.x = (accS[mt][0].x & 0xffffu) | (accS[mt][1].x << 16); o.y = (accS[mt][2].x & 0xffffu) | (accS[mt][3].x << 16);
      *(uint2*)(ACC + (row + 0) * 1024 + col) = o;
      o.x = (accS[mt][0].x >> 16) | (accS[mt][1].x & 0xffff0000u); o.y = (accS[mt][2].x >> 16) | (accS[mt][3].x & 0xffff0000u);
      *(uint2*)(ACC + (row + 1) * 1024 + col) = o;
      o.x = (accS[mt][0].y & 0xffffu) | (accS[mt][1].y << 16); o.y = (accS[mt][2].y & 0xffffu) | (accS[mt][3].y << 16);
      *(uint2*)(ACC + (row + 2) * 1024 + col) = o;
      o.x = (accS[mt][0].y >> 16) | (accS[mt][1].y & 0xffff0000u); o.y = (accS[mt][2].y >> 16) | (accS[mt][3].y & 0xffff0000u);
      *(uint2*)(ACC + (row + 3) * 1024 + col) = o;
    }
  }
}

DI void ph_resgemm(const Params& p, int l, const bf16_t* A, int K, const bf16_t* Bt, const float* hsrc_lat, const float* hsrc_ctx, int gate_off, char* smem) {
  const int lane = my_tid() & 63, wid = my_tid() >> 6, wm = wid >> 1, wn = wid & 1, g = lane >> 4, r16 = lane & 15;
  const int mtiles = (l == 0) ? 136 : 128;
  const float* mod = (const float*)(p.ws + MISC_MOD) + (size_t)l * 9 * 6144;
  float* hc = (float*)(p.ws + OFF_HC);
  for (int it = 0;; ++it) {
    int mtile, ntile;
    if (!next_tile(it, mtiles, 8, mtile, ntile)) break;
    f32x4 acc[4][4]; zero_acc<4>(acc);
    gemm_glds(acc, A, K, RowPlain{(long)mtile * 256}, Bt + (size_t)ntile * 128 * K, K, K, smem, (const bf16_t*)(p.ws + MISC_ZERO));
    const int b = mtile < 128 ? (mtile >> 4) : 8;
    const float* gt = mod + (size_t)b * 6144 + gate_off;
    const int col = ntile * 128 + wn * 64 + r16 * 4;
    const float4 gv = *(const float4*)(gt + col);
#pragma unroll
    for (int mt = 0; mt < 4; ++mt)
#pragma unroll
      for (int e = 0; e < 4; ++e) {
        const int row = mtile * 256 + wm * 64 + mt * 16 + g * 4 + e;
        const float* hs; float* hd;
        if (row < ML) { size_t o = (size_t)row * D + col; hs = hsrc_lat + o; hd = p.out + o; }
        else { size_t o = (size_t)(row - ML) * D + col; hs = hsrc_ctx + o; hd = hc + o; }
        const float4 h = *(const float4*)hs;
        float4 r;
        r.x = DN_ALPHA * h.x + gv.x * acc[mt][0][e]; r.y = DN_ALPHA * h.y + gv.y * acc[mt][1][e];
        r.z = DN_ALPHA * h.z + gv.z * acc[mt][2][e]; r.w = DN_ALPHA * h.w + gv.w * acc[mt][3][e];
        *(float4*)hd = r;
      }
  }
}

DI void ph_ffnup(const Params& p, int l, char* smem) {
  const bf16_t* U = (const bf16_t*)(p.ws + R_U);
  const bf16_t* Bt = (const bf16_t*)(p.ws + WB_UP);
  bf16_t* HID = (bf16_t*)(p.ws + R_HID);
  const float* cw = p.in[38] + (size_t)l * 3 * 5632; const float* cb = p.in[39] + (size_t)l * 5632;
  const int tid = my_tid(), lane = tid & 63, wid = tid >> 6, wm = wid >> 2, wn = wid & 3, g = lane >> 4, r16 = lane & 15;
  const int mtiles = (l == 0) ? 144 : 136;
  constexpr int TS = 528;
  for (int it = 0;; ++it) {
    int mtile, ntile;
    if (!next_tile(it, mtiles, 22, mtile, ntile)) break;
    long rowbase; int t0, len, r0, r1;
    if (mtile < 136) { int b = mtile / 17; int tt = mtile % 17; len = SL; rowbase = (long)b * SL; t0 = tt * 254 - 1; r0 = 1; r1 = 254; }
    else { int b = mtile - 136; len = CL; rowbase = (long)ML + b * CL; t0 = 0; r0 = 0; r1 = 255; }
    f32x4 acc[8][4]; zero_acc256(acc);
    gemm_glds256(acc, U, 1024, rowbase + t0, Bt + (size_t)ntile * 256 * 1024, 1024, 1024, smem);
#pragma unroll
    for (int mt = 0; mt < 8; ++mt)
#pragma unroll
      for (int e = 0; e < 4; ++e) {
        uint2 o; o.x = pack2(acc[mt][0][e], acc[mt][1][e]); o.y = pack2(acc[mt][2][e], acc[mt][3][e]);
        *(uint2*)(smem + (wm * 128 + mt * 16 + g * 4 + e) * TS + (wn * 64 + r16 * 4) * 2) = o;
      }
    __syncthreads();
    {
      const int ch = (tid & 31) * 4, rgp = tid >> 5; const int ca = ntile * 128 + ch, cbx = 2816 + ca;
      const float4 wa0 = *(const float4*)(cw + ca), wa1 = *(const float4*)(cw + 5632 + ca), wa2 = *(const float4*)(cw + 2 * 5632 + ca), wab = *(const float4*)(cb + ca);
      const float4 wb0 = *(const float4*)(cw + cbx), wb1 = *(const float4*)(cw + 5632 + cbx), wb2 = *(const float4*)(cw + 2 * 5632 + cbx), wbb = *(const float4*)(cb + cbx);
      for (int r = r0 + rgp; r <= r1; r += 16) {
        const int tok = t0 + r;
        if (tok < len) {
          const char* Tr = smem + r * TS + ch * 2;
          const uint2 z2 = make_uint2(0u, 0u);
          const uint2 ua = *(const uint2*)(Tr), ub = *(const uint2*)(Tr + 256);
          const uint2 pa = tok >= 1 ? *(const uint2*)(Tr - TS) : z2, pb_ = tok >= 1 ? *(const uint2*)(Tr - TS + 256) : z2;
          const uint2 na = tok + 1 < len ? *(const uint2*)(Tr + TS) : z2, nb = tok + 1 < len ? *(const uint2*)(Tr + TS + 256) : z2;
          const float av0 = wa0.x * bflo(pa.x) + wa1.x * bflo(ua.x) + wa2.x * bflo(na.x) + wab.x;
          const float av1 = wa0.y * bfhi(pa.x) + wa1.y * bfhi(ua.x) + wa2.y * bfhi(na.x) + wab.y;
          const float av2 = wa0.z * bflo(pa.y) + wa1.z * bflo(ua.y) + wa2.z * bflo(na.y) + wab.z;
          const float av3 = wa0.w * bfhi(pa.y) + wa1.w * bfhi(ua.y) + wa2.w * bfhi(na.y) + wab.w;
          const float bv0 = wb0.x * bflo(pb_.x) + wb1.x * bflo(ub.x) + wb2.x * bflo(nb.x) + wbb.x;
          const float bv1 = wb0.y * bfhi(pb_.x) + wb1.y * bfhi(ub.x) + wb2.y * bfhi(nb.x) + wbb.y;
          const float bv2 = wb0.z * bflo(pb_.y) + wb1.z * bflo(ub.y) + wb2.z * bflo(nb.y) + wbb.z;
          const float bv3 = wb0.w * bfhi(pb_.y) + wb1.w * bfhi(ub.y) + wb2.w * bfhi(nb.y) + wbb.w;
          uint2 o; o.x = pack2(siluf_(av0) * bv0, siluf_(av1) * bv1); o.y = pack2(siluf_(av2) * bv2, siluf_(av3) * bv3);
          *(uint2*)(HID + (size_t)(rowbase + tok) * 2816 + ca) = o;
        }
      }
    }
  }
}

#ifndef REP_PREP
#define REP_PREP 1
#endif
#ifndef REP_GEMM
#define REP_GEMM 1
#endif
#ifndef REP_HY
#define REP_HY 1
#endif
#ifndef REP_RWP
#define REP_RWP 1
#endif
#ifndef REP_SCAN
#define REP_SCAN 1
#endif
#ifndef REP_ATTN
#define REP_ATTN 1
#endif
#ifndef PH_END
#define PH_END 24
#endif
#define XB_TMO      128
#define XB_XCNT(j)  (256  + 64 * (j))
#define XB_XSUB(j)  (1280 + 64 * (j))
#define XB_XGEN(j)  (2304 + 64 * (j))
#define XB_TOP      3328
#define XB_TOPGEN   3392
#define XCD_BAR_WORDS 3456
#define XB_SPIN_CAP (1u << 22)
DI unsigned xb_ld(unsigned* p) { return __hip_atomic_load(p, __ATOMIC_RELAXED, __HIP_MEMORY_SCOPE_AGENT); }
DI unsigned xb_add(unsigned* p, unsigned v) { return __hip_atomic_fetch_add(p, v, __ATOMIC_RELAXED, __HIP_MEMORY_SCOPE_AGENT); }
DI unsigned xb_xcc_id() { return (unsigned)__builtin_amdgcn_s_getreg((3 << 11) | 20) & 0xFu; }
#define XB_SPIN(cond, bar) do { unsigned _sp = 0; while (cond) { __builtin_amdgcn_s_sleep(1); \
    if ((++_sp & 255u) == 0u) { if (xb_ld(&(bar)[XB_TMO])) break; if (_sp > XB_SPIN_CAP) { atomicAdd(&(bar)[XB_TMO], 1u); break; } } } } while (0)
DI void xcd_barrier_complete(unsigned* bar, unsigned x, unsigned& nloc, unsigned& nx) {
  const unsigned G = gridDim.x;
  unsigned sum, cnt, mine, sp = 0u;
  for (;;) {
    sum = 0u; cnt = 0u; mine = 0u;
#pragma unroll
    for (unsigned j = 0; j < 16; ++j) { const unsigned c = xb_ld(&bar[XB_XCNT(j)]); sum += c; cnt += (c > 0u) ? 1u : 0u; mine = (j == x) ? c : mine; }
    if (sum == G) break;
    __builtin_amdgcn_s_sleep(1);
    if ((++sp & 255u) == 0u) { if (xb_ld(&bar[XB_TMO])) break; if (sp > XB_SPIN_CAP) { atomicAdd(&bar[XB_TMO], 1u); break; } }
  }
  nloc = mine > 0u ? mine : 1u; nx = cnt > 0u ? cnt : 1u;
}
DI void grid_barrier(unsigned* bar, volatile unsigned* st) {
  asm volatile("s_waitcnt vmcnt(0)" ::: "memory");
  __syncthreads();
  if (my_tid() == 0) {
    const unsigned x = xb_xcc_id();
    __builtin_amdgcn_s_waitcnt(0);
    unsigned nloc = st[0], nx = st[1];
    if (nloc == 0u) { xcd_barrier_complete(bar, x, nloc, nx); st[0] = nloc; st[1] = nx; }
    const unsigned old = xb_add(&bar[XB_XSUB(x)], 1u);
    const unsigned gen = old / nloc;
    if (old + 1u == (gen + 1u) * nloc) {
      __builtin_amdgcn_fence(__ATOMIC_RELEASE, "agent");
      asm volatile("s_waitcnt vmcnt(0)" ::: "memory");
      const unsigned og = xb_add(&bar[XB_TOP], 1u);
      const unsigned tg = og / nx;
      if (og + 1u == (tg + 1u) * nx) xb_add(&bar[XB_TOPGEN], 1u);
      else XB_SPIN(xb_ld(&bar[XB_TOPGEN]) == tg, bar);
      __builtin_amdgcn_fence(__ATOMIC_ACQUIRE, "agent");
      xb_add(&bar[XB_XGEN(x)], 1u);
      asm volatile("s_waitcnt vmcnt(0)" ::: "memory");
    } else {
      XB_SPIN(xb_ld(&bar[XB_XGEN(x)]) == gen, bar);
      __builtin_amdgcn_fence(__ATOMIC_ACQUIRE, "agent");
      asm volatile("s_waitcnt vmcnt(0)" ::: "memory");
    }
  }
  __syncthreads();
}
#define SYNC_OR_RET(idx) do { if ((idx) + 1 >= PH_END) return; if ((idx) == 0) { grid.sync(); if (my_tid() == 0) (void)xb_add(&((unsigned*)(p.ws + MISC_XBAR))[XB_XCNT(xb_xcc_id())], 1u); } else grid_barrier((unsigned*)(p.ws + MISC_XBAR), (volatile unsigned*)(smem + 144 * 1024)); } while (0)
template <int l>
DI void run_layer(const Params& p, cg::grid_group& grid, char* smem, unsigned& epoch) {
  const float* mod = (const float*)(p.ws + MISC_MOD) + (size_t)l * 9 * 6144;
  float* hc = (float*)(p.ws + OFF_HC);
  const float* hl_src = (l == 0) ? p.in[0] : p.out;
  const float* hc_src = (l == 0) ? p.in[2] : hc;
  constexpr int B0 = l * 12;
  if (l == 0) {
    ph_convert(p, 0, smem);
    ph_ada(p, smem);
    hy_rawfilter(p, 0, SL, (float*)(p.ws + R_RAWF), smem);
    hy_rawfilter(p, 0, CL, (float*)(p.ws + MISC_RAWC), smem);
    SYNC_OR_RET(B0 + 0);
    ph_kf(p, 0, smem);
    ph_ln(hl_src, hc_src, nullptr, nullptr, nullptr, nullptr, (bf16_t*)p.out, mod, 0, MT);
    SYNC_OR_RET(B0 + 1);
  }
  for (int rep = 0; rep < REP_GEMM; ++rep) ph_inproj(p, l == 0 ? (const bf16_t*)p.out : (const bf16_t*)(p.ws + R_U), smem);
  SYNC_OR_RET(B0 + 2);
  for (int rep = 0; rep < REP_HY; ++rep) {
  if (blockIdx.x == 0 && my_tid() == 0) *(unsigned*)(p.ws + MISC_BAR + 64 + 64 * l) = 0u;
  ph_hyena(p, l, smem);
  if (l == 0) ph_hyena_ctx(p, l, smem);
  }
  ph_rope(p, smem);
  for (int rep = 0; rep < REP_RWP; ++rep) ph_rwprep(p, l, smem);
  SYNC_OR_RET(B0 + 3);
  for (int rep = 0; rep < REP_SCAN; ++rep) ph_scan(p, smem);
  for (int rep = 0; rep < REP_ATTN; ++rep) ph_attn(p, l, smem);
  SYNC_OR_RET(B0 + 4);
  ph_rwout(p, l);
  if (l != 0) ph_ln(hl_src, hc_src, nullptr, nullptr, nullptr, nullptr, (bf16_t*)(p.ws + R_URE), mod, 0, ML);
  SYNC_OR_RET(B0 + 5);
  for (int rep = 0; rep < REP_GEMM; ++rep) ph_merge(p, l, l == 0 ? (const bf16_t*)p.out : (const bf16_t*)(p.ws + R_URE), smem);
  SYNC_OR_RET(B0 + 6);
  ph_resgemm(p, l, (const bf16_t*)(p.ws + R_ACC), 1024, (const bf16_t*)(p.ws + WB_OUT), hl_src, hc_src, 2048, smem);
  if (l == 0) hy_rawfilter(p, 1, SL, (float*)(p.ws + R_RAWF), smem);
  SYNC_OR_RET(B0 + 7);
  ph_ln(p.out, hc, p.out, hc, p.in[35] + (size_t)l * D, p.in[36] + (size_t)l * D, (bf16_t*)(p.ws + R_U), mod, 3072, l == 0 ? MT : ML);
  if (l == 0) ph_kf(p, 1, smem);
  SYNC_OR_RET(B0 + 8);
  for (int rep = 0; rep < REP_GEMM; ++rep) ph_ffnup(p, l, smem);
  SYNC_OR_RET(B0 + 9);
  ph_resgemm(p, l, (const bf16_t*)(p.ws + R_HID), 2816, (const bf16_t*)(p.ws + WB_DOWN), p.out, hc, 5120, smem);
  SYNC_OR_RET(B0 + 10);
  if (l == 0) {
    ph_ln(p.out, hc, p.out, hc, p.in[41], p.in[42], (bf16_t*)(p.ws + R_U), mod + 9 * 6144, 0, MT);
    ph_convert(p, 1, smem);
  } else {
    ph_ln(p.out, hc, p.out, hc, p.in[41] + (size_t)l * D, p.in[42] + (size_t)l * D, nullptr, mod, 0, ML);
  }
  SYNC_OR_RET(B0 + 11);
}

__global__ void __launch_bounds__(NTHR) mega(Params p) {
  extern __shared__ __attribute__((aligned(16))) char smem[];
  cg::grid_group grid = cg::this_grid();
  unsigned epoch = 0;
  if (blockIdx.x == 0) for (int i = my_tid(); i < XCD_BAR_WORDS; i += NTHR) ((unsigned*)(p.ws + MISC_XBAR))[i] = 0u;
  if (my_tid() < 2) ((volatile unsigned*)(smem + 144 * 1024))[my_tid()] = 0u;
  if (blockIdx.x == 0 && my_tid() < 64) *(unsigned*)(p.ws + MISC_ZERO + my_tid() * 4) = 0u;
  run_layer<0>(p, grid, smem, epoch);
  if (PH_END > 12) run_layer<1>(p, grid, smem, epoch);
}

extern "C" void kernel_launch(void* const* d_in, const int* in_sizes, int n_in, void* d_out, int out_size,
                              void* d_ws, size_t ws_size, hipStream_t stream) {
  static int grid_blocks = 0;
  if (!grid_blocks) {
    int dev = 0, cus = 0, per_cu = 0;
    (void)hipGetDevice(&dev);
    (void)hipDeviceGetAttribute(&cus, hipDeviceAttributeMultiprocessorCount, dev);
    (void)hipFuncSetAttribute((const void*)mega, hipFuncAttributeMaxDynamicSharedMemorySize, SMEM_BYTES);
    (void)hipOccupancyMaxActiveBlocksPerMultiprocessor(&per_cu, mega, NTHR, SMEM_BYTES);
    if (per_cu < 1) per_cu = 1;
    if (per_cu > 1) per_cu = 1;
    grid_blocks = cus * per_cu;
  }
  Params p{};
  for (int i = 0; i < 43; ++i) p.in[i] = (const float*)d_in[i];
  p.out = (float*)d_out; p.ws = (char*)d_ws;
  void* args[] = {&p};
  hipError_t e = hipLaunchCooperativeKernel((void*)mega, dim3(grid_blocks), dim3(NTHR), args, SMEM_BYTES, stream);
  if (e != hipSuccess) fprintf(stderr, "cooperative launch failed: %s (grid %d)\n", hipGetErrorString(e), grid_blocks);
}
```

```cpp
#include <hip/hip_runtime.h>
#include <hip/hip_cooperative_groups.h>
#include <cstdio>
#include <cstdint>
namespace cg = cooperative_groups;

#define DI __device__ __forceinline__
typedef unsigned short bf16_t;
typedef short bf16x8 __attribute__((ext_vector_type(8)));
typedef float f32x4 __attribute__((ext_vector_type(4)));

constexpr int D = 1024, NB = 8, SL = 4096, CL = 256;
constexpr int ML = NB * SL, MC = NB * CL, MT = ML + MC;
constexpr int KEYS = SL + CL;
constexpr int NTHR = 512;
constexpr float DN_ALPHA = 1.41421356237f;
constexpr size_t UNIT = (size_t)MT * 512;

constexpr size_t WB_IN = 0;
constexpr size_t WB_GATE = WB_IN + (size_t)3328 * 1024 * 2;
constexpr size_t WB_BR = WB_GATE + (size_t)4096 * 1024 * 2;
constexpr size_t WB_OUT = WB_BR + (size_t)4 * 1024 * 256 * 2;
constexpr size_t WB_UP = WB_OUT + (size_t)1024 * 1024 * 2;
constexpr size_t WB_DOWN = WB_UP + (size_t)5632 * 1024 * 2;
constexpr size_t WB_END = WB_DOWN + (size_t)1024 * 2816 * 2;
constexpr size_t OFF_KF = WB_END;
constexpr size_t OFF_HC = OFF_KF + (size_t)512 * 8192 * 8;
constexpr size_t OFF_MISC = OFF_HC + (size_t)MC * D * 4;
constexpr size_t MISC_MOD = OFF_MISC;
constexpr size_t MISC_TW = MISC_MOD + (size_t)2 * 9 * 6144 * 4;
constexpr size_t MISC_RAWC = MISC_TW + 4096 * 8;
constexpr size_t MISC_GCTX = MISC_RAWC + (size_t)256 * 1024 * 4;
constexpr size_t MISC_RWW = MISC_GCTX + (size_t)512 * 512 * 4;
constexpr size_t RWW_F = MISC_RWW, RWW_B = RWW_F + 256 * 64 * 2, RWW_A = RWW_B + 256 * 64 * 2, RWW_GF = RWW_A + 256 * 64 * 2, RWW_GB = RWW_GF + 256 * 128 * 2;
constexpr size_t MISC_XBAR = OFF_MISC + (size_t)3 * 1024 * 1024;
constexpr size_t OFF_R = OFF_MISC + (size_t)4 * 1024 * 1024;
constexpr size_t MISC_BAR = OFF_R - 256;
constexpr size_t MISC_ZERO = OFF_R - 512;
static_assert(RWW_GB + 256 * 128 * 2 <= MISC_ZERO, "misc overflow");
constexpr size_t R_YHY = OFF_R, R_YSW = OFF_R + UNIT, R_YDF = OFF_R + 2 * UNIT;
constexpr size_t R_PHY = OFF_R + 3 * UNIT;
constexpr size_t R_PSW = OFF_R + 6 * UNIT;
constexpr size_t R_VTSW = R_PSW + (size_t)MT * 384 * 2;
constexpr size_t R_PDF = OFF_R + 8 * UNIT;
constexpr size_t R_VTDF = OFF_R + 10 * UNIT;
constexpr size_t R_PRW = OFF_R + 11 * UNIT;
constexpr size_t R_STR = R_PRW + (size_t)MT * 1216 * 2;
constexpr size_t R_G = R_STR + 7 * UNIT;
constexpr size_t R_END = R_G + 2 * UNIT;
constexpr size_t R_RAWF = OFF_R;
constexpr size_t R_OF = R_PHY, R_OB = R_PHY + UNIT;
constexpr size_t R_URE = R_PSW;
constexpr size_t R_YRW = R_VTDF;
constexpr size_t R_ACC = R_PRW;
constexpr size_t R_U = R_STR;
constexpr size_t R_HID = OFF_R;
static_assert(R_END <= (size_t)512 * 1024 * 1024, "ws overflow");
static_assert((size_t)MT * 2816 * 2 <= 11 * UNIT, "hid");

constexpr int SMEM_BYTES = 144 * 1024 + 64;

struct Params {
  const float* in[43];
  float* out;
  char* ws;
};

DI int my_tid() { int t = (int)__builtin_amdgcn_workitem_id_x(); asm volatile("" : "+v"(t)); return t; }
DI unsigned f2bf(float f) { unsigned u = __float_as_uint(f); u += 0x7fffu + ((u >> 16) & 1u); return u >> 16; }
DI float bf2f(unsigned h) { return __uint_as_float(h << 16); }
typedef __bf16 bf16v2_t __attribute__((ext_vector_type(2)));
typedef float f32v2_t __attribute__((ext_vector_type(2)));
DI unsigned pack2(float lo, float hi) { f32v2_t v = {lo, hi}; bf16v2_t b = __builtin_convertvector(v, bf16v2_t); return __builtin_bit_cast(unsigned, b); }

DI float bflo(unsigned w) { return __uint_as_float(w << 16); }
DI float bfhi(unsigned w) { return __uint_as_float(w & 0xffff0000u); }
DI float sigmoidf_(float x) { return __builtin_amdgcn_rcpf(1.f + __expf(-x)); }
DI float siluf_(float x) { return x * __builtin_amdgcn_rcpf(1.f + __expf(-x)); }
DI float wave_sum(float v) {
#pragma unroll
  for (int o = 32; o >= 1; o >>= 1) v += __shfl_xor(v, o);
  return v;
}
template <int CTRL> DI float dpp_mov(float v) {
  return __int_as_float(__builtin_amdgcn_update_dpp(0, __float_as_int(v), CTRL, 0xf, 0xf, false));
}
DI float sum16(float v) {
  v += dpp_mov<0xB1>(v);
  v += dpp_mov<0x4E>(v);
  v += dpp_mov<0x141>(v);
  v += dpp_mov<0x140>(v);
  return v;
}
DI void lds_barrier() { asm volatile("s_waitcnt lgkmcnt(0)" ::: "memory"); __builtin_amdgcn_s_barrier(); asm volatile("" ::: "memory"); }
DI uint4 sel4(bool z, uint4 v) { return make_uint4(z ? 0u : v.x, z ? 0u : v.y, z ? 0u : v.z, z ? 0u : v.w); }
DI int mod_idx(int row) { return row < ML ? (row >> 12) : 8; }

template <int NTW, bool DEEP, class RowFn>
DI void gemm_main(f32x4 (&acc)[4][NTW], const bf16_t* __restrict__ A, int lda, RowFn rowfn,
                  const bf16_t* __restrict__ Bt, int ldb, int K, char* smem) {
  constexpr int BN = NTW * 32;
  constexpr int A_BYTES = 256 * 128, B_BYTES = BN * 128, STAGE = A_BYTES + B_BYTES;
  constexpr int NBL = BN / 64;
  const int tid = my_tid(), lane = tid & 63, wid = tid >> 6, wm = wid >> 1, wn = wid & 1, g = lane >> 4, r16 = lane & 15;
  const int chunk = tid & 7, lrow = tid >> 3;
  long a0 = rowfn(lrow), a1 = rowfn(lrow + 64), a2 = rowfn(lrow + 128), a3 = rowfn(lrow + 192);
  const long c0 = a0 < 0 ? 0 : a0, c1 = a1 < 0 ? 0 : a1, c2 = a2 < 0 ? 0 : a2, c3 = a3 < 0 ? 0 : a3;
  const bf16_t* Bp = Bt + (long)lrow * ldb + chunk * 8;
  const bf16_t* Ap0 = A + c0 * lda + chunk * 8; const bf16_t* Ap1 = A + c1 * lda + chunk * 8;
  const bf16_t* Ap2 = A + c2 * lda + chunk * 8; const bf16_t* Ap3 = A + c3 * lda + chunk * 8;
  struct Regs { uint4 a0, a1, a2, a3, b0, b1; };
  Regs R0, R1;
  R0.b1 = make_uint4(0, 0, 0, 0); R1.b1 = make_uint4(0, 0, 0, 0);
  auto GLOAD = [&](Regs& R, int k0) {
    R.a0 = *(const uint4*)(Ap0 + k0); R.a1 = *(const uint4*)(Ap1 + k0);
    R.a2 = *(const uint4*)(Ap2 + k0); R.a3 = *(const uint4*)(Ap3 + k0);
    R.b0 = *(const uint4*)(Bp + k0);
    if constexpr (NBL > 1) R.b1 = *(const uint4*)(Bp + (long)64 * ldb + k0);
  };
  auto SSTORE = [&](const Regs& R, int st) {
    char* base = smem + st * STAGE + lrow * 128 + ((chunk ^ (lrow & 7)) << 4);
    *(uint4*)(base) = sel4(a0 < 0, R.a0); *(uint4*)(base + 64 * 128) = sel4(a1 < 0, R.a1);
    *(uint4*)(base + 128 * 128) = sel4(a2 < 0, R.a2); *(uint4*)(base + 192 * 128) = sel4(a3 < 0, R.a3);
    *(uint4*)(base + A_BYTES) = R.b0;
    if constexpr (NBL > 1) *(uint4*)(base + A_BYTES + 64 * 128) = R.b1;
  };
  auto COMPUTE = [&](int st) {
    const char* As = smem + st * STAGE + (wm * 64 + r16) * 128;
    const char* Bs = smem + st * STAGE + A_BYTES + (wn * (NTW * 16) + r16) * 128;
#pragma unroll
    for (int kk = 0; kk < 2; ++kk) {
      const int sw = ((kk * 4 + g) ^ (r16 & 7)) << 4;
      bf16x8 af[4], bfr[NTW];
#pragma unroll
      for (int mt = 0; mt < 4; ++mt) af[mt] = *(const bf16x8*)(As + mt * 16 * 128 + sw);
#pragma unroll
      for (int nt = 0; nt < NTW; ++nt) bfr[nt] = *(const bf16x8*)(Bs + nt * 16 * 128 + sw);
#pragma unroll
      for (int mt = 0; mt < 4; ++mt)
#pragma unroll
        for (int nt = 0; nt < NTW; ++nt)
          acc[mt][nt] = __builtin_amdgcn_mfma_f32_16x16x32_bf16(af[mt], bfr[nt], acc[mt][nt], 0, 0, 0);
    }
  };
  const int nk = K >> 6;
  __syncthreads();
  GLOAD(R0, 0);
  SSTORE(R0, 0);
  if constexpr (DEEP) {
    GLOAD(R0, 64);
    if (nk > 2) GLOAD(R1, 128);
    lds_barrier();
    bf16x8 fa0[4], fb0[NTW], fa1[4], fb1[NTW];
    auto READF = [&](bf16x8 (&fa)[4], bf16x8 (&fb)[NTW], int st, int kk) {
      const int sw = ((kk * 4 + g) ^ (r16 & 7)) << 4;
      const char* As = smem + st * STAGE + (wm * 64 + r16) * 128 + sw;
      const char* Bs = smem + st * STAGE + A_BYTES + (wn * (NTW * 16) + r16) * 128 + sw;
#pragma unroll
      for (int mt = 0; mt < 4; ++mt) fa[mt] = *(const bf16x8*)(As + mt * 16 * 128);
#pragma unroll
      for (int nt = 0; nt < NTW; ++nt) fb[nt] = *(const bf16x8*)(Bs + nt * 16 * 128);
    };
    auto MMA = [&](const bf16x8 (&fa)[4], const bf16x8 (&fb)[NTW]) {
#pragma unroll
      for (int mt = 0; mt < 4; ++mt)
#pragma unroll
        for (int nt = 0; nt < NTW; ++nt)
          acc[mt][nt] = __builtin_amdgcn_mfma_f32_16x16x32_bf16(fa[mt], fb[nt], acc[mt][nt], 0, 0, 0);
    };
    READF(fa0, fb0, 0, 0);
    for (int kt = 0; kt < nk; kt += 2) {
      READF(fa1, fb1, 0, 1);
      MMA(fa0, fb0);
#pragma unroll
      for (int i = 0; i < 4 + NTW; ++i) { __builtin_amdgcn_sched_group_barrier(0x100, 1, 0); __builtin_amdgcn_sched_group_barrier(0x008, 2, 0); }
      __builtin_amdgcn_sched_barrier(0);
      SSTORE(R0, 1);
      if (kt + 3 < nk) GLOAD(R0, (kt + 3) * 64);
      MMA(fa1, fb1);
#pragma unroll
      for (int i = 0; i < 6; ++i) { __builtin_amdgcn_sched_group_barrier(0x200, 1, 0); __builtin_amdgcn_sched_group_barrier(0x020, 1, 0); __builtin_amdgcn_sched_group_barrier(0x008, 2, 0); }
      __builtin_amdgcn_sched_barrier(0);
      lds_barrier();
      READF(fa0, fb0, 1, 0);
      READF(fa1, fb1, 1, 1);
      MMA(fa0, fb0);
#pragma unroll
      for (int i = 0; i < 4 + NTW; ++i) { __builtin_amdgcn_sched_group_barrier(0x100, 1, 0); __builtin_amdgcn_sched_group_barrier(0x008, 2, 0); }
      __builtin_amdgcn_sched_barrier(0);
      if (kt + 2 < nk) SSTORE(R1, 0);
      if (kt + 4 < nk) GLOAD(R1, (kt + 4) * 64);
      MMA(fa1, fb1);
#pragma unroll
      for (int i = 0; i < 6; ++i) { __builtin_amdgcn_sched_group_barrier(0x200, 1, 0); __builtin_amdgcn_sched_group_barrier(0x020, 1, 0); __builtin_amdgcn_sched_group_barrier(0x008, 2, 0); }
      __builtin_amdgcn_sched_barrier(0);
      lds_barrier();
      if (kt + 2 < nk) READF(fa0, fb0, 0, 0);
    }
  } else {
    lds_barrier();
    for (int kt = 0; kt < nk; ++kt) {
      const int st = kt & 1;
      if (kt + 1 < nk) GLOAD(R0, (kt + 1) * 64);
      __builtin_amdgcn_sched_barrier(0);
      COMPUTE(st);
      __builtin_amdgcn_sched_barrier(0);
      if (kt + 1 < nk) SSTORE(R0, st ^ 1);
      lds_barrier();
    }
  }
}

#define GLDS16(gp, lp) __builtin_amdgcn_global_load_lds((const unsigned*)(gp), (unsigned*)(lp), 16, 0, 0)
template <class RowFn>
DI void gemm_glds(f32x4 (&acc)[4][4], const bf16_t* __restrict__ A, int lda, RowFn rowfn,
                  const bf16_t* __restrict__ Bt, int ldb, int K, char* smem, const bf16_t* zrow) {
  constexpr int A_BYTES = 256 * 128, STAGE = A_BYTES + 128 * 128;
  const int tid = my_tid(), lane = tid & 63, wid = tid >> 6, wm = wid >> 1, wn = wid & 1, g = lane >> 4, r16 = lane & 15;
  const int lrow = tid >> 3, c = (tid & 7) ^ (lrow & 7);
  const long a0 = rowfn(lrow), a1 = rowfn(lrow + 64), a2 = rowfn(lrow + 128), a3 = rowfn(lrow + 192);
  const bf16_t* pa0 = (a0 >= 0 ? A + a0 * lda : zrow) + c * 8; const int m0 = a0 >= 0 ? 1 : 0;
  const bf16_t* pa1 = (a1 >= 0 ? A + a1 * lda : zrow) + c * 8; const int m1 = a1 >= 0 ? 1 : 0;
  const bf16_t* pa2 = (a2 >= 0 ? A + a2 * lda : zrow) + c * 8; const int m2 = a2 >= 0 ? 1 : 0;
  const bf16_t* pa3 = (a3 >= 0 ? A + a3 * lda : zrow) + c * 8; const int m3 = a3 >= 0 ? 1 : 0;
  const bf16_t* pb0 = Bt + (long)lrow * ldb + c * 8; const bf16_t* pb1 = pb0 + (long)64 * ldb;
  auto ISSUE = [&](int kt, int bi) {
    char* d = smem + bi * STAGE + tid * 16;
    const int k0 = kt * 64;
    GLDS16(pa0 + k0 * m0, d); GLDS16(pa1 + k0 * m1, d + 8192); GLDS16(pa2 + k0 * m2, d + 16384); GLDS16(pa3 + k0 * m3, d + 24576);
    GLDS16(pb0 + k0, d + A_BYTES); GLDS16(pb1 + k0, d + A_BYTES + 8192);
  };
  auto COMPUTE = [&](int bi) {
    const char* As = smem + bi * STAGE + (wm * 64 + r16) * 128;
    const char* Bs = smem + bi * STAGE + A_BYTES + (wn * 64 + r16) * 128;
#pragma unroll
    for (int kk = 0; kk < 2; ++kk) {
      const int sw = ((kk * 4 + g) ^ (r16 & 7)) << 4;
      bf16x8 af[4], bfr[4];
#pragma unroll
      for (int mt = 0; mt < 4; ++mt) af[mt] = *(const bf16x8*)(As + mt * 16 * 128 + sw);
#pragma unroll
      for (int nt = 0; nt < 4; ++nt) bfr[nt] = *(const bf16x8*)(Bs + nt * 16 * 128 + sw);
      __builtin_amdgcn_s_setprio(1);
#pragma unroll
      for (int mt = 0; mt < 4; ++mt)
#pragma unroll
        for (int nt = 0; nt < 4; ++nt)
          acc[mt][nt] = __builtin_amdgcn_mfma_f32_16x16x32_bf16(af[mt], bfr[nt], acc[mt][nt], 0, 0, 0);
      __builtin_amdgcn_s_setprio(0);
    }
  };
  const int nk = K >> 6;
  __syncthreads();
  ISSUE(0, 0);
  ISSUE(1, 1);
  asm volatile("s_waitcnt vmcnt(6)" ::: "memory");
  __builtin_amdgcn_s_barrier();
  asm volatile("" ::: "memory");
  int bi = 0;
  for (int kt = 0; kt < nk; ++kt) {
    const int b2 = bi >= 1 ? bi - 1 : 2;
    if (kt + 2 < nk) ISSUE(kt + 2, b2);
    COMPUTE(bi);
    if (kt + 2 < nk) asm volatile("s_waitcnt vmcnt(6)" ::: "memory");
    else asm volatile("s_waitcnt vmcnt(0)" ::: "memory");
    asm volatile("s_waitcnt lgkmcnt(0)" ::: "memory");
    __builtin_amdgcn_s_barrier();
    asm volatile("" ::: "memory");
    bi = bi == 2 ? 0 : bi + 1;
  }
}

DI void gemm_glds256(f32x4 (&acc)[8][4], const bf16_t* __restrict__ A, int lda, long arow0,
                     const bf16_t* __restrict__ Bt, int ldb, int K, char* smem) {
  constexpr int A_BYTES = 256 * 128, STAGE = 2 * A_BYTES;
  const int tid = my_tid(), lane = tid & 63, wid = tid >> 6, wm = wid >> 2, wn = wid & 3, g = lane >> 4, r16 = lane & 15;
  const int lrow = tid >> 3, c = (tid & 7) ^ (lrow & 7);
  const bf16_t* pa = A + (arow0 + lrow) * (long)lda + c * 8;
  const bf16_t* pb = Bt + (long)lrow * ldb + c * 8;
  const long a64 = (long)64 * lda, b64 = (long)64 * ldb;
  auto ISSUE = [&](int kt, int bi) {
    char* d = smem + bi * STAGE + tid * 16;
    const int k0 = kt * 64;
    GLDS16(pa + k0, d); GLDS16(pa + a64 + k0, d + 8192); GLDS16(pa + 2 * a64 + k0, d + 16384); GLDS16(pa + 3 * a64 + k0, d + 24576);
    GLDS16(pb + k0, d + A_BYTES); GLDS16(pb + b64 + k0, d + A_BYTES + 8192); GLDS16(pb + 2 * b64 + k0, d + A_BYTES + 16384); GLDS16(pb + 3 * b64 + k0, d + A_BYTES + 24576);
  };
  auto COMPUTE = [&](int bi) {
    const char* As = smem + bi * STAGE + (wm * 128 + r16) * 128;
    const char* Bs = smem + bi * STAGE + A_BYTES + (wn * 64 + r16) * 128;
#pragma unroll
    for (int kk = 0; kk < 2; ++kk) {
      const int sw = ((kk * 4 + g) ^ (r16 & 7)) << 4;
      bf16x8 bfr[4];
#pragma unroll
      for (int nt = 0; nt < 4; ++nt) bfr[nt] = *(const bf16x8*)(Bs + nt * 16 * 128 + sw);
      __builtin_amdgcn_s_setprio(1);
#pragma unroll
      for (int mt = 0; mt < 8; ++mt) {
        const bf16x8 af = *(const bf16x8*)(As + mt * 16 * 128 + sw);
#pragma unroll
        for (int nt = 0; nt < 4; ++nt)
          acc[mt][nt] = __builtin_amdgcn_mfma_f32_16x16x32_bf16(af, bfr[nt], acc[mt][nt], 0, 0, 0);
      }
      __builtin_amdgcn_s_setprio(0);
    }
  };
  const int nk = K >> 6;
  __syncthreads();
  ISSUE(0, 0);
  asm volatile("s_waitcnt vmcnt(0)" ::: "memory");
  __builtin_amdgcn_s_barrier();
  asm volatile("" ::: "memory");
  int bi = 0;
  for (int kt = 0; kt < nk; ++kt) {
    if (kt + 1 < nk) ISSUE(kt + 1, bi ^ 1);
    COMPUTE(bi);
    asm volatile("s_waitcnt vmcnt(0)" ::: "memory");
    asm volatile("s_waitcnt lgkmcnt(0)" ::: "memory");
    __builtin_amdgcn_s_barrier();
    asm volatile("" ::: "memory");
    bi ^= 1;
  }
}
DI void zero_acc256(f32x4 (&acc)[8][4]) {
#pragma unroll
  for (int i = 0; i < 8; ++i)
#pragma unroll
    for (int j = 0; j < 4; ++j) acc[i][j] = (f32x4){0.f, 0.f, 0.f, 0.f};
}

DI bool next_tile(int i, int MTILES, int NTILES, int& mt, int& nt) {
  const int xcd = blockIdx.x & 7, slot = blockIdx.x >> 3, nslot = gridDim.x >> 3;
  const int m_lo = (MTILES * xcd) >> 3, m_hi = (MTILES * (xcd + 1)) >> 3, Mloc = m_hi - m_lo;
  const int q = i * nslot + slot;
  if (q >= Mloc * NTILES) return false;
  const int gidx = q / (4 * NTILES), m0 = gidx * 4;
  const int rows = (Mloc - m0) < 4 ? (Mloc - m0) : 4;
  const int within = q - gidx * 4 * NTILES;
  nt = within / rows; mt = m_lo + m0 + within % rows;
  return true;
}

struct RowPlain { long base; DI long operator()(int r) const { return base + r; } };
struct RowHalo { long rowbase; int t0; int len; DI long operator()(int r) const { int t = t0 + r; return (t >= 0 && t < len) ? rowbase + t : -1; } };

template <int NTW> DI void zero_acc(f32x4 (&acc)[4][NTW]) {
#pragma unroll
  for (int i = 0; i < 4; ++i)
#pragma unroll
    for (int j = 0; j < NTW; ++j) acc[i][j] = (f32x4){0.f, 0.f, 0.f, 0.f};
}

DI void cvt_unit(const float* __restrict__ src, int ldsrc, int srccol0, int k0, bf16_t* __restrict__ dst, int K, int n0, char* smem, bool perm = true) {
  float* T = (float*)smem;
  const int tid = my_tid();
  __syncthreads();
  if (srccol0 >= 0) {
#pragma unroll
    for (int i = 0; i < 8; ++i) {
      int idx = tid + i * 512; int k = idx >> 6, n = idx & 63;
      T[k * 65 + n] = src[(long)(k0 + k) * ldsrc + srccol0 + n];
    }
  }
  __syncthreads();
  int nd = tid >> 3, kc = (tid & 7) * 8; int n = perm ? ((nd & 15) * 4 + (nd >> 4)) : nd;
  uint4 o = make_uint4(0, 0, 0, 0);
  if (srccol0 >= 0) {
    o.x = pack2(T[(kc + 0) * 65 + n], T[(kc + 1) * 65 + n]);
    o.y = pack2(T[(kc + 2) * 65 + n], T[(kc + 3) * 65 + n]);
    o.z = pack2(T[(kc + 4) * 65 + n], T[(kc + 5) * 65 + n]);
    o.w = pack2(T[(kc + 6) * 65 + n], T[(kc + 7) * 65 + n]);
  }
  *(uint4*)(dst + (long)(n0 + nd) * K + k0 + kc) = o;
}

DI void ph_convert(const Params& p, int l, char* smem) {
  for (int u = blockIdx.x; u < 4508; u += gridDim.x) {
    if (u < 832) {
      int gI = u >> 4, kt = u & 15; int n0 = gI * 64; int sc;
      if (n0 < 1280) sc = n0; else if (n0 < 2048) sc = 2496 + (n0 - 1280); else if (n0 < 3264) sc = 1280 + (n0 - 2048); else sc = -1;
      cvt_unit(p.in[6] + (size_t)l * 1024 * 7360, 7360, sc, kt * 64, (bf16_t*)(p.ws + WB_IN), 1024, n0, smem);
    } else if (u < 1856) {
      int v = u - 832; int gI = v >> 4, kt = v & 15;
      cvt_unit(p.in[6] + (size_t)l * 1024 * 7360, 7360, 3264 + gI * 64, kt * 64, (bf16_t*)(p.ws + WB_GATE), 1024, gI * 64, smem);
    } else if (u < 2112) {
      int v = u - 1856; int gI = v >> 2, kt = v & 3; int j = gI >> 4, gg = gI & 15;
      cvt_unit(p.in[33] + ((size_t)l * 4 + j) * 256 * 1024, 1024, gg * 64, kt * 64, (bf16_t*)(p.ws + WB_BR) + (size_t)j * 1024 * 256, 256, gg * 64, smem);
    } else if (u < 2368) {
      int v = u - 2112; int gI = v >> 4, kt = v & 15;
      cvt_unit(p.in[34] + (size_t)l * 1024 * 1024, 1024, gI * 64, kt * 64, (bf16_t*)(p.ws + WB_OUT), 1024, gI * 64, smem);
    } else if (u < 3776) {
      int v = u - 2368; int gI = v >> 4, kt = v & 15; int nt = gI >> 2, q = gI & 3;
      cvt_unit(p.in[37] + (size_t)l * 1024 * 5632, 5632, (q >> 1) * 2816 + nt * 128 + (q & 1) * 64, kt * 64, (bf16_t*)(p.ws + WB_UP), 1024, gI * 64, smem);
    } else if (u < 4480) {
      int v = u - 3776; int gI = v / 44, kt = v % 44;
      cvt_unit(p.in[40] + (size_t)l * 2816 * 1024, 1024, gI * 64, kt * 64, (bf16_t*)(p.ws + WB_DOWN), 2816, gI * 64, smem);
    } else {
      int v = u - 4480;
      if (v < 4) cvt_unit(p.in[19] + (size_t)l * 2 * 64 * 256, 256, v * 64, 0, (bf16_t*)(p.ws + RWW_F), 64, v * 64, smem);
      else if (v < 8) cvt_unit(p.in[19] + (size_t)l * 2 * 64 * 256 + 64 * 256, 256, (v - 4) * 64, 0, (bf16_t*)(p.ws + RWW_B), 64, (v - 4) * 64, smem);
      else if (v < 12) cvt_unit(p.in[21] + (size_t)l * 64 * 256, 256, (v - 8) * 64, 0, (bf16_t*)(p.ws + RWW_A), 64, (v - 8) * 64, smem);
      else if (v < 20) { int w = v - 12; cvt_unit(p.in[22] + (size_t)l * 2 * 128 * 256, 256, (w >> 1) * 64, (w & 1) * 64, (bf16_t*)(p.ws + RWW_GF), 128, (w >> 1) * 64, smem); }
      else { int w = v - 20; cvt_unit(p.in[22] + (size_t)l * 2 * 128 * 256 + 128 * 256, 256, (w >> 1) * 64, (w & 1) * 64, (bf16_t*)(p.ws + RWW_GB), 128, (w >> 1) * 64, smem); }
    }
  }
}

DI void ph_ada(const Params& p, char* smem) {
  float* S = (float*)smem;
  float* R = S + 9 * 1024;
  const int tid = my_tid();
  bool loaded = false;
  for (int u = blockIdx.x; u < 192; u += gridDim.x) {
    if (!loaded) {
      __syncthreads();
      for (int i = tid; i < 9 * 1024; i += NTHR) { float c = i < 8192 ? p.in[1][i] : p.in[3][i - 8192]; S[i] = siluf_(c); }
      loaded = true;
    }
    __syncthreads();
    int l = u / 96, n0 = (u % 96) * 64;
    int col = tid & 63, ks = tid >> 6;
    const float* W = p.in[4] + (size_t)l * 1024 * 6144 + n0 + col;
    float a[9];
#pragma unroll
    for (int b = 0; b < 9; ++b) a[b] = 0.f;
    for (int k = ks * 128; k < ks * 128 + 128; ++k) {
      float w = W[(size_t)k * 6144];
#pragma unroll
      for (int b = 0; b < 9; ++b) a[b] += S[b * 1024 + k] * w;
    }
#pragma unroll
    for (int b = 0; b < 9; ++b) R[(ks * 9 + b) * 64 + col] = a[b];
    __syncthreads();
    for (int i = tid; i < 9 * 64; i += NTHR) {
      int b = i >> 6, c = i & 63; float s = 0.f;
#pragma unroll
      for (int k2 = 0; k2 < 8; ++k2) s += R[(k2 * 9 + b) * 64 + c];
      s += p.in[5][(size_t)l * 6144 + n0 + c];
      ((float*)(p.ws + MISC_MOD))[((size_t)l * 9 + b) * 6144 + n0 + c] = s;
    }
  }
  for (int i = blockIdx.x * NTHR + tid; i < 4096; i += gridDim.x * NTHR) {
    float s, c; sincospif(-(float)i / 4096.f, &s, &c);
    ((float2*)(p.ws + MISC_TW))[i] = make_float2(c, s);
  }
}

DI void hy_rawfilter(const Params& p, int l, int Lf, float* __restrict__ dst, char* smem) {
  float* W1 = (float*)smem;
  float* W2 = W1 + 33 * 64;
  float* Z = W2 + 64 * 64;
  float* H1 = Z + 16 * 36;
  float* H2 = H1 + 16 * 64;
  const int tid = my_tid();
  const float* w1 = p.in[9] + (size_t)l * 33 * 64; const float* b1 = p.in[10] + l * 64;
  const float* w2 = p.in[11] + (size_t)l * 64 * 64; const float* b2 = p.in[12] + l * 64;
  const float* w3 = p.in[13] + (size_t)l * 64 * 1024; const float* fr = p.in[14] + l * 64;
  const int nunits = Lf / 16;
  bool loaded = false;
  for (int u = blockIdx.x; u < nunits; u += gridDim.x) {
    __syncthreads();
    if (!loaded) {
      for (int i = tid; i < 33 * 64; i += NTHR) W1[i] = w1[i];
      for (int i = tid; i < 64 * 64; i += NTHR) W2[i] = w2[i];
      loaded = true;
    }
    const int t0 = u * 16;
    for (int i = tid; i < 16 * 33; i += NTHR) {
      int tt = i / 33, f = i % 33; int t = t0 + tt; float v;
      if (f == 0) v = (float)t / (float)(Lf - 1);
      else {
        int bi = (f - 1) & 15;
        float wv = 6.283185307179586f * (float)t / (float)Lf;
        float fb = 1e-4f + (15.f - 1e-4f) * (float)bi / 15.f;
        float ang = wv * fb;
        v = (f <= 16) ? cosf(ang) : -sinf(ang);
      }
      Z[tt * 36 + f] = v;
    }
    __syncthreads();
    for (int i = tid; i < 16 * 64; i += NTHR) {
      int tt = i >> 6, f = i & 63; float s = b1[f];
      for (int k = 0; k < 33; ++k) s += Z[tt * 36 + k] * W1[k * 64 + f];
      H1[tt * 64 + f] = sinf(fr[f] * s);
    }
    __syncthreads();
    for (int i = tid; i < 16 * 64; i += NTHR) {
      int tt = i >> 6, f = i & 63; float s = b2[f];
      for (int k = 0; k < 64; ++k) s += H1[tt * 64 + k] * W2[k * 64 + f];
      H2[tt * 64 + f] = sinf(fr[f] * s);
    }
    __syncthreads();
    float a0[16], a1[16];
#pragma unroll
    for (int i = 0; i < 16; ++i) { a0[i] = 0.f; a1[i] = 0.f; }
    for (int k = 0; k < 64; ++k) {
      float wa = w3[k * 1024 + tid], wb = w3[k * 1024 + 512 + tid];
#pragma unroll
      for (int i = 0; i < 16; ++i) { float h = H2[i * 64 + k]; a0[i] += h * wa; a1[i] += h * wb; }
    }
    {
      int w = tid & 255;
      float delta = fabsf(-3.0701134573253944f + (-15.350567286626972f + 3.0701134573253944f) * (float)w / 255.f);
#pragma unroll
      for (int i = 0; i < 16; ++i) {
        float tn = (float)(t0 + i) / (float)(Lf - 1);
        float dec = expf(-tn * delta);
        dst[(size_t)(t0 + i) * 1024 + tid] = a0[i] * dec;
        dst[(size_t)(t0 + i) * 1024 + 512 + tid] = a1[i] * dec;
      }
    }
  }
}

DI float2 cmul(float2 a, float2 b) { return make_float2(a.x * b.x - a.y * b.y, a.x * b.y + a.y * b.x); }
DI float2 cmulc(float2 a, float2 b) { return make_float2(a.x * b.x + a.y * b.y, a.y * b.x - a.x * b.y); }
DI float2 cadd(float2 a, float2 b) { return make_float2(a.x + b.x, a.y + b.y); }
DI float2 csub(float2 a, float2 b) { return make_float2(a.x - b.x, a.y - b.y); }
DI void fft_dif(float2* X, const float2* W) {
  const int tid = my_tid();
  for (int ls = 12; ls >= 2; ls -= 2) {
    const int s = 1 << ls, h = s >> 1;
    __syncthreads();
#pragma unroll
    for (int i = 0; i < 4; ++i) {
      const int bf = tid + i * 512; const int j = bf & (h - 1); const int base = ((bf >> (ls - 1)) << (ls + 1)) + j;
      const float2 x0 = X[base], x1 = X[base + h], x2 = X[base + s], x3 = X[base + s + h];
      const float2 w1 = W[s - 1 + j], w2 = W[h - 1 + j];
      const float2 y0 = cadd(x0, x2), y2 = cmul(csub(x0, x2), w1), y1 = cadd(x1, x3);
      const float2 t = cmul(csub(x1, x3), w1); const float2 y3 = make_float2(t.y, -t.x);
      X[base] = cadd(y0, y1); X[base + h] = cmul(csub(y0, y1), w2);
      X[base + s] = cadd(y2, y3); X[base + s + h] = cmul(csub(y2, y3), w2);
    }
  }
  __syncthreads();
#pragma unroll
  for (int i = 0; i < 4; ++i) {
    const int q = tid + i * 512;
    float4 a = *(float4*)(X + 4 * q), b = *(float4*)(X + 4 * q + 2);
    *(float4*)(X + 4 * q) = make_float4(a.x + a.z, a.y + a.w, a.x - a.z, a.y - a.w);
    *(float4*)(X + 4 * q + 2) = make_float4(b.x + b.z, b.y + b.w, b.x - b.z, b.y - b.w);
  }
  __syncthreads();
}
DI void fft_dit_inv(float2* X, const float2* W) {
  const int tid = my_tid();
  __syncthreads();
#pragma unroll
  for (int i = 0; i < 4; ++i) {
    const int q = tid + i * 512;
    float4 a = *(float4*)(X + 4 * q), b = *(float4*)(X + 4 * q + 2);
    *(float4*)(X + 4 * q) = make_float4(a.x + a.z, a.y + a.w, a.x - a.z, a.y - a.w);
    *(float4*)(X + 4 * q + 2) = make_float4(b.x + b.z, b.y + b.w, b.x - b.z, b.y - b.w);
  }
  for (int ls = 2; ls <= 12; ls += 2) {
    const int s = 1 << ls, h = s >> 1;
    __syncthreads();
#pragma unroll
    for (int i = 0; i < 4; ++i) {
      const int bf = tid + i * 512; const int j = bf & (h - 1); const int base = ((bf >> (ls - 1)) << (ls + 1)) + j;
      const float2 e0 = X[base], e1 = X[base + h], e2 = X[base + s], e3 = X[base + s + h];
      const float2 w1 = W[s - 1 + j], w2 = W[h - 1 + j];
      const float2 t1 = cmulc(e1, w2), t3 = cmulc(e3, w2);
      const float2 u0 = cadd(e0, t1), u1 = csub(e0, t1), u2 = cadd(e2, t3), u3 = csub(e2, t3);
      const float2 a2 = cmulc(u2, w1); const float2 q3 = cmulc(u3, w1); const float2 a3 = make_float2(-q3.y, q3.x);
      X[base] = cadd(u0, a2); X[base + s] = csub(u0, a2);
      X[base + h] = cadd(u1, a3); X[base + s + h] = csub(u1, a3);
    }
  }
  __syncthreads();
}
DI void load_twiddles(const Params& p, float2* W) {
  const float2* tw = (const float2*)(p.ws + MISC_TW);
  for (int i = my_tid(); i < 8191; i += NTHR) {
    const int ls = 31 - __clz(i + 1); const int pos = i + 1 - (1 << ls);
    W[i] = tw[pos << (12 - ls)];
  }
}

DI void ph_kf(const Params& p, int l, char* smem) {
  float2* X = (float2*)smem; float2* W = X + 8192; float* red = (float*)(W + 8192);
  const int tid = my_tid(), lane = tid & 63, wid = tid >> 6;
  const float* rawf = (const float*)(p.ws + R_RAWF);
  float2* kf = (float2*)(p.ws + OFF_KF);
  bool tw = false;
  for (int u = blockIdx.x; u < 256; u += gridDim.x) {
    if (!tw) { load_twiddles(p, W); tw = true; }
    const int o = u >> 7, c = (u & 127) * 2;
    float2 fw[8], bw[8]; float sa = 0.f, sb = 0.f;
#pragma unroll
    for (int i = 0; i < 8; ++i) {
      int t = tid + i * 512;
      fw[i] = *(const float2*)(rawf + (size_t)t * 1024 + o * 512 + c);
      bw[i] = *(const float2*)(rawf + (size_t)t * 1024 + o * 512 + 256 + c);
      sa += fabsf(fw[i].x) + fabsf(bw[i].x); sb += fabsf(fw[i].y) + fabsf(bw[i].y);
    }
    sa = wave_sum(sa); sb = wave_sum(sb);
    __syncthreads();
    if (lane == 0) { red[wid * 2] = sa; red[wid * 2 + 1] = sb; }
    __syncthreads();
    float ta = 0.f, tb = 0.f;
#pragma unroll
    for (int w = 0; w < 8; ++w) { ta += red[w * 2]; tb += red[w * 2 + 1]; }
    const float ia = 1.f / ta, ib = 1.f / tb;
#pragma unroll
    for (int i = 0; i < 8; ++i) {
      int t = tid + i * 512;
      X[t] = make_float2(fw[i].x * ia, fw[i].y * ib);
      if (t >= 1) X[8192 - t] = make_float2(bw[i].x * ia, bw[i].y * ib);
      else X[4096] = make_float2(0.f, 0.f);
    }
    fft_dif(X, W);
    float2* ka = kf + (size_t)(o * 256 + c) * 8192; float2* kb = ka + 8192;
#pragma unroll 4
    for (int i = 0; i < 16; ++i) {
      int pidx = tid + i * 512;
      int k = (int)(__brev((unsigned)pidx) >> 19);
      int k2 = (8192 - k) & 8191;
      int p2 = (int)(__brev((unsigned)k2) >> 19);
      float2 c1 = X[pidx], c2 = X[p2];
      float2 A = make_float2(0.5f * (c1.x + c2.x), 0.5f * (c1.y - c2.y));
      float2 Bv = make_float2(0.5f * (c1.y + c2.y), -0.5f * (c1.x - c2.x));
      ka[pidx] = A; kb[pidx] = Bv;
    }
    __syncthreads();
  }
  if (l == 0) {
    const float* rawc = (const float*)(p.ws + MISC_RAWC);
    float* G = (float*)(p.ws + MISC_GCTX);
    for (int u = blockIdx.x * 8 + wid; u < 512; u += gridDim.x * 8) {
      int o = u >> 8, c = u & 255; float f[4], b[4]; float s = 0.f;
#pragma unroll
      for (int i = 0; i < 4; ++i) {
        int t = lane + i * 64;
        f[i] = rawc[(size_t)t * 1024 + o * 512 + c]; b[i] = rawc[(size_t)t * 1024 + o * 512 + 256 + c];
        s += fabsf(f[i]) + fabsf(b[i]);
      }
      s = wave_sum(s); float inv = 1.f / s;
#pragma unroll
      for (int i = 0; i < 4; ++i) {
        int t = lane + i * 64;
        G[(size_t)u * 512 + 256 + t] = f[i] * inv;
        if (t >= 1) G[(size_t)u * 512 + 256 - t] = b[i] * inv;
      }
      if (lane == 0) G[(size_t)u * 512] = 0.f;
    }
  }
}

DI void ph_ln(const float* __restrict__ src_lat, const float* __restrict__ src_ctx, float* dst_lat, float* dst_ctx,
              const float* __restrict__ ag, const float* __restrict__ ab, bf16_t* U, const float* __restrict__ mod, int sh_off, int nrows) {
  const int lane = my_tid() & 63, wid = my_tid() >> 6;
  const int stride = gridDim.x * 8;
  float4 nv[4];
  {
    const int row = blockIdx.x * 8 + wid;
    if (row < nrows) {
      const float* src = row < ML ? src_lat + (size_t)row * D : src_ctx + (size_t)(row - ML) * D;
#pragma unroll
      for (int i = 0; i < 4; ++i) nv[i] = *(const float4*)(src + i * 256 + lane * 4);
    }
  }
  for (int row = blockIdx.x * 8 + wid; row < nrows; row += stride) {
    float4 v[4];
#pragma unroll
    for (int i = 0; i < 4; ++i) v[i] = nv[i];
    if (row + stride < nrows) {
      const int r2 = row + stride;
      const float* src2 = r2 < ML ? src_lat + (size_t)r2 * D : src_ctx + (size_t)(r2 - ML) * D;
#pragma unroll
      for (int i = 0; i < 4; ++i) nv[i] = *(const float4*)(src2 + i * 256 + lane * 4);
    }
    float s = 0.f;
#pragma unroll
    for (int i = 0; i < 4; ++i) s += v[i].x + v[i].y + v[i].z + v[i].w;
    float mu = wave_sum(s) * (1.f / 1024.f);
    float q = 0.f;
#pragma unroll
    for (int i = 0; i < 4; ++i) { v[i].x -= mu; v[i].y -= mu; v[i].z -= mu; v[i].w -= mu; q += v[i].x * v[i].x + v[i].y * v[i].y + v[i].z * v[i].z + v[i].w * v[i].w; }
    float rs = rsqrtf(wave_sum(q) * (1.f / 1024.f) + 1e-6f);
#pragma unroll
    for (int i = 0; i < 4; ++i) { v[i].x *= rs; v[i].y *= rs; v[i].z *= rs; v[i].w *= rs; }
    if (ag) {
      float* dst = row < ML ? dst_lat + (size_t)row * D : dst_ctx + (size_t)(row - ML) * D;
#pragma unroll
      for (int i = 0; i < 4; ++i) {
        float4 gg = *(const float4*)(ag + i * 256 + lane * 4), bb = *(const float4*)(ab + i * 256 + lane * 4);
        v[i].x = v[i].x * gg.x + bb.x; v[i].y = v[i].y * gg.y + bb.y; v[i].z = v[i].z * gg.z + bb.z; v[i].w = v[i].w * gg.w + bb.w;
        *(float4*)(dst + i * 256 + lane * 4) = v[i];
      }
      if (U) {
        s = 0.f;
#pragma unroll
        for (int i = 0; i < 4; ++i) s += v[i].x + v[i].y + v[i].z + v[i].w;
        mu = wave_sum(s) * (1.f / 1024.f); q = 0.f;
#pragma unroll
        for (int i = 0; i < 4; ++i) { v[i].x -= mu; v[i].y -= mu; v[i].z -= mu; v[i].w -= mu; q += v[i].x * v[i].x + v[i].y * v[i].y + v[i].z * v[i].z + v[i].w * v[i].w; }
        rs = rsqrtf(wave_sum(q) * (1.f / 1024.f) + 1e-6f);
#pragma unroll
        for (int i = 0; i < 4; ++i) { v[i].x *= rs; v[i].y *= rs; v[i].z *= rs; v[i].w *= rs; }
      }
    }
    if (U) {
      const float* m = mod + (size_t)mod_idx(row) * 6144 + sh_off;
#pragma unroll
      for (int i = 0; i < 4; ++i) {
        float4 sh = *(const float4*)(m + i * 256 + lane * 4), sc = *(const float4*)(m + 1024 + i * 256 + lane * 4);
        uint2 o; o.x = pack2(v[i].x * (1.f + sc.x) + sh.x, v[i].y * (1.f + sc.y) + sh.y);
        o.y = pack2(v[i].z * (1.f + sc.z) + sh.z, v[i].w * (1.f + sc.w) + sh.w);
        *(uint2*)(U + (size_t)row * D + i * 256 + lane * 4) = o;
      }
    }
  }
}

DI void ph_inproj(const Params& p, const bf16_t* U, char* smem) {
  const bf16_t* Bt = (const bf16_t*)(p.ws + WB_IN);
  const int lane = my_tid() & 63, wid = my_tid() >> 6, wm = wid >> 2, wn = wid & 3, g = lane >> 4, r16 = lane & 15;
  for (int it = 0;; ++it) {
    int mtile, ntile;
    if (!next_tile(it, 136, 13, mtile, ntile)) break;
    f32x4 acc[8][4]; zero_acc256(acc);
    gemm_glds256(acc, U, 1024, (long)mtile * 256, Bt + (size_t)ntile * 256 * 1024, 1024, 1024, smem);
    int b, key0;
    if (mtile < 128) { b = mtile >> 4; key0 = (mtile & 15) * 256; } else { b = mtile - 128; key0 = SL; }
    const int wc0 = ntile * 256 + wn * 64;
    bf16_t* tbase = nullptr; int tcols = 0, tcol0 = 0;
    if (wc0 < 768) { tbase = (bf16_t*)(p.ws + R_PHY); tcols = 768; tcol0 = wc0; }
    else if (wc0 >= 1152 && wc0 < 1280) { tbase = (bf16_t*)(p.ws + R_VTSW); tcols = 128; tcol0 = wc0 - 1152; }
    else if (wc0 >= 1792 && wc0 < 2048) { tbase = (bf16_t*)(p.ws + R_VTDF); tcols = 256; tcol0 = wc0 - 1792; }
    if (tbase) {
#pragma unroll
      for (int mt = 0; mt < 8; ++mt)
#pragma unroll
        for (int nt = 0; nt < 4; ++nt) {
          int col = tcol0 + r16 * 4 + nt;
          int key = key0 + wm * 128 + mt * 16 + g * 4;
          uint2 o; o.x = pack2(acc[mt][nt][0], acc[mt][nt][1]); o.y = pack2(acc[mt][nt][2], acc[mt][nt][3]);
          *(uint2*)(tbase + ((size_t)b * tcols + col) * KEYS + key) = o;
        }
    } else if (wc0 < 3264) {
      bf16_t* rb; int ld, c0;
      if (wc0 < 1152) { rb = (bf16_t*)(p.ws + R_PSW); ld = 384; c0 = wc0 - 768; }
      else if (wc0 < 1792) { rb = (bf16_t*)(p.ws + R_PDF); ld = 512; c0 = wc0 - 1280; }
      else { rb = (bf16_t*)(p.ws + R_PRW); ld = 1216; c0 = wc0 - 2048; }
      const int col = c0 + r16 * 4;
#pragma unroll
      for (int mt = 0; mt < 8; ++mt)
#pragma unroll
        for (int j = 0; j < 4; ++j) {
          size_t row = (size_t)mtile * 256 + wm * 128 + mt * 16 + g * 4 + j;
          uint2 o; o.x = pack2(acc[mt][0][j], acc[mt][1][j]); o.y = pack2(acc[mt][2][j], acc[mt][3][j]);
          *(uint2*)(rb + row * ld + col) = o;
        }
    }
  }
}

DI float hy_conv3(const bf16_t* __restrict__ P, int t, int len, float w0, float w1, float w2, float bias) {
  float a = t >= 1 ? bf2f(P[t - 1]) : 0.f, b = bf2f(P[t]), c = (t + 1 < len) ? bf2f(P[t + 1]) : 0.f;
  return w0 * a + w1 * b + w2 * c + bias;
}
DI void hy_conv8(const bf16_t* __restrict__ P, int tb, int len, float w0, float w1, float w2, float bias, float (&out)[8]) {
  const uint4 u = *(const uint4*)(P + tb);
  float x[10];
  x[0] = tb >= 1 ? bf2f(P[tb - 1]) : 0.f;
  x[1] = bflo(u.x); x[2] = bfhi(u.x); x[3] = bflo(u.y); x[4] = bfhi(u.y); x[5] = bflo(u.z); x[6] = bfhi(u.z); x[7] = bflo(u.w); x[8] = bfhi(u.w);
  x[9] = (tb + 8 < len) ? bf2f(P[tb + 8]) : 0.f;
#pragma unroll
  for (int i = 0; i < 8; ++i) out[i] = w0 * x[i] + w1 * x[i + 1] + w2 * x[i + 2] + bias;
}
DI void ph_hyena(const Params& p, int l, char* smem) {
  float2* X = (float2*)smem; float2* W = X + 8192;
  const int tid = my_tid();
  const int tb = tid * 8;
  const bf16_t* PT = (const bf16_t*)(p.ws + R_PHY);
  const float2* kf = (const float2*)(p.ws + OFF_KF);
  const float* cw = p.in[7] + (size_t)l * 3 * 768; const float* cb = p.in[8] + (size_t)l * 768;
  const float* hb = p.in[15] + (size_t)l * 512;
  bf16_t* Y = (bf16_t*)(p.ws + R_YHY);
  bool tw = false;
  for (int u = blockIdx.x; u < 1024; u += gridDim.x) {
    if (!tw) { load_twiddles(p, W); tw = true; }
    const int bp = u >> 8, c = u & 255; const int b0 = bp * 2, b1 = b0 + 1;
    const bf16_t* P0 = PT + ((size_t)b0 * 768) * KEYS; const bf16_t* P1 = PT + ((size_t)b1 * 768) * KEYS;
    const float bias0 = hb[c], bias1 = hb[256 + c];
    float va[8], vb[8];
    hy_conv8(P0 + (size_t)c * KEYS, tb, SL, cw[c], cw[768 + c], cw[1536 + c], cb[c], va);
    hy_conv8(P1 + (size_t)c * KEYS, tb, SL, cw[c], cw[768 + c], cw[1536 + c], cb[c], vb);
    __syncthreads();
#pragma unroll
    for (int i = 0; i < 8; ++i) { X[tb + i] = make_float2(va[i], vb[i]); X[tb + i + 4096] = make_float2(0.f, 0.f); }
    fft_dif(X, W);
    {
      const float2* H = kf + (size_t)c * 8192;
#pragma unroll 4
      for (int i = 0; i < 16; ++i) { int q = tid + i * 512; X[q] = cmul(X[q], H[q]); }
    }
    fft_dit_inv(X, W);
    float za[8], zb[8];
    {
      float xa[8], xb[8];
      hy_conv8(P0 + (size_t)(256 + c) * KEYS, tb, SL, cw[256 + c], cw[768 + 256 + c], cw[1536 + 256 + c], cb[256 + c], xa);
      hy_conv8(P1 + (size_t)(256 + c) * KEYS, tb, SL, cw[256 + c], cw[768 + 256 + c], cw[1536 + 256 + c], cb[256 + c], xb);
#pragma unroll
      for (int i = 0; i < 8; ++i) {
        const float2 y = X[tb + i];
        za[i] = xa[i] * (y.x * (1.f / 8192.f) + bias0 * va[i]);
        zb[i] = xb[i] * (y.y * (1.f / 8192.f) + bias0 * vb[i]);
      }
    }
    __syncthreads();
#pragma unroll
    for (int i = 0; i < 8; ++i) { X[tb + i] = make_float2(za[i], zb[i]); X[tb + i + 4096] = make_float2(0.f, 0.f); }
    fft_dif(X, W);
    {
      const float2* H = kf + (size_t)(256 + c) * 8192;
#pragma unroll 4
      for (int i = 0; i < 16; ++i) { int q = tid + i * 512; X[q] = cmul(X[q], H[q]); }
    }
    fft_dit_inv(X, W);
    {
      float xa[8], xb[8];
      hy_conv8(P0 + (size_t)(512 + c) * KEYS, tb, SL, cw[512 + c], cw[768 + 512 + c], cw[1536 + 512 + c], cb[512 + c], xa);
      hy_conv8(P1 + (size_t)(512 + c) * KEYS, tb, SL, cw[512 + c], cw[768 + 512 + c], cw[1536 + 512 + c], cb[512 + c], xb);
#pragma unroll
      for (int i = 0; i < 8; ++i) {
        const float2 y = X[tb + i];
        const float oa = xa[i] * (y.x * (1.f / 8192.f) + bias1 * za[i]);
        const float ob = xb[i] * (y.y * (1.f / 8192.f) + bias1 * zb[i]);
        Y[((size_t)b0 * SL + tb + i) * 256 + c] = (bf16_t)f2bf(oa);
        Y[((size_t)b1 * SL + tb + i) * 256 + c] = (bf16_t)f2bf(ob);
      }
    }
  }
}

DI void ph_hyena_ctx(const Params& p, int l, char* smem) {
  const int tid = my_tid(), lane = tid & 63, wid = tid >> 6;
  float* Zb = (float*)smem + wid * 1024;
  float* Gb = Zb + 256;
  const bf16_t* PT = (const bf16_t*)(p.ws + R_PHY);
  const float* G = (const float*)(p.ws + MISC_GCTX);
  const float* cw = p.in[7] + (size_t)l * 3 * 768; const float* cb = p.in[8] + (size_t)l * 768;
  const float* hb = p.in[15] + (size_t)l * 512;
  bf16_t* Y = (bf16_t*)(p.ws + R_YHY);
  for (int base = blockIdx.x * 8; base < 2048; base += gridDim.x * 8) {
    const int u = base + wid; const int b = u >> 8, c = u & 255;
    const bf16_t* Pb = PT + ((size_t)b * 768) * KEYS + SL;
    float v[4], x1[4], x2[4], zz[4];
#pragma unroll
    for (int i = 0; i < 4; ++i) {
      int t = lane + i * 64;
      v[i] = hy_conv3(Pb + (size_t)c * KEYS, t, CL, cw[c], cw[768 + c], cw[1536 + c], cb[c]);
      x1[i] = hy_conv3(Pb + (size_t)(256 + c) * KEYS, t, CL, cw[256 + c], cw[768 + 256 + c], cw[1536 + 256 + c], cb[256 + c]);
      x2[i] = hy_conv3(Pb + (size_t)(512 + c) * KEYS, t, CL, cw[512 + c], cw[768 + 512 + c], cw[1536 + 512 + c], cb[512 + c]);
    }
    __syncthreads();
#pragma unroll
    for (int i = 0; i < 4; ++i) Zb[lane + i * 64] = v[i];
    for (int i = lane; i < 512; i += 64) Gb[i] = G[(size_t)c * 512 + i];
    __syncthreads();
#pragma unroll
    for (int i = 0; i < 4; ++i) {
      int t = lane + i * 64; float s = 0.f;
      for (int s2 = 0; s2 < 256; ++s2) s += Gb[256 + t - s2] * Zb[s2];
      zz[i] = x1[i] * (s + hb[c] * v[i]);
    }
    __syncthreads();
#pragma unroll
    for (int i = 0; i < 4; ++i) Zb[lane + i * 64] = zz[i];
    for (int i = lane; i < 512; i += 64) Gb[i] = G[(size_t)(256 + c) * 512 + i];
    __syncthreads();
#pragma unroll
    for (int i = 0; i < 4; ++i) {
      int t = lane + i * 64; float s = 0.f;
      for (int s2 = 0; s2 < 256; ++s2) s += Gb[256 + t - s2] * Zb[s2];
      float o = x2[i] * (s + hb[256 + c] * zz[i]);
      Y[((size_t)ML + b * CL + t) * 256 + c] = (bf16_t)f2bf(o);
    }
  }
}

DI void ph_rope(const Params& p, char* smem) {
  float2* T16 = (float2*)smem;
  float2* T8 = T16 + 64 * 16;
  const int tid = my_tid(), lane = tid & 63, wid = tid >> 6;
  __syncthreads();
  for (int i = tid; i < 64 * 16; i += NTHR) {
    int pos = i >> 4, f = i & 15; float inv = powf(10000.f, -(float)f / 16.f); float s, c; sincosf((float)pos * inv, &s, &c);
    T16[i] = make_float2(c, s);
  }
  for (int i = tid; i < 64 * 8; i += NTHR) {
    int pos = i >> 3, f = i & 7; float inv = powf(10000.f, -(float)f / 8.f); float s, c; sincosf((float)pos * inv, &s, &c);
    T8[i] = make_float2(c, s);
  }
  __syncthreads();
  bf16_t* Psw = (bf16_t*)(p.ws + R_PSW); bf16_t* Pdf = (bf16_t*)(p.ws + R_PDF);
  bf16_t* rowbase_ptr; int e1, e2, nf, f0; bool hsel; bool active = lane < 56;
  if (lane < 24) { const int hd = lane >> 2, half = (lane >> 1) & 1, cp = lane & 1; e1 = hd * 64 + half * 32 + cp * 8; e2 = e1 + 16; nf = 16; f0 = cp * 8; hsel = half; }
  else { const int j = lane - 24; const int gi = j >> 1, half = j & 1; e1 = gi * 32 + half * 16; e2 = e1 + 8; nf = 8; f0 = 0; hsel = half; }
  const float2* Tb = (lane < 24) ? T16 : T8;
  for (int row = blockIdx.x * 8 + wid; row < ML; row += gridDim.x * 8) {
    if (active) {
      const int t = row & (SL - 1); const int pos = hsel ? (t & 63) : (t >> 6);
      rowbase_ptr = (lane < 24) ? Psw + (size_t)row * 384 : Pdf + (size_t)row * 512;
      const uint4 u1 = *(const uint4*)(rowbase_ptr + e1), u2 = *(const uint4*)(rowbase_ptr + e2);
      const float4* cs = (const float4*)(Tb + pos * nf + f0);
      const float4 c0 = cs[0], c1 = cs[1], c2 = cs[2], c3 = cs[3];
      const unsigned w1[4] = {u1.x, u1.y, u1.z, u1.w}, w2[4] = {u2.x, u2.y, u2.z, u2.w};
      const float4 cc[4] = {c0, c1, c2, c3};
      unsigned o1[4], o2[4];
#pragma unroll
      for (int i = 0; i < 4; ++i) {
        const float xa = bflo(w1[i]), xb = bfhi(w1[i]), ya = bflo(w2[i]), yb = bfhi(w2[i]);
        o1[i] = pack2(xa * cc[i].x - ya * cc[i].y, xb * cc[i].z - yb * cc[i].w);
        o2[i] = pack2(xa * cc[i].y + ya * cc[i].x, xb * cc[i].w + yb * cc[i].z);
      }
      *(uint4*)(rowbase_ptr + e1) = make_uint4(o1[0], o1[1], o1[2], o1[3]);
      *(uint4*)(rowbase_ptr + e2) = make_uint4(o2[0], o2[1], o2[2], o2[3]);
    }
  }
}

DI float rw_shift(const bf16_t* __restrict__ P, int row, int t, int len, int col, float mu) {
  float c = bf2f(P[(size_t)row * 1216 + col]);
  float a = t >= 1 ? bf2f(P[(size_t)(row - 1) * 1216 + col]) : 0.f;
  float b = t + 1 < len ? bf2f(P[(size_t)(row + 1) * 1216 + col]) : 0.f;
  return c + (0.5f * (a + b) - c) * mu;
}
DI void ph_rwprep(const Params& p, int l, char* smem) {
  constexpr int AST = 912, RST = 1552, ROFF = 32 * AST;
  const int tid = my_tid(), lane = tid & 63, wid = tid >> 6, g = lane >> 4, r16 = lane & 15;
  const int tg = wid >> 2, hd = wid & 3;
  const bf16_t* P = (const bf16_t*)(p.ws + R_PRW);
  const float* mu = p.in[17] + (size_t)l * 1216;
  const float* w0 = p.in[18] + (size_t)l * 512; const float* a0 = p.in[20] + (size_t)l * 256;
  const float* kkw = p.in[23] + (size_t)l * 256; const float* kaw = p.in[24] + (size_t)l * 256;
  bf16_t* S = (bf16_t*)(p.ws + R_STR); bf16_t* Gs = (bf16_t*)(p.ws + R_G);
  const size_t SU = (size_t)MT * 256;
  float w0f[4], w0b[4], a0c[4], kkc[4], kac[4];
#pragma unroll
  for (int nt = 0; nt < 4; ++nt) { int c = hd * 64 + r16 * 4 + nt; w0f[nt] = w0[c]; w0b[nt] = w0[256 + c]; a0c[nt] = a0[c]; kkc[nt] = kkw[c]; kac[nt] = kaw[c]; }
  for (int u = blockIdx.x; u < MT / 32; u += gridDim.x) {
    const int row0 = u * 32; int t0, len;
    if (row0 < ML) { t0 = row0 & (SL - 1); len = SL; } else { t0 = (row0 - ML) & (CL - 1); len = CL; }
    __syncthreads();
    for (int item = tid; item < 32 * 152; item += NTHR) {
      const int tk = item / 152, c8 = item - tk * 152; const int row = row0 + tk, t = t0 + tk;
      const uint4 uc = *(const uint4*)(P + (size_t)row * 1216 + c8 * 8);
      uint4 ua = make_uint4(0, 0, 0, 0), ub = make_uint4(0, 0, 0, 0);
      if (t >= 1) ua = *(const uint4*)(P + (size_t)(row - 1) * 1216 + c8 * 8);
      if (t + 1 < len) ub = *(const uint4*)(P + (size_t)(row + 1) * 1216 + c8 * 8);
      const float4 m0 = *(const float4*)(mu + c8 * 8), m1 = *(const float4*)(mu + c8 * 8 + 4);
      float o[8];
      {
        const unsigned wc[4] = {uc.x, uc.y, uc.z, uc.w}, wa[4] = {ua.x, ua.y, ua.z, ua.w}, wb[4] = {ub.x, ub.y, ub.z, ub.w};
        const float mm[8] = {m0.x, m0.y, m0.z, m0.w, m1.x, m1.y, m1.z, m1.w};
#pragma unroll
        for (int i = 0; i < 4; ++i) {
          float c_lo = bflo(wc[i]), c_hi = bfhi(wc[i]);
          o[2 * i] = c_lo + (0.5f * (bflo(wa[i]) + bflo(wb[i])) - c_lo) * mm[2 * i];
          o[2 * i + 1] = c_hi + (0.5f * (bfhi(wa[i]) + bfhi(wb[i])) - c_hi) * mm[2 * i + 1];
        }
      }
      char* dst;
      if (c8 < 96) dst = smem + ROFF + tk * RST + c8 * 16;
      else {
        const int cc = c8 * 8 - 768;
        if (cc < 128) {
#pragma unroll
          for (int i = 0; i < 8; ++i) o[i] = 1.f - 2.f * __builtin_amdgcn_rcpf(1.f + __expf(2.f * o[i]));
        } else if (cc >= 192) {
#pragma unroll
          for (int i = 0; i < 8; ++i) o[i] = sigmoidf_(o[i]);
        }
        dst = smem + tk * AST + cc * 2;
      }
      uint4 ov; ov.x = pack2(o[0], o[1]); ov.y = pack2(o[2], o[3]); ov.z = pack2(o[4], o[5]); ov.w = pack2(o[6], o[7]);
      *(uint4*)dst = ov;
    }
    __syncthreads();
    f32x4 acc[5][4];
#pragma unroll
    for (int o5 = 0; o5 < 5; ++o5)
#pragma unroll
      for (int nt = 0; nt < 4; ++nt) acc[o5][nt] = (f32x4){0.f, 0.f, 0.f, 0.f};
    const char* Arow = smem + (tg * 16 + r16) * AST + g * 16;
#pragma unroll
    for (int o5 = 0; o5 < 5; ++o5) {
      const int kbase = o5 < 3 ? o5 * 64 : (o5 == 3 ? 192 : 320);
      const int KK = o5 < 3 ? 64 : 128;
      const bf16_t* Wt = (const bf16_t*)(p.ws + (o5 == 0 ? RWW_F : o5 == 1 ? RWW_B : o5 == 2 ? RWW_A : o5 == 3 ? RWW_GF : RWW_GB));
#pragma unroll
      for (int ks = 0; ks < KK / 32; ++ks) {
        const bf16x8 af = *(const bf16x8*)(Arow + (kbase + ks * 32) * 2);
#pragma unroll
        for (int nt = 0; nt < 4; ++nt) {
          const bf16x8 bf = *(const bf16x8*)(Wt + (size_t)(hd * 64 + nt * 16 + r16) * KK + ks * 32 + g * 8);
          acc[o5][nt] = __builtin_amdgcn_mfma_f32_16x16x32_bf16(af, bf, acc[o5][nt], 0, 0, 0);
        }
        if (ks & 1) asm volatile("" ::: "memory");
      }
    }
#pragma unroll
    for (int j = 0; j < 4; ++j) {
      const int tk = tg * 16 + g * 4 + j; const size_t row = (size_t)row0 + tk;
      const char* rk = smem + ROFF + tk * RST;
      const int c0 = hd * 64 + r16 * 4;
      const uint2 ur = *(const uint2*)(rk + c0 * 2), uk = *(const uint2*)(rk + (256 + c0) * 2), uv = *(const uint2*)(rk + (512 + c0) * 2);
      const float rv[4] = {bflo(ur.x), bfhi(ur.x), bflo(ur.y), bfhi(ur.y)};
      const float kv[4] = {bflo(uk.x), bfhi(uk.x), bflo(uk.y), bfhi(uk.y)};
      const float vv[4] = {bflo(uv.x), bfhi(uv.x), bflo(uv.y), bfhi(uv.y)};
      float n2 = 0.f;
#pragma unroll
      for (int nt = 0; nt < 4; ++nt) { float q = kv[nt] * kkc[nt]; n2 += q * q; }
      n2 = sum16(n2);
      const float inv = __builtin_amdgcn_rsqf(fmaxf(n2, 1e-24f));
      float o_kp[4], o_kk[4], o_b[4], o_df[4], o_db[4];
#pragma unroll
      for (int nt = 0; nt < 4; ++nt) {
        const float k = kv[nt];
        const float a = sigmoidf_(a0c[nt] + acc[2][nt][j]);
        const float kk = k * kkc[nt] * inv;
        o_kp[nt] = k * (1.f + (a - 1.f) * kac[nt]);
        o_kk[nt] = kk; o_b[nt] = kk * a;
        const float xf = -(w0f[nt] + acc[0][nt][j]); const float spf = fmaxf(xf, 0.f) + __logf(1.f + __expf(-fabsf(xf)));
        const float xb = -(w0b[nt] + acc[1][nt][j]); const float spb = fmaxf(xb, 0.f) + __logf(1.f + __expf(-fabsf(xb)));
        const float ef = __expf(-spf - 0.5f), eb = __expf(-spb - 0.5f);
        o_df[nt] = 1.f - __expf(-ef); o_db[nt] = 1.f - __expf(-eb);
      }
      const size_t o = row * 256 + c0;
      uint2 w;
      w.x = pack2(rv[0], rv[1]); w.y = pack2(rv[2], rv[3]); *(uint2*)(S + o) = w;
      w.x = pack2(o_kp[0], o_kp[1]); w.y = pack2(o_kp[2], o_kp[3]); *(uint2*)(S + SU + o) = w;
      w.x = pack2(vv[0], vv[1]); w.y = pack2(vv[2], vv[3]); *(uint2*)(S + 2 * SU + o) = w;
      w.x = pack2(o_kk[0], o_kk[1]); w.y = pack2(o_kk[2], o_kk[3]); *(uint2*)(S + 3 * SU + o) = w;
      w.x = pack2(o_b[0], o_b[1]); w.y = pack2(o_b[2], o_b[3]); *(uint2*)(S + 4 * SU + o) = w;
      w.x = pack2(o_df[0], o_df[1]); w.y = pack2(o_df[2], o_df[3]); *(uint2*)(S + 5 * SU + o) = w;
      w.x = pack2(o_db[0], o_db[1]); w.y = pack2(o_db[2], o_db[3]); *(uint2*)(S + 6 * SU + o) = w;
      w.x = pack2(acc[3][0][j], acc[3][1][j]); w.y = pack2(acc[3][2][j], acc[3][3][j]); *(uint2*)(Gs + o) = w;
      w.x = pack2(acc[4][0][j], acc[4][1][j]); w.y = pack2(acc[4][2][j], acc[4][3][j]); *(uint2*)(Gs + SU + o) = w;
    }
  }
}

DI long scan_row(int b, int dir, int s) {
  if (s < CL) return (long)ML + b * CL + (dir ? (CL - 1 - s) : s);
  int t = s - CL; return (long)b * SL + (dir ? (SL - 1 - t) : t);
}
DI float sum8(float v) {
  v += dpp_mov<0xB1>(v);
  v += dpp_mov<0x4E>(v);
  v += dpp_mov<0x141>(v);
  return v;
}
DI void ph_scan(const Params& p, char* smem) {
  const int tid = my_tid(), lane = tid & 63, wid = tid >> 6;
  const bf16_t* S = (const bf16_t*)(p.ws + R_STR);
  const size_t SU = (size_t)MT * 256;
  constexpr int T = 32, NSTEP = CL + SL, NCH = NSTEP / T;
  typedef float f32x2 __attribute__((ext_vector_type(2)));
  for (int u = blockIdx.x; u < 128; u += gridDim.x) {
    const int chain = u >> 1, rg = u & 1; const int dir = chain & 1, bh = chain >> 1, b = bh >> 2, h = bh & 3;
    bf16_t* O = (bf16_t*)(p.ws + (dir ? R_OB : R_OF));
    uint4 q0, q1, q2;
    auto SC_GLOAD = [&](int ci) {
#pragma unroll
      for (int j = 0; j < 3; ++j) {
        int idx = tid + j * 512; int st = idx >> 8, s = (idx & 255) >> 3, ck = idx & 7;
        long row = scan_row(b, dir, ci * T + s);
        int sid = st < 5 ? st : 5 + dir;
        uint4 v = *(const uint4*)(S + sid * SU + row * 256 + h * 64 + ck * 8);
        if (j == 0) q0 = v; else if (j == 1) q1 = v; else q2 = v;
      }
    };
    auto SC_SSTORE = [&](int buf) {
#pragma unroll
      for (int j = 0; j < 3; ++j) {
        int idx = tid + j * 512; int st = idx >> 8;
        uint4 v = j == 0 ? q0 : (j == 1 ? q1 : q2);
        float4 lo = make_float4(bflo(v.x), bfhi(v.x), bflo(v.y), bfhi(v.y));
        float4 hi = make_float4(bflo(v.z), bfhi(v.z), bflo(v.w), bfhi(v.w));
        if (st == 5) { lo.x = 1.f - lo.x; lo.y = 1.f - lo.y; lo.z = 1.f - lo.z; lo.w = 1.f - lo.w; hi.x = 1.f - hi.x; hi.y = 1.f - hi.y; hi.z = 1.f - hi.z; hi.w = 1.f - hi.w; }
        char* base = smem + buf * 49152 + idx * 32;
        *(float4*)(base) = lo; *(float4*)(base + 16) = hi;
      }
    };
    auto FLUSH = [&](int ci) {
      const int s = tid >> 4, part = tid & 15;
      const float2 v = *(const float2*)(smem + 98304 + (ci & 1) * 4096 + s * 128 + part * 8);
      long row = scan_row(b, dir, ci * T + s);
      *(unsigned*)(O + row * 256 + h * 64 + rg * 32 + part * 2) = pack2(v.x, v.y);
    };
    __syncthreads();
    SC_GLOAD(0);
    SC_SSTORE(0);
    __syncthreads();
    f32x2 st0 = {0.f, 0.f}, st1 = {0.f, 0.f}, st2 = {0.f, 0.f}, st3 = {0.f, 0.f};
    const int rsub = lane >> 3, ks = lane & 7;
    const int lrow = (wid & 3) * 8 + rsub;
    const int vrow = rg * 32 + lrow;
    struct Step { f32x2 r[4], k[4], kk[4], b[4], w[4]; float v; };
    auto LOADSTEP = [&](Step& x, const char* B, int s) {
#pragma unroll
      for (int hh = 0; hh < 2; ++hh) {
        const float4 r = *(const float4*)(B + (0 * T + s) * 256 + ks * 32 + hh * 16);
        const float4 k = *(const float4*)(B + (1 * T + s) * 256 + ks * 32 + hh * 16);
        const float4 kk = *(const float4*)(B + (3 * T + s) * 256 + ks * 32 + hh * 16);
        const float4 bb = *(const float4*)(B + (4 * T + s) * 256 + ks * 32 + hh * 16);
        const float4 w = *(const float4*)(B + (5 * T + s) * 256 + ks * 32 + hh * 16);
        x.r[2 * hh] = (f32x2){r.x, r.y}; x.r[2 * hh + 1] = (f32x2){r.z, r.w};
        x.k[2 * hh] = (f32x2){k.x, k.y}; x.k[2 * hh + 1] = (f32x2){k.z, k.w};
        x.kk[2 * hh] = (f32x2){kk.x, kk.y}; x.kk[2 * hh + 1] = (f32x2){kk.z, kk.w};
        x.b[2 * hh] = (f32x2){bb.x, bb.y}; x.b[2 * hh + 1] = (f32x2){bb.z, bb.w};
        x.w[2 * hh] = (f32x2){w.x, w.y}; x.w[2 * hh + 1] = (f32x2){w.z, w.w};
      }
      x.v = *(const float*)(B + (2 * T + s) * 256 + vrow * 4);
    };
    for (int ci = 0; ci < NCH; ++ci) {
      if (ci + 1 < NCH) { SC_GLOAD(ci + 1); }
      if (ci > 0) FLUSH(ci - 1);
      if (wid < 4) {
        const char* B = smem + (ci & 1) * 49152;
        float* ob = (float*)(smem + 98304 + (ci & 1) * 4096);
        Step nx; LOADSTEP(nx, B, 0);
#pragma unroll 2
        for (int s = 0; s < T; ++s) {
          const Step c = nx;
          LOADSTEP(nx, B, s + 1);
          f32x2 pa = st0 * c.kk[0] + st1 * c.kk[1];
          f32x2 pb = st2 * c.kk[2] + st3 * c.kk[3];
          pa = pa + pb;
          float sa = -(pa.x + pa.y);
          sa = sum8(sa);
          const f32x2 sa2 = {sa, sa}; const f32x2 v2 = {c.v, c.v};
          st0 = st0 * c.w[0] + sa2 * c.b[0] + v2 * c.k[0];
          st1 = st1 * c.w[1] + sa2 * c.b[1] + v2 * c.k[1];
          st2 = st2 * c.w[2] + sa2 * c.b[2] + v2 * c.k[2];
          st3 = st3 * c.w[3] + sa2 * c.b[3] + v2 * c.k[3];
          f32x2 oa = st0 * c.r[0] + st1 * c.r[1];
          f32x2 ob2 = st2 * c.r[2] + st3 * c.r[3];
          oa = oa + ob2;
          float o = sum8(oa.x + oa.y);
          ob[s * 32 + lrow] = o;
        }
      }
      if (ci + 1 < NCH) { SC_SSTORE((ci + 1) & 1); }
      __syncthreads();
    }
    FLUSH(NCH - 1);
  }
}

template <bool DIFF>
DI void attn_unit(const Params& p, int l, int b, int h, int qrow0, int qpos0, int kb_lo, int kb_hi, int kc_lo, char* smem) {
  const int tid = my_tid(), lane = tid & 63, wid = tid >> 6, g = lane >> 4, r16 = lane & 15;
  const bf16_t* QK = (const bf16_t*)(p.ws + (DIFF ? R_PDF : R_PSW));
  const int ldq = DIFF ? 512 : 384;
  const int qc0 = h * 64;
  const int kc0 = 256 + (DIFF ? h * 64 : (h >> 1) * 64);
  const bf16_t* VT = DIFF ? (const bf16_t*)(p.ws + R_VTDF) + ((size_t)b * 256 + h * 64) * KEYS
                          : (const bf16_t*)(p.ws + R_VTSW) + ((size_t)b * 128 + (h >> 1) * 64) * KEYS;
  const int nblk = (kb_hi - kb_lo) + (68 - kc_lo);
  const float sc = (DIFF ? 0.17677669529663687f : 0.125f) * 1.4426950408889634f;
  bf16x8 qf[2];
  {
    const bf16_t* qp = QK + (size_t)(qrow0 + wid * 16 + r16) * ldq + qc0 + g * 8;
    qf[0] = *(const bf16x8*)(qp); qf[1] = *(const bf16x8*)(qp + 32);
  }
  constexpr int NC = DIFF ? 2 : 1;
  float m[NC], lsum[NC];
  f32x4 O[NC][4];
#pragma unroll
  for (int c = 0; c < NC; ++c) {
    if (DIFF) { m[c] = -1e30f; lsum[c] = 0.f; }
    else { m[c] = p.in[16][l * 4 + h] * 1.4426950408889634f; lsum[c] = (g == 0) ? 1.f : 0.f; }
#pragma unroll
    for (int dt = 0; dt < 4; ++dt) O[c][dt] = (f32x4){0.f, 0.f, 0.f, 0.f};
  }
  const int lr = tid >> 3, lc = tid & 7;
  uint4 rkA, rvA, rkB, rvB;
  rkA = make_uint4(0, 0, 0, 0); rvA = rkA; rkB = rkA; rvB = rkA;
  auto AT_GLOAD = [&](int i, uint4& rk, uint4& rv) {
    int kb = i < (kb_hi - kb_lo) ? kb_lo + i : kc_lo + (i - (kb_hi - kb_lo));
    long krow = kb < 64 ? (long)b * SL + kb * 64 + lr : (long)ML + b * CL + (kb - 64) * 64 + lr;
    rk = *(const uint4*)(QK + krow * ldq + kc0 + lc * 8);
    rv = *(const uint4*)(VT + (size_t)lr * KEYS + kb * 64 + lc * 8);
  };
  auto AT_SSTORE = [&](int buf, const uint4& rk, const uint4& rv) {
    *(uint4*)(smem + buf * 18432 + lr * 128 + ((lc ^ (lr & 7)) << 4)) = rk;
    *(uint4*)(smem + buf * 18432 + 9216 + lr * 144 + lc * 16) = rv;
  };
  __syncthreads();
  AT_GLOAD(0, rkA, rvA);
  AT_SSTORE(0, rkA, rvA);
  if (1 < nblk) AT_GLOAD(1, rkA, rvA);
  if (2 < nblk) AT_GLOAD(2, rkB, rvB);
  lds_barrier();
  const int qpos = qpos0 + wid * 16 + r16;
  for (int i = 0; i < nblk; ++i) {
    const int kb = i < (kb_hi - kb_lo) ? kb_lo + i : kc_lo + (i - (kb_hi - kb_lo));
    const bool masked = (!DIFF) && (kb < 64);
    const char* Kt = smem + (i & 1) * 18432; const char* Vt = Kt + 9216;
    f32x4 S[NC][4];
#pragma unroll
    for (int kt = 0; kt < 4; ++kt) {
      bf16x8 k0 = *(const bf16x8*)(Kt + (kt * 16 + r16) * 128 + ((g ^ (r16 & 7)) << 4));
      bf16x8 k1 = *(const bf16x8*)(Kt + (kt * 16 + r16) * 128 + (((4 + g) ^ (r16 & 7)) << 4));
      if (DIFF) {
        S[0][kt] = __builtin_amdgcn_mfma_f32_16x16x32_bf16(k0, qf[0], (f32x4){0.f, 0.f, 0.f, 0.f}, 0, 0, 0);
        S[NC - 1][kt] = __builtin_amdgcn_mfma_f32_16x16x32_bf16(k1, qf[1], (f32x4){0.f, 0.f, 0.f, 0.f}, 0, 0, 0);
      } else {
        f32x4 t = __builtin_amdgcn_mfma_f32_16x16x32_bf16(k0, qf[0], (f32x4){0.f, 0.f, 0.f, 0.f}, 0, 0, 0);
        S[0][kt] = __builtin_amdgcn_mfma_f32_16x16x32_bf16(k1, qf[1], t, 0, 0, 0);
      }
    }
    bf16x8 pf[NC][2];
#pragma unroll
    for (int c = 0; c < NC; ++c) {
      float mx = -1e30f;
#pragma unroll
      for (int kt = 0; kt < 4; ++kt)
#pragma unroll
        for (int j = 0; j < 4; ++j) {
          float v = S[c][kt][j];
          if (masked) { int kpos = kb * 64 + kt * 16 + g * 4 + j; int dd = kpos - qpos; if (dd > 128 || dd < -128) v = -3e38f; S[c][kt][j] = v; }
          mx = fmaxf(mx, v);
        }
      mx *= sc;
      mx = fmaxf(mx, __shfl_xor(mx, 16)); mx = fmaxf(mx, __shfl_xor(mx, 32));
      const float mn = fmaxf(m[c], mx);
      const bool grow = mn > m[c];
      float ps = 0.f;
      unsigned pk[8];
#pragma unroll
      for (int kt = 0; kt < 4; ++kt) {
        float e0 = __builtin_amdgcn_exp2f(fmaf(S[c][kt][0], sc, -mn)), e1 = __builtin_amdgcn_exp2f(fmaf(S[c][kt][1], sc, -mn));
        float e2 = __builtin_amdgcn_exp2f(fmaf(S[c][kt][2], sc, -mn)), e3 = __builtin_amdgcn_exp2f(fmaf(S[c][kt][3], sc, -mn));
        ps += (e0 + e1) + (e2 + e3);
        pk[kt * 2] = pack2(e0, e1); pk[kt * 2 + 1] = pack2(e2, e3);
      }
      if (__builtin_amdgcn_ballot_w64(grow) != 0ull) {
        const float alpha = __builtin_amdgcn_exp2f(m[c] - mn);
        m[c] = mn;
        lsum[c] *= alpha;
#pragma unroll
        for (int dt = 0; dt < 4; ++dt) { O[c][dt][0] *= alpha; O[c][dt][1] *= alpha; O[c][dt][2] *= alpha; O[c][dt][3] *= alpha; }
      }
      lsum[c] += ps;
      union { unsigned u[4]; bf16x8 v; } cv;
      cv.u[0] = pk[0]; cv.u[1] = pk[1]; cv.u[2] = pk[2]; cv.u[3] = pk[3]; pf[c][0] = cv.v;
      cv.u[0] = pk[4]; cv.u[1] = pk[5]; cv.u[2] = pk[6]; cv.u[3] = pk[7]; pf[c][1] = cv.v;
    }
#pragma unroll
    for (int dt = 0; dt < 4; ++dt)
#pragma unroll
      for (int s2 = 0; s2 < 2; ++s2) {
        union { uint2 u[2]; bf16x8 v; } vf;
        vf.u[0] = *(const uint2*)(Vt + (dt * 16 + r16) * 144 + (2 * s2) * 32 + g * 8);
        vf.u[1] = *(const uint2*)(Vt + (dt * 16 + r16) * 144 + (2 * s2 + 1) * 32 + g * 8);
#pragma unroll
        for (int c = 0; c < NC; ++c) O[c][dt] = __builtin_amdgcn_mfma_f32_16x16x32_bf16(vf.v, pf[c][s2], O[c][dt], 0, 0, 0);
      }
    if (i + 1 < nblk) AT_SSTORE((i + 1) & 1, rkA, rvA);
    rkA = rkB; rvA = rvB;
    if (i + 3 < nblk) AT_GLOAD(i + 3, rkB, rvB);
    lds_barrier();
  }
  float linv[NC];
#pragma unroll
  for (int c = 0; c < NC; ++c) { float t = lsum[c]; t += __shfl_xor(t, 16); t += __shfl_xor(t, 32); linv[c] = 1.f / t; }
  const size_t orow = (size_t)(qrow0 + wid * 16 + r16);
  if (!DIFF) {
    bf16_t* Y = (bf16_t*)(p.ws + R_YSW);
#pragma unroll
    for (int dt = 0; dt < 4; ++dt) {
      uint2 o; o.x = pack2(O[0][dt][0] * linv[0], O[0][dt][1] * linv[0]); o.y = pack2(O[0][dt][2] * linv[0], O[0][dt][3] * linv[0]);
      *(uint2*)(Y + orow * 256 + h * 64 + dt * 16 + g * 4) = o;
    }
  } else {
    const float lam_init = 0.8f - 0.6f * __expf(-0.3f * (float)l);
    float d1 = 0.f, d2 = 0.f;
    if (lane < 32) { d1 = p.in[28][l * 32 + lane] * p.in[29][l * 32 + lane]; d2 = p.in[30][l * 32 + lane] * p.in[31][l * 32 + lane]; }
    d1 = wave_sum(d1); d2 = wave_sum(d2);
    const float lam = expf(d1) - expf(d2) + lam_init;
    float ov[4][4]; float ss = 0.f;
#pragma unroll
    for (int dt = 0; dt < 4; ++dt)
#pragma unroll
      for (int j = 0; j < 4; ++j) { float v = O[0][dt][j] * linv[0] - lam * O[NC - 1][dt][j] * linv[NC - 1]; ov[dt][j] = v; ss += v * v; }
    ss += __shfl_xor(ss, 16); ss += __shfl_xor(ss, 32);
    const float rms = rsqrtf(ss * (1.f / 64.f) + 1e-5f) * (1.f - lam_init);
    const float* sg = p.in[32] + l * 64;
    bf16_t* Y = (bf16_t*)(p.ws + R_YDF);
#pragma unroll
    for (int dt = 0; dt < 4; ++dt) {
      const int d0 = dt * 16 + g * 4;
      uint2 o; o.x = pack2(ov[dt][0] * rms * sg[d0], ov[dt][1] * rms * sg[d0 + 1]); o.y = pack2(ov[dt][2] * rms * sg[d0 + 2], ov[dt][3] * rms * sg[d0 + 3]);
      *(uint2*)(Y + orow * 256 + h * 64 + d0) = o;
    }
  }
}

DI void ph_attn(const Params& p, int l, char* smem) {
  const bool need_ctx = (l == 0);
  const int n_sw = 1024 + (need_ctx ? 64 : 0);
  const int n_df = 1024 + (need_ctx ? 64 : 0);
  unsigned* ctr = (unsigned*)(p.ws + MISC_BAR + 64 + 64 * l);
  volatile int* slot = (volatile int*)(smem + 40960);
  for (;;) {
    __syncthreads();
    if (my_tid() == 0) *slot = (int)__hip_atomic_fetch_add(ctr, 1u, __ATOMIC_RELAXED, __HIP_MEMORY_SCOPE_AGENT);
    __syncthreads();
    const int u = *slot;
    if (u >= n_sw + n_df) break;
    if (u < n_df) {
      if (u < 1024) { int b = u >> 7, h = (u >> 5) & 3, n = u & 31; attn_unit<true>(p, l, b, h, b * SL + n * 128, n * 128, 0, 64, 64, smem); }
      else { int v = u - 1024; int b = v >> 3, h = (v >> 1) & 3, n = v & 1; attn_unit<true>(p, l, b, h, ML + b * CL + n * 128, 0, 0, 0, 64, smem); }
    } else {
      int w = u - n_df;
      if (w < 1024) {
        int b = w >> 7, h = (w >> 5) & 3, n = w & 31;
        int lo = (n - 1) * 2; if (lo < 0) lo = 0; int hi = (n + 2) * 2; if (hi > 64) hi = 64;
        attn_unit<false>(p, l, b, h, b * SL + n * 128, n * 128, lo, hi, 64, smem);
      } else { int v = w - 1024; int b = v >> 3, h = (v >> 1) & 3, n = v & 1; attn_unit<false>(p, l, b, h, ML + b * CL + n * 128, 0, 0, 0, 64, smem); }
    }
  }
}

DI void ph_rwout(const Params& p, int l) {
  const int lane = my_tid() & 63, wid = my_tid() >> 6;
  const bf16_t* S = (const bf16_t*)(p.ws + R_STR); const bf16_t* Gs = (const bf16_t*)(p.ws + R_G);
  const bf16_t* OF = (const bf16_t*)(p.ws + R_OF); const bf16_t* OB = (const bf16_t*)(p.ws + R_OB);
  bf16_t* Y = (bf16_t*)(p.ws + R_YRW);
  const size_t SU = (size_t)MT * 256;
  const float4 rk = *(const float4*)(p.in[25] + (size_t)l * 256 + lane * 4);
  const float4 gam = *(const float4*)(p.in[26] + (size_t)l * 256 + lane * 4);
  const float4 bet = *(const float4*)(p.in[27] + (size_t)l * 256 + lane * 4);
  const int nrows = (l == 0) ? MT : ML;
  for (int row = blockIdx.x * 8 + wid; row < nrows; row += gridDim.x * 8) {
    const size_t o = (size_t)row * 256 + lane * 4;
    uint2 ur = *(const uint2*)(S + o), uk = *(const uint2*)(S + SU + o), uv = *(const uint2*)(S + 2 * SU + o);
    uint2 uf = *(const uint2*)(OF + o), ub = *(const uint2*)(OB + o), ugf = *(const uint2*)(Gs + o), ugb = *(const uint2*)(Gs + SU + o);
    float r[4] = {bflo(ur.x), bfhi(ur.x), bflo(ur.y), bfhi(ur.y)};
    float k[4] = {bflo(uk.x), bfhi(uk.x), bflo(uk.y), bfhi(uk.y)};
    float v[4] = {bflo(uv.x), bfhi(uv.x), bflo(uv.y), bfhi(uv.y)};
    float f[4] = {bflo(uf.x), bfhi(uf.x), bflo(uf.y), bfhi(uf.y)};
    float bb[4] = {bflo(ub.x), bfhi(ub.x), bflo(ub.y), bfhi(ub.y)};
    float gf[4] = {bflo(ugf.x), bfhi(ugf.x), bflo(ugf.y), bfhi(ugf.y)};
    float gb[4] = {bflo(ugb.x), bfhi(ugb.x), bflo(ugb.y), bfhi(ugb.y)};
    const float rkv[4] = {rk.x, rk.y, rk.z, rk.w}; const float ga[4] = {gam.x, gam.y, gam.z, gam.w}; const float be[4] = {bet.x, bet.y, bet.z, bet.w};
    float bon = 0.f, sf = 0.f, sb = 0.f;
#pragma unroll
    for (int i = 0; i < 4; ++i) { bon += r[i] * k[i] * rkv[i]; sf += f[i]; sb += bb[i]; }
    bon = sum16(bon); float muf = sum16(sf) * (1.f / 64.f), mub = sum16(sb) * (1.f / 64.f);
    float qf = 0.f, qb = 0.f;
#pragma unroll
    for (int i = 0; i < 4; ++i) { f[i] -= muf; bb[i] -= mub; qf += f[i] * f[i]; qb += bb[i] * bb[i]; }
    float rsf = rsqrtf(sum16(qf) * (1.f / 64.f) + 64e-5f), rsb = rsqrtf(sum16(qb) * (1.f / 64.f) + 64e-5f);
    float y[4];
#pragma unroll
    for (int i = 0; i < 4; ++i) {
      float bn = bon * v[i];
      y[i] = (f[i] * rsf * ga[i] + be[i] + bn) * gf[i] + (bb[i] * rsb * ga[i] + be[i] + bn) * gb[i];
    }
    uint2 oo; oo.x = pack2(y[0], y[1]); oo.y = pack2(y[2], y[3]);
    *(uint2*)(Y + o) = oo;
  }
}

DI void ph_merge(const Params& p, int l, const bf16_t* U, char* smem) {
  const int lane = my_tid() & 63, wid = my_tid() >> 6, wm = wid >> 1, wn = wid & 1, g = lane >> 4, r16 = lane & 15;
  const int mtiles = (l == 0) ? 136 : 128;
  bf16_t* ACC = (bf16_t*)(p.ws + R_ACC);
  for (int it = 0;; ++it) {
    int mtile, ntile;
    if (!next_tile(it, mtiles, 8, mtile, ntile)) break;
    uint2 accS[4][4];
#pragma unroll
    for (int mt = 0; mt < 4; ++mt)
#pragma unroll
      for (int nt = 0; nt < 4; ++nt) accS[mt][nt] = make_uint2(0u, 0u);
    for (int j = 0; j < 4; ++j) {
      uint2 pb[4][4];
      {
        f32x4 accB[4][4]; zero_acc<4>(accB);
        const size_t yoff = (j == 0) ? R_YHY : (j == 1) ? R_YSW : (j == 2) ? R_YRW : R_YDF;
        gemm_glds(accB, (const bf16_t*)(p.ws + yoff), 256, RowPlain{(long)mtile * 256}, (const bf16_t*)(p.ws + WB_BR) + ((size_t)j * 1024 + ntile * 128) * 256, 256, 256, smem, (const bf16_t*)(p.ws + MISC_ZERO));
#pragma unroll
        for (int mt = 0; mt < 4; ++mt)
#pragma unroll
          for (int nt = 0; nt < 4; ++nt) { pb[mt][nt].x = pack2(accB[mt][nt][0], accB[mt][nt][1]); pb[mt][nt].y = pack2(accB[mt][nt][2], accB[mt][nt][3]); }
      }
      f32x4 accG[4][4]; zero_acc<4>(accG);
      gemm_glds(accG, U, 1024, RowPlain{(long)mtile * 256}, (const bf16_t*)(p.ws + WB_GATE) + ((size_t)j * 1024 + ntile * 128) * 1024, 1024, 1024, smem, (const bf16_t*)(p.ws + MISC_ZERO));
#pragma unroll
      for (int mt = 0; mt < 4; ++mt)
#pragma unroll
        for (int nt = 0; nt < 4; ++nt) {
          float v0 = bflo(accS[mt][nt].x) + sigmoidf_(accG[mt][nt][0]) * bflo(pb[mt][nt].x);
          float v1 = bfhi(accS[mt][nt].x) + sigmoidf_(accG[mt][nt][1]) * bfhi(pb[mt][nt].x);
          float v2 = bflo(accS[mt][nt].y) + sigmoidf_(accG[mt][nt][2]) * bflo(pb[mt][nt].y);
          float v3 = bfhi(accS[mt][nt].y) + sigmoidf_(accG[mt][nt][3]) * bfhi(pb[mt][nt].y);
          accS[mt][nt].x = pack2(v0, v1); accS[mt][nt].y = pack2(v2, v3);
        }
    }
#pragma unroll
    for (int mt = 0; mt < 4; ++mt) {
      const int col = ntile * 128 + wn * 64 + r16 * 4;
      const size_t row = (size_t)mtile * 256 + wm * 64 + mt * 16 + g * 4;
      uint2 o;
      o.x = (accS[mt][0].x & 0xffffu) | (accS[mt][1].x << 16); o.y = (accS[mt][2].x & 0xffffu) | (accS[mt][3].x << 16);
      *(uint2*)(ACC + (row + 0) * 1024 + col) = o;
      o.x = (accS[mt][0].x >> 16) | (accS[mt][1].x & 0xffff0000u); o.y = (accS[mt][2].x >> 16) | (accS[mt][3].x & 0xffff0000u);
      *(uint2*)(ACC + (row + 1) * 1024 + col) = o;
      o.x = (accS[mt][0].y & 0xffffu) | (accS[mt][1].y << 16); o.y = (accS[mt][2].y & 0xffffu) | (accS[mt][3].y << 16);
      *(uint2*)(ACC + (row + 2) * 1024 + col) = o;
      o.x = (accS[mt][0].y >> 16) | (accS[mt][1].y & 0xffff0000u); o.y = (accS[mt][2].y >> 16) | (accS[mt][3].y & 0xffff0000u);
      *(uint2*)(ACC + (row + 3) * 1024 + col) = o;
    }
  }
}

DI void ph_resgemm(const Params& p, int l, const bf16_t* A, int K, const bf16_t* Bt, const float* hsrc_lat, const float* hsrc_ctx, int gate_off, char* smem) {
  const int lane = my_tid() & 63, wid = my_tid() >> 6, wm = wid >> 1, wn = wid & 1, g = lane >> 4, r16 = lane & 15;
  const int mtiles = (l == 0) ? 136 : 128;
  const float* mod = (const float*)(p.ws + MISC_MOD) + (size_t)l * 9 * 6144;
  float* hc = (float*)(p.ws + OFF_HC);
  for (int it = 0;; ++it) {
    int mtile, ntile;
    if (!next_tile(it, mtiles, 8, mtile, ntile)) break;
    f32x4 acc[4][4]; zero_acc<4>(acc);
    gemm_glds(acc, A, K, RowPlain{(long)mtile * 256}, Bt + (size_t)ntile * 128 * K, K, K, smem, (const bf16_t*)(p.ws + MISC_ZERO));
    const int b = mtile < 128 ? (mtile >> 4) : 8;
    const float* gt = mod + (size_t)b * 6144 + gate_off;
    const int col = ntile * 128 + wn * 64 + r16 * 4;
    const float4 gv = *(const float4*)(gt + col);
#pragma unroll
    for (int mt = 0; mt < 4; ++mt)
#pragma unroll
      for (int e = 0; e < 4; ++e) {
        const int row = mtile * 256 + wm * 64 + mt * 16 + g * 4 + e;
        const float* hs; float* hd;
        if (row < ML) { size_t o = (size_t)row * D + col; hs = hsrc_lat + o; hd = p.out + o; }
        else { size_t o = (size_t)(row - ML) * D + col; hs = hsrc_ctx + o; hd = hc + o; }
        const float4 h = *(const float4*)hs;
        float4 r;
        r.x = DN_ALPHA * h.x + gv.x * acc[mt][0][e]; r.y = DN_ALPHA * h.y + gv.y * acc[mt][1][e];
        r.z = DN_ALPHA * h.z + gv.z * acc[mt][2][e]; r.w = DN_ALPHA * h.w + gv.w * acc[mt][3][e];
        *(float4*)hd = r;
      }
  }
}

DI void ph_ffnup(const Params& p, int l, char* smem) {
  const bf16_t* U = (const bf16_t*)(p.ws + R_U);
  const bf16_t* Bt = (const bf16_t*)(p.ws + WB_UP);
  bf16_t* HID = (bf16_t*)(p.ws + R_HID);
  const float* cw = p.in[38] + (size_t)l * 3 * 5632; const float* cb = p.in[39] + (size_t)l * 5632;
  const int tid = my_tid(), lane = tid & 63, wid = tid >> 6, wm = wid >> 2, wn = wid & 3, g = lane >> 4, r16 = lane & 15;
  const int mtiles = (l == 0) ? 144 : 136;
  constexpr int TS = 528;
  for (int it = 0;; ++it) {
    int mtile, ntile;
    if (!next_tile(it, mtiles, 22, mtile, ntile)) break;
    long rowbase; int t0, len, r0, r1;
    if (mtile < 136) { int b = mtile / 17; int tt = mtile % 17; len = SL; rowbase = (long)b * SL; t0 = tt * 254 - 1; r0 = 1; r1 = 254; }
    else { int b = mtile - 136; len = CL; rowbase = (long)ML + b * CL; t0 = 0; r0 = 0; r1 = 255; }
    f32x4 acc[8][4]; zero_acc256(acc);
    gemm_glds256(acc, U, 1024, rowbase + t0, Bt + (size_t)ntile * 256 * 1024, 1024, 1024, smem);
#pragma unroll
    for (int mt = 0; mt < 8; ++mt)
#pragma unroll
      for (int e = 0; e < 4; ++e) {
        uint2 o; o.x = pack2(acc[mt][0][e], acc[mt][1][e]); o.y = pack2(acc[mt][2][e], acc[mt][3][e]);
        *(uint2*)(smem + (wm * 128 + mt * 16 + g * 4 + e) * TS + (wn * 64 + r16 * 4) * 2) = o;
      }
    __syncthreads();
    {
      const int ch = (tid & 31) * 4, rgp = tid >> 5; const int ca = ntile * 128 + ch, cbx = 2816 + ca;
      const float4 wa0 = *(const float4*)(cw + ca), wa1 = *(const float4*)(cw + 5632 + ca), wa2 = *(const float4*)(cw + 2 * 5632 + ca), wab = *(const float4*)(cb + ca);
      const float4 wb0 = *(const float4*)(cw + cbx), wb1 = *(const float4*)(cw + 5632 + cbx), wb2 = *(const float4*)(cw + 2 * 5632 + cbx), wbb = *(const float4*)(cb + cbx);
      for (int r = r0 + rgp; r <= r1; r += 16) {
        const int tok = t0 + r;
        if (tok < len) {
          const char* Tr = smem + r * TS + ch * 2;
          const uint2 z2 = make_uint2(0u, 0u);
          const uint2 ua = *(const uint2*)(Tr), ub = *(const uint2*)(Tr + 256);
          const uint2 pa = tok >= 1 ? *(const uint2*)(Tr - TS) : z2, pb_ = tok >= 1 ? *(const uint2*)(Tr - TS + 256) : z2;
          const uint2 na = tok + 1 < len ? *(const uint2*)(Tr + TS) : z2, nb = tok + 1 < len ? *(const uint2*)(Tr + TS + 256) : z2;
          const float av0 = wa0.x * bflo(pa.x) + wa1.x * bflo(ua.x) + wa2.x * bflo(na.x) + wab.x;
          const float av1 = wa0.y * bfhi(pa.x) + wa1.y * bfhi(ua.x) + wa2.y * bfhi(na.x) + wab.y;
          const float av2 = wa0.z * bflo(pa.y) + wa1.z * bflo(ua.y) + wa2.z * bflo(na.y) + wab.z;
          const float av3 = wa0.w * bfhi(pa.y) + wa1.w * bfhi(ua.y) + wa2.w * bfhi(na.y) + wab.w;
          const float bv0 = wb0.x * bflo(pb_.x) + wb1.x * bflo(ub.x) + wb2.x * bflo(nb.x) + wbb.x;
          const float bv1 = wb0.y * bfhi(pb_.x) + wb1.y * bfhi(ub.x) + wb2.y * bfhi(nb.x) + wbb.y;
          const float bv2 = wb0.z * bflo(pb_.y) + wb1.z * bflo(ub.y) + wb2.z * bflo(nb.y) + wbb.z;
          const float bv3 = wb0.w * bfhi(pb_.y) + wb1.w * bfhi(ub.y) + wb2.w * bfhi(nb.y) + wbb.w;
          uint2 o; o.x = pack2(siluf_(av0) * bv0, siluf_(av1) * bv1); o.y = pack2(siluf_(av2) * bv2, siluf_(av3) * bv3);
          *(uint2*)(HID + (size_t)(rowbase + tok) * 2816 + ca) = o;
        }
      }
    }
  }
}

#ifndef REP_PREP
#define REP_PREP 1
#endif
#ifndef REP_GEMM
#define REP_GEMM 1
#endif
#ifndef REP_HY
#define REP_HY 1
#endif
#ifndef REP_RWP
#define REP_RWP 1
#endif
#ifndef REP_SCAN
#define REP_SCAN 1
#endif
#ifndef REP_ATTN
#define REP_ATTN 1
#endif
#ifndef PH_END
#define PH_END 24
#endif
#define XB_TMO      128
#define XB_XCNT(j)  (256  + 64 * (j))
#define XB_XSUB(j)  (1280 + 64 * (j))
#define XB_XGEN(j)  (2304 + 64 * (j))
#define XB_TOP      3328
#define XB_TOPGEN   3392
#define XCD_BAR_WORDS 3456
#define XB_SPIN_CAP (1u << 22)
DI unsigned xb_ld(unsigned* p) { return __hip_atomic_load(p, __ATOMIC_RELAXED, __HIP_MEMORY_SCOPE_AGENT); }
DI unsigned xb_add(unsigned* p, unsigned v) { return __hip_atomic_fetch_add(p, v, __ATOMIC_RELAXED, __HIP_MEMORY_SCOPE_AGENT); }
DI unsigned xb_xcc_id() { return (unsigned)__builtin_amdgcn_s_getreg((3 << 11) | 20) & 0xFu; }
#define XB_SPIN(cond, bar) do { unsigned _sp = 0; while (cond) { __builtin_amdgcn_s_sleep(1); \
    if ((++_sp & 255u) == 0u) { if (xb_ld(&(bar)[XB_TMO])) break; if (_sp > XB_SPIN_CAP) { atomicAdd(&(bar)[XB_TMO], 1u); break; } } } } while (0)
DI void xcd_barrier_complete(unsigned* bar, unsigned x, unsigned& nloc, unsigned& nx) {
  const unsigned G = gridDim.x;
  unsigned sum, cnt, mine, sp = 0u;
  for (;;) {
    sum = 0u; cnt = 0u; mine = 0u;
#pragma unroll
    for (unsigned j = 0; j < 16; ++j) { const unsigned c = xb_ld(&bar[XB_XCNT(j)]); sum += c; cnt += (c > 0u) ? 1u : 0u; mine = (j == x) ? c : mine; }
    if (sum == G) break;
    __builtin_amdgcn_s_sleep(1);
    if ((++sp & 255u) == 0u) { if (xb_ld(&bar[XB_TMO])) break; if (sp > XB_SPIN_CAP) { atomicAdd(&bar[XB_TMO], 1u); break; } }
  }
  nloc = mine > 0u ? mine : 1u; nx = cnt > 0u ? cnt : 1u;
}
DI void grid_barrier(unsigned* bar, volatile unsigned* st) {
  asm volatile("s_waitcnt vmcnt(0)" ::: "memory");
  __syncthreads();
  if (my_tid() == 0) {
    const unsigned x = xb_xcc_id();
    __builtin_amdgcn_s_waitcnt(0);
    unsigned nloc = st[0], nx = st[1];
    if (nloc == 0u) { xcd_barrier_complete(bar, x, nloc, nx); st[0] = nloc; st[1] = nx; }
    const unsigned old = xb_add(&bar[XB_XSUB(x)], 1u);
    const unsigned gen = old / nloc;
    if (old + 1u == (gen + 1u) * nloc) {
      __builtin_amdgcn_fence(__ATOMIC_RELEASE, "agent");
      asm volatile("s_waitcnt vmcnt(0)" ::: "memory");
      const unsigned og = xb_add(&bar[XB_TOP], 1u);
      const unsigned tg = og / nx;
      if (og + 1u == (tg + 1u) * nx) xb_add(&bar[XB_TOPGEN], 1u);
      else XB_SPIN(xb_ld(&bar[XB_TOPGEN]) == tg, bar);
      __builtin_amdgcn_fence(__ATOMIC_ACQUIRE, "agent");
      xb_add(&bar[XB_XGEN(x)], 1u);
      asm volatile("s_waitcnt vmcnt(0)" ::: "memory");
    } else {
      XB_SPIN(xb_ld(&bar[XB_XGEN(x)]) == gen, bar);
      __builtin_amdgcn_fence(__ATOMIC_ACQUIRE, "agent");
      asm volatile("s_waitcnt vmcnt(0)" ::: "memory");
    }
  }
  __syncthreads();
}
#define SYNC_OR_RET(idx) do { if ((idx) + 1 >= PH_END) return; if ((idx) == 0) { grid.sync(); if (my_tid() == 0) (void)xb_add(&((unsigned*)(p.ws + MISC_XBAR))[XB_XCNT(xb_xcc_id())], 1u); } else grid_barrier((unsigned*)(p.ws + MISC_XBAR), (volatile unsigned*)(smem + 144 * 1024)); } while (0)
template <int l>
DI void run_layer(const Params& p, cg::grid_group& grid, char* smem, unsigned& epoch) {
  const float* mod = (const float*)(p.ws + MISC_MOD) + (size_t)l * 9 * 6144;
  float* hc = (float*)(p.ws + OFF_HC);
  const float* hl_src = (l == 0) ? p.in[0] : p.out;
  const float* hc_src = (l == 0) ? p.in[2] : hc;
  constexpr int B0 = l * 12;
  if (l == 0) {
    ph_convert(p, 0, smem);
    ph_ada(p, smem);
    hy_rawfilter(p, 0, SL, (float*)(p.ws + R_RAWF), smem);
    hy_rawfilter(p, 0, CL, (float*)(p.ws + MISC_RAWC), smem);
    SYNC_OR_RET(B0 + 0);
    ph_kf(p, 0, smem);
    ph_ln(hl_src, hc_src, nullptr, nullptr, nullptr, nullptr, (bf16_t*)p.out, mod, 0, MT);
    SYNC_OR_RET(B0 + 1);
  }
  for (int rep = 0; rep < REP_GEMM; ++rep) ph_inproj(p, l == 0 ? (const bf16_t*)p.out : (const bf16_t*)(p.ws + R_U), smem);
  SYNC_OR_RET(B0 + 2);
  for (int rep = 0; rep < REP_HY; ++rep) {
  if (blockIdx.x == 0 && my_tid() == 0) *(unsigned*)(p.ws + MISC_BAR + 64 + 64 * l) = 0u;
  ph_hyena(p, l, smem);
  if (l == 0) ph_hyena_ctx(p, l, smem);
  }
  ph_rope(p, smem);
  for (int rep = 0; rep < REP_RWP; ++rep) ph_rwprep(p, l, smem);
  SYNC_OR_RET(B0 + 3);
  for (int rep = 0; rep < REP_SCAN; ++rep) ph_scan(p, smem);
  for (int rep = 0; rep < REP_ATTN; ++rep) ph_attn(p, l, smem);
  SYNC_OR_RET(B0 + 4);
  ph_rwout(p, l);
  if (l != 0) ph_ln(hl_src, hc_src, nullptr, nullptr, nullptr, nullptr, (bf16_t*)(p.ws + R_URE), mod, 0, ML);
  SYNC_OR_RET(B0 + 5);
  for (int rep = 0; rep < REP_GEMM; ++rep) ph_merge(p, l, l == 0 ? (const bf16_t*)p.out : (const bf16_t*)(p.ws + R_URE), smem);
  SYNC_OR_RET(B0 + 6);
  ph_resgemm(p, l, (const bf16_t*)(p.ws + R_ACC), 1024, (const bf16_t*)(p.ws + WB_OUT), hl_src, hc_src, 2048, smem);
  if (l == 0) hy_rawfilter(p, 1, SL, (float*)(p.ws + R_RAWF), smem);
  SYNC_OR_RET(B0 + 7);
  ph_ln(p.out, hc, p.out, hc, p.in[35] + (size_t)l * D, p.in[36] + (size_t)l * D, (bf16_t*)(p.ws + R_U), mod, 3072, l == 0 ? MT : ML);
  if (l == 0) ph_kf(p, 1, smem);
  SYNC_OR_RET(B0 + 8);
  for (int rep = 0; rep < REP_GEMM; ++rep) ph_ffnup(p, l, smem);
  SYNC_OR_RET(B0 + 9);
  ph_resgemm(p, l, (const bf16_t*)(p.ws + R_HID), 2816, (const bf16_t*)(p.ws + WB_DOWN), p.out, hc, 5120, smem);
  SYNC_OR_RET(B0 + 10);
  if (l == 0) {
    ph_ln(p.out, hc, p.out, hc, p.in[41], p.in[42], (bf16_t*)(p.ws + R_U), mod + 9 * 6144, 0, MT);
    ph_convert(p, 1, smem);
  } else {
    ph_ln(p.out, hc, p.out, hc, p.in[41] + (size_t)l * D, p.in[42] + (size_t)l * D, nullptr, mod, 0, ML);
  }
  SYNC_OR_RET(B0 + 11);
}

__global__ void __launch_bounds__(NTHR) mega(Params p) {
  extern __shared__ __attribute__((aligned(16))) char smem[];
  cg::grid_group grid = cg::this_grid();
  unsigned epoch = 0;
  if (blockIdx.x == 0) for (int i = my_tid(); i < XCD_BAR_WORDS; i += NTHR) ((unsigned*)(p.ws + MISC_XBAR))[i] = 0u;
  if (my_tid() < 2) ((volatile unsigned*)(smem + 144 * 1024))[my_tid()] = 0u;
  if (blockIdx.x == 0 && my_tid() < 64) *(unsigned*)(p.ws + MISC_ZERO + my_tid() * 4) = 0u;
  run_layer<0>(p, grid, smem, epoch);
  if (PH_END > 12) run_layer<1>(p, grid, smem, epoch);
}

extern "C" void kernel_launch(void* const* d_in, const int* in_sizes, int n_in, void* d_out, int out_size,
                              void* d_ws, size_t ws_size, hipStream_t stream) {
  static int grid_blocks = 0;
  if (!grid_blocks) {
    int dev = 0, cus = 0, per_cu = 0;
    (void)hipGetDevice(&dev);
    (void)hipDeviceGetAttribute(&cus, hipDeviceAttributeMultiprocessorCount, dev);
    (void)hipFuncSetAttribute((const void*)mega, hipFuncAttributeMaxDynamicSharedMemorySize, SMEM_BYTES);
    (void)hipOccupancyMaxActiveBlocksPerMultiprocessor(&per_cu, mega, NTHR, SMEM_BYTES);
    if (per_cu < 1) per_cu = 1;
    if (per_cu > 1) per_cu = 1;
    grid_blocks = cus * per_cu;
  }
  Params p{};
  for (int i = 0; i < 43; ++i) p.in[i] = (const float*)d_in[i];
  p.out = (float*)d_out; p.ws = (char*)d_ws;
  void* args[] = {&p};
  hipError_t e = hipLaunchCooperativeKernel((void*)mega, dim3(grid_blocks), dim3(NTHR), args, SMEM_BYTES, stream);
  if (e != hipSuccess) fprintf(stderr, "cooperative launch failed: %s (grid %d)\n", hipGetErrorString(e), grid_blocks);
}
```

```cpp
#include <hip/hip_runtime.h>
#include <hip/hip_cooperative_groups.h>
#include <cstdio>
#include <cstdint>
namespace cg = cooperative_groups;

#define DI __device__ __forceinline__
typedef unsigned short bf16_t;
typedef short bf16x8 __attribute__((ext_vector_type(8)));
typedef float f32x4 __attribute__((ext_vector_type(4)));

constexpr int D = 1024, NB = 8, SL = 4096, CL = 256;
constexpr int ML = NB * SL, MC = NB * CL, MT = ML + MC;
constexpr int KEYS = SL + CL;
constexpr int NTHR = 512;
constexpr float DN_ALPHA = 1.41421356237f;
constexpr size_t UNIT = (size_t)MT * 512;

constexpr size_t WB_IN = 0;
constexpr size_t WB_GATE = WB_IN + (size_t)3328 * 1024 * 2;
constexpr size_t WB_BR = WB_GATE + (size_t)4096 * 1024 * 2;
constexpr size_t WB_OUT = WB_BR + (size_t)4 * 1024 * 256 * 2;
constexpr size_t WB_UP = WB_OUT + (size_t)1024 * 1024 * 2;
constexpr size_t WB_DOWN = WB_UP + (size_t)5632 * 1024 * 2;
constexpr size_t WB_END = WB_DOWN + (size_t)1024 * 2816 * 2;
constexpr size_t OFF_KF = WB_END;
constexpr size_t OFF_HC = OFF_KF + (size_t)512 * 8192 * 8;
constexpr size_t OFF_MISC = OFF_HC + (size_t)MC * D * 4;
constexpr size_t MISC_MOD = OFF_MISC;
constexpr size_t MISC_TW = MISC_MOD + (size_t)2 * 9 * 6144 * 4;
constexpr size_t MISC_RAWC = MISC_TW + 4096 * 8;
constexpr size_t MISC_GCTX = MISC_RAWC + (size_t)256 * 1024 * 4;
constexpr size_t MISC_RWW = MISC_GCTX + (size_t)512 * 512 * 4;
constexpr size_t RWW_F = MISC_RWW, RWW_B = RWW_F + 256 * 64 * 2, RWW_A = RWW_B + 256 * 64 * 2, RWW_GF = RWW_A + 256 * 64 * 2, RWW_GB = RWW_GF + 256 * 128 * 2;
constexpr size_t MISC_XBAR = OFF_MISC + (size_t)3 * 1024 * 1024;
constexpr size_t OFF_R = OFF_MISC + (size_t)4 * 1024 * 1024;
constexpr size_t MISC_BAR = OFF_R - 256;
constexpr size_t MISC_ZERO = OFF_R - 512;
static_assert(RWW_GB + 256 * 128 * 2 <= MISC_ZERO, "misc overflow");
constexpr size_t R_YHY = OFF_R, R_YSW = OFF_R + UNIT, R_YDF = OFF_R + 2 * UNIT;
constexpr size_t R_PHY = OFF_R + 3 * UNIT;
constexpr size_t R_PSW = OFF_R + 6 * UNIT;
constexpr size_t R_VTSW = R_PSW + (size_t)MT * 384 * 2;
constexpr size_t R_PDF = OFF_R + 8 * UNIT;
constexpr size_t R_VTDF = OFF_R + 10 * UNIT;
constexpr size_t R_PRW = OFF_R + 11 * UNIT;
constexpr size_t R_STR = R_PRW + (size_t)MT * 1216 * 2;
constexpr size_t R_G = R_STR + 7 * UNIT;
constexpr size_t R_END = R_G + 2 * UNIT;
constexpr size_t R_RAWF = OFF_R;
constexpr size_t R_OF = R_PHY, R_OB = R_PHY + UNIT;
constexpr size_t R_URE = R_PSW;
constexpr size_t R_YRW = R_VTDF;
constexpr size_t R_ACC = R_PRW;
constexpr size_t R_U = R_STR;
constexpr size_t R_HID = OFF_R;
static_assert(R_END <= (size_t)512 * 1024 * 1024, "ws overflow");
static_assert((size_t)MT * 2816 * 2 <= 11 * UNIT, "hid");

constexpr int SMEM_BYTES = 144 * 1024 + 64;

struct Params {
  const float* in[43];
  float* out;
  char* ws;
};

DI int my_tid() { int t = (int)__builtin_amdgcn_workitem_id_x(); asm volatile("" : "+v"(t)); return t; }
DI unsigned f2bf(float f) { unsigned u = __float_as_uint(f); u += 0x7fffu + ((u >> 16) & 1u); return u >> 16; }
DI float bf2f(unsigned h) { return __uint_as_float(h << 16); }
typedef __bf16 bf16v2_t __attribute__((ext_vector_type(2)));
typedef float f32v2_t __attribute__((ext_vector_type(2)));
DI unsigned pack2(float lo, float hi) { f32v2_t v = {lo, hi}; bf16v2_t b = __builtin_convertvector(v, bf16v2_t); return __builtin_bit_cast(unsigned, b); }

DI float bflo(unsigned w) { return __uint_as_float(w << 16); }
DI float bfhi(unsigned w) { return __uint_as_float(w & 0xffff0000u); }
DI float sigmoidf_(float x) { return __builtin_amdgcn_rcpf(1.f + __expf(-x)); }
DI float siluf_(float x) { return x * __builtin_amdgcn_rcpf(1.f + __expf(-x)); }
DI float wave_sum(float v) {
#pragma unroll
  for (int o = 32; o >= 1; o >>= 1) v += __shfl_xor(v, o);
  return v;
}
template <int CTRL> DI float dpp_mov(float v) {
  return __int_as_float(__builtin_amdgcn_update_dpp(0, __float_as_int(v), CTRL, 0xf, 0xf, false));
}
DI float sum16(float v) {
  v += dpp_mov<0xB1>(v);
  v += dpp_mov<0x4E>(v);
  v += dpp_mov<0x141>(v);
  v += dpp_mov<0x140>(v);
  return v;
}
DI void lds_barrier() { asm volatile("s_waitcnt lgkmcnt(0)" ::: "memory"); __builtin_amdgcn_s_barrier(); asm volatile("" ::: "memory"); }
DI uint4 sel4(bool z, uint4 v) { return make_uint4(z ? 0u : v.x, z ? 0u : v.y, z ? 0u : v.z, z ? 0u : v.w); }
DI int mod_idx(int row) { return row < ML ? (row >> 12) : 8; }

template <int NTW, bool DEEP, class RowFn>
DI void gemm_main(f32x4 (&acc)[4][NTW], const bf16_t* __restrict__ A, int lda, RowFn rowfn,
                  const bf16_t* __restrict__ Bt, int ldb, int K, char* smem) {
  constexpr int BN = NTW * 32;
  constexpr int A_BYTES = 256 * 128, B_BYTES = BN * 128, STAGE = A_BYTES + B_BYTES;
  constexpr int NBL = BN / 64;
  const int tid = my_tid(), lane = tid & 63, wid = tid >> 6, wm = wid >> 1, wn = wid & 1, g = lane >> 4, r16 = lane & 15;
  const int chunk = tid & 7, lrow = tid >> 3;
  long a0 = rowfn(lrow), a1 = rowfn(lrow + 64), a2 = rowfn(lrow + 128), a3 = rowfn(lrow + 192);
  const long c0 = a0 < 0 ? 0 : a0, c1 = a1 < 0 ? 0 : a1, c2 = a2 < 0 ? 0 : a2, c3 = a3 < 0 ? 0 : a3;
  const bf16_t* Bp = Bt + (long)lrow * ldb + chunk * 8;
  const bf16_t* Ap0 = A + c0 * lda + chunk * 8; const bf16_t* Ap1 = A + c1 * lda + chunk * 8;
  const bf16_t* Ap2 = A + c2 * lda + chunk * 8; const bf16_t* Ap3 = A + c3 * lda + chunk * 8;
  struct Regs { uint4 a0, a1, a2, a3, b0, b1; };
  Regs R0, R1;
  R0.b1 = make_uint4(0, 0, 0, 0); R1.b1 = make_uint4(0, 0, 0, 0);
  auto GLOAD = [&](Regs& R, int k0) {
    R.a0 = *(const uint4*)(Ap0 + k0); R.a1 = *(const uint4*)(Ap1 + k0);
    R.a2 = *(const uint4*)(Ap2 + k0); R.a3 = *(const uint4*)(Ap3 + k0);
    R.b0 = *(const uint4*)(Bp + k0);
    if constexpr (NBL > 1) R.b1 = *(const uint4*)(Bp + (long)64 * ldb + k0);
  };
  auto SSTORE = [&](const Regs& R, int st) {
    char* base = smem + st * STAGE + lrow * 128 + ((chunk ^ (lrow & 7)) << 4);
    *(uint4*)(base) = sel4(a0 < 0, R.a0); *(uint4*)(base + 64 * 128) = sel4(a1 < 0, R.a1);
    *(uint4*)(base + 128 * 128) = sel4(a2 < 0, R.a2); *(uint4*)(base + 192 * 128) = sel4(a3 < 0, R.a3);
    *(uint4*)(base + A_BYTES) = R.b0;
    if constexpr (NBL > 1) *(uint4*)(base + A_BYTES + 64 * 128) = R.b1;
  };
  auto COMPUTE = [&](int st) {
    const char* As = smem + st * STAGE + (wm * 64 + r16) * 128;
    const char* Bs = smem + st * STAGE + A_BYTES + (wn * (NTW * 16) + r16) * 128;
#pragma unroll
    for (int kk = 0; kk < 2; ++kk) {
      const int sw = ((kk * 4 + g) ^ (r16 & 7)) << 4;
      bf16x8 af[4], bfr[NTW];
#pragma unroll
      for (int mt = 0; mt < 4; ++mt) af[mt] = *(const bf16x8*)(As + mt * 16 * 128 + sw);
#pragma unroll
      for (int nt = 0; nt < NTW; ++nt) bfr[nt] = *(const bf16x8*)(Bs + nt * 16 * 128 + sw);
#pragma unroll
      for (int mt = 0; mt < 4; ++mt)
#pragma unroll
        for (int nt = 0; nt < NTW; ++nt)
          acc[mt][nt] = __builtin_amdgcn_mfma_f32_16x16x32_bf16(af[mt], bfr[nt], acc[mt][nt], 0, 0, 0);
    }
  };
  const int nk = K >> 6;
  __syncthreads();
  GLOAD(R0, 0);
  SSTORE(R0, 0);
  if constexpr (DEEP) {
    GLOAD(R0, 64);
    if (nk > 2) GLOAD(R1, 128);
    lds_barrier();
    bf16x8 fa0[4], fb0[NTW], fa1[4], fb1[NTW];
    auto READF = [&](bf16x8 (&fa)[4], bf16x8 (&fb)[NTW], int st, int kk) {
      const int sw = ((kk * 4 + g) ^ (r16 & 7)) << 4;
      const char* As = smem + st * STAGE + (wm * 64 + r16) * 128 + sw;
      const char* Bs = smem + st * STAGE + A_BYTES + (wn * (NTW * 16) + r16) * 128 + sw;
#pragma unroll
      for (int mt = 0; mt < 4; ++mt) fa[mt] = *(const bf16x8*)(As + mt * 16 * 128);
#pragma unroll
      for (int nt = 0; nt < NTW; ++nt) fb[nt] = *(const bf16x8*)(Bs + nt * 16 * 128);
    };
    auto MMA = [&](const bf16x8 (&fa)[4], const bf16x8 (&fb)[NTW]) {
#pragma unroll
      for (int mt = 0; mt < 4; ++mt)
#pragma unroll
        for (int nt = 0; nt < NTW; ++nt)
          acc[mt][nt] = __builtin_amdgcn_mfma_f32_16x16x32_bf16(fa[mt], fb[nt], acc[mt][nt], 0, 0, 0);
    };
    READF(fa0, fb0, 0, 0);
    for (int kt = 0; kt < nk; kt += 2) {
      READF(fa1, fb1, 0, 1);
      MMA(fa0, fb0);
#pragma unroll
      for (int i = 0; i < 4 + NTW; ++i) { __builtin_amdgcn_sched_group_barrier(0x100, 1, 0); __builtin_amdgcn_sched_group_barrier(0x008, 2, 0); }
      __builtin_amdgcn_sched_barrier(0);
      SSTORE(R0, 1);
      if (kt + 3 < nk) GLOAD(R0, (kt + 3) * 64);
      MMA(fa1, fb1);
#pragma unroll
      for (int i = 0; i < 6; ++i) { __builtin_amdgcn_sched_group_barrier(0x200, 1, 0); __builtin_amdgcn_sched_group_barrier(0x020, 1, 0); __builtin_amdgcn_sched_group_barrier(0x008, 2, 0); }
      __builtin_amdgcn_sched_barrier(0);
      lds_barrier();
      READF(fa0, fb0, 1, 0);
      READF(fa1, fb1, 1, 1);
      MMA(fa0, fb0);
#pragma unroll
      for (int i = 0; i < 4 + NTW; ++i) { __builtin_amdgcn_sched_group_barrier(0x100, 1, 0); __builtin_amdgcn_sched_group_barrier(0x008, 2, 0); }
      __builtin_amdgcn_sched_barrier(0);
      if (kt + 2 < nk) SSTORE(R1, 0);
      if (kt + 4 < nk) GLOAD(R1, (kt + 4) * 64);
      MMA(fa1, fb1);
#pragma unroll
      for (int i = 0; i < 6; ++i) { __builtin_amdgcn_sched_group_barrier(0x200, 1, 0); __builtin_amdgcn_sched_group_barrier(0x020, 1, 0); __builtin_amdgcn_sched_group_barrier(0x008, 2, 0); }
      __builtin_amdgcn_sched_barrier(0);
      lds_barrier();
      if (kt + 2 < nk) READF(fa0, fb0, 0, 0);
    }
  } else {
    lds_barrier();
    for (int kt = 0; kt < nk; ++kt) {
      const int st = kt & 1;
      if (kt + 1 < nk) GLOAD(R0, (kt + 1) * 64);
      __builtin_amdgcn_sched_barrier(0);
      COMPUTE(st);
      __builtin_amdgcn_sched_barrier(0);
      if (kt + 1 < nk) SSTORE(R0, st ^ 1);
      lds_barrier();
    }
  }
}

#define GLDS16(gp, lp) __builtin_amdgcn_global_load_lds((const unsigned*)(gp), (unsigned*)(lp), 16, 0, 0)
template <class RowFn>
DI void gemm_glds(f32x4 (&acc)[4][4], const bf16_t* __restrict__ A, int lda, RowFn rowfn,
                  const bf16_t* __restrict__ Bt, int ldb, int K, char* smem, const bf16_t* zrow) {
  constexpr int A_BYTES = 256 * 128, STAGE = A_BYTES + 128 * 128;
  const int tid = my_tid(), lane = tid & 63, wid = tid >> 6, wm = wid >> 1, wn = wid & 1, g = lane >> 4, r16 = lane & 15;
  const int lrow = tid >> 3, c = (tid & 7) ^ (lrow & 7);
  const long a0 = rowfn(lrow), a1 = rowfn(lrow + 64), a2 = rowfn(lrow + 128), a3 = rowfn(lrow + 192);
  const bf16_t* pa0 = (a0 >= 0 ? A + a0 * lda : zrow) + c * 8; const int m0 = a0 >= 0 ? 1 : 0;
  const bf16_t* pa1 = (a1 >= 0 ? A + a1 * lda : zrow) + c * 8; const int m1 = a1 >= 0 ? 1 : 0;
  const bf16_t* pa2 = (a2 >= 0 ? A + a2 * lda : zrow) + c * 8; const int m2 = a2 >= 0 ? 1 : 0;
  const bf16_t* pa3 = (a3 >= 0 ? A + a3 * lda : zrow) + c * 8; const int m3 = a3 >= 0 ? 1 : 0;
  const bf16_t* pb0 = Bt + (long)lrow * ldb + c * 8; const bf16_t* pb1 = pb0 + (long)64 * ldb;
  auto ISSUE = [&](int kt, int bi) {
    char* d = smem + bi * STAGE + tid * 16;
    const int k0 = kt * 64;
    GLDS16(pa0 + k0 * m0, d); GLDS16(pa1 + k0 * m1, d + 8192); GLDS16(pa2 + k0 * m2, d + 16384); GLDS16(pa3 + k0 * m3, d + 24576);
    GLDS16(pb0 + k0, d + A_BYTES); GLDS16(pb1 + k0, d + A_BYTES + 8192);
  };
  auto COMPUTE = [&](int bi) {
    const char* As = smem + bi * STAGE + (wm * 64 + r16) * 128;
    const char* Bs = smem + bi * STAGE + A_BYTES + (wn * 64 + r16) * 128;
#pragma unroll
    for (int kk = 0; kk < 2; ++kk) {
      const int sw = ((kk * 4 + g) ^ (r16 & 7)) << 4;
      bf16x8 af[4], bfr[4];
#pragma unroll
      for (int mt = 0; mt < 4; ++mt) af[mt] = *(const bf16x8*)(As + mt * 16 * 128 + sw);
#pragma unroll
      for (int nt = 0; nt < 4; ++nt) bfr[nt] = *(const bf16x8*)(Bs + nt * 16 * 128 + sw);
      __builtin_amdgcn_s_setprio(1);
#pragma unroll
      for (int mt = 0; mt < 4; ++mt)
#pragma unroll
        for (int nt = 0; nt < 4; ++nt)
          acc[mt][nt] = __builtin_amdgcn_mfma_f32_16x16x32_bf16(af[mt], bfr[nt], acc[mt][nt], 0, 0, 0);
      __builtin_amdgcn_s_setprio(0);
    }
  };
  const int nk = K >> 6;
  __syncthreads();
  ISSUE(0, 0);
  ISSUE(1, 1);
  asm volatile("s_waitcnt vmcnt(6)" ::: "memory");
  __builtin_amdgcn_s_barrier();
  asm volatile("" ::: "memory");
  int bi = 0;
  for (int kt = 0; kt < nk; ++kt) {
    const int b2 = bi >= 1 ? bi - 1 : 2;
    if (kt + 2 < nk) ISSUE(kt + 2, b2);
    COMPUTE(bi);
    if (kt + 2 < nk) asm volatile("s_waitcnt vmcnt(6)" ::: "memory");
    else asm volatile("s_waitcnt vmcnt(0)" ::: "memory");
    asm volatile("s_waitcnt lgkmcnt(0)" ::: "memory");
    __builtin_amdgcn_s_barrier();
    asm volatile("" ::: "memory");
    bi = bi == 2 ? 0 : bi + 1;
  }
}

DI void gemm_glds256(f32x4 (&acc)[8][4], const bf16_t* __restrict__ A, int lda, long arow0,
                     const bf16_t* __restrict__ Bt, int ldb, int K, char* smem) {
  constexpr int A_BYTES = 256 * 128, STAGE = 2 * A_BYTES;
  const int tid = my_tid(), lane = tid & 63, wid = tid >> 6, wm = wid >> 2, wn = wid & 3, g = lane >> 4, r16 = lane & 15;
  const int lrow = tid >> 3, c = (tid & 7) ^ (lrow & 7);
  const bf16_t* pa = A + (arow0 + lrow) * (long)lda + c * 8;
  const bf16_t* pb = Bt + (long)lrow * ldb + c * 8;
  const long a64 = (long)64 * lda, b64 = (long)64 * ldb;
  auto ISSUE = [&](int kt, int bi) {
    char* d = smem + bi * STAGE + tid * 16;
    const int k0 = kt * 64;
    GLDS16(pa + k0, d); GLDS16(pa + a64 + k0, d + 8192); GLDS16(pa + 2 * a64 + k0, d + 16384); GLDS16(pa + 3 * a64 + k0, d + 24576);
    GLDS16(pb + k0, d + A_BYTES); GLDS16(pb + b64 + k0, d + A_BYTES + 8192); GLDS16(pb + 2 * b64 + k0, d + A_BYTES + 16384); GLDS16(pb + 3 * b64 + k0, d + A_BYTES + 24576);
  };
  auto COMPUTE = [&](int bi) {
    const char* As = smem + bi * STAGE + (wm * 128 + r16) * 128;
    const char* Bs = smem + bi * STAGE + A_BYTES + (wn * 64 + r16) * 128;
#pragma unroll
    for (int kk = 0; kk < 2; ++kk) {
      const int sw = ((kk * 4 + g) ^ (r16 & 7)) << 4;
      bf16x8 bfr[4];
#pragma unroll
      for (int nt = 0; nt < 4; ++nt) bfr[nt] = *(const bf16x8*)(Bs + nt * 16 * 128 + sw);
      __builtin_amdgcn_s_setprio(1);
#pragma unroll
      for (int mt = 0; mt < 8; ++mt) {
        const bf16x8 af = *(const bf16x8*)(As + mt * 16 * 128 + sw);
#pragma unroll
        for (int nt = 0; nt < 4; ++nt)
          acc[mt][nt] = __builtin_amdgcn_mfma_f32_16x16x32_bf16(af, bfr[nt], acc[mt][nt], 0, 0, 0);
      }
      __builtin_amdgcn_s_setprio(0);
    }
  };
  const int nk = K >> 6;
  __syncthreads();
  ISSUE(0, 0);
  asm volatile("s_waitcnt vmcnt(0)" ::: "memory");
  __builtin_amdgcn_s_barrier();
  asm volatile("" ::: "memory");
  int bi = 0;
  for (int kt = 0; kt < nk; ++kt) {
    if (kt + 1 < nk) ISSUE(kt + 1, bi ^ 1);
    COMPUTE(bi);
    asm volatile("s_waitcnt vmcnt(0)" ::: "memory");
    asm volatile("s_waitcnt lgkmcnt(0)" ::: "memory");
    __builtin_amdgcn_s_barrier();
    asm volatile("" ::: "memory");
    bi ^= 1;
  }
}
DI void zero_acc256(f32x4 (&acc)[8][4]) {
#pragma unroll
  for (int i = 0; i < 8; ++i)
#pragma unroll
    for (int j = 0; j < 4; ++j) acc[i][j] = (f32x4){0.f, 0.f, 0.f, 0.f};
}

DI bool next_tile(int i, int MTILES, int NTILES, int& mt, int& nt) {
  const int xcd = blockIdx.x & 7, slot = blockIdx.x >> 3, nslot = gridDim.x >> 3;
  const int m_lo = (MTILES * xcd) >> 3, m_hi = (MTILES * (xcd + 1)) >> 3, Mloc = m_hi - m_lo;
  const int q = i * nslot + slot;
  if (q >= Mloc * NTILES) return false;
  const int gidx = q / (4 * NTILES), m0 = gidx * 4;
  const int rows = (Mloc - m0) < 4 ? (Mloc - m0) : 4;
  const int within = q - gidx * 4 * NTILES;
  nt = within / rows; mt = m_lo + m0 + within % rows;
  return true;
}

struct RowPlain { long base; DI long operator()(int r) const { return base + r; } };
struct RowHalo { long rowbase; int t0; int len; DI long operator()(int r) const { int t = t0 + r; return (t >= 0 && t < len) ? rowbase + t : -1; } };

template <int NTW> DI void zero_acc(f32x4 (&acc)[4][NTW]) {
#pragma unroll
  for (int i = 0; i < 4; ++i)
#pragma unroll
    for (int j = 0; j < NTW; ++j) acc[i][j] = (f32x4){0.f, 0.f, 0.f, 0.f};
}

DI void cvt_unit(const float* __restrict__ src, int ldsrc, int srccol0, int k0, bf16_t* __restrict__ dst, int K, int n0, char* smem, bool perm = true) {
  float* T = (float*)smem;
  const int tid = my_tid();
  __syncthreads();
  if (srccol0 >= 0) {
#pragma unroll
    for (int i = 0; i < 8; ++i) {
      int idx = tid + i * 512; int k = idx >> 6, n = idx & 63;
      T[k * 65 + n] = src[(long)(k0 + k) * ldsrc + srccol0 + n];
    }
  }
  __syncthreads();
  int nd = tid >> 3, kc = (tid & 7) * 8; int n = perm ? ((nd & 15) * 4 + (nd >> 4)) : nd;
  uint4 o = make_uint4(0, 0, 0, 0);
  if (srccol0 >= 0) {
    o.x = pack2(T[(kc + 0) * 65 + n], T[(kc + 1) * 65 + n]);
    o.y = pack2(T[(kc + 2) * 65 + n], T[(kc + 3) * 65 + n]);
    o.z = pack2(T[(kc + 4) * 65 + n], T[(kc + 5) * 65 + n]);
    o.w = pack2(T[(kc + 6) * 65 + n], T[(kc + 7) * 65 + n]);
  }
  *(uint4*)(dst + (long)(n0 + nd) * K + k0 + kc) = o;
}

DI void ph_convert(const Params& p, int l, char* smem) {
  for (int u = blockIdx.x; u < 4508; u += gridDim.x) {
    if (u < 832) {
      int gI = u >> 4, kt = u & 15; int n0 = gI * 64; int sc;
      if (n0 < 1280) sc = n0; else if (n0 < 2048) sc = 2496 + (n0 - 1280); else if (n0 < 3264) sc = 1280 + (n0 - 2048); else sc = -1;
      cvt_unit(p.in[6] + (size_t)l * 1024 * 7360, 7360, sc, kt * 64, (bf16_t*)(p.ws + WB_IN), 1024, n0, smem);
    } else if (u < 1856) {
      int v = u - 832; int gI = v >> 4, kt = v & 15;
      cvt_unit(p.in[6] + (size_t)l * 1024 * 7360, 7360, 3264 + gI * 64, kt * 64, (bf16_t*)(p.ws + WB_GATE), 1024, gI * 64, smem);
    } else if (u < 2112) {
      int v = u - 1856; int gI = v >> 2, kt = v & 3; int j = gI >> 4, gg = gI & 15;
      cvt_unit(p.in[33] + ((size_t)l * 4 + j) * 256 * 1024, 1024, gg * 64, kt * 64, (bf16_t*)(p.ws + WB_BR) + (size_t)j * 1024 * 256, 256, gg * 64, smem);
    } else if (u < 2368) {
      int v = u - 2112; int gI = v >> 4, kt = v & 15;
      cvt_unit(p.in[34] + (size_t)l * 1024 * 1024, 1024, gI * 64, kt * 64, (bf16_t*)(p.ws + WB_OUT), 1024, gI * 64, smem);
    } else if (u < 3776) {
      int v = u - 2368; int gI = v >> 4, kt = v & 15; int nt = gI >> 2, q = gI & 3;
      cvt_unit(p.in[37] + (size_t)l * 1024 * 5632, 5632, (q >> 1) * 2816 + nt * 128 + (q & 1) * 64, kt * 64, (bf16_t*)(p.ws + WB_UP), 1024, gI * 64, smem);
    } else if (u < 4480) {
      int v = u - 3776; int gI = v / 44, kt = v % 44;
      cvt_unit(p.in[40] + (size_t)l * 2816 * 1024, 1024, gI * 64, kt * 64, (bf16_t*)(p.ws + WB_DOWN), 2816, gI * 64, smem);
    } else {
      int v = u - 4480;
      if (v < 4) cvt_unit(p.in[19] + (size_t)l * 2 * 64 * 256, 256, v * 64, 0, (bf16_t*)(p.ws + RWW_F), 64, v * 64, smem);
      else if (v < 8) cvt_unit(p.in[19] + (size_t)l * 2 * 64 * 256 + 64 * 256, 256, (v - 4) * 64, 0, (bf16_t*)(p.ws + RWW_B), 64, (v - 4) * 64, smem);
      else if (v < 12) cvt_unit(p.in[21] + (size_t)l * 64 * 256, 256, (v - 8) * 64, 0, (bf16_t*)(p.ws + RWW_A), 64, (v - 8) * 64, smem);
      else if (v < 20) { int w = v - 12; cvt_unit(p.in[22] + (size_t)l * 2 * 128 * 256, 256, (w >> 1) * 64, (w & 1) * 64, (bf16_t*)(p.ws + RWW_GF), 128, (w >> 1) * 64, smem); }
      else { int w = v - 20; cvt_unit(p.in[22] + (size_t)l * 2 * 128 * 256 + 128 * 256, 256, (w >> 1) * 64, (w & 1) * 64, (bf16_t*)(p.ws + RWW_GB), 128, (w >> 1) * 64, smem); }
    }
  }
}

DI void ph_ada(const Params& p, char* smem) {
  float* S = (float*)smem;
  float* R = S + 9 * 1024;
  const int tid = my_tid();
  bool loaded = false;
  for (int u = blockIdx.x; u < 192; u += gridDim.x) {
    if (!loaded) {
      __syncthreads();
      for (int i = tid; i < 9 * 1024; i += NTHR) { float c = i < 8192 ? p.in[1][i] : p.in[3][i - 8192]; S[i] = siluf_(c); }
      loaded = true;
    }
    __syncthreads();
    int l = u / 96, n0 = (u % 96) * 64;
    int col = tid & 63, ks = tid >> 6;
    const float* W = p.in[4] + (size_t)l * 1024 * 6144 + n0 + col;
    float a[9];
#pragma unroll
    for (int b = 0; b < 9; ++b) a[b] = 0.f;
    for (int k = ks * 128; k < ks * 128 + 128; ++k) {
      float w = W[(size_t)k * 6144];
#pragma unroll
      for (int b = 0; b < 9; ++b) a[b] += S[b * 1024 + k] * w;
    }
#pragma unroll
    for (int b = 0; b < 9; ++b) R[(ks * 9 + b) * 64 + col] = a[b];
    __syncthreads();
    for (int i = tid; i < 9 * 64; i += NTHR) {
      int b = i >> 6, c = i & 63; float s = 0.f;
#pragma unroll
      for (int k2 = 0; k2 < 8; ++k2) s += R[(k2 * 9 + b) * 64 + c];
      s += p.in[5][(size_t)l * 6144 + n0 + c];
      ((float*)(p.ws + MISC_MOD))[((size_t)l * 9 + b) * 6144 + n0 + c] = s;
    }
  }
  for (int i = blockIdx.x * NTHR + tid; i < 4096; i += gridDim.x * NTHR) {
    float s, c; sincospif(-(float)i / 4096.f, &s, &c);
    ((float2*)(p.ws + MISC_TW))[i] = make_float2(c, s);
  }
}

DI void hy_rawfilter(const Params& p, int l, int Lf, float* __restrict__ dst, char* smem) {
  float* W1 = (float*)smem;
  float* W2 = W1 + 33 * 64;
  float* Z = W2 + 64 * 64;
  float* H1 = Z + 16 * 36;
  float* H2 = H1 + 16 * 64;
  const int tid = my_tid();
  const float* w1 = p.in[9] + (size_t)l * 33 * 64; const float* b1 = p.in[10] + l * 64;
  const float* w2 = p.in[11] + (size_t)l * 64 * 64; const float* b2 = p.in[12] + l * 64;
  const float* w3 = p.in[13] + (size_t)l * 64 * 1024; const float* fr = p.in[14] + l * 64;
  const int nunits = Lf / 16;
  bool loaded = false;
  for (int u = blockIdx.x; u < nunits; u += gridDim.x) {
    __syncthreads();
    if (!loaded) {
      for (int i = tid; i < 33 * 64; i += NTHR) W1[i] = w1[i];
      for (int i = tid; i < 64 * 64; i += NTHR) W2[i] = w2[i];
      loaded = true;
    }
    const int t0 = u * 16;
    for (int i = tid; i < 16 * 33; i += NTHR) {
      int tt = i / 33, f = i % 33; int t = t0 + tt; float v;
      if (f == 0) v = (float)t / (float)(Lf - 1);
      else {
        int bi = (f - 1) & 15;
        float wv = 6.283185307179586f * (float)t / (float)Lf;
        float fb = 1e-4f + (15.f - 1e-4f) * (float)bi / 15.f;
        float ang = wv * fb;
        v = (f <= 16) ? cosf(ang) : -sinf(ang);
      }
      Z[tt * 36 + f] = v;
    }
    __syncthreads();
    for (int i = tid; i < 16 * 64; i += NTHR) {
      int tt = i >> 6, f = i & 63; float s = b1[f];
      for (int k = 0; k < 33; ++k) s += Z[tt * 36 + k] * W1[k * 64 + f];
      H1[tt * 64 + f] = sinf(fr[f] * s);
    }
    __syncthreads();
    for (int i = tid; i < 16 * 64; i += NTHR) {
      int tt = i >> 6, f = i & 63; float s = b2[f];
      for (int k = 0; k < 64; ++k) s += H1[tt * 64 + k] * W2[k * 64 + f];
      H2[tt * 64 + f] = sinf(fr[f] * s);
    }
    __syncthreads();
    float a0[16], a1[16];
#pragma unroll
    for (int i = 0; i < 16; ++i) { a0[i] = 0.f; a1[i] = 0.f; }
    for (int k = 0; k < 64; ++k) {
      float wa = w3[k * 1024 + tid], wb = w3[k * 1024 + 512 + tid];
#pragma unroll
      for (int i = 0; i < 16; ++i) { float h = H2[i * 64 + k]; a0[i] += h * wa; a1[i] += h * wb; }
    }
    {
      int w = tid & 255;
      float delta = fabsf(-3.0701134573253944f + (-15.350567286626972f + 3.0701134573253944f) * (float)w / 255.f);
#pragma unroll
      for (int i = 0; i < 16; ++i) {
        float tn = (float)(t0 + i) / (float)(Lf - 1);
        float dec = expf(-tn * delta);
        dst[(size_t)(t0 + i) * 1024 + tid] = a0[i] * dec;
        dst[(size_t)(t0 + i) * 1024 + 512 + tid] = a1[i] * dec;
      }
    }
  }
}

DI float2 cmul(float2 a, float2 b) { return make_float2(a.x * b.x - a.y * b.y, a.x * b.y + a.y * b.x); }
DI float2 cmulc(float2 a, float2 b) { return make_float2(a.x * b.x + a.y * b.y, a.y * b.x - a.x * b.y); }
DI float2 cadd(float2 a, float2 b) { return make_float2(a.x + b.x, a.y + b.y); }
DI float2 csub(float2 a, float2 b) { return make_float2(a.x - b.x, a.y - b.y); }
DI void fft_dif(float2* X, const float2* W) {
  const int tid = my_tid();
  for (int ls = 12; ls >= 2; ls -= 2) {
    const int s = 1 << ls, h = s >> 1;
    __syncthreads();
#pragma unroll
    for (int i = 0; i < 4; ++i) {
      const int bf = tid + i * 512; const int j = bf & (h - 1); const int base = ((bf >> (ls - 1)) << (ls + 1)) + j;
      const float2 x0 = X[base], x1 = X[base + h], x2 = X[base + s], x3 = X[base + s + h];
      const float2 w1 = W[s - 1 + j], w2 = W[h - 1 + j];
      const float2 y0 = cadd(x0, x2), y2 = cmul(csub(x0, x2), w1), y1 = cadd(x1, x3);
      const float2 t = cmul(csub(x1, x3), w1); const float2 y3 = make_float2(t.y, -t.x);
      X[base] = cadd(y0, y1); X[base + h] = cmul(csub(y0, y1), w2);
      X[base + s] = cadd(y2, y3); X[base + s + h] = cmul(csub(y2, y3), w2);
    }
  }
  __syncthreads();
#pragma unroll
  for (int i = 0; i < 4; ++i) {
    const int q = tid + i * 512;
    float4 a = *(float4*)(X + 4 * q), b = *(float4*)(X + 4 * q + 2);
    *(float4*)(X + 4 * q) = make_float4(a.x + a.z, a.y + a.w, a.x - a.z, a.y - a.w);
    *(float4*)(X + 4 * q + 2) = make_float4(b.x + b.z, b.y + b.w, b.x - b.z, b.y - b.w);
  }
  __syncthreads();
}
DI void fft_dit_inv(float2* X, const float2* W) {
  const int tid = my_tid();
  __syncthreads();
#pragma unroll
  for (int i = 0; i < 4; ++i) {
    const int q = tid + i * 512;
    float4 a = *(float4*)(X + 4 * q), b = *(float4*)(X + 4 * q + 2);
    *(float4*)(X + 4 * q) = make_float4(a.x + a.z, a.y + a.w, a.x - a.z, a.y - a.w);
    *(float4*)(X + 4 * q + 2) = make_float4(b.x + b.z, b.y + b.w, b.x - b.z, b.y - b.w);
  }
  for (int ls = 2; ls <= 12; ls += 2) {
    const int s = 1 << ls, h = s >> 1;
    __syncthreads();
#pragma unroll
    for (int i = 0; i < 4; ++i) {
      const int bf = tid + i * 512; const int j = bf & (h - 1); const int base = ((bf >> (ls - 1)) << (ls + 1)) + j;
      const float2 e0 = X[base], e1 = X[base + h], e2 = X[base + s], e3 = X[base + s + h];
      const float2 w1 = W[s - 1 + j], w2 = W[h - 1 + j];
      const float2 t1 = cmulc(e1, w2), t3 = cmulc(e3, w2);
      const float2 u0 = cadd(e0, t1), u1 = csub(e0, t1), u2 = cadd(e2, t3), u3 = csub(e2, t3);
      const float2 a2 = cmulc(u2, w1); const float2 q3 = cmulc(u3, w1); const float2 a3 = make_float2(-q3.y, q3.x);
      X[base] = cadd(u0, a2); X[base + s] = csub(u0, a2);
      X[base + h] = cadd(u1, a3); X[base + s + h] = csub(u1, a3);
    }
  }
  __syncthreads();
}
DI void load_twiddles(const Params& p, float2* W) {
  const float2* tw = (const float2*)(p.ws + MISC_TW);
  for (int i = my_tid(); i < 8191; i += NTHR) {
    const int ls = 31 - __clz(i + 1); const int pos = i + 1 - (1 << ls);
    W[i] = tw[pos << (12 - ls)];
  }
}

DI void ph_kf(const Params& p, int l, char* smem) {
  float2* X = (float2*)smem; float2* W = X + 8192; float* red = (float*)(W + 8192);
  const int tid = my_tid(), lane = tid & 63, wid = tid >> 6;
  const float* rawf = (const float*)(p.ws + R_RAWF);
  float2* kf = (float2*)(p.ws + OFF_KF);
  bool tw = false;
  for (int u = blockIdx.x; u < 256; u += gridDim.x) {
    if (!tw) { load_twiddles(p, W); tw = true; }
    const int o = u >> 7, c = (u & 127) * 2;
    float2 fw[8], bw[8]; float sa = 0.f, sb = 0.f;
#pragma unroll
    for (int i = 0; i < 8; ++i) {
      int t = tid + i * 512;
      fw[i] = *(const float2*)(rawf + (size_t)t * 1024 + o * 512 + c);
      bw[i] = *(const float2*)(rawf + (size_t)t * 1024 + o * 512 + 256 + c);
      sa += fabsf(fw[i].x) + fabsf(bw[i].x); sb += fabsf(fw[i].y) + fabsf(bw[i].y);
    }
    sa = wave_sum(sa); sb = wave_sum(sb);
    __syncthreads();
    if (lane == 0) { red[wid * 2] = sa; red[wid * 2 + 1] = sb; }
    __syncthreads();
    float ta = 0.f, tb = 0.f;
#pragma unroll
    for (int w = 0; w < 8; ++w) { ta += red[w * 2]; tb += red[w * 2 + 1]; }
    const float ia = 1.f / ta, ib = 1.f / tb;
#pragma unroll
    for (int i = 0; i < 8; ++i) {
      int t = tid + i * 512;
      X[t] = make_float2(fw[i].x * ia, fw[i].y * ib);
      if (t >= 1) X[8192 - t] = make_float2(bw[i].x * ia, bw[i].y * ib);
      else X[4096] = make_float2(0.f, 0.f);
    }
    fft_dif(X, W);
    float2* ka = kf + (size_t)(o * 256 + c) * 8192; float2* kb = ka + 8192;
#pragma unroll 4
    for (int i = 0; i < 16; ++i) {
      int pidx = tid + i * 512;
      int k = (int)(__brev((unsigned)pidx) >> 19);
      int k2 = (8192 - k) & 8191;
      int p2 = (int)(__brev((unsigned)k2) >> 19);
      float2 c1 = X[pidx], c2 = X[p2];
      float2 A = make_float2(0.5f * (c1.x + c2.x), 0.5f * (c1.y - c2.y));
      float2 Bv = make_float2(0.5f * (c1.y + c2.y), -0.5f * (c1.x - c2.x));
      ka[pidx] = A; kb[pidx] = Bv;
    }
    __syncthreads();
  }
  if (l == 0) {
    const float* rawc = (const float*)(p.ws + MISC_RAWC);
    float* G = (float*)(p.ws + MISC_GCTX);
    for (int u = blockIdx.x * 8 + wid; u < 512; u += gridDim.x * 8) {
      int o = u >> 8, c = u & 255; float f[4], b[4]; float s = 0.f;
#pragma unroll
      for (int i = 0; i < 4; ++i) {
        int t = lane + i * 64;
        f[i] = rawc[(size_t)t * 1024 + o * 512 + c]; b[i] = rawc[(size_t)t * 1024 + o * 512 + 256 + c];
        s += fabsf(f[i]) + fabsf(b[i]);
      }
      s = wave_sum(s); float inv = 1.f / s;
#pragma unroll
      for (int i = 0; i < 4; ++i) {
        int t = lane + i * 64;
        G[(size_t)u * 512 + 256 + t] = f[i] * inv;
        if (t >= 1) G[(size_t)u * 512 + 256 - t] = b[i] * inv;
      }
      if (lane == 0) G[(size_t)u * 512] = 0.f;
    }
  }
}

DI void ph_ln(const float* __restrict__ src_lat, const float* __restrict__ src_ctx, float* dst_lat, float* dst_ctx,
              const float* __restrict__ ag, const float* __restrict__ ab, bf16_t* U, const float* __restrict__ mod, int sh_off, int nrows) {
  const int lane = my_tid() & 63, wid = my_tid() >> 6;
  const int stride = gridDim.x * 8;
  float4 nv[4];
  {
    const int row = blockIdx.x * 8 + wid;
    if (row < nrows) {
      const float* src = row < ML ? src_lat + (size_t)row * D : src_ctx + (size_t)(row - ML) * D;
#pragma unroll
      for (int i = 0; i < 4; ++i) nv[i] = *(const float4*)(src + i * 256 + lane * 4);
    }
  }
  for (int row = blockIdx.x * 8 + wid; row < nrows; row += stride) {
    float4 v[4];
#pragma unroll
    for (int i = 0; i < 4; ++i) v[i] = nv[i];
    if (row + stride < nrows) {
      const int r2 = row + stride;
      const float* src2 = r2 < ML ? src_lat + (size_t)r2 * D : src_ctx + (size_t)(r2 - ML) * D;
#pragma unroll
      for (int i = 0; i < 4; ++i) nv[i] = *(const float4*)(src2 + i * 256 + lane * 4);
    }
    float s = 0.f;
#pragma unroll
    for (int i = 0; i < 4; ++i) s += v[i].x + v[i].y + v[i].z + v[i].w;
    float mu = wave_sum(s) * (1.f / 1024.f);
    float q = 0.f;
#pragma unroll
    for (int i = 0; i < 4; ++i) { v[i].x -= mu; v[i].y -= mu; v[i].z -= mu; v[i].w -= mu; q += v[i].x * v[i].x + v[i].y * v[i].y + v[i].z * v[i].z + v[i].w * v[i].w; }
    float rs = rsqrtf(wave_sum(q) * (1.f / 1024.f) + 1e-6f);
#pragma unroll
    for (int i = 0; i < 4; ++i) { v[i].x *= rs; v[i].y *= rs; v[i].z *= rs; v[i].w *= rs; }
    if (ag) {
      float* dst = row < ML ? dst_lat + (size_t)row * D : dst_ctx + (size_t)(row - ML) * D;
#pragma unroll
      for (int i = 0; i < 4; ++i) {
        float4 gg = *(const float4*)(ag + i * 256 + lane * 4), bb = *(const float4*)(ab + i * 256 + lane * 4);
        v[i].x = v[i].x * gg.x + bb.x; v[i].y = v[i].y * gg.y + bb.y; v[i].z = v[i].z * gg.z + bb.z; v[i].w = v[i].w * gg.w + bb.w;
        *(float4*)(dst + i * 256 + lane * 4) = v[i];
      }
      if (U) {
        s = 0.f;
#pragma unroll
        for (int i = 0; i < 4; ++i) s += v[i].x + v[i].y + v[i].z + v[i].w;
        mu = wave_sum(s) * (1.f / 1024.f); q = 0.f;
#pragma unroll
        for (int i = 0; i < 4; ++i) { v[i].x -= mu; v[i].y -= mu; v[i].z -= mu; v[i].w -= mu; q += v[i].x * v[i].x + v[i].y * v[i].y + v[i].z * v[i].z + v[i].w * v[i].w; }
        rs = rsqrtf(wave_sum(q) * (1.f / 1024.f) + 1e-6f);
#pragma unroll
        for (int i = 0; i < 4; ++i) { v[i].x *= rs; v[i].y *= rs; v[i].z *= rs; v[i].w *= rs; }
      }
    }
    if (U) {
      const float* m = mod + (size_t)mod_idx(row) * 6144 + sh_off;
#pragma unroll
      for (int i = 0; i < 4; ++i) {
        float4 sh = *(const float4*)(m + i * 256 + lane * 4), sc = *(const float4*)(m + 1024 + i * 256 + lane * 4);
        uint2 o; o.x = pack2(v[i].x * (1.f + sc.x) + sh.x, v[i].y * (1.f + sc.y) + sh.y);
        o.y = pack2(v[i].z * (1.f + sc.z) + sh.z, v[i].w * (1.f + sc.w) + sh.w);
        *(uint2*)(U + (size_t)row * D + i * 256 + lane * 4) = o;
      }
    }
  }
}

DI void ph_inproj(const Params& p, const bf16_t* U, char* smem) {
  const bf16_t* Bt = (const bf16_t*)(p.ws + WB_IN);
  const int lane = my_tid() & 63, wid = my_tid() >> 6, wm = wid >> 2, wn = wid & 3, g = lane >> 4, r16 = lane & 15;
  for (int it = 0;; ++it) {
    int mtile, ntile;
    if (!next_tile(it, 136, 13, mtile, ntile)) break;
    f32x4 acc[8][4]; zero_acc256(acc);
    gemm_glds256(acc, U, 1024, (long)mtile * 256, Bt + (size_t)ntile * 256 * 1024, 1024, 1024, smem);
    int b, key0;
    if (mtile < 128) { b = mtile >> 4; key0 = (mtile & 15) * 256; } else { b = mtile - 128; key0 = SL; }
    const int wc0 = ntile * 256 + wn * 64;
    bf16_t* tbase = nullptr; int tcols = 0, tcol0 = 0;
    if (wc0 < 768) { tbase = (bf16_t*)(p.ws + R_PHY); tcols = 768; tcol0 = wc0; }
    else if (wc0 >= 1152 && wc0 < 1280) { tbase = (bf16_t*)(p.ws + R_VTSW); tcols = 128; tcol0 = wc0 - 1152; }
    else if (wc0 >= 1792 && wc0 < 2048) { tbase = (bf16_t*)(p.ws + R_VTDF); tcols = 256; tcol0 = wc0 - 1792; }
    if (tbase) {
#pragma unroll
      for (int mt = 0; mt < 8; ++mt)
#pragma unroll
        for (int nt = 0; nt < 4; ++nt) {
          int col = tcol0 + r16 * 4 + nt;
          int key = key0 + wm * 128 + mt * 16 + g * 4;
          uint2 o; o.x = pack2(acc[mt][nt][0], acc[mt][nt][1]); o.y = pack2(acc[mt][nt][2], acc[mt][nt][3]);
          *(uint2*)(tbase + ((size_t)b * tcols + col) * KEYS + key) = o;
        }
    } else if (wc0 < 3264) {
      bf16_t* rb; int ld, c0;
      if (wc0 < 1152) { rb = (bf16_t*)(p.ws + R_PSW); ld = 384; c0 = wc0 - 768; }
      else if (wc0 < 1792) { rb = (bf16_t*)(p.ws + R_PDF); ld = 512; c0 = wc0 - 1280; }
      else { rb = (bf16_t*)(p.ws + R_PRW); ld = 1216; c0 = wc0 - 2048; }
      const int col = c0 + r16 * 4;
#pragma unroll
      for (int mt = 0; mt < 8; ++mt)
#pragma unroll
        for (int j = 0; j < 4; ++j) {
          size_t row = (size_t)mtile * 256 + wm * 128 + mt * 16 + g * 4 + j;
          uint2 o; o.x = pack2(acc[mt][0][j], acc[mt][1][j]); o.y = pack2(acc[mt][2][j], acc[mt][3][j]);
          *(uint2*)(rb + row * ld + col) = o;
        }
    }
  }
}

DI float hy_conv3(const bf16_t* __restrict__ P, int t, int len, float w0, float w1, float w2, float bias) {
  float a = t >= 1 ? bf2f(P[t - 1]) : 0.f, b = bf2f(P[t]), c = (t + 1 < len) ? bf2f(P[t + 1]) : 0.f;
  return w0 * a + w1 * b + w2 * c + bias;
}
DI void hy_conv8(const bf16_t* __restrict__ P, int tb, int len, float w0, float w1, float w2, float bias, float (&out)[8]) {
  const uint4 u = *(const uint4*)(P + tb);
  float x[10];
  x[0] = tb >= 1 ? bf2f(P[tb - 1]) : 0.f;
  x[1] = bflo(u.x); x[2] = bfhi(u.x); x[3] = bflo(u.y); x[4] = bfhi(u.y); x[5] = bflo(u.z); x[6] = bfhi(u.z); x[7] = bflo(u.w); x[8] = bfhi(u.w);
  x[9] = (tb + 8 < len) ? bf2f(P[tb + 8]) : 0.f;
#pragma unroll
  for (int i = 0; i < 8; ++i) out[i] = w0 * x[i] + w1 * x[i + 1] + w2 * x[i + 2] + bias;
}
DI void ph_hyena(const Params& p, int l, char* smem) {
  float2* X = (float2*)smem; float2* W = X + 8192;
  const int tid = my_tid();
  const int tb = tid * 8;
  const bf16_t* PT = (const bf16_t*)(p.ws + R_PHY);
  const float2* kf = (const float2*)(p.ws + OFF_KF);
  const float* cw = p.in[7] + (size_t)l * 3 * 768; const float* cb = p.in[8] + (size_t)l * 768;
  const float* hb = p.in[15] + (size_t)l * 512;
  bf16_t* Y = (bf16_t*)(p.ws + R_YHY);
  bool tw = false;
  for (int u = blockIdx.x; u < 1024; u += gridDim.x) {
    if (!tw) { load_twiddles(p, W); tw = true; }
    const int bp = u >> 8, c = u & 255; const int b0 = bp * 2, b1 = b0 + 1;
    const bf16_t* P0 = PT + ((size_t)b0 * 768) * KEYS; const bf16_t* P1 = PT + ((size_t)b1 * 768) * KEYS;
    const float bias0 = hb[c], bias1 = hb[256 + c];
    float va[8], vb[8];
    hy_conv8(P0 + (size_t)c * KEYS, tb, SL, cw[c], cw[768 + c], cw[1536 + c], cb[c], va);
    hy_conv8(P1 + (size_t)c * KEYS, tb, SL, cw[c], cw[768 + c], cw[1536 + c], cb[c], vb);
    __syncthreads();
#pragma unroll
    for (int i = 0; i < 8; ++i) { X[tb + i] = make_float2(va[i], vb[i]); X[tb + i + 4096] = make_float2(0.f, 0.f); }
    fft_dif(X, W);
    {
      const float2* H = kf + (size_t)c * 8192;
#pragma unroll 4
      for (int i = 0; i < 16; ++i) { int q = tid + i * 512; X[q] = cmul(X[q], H[q]); }
    }
    fft_dit_inv(X, W);
    float za[8], zb[8];
    {
      float xa[8], xb[8];
      hy_conv8(P0 + (size_t)(256 + c) * KEYS, tb, SL, cw[256 + c], cw[768 + 256 + c], cw[1536 + 256 + c], cb[256 + c], xa);
      hy_conv8(P1 + (size_t)(256 + c) * KEYS, tb, SL, cw[256 + c], cw[768 + 256 + c], cw[1536 + 256 + c], cb[256 + c], xb);
#pragma unroll
      for (int i = 0; i < 8; ++i) {
        const float2 y = X[tb + i];
        za[i] = xa[i] * (y.x * (1.f / 8192.f) + bias0 * va[i]);
        zb[i] = xb[i] * (y.y * (1.f / 8192.f) + bias0 * vb[i]);
      }
    }
    __syncthreads();
#pragma unroll
    for (int i = 0; i < 8; ++i) { X[tb + i] = make_float2(za[i], zb[i]); X[tb + i + 4096] = make_float2(0.f, 0.f); }
    fft_dif(X, W);
    {
      const float2* H = kf + (size_t)(256 + c) * 8192;
#pragma unroll 4
      for (int i = 0; i < 16; ++i) { int q = tid + i * 512; X[q] = cmul(X[q], H[q]); }
    }
    fft_dit_inv(X, W);
    {
      float xa[8], xb[8];
      hy_conv8(P0 + (size_t)(512 + c) * KEYS, tb, SL, cw[512 + c], cw[768 + 512 + c], cw[1536 + 512 + c], cb[512 + c], xa);
      hy_conv8(P1 + (size_t)(512 + c) * KEYS, tb, SL, cw[512 + c], cw[768 + 512 + c], cw[1536 + 512 + c], cb[512 + c], xb);
#pragma unroll
      for (int i = 0; i < 8; ++i) {
        const float2 y = X[tb + i];
        const float oa = xa[i] * (y.x * (1.f / 8192.f) + bias1 * za[i]);
        const float ob = xb[i] * (y.y * (1.f / 8192.f) + bias1 * zb[i]);
        Y[((size_t)b0 * SL + tb + i) * 256 + c] = (bf16_t)f2bf(oa);
        Y[((size_t)b1 * SL + tb + i) * 256 + c] = (bf16_t)f2bf(ob);
      }
    }
  }
}

DI void ph_hyena_ctx(const Params& p, int l, char* smem) {
  const int tid = my_tid(), lane = tid & 63, wid = tid >> 6;
  float* Zb = (float*)smem + wid * 1024;
  float* Gb = Zb + 256;
  const bf16_t* PT = (const bf16_t*)(p.ws + R_PHY);
  const float* G = (const float*)(p.ws + MISC_GCTX);
  const float* cw = p.in[7] + (size_t)l * 3 * 768; const float* cb = p.in[8] + (size_t)l * 768;
  const float* hb = p.in[15] + (size_t)l * 512;
  bf16_t* Y = (bf16_t*)(p.ws + R_YHY);
  for (int base = blockIdx.x * 8; base < 2048; base += gridDim.x * 8) {
    const int u = base + wid; const int b = u >> 8, c = u & 255;
    const bf16_t* Pb = PT + ((size_t)b * 768) * KEYS + SL;
    float v[4], x1[4], x2[4], zz[4];
#pragma unroll
    for (int i = 0; i < 4; ++i) {
      int t = lane + i * 64;
      v[i] = hy_conv3(Pb + (size_t)c * KEYS, t, CL, cw[c], cw[768 + c], cw[1536 + c], cb[c]);
      x1[i] = hy_conv3(Pb + (size_t)(256 + c) * KEYS, t, CL, cw[256 + c], cw[768 + 256 + c], cw[1536 + 256 + c], cb[256 + c]);
      x2[i] = hy_conv3(Pb + (size_t)(512 + c) * KEYS, t, CL, cw[512 + c], cw[768 + 512 + c], cw[1536 + 512 + c], cb[512 + c]);
    }
    __syncthreads();
#pragma unroll
    for (int i = 0; i < 4; ++i) Zb[lane + i * 64] = v[i];
    for (int i = lane; i < 512; i += 64) Gb[i] = G[(size_t)c * 512 + i];
    __syncthreads();
#pragma unroll
    for (int i = 0; i < 4; ++i) {
      int t = lane + i * 64; float s = 0.f;
      for (int s2 = 0; s2 < 256; ++s2) s += Gb[256 + t - s2] * Zb[s2];
      zz[i] = x1[i] * (s + hb[c] * v[i]);
    }
    __syncthreads();
#pragma unroll
    for (int i = 0; i < 4; ++i) Zb[lane + i * 64] = zz[i];
    for (int i = lane; i < 512; i += 64) Gb[i] = G[(size_t)(256 + c) * 512 + i];
    __syncthreads();
#pragma unroll
    for (int i = 0; i < 4; ++i) {
      int t = lane + i * 64; float s = 0.f;
      for (int s2 = 0; s2 < 256; ++s2) s += Gb[256 + t - s2] * Zb[s2];
      float o = x2[i] * (s + hb[256 + c] * zz[i]);
      Y[((size_t)ML + b * CL + t) * 256 + c] = (bf16_t)f2bf(o);
    }
  }
}

DI void ph_rope(const Params& p, char* smem) {
  float2* T16 = (float2*)smem;
  float2* T8 = T16 + 64 * 16;
  const int tid = my_tid(), lane = tid & 63, wid = tid >> 6;
  __syncthreads();
  for (int i = tid; i < 64 * 16; i += NTHR) {
    int pos = i >> 4, f = i & 15; float inv = powf(10000.f, -(float)f / 16.f); float s, c; sincosf((float)pos * inv, &s, &c);
    T16[i] = make_float2(c, s);
  }
  for (int i = tid; i < 64 * 8; i += NTHR) {
    int pos = i >> 3, f = i & 7; float inv = powf(10000.f, -(float)f / 8.f); float s, c; sincosf((float)pos * inv, &s, &c);
    T8[i] = make_float2(c, s);
  }
  __syncthreads();
  bf16_t* Psw = (bf16_t*)(p.ws + R_PSW); bf16_t* Pdf = (bf16_t*)(p.ws + R_PDF);
  bf16_t* rowbase_ptr; int e1, e2, nf, f0; bool hsel; bool active = lane < 56;
  if (lane < 24) { const int hd = lane >> 2, half = (lane >> 1) & 1, cp = lane & 1; e1 = hd * 64 + half * 32 + cp * 8; e2 = e1 + 16; nf = 16; f0 = cp * 8; hsel = half; }
  else { const int j = lane - 24; const int gi = j >> 1, half = j & 1; e1 = gi * 32 + half * 16; e2 = e1 + 8; nf = 8; f0 = 0; hsel = half; }
  const float2* Tb = (lane < 24) ? T16 : T8;
  for (int row = blockIdx.x * 8 + wid; row < ML; row += gridDim.x * 8) {
    if (active) {
      const int t = row & (SL - 1); const int pos = hsel ? (t & 63) : (t >> 6);
      rowbase_ptr = (lane < 24) ? Psw + (size_t)row * 384 : Pdf + (size_t)row * 512;
      const uint4 u1 = *(const uint4*)(rowbase_ptr + e1), u2 = *(const uint4*)(rowbase_ptr + e2);
      const float4* cs = (const float4*)(Tb + pos * nf + f0);
      const float4 c0 = cs[0], c1 = cs[1], c2 = cs[2], c3 = cs[3];
      const unsigned w1[4] = {u1.x, u1.y, u1.z, u1.w}, w2[4] = {u2.x, u2.y, u2.z, u2.w};
      const float4 cc[4] = {c0, c1, c2, c3};
      unsigned o1[4], o2[4];
#pragma unroll
      for (int i = 0; i < 4; ++i) {
        const float xa = bflo(w1[i]), xb = bfhi(w1[i]), ya = bflo(w2[i]), yb = bfhi(w2[i]);
        o1[i] = pack2(xa * cc[i].x - ya * cc[i].y, xb * cc[i].z - yb * cc[i].w);
        o2[i] = pack2(xa * cc[i].y + ya * cc[i].x, xb * cc[i].w + yb * cc[i].z);
      }
      *(uint4*)(rowbase_ptr + e1) = make_uint4(o1[0], o1[1], o1[2], o1[3]);
      *(uint4*)(rowbase_ptr + e2) = make_uint4(o2[0], o2[1], o2[2], o2[3]);
    }
  }
}

DI float rw_shift(const bf16_t* __restrict__ P, int row, int t, int len, int col, float mu) {
  float c = bf2f(P[(size_t)row * 1216 + col]);
  float a = t >= 1 ? bf2f(P[(size_t)(row - 1) * 1216 + col]) : 0.f;
  float b = t + 1 < len ? bf2f(P[(size_t)(row + 1) * 1216 + col]) : 0.f;
  return c + (0.5f * (a + b) - c) * mu;
}
DI void ph_rwprep(const Params& p, int l, char* smem) {
  constexpr int AST = 912, RST = 1552, ROFF = 32 * AST;
  const int tid = my_tid(), lane = tid & 63, wid = tid >> 6, g = lane >> 4, r16 = lane & 15;
  const int tg = wid >> 2, hd = wid & 3;
  const bf16_t* P = (const bf16_t*)(p.ws + R_PRW);
  const float* mu = p.in[17] + (size_t)l * 1216;
  const float* w0 = p.in[18] + (size_t)l * 512; const float* a0 = p.in[20] + (size_t)l * 256;
  const float* kkw = p.in[23] + (size_t)l * 256; const float* kaw = p.in[24] + (size_t)l * 256;
  bf16_t* S = (bf16_t*)(p.ws + R_STR); bf16_t* Gs = (bf16_t*)(p.ws + R_G);
  const size_t SU = (size_t)MT * 256;
  float w0f[4], w0b[4], a0c[4], kkc[4], kac[4];
#pragma unroll
  for (int nt = 0; nt < 4; ++nt) { int c = hd * 64 + r16 * 4 + nt; w0f[nt] = w0[c]; w0b[nt] = w0[256 + c]; a0c[nt] = a0[c]; kkc[nt] = kkw[c]; kac[nt] = kaw[c]; }
  for (int u = blockIdx.x; u < MT / 32; u += gridDim.x) {
    const int row0 = u * 32; int t0, len;
    if (row0 < ML) { t0 = row0 & (SL - 1); len = SL; } else { t0 = (row0 - ML) & (CL - 1); len = CL; }
    __syncthreads();
    for (int item = tid; item < 32 * 152; item += NTHR) {
      const int tk = item / 152, c8 = item - tk * 152; const int row = row0 + tk, t = t0 + tk;
      const uint4 uc = *(const uint4*)(P + (size_t)row * 1216 + c8 * 8);
      uint4 ua = make_uint4(0, 0, 0, 0), ub = make_uint4(0, 0, 0, 0);
      if (t >= 1) ua = *(const uint4*)(P + (size_t)(row - 1) * 1216 + c8 * 8);
      if (t + 1 < len) ub = *(const uint4*)(P + (size_t)(row + 1) * 1216 + c8 * 8);
      const float4 m0 = *(const float4*)(mu + c8 * 8), m1 = *(const float4*)(mu + c8 * 8 + 4);
      float o[8];
      {
        const unsigned wc[4] = {uc.x, uc.y, uc.z, uc.w}, wa[4] = {ua.x, ua.y, ua.z, ua.w}, wb[4] = {ub.x, ub.y, ub.z, ub.w};
        const float mm[8] = {m0.x, m0.y, m0.z, m0.w, m1.x, m1.y, m1.z, m1.w};
#pragma unroll
        for (int i = 0; i < 4; ++i) {
          float c_lo = bflo(wc[i]), c_hi = bfhi(wc[i]);
          o[2 * i] = c_lo + (0.5f * (bflo(wa[i]) + bflo(wb[i])) - c_lo) * mm[2 * i];
          o[2 * i + 1] = c_hi + (0.5f * (bfhi(wa[i]) + bfhi(wb[i])) - c_hi) * mm[2 * i + 1];
        }
      }
      char* dst;
      if (c8 < 96) dst = smem + ROFF + tk * RST + c8 * 16;
      else {
        const int cc = c8 * 8 - 768;
        if (cc < 128) {
#pragma unroll
          for (int i = 0; i < 8; ++i) o[i] = 1.f - 2.f * __builtin_amdgcn_rcpf(1.f + __expf(2.f * o[i]));
        } else if (cc >= 192) {
#pragma unroll
          for (int i = 0; i < 8; ++i) o[i] = sigmoidf_(o[i]);
        }
        dst = smem + tk * AST + cc * 2;
      }
      uint4 ov; ov.x = pack2(o[0], o[1]); ov.y = pack2(o[2], o[3]); ov.z = pack2(o[4], o[5]); ov.w = pack2(o[6], o[7]);
      *(uint4*)dst = ov;
    }
    __syncthreads();
    f32x4 acc[5][4];
#pragma unroll
    for (int o5 = 0; o5 < 5; ++o5)
#pragma unroll
      for (int nt = 0; nt < 4; ++nt) acc[o5][nt] = (f32x4){0.f, 0.f, 0.f, 0.f};
    const char* Arow = smem + (tg * 16 + r16) * AST + g * 16;
#pragma unroll
    for (int o5 = 0; o5 < 5; ++o5) {
      const int kbase = o5 < 3 ? o5 * 64 : (o5 == 3 ? 192 : 320);
      const int KK = o5 < 3 ? 64 : 128;
      const bf16_t* Wt = (const bf16_t*)(p.ws + (o5 == 0 ? RWW_F : o5 == 1 ? RWW_B : o5 == 2 ? RWW_A : o5 == 3 ? RWW_GF : RWW_GB));
#pragma unroll
      for (int ks = 0; ks < KK / 32; ++ks) {
        const bf16x8 af = *(const bf16x8*)(Arow + (kbase + ks * 32) * 2);
#pragma unroll
        for (int nt = 0; nt < 4; ++nt) {
          const bf16x8 bf = *(const bf16x8*)(Wt + (size_t)(hd * 64 + nt * 16 + r16) * KK + ks * 32 + g * 8);
          acc[o5][nt] = __builtin_amdgcn_mfma_f32_16x16x32_bf16(af, bf, acc[o5][nt], 0, 0, 0);
        }
        if ((ks & 3) == 3) asm volatile("" ::: "memory");
      }
    }
#pragma unroll
    for (int j = 0; j < 4; ++j) {
      const int tk = tg * 16 + g * 4 + j; const size_t row = (size_t)row0 + tk;
      const char* rk = smem + ROFF + tk * RST;
      const int c0 = hd * 64 + r16 * 4;
      const uint2 ur = *(const uint2*)(rk + c0 * 2), uk = *(const uint2*)(rk + (256 + c0) * 2), uv = *(const uint2*)(rk + (512 + c0) * 2);
      const float rv[4] = {bflo(ur.x), bfhi(ur.x), bflo(ur.y), bfhi(ur.y)};
      const float kv[4] = {bflo(uk.x), bfhi(uk.x), bflo(uk.y), bfhi(uk.y)};
      const float vv[4] = {bflo(uv.x), bfhi(uv.x), bflo(uv.y), bfhi(uv.y)};
      float n2 = 0.f;
#pragma unroll
      for (int nt = 0; nt < 4; ++nt) { float q = kv[nt] * kkc[nt]; n2 += q * q; }
      n2 = sum16(n2);
      const float inv = __builtin_amdgcn_rsqf(fmaxf(n2, 1e-24f));
      float o_kp[4], o_kk[4], o_b[4], o_df[4], o_db[4];
#pragma unroll
      for (int nt = 0; nt < 4; ++nt) {
        const float k = kv[nt];
        const float a = sigmoidf_(a0c[nt] + acc[2][nt][j]);
        const float kk = k * kkc[nt] * inv;
        o_kp[nt] = k * (1.f + (a - 1.f) * kac[nt]);
        o_kk[nt] = kk; o_b[nt] = kk * a;
        const float xf = -(w0f[nt] + acc[0][nt][j]); const float spf = fmaxf(xf, 0.f) + __logf(1.f + __expf(-fabsf(xf)));
        const float xb = -(w0b[nt] + acc[1][nt][j]); const float spb = fmaxf(xb, 0.f) + __logf(1.f + __expf(-fabsf(xb)));
        const float ef = __expf(-spf - 0.5f), eb = __expf(-spb - 0.5f);
        o_df[nt] = 1.f - __expf(-ef); o_db[nt] = 1.f - __expf(-eb);
      }
      const size_t o = row * 256 + c0;
      uint2 w;
      w.x = pack2(rv[0], rv[1]); w.y = pack2(rv[2], rv[3]); *(uint2*)(S + o) = w;
      w.x = pack2(o_kp[0], o_kp[1]); w.y = pack2(o_kp[2], o_kp[3]); *(uint2*)(S + SU + o) = w;
      w.x = pack2(vv[0], vv[1]); w.y = pack2(vv[2], vv[3]); *(uint2*)(S + 2 * SU + o) = w;
      w.x = pack2(o_kk[0], o_kk[1]); w.y = pack2(o_kk[2], o_kk[3]); *(uint2*)(S + 3 * SU + o) = w;
      w.x = pack2(o_b[0], o_b[1]); w.y = pack2(o_b[2], o_b[3]); *(uint2*)(S + 4 * SU + o) = w;
      w.x = pack2(o_df[0], o_df[1]); w.y = pack2(o_df[2], o_df[3]); *(uint2*)(S + 5 * SU + o) = w;
      w.x = pack2(o_db[0], o_db[1]); w.y = pack2(o_db[2], o_db[3]); *(uint2*)(S + 6 * SU + o) = w;
      w.x = pack2(acc[3][0][j], acc[3][1][j]); w.y = pack2(acc[3][2][j], acc[3][3][j]); *(uint2*)(Gs + o) = w;
      w.x = pack2(acc[4][0][j], acc[4][1][j]); w.y = pack2(acc[4][2][j], acc[4][3][j]); *(uint2*)(Gs + SU + o) = w;
    }
  }
}

DI long scan_row(int b, int dir, int s) {
  if (s < CL) return (long)ML + b * CL + (dir ? (CL - 1 - s) : s);
  int t = s - CL; return (long)b * SL + (dir ? (SL - 1 - t) : t);
}
DI float sum8(float v) {
  v += dpp_mov<0xB1>(v);
  v += dpp_mov<0x4E>(v);
  v += dpp_mov<0x141>(v);
  return v;
}
DI void ph_scan(const Params& p, char* smem) {
  const int tid = my_tid(), lane = tid & 63, wid = tid >> 6;
  const bf16_t* S = (const bf16_t*)(p.ws + R_STR);
  const size_t SU = (size_t)MT * 256;
  constexpr int T = 32, NSTEP = CL + SL, NCH = NSTEP / T;
  typedef float f32x2 __attribute__((ext_vector_type(2)));
  for (int u = blockIdx.x; u < 128; u += gridDim.x) {
    const int chain = u >> 1, rg = u & 1; const int dir = chain & 1, bh = chain >> 1, b = bh >> 2, h = bh & 3;
    bf16_t* O = (bf16_t*)(p.ws + (dir ? R_OB : R_OF));
    uint4 q0, q1, q2;
    auto SC_GLOAD = [&](int ci) {
#pragma unroll
      for (int j = 0; j < 3; ++j) {
        int idx = tid + j * 512; int st = idx >> 8, s = (idx & 255) >> 3, ck = idx & 7;
        long row = scan_row(b, dir, ci * T + s);
        int sid = st < 5 ? st : 5 + dir;
        uint4 v = *(const uint4*)(S + sid * SU + row * 256 + h * 64 + ck * 8);
        if (j == 0) q0 = v; else if (j == 1) q1 = v; else q2 = v;
      }
    };
    auto SC_SSTORE = [&](int buf) {
#pragma unroll
      for (int j = 0; j < 3; ++j) {
        int idx = tid + j * 512; int st = idx >> 8;
        uint4 v = j == 0 ? q0 : (j == 1 ? q1 : q2);
        float4 lo = make_float4(bflo(v.x), bfhi(v.x), bflo(v.y), bfhi(v.y));
        float4 hi = make_float4(bflo(v.z), bfhi(v.z), bflo(v.w), bfhi(v.w));
        if (st == 5) { lo.x = 1.f - lo.x; lo.y = 1.f - lo.y; lo.z = 1.f - lo.z; lo.w = 1.f - lo.w; hi.x = 1.f - hi.x; hi.y = 1.f - hi.y; hi.z = 1.f - hi.z; hi.w = 1.f - hi.w; }
        char* base = smem + buf * 49152 + idx * 32;
        *(float4*)(base) = lo; *(float4*)(base + 16) = hi;
      }
    };
    auto FLUSH = [&](int ci) {
      const int s = tid >> 4, part = tid & 15;
      const float2 v = *(const float2*)(smem + 98304 + (ci & 1) * 4096 + s * 128 + part * 8);
      long row = scan_row(b, dir, ci * T + s);
      *(unsigned*)(O + row * 256 + h * 64 + rg * 32 + part * 2) = pack2(v.x, v.y);
    };
    __syncthreads();
    SC_GLOAD(0);
    SC_SSTORE(0);
    __syncthreads();
    f32x2 st0 = {0.f, 0.f}, st1 = {0.f, 0.f}, st2 = {0.f, 0.f}, st3 = {0.f, 0.f};
    const int rsub = lane >> 3, ks = lane & 7;
    const int lrow = (wid & 3) * 8 + rsub;
    const int vrow = rg * 32 + lrow;
    struct Step { f32x2 r[4], k[4], kk[4], b[4], w[4]; float v; };
    auto LOADSTEP = [&](Step& x, const char* B, int s) {
#pragma unroll
      for (int hh = 0; hh < 2; ++hh) {
        const float4 r = *(const float4*)(B + (0 * T + s) * 256 + ks * 32 + hh * 16);
        const float4 k = *(const float4*)(B + (1 * T + s) * 256 + ks * 32 + hh * 16);
        const float4 kk = *(const float4*)(B + (3 * T + s) * 256 + ks * 32 + hh * 16);
        const float4 bb = *(const float4*)(B + (4 * T + s) * 256 + ks * 32 + hh * 16);
        const float4 w = *(const float4*)(B + (5 * T + s) * 256 + ks * 32 + hh * 16);
        x.r[2 * hh] = (f32x2){r.x, r.y}; x.r[2 * hh + 1] = (f32x2){r.z, r.w};
        x.k[2 * hh] = (f32x2){k.x, k.y}; x.k[2 * hh + 1] = (f32x2){k.z, k.w};
        x.kk[2 * hh] = (f32x2){kk.x, kk.y}; x.kk[2 * hh + 1] = (f32x2){kk.z, kk.w};
        x.b[2 * hh] = (f32x2){bb.x, bb.y}; x.b[2 * hh + 1] = (f32x2){bb.z, bb.w};
        x.w[2 * hh] = (f32x2){w.x, w.y}; x.w[2 * hh + 1] = (f32x2){w.z, w.w};
      }
      x.v = *(const float*)(B + (2 * T + s) * 256 + vrow * 4);
    };
    for (int ci = 0; ci < NCH; ++ci) {
      if (ci + 1 < NCH) { SC_GLOAD(ci + 1); }
      if (ci > 0) FLUSH(ci - 1);
      if (wid < 4) {
        const char* B = smem + (ci & 1) * 49152;
        float* ob = (float*)(smem + 98304 + (ci & 1) * 4096);
        Step nx; LOADSTEP(nx, B, 0);
#pragma unroll 2
        for (int s = 0; s < T; ++s) {
          const Step c = nx;
          LOADSTEP(nx, B, s + 1);
          f32x2 pa = st0 * c.kk[0] + st1 * c.kk[1];
          f32x2 pb = st2 * c.kk[2] + st3 * c.kk[3];
          pa = pa + pb;
          float sa = -(pa.x + pa.y);
          sa = sum8(sa);
          const f32x2 sa2 = {sa, sa}; const f32x2 v2 = {c.v, c.v};
          st0 = st0 * c.w[0] + sa2 * c.b[0] + v2 * c.k[0];
          st1 = st1 * c.w[1] + sa2 * c.b[1] + v2 * c.k[1];
          st2 = st2 * c.w[2] + sa2 * c.b[2] + v2 * c.k[2];
          st3 = st3 * c.w[3] + sa2 * c.b[3] + v2 * c.k[3];
          f32x2 oa = st0 * c.r[0] + st1 * c.r[1];
          f32x2 ob2 = st2 * c.r[2] + st3 * c.r[3];
          oa = oa + ob2;
          float o = sum8(oa.x + oa.y);
          ob[s * 32 + lrow] = o;
        }
      }
      if (ci + 1 < NCH) { SC_SSTORE((ci + 1) & 1); }
      __syncthreads();
    }
    FLUSH(NCH - 1);
  }
}

template <bool DIFF>
DI void attn_unit(const Params& p, int l, int b, int h, int qrow0, int qpos0, int kb_lo, int kb_hi, int kc_lo, char* smem) {
  const int tid = my_tid(), lane = tid & 63, wid = tid >> 6, g = lane >> 4, r16 = lane & 15;
  const bf16_t* QK = (const bf16_t*)(p.ws + (DIFF ? R_PDF : R_PSW));
  const int ldq = DIFF ? 512 : 384;
  const int qc0 = h * 64;
  const int kc0 = 256 + (DIFF ? h * 64 : (h >> 1) * 64);
  const bf16_t* VT = DIFF ? (const bf16_t*)(p.ws + R_VTDF) + ((size_t)b * 256 + h * 64) * KEYS
                          : (const bf16_t*)(p.ws + R_VTSW) + ((size_t)b * 128 + (h >> 1) * 64) * KEYS;
  const int nblk = (kb_hi - kb_lo) + (68 - kc_lo);
  const float sc = (DIFF ? 0.17677669529663687f : 0.125f) * 1.4426950408889634f;
  bf16x8 qf[2];
  {
    const bf16_t* qp = QK + (size_t)(qrow0 + wid * 16 + r16) * ldq + qc0 + g * 8;
    qf[0] = *(const bf16x8*)(qp); qf[1] = *(const bf16x8*)(qp + 32);
  }
  constexpr int NC = DIFF ? 2 : 1;
  float m[NC], lsum[NC];
  f32x4 O[NC][4];
#pragma unroll
  for (int c = 0; c < NC; ++c) {
    if (DIFF) { m[c] = -1e30f; lsum[c] = 0.f; }
    else { m[c] = p.in[16][l * 4 + h] * 1.4426950408889634f; lsum[c] = (g == 0) ? 1.f : 0.f; }
#pragma unroll
    for (int dt = 0; dt < 4; ++dt) O[c][dt] = (f32x4){0.f, 0.f, 0.f, 0.f};
  }
  const int lr = tid >> 3, lc = tid & 7;
  uint4 rkA, rvA, rkB, rvB;
  rkA = make_uint4(0, 0, 0, 0); rvA = rkA; rkB = rkA; rvB = rkA;
  auto AT_GLOAD = [&](int i, uint4& rk, uint4& rv) {
    int kb = i < (kb_hi - kb_lo) ? kb_lo + i : kc_lo + (i - (kb_hi - kb_lo));
    long krow = kb < 64 ? (long)b * SL + kb * 64 + lr : (long)ML + b * CL + (kb - 64) * 64 + lr;
    rk = *(const uint4*)(QK + krow * ldq + kc0 + lc * 8);
    rv = *(const uint4*)(VT + (size_t)lr * KEYS + kb * 64 + lc * 8);
  };
  auto AT_SSTORE = [&](int buf, const uint4& rk, const uint4& rv) {
    *(uint4*)(smem + buf * 18432 + lr * 128 + ((lc ^ (lr & 7)) << 4)) = rk;
    *(uint4*)(smem + buf * 18432 + 9216 + lr * 144 + lc * 16) = rv;
  };
  __syncthreads();
  AT_GLOAD(0, rkA, rvA);
  AT_SSTORE(0, rkA, rvA);
  if (1 < nblk) AT_GLOAD(1, rkA, rvA);
  if (2 < nblk) AT_GLOAD(2, rkB, rvB);
  lds_barrier();
  const int qpos = qpos0 + wid * 16 + r16;
  for (int i = 0; i < nblk; ++i) {
    const int kb = i < (kb_hi - kb_lo) ? kb_lo + i : kc_lo + (i - (kb_hi - kb_lo));
    const bool masked = (!DIFF) && (kb < 64);
    const char* Kt = smem + (i & 1) * 18432; const char* Vt = Kt + 9216;
    f32x4 S[NC][4];
#pragma unroll
    for (int kt = 0; kt < 4; ++kt) {
      bf16x8 k0 = *(const bf16x8*)(Kt + (kt * 16 + r16) * 128 + ((g ^ (r16 & 7)) << 4));
      bf16x8 k1 = *(const bf16x8*)(Kt + (kt * 16 + r16) * 128 + (((4 + g) ^ (r16 & 7)) << 4));
      if (DIFF) {
        S[0][kt] = __builtin_amdgcn_mfma_f32_16x16x32_bf16(k0, qf[0], (f32x4){0.f, 0.f, 0.f, 0.f}, 0, 0, 0);
        S[NC - 1][kt] = __builtin_amdgcn_mfma_f32_16x16x32_bf16(k1, qf[1], (f32x4){0.f, 0.f, 0.f, 0.f}, 0, 0, 0);
      } else {
        f32x4 t = __builtin_amdgcn_mfma_f32_16x16x32_bf16(k0, qf[0], (f32x4){0.f, 0.f, 0.f, 0.f}, 0, 0, 0);
        S[0][kt] = __builtin_amdgcn_mfma_f32_16x16x32_bf16(k1, qf[1], t, 0, 0, 0);
      }
    }
    bf16x8 pf[NC][2];
#pragma unroll
    for (int c = 0; c < NC; ++c) {
      float mx = -1e30f;
#pragma unroll
      for (int kt = 0; kt < 4; ++kt)
#pragma unroll
        for (int j = 0; j < 4; ++j) {
          float v = S[c][kt][j];
          if (masked) { int kpos = kb * 64 + kt * 16 + g * 4 + j; int dd = kpos - qpos; if (dd > 128 || dd < -128) v = -3e38f; S[c][kt][j] = v; }
          mx = fmaxf(mx, v);
        }
      mx *= sc;
      mx = fmaxf(mx, __shfl_xor(mx, 16)); mx = fmaxf(mx, __shfl_xor(mx, 32));
      const float mn = fmaxf(m[c], mx);
      const bool grow = mn > m[c];
      float ps = 0.f;
      unsigned pk[8];
#pragma unroll
      for (int kt = 0; kt < 4; ++kt) {
        float e0 = __builtin_amdgcn_exp2f(fmaf(S[c][kt][0], sc, -mn)), e1 = __builtin_amdgcn_exp2f(fmaf(S[c][kt][1], sc, -mn));
        float e2 = __builtin_amdgcn_exp2f(fmaf(S[c][kt][2], sc, -mn)), e3 = __builtin_amdgcn_exp2f(fmaf(S[c][kt][3], sc, -mn));
        ps += (e0 + e1) + (e2 + e3);
        pk[kt * 2] = pack2(e0, e1); pk[kt * 2 + 1] = pack2(e2, e3);
      }
      if (__builtin_amdgcn_ballot_w64(grow) != 0ull) {
        const float alpha = __builtin_amdgcn_exp2f(m[c] - mn);
        m[c] = mn;
        lsum[c] *= alpha;
#pragma unroll
        for (int dt = 0; dt < 4; ++dt) { O[c][dt][0] *= alpha; O[c][dt][1] *= alpha; O[c][dt][2] *= alpha; O[c][dt][3] *= alpha; }
      }
      lsum[c] += ps;
      union { unsigned u[4]; bf16x8 v; } cv;
      cv.u[0] = pk[0]; cv.u[1] = pk[1]; cv.u[2] = pk[2]; cv.u[3] = pk[3]; pf[c][0] = cv.v;
      cv.u[0] = pk[4]; cv.u[1] = pk[5]; cv.u[2] = pk[6]; cv.u[3] = pk[7]; pf[c][1] = cv.v;
    }
#pragma unroll
    for (int dt = 0; dt < 4; ++dt)
#pragma unroll
      for (int s2 = 0; s2 < 2; ++s2) {
        union { uint2 u[2]; bf16x8 v; } vf;
        vf.u[0] = *(const uint2*)(Vt + (dt * 16 + r16) * 144 + (2 * s2) * 32 + g * 8);
        vf.u[1] = *(const uint2*)(Vt + (dt * 16 + r16) * 144 + (2 * s2 + 1) * 32 + g * 8);
#pragma unroll
        for (int c = 0; c < NC; ++c) O[c][dt] = __builtin_amdgcn_mfma_f32_16x16x32_bf16(vf.v, pf[c][s2], O[c][dt], 0, 0, 0);
      }
    if (i + 1 < nblk) AT_SSTORE((i + 1) & 1, rkA, rvA);
    rkA = rkB; rvA = rvB;
    if (i + 3 < nblk) AT_GLOAD(i + 3, rkB, rvB);
    lds_barrier();
  }
  float linv[NC];
#pragma unroll
  for (int c = 0; c < NC; ++c) { float t = lsum[c]; t += __shfl_xor(t, 16); t += __shfl_xor(t, 32); linv[c] = 1.f / t; }
  const size_t orow = (size_t)(qrow0 + wid * 16 + r16);
  if (!DIFF) {
    bf16_t* Y = (bf16_t*)(p.ws + R_YSW);
#pragma unroll
    for (int dt = 0; dt < 4; ++dt) {
      uint2 o; o.x = pack2(O[0][dt][0] * linv[0], O[0][dt][1] * linv[0]); o.y = pack2(O[0][dt][2] * linv[0], O[0][dt][3] * linv[0]);
      *(uint2*)(Y + orow * 256 + h * 64 + dt * 16 + g * 4) = o;
    }
  } else {
    const float lam_init = 0.8f - 0.6f * __expf(-0.3f * (float)l);
    float d1 = 0.f, d2 = 0.f;
    if (lane < 32) { d1 = p.in[28][l * 32 + lane] * p.in[29][l * 32 + lane]; d2 = p.in[30][l * 32 + lane] * p.in[31][l * 32 + lane]; }
    d1 = wave_sum(d1); d2 = wave_sum(d2);
    const float lam = expf(d1) - expf(d2) + lam_init;
    float ov[4][4]; float ss = 0.f;
#pragma unroll
    for (int dt = 0; dt < 4; ++dt)
#pragma unroll
      for (int j = 0; j < 4; ++j) { float v = O[0][dt][j] * linv[0] - lam * O[NC - 1][dt][j] * linv[NC - 1]; ov[dt][j] = v; ss += v * v; }
    ss += __shfl_xor(ss, 16); ss += __shfl_xor(ss, 32);
    const float rms = rsqrtf(ss * (1.f / 64.f) + 1e-5f) * (1.f - lam_init);
    const float* sg = p.in[32] + l * 64;
    bf16_t* Y = (bf16_t*)(p.ws + R_YDF);
#pragma unroll
    for (int dt = 0; dt < 4; ++dt) {
      const int d0 = dt * 16 + g * 4;
      uint2 o; o.x = pack2(ov[dt][0] * rms * sg[d0], ov[dt][1] * rms * sg[d0 + 1]); o.y = pack2(ov[dt][2] * rms * sg[d0 + 2], ov[dt][3] * rms * sg[d0 + 3]);
      *(uint2*)(Y + orow * 256 + h * 64 + d0) = o;
    }
  }
}

DI void ph_attn(const Params& p, int l, char* smem) {
  const bool need_ctx = (l == 0);
  const int n_sw = 1024 + (need_ctx ? 64 : 0);
  const int n_df = 1024 + (need_ctx ? 64 : 0);
  unsigned* ctr = (unsigned*)(p.ws + MISC_BAR + 64 + 64 * l);
  volatile int* slot = (volatile int*)(smem + 40960);
  for (;;) {
    __syncthreads();
    if (my_tid() == 0) *slot = (int)__hip_atomic_fetch_add(ctr, 1u, __ATOMIC_RELAXED, __HIP_MEMORY_SCOPE_AGENT);
    __syncthreads();
    const int u = *slot;
    if (u >= n_sw + n_df) break;
    if (u < n_df) {
      if (u < 1024) { int b = u >> 7, h = (u >> 5) & 3, n = u & 31; attn_unit<true>(p, l, b, h, b * SL + n * 128, n * 128, 0, 64, 64, smem); }
      else { int v = u - 1024; int b = v >> 3, h = (v >> 1) & 3, n = v & 1; attn_unit<true>(p, l, b, h, ML + b * CL + n * 128, 0, 0, 0, 64, smem); }
    } else {
      int w = u - n_df;
      if (w < 1024) {
        int b = w >> 7, h = (w >> 5) & 3, n = w & 31;
        int lo = (n - 1) * 2; if (lo < 0) lo = 0; int hi = (n + 2) * 2; if (hi > 64) hi = 64;
        attn_unit<false>(p, l, b, h, b * SL + n * 128, n * 128, lo, hi, 64, smem);
      } else { int v = w - 1024; int b = v >> 3, h = (v >> 1) & 3, n = v & 1; attn_unit<false>(p, l, b, h, ML + b * CL + n * 128, 0, 0, 0, 64, smem); }
    }
  }
}

DI void ph_rwout(const Params& p, int l) {
  const int lane = my_tid() & 63, wid = my_tid() >> 6;
  const bf16_t* S = (const bf16_t*)(p.ws + R_STR); const bf16_t* Gs = (const bf16_t*)(p.ws + R_G);
  const bf16_t* OF = (const bf16_t*)(p.ws + R_OF); const bf16_t* OB = (const bf16_t*)(p.ws + R_OB);
  bf16_t* Y = (bf16_t*)(p.ws + R_YRW);
  const size_t SU = (size_t)MT * 256;
  const float4 rk = *(const float4*)(p.in[25] + (size_t)l * 256 + lane * 4);
  const float4 gam = *(const float4*)(p.in[26] + (size_t)l * 256 + lane * 4);
  const float4 bet = *(const float4*)(p.in[27] + (size_t)l * 256 + lane * 4);
  const int nrows = (l == 0) ? MT : ML;
  for (int row = blockIdx.x * 8 + wid; row < nrows; row += gridDim.x * 8) {
    const size_t o = (size_t)row * 256 + lane * 4;
    uint2 ur = *(const uint2*)(S + o), uk = *(const uint2*)(S + SU + o), uv = *(const uint2*)(S + 2 * SU + o);
    uint2 uf = *(const uint2*)(OF + o), ub = *(const uint2*)(OB + o), ugf = *(const uint2*)(Gs + o), ugb = *(const uint2*)(Gs + SU + o);
    float r[4] = {bflo(ur.x), bfhi(ur.x), bflo(ur.y), bfhi(ur.y)};
    float k[4] = {bflo(uk.x), bfhi(uk.x), bflo(uk.y), bfhi(uk.y)};
    float v[4] = {bflo(uv.x), bfhi(uv.x), bflo(uv.y), bfhi(uv.y)};
    float f[4] = {bflo(uf.x), bfhi(uf.x), bflo(uf.y), bfhi(uf.y)};
    float bb[4] = {bflo(ub.x), bfhi(ub.x), bflo(ub.y), bfhi(ub.y)};
    float gf[4] = {bflo(ugf.x), bfhi(ugf.x), bflo(ugf.y), bfhi(ugf.y)};
    float gb[4] = {bflo(ugb.x), bfhi(ugb.x), bflo(ugb.y), bfhi(ugb.y)};
    const float rkv[4] = {rk.x, rk.y, rk.z, rk.w}; const float ga[4] = {gam.x, gam.y, gam.z, gam.w}; const float be[4] = {bet.x, bet.y, bet.z, bet.w};
    float bon = 0.f, sf = 0.f, sb = 0.f;
#pragma unroll
    for (int i = 0; i < 4; ++i) { bon += r[i] * k[i] * rkv[i]; sf += f[i]; sb += bb[i]; }
    bon = sum16(bon); float muf = sum16(sf) * (1.f / 64.f), mub = sum16(sb) * (1.f / 64.f);
    float qf = 0.f, qb = 0.f;
#pragma unroll
    for (int i = 0; i < 4; ++i) { f[i] -= muf; bb[i] -= mub; qf += f[i] * f[i]; qb += bb[i] * bb[i]; }
    float rsf = rsqrtf(sum16(qf) * (1.f / 64.f) + 64e-5f), rsb = rsqrtf(sum16(qb) * (1.f / 64.f) + 64e-5f);
    float y[4];
#pragma unroll
    for (int i = 0; i < 4; ++i) {
      float bn = bon * v[i];
      y[i] = (f[i] * rsf * ga[i] + be[i] + bn) * gf[i] + (bb[i] * rsb * ga[i] + be[i] + bn) * gb[i];
    }
    uint2 oo; oo.x = pack2(y[0], y[1]); oo.y = pack2(y[2], y[3]);
    *(uint2*)(Y + o) = oo;
  }
}

DI void ph_merge(const Params& p, int l, const bf16_t* U, char* smem) {
  const int lane = my_tid() & 63, wid = my_tid() >> 6, wm = wid >> 1, wn = wid & 1, g = lane >> 4, r16 = lane & 15;
  const int mtiles = (l == 0) ? 136 : 128;
  bf16_t* ACC = (bf16_t*)(p.ws + R_ACC);
  for (int it = 0;; ++it) {
    int mtile, ntile;
    if (!next_tile(it, mtiles, 8, mtile, ntile)) break;
    uint2 accS[4][4];
#pragma unroll
    for (int mt = 0; mt < 4; ++mt)
#pragma unroll
      for (int nt = 0; nt < 4; ++nt) accS[mt][nt] = make_uint2(0u, 0u);
    for (int j = 0; j < 4; ++j) {
      uint2 pb[4][4];
      {
        f32x4 accB[4][4]; zero_acc<4>(accB);
        const size_t yoff = (j == 0) ? R_YHY : (j == 1) ? R_YSW : (j == 2) ? R_YRW : R_YDF;
        gemm_glds(accB, (const bf16_t*)(p.ws + yoff), 256, RowPlain{(long)mtile * 256}, (const bf16_t*)(p.ws + WB_BR) + ((size_t)j * 1024 + ntile * 128) * 256, 256, 256, smem, (const bf16_t*)(p.ws + MISC_ZERO));
#pragma unroll
        for (int mt = 0; mt < 4; ++mt)
#pragma unroll
          for (int nt = 0; nt < 4; ++nt) { pb[mt][nt].x = pack2(accB[mt][nt][0], accB[mt][nt][1]); pb[mt][nt].y = pack2(accB[mt][nt][2], accB[mt][nt][3]); }
      }
      f32x4 accG[4][4]; zero_acc<4>(accG);
      gemm_glds(accG, U, 1024, RowPlain{(long)mtile * 256}, (const bf16_t*)(p.ws + WB_GATE) + ((size_t)j * 1024 + ntile * 128) * 1024, 1024, 1024, smem, (const bf16_t*)(p.ws + MISC_ZERO));
#pragma unroll
      for (int mt = 0; mt < 4; ++mt)
#pragma unroll
        for (int nt = 0; nt < 4; ++nt) {
          float v0 = bflo(accS[mt][nt].x) + sigmoidf_(accG[mt][nt][0]) * bflo(pb[mt][nt].x);
          float v1 = bfhi(accS[mt][nt].x) + sigmoidf_(accG[mt][nt][1]) * bfhi(pb[mt][nt].x);
          float v2 = bflo(accS[mt][nt].y) + sigmoidf_(accG[mt][nt][2]) * bflo(pb[mt][nt].y);
          float v3 = bfhi(accS[mt][nt].y) + sigmoidf_(accG[mt][nt][3]) * bfhi(pb[mt][nt].y);
          accS[mt][nt].x = pack2(v0, v1); accS[mt][nt].y = pack2(v2, v3);
        }
    }
#pragma unroll
    for (int mt = 0; mt < 4; ++mt) {
      const int col = ntile * 128 + wn * 64 + r16 * 4;
      const size_t row = (size_t)mtile * 256 + wm * 64 + mt * 16 + g * 4;
      uint2 o;
      o.x = (accS[mt][0].x & 0xffffu) | (accS[mt][1].x << 16); o.y = (accS[mt][2].x & 0xffffu) | (accS[mt][3].x << 16);
      *(uint2*)(ACC + (row + 0) * 1024 + col) = o;
      o.x = (accS[mt][0].x >> 16) | (accS[mt][1].x & 0xffff0000u); o.y = (accS[mt][2].x >> 16) | (accS[mt][3].x & 0xffff0000u);
      *(uint2*)(ACC + (row + 1) * 1024 + col) = o;
      o.x = (accS[mt][0].y & 0xffffu) | (accS[mt][1].y << 16); o.y = (accS[mt][2].y & 0xffffu) | (accS[mt][3].y << 16);
      *(uint2*)(ACC + (row + 2) * 1024 + col) = o;
      o.x = (accS[mt][0].y >> 16) | (accS[mt][1].y & 0xffff0000u); o.y = (accS[mt][2].y >> 16) | (accS[mt][3].y & 0xffff0000u);
      *(uint2*)(ACC + (row + 3) * 1024 + col) = o;
    }
  }
}

DI void ph_resgemm(const Params& p, int l, const bf16_t* A, int K, const bf16_t* Bt, const float* hsrc_lat, const float* hsrc_ctx, int gate_off, char* smem) {
  const int lane = my_tid() & 63, wid = my_tid() >> 6, wm = wid >> 1, wn = wid & 1, g = lane >> 4, r16 = lane & 15;
  const int mtiles = (l == 0) ? 136 : 128;
  const float* mod = (const float*)(p.ws + MISC_MOD) + (size_t)l * 9 * 6144;
  float* hc = (float*)(p.ws + OFF_HC);
  for (int it = 0;; ++it) {
    int mtile, ntile;
    if (!next_tile(it, mtiles, 8, mtile, ntile)) break;
    f32x4 acc[4][4]; zero_acc<4>(acc);
    gemm_glds(acc, A, K, RowPlain{(long)mtile * 256}, Bt + (size_t)ntile * 128 * K, K, K, smem, (const bf16_t*)(p.ws + MISC_ZERO));
    const int b = mtile < 128 ? (mtile >> 4) : 8;
    const float* gt = mod + (size_t)b * 6144 + gate_off;
    const int col = ntile * 128 + wn * 64 + r16 * 4;
    const float4 gv = *(const float4*)(gt + col);
#pragma unroll
    for (int mt = 0; mt < 4; ++mt)
#pragma unroll
      for (int e = 0; e < 4; ++e) {
        const int row = mtile * 256 + wm * 64 + mt * 16 + g * 4 + e;
        const float* hs; float* hd;
        if (row < ML) { size_t o = (size_t)row * D + col; hs = hsrc_lat + o; hd = p.out + o; }
        else { size_t o = (size_t)(row - ML) * D + col; hs = hsrc_ctx + o; hd = hc + o; }
        const float4 h = *(const float4*)hs;
        float4 r;
        r.x = DN_ALPHA * h.x + gv.x * acc[mt][0][e]; r.y = DN_ALPHA * h.y + gv.y * acc[mt][1][e];
        r.z = DN_ALPHA * h.z + gv.z * acc[mt][2][e]; r.w = DN_ALPHA * h.w + gv.w * acc[mt][3][e];
        *(float4*)hd = r;
      }
  }
}

DI void ph_ffnup(const Params& p, int l, char* smem) {
  const bf16_t* U = (const bf16_t*)(p.ws + R_U);
  const bf16_t* Bt = (const bf16_t*)(p.ws + WB_UP);
  bf16_t* HID = (bf16_t*)(p.ws + R_HID);
  const float* cw = p.in[38] + (size_t)l * 3 * 5632; const float* cb = p.in[39] + (size_t)l * 5632;
  const int tid = my_tid(), lane = tid & 63, wid = tid >> 6, wm = wid >> 2, wn = wid & 3, g = lane >> 4, r16 = lane & 15;
  const int mtiles = (l == 0) ? 144 : 136;
  constexpr int TS = 528;
  for (int it = 0;; ++it) {
    int mtile, ntile;
    if (!next_tile(it, mtiles, 22, mtile, ntile)) break;
    long rowbase; int t0, len, r0, r1;
    if (mtile < 136) { int b = mtile / 17; int tt = mtile % 17; len = SL; rowbase = (long)b * SL; t0 = tt * 254 - 1; r0 = 1; r1 = 254; }
    else { int b = mtile - 136; len = CL; rowbase = (long)ML + b * CL; t0 = 0; r0 = 0; r1 = 255; }
    f32x4 acc[8][4]; zero_acc256(acc);
    gemm_glds256(acc, U, 1024, rowbase + t0, Bt + (size_t)ntile * 256 * 1024, 1024, 1024, smem);
#pragma unroll
    for (int mt = 0; mt < 8; ++mt)
#pragma unroll
      for (int e = 0; e < 4; ++e) {
        uint2 o; o.x = pack2(acc[mt][0][e], acc[mt][1][e]); o.y = pack2(acc[mt][2][e], acc[mt][3][e]);
        *(uint2*)(smem + (wm * 128 + mt * 16 + g * 4 + e) * TS + (wn * 64 + r16 * 4) * 2) = o;
      }
    __syncthreads();
    {
      const int ch = (tid & 31) * 4, rgp = tid >> 5; const int ca = ntile * 128 + ch, cbx = 2816 + ca;
      const float4 wa0 = *(const float4*)(cw + ca), wa1 = *(const float4*)(cw + 5632 + ca), wa2 = *(const float4*)(cw + 2 * 5632 + ca), wab = *(const float4*)(cb + ca);
      const float4 wb0 = *(const float4*)(cw + cbx), wb1 = *(const float4*)(cw + 5632 + cbx), wb2 = *(const float4*)(cw + 2 * 5632 + cbx), wbb = *(const float4*)(cb + cbx);
      for (int r = r0 + rgp; r <= r1; r += 16) {
        const int tok = t0 + r;
        if (tok < len) {
          const char* Tr = smem + r * TS + ch * 2;
          const uint2 z2 = make_uint2(0u, 0u);
          const uint2 ua = *(const uint2*)(Tr), ub = *(const uint2*)(Tr + 256);
          const uint2 pa = tok >= 1 ? *(const uint2*)(Tr - TS) : z2, pb_ = tok >= 1 ? *(const uint2*)(Tr - TS + 256) : z2;
          const uint2 na = tok + 1 < len ? *(const uint2*)(Tr + TS) : z2, nb = tok + 1 < len ? *(const uint2*)(Tr + TS + 256) : z2;
          const float av0 = wa0.x * bflo(pa.x) + wa1.x * bflo(ua.x) + wa2.x * bflo(na.x) + wab.x;
          const float av1 = wa0.y * bfhi(pa.x) + wa1.y * bfhi(ua.x) + wa2.y * bfhi(na.x) + wab.y;
          const float av2 = wa0.z * bflo(pa.y) + wa1.z * bflo(ua.y) + wa2.z * bflo(na.y) + wab.z;
          const float av3 = wa0.w * bfhi(pa.y) + wa1.w * bfhi(ua.y) + wa2.w * bfhi(na.y) + wab.w;
          const float bv0 = wb0.x * bflo(pb_.x) + wb1.x * bflo(ub.x) + wb2.x * bflo(nb.x) + wbb.x;
          const float bv1 = wb0.y * bfhi(pb_.x) + wb1.y * bfhi(ub.x) + wb2.y * bfhi(nb.x) + wbb.y;
          const float bv2 = wb0.z * bflo(pb_.y) + wb1.z * bflo(ub.y) + wb2.z * bflo(nb.y) + wbb.z;
          const float bv3 = wb0.w * bfhi(pb_.y) + wb1.w * bfhi(ub.y) + wb2.w * bfhi(nb.y) + wbb.w;
          uint2 o; o.x = pack2(siluf_(av0) * bv0, siluf_(av1) * bv1); o.y = pack2(siluf_(av2) * bv2, siluf_(av3) * bv3);
          *(uint2*)(HID + (size_t)(rowbase + tok) * 2816 + ca) = o;
        }
      }
    }
  }
}

#ifndef REP_PREP
#define REP_PREP 1
#endif
#ifndef REP_GEMM
#define REP_GEMM 1
#endif
#ifndef REP_HY
#define REP_HY 1
#endif
#ifndef REP_RWP
#define REP_RWP 1
#endif
#ifndef REP_SCAN
#define REP_SCAN 1
#endif
#ifndef REP_ATTN
#define REP_ATTN 1
#endif
#ifndef PH_END
#define PH_END 24
#endif
#define XB_TMO      128
#define XB_XCNT(j)  (256  + 64 * (j))
#define XB_XSUB(j)  (1280 + 64 * (j))
#define XB_XGEN(j)  (2304 + 64 * (j))
#define XB_TOP      3328
#define XB_TOPGEN   3392
#define XCD_BAR_WORDS 3456
#define XB_SPIN_CAP (1u << 22)
DI unsigned xb_ld(unsigned* p) { return __hip_atomic_load(p, __ATOMIC_RELAXED, __HIP_MEMORY_SCOPE_AGENT); }
DI unsigned xb_add(unsigned* p, unsigned v) { return __hip_atomic_fetch_add(p, v, __ATOMIC_RELAXED, __HIP_MEMORY_SCOPE_AGENT); }
DI unsigned xb_xcc_id() { return (unsigned)__builtin_amdgcn_s_getreg((3 << 11) | 20) & 0xFu; }
#define XB_SPIN(cond, bar) do { unsigned _sp = 0; while (cond) { __builtin_amdgcn_s_sleep(1); \
    if ((++_sp & 255u) == 0u) { if (xb_ld(&(bar)[XB_TMO])) break; if (_sp > XB_SPIN_CAP) { atomicAdd(&(bar)[XB_TMO], 1u); break; } } } } while (0)
DI void xcd_barrier_complete(unsigned* bar, unsigned x, unsigned& nloc, unsigned& nx) {
  const unsigned G = gridDim.x;
  unsigned sum, cnt, mine, sp = 0u;
  for (;;) {
    sum = 0u; cnt = 0u; mine = 0u;
#pragma unroll
    for (unsigned j = 0; j < 16; ++j) { const unsigned c = xb_ld(&bar[XB_XCNT(j)]); sum += c; cnt += (c > 0u) ? 1u : 0u; mine = (j == x) ? c : mine; }
    if (sum == G) break;
    __builtin_amdgcn_s_sleep(1);
    if ((++sp & 255u) == 0u) { if (xb_ld(&bar[XB_TMO])) break; if (sp > XB_SPIN_CAP) { atomicAdd(&bar[XB_TMO], 1u); break; } }
  }
  nloc = mine > 0u ? mine : 1u; nx = cnt > 0u ? cnt : 1u;
}
DI void grid_barrier(unsigned* bar, volatile unsigned* st) {
  asm volatile("s_waitcnt vmcnt(0)" ::: "memory");
  __syncthreads();
  if (my_tid() == 0) {
    const unsigned x = xb_xcc_id();
    __builtin_amdgcn_s_waitcnt(0);
    unsigned nloc = st[0], nx = st[1];
    if (nloc == 0u) { xcd_barrier_complete(bar, x, nloc, nx); st[0] = nloc; st[1] = nx; }
    const unsigned old = xb_add(&bar[XB_XSUB(x)], 1u);
    const unsigned gen = old / nloc;
    if (old + 1u == (gen + 1u) * nloc) {
      __builtin_amdgcn_fence(__ATOMIC_RELEASE, "agent");
      asm volatile("s_waitcnt vmcnt(0)" ::: "memory");
      const unsigned og = xb_add(&bar[XB_TOP], 1u);
      const unsigned tg = og / nx;
      if (og + 1u == (tg + 1u) * nx) xb_add(&bar[XB_TOPGEN], 1u);
      else XB_SPIN(xb_ld(&bar[XB_TOPGEN]) == tg, bar);
      __builtin_amdgcn_fence(__ATOMIC_ACQUIRE, "agent");
      xb_add(&bar[XB_XGEN(x)], 1u);
      asm volatile("s_waitcnt vmcnt(0)" ::: "memory");
    } else {
      XB_SPIN(xb_ld(&bar[XB_XGEN(x)]) == gen, bar);
      __builtin_amdgcn_fence(__ATOMIC_ACQUIRE, "agent");
      asm volatile("s_waitcnt vmcnt(0)" ::: "memory");
    }
  }
  __syncthreads();
}
#define SYNC_OR_RET(idx) do { if ((idx) + 1 >= PH_END) return; if ((idx) == 0) { grid.sync(); if (my_tid() == 0) (void)xb_add(&((unsigned*)(p.ws + MISC_XBAR))[XB_XCNT(xb_xcc_id())], 1u); } else grid_barrier((unsigned*)(p.ws + MISC_XBAR), (volatile unsigned*)(smem + 144 * 1024)); } while (0)
template <int l>
DI void run_layer(const Params& p, cg::grid_group& grid, char* smem, unsigned& epoch) {
  const float* mod = (const float*)(p.ws + MISC_MOD) + (size_t)l * 9 * 6144;
  float* hc = (float*)(p.ws + OFF_HC);
  const float* hl_src = (l == 0) ? p.in[0] : p.out;
  const float* hc_src = (l == 0) ? p.in[2] : hc;
  constexpr int B0 = l * 12;
  if (l == 0) {
    ph_convert(p, 0, smem);
    ph_ada(p, smem);
    hy_rawfilter(p, 0, SL, (float*)(p.ws + R_RAWF), smem);
    hy_rawfilter(p, 0, CL, (float*)(p.ws + MISC_RAWC), smem);
    SYNC_OR_RET(B0 + 0);
    ph_kf(p, 0, smem);
    ph_ln(hl_src, hc_src, nullptr, nullptr, nullptr, nullptr, (bf16_t*)p.out, mod, 0, MT);
    SYNC_OR_RET(B0 + 1);
  }
  for (int rep = 0; rep < REP_GEMM; ++rep) ph_inproj(p, l == 0 ? (const bf16_t*)p.out : (const bf16_t*)(p.ws + R_U), smem);
  SYNC_OR_RET(B0 + 2);
  for (int rep = 0; rep < REP_HY; ++rep) {
  if (blockIdx.x == 0 && my_tid() == 0) *(unsigned*)(p.ws + MISC_BAR + 64 + 64 * l) = 0u;
  ph_hyena(p, l, smem);
  if (l == 0) ph_hyena_ctx(p, l, smem);
  }
  ph_rope(p, smem);
  for (int rep = 0; rep < REP_RWP; ++rep) ph_rwprep(p, l, smem);
  SYNC_OR_RET(B0 + 3);
  for (int rep = 0; rep < REP_SCAN; ++rep) ph_scan(p, smem);
  for (int rep = 0; rep < REP_ATTN; ++rep) ph_attn(p, l, smem);
  SYNC_OR_RET(B0 + 4);
  ph_rwout(p, l);
  if (l != 0) ph_ln(hl_src, hc_src, nullptr, nullptr, nullptr, nullptr, (bf16_t*)(p.ws + R_URE), mod, 0, ML);
  SYNC_OR_RET(B0 + 5);
  for (int rep = 0; rep < REP_GEMM; ++rep) ph_merge(p, l, l == 0 ? (const bf16_t*)p.out : (const bf16_t*)(p.ws + R_URE), smem);
  SYNC_OR_RET(B0 + 6);
  ph_resgemm(p, l, (const bf16_t*)(p.ws + R_ACC), 1024, (const bf16_t*)(p.ws + WB_OUT), hl_src, hc_src, 2048, smem);
  if (l == 0) hy_rawfilter(p, 1, SL, (float*)(p.ws + R_RAWF), smem);
  SYNC_OR_RET(B0 + 7);
  ph_ln(p.out, hc, p.out, hc, p.in[35] + (size_t)l * D, p.in[36] + (size_t)l * D, (bf16_t*)(p.ws + R_U), mod, 3072, l == 0 ? MT : ML);
  if (l == 0) ph_kf(p, 1, smem);
  SYNC_OR_RET(B0 + 8);
  for (int rep = 0; rep < REP_GEMM; ++rep) ph_ffnup(p, l, smem);
  SYNC_OR_RET(B0 + 9);
  ph_resgemm(p, l, (const bf16_t*)(p.ws + R_HID), 2816, (const bf16_t*)(p.ws + WB_DOWN), p.out, hc, 5120, smem);
  SYNC_OR_RET(B0 + 10);
  if (l == 0) {
    ph_ln(p.out, hc, p.out, hc, p.in[41], p.in[42], (bf16_t*)(p.ws + R_U), mod + 9 * 6144, 0, MT);
    ph_convert(p, 1, smem);
  } else {
    ph_ln(p.out, hc, p.out, hc, p.in[41] + (size_t)l * D, p.in[42] + (size_t)l * D, nullptr, mod, 0, ML);
  }
  SYNC_OR_RET(B0 + 11);
}

__global__ void __launch_bounds__(NTHR) mega(Params p) {
  extern __shared__ __attribute__((aligned(16))) char smem[];
  cg::grid_group grid = cg::this_grid();
  unsigned epoch = 0;
  if (blockIdx.x == 0) for (int i = my_tid(); i < XCD_BAR_WORDS; i += NTHR) ((unsigned*)(p.ws + MISC_XBAR))[i] = 0u;
  if (my_tid() < 2) ((volatile unsigned*)(smem + 144 * 1024))[my_tid()] = 0u;
  if (blockIdx.x == 0 && my_tid() < 64) *(unsigned*)(p.ws + MISC_ZERO + my_tid() * 4) = 0u;
  run_layer<0>(p, grid, smem, epoch);
  if (PH_END > 12) run_layer<1>(p, grid, smem, epoch);
}

extern "C" void kernel_launch(void* const* d_in, const int* in_sizes, int n_in, void* d_out, int out_size,
                              void* d_ws, size_t ws_size, hipStream_t stream) {
  static int grid_blocks = 0;
  if (!grid_blocks) {
    int dev = 0, cus = 0, per_cu = 0;
    (void)hipGetDevice(&dev);
    (void)hipDeviceGetAttribute(&cus, hipDeviceAttributeMultiprocessorCount, dev);
    (void)hipFuncSetAttribute((const void*)mega, hipFuncAttributeMaxDynamicSharedMemorySize, SMEM_BYTES);
    (void)hipOccupancyMaxActiveBlocksPerMultiprocessor(&per_cu, mega, NTHR, SMEM_BYTES);
    if (per_cu < 1) per_cu = 1;
    if (per_cu > 1) per_cu = 1;
    grid_blocks = cus * per_cu;
  }
  Params p{};
  for (int i = 0; i < 43; ++i) p.in[i] = (const float*)d_in[i];
  p.out = (float*)d_out; p.ws = (char*)d_ws;
  void* args[] = {&p};
  hipError_t e = hipLaunchCooperativeKernel((void*)mega, dim3(grid_blocks), dim3(NTHR), args, SMEM_BYTES, stream);
  if (e != hipSuccess) fprintf(stderr, "cooperative launch failed: %s (grid %d)\n", hipGetErrorString(e), grid_blocks);
}
```

```cpp
#include <hip/hip_runtime.h>
#include <hip/hip_cooperative_groups.h>
#include <cstdio>
#include <cstdint>
namespace cg = cooperative_groups;

#define DI __device__ __forceinline__
typedef unsigned short bf16_t;
typedef short bf16x8 __attribute__((ext_vector_type(8)));
typedef float f32x4 __attribute__((ext_vector_type(4)));

constexpr int D = 1024, NB = 8, SL = 4096, CL = 256;
constexpr int ML = NB * SL, MC = NB * CL, MT = ML + MC;
constexpr int KEYS = SL + CL;
constexpr int NTHR = 512;
constexpr float DN_ALPHA = 1.41421356237f;
constexpr size_t UNIT = (size_t)MT * 512;

constexpr size_t WB_IN = 0;
constexpr size_t WB_GATE = WB_IN + (size_t)3328 * 1024 * 2;
constexpr size_t WB_BR = WB_GATE + (size_t)4096 * 1024 * 2;
constexpr size_t WB_OUT = WB_BR + (size_t)4 * 1024 * 256 * 2;
constexpr size_t WB_UP = WB_OUT + (size_t)1024 * 1024 * 2;
constexpr size_t WB_DOWN = WB_UP + (size_t)5632 * 1024 * 2;
constexpr size_t WB_END = WB_DOWN + (size_t)1024 * 2816 * 2;
constexpr size_t OFF_KF = WB_END;
constexpr size_t OFF_HC = OFF_KF + (size_t)512 * 8192 * 8;
constexpr size_t OFF_MISC = OFF_HC + (size_t)MC * D * 4;
constexpr size_t MISC_MOD = OFF_MISC;
constexpr size_t MISC_TW = MISC_MOD + (size_t)2 * 9 * 6144 * 4;
constexpr size_t MISC_RAWC = MISC_TW + 4096 * 8;
constexpr size_t MISC_GCTX = MISC_RAWC + (size_t)256 * 1024 * 4;
constexpr size_t MISC_RWW = MISC_GCTX + (size_t)512 * 512 * 4;
constexpr size_t RWW_F = MISC_RWW, RWW_B = RWW_F + 256 * 64 * 2, RWW_A = RWW_B + 256 * 64 * 2, RWW_GF = RWW_A + 256 * 64 * 2, RWW_GB = RWW_GF + 256 * 128 * 2;
constexpr size_t MISC_XBAR = OFF_MISC + (size_t)3 * 1024 * 1024;
constexpr size_t OFF_R = OFF_MISC + (size_t)4 * 1024 * 1024;
constexpr size_t MISC_BAR = OFF_R - 256;
constexpr size_t MISC_ZERO = OFF_R - 512;
static_assert(RWW_GB + 256 * 128 * 2 <= MISC_ZERO, "misc overflow");
constexpr size_t R_YHY = OFF_R, R_YSW = OFF_R + UNIT, R_YDF = OFF_R + 2 * UNIT;
constexpr size_t R_PHY = OFF_R + 3 * UNIT;
constexpr size_t R_PSW = OFF_R + 6 * UNIT;
constexpr size_t R_VTSW = R_PSW + (size_t)MT * 384 * 2;
constexpr size_t R_PDF = OFF_R + 8 * UNIT;
constexpr size_t R_VTDF = OFF_R + 10 * UNIT;
constexpr size_t R_PRW = OFF_R + 11 * UNIT;
constexpr size_t R_STR = R_PRW + (size_t)MT * 1216 * 2;
constexpr size_t R_G = R_STR + 7 * UNIT;
constexpr size_t R_END = R_G + 2 * UNIT;
constexpr size_t R_RAWF = OFF_R;
constexpr size_t R_OF = R_PHY, R_OB = R_PHY + UNIT;
constexpr size_t R_URE = R_PSW;
constexpr size_t R_YRW = R_VTDF;
constexpr size_t R_ACC = R_PRW;
constexpr size_t R_U = R_STR;
constexpr size_t R_HID = OFF_R;
static_assert(R_END <= (size_t)512 * 1024 * 1024, "ws overflow");
static_assert((size_t)MT * 2816 * 2 <= 11 * UNIT, "hid");

constexpr int SMEM_BYTES = 144 * 1024 + 64;

struct Params {
  const float* in[43];
  float* out;
  char* ws;
};

DI int my_tid() { int t = (int)__builtin_amdgcn_workitem_id_x(); asm volatile("" : "+v"(t)); return t; }
DI unsigned f2bf(float f) { unsigned u = __float_as_uint(f); u += 0x7fffu + ((u >> 16) & 1u); return u >> 16; }
DI float bf2f(unsigned h) { return __uint_as_float(h << 16); }
typedef __bf16 bf16v2_t __attribute__((ext_vector_type(2)));
typedef float f32v2_t __attribute__((ext_vector_type(2)));
DI unsigned pack2(float lo, float hi) { f32v2_t v = {lo, hi}; bf16v2_t b = __builtin_convertvector(v, bf16v2_t); return __builtin_bit_cast(unsigned, b); }

DI float bflo(unsigned w) { return __uint_as_float(w << 16); }
DI float bfhi(unsigned w) { return __uint_as_float(w & 0xffff0000u); }
DI float sigmoidf_(float x) { return __builtin_amdgcn_rcpf(1.f + __expf(-x)); }
DI float siluf_(float x) { return x * __builtin_amdgcn_rcpf(1.f + __expf(-x)); }
DI float wave_sum(float v) {
#pragma unroll
  for (int o = 32; o >= 1; o >>= 1) v += __shfl_xor(v, o);
  return v;
}
template <int CTRL> DI float dpp_mov(float v) {
  return __int_as_float(__builtin_amdgcn_update_dpp(0, __float_as_int(v), CTRL, 0xf, 0xf, false));
}
DI float sum16(float v) {
  v += dpp_mov<0xB1>(v);
  v += dpp_mov<0x4E>(v);
  v += dpp_mov<0x141>(v);
  v += dpp_mov<0x140>(v);
  return v;
}
DI void lds_barrier() { asm volatile("s_waitcnt lgkmcnt(0)" ::: "memory"); __builtin_amdgcn_s_barrier(); asm volatile("" ::: "memory"); }
DI uint4 sel4(bool z, uint4 v) { return make_uint4(z ? 0u : v.x, z ? 0u : v.y, z ? 0u : v.z, z ? 0u : v.w); }
DI int mod_idx(int row) { return row < ML ? (row >> 12) : 8; }

template <int NTW, bool DEEP, class RowFn>
DI void gemm_main(f32x4 (&acc)[4][NTW], const bf16_t* __restrict__ A, int lda, RowFn rowfn,
                  const bf16_t* __restrict__ Bt, int ldb, int K, char* smem) {
  constexpr int BN = NTW * 32;
  constexpr int A_BYTES = 256 * 128, B_BYTES = BN * 128, STAGE = A_BYTES + B_BYTES;
  constexpr int NBL = BN / 64;
  const int tid = my_tid(), lane = tid & 63, wid = tid >> 6, wm = wid >> 1, wn = wid & 1, g = lane >> 4, r16 = lane & 15;
  const int chunk = tid & 7, lrow = tid >> 3;
  long a0 = rowfn(lrow), a1 = rowfn(lrow + 64), a2 = rowfn(lrow + 128), a3 = rowfn(lrow + 192);
  const long c0 = a0 < 0 ? 0 : a0, c1 = a1 < 0 ? 0 : a1, c2 = a2 < 0 ? 0 : a2, c3 = a3 < 0 ? 0 : a3;
  const bf16_t* Bp = Bt + (long)lrow * ldb + chunk * 8;
  const bf16_t* Ap0 = A + c0 * lda + chunk * 8; const bf16_t* Ap1 = A + c1 * lda + chunk * 8;
  const bf16_t* Ap2 = A + c2 * lda + chunk * 8; const bf16_t* Ap3 = A + c3 * lda + chunk * 8;
  struct Regs { uint4 a0, a1, a2, a3, b0, b1; };
  Regs R0, R1;
  R0.b1 = make_uint4(0, 0, 0, 0); R1.b1 = make_uint4(0, 0, 0, 0);
  auto GLOAD = [&](Regs& R, int k0) {
    R.a0 = *(const uint4*)(Ap0 + k0); R.a1 = *(const uint4*)(Ap1 + k0);
    R.a2 = *(const uint4*)(Ap2 + k0); R.a3 = *(const uint4*)(Ap3 + k0);
    R.b0 = *(const uint4*)(Bp + k0);
    if constexpr (NBL > 1) R.b1 = *(const uint4*)(Bp + (long)64 * ldb + k0);
  };
  auto SSTORE = [&](const Regs& R, int st) {
    char* base = smem + st * STAGE + lrow * 128 + ((chunk ^ (lrow & 7)) << 4);
    *(uint4*)(base) = sel4(a0 < 0, R.a0); *(uint4*)(base + 64 * 128) = sel4(a1 < 0, R.a1);
    *(uint4*)(base + 128 * 128) = sel4(a2 < 0, R.a2); *(uint4*)(base + 192 * 128) = sel4(a3 < 0, R.a3);
    *(uint4*)(base + A_BYTES) = R.b0;
    if constexpr (NBL > 1) *(uint4*)(base + A_BYTES + 64 * 128) = R.b1;
  };
  auto COMPUTE = [&](int st) {
    const char* As = smem + st * STAGE + (wm * 64 + r16) * 128;
    const char* Bs = smem + st * STAGE + A_BYTES + (wn * (NTW * 16) + r16) * 128;
#pragma unroll
    for (int kk = 0; kk < 2; ++kk) {
      const int sw = ((kk * 4 + g) ^ (r16 & 7)) << 4;
      bf16x8 af[4], bfr[NTW];
#pragma unroll
      for (int mt = 0; mt < 4; ++mt) af[mt] = *(const bf16x8*)(As + mt * 16 * 128 + sw);
#pragma unroll
      for (int nt = 0; nt < NTW; ++nt) bfr[nt] = *(const bf16x8*)(Bs + nt * 16 * 128 + sw);
#pragma unroll
      for (int mt = 0; mt < 4; ++mt)
#pragma unroll
        for (int nt = 0; nt < NTW; ++nt)
          acc[mt][nt] = __builtin_amdgcn_mfma_f32_16x16x32_bf16(af[mt], bfr[nt], acc[mt][nt], 0, 0, 0);
    }
  };
  const int nk = K >> 6;
  __syncthreads();
  GLOAD(R0, 0);
  SSTORE(R0, 0);
  if constexpr (DEEP) {
    GLOAD(R0, 64);
    if (nk > 2) GLOAD(R1, 128);
    lds_barrier();
    bf16x8 fa0[4], fb0[NTW], fa1[4], fb1[NTW];
    auto READF = [&](bf16x8 (&fa)[4], bf16x8 (&fb)[NTW], int st, int kk) {
      const int sw = ((kk * 4 + g) ^ (r16 & 7)) << 4;
      const char* As = smem + st * STAGE + (wm * 64 + r16) * 128 + sw;
      const char* Bs = smem + st * STAGE + A_BYTES + (wn * (NTW * 16) + r16) * 128 + sw;
#pragma unroll
      for (int mt = 0; mt < 4; ++mt) fa[mt] = *(const bf16x8*)(As + mt * 16 * 128);
#pragma unroll
      for (int nt = 0; nt < NTW; ++nt) fb[nt] = *(const bf16x8*)(Bs + nt * 16 * 128);
    };
    auto MMA = [&](const bf16x8 (&fa)[4], const bf16x8 (&fb)[NTW]) {
#pragma unroll
      for (int mt = 0; mt < 4; ++mt)
#pragma unroll
        for (int nt = 0; nt < NTW; ++nt)
          acc[mt][nt] = __builtin_amdgcn_mfma_f32_16x16x32_bf16(fa[mt], fb[nt], acc[mt][nt], 0, 0, 0);
    };
    READF(fa0, fb0, 0, 0);
    for (int kt = 0; kt < nk; kt += 2) {
      READF(fa1, fb1, 0, 1);
      MMA(fa0, fb0);
#pragma unroll
      for (int i = 0; i < 4 + NTW; ++i) { __builtin_amdgcn_sched_group_barrier(0x100, 1, 0); __builtin_amdgcn_sched_group_barrier(0x008, 2, 0); }
      __builtin_amdgcn_sched_barrier(0);
      SSTORE(R0, 1);
      if (kt + 3 < nk) GLOAD(R0, (kt + 3) * 64);
      MMA(fa1, fb1);
#pragma unroll
      for (int i = 0; i < 6; ++i) { __builtin_amdgcn_sched_group_barrier(0x200, 1, 0); __builtin_amdgcn_sched_group_barrier(0x020, 1, 0); __builtin_amdgcn_sched_group_barrier(0x008, 2, 0); }
      __builtin_amdgcn_sched_barrier(0);
      lds_barrier();
      READF(fa0, fb0, 1, 0);
      READF(fa1, fb1, 1, 1);
      MMA(fa0, fb0);
#pragma unroll
      for (int i = 0; i < 4 + NTW; ++i) { __builtin_amdgcn_sched_group_barrier(0x100, 1, 0); __builtin_amdgcn_sched_group_barrier(0x008, 2, 0); }
      __builtin_amdgcn_sched_barrier(0);
      if (kt + 2 < nk) SSTORE(R1, 0);
      if (kt + 4 < nk) GLOAD(R1, (kt + 4) * 64);
      MMA(fa1, fb1);
#pragma unroll
      for (int i = 0; i < 6; ++i) { __builtin_amdgcn_sched_group_barrier(0x200, 1, 0); __builtin_amdgcn_sched_group_barrier(0x020, 1, 0); __builtin_amdgcn_sched_group_barrier(0x008, 2, 0); }
      __builtin_amdgcn_sched_barrier(0);
      lds_barrier();
      if (kt + 2 < nk) READF(fa0, fb0, 0, 0);
    }
  } else {
    lds_barrier();
    for (int kt = 0; kt < nk; ++kt) {
      const int st = kt & 1;
      if (kt + 1 < nk) GLOAD(R0, (kt + 1) * 64);
      __builtin_amdgcn_sched_barrier(0);
      COMPUTE(st);
      __builtin_amdgcn_sched_barrier(0);
      if (kt + 1 < nk) SSTORE(R0, st ^ 1);
      lds_barrier();
    }
  }
}

#define GLDS16(gp, lp) __builtin_amdgcn_global_load_lds((const unsigned*)(gp), (unsigned*)(lp), 16, 0, 0)
template <class RowFn>
DI void gemm_glds(f32x4 (&acc)[4][4], const bf16_t* __restrict__ A, int lda, RowFn rowfn,
                  const bf16_t* __restrict__ Bt, int ldb, int K, char* smem, const bf16_t* zrow) {
  constexpr int A_BYTES = 256 * 128, STAGE = A_BYTES + 128 * 128;
  const int tid = my_tid(), lane = tid & 63, wid = tid >> 6, wm = wid >> 1, wn = wid & 1, g = lane >> 4, r16 = lane & 15;
  const int lrow = tid >> 3, c = (tid & 7) ^ (lrow & 7);
  const long a0 = rowfn(lrow), a1 = rowfn(lrow + 64), a2 = rowfn(lrow + 128), a3 = rowfn(lrow + 192);
  const bf16_t* pa0 = (a0 >= 0 ? A + a0 * lda : zrow) + c * 8; const int m0 = a0 >= 0 ? 1 : 0;
  const bf16_t* pa1 = (a1 >= 0 ? A + a1 * lda : zrow) + c * 8; const int m1 = a1 >= 0 ? 1 : 0;
  const bf16_t* pa2 = (a2 >= 0 ? A + a2 * lda : zrow) + c * 8; const int m2 = a2 >= 0 ? 1 : 0;
  const bf16_t* pa3 = (a3 >= 0 ? A + a3 * lda : zrow) + c * 8; const int m3 = a3 >= 0 ? 1 : 0;
  const bf16_t* pb0 = Bt + (long)lrow * ldb + c * 8; const bf16_t* pb1 = pb0 + (long)64 * ldb;
  auto ISSUE = [&](int kt, int bi) {
    char* d = smem + bi * STAGE + tid * 16;
    const int k0 = kt * 64;
    GLDS16(pa0 + k0 * m0, d); GLDS16(pa1 + k0 * m1, d + 8192); GLDS16(pa2 + k0 * m2, d + 16384); GLDS16(pa3 + k0 * m3, d + 24576);
    GLDS16(pb0 + k0, d + A_BYTES); GLDS16(pb1 + k0, d + A_BYTES + 8192);
  };
  auto COMPUTE = [&](int bi) {
    const char* As = smem + bi * STAGE + (wm * 64 + r16) * 128;
    const char* Bs = smem + bi * STAGE + A_BYTES + (wn * 64 + r16) * 128;
#pragma unroll
    for (int kk = 0; kk < 2; ++kk) {
      const int sw = ((kk * 4 + g) ^ (r16 & 7)) << 4;
      bf16x8 af[4], bfr[4];
#pragma unroll
      for (int mt = 0; mt < 4; ++mt) af[mt] = *(const bf16x8*)(As + mt * 16 * 128 + sw);
#pragma unroll
      for (int nt = 0; nt < 4; ++nt) bfr[nt] = *(const bf16x8*)(Bs + nt * 16 * 128 + sw);
      __builtin_amdgcn_s_setprio(1);
#pragma unroll
      for (int mt = 0; mt < 4; ++mt)
#pragma unroll
        for (int nt = 0; nt < 4; ++nt)
          acc[mt][nt] = __builtin_amdgcn_mfma_f32_16x16x32_bf16(af[mt], bfr[nt], acc[mt][nt], 0, 0, 0);
      __builtin_amdgcn_s_setprio(0);
    }
  };
  const int nk = K >> 6;
  __syncthreads();
  ISSUE(0, 0);
  ISSUE(1, 1);
  asm volatile("s_waitcnt vmcnt(6)" ::: "memory");
  __builtin_amdgcn_s_barrier();
  asm volatile("" ::: "memory");
  int bi = 0;
  for (int kt = 0; kt < nk; ++kt) {
    const int b2 = bi >= 1 ? bi - 1 : 2;
    if (kt + 2 < nk) ISSUE(kt + 2, b2);
    COMPUTE(bi);
    if (kt + 2 < nk) asm volatile("s_waitcnt vmcnt(6)" ::: "memory");
    else asm volatile("s_waitcnt vmcnt(0)" ::: "memory");
    asm volatile("s_waitcnt lgkmcnt(0)" ::: "memory");
    __builtin_amdgcn_s_barrier();
    asm volatile("" ::: "memory");
    bi = bi == 2 ? 0 : bi + 1;
  }
}

DI void gemm_glds256(f32x4 (&acc)[8][4], const bf16_t* __restrict__ A, int lda, long arow0,
                     const bf16_t* __restrict__ Bt, int ldb, int K, char* smem) {
  constexpr int A_BYTES = 256 * 128, STAGE = 2 * A_BYTES;
  const int tid = my_tid(), lane = tid & 63, wid = tid >> 6, wm = wid >> 2, wn = wid & 3, g = lane >> 4, r16 = lane & 15;
  const int lrow = tid >> 3, c = (tid & 7) ^ (lrow & 7);
  const bf16_t* pa = A + (arow0 + lrow) * (long)lda + c * 8;
  const bf16_t* pb = Bt + (long)lrow * ldb + c * 8;
  const long a64 = (long)64 * lda, b64 = (long)64 * ldb;
  auto ISSUE = [&](int kt, int bi) {
    char* d = smem + bi * STAGE + tid * 16;
    const int k0 = kt * 64;
    GLDS16(pa + k0, d); GLDS16(pa + a64 + k0, d + 8192); GLDS16(pa + 2 * a64 + k0, d + 16384); GLDS16(pa + 3 * a64 + k0, d + 24576);
    GLDS16(pb + k0, d + A_BYTES); GLDS16(pb + b64 + k0, d + A_BYTES + 8192); GLDS16(pb + 2 * b64 + k0, d + A_BYTES + 16384); GLDS16(pb + 3 * b64 + k0, d + A_BYTES + 24576);
  };
  auto COMPUTE = [&](int bi) {
    const char* As = smem + bi * STAGE + (wm * 128 + r16) * 128;
    const char* Bs = smem + bi * STAGE + A_BYTES + (wn * 64 + r16) * 128;
#pragma unroll
    for (int kk = 0; kk < 2; ++kk) {
      const int sw = ((kk * 4 + g) ^ (r16 & 7)) << 4;
      bf16x8 bfr[4];
#pragma unroll
      for (int nt = 0; nt < 4; ++nt) bfr[nt] = *(const bf16x8*)(Bs + nt * 16 * 128 + sw);
      __builtin_amdgcn_s_setprio(1);
#pragma unroll
      for (int mt = 0; mt < 8; ++mt) {
        const bf16x8 af = *(const bf16x8*)(As + mt * 16 * 128 + sw);
#pragma unroll
        for (int nt = 0; nt < 4; ++nt)
          acc[mt][nt] = __builtin_amdgcn_mfma_f32_16x16x32_bf16(af, bfr[nt], acc[mt][nt], 0, 0, 0);
      }
      __builtin_amdgcn_s_setprio(0);
    }
  };
  const int nk = K >> 6;
  __syncthreads();
  ISSUE(0, 0);
  asm volatile("s_waitcnt vmcnt(0)" ::: "memory");
  __builtin_amdgcn_s_barrier();
  asm volatile("" ::: "memory");
  int bi = 0;
  for (int kt = 0; kt < nk; ++kt) {
    if (kt + 1 < nk) ISSUE(kt + 1, bi ^ 1);
    COMPUTE(bi);
    asm volatile("s_waitcnt vmcnt(0)" ::: "memory");
    asm volatile("s_waitcnt lgkmcnt(0)" ::: "memory");
    __builtin_amdgcn_s_barrier();
    asm volatile("" ::: "memory");
    bi ^= 1;
  }
}
DI void zero_acc256(f32x4 (&acc)[8][4]) {
#pragma unroll
  for (int i = 0; i < 8; ++i)
#pragma unroll
    for (int j = 0; j < 4; ++j) acc[i][j] = (f32x4){0.f, 0.f, 0.f, 0.f};
}

DI bool next_tile(int i, int MTILES, int NTILES, int& mt, int& nt) {
  const int xcd = blockIdx.x & 7, slot = blockIdx.x >> 3, nslot = gridDim.x >> 3;
  const int m_lo = (MTILES * xcd) >> 3, m_hi = (MTILES * (xcd + 1)) >> 3, Mloc = m_hi - m_lo;
  const int q = i * nslot + slot;
  if (q >= Mloc * NTILES) return false;
  const int gidx = q / (4 * NTILES), m0 = gidx * 4;
  const int rows = (Mloc - m0) < 4 ? (Mloc - m0) : 4;
  const int within = q - gidx * 4 * NTILES;
  nt = within / rows; mt = m_lo + m0 + within % rows;
  return true;
}

struct RowPlain { long base; DI long operator()(int r) const { return base + r; } };
struct RowHalo { long rowbase; int t0; int len; DI long operator()(int r) const { int t = t0 + r; return (t >= 0 && t < len) ? rowbase + t : -1; } };

template <int NTW> DI void zero_acc(f32x4 (&acc)[4][NTW]) {
#pragma unroll
  for (int i = 0; i < 4; ++i)
#pragma unroll
    for (int j = 0; j < NTW; ++j) acc[i][j] = (f32x4){0.f, 0.f, 0.f, 0.f};
}

DI void cvt_unit(const float* __restrict__ src, int ldsrc, int srccol0, int k0, bf16_t* __restrict__ dst, int K, int n0, char* smem, bool perm = true) {
  float* T = (float*)smem;
  const int tid = my_tid();
  __syncthreads();
  if (srccol0 >= 0) {
#pragma unroll
    for (int i = 0; i < 8; ++i) {
      int idx = tid + i * 512; int k = idx >> 6, n = idx & 63;
      T[k * 65 + n] = src[(long)(k0 + k) * ldsrc + srccol0 + n];
    }
  }
  __syncthreads();
  int nd = tid >> 3, kc = (tid & 7) * 8; int n = perm ? ((nd & 15) * 4 + (nd >> 4)) : nd;
  uint4 o = make_uint4(0, 0, 0, 0);
  if (srccol0 >= 0) {
    o.x = pack2(T[(kc + 0) * 65 + n], T[(kc + 1) * 65 + n]);
    o.y = pack2(T[(kc + 2) * 65 + n], T[(kc + 3) * 65 + n]);
    o.z = pack2(T[(kc + 4) * 65 + n], T[(kc + 5) * 65 + n]);
    o.w = pack2(T[(kc + 6) * 65 + n], T[(kc + 7) * 65 + n]);
  }
  *(uint4*)(dst + (long)(n0 + nd) * K + k0 + kc) = o;
}

DI void ph_convert(const Params& p, int l, char* smem) {
  for (int u = blockIdx.x; u < 4508; u += gridDim.x) {
    if (u < 832) {
      int gI = u >> 4, kt = u & 15; int n0 = gI * 64; int sc;
      if (n0 < 1280) sc = n0; else if (n0 < 2048) sc = 2496 + (n0 - 1280); else if (n0 < 3264) sc = 1280 + (n0 - 2048); else sc = -1;
      cvt_unit(p.in[6] + (size_t)l * 1024 * 7360, 7360, sc, kt * 64, (bf16_t*)(p.ws + WB_IN), 1024, n0, smem);
    } else if (u < 1856) {
      int v = u - 832; int gI = v >> 4, kt = v & 15;
      cvt_unit(p.in[6] + (size_t)l * 1024 * 7360, 7360, 3264 + gI * 64, kt * 64, (bf16_t*)(p.ws + WB_GATE), 1024, gI * 64, smem);
    } else if (u < 2112) {
      int v = u - 1856; int gI = v >> 2, kt = v & 3; int j = gI >> 4, gg = gI & 15;
      cvt_unit(p.in[33] + ((size_t)l * 4 + j) * 256 * 1024, 1024, gg * 64, kt * 64, (bf16_t*)(p.ws + WB_BR) + (size_t)j * 1024 * 256, 256, gg * 64, smem);
    } else if (u < 2368) {
      int v = u - 2112; int gI = v >> 4, kt = v & 15;
      cvt_unit(p.in[34] + (size_t)l * 1024 * 1024, 1024, gI * 64, kt * 64, (bf16_t*)(p.ws + WB_OUT), 1024, gI * 64, smem);
    } else if (u < 3776) {
      int v = u - 2368; int gI = v >> 4, kt = v & 15; int nt = gI >> 2, q = gI & 3;
      cvt_unit(p.in[37] + (size_t)l * 1024 * 5632, 5632, (q >> 1) * 2816 + nt * 128 + (q & 1) * 64, kt * 64, (bf16_t*)(p.ws + WB_UP), 1024, gI * 64, smem);
    } else if (u < 4480) {
      int v = u - 3776; int gI = v / 44, kt = v % 44;
      cvt_unit(p.in[40] + (size_t)l * 2816 * 1024, 1024, gI * 64, kt * 64, (bf16_t*)(p.ws + WB_DOWN), 2816, gI * 64, smem);
    } else {
      int v = u - 4480;
      if (v < 4) cvt_unit(p.in[19] + (size_t)l * 2 * 64 * 256, 256, v * 64, 0, (bf16_t*)(p.ws + RWW_F), 64, v * 64, smem);
      else if (v < 8) cvt_unit(p.in[19] + (size_t)l * 2 * 64 * 256 + 64 * 256, 256, (v - 4) * 64, 0, (bf16_t*)(p.ws + RWW_B), 64, (v - 4) * 64, smem);
      else if (v < 12) cvt_unit(p.in[21] + (size_t)l * 64 * 256, 256, (v - 8) * 64, 0, (bf16_t*)(p.ws + RWW_A), 64, (v - 8) * 64, smem);
      else if (v < 20) { int w = v - 12; cvt_unit(p.in[22] + (size_t)l * 2 * 128 * 256, 256, (w >> 1) * 64, (w & 1) * 64, (bf16_t*)(p.ws + RWW_GF), 128, (w >> 1) * 64, smem); }
      else { int w = v - 20; cvt_unit(p.in[22] + (size_t)l * 2 * 128 * 256 + 128 * 256, 256, (w >> 1) * 64, (w & 1) * 64, (bf16_t*)(p.ws + RWW_GB), 128, (w >> 1) * 64, smem); }
    }
  }
}

DI void ph_ada(const Params& p, char* smem) {
  float* S = (float*)smem;
  float* R = S + 9 * 1024;
  const int tid = my_tid();
  bool loaded = false;
  for (int u = blockIdx.x; u < 192; u += gridDim.x) {
    if (!loaded) {
      __syncthreads();
      for (int i = tid; i < 9 * 1024; i += NTHR) { float c = i < 8192 ? p.in[1][i] : p.in[3][i - 8192]; S[i] = siluf_(c); }
      loaded = true;
    }
    __syncthreads();
    int l = u / 96, n0 = (u % 96) * 64;
    int col = tid & 63, ks = tid >> 6;
    const float* W = p.in[4] + (size_t)l * 1024 * 6144 + n0 + col;
    float a[9];
#pragma unroll
    for (int b = 0; b < 9; ++b) a[b] = 0.f;
    for (int k = ks * 128; k < ks * 128 + 128; ++k) {
      float w = W[(size_t)k * 6144];
#pragma unroll
      for (int b = 0; b < 9; ++b) a[b] += S[b * 1024 + k] * w;
    }
#pragma unroll
    for (int b = 0; b < 9; ++b) R[(ks * 9 + b) * 64 + col] = a[b];
    __syncthreads();
    for (int i = tid; i < 9 * 64; i += NTHR) {
      int b = i >> 6, c = i & 63; float s = 0.f;
#pragma unroll
      for (int k2 = 0; k2 < 8; ++k2) s += R[(k2 * 9 + b) * 64 + c];
      s += p.in[5][(size_t)l * 6144 + n0 + c];
      ((float*)(p.ws + MISC_MOD))[((size_t)l * 9 + b) * 6144 + n0 + c] = s;
    }
  }
  for (int i = blockIdx.x * NTHR + tid; i < 4096; i += gridDim.x * NTHR) {
    float s, c; sincospif(-(float)i / 4096.f, &s, &c);
    ((float2*)(p.ws + MISC_TW))[i] = make_float2(c, s);
  }
}

DI void hy_rawfilter(const Params& p, int l, int Lf, float* __restrict__ dst, char* smem) {
  float* W1 = (float*)smem;
  float* W2 = W1 + 33 * 64;
  float* Z = W2 + 64 * 64;
  float* H1 = Z + 16 * 36;
  float* H2 = H1 + 16 * 64;
  const int tid = my_tid();
  const float* w1 = p.in[9] + (size_t)l * 33 * 64; const float* b1 = p.in[10] + l * 64;
  const float* w2 = p.in[11] + (size_t)l * 64 * 64; const float* b2 = p.in[12] + l * 64;
  const float* w3 = p.in[13] + (size_t)l * 64 * 1024; const float* fr = p.in[14] + l * 64;
  const int nunits = Lf / 16;
  bool loaded = false;
  for (int u = blockIdx.x; u < nunits; u += gridDim.x) {
    __syncthreads();
    if (!loaded) {
      for (int i = tid; i < 33 * 64; i += NTHR) W1[i] = w1[i];
      for (int i = tid; i < 64 * 64; i += NTHR) W2[i] = w2[i];
      loaded = true;
    }
    const int t0 = u * 16;
    for (int i = tid; i < 16 * 33; i += NTHR) {
      int tt = i / 33, f = i % 33; int t = t0 + tt; float v;
      if (f == 0) v = (float)t / (float)(Lf - 1);
      else {
        int bi = (f - 1) & 15;
        float wv = 6.283185307179586f * (float)t / (float)Lf;
        float fb = 1e-4f + (15.f - 1e-4f) * (float)bi / 15.f;
        float ang = wv * fb;
        v = (f <= 16) ? cosf(ang) : -sinf(ang);
      }
      Z[tt * 36 + f] = v;
    }
    __syncthreads();
    for (int i = tid; i < 16 * 64; i += NTHR) {
      int tt = i >> 6, f = i & 63; float s = b1[f];
      for (int k = 0; k < 33; ++k) s += Z[tt * 36 + k] * W1[k * 64 + f];
      H1[tt * 64 + f] = sinf(fr[f] * s);
    }
    __syncthreads();
    for (int i = tid; i < 16 * 64; i += NTHR) {
      int tt = i >> 6, f = i & 63; float s = b2[f];
      for (int k = 0; k < 64; ++k) s += H1[tt * 64 + k] * W2[k * 64 + f];
      H2[tt * 64 + f] = sinf(fr[f] * s);
    }
    __syncthreads();
    float a0[16], a1[16];
#pragma unroll
    for (int i = 0; i < 16; ++i) { a0[i] = 0.f; a1[i] = 0.f; }
    for (int k = 0; k < 64; ++k) {
      float wa = w3[k * 1024 + tid], wb = w3[k * 1024 + 512 + tid];
#pragma unroll
      for (int i = 0; i < 16; ++i) { float h = H2[i * 64 + k]; a0[i] += h * wa; a1[i] += h * wb; }
    }
    {
      int w = tid & 255;
      float delta = fabsf(-3.0701134573253944f + (-15.350567286626972f + 3.0701134573253944f) * (float)w / 255.f);
#pragma unroll
      for (int i = 0; i < 16; ++i) {
        float tn = (float)(t0 + i) / (float)(Lf - 1);
        float dec = expf(-tn * delta);
        dst[(size_t)(t0 + i) * 1024 + tid] = a0[i] * dec;
        dst[(size_t)(t0 + i) * 1024 + 512 + tid] = a1[i] * dec;
      }
    }
  }
}

DI float2 cmul(float2 a, float2 b) { return make_float2(a.x * b.x - a.y * b.y, a.x * b.y + a.y * b.x); }
DI float2 cmulc(float2 a, float2 b) { return make_float2(a.x * b.x + a.y * b.y, a.y * b.x - a.x * b.y); }
DI float2 cadd(float2 a, float2 b) { return make_float2(a.x + b.x, a.y + b.y); }
DI float2 csub(float2 a, float2 b) { return make_float2(a.x - b.x, a.y - b.y); }
DI void fft_dif(float2* X, const float2* W) {
  const int tid = my_tid();
  for (int ls = 12; ls >= 2; ls -= 2) {
    const int s = 1 << ls, h = s >> 1;
    __syncthreads();
#pragma unroll
    for (int i = 0; i < 4; ++i) {
      const int bf = tid + i * 512; const int j = bf & (h - 1); const int base = ((bf >> (ls - 1)) << (ls + 1)) + j;
      const float2 x0 = X[base], x1 = X[base + h], x2 = X[base + s], x3 = X[base + s + h];
      const float2 w1 = W[s - 1 + j], w2 = W[h - 1 + j];
      const float2 y0 = cadd(x0, x2), y2 = cmul(csub(x0, x2), w1), y1 = cadd(x1, x3);
      const float2 t = cmul(csub(x1, x3), w1); const float2 y3 = make_float2(t.y, -t.x);
      X[base] = cadd(y0, y1); X[base + h] = cmul(csub(y0, y1), w2);
      X[base + s] = cadd(y2, y3); X[base + s + h] = cmul(csub(y2, y3), w2);
    }
  }
  __syncthreads();
#pragma unroll
  for (int i = 0; i < 4; ++i) {
    const int q = tid + i * 512;
    float4 a = *(float4*)(X + 4 * q), b = *(float4*)(X + 4 * q + 2);
    *(float4*)(X + 4 * q) = make_float4(a.x + a.z, a.y + a.w, a.x - a.z, a.y - a.w);
    *(float4*)(X + 4 * q + 2) = make_float4(b.x + b.z, b.y + b.w, b.x - b.z, b.y - b.w);
  }
  __syncthreads();
}
DI void fft_dit_inv(float2* X, const float2* W) {
  const int tid = my_tid();
  __syncthreads();
#pragma unroll
  for (int i = 0; i < 4; ++i) {
    const int q = tid + i * 512;
    float4 a = *(float4*)(X + 4 * q), b = *(float4*)(X + 4 * q + 2);
    *(float4*)(X + 4 * q) = make_float4(a.x + a.z, a.y + a.w, a.x - a.z, a.y - a.w);
    *(float4*)(X + 4 * q + 2) = make_float4(b.x + b.z, b.y + b.w, b.x - b.z, b.y - b.w);
  }
  for (int ls = 2; ls <= 12; ls += 2) {
    const int s = 1 << ls, h = s >> 1;
    __syncthreads();
#pragma unroll
    for (int i = 0; i < 4; ++i) {
      const int bf = tid + i * 512; const int j = bf & (h - 1); const int base = ((bf >> (ls - 1)) << (ls + 1)) + j;
      const float2 e0 = X[base], e1 = X[base + h], e2 = X[base + s], e3 = X[base + s + h];
      const float2 w1 = W[s - 1 + j], w2 = W[h - 1 + j];
      const float2 t1 = cmulc(e1, w2), t3 = cmulc(e3, w2);
      const float2 u0 = cadd(e0, t1), u1 = csub(e0, t1), u2 = cadd(e2, t3), u3 = csub(e2, t3);
      const float2 a2 = cmulc(u2, w1); const float2 q3 = cmulc(u3, w1); const float2 a3 = make_float2(-q3.y, q3.x);
      X[base] = cadd(u0, a2); X[base + s] = csub(u0, a2);
      X[base + h] = cadd(u1, a3); X[base + s + h] = csub(u1, a3);
    }
  }
  __syncthreads();
}
DI void load_twiddles(const Params& p, float2* W) {
  const float2* tw = (const float2*)(p.ws + MISC_TW);
  for (int i = my_tid(); i < 8191; i += NTHR) {
    const int ls = 31 - __clz(i + 1); const int pos = i + 1 - (1 << ls);
    W[i] = tw[pos << (12 - ls)];
  }
}

DI void ph_kf(const Params& p, int l, char* smem) {
  float2* X = (float2*)smem; float2* W = X + 8192; float* red = (float*)(W + 8192);
  const int tid = my_tid(), lane = tid & 63, wid = tid >> 6;
  const float* rawf = (const float*)(p.ws + R_RAWF);
  float2* kf = (float2*)(p.ws + OFF_KF);
  bool tw = false;
  for (int u = blockIdx.x; u < 256; u += gridDim.x) {
    if (!tw) { load_twiddles(p, W); tw = true; }
    const int o = u >> 7, c = (u & 127) * 2;
    float2 fw[8], bw[8]; float sa = 0.f, sb = 0.f;
#pragma unroll
    for (int i = 0; i < 8; ++i) {
      int t = tid + i * 512;
      fw[i] = *(const float2*)(rawf + (size_t)t * 1024 + o * 512 + c);
      bw[i] = *(const float2*)(rawf + (size_t)t * 1024 + o * 512 + 256 + c);
      sa += fabsf(fw[i].x) + fabsf(bw[i].x); sb += fabsf(fw[i].y) + fabsf(bw[i].y);
    }
    sa = wave_sum(sa); sb = wave_sum(sb);
    __syncthreads();
    if (lane == 0) { red[wid * 2] = sa; red[wid * 2 + 1] = sb; }
    __syncthreads();
    float ta = 0.f, tb = 0.f;
#pragma unroll
    for (int w = 0; w < 8; ++w) { ta += red[w * 2]; tb += red[w * 2 + 1]; }
    const float ia = 1.f / ta, ib = 1.f / tb;
#pragma unroll
    for (int i = 0; i < 8; ++i) {
      int t = tid + i * 512;
      X[t] = make_float2(fw[i].x * ia, fw[i].y * ib);
      if (t >= 1) X[8192 - t] = make_float2(bw[i].x * ia, bw[i].y * ib);
      else X[4096] = make_float2(0.f, 0.f);
    }
    fft_dif(X, W);
    float2* ka = kf + (size_t)(o * 256 + c) * 8192; float2* kb = ka + 8192;
#pragma unroll 4
    for (int i = 0; i < 16; ++i) {
      int pidx = tid + i * 512;
      int k = (int)(__brev((unsigned)pidx) >> 19);
      int k2 = (8192 - k) & 8191;
      int p2 = (int)(__brev((unsigned)k2) >> 19);
      float2 c1 = X[pidx], c2 = X[p2];
      float2 A = make_float2(0.5f * (c1.x + c2.x), 0.5f * (c1.y - c2.y));
      float2 Bv = make_float2(0.5f * (c1.y + c2.y), -0.5f * (c1.x - c2.x));
      ka[pidx] = A; kb[pidx] = Bv;
    }
    __syncthreads();
  }
  if (l == 0) {
    const float* rawc = (const float*)(p.ws + MISC_RAWC);
    float* G = (float*)(p.ws + MISC_GCTX);
    for (int u = blockIdx.x * 8 + wid; u < 512; u += gridDim.x * 8) {
      int o = u >> 8, c = u & 255; float f[4], b[4]; float s = 0.f;
#pragma unroll
      for (int i = 0; i < 4; ++i) {
        int t = lane + i * 64;
        f[i] = rawc[(size_t)t * 1024 + o * 512 + c]; b[i] = rawc[(size_t)t * 1024 + o * 512 + 256 + c];
        s += fabsf(f[i]) + fabsf(b[i]);
      }
      s = wave_sum(s); float inv = 1.f / s;
#pragma unroll
      for (int i = 0; i < 4; ++i) {
        int t = lane + i * 64;
        G[(size_t)u * 512 + 256 + t] = f[i] * inv;
        if (t >= 1) G[(size_t)u * 512 + 256 - t] = b[i] * inv;
      }
      if (lane == 0) G[(size_t)u * 512] = 0.f;
    }
  }
}

DI void ph_ln(const float* __restrict__ src_lat, const float* __restrict__ src_ctx, float* dst_lat, float* dst_ctx,
              const float* __restrict__ ag, const float* __restrict__ ab, bf16_t* U, const float* __restrict__ mod, int sh_off, int nrows) {
  const int lane = my_tid() & 63, wid = my_tid() >> 6;
  const int stride = gridDim.x * 8;
  float4 nv[4];
  {
    const int row = blockIdx.x * 8 + wid;
    if (row < nrows) {
      const float* src = row < ML ? src_lat + (size_t)row * D : src_ctx + (size_t)(row - ML) * D;
#pragma unroll
      for (int i = 0; i < 4; ++i) nv[i] = *(const float4*)(src + i * 256 + lane * 4);
    }
  }
  for (int row = blockIdx.x * 8 + wid; row < nrows; row += stride) {
    float4 v[4];
#pragma unroll
    for (int i = 0; i < 4; ++i) v[i] = nv[i];
    if (row + stride < nrows) {
      const int r2 = row + stride;
      const float* src2 = r2 < ML ? src_lat + (size_t)r2 * D : src_ctx + (size_t)(r2 - ML) * D;
#pragma unroll
      for (int i = 0; i < 4; ++i) nv[i] = *(const float4*)(src2 + i * 256 + lane * 4);
    }
    float s = 0.f;
#pragma unroll
    for (int i = 0; i < 4; ++i) s += v[i].x + v[i].y + v[i].z + v[i].w;
    float mu = wave_sum(s) * (1.f / 1024.f);
    float q = 0.f;
#pragma unroll
    for (int i = 0; i < 4; ++i) { v[i].x -= mu; v[i].y -= mu; v[i].z -= mu; v[i].w -= mu; q += v[i].x * v[i].x + v[i].y * v[i].y + v[i].z * v[i].z + v[i].w * v[i].w; }
    float rs = rsqrtf(wave_sum(q) * (1.f / 1024.f) + 1e-6f);
#pragma unroll
    for (int i = 0; i < 4; ++i) { v[i].x *= rs; v[i].y *= rs; v[i].z *= rs; v[i].w *= rs; }
    if (ag) {
      float* dst = row < ML ? dst_lat + (size_t)row * D : dst_ctx + (size_t)(row - ML) * D;
#pragma unroll
      for (int i = 0; i < 4; ++i) {
        float4 gg = *(const float4*)(ag + i * 256 + lane * 4), bb = *(const float4*)(ab + i * 256 + lane * 4);
        v[i].x = v[i].x * gg.x + bb.x; v[i].y = v[i].y * gg.y + bb.y; v[i].z = v[i].z * gg.z + bb.z; v[i].w = v[i].w * gg.w + bb.w;
        *(float4*)(dst + i * 256 + lane * 4) = v[i];
      }
      if (U) {
        s = 0.f;
#pragma unroll
        for (int i = 0; i < 4; ++i) s += v[i].x + v[i].y + v[i].z + v[i].w;
        mu = wave_sum(s) * (1.f / 1024.f); q = 0.f;
#pragma unroll
        for (int i = 0; i < 4; ++i) { v[i].x -= mu; v[i].y -= mu; v[i].z -= mu; v[i].w -= mu; q += v[i].x * v[i].x + v[i].y * v[i].y + v[i].z * v[i].z + v[i].w * v[i].w; }
        rs = rsqrtf(wave_sum(q) * (1.f / 1024.f) + 1e-6f);
#pragma unroll
        for (int i = 0; i < 4; ++i) { v[i].x *= rs; v[i].y *= rs; v[i].z *= rs; v[i].w *= rs; }
      }
    }
    if (U) {
      const float* m = mod + (size_t)mod_idx(row) * 6144 + sh_off;
#pragma unroll
      for (int i = 0; i < 4; ++i) {
        float4 sh = *(const float4*)(m + i * 256 + lane * 4), sc = *(const float4*)(m + 1024 + i * 256 + lane * 4);
        uint2 o; o.x = pack2(v[i].x * (1.f + sc.x) + sh.x, v[i].y * (1.f + sc.y) + sh.y);
        o.y = pack2(v[i].z * (1.f + sc.z) + sh.z, v[i].w * (1.f + sc.w) + sh.w);
        *(uint2*)(U + (size_t)row * D + i * 256 + lane * 4) = o;
      }
    }
  }
}

DI void ph_inproj(const Params& p, const bf16_t* U, char* smem) {
  const bf16_t* Bt = (const bf16_t*)(p.ws + WB_IN);
  const int lane = my_tid() & 63, wid = my_tid() >> 6, wm = wid >> 2, wn = wid & 3, g = lane >> 4, r16 = lane & 15;
  for (int it = 0;; ++it) {
    int mtile, ntile;
    if (!next_tile(it, 136, 13, mtile, ntile)) break;
    f32x4 acc[8][4]; zero_acc256(acc);
    gemm_glds256(acc, U, 1024, (long)mtile * 256, Bt + (size_t)ntile * 256 * 1024, 1024, 1024, smem);
    int b, key0;
    if (mtile < 128) { b = mtile >> 4; key0 = (mtile & 15) * 256; } else { b = mtile - 128; key0 = SL; }
    const int wc0 = ntile * 256 + wn * 64;
    bf16_t* tbase = nullptr; int tcols = 0, tcol0 = 0;
    if (wc0 < 768) { tbase = (bf16_t*)(p.ws + R_PHY); tcols = 768; tcol0 = wc0; }
    else if (wc0 >= 1152 && wc0 < 1280) { tbase = (bf16_t*)(p.ws + R_VTSW); tcols = 128; tcol0 = wc0 - 1152; }
    else if (wc0 >= 1792 && wc0 < 2048) { tbase = (bf16_t*)(p.ws + R_VTDF); tcols = 256; tcol0 = wc0 - 1792; }
    if (tbase) {
#pragma unroll
      for (int mt = 0; mt < 8; ++mt)
#pragma unroll
        for (int nt = 0; nt < 4; ++nt) {
          int col = tcol0 + r16 * 4 + nt;
          int key = key0 + wm * 128 + mt * 16 + g * 4;
          uint2 o; o.x = pack2(acc[mt][nt][0], acc[mt][nt][1]); o.y = pack2(acc[mt][nt][2], acc[mt][nt][3]);
          *(uint2*)(tbase + ((size_t)b * tcols + col) * KEYS + key) = o;
        }
    } else if (wc0 < 3264) {
      bf16_t* rb; int ld, c0;
      if (wc0 < 1152) { rb = (bf16_t*)(p.ws + R_PSW); ld = 384; c0 = wc0 - 768; }
      else if (wc0 < 1792) { rb = (bf16_t*)(p.ws + R_PDF); ld = 512; c0 = wc0 - 1280; }
      else { rb = (bf16_t*)(p.ws + R_PRW); ld = 1216; c0 = wc0 - 2048; }
      const int col = c0 + r16 * 4;
#pragma unroll
      for (int mt = 0; mt < 8; ++mt)
#pragma unroll
        for (int j = 0; j < 4; ++j) {
          size_t row = (size_t)mtile * 256 + wm * 128 + mt * 16 + g * 4 + j;
          uint2 o; o.x = pack2(acc[mt][0][j], acc[mt][1][j]); o.y = pack2(acc[mt][2][j], acc[mt][3][j]);
          *(uint2*)(rb + row * ld + col) = o;
        }
    }
  }
}

DI float hy_conv3(const bf16_t* __restrict__ P, int t, int len, float w0, float w1, float w2, float bias) {
  float a = t >= 1 ? bf2f(P[t - 1]) : 0.f, b = bf2f(P[t]), c = (t + 1 < len) ? bf2f(P[t + 1]) : 0.f;
  return w0 * a + w1 * b + w2 * c + bias;
}
DI void hy_conv8(const bf16_t* __restrict__ P, int tb, int len, float w0, float w1, float w2, float bias, float (&out)[8]) {
  const uint4 u = *(const uint4*)(P + tb);
  float x[10];
  x[0] = tb >= 1 ? bf2f(P[tb - 1]) : 0.f;
  x[1] = bflo(u.x); x[2] = bfhi(u.x); x[3] = bflo(u.y); x[4] = bfhi(u.y); x[5] = bflo(u.z); x[6] = bfhi(u.z); x[7] = bflo(u.w); x[8] = bfhi(u.w);
  x[9] = (tb + 8 < len) ? bf2f(P[tb + 8]) : 0.f;
#pragma unroll
  for (int i = 0; i < 8; ++i) out[i] = w0 * x[i] + w1 * x[i + 1] + w2 * x[i + 2] + bias;
}
DI void ph_hyena(const Params& p, int l, char* smem) {
  float2* X = (float2*)smem; float2* W = X + 8192;
  const int tid = my_tid();
  const int tb = tid * 8;
  const bf16_t* PT = (const bf16_t*)(p.ws + R_PHY);
  const float2* kf = (const float2*)(p.ws + OFF_KF);
  const float* cw = p.in[7] + (size_t)l * 3 * 768; const float* cb = p.in[8] + (size_t)l * 768;
  const float* hb = p.in[15] + (size_t)l * 512;
  bf16_t* Y = (bf16_t*)(p.ws + R_YHY);
  bool tw = false;
  for (int u = blockIdx.x; u < 1024; u += gridDim.x) {
    if (!tw) { load_twiddles(p, W); tw = true; }
    const int bp = u >> 8, c = u & 255; const int b0 = bp * 2, b1 = b0 + 1;
    const bf16_t* P0 = PT + ((size_t)b0 * 768) * KEYS; const bf16_t* P1 = PT + ((size_t)b1 * 768) * KEYS;
    const float bias0 = hb[c], bias1 = hb[256 + c];
    float va[8], vb[8];
    hy_conv8(P0 + (size_t)c * KEYS, tb, SL, cw[c], cw[768 + c], cw[1536 + c], cb[c], va);
    hy_conv8(P1 + (size_t)c * KEYS, tb, SL, cw[c], cw[768 + c], cw[1536 + c], cb[c], vb);
    __syncthreads();
#pragma unroll
    for (int i = 0; i < 8; ++i) { X[tb + i] = make_float2(va[i], vb[i]); X[tb + i + 4096] = make_float2(0.f, 0.f); }
    fft_dif(X, W);
    {
      const float2* H = kf + (size_t)c * 8192;
#pragma unroll 4
      for (int i = 0; i < 16; ++i) { int q = tid + i * 512; X[q] = cmul(X[q], H[q]); }
    }
    fft_dit_inv(X, W);
    float za[8], zb[8];
    {
      float xa[8], xb[8];
      hy_conv8(P0 + (size_t)(256 + c) * KEYS, tb, SL, cw[256 + c], cw[768 + 256 + c], cw[1536 + 256 + c], cb[256 + c], xa);
      hy_conv8(P1 + (size_t)(256 + c) * KEYS, tb, SL, cw[256 + c], cw[768 + 256 + c], cw[1536 + 256 + c], cb[256 + c], xb);
#pragma unroll
      for (int i = 0; i < 8; ++i) {
        const float2 y = X[tb + i];
        za[i] = xa[i] * (y.x * (1.f / 8192.f) + bias0 * va[i]);
        zb[i] = xb[i] * (y.y * (1.f / 8192.f) + bias0 * vb[i]);
      }
    }
    __syncthreads();
#pragma unroll
    for (int i = 0; i < 8; ++i) { X[tb + i] = make_float2(za[i], zb[i]); X[tb + i + 4096] = make_float2(0.f, 0.f); }
    fft_dif(X, W);
    {
      const float2* H = kf + (size_t)(256 + c) * 8192;
#pragma unroll 4
      for (int i = 0; i < 16; ++i) { int q = tid + i * 512; X[q] = cmul(X[q], H[q]); }
    }
    fft_dit_inv(X, W);
    {
      float xa[8], xb[8];
      hy_conv8(P0 + (size_t)(512 + c) * KEYS, tb, SL, cw[512 + c], cw[768 + 512 + c], cw[1536 + 512 + c], cb[512 + c], xa);
      hy_conv8(P1 + (size_t)(512 + c) * KEYS, tb, SL, cw[512 + c], cw[768 + 512 + c], cw[1536 + 512 + c], cb[512 + c], xb);
#pragma unroll
      for (int i = 0; i < 8; ++i) {
        const float2 y = X[tb + i];
        const float oa = xa[i] * (y.x * (1.f / 8192.f) + bias1 * za[i]);
        const float ob = xb[i] * (y.y * (1.f / 8192.f) + bias1 * zb[i]);
        Y[((size_t)b0 * SL + tb + i) * 256 + c] = (bf16_t)f2bf(oa);
        Y[((size_t)b1 * SL + tb + i) * 256 + c] = (bf16_t)f2bf(ob);
      }
    }
  }
}

DI void ph_hyena_ctx(const Params& p, int l, char* smem) {
  const int tid = my_tid(), lane = tid & 63, wid = tid >> 6;
  float* Zb = (float*)smem + wid * 1024;
  float* Gb = Zb + 256;
  const bf16_t* PT = (const bf16_t*)(p.ws + R_PHY);
  const float* G = (const float*)(p.ws + MISC_GCTX);
  const float* cw = p.in[7] + (size_t)l * 3 * 768; const float* cb = p.in[8] + (size_t)l * 768;
  const float* hb = p.in[15] + (size_t)l * 512;
  bf16_t* Y = (bf16_t*)(p.ws + R_YHY);
  for (int base = blockIdx.x * 8; base < 2048; base += gridDim.x * 8) {
    const int u = base + wid; const int b = u >> 8, c = u & 255;
    const bf16_t* Pb = PT + ((size_t)b * 768) * KEYS + SL;
    float v[4], x1[4], x2[4], zz[4];
#pragma unroll
    for (int i = 0; i < 4; ++i) {
      int t = lane + i * 64;
      v[i] = hy_conv3(Pb + (size_t)c * KEYS, t, CL, cw[c], cw[768 + c], cw[1536 + c], cb[c]);
      x1[i] = hy_conv3(Pb + (size_t)(256 + c) * KEYS, t, CL, cw[256 + c], cw[768 + 256 + c], cw[1536 + 256 + c], cb[256 + c]);
      x2[i] = hy_conv3(Pb + (size_t)(512 + c) * KEYS, t, CL, cw[512 + c], cw[768 + 512 + c], cw[1536 + 512 + c], cb[512 + c]);
    }
    __syncthreads();
#pragma unroll
    for (int i = 0; i < 4; ++i) Zb[lane + i * 64] = v[i];
    for (int i = lane; i < 512; i += 64) Gb[i] = G[(size_t)c * 512 + i];
    __syncthreads();
#pragma unroll
    for (int i = 0; i < 4; ++i) {
      int t = lane + i * 64; float s = 0.f;
      for (int s2 = 0; s2 < 256; ++s2) s += Gb[256 + t - s2] * Zb[s2];
      zz[i] = x1[i] * (s + hb[c] * v[i]);
    }
    __syncthreads();
#pragma unroll
    for (int i = 0; i < 4; ++i) Zb[lane + i * 64] = zz[i];
    for (int i = lane; i < 512; i += 64) Gb[i] = G[(size_t)(256 + c) * 512 + i];
    __syncthreads();
#pragma unroll
    for (int i = 0; i < 4; ++i) {
      int t = lane + i * 64; float s = 0.f;
      for (int s2 = 0; s2 < 256; ++s2) s += Gb[256 + t - s2] * Zb[s2];
      float o = x2[i] * (s + hb[256 + c] * zz[i]);
      Y[((size_t)ML + b * CL + t) * 256 + c] = (bf16_t)f2bf(o);
    }
  }
}

DI void ph_rope(const Params& p, char* smem) {
  float2* T16 = (float2*)smem;
  float2* T8 = T16 + 64 * 16;
  const int tid = my_tid(), lane = tid & 63, wid = tid >> 6;
  __syncthreads();
  for (int i = tid; i < 64 * 16; i += NTHR) {
    int pos = i >> 4, f = i & 15; float inv = powf(10000.f, -(float)f / 16.f); float s, c; sincosf((float)pos * inv, &s, &c);
    T16[i] = make_float2(c, s);
  }
  for (int i = tid; i < 64 * 8; i += NTHR) {
    int pos = i >> 3, f = i & 7; float inv = powf(10000.f, -(float)f / 8.f); float s, c; sincosf((float)pos * inv, &s, &c);
    T8[i] = make_float2(c, s);
  }
  __syncthreads();
  bf16_t* Psw = (bf16_t*)(p.ws + R_PSW); bf16_t* Pdf = (bf16_t*)(p.ws + R_PDF);
  bf16_t* rowbase_ptr; int e1, e2, nf, f0; bool hsel; bool active = lane < 56;
  if (lane < 24) { const int hd = lane >> 2, half = (lane >> 1) & 1, cp = lane & 1; e1 = hd * 64 + half * 32 + cp * 8; e2 = e1 + 16; nf = 16; f0 = cp * 8; hsel = half; }
  else { const int j = lane - 24; const int gi = j >> 1, half = j & 1; e1 = gi * 32 + half * 16; e2 = e1 + 8; nf = 8; f0 = 0; hsel = half; }
  const float2* Tb = (lane < 24) ? T16 : T8;
  for (int row = blockIdx.x * 8 + wid; row < ML; row += gridDim.x * 8) {
    if (active) {
      const int t = row & (SL - 1); const int pos = hsel ? (t & 63) : (t >> 6);
      rowbase_ptr = (lane < 24) ? Psw + (size_t)row * 384 : Pdf + (size_t)row * 512;
      const uint4 u1 = *(const uint4*)(rowbase_ptr + e1), u2 = *(const uint4*)(rowbase_ptr + e2);
      const float4* cs = (const float4*)(Tb + pos * nf + f0);
      const float4 c0 = cs[0], c1 = cs[1], c2 = cs[2], c3 = cs[3];
      const unsigned w1[4] = {u1.x, u1.y, u1.z, u1.w}, w2[4] = {u2.x, u2.y, u2.z, u2.w};
      const float4 cc[4] = {c0, c1, c2, c3};
      unsigned o1[4], o2[4];
#pragma unroll
      for (int i = 0; i < 4; ++i) {
        const float xa = bflo(w1[i]), xb = bfhi(w1[i]), ya = bflo(w2[i]), yb = bfhi(w2[i]);
        o1[i] = pack2(xa * cc[i].x - ya * cc[i].y, xb * cc[i].z - yb * cc[i].w);
        o2[i] = pack2(xa * cc[i].y + ya * cc[i].x, xb * cc[i].w + yb * cc[i].z);
      }
      *(uint4*)(rowbase_ptr + e1) = make_uint4(o1[0], o1[1], o1[2], o1[3]);
      *(uint4*)(rowbase_ptr + e2) = make_uint4(o2[0], o2[1], o2[2], o2[3]);
    }
  }
}

DI float rw_shift(const bf16_t* __restrict__ P, int row, int t, int len, int col, float mu) {
  float c = bf2f(P[(size_t)row * 1216 + col]);
  float a = t >= 1 ? bf2f(P[(size_t)(row - 1) * 1216 + col]) : 0.f;
  float b = t + 1 < len ? bf2f(P[(size_t)(row + 1) * 1216 + col]) : 0.f;
  return c + (0.5f * (a + b) - c) * mu;
}
DI void ph_rwprep(const Params& p, int l, char* smem) {
  constexpr int AST = 912, RST = 1552, ROFF = 32 * AST;
  const int tid = my_tid(), lane = tid & 63, wid = tid >> 6, g = lane >> 4, r16 = lane & 15;
  const int tg = wid >> 2, hd = wid & 3;
  const bf16_t* P = (const bf16_t*)(p.ws + R_PRW);
  const float* mu = p.in[17] + (size_t)l * 1216;
  const float* w0 = p.in[18] + (size_t)l * 512; const float* a0 = p.in[20] + (size_t)l * 256;
  const float* kkw = p.in[23] + (size_t)l * 256; const float* kaw = p.in[24] + (size_t)l * 256;
  bf16_t* S = (bf16_t*)(p.ws + R_STR); bf16_t* Gs = (bf16_t*)(p.ws + R_G);
  const size_t SU = (size_t)MT * 256;
  float w0f[4], w0b[4], a0c[4], kkc[4], kac[4];
#pragma unroll
  for (int nt = 0; nt < 4; ++nt) { int c = hd * 64 + r16 * 4 + nt; w0f[nt] = w0[c]; w0b[nt] = w0[256 + c]; a0c[nt] = a0[c]; kkc[nt] = kkw[c]; kac[nt] = kaw[c]; }
  for (int u = blockIdx.x; u < MT / 32; u += gridDim.x) {
    const int row0 = u * 32; int t0, len;
    if (row0 < ML) { t0 = row0 & (SL - 1); len = SL; } else { t0 = (row0 - ML) & (CL - 1); len = CL; }
    __syncthreads();
    for (int item = tid; item < 32 * 152; item += NTHR) {
      const int tk = item / 152, c8 = item - tk * 152; const int row = row0 + tk, t = t0 + tk;
      const uint4 uc = *(const uint4*)(P + (size_t)row * 1216 + c8 * 8);
      uint4 ua = make_uint4(0, 0, 0, 0), ub = make_uint4(0, 0, 0, 0);
      if (t >= 1) ua = *(const uint4*)(P + (size_t)(row - 1) * 1216 + c8 * 8);
      if (t + 1 < len) ub = *(const uint4*)(P + (size_t)(row + 1) * 1216 + c8 * 8);
      const float4 m0 = *(const float4*)(mu + c8 * 8), m1 = *(const float4*)(mu + c8 * 8 + 4);
      float o[8];
      {
        const unsigned wc[4] = {uc.x, uc.y, uc.z, uc.w}, wa[4] = {ua.x, ua.y, ua.z, ua.w}, wb[4] = {ub.x, ub.y, ub.z, ub.w};
        const float mm[8] = {m0.x, m0.y, m0.z, m0.w, m1.x, m1.y, m1.z, m1.w};
#pragma unroll
        for (int i = 0; i < 4; ++i) {
          float c_lo = bflo(wc[i]), c_hi = bfhi(wc[i]);
          o[2 * i] = c_lo + (0.5f * (bflo(wa[i]) + bflo(wb[i])) - c_lo) * mm[2 * i];
          o[2 * i + 1] = c_hi + (0.5f * (bfhi(wa[i]) + bfhi(wb[i])) - c_hi) * mm[2 * i + 1];
        }
      }
      char* dst;
      if (c8 < 96) dst = smem + ROFF + tk * RST + c8 * 16;
      else {
        const int cc = c8 * 8 - 768;
        if (cc < 128) {
#pragma unroll
          for (int i = 0; i < 8; ++i) o[i] = 1.f - 2.f * __builtin_amdgcn_rcpf(1.f + __expf(2.f * o[i]));
        } else if (cc >= 192) {
#pragma unroll
          for (int i = 0; i < 8; ++i) o[i] = sigmoidf_(o[i]);
        }
        dst = smem + tk * AST + cc * 2;
      }
      uint4 ov; ov.x = pack2(o[0], o[1]); ov.y = pack2(o[2], o[3]); ov.z = pack2(o[4], o[5]); ov.w = pack2(o[6], o[7]);
      *(uint4*)dst = ov;
    }
    __syncthreads();
    f32x4 acc[5][4];
#pragma unroll
    for (int o5 = 0; o5 < 5; ++o5)
#pragma unroll
      for (int nt = 0; nt < 4; ++nt) acc[o5][nt] = (f32x4){0.f, 0.f, 0.f, 0.f};
    const char* Arow = smem + (tg * 16 + r16) * AST + g * 16;
#pragma unroll
    for (int o5 = 0; o5 < 5; ++o5) {
      const int kbase = o5 < 3 ? o5 * 64 : (o5 == 3 ? 192 : 320);
      const int KK = o5 < 3 ? 64 : 128;
      const bf16_t* Wt = (const bf16_t*)(p.ws + (o5 == 0 ? RWW_F : o5 == 1 ? RWW_B : o5 == 2 ? RWW_A : o5 == 3 ? RWW_GF : RWW_GB));
#pragma unroll
      for (int ks = 0; ks < KK / 32; ++ks) {
        const bf16x8 af = *(const bf16x8*)(Arow + (kbase + ks * 32) * 2);
#pragma unroll
        for (int nt = 0; nt < 4; ++nt) {
          const bf16x8 bf = *(const bf16x8*)(Wt + (size_t)(hd * 64 + nt * 16 + r16) * KK + ks * 32 + g * 8);
          acc[o5][nt] = __builtin_amdgcn_mfma_f32_16x16x32_bf16(af, bf, acc[o5][nt], 0, 0, 0);
        }
        if ((ks & 3) == 3) asm volatile("" ::: "memory");
      }
    }
#pragma unroll
    for (int j = 0; j < 4; ++j) {
      const int tk = tg * 16 + g * 4 + j; const size_t row = (size_t)row0 + tk;
      const char* rk = smem + ROFF + tk * RST;
      const int c0 = hd * 64 + r16 * 4;
      const uint2 ur = *(const uint2*)(rk + c0 * 2), uk = *(const uint2*)(rk + (256 + c0) * 2), uv = *(const uint2*)(rk + (512 + c0) * 2);
      const float rv[4] = {bflo(ur.x), bfhi(ur.x), bflo(ur.y), bfhi(ur.y)};
      const float kv[4] = {bflo(uk.x), bfhi(uk.x), bflo(uk.y), bfhi(uk.y)};
      const float vv[4] = {bflo(uv.x), bfhi(uv.x), bflo(uv.y), bfhi(uv.y)};
      float n2 = 0.f;
#pragma unroll
      for (int nt = 0; nt < 4; ++nt) { float q = kv[nt] * kkc[nt]; n2 += q * q; }
      n2 = sum16(n2);
      const float inv = __builtin_amdgcn_rsqf(fmaxf(n2, 1e-24f));
      float o_kp[4], o_kk[4], o_b[4], o_df[4], o_db[4];
#pragma unroll
      for (int nt = 0; nt < 4; ++nt) {
        const float k = kv[nt];
        const float a = sigmoidf_(a0c[nt] + acc[2][nt][j]);
        const float kk = k * kkc[nt] * inv;
        o_kp[nt] = k * (1.f + (a - 1.f) * kac[nt]);
        o_kk[nt] = kk; o_b[nt] = kk * a;
        const float xf = -(w0f[nt] + acc[0][nt][j]); const float spf = fmaxf(xf, 0.f) + __logf(1.f + __expf(-fabsf(xf)));
        const float xb = -(w0b[nt] + acc[1][nt][j]); const float spb = fmaxf(xb, 0.f) + __logf(1.f + __expf(-fabsf(xb)));
        const float ef = __expf(-spf - 0.5f), eb = __expf(-spb - 0.5f);
        o_df[nt] = 1.f - __expf(-ef); o_db[nt] = 1.f - __expf(-eb);
      }
      const size_t o = row * 256 + c0;
      uint2 w;
      w.x = pack2(rv[0], rv[1]); w.y = pack2(rv[2], rv[3]); *(uint2*)(S + o) = w;
      w.x = pack2(o_kp[0], o_kp[1]); w.y = pack2(o_kp[2], o_kp[3]); *(uint2*)(S + SU + o) = w;
      w.x = pack2(vv[0], vv[1]); w.y = pack2(vv[2], vv[3]); *(uint2*)(S + 2 * SU + o) = w;
      w.x = pack2(o_kk[0], o_kk[1]); w.y = pack2(o_kk[2], o_kk[3]); *(uint2*)(S + 3 * SU + o) = w;
      w.x = pack2(o_b[0], o_b[1]); w.y = pack2(o_b[2], o_b[3]); *(uint2*)(S + 4 * SU + o) = w;
      w.x = pack2(o_df[0], o_df[1]); w.y = pack2(o_df[2], o_df[3]); *(uint2*)(S + 5 * SU + o) = w;
      w.x = pack2(o_db[0], o_db[1]); w.y = pack2(o_db[2], o_db[3]); *(uint2*)(S + 6 * SU + o) = w;
      w.x = pack2(acc[3][0][j], acc[3][1][j]); w.y = pack2(acc[3][2][j], acc[3][3][j]); *(uint2*)(Gs + o) = w;
      w.x = pack2(acc[4][0][j], acc[4][1][j]); w.y = pack2(acc[4][2][j], acc[4][3][j]); *(uint2*)(Gs + SU + o) = w;
    }
  }
}

DI long scan_row(int b, int dir, int s) {
  if (s < CL) return (long)ML + b * CL + (dir ? (CL - 1 - s) : s);
  int t = s - CL; return (long)b * SL + (dir ? (SL - 1 - t) : t);
}
DI float sum8(float v) {
  v += dpp_mov<0xB1>(v);
  v += dpp_mov<0x4E>(v);
  v += dpp_mov<0x141>(v);
  return v;
}
DI void ph_scan(const Params& p, char* smem) {
  const int tid = my_tid(), lane = tid & 63, wid = tid >> 6;
  const bf16_t* S = (const bf16_t*)(p.ws + R_STR);
  const size_t SU = (size_t)MT * 256;
  constexpr int T = 32, NSTEP = CL + SL, NCH = NSTEP / T;
  typedef float f32x2 __attribute__((ext_vector_type(2)));
  for (int u = blockIdx.x; u < 128; u += gridDim.x) {
    const int chain = u >> 1, rg = u & 1; const int dir = chain & 1, bh = chain >> 1, b = bh >> 2, h = bh & 3;
    bf16_t* O = (bf16_t*)(p.ws + (dir ? R_OB : R_OF));
    uint4 q0, q1, q2;
    auto SC_GLOAD = [&](int ci) {
#pragma unroll
      for (int j = 0; j < 3; ++j) {
        int idx = tid + j * 512; int st = idx >> 8, s = (idx & 255) >> 3, ck = idx & 7;
        long row = scan_row(b, dir, ci * T + s);
        int sid = st < 5 ? st : 5 + dir;
        uint4 v = *(const uint4*)(S + sid * SU + row * 256 + h * 64 + ck * 8);
        if (j == 0) q0 = v; else if (j == 1) q1 = v; else q2 = v;
      }
    };
    auto SC_SSTORE = [&](int buf) {
#pragma unroll
      for (int j = 0; j < 3; ++j) {
        int idx = tid + j * 512; int st = idx >> 8;
        uint4 v = j == 0 ? q0 : (j == 1 ? q1 : q2);
        float4 lo = make_float4(bflo(v.x), bfhi(v.x), bflo(v.y), bfhi(v.y));
        float4 hi = make_float4(bflo(v.z), bfhi(v.z), bflo(v.w), bfhi(v.w));
        if (st == 5) { lo.x = 1.f - lo.x; lo.y = 1.f - lo.y; lo.z = 1.f - lo.z; lo.w = 1.f - lo.w; hi.x = 1.f - hi.x; hi.y = 1.f - hi.y; hi.z = 1.f - hi.z; hi.w = 1.f - hi.w; }
        char* base = smem + buf * 49152 + idx * 32;
        *(float4*)(base) = lo; *(float4*)(base + 16) = hi;
      }
    };
    auto FLUSH = [&](int ci) {
      const int s = tid >> 4, part = tid & 15;
      const float2 v = *(const float2*)(smem + 98304 + (ci & 1) * 4096 + s * 128 + part * 8);
      long row = scan_row(b, dir, ci * T + s);
      *(unsigned*)(O + row * 256 + h * 64 + rg * 32 + part * 2) = pack2(v.x, v.y);
    };
    __syncthreads();
    SC_GLOAD(0);
    SC_SSTORE(0);
    __syncthreads();
    f32x2 st0 = {0.f, 0.f}, st1 = {0.f, 0.f}, st2 = {0.f, 0.f}, st3 = {0.f, 0.f};
    const int rsub = lane >> 3, ks = lane & 7;
    const int lrow = (wid & 3) * 8 + rsub;
    const int vrow = rg * 32 + lrow;
    struct Step { f32x2 r[4], k[4], kk[4], b[4], w[4]; float v; };
    auto LOADSTEP = [&](Step& x, const char* B, int s) {
#pragma unroll
      for (int hh = 0; hh < 2; ++hh) {
        const float4 r = *(const float4*)(B + (0 * T + s) * 256 + ks * 32 + hh * 16);
        const float4 k = *(const float4*)(B + (1 * T + s) * 256 + ks * 32 + hh * 16);
        const float4 kk = *(const float4*)(B + (3 * T + s) * 256 + ks * 32 + hh * 16);
        const float4 bb = *(const float4*)(B + (4 * T + s) * 256 + ks * 32 + hh * 16);
        const float4 w = *(const float4*)(B + (5 * T + s) * 256 + ks * 32 + hh * 16);
        x.r[2 * hh] = (f32x2){r.x, r.y}; x.r[2 * hh + 1] = (f32x2){r.z, r.w};
        x.k[2 * hh] = (f32x2){k.x, k.y}; x.k[2 * hh + 1] = (f32x2){k.z, k.w};
        x.kk[2 * hh] = (f32x2){kk.x, kk.y}; x.kk[2 * hh + 1] = (f32x2){kk.z, kk.w};
        x.b[2 * hh] = (f32x2){bb.x, bb.y}; x.b[2 * hh + 1] = (f32x2){bb.z, bb.w};
        x.w[2 * hh] = (f32x2){w.x, w.y}; x.w[2 * hh + 1] = (f32x2){w.z, w.w};
      }
      x.v = *(const float*)(B + (2 * T + s) * 256 + vrow * 4);
    };
    for (int ci = 0; ci < NCH; ++ci) {
      if (ci + 1 < NCH) { SC_GLOAD(ci + 1); }
      if (ci > 0) FLUSH(ci - 1);
      if (wid < 4) {
        const char* B = smem + (ci & 1) * 49152;
        float* ob = (float*)(smem + 98304 + (ci & 1) * 4096);
        Step nx; LOADSTEP(nx, B, 0);
#pragma unroll 4
        for (int s = 0; s < T; ++s) {
          const Step c = nx;
          LOADSTEP(nx, B, s + 1);
          f32x2 pa = st0 * c.kk[0] + st1 * c.kk[1];
          f32x2 pb = st2 * c.kk[2] + st3 * c.kk[3];
          pa = pa + pb;
          float sa = -(pa.x + pa.y);
          sa = sum8(sa);
          const f32x2 sa2 = {sa, sa}; const f32x2 v2 = {c.v, c.v};
          st0 = st0 * c.w[0] + sa2 * c.b[0] + v2 * c.k[0];
          st1 = st1 * c.w[1] + sa2 * c.b[1] + v2 * c.k[1];
          st2 = st2 * c.w[2] + sa2 * c.b[2] + v2 * c.k[2];
          st3 = st3 * c.w[3] + sa2 * c.b[3] + v2 * c.k[3];
          f32x2 oa = st0 * c.r[0] + st1 * c.r[1];
          f32x2 ob2 = st2 * c.r[2] + st3 * c.r[3];
          oa = oa + ob2;
          float o = sum8(oa.x + oa.y);
          ob[s * 32 + lrow] = o;
        }
      }
      if (ci + 1 < NCH) { SC_SSTORE((ci + 1) & 1); }
      __syncthreads();
    }
    FLUSH(NCH - 1);
  }
}

template <bool DIFF>
DI void attn_unit(const Params& p, int l, int b, int h, int qrow0, int qpos0, int kb_lo, int kb_hi, int kc_lo, char* smem) {
  const int tid = my_tid(), lane = tid & 63, wid = tid >> 6, g = lane >> 4, r16 = lane & 15;
  const bf16_t* QK = (const bf16_t*)(p.ws + (DIFF ? R_PDF : R_PSW));
  const int ldq = DIFF ? 512 : 384;
  const int qc0 = h * 64;
  const int kc0 = 256 + (DIFF ? h * 64 : (h >> 1) * 64);
  const bf16_t* VT = DIFF ? (const bf16_t*)(p.ws + R_VTDF) + ((size_t)b * 256 + h * 64) * KEYS
                          : (const bf16_t*)(p.ws + R_VTSW) + ((size_t)b * 128 + (h >> 1) * 64) * KEYS;
  const int nblk = (kb_hi - kb_lo) + (68 - kc_lo);
  const float sc = (DIFF ? 0.17677669529663687f : 0.125f) * 1.4426950408889634f;
  bf16x8 qf[2];
  {
    const bf16_t* qp = QK + (size_t)(qrow0 + wid * 16 + r16) * ldq + qc0 + g * 8;
    qf[0] = *(const bf16x8*)(qp); qf[1] = *(const bf16x8*)(qp + 32);
  }
  constexpr int NC = DIFF ? 2 : 1;
  float m[NC], lsum[NC];
  f32x4 O[NC][4];
#pragma unroll
  for (int c = 0; c < NC; ++c) {
    if (DIFF) { m[c] = -1e30f; lsum[c] = 0.f; }
    else { m[c] = p.in[16][l * 4 + h] * 1.4426950408889634f; lsum[c] = (g == 0) ? 1.f : 0.f; }
#pragma unroll
    for (int dt = 0; dt < 4; ++dt) O[c][dt] = (f32x4){0.f, 0.f, 0.f, 0.f};
  }
  const int lr = tid >> 3, lc = tid & 7;
  uint4 rkA, rvA, rkB, rvB;
  rkA = make_uint4(0, 0, 0, 0); rvA = rkA; rkB = rkA; rvB = rkA;
  auto AT_GLOAD = [&](int i, uint4& rk, uint4& rv) {
    int kb = i < (kb_hi - kb_lo) ? kb_lo + i : kc_lo + (i - (kb_hi - kb_lo));
    long krow = kb < 64 ? (long)b * SL + kb * 64 + lr : (long)ML + b * CL + (kb - 64) * 64 + lr;
    rk = *(const uint4*)(QK + krow * ldq + kc0 + lc * 8);
    rv = *(const uint4*)(VT + (size_t)lr * KEYS + kb * 64 + lc * 8);
  };
  auto AT_SSTORE = [&](int buf, const uint4& rk, const uint4& rv) {
    *(uint4*)(smem + buf * 18432 + lr * 128 + ((lc ^ (lr & 7)) << 4)) = rk;
    *(uint4*)(smem + buf * 18432 + 9216 + lr * 144 + lc * 16) = rv;
  };
  __syncthreads();
  AT_GLOAD(0, rkA, rvA);
  AT_SSTORE(0, rkA, rvA);
  if (1 < nblk) AT_GLOAD(1, rkA, rvA);
  if (2 < nblk) AT_GLOAD(2, rkB, rvB);
  lds_barrier();
  const int qpos = qpos0 + wid * 16 + r16;
  for (int i = 0; i < nblk; ++i) {
    const int kb = i < (kb_hi - kb_lo) ? kb_lo + i : kc_lo + (i - (kb_hi - kb_lo));
    const bool masked = (!DIFF) && (kb < 64);
    const char* Kt = smem + (i & 1) * 18432; const char* Vt = Kt + 9216;
    f32x4 S[NC][4];
#pragma unroll
    for (int kt = 0; kt < 4; ++kt) {
      bf16x8 k0 = *(const bf16x8*)(Kt + (kt * 16 + r16) * 128 + ((g ^ (r16 & 7)) << 4));
      bf16x8 k1 = *(const bf16x8*)(Kt + (kt * 16 + r16) * 128 + (((4 + g) ^ (r16 & 7)) << 4));
      if (DIFF) {
        S[0][kt] = __builtin_amdgcn_mfma_f32_16x16x32_bf16(k0, qf[0], (f32x4){0.f, 0.f, 0.f, 0.f}, 0, 0, 0);
        S[NC - 1][kt] = __builtin_amdgcn_mfma_f32_16x16x32_bf16(k1, qf[1], (f32x4){0.f, 0.f, 0.f, 0.f}, 0, 0, 0);
      } else {
        f32x4 t = __builtin_amdgcn_mfma_f32_16x16x32_bf16(k0, qf[0], (f32x4){0.f, 0.f, 0.f, 0.f}, 0, 0, 0);
        S[0][kt] = __builtin_amdgcn_mfma_f32_16x16x32_bf16(k1, qf[1], t, 0, 0, 0);
      }
    }
    bf16x8 pf[NC][2];
#pragma unroll
    for (int c = 0; c < NC; ++c) {
      float mx = -1e30f;
#pragma unroll
      for (int kt = 0; kt < 4; ++kt)
#pragma unroll
        for (int j = 0; j < 4; ++j) {
          float v = S[c][kt][j];
          if (masked) { int kpos = kb * 64 + kt * 16 + g * 4 + j; int dd = kpos - qpos; if (dd > 128 || dd < -128) v = -3e38f; S[c][kt][j] = v; }
          mx = fmaxf(mx, v);
        }
      mx *= sc;
      mx = fmaxf(mx, __shfl_xor(mx, 16)); mx = fmaxf(mx, __shfl_xor(mx, 32));
      const float mn = fmaxf(m[c], mx);
      const bool grow = mn > m[c];
      float ps = 0.f;
      unsigned pk[8];
#pragma unroll
      for (int kt = 0; kt < 4; ++kt) {
        float e0 = __builtin_amdgcn_exp2f(fmaf(S[c][kt][0], sc, -mn)), e1 = __builtin_amdgcn_exp2f(fmaf(S[c][kt][1], sc, -mn));
        float e2 = __builtin_amdgcn_exp2f(fmaf(S[c][kt][2], sc, -mn)), e3 = __builtin_amdgcn_exp2f(fmaf(S[c][kt][3], sc, -mn));
        ps += (e0 + e1) + (e2 + e3);
        pk[kt * 2] = pack2(e0, e1); pk[kt * 2 + 1] = pack2(e2, e3);
      }
      if (__builtin_amdgcn_ballot_w64(grow) != 0ull) {
        const float alpha = __builtin_amdgcn_exp2f(m[c] - mn);
        m[c] = mn;
        lsum[c] *= alpha;
#pragma unroll
        for (int dt = 0; dt < 4; ++dt) { O[c][dt][0] *= alpha; O[c][dt][1] *= alpha; O[c][dt][2] *= alpha; O[c][dt][3] *= alpha; }
      }
      lsum[c] += ps;
      union { unsigned u[4]; bf16x8 v; } cv;
      cv.u[0] = pk[0]; cv.u[1] = pk[1]; cv.u[2] = pk[2]; cv.u[3] = pk[3]; pf[c][0] = cv.v;
      cv.u[0] = pk[4]; cv.u[1] = pk[5]; cv.u[2] = pk[6]; cv.u[3] = pk[7]; pf[c][1] = cv.v;
    }
#pragma unroll
    for (int dt = 0; dt < 4; ++dt)
#pragma unroll
      for (int s2 = 0; s2 < 2; ++s2) {
        union { uint2 u[2]; bf16x8 v; } vf;
        vf.u[0] = *(const uint2*)(Vt + (dt * 16 + r16) * 144 + (2 * s2) * 32 + g * 8);
        vf.u[1] = *(const uint2*)(Vt + (dt * 16 + r16) * 144 + (2 * s2 + 1) * 32 + g * 8);
#pragma unroll
        for (int c = 0; c < NC; ++c) O[c][dt] = __builtin_amdgcn_mfma_f32_16x16x32_bf16(vf.v, pf[c][s2], O[c][dt], 0, 0, 0);
      }
    if (i + 1 < nblk) AT_SSTORE((i + 1) & 1, rkA, rvA);
    rkA = rkB; rvA = rvB;
    if (i + 3 < nblk) AT_GLOAD(i + 3, rkB, rvB);
    lds_barrier();
  }
  float linv[NC];
#pragma unroll
  for (int c = 0; c < NC; ++c) { float t = lsum[c]; t += __shfl_xor(t, 16); t += __shfl_xor(t, 32); linv[c] = 1.f / t; }
  const size_t orow = (size_t)(qrow0 + wid * 16 + r16);
  if (!DIFF) {
    bf16_t* Y = (bf16_t*)(p.ws + R_YSW);
#pragma unroll
    for (int dt = 0; dt < 4; ++dt) {
      uint2 o; o.x = pack2(O[0][dt][0] * linv[0], O[0][dt][1] * linv[0]); o.y = pack2(O[0][dt][2] * linv[0], O[0][dt][3] * linv[0]);
      *(uint2*)(Y + orow * 256 + h * 64 + dt * 16 + g * 4) = o;
    }
  } else {
    const float lam_init = 0.8f - 0.6f * __expf(-0.3f * (float)l);
    float d1 = 0.f, d2 = 0.f;
    if (lane < 32) { d1 = p.in[28][l * 32 + lane] * p.in[29][l * 32 + lane]; d2 = p.in[30][l * 32 + lane] * p.in[31][l * 32 + lane]; }
    d1 = wave_sum(d1); d2 = wave_sum(d2);
    const float lam = expf(d1) - expf(d2) + lam_init;
    float ov[4][4]; float ss = 0.f;
#pragma unroll
    for (int dt = 0; dt < 4; ++dt)
#pragma unroll
      for (int j = 0; j < 4; ++j) { float v = O[0][dt][j] * linv[0] - lam * O[NC - 1][dt][j] * linv[NC - 1]; ov[dt][j] = v; ss += v * v; }
    ss += __shfl_xor(ss, 16); ss += __shfl_xor(ss, 32);
    const float rms = rsqrtf(ss * (1.f / 64.f) + 1e-5f) * (1.f - lam_init);
    const float* sg = p.in[32] + l * 64;
    bf16_t* Y = (bf16_t*)(p.ws + R_YDF);
#pragma unroll
    for (int dt = 0; dt < 4; ++dt) {
      const int d0 = dt * 16 + g * 4;
      uint2 o; o.x = pack2(ov[dt][0] * rms * sg[d0], ov[dt][1] * rms * sg[d0 + 1]); o.y = pack2(ov[dt][2] * rms * sg[d0 + 2], ov[dt][3] * rms * sg[d0 + 3]);
      *(uint2*)(Y + orow * 256 + h * 64 + d0) = o;
    }
  }
}

DI void ph_attn(const Params& p, int l, char* smem) {
  const bool need_ctx = (l == 0);
  const int n_sw = 1024 + (need_ctx ? 64 : 0);
  const int n_df = 1024 + (need_ctx ? 64 : 0);
  unsigned* ctr = (unsigned*)(p.ws + MISC_BAR + 64 + 64 * l);
  volatile int* slot = (volatile int*)(smem + 40960);
  for (;;) {
    __syncthreads();
    if (my_tid() == 0) *slot = (int)__hip_atomic_fetch_add(ctr, 1u, __ATOMIC_RELAXED, __HIP_MEMORY_SCOPE_AGENT);
    __syncthreads();
    const int u = *slot;
    if (u >= n_sw + n_df) break;
    if (u < n_df) {
      if (u < 1024) { int b = u >> 7, h = (u >> 5) & 3, n = u & 31; attn_unit<true>(p, l, b, h, b * SL + n * 128, n * 128, 0, 64, 64, smem); }
      else { int v = u - 1024; int b = v >> 3, h = (v >> 1) & 3, n = v & 1; attn_unit<true>(p, l, b, h, ML + b * CL + n * 128, 0, 0, 0, 64, smem); }
    } else {
      int w = u - n_df;
      if (w < 1024) {
        int b = w >> 7, h = (w >> 5) & 3, n = w & 31;
        int lo = (n - 1) * 2; if (lo < 0) lo = 0; int hi = (n + 2) * 2; if (hi > 64) hi = 64;
        attn_unit<false>(p, l, b, h, b * SL + n * 128, n * 128, lo, hi, 64, smem);
      } else { int v = w - 1024; int b = v >> 3, h = (v >> 1) & 3, n = v & 1; attn_unit<false>(p, l, b, h, ML + b * CL + n * 128, 0, 0, 0, 64, smem); }
    }
  }
}

DI void ph_rwout(const Params& p, int l) {
  const int lane = my_tid() & 63, wid = my_tid() >> 6;
  const bf16_t* S = (const bf16_t*)(p.ws + R_STR); const bf16_t* Gs = (const bf16_t*)(p.ws + R_G);
  const bf16_t* OF = (const bf16_t*)(p.ws + R_OF); const bf16_t* OB = (const bf16_t*)(p.ws + R_OB);
  bf16_t* Y = (bf16_t*)(p.ws + R_YRW);
  const size_t SU = (size_t)MT * 256;
  const float4 rk = *(const float4*)(p.in[25] + (size_t)l * 256 + lane * 4);
  const float4 gam = *(const float4*)(p.in[26] + (size_t)l * 256 + lane * 4);
  const float4 bet = *(const float4*)(p.in[27] + (size_t)l * 256 + lane * 4);
  const int nrows = (l == 0) ? MT : ML;
  for (int row = blockIdx.x * 8 + wid; row < nrows; row += gridDim.x * 8) {
    const size_t o = (size_t)row * 256 + lane * 4;
    uint2 ur = *(const uint2*)(S + o), uk = *(const uint2*)(S + SU + o), uv = *(const uint2*)(S + 2 * SU + o);
    uint2 uf = *(const uint2*)(OF + o), ub = *(const uint2*)(OB + o), ugf = *(const uint2*)(Gs + o), ugb = *(const uint2*)(Gs + SU + o);
    float r[4] = {bflo(ur.x), bfhi(ur.x), bflo(ur.y), bfhi(ur.y)};
    float k[4] = {bflo(uk.x), bfhi(uk.x), bflo(uk.y), bfhi(uk.y)};
    float v[4] = {bflo(uv.x), bfhi(uv.x), bflo(uv.y), bfhi(uv.y)};
    float f[4] = {bflo(uf.x), bfhi(uf.x), bflo(uf.y), bfhi(uf.y)};
    float bb[4] = {bflo(ub.x), bfhi(ub.x), bflo(ub.y), bfhi(ub.y)};
    float gf[4] = {bflo(ugf.x), bfhi(ugf.x), bflo(ugf.y), bfhi(ugf.y)};
    float gb[4] = {bflo(ugb.x), bfhi(ugb.x), bflo(ugb.y), bfhi(ugb.y)};
    const float rkv[4] = {rk.x, rk.y, rk.z, rk.w}; const float ga[4] = {gam.x, gam.y, gam.z, gam.w}; const float be[4] = {bet.x, bet.y, bet.z, bet.w};
    float bon = 0.f, sf = 0.f, sb = 0.f;
#pragma unroll
    for (int i = 0; i < 4; ++i) { bon += r[i] * k[i] * rkv[i]; sf += f[i]; sb += bb[i]; }
    bon = sum16(bon); float muf = sum16(sf) * (1.f / 64.f), mub = sum16(sb) * (1.f / 64.f);
    float qf = 0.f, qb = 0.f;
#pragma unroll
    for (int i = 0; i < 4; ++i) { f[i] -= muf; bb[i] -= mub; qf += f[i] * f[i]; qb += bb[i] * bb[i]; }
    float rsf = rsqrtf(sum16(qf) * (1.f / 64.f) + 64e-5f), rsb = rsqrtf(sum16(qb) * (1.f / 64.f) + 64e-5f);
    float y[4];
#pragma unroll
    for (int i = 0; i < 4; ++i) {
      float bn = bon * v[i];
      y[i] = (f[i] * rsf * ga[i] + be[i] + bn) * gf[i] + (bb[i] * rsb * ga[i] + be[i] + bn) * gb[i];
    }
    uint2 oo; oo.x = pack2(y[0], y[1]); oo.y = pack2(y[2], y[3]);
    *(uint2*)(Y + o) = oo;
  }
}

DI void ph_merge(const Params& p, int l, const bf16_t* U, char* smem) {
  const int lane = my_tid() & 63, wid = my_tid() >> 6, wm = wid >> 1, wn = wid & 1, g = lane >> 4, r16 = lane & 15;
  const int mtiles = (l == 0) ? 136 : 128;
  bf16_t* ACC = (bf16_t*)(p.ws + R_ACC);
  for (int it = 0;; ++it) {
    int mtile, ntile;
    if (!next_tile(it, mtiles, 8, mtile, ntile)) break;
    uint2 accS[4][4];
#pragma unroll
    for (int mt = 0; mt < 4; ++mt)
#pragma unroll
      for (int nt = 0; nt < 4; ++nt) accS[mt][nt] = make_uint2(0u, 0u);
    for (int j = 0; j < 4; ++j) {
      uint2 pb[4][4];
      {
        f32x4 accB[4][4]; zero_acc<4>(accB);
        const size_t yoff = (j == 0) ? R_YHY : (j == 1) ? R_YSW : (j == 2) ? R_YRW : R_YDF;
        gemm_glds(accB, (const bf16_t*)(p.ws + yoff), 256, RowPlain{(long)mtile * 256}, (const bf16_t*)(p.ws + WB_BR) + ((size_t)j * 1024 + ntile * 128) * 256, 256, 256, smem, (const bf16_t*)(p.ws + MISC_ZERO));
#pragma unroll
        for (int mt = 0; mt < 4; ++mt)
#pragma unroll
          for (int nt = 0; nt < 4; ++nt) { pb[mt][nt].x = pack2(accB[mt][nt][0], accB[mt][nt][1]); pb[mt][nt].y = pack2(accB[mt][nt][2], accB[mt][nt][3]); }
      }
      f32x4 accG[4][4]; zero_acc<4>(accG);
      gemm_glds(accG, U, 1024, RowPlain{(long)mtile * 256}, (const bf16_t*)(p.ws + WB_GATE) + ((size_t)j * 1024 + ntile * 128) * 1024, 1024, 1024, smem, (const bf16_t*)(p.ws + MISC_ZERO));
#pragma unroll
      for (int mt = 0; mt < 4; ++mt)
#pragma unroll
        for (int nt = 0; nt < 4; ++nt) {
          float v0 = bflo(accS[mt][nt].x) + sigmoidf_(accG[mt][nt][0]) * bflo(pb[mt][nt].x);
          float v1 = bfhi(accS[mt][nt].x) + sigmoidf_(accG[mt][nt][1]) * bfhi(pb[mt][nt].x);
          float v2 = bflo(accS[mt][nt].y) + sigmoidf_(accG[mt][nt][2]) * bflo(pb[mt][nt].y);
          float v3 = bfhi(accS[mt][nt].y) + sigmoidf_(accG[mt][nt][3]) * bfhi(pb[mt][nt].y);
          accS[mt][nt].x = pack2(v0, v1); accS[mt][nt].y = pack2(v2, v3);
        }
    }
#pragma unroll
    for (int mt = 0; mt < 4; ++mt) {
      const int col = ntile * 128 + wn * 64 + r16 * 4;
      const size_t row = (size_t)mtile * 256 + wm * 64 + mt * 16 + g * 4;
      uint2 o;
      o.x = (accS[mt][0].x & 0xffffu) | (accS[mt][1].x << 16); o.y = (accS[mt][2].x & 0xffffu) | (accS[mt][3].x << 16);
      *(uint2*)(ACC + (row + 0) * 1024 + col) = o;
      o.x = (accS[mt][0].x >> 16) | (accS[mt][1].x & 0xffff0000u); o.y = (accS[mt][2].x >> 16) | (accS[mt][3].x & 0xffff0000u);
      *(uint2*)(ACC + (row + 1) * 1024 + col) = o;
      o.x = (accS[mt][0].y & 0xffffu) | (accS[mt][1].y << 16); o.y = (accS[mt][2].y & 0xffffu) | (accS[mt][3].y << 16);
      *(uint2*)(ACC + (row + 2) * 1024 + col) = o;
      o.x = (accS[mt][0].y >> 16) | (accS[mt][1].y & 0xffff0000u); o.y = (accS[mt][2].y >> 16) | (accS[mt][3].y & 0xffff0000u);
      *(uint2*)(ACC + (row + 3) * 1024 + col) = o;
    }
  }
}

DI void ph_resgemm(const Params& p, int l, const bf16_t* A, int K, const bf16_t* Bt, const float* hsrc_lat, const float* hsrc_ctx, int gate_off, char* smem) {
  const int lane = my_tid() & 63, wid = my_tid() >> 6, wm = wid >> 1, wn = wid & 1, g = lane >> 4, r16 = lane & 15;
  const int mtiles = (l == 0) ? 136 : 128;
  const float* mod = (const float*)(p.ws + MISC_MOD) + (size_t)l * 9 * 6144;
  float* hc = (float*)(p.ws + OFF_HC);
  for (int it = 0;; ++it) {
    int mtile, ntile;
    if (!next_tile(it, mtiles, 8, mtile, ntile)) break;
    f32x4 acc[4][4]; zero_acc<4>(acc);
    gemm_glds(acc, A, K, RowPlain{(long)mtile * 256}, Bt + (size_t)ntile * 128 * K, K, K, smem, (const bf16_t*)(p.ws + MISC_ZERO));
    const int b = mtile < 128 ? (mtile >> 4) : 8;
    const float* gt = mod + (size_t)b * 6144 + gate_off;
    const int col = ntile * 128 + wn * 64 + r16 * 4;
    const float4 gv = *(const float4*)(gt + col);
#pragma unroll
    for (int mt = 0; mt < 4; ++mt)
#pragma unroll
      for (int e = 0; e < 4; ++e) {
        const int row = mtile * 256 + wm * 64 + mt * 16 + g * 4 + e;
        const float* hs; float* hd;
        if (row < ML) { size_t o = (size_t)row * D + col; hs = hsrc_lat + o; hd = p.out + o; }
        else { size_t o = (size_t)(row - ML) * D + col; hs = hsrc_ctx + o; hd = hc + o; }
        const float4 h = *(const float4*)hs;
        float4 r;
        r.x = DN_ALPHA * h.x + gv.x * acc[mt][0][e]; r.y = DN_ALPHA * h.y + gv.y * acc[mt][1][e];
        r.z = DN_ALPHA * h.z + gv.z * acc[mt][2][e]; r.w = DN_ALPHA * h.w + gv.w * acc[mt][3][e];
        *(float4*)hd = r;
      }
  }
}

DI void ph_ffnup(const Params& p, int l, char* smem) {
  const bf16_t* U = (const bf16_t*)(p.ws + R_U);
  const bf16_t* Bt = (const bf16_t*)(p.ws + WB_UP);
  bf16_t* HID = (bf16_t*)(p.ws + R_HID);
  const float* cw = p.in[38] + (size_t)l * 3 * 5632; const float* cb = p.in[39] + (size_t)l * 5632;
  const int tid = my_tid(), lane = tid & 63, wid = tid >> 6, wm = wid >> 2, wn = wid & 3, g = lane >> 4, r16 = lane & 15;
  const int mtiles = (l == 0) ? 144 : 136;
  constexpr int TS = 528;
  for (int it = 0;; ++it) {
    int mtile, ntile;
    if (!next_tile(it, mtiles, 22, mtile, ntile)) break;
    long rowbase; int t0, len, r0, r1;
    if (mtile < 136) { int b = mtile / 17; int tt = mtile % 17; len = SL; rowbase = (long)b * SL; t0 = tt * 254 - 1; r0 = 1; r1 = 254; }
    else { int b = mtile - 136; len = CL; rowbase = (long)ML + b * CL; t0 = 0; r0 = 0; r1 = 255; }
    f32x4 acc[8][4]; zero_acc256(acc);
    gemm_glds256(acc, U, 1024, rowbase + t0, Bt + (size_t)ntile * 256 * 1024, 1024, 1024, smem);
#pragma unroll
    for (int mt = 0; mt < 8; ++mt)
#pragma unroll
      for (int e = 0; e < 4; ++e) {
        uint2 o; o.x = pack2(acc[mt][0][e], acc[mt][1][e]); o.y = pack2(acc[mt][2][e], acc[mt][3][e]);
        *(uint2*)(smem + (wm * 128 + mt * 16 + g * 4 + e) * TS + (wn * 64 + r16 * 4) * 2) = o;
      }
    __syncthreads();
    {
      const int ch = (tid & 31) * 4, rgp = tid >> 5; const int ca = ntile * 128 + ch, cbx = 2816 + ca;
      const float4 wa0 = *(const float4*)(cw + ca), wa1 = *(const float4*)(cw + 5632 + ca), wa2 = *(const float4*)(cw + 2 * 5632 + ca), wab = *(const float4*)(cb + ca);
      const float4 wb0 = *(const float4*)(cw + cbx), wb1 = *(const float4*)(cw + 5632 + cbx), wb2 = *(const float4*)(cw + 2 * 5632 + cbx), wbb = *(const float4*)(cb + cbx);
      for (int r = r0 + rgp; r <= r1; r += 16) {
        const int tok = t0 + r;
        if (tok < len) {
          const char* Tr = smem + r * TS + ch * 2;
          const uint2 z2 = make_uint2(0u, 0u);
          const uint2 ua = *(const uint2*)(Tr), ub = *(const uint2*)(Tr + 256);
          const uint2 pa = tok >= 1 ? *(const uint2*)(Tr - TS) : z2, pb_ = tok >= 1 ? *(const uint2*)(Tr - TS + 256) : z2;
          const uint2 na = tok + 1 < len ? *(const uint2*)(Tr + TS) : z2, nb = tok + 1 < len ? *(const uint2*)(Tr + TS + 256) : z2;
          const float av0 = wa0.x * bflo(pa.x) + wa1.x * bflo(ua.x) + wa2.x * bflo(na.x) + wab.x;
          const float av1 = wa0.y * bfhi(pa.x) + wa1.y * bfhi(ua.x) + wa2.y * bfhi(na.x) + wab.y;
          const float av2 = wa0.z * bflo(pa.y) + wa1.z * bflo(ua.y) + wa2.z * bflo(na.y) + wab.z;
          const float av3 = wa0.w * bfhi(pa.y) + wa1.w * bfhi(ua.y) + wa2.w * bfhi(na.y) + wab.w;
          const float bv0 = wb0.x * bflo(pb_.x) + wb1.x * bflo(ub.x) + wb2.x * bflo(nb.x) + wbb.x;
          const float bv1 = wb0.y * bfhi(pb_.x) + wb1.y * bfhi(ub.x) + wb2.y * bfhi(nb.x) + wbb.y;
          const float bv2 = wb0.z * bflo(pb_.y) + wb1.z * bflo(ub.y) + wb2.z * bflo(nb.y) + wbb.z;
          const float bv3 = wb0.w * bfhi(pb_.y) + wb1.w * bfhi(ub.y) + wb2.w * bfhi(nb.y) + wbb.w;
          uint2 o; o.x = pack2(siluf_(av0) * bv0, siluf_(av1) * bv1); o.y = pack2(siluf_(av2) * bv2, siluf_(av3) * bv3);
          *(uint2*)(HID + (size_t)(rowbase + tok) * 2816 + ca) = o;
        }
      }
    }
  }
}

#ifndef REP_PREP
#define REP_PREP 1
#endif
#ifndef REP_GEMM
#define REP_GEMM 1
#endif
#ifndef REP_HY
#define REP_HY 1
#endif
#ifndef REP_RWP
#define REP_RWP 1
#endif
#ifndef REP_SCAN
#define REP_SCAN 1
#endif
#ifndef REP_ATTN
#define REP_ATTN 1
#endif
#ifndef PH_END
#define PH_END 24
#endif
#define XB_TMO      128
#define XB_XCNT(j)  (256  + 64 * (j))
#define XB_XSUB(j)  (1280 + 64 * (j))
#define XB_XGEN(j)  (2304 + 64 * (j))
#define XB_TOP      3328
#define XB_TOPGEN   3392
#define XCD_BAR_WORDS 3456
#define XB_SPIN_CAP (1u << 22)
DI unsigned xb_ld(unsigned* p) { return __hip_atomic_load(p, __ATOMIC_RELAXED, __HIP_MEMORY_SCOPE_AGENT); }
DI unsigned xb_add(unsigned* p, unsigned v) { return __hip_atomic_fetch_add(p, v, __ATOMIC_RELAXED, __HIP_MEMORY_SCOPE_AGENT); }
DI unsigned xb_xcc_id() { return (unsigned)__builtin_amdgcn_s_getreg((3 << 11) | 20) & 0xFu; }
#define XB_SPIN(cond, bar) do { unsigned _sp = 0; while (cond) { __builtin_amdgcn_s_sleep(1); \
    if ((++_sp & 255u) == 0u) { if (xb_ld(&(bar)[XB_TMO])) break; if (_sp > XB_SPIN_CAP) { atomicAdd(&(bar)[XB_TMO], 1u); break; } } } } while (0)
DI void xcd_barrier_complete(unsigned* bar, unsigned x, unsigned& nloc, unsigned& nx) {
  const unsigned G = gridDim.x;
  unsigned sum, cnt, mine, sp = 0u;
  for (;;) {
    sum = 0u; cnt = 0u; mine = 0u;
#pragma unroll
    for (unsigned j = 0; j < 16; ++j) { const unsigned c = xb_ld(&bar[XB_XCNT(j)]); sum += c; cnt += (c > 0u) ? 1u : 0u; mine = (j == x) ? c : mine; }
    if (sum == G) break;
    __builtin_amdgcn_s_sleep(1);
    if ((++sp & 255u) == 0u) { if (xb_ld(&bar[XB_TMO])) break; if (sp > XB_SPIN_CAP) { atomicAdd(&bar[XB_TMO], 1u); break; } }
  }
  nloc = mine > 0u ? mine : 1u; nx = cnt > 0u ? cnt : 1u;
}
DI void grid_barrier(unsigned* bar, volatile unsigned* st) {
  asm volatile("s_waitcnt vmcnt(0)" ::: "memory");
  __syncthreads();
  if (my_tid() == 0) {
    const unsigned x = xb_xcc_id();
    __builtin_amdgcn_s_waitcnt(0);
    unsigned nloc = st[0], nx = st[1];
    if (nloc == 0u) { xcd_barrier_complete(bar, x, nloc, nx); st[0] = nloc; st[1] = nx; }
    const unsigned old = xb_add(&bar[XB_XSUB(x)], 1u);
    const unsigned gen = old / nloc;
    if (old + 1u == (gen + 1u) * nloc) {
      __builtin_amdgcn_fence(__ATOMIC_RELEASE, "agent");
      asm volatile("s_waitcnt vmcnt(0)" ::: "memory");
      const unsigned og = xb_add(&bar[XB_TOP], 1u);
      const unsigned tg = og / nx;
      if (og + 1u == (tg + 1u) * nx) xb_add(&bar[XB_TOPGEN], 1u);
      else XB_SPIN(xb_ld(&bar[XB_TOPGEN]) == tg, bar);
      __builtin_amdgcn_fence(__ATOMIC_ACQUIRE, "agent");
      xb_add(&bar[XB_XGEN(x)], 1u);
      asm volatile("s_waitcnt vmcnt(0)" ::: "memory");
    } else {
      XB_SPIN(xb_ld(&bar[XB_XGEN(x)]) == gen, bar);
      __builtin_amdgcn_fence(__ATOMIC_ACQUIRE, "agent");
      asm volatile("s_waitcnt vmcnt(0)" ::: "memory");
    }
  }
  __syncthreads();
}
#define SYNC_OR_RET(idx) do { if ((idx) + 1 >= PH_END) return; if ((idx) == 0) { grid.sync(); if (my_tid() == 0) (void)xb_add(&((unsigned*)(p.ws + MISC_XBAR))[XB_XCNT(xb_xcc_id())], 1u); } else grid_barrier((unsigned*)(p.ws + MISC_XBAR), (volatile unsigned*)(smem + 144 * 1024)); } while (0)
template <int l>
DI void run_layer(const Params& p, cg::grid_group& grid, char* smem, unsigned& epoch) {
  const float* mod = (const float*)(p.ws + MISC_MOD) + (size_t)l * 9 * 6144;
  float* hc = (float*)(p.ws + OFF_HC);
  const float* hl_src = (l == 0) ? p.in[0] : p.out;
  const float* hc_src = (l == 0) ? p.in[2] : hc;
  constexpr int B0 = l * 12;
  if (l == 0) {
    ph_convert(p, 0, smem);
    ph_ada(p, smem);
    hy_rawfilter(p, 0, SL, (float*)(p.ws + R_RAWF), smem);
    hy_rawfilter(p, 0, CL, (float*)(p.ws + MISC_RAWC), smem);
    SYNC_OR_RET(B0 + 0);
    ph_kf(p, 0, smem);
    ph_ln(hl_src, hc_src, nullptr, nullptr, nullptr, nullptr, (bf16_t*)p.out, mod, 0, MT);
    SYNC_OR_RET(B0 + 1);
  }
  for (int rep = 0; rep < REP_GEMM; ++rep) ph_inproj(p, l == 0 ? (const bf16_t*)p.out : (const bf16_t*)(p.ws + R_U), smem);
  SYNC_OR_RET(B0 + 2);
  for (int rep = 0; rep < REP_HY; ++rep) {
  if (blockIdx.x == 0 && my_tid() == 0) *(unsigned*)(p.ws + MISC_BAR + 64 + 64 * l) = 0u;
  ph_hyena(p, l, smem);
  if (l == 0) ph_hyena_ctx(p, l, smem);
  }
  ph_rope(p, smem);
  for (int rep = 0; rep < REP_RWP; ++rep) ph_rwprep(p, l, smem);
  SYNC_OR_RET(B0 + 3);
  for (int rep = 0; rep < REP_SCAN; ++rep) ph_scan(p, smem);
  for (int rep = 0; rep < REP_ATTN; ++rep) ph_attn(p, l, smem);
  SYNC_OR_RET(B0 + 4);
  ph_rwout(p, l);
  if (l != 0) ph_ln(hl_src, hc_src, nullptr, nullptr, nullptr, nullptr, (bf16_t*)(p.ws + R_URE), mod, 0, ML);
  SYNC_OR_RET(B0 + 5);
  for (int rep = 0; rep < REP_GEMM; ++rep) ph_merge(p, l, l == 0 ? (const bf16_t*)p.out : (const bf16_t*)(p.ws + R_URE), smem);
  SYNC_OR_RET(B0 + 6);
  ph_resgemm(p, l, (const bf16_t*)(p.ws + R_ACC), 1024, (const bf16_t*)(p.ws + WB_OUT), hl_src, hc_src, 2048, smem);
  if (l == 0) hy_rawfilter(p, 1, SL, (float*)(p.ws + R_RAWF), smem);
  SYNC_OR_RET(B0 + 7);
  ph_ln(p.out, hc, p.out, hc, p.in[35] + (size_t)l * D, p.in[36] + (size_t)l * D, (bf16_t*)(p.ws + R_U), mod, 3072, l == 0 ? MT : ML);
  if (l == 0) ph_kf(p, 1, smem);
  SYNC_OR_RET(B0 + 8);
  for (int rep = 0; rep < REP_GEMM; ++rep) ph_ffnup(p, l, smem);
  SYNC_OR_RET(B0 + 9);
  ph_resgemm(p, l, (const bf16_t*)(p.ws + R_HID), 2816, (const bf16_t*)(p.ws + WB_DOWN), p.out, hc, 5120, smem);
  SYNC_OR_RET(B0 + 10);
  if (l == 0) {
    ph_ln(p.out, hc, p.out, hc, p.in[41], p.in[42], (bf16_t*)(p.ws + R_U), mod + 9 * 6144, 0, MT);
    ph_convert(p, 1, smem);
  } else {
    ph_ln(p.out, hc, p.out, hc, p.in[41] + (size_t)l * D, p.in[42] + (size_t)l * D, nullptr, mod, 0, ML);
  }
  SYNC_OR_RET(B0 + 11);
}

__global__ void __launch_bounds__(NTHR) mega(Params p) {
  extern __shared__ __attribute__((aligned(16))) char smem[];
  cg::grid_group grid = cg::this_grid();
  unsigned epoch = 0;
  if (blockIdx.x == 0) for (int i = my_tid(); i < XCD_BAR_WORDS; i += NTHR) ((unsigned*)(p.ws + MISC_XBAR))[i] = 0u;
  if (my_tid() < 2) ((volatile unsigned*)(smem + 144 * 1024))[my_tid()] = 0u;
  if (blockIdx.x == 0 && my_tid() < 64) *(unsigned*)(p.ws + MISC_ZERO + my_tid() * 4) = 0u;
  run_layer<0>(p, grid, smem, epoch);
  if (PH_END > 12) run_layer<1>(p, grid, smem, epoch);
}

extern "C" void kernel_launch(void* const* d_in, const int* in_sizes, int n_in, void* d_out, int out_size,
                              void* d_ws, size_t ws_size, hipStream_t stream) {
  static int grid_blocks = 0;
  if (!grid_blocks) {
    int dev = 0, cus = 0, per_cu = 0;
    (void)hipGetDevice(&dev);
    (void)hipDeviceGetAttribute(&cus, hipDeviceAttributeMultiprocessorCount, dev);
    (void)hipFuncSetAttribute((const void*)mega, hipFuncAttributeMaxDynamicSharedMemorySize, SMEM_BYTES);
    (void)hipOccupancyMaxActiveBlocksPerMultiprocessor(&per_cu, mega, NTHR, SMEM_BYTES);
    if (per_cu < 1) per_cu = 1;
    if (per_cu > 1) per_cu = 1;
    grid_blocks = cus * per_cu;
  }
  Params p{};
  for (int i = 0; i < 43; ++i) p.in[i] = (const float*)d_in[i];
  p.out = (float*)d_out; p.ws = (char*)d_ws;
  void* args[] = {&p};
  hipError_t e = hipLaunchCooperativeKernel((void*)mega, dim3(grid_blocks), dim3(NTHR), args, SMEM_BYTES, stream);
  if (e != hipSuccess) fprintf(stderr, "cooperative launch failed: %s (grid %d)\n", hipGetErrorString(e), grid_blocks);
}
```

```cpp
#include <hip/hip_runtime.h>
#include <hip/hip_cooperative_groups.h>
#include <cstdio>
#include <cstdint>
namespace cg = cooperative_groups;

#define DI __device__ __forceinline__
typedef unsigned short bf16_t;
typedef short bf16x8 __attribute__((ext_vector_type(8)));
typedef float f32x4 __attribute__((ext_vector_type(4)));

constexpr int D = 1024, NB = 8, SL = 4096, CL = 256;
constexpr int ML = NB * SL, MC = NB * CL, MT = ML + MC;
constexpr int KEYS = SL + CL;
constexpr int NTHR = 512;
constexpr float DN_ALPHA = 1.41421356237f;
constexpr size_t UNIT = (size_t)MT * 512;

constexpr size_t WB_IN = 0;
constexpr size_t WB_GATE = WB_IN + (size_t)3328 * 1024 * 2;
constexpr size_t WB_BR = WB_GATE + (size_t)4096 * 1024 * 2;
constexpr size_t WB_OUT = WB_BR + (size_t)4 * 1024 * 256 * 2;
constexpr size_t WB_UP = WB_OUT + (size_t)1024 * 1024 * 2;
constexpr size_t WB_DOWN = WB_UP + (size_t)5632 * 1024 * 2;
constexpr size_t WB_END = WB_DOWN + (size_t)1024 * 2816 * 2;
constexpr size_t OFF_KF = WB_END;
constexpr size_t OFF_HC = OFF_KF + (size_t)512 * 8192 * 8;
constexpr size_t OFF_MISC = OFF_HC + (size_t)MC * D * 4;
constexpr size_t MISC_MOD = OFF_MISC;
constexpr size_t MISC_TW = MISC_MOD + (size_t)2 * 9 * 6144 * 4;
constexpr size_t MISC_RAWC = MISC_TW + 4096 * 8;
constexpr size_t MISC_GCTX = MISC_RAWC + (size_t)256 * 1024 * 4;
constexpr size_t MISC_RWW = MISC_GCTX + (size_t)512 * 512 * 4;
constexpr size_t RWW_F = MISC_RWW, RWW_B = RWW_F + 256 * 64 * 2, RWW_A = RWW_B + 256 * 64 * 2, RWW_GF = RWW_A + 256 * 64 * 2, RWW_GB = RWW_GF + 256 * 128 * 2;
constexpr size_t MISC_XBAR = OFF_MISC + (size_t)3 * 1024 * 1024;
constexpr size_t OFF_R = OFF_MISC + (size_t)4 * 1024 * 1024;
constexpr size_t MISC_BAR = OFF_R - 256;
constexpr size_t MISC_ZERO = OFF_R - 512;
static_assert(RWW_GB + 256 * 128 * 2 <= MISC_ZERO, "misc overflow");
constexpr size_t R_YHY = OFF_R, R_YSW = OFF_R + UNIT, R_YDF = OFF_R + 2 * UNIT;
constexpr size_t R_PHY = OFF_R + 3 * UNIT;
constexpr size_t R_PSW = OFF_R + 6 * UNIT;
constexpr size_t R_VTSW = R_PSW + (size_t)MT * 384 * 2;
constexpr size_t R_PDF = OFF_R + 8 * UNIT;
constexpr size_t R_VTDF = OFF_R + 10 * UNIT;
constexpr size_t R_PRW = OFF_R + 11 * UNIT;
constexpr size_t R_STR = R_PRW + (size_t)MT * 1216 * 2;
constexpr size_t R_G = R_STR + 7 * UNIT;
constexpr size_t R_END = R_G + 2 * UNIT;
constexpr size_t R_RAWF = OFF_R;
constexpr size_t R_OF = R_PHY, R_OB = R_PHY + UNIT;
constexpr size_t R_URE = R_PSW;
constexpr size_t R_YRW = R_VTDF;
constexpr size_t R_ACC = R_PRW;
constexpr size_t R_U = R_STR;
constexpr size_t R_HID = OFF_R;
static_assert(R_END <= (size_t)512 * 1024 * 1024, "ws overflow");
static_assert((size_t)MT * 2816 * 2 <= 11 * UNIT, "hid");

constexpr int SMEM_BYTES = 144 * 1024 + 64;

struct Params {
  const float* in[43];
  float* out;
  char* ws;
};

DI int my_tid() { int t = (int)__builtin_amdgcn_workitem_id_x(); asm volatile("" : "+v"(t)); return t; }
DI unsigned f2bf(float f) { unsigned u = __float_as_uint(f); u += 0x7fffu + ((u >> 16) & 1u); return u >> 16; }
DI float bf2f(unsigned h) { return __uint_as_float(h << 16); }
typedef __bf16 bf16v2_t __attribute__((ext_vector_type(2)));
typedef float f32v2_t __attribute__((ext_vector_type(2)));
DI unsigned pack2(float lo, float hi) { f32v2_t v = {lo, hi}; bf16v2_t b = __builtin_convertvector(v, bf16v2_t); return __builtin_bit_cast(unsigned, b); }

DI float bflo(unsigned w) { return __uint_as_float(w << 16); }
DI float bfhi(unsigned w) { return __uint_as_float(w & 0xffff0000u); }
DI float sigmoidf_(float x) { return __builtin_amdgcn_rcpf(1.f + __expf(-x)); }
DI float siluf_(float x) { return x * __builtin_amdgcn_rcpf(1.f + __expf(-x)); }
DI float wave_sum(float v) {
#pragma unroll
  for (int o = 32; o >= 1; o >>= 1) v += __shfl_xor(v, o);
  return v;
}
template <int CTRL> DI float dpp_mov(float v) {
  return __int_as_float(__builtin_amdgcn_update_dpp(0, __float_as_int(v), CTRL, 0xf, 0xf, false));
}
DI float sum16(float v) {
  v += dpp_mov<0xB1>(v);
  v += dpp_mov<0x4E>(v);
  v += dpp_mov<0x141>(v);
  v += dpp_mov<0x140>(v);
  return v;
}
DI void lds_barrier() { asm volatile("s_waitcnt lgkmcnt(0)" ::: "memory"); __builtin_amdgcn_s_barrier(); asm volatile("" ::: "memory"); }
DI uint4 sel4(bool z, uint4 v) { return make_uint4(z ? 0u : v.x, z ? 0u : v.y, z ? 0u : v.z, z ? 0u : v.w); }
DI int mod_idx(int row) { return row < ML ? (row >> 12) : 8; }

template <int NTW, bool DEEP, class RowFn>
DI void gemm_main(f32x4 (&acc)[4][NTW], const bf16_t* __restrict__ A, int lda, RowFn rowfn,
                  const bf16_t* __restrict__ Bt, int ldb, int K, char* smem) {
  constexpr int BN = NTW * 32;
  constexpr int A_BYTES = 256 * 128, B_BYTES = BN * 128, STAGE = A_BYTES + B_BYTES;
  constexpr int NBL = BN / 64;
  const int tid = my_tid(), lane = tid & 63, wid = tid >> 6, wm = wid >> 1, wn = wid & 1, g = lane >> 4, r16 = lane & 15;
  const int chunk = tid & 7, lrow = tid >> 3;
  long a0 = rowfn(lrow), a1 = rowfn(lrow + 64), a2 = rowfn(lrow + 128), a3 = rowfn(lrow + 192);
  const long c0 = a0 < 0 ? 0 : a0, c1 = a1 < 0 ? 0 : a1, c2 = a2 < 0 ? 0 : a2, c3 = a3 < 0 ? 0 : a3;
  const bf16_t* Bp = Bt + (long)lrow * ldb + chunk * 8;
  const bf16_t* Ap0 = A + c0 * lda + chunk * 8; const bf16_t* Ap1 = A + c1 * lda + chunk * 8;
  const bf16_t* Ap2 = A + c2 * lda + chunk * 8; const bf16_t* Ap3 = A + c3 * lda + chunk * 8;
  struct Regs { uint4 a0, a1, a2, a3, b0, b1; };
  Regs R0, R1;
  R0.b1 = make_uint4(0, 0, 0, 0); R1.b1 = make_uint4(0, 0, 0, 0);
  auto GLOAD = [&](Regs& R, int k0) {
    R.a0 = *(const uint4*)(Ap0 + k0); R.a1 = *(const uint4*)(Ap1 + k0);
    R.a2 = *(const uint4*)(Ap2 + k0); R.a3 = *(const uint4*)(Ap3 + k0);
    R.b0 = *(const uint4*)(Bp + k0);
    if constexpr (NBL > 1) R.b1 = *(const uint4*)(Bp + (long)64 * ldb + k0);
  };
  auto SSTORE = [&](const Regs& R, int st) {
    char* base = smem + st * STAGE + lrow * 128 + ((chunk ^ (lrow & 7)) << 4);
    *(uint4*)(base) = sel4(a0 < 0, R.a0); *(uint4*)(base + 64 * 128) = sel4(a1 < 0, R.a1);
    *(uint4*)(base + 128 * 128) = sel4(a2 < 0, R.a2); *(uint4*)(base + 192 * 128) = sel4(a3 < 0, R.a3);
    *(uint4*)(base + A_BYTES) = R.b0;
    if constexpr (NBL > 1) *(uint4*)(base + A_BYTES + 64 * 128) = R.b1;
  };
  auto COMPUTE = [&](int st) {
    const char* As = smem + st * STAGE + (wm * 64 + r16) * 128;
    const char* Bs = smem + st * STAGE + A_BYTES + (wn * (NTW * 16) + r16) * 128;
#pragma unroll
    for (int kk = 0; kk < 2; ++kk) {
      const int sw = ((kk * 4 + g) ^ (r16 & 7)) << 4;
      bf16x8 af[4], bfr[NTW];
#pragma unroll
      for (int mt = 0; mt < 4; ++mt) af[mt] = *(const bf16x8*)(As + mt * 16 * 128 + sw);
#pragma unroll
      for (int nt = 0; nt < NTW; ++nt) bfr[nt] = *(const bf16x8*)(Bs + nt * 16 * 128 + sw);
#pragma unroll
      for (int mt = 0; mt < 4; ++mt)
#pragma unroll
        for (int nt = 0; nt < NTW; ++nt)
          acc[mt][nt] = __builtin_amdgcn_mfma_f32_16x16x32_bf16(af[mt], bfr[nt], acc[mt][nt], 0, 0, 0);
    }
  };
  const int nk = K >> 6;
  __syncthreads();
  GLOAD(R0, 0);
  SSTORE(R0, 0);
  if constexpr (DEEP) {
    GLOAD(R0, 64);
    if (nk > 2) GLOAD(R1, 128);
    lds_barrier();
    bf16x8 fa0[4], fb0[NTW], fa1[4], fb1[NTW];
    auto READF = [&](bf16x8 (&fa)[4], bf16x8 (&fb)[NTW], int st, int kk) {
      const int sw = ((kk * 4 + g) ^ (r16 & 7)) << 4;
      const char* As = smem + st * STAGE + (wm * 64 + r16) * 128 + sw;
      const char* Bs = smem + st * STAGE + A_BYTES + (wn * (NTW * 16) + r16) * 128 + sw;
#pragma unroll
      for (int mt = 0; mt < 4; ++mt) fa[mt] = *(const bf16x8*)(As + mt * 16 * 128);
#pragma unroll
      for (int nt = 0; nt < NTW; ++nt) fb[nt] = *(const bf16x8*)(Bs + nt * 16 * 128);
    };
    auto MMA = [&](const bf16x8 (&fa)[4], const bf16x8 (&fb)[NTW]) {
#pragma unroll
      for (int mt = 0; mt < 4; ++mt)
#pragma unroll
        for (int nt = 0; nt < NTW; ++nt)
          acc[mt][nt] = __builtin_amdgcn_mfma_f32_16x16x32_bf16(fa[mt], fb[nt], acc[mt][nt], 0, 0, 0);
    };
    READF(fa0, fb0, 0, 0);
    for (int kt = 0; kt < nk; kt += 2) {
      READF(fa1, fb1, 0, 1);
      MMA(fa0, fb0);
#pragma unroll
      for (int i = 0; i < 4 + NTW; ++i) { __builtin_amdgcn_sched_group_barrier(0x100, 1, 0); __builtin_amdgcn_sched_group_barrier(0x008, 2, 0); }
      __builtin_amdgcn_sched_barrier(0);
      SSTORE(R0, 1);
      if (kt + 3 < nk) GLOAD(R0, (kt + 3) * 64);
      MMA(fa1, fb1);
#pragma unroll
      for (int i = 0; i < 6; ++i) { __builtin_amdgcn_sched_group_barrier(0x200, 1, 0); __builtin_amdgcn_sched_group_barrier(0x020, 1, 0); __builtin_amdgcn_sched_group_barrier(0x008, 2, 0); }
      __builtin_amdgcn_sched_barrier(0);
      lds_barrier();
      READF(fa0, fb0, 1, 0);
      READF(fa1, fb1, 1, 1);
      MMA(fa0, fb0);
#pragma unroll
      for (int i = 0; i < 4 + NTW; ++i) { __builtin_amdgcn_sched_group_barrier(0x100, 1, 0); __builtin_amdgcn_sched_group_barrier(0x008, 2, 0); }
      __builtin_amdgcn_sched_barrier(0);
      if (kt + 2 < nk) SSTORE(R1, 0);
      if (kt + 4 < nk) GLOAD(R1, (kt + 4) * 64);
      MMA(fa1, fb1);
#pragma unroll
      for (int i = 0; i < 6; ++i) { __builtin_amdgcn_sched_group_barrier(0x200, 1, 0); __builtin_amdgcn_sched_group_barrier(0x020, 1, 0); __builtin_amdgcn_sched_group_barrier(0x008, 2, 0); }
      __builtin_amdgcn_sched_barrier(0);
      lds_barrier();
      if (kt + 2 < nk) READF(fa0, fb0, 0, 0);
    }
  } else {
    lds_barrier();
    for (int kt = 0; kt < nk; ++kt) {
      const int st = kt & 1;
      if (kt + 1 < nk) GLOAD(R0, (kt + 1) * 64);
      __builtin_amdgcn_sched_barrier(0);
      COMPUTE(st);
      __builtin_amdgcn_sched_barrier(0);
      if (kt + 1 < nk) SSTORE(R0, st ^ 1);
      lds_barrier();
    }
  }
}

#define GLDS16(gp, lp) __builtin_amdgcn_global_load_lds((const unsigned*)(gp), (unsigned*)(lp), 16, 0, 0)
template <class RowFn>
DI void gemm_glds(f32x4 (&acc)[4][4], const bf16_t* __restrict__ A, int lda, RowFn rowfn,
                  const bf16_t* __restrict__ Bt, int ldb, int K, char* smem, const bf16_t* zrow) {
  constexpr int A_BYTES = 256 * 128, STAGE = A_BYTES + 128 * 128;
  const int tid = my_tid(), lane = tid & 63, wid = tid >> 6, wm = wid >> 1, wn = wid & 1, g = lane >> 4, r16 = lane & 15;
  const int lrow = tid >> 3, c = (tid & 7) ^ (lrow & 7);
  const long a0 = rowfn(lrow), a1 = rowfn(lrow + 64), a2 = rowfn(lrow + 128), a3 = rowfn(lrow + 192);
  const bf16_t* pa0 = (a0 >= 0 ? A + a0 * lda : zrow) + c * 8; const int m0 = a0 >= 0 ? 1 : 0;
  const bf16_t* pa1 = (a1 >= 0 ? A + a1 * lda : zrow) + c * 8; const int m1 = a1 >= 0 ? 1 : 0;
  const bf16_t* pa2 = (a2 >= 0 ? A + a2 * lda : zrow) + c * 8; const int m2 = a2 >= 0 ? 1 : 0;
  const bf16_t* pa3 = (a3 >= 0 ? A + a3 * lda : zrow) + c * 8; const int m3 = a3 >= 0 ? 1 : 0;
  const bf16_t* pb0 = Bt + (long)lrow * ldb + c * 8; const bf16_t* pb1 = pb0 + (long)64 * ldb;
  auto ISSUE = [&](int kt, int bi) {
    char* d = smem + bi * STAGE + tid * 16;
    const int k0 = kt * 64;
    GLDS16(pa0 + k0 * m0, d); GLDS16(pa1 + k0 * m1, d + 8192); GLDS16(pa2 + k0 * m2, d + 16384); GLDS16(pa3 + k0 * m3, d + 24576);
    GLDS16(pb0 + k0, d + A_BYTES); GLDS16(pb1 + k0, d + A_BYTES + 8192);
  };
  auto COMPUTE = [&](int bi) {
    const char* As = smem + bi * STAGE + (wm * 64 + r16) * 128;
    const char* Bs = smem + bi * STAGE + A_BYTES + (wn * 64 + r16) * 128;
#pragma unroll
    for (int kk = 0; kk < 2; ++kk) {
      const int sw = ((kk * 4 + g) ^ (r16 & 7)) << 4;
      bf16x8 af[4], bfr[4];
#pragma unroll
      for (int mt = 0; mt < 4; ++mt) af[mt] = *(const bf16x8*)(As + mt * 16 * 128 + sw);
#pragma unroll
      for (int nt = 0; nt < 4; ++nt) bfr[nt] = *(const bf16x8*)(Bs + nt * 16 * 128 + sw);
      __builtin_amdgcn_s_setprio(1);
#pragma unroll
      for (int mt = 0; mt < 4; ++mt)
#pragma unroll
        for (int nt = 0; nt < 4; ++nt)
          acc[mt][nt] = __builtin_amdgcn_mfma_f32_16x16x32_bf16(af[mt], bfr[nt], acc[mt][nt], 0, 0, 0);
      __builtin_amdgcn_s_setprio(0);
    }
  };
  const int nk = K >> 6;
  __syncthreads();
  ISSUE(0, 0);
  ISSUE(1, 1);
  asm volatile("s_waitcnt vmcnt(6)" ::: "memory");
  __builtin_amdgcn_s_barrier();
  asm volatile("" ::: "memory");
  int bi = 0;
  for (int kt = 0; kt < nk; ++kt) {
    const int b2 = bi >= 1 ? bi - 1 : 2;
    if (kt + 2 < nk) ISSUE(kt + 2, b2);
    COMPUTE(bi);
    if (kt + 2 < nk) asm volatile("s_waitcnt vmcnt(6)" ::: "memory");
    else asm volatile("s_waitcnt vmcnt(0)" ::: "memory");
    asm volatile("s_waitcnt lgkmcnt(0)" ::: "memory");
    __builtin_amdgcn_s_barrier();
    asm volatile("" ::: "memory");
    bi = bi == 2 ? 0 : bi + 1;
  }
}

DI void gemm_glds256(f32x4 (&acc)[8][4], const bf16_t* __restrict__ A, int lda, long arow0,
                     const bf16_t* __restrict__ Bt, int ldb, int K, char* smem) {
  constexpr int A_BYTES = 256 * 128, STAGE = 2 * A_BYTES;
  const int tid = my_tid(), lane = tid & 63, wid = tid >> 6, wm = wid >> 2, wn = wid & 3, g = lane >> 4, r16 = lane & 15;
  const int lrow = tid >> 3, c = (tid & 7) ^ (lrow & 7);
  const bf16_t* pa = A + (arow0 + lrow) * (long)lda + c * 8;
  const bf16_t* pb = Bt + (long)lrow * ldb + c * 8;
  const long a64 = (long)64 * lda, b64 = (long)64 * ldb;
  auto ISSUE = [&](int kt, int bi) {
    char* d = smem + bi * STAGE + tid * 16;
    const int k0 = kt * 64;
    GLDS16(pa + k0, d); GLDS16(pa + a64 + k0, d + 8192); GLDS16(pa + 2 * a64 + k0, d + 16384); GLDS16(pa + 3 * a64 + k0, d + 24576);
    GLDS16(pb + k0, d + A_BYTES); GLDS16(pb + b64 + k0, d + A_BYTES + 8192); GLDS16(pb + 2 * b64 + k0, d + A_BYTES + 16384); GLDS16(pb + 3 * b64 + k0, d + A_BYTES + 24576);
  };
  auto COMPUTE = [&](int bi) {
    const char* As = smem + bi * STAGE + (wm * 128 + r16) * 128;
    const char* Bs = smem + bi * STAGE + A_BYTES + (wn * 64 + r16) * 128;
#pragma unroll
    for (int kk = 0; kk < 2; ++kk) {
      const int sw = ((kk * 4 + g) ^ (r16 & 7)) << 4;
      bf16x8 bfr[4];
#pragma unroll
      for (int nt = 0; nt < 4; ++nt) bfr[nt] = *(const bf16x8*)(Bs + nt * 16 * 128 + sw);
      __builtin_amdgcn_s_setprio(1);
#pragma unroll
      for (int mt = 0; mt < 8; ++mt) {
        const bf16x8 af = *(const bf16x8*)(As + mt * 16 * 128 + sw);
#pragma unroll
        for (int nt = 0; nt < 4; ++nt)
          acc[mt][nt] = __builtin_amdgcn_mfma_f32_16x16x32_bf16(af, bfr[nt], acc[mt][nt], 0, 0, 0);
      }
      __builtin_amdgcn_s_setprio(0);
    }
  };
  const int nk = K >> 6;
  __syncthreads();
  ISSUE(0, 0);
  asm volatile("s_waitcnt vmcnt(0)" ::: "memory");
  __builtin_amdgcn_s_barrier();
  asm volatile("" ::: "memory");
  int bi = 0;
  for (int kt = 0; kt < nk; ++kt) {
    if (kt + 1 < nk) ISSUE(kt + 1, bi ^ 1);
    COMPUTE(bi);
    asm volatile("s_waitcnt vmcnt(0)" ::: "memory");
    asm volatile("s_waitcnt lgkmcnt(0)" ::: "memory");
    __builtin_amdgcn_s_barrier();
    asm volatile("" ::: "memory");
    bi ^= 1;
  }
}
DI void zero_acc256(f32x4 (&acc)[8][4]) {
#pragma unroll
  for (int i = 0; i < 8; ++i)
#pragma unroll
    for (int j = 0; j < 4; ++j) acc[i][j] = (f32x4){0.f, 0.f, 0.f, 0.f};
}

DI bool next_tile(int i, int MTILES, int NTILES, int& mt, int& nt) {
  const int xcd = blockIdx.x & 7, slot = blockIdx.x >> 3, nslot = gridDim.x >> 3;
  const int m_lo = (MTILES * xcd) >> 3, m_hi = (MTILES * (xcd + 1)) >> 3, Mloc = m_hi - m_lo;
  const int q = i * nslot + slot;
  if (q >= Mloc * NTILES) return false;
  const int gidx = q / (4 * NTILES), m0 = gidx * 4;
  const int rows = (Mloc - m0) < 4 ? (Mloc - m0) : 4;
  const int within = q - gidx * 4 * NTILES;
  nt = within / rows; mt = m_lo + m0 + within % rows;
  return true;
}

struct RowPlain { long base; DI long operator()(int r) const { return base + r; } };
struct RowHalo { long rowbase; int t0; int len; DI long operator()(int r) const { int t = t0 + r; return (t >= 0 && t < len) ? rowbase + t : -1; } };

template <int NTW> DI void zero_acc(f32x4 (&acc)[4][NTW]) {
#pragma unroll
  for (int i = 0; i < 4; ++i)
#pragma unroll
    for (int j = 0; j < NTW; ++j) acc[i][j] = (f32x4){0.f, 0.f, 0.f, 0.f};
}

DI void cvt_unit(const float* __restrict__ src, int ldsrc, int srccol0, int k0, bf16_t* __restrict__ dst, int K, int n0, char* smem, bool perm = true) {
  float* T = (float*)smem;
  const int tid = my_tid();
  __syncthreads();
  if (srccol0 >= 0) {
#pragma unroll
    for (int i = 0; i < 8; ++i) {
      int idx = tid + i * 512; int k = idx >> 6, n = idx & 63;
      T[k * 65 + n] = src[(long)(k0 + k) * ldsrc + srccol0 + n];
    }
  }
  __syncthreads();
  int nd = tid >> 3, kc = (tid & 7) * 8; int n = perm ? ((nd & 15) * 4 + (nd >> 4)) : nd;
  uint4 o = make_uint4(0, 0, 0, 0);
  if (srccol0 >= 0) {
    o.x = pack2(T[(kc + 0) * 65 + n], T[(kc + 1) * 65 + n]);
    o.y = pack2(T[(kc + 2) * 65 + n], T[(kc + 3) * 65 + n]);
    o.z = pack2(T[(kc + 4) * 65 + n], T[(kc + 5) * 65 + n]);
    o.w = pack2(T[(kc + 6) * 65 + n], T[(kc + 7) * 65 + n]);
  }
  *(uint4*)(dst + (long)(n0 + nd) * K + k0 + kc) = o;
}

DI void ph_convert(const Params& p, int l, char* smem) {
  for (int u = blockIdx.x; u < 4508; u += gridDim.x) {
    if (u < 832) {
      int gI = u >> 4, kt = u & 15; int n0 = gI * 64; int sc;
      if (n0 < 1280) sc = n0; else if (n0 < 2048) sc = 2496 + (n0 - 1280); else if (n0 < 3264) sc = 1280 + (n0 - 2048); else sc = -1;
      cvt_unit(p.in[6] + (size_t)l * 1024 * 7360, 7360, sc, kt * 64, (bf16_t*)(p.ws + WB_IN), 1024, n0, smem);
    } else if (u < 1856) {
      int v = u - 832; int gI = v >> 4, kt = v & 15;
      cvt_unit(p.in[6] + (size_t)l * 1024 * 7360, 7360, 3264 + gI * 64, kt * 64, (bf16_t*)(p.ws + WB_GATE), 1024, gI * 64, smem);
    } else if (u < 2112) {
      int v = u - 1856; int gI = v >> 2, kt = v & 3; int j = gI >> 4, gg = gI & 15;
      cvt_unit(p.in[33] + ((size_t)l * 4 + j) * 256 * 1024, 1024, gg * 64, kt * 64, (bf16_t*)(p.ws + WB_BR) + (size_t)j * 1024 * 256, 256, gg * 64, smem);
    } else if (u < 2368) {
      int v = u - 2112; int gI = v >> 4, kt = v & 15;
      cvt_unit(p.in[34] + (size_t)l * 1024 * 1024, 1024, gI * 64, kt * 64, (bf16_t*)(p.ws + WB_OUT), 1024, gI * 64, smem);
    } else if (u < 3776) {
      int v = u - 2368; int gI = v >> 4, kt = v & 15; int nt = gI >> 2, q = gI & 3;
      cvt_unit(p.in[37] + (size_t)l * 1024 * 5632, 5632, (q >> 1) * 2816 + nt * 128 + (q & 1) * 64, kt * 64, (bf16_t*)(p.ws + WB_UP), 1024, gI * 64, smem);
    } else if (u < 4480) {
      int v = u - 3776; int gI = v / 44, kt = v % 44;
      cvt_unit(p.in[40] + (size_t)l * 2816 * 1024, 1024, gI * 64, kt * 64, (bf16_t*)(p.ws + WB_DOWN), 2816, gI * 64, smem);
    } else {
      int v = u - 4480;
      if (v < 4) cvt_unit(p.in[19] + (size_t)l * 2 * 64 * 256, 256, v * 64, 0, (bf16_t*)(p.ws + RWW_F), 64, v * 64, smem);
      else if (v < 8) cvt_unit(p.in[19] + (size_t)l * 2 * 64 * 256 + 64 * 256, 256, (v - 4) * 64, 0, (bf16_t*)(p.ws + RWW_B), 64, (v - 4) * 64, smem);
      else if (v < 12) cvt_unit(p.in[21] + (size_t)l * 64 * 256, 256, (v - 8) * 64, 0, (bf16_t*)(p.ws + RWW_A), 64, (v - 8) * 64, smem);
      else if (v < 20) { int w = v - 12; cvt_unit(p.in[22] + (size_t)l * 2 * 128 * 256, 256, (w >> 1) * 64, (w & 1) * 64, (bf16_t*)(p.ws + RWW_GF), 128, (w >> 1) * 64, smem); }
      else { int w = v - 20; cvt_unit(p.in[22] + (size_t)l * 2 * 128 * 256 + 128 * 256, 256, (w >> 1) * 64, (w & 1) * 64, (bf16_t*)(p.ws + RWW_GB), 128, (w >> 1) * 64, smem); }
    }
  }
}

DI void ph_ada(const Params& p, char* smem) {
  float* S = (float*)smem;
  float* R = S + 9 * 1024;
  const int tid = my_tid();
  bool loaded = false;
  for (int u = blockIdx.x; u < 192; u += gridDim.x) {
    if (!loaded) {
      __syncthreads();
      for (int i = tid; i < 9 * 1024; i += NTHR) { float c = i < 8192 ? p.in[1][i] : p.in[3][i - 8192]; S[i] = siluf_(c); }
      loaded = true;
    }
    __syncthreads();
    int l = u / 96, n0 = (u % 96) * 64;
    int col = tid & 63, ks = tid >> 6;
    const float* W = p.in[4] + (size_t)l * 1024 * 6144 + n0 + col;
    float a[9];
#pragma unroll
    for (int b = 0; b < 9; ++b) a[b] = 0.f;
    for (int k = ks * 128; k < ks * 128 + 128; ++k) {
      float w = W[(size_t)k * 6144];
#pragma unroll
      for (int b = 0; b < 9; ++b) a[b] += S[b * 1024 + k] * w;
    }
#pragma unroll
    for (int b = 0; b < 9; ++b) R[(ks * 9 + b) * 64 + col] = a[b];
    __syncthreads();
    for (int i = tid; i < 9 * 64; i += NTHR) {
      int b = i >> 6, c = i & 63; float s = 0.f;
#pragma unroll
      for (int k2 = 0; k2 < 8; ++k2) s += R[(k2 * 9 + b) * 64 + c];
      s += p.in[5][(size_t)l * 6144 + n0 + c];
      ((float*)(p.ws + MISC_MOD))[((size_t)l * 9 + b) * 6144 + n0 + c] = s;
    }
  }
  for (int i = blockIdx.x * NTHR + tid; i < 4096; i += gridDim.x * NTHR) {
    float s, c; sincospif(-(float)i / 4096.f, &s, &c);
    ((float2*)(p.ws + MISC_TW))[i] = make_float2(c, s);
  }
}

DI void hy_rawfilter(const Params& p, int l, int Lf, float* __restrict__ dst, char* smem) {
  float* W1 = (float*)smem;
  float* W2 = W1 + 33 * 64;
  float* Z = W2 + 64 * 64;
  float* H1 = Z + 16 * 36;
  float* H2 = H1 + 16 * 64;
  const int tid = my_tid();
  const float* w1 = p.in[9] + (size_t)l * 33 * 64; const float* b1 = p.in[10] + l * 64;
  const float* w2 = p.in[11] + (size_t)l * 64 * 64; const float* b2 = p.in[12] + l * 64;
  const float* w3 = p.in[13] + (size_t)l * 64 * 1024; const float* fr = p.in[14] + l * 64;
  const int nunits = Lf / 16;
  bool loaded = false;
  for (int u = blockIdx.x; u < nunits; u += gridDim.x) {
    __syncthreads();
    if (!loaded) {
      for (int i = tid; i < 33 * 64; i += NTHR) W1[i] = w1[i];
      for (int i = tid; i < 64 * 64; i += NTHR) W2[i] = w2[i];
      loaded = true;
    }
    const int t0 = u * 16;
    for (int i = tid; i < 16 * 33; i += NTHR) {
      int tt = i / 33, f = i % 33; int t = t0 + tt; float v;
      if (f == 0) v = (float)t / (float)(Lf - 1);
      else {
        int bi = (f - 1) & 15;
        float wv = 6.283185307179586f * (float)t / (float)Lf;
        float fb = 1e-4f + (15.f - 1e-4f) * (float)bi / 15.f;
        float ang = wv * fb;
        v = (f <= 16) ? cosf(ang) : -sinf(ang);
      }
      Z[tt * 36 + f] = v;
    }
    __syncthreads();
    for (int i = tid; i < 16 * 64; i += NTHR) {
      int tt = i >> 6, f = i & 63; float s = b1[f];
      for (int k = 0; k < 33; ++k) s += Z[tt * 36 + k] * W1[k * 64 + f];
      H1[tt * 64 + f] = sinf(fr[f] * s);
    }
    __syncthreads();
    for (int i = tid; i < 16 * 64; i += NTHR) {
      int tt = i >> 6, f = i & 63; float s = b2[f];
      for (int k = 0; k < 64; ++k) s += H1[tt * 64 + k] * W2[k * 64 + f];
      H2[tt * 64 + f] = sinf(fr[f] * s);
    }
    __syncthreads();
    float a0[16], a1[16];
#pragma unroll
    for (int i = 0; i < 16; ++i) { a0[i] = 0.f; a1[i] = 0.f; }
    for (int k = 0; k < 64; ++k) {
      float wa = w3[k * 1024 + tid], wb = w3[k * 1024 + 512 + tid];
#pragma unroll
      for (int i = 0; i < 16; ++i) { float h = H2[i * 64 + k]; a0[i] += h * wa; a1[i] += h * wb; }
    }
    {
      int w = tid & 255;
      float delta = fabsf(-3.0701134573253944f + (-15.350567286626972f + 3.0701134573253944f) * (float)w / 255.f);
#pragma unroll
      for (int i = 0; i < 16; ++i) {
        float tn = (float)(t0 + i) / (float)(Lf - 1);
        float dec = expf(-tn * delta);
        dst[(size_t)(t0 + i) * 1024 + tid] = a0[i] * dec;
        dst[(size_t)(t0 + i) * 1024 + 512 + tid] = a1[i] * dec;
      }
    }
  }
}

DI float2 cmul(float2 a, float2 b) { return make_float2(a.x * b.x - a.y * b.y, a.x * b.y + a.y * b.x); }
DI float2 cmulc(float2 a, float2 b) { return make_float2(a.x * b.x + a.y * b.y, a.y * b.x - a.x * b.y); }
DI float2 cadd(float2 a, float2 b) { return make_float2(a.x + b.x, a.y + b.y); }
DI float2 csub(float2 a, float2 b) { return make_float2(a.x - b.x, a.y - b.y); }
DI void fft_dif(float2* X, const float2* W) {
  const int tid = my_tid();
  for (int ls = 12; ls >= 2; ls -= 2) {
    const int s = 1 << ls, h = s >> 1;
    __syncthreads();
#pragma unroll
    for (int i = 0; i < 4; ++i) {
      const int bf = tid + i * 512; const int j = bf & (h - 1); const int base = ((bf >> (ls - 1)) << (ls + 1)) + j;
      const float2 x0 = X[base], x1 = X[base + h], x2 = X[base + s], x3 = X[base + s + h];
      const float2 w1 = W[s - 1 + j], w2 = W[h - 1 + j];
      const float2 y0 = cadd(x0, x2), y2 = cmul(csub(x0, x2), w1), y1 = cadd(x1, x3);
      const float2 t = cmul(csub(x1, x3), w1); const float2 y3 = make_float2(t.y, -t.x);
      X[base] = cadd(y0, y1); X[base + h] = cmul(csub(y0, y1), w2);
      X[base + s] = cadd(y2, y3); X[base + s + h] = cmul(csub(y2, y3), w2);
    }
  }
  __syncthreads();
#pragma unroll
  for (int i = 0; i < 4; ++i) {
    const int q = tid + i * 512;
    float4 a = *(float4*)(X + 4 * q), b = *(float4*)(X + 4 * q + 2);
    *(float4*)(X + 4 * q) = make_float4(a.x + a.z, a.y + a.w, a.x - a.z, a.y - a.w);
    *(float4*)(X + 4 * q + 2) = make_float4(b.x + b.z, b.y + b.w, b.x - b.z, b.y - b.w);
  }
  __syncthreads();
}
DI void fft_dit_inv(float2* X, const float2* W) {
  const int tid = my_tid();
  __syncthreads();
#pragma unroll
  for (int i = 0; i < 4; ++i) {
    const int q = tid + i * 512;
    float4 a = *(float4*)(X + 4 * q), b = *(float4*)(X + 4 * q + 2);
    *(float4*)(X + 4 * q) = make_float4(a.x + a.z, a.y + a.w, a.x - a.z, a.y - a.w);
    *(float4*)(X + 4 * q + 2) = make_float4(b.x + b.z, b.y + b.w, b.x - b.z, b.y - b.w);
  }
  for (int ls = 2; ls <= 12; ls += 2) {
    const int s = 1 << ls, h = s >> 1;
    __syncthreads();
#pragma unroll
    for (int i = 0; i < 4; ++i) {
      const int bf = tid + i * 512; const int j = bf & (h - 1); const int base = ((bf >> (ls - 1)) << (ls + 1)) + j;
      const float2 e0 = X[base], e1 = X[base + h], e2 = X[base + s], e3 = X[base + s + h];
      const float2 w1 = W[s - 1 + j], w2 = W[h - 1 + j];
      const float2 t1 = cmulc(e1, w2), t3 = cmulc(e3, w2);
      const float2 u0 = cadd(e0, t1), u1 = csub(e0, t1), u2 = cadd(e2, t3), u3 = csub(e2, t3);
      const float2 a2 = cmulc(u2, w1); const float2 q3 = cmulc(u3, w1); const float2 a3 = make_float2(-q3.y, q3.x);
      X[base] = cadd(u0, a2); X[base + s] = csub(u0, a2);
      X[base + h] = cadd(u1, a3); X[base + s + h] = csub(u1, a3);
    }
  }
  __syncthreads();
}
DI void load_twiddles(const Params& p, float2* W) {
  const float2* tw = (const float2*)(p.ws + MISC_TW);
  for (int i = my_tid(); i < 8191; i += NTHR) {
    const int ls = 31 - __clz(i + 1); const int pos = i + 1 - (1 << ls);
    W[i] = tw[pos << (12 - ls)];
  }
}

DI void ph_kf(const Params& p, int l, char* smem) {
  float2* X = (float2*)smem; float2* W = X + 8192; float* red = (float*)(W + 8192);
  const int tid = my_tid(), lane = tid & 63, wid = tid >> 6;
  const float* rawf = (const float*)(p.ws + R_RAWF);
  float2* kf = (float2*)(p.ws + OFF_KF);
  bool tw = false;
  for (int u = blockIdx.x; u < 256; u += gridDim.x) {
    if (!tw) { load_twiddles(p, W); tw = true; }
    const int o = u >> 7, c = (u & 127) * 2;
    float2 fw[8], bw[8]; float sa = 0.f, sb = 0.f;
#pragma unroll
    for (int i = 0; i < 8; ++i) {
      int t = tid + i * 512;
      fw[i] = *(const float2*)(rawf + (size_t)t * 1024 + o * 512 + c);
      bw[i] = *(const float2*)(rawf + (size_t)t * 1024 + o * 512 + 256 + c);
      sa += fabsf(fw[i].x) + fabsf(bw[i].x); sb += fabsf(fw[i].y) + fabsf(bw[i].y);
    }
    sa = wave_sum(sa); sb = wave_sum(sb);
    __syncthreads();
    if (lane == 0) { red[wid * 2] = sa; red[wid * 2 + 1] = sb; }
    __syncthreads();
    float ta = 0.f, tb = 0.f;
#pragma unroll
    for (int w = 0; w < 8; ++w) { ta += red[w * 2]; tb += red[w * 2 + 1]; }
    const float ia = 1.f / ta, ib = 1.f / tb;
#pragma unroll
    for (int i = 0; i < 8; ++i) {
      int t = tid + i * 512;
      X[t] = make_float2(fw[i].x * ia, fw[i].y * ib);
      if (t >= 1) X[8192 - t] = make_float2(bw[i].x * ia, bw[i].y * ib);
      else X[4096] = make_float2(0.f, 0.f);
    }
    fft_dif(X, W);
    float2* ka = kf + (size_t)(o * 256 + c) * 8192; float2* kb = ka + 8192;
#pragma unroll 4
    for (int i = 0; i < 16; ++i) {
      int pidx = tid + i * 512;
      int k = (int)(__brev((unsigned)pidx) >> 19);
      int k2 = (8192 - k) & 8191;
      int p2 = (int)(__brev((unsigned)k2) >> 19);
      float2 c1 = X[pidx], c2 = X[p2];
      float2 A = make_float2(0.5f * (c1.x + c2.x), 0.5f * (c1.y - c2.y));
      float2 Bv = make_float2(0.5f * (c1.y + c2.y), -0.5f * (c1.x - c2.x));
      ka[pidx] = A; kb[pidx] = Bv;
    }
    __syncthreads();
  }
  if (l == 0) {
    const float* rawc = (const float*)(p.ws + MISC_RAWC);
    float* G = (float*)(p.ws + MISC_GCTX);
    for (int u = blockIdx.x * 8 + wid; u < 512; u += gridDim.x * 8) {
      int o = u >> 8, c = u & 255; float f[4], b[4]; float s = 0.f;
#pragma unroll
      for (int i = 0; i < 4; ++i) {
        int t = lane + i * 64;
        f[i] = rawc[(size_t)t * 1024 + o * 512 + c]; b[i] = rawc[(size_t)t * 1024 + o * 512 + 256 + c];
        s += fabsf(f[i]) + fabsf(b[i]);
      }
      s = wave_sum(s); float inv = 1.f / s;
#pragma unroll
      for (int i = 0; i < 4; ++i) {
        int t = lane + i * 64;
        G[(size_t)u * 512 + 256 + t] = f[i] * inv;
        if (t >= 1) G[(size_t)u * 512 + 256 - t] = b[i] * inv;
      }
      if (lane == 0) G[(size_t)u * 512] = 0.f;
    }
  }
}

DI void ph_ln(const float* __restrict__ src_lat, const float* __restrict__ src_ctx, float* dst_lat, float* dst_ctx,
              const float* __restrict__ ag, const float* __restrict__ ab, bf16_t* U, const float* __restrict__ mod, int sh_off, int nrows) {
  const int lane = my_tid() & 63, wid = my_tid() >> 6;
  const int stride = gridDim.x * 8;
  float4 nv[4];
  {
    const int row = blockIdx.x * 8 + wid;
    if (row < nrows) {
      const float* src = row < ML ? src_lat + (size_t)row * D : src_ctx + (size_t)(row - ML) * D;
#pragma unroll
      for (int i = 0; i < 4; ++i) nv[i] = *(const float4*)(src + i * 256 + lane * 4);
    }
  }
  for (int row = blockIdx.x * 8 + wid; row < nrows; row += stride) {
    float4 v[4];
#pragma unroll
    for (int i = 0; i < 4; ++i) v[i] = nv[i];
    if (row + stride < nrows) {
      const int r2 = row + stride;
      const float* src2 = r2 < ML ? src_lat + (size_t)r2 * D : src_ctx + (size_t)(r2 - ML) * D;
#pragma unroll
      for (int i = 0; i < 4; ++i) nv[i] = *(const float4*)(src2 + i * 256 + lane * 4);
    }
    float s = 0.f;
#pragma unroll
    for (int i = 0; i < 4; ++i) s += v[i].x + v[i].y + v[i].z + v[i].w;
    float mu = wave_sum(s) * (1.f / 1024.f);
    float q = 0.f;
#pragma unroll
    for (int i = 0; i < 4; ++i) { v[i].x -= mu; v[i].y -= mu; v[i].z -= mu; v[i].w -= mu; q += v[i].x * v[i].x + v[i].y * v[i].y + v[i].z * v[i].z + v[i].w * v[i].w; }
    float rs = rsqrtf(wave_sum(q) * (1.f / 1024.f) + 1e-6f);
#pragma unroll
    for (int i = 0; i < 4; ++i) { v[i].x *= rs; v[i].y *= rs; v[i].z *= rs; v[i].w *= rs; }
    if (ag) {
      float* dst = row < ML ? dst_lat + (size_t)row * D : dst_ctx + (size_t)(row - ML) * D;
#pragma unroll
      for (int i = 0; i < 4; ++i) {
        float4 gg = *(const float4*)(ag + i * 256 + lane * 4), bb = *(const float4*)(ab + i * 256 + lane * 4);
        v[i].x = v[i].x * gg.x + bb.x; v[i].y = v[i].y * gg.y + bb.y; v[i].z = v[i].z * gg.z + bb.z; v[i].w = v[i].w * gg.w + bb.w;
        *(float4*)(dst + i * 256 + lane * 4) = v[i];
      }
      if (U) {
        s = 0.f;
#pragma unroll
        for (int i = 0; i < 4; ++i) s += v[i].x + v[i].y + v[i].z + v[i].w;
        mu = wave_sum(s) * (1.f / 1024.f); q = 0.f;
#pragma unroll
        for (int i = 0; i < 4; ++i) { v[i].x -= mu; v[i].y -= mu; v[i].z -= mu; v[i].w -= mu; q += v[i].x * v[i].x + v[i].y * v[i].y + v[i].z * v[i].z + v[i].w * v[i].w; }
        rs = rsqrtf(wave_sum(q) * (1.f / 1024.f) + 1e-6f);
#pragma unroll
        for (int i = 0; i < 4; ++i) { v[i].x *= rs; v[i].y *= rs; v[i].z *= rs; v[i].w *= rs; }
      }
    }
    if (U) {
      const float* m = mod + (size_t)mod_idx(row) * 6144 + sh_off;
#pragma unroll
      for (int i = 0; i < 4; ++i) {
        float4 sh = *(const float4*)(m + i * 256 + lane * 4), sc = *(const float4*)(m + 1024 + i * 256 + lane * 4);
        uint2 o; o.x = pack2(v[i].x * (1.f + sc.x) + sh.x, v[i].y * (1.f + sc.y) + sh.y);
        o.y = pack2(v[i].z * (1.f + sc.z) + sh.z, v[i].w * (1.f + sc.w) + sh.w);
        *(uint2*)(U + (size_t)row * D + i * 256 + lane * 4) = o;
      }
    }
  }
}

DI void ph_inproj(const Params& p, const bf16_t* U, char* smem) {
  const bf16_t* Bt = (const bf16_t*)(p.ws + WB_IN);
  const int lane = my_tid() & 63, wid = my_tid() >> 6, wm = wid >> 2, wn = wid & 3, g = lane >> 4, r16 = lane & 15;
  for (int it = 0;; ++it) {
    int mtile, ntile;
    if (!next_tile(it, 136, 13, mtile, ntile)) break;
    f32x4 acc[8][4]; zero_acc256(acc);
    gemm_glds256(acc, U, 1024, (long)mtile * 256, Bt + (size_t)ntile * 256 * 1024, 1024, 1024, smem);
    int b, key0;
    if (mtile < 128) { b = mtile >> 4; key0 = (mtile & 15) * 256; } else { b = mtile - 128; key0 = SL; }
    const int wc0 = ntile * 256 + wn * 64;
    bf16_t* tbase = nullptr; int tcols = 0, tcol0 = 0;
    if (wc0 < 768) { tbase = (bf16_t*)(p.ws + R_PHY); tcols = 768; tcol0 = wc0; }
    else if (wc0 >= 1152 && wc0 < 1280) { tbase = (bf16_t*)(p.ws + R_VTSW); tcols = 128; tcol0 = wc0 - 1152; }
    else if (wc0 >= 1792 && wc0 < 2048) { tbase = (bf16_t*)(p.ws + R_VTDF); tcols = 256; tcol0 = wc0 - 1792; }
    if (tbase) {
#pragma unroll
      for (int mt = 0; mt < 8; ++mt)
#pragma unroll
        for (int nt = 0; nt < 4; ++nt) {
          int col = tcol0 + r16 * 4 + nt;
          int key = key0 + wm * 128 + mt * 16 + g * 4;
          uint2 o; o.x = pack2(acc[mt][nt][0], acc[mt][nt][1]); o.y = pack2(acc[mt][nt][2], acc[mt][nt][3]);
          *(uint2*)(tbase + ((size_t)b * tcols + col) * KEYS + key) = o;
        }
    } else if (wc0 < 3264) {
      bf16_t* rb; int ld, c0;
      if (wc0 < 1152) { rb = (bf16_t*)(p.ws + R_PSW); ld = 384; c0 = wc0 - 768; }
      else if (wc0 < 1792) { rb = (bf16_t*)(p.ws + R_PDF); ld = 512; c0 = wc0 - 1280; }
      else { rb = (bf16_t*)(p.ws + R_PRW); ld = 1216; c0 = wc0 - 2048; }
      const int col = c0 + r16 * 4;
#pragma unroll
      for (int mt = 0; mt < 8; ++mt)
#pragma unroll
        for (int j = 0; j < 4; ++j) {
          size_t row = (size_t)mtile * 256 + wm * 128 + mt * 16 + g * 4 + j;
          uint2 o; o.x = pack2(acc[mt][0][j], acc[mt][1][j]); o.y = pack2(acc[mt][2][j], acc[mt][3][j]);
          *(uint2*)(rb + row * ld + col) = o;
        }
    }
  }
}

DI float hy_conv3(const bf16_t* __restrict__ P, int t, int len, float w0, float w1, float w2, float bias) {
  float a = t >= 1 ? bf2f(P[t - 1]) : 0.f, b = bf2f(P[t]), c = (t + 1 < len) ? bf2f(P[t + 1]) : 0.f;
  return w0 * a + w1 * b + w2 * c + bias;
}
DI void hy_conv8(const bf16_t* __restrict__ P, int tb, int len, float w0, float w1, float w2, float bias, float (&out)[8]) {
  const uint4 u = *(const uint4*)(P + tb);
  float x[10];
  x[0] = tb >= 1 ? bf2f(P[tb - 1]) : 0.f;
  x[1] = bflo(u.x); x[2] = bfhi(u.x); x[3] = bflo(u.y); x[4] = bfhi(u.y); x[5] = bflo(u.z); x[6] = bfhi(u.z); x[7] = bflo(u.w); x[8] = bfhi(u.w);
  x[9] = (tb + 8 < len) ? bf2f(P[tb + 8]) : 0.f;
#pragma unroll
  for (int i = 0; i < 8; ++i) out[i] = w0 * x[i] + w1 * x[i + 1] + w2 * x[i + 2] + bias;
}
DI void ph_hyena(const Params& p, int l, char* smem) {
  float2* X = (float2*)smem; float2* W = X + 8192;
  const int tid = my_tid();
  const int tb = tid * 8;
  const bf16_t* PT = (const bf16_t*)(p.ws + R_PHY);
  const float2* kf = (const float2*)(p.ws + OFF_KF);
  const float* cw = p.in[7] + (size_t)l * 3 * 768; const float* cb = p.in[8] + (size_t)l * 768;
  const float* hb = p.in[15] + (size_t)l * 512;
  bf16_t* Y = (bf16_t*)(p.ws + R_YHY);
  bool tw = false;
  for (int u = blockIdx.x; u < 1024; u += gridDim.x) {
    if (!tw) { load_twiddles(p, W); tw = true; }
    const int bp = u >> 8, c = u & 255; const int b0 = bp * 2, b1 = b0 + 1;
    const bf16_t* P0 = PT + ((size_t)b0 * 768) * KEYS; const bf16_t* P1 = PT + ((size_t)b1 * 768) * KEYS;
    const float bias0 = hb[c], bias1 = hb[256 + c];
    float va[8], vb[8];
    hy_conv8(P0 + (size_t)c * KEYS, tb, SL, cw[c], cw[768 + c], cw[1536 + c], cb[c], va);
    hy_conv8(P1 + (size_t)c * KEYS, tb, SL, cw[c], cw[768 + c], cw[1536 + c], cb[c], vb);
    __syncthreads();
#pragma unroll
    for (int i = 0; i < 8; ++i) { X[tb + i] = make_float2(va[i], vb[i]); X[tb + i + 4096] = make_float2(0.f, 0.f); }
    fft_dif(X, W);
    {
      const float2* H = kf + (size_t)c * 8192;
#pragma unroll 4
      for (int i = 0; i < 16; ++i) { int q = tid + i * 512; X[q] = cmul(X[q], H[q]); }
    }
    fft_dit_inv(X, W);
    float za[8], zb[8];
    {
      float xa[8], xb[8];
      hy_conv8(P0 + (size_t)(256 + c) * KEYS, tb, SL, cw[256 + c], cw[768 + 256 + c], cw[1536 + 256 + c], cb[256 + c], xa);
      hy_conv8(P1 + (size_t)(256 + c) * KEYS, tb, SL, cw[256 + c], cw[768 + 256 + c], cw[1536 + 256 + c], cb[256 + c], xb);
#pragma unroll
      for (int i = 0; i < 8; ++i) {
        const float2 y = X[tb + i];
        za[i] = xa[i] * (y.x * (1.f / 8192.f) + bias0 * va[i]);
        zb[i] = xb[i] * (y.y * (1.f / 8192.f) + bias0 * vb[i]);
      }
    }
    __syncthreads();
#pragma unroll
    for (int i = 0; i < 8; ++i) { X[tb + i] = make_float2(za[i], zb[i]); X[tb + i + 4096] = make_float2(0.f, 0.f); }
    fft_dif(X, W);
    {
      const float2* H = kf + (size_t)(256 + c) * 8192;
#pragma unroll 4
      for (int i = 0; i < 16; ++i) { int q = tid + i * 512; X[q] = cmul(X[q], H[q]); }
    }
    fft_dit_inv(X, W);
    {
      float xa[8], xb[8];
      hy_conv8(P0 + (size_t)(512 + c) * KEYS, tb, SL, cw[512 + c], cw[768 + 512 + c], cw[1536 + 512 + c], cb[512 + c], xa);
      hy_conv8(P1 + (size_t)(512 + c) * KEYS, tb, SL, cw[512 + c], cw[768 + 512 + c], cw[1536 + 512 + c], cb[512 + c], xb);
#pragma unroll
      for (int i = 0; i < 8; ++i) {
        const float2 y = X[tb + i];
        const float oa = xa[i] * (y.x * (1.f / 8192.f) + bias1 * za[i]);
        const float ob = xb[i] * (y.y * (1.f / 8192.f) + bias1 * zb[i]);
        Y[((size_t)b0 * SL + tb + i) * 256 + c] = (bf16_t)f2bf(oa);
        Y[((size_t)b1 * SL + tb + i) * 256 + c] = (bf16_t)f2bf(ob);
      }
    }
  }
}

DI void ph_hyena_ctx(const Params& p, int l, char* smem) {
  const int tid = my_tid(), lane = tid & 63, wid = tid >> 6;
  float* Zb = (float*)smem + wid * 1024;
  float* Gb = Zb + 256;
  const bf16_t* PT = (const bf16_t*)(p.ws + R_PHY);
  const float* G = (const float*)(p.ws + MISC_GCTX);
  const float* cw = p.in[7] + (size_t)l * 3 * 768; const float* cb = p.in[8] + (size_t)l * 768;
  const float* hb = p.in[15] + (size_t)l * 512;
  bf16_t* Y = (bf16_t*)(p.ws + R_YHY);
  for (int base = blockIdx.x * 8; base < 2048; base += gridDim.x * 8) {
    const int u = base + wid; const int b = u >> 8, c = u & 255;
    const bf16_t* Pb = PT + ((size_t)b * 768) * KEYS + SL;
    float v[4], x1[4], x2[4], zz[4];
#pragma unroll
    for (int i = 0; i < 4; ++i) {
      int t = lane + i * 64;
      v[i] = hy_conv3(Pb + (size_t)c * KEYS, t, CL, cw[c], cw[768 + c], cw[1536 + c], cb[c]);
      x1[i] = hy_conv3(Pb + (size_t)(256 + c) * KEYS, t, CL, cw[256 + c], cw[768 + 256 + c], cw[1536 + 256 + c], cb[256 + c]);
      x2[i] = hy_conv3(Pb + (size_t)(512 + c) * KEYS, t, CL, cw[512 + c], cw[768 + 512 + c], cw[1536 + 512 + c], cb[512 + c]);
    }
    __syncthreads();
#pragma unroll
    for (int i = 0; i < 4; ++i) Zb[lane + i * 64] = v[i];
    for (int i = lane; i < 512; i += 64) Gb[i] = G[(size_t)c * 512 + i];
    __syncthreads();
#pragma unroll
    for (int i = 0; i < 4; ++i) {
      int t = lane + i * 64; float s = 0.f;
      for (int s2 = 0; s2 < 256; ++s2) s += Gb[256 + t - s2] * Zb[s2];
      zz[i] = x1[i] * (s + hb[c] * v[i]);
    }
    __syncthreads();
#pragma unroll
    for (int i = 0; i < 4; ++i) Zb[lane + i * 64] = zz[i];
    for (int i = lane; i < 512; i += 64) Gb[i] = G[(size_t)(256 + c) * 512 + i];
    __syncthreads();
#pragma unroll
    for (int i = 0; i < 4; ++i) {
      int t = lane + i * 64; float s = 0.f;
      for (int s2 = 0; s2 < 256; ++s2) s += Gb[256 + t - s2] * Zb[s2];
      float o = x2[i] * (s + hb[256 + c] * zz[i]);
      Y[((size_t)ML + b * CL + t) * 256 + c] = (bf16_t)f2bf(o);
    }
  }
}

DI void ph_rope(const Params& p, char* smem) {
  float2* T16 = (float2*)smem;
  float2* T8 = T16 + 64 * 16;
  const int tid = my_tid(), lane = tid & 63, wid = tid >> 6;
  __syncthreads();
  for (int i = tid; i < 64 * 16; i += NTHR) {
    int pos = i >> 4, f = i & 15; float inv = powf(10000.f, -(float)f / 16.f); float s, c; sincosf((float)pos * inv, &s, &c);
    T16[i] = make_float2(c, s);
  }
  for (int i = tid; i < 64 * 8; i += NTHR) {
    int pos = i >> 3, f = i & 7; float inv = powf(10000.f, -(float)f / 8.f); float s, c; sincosf((float)pos * inv, &s, &c);
    T8[i] = make_float2(c, s);
  }
  __syncthreads();
  bf16_t* Psw = (bf16_t*)(p.ws + R_PSW); bf16_t* Pdf = (bf16_t*)(p.ws + R_PDF);
  bf16_t* rowbase_ptr; int e1, e2, nf, f0; bool hsel; bool active = lane < 56;
  if (lane < 24) { const int hd = lane >> 2, half = (lane >> 1) & 1, cp = lane & 1; e1 = hd * 64 + half * 32 + cp * 8; e2 = e1 + 16; nf = 16; f0 = cp * 8; hsel = half; }
  else { const int j = lane - 24; const int gi = j >> 1, half = j & 1; e1 = gi * 32 + half * 16; e2 = e1 + 8; nf = 8; f0 = 0; hsel = half; }
  const float2* Tb = (lane < 24) ? T16 : T8;
  for (int row = blockIdx.x * 8 + wid; row < ML; row += gridDim.x * 8) {
    if (active) {
      const int t = row & (SL - 1); const int pos = hsel ? (t & 63) : (t >> 6);
      rowbase_ptr = (lane < 24) ? Psw + (size_t)row * 384 : Pdf + (size_t)row * 512;
      const uint4 u1 = *(const uint4*)(rowbase_ptr + e1), u2 = *(const uint4*)(rowbase_ptr + e2);
      const float4* cs = (const float4*)(Tb + pos * nf + f0);
      const float4 c0 = cs[0], c1 = cs[1], c2 = cs[2], c3 = cs[3];
      const unsigned w1[4] = {u1.x, u1.y, u1.z, u1.w}, w2[4] = {u2.x, u2.y, u2.z, u2.w};
      const float4 cc[4] = {c0, c1, c2, c3};
      unsigned o1[4], o2[4];
#pragma unroll
      for (int i = 0; i < 4; ++i) {
        const float xa = bflo(w1[i]), xb = bfhi(w1[i]), ya = bflo(w2[i]), yb = bfhi(w2[i]);
        o1[i] = pack2(xa * cc[i].x - ya * cc[i].y, xb * cc[i].z - yb * cc[i].w);
        o2[i] = pack2(xa * cc[i].y + ya * cc[i].x, xb * cc[i].w + yb * cc[i].z);
      }
      *(uint4*)(rowbase_ptr + e1) = make_uint4(o1[0], o1[1], o1[2], o1[3]);
      *(uint4*)(rowbase_ptr + e2) = make_uint4(o2[0], o2[1], o2[2], o2[3]);
    }
  }
}

DI float rw_shift(const bf16_t* __restrict__ P, int row, int t, int len, int col, float mu) {
  float c = bf2f(P[(size_t)row * 1216 + col]);
  float a = t >= 1 ? bf2f(P[(size_t)(row - 1) * 1216 + col]) : 0.f;
  float b = t + 1 < len ? bf2f(P[(size_t)(row + 1) * 1216 + col]) : 0.f;
  return c + (0.5f * (a + b) - c) * mu;
}
DI void ph_rwprep(const Params& p, int l, char* smem) {
  constexpr int AST = 912, RST = 1552, ROFF = 32 * AST;
  const int tid = my_tid(), lane = tid & 63, wid = tid >> 6, g = lane >> 4, r16 = lane & 15;
  const int tg = wid >> 2, hd = wid & 3;
  const bf16_t* P = (const bf16_t*)(p.ws + R_PRW);
  const float* mu = p.in[17] + (size_t)l * 1216;
  const float* w0 = p.in[18] + (size_t)l * 512; const float* a0 = p.in[20] + (size_t)l * 256;
  const float* kkw = p.in[23] + (size_t)l * 256; const float* kaw = p.in[24] + (size_t)l * 256;
  bf16_t* S = (bf16_t*)(p.ws + R_STR); bf16_t* Gs = (bf16_t*)(p.ws + R_G);
  const size_t SU = (size_t)MT * 256;
  float w0f[4], w0b[4], a0c[4], kkc[4], kac[4];
#pragma unroll
  for (int nt = 0; nt < 4; ++nt) { int c = hd * 64 + r16 * 4 + nt; w0f[nt] = w0[c]; w0b[nt] = w0[256 + c]; a0c[nt] = a0[c]; kkc[nt] = kkw[c]; kac[nt] = kaw[c]; }
  for (int u = blockIdx.x; u < MT / 32; u += gridDim.x) {
    const int row0 = u * 32; int t0, len;
    if (row0 < ML) { t0 = row0 & (SL - 1); len = SL; } else { t0 = (row0 - ML) & (CL - 1); len = CL; }
    __syncthreads();
    for (int item = tid; item < 32 * 152; item += NTHR) {
      const int tk = item / 152, c8 = item - tk * 152; const int row = row0 + tk, t = t0 + tk;
      const uint4 uc = *(const uint4*)(P + (size_t)row * 1216 + c8 * 8);
      uint4 ua = make_uint4(0, 0, 0, 0), ub = make_uint4(0, 0, 0, 0);
      if (t >= 1) ua = *(const uint4*)(P + (size_t)(row - 1) * 1216 + c8 * 8);
      if (t + 1 < len) ub = *(const uint4*)(P + (size_t)(row + 1) * 1216 + c8 * 8);
      const float4 m0 = *(const float4*)(mu + c8 * 8), m1 = *(const float4*)(mu + c8 * 8 + 4);
      float o[8];
      {
        const unsigned wc[4] = {uc.x, uc.y, uc.z, uc.w}, wa[4] = {ua.x, ua.y, ua.z, ua.w}, wb[4] = {ub.x, ub.y, ub.z, ub.w};
        const float mm[8] = {m0.x, m0.y, m0.z, m0.w, m1.x, m1.y, m1.z, m1.w};
#pragma unroll
        for (int i = 0; i < 4; ++i) {
          float c_lo = bflo(wc[i]), c_hi = bfhi(wc[i]);
          o[2 * i] = c_lo + (0.5f * (bflo(wa[i]) + bflo(wb[i])) - c_lo) * mm[2 * i];
          o[2 * i + 1] = c_hi + (0.5f * (bfhi(wa[i]) + bfhi(wb[i])) - c_hi) * mm[2 * i + 1];
        }
      }
      char* dst;
      if (c8 < 96) dst = smem + ROFF + tk * RST + c8 * 16;
      else {
        const int cc = c8 * 8 - 768;
        if (cc < 128) {
#pragma unroll
          for (int i = 0; i < 8; ++i) o[i] = 1.f - 2.f * __builtin_amdgcn_rcpf(1.f + __expf(2.f * o[i]));
        } else if (cc >= 192) {
#pragma unroll
          for (int i = 0; i < 8; ++i) o[i] = sigmoidf_(o[i]);
        }
        dst = smem + tk * AST + cc * 2;
      }
      uint4 ov; ov.x = pack2(o[0], o[1]); ov.y = pack2(o[2], o[3]); ov.z = pack2(o[4], o[5]); ov.w = pack2(o[6], o[7]);
      *(uint4*)dst = ov;
    }
    __syncthreads();
    f32x4 acc[5][4];
#pragma unroll
    for (int o5 = 0; o5 < 5; ++o5)
#pragma unroll
      for (int nt = 0; nt < 4; ++nt) acc[o5][nt] = (f32x4){0.f, 0.f, 0.f, 0.f};
    const char* Arow = smem + (tg * 16 + r16) * AST + g * 16;
#pragma unroll
    for (int o5 = 0; o5 < 5; ++o5) {
      const int kbase = o5 < 3 ? o5 * 64 : (o5 == 3 ? 192 : 320);
      const int KK = o5 < 3 ? 64 : 128;
      const bf16_t* Wt = (const bf16_t*)(p.ws + (o5 == 0 ? RWW_F : o5 == 1 ? RWW_B : o5 == 2 ? RWW_A : o5 == 3 ? RWW_GF : RWW_GB));
#pragma unroll
      for (int ks = 0; ks < KK / 32; ++ks) {
        const bf16x8 af = *(const bf16x8*)(Arow + (kbase + ks * 32) * 2);
#pragma unroll
        for (int nt = 0; nt < 4; ++nt) {
          const bf16x8 bf = *(const bf16x8*)(Wt + (size_t)(hd * 64 + nt * 16 + r16) * KK + ks * 32 + g * 8);
          acc[o5][nt] = __builtin_amdgcn_mfma_f32_16x16x32_bf16(af, bf, acc[o5][nt], 0, 0, 0);
        }
        if ((ks & 3) == 3) asm volatile("" ::: "memory");
      }
    }
#pragma unroll
    for (int j = 0; j < 4; ++j) {
      const int tk = tg * 16 + g * 4 + j; const size_t row = (size_t)row0 + tk;
      const char* rk = smem + ROFF + tk * RST;
      const int c0 = hd * 64 + r16 * 4;
      const uint2 ur = *(const uint2*)(rk + c0 * 2), uk = *(const uint2*)(rk + (256 + c0) * 2), uv = *(const uint2*)(rk + (512 + c0) * 2);
      const float rv[4] = {bflo(ur.x), bfhi(ur.x), bflo(ur.y), bfhi(ur.y)};
      const float kv[4] = {bflo(uk.x), bfhi(uk.x), bflo(uk.y), bfhi(uk.y)};
      const float vv[4] = {bflo(uv.x), bfhi(uv.x), bflo(uv.y), bfhi(uv.y)};
      float n2 = 0.f;
#pragma unroll
      for (int nt = 0; nt < 4; ++nt) { float q = kv[nt] * kkc[nt]; n2 += q * q; }
      n2 = sum16(n2);
      const float inv = __builtin_amdgcn_rsqf(fmaxf(n2, 1e-24f));
      float o_kp[4], o_kk[4], o_b[4], o_df[4], o_db[4];
#pragma unroll
      for (int nt = 0; nt < 4; ++nt) {
        const float k = kv[nt];
        const float a = sigmoidf_(a0c[nt] + acc[2][nt][j]);
        const float kk = k * kkc[nt] * inv;
        o_kp[nt] = k * (1.f + (a - 1.f) * kac[nt]);
        o_kk[nt] = kk; o_b[nt] = kk * a;
        const float xf = -(w0f[nt] + acc[0][nt][j]); const float spf = fmaxf(xf, 0.f) + __logf(1.f + __expf(-fabsf(xf)));
        const float xb = -(w0b[nt] + acc[1][nt][j]); const float spb = fmaxf(xb, 0.f) + __logf(1.f + __expf(-fabsf(xb)));
        const float ef = __expf(-spf - 0.5f), eb = __expf(-spb - 0.5f);
        o_df[nt] = 1.f - __expf(-ef); o_db[nt] = 1.f - __expf(-eb);
      }
      const size_t o = row * 256 + c0;
      uint2 w;
      w.x = pack2(rv[0], rv[1]); w.y = pack2(rv[2], rv[3]); *(uint2*)(S + o) = w;
      w.x = pack2(o_kp[0], o_kp[1]); w.y = pack2(o_kp[2], o_kp[3]); *(uint2*)(S + SU + o) = w;
      w.x = pack2(vv[0], vv[1]); w.y = pack2(vv[2], vv[3]); *(uint2*)(S + 2 * SU + o) = w;
      w.x = pack2(o_kk[0], o_kk[1]); w.y = pack2(o_kk[2], o_kk[3]); *(uint2*)(S + 3 * SU + o) = w;
      w.x = pack2(o_b[0], o_b[1]); w.y = pack2(o_b[2], o_b[3]); *(uint2*)(S + 4 * SU + o) = w;
      w.x = pack2(o_df[0], o_df[1]); w.y = pack2(o_df[2], o_df[3]); *(uint2*)(S + 5 * SU + o) = w;
      w.x = pack2(o_db[0], o_db[1]); w.y = pack2(o_db[2], o_db[3]); *(uint2*)(S + 6 * SU + o) = w;
      w.x = pack2(acc[3][0][j], acc[3][1][j]); w.y = pack2(acc[3][2][j], acc[3][3][j]); *(uint2*)(Gs + o) = w;
      w.x = pack2(acc[4][0][j], acc[4][1][j]); w.y = pack2(acc[4][2][j], acc[4][3][j]); *(uint2*)(Gs + SU + o) = w;
    }
  }
}

DI long scan_row(int b, int dir, int s) {
  if (s < CL) return (long)ML + b * CL + (dir ? (CL - 1 - s) : s);
  int t = s - CL; return (long)b * SL + (dir ? (SL - 1 - t) : t);
}
DI float sum8(float v) {
  v += dpp_mov<0xB1>(v);
  v += dpp_mov<0x4E>(v);
  v += dpp_mov<0x141>(v);
  return v;
}
DI void ph_scan(const Params& p, char* smem) {
  const int tid = my_tid(), lane = tid & 63, wid = tid >> 6;
  const bf16_t* S = (const bf16_t*)(p.ws + R_STR);
  const size_t SU = (size_t)MT * 256;
  constexpr int T = 32, NSTEP = CL + SL, NCH = NSTEP / T;
  typedef float f32x2 __attribute__((ext_vector_type(2)));
  for (int u = blockIdx.x; u < 128; u += gridDim.x) {
    const int chain = u >> 1, rg = u & 1; const int dir = chain & 1, bh = chain >> 1, b = bh >> 2, h = bh & 3;
    bf16_t* O = (bf16_t*)(p.ws + (dir ? R_OB : R_OF));
    uint4 q0, q1, q2;
    auto SC_GLOAD = [&](int ci) {
#pragma unroll
      for (int j = 0; j < 3; ++j) {
        int idx = tid + j * 512; int st = idx >> 8, s = (idx & 255) >> 3, ck = idx & 7;
        long row = scan_row(b, dir, ci * T + s);
        int sid = st < 5 ? st : 5 + dir;
        uint4 v = *(const uint4*)(S + sid * SU + row * 256 + h * 64 + ck * 8);
        if (j == 0) q0 = v; else if (j == 1) q1 = v; else q2 = v;
      }
    };
    auto SC_SSTORE = [&](int buf) {
#pragma unroll
      for (int j = 0; j < 3; ++j) {
        int idx = tid + j * 512; int st = idx >> 8;
        uint4 v = j == 0 ? q0 : (j == 1 ? q1 : q2);
        float4 lo = make_float4(bflo(v.x), bfhi(v.x), bflo(v.y), bfhi(v.y));
        float4 hi = make_float4(bflo(v.z), bfhi(v.z), bflo(v.w), bfhi(v.w));
        if (st == 5) { lo.x = 1.f - lo.x; lo.y = 1.f - lo.y; lo.z = 1.f - lo.z; lo.w = 1.f - lo.w; hi.x = 1.f - hi.x; hi.y = 1.f - hi.y; hi.z = 1.f - hi.z; hi.w = 1.f - hi.w; }
        char* base = smem + buf * 49152 + idx * 32;
        *(float4*)(base) = lo; *(float4*)(base + 16) = hi;
      }
    };
    auto FLUSH = [&](int ci) {
      const int s = tid >> 4, part = tid & 15;
      const float2 v = *(const float2*)(smem + 98304 + (ci & 1) * 4096 + s * 128 + part * 8);
      long row = scan_row(b, dir, ci * T + s);
      *(unsigned*)(O + row * 256 + h * 64 + rg * 32 + part * 2) = pack2(v.x, v.y);
    };
    __syncthreads();
    SC_GLOAD(0);
    SC_SSTORE(0);
    __syncthreads();
    f32x2 st0 = {0.f, 0.f}, st1 = {0.f, 0.f}, st2 = {0.f, 0.f}, st3 = {0.f, 0.f};
    const int rsub = lane >> 3, ks = lane & 7;
    const int lrow = (wid & 3) * 8 + rsub;
    const int vrow = rg * 32 + lrow;
    struct Step { f32x2 r[4], k[4], kk[4], b[4], w[4]; float v; };
    auto LOADSTEP = [&](Step& x, const char* B, int s) {
#pragma unroll
      for (int hh = 0; hh < 2; ++hh) {
        const float4 r = *(const float4*)(B + (0 * T + s) * 256 + ks * 32 + hh * 16);
        const float4 k = *(const float4*)(B + (1 * T + s) * 256 + ks * 32 + hh * 16);
        const float4 kk = *(const float4*)(B + (3 * T + s) * 256 + ks * 32 + hh * 16);
        const float4 bb = *(const float4*)(B + (4 * T + s) * 256 + ks * 32 + hh * 16);
        const float4 w = *(const float4*)(B + (5 * T + s) * 256 + ks * 32 + hh * 16);
        x.r[2 * hh] = (f32x2){r.x, r.y}; x.r[2 * hh + 1] = (f32x2){r.z, r.w};
        x.k[2 * hh] = (f32x2){k.x, k.y}; x.k[2 * hh + 1] = (f32x2){k.z, k.w};
        x.kk[2 * hh] = (f32x2){kk.x, kk.y}; x.kk[2 * hh + 1] = (f32x2){kk.z, kk.w};
        x.b[2 * hh] = (f32x2){bb.x, bb.y}; x.b[2 * hh + 1] = (f32x2){bb.z, bb.w};
        x.w[2 * hh] = (f32x2){w.x, w.y}; x.w[2 * hh + 1] = (f32x2){w.z, w.w};
      }
      x.v = *(const float*)(B + (2 * T + s) * 256 + vrow * 4);
    };
    for (int ci = 0; ci < NCH; ++ci) {
      if (ci + 1 < NCH) { SC_GLOAD(ci + 1); }
      if (ci > 0) FLUSH(ci - 1);
      if (wid < 4) {
        const char* B = smem + (ci & 1) * 49152;
        float* ob = (float*)(smem + 98304 + (ci & 1) * 4096);
        Step nx; LOADSTEP(nx, B, 0);
#pragma unroll 4
        for (int s = 0; s < T; ++s) {
          const Step c = nx;
          LOADSTEP(nx, B, s + 1);
          f32x2 pa = st0 * c.kk[0] + st1 * c.kk[1];
          f32x2 pb = st2 * c.kk[2] + st3 * c.kk[3];
          pa = pa + pb;
          float sa = -(pa.x + pa.y);
          sa = sum8(sa);
          const f32x2 sa2 = {sa, sa}; const f32x2 v2 = {c.v, c.v};
          st0 = st0 * c.w[0] + sa2 * c.b[0] + v2 * c.k[0];
          st1 = st1 * c.w[1] + sa2 * c.b[1] + v2 * c.k[1];
          st2 = st2 * c.w[2] + sa2 * c.b[2] + v2 * c.k[2];
          st3 = st3 * c.w[3] + sa2 * c.b[3] + v2 * c.k[3];
          f32x2 oa = st0 * c.r[0] + st1 * c.r[1];
          f32x2 ob2 = st2 * c.r[2] + st3 * c.r[3];
          oa = oa + ob2;
          float o = sum8(oa.x + oa.y);
          ob[s * 32 + lrow] = o;
        }
      }
      if (ci + 1 < NCH) { SC_SSTORE((ci + 1) & 1); }
      __syncthreads();
    }
    FLUSH(NCH - 1);
  }
}

template <bool DIFF>
DI void attn_unit(const Params& p, int l, int b, int h, int qrow0, int qpos0, int kb_lo, int kb_hi, int kc_lo, char* smem) {
  const int tid = my_tid(), lane = tid & 63, wid = tid >> 6, g = lane >> 4, r16 = lane & 15;
  const bf16_t* QK = (const bf16_t*)(p.ws + (DIFF ? R_PDF : R_PSW));
  const int ldq = DIFF ? 512 : 384;
  const int qc0 = h * 64;
  const int kc0 = 256 + (DIFF ? h * 64 : (h >> 1) * 64);
  const bf16_t* VT = DIFF ? (const bf16_t*)(p.ws + R_VTDF) + ((size_t)b * 256 + h * 64) * KEYS
                          : (const bf16_t*)(p.ws + R_VTSW) + ((size_t)b * 128 + (h >> 1) * 64) * KEYS;
  const int nblk = (kb_hi - kb_lo) + (68 - kc_lo);
  const float sc = (DIFF ? 0.17677669529663687f : 0.125f) * 1.4426950408889634f;
  bf16x8 qf[2];
  {
    const bf16_t* qp = QK + (size_t)(qrow0 + wid * 16 + r16) * ldq + qc0 + g * 8;
    qf[0] = *(const bf16x8*)(qp); qf[1] = *(const bf16x8*)(qp + 32);
  }
  constexpr int NC = DIFF ? 2 : 1;
  float m[NC], lsum[NC];
  f32x4 O[NC][4];
#pragma unroll
  for (int c = 0; c < NC; ++c) {
    if (DIFF) { m[c] = -1e30f; lsum[c] = 0.f; }
    else { m[c] = p.in[16][l * 4 + h] * 1.4426950408889634f; lsum[c] = (g == 0) ? 1.f : 0.f; }
#pragma unroll
    for (int dt = 0; dt < 4; ++dt) O[c][dt] = (f32x4){0.f, 0.f, 0.f, 0.f};
  }
  const int lr = tid >> 3, lc = tid & 7;
  uint4 rkA, rvA, rkB, rvB;
  rkA = make_uint4(0, 0, 0, 0); rvA = rkA; rkB = rkA; rvB = rkA;
  auto AT_GLOAD = [&](int i, uint4& rk, uint4& rv) {
    int kb = i < (kb_hi - kb_lo) ? kb_lo + i : kc_lo + (i - (kb_hi - kb_lo));
    long krow = kb < 64 ? (long)b * SL + kb * 64 + lr : (long)ML + b * CL + (kb - 64) * 64 + lr;
    rk = *(const uint4*)(QK + krow * ldq + kc0 + lc * 8);
    rv = *(const uint4*)(VT + (size_t)lr * KEYS + kb * 64 + lc * 8);
  };
  auto AT_SSTORE = [&](int buf, const uint4& rk, const uint4& rv) {
    *(uint4*)(smem + buf * 18432 + lr * 128 + ((lc ^ (lr & 7)) << 4)) = rk;
    *(uint4*)(smem + buf * 18432 + 9216 + lr * 144 + lc * 16) = rv;
  };
  __syncthreads();
  AT_GLOAD(0, rkA, rvA);
  AT_SSTORE(0, rkA, rvA);
  if (1 < nblk) AT_GLOAD(1, rkA, rvA);
  if (2 < nblk) AT_GLOAD(2, rkB, rvB);
  lds_barrier();
  const int qpos = qpos0 + wid * 16 + r16;
  for (int i = 0; i < nblk; ++i) {
    const int kb = i < (kb_hi - kb_lo) ? kb_lo + i : kc_lo + (i - (kb_hi - kb_lo));
    const bool masked = (!DIFF) && (kb < 64);
    const char* Kt = smem + (i & 1) * 18432; const char* Vt = Kt + 9216;
    f32x4 S[NC][4];
#pragma unroll
    for (int kt = 0; kt < 4; ++kt) {
      bf16x8 k0 = *(const bf16x8*)(Kt + (kt * 16 + r16) * 128 + ((g ^ (r16 & 7)) << 4));
      bf16x8 k1 = *(const bf16x8*)(Kt + (kt * 16 + r16) * 128 + (((4 + g) ^ (r16 & 7)) << 4));
      if (DIFF) {
        S[0][kt] = __builtin_amdgcn_mfma_f32_16x16x32_bf16(k0, qf[0], (f32x4){0.f, 0.f, 0.f, 0.f}, 0, 0, 0);
        S[NC - 1][kt] = __builtin_amdgcn_mfma_f32_16x16x32_bf16(k1, qf[1], (f32x4){0.f, 0.f, 0.f, 0.f}, 0, 0, 0);
      } else {
        f32x4 t = __builtin_amdgcn_mfma_f32_16x16x32_bf16(k0, qf[0], (f32x4){0.f, 0.f, 0.f, 0.f}, 0, 0, 0);
        S[0][kt] = __builtin_amdgcn_mfma_f32_16x16x32_bf16(k1, qf[1], t, 0, 0, 0);
      }
    }
    bf16x8 pf[NC][2];
#pragma unroll
    for (int c = 0; c < NC; ++c) {
      float mx = -1e30f;
#pragma unroll
      for (int kt = 0; kt < 4; ++kt)
#pragma unroll
        for (int j = 0; j < 4; ++j) {
          float v = S[c][kt][j];
          if (masked) { int kpos = kb * 64 + kt * 16 + g * 4 + j; int dd = kpos - qpos; if (dd > 128 || dd < -128) v = -3e38f; S[c][kt][j] = v; }
          mx = fmaxf(mx, v);
        }
      mx *= sc;
      mx = fmaxf(mx, __shfl_xor(mx, 16)); mx = fmaxf(mx, __shfl_xor(mx, 32));
      const float mn = fmaxf(m[c], mx);
      const bool grow = mn > m[c];
      float ps = 0.f;
      unsigned pk[8];
#pragma unroll
      for (int kt = 0; kt < 4; ++kt) {
        float e0 = __builtin_amdgcn_exp2f(fmaf(S[c][kt][0], sc, -mn)), e1 = __builtin_amdgcn_exp2f(fmaf(S[c][kt][1], sc, -mn));
        float e2 = __builtin_amdgcn_exp2f(fmaf(S[c][kt][2], sc, -mn)), e3 = __builtin_amdgcn_exp2f(fmaf(S[c][kt][3], sc, -mn));
        ps += (e0 + e1) + (e2 + e3);
        pk[kt * 2] = pack2(e0, e1); pk[kt * 2 + 1] = pack2(e2, e3);
      }
      if (__builtin_amdgcn_ballot_w64(grow) != 0ull) {
        const float alpha = __builtin_amdgcn_exp2f(m[c] - mn);
        m[c] = mn;
        lsum[c] *= alpha;
#pragma unroll
        for (int dt = 0; dt < 4; ++dt) { O[c][dt][0] *= alpha; O[c][dt][1] *= alpha; O[c][dt][2] *= alpha; O[c][dt][3] *= alpha; }
      }
      lsum[c] += ps;
      union { unsigned u[4]; bf16x8 v; } cv;
      cv.u[0] = pk[0]; cv.u[1] = pk[1]; cv.u[2] = pk[2]; cv.u[3] = pk[3]; pf[c][0] = cv.v;
      cv.u[0] = pk[4]; cv.u[1] = pk[5]; cv.u[2] = pk[6]; cv.u[3] = pk[7]; pf[c][1] = cv.v;
    }
#pragma unroll
    for (int dt = 0; dt < 4; ++dt)
#pragma unroll
      for (int s2 = 0; s2 < 2; ++s2) {
        union { uint2 u[2]; bf16x8 v; } vf;
        vf.u[0] = *(const uint2*)(Vt + (dt * 16 + r16) * 144 + (2 * s2) * 32 + g * 8);
        vf.u[1] = *(const uint2*)(Vt + (dt * 16 + r16) * 144 + (2 * s2 + 1) * 32 + g * 8);
#pragma unroll
        for (int c = 0; c < NC; ++c) O[c][dt] = __builtin_amdgcn_mfma_f32_16x16x32_bf16(vf.v, pf[c][s2], O[c][dt], 0, 0, 0);
      }
    if (i + 1 < nblk) AT_SSTORE((i + 1) & 1, rkA, rvA);
    rkA = rkB; rvA = rvB;
    if (i + 3 < nblk) AT_GLOAD(i + 3, rkB, rvB);
    lds_barrier();
  }
  float linv[NC];
#pragma unroll
  for (int c = 0; c < NC; ++c) { float t = lsum[c]; t += __shfl_xor(t, 16); t += __shfl_xor(t, 32); linv[c] = 1.f / t; }
  const size_t orow = (size_t)(qrow0 + wid * 16 + r16);
  if (!DIFF) {
    bf16_t* Y = (bf16_t*)(p.ws + R_YSW);
#pragma unroll
    for (int dt = 0; dt < 4; ++dt) {
      uint2 o; o.x = pack2(O[0][dt][0] * linv[0], O[0][dt][1] * linv[0]); o.y = pack2(O[0][dt][2] * linv[0], O[0][dt][3] * linv[0]);
      *(uint2*)(Y + orow * 256 + h * 64 + dt * 16 + g * 4) = o;
    }
  } else {
    const float lam_init = 0.8f - 0.6f * __expf(-0.3f * (float)l);
    float d1 = 0.f, d2 = 0.f;
    if (lane < 32) { d1 = p.in[28][l * 32 + lane] * p.in[29][l * 32 + lane]; d2 = p.in[30][l * 32 + lane] * p.in[31][l * 32 + lane]; }
    d1 = wave_sum(d1); d2 = wave_sum(d2);
    const float lam = expf(d1) - expf(d2) + lam_init;
    float ov[4][4]; float ss = 0.f;
#pragma unroll
    for (int dt = 0; dt < 4; ++dt)
#pragma unroll
      for (int j = 0; j < 4; ++j) { float v = O[0][dt][j] * linv[0] - lam * O[NC - 1][dt][j] * linv[NC - 1]; ov[dt][j] = v; ss += v * v; }
    ss += __shfl_xor(ss, 16); ss += __shfl_xor(ss, 32);
    const float rms = rsqrtf(ss * (1.f / 64.f) + 1e-5f) * (1.f - lam_init);
    const float* sg = p.in[32] + l * 64;
    bf16_t* Y = (bf16_t*)(p.ws + R_YDF);
#pragma unroll
    for (int dt = 0; dt < 4; ++dt) {
      const int d0 = dt * 16 + g * 4;
      uint2 o; o.x = pack2(ov[dt][0] * rms * sg[d0], ov[dt][1] * rms * sg[d0 + 1]); o.y = pack2(ov[dt][2] * rms * sg[d0 + 2], ov[dt][3] * rms * sg[d0 + 3]);
      *(uint2*)(Y + orow * 256 + h * 64 + d0) = o;
    }
  }
}

DI void ph_attn(const Params& p, int l, char* smem) {
  const bool need_ctx = (l == 0);
  const int n_sw = 1024 + (need_ctx ? 64 : 0);
  const int n_df = 1024 + (need_ctx ? 64 : 0);
  unsigned* ctr = (unsigned*)(p.ws + MISC_BAR + 64 + 64 * l);
  volatile int* slot = (volatile int*)(smem + 40960);
  for (;;) {
    __syncthreads();
    if (my_tid() == 0) *slot = (int)__hip_atomic_fetch_add(ctr, 1u, __ATOMIC_RELAXED, __HIP_MEMORY_SCOPE_AGENT);
    __syncthreads();
    const int u = *slot;
    if (u >= n_sw + n_df) break;
    if (u < n_df) {
      if (u < 1024) { int b = u >> 7, h = (u >> 5) & 3, n = u & 31; attn_unit<true>(p, l, b, h, b * SL + n * 128, n * 128, 0, 64, 64, smem); }
      else { int v = u - 1024; int b = v >> 3, h = (v >> 1) & 3, n = v & 1; attn_unit<true>(p, l, b, h, ML + b * CL + n * 128, 0, 0, 0, 64, smem); }
    } else {
      int w = u - n_df;
      if (w < 1024) {
        int b = w >> 7, h = (w >> 5) & 3, n = w & 31;
        int lo = (n - 1) * 2; if (lo < 0) lo = 0; int hi = (n + 2) * 2; if (hi > 64) hi = 64;
        attn_unit<false>(p, l, b, h, b * SL + n * 128, n * 128, lo, hi, 64, smem);
      } else { int v = w - 1024; int b = v >> 3, h = (v >> 1) & 3, n = v & 1; attn_unit<false>(p, l, b, h, ML + b * CL + n * 128, 0, 0, 0, 64, smem); }
    }
  }
}

DI void ph_rwout(const Params& p, int l) {
  const int lane = my_tid() & 63, wid = my_tid() >> 6;
  const bf16_t* S = (const bf16_t*)(p.ws + R_STR); const bf16_t* Gs = (const bf16_t*)(p.ws + R_G);
  const bf16_t* OF = (const bf16_t*)(p.ws + R_OF); const bf16_t* OB = (const bf16_t*)(p.ws + R_OB);
  bf16_t* Y = (bf16_t*)(p.ws + R_YRW);
  const size_t SU = (size_t)MT * 256;
  const float4 rk = *(const float4*)(p.in[25] + (size_t)l * 256 + lane * 4);
  const float4 gam = *(const float4*)(p.in[26] + (size_t)l * 256 + lane * 4);
  const float4 bet = *(const float4*)(p.in[27] + (size_t)l * 256 + lane * 4);
  const int nrows = (l == 0) ? MT : ML;
  for (int row = blockIdx.x * 8 + wid; row < nrows; row += gridDim.x * 8) {
    const size_t o = (size_t)row * 256 + lane * 4;
    uint2 ur = *(const uint2*)(S + o), uk = *(const uint2*)(S + SU + o), uv = *(const uint2*)(S + 2 * SU + o);
    uint2 uf = *(const uint2*)(OF + o), ub = *(const uint2*)(OB + o), ugf = *(const uint2*)(Gs + o), ugb = *(const uint2*)(Gs + SU + o);
    float r[4] = {bflo(ur.x), bfhi(ur.x), bflo(ur.y), bfhi(ur.y)};
    float k[4] = {bflo(uk.x), bfhi(uk.x), bflo(uk.y), bfhi(uk.y)};
    float v[4] = {bflo(uv.x), bfhi(uv.x), bflo(uv.y), bfhi(uv.y)};
    float f[4] = {bflo(uf.x), bfhi(uf.x), bflo(uf.y), bfhi(uf.y)};
    float bb[4] = {bflo(ub.x), bfhi(ub.x), bflo(ub.y), bfhi(ub.y)};
    float gf[4] = {bflo(ugf.x), bfhi(ugf.x), bflo(ugf.y), bfhi(ugf.y)};
    float gb[4] = {bflo(ugb.x), bfhi(ugb.x), bflo(ugb.y), bfhi(ugb.y)};
    const float rkv[4] = {rk.x, rk.y, rk.z, rk.w}; const float ga[4] = {gam.x, gam.y, gam.z, gam.w}; const float be[4] = {bet.x, bet.y, bet.z, bet.w};
    float bon = 0.f, sf = 0.f, sb = 0.f;
#pragma unroll
    for (int i = 0; i < 4; ++i) { bon += r[i] * k[i] * rkv[i]; sf += f[i]; sb += bb[i]; }
    bon = sum16(bon); float muf = sum16(sf) * (1.f / 64.f), mub = sum16(sb) * (1.f / 64.f);
    float qf = 0.f, qb = 0.f;
#pragma unroll
    for (int i = 0; i < 4; ++i) { f[i] -= muf; bb[i] -= mub; qf += f[i] * f[i]; qb += bb[i] * bb[i]; }
    float rsf = rsqrtf(sum16(qf) * (1.f / 64.f) + 64e-5f), rsb = rsqrtf(sum16(qb) * (1.f / 64.f) + 64e-5f);
    float y[4];
#pragma unroll
    for (int i = 0; i < 4; ++i) {
      float bn = bon * v[i];
      y[i] = (f[i] * rsf * ga[i] + be[i] + bn) * gf[i] + (bb[i] * rsb * ga[i] + be[i] + bn) * gb[i];
    }
    uint2 oo; oo.x = pack2(y[0], y[1]); oo.y = pack2(y[2], y[3]);
    *(uint2*)(Y + o) = oo;
  }
}

DI void ph_merge(const Params& p, int l, const bf16_t* U, char* smem) {
  const int lane = my_tid() & 63, wid = my_tid() >> 6, wm = wid >> 1, wn = wid & 1, g = lane >> 4, r16 = lane & 15;
  const int mtiles = (l == 0) ? 136 : 128;
  bf16_t* ACC = (bf16_t*)(p.ws + R_ACC);
  for (int it = 0;; ++it) {
    int mtile, ntile;
    if (!next_tile(it, mtiles, 8, mtile, ntile)) break;
    uint2 accS[4][4];
#pragma unroll
    for (int mt = 0; mt < 4; ++mt)
#pragma unroll
      for (int nt = 0; nt < 4; ++nt) accS[mt][nt] = make_uint2(0u, 0u);
    for (int j = 0; j < 4; ++j) {
      uint2 pb[4][4];
      {
        f32x4 accB[4][4]; zero_acc<4>(accB);
        const size_t yoff = (j == 0) ? R_YHY : (j == 1) ? R_YSW : (j == 2) ? R_YRW : R_YDF;
        gemm_glds(accB, (const bf16_t*)(p.ws + yoff), 256, RowPlain{(long)mtile * 256}, (const bf16_t*)(p.ws + WB_BR) + ((size_t)j * 1024 + ntile * 128) * 256, 256, 256, smem, (const bf16_t*)(p.ws + MISC_ZERO));
#pragma unroll
        for (int mt = 0; mt < 4; ++mt)
#pragma unroll
          for (int nt = 0; nt < 4; ++nt) { pb[mt][nt].x = pack2(accB[mt][nt][0], accB[mt][nt][1]); pb[mt][nt].y = pack2(accB[mt][nt][2], accB[mt][nt][3]); }
      }
      f32x4 accG[4][4]; zero_acc<4>(accG);
      gemm_glds(accG, U, 1024, RowPlain{(long)mtile * 256}, (const bf16_t*)(p.ws + WB_GATE) + ((size_t)j * 1024 + ntile * 128) * 1024, 1024, 1024, smem, (const bf16_t*)(p.ws + MISC_ZERO));
#pragma unroll
      for (int mt = 0; mt < 4; ++mt)
#pragma unroll
        for (int nt = 0; nt < 4; ++nt) {
          float v0 = bflo(accS[mt][nt].x) + sigmoidf_(accG[mt][nt][0]) * bflo(pb[mt][nt].x);
          float v1 = bfhi(accS[mt][nt].x) + sigmoidf_(accG[mt][nt][1]) * bfhi(pb[mt][nt].x);
          float v2 = bflo(accS[mt][nt].y) + sigmoidf_(accG[mt][nt][2]) * bflo(pb[mt][nt].y);
          float v3 = bfhi(accS[mt][nt].y) + sigmoidf_(accG[mt][nt][3]) * bfhi(pb[mt][nt].y);
          accS[mt][nt].x = pack2(v0, v1); accS[mt][nt].y = pack2(v2, v3);
        }
    }
#pragma unroll
    for (int mt = 0; mt < 4; ++mt) {
      const int col = ntile * 128 + wn * 64 + r16 * 4;
      const size_t row = (size_t)mtile * 256 + wm * 64 + mt * 16 + g * 4;
      uint2 o;
      o.x = (accS[mt][0].x & 0xffffu) | (accS[mt][1].x << 16); o.y = (accS[mt][2].x & 0xffffu) | (accS[mt][3].x << 16);
      *(uint2*)(ACC + (row + 0) * 1024 + col) = o;
      o.x = (accS[mt][0].x >> 16) | (accS[mt][1].x & 0xffff0000u); o.y = (accS[mt][2].x >> 16) | (accS[mt][3].x & 0xffff0000u);
      *(uint2*)(ACC + (row + 1) * 1024 + col) = o;
      o.x = (accS[mt][0].y & 0xffffu) | (accS[mt][1].y << 16); o.y = (accS[mt][2].y & 0xffffu) | (accS[mt][3].y << 16);
      *(uint2*)(ACC + (row + 2) * 1024 + col) = o;
      o.x = (accS[mt][0].y >> 16) | (accS[mt][1].y & 0xffff0000u); o.y = (accS[mt][2].y >> 16) | (accS[mt][3].y & 0xffff0000u);
      *(uint2*)(ACC + (row + 3) * 1024 + col) = o;
    }
  }
}

DI void ph_resgemm(const Params& p, int l, const bf16_t* A, int K, const bf16_t* Bt, const float* hsrc_lat, const float* hsrc_ctx, int gate_off, char* smem) {
  const int lane = my_tid() & 63, wid = my_tid() >> 6, wm = wid >> 1, wn = wid & 1, g = lane >> 4, r16 = lane & 15;
  const int mtiles = (l == 0) ? 136 : 128;
  const float* mod = (const float*)(p.ws + MISC_MOD) + (size_t)l * 9 * 6144;
  float* hc = (float*)(p.ws + OFF_HC);
  for (int it = 0;; ++it) {
    int mtile, ntile;
    if (!next_tile(it, mtiles, 8, mtile, ntile)) break;
    f32x4 acc[4][4]; zero_acc<4>(acc);
    gemm_glds(acc, A, K, RowPlain{(long)mtile * 256}, Bt + (size_t)ntile * 128 * K, K, K, smem, (const bf16_t*)(p.ws + MISC_ZERO));
    const int b = mtile < 128 ? (mtile >> 4) : 8;
    const float* gt = mod + (size_t)b * 6144 + gate_off;
    const int col = ntile * 128 + wn * 64 + r16 * 4;
    const float4 gv = *(const float4*)(gt + col);
    const float* hs_tile = mtile < 128 ? hsrc_lat + (size_t)mtile * 256 * D : hsrc_ctx + (size_t)(mtile - 128) * 256 * D;
    float* hd_tile = mtile < 128 ? p.out + (size_t)mtile * 256 * D : hc + (size_t)(mtile - 128) * 256 * D;
#pragma unroll
    for (int mt = 0; mt < 4; ++mt)
#pragma unroll
      for (int e = 0; e < 4; ++e) {
        const size_t o = (size_t)(wm * 64 + mt * 16 + g * 4 + e) * D + col;
        const float* hs = hs_tile + o; float* hd = hd_tile + o;
        const float4 h = *(const float4*)hs;
        float4 r;
        r.x = DN_ALPHA * h.x + gv.x * acc[mt][0][e]; r.y = DN_ALPHA * h.y + gv.y * acc[mt][1][e];
        r.z = DN_ALPHA * h.z + gv.z * acc[mt][2][e]; r.w = DN_ALPHA * h.w + gv.w * acc[mt][3][e];
        *(float4*)hd = r;
      }
  }
}

DI void ph_ffnup(const Params& p, int l, char* smem) {
  const bf16_t* U = (const bf16_t*)(p.ws + R_U);
  const bf16_t* Bt = (const bf16_t*)(p.ws + WB_UP);
  bf16_t* HID = (bf16_t*)(p.ws + R_HID);
  const float* cw = p.in[38] + (size_t)l * 3 * 5632; const float* cb = p.in[39] + (size_t)l * 5632;
  const int tid = my_tid(), lane = tid & 63, wid = tid >> 6, wm = wid >> 2, wn = wid & 3, g = lane >> 4, r16 = lane & 15;
  const int mtiles = (l == 0) ? 144 : 136;
  constexpr int TS = 528;
  for (int it = 0;; ++it) {
    int mtile, ntile;
    if (!next_tile(it, mtiles, 22, mtile, ntile)) break;
    long rowbase; int t0, len, r0, r1;
    if (mtile < 136) { int b = mtile / 17; int tt = mtile % 17; len = SL; rowbase = (long)b * SL; t0 = tt * 254 - 1; r0 = 1; r1 = 254; }
    else { int b = mtile - 136; len = CL; rowbase = (long)ML + b * CL; t0 = 0; r0 = 0; r1 = 255; }
    f32x4 acc[8][4]; zero_acc256(acc);
    gemm_glds256(acc, U, 1024, rowbase + t0, Bt + (size_t)ntile * 256 * 1024, 1024, 1024, smem);
#pragma unroll
    for (int mt = 0; mt < 8; ++mt)
#pragma unroll
      for (int e = 0; e < 4; ++e) {
        uint2 o; o.x = pack2(acc[mt][0][e], acc[mt][1][e]); o.y = pack2(acc[mt][2][e], acc[mt][3][e]);
        *(uint2*)(smem + (wm * 128 + mt * 16 + g * 4 + e) * TS + (wn * 64 + r16 * 4) * 2) = o;
      }
    __syncthreads();
    {
      const int ch = (tid & 31) * 4, rgp = tid >> 5; const int ca = ntile * 128 + ch, cbx = 2816 + ca;
      const float4 wa0 = *(const float4*)(cw + ca), wa1 = *(const float4*)(cw + 5632 + ca), wa2 = *(const float4*)(cw + 2 * 5632 + ca), wab = *(const float4*)(cb + ca);
      const float4 wb0 = *(const float4*)(cw + cbx), wb1 = *(const float4*)(cw + 5632 + cbx), wb2 = *(const float4*)(cw + 2 * 5632 + cbx), wbb = *(const float4*)(cb + cbx);
      for (int r = r0 + rgp; r <= r1; r += 16) {
        const int tok = t0 + r;
        if (tok < len) {
          const char* Tr = smem + r * TS + ch * 2;
          const uint2 z2 = make_uint2(0u, 0u);
          const uint2 ua = *(const uint2*)(Tr), ub = *(const uint2*)(Tr + 256);
          const uint2 pa = tok >= 1 ? *(const uint2*)(Tr - TS) : z2, pb_ = tok >= 1 ? *(const uint2*)(Tr - TS + 256) : z2;
          const uint2 na = tok + 1 < len ? *(const uint2*)(Tr + TS) : z2, nb = tok + 1 < len ? *(const uint2*)(Tr + TS + 256) : z2;
          const float av0 = wa0.x * bflo(pa.x) + wa1.x * bflo(ua.x) + wa2.x * bflo(na.x) + wab.x;
          const float av1 = wa0.y * bfhi(pa.x) + wa1.y * bfhi(ua.x) + wa2.y * bfhi(na.x) + wab.y;
          const float av2 = wa0.z * bflo(pa.y) + wa1.z * bflo(ua.y) + wa2.z * bflo(na.y) + wab.z;
          const float av3 = wa0.w * bfhi(pa.y) + wa1.w * bfhi(ua.y) + wa2.w * bfhi(na.y) + wab.w;
          const float bv0 = wb0.x * bflo(pb_.x) + wb1.x * bflo(ub.x) + wb2.x * bflo(nb.x) + wbb.x;
          const float bv1 = wb0.y * bfhi(pb_.x) + wb1.y * bfhi(ub.x) + wb2.y * bfhi(nb.x) + wbb.y;
          const float bv2 = wb0.z * bflo(pb_.y) + wb1.z * bflo(ub.y) + wb2.z * bflo(nb.y) + wbb.z;
          const float bv3 = wb0.w * bfhi(pb_.y) + wb1.w * bfhi(ub.y) + wb2.w * bfhi(nb.y) + wbb.w;
          uint2 o; o.x = pack2(siluf_(av0) * bv0, siluf_(av1) * bv1); o.y = pack2(siluf_(av2) * bv2, siluf_(av3) * bv3);
          *(uint2*)(HID + (size_t)(rowbase + tok) * 2816 + ca) = o;
        }
      }
    }
  }
}

#ifndef REP_PREP
#define REP_PREP 1
#endif
#ifndef REP_GEMM
#define REP_GEMM 1
#endif
#ifndef REP_HY
#define REP_HY 1
#endif
#ifndef REP_RWP
#define REP_RWP 1
#endif
#ifndef REP_SCAN
#define REP_SCAN 1
#endif
#ifndef REP_ATTN
#define REP_ATTN 1
#endif
#ifndef PH_END
#define PH_END 24
#endif
#define XB_TMO      128
#define XB_XCNT(j)  (256  + 64 * (j))
#define XB_XSUB(j)  (1280 + 64 * (j))
#define XB_XGEN(j)  (2304 + 64 * (j))
#define XB_TOP      3328
#define XB_TOPGEN   3392
#define XCD_BAR_WORDS 3456
#define XB_SPIN_CAP (1u << 22)
DI unsigned xb_ld(unsigned* p) { return __hip_atomic_load(p, __ATOMIC_RELAXED, __HIP_MEMORY_SCOPE_AGENT); }
DI unsigned xb_add(unsigned* p, unsigned v) { return __hip_atomic_fetch_add(p, v, __ATOMIC_RELAXED, __HIP_MEMORY_SCOPE_AGENT); }
DI unsigned xb_xcc_id() { return (unsigned)__builtin_amdgcn_s_getreg((3 << 11) | 20) & 0xFu; }
#define XB_SPIN(cond, bar) do { unsigned _sp = 0; while (cond) { __builtin_amdgcn_s_sleep(1); \
    if ((++_sp & 255u) == 0u) { if (xb_ld(&(bar)[XB_TMO])) break; if (_sp > XB_SPIN_CAP) { atomicAdd(&(bar)[XB_TMO], 1u); break; } } } } while (0)
DI void xcd_barrier_complete(unsigned* bar, unsigned x, unsigned& nloc, unsigned& nx) {
  const unsigned G = gridDim.x;
  unsigned sum, cnt, mine, sp = 0u;
  for (;;) {
    sum = 0u; cnt = 0u; mine = 0u;
#pragma unroll
    for (unsigned j = 0; j < 16; ++j) { const unsigned c = xb_ld(&bar[XB_XCNT(j)]); sum += c; cnt += (c > 0u) ? 1u : 0u; mine = (j == x) ? c : mine; }
    if (sum == G) break;
    __builtin_amdgcn_s_sleep(1);
    if ((++sp & 255u) == 0u) { if (xb_ld(&bar[XB_TMO])) break; if (sp > XB_SPIN_CAP) { atomicAdd(&bar[XB_TMO], 1u); break; } }
  }
  nloc = mine > 0u ? mine : 1u; nx = cnt > 0u ? cnt : 1u;
}
DI void grid_barrier(unsigned* bar, volatile unsigned* st) {
  asm volatile("s_waitcnt vmcnt(0)" ::: "memory");
  __syncthreads();
  if (my_tid() == 0) {
    const unsigned x = xb_xcc_id();
    __builtin_amdgcn_s_waitcnt(0);
    unsigned nloc = st[0], nx = st[1];
    if (nloc == 0u) { xcd_barrier_complete(bar, x, nloc, nx); st[0] = nloc; st[1] = nx; }
    const unsigned old = xb_add(&bar[XB_XSUB(x)], 1u);
    const unsigned gen = old / nloc;
    if (old + 1u == (gen + 1u) * nloc) {
      __builtin_amdgcn_fence(__ATOMIC_RELEASE, "agent");
      asm volatile("s_waitcnt vmcnt(0)" ::: "memory");
      const unsigned og = xb_add(&bar[XB_TOP], 1u);
      const unsigned tg = og / nx;
      if (og + 1u == (tg + 1u) * nx) xb_add(&bar[XB_TOPGEN], 1u);
      else XB_SPIN(xb_ld(&bar[XB_TOPGEN]) == tg, bar);
      __builtin_amdgcn_fence(__ATOMIC_ACQUIRE, "agent");
      xb_add(&bar[XB_XGEN(x)], 1u);
      asm volatile("s_waitcnt vmcnt(0)" ::: "memory");
    } else {
      XB_SPIN(xb_ld(&bar[XB_XGEN(x)]) == gen, bar);
      __builtin_amdgcn_fence(__ATOMIC_ACQUIRE, "agent");
      asm volatile("s_waitcnt vmcnt(0)" ::: "memory");
    }
  }
  __syncthreads();
}
#define SYNC_OR_RET(idx) do { if ((idx) + 1 >= PH_END) return; if ((idx) == 0) { grid.sync(); if (my_tid() == 0) (void)xb_add(&((unsigned*)(p.ws + MISC_XBAR))[XB_XCNT(xb_xcc_id())], 1u); } else grid_barrier((unsigned*)(p.ws + MISC_XBAR), (volatile unsigned*)(smem + 144 * 1024)); } while (0)
template <int l>
DI void run_layer(const Params& p, cg::grid_group& grid, char* smem, unsigned& epoch) {
  const float* mod = (const float*)(p.ws + MISC_MOD) + (size_t)l * 9 * 6144;
  float* hc = (float*)(p.ws + OFF_HC);
  const float* hl_src = (l == 0) ? p.in[0] : p.out;
  const float* hc_src = (l == 0) ? p.in[2] : hc;
  constexpr int B0 = l * 12;
  if (l == 0) {
    ph_convert(p, 0, smem);
    ph_ada(p, smem);
    hy_rawfilter(p, 0, SL, (float*)(p.ws + R_RAWF), smem);
    hy_rawfilter(p, 0, CL, (float*)(p.ws + MISC_RAWC), smem);
    SYNC_OR_RET(B0 + 0);
    ph_kf(p, 0, smem);
    ph_ln(hl_src, hc_src, nullptr, nullptr, nullptr, nullptr, (bf16_t*)p.out, mod, 0, MT);
    SYNC_OR_RET(B0 + 1);
  }
  for (int rep = 0; rep < REP_GEMM; ++rep) ph_inproj(p, l == 0 ? (const bf16_t*)p.out : (const bf16_t*)(p.ws + R_U), smem);
  SYNC_OR_RET(B0 + 2);
  for (int rep = 0; rep < REP_HY; ++rep) {
  if (blockIdx.x == 0 && my_tid() == 0) *(unsigned*)(p.ws + MISC_BAR + 64 + 64 * l) = 0u;
  ph_hyena(p, l, smem);
  if (l == 0) ph_hyena_ctx(p, l, smem);
  }
  ph_rope(p, smem);
  for (int rep = 0; rep < REP_RWP; ++rep) ph_rwprep(p, l, smem);
  SYNC_OR_RET(B0 + 3);
  for (int rep = 0; rep < REP_SCAN; ++rep) ph_scan(p, smem);
  for (int rep = 0; rep < REP_ATTN; ++rep) ph_attn(p, l, smem);
  SYNC_OR_RET(B0 + 4);
  ph_rwout(p, l);
  if (l != 0) ph_ln(hl_src, hc_src, nullptr, nullptr, nullptr, nullptr, (bf16_t*)(p.ws + R_URE), mod, 0, ML);
  SYNC_OR_RET(B0 + 5);
  for (int rep = 0; rep < REP_GEMM; ++rep) ph_merge(p, l, l == 0 ? (const bf16_t*)p.out : (const bf16_t*)(p.ws + R_URE), smem);
  SYNC_OR_RET(B0 + 6);
  ph_resgemm(p, l, (const bf16_t*)(p.ws + R_ACC), 1024, (const bf16_t*)(p.ws + WB_OUT), hl_src, hc_src, 2048, smem);
  if (l == 0) hy_rawfilter(p, 1, SL, (float*)(p.ws + R_RAWF), smem);
  SYNC_OR_RET(B0 + 7);
  ph_ln(p.out, hc, p.out, hc, p.in[35] + (size_t)l * D, p.in[36] + (size_t)l * D, (bf16_t*)(p.ws + R_U), mod, 3072, l == 0 ? MT : ML);
  if (l == 0) ph_kf(p, 1, smem);
  SYNC_OR_RET(B0 + 8);
  for (int rep = 0; rep < REP_GEMM; ++rep) ph_ffnup(p, l, smem);
  SYNC_OR_RET(B0 + 9);
  ph_resgemm(p, l, (const bf16_t*)(p.ws + R_HID), 2816, (const bf16_t*)(p.ws + WB_DOWN), p.out, hc, 5120, smem);
  SYNC_OR_RET(B0 + 10);
  if (l == 0) {
    ph_ln(p.out, hc, p.out, hc, p.in[41], p.in[42], (bf16_t*)(p.ws + R_U), mod + 9 * 6144, 0, MT);
    ph_convert(p, 1, smem);
  } else {
    ph_ln(p.out, hc, p.out, hc, p.in[41] + (size_t)l * D, p.in[42] + (size_t)l * D, nullptr, mod, 0, ML);
  }
  SYNC_OR_RET(B0 + 11);
}

__global__ void __launch_bounds__(NTHR) mega(Params p) {
  extern __shared__ __attribute__((aligned(16))) char smem[];
  cg::grid_group grid = cg::this_grid();
  unsigned epoch = 0;
  if (blockIdx.x == 0) for (int i = my_tid(); i < XCD_BAR_WORDS; i += NTHR) ((unsigned*)(p.ws + MISC_XBAR))[i] = 0u;
  if (my_tid() < 2) ((volatile unsigned*)(smem + 144 * 1024))[my_tid()] = 0u;
  if (blockIdx.x == 0 && my_tid() < 64) *(unsigned*)(p.ws + MISC_ZERO + my_tid() * 4) = 0u;
  run_layer<0>(p, grid, smem, epoch);
  if (PH_END > 12) run_layer<1>(p, grid, smem, epoch);
}

extern "C" void kernel_launch(void* const* d_in, const int* in_sizes, int n_in, void* d_out, int out_size,
                              void* d_ws, size_t ws_size, hipStream_t stream) {
  static int grid_blocks = 0;
  if (!grid_blocks) {
    int dev = 0, cus = 0, per_cu = 0;
    (void)hipGetDevice(&dev);
    (void)hipDeviceGetAttribute(&cus, hipDeviceAttributeMultiprocessorCount, dev);
    (void)hipFuncSetAttribute((const void*)mega, hipFuncAttributeMaxDynamicSharedMemorySize, SMEM_BYTES);
    (void)hipOccupancyMaxActiveBlocksPerMultiprocessor(&per_cu, mega, NTHR, SMEM_BYTES);
    if (per_cu < 1) per_cu = 1;
    if (per_cu > 1) per_cu = 1;
    grid_blocks = cus * per_cu;
  }
  Params p{};
  for (int i = 0; i < 43; ++i) p.in[i] = (const float*)d_in[i];
  p.out = (float*)d_out; p.ws = (char*)d_ws;
  void* args[] = {&p};
  hipError_t e = hipLaunchCooperativeKernel((void*)mega, dim3(grid_blocks), dim3(NTHR), args, SMEM_BYTES, stream);
  if (e != hipSuccess) fprintf(stderr, "cooperative launch failed: %s (grid %d)\n", hipGetErrorString(e), grid_blocks);
}
```

```cpp
#include <hip/hip_runtime.h>
#include <hip/hip_cooperative_groups.h>
#include <cstdio>
#include <cstdint>
namespace cg = cooperative_groups;

#define DI __device__ __forceinline__
typedef unsigned short bf16_t;
typedef short bf16x8 __attribute__((ext_vector_type(8)));
typedef float f32x4 __attribute__((ext_vector_type(4)));

constexpr int D = 1024, NB = 8, SL = 4096, CL = 256;
constexpr int ML = NB * SL, MC = NB * CL, MT = ML + MC;
constexpr int KEYS = SL + CL;
constexpr int NTHR = 512;
constexpr float DN_ALPHA = 1.41421356237f;
constexpr size_t UNIT = (size_t)MT * 512;

constexpr size_t WB_IN = 0;
constexpr size_t WB_GATE = WB_IN + (size_t)3328 * 1024 * 2;
constexpr size_t WB_BR = WB_GATE + (size_t)4096 * 1024 * 2;
constexpr size_t WB_OUT = WB_BR + (size_t)4 * 1024 * 256 * 2;
constexpr size_t WB_UP = WB_OUT + (size_t)1024 * 1024 * 2;
constexpr size_t WB_DOWN = WB_UP + (size_t)5632 * 1024 * 2;
constexpr size_t WB_END = WB_DOWN + (size_t)1024 * 2816 * 2;
constexpr size_t OFF_KF = WB_END;
constexpr size_t OFF_HC = OFF_KF + (size_t)512 * 8192 * 8;
constexpr size_t OFF_MISC = OFF_HC + (size_t)MC * D * 4;
constexpr size_t MISC_MOD = OFF_MISC;
constexpr size_t MISC_TW = MISC_MOD + (size_t)2 * 9 * 6144 * 4;
constexpr size_t MISC_RAWC = MISC_TW + 4096 * 8;
constexpr size_t MISC_GCTX = MISC_RAWC + (size_t)256 * 1024 * 4;
constexpr size_t MISC_RWW = MISC_GCTX + (size_t)512 * 512 * 4;
constexpr size_t RWW_F = MISC_RWW, RWW_B = RWW_F + 256 * 64 * 2, RWW_A = RWW_B + 256 * 64 * 2, RWW_GF = RWW_A + 256 * 64 * 2, RWW_GB = RWW_GF + 256 * 128 * 2;
constexpr size_t MISC_XBAR = OFF_MISC + (size_t)3 * 1024 * 1024;
constexpr size_t OFF_R = OFF_MISC + (size_t)4 * 1024 * 1024;
constexpr size_t MISC_BAR = OFF_R - 256;
constexpr size_t MISC_ZERO = OFF_R - 512;
static_assert(RWW_GB + 256 * 128 * 2 <= MISC_ZERO, "misc overflow");
constexpr size_t R_YHY = OFF_R, R_YSW = OFF_R + UNIT, R_YDF = OFF_R + 2 * UNIT;
constexpr size_t R_PHY = OFF_R + 3 * UNIT;
constexpr size_t R_PSW = OFF_R + 6 * UNIT;
constexpr size_t R_VTSW = R_PSW + (size_t)MT * 384 * 2;
constexpr size_t R_PDF = OFF_R + 8 * UNIT;
constexpr size_t R_VTDF = OFF_R + 10 * UNIT;
constexpr size_t R_PRW = OFF_R + 11 * UNIT;
constexpr size_t R_STR = R_PRW + (size_t)MT * 1216 * 2;
constexpr size_t R_G = R_STR + 7 * UNIT;
constexpr size_t R_END = R_G + 2 * UNIT;
constexpr size_t R_RAWF = OFF_R;
constexpr size_t R_OF = R_PHY, R_OB = R_PHY + UNIT;
constexpr size_t R_URE = R_PSW;
constexpr size_t R_YRW = R_VTDF;
constexpr size_t R_ACC = R_PRW;
constexpr size_t R_U = R_STR;
constexpr size_t R_HID = OFF_R;
static_assert(R_END <= (size_t)512 * 1024 * 1024, "ws overflow");
static_assert((size_t)MT * 2816 * 2 <= 11 * UNIT, "hid");

constexpr int SMEM_BYTES = 144 * 1024 + 64;

struct Params {
  const float* in[43];
  float* out;
  char* ws;
};

DI int my_tid() { int t = (int)__builtin_amdgcn_workitem_id_x(); asm volatile("" : "+v"(t)); return t; }
DI unsigned f2bf(float f) { unsigned u = __float_as_uint(f); u += 0x7fffu + ((u >> 16) & 1u); return u >> 16; }
DI float bf2f(unsigned h) { return __uint_as_float(h << 16); }
typedef __bf16 bf16v2_t __attribute__((ext_vector_type(2)));
typedef float f32v2_t __attribute__((ext_vector_type(2)));
DI unsigned pack2(float lo, float hi) { f32v2_t v = {lo, hi}; bf16v2_t b = __builtin_convertvector(v, bf16v2_t); return __builtin_bit_cast(unsigned, b); }

DI float bflo(unsigned w) { return __uint_as_float(w << 16); }
DI float bfhi(unsigned w) { return __uint_as_float(w & 0xffff0000u); }
DI float sigmoidf_(float x) { return __builtin_amdgcn_rcpf(1.f + __expf(-x)); }
DI float siluf_(float x) { return x * __builtin_amdgcn_rcpf(1.f + __expf(-x)); }
DI float wave_sum(float v) {
#pragma unroll
  for (int o = 32; o >= 1; o >>= 1) v += __shfl_xor(v, o);
  return v;
}
template <int CTRL> DI float dpp_mov(float v) {
  return __int_as_float(__builtin_amdgcn_update_dpp(0, __float_as_int(v), CTRL, 0xf, 0xf, false));
}
DI float sum16(float v) {
  v += dpp_mov<0xB1>(v);
  v += dpp_mov<0x4E>(v);
  v += dpp_mov<0x141>(v);
  v += dpp_mov<0x140>(v);
  return v;
}
DI void lds_barrier() { asm volatile("s_waitcnt lgkmcnt(0)" ::: "memory"); __builtin_amdgcn_s_barrier(); asm volatile("" ::: "memory"); }
DI uint4 sel4(bool z, uint4 v) { return make_uint4(z ? 0u : v.x, z ? 0u : v.y, z ? 0u : v.z, z ? 0u : v.w); }
DI int mod_idx(int row) { return row < ML ? (row >> 12) : 8; }

template <int NTW, bool DEEP, class RowFn>
DI void gemm_main(f32x4 (&acc)[4][NTW], const bf16_t* __restrict__ A, int lda, RowFn rowfn,
                  const bf16_t* __restrict__ Bt, int ldb, int K, char* smem) {
  constexpr int BN = NTW * 32;
  constexpr int A_BYTES = 256 * 128, B_BYTES = BN * 128, STAGE = A_BYTES + B_BYTES;
  constexpr int NBL = BN / 64;
  const int tid = my_tid(), lane = tid & 63, wid = tid >> 6, wm = wid >> 1, wn = wid & 1, g = lane >> 4, r16 = lane & 15;
  const int chunk = tid & 7, lrow = tid >> 3;
  long a0 = rowfn(lrow), a1 = rowfn(lrow + 64), a2 = rowfn(lrow + 128), a3 = rowfn(lrow + 192);
  const long c0 = a0 < 0 ? 0 : a0, c1 = a1 < 0 ? 0 : a1, c2 = a2 < 0 ? 0 : a2, c3 = a3 < 0 ? 0 : a3;
  const bf16_t* Bp = Bt + (long)lrow * ldb + chunk * 8;
  const bf16_t* Ap0 = A + c0 * lda + chunk * 8; const bf16_t* Ap1 = A + c1 * lda + chunk * 8;
  const bf16_t* Ap2 = A + c2 * lda + chunk * 8; const bf16_t* Ap3 = A + c3 * lda + chunk * 8;
  struct Regs { uint4 a0, a1, a2, a3, b0, b1; };
  Regs R0, R1;
  R0.b1 = make_uint4(0, 0, 0, 0); R1.b1 = make_uint4(0, 0, 0, 0);
  auto GLOAD = [&](Regs& R, int k0) {
    R.a0 = *(const uint4*)(Ap0 + k0); R.a1 = *(const uint4*)(Ap1 + k0);
    R.a2 = *(const uint4*)(Ap2 + k0); R.a3 = *(const uint4*)(Ap3 + k0);
    R.b0 = *(const uint4*)(Bp + k0);
    if constexpr (NBL > 1) R.b1 = *(const uint4*)(Bp + (long)64 * ldb + k0);
  };
  auto SSTORE = [&](const Regs& R, int st) {
    char* base = smem + st * STAGE + lrow * 128 + ((chunk ^ (lrow & 7)) << 4);
    *(uint4*)(base) = sel4(a0 < 0, R.a0); *(uint4*)(base + 64 * 128) = sel4(a1 < 0, R.a1);
    *(uint4*)(base + 128 * 128) = sel4(a2 < 0, R.a2); *(uint4*)(base + 192 * 128) = sel4(a3 < 0, R.a3);
    *(uint4*)(base + A_BYTES) = R.b0;
    if constexpr (NBL > 1) *(uint4*)(base + A_BYTES + 64 * 128) = R.b1;
  };
  auto COMPUTE = [&](int st) {
    const char* As = smem + st * STAGE + (wm * 64 + r16) * 128;
    const char* Bs = smem + st * STAGE + A_BYTES + (wn * (NTW * 16) + r16) * 128;
#pragma unroll
    for (int kk = 0; kk < 2; ++kk) {
      const int sw = ((kk * 4 + g) ^ (r16 & 7)) << 4;
      bf16x8 af[4], bfr[NTW];
#pragma unroll
      for (int mt = 0; mt < 4; ++mt) af[mt] = *(const bf16x8*)(As + mt * 16 * 128 + sw);
#pragma unroll
      for (int nt = 0; nt < NTW; ++nt) bfr[nt] = *(const bf16x8*)(Bs + nt * 16 * 128 + sw);
#pragma unroll
      for (int mt = 0; mt < 4; ++mt)
#pragma unroll
        for (int nt = 0; nt < NTW; ++nt)
          acc[mt][nt] = __builtin_amdgcn_mfma_f32_16x16x32_bf16(af[mt], bfr[nt], acc[mt][nt], 0, 0, 0);
    }
  };
  const int nk = K >> 6;
  __syncthreads();
  GLOAD(R0, 0);
  SSTORE(R0, 0);
  if constexpr (DEEP) {
    GLOAD(R0, 64);
    if (nk > 2) GLOAD(R1, 128);
    lds_barrier();
    bf16x8 fa0[4], fb0[NTW], fa1[4], fb1[NTW];
    auto READF = [&](bf16x8 (&fa)[4], bf16x8 (&fb)[NTW], int st, int kk) {
      const int sw = ((kk * 4 + g) ^ (r16 & 7)) << 4;
      const char* As = smem + st * STAGE + (wm * 64 + r16) * 128 + sw;
      const char* Bs = smem + st * STAGE + A_BYTES + (wn * (NTW * 16) + r16) * 128 + sw;
#pragma unroll
      for (int mt = 0; mt < 4; ++mt) fa[mt] = *(const bf16x8*)(As + mt * 16 * 128);
#pragma unroll
      for (int nt = 0; nt < NTW; ++nt) fb[nt] = *(const bf16x8*)(Bs + nt * 16 * 128);
    };
    auto MMA = [&](const bf16x8 (&fa)[4], const bf16x8 (&fb)[NTW]) {
#pragma unroll
      for (int mt = 0; mt < 4; ++mt)
#pragma unroll
        for (int nt = 0; nt < NTW; ++nt)
          acc[mt][nt] = __builtin_amdgcn_mfma_f32_16x16x32_bf16(fa[mt], fb[nt], acc[mt][nt], 0, 0, 0);
    };
    READF(fa0, fb0, 0, 0);
    for (int kt = 0; kt < nk; kt += 2) {
      READF(fa1, fb1, 0, 1);
      MMA(fa0, fb0);
#pragma unroll
      for (int i = 0; i < 4 + NTW; ++i) { __builtin_amdgcn_sched_group_barrier(0x100, 1, 0); __builtin_amdgcn_sched_group_barrier(0x008, 2, 0); }
      __builtin_amdgcn_sched_barrier(0);
      SSTORE(R0, 1);
      if (kt + 3 < nk) GLOAD(R0, (kt + 3) * 64);
      MMA(fa1, fb1);
#pragma unroll
      for (int i = 0; i < 6; ++i) { __builtin_amdgcn_sched_group_barrier(0x200, 1, 0); __builtin_amdgcn_sched_group_barrier(0x020, 1, 0); __builtin_amdgcn_sched_group_barrier(0x008, 2, 0); }
      __builtin_amdgcn_sched_barrier(0);
      lds_barrier();
      READF(fa0, fb0, 1, 0);
      READF(fa1, fb1, 1, 1);
      MMA(fa0, fb0);
#pragma unroll
      for (int i = 0; i < 4 + NTW; ++i) { __builtin_amdgcn_sched_group_barrier(0x100, 1, 0); __builtin_amdgcn_sched_group_barrier(0x008, 2, 0); }
      __builtin_amdgcn_sched_barrier(0);
      if (kt + 2 < nk) SSTORE(R1, 0);
      if (kt + 4 < nk) GLOAD(R1, (kt + 4) * 64);
      MMA(fa1, fb1);
#pragma unroll
      for (int i = 0; i < 6; ++i) { __builtin_amdgcn_sched_group_barrier(0x200, 1, 0); __builtin_amdgcn_sched_group_barrier(0x020, 1, 0); __builtin_amdgcn_sched_group_barrier(0x008, 2, 0); }
      __builtin_amdgcn_sched_barrier(0);
      lds_barrier();
      if (kt + 2 < nk) READF(fa0, fb0, 0, 0);
    }
  } else {
    lds_barrier();
    for (int kt = 0; kt < nk; ++kt) {
      const int st = kt & 1;
      if (kt + 1 < nk) GLOAD(R0, (kt + 1) * 64);
      __builtin_amdgcn_sched_barrier(0);
      COMPUTE(st);
      __builtin_amdgcn_sched_barrier(0);
      if (kt + 1 < nk) SSTORE(R0, st ^ 1);
      lds_barrier();
    }
  }
}

#define GLDS16(gp, lp) __builtin_amdgcn_global_load_lds((const unsigned*)(gp), (unsigned*)(lp), 16, 0, 0)
template <class RowFn>
DI void gemm_glds(f32x4 (&acc)[4][4], const bf16_t* __restrict__ A, int lda, RowFn rowfn,
                  const bf16_t* __restrict__ Bt, int ldb, int K, char* smem, const bf16_t* zrow) {
  constexpr int A_BYTES = 256 * 128, STAGE = A_BYTES + 128 * 128;
  const int tid = my_tid(), lane = tid & 63, wid = tid >> 6, wm = wid >> 1, wn = wid & 1, g = lane >> 4, r16 = lane & 15;
  const int lrow = tid >> 3, c = (tid & 7) ^ (lrow & 7);
  const long a0 = rowfn(lrow), a1 = rowfn(lrow + 64), a2 = rowfn(lrow + 128), a3 = rowfn(lrow + 192);
  const bf16_t* pa0 = (a0 >= 0 ? A + a0 * lda : zrow) + c * 8; const int m0 = a0 >= 0 ? 1 : 0;
  const bf16_t* pa1 = (a1 >= 0 ? A + a1 * lda : zrow) + c * 8; const int m1 = a1 >= 0 ? 1 : 0;
  const bf16_t* pa2 = (a2 >= 0 ? A + a2 * lda : zrow) + c * 8; const int m2 = a2 >= 0 ? 1 : 0;
  const bf16_t* pa3 = (a3 >= 0 ? A + a3 * lda : zrow) + c * 8; const int m3 = a3 >= 0 ? 1 : 0;
  const bf16_t* pb0 = Bt + (long)lrow * ldb + c * 8; const bf16_t* pb1 = pb0 + (long)64 * ldb;
  auto ISSUE = [&](int kt, int bi) {
    char* d = smem + bi * STAGE + tid * 16;
    const int k0 = kt * 64;
    GLDS16(pa0 + k0 * m0, d); GLDS16(pa1 + k0 * m1, d + 8192); GLDS16(pa2 + k0 * m2, d + 16384); GLDS16(pa3 + k0 * m3, d + 24576);
    GLDS16(pb0 + k0, d + A_BYTES); GLDS16(pb1 + k0, d + A_BYTES + 8192);
  };
  auto COMPUTE = [&](int bi) {
    const char* As = smem + bi * STAGE + (wm * 64 + r16) * 128;
    const char* Bs = smem + bi * STAGE + A_BYTES + (wn * 64 + r16) * 128;
#pragma unroll
    for (int kk = 0; kk < 2; ++kk) {
      const int sw = ((kk * 4 + g) ^ (r16 & 7)) << 4;
      bf16x8 af[4], bfr[4];
#pragma unroll
      for (int mt = 0; mt < 4; ++mt) af[mt] = *(const bf16x8*)(As + mt * 16 * 128 + sw);
#pragma unroll
      for (int nt = 0; nt < 4; ++nt) bfr[nt] = *(const bf16x8*)(Bs + nt * 16 * 128 + sw);
      __builtin_amdgcn_s_setprio(1);
#pragma unroll
      for (int mt = 0; mt < 4; ++mt)
#pragma unroll
        for (int nt = 0; nt < 4; ++nt)
          acc[mt][nt] = __builtin_amdgcn_mfma_f32_16x16x32_bf16(af[mt], bfr[nt], acc[mt][nt], 0, 0, 0);
      __builtin_amdgcn_s_setprio(0);
    }
  };
  const int nk = K >> 6;
  __syncthreads();
  ISSUE(0, 0);
  ISSUE(1, 1);
  asm volatile("s_waitcnt vmcnt(6)" ::: "memory");
  __builtin_amdgcn_s_barrier();
  asm volatile("" ::: "memory");
  int bi = 0;
  for (int kt = 0; kt < nk; ++kt) {
    const int b2 = bi >= 1 ? bi - 1 : 2;
    if (kt + 2 < nk) ISSUE(kt + 2, b2);
    COMPUTE(bi);
    if (kt + 2 < nk) asm volatile("s_waitcnt vmcnt(6)" ::: "memory");
    else asm volatile("s_waitcnt vmcnt(0)" ::: "memory");
    asm volatile("s_waitcnt lgkmcnt(0)" ::: "memory");
    __builtin_amdgcn_s_barrier();
    asm volatile("" ::: "memory");
    bi = bi == 2 ? 0 : bi + 1;
  }
}

DI void gemm_glds256(f32x4 (&acc)[8][4], const bf16_t* __restrict__ A, int lda, long arow0,
                     const bf16_t* __restrict__ Bt, int ldb, int K, char* smem) {
  constexpr int A_BYTES = 256 * 128, STAGE = 2 * A_BYTES;
  const int tid = my_tid(), lane = tid & 63, wid = tid >> 6, wm = wid >> 2, wn = wid & 3, g = lane >> 4, r16 = lane & 15;
  const int lrow = tid >> 3, c = (tid & 7) ^ (lrow & 7);
  const bf16_t* pa = A + (arow0 + lrow) * (long)lda + c * 8;
  const bf16_t* pb = Bt + (long)lrow * ldb + c * 8;
  const long a64 = (long)64 * lda, b64 = (long)64 * ldb;
  auto ISSUE = [&](int kt, int bi) {
    char* d = smem + bi * STAGE + tid * 16;
    const int k0 = kt * 64;
    GLDS16(pa + k0, d); GLDS16(pa + a64 + k0, d + 8192); GLDS16(pa + 2 * a64 + k0, d + 16384); GLDS16(pa + 3 * a64 + k0, d + 24576);
    GLDS16(pb + k0, d + A_BYTES); GLDS16(pb + b64 + k0, d + A_BYTES + 8192); GLDS16(pb + 2 * b64 + k0, d + A_BYTES + 16384); GLDS16(pb + 3 * b64 + k0, d + A_BYTES + 24576);
  };
  auto COMPUTE = [&](int bi) {
    const char* As = smem + bi * STAGE + (wm * 128 + r16) * 128;
    const char* Bs = smem + bi * STAGE + A_BYTES + (wn * 64 + r16) * 128;
#pragma unroll
    for (int kk = 0; kk < 2; ++kk) {
      const int sw = ((kk * 4 + g) ^ (r16 & 7)) << 4;
      bf16x8 bfr[4];
#pragma unroll
      for (int nt = 0; nt < 4; ++nt) bfr[nt] = *(const bf16x8*)(Bs + nt * 16 * 128 + sw);
      __builtin_amdgcn_s_setprio(1);
#pragma unroll
      for (int mt = 0; mt < 8; ++mt) {
        const bf16x8 af = *(const bf16x8*)(As + mt * 16 * 128 + sw);
#pragma unroll
        for (int nt = 0; nt < 4; ++nt)
          acc[mt][nt] = __builtin_amdgcn_mfma_f32_16x16x32_bf16(af, bfr[nt], acc[mt][nt], 0, 0, 0);
      }
      __builtin_amdgcn_s_setprio(0);
    }
  };
  const int nk = K >> 6;
  __syncthreads();
  ISSUE(0, 0);
  asm volatile("s_waitcnt vmcnt(0)" ::: "memory");
  __builtin_amdgcn_s_barrier();
  asm volatile("" ::: "memory");
  int bi = 0;
  for (int kt = 0; kt < nk; ++kt) {
    if (kt + 1 < nk) ISSUE(kt + 1, bi ^ 1);
    COMPUTE(bi);
    asm volatile("s_waitcnt vmcnt(0)" ::: "memory");
    asm volatile("s_waitcnt lgkmcnt(0)" ::: "memory");
    __builtin_amdgcn_s_barrier();
    asm volatile("" ::: "memory");
    bi ^= 1;
  }
}
DI void zero_acc256(f32x4 (&acc)[8][4]) {
#pragma unroll
  for (int i = 0; i < 8; ++i)
#pragma unroll
    for (int j = 0; j < 4; ++j) acc[i][j] = (f32x4){0.f, 0.f, 0.f, 0.f};
}

DI bool next_tile(int i, int MTILES, int NTILES, int& mt, int& nt) {
  const int xcd = blockIdx.x & 7, slot = blockIdx.x >> 3, nslot = gridDim.x >> 3;
  const int m_lo = (MTILES * xcd) >> 3, m_hi = (MTILES * (xcd + 1)) >> 3, Mloc = m_hi - m_lo;
  const int q = i * nslot + slot;
  if (q >= Mloc * NTILES) return false;
  const int gidx = q / (4 * NTILES), m0 = gidx * 4;
  const int rows = (Mloc - m0) < 4 ? (Mloc - m0) : 4;
  const int within = q - gidx * 4 * NTILES;
  nt = within / rows; mt = m_lo + m0 + within % rows;
  return true;
}

struct RowPlain { long base; DI long operator()(int r) const { return base + r; } };
struct RowHalo { long rowbase; int t0; int len; DI long operator()(int r) const { int t = t0 + r; return (t >= 0 && t < len) ? rowbase + t : -1; } };

template <int NTW> DI void zero_acc(f32x4 (&acc)[4][NTW]) {
#pragma unroll
  for (int i = 0; i < 4; ++i)
#pragma unroll
    for (int j = 0; j < NTW; ++j) acc[i][j] = (f32x4){0.f, 0.f, 0.f, 0.f};
}

DI void cvt_unit(const float* __restrict__ src, int ldsrc, int srccol0, int k0, bf16_t* __restrict__ dst, int K, int n0, char* smem, bool perm = true) {
  float* T = (float*)smem;
  const int tid = my_tid();
  __syncthreads();
  if (srccol0 >= 0) {
#pragma unroll
    for (int i = 0; i < 8; ++i) {
      int idx = tid + i * 512; int k = idx >> 6, n = idx & 63;
      T[k * 65 + n] = src[(long)(k0 + k) * ldsrc + srccol0 + n];
    }
  }
  __syncthreads();
  int nd = tid >> 3, kc = (tid & 7) * 8; int n = perm ? ((nd & 15) * 4 + (nd >> 4)) : nd;
  uint4 o = make_uint4(0, 0, 0, 0);
  if (srccol0 >= 0) {
    o.x = pack2(T[(kc + 0) * 65 + n], T[(kc + 1) * 65 + n]);
    o.y = pack2(T[(kc + 2) * 65 + n], T[(kc + 3) * 65 + n]);
    o.z = pack2(T[(kc + 4) * 65 + n], T[(kc + 5) * 65 + n]);
    o.w = pack2(T[(kc + 6) * 65 + n], T[(kc + 7) * 65 + n]);
  }
  *(uint4*)(dst + (long)(n0 + nd) * K + k0 + kc) = o;
}

DI void ph_convert(const Params& p, int l, char* smem) {
  for (int u = blockIdx.x; u < 4508; u += gridDim.x) {
    if (u < 832) {
      int gI = u >> 4, kt = u & 15; int n0 = gI * 64; int sc;
      if (n0 < 1280) sc = n0; else if (n0 < 2048) sc = 2496 + (n0 - 1280); else if (n0 < 3264) sc = 1280 + (n0 - 2048); else sc = -1;
      cvt_unit(p.in[6] + (size_t)l * 1024 * 7360, 7360, sc, kt * 64, (bf16_t*)(p.ws + WB_IN), 1024, n0, smem);
    } else if (u < 1856) {
      int v = u - 832; int gI = v >> 4, kt = v & 15;
      cvt_unit(p.in[6] + (size_t)l * 1024 * 7360, 7360, 3264 + gI * 64, kt * 64, (bf16_t*)(p.ws + WB_GATE), 1024, gI * 64, smem);
    } else if (u < 2112) {
      int v = u - 1856; int gI = v >> 2, kt = v & 3; int j = gI >> 4, gg = gI & 15;
      cvt_unit(p.in[33] + ((size_t)l * 4 + j) * 256 * 1024, 1024, gg * 64, kt * 64, (bf16_t*)(p.ws + WB_BR) + (size_t)j * 1024 * 256, 256, gg * 64, smem);
    } else if (u < 2368) {
      int v = u - 2112; int gI = v >> 4, kt = v & 15;
      cvt_unit(p.in[34] + (size_t)l * 1024 * 1024, 1024, gI * 64, kt * 64, (bf16_t*)(p.ws + WB_OUT), 1024, gI * 64, smem);
    } else if (u < 3776) {
      int v = u - 2368; int gI = v >> 4, kt = v & 15; int nt = gI >> 2, q = gI & 3;
      cvt_unit(p.in[37] + (size_t)l * 1024 * 5632, 5632, (q >> 1) * 2816 + nt * 128 + (q & 1) * 64, kt * 64, (bf16_t*)(p.ws + WB_UP), 1024, gI * 64, smem);
    } else if (u < 4480) {
      int v = u - 3776; int gI = v / 44, kt = v % 44;
      cvt_unit(p.in[40] + (size_t)l * 2816 * 1024, 1024, gI * 64, kt * 64, (bf16_t*)(p.ws + WB_DOWN), 2816, gI * 64, smem);
    } else {
      int v = u - 4480;
      if (v < 4) cvt_unit(p.in[19] + (size_t)l * 2 * 64 * 256, 256, v * 64, 0, (bf16_t*)(p.ws + RWW_F), 64, v * 64, smem);
      else if (v < 8) cvt_unit(p.in[19] + (size_t)l * 2 * 64 * 256 + 64 * 256, 256, (v - 4) * 64, 0, (bf16_t*)(p.ws + RWW_B), 64, (v - 4) * 64, smem);
      else if (v < 12) cvt_unit(p.in[21] + (size_t)l * 64 * 256, 256, (v - 8) * 64, 0, (bf16_t*)(p.ws + RWW_A), 64, (v - 8) * 64, smem);
      else if (v < 20) { int w = v - 12; cvt_unit(p.in[22] + (size_t)l * 2 * 128 * 256, 256, (w >> 1) * 64, (w & 1) * 64, (bf16_t*)(p.ws + RWW_GF), 128, (w >> 1) * 64, smem); }
      else { int w = v - 20; cvt_unit(p.in[22] + (size_t)l * 2 * 128 * 256 + 128 * 256, 256, (w >> 1) * 64, (w & 1) * 64, (bf16_t*)(p.ws + RWW_GB), 128, (w >> 1) * 64, smem); }
    }
  }
}

DI void ph_ada(const Params& p, char* smem) {
  float* S = (float*)smem;
  float* R = S + 9 * 1024;
  const int tid = my_tid();
  bool loaded = false;
  for (int u = blockIdx.x; u < 192; u += gridDim.x) {
    if (!loaded) {
      __syncthreads();
      for (int i = tid; i < 9 * 1024; i += NTHR) { float c = i < 8192 ? p.in[1][i] : p.in[3][i - 8192]; S[i] = siluf_(c); }
      loaded = true;
    }
    __syncthreads();
    int l = u / 96, n0 = (u % 96) * 64;
    int col = tid & 63, ks = tid >> 6;
    const float* W = p.in[4] + (size_t)l * 1024 * 6144 + n0 + col;
    float a[9];
#pragma unroll
    for (int b = 0; b < 9; ++b) a[b] = 0.f;
    for (int k = ks * 128; k < ks * 128 + 128; ++k) {
      float w = W[(size_t)k * 6144];
#pragma unroll
      for (int b = 0; b < 9; ++b) a[b] += S[b * 1024 + k] * w;
    }
#pragma unroll
    for (int b = 0; b < 9; ++b) R[(ks * 9 + b) * 64 + col] = a[b];
    __syncthreads();
    for (int i = tid; i < 9 * 64; i += NTHR) {
      int b = i >> 6, c = i & 63; float s = 0.f;
#pragma unroll
      for (int k2 = 0; k2 < 8; ++k2) s += R[(k2 * 9 + b) * 64 + c];
      s += p.in[5][(size_t)l * 6144 + n0 + c];
      ((float*)(p.ws + MISC_MOD))[((size_t)l * 9 + b) * 6144 + n0 + c] = s;
    }
  }
  for (int i = blockIdx.x * NTHR + tid; i < 4096; i += gridDim.x * NTHR) {
    float s, c; sincospif(-(float)i / 4096.f, &s, &c);
    ((float2*)(p.ws + MISC_TW))[i] = make_float2(c, s);
  }
}

DI void hy_rawfilter(const Params& p, int l, int Lf, float* __restrict__ dst, char* smem) {
  float* W1 = (float*)smem;
  float* W2 = W1 + 33 * 64;
  float* Z = W2 + 64 * 64;
  float* H1 = Z + 16 * 36;
  float* H2 = H1 + 16 * 64;
  const int tid = my_tid();
  const float* w1 = p.in[9] + (size_t)l * 33 * 64; const float* b1 = p.in[10] + l * 64;
  const float* w2 = p.in[11] + (size_t)l * 64 * 64; const float* b2 = p.in[12] + l * 64;
  const float* w3 = p.in[13] + (size_t)l * 64 * 1024; const float* fr = p.in[14] + l * 64;
  const int nunits = Lf / 16;
  bool loaded = false;
  for (int u = blockIdx.x; u < nunits; u += gridDim.x) {
    __syncthreads();
    if (!loaded) {
      for (int i = tid; i < 33 * 64; i += NTHR) W1[i] = w1[i];
      for (int i = tid; i < 64 * 64; i += NTHR) W2[i] = w2[i];
      loaded = true;
    }
    const int t0 = u * 16;
    for (int i = tid; i < 16 * 33; i += NTHR) {
      int tt = i / 33, f = i % 33; int t = t0 + tt; float v;
      if (f == 0) v = (float)t / (float)(Lf - 1);
      else {
        int bi = (f - 1) & 15;
        float wv = 6.283185307179586f * (float)t / (float)Lf;
        float fb = 1e-4f + (15.f - 1e-4f) * (float)bi / 15.f;
        float ang = wv * fb;
        v = (f <= 16) ? cosf(ang) : -sinf(ang);
      }
      Z[tt * 36 + f] = v;
    }
    __syncthreads();
    for (int i = tid; i < 16 * 64; i += NTHR) {
      int tt = i >> 6, f = i & 63; float s = b1[f];
      for (int k = 0; k < 33; ++k) s += Z[tt * 36 + k] * W1[k * 64 + f];
      H1[tt * 64 + f] = sinf(fr[f] * s);
    }
    __syncthreads();
    for (int i = tid; i < 16 * 64; i += NTHR) {
      int tt = i >> 6, f = i & 63; float s = b2[f];
      for (int k = 0; k < 64; ++k) s += H1[tt * 64 + k] * W2[k * 64 + f];
      H2[tt * 64 + f] = sinf(fr[f] * s);
    }
    __syncthreads();
    float a0[16], a1[16];
#pragma unroll
    for (int i = 0; i < 16; ++i) { a0[i] = 0.f; a1[i] = 0.f; }
    for (int k = 0; k < 64; ++k) {
      float wa = w3[k * 1024 + tid], wb = w3[k * 1024 + 512 + tid];
#pragma unroll
      for (int i = 0; i < 16; ++i) { float h = H2[i * 64 + k]; a0[i] += h * wa; a1[i] += h * wb; }
    }
    {
      int w = tid & 255;
      float delta = fabsf(-3.0701134573253944f + (-15.350567286626972f + 3.0701134573253944f) * (float)w / 255.f);
#pragma unroll
      for (int i = 0; i < 16; ++i) {
        float tn = (float)(t0 + i) / (float)(Lf - 1);
        float dec = expf(-tn * delta);
        dst[(size_t)(t0 + i) * 1024 + tid] = a0[i] * dec;
        dst[(size_t)(t0 + i) * 1024 + 512 + tid] = a1[i] * dec;
      }
    }
  }
}

DI float2 cmul(float2 a, float2 b) { return make_float2(a.x * b.x - a.y * b.y, a.x * b.y + a.y * b.x); }
DI float2 cmulc(float2 a, float2 b) { return make_float2(a.x * b.x + a.y * b.y, a.y * b.x - a.x * b.y); }
DI float2 cadd(float2 a, float2 b) { return make_float2(a.x + b.x, a.y + b.y); }
DI float2 csub(float2 a, float2 b) { return make_float2(a.x - b.x, a.y - b.y); }
DI void fft_dif(float2* X, const float2* W) {
  const int tid = my_tid();
  for (int ls = 12; ls >= 2; ls -= 2) {
    const int s = 1 << ls, h = s >> 1;
    __syncthreads();
#pragma unroll
    for (int i = 0; i < 4; ++i) {
      const int bf = tid + i * 512; const int j = bf & (h - 1); const int base = ((bf >> (ls - 1)) << (ls + 1)) + j;
      const float2 x0 = X[base], x1 = X[base + h], x2 = X[base + s], x3 = X[base + s + h];
      const float2 w1 = W[s - 1 + j], w2 = W[h - 1 + j];
      const float2 y0 = cadd(x0, x2), y2 = cmul(csub(x0, x2), w1), y1 = cadd(x1, x3);
      const float2 t = cmul(csub(x1, x3), w1); const float2 y3 = make_float2(t.y, -t.x);
      X[base] = cadd(y0, y1); X[base + h] = cmul(csub(y0, y1), w2);
      X[base + s] = cadd(y2, y3); X[base + s + h] = cmul(csub(y2, y3), w2);
    }
  }
  __syncthreads();
#pragma unroll
  for (int i = 0; i < 4; ++i) {
    const int q = tid + i * 512;
    float4 a = *(float4*)(X + 4 * q), b = *(float4*)(X + 4 * q + 2);
    *(float4*)(X + 4 * q) = make_float4(a.x + a.z, a.y + a.w, a.x - a.z, a.y - a.w);
    *(float4*)(X + 4 * q + 2) = make_float4(b.x + b.z, b.y + b.w, b.x - b.z, b.y - b.w);
  }
  __syncthreads();
}
DI void fft_dit_inv(float2* X, const float2* W) {
  const int tid = my_tid();
  __syncthreads();
#pragma unroll
  for (int i = 0; i < 4; ++i) {
    const int q = tid + i * 512;
    float4 a = *(float4*)(X + 4 * q), b = *(float4*)(X + 4 * q + 2);
    *(float4*)(X + 4 * q) = make_float4(a.x + a.z, a.y + a.w, a.x - a.z, a.y - a.w);
    *(float4*)(X + 4 * q + 2) = make_float4(b.x + b.z, b.y + b.w, b.x - b.z, b.y - b.w);
  }
  for (int ls = 2; ls <= 12; ls += 2) {
    const int s = 1 << ls, h = s >> 1;
    __syncthreads();
#pragma unroll
    for (int i = 0; i < 4; ++i) {
      const int bf = tid + i * 512; const int j = bf & (h - 1); const int base = ((bf >> (ls - 1)) << (ls + 1)) + j;
      const float2 e0 = X[base], e1 = X[base + h], e2 = X[base + s], e3 = X[base + s + h];
      const float2 w1 = W[s - 1 + j], w2 = W[h - 1 + j];
      const float2 t1 = cmulc(e1, w2), t3 = cmulc(e3, w2);
      const float2 u0 = cadd(e0, t1), u1 = csub(e0, t1), u2 = cadd(e2, t3), u3 = csub(e2, t3);
      const float2 a2 = cmulc(u2, w1); const float2 q3 = cmulc(u3, w1); const float2 a3 = make_float2(-q3.y, q3.x);
      X[base] = cadd(u0, a2); X[base + s] = csub(u0, a2);
      X[base + h] = cadd(u1, a3); X[base + s + h] = csub(u1, a3);
    }
  }
  __syncthreads();
}
DI void load_twiddles(const Params& p, float2* W) {
  const float2* tw = (const float2*)(p.ws + MISC_TW);
  for (int i = my_tid(); i < 8191; i += NTHR) {
    const int ls = 31 - __clz(i + 1); const int pos = i + 1 - (1 << ls);
    W[i] = tw[pos << (12 - ls)];
  }
}

DI void ph_kf(const Params& p, int l, char* smem) {
  float2* X = (float2*)smem; float2* W = X + 8192; float* red = (float*)(W + 8192);
  const int tid = my_tid(), lane = tid & 63, wid = tid >> 6;
  const float* rawf = (const float*)(p.ws + R_RAWF);
  float2* kf = (float2*)(p.ws + OFF_KF);
  bool tw = false;
  for (int u = blockIdx.x; u < 256; u += gridDim.x) {
    if (!tw) { load_twiddles(p, W); tw = true; }
    const int o = u >> 7, c = (u & 127) * 2;
    float2 fw[8], bw[8]; float sa = 0.f, sb = 0.f;
#pragma unroll
    for (int i = 0; i < 8; ++i) {
      int t = tid + i * 512;
      fw[i] = *(const float2*)(rawf + (size_t)t * 1024 + o * 512 + c);
      bw[i] = *(const float2*)(rawf + (size_t)t * 1024 + o * 512 + 256 + c);
      sa += fabsf(fw[i].x) + fabsf(bw[i].x); sb += fabsf(fw[i].y) + fabsf(bw[i].y);
    }
    sa = wave_sum(sa); sb = wave_sum(sb);
    __syncthreads();
    if (lane == 0) { red[wid * 2] = sa; red[wid * 2 + 1] = sb; }
    __syncthreads();
    float ta = 0.f, tb = 0.f;
#pragma unroll
    for (int w = 0; w < 8; ++w) { ta += red[w * 2]; tb += red[w * 2 + 1]; }
    const float ia = 1.f / ta, ib = 1.f / tb;
#pragma unroll
    for (int i = 0; i < 8; ++i) {
      int t = tid + i * 512;
      X[t] = make_float2(fw[i].x * ia, fw[i].y * ib);
      if (t >= 1) X[8192 - t] = make_float2(bw[i].x * ia, bw[i].y * ib);
      else X[4096] = make_float2(0.f, 0.f);
    }
    fft_dif(X, W);
    float2* ka = kf + (size_t)(o * 256 + c) * 8192; float2* kb = ka + 8192;
#pragma unroll 4
    for (int i = 0; i < 16; ++i) {
      int pidx = tid + i * 512;
      int k = (int)(__brev((unsigned)pidx) >> 19);
      int k2 = (8192 - k) & 8191;
      int p2 = (int)(__brev((unsigned)k2) >> 19);
      float2 c1 = X[pidx], c2 = X[p2];
      float2 A = make_float2(0.5f * (c1.x + c2.x), 0.5f * (c1.y - c2.y));
      float2 Bv = make_float2(0.5f * (c1.y + c2.y), -0.5f * (c1.x - c2.x));
      ka[pidx] = A; kb[pidx] = Bv;
    }
    __syncthreads();
  }
  if (l == 0) {
    const float* rawc = (const float*)(p.ws + MISC_RAWC);
    float* G = (float*)(p.ws + MISC_GCTX);
    for (int u = blockIdx.x * 8 + wid; u < 512; u += gridDim.x * 8) {
      int o = u >> 8, c = u & 255; float f[4], b[4]; float s = 0.f;
#pragma unroll
      for (int i = 0; i < 4; ++i) {
        int t = lane + i * 64;
        f[i] = rawc[(size_t)t * 1024 + o * 512 + c]; b[i] = rawc[(size_t)t * 1024 + o * 512 + 256 + c];
        s += fabsf(f[i]) + fabsf(b[i]);
      }
      s = wave_sum(s); float inv = 1.f / s;
#pragma unroll
      for (int i = 0; i < 4; ++i) {
        int t = lane + i * 64;
        G[(size_t)u * 512 + 256 + t] = f[i] * inv;
        if (t >= 1) G[(size_t)u * 512 + 256 - t] = b[i] * inv;
      }
      if (lane == 0) G[(size_t)u * 512] = 0.f;
    }
  }
}

DI void ph_ln(const float* __restrict__ src_lat, const float* __restrict__ src_ctx, float* dst_lat, float* dst_ctx,
              const float* __restrict__ ag, const float* __restrict__ ab, bf16_t* U, const float* __restrict__ mod, int sh_off, int nrows) {
  const int lane = my_tid() & 63, wid = my_tid() >> 6;
  const int stride = gridDim.x * 8;
  float4 nv[4];
  {
    const int row = blockIdx.x * 8 + wid;
    if (row < nrows) {
      const float* src = row < ML ? src_lat + (size_t)row * D : src_ctx + (size_t)(row - ML) * D;
#pragma unroll
      for (int i = 0; i < 4; ++i) nv[i] = *(const float4*)(src + i * 256 + lane * 4);
    }
  }
  for (int row = blockIdx.x * 8 + wid; row < nrows; row += stride) {
    float4 v[4];
#pragma unroll
    for (int i = 0; i < 4; ++i) v[i] = nv[i];
    if (row + stride < nrows) {
      const int r2 = row + stride;
      const float* src2 = r2 < ML ? src_lat + (size_t)r2 * D : src_ctx + (size_t)(r2 - ML) * D;
#pragma unroll
      for (int i = 0; i < 4; ++i) nv[i] = *(const float4*)(src2 + i * 256 + lane * 4);
    }
    float s = 0.f;
#pragma unroll
    for (int i = 0; i < 4; ++i) s += v[i].x + v[i].y + v[i].z + v[i].w;
    float mu = wave_sum(s) * (1.f / 1024.f);
    float q = 0.f;
#pragma unroll
    for (int i = 0; i < 4; ++i) { v[i].x -= mu; v[i].y -= mu; v[i].z -= mu; v[i].w -= mu; q += v[i].x * v[i].x + v[i].y * v[i].y + v[i].z * v[i].z + v[i].w * v[i].w; }
    float rs = rsqrtf(wave_sum(q) * (1.f / 1024.f) + 1e-6f);
#pragma unroll
    for (int i = 0; i < 4; ++i) { v[i].x *= rs; v[i].y *= rs; v[i].z *= rs; v[i].w *= rs; }
    if (ag) {
      float* dst = row < ML ? dst_lat + (size_t)row * D : dst_ctx + (size_t)(row - ML) * D;
#pragma unroll
      for (int i = 0; i < 4; ++i) {
        float4 gg = *(const float4*)(ag + i * 256 + lane * 4), bb = *(const float4*)(ab + i * 256 + lane * 4);
        v[i].x = v[i].x * gg.x + bb.x; v[i].y = v[i].y * gg.y + bb.y; v[i].z = v[i].z * gg.z + bb.z; v[i].w = v[i].w * gg.w + bb.w;
        *(float4*)(dst + i * 256 + lane * 4) = v[i];
      }
      if (U) {
        s = 0.f;
#pragma unroll
        for (int i = 0; i < 4; ++i) s += v[i].x + v[i].y + v[i].z + v[i].w;
        mu = wave_sum(s) * (1.f / 1024.f); q = 0.f;
#pragma unroll
        for (int i = 0; i < 4; ++i) { v[i].x -= mu; v[i].y -= mu; v[i].z -= mu; v[i].w -= mu; q += v[i].x * v[i].x + v[i].y * v[i].y + v[i].z * v[i].z + v[i].w * v[i].w; }
        rs = rsqrtf(wave_sum(q) * (1.f / 1024.f) + 1e-6f);
#pragma unroll
        for (int i = 0; i < 4; ++i) { v[i].x *= rs; v[i].y *= rs; v[i].z *= rs; v[i].w *= rs; }
      }
    }
    if (U) {
      const float* m = mod + (size_t)mod_idx(row) * 6144 + sh_off;
#pragma unroll
      for (int i = 0; i < 4; ++i) {
        float4 sh = *(const float4*)(m + i * 256 + lane * 4), sc = *(const float4*)(m + 1024 + i * 256 + lane * 4);
        uint2 o; o.x = pack2(v[i].x * (1.f + sc.x) + sh.x, v[i].y * (1.f + sc.y) + sh.y);
        o.y = pack2(v[i].z * (1.f + sc.z) + sh.z, v[i].w * (1.f + sc.w) + sh.w);
        *(uint2*)(U + (size_t)row * D + i * 256 + lane * 4) = o;
      }
    }
  }
}

DI void ph_inproj(const Params& p, const bf16_t* U, char* smem) {
  const bf16_t* Bt = (const bf16_t*)(p.ws + WB_IN);
  const int lane = my_tid() & 63, wid = my_tid() >> 6, wm = wid >> 2, wn = wid & 3, g = lane >> 4, r16 = lane & 15;
  for (int it = 0;; ++it) {
    int mtile, ntile;
    if (!next_tile(it, 136, 13, mtile, ntile)) break;
    f32x4 acc[8][4]; zero_acc256(acc);
    gemm_glds256(acc, U, 1024, (long)mtile * 256, Bt + (size_t)ntile * 256 * 1024, 1024, 1024, smem);
    int b, key0;
    if (mtile < 128) { b = mtile >> 4; key0 = (mtile & 15) * 256; } else { b = mtile - 128; key0 = SL; }
    const int wc0 = ntile * 256 + wn * 64;
    bf16_t* tbase = nullptr; int tcols = 0, tcol0 = 0;
    if (wc0 < 768) { tbase = (bf16_t*)(p.ws + R_PHY); tcols = 768; tcol0 = wc0; }
    else if (wc0 >= 1152 && wc0 < 1280) { tbase = (bf16_t*)(p.ws + R_VTSW); tcols = 128; tcol0 = wc0 - 1152; }
    else if (wc0 >= 1792 && wc0 < 2048) { tbase = (bf16_t*)(p.ws + R_VTDF); tcols = 256; tcol0 = wc0 - 1792; }
    if (tbase) {
#pragma unroll
      for (int mt = 0; mt < 8; ++mt)
#pragma unroll
        for (int nt = 0; nt < 4; ++nt) {
          int col = tcol0 + r16 * 4 + nt;
          int key = key0 + wm * 128 + mt * 16 + g * 4;
          uint2 o; o.x = pack2(acc[mt][nt][0], acc[mt][nt][1]); o.y = pack2(acc[mt][nt][2], acc[mt][nt][3]);
          *(uint2*)(tbase + ((size_t)b * tcols + col) * KEYS + key) = o;
        }
    } else if (wc0 < 3264) {
      bf16_t* rb; int ld, c0;
      if (wc0 < 1152) { rb = (bf16_t*)(p.ws + R_PSW); ld = 384; c0 = wc0 - 768; }
      else if (wc0 < 1792) { rb = (bf16_t*)(p.ws + R_PDF); ld = 512; c0 = wc0 - 1280; }
      else { rb = (bf16_t*)(p.ws + R_PRW); ld = 1216; c0 = wc0 - 2048; }
      const int col = c0 + r16 * 4;
#pragma unroll
      for (int mt = 0; mt < 8; ++mt)
#pragma unroll
        for (int j = 0; j < 4; ++j) {
          size_t row = (size_t)mtile * 256 + wm * 128 + mt * 16 + g * 4 + j;
          uint2 o; o.x = pack2(acc[mt][0][j], acc[mt][1][j]); o.y = pack2(acc[mt][2][j], acc[mt][3][j]);
          *(uint2*)(rb + row * ld + col) = o;
        }
    }
  }
}

DI float hy_conv3(const bf16_t* __restrict__ P, int t, int len, float w0, float w1, float w2, float bias) {
  float a = t >= 1 ? bf2f(P[t - 1]) : 0.f, b = bf2f(P[t]), c = (t + 1 < len) ? bf2f(P[t + 1]) : 0.f;
  return w0 * a + w1 * b + w2 * c + bias;
}
DI void hy_conv8(const bf16_t* __restrict__ P, int tb, int len, float w0, float w1, float w2, float bias, float (&out)[8]) {
  const uint4 u = *(const uint4*)(P + tb);
  float x[10];
  x[0] = tb >= 1 ? bf2f(P[tb - 1]) : 0.f;
  x[1] = bflo(u.x); x[2] = bfhi(u.x); x[3] = bflo(u.y); x[4] = bfhi(u.y); x[5] = bflo(u.z); x[6] = bfhi(u.z); x[7] = bflo(u.w); x[8] = bfhi(u.w);
  x[9] = (tb + 8 < len) ? bf2f(P[tb + 8]) : 0.f;
#pragma unroll
  for (int i = 0; i < 8; ++i) out[i] = w0 * x[i] + w1 * x[i + 1] + w2 * x[i + 2] + bias;
}
DI void ph_hyena(const Params& p, int l, char* smem) {
  float2* X = (float2*)smem; float2* W = X + 8192;
  const int tid = my_tid();
  const int tb = tid * 8;
  const bf16_t* PT = (const bf16_t*)(p.ws + R_PHY);
  const float2* kf = (const float2*)(p.ws + OFF_KF);
  const float* cw = p.in[7] + (size_t)l * 3 * 768; const float* cb = p.in[8] + (size_t)l * 768;
  const float* hb = p.in[15] + (size_t)l * 512;
  bf16_t* Y = (bf16_t*)(p.ws + R_YHY);
  bool tw = false;
  for (int u = blockIdx.x; u < 1024; u += gridDim.x) {
    if (!tw) { load_twiddles(p, W); tw = true; }
    const int bp = u >> 8, c = u & 255; const int b0 = bp * 2, b1 = b0 + 1;
    const bf16_t* P0 = PT + ((size_t)b0 * 768) * KEYS; const bf16_t* P1 = PT + ((size_t)b1 * 768) * KEYS;
    const float bias0 = hb[c], bias1 = hb[256 + c];
    float va[8], vb[8];
    hy_conv8(P0 + (size_t)c * KEYS, tb, SL, cw[c], cw[768 + c], cw[1536 + c], cb[c], va);
    hy_conv8(P1 + (size_t)c * KEYS, tb, SL, cw[c], cw[768 + c], cw[1536 + c], cb[c], vb);
    __syncthreads();
#pragma unroll
    for (int i = 0; i < 8; ++i) { X[tb + i] = make_float2(va[i], vb[i]); X[tb + i + 4096] = make_float2(0.f, 0.f); }
    fft_dif(X, W);
    {
      const float2* H = kf + (size_t)c * 8192;
#pragma unroll 4
      for (int i = 0; i < 16; ++i) { int q = tid + i * 512; X[q] = cmul(X[q], H[q]); }
    }
    fft_dit_inv(X, W);
    float za[8], zb[8];
    {
      float xa[8], xb[8];
      hy_conv8(P0 + (size_t)(256 + c) * KEYS, tb, SL, cw[256 + c], cw[768 + 256 + c], cw[1536 + 256 + c], cb[256 + c], xa);
      hy_conv8(P1 + (size_t)(256 + c) * KEYS, tb, SL, cw[256 + c], cw[768 + 256 + c], cw[1536 + 256 + c], cb[256 + c], xb);
#pragma unroll
      for (int i = 0; i < 8; ++i) {
        const float2 y = X[tb + i];
        za[i] = xa[i] * (y.x * (1.f / 8192.f) + bias0 * va[i]);
        zb[i] = xb[i] * (y.y * (1.f / 8192.f) + bias0 * vb[i]);
      }
    }
    __syncthreads();
#pragma unroll
    for (int i = 0; i < 8; ++i) { X[tb + i] = make_float2(za[i], zb[i]); X[tb + i + 4096] = make_float2(0.f, 0.f); }
    fft_dif(X, W);
    {
      const float2* H = kf + (size_t)(256 + c) * 8192;
#pragma unroll 4
      for (int i = 0; i < 16; ++i) { int q = tid + i * 512; X[q] = cmul(X[q], H[q]); }
    }
    fft_dit_inv(X, W);
    {
      float xa[8], xb[8];
      hy_conv8(P0 + (size_t)(512 + c) * KEYS, tb, SL, cw[512 + c], cw[768 + 512 + c], cw[1536 + 512 + c], cb[512 + c], xa);
      hy_conv8(P1 + (size_t)(512 + c) * KEYS, tb, SL, cw[512 + c], cw[768 + 512 + c], cw[1536 + 512 + c], cb[512 + c], xb);
#pragma unroll
      for (int i = 0; i < 8; ++i) {
        const float2 y = X[tb + i];
        const float oa = xa[i] * (y.x * (1.f / 8192.f) + bias1 * za[i]);
        const float ob = xb[i] * (y.y * (1.f / 8192.f) + bias1 * zb[i]);
        Y[((size_t)b0 * SL + tb + i) * 256 + c] = (bf16_t)f2bf(oa);
        Y[((size_t)b1 * SL + tb + i) * 256 + c] = (bf16_t)f2bf(ob);
      }
    }
  }
}

DI void ph_hyena_ctx(const Params& p, int l, char* smem) {
  const int tid = my_tid(), lane = tid & 63, wid = tid >> 6;
  float* Zb = (float*)smem + wid * 1024;
  float* Gb = Zb + 256;
  const bf16_t* PT = (const bf16_t*)(p.ws + R_PHY);
  const float* G = (const float*)(p.ws + MISC_GCTX);
  const float* cw = p.in[7] + (size_t)l * 3 * 768; const float* cb = p.in[8] + (size_t)l * 768;
  const float* hb = p.in[15] + (size_t)l * 512;
  bf16_t* Y = (bf16_t*)(p.ws + R_YHY);
  for (int base = blockIdx.x * 8; base < 2048; base += gridDim.x * 8) {
    const int u = base + wid; const int b = u >> 8, c = u & 255;
    const bf16_t* Pb = PT + ((size_t)b * 768) * KEYS + SL;
    float v[4], x1[4], x2[4], zz[4];
#pragma unroll
    for (int i = 0; i < 4; ++i) {
      int t = lane + i * 64;
      v[i] = hy_conv3(Pb + (size_t)c * KEYS, t, CL, cw[c], cw[768 + c], cw[1536 + c], cb[c]);
      x1[i] = hy_conv3(Pb + (size_t)(256 + c) * KEYS, t, CL, cw[256 + c], cw[768 + 256 + c], cw[1536 + 256 + c], cb[256 + c]);
      x2[i] = hy_conv3(Pb + (size_t)(512 + c) * KEYS, t, CL, cw[512 + c], cw[768 + 512 + c], cw[1536 + 512 + c], cb[512 + c]);
    }
    __syncthreads();
#pragma unroll
    for (int i = 0; i < 4; ++i) Zb[lane + i * 64] = v[i];
    for (int i = lane; i < 512; i += 64) Gb[i] = G[(size_t)c * 512 + i];
    __syncthreads();
#pragma unroll
    for (int i = 0; i < 4; ++i) {
      int t = lane + i * 64; float s = 0.f;
      for (int s2 = 0; s2 < 256; ++s2) s += Gb[256 + t - s2] * Zb[s2];
      zz[i] = x1[i] * (s + hb[c] * v[i]);
    }
    __syncthreads();
#pragma unroll
    for (int i = 0; i < 4; ++i) Zb[lane + i * 64] = zz[i];
    for (int i = lane; i < 512; i += 64) Gb[i] = G[(size_t)(256 + c) * 512 + i];
    __syncthreads();
#pragma unroll
    for (int i = 0; i < 4; ++i) {
      int t = lane + i * 64; float s = 0.f;
      for (int s2 = 0; s2 < 256; ++s2) s += Gb[256 + t - s2] * Zb[s2];
      float o = x2[i] * (s + hb[256 + c] * zz[i]);
      Y[((size_t)ML + b * CL + t) * 256 + c] = (bf16_t)f2bf(o);
    }
  }
}

DI void ph_rope(const Params& p, char* smem) {
  float2* T16 = (float2*)smem;
  float2* T8 = T16 + 64 * 16;
  const int tid = my_tid(), lane = tid & 63, wid = tid >> 6;
  __syncthreads();
  for (int i = tid; i < 64 * 16; i += NTHR) {
    int pos = i >> 4, f = i & 15; float inv = powf(10000.f, -(float)f / 16.f); float s, c; sincosf((float)pos * inv, &s, &c);
    T16[i] = make_float2(c, s);
  }
  for (int i = tid; i < 64 * 8; i += NTHR) {
    int pos = i >> 3, f = i & 7; float inv = powf(10000.f, -(float)f / 8.f); float s, c; sincosf((float)pos * inv, &s, &c);
    T8[i] = make_float2(c, s);
  }
  __syncthreads();
  bf16_t* Psw = (bf16_t*)(p.ws + R_PSW); bf16_t* Pdf = (bf16_t*)(p.ws + R_PDF);
  bf16_t* rowbase_ptr; int e1, e2, nf, f0; bool hsel; bool active = lane < 56;
  if (lane < 24) { const int hd = lane >> 2, half = (lane >> 1) & 1, cp = lane & 1; e1 = hd * 64 + half * 32 + cp * 8; e2 = e1 + 16; nf = 16; f0 = cp * 8; hsel = half; }
  else { const int j = lane - 24; const int gi = j >> 1, half = j & 1; e1 = gi * 32 + half * 16; e2 = e1 + 8; nf = 8; f0 = 0; hsel = half; }
  const float2* Tb = (lane < 24) ? T16 : T8;
  for (int row = blockIdx.x * 8 + wid; row < ML; row += gridDim.x * 8) {
    if (active) {
      const int t = row & (SL - 1); const int pos = hsel ? (t & 63) : (t >> 6);
      rowbase_ptr = (lane < 24) ? Psw + (size_t)row * 384 : Pdf + (size_t)row * 512;
      const uint4 u1 = *(const uint4*)(rowbase_ptr + e1), u2 = *(const uint4*)(rowbase_ptr + e2);
      const float4* cs = (const float4*)(Tb + pos * nf + f0);
      const float4 c0 = cs[0], c1 = cs[1], c2 = cs[2], c3 = cs[3];
      const unsigned w1[4] = {u1.x, u1.y, u1.z, u1.w}, w2[4] = {u2.x, u2.y, u2.z, u2.w};
      const float4 cc[4] = {c0, c1, c2, c3};
      unsigned o1[4], o2[4];
#pragma unroll
      for (int i = 0; i < 4; ++i) {
        const float xa = bflo(w1[i]), xb = bfhi(w1[i]), ya = bflo(w2[i]), yb = bfhi(w2[i]);
        o1[i] = pack2(xa * cc[i].x - ya * cc[i].y, xb * cc[i].z - yb * cc[i].w);
        o2[i] = pack2(xa * cc[i].y + ya * cc[i].x, xb * cc[i].w + yb * cc[i].z);
      }
      *(uint4*)(rowbase_ptr + e1) = make_uint4(o1[0], o1[1], o1[2], o1[3]);
      *(uint4*)(rowbase_ptr + e2) = make_uint4(o2[0], o2[1], o2[2], o2[3]);
    }
  }
}

DI float rw_shift(const bf16_t* __restrict__ P, int row, int t, int len, int col, float mu) {
  float c = bf2f(P[(size_t)row * 1216 + col]);
  float a = t >= 1 ? bf2f(P[(size_t)(row - 1) * 1216 + col]) : 0.f;
  float b = t + 1 < len ? bf2f(P[(size_t)(row + 1) * 1216 + col]) : 0.f;
  return c + (0.5f * (a + b) - c) * mu;
}
DI void ph_rwprep(const Params& p, int l, char* smem) {
  constexpr int AST = 912, RST = 1552, ROFF = 32 * AST;
  const int tid = my_tid(), lane = tid & 63, wid = tid >> 6, g = lane >> 4, r16 = lane & 15;
  const int tg = wid >> 2, hd = wid & 3;
  const bf16_t* P = (const bf16_t*)(p.ws + R_PRW);
  const float* mu = p.in[17] + (size_t)l * 1216;
  const float* w0 = p.in[18] + (size_t)l * 512; const float* a0 = p.in[20] + (size_t)l * 256;
  const float* kkw = p.in[23] + (size_t)l * 256; const float* kaw = p.in[24] + (size_t)l * 256;
  bf16_t* S = (bf16_t*)(p.ws + R_STR); bf16_t* Gs = (bf16_t*)(p.ws + R_G);
  const size_t SU = (size_t)MT * 256;
  float w0f[4], w0b[4], a0c[4], kkc[4], kac[4];
#pragma unroll
  for (int nt = 0; nt < 4; ++nt) { int c = hd * 64 + r16 * 4 + nt; w0f[nt] = w0[c]; w0b[nt] = w0[256 + c]; a0c[nt] = a0[c]; kkc[nt] = kkw[c]; kac[nt] = kaw[c]; }
  for (int u = blockIdx.x; u < MT / 32; u += gridDim.x) {
    const int row0 = u * 32; int t0, len;
    if (row0 < ML) { t0 = row0 & (SL - 1); len = SL; } else { t0 = (row0 - ML) & (CL - 1); len = CL; }
    __syncthreads();
    for (int item = tid; item < 32 * 152; item += NTHR) {
      const int tk = item / 152, c8 = item - tk * 152; const int row = row0 + tk, t = t0 + tk;
      const uint4 uc = *(const uint4*)(P + (size_t)row * 1216 + c8 * 8);
      uint4 ua = make_uint4(0, 0, 0, 0), ub = make_uint4(0, 0, 0, 0);
      if (t >= 1) ua = *(const uint4*)(P + (size_t)(row - 1) * 1216 + c8 * 8);
      if (t + 1 < len) ub = *(const uint4*)(P + (size_t)(row + 1) * 1216 + c8 * 8);
      const float4 m0 = *(const float4*)(mu + c8 * 8), m1 = *(const float4*)(mu + c8 * 8 + 4);
      float o[8];
      {
        const unsigned wc[4] = {uc.x, uc.y, uc.z, uc.w}, wa[4] = {ua.x, ua.y, ua.z, ua.w}, wb[4] = {ub.x, ub.y, ub.z, ub.w};
        const float mm[8] = {m0.x, m0.y, m0.z, m0.w, m1.x, m1.y, m1.z, m1.w};
#pragma unroll
        for (int i = 0; i < 4; ++i) {
          float c_lo = bflo(wc[i]), c_hi = bfhi(wc[i]);
          o[2 * i] = c_lo + (0.5f * (bflo(wa[i]) + bflo(wb[i])) - c_lo) * mm[2 * i];
          o[2 * i + 1] = c_hi + (0.5f * (bfhi(wa[i]) + bfhi(wb[i])) - c_hi) * mm[2 * i + 1];
        }
      }
      char* dst;
      if (c8 < 96) dst = smem + ROFF + tk * RST + c8 * 16;
      else {
        const int cc = c8 * 8 - 768;
        if (cc < 128) {
#pragma unroll
          for (int i = 0; i < 8; ++i) o[i] = 1.f - 2.f * __builtin_amdgcn_rcpf(1.f + __expf(2.f * o[i]));
        } else if (cc >= 192) {
#pragma unroll
          for (int i = 0; i < 8; ++i) o[i] = sigmoidf_(o[i]);
        }
        dst = smem + tk * AST + cc * 2;
      }
      uint4 ov; ov.x = pack2(o[0], o[1]); ov.y = pack2(o[2], o[3]); ov.z = pack2(o[4], o[5]); ov.w = pack2(o[6], o[7]);
      *(uint4*)dst = ov;
    }
    __syncthreads();
    f32x4 acc[5][4];
#pragma unroll
    for (int o5 = 0; o5 < 5; ++o5)
#pragma unroll
      for (int nt = 0; nt < 4; ++nt) acc[o5][nt] = (f32x4){0.f, 0.f, 0.f, 0.f};
    const char* Arow = smem + (tg * 16 + r16) * AST + g * 16;
#pragma unroll
    for (int o5 = 0; o5 < 5; ++o5) {
      const int kbase = o5 < 3 ? o5 * 64 : (o5 == 3 ? 192 : 320);
      const int KK = o5 < 3 ? 64 : 128;
      const bf16_t* Wt = (const bf16_t*)(p.ws + (o5 == 0 ? RWW_F : o5 == 1 ? RWW_B : o5 == 2 ? RWW_A : o5 == 3 ? RWW_GF : RWW_GB));
#pragma unroll
      for (int ks = 0; ks < KK / 32; ++ks) {
        const bf16x8 af = *(const bf16x8*)(Arow + (kbase + ks * 32) * 2);
#pragma unroll
        for (int nt = 0; nt < 4; ++nt) {
          const bf16x8 bf = *(const bf16x8*)(Wt + (size_t)(hd * 64 + nt * 16 + r16) * KK + ks * 32 + g * 8);
          acc[o5][nt] = __builtin_amdgcn_mfma_f32_16x16x32_bf16(af, bf, acc[o5][nt], 0, 0, 0);
        }
        if (ks == KK / 32 - 1 && (o5 == 2 || o5 == 4)) asm volatile("" ::: "memory");
      }
    }
#pragma unroll
    for (int j = 0; j < 4; ++j) {
      const int tk = tg * 16 + g * 4 + j; const size_t row = (size_t)row0 + tk;
      const char* rk = smem + ROFF + tk * RST;
      const int c0 = hd * 64 + r16 * 4;
      const uint2 ur = *(const uint2*)(rk + c0 * 2), uk = *(const uint2*)(rk + (256 + c0) * 2), uv = *(const uint2*)(rk + (512 + c0) * 2);
      const float rv[4] = {bflo(ur.x), bfhi(ur.x), bflo(ur.y), bfhi(ur.y)};
      const float kv[4] = {bflo(uk.x), bfhi(uk.x), bflo(uk.y), bfhi(uk.y)};
      const float vv[4] = {bflo(uv.x), bfhi(uv.x), bflo(uv.y), bfhi(uv.y)};
      float n2 = 0.f;
#pragma unroll
      for (int nt = 0; nt < 4; ++nt) { float q = kv[nt] * kkc[nt]; n2 += q * q; }
      n2 = sum16(n2);
      const float inv = __builtin_amdgcn_rsqf(fmaxf(n2, 1e-24f));
      float o_kp[4], o_kk[4], o_b[4], o_df[4], o_db[4];
#pragma unroll
      for (int nt = 0; nt < 4; ++nt) {
        const float k = kv[nt];
        const float a = sigmoidf_(a0c[nt] + acc[2][nt][j]);
        const float kk = k * kkc[nt] * inv;
        o_kp[nt] = k * (1.f + (a - 1.f) * kac[nt]);
        o_kk[nt] = kk; o_b[nt] = kk * a;
        const float xf = -(w0f[nt] + acc[0][nt][j]); const float spf = fmaxf(xf, 0.f) + __logf(1.f + __expf(-fabsf(xf)));
        const float xb = -(w0b[nt] + acc[1][nt][j]); const float spb = fmaxf(xb, 0.f) + __logf(1.f + __expf(-fabsf(xb)));
        const float ef = __expf(-spf - 0.5f), eb = __expf(-spb - 0.5f);
        o_df[nt] = 1.f - __expf(-ef); o_db[nt] = 1.f - __expf(-eb);
      }
      const size_t o = row * 256 + c0;
      uint2 w;
      w.x = pack2(rv[0], rv[1]); w.y = pack2(rv[2], rv[3]); *(uint2*)(S + o) = w;
      w.x = pack2(o_kp[0], o_kp[1]); w.y = pack2(o_kp[2], o_kp[3]); *(uint2*)(S + SU + o) = w;
      w.x = pack2(vv[0], vv[1]); w.y = pack2(vv[2], vv[3]); *(uint2*)(S + 2 * SU + o) = w;
      w.x = pack2(o_kk[0], o_kk[1]); w.y = pack2(o_kk[2], o_kk[3]); *(uint2*)(S + 3 * SU + o) = w;
      w.x = pack2(o_b[0], o_b[1]); w.y = pack2(o_b[2], o_b[3]); *(uint2*)(S + 4 * SU + o) = w;
      w.x = pack2(o_df[0], o_df[1]); w.y = pack2(o_df[2], o_df[3]); *(uint2*)(S + 5 * SU + o) = w;
      w.x = pack2(o_db[0], o_db[1]); w.y = pack2(o_db[2], o_db[3]); *(uint2*)(S + 6 * SU + o) = w;
      w.x = pack2(acc[3][0][j], acc[3][1][j]); w.y = pack2(acc[3][2][j], acc[3][3][j]); *(uint2*)(Gs + o) = w;
      w.x = pack2(acc[4][0][j], acc[4][1][j]); w.y = pack2(acc[4][2][j], acc[4][3][j]); *(uint2*)(Gs + SU + o) = w;
    }
  }
}

DI long scan_row(int b, int dir, int s) {
  if (s < CL) return (long)ML + b * CL + (dir ? (CL - 1 - s) : s);
  int t = s - CL; return (long)b * SL + (dir ? (SL - 1 - t) : t);
}
DI float sum8(float v) {
  v += dpp_mov<0xB1>(v);
  v += dpp_mov<0x4E>(v);
  v += dpp_mov<0x141>(v);
  return v;
}
DI void ph_scan(const Params& p, char* smem) {
  const int tid = my_tid(), lane = tid & 63, wid = tid >> 6;
  const bf16_t* S = (const bf16_t*)(p.ws + R_STR);
  const size_t SU = (size_t)MT * 256;
  constexpr int T = 32, NSTEP = CL + SL, NCH = NSTEP / T;
  typedef float f32x2 __attribute__((ext_vector_type(2)));
  for (int u = blockIdx.x; u < 128; u += gridDim.x) {
    const int chain = u >> 1, rg = u & 1; const int dir = chain & 1, bh = chain >> 1, b = bh >> 2, h = bh & 3;
    bf16_t* O = (bf16_t*)(p.ws + (dir ? R_OB : R_OF));
    uint4 q0, q1, q2;
    auto SC_GLOAD = [&](int ci) {
#pragma unroll
      for (int j = 0; j < 3; ++j) {
        int idx = tid + j * 512; int st = idx >> 8, s = (idx & 255) >> 3, ck = idx & 7;
        long row = scan_row(b, dir, ci * T + s);
        int sid = st < 5 ? st : 5 + dir;
        uint4 v = *(const uint4*)(S + sid * SU + row * 256 + h * 64 + ck * 8);
        if (j == 0) q0 = v; else if (j == 1) q1 = v; else q2 = v;
      }
    };
    auto SC_SSTORE = [&](int buf) {
#pragma unroll
      for (int j = 0; j < 3; ++j) {
        int idx = tid + j * 512; int st = idx >> 8;
        uint4 v = j == 0 ? q0 : (j == 1 ? q1 : q2);
        float4 lo = make_float4(bflo(v.x), bfhi(v.x), bflo(v.y), bfhi(v.y));
        float4 hi = make_float4(bflo(v.z), bfhi(v.z), bflo(v.w), bfhi(v.w));
        if (st == 5) { lo.x = 1.f - lo.x; lo.y = 1.f - lo.y; lo.z = 1.f - lo.z; lo.w = 1.f - lo.w; hi.x = 1.f - hi.x; hi.y = 1.f - hi.y; hi.z = 1.f - hi.z; hi.w = 1.f - hi.w; }
        char* base = smem + buf * 49152 + idx * 32;
        *(float4*)(base) = lo; *(float4*)(base + 16) = hi;
      }
    };
    auto FLUSH = [&](int ci) {
      const int s = tid >> 4, part = tid & 15;
      const float2 v = *(const float2*)(smem + 98304 + (ci & 1) * 4096 + s * 128 + part * 8);
      long row = scan_row(b, dir, ci * T + s);
      *(unsigned*)(O + row * 256 + h * 64 + rg * 32 + part * 2) = pack2(v.x, v.y);
    };
    __syncthreads();
    SC_GLOAD(0);
    SC_SSTORE(0);
    __syncthreads();
    f32x2 st0 = {0.f, 0.f}, st1 = {0.f, 0.f}, st2 = {0.f, 0.f}, st3 = {0.f, 0.f};
    const int rsub = lane >> 3, ks = lane & 7;
    const int lrow = (wid & 3) * 8 + rsub;
    const int vrow = rg * 32 + lrow;
    struct Step { f32x2 r[4], k[4], kk[4], b[4], w[4]; float v; };
    auto LOADSTEP = [&](Step& x, const char* B, int s) {
#pragma unroll
      for (int hh = 0; hh < 2; ++hh) {
        const float4 r = *(const float4*)(B + (0 * T + s) * 256 + ks * 32 + hh * 16);
        const float4 k = *(const float4*)(B + (1 * T + s) * 256 + ks * 32 + hh * 16);
        const float4 kk = *(const float4*)(B + (3 * T + s) * 256 + ks * 32 + hh * 16);
        const float4 bb = *(const float4*)(B + (4 * T + s) * 256 + ks * 32 + hh * 16);
        const float4 w = *(const float4*)(B + (5 * T + s) * 256 + ks * 32 + hh * 16);
        x.r[2 * hh] = (f32x2){r.x, r.y}; x.r[2 * hh + 1] = (f32x2){r.z, r.w};
        x.k[2 * hh] = (f32x2){k.x, k.y}; x.k[2 * hh + 1] = (f32x2){k.z, k.w};
        x.kk[2 * hh] = (f32x2){kk.x, kk.y}; x.kk[2 * hh + 1] = (f32x2){kk.z, kk.w};
        x.b[2 * hh] = (f32x2){bb.x, bb.y}; x.b[2 * hh + 1] = (f32x2){bb.z, bb.w};
        x.w[2 * hh] = (f32x2){w.x, w.y}; x.w[2 * hh + 1] = (f32x2){w.z, w.w};
      }
      x.v = *(const float*)(B + (2 * T + s) * 256 + vrow * 4);
    };
    for (int ci = 0; ci < NCH; ++ci) {
      if (ci + 1 < NCH) { SC_GLOAD(ci + 1); }
      if (ci > 0) FLUSH(ci - 1);
      if (wid < 4) {
        const char* B = smem + (ci & 1) * 49152;
        float* ob = (float*)(smem + 98304 + (ci & 1) * 4096);
        Step nx; LOADSTEP(nx, B, 0);
#pragma unroll 4
        for (int s = 0; s < T; ++s) {
          const Step c = nx;
          LOADSTEP(nx, B, s + 1);
          f32x2 pa = st0 * c.kk[0] + st1 * c.kk[1];
          f32x2 pb = st2 * c.kk[2] + st3 * c.kk[3];
          pa = pa + pb;
          float sa = -(pa.x + pa.y);
          sa = sum8(sa);
          const f32x2 sa2 = {sa, sa}; const f32x2 v2 = {c.v, c.v};
          st0 = st0 * c.w[0] + sa2 * c.b[0] + v2 * c.k[0];
          st1 = st1 * c.w[1] + sa2 * c.b[1] + v2 * c.k[1];
          st2 = st2 * c.w[2] + sa2 * c.b[2] + v2 * c.k[2];
          st3 = st3 * c.w[3] + sa2 * c.b[3] + v2 * c.k[3];
          f32x2 oa = st0 * c.r[0] + st1 * c.r[1];
          f32x2 ob2 = st2 * c.r[2] + st3 * c.r[3];
          oa = oa + ob2;
          float o = sum8(oa.x + oa.y);
          ob[s * 32 + lrow] = o;
        }
      }
      if (ci + 1 < NCH) { SC_SSTORE((ci + 1) & 1); }
      __syncthreads();
    }
    FLUSH(NCH - 1);
  }
}

template <bool DIFF>
DI void attn_unit(const Params& p, int l, int b, int h, int qrow0, int qpos0, int kb_lo, int kb_hi, int kc_lo, char* smem) {
  const int tid = my_tid(), lane = tid & 63, wid = tid >> 6, g = lane >> 4, r16 = lane & 15;
  const bf16_t* QK = (const bf16_t*)(p.ws + (DIFF ? R_PDF : R_PSW));
  const int ldq = DIFF ? 512 : 384;
  const int qc0 = h * 64;
  const int kc0 = 256 + (DIFF ? h * 64 : (h >> 1) * 64);
  const bf16_t* VT = DIFF ? (const bf16_t*)(p.ws + R_VTDF) + ((size_t)b * 256 + h * 64) * KEYS
                          : (const bf16_t*)(p.ws + R_VTSW) + ((size_t)b * 128 + (h >> 1) * 64) * KEYS;
  const int nblk = (kb_hi - kb_lo) + (68 - kc_lo);
  const float sc = (DIFF ? 0.17677669529663687f : 0.125f) * 1.4426950408889634f;
  bf16x8 qf[2];
  {
    const bf16_t* qp = QK + (size_t)(qrow0 + wid * 16 + r16) * ldq + qc0 + g * 8;
    qf[0] = *(const bf16x8*)(qp); qf[1] = *(const bf16x8*)(qp + 32);
  }
  constexpr int NC = DIFF ? 2 : 1;
  float m[NC], lsum[NC];
  f32x4 O[NC][4];
#pragma unroll
  for (int c = 0; c < NC; ++c) {
    if (DIFF) { m[c] = -1e30f; lsum[c] = 0.f; }
    else { m[c] = p.in[16][l * 4 + h] * 1.4426950408889634f; lsum[c] = (g == 0) ? 1.f : 0.f; }
#pragma unroll
    for (int dt = 0; dt < 4; ++dt) O[c][dt] = (f32x4){0.f, 0.f, 0.f, 0.f};
  }
  const int lr = tid >> 3, lc = tid & 7;
  uint4 rkA, rvA, rkB, rvB;
  rkA = make_uint4(0, 0, 0, 0); rvA = rkA; rkB = rkA; rvB = rkA;
  auto AT_GLOAD = [&](int i, uint4& rk, uint4& rv) {
    int kb = i < (kb_hi - kb_lo) ? kb_lo + i : kc_lo + (i - (kb_hi - kb_lo));
    long krow = kb < 64 ? (long)b * SL + kb * 64 + lr : (long)ML + b * CL + (kb - 64) * 64 + lr;
    rk = *(const uint4*)(QK + krow * ldq + kc0 + lc * 8);
    rv = *(const uint4*)(VT + (size_t)lr * KEYS + kb * 64 + lc * 8);
  };
  auto AT_SSTORE = [&](int buf, const uint4& rk, const uint4& rv) {
    *(uint4*)(smem + buf * 18432 + lr * 128 + ((lc ^ (lr & 7)) << 4)) = rk;
    *(uint4*)(smem + buf * 18432 + 9216 + lr * 144 + lc * 16) = rv;
  };
  __syncthreads();
  AT_GLOAD(0, rkA, rvA);
  AT_SSTORE(0, rkA, rvA);
  if (1 < nblk) AT_GLOAD(1, rkA, rvA);
  if (2 < nblk) AT_GLOAD(2, rkB, rvB);
  lds_barrier();
  const int qpos = qpos0 + wid * 16 + r16;
  for (int i = 0; i < nblk; ++i) {
    const int kb = i < (kb_hi - kb_lo) ? kb_lo + i : kc_lo + (i - (kb_hi - kb_lo));
    const bool masked = (!DIFF) && (kb < 64);
    const char* Kt = smem + (i & 1) * 18432; const char* Vt = Kt + 9216;
    f32x4 S[NC][4];
#pragma unroll
    for (int kt = 0; kt < 4; ++kt) {
      bf16x8 k0 = *(const bf16x8*)(Kt + (kt * 16 + r16) * 128 + ((g ^ (r16 & 7)) << 4));
      bf16x8 k1 = *(const bf16x8*)(Kt + (kt * 16 + r16) * 128 + (((4 + g) ^ (r16 & 7)) << 4));
      if (DIFF) {
        S[0][kt] = __builtin_amdgcn_mfma_f32_16x16x32_bf16(k0, qf[0], (f32x4){0.f, 0.f, 0.f, 0.f}, 0, 0, 0);
        S[NC - 1][kt] = __builtin_amdgcn_mfma_f32_16x16x32_bf16(k1, qf[1], (f32x4){0.f, 0.f, 0.f, 0.f}, 0, 0, 0);
      } else {
        f32x4 t = __builtin_amdgcn_mfma_f32_16x16x32_bf16(k0, qf[0], (f32x4){0.f, 0.f, 0.f, 0.f}, 0, 0, 0);
        S[0][kt] = __builtin_amdgcn_mfma_f32_16x16x32_bf16(k1, qf[1], t, 0, 0, 0);
      }
    }
    bf16x8 pf[NC][2];
#pragma unroll
    for (int c = 0; c < NC; ++c) {
      float mx = -1e30f;
#pragma unroll
      for (int kt = 0; kt < 4; ++kt)
#pragma unroll
        for (int j = 0; j < 4; ++j) {
          float v = S[c][kt][j];
          if (masked) { int kpos = kb * 64 + kt * 16 + g * 4 + j; int dd = kpos - qpos; if (dd > 128 || dd < -128) v = -3e38f; S[c][kt][j] = v; }
          mx = fmaxf(mx, v);
        }
      mx *= sc;
      mx = fmaxf(mx, __shfl_xor(mx, 16)); mx = fmaxf(mx, __shfl_xor(mx, 32));
      const float mn = fmaxf(m[c], mx);
      const bool grow = mn > m[c];
      float ps = 0.f;
      unsigned pk[8];
#pragma unroll
      for (int kt = 0; kt < 4; ++kt) {
        float e0 = __builtin_amdgcn_exp2f(fmaf(S[c][kt][0], sc, -mn)), e1 = __builtin_amdgcn_exp2f(fmaf(S[c][kt][1], sc, -mn));
        float e2 = __builtin_amdgcn_exp2f(fmaf(S[c][kt][2], sc, -mn)), e3 = __builtin_amdgcn_exp2f(fmaf(S[c][kt][3], sc, -mn));
        ps += (e0 + e1) + (e2 + e3);
        pk[kt * 2] = pack2(e0, e1); pk[kt * 2 + 1] = pack2(e2, e3);
      }
      if (__builtin_amdgcn_ballot_w64(grow) != 0ull) {
        const float alpha = __builtin_amdgcn_exp2f(m[c] - mn);
        m[c] = mn;
        lsum[c] *= alpha;
#pragma unroll
        for (int dt = 0; dt < 4; ++dt) { O[c][dt][0] *= alpha; O[c][dt][1] *= alpha; O[c][dt][2] *= alpha; O[c][dt][3] *= alpha; }
      }
      lsum[c] += ps;
      union { unsigned u[4]; bf16x8 v; } cv;
      cv.u[0] = pk[0]; cv.u[1] = pk[1]; cv.u[2] = pk[2]; cv.u[3] = pk[3]; pf[c][0] = cv.v;
      cv.u[0] = pk[4]; cv.u[1] = pk[5]; cv.u[2] = pk[6]; cv.u[3] = pk[7]; pf[c][1] = cv.v;
    }
#pragma unroll
    for (int dt = 0; dt < 4; ++dt)
#pragma unroll
      for (int s2 = 0; s2 < 2; ++s2) {
        union { uint2 u[2]; bf16x8 v; } vf;
        vf.u[0] = *(const uint2*)(Vt + (dt * 16 + r16) * 144 + (2 * s2) * 32 + g * 8);
        vf.u[1] = *(const uint2*)(Vt + (dt * 16 + r16) * 144 + (2 * s2 + 1) * 32 + g * 8);
#pragma unroll
        for (int c = 0; c < NC; ++c) O[c][dt] = __builtin_amdgcn_mfma_f32_16x16x32_bf16(vf.v, pf[c][s2], O[c][dt], 0, 0, 0);
      }
    if (i + 1 < nblk) AT_SSTORE((i + 1) & 1, rkA, rvA);
    rkA = rkB; rvA = rvB;
    if (i + 3 < nblk) AT_GLOAD(i + 3, rkB, rvB);
    lds_barrier();
  }
  float linv[NC];
#pragma unroll
  for (int c = 0; c < NC; ++c) { float t = lsum[c]; t += __shfl_xor(t, 16); t += __shfl_xor(t, 32); linv[c] = 1.f / t; }
  const size_t orow = (size_t)(qrow0 + wid * 16 + r16);
  if (!DIFF) {
    bf16_t* Y = (bf16_t*)(p.ws + R_YSW);
#pragma unroll
    for (int dt = 0; dt < 4; ++dt) {
      uint2 o; o.x = pack2(O[0][dt][0] * linv[0], O[0][dt][1] * linv[0]); o.y = pack2(O[0][dt][2] * linv[0], O[0][dt][3] * linv[0]);
      *(uint2*)(Y + orow * 256 + h * 64 + dt * 16 + g * 4) = o;
    }
  } else {
    const float lam_init = 0.8f - 0.6f * __expf(-0.3f * (float)l);
    float d1 = 0.f, d2 = 0.f;
    if (lane < 32) { d1 = p.in[28][l * 32 + lane] * p.in[29][l * 32 + lane]; d2 = p.in[30][l * 32 + lane] * p.in[31][l * 32 + lane]; }
    d1 = wave_sum(d1); d2 = wave_sum(d2);
    const float lam = expf(d1) - expf(d2) + lam_init;
    float ov[4][4]; float ss = 0.f;
#pragma unroll
    for (int dt = 0; dt < 4; ++dt)
#pragma unroll
      for (int j = 0; j < 4; ++j) { float v = O[0][dt][j] * linv[0] - lam * O[NC - 1][dt][j] * linv[NC - 1]; ov[dt][j] = v; ss += v * v; }
    ss += __shfl_xor(ss, 16); ss += __shfl_xor(ss, 32);
    const float rms = rsqrtf(ss * (1.f / 64.f) + 1e-5f) * (1.f - lam_init);
    const float* sg = p.in[32] + l * 64;
    bf16_t* Y = (bf16_t*)(p.ws + R_YDF);
#pragma unroll
    for (int dt = 0; dt < 4; ++dt) {
      const int d0 = dt * 16 + g * 4;
      uint2 o; o.x = pack2(ov[dt][0] * rms * sg[d0], ov[dt][1] * rms * sg[d0 + 1]); o.y = pack2(ov[dt][2] * rms * sg[d0 + 2], ov[dt][3] * rms * sg[d0 + 3]);
      *(uint2*)(Y + orow * 256 + h * 64 + d0) = o;
    }
  }
}

DI void ph_attn(const Params& p, int l, char* smem) {
  const bool need_ctx = (l == 0);
  const int n_sw = 1024 + (need_ctx ? 64 : 0);
  const int n_df = 1024 + (need_ctx ? 64 : 0);
  unsigned* ctr = (unsigned*)(p.ws + MISC_BAR + 64 + 64 * l);
  volatile int* slot = (volatile int*)(smem + 40960);
  for (;;) {
    __syncthreads();
    if (my_tid() == 0) *slot = (int)__hip_atomic_fetch_add(ctr, 1u, __ATOMIC_RELAXED, __HIP_MEMORY_SCOPE_AGENT);
    __syncthreads();
    const int u = *slot;
    if (u >= n_sw + n_df) break;
    if (u < n_df) {
      if (u < 1024) { int b = u >> 7, h = (u >> 5) & 3, n = u & 31; attn_unit<true>(p, l, b, h, b * SL + n * 128, n * 128, 0, 64, 64, smem); }
      else { int v = u - 1024; int b = v >> 3, h = (v >> 1) & 3, n = v & 1; attn_unit<true>(p, l, b, h, ML + b * CL + n * 128, 0, 0, 0, 64, smem); }
    } else {
      int w = u - n_df;
      if (w < 1024) {
        int b = w >> 7, h = (w >> 5) & 3, n = w & 31;
        int lo = (n - 1) * 2; if (lo < 0) lo = 0; int hi = (n + 2) * 2; if (hi > 64) hi = 64;
        attn_unit<false>(p, l, b, h, b * SL + n * 128, n * 128, lo, hi, 64, smem);
      } else { int v = w - 1024; int b = v >> 3, h = (v >> 1) & 3, n = v & 1; attn_unit<false>(p, l, b, h, ML + b * CL + n * 128, 0, 0, 0, 64, smem); }
    }
  }
}

DI void ph_rwout(const Params& p, int l) {
  const int lane = my_tid() & 63, wid = my_tid() >> 6;
  const bf16_t* S = (const bf16_t*)(p.ws + R_STR); const bf16_t* Gs = (const bf16_t*)(p.ws + R_G);
  const bf16_t* OF = (const bf16_t*)(p.ws + R_OF); const bf16_t* OB = (const bf16_t*)(p.ws + R_OB);
  bf16_t* Y = (bf16_t*)(p.ws + R_YRW);
  const size_t SU = (size_t)MT * 256;
  const float4 rk = *(const float4*)(p.in[25] + (size_t)l * 256 + lane * 4);
  const float4 gam = *(const float4*)(p.in[26] + (size_t)l * 256 + lane * 4);
  const float4 bet = *(const float4*)(p.in[27] + (size_t)l * 256 + lane * 4);
  const int nrows = (l == 0) ? MT : ML;
  for (int row = blockIdx.x * 8 + wid; row < nrows; row += gridDim.x * 8) {
    const size_t o = (size_t)row * 256 + lane * 4;
    uint2 ur = *(const uint2*)(S + o), uk = *(const uint2*)(S + SU + o), uv = *(const uint2*)(S + 2 * SU + o);
    uint2 uf = *(const uint2*)(OF + o), ub = *(const uint2*)(OB + o), ugf = *(const uint2*)(Gs + o), ugb = *(const uint2*)(Gs + SU + o);
    float r[4] = {bflo(ur.x), bfhi(ur.x), bflo(ur.y), bfhi(ur.y)};
    float k[4] = {bflo(uk.x), bfhi(uk.x), bflo(uk.y), bfhi(uk.y)};
    float v[4] = {bflo(uv.x), bfhi(uv.x), bflo(uv.y), bfhi(uv.y)};
    float f[4] = {bflo(uf.x), bfhi(uf.x), bflo(uf.y), bfhi(uf.y)};
    float bb[4] = {bflo(ub.x), bfhi(ub.x), bflo(ub.y), bfhi(ub.y)};
    float gf[4] = {bflo(ugf.x), bfhi(ugf.x), bflo(ugf.y), bfhi(ugf.y)};
    float gb[4] = {bflo(ugb.x), bfhi(ugb.x), bflo(ugb.y), bfhi(ugb.y)};
    const float rkv[4] = {rk.x, rk.y, rk.z, rk.w}; const float ga[4] = {gam.x, gam.y, gam.z, gam.w}; const float be[4] = {bet.x, bet.y, bet.z, bet.w};
    float bon = 0.f, sf = 0.f, sb = 0.f;
#pragma unroll
    for (int i = 0; i < 4; ++i) { bon += r[i] * k[i] * rkv[i]; sf += f[i]; sb += bb[i]; }
    bon = sum16(bon); float muf = sum16(sf) * (1.f / 64.f), mub = sum16(sb) * (1.f / 64.f);
    float qf = 0.f, qb = 0.f;
#pragma unroll
    for (int i = 0; i < 4; ++i) { f[i] -= muf; bb[i] -= mub; qf += f[i] * f[i]; qb += bb[i] * bb[i]; }
    float rsf = rsqrtf(sum16(qf) * (1.f / 64.f) + 64e-5f), rsb = rsqrtf(sum16(qb) * (1.f / 64.f) + 64e-5f);
    float y[4];
#pragma unroll
    for (int i = 0; i < 4; ++i) {
      float bn = bon * v[i];
      y[i] = (f[i] * rsf * ga[i] + be[i] + bn) * gf[i] + (bb[i] * rsb * ga[i] + be[i] + bn) * gb[i];
    }
    uint2 oo; oo.x = pack2(y[0], y[1]); oo.y = pack2(y[2], y[3]);
    *(uint2*)(Y + o) = oo;
  }
}

DI void ph_merge(const Params& p, int l, const bf16_t* U, char* smem) {
  const int lane = my_tid() & 63, wid = my_tid() >> 6, wm = wid >> 1, wn = wid & 1, g = lane >> 4, r16 = lane & 15;
  const int mtiles = (l == 0) ? 136 : 128;
  bf16_t* ACC = (bf16_t*)(p.ws + R_ACC);
  for (int it = 0;; ++it) {
    int mtile, ntile;
    if (!next_tile(it, mtiles, 8, mtile, ntile)) break;
    uint2 accS[4][4];
#pragma unroll
    for (int mt = 0; mt < 4; ++mt)
#pragma unroll
      for (int nt = 0; nt < 4; ++nt) accS[mt][nt] = make_uint2(0u, 0u);
    for (int j = 0; j < 4; ++j) {
      uint2 pb[4][4];
      {
        f32x4 accB[4][4]; zero_acc<4>(accB);
        const size_t yoff = (j == 0) ? R_YHY : (j == 1) ? R_YSW : (j == 2) ? R_YRW : R_YDF;
        gemm_glds(accB, (const bf16_t*)(p.ws + yoff), 256, RowPlain{(long)mtile * 256}, (const bf16_t*)(p.ws + WB_BR) + ((size_t)j * 1024 + ntile * 128) * 256, 256, 256, smem, (const bf16_t*)(p.ws + MISC_ZERO));
#pragma unroll
        for (int mt = 0; mt < 4; ++mt)
#pragma unroll
          for (int nt = 0; nt < 4; ++nt) { pb[mt][nt].x = pack2(accB[mt][nt][0], accB[mt][nt][1]); pb[mt][nt].y = pack2(accB[mt][nt][2], accB[mt][nt][3]); }
      }
      f32x4 accG[4][4]; zero_acc<4>(accG);
      gemm_glds(accG, U, 1024, RowPlain{(long)mtile * 256}, (const bf16_t*)(p.ws + WB_GATE) + ((size_t)j * 1024 + ntile * 128) * 1024, 1024, 1024, smem, (const bf16_t*)(p.ws + MISC_ZERO));
#pragma unroll
      for (int mt = 0; mt < 4; ++mt)
#pragma unroll
        for (int nt = 0; nt < 4; ++nt) {
          float v0 = bflo(accS[mt][nt].x) + sigmoidf_(accG[mt][nt][0]) * bflo(pb[mt][nt].x);
          float v1 = bfhi(accS[mt][nt].x) + sigmoidf_(accG[mt][nt][1]) * bfhi(pb[mt][nt].x);
          float v2 = bflo(accS[mt][nt].y) + sigmoidf_(accG[mt][nt][2]) * bflo(pb[mt][nt].y);
          float v3 = bfhi(accS[mt][nt].y) + sigmoidf_(accG[mt][nt][3]) * bfhi(pb[mt][nt].y);
          accS[mt][nt].x = pack2(v0, v1); accS[mt][nt].y = pack2(v2, v3);
        }
    }
#pragma unroll
    for (int mt = 0; mt < 4; ++mt) {
      const int col = ntile * 128 + wn * 64 + r16 * 4;
      const size_t row = (size_t)mtile * 256 + wm * 64 + mt * 16 + g * 4;
      uint2 o;
      o.x = (accS[mt][0].x & 0xffffu) | (accS[mt][1].x << 16); o.y = (accS[mt][2].x & 0xffffu) | (accS[mt][3].x << 16);
      *(uint2*)(ACC + (row + 0) * 1024 + col) = o;
      o.x = (accS[mt][0].x >> 16) | (accS[mt][1].x & 0xffff0000u); o.y = (accS[mt][2].x >> 16) | (accS[mt][3].x & 0xffff0000u);
      *(uint2*)(ACC + (row + 1) * 1024 + col) = o;
      o.x = (accS[mt][0].y & 0xffffu) | (accS[mt][1].y << 16); o.y = (accS[mt][2].y & 0xffffu) | (accS[mt][3].y << 16);
      *(uint2*)(ACC + (row + 2) * 1024 + col) = o;
      o.x = (accS[mt][0].y >> 16) | (accS[mt][1].y & 0xffff0000u); o.y = (accS[mt][2].y >> 16) | (accS[mt][3].y & 0xffff0000u);
      *(uint2*)(ACC + (row + 3) * 1024 + col) = o;
    }
  }
}

DI void ph_resgemm(const Params& p, int l, const bf16_t* A, int K, const bf16_t* Bt, const float* hsrc_lat, const float* hsrc_ctx, int gate_off, char* smem) {
  const int lane = my_tid() & 63, wid = my_tid() >> 6, wm = wid >> 1, wn = wid & 1, g = lane >> 4, r16 = lane & 15;
  const int mtiles = (l == 0) ? 136 : 128;
  const float* mod = (const float*)(p.ws + MISC_MOD) + (size_t)l * 9 * 6144;
  float* hc = (float*)(p.ws + OFF_HC);
  for (int it = 0;; ++it) {
    int mtile, ntile;
    if (!next_tile(it, mtiles, 8, mtile, ntile)) break;
    f32x4 acc[4][4]; zero_acc<4>(acc);
    gemm_glds(acc, A, K, RowPlain{(long)mtile * 256}, Bt + (size_t)ntile * 128 * K, K, K, smem, (const bf16_t*)(p.ws + MISC_ZERO));
    const int b = mtile < 128 ? (mtile >> 4) : 8;
    const float* gt = mod + (size_t)b * 6144 + gate_off;
    const int col = ntile * 128 + wn * 64 + r16 * 4;
    const float4 gv = *(const float4*)(gt + col);
    const float* hs_tile = mtile < 128 ? hsrc_lat + (size_t)mtile * 256 * D : hsrc_ctx + (size_t)(mtile - 128) * 256 * D;
    float* hd_tile = mtile < 128 ? p.out + (size_t)mtile * 256 * D : hc + (size_t)(mtile - 128) * 256 * D;
#pragma unroll
    for (int mt = 0; mt < 4; ++mt)
#pragma unroll
      for (int e = 0; e < 4; ++e) {
        const size_t o = (size_t)(wm * 64 + mt * 16 + g * 4 + e) * D + col;
        const float* hs = hs_tile + o; float* hd = hd_tile + o;
        const float4 h = *(const float4*)hs;
        float4 r;
        r.x = DN_ALPHA * h.x + gv.x * acc[mt][0][e]; r.y = DN_ALPHA * h.y + gv.y * acc[mt][1][e];
        r.z = DN_ALPHA * h.z + gv.z * acc[mt][2][e]; r.w = DN_ALPHA * h.w + gv.w * acc[mt][3][e];
        *(float4*)hd = r;
      }
  }
}

DI void ph_ffnup(const Params& p, int l, char* smem) {
  const bf16_t* U = (const bf16_t*)(p.ws + R_U);
  const bf16_t* Bt = (const bf16_t*)(p.ws + WB_UP);
  bf16_t* HID = (bf16_t*)(p.ws + R_HID);
  const float* cw = p.in[38] + (size_t)l * 3 * 5632; const float* cb = p.in[39] + (size_t)l * 5632;
  const int tid = my_tid(), lane = tid & 63, wid = tid >> 6, wm = wid >> 2, wn = wid & 3, g = lane >> 4, r16 = lane & 15;
  const int mtiles = (l == 0) ? 144 : 136;
  constexpr int TS = 528;
  for (int it = 0;; ++it) {
    int mtile, ntile;
    if (!next_tile(it, mtiles, 22, mtile, ntile)) break;
    long rowbase; int t0, len, r0, r1;
    if (mtile < 136) { int b = mtile / 17; int tt = mtile % 17; len = SL; rowbase = (long)b * SL; t0 = tt * 254 - 1; r0 = 1; r1 = 254; }
    else { int b = mtile - 136; len = CL; rowbase = (long)ML + b * CL; t0 = 0; r0 = 0; r1 = 255; }
    f32x4 acc[8][4]; zero_acc256(acc);
    gemm_glds256(acc, U, 1024, rowbase + t0, Bt + (size_t)ntile * 256 * 1024, 1024, 1024, smem);
#pragma unroll
    for (int mt = 0; mt < 8; ++mt)
#pragma unroll
      for (int e = 0; e < 4; ++e) {
        uint2 o; o.x = pack2(acc[mt][0][e], acc[mt][1][e]); o.y = pack2(acc[mt][2][e], acc[mt][3][e]);
        *(uint2*)(smem + (wm * 128 + mt * 16 + g * 4 + e) * TS + (wn * 64 + r16 * 4) * 2) = o;
      }
    __syncthreads();
    {
      const int ch = (tid & 31) * 4, rgp = tid >> 5; const int ca = ntile * 128 + ch, cbx = 2816 + ca;
      const float4 wa0 = *(const float4*)(cw + ca), wa1 = *(const float4*)(cw + 5632 + ca), wa2 = *(const float4*)(cw + 2 * 5632 + ca), wab = *(const float4*)(cb + ca);
      const float4 wb0 = *(const float4*)(cw + cbx), wb1 = *(const float4*)(cw + 5632 + cbx), wb2 = *(const float4*)(cw + 2 * 5632 + cbx), wbb = *(const float4*)(cb + cbx);
      for (int r = r0 + rgp; r <= r1; r += 16) {
        const int tok = t0 + r;
        if (tok < len) {
          const char* Tr = smem + r * TS + ch * 2;
          const uint2 z2 = make_uint2(0u, 0u);
          const uint2 ua = *(const uint2*)(Tr), ub = *(const uint2*)(Tr + 256);
          const uint2 pa = tok >= 1 ? *(const uint2*)(Tr - TS) : z2, pb_ = tok >= 1 ? *(const uint2*)(Tr - TS + 256) : z2;
          const uint2 na = tok + 1 < len ? *(const uint2*)(Tr + TS) : z2, nb = tok + 1 < len ? *(const uint2*)(Tr + TS + 256) : z2;
          const float av0 = wa0.x * bflo(pa.x) + wa1.x * bflo(ua.x) + wa2.x * bflo(na.x) + wab.x;
          const float av1 = wa0.y * bfhi(pa.x) + wa1.y * bfhi(ua.x) + wa2.y * bfhi(na.x) + wab.y;
          const float av2 = wa0.z * bflo(pa.y) + wa1.z * bflo(ua.y) + wa2.z * bflo(na.y) + wab.z;
          const float av3 = wa0.w * bfhi(pa.y) + wa1.w * bfhi(ua.y) + wa2.w * bfhi(na.y) + wab.w;
          const float bv0 = wb0.x * bflo(pb_.x) + wb1.x * bflo(ub.x) + wb2.x * bflo(nb.x) + wbb.x;
          const float bv1 = wb0.y * bfhi(pb_.x) + wb1.y * bfhi(ub.x) + wb2.y * bfhi(nb.x) + wbb.y;
          const float bv2 = wb0.z * bflo(pb_.y) + wb1.z * bflo(ub.y) + wb2.z * bflo(nb.y) + wbb.z;
          const float bv3 = wb0.w * bfhi(pb_.y) + wb1.w * bfhi(ub.y) + wb2.w * bfhi(nb.y) + wbb.w;
          uint2 o; o.x = pack2(siluf_(av0) * bv0, siluf_(av1) * bv1); o.y = pack2(siluf_(av2) * bv2, siluf_(av3) * bv3);
          *(uint2*)(HID + (size_t)(rowbase + tok) * 2816 + ca) = o;
        }
      }
    }
  }
}

#ifndef REP_PREP
#define REP_PREP 1
#endif
#ifndef REP_GEMM
#define REP_GEMM 1
#endif
#ifndef REP_HY
#define REP_HY 1
#endif
#ifndef REP_RWP
#define REP_RWP 1
#endif
#ifndef REP_SCAN
#define REP_SCAN 1
#endif
#ifndef REP_ATTN
#define REP_ATTN 1
#endif
#ifndef PH_END
#define PH_END 24
#endif
#define XB_TMO      128
#define XB_XCNT(j)  (256  + 64 * (j))
#define XB_XSUB(j)  (1280 + 64 * (j))
#define XB_XGEN(j)  (2304 + 64 * (j))
#define XB_TOP      3328
#define XB_TOPGEN   3392
#define XCD_BAR_WORDS 3456
#define XB_SPIN_CAP (1u << 22)
DI unsigned xb_ld(unsigned* p) { return __hip_atomic_load(p, __ATOMIC_RELAXED, __HIP_MEMORY_SCOPE_AGENT); }
DI unsigned xb_add(unsigned* p, unsigned v) { return __hip_atomic_fetch_add(p, v, __ATOMIC_RELAXED, __HIP_MEMORY_SCOPE_AGENT); }
DI unsigned xb_xcc_id() { return (unsigned)__builtin_amdgcn_s_getreg((3 << 11) | 20) & 0xFu; }
#define XB_SPIN(cond, bar) do { unsigned _sp = 0; while (cond) { __builtin_amdgcn_s_sleep(1); \
    if ((++_sp & 255u) == 0u) { if (xb_ld(&(bar)[XB_TMO])) break; if (_sp > XB_SPIN_CAP) { atomicAdd(&(bar)[XB_TMO], 1u); break; } } } } while (0)
DI void xcd_barrier_complete(unsigned* bar, unsigned x, unsigned& nloc, unsigned& nx) {
  const unsigned G = gridDim.x;
  unsigned sum, cnt, mine, sp = 0u;
  for (;;) {
    sum = 0u; cnt = 0u; mine = 0u;
#pragma unroll
    for (unsigned j = 0; j < 16; ++j) { const unsigned c = xb_ld(&bar[XB_XCNT(j)]); sum += c; cnt += (c > 0u) ? 1u : 0u; mine = (j == x) ? c : mine; }
    if (sum == G) break;
    __builtin_amdgcn_s_sleep(1);
    if ((++sp & 255u) == 0u) { if (xb_ld(&bar[XB_TMO])) break; if (sp > XB_SPIN_CAP) { atomicAdd(&bar[XB_TMO], 1u); break; } }
  }
  nloc = mine > 0u ? mine : 1u; nx = cnt > 0u ? cnt : 1u;
}
DI void grid_barrier(unsigned* bar, volatile unsigned* st) {
  asm volatile("s_waitcnt vmcnt(0)" ::: "memory");
  __syncthreads();
  if (my_tid() == 0) {
    const unsigned x = xb_xcc_id();
    __builtin_amdgcn_s_waitcnt(0);
    unsigned nloc = st[0], nx = st[1];
    if (nloc == 0u) { xcd_barrier_complete(bar, x, nloc, nx); st[0] = nloc; st[1] = nx; }
    const unsigned old = xb_add(&bar[XB_XSUB(x)], 1u);
    const unsigned gen = old / nloc;
    if (old + 1u == (gen + 1u) * nloc) {
      __builtin_amdgcn_fence(__ATOMIC_RELEASE, "agent");
      asm volatile("s_waitcnt vmcnt(0)" ::: "memory");
      const unsigned og = xb_add(&bar[XB_TOP], 1u);
      const unsigned tg = og / nx;
      if (og + 1u == (tg + 1u) * nx) xb_add(&bar[XB_TOPGEN], 1u);
      else XB_SPIN(xb_ld(&bar[XB_TOPGEN]) == tg, bar);
      __builtin_amdgcn_fence(__ATOMIC_ACQUIRE, "agent");
      xb_add(&bar[XB_XGEN(x)], 1u);
      asm volatile("s_waitcnt vmcnt(0)" ::: "memory");
    } else {
      XB_SPIN(xb_ld(&bar[XB_XGEN(x)]) == gen, bar);
      __builtin_amdgcn_fence(__ATOMIC_ACQUIRE, "agent");
      asm volatile("s_waitcnt vmcnt(0)" ::: "memory");
    }
  }
  __syncthreads();
}
#define SYNC_OR_RET(idx) do { if ((idx) + 1 >= PH_END) return; if ((idx) == 0) { grid.sync(); if (my_tid() == 0) (void)xb_add(&((unsigned*)(p.ws + MISC_XBAR))[XB_XCNT(xb_xcc_id())], 1u); } else grid_barrier((unsigned*)(p.ws + MISC_XBAR), (volatile unsigned*)(smem + 144 * 1024)); } while (0)
template <int l>
DI void run_layer(const Params& p, cg::grid_group& grid, char* smem, unsigned& epoch) {
  const float* mod = (const float*)(p.ws + MISC_MOD) + (size_t)l * 9 * 6144;
  float* hc = (float*)(p.ws + OFF_HC);
  const float* hl_src = (l == 0) ? p.in[0] : p.out;
  const float* hc_src = (l == 0) ? p.in[2] : hc;
  constexpr int B0 = l * 12;
  if (l == 0) {
    ph_convert(p, 0, smem);
    ph_ada(p, smem);
    hy_rawfilter(p, 0, SL, (float*)(p.ws + R_RAWF), smem);
    hy_rawfilter(p, 0, CL, (float*)(p.ws + MISC_RAWC), smem);
    SYNC_OR_RET(B0 + 0);
    ph_kf(p, 0, smem);
    ph_ln(hl_src, hc_src, nullptr, nullptr, nullptr, nullptr, (bf16_t*)p.out, mod, 0, MT);
    SYNC_OR_RET(B0 + 1);
  }
  for (int rep = 0; rep < REP_GEMM; ++rep) ph_inproj(p, l == 0 ? (const bf16_t*)p.out : (const bf16_t*)(p.ws + R_U), smem);
  SYNC_OR_RET(B0 + 2);
  for (int rep = 0; rep < REP_HY; ++rep) {
  if (blockIdx.x == 0 && my_tid() == 0) *(unsigned*)(p.ws + MISC_BAR + 64 + 64 * l) = 0u;
  ph_hyena(p, l, smem);
  if (l == 0) ph_hyena_ctx(p, l, smem);
  }
  ph_rope(p, smem);
  for (int rep = 0; rep < REP_RWP; ++rep) ph_rwprep(p, l, smem);
  SYNC_OR_RET(B0 + 3);
  for (int rep = 0; rep < REP_SCAN; ++rep) ph_scan(p, smem);
  for (int rep = 0; rep < REP_ATTN; ++rep) ph_attn(p, l, smem);
  SYNC_OR_RET(B0 + 4);
  ph_rwout(p, l);
  if (l != 0) ph_ln(hl_src, hc_src, nullptr, nullptr, nullptr, nullptr, (bf16_t*)(p.ws + R_URE), mod, 0, ML);
  SYNC_OR_RET(B0 + 5);
  for (int rep = 0; rep < REP_GEMM; ++rep) ph_merge(p, l, l == 0 ? (const bf16_t*)p.out : (const bf16_t*)(p.ws + R_URE), smem);
  SYNC_OR_RET(B0 + 6);
  ph_resgemm(p, l, (const bf16_t*)(p.ws + R_ACC), 1024, (const bf16_t*)(p.ws + WB_OUT), hl_src, hc_src, 2048, smem);
  if (l == 0) hy_rawfilter(p, 1, SL, (float*)(p.ws + R_RAWF), smem);
  SYNC_OR_RET(B0 + 7);
  ph_ln(p.out, hc, p.out, hc, p.in[35] + (size_t)l * D, p.in[36] + (size_t)l * D, (bf16_t*)(p.ws + R_U), mod, 3072, l == 0 ? MT : ML);
  if (l == 0) ph_kf(p, 1, smem);
  SYNC_OR_RET(B0 + 8);
  for (int rep = 0; rep < REP_GEMM; ++rep) ph_ffnup(p, l, smem);
  SYNC_OR_RET(B0 + 9);
  ph_resgemm(p, l, (const bf16_t*)(p.ws + R_HID), 2816, (const bf16_t*)(p.ws + WB_DOWN), p.out, hc, 5120, smem);
  SYNC_OR_RET(B0 + 10);
  if (l == 0) {
    ph_ln(p.out, hc, p.out, hc, p.in[41], p.in[42], (bf16_t*)(p.ws + R_U), mod + 9 * 6144, 0, MT);
    ph_convert(p, 1, smem);
  } else {
    ph_ln(p.out, hc, p.out, hc, p.in[41] + (size_t)l * D, p.in[42] + (size_t)l * D, nullptr, mod, 0, ML);
  }
  SYNC_OR_RET(B0 + 11);
}

__global__ void __launch_bounds__(NTHR) mega(Params p) {
  extern __shared__ __attribute__((aligned(16))) char smem[];
  cg::grid_group grid = cg::this_grid();
  unsigned epoch = 0;
  if (blockIdx.x == 0) for (int i = my_tid(); i < XCD_BAR_WORDS; i += NTHR) ((unsigned*)(p.ws + MISC_XBAR))[i] = 0u;
  if (my_tid() < 2) ((volatile unsigned*)(smem + 144 * 1024))[my_tid()] = 0u;
  if (blockIdx.x == 0 && my_tid() < 64) *(unsigned*)(p.ws + MISC_ZERO + my_tid() * 4) = 0u;
  run_layer<0>(p, grid, smem, epoch);
  if (PH_END > 12) run_layer<1>(p, grid, smem, epoch);
}

extern "C" void kernel_launch(void* const* d_in, const int* in_sizes, int n_in, void* d_out, int out_size,
                              void* d_ws, size_t ws_size, hipStream_t stream) {
  static int grid_blocks = 0;
  if (!grid_blocks) {
    int dev = 0, cus = 0, per_cu = 0;
    (void)hipGetDevice(&dev);
    (void)hipDeviceGetAttribute(&cus, hipDeviceAttributeMultiprocessorCount, dev);
    (void)hipFuncSetAttribute((const void*)mega, hipFuncAttributeMaxDynamicSharedMemorySize, SMEM_BYTES);
    (void)hipOccupancyMaxActiveBlocksPerMultiprocessor(&per_cu, mega, NTHR, SMEM_BYTES);
    if (per_cu < 1) per_cu = 1;
    if (per_cu > 1) per_cu = 1;
    grid_blocks = cus * per_cu;
  }
  Params p{};
  for (int i = 0; i < 43; ++i) p.in[i] = (const float*)d_in[i];
  p.out = (float*)d_out; p.ws = (char*)d_ws;
  void* args[] = {&p};
  hipError_t e = hipLaunchCooperativeKernel((void*)mega, dim3(grid_blocks), dim3(NTHR), args, SMEM_BYTES, stream);
  if (e != hipSuccess) fprintf(stderr, "cooperative launch failed: %s (grid %d)\n", hipGetErrorString(e), grid_blocks);
}
```

```cpp
#include <hip/hip_runtime.h>
#include <hip/hip_cooperative_groups.h>
#include <cstdio>
#include <cstdint>
namespace cg = cooperative_groups;

#define DI __device__ __forceinline__
typedef unsigned short bf16_t;
typedef short bf16x8 __attribute__((ext_vector_type(8)));
typedef float f32x4 __attribute__((ext_vector_type(4)));

constexpr int D = 1024, NB = 8, SL = 4096, CL = 256;
constexpr int ML = NB * SL, MC = NB * CL, MT = ML + MC;
constexpr int KEYS = SL + CL;
constexpr int NTHR = 512;
constexpr float DN_ALPHA = 1.41421356237f;
constexpr size_t UNIT = (size_t)MT * 512;

constexpr size_t WB_IN = 0;
constexpr size_t WB_GATE = WB_IN + (size_t)3328 * 1024 * 2;
constexpr size_t WB_BR = WB_GATE + (size_t)4096 * 1024 * 2;
constexpr size_t WB_OUT = WB_BR + (size_t)4 * 1024 * 256 * 2;
constexpr size_t WB_UP = WB_OUT + (size_t)1024 * 1024 * 2;
constexpr size_t WB_DOWN = WB_UP + (size_t)5632 * 1024 * 2;
constexpr size_t WB_END = WB_DOWN + (size_t)1024 * 2816 * 2;
constexpr size_t OFF_KF = WB_END;
constexpr size_t OFF_HC = OFF_KF + (size_t)512 * 8192 * 8;
constexpr size_t OFF_MISC = OFF_HC + (size_t)MC * D * 4;
constexpr size_t MISC_MOD = OFF_MISC;
constexpr size_t MISC_TW = MISC_MOD + (size_t)2 * 9 * 6144 * 4;
constexpr size_t MISC_RAWC = MISC_TW + 4096 * 8;
constexpr size_t MISC_GCTX = MISC_RAWC + (size_t)256 * 1024 * 4;
constexpr size_t MISC_RWW = MISC_GCTX + (size_t)512 * 512 * 4;
constexpr size_t RWW_F = MISC_RWW, RWW_B = RWW_F + 256 * 64 * 2, RWW_A = RWW_B + 256 * 64 * 2, RWW_GF = RWW_A + 256 * 64 * 2, RWW_GB = RWW_GF + 256 * 128 * 2;
constexpr size_t MISC_XBAR = OFF_MISC + (size_t)3 * 1024 * 1024;
constexpr size_t OFF_R = OFF_MISC + (size_t)4 * 1024 * 1024;
constexpr size_t MISC_BAR = OFF_R - 256;
constexpr size_t MISC_ZERO = OFF_R - 512;
static_assert(RWW_GB + 256 * 128 * 2 <= MISC_ZERO, "misc overflow");
constexpr size_t R_YHY = OFF_R, R_YSW = OFF_R + UNIT, R_YDF = OFF_R + 2 * UNIT;
constexpr size_t R_PHY = OFF_R + 3 * UNIT;
constexpr size_t R_PSW = OFF_R + 6 * UNIT;
constexpr size_t R_VTSW = R_PSW + (size_t)MT * 384 * 2;
constexpr size_t R_PDF = OFF_R + 8 * UNIT;
constexpr size_t R_VTDF = OFF_R + 10 * UNIT;
constexpr size_t R_PRW = OFF_R + 11 * UNIT;
constexpr size_t R_STR = R_PRW + (size_t)MT * 1216 * 2;
constexpr size_t R_G = R_STR + 7 * UNIT;
constexpr size_t R_END = R_G + 2 * UNIT;
constexpr size_t R_RAWF = OFF_R;
constexpr size_t R_OF = R_PHY, R_OB = R_PHY + UNIT;
constexpr size_t R_URE = R_PSW;
constexpr size_t R_YRW = R_VTDF;
constexpr size_t R_ACC = R_PRW;
constexpr size_t R_U = R_STR;
constexpr size_t R_HID = OFF_R;
static_assert(R_END <= (size_t)512 * 1024 * 1024, "ws overflow");
static_assert((size_t)MT * 2816 * 2 <= 11 * UNIT, "hid");

constexpr int SMEM_BYTES = 144 * 1024 + 64;

struct Params {
  const float* in[43];
  float* out;
  char* ws;
};

DI int my_tid() { int t = (int)__builtin_amdgcn_workitem_id_x(); asm volatile("" : "+v"(t)); return t; }
DI unsigned f2bf(float f) { unsigned u = __float_as_uint(f); u += 0x7fffu + ((u >> 16) & 1u); return u >> 16; }
DI float bf2f(unsigned h) { return __uint_as_float(h << 16); }
typedef __bf16 bf16v2_t __attribute__((ext_vector_type(2)));
typedef float f32v2_t __attribute__((ext_vector_type(2)));
DI unsigned pack2(float lo, float hi) { f32v2_t v = {lo, hi}; bf16v2_t b = __builtin_convertvector(v, bf16v2_t); return __builtin_bit_cast(unsigned, b); }

DI float bflo(unsigned w) { return __uint_as_float(w << 16); }
DI float bfhi(unsigned w) { return __uint_as_float(w & 0xffff0000u); }
DI float sigmoidf_(float x) { return __builtin_amdgcn_rcpf(1.f + __expf(-x)); }
DI float siluf_(float x) { return x * __builtin_amdgcn_rcpf(1.f + __expf(-x)); }
DI float wave_sum(float v) {
#pragma unroll
  for (int o = 32; o >= 1; o >>= 1) v += __shfl_xor(v, o);
  return v;
}
template <int CTRL> DI float dpp_mov(float v) {
  return __int_as_float(__builtin_amdgcn_update_dpp(0, __float_as_int(v), CTRL, 0xf, 0xf, false));
}
DI float sum16(float v) {
  v += dpp_mov<0xB1>(v);
  v += dpp_mov<0x4E>(v);
  v += dpp_mov<0x141>(v);
  v += dpp_mov<0x140>(v);
  return v;
}
DI void lds_barrier() { asm volatile("s_waitcnt lgkmcnt(0)" ::: "memory"); __builtin_amdgcn_s_barrier(); asm volatile("" ::: "memory"); }
DI uint4 sel4(bool z, uint4 v) { return make_uint4(z ? 0u : v.x, z ? 0u : v.y, z ? 0u : v.z, z ? 0u : v.w); }
DI int mod_idx(int row) { return row < ML ? (row >> 12) : 8; }

template <int NTW, bool DEEP, class RowFn>
DI void gemm_main(f32x4 (&acc)[4][NTW], const bf16_t* __restrict__ A, int lda, RowFn rowfn,
                  const bf16_t* __restrict__ Bt, int ldb, int K, char* smem) {
  constexpr int BN = NTW * 32;
  constexpr int A_BYTES = 256 * 128, B_BYTES = BN * 128, STAGE = A_BYTES + B_BYTES;
  constexpr int NBL = BN / 64;
  const int tid = my_tid(), lane = tid & 63, wid = tid >> 6, wm = wid >> 1, wn = wid & 1, g = lane >> 4, r16 = lane & 15;
  const int chunk = tid & 7, lrow = tid >> 3;
  long a0 = rowfn(lrow), a1 = rowfn(lrow + 64), a2 = rowfn(lrow + 128), a3 = rowfn(lrow + 192);
  const long c0 = a0 < 0 ? 0 : a0, c1 = a1 < 0 ? 0 : a1, c2 = a2 < 0 ? 0 : a2, c3 = a3 < 0 ? 0 : a3;
  const bf16_t* Bp = Bt + (long)lrow * ldb + chunk * 8;
  const bf16_t* Ap0 = A + c0 * lda + chunk * 8; const bf16_t* Ap1 = A + c1 * lda + chunk * 8;
  const bf16_t* Ap2 = A + c2 * lda + chunk * 8; const bf16_t* Ap3 = A + c3 * lda + chunk * 8;
  struct Regs { uint4 a0, a1, a2, a3, b0, b1; };
  Regs R0, R1;
  R0.b1 = make_uint4(0, 0, 0, 0); R1.b1 = make_uint4(0, 0, 0, 0);
  auto GLOAD = [&](Regs& R, int k0) {
    R.a0 = *(const uint4*)(Ap0 + k0); R.a1 = *(const uint4*)(Ap1 + k0);
    R.a2 = *(const uint4*)(Ap2 + k0); R.a3 = *(const uint4*)(Ap3 + k0);
    R.b0 = *(const uint4*)(Bp + k0);
    if constexpr (NBL > 1) R.b1 = *(const uint4*)(Bp + (long)64 * ldb + k0);
  };
  auto SSTORE = [&](const Regs& R, int st) {
    char* base = smem + st * STAGE + lrow * 128 + ((chunk ^ (lrow & 7)) << 4);
    *(uint4*)(base) = sel4(a0 < 0, R.a0); *(uint4*)(base + 64 * 128) = sel4(a1 < 0, R.a1);
    *(uint4*)(base + 128 * 128) = sel4(a2 < 0, R.a2); *(uint4*)(base + 192 * 128) = sel4(a3 < 0, R.a3);
    *(uint4*)(base + A_BYTES) = R.b0;
    if constexpr (NBL > 1) *(uint4*)(base + A_BYTES + 64 * 128) = R.b1;
  };
  auto COMPUTE = [&](int st) {
    const char* As = smem + st * STAGE + (wm * 64 + r16) * 128;
    const char* Bs = smem + st * STAGE + A_BYTES + (wn * (NTW * 16) + r16) * 128;
#pragma unroll
    for (int kk = 0; kk < 2; ++kk) {
      const int sw = ((kk * 4 + g) ^ (r16 & 7)) << 4;
      bf16x8 af[4], bfr[NTW];
#pragma unroll
      for (int mt = 0; mt < 4; ++mt) af[mt] = *(const bf16x8*)(As + mt * 16 * 128 + sw);
#pragma unroll
      for (int nt = 0; nt < NTW; ++nt) bfr[nt] = *(const bf16x8*)(Bs + nt * 16 * 128 + sw);
#pragma unroll
      for (int mt = 0; mt < 4; ++mt)
#pragma unroll
        for (int nt = 0; nt < NTW; ++nt)
          acc[mt][nt] = __builtin_amdgcn_mfma_f32_16x16x32_bf16(af[mt], bfr[nt], acc[mt][nt], 0, 0, 0);
    }
  };
  const int nk = K >> 6;
  __syncthreads();
  GLOAD(R0, 0);
  SSTORE(R0, 0);
  if constexpr (DEEP) {
    GLOAD(R0, 64);
    if (nk > 2) GLOAD(R1, 128);
    lds_barrier();
    bf16x8 fa0[4], fb0[NTW], fa1[4], fb1[NTW];
    auto READF = [&](bf16x8 (&fa)[4], bf16x8 (&fb)[NTW], int st, int kk) {
      const int sw = ((kk * 4 + g) ^ (r16 & 7)) << 4;
      const char* As = smem + st * STAGE + (wm * 64 + r16) * 128 + sw;
      const char* Bs = smem + st * STAGE + A_BYTES + (wn * (NTW * 16) + r16) * 128 + sw;
#pragma unroll
      for (int mt = 0; mt < 4; ++mt) fa[mt] = *(const bf16x8*)(As + mt * 16 * 128);
#pragma unroll
      for (int nt = 0; nt < NTW; ++nt) fb[nt] = *(const bf16x8*)(Bs + nt * 16 * 128);
    };
    auto MMA = [&](const bf16x8 (&fa)[4], const bf16x8 (&fb)[NTW]) {
#pragma unroll
      for (int mt = 0; mt < 4; ++mt)
#pragma unroll
        for (int nt = 0; nt < NTW; ++nt)
          acc[mt][nt] = __builtin_amdgcn_mfma_f32_16x16x32_bf16(fa[mt], fb[nt], acc[mt][nt], 0, 0, 0);
    };
    READF(fa0, fb0, 0, 0);
    for (int kt = 0; kt < nk; kt += 2) {
      READF(fa1, fb1, 0, 1);
      MMA(fa0, fb0);
#pragma unroll
      for (int i = 0; i < 4 + NTW; ++i) { __builtin_amdgcn_sched_group_barrier(0x100, 1, 0); __builtin_amdgcn_sched_group_barrier(0x008, 2, 0); }
      __builtin_amdgcn_sched_barrier(0);
      SSTORE(R0, 1);
      if (kt + 3 < nk) GLOAD(R0, (kt + 3) * 64);
      MMA(fa1, fb1);
#pragma unroll
      for (int i = 0; i < 6; ++i) { __builtin_amdgcn_sched_group_barrier(0x200, 1, 0); __builtin_amdgcn_sched_group_barrier(0x020, 1, 0); __builtin_amdgcn_sched_group_barrier(0x008, 2, 0); }
      __builtin_amdgcn_sched_barrier(0);
      lds_barrier();
      READF(fa0, fb0, 1, 0);
      READF(fa1, fb1, 1, 1);
      MMA(fa0, fb0);
#pragma unroll
      for (int i = 0; i < 4 + NTW; ++i) { __builtin_amdgcn_sched_group_barrier(0x100, 1, 0); __builtin_amdgcn_sched_group_barrier(0x008, 2, 0); }
      __builtin_amdgcn_sched_barrier(0);
      if (kt + 2 < nk) SSTORE(R1, 0);
      if (kt + 4 < nk) GLOAD(R1, (kt + 4) * 64);
      MMA(fa1, fb1);
#pragma unroll
      for (int i = 0; i < 6; ++i) { __builtin_amdgcn_sched_group_barrier(0x200, 1, 0); __builtin_amdgcn_sched_group_barrier(0x020, 1, 0); __builtin_amdgcn_sched_group_barrier(0x008, 2, 0); }
      __builtin_amdgcn_sched_barrier(0);
      lds_barrier();
      if (kt + 2 < nk) READF(fa0, fb0, 0, 0);
    }
  } else {
    lds_barrier();
    for (int kt = 0; kt < nk; ++kt) {
      const int st = kt & 1;
      if (kt + 1 < nk) GLOAD(R0, (kt + 1) * 64);
      __builtin_amdgcn_sched_barrier(0);
      COMPUTE(st);
      __builtin_amdgcn_sched_barrier(0);
      if (kt + 1 < nk) SSTORE(R0, st ^ 1);
      lds_barrier();
    }
  }
}

#define GLDS16(gp, lp) __builtin_amdgcn_global_load_lds((const unsigned*)(gp), (unsigned*)(lp), 16, 0, 0)
template <class RowFn>
DI void gemm_glds(f32x4 (&acc)[4][4], const bf16_t* __restrict__ A, int lda, RowFn rowfn,
                  const bf16_t* __restrict__ Bt, int ldb, int K, char* smem, const bf16_t* zrow) {
  constexpr int A_BYTES = 256 * 128, STAGE = A_BYTES + 128 * 128;
  const int tid = my_tid(), lane = tid & 63, wid = tid >> 6, wm = wid >> 1, wn = wid & 1, g = lane >> 4, r16 = lane & 15;
  const int lrow = tid >> 3, c = (tid & 7) ^ (lrow & 7);
  const long a0 = rowfn(lrow), a1 = rowfn(lrow + 64), a2 = rowfn(lrow + 128), a3 = rowfn(lrow + 192);
  const bf16_t* pa0 = (a0 >= 0 ? A + a0 * lda : zrow) + c * 8; const int m0 = a0 >= 0 ? 1 : 0;
  const bf16_t* pa1 = (a1 >= 0 ? A + a1 * lda : zrow) + c * 8; const int m1 = a1 >= 0 ? 1 : 0;
  const bf16_t* pa2 = (a2 >= 0 ? A + a2 * lda : zrow) + c * 8; const int m2 = a2 >= 0 ? 1 : 0;
  const bf16_t* pa3 = (a3 >= 0 ? A + a3 * lda : zrow) + c * 8; const int m3 = a3 >= 0 ? 1 : 0;
  const bf16_t* pb0 = Bt + (long)lrow * ldb + c * 8; const bf16_t* pb1 = pb0 + (long)64 * ldb;
  auto ISSUE = [&](int kt, int bi) {
    char* d = smem + bi * STAGE + tid * 16;
    const int k0 = kt * 64;
    GLDS16(pa0 + k0 * m0, d); GLDS16(pa1 + k0 * m1, d + 8192); GLDS16(pa2 + k0 * m2, d + 16384); GLDS16(pa3 + k0 * m3, d + 24576);
    GLDS16(pb0 + k0, d + A_BYTES); GLDS16(pb1 + k0, d + A_BYTES + 8192);
  };
  auto COMPUTE = [&](int bi) {
    const char* As = smem + bi * STAGE + (wm * 64 + r16) * 128;
    const char* Bs = smem + bi * STAGE + A_BYTES + (wn * 64 + r16) * 128;
#pragma unroll
    for (int kk = 0; kk < 2; ++kk) {
      const int sw = ((kk * 4 + g) ^ (r16 & 7)) << 4;
      bf16x8 af[4], bfr[4];
#pragma unroll
      for (int mt = 0; mt < 4; ++mt) af[mt] = *(const bf16x8*)(As + mt * 16 * 128 + sw);
#pragma unroll
      for (int nt = 0; nt < 4; ++nt) bfr[nt] = *(const bf16x8*)(Bs + nt * 16 * 128 + sw);
      __builtin_amdgcn_s_setprio(1);
#pragma unroll
      for (int mt = 0; mt < 4; ++mt)
#pragma unroll
        for (int nt = 0; nt < 4; ++nt)
          acc[mt][nt] = __builtin_amdgcn_mfma_f32_16x16x32_bf16(af[mt], bfr[nt], acc[mt][nt], 0, 0, 0);
      __builtin_amdgcn_s_setprio(0);
    }
  };
  const int nk = K >> 6;
  __syncthreads();
  ISSUE(0, 0);
  ISSUE(1, 1);
  asm volatile("s_waitcnt vmcnt(6)" ::: "memory");
  __builtin_amdgcn_s_barrier();
  asm volatile("" ::: "memory");
  int bi = 0;
  for (int kt = 0; kt < nk; ++kt) {
    const int b2 = bi >= 1 ? bi - 1 : 2;
    if (kt + 2 < nk) ISSUE(kt + 2, b2);
    COMPUTE(bi);
    if (kt + 2 < nk) asm volatile("s_waitcnt vmcnt(6)" ::: "memory");
    else asm volatile("s_waitcnt vmcnt(0)" ::: "memory");
    asm volatile("s_waitcnt lgkmcnt(0)" ::: "memory");
    __builtin_amdgcn_s_barrier();
    asm volatile("" ::: "memory");
    bi = bi == 2 ? 0 : bi + 1;
  }
}

DI void gemm_glds256(f32x4 (&acc)[8][4], const bf16_t* __restrict__ A, int lda, long arow0,
                     const bf16_t* __restrict__ Bt, int ldb, int K, char* smem) {
  constexpr int A_BYTES = 256 * 128, STAGE = 2 * A_BYTES;
  const int tid = my_tid(), lane = tid & 63, wid = tid >> 6, wm = wid >> 2, wn = wid & 3, g = lane >> 4, r16 = lane & 15;
  const int lrow = tid >> 3, c = (tid & 7) ^ (lrow & 7);
  const bf16_t* pa = A + (arow0 + lrow) * (long)lda + c * 8;
  const bf16_t* pb = Bt + (long)lrow * ldb + c * 8;
  const long a64 = (long)64 * lda, b64 = (long)64 * ldb;
  auto ISSUE = [&](int kt, int bi) {
    char* d = smem + bi * STAGE + tid * 16;
    const int k0 = kt * 64;
    GLDS16(pa + k0, d); GLDS16(pa + a64 + k0, d + 8192); GLDS16(pa + 2 * a64 + k0, d + 16384); GLDS16(pa + 3 * a64 + k0, d + 24576);
    GLDS16(pb + k0, d + A_BYTES); GLDS16(pb + b64 + k0, d + A_BYTES + 8192); GLDS16(pb + 2 * b64 + k0, d + A_BYTES + 16384); GLDS16(pb + 3 * b64 + k0, d + A_BYTES + 24576);
  };
  auto COMPUTE = [&](int bi) {
    const char* As = smem + bi * STAGE + (wm * 128 + r16) * 128;
    const char* Bs = smem + bi * STAGE + A_BYTES + (wn * 64 + r16) * 128;
#pragma unroll
    for (int kk = 0; kk < 2; ++kk) {
      const int sw = ((kk * 4 + g) ^ (r16 & 7)) << 4;
      bf16x8 bfr[4];
#pragma unroll
      for (int nt = 0; nt < 4; ++nt) bfr[nt] = *(const bf16x8*)(Bs + nt * 16 * 128 + sw);
      __builtin_amdgcn_s_setprio(1);
#pragma unroll
      for (int mt = 0; mt < 8; ++mt) {
        const bf16x8 af = *(const bf16x8*)(As + mt * 16 * 128 + sw);
#pragma unroll
        for (int nt = 0; nt < 4; ++nt)
          acc[mt][nt] = __builtin_amdgcn_mfma_f32_16x16x32_bf16(af, bfr[nt], acc[mt][nt], 0, 0, 0);
      }
      __builtin_amdgcn_s_setprio(0);
    }
  };
  const int nk = K >> 6;
  __syncthreads();
  ISSUE(0, 0);
  asm volatile("s_waitcnt vmcnt(0)" ::: "memory");
  __builtin_amdgcn_s_barrier();
  asm volatile("" ::: "memory");
  int bi = 0;
  for (int kt = 0; kt < nk; ++kt) {
    if (kt + 1 < nk) ISSUE(kt + 1, bi ^ 1);
    COMPUTE(bi);
    asm volatile("s_waitcnt vmcnt(0)" ::: "memory");
    asm volatile("s_waitcnt lgkmcnt(0)" ::: "memory");
    __builtin_amdgcn_s_barrier();
    asm volatile("" ::: "memory");
    bi ^= 1;
  }
}
DI void zero_acc256(f32x4 (&acc)[8][4]) {
#pragma unroll
  for (int i = 0; i < 8; ++i)
#pragma unroll
    for (int j = 0; j < 4; ++j) acc[i][j] = (f32x4){0.f, 0.f, 0.f, 0.f};
}

DI bool next_tile(int i, int MTILES, int NTILES, int& mt, int& nt) {
  const int xcd = blockIdx.x & 7, slot = blockIdx.x >> 3, nslot = gridDim.x >> 3;
  const int m_lo = (MTILES * xcd) >> 3, m_hi = (MTILES * (xcd + 1)) >> 3, Mloc = m_hi - m_lo;
  const int q = i * nslot + slot;
  if (q >= Mloc * NTILES) return false;
  const int gidx = q / (4 * NTILES), m0 = gidx * 4;
  const int rows = (Mloc - m0) < 4 ? (Mloc - m0) : 4;
  const int within = q - gidx * 4 * NTILES;
  nt = within / rows; mt = m_lo + m0 + within % rows;
  return true;
}

struct RowPlain { long base; DI long operator()(int r) const { return base + r; } };
struct RowHalo { long rowbase; int t0; int len; DI long operator()(int r) const { int t = t0 + r; return (t >= 0 && t < len) ? rowbase + t : -1; } };

template <int NTW> DI void zero_acc(f32x4 (&acc)[4][NTW]) {
#pragma unroll
  for (int i = 0; i < 4; ++i)
#pragma unroll
    for (int j = 0; j < NTW; ++j) acc[i][j] = (f32x4){0.f, 0.f, 0.f, 0.f};
}

DI void cvt_unit(const float* __restrict__ src, int ldsrc, int srccol0, int k0, bf16_t* __restrict__ dst, int K, int n0, char* smem, bool perm = true) {
  float* T = (float*)smem;
  const int tid = my_tid();
  __syncthreads();
  if (srccol0 >= 0) {
#pragma unroll
    for (int i = 0; i < 8; ++i) {
      int idx = tid + i * 512; int k = idx >> 6, n = idx & 63;
      T[k * 65 + n] = src[(long)(k0 + k) * ldsrc + srccol0 + n];
    }
  }
  __syncthreads();
  int nd = tid >> 3, kc = (tid & 7) * 8; int n = perm ? ((nd & 15) * 4 + (nd >> 4)) : nd;
  uint4 o = make_uint4(0, 0, 0, 0);
  if (srccol0 >= 0) {
    o.x = pack2(T[(kc + 0) * 65 + n], T[(kc + 1) * 65 + n]);
    o.y = pack2(T[(kc + 2) * 65 + n], T[(kc + 3) * 65 + n]);
    o.z = pack2(T[(kc + 4) * 65 + n], T[(kc + 5) * 65 + n]);
    o.w = pack2(T[(kc + 6) * 65 + n], T[(kc + 7) * 65 + n]);
  }
  *(uint4*)(dst + (long)(n0 + nd) * K + k0 + kc) = o;
}

DI void ph_convert(const Params& p, int l, char* smem) {
  for (int u = blockIdx.x; u < 4508; u += gridDim.x) {
    if (u < 832) {
      int gI = u >> 4, kt = u & 15; int n0 = gI * 64; int sc;
      if (n0 < 1280) sc = n0; else if (n0 < 2048) sc = 2496 + (n0 - 1280); else if (n0 < 3264) sc = 1280 + (n0 - 2048); else sc = -1;
      cvt_unit(p.in[6] + (size_t)l * 1024 * 7360, 7360, sc, kt * 64, (bf16_t*)(p.ws + WB_IN), 1024, n0, smem);
    } else if (u < 1856) {
      int v = u - 832; int gI = v >> 4, kt = v & 15;
      cvt_unit(p.in[6] + (size_t)l * 1024 * 7360, 7360, 3264 + gI * 64, kt * 64, (bf16_t*)(p.ws + WB_GATE), 1024, gI * 64, smem);
    } else if (u < 2112) {
      int v = u - 1856; int gI = v >> 2, kt = v & 3; int j = gI >> 4, gg = gI & 15;
      cvt_unit(p.in[33] + ((size_t)l * 4 + j) * 256 * 1024, 1024, gg * 64, kt * 64, (bf16_t*)(p.ws + WB_BR) + (size_t)j * 1024 * 256, 256, gg * 64, smem);
    } else if (u < 2368) {
      int v = u - 2112; int gI = v >> 4, kt = v & 15;
      cvt_unit(p.in[34] + (size_t)l * 1024 * 1024, 1024, gI * 64, kt * 64, (bf16_t*)(p.ws + WB_OUT), 1024, gI * 64, smem);
    } else if (u < 3776) {
      int v = u - 2368; int gI = v >> 4, kt = v & 15; int nt = gI >> 2, q = gI & 3;
      cvt_unit(p.in[37] + (size_t)l * 1024 * 5632, 5632, (q >> 1) * 2816 + nt * 128 + (q & 1) * 64, kt * 64, (bf16_t*)(p.ws + WB_UP), 1024, gI * 64, smem);
    } else if (u < 4480) {
      int v = u - 3776; int gI = v / 44, kt = v % 44;
      cvt_unit(p.in[40] + (size_t)l * 2816 * 1024, 1024, gI * 64, kt * 64, (bf16_t*)(p.ws + WB_DOWN), 2816, gI * 64, smem);
    } else {
      int v = u - 4480;
      if (v < 4) cvt_unit(p.in[19] + (size_t)l * 2 * 64 * 256, 256, v * 64, 0, (bf16_t*)(p.ws + RWW_F), 64, v * 64, smem);
      else if (v < 8) cvt_unit(p.in[19] + (size_t)l * 2 * 64 * 256 + 64 * 256, 256, (v - 4) * 64, 0, (bf16_t*)(p.ws + RWW_B), 64, (v - 4) * 64, smem);
      else if (v < 12) cvt_unit(p.in[21] + (size_t)l * 64 * 256, 256, (v - 8) * 64, 0, (bf16_t*)(p.ws + RWW_A), 64, (v - 8) * 64, smem);
      else if (v < 20) { int w = v - 12; cvt_unit(p.in[22] + (size_t)l * 2 * 128 * 256, 256, (w >> 1) * 64, (w & 1) * 64, (bf16_t*)(p.ws + RWW_GF), 128, (w >> 1) * 64, smem); }
      else { int w = v - 20; cvt_unit(p.in[22] + (size_t)l * 2 * 128 * 256 + 128 * 256, 256, (w >> 1) * 64, (w & 1) * 64, (bf16_t*)(p.ws + RWW_GB), 128, (w >> 1) * 64, smem); }
    }
  }
}

DI void ph_ada(const Params& p, char* smem) {
  float* S = (float*)smem;
  float* R = S + 9 * 1024;
  const int tid = my_tid();
  bool loaded = false;
  for (int u = blockIdx.x; u < 192; u += gridDim.x) {
    if (!loaded) {
      __syncthreads();
      for (int i = tid; i < 9 * 1024; i += NTHR) { float c = i < 8192 ? p.in[1][i] : p.in[3][i - 8192]; S[i] = siluf_(c); }
      loaded = true;
    }
    __syncthreads();
    int l = u / 96, n0 = (u % 96) * 64;
    int col = tid & 63, ks = tid >> 6;
    const float* W = p.in[4] + (size_t)l * 1024 * 6144 + n0 + col;
    float a[9];
#pragma unroll
    for (int b = 0; b < 9; ++b) a[b] = 0.f;
    for (int k = ks * 128; k < ks * 128 + 128; ++k) {
      float w = W[(size_t)k * 6144];
#pragma unroll
      for (int b = 0; b < 9; ++b) a[b] += S[b * 1024 + k] * w;
    }
#pragma unroll
    for (int b = 0; b < 9; ++b) R[(ks * 9 + b) * 64 + col] = a[b];
    __syncthreads();
    for (int i = tid; i < 9 * 64; i += NTHR) {
      int b = i >> 6, c = i & 63; float s = 0.f;
#pragma unroll
      for (int k2 = 0; k2 < 8; ++k2) s += R[(k2 * 9 + b) * 64 + c];
      s += p.in[5][(size_t)l * 6144 + n0 + c];
      ((float*)(p.ws + MISC_MOD))[((size_t)l * 9 + b) * 6144 + n0 + c] = s;
    }
  }
  for (int i = blockIdx.x * NTHR + tid; i < 4096; i += gridDim.x * NTHR) {
    float s, c; sincospif(-(float)i / 4096.f, &s, &c);
    ((float2*)(p.ws + MISC_TW))[i] = make_float2(c, s);
  }
}

DI void hy_rawfilter(const Params& p, int l, int Lf, float* __restrict__ dst, char* smem) {
  float* W1 = (float*)smem;
  float* W2 = W1 + 33 * 64;
  float* Z = W2 + 64 * 64;
  float* H1 = Z + 16 * 36;
  float* H2 = H1 + 16 * 64;
  const int tid = my_tid();
  const float* w1 = p.in[9] + (size_t)l * 33 * 64; const float* b1 = p.in[10] + l * 64;
  const float* w2 = p.in[11] + (size_t)l * 64 * 64; const float* b2 = p.in[12] + l * 64;
  const float* w3 = p.in[13] + (size_t)l * 64 * 1024; const float* fr = p.in[14] + l * 64;
  const int nunits = Lf / 16;
  bool loaded = false;
  for (int u = blockIdx.x; u < nunits; u += gridDim.x) {
    __syncthreads();
    if (!loaded) {
      for (int i = tid; i < 33 * 64; i += NTHR) W1[i] = w1[i];
      for (int i = tid; i < 64 * 64; i += NTHR) W2[i] = w2[i];
      loaded = true;
    }
    const int t0 = u * 16;
    for (int i = tid; i < 16 * 33; i += NTHR) {
      int tt = i / 33, f = i % 33; int t = t0 + tt; float v;
      if (f == 0) v = (float)t / (float)(Lf - 1);
      else {
        int bi = (f - 1) & 15;
        float wv = 6.283185307179586f * (float)t / (float)Lf;
        float fb = 1e-4f + (15.f - 1e-4f) * (float)bi / 15.f;
        float ang = wv * fb;
        v = (f <= 16) ? cosf(ang) : -sinf(ang);
      }
      Z[tt * 36 + f] = v;
    }
    __syncthreads();
    for (int i = tid; i < 16 * 64; i += NTHR) {
      int tt = i >> 6, f = i & 63; float s = b1[f];
      for (int k = 0; k < 33; ++k) s += Z[tt * 36 + k] * W1[k * 64 + f];
      H1[tt * 64 + f] = sinf(fr[f] * s);
    }
    __syncthreads();
    for (int i = tid; i < 16 * 64; i += NTHR) {
      int tt = i >> 6, f = i & 63; float s = b2[f];
      for (int k = 0; k < 64; ++k) s += H1[tt * 64 + k] * W2[k * 64 + f];
      H2[tt * 64 + f] = sinf(fr[f] * s);
    }
    __syncthreads();
    float a0[16], a1[16];
#pragma unroll
    for (int i = 0; i < 16; ++i) { a0[i] = 0.f; a1[i] = 0.f; }
    for (int k = 0; k < 64; ++k) {
      float wa = w3[k * 1024 + tid], wb = w3[k * 1024 + 512 + tid];
#pragma unroll
      for (int i = 0; i < 16; ++i) { float h = H2[i * 64 + k]; a0[i] += h * wa; a1[i] += h * wb; }
    }
    {
      int w = tid & 255;
      float delta = fabsf(-3.0701134573253944f + (-15.350567286626972f + 3.0701134573253944f) * (float)w / 255.f);
#pragma unroll
      for (int i = 0; i < 16; ++i) {
        float tn = (float)(t0 + i) / (float)(Lf - 1);
        float dec = expf(-tn * delta);
        dst[(size_t)(t0 + i) * 1024 + tid] = a0[i] * dec;
        dst[(size_t)(t0 + i) * 1024 + 512 + tid] = a1[i] * dec;
      }
    }
  }
}

DI float2 cmul(float2 a, float2 b) { return make_float2(a.x * b.x - a.y * b.y, a.x * b.y + a.y * b.x); }
DI float2 cmulc(float2 a, float2 b) { return make_float2(a.x * b.x + a.y * b.y, a.y * b.x - a.x * b.y); }
DI float2 cadd(float2 a, float2 b) { return make_float2(a.x + b.x, a.y + b.y); }
DI float2 csub(float2 a, float2 b) { return make_float2(a.x - b.x, a.y - b.y); }
DI void fft_dif(float2* X, const float2* W) {
  const int tid = my_tid();
  for (int ls = 12; ls >= 2; ls -= 2) {
    const int s = 1 << ls, h = s >> 1;
    __syncthreads();
#pragma unroll
    for (int i = 0; i < 4; ++i) {
      const int bf = tid + i * 512; const int j = bf & (h - 1); const int base = ((bf >> (ls - 1)) << (ls + 1)) + j;
      const float2 x0 = X[base], x1 = X[base + h], x2 = X[base + s], x3 = X[base + s + h];
      const float2 w1 = W[s - 1 + j], w2 = W[h - 1 + j];
      const float2 y0 = cadd(x0, x2), y2 = cmul(csub(x0, x2), w1), y1 = cadd(x1, x3);
      const float2 t = cmul(csub(x1, x3), w1); const float2 y3 = make_float2(t.y, -t.x);
      X[base] = cadd(y0, y1); X[base + h] = cmul(csub(y0, y1), w2);
      X[base + s] = cadd(y2, y3); X[base + s + h] = cmul(csub(y2, y3), w2);
    }
  }
  __syncthreads();
#pragma unroll
  for (int i = 0; i < 4; ++i) {
    const int q = tid + i * 512;
    float4 a = *(float4*)(X + 4 * q), b = *(float4*)(X + 4 * q + 2);
    *(float4*)(X + 4 * q) = make_float4(a.x + a.z, a.y + a.w, a.x - a.z, a.y - a.w);
    *(float4*)(X + 4 * q + 2) = make_float4(b.x + b.z, b.y + b.w, b.x - b.z, b.y - b.w);
  }
  __syncthreads();
}
DI void fft_dit_inv(float2* X, const float2* W) {
  const int tid = my_tid();
  __syncthreads();
#pragma unroll
  for (int i = 0; i < 4; ++i) {
    const int q = tid + i * 512;
    float4 a = *(float4*)(X + 4 * q), b = *(float4*)(X + 4 * q + 2);
    *(float4*)(X + 4 * q) = make_float4(a.x + a.z, a.y + a.w, a.x - a.z, a.y - a.w);
    *(float4*)(X + 4 * q + 2) = make_float4(b.x + b.z, b.y + b.w, b.x - b.z, b.y - b.w);
  }
  for (int ls = 2; ls <= 12; ls += 2) {
    const int s = 1 << ls, h = s >> 1;
    __syncthreads();
#pragma unroll
    for (int i = 0; i < 4; ++i) {
      const int bf = tid + i * 512; const int j = bf & (h - 1); const int base = ((bf >> (ls - 1)) << (ls + 1)) + j;
      const float2 e0 = X[base], e1 = X[base + h], e2 = X[base + s], e3 = X[base + s + h];
      const float2 w1 = W[s - 1 + j], w2 = W[h - 1 + j];
      const float2 t1 = cmulc(e1, w2), t3 = cmulc(e3, w2);
      const float2 u0 = cadd(e0, t1), u1 = csub(e0, t1), u2 = cadd(e2, t3), u3 = csub(e2, t3);
      const float2 a2 = cmulc(u2, w1); const float2 q3 = cmulc(u3, w1); const float2 a3 = make_float2(-q3.y, q3.x);
      X[base] = cadd(u0, a2); X[base + s] = csub(u0, a2);
      X[base + h] = cadd(u1, a3); X[base + s + h] = csub(u1, a3);
    }
  }
  __syncthreads();
}
DI void load_twiddles(const Params& p, float2* W) {
  const float2* tw = (const float2*)(p.ws + MISC_TW);
  for (int i = my_tid(); i < 8191; i += NTHR) {
    const int ls = 31 - __clz(i + 1); const int pos = i + 1 - (1 << ls);
    W[i] = tw[pos << (12 - ls)];
  }
}

DI void ph_kf(const Params& p, int l, char* smem) {
  float2* X = (float2*)smem; float2* W = X + 8192; float* red = (float*)(W + 8192);
  const int tid = my_tid(), lane = tid & 63, wid = tid >> 6;
  const float* rawf = (const float*)(p.ws + R_RAWF);
  float2* kf = (float2*)(p.ws + OFF_KF);
  bool tw = false;
  for (int u = blockIdx.x; u < 256; u += gridDim.x) {
    if (!tw) { load_twiddles(p, W); tw = true; }
    const int o = u >> 7, c = (u & 127) * 2;
    float2 fw[8], bw[8]; float sa = 0.f, sb = 0.f;
#pragma unroll
    for (int i = 0; i < 8; ++i) {
      int t = tid + i * 512;
      fw[i] = *(const float2*)(rawf + (size_t)t * 1024 + o * 512 + c);
      bw[i] = *(const float2*)(rawf + (size_t)t * 1024 + o * 512 + 256 + c);
      sa += fabsf(fw[i].x) + fabsf(bw[i].x); sb += fabsf(fw[i].y) + fabsf(bw[i].y);
    }
    sa = wave_sum(sa); sb = wave_sum(sb);
    __syncthreads();
    if (lane == 0) { red[wid * 2] = sa; red[wid * 2 + 1] = sb; }
    __syncthreads();
    float ta = 0.f, tb = 0.f;
#pragma unroll
    for (int w = 0; w < 8; ++w) { ta += red[w * 2]; tb += red[w * 2 + 1]; }
    const float ia = 1.f / ta, ib = 1.f / tb;
#pragma unroll
    for (int i = 0; i < 8; ++i) {
      int t = tid + i * 512;
      X[t] = make_float2(fw[i].x * ia, fw[i].y * ib);
      if (t >= 1) X[8192 - t] = make_float2(bw[i].x * ia, bw[i].y * ib);
      else X[4096] = make_float2(0.f, 0.f);
    }
    fft_dif(X, W);
    float2* ka = kf + (size_t)(o * 256 + c) * 8192; float2* kb = ka + 8192;
#pragma unroll 4
    for (int i = 0; i < 16; ++i) {
      int pidx = tid + i * 512;
      int k = (int)(__brev((unsigned)pidx) >> 19);
      int k2 = (8192 - k) & 8191;
      int p2 = (int)(__brev((unsigned)k2) >> 19);
      float2 c1 = X[pidx], c2 = X[p2];
      float2 A = make_float2(0.5f * (c1.x + c2.x), 0.5f * (c1.y - c2.y));
      float2 Bv = make_float2(0.5f * (c1.y + c2.y), -0.5f * (c1.x - c2.x));
      ka[pidx] = A; kb[pidx] = Bv;
    }
    __syncthreads();
  }
  if (l == 0) {
    const float* rawc = (const float*)(p.ws + MISC_RAWC);
    float* G = (float*)(p.ws + MISC_GCTX);
    for (int u = blockIdx.x * 8 + wid; u < 512; u += gridDim.x * 8) {
      int o = u >> 8, c = u & 255; float f[4], b[4]; float s = 0.f;
#pragma unroll
      for (int i = 0; i < 4; ++i) {
        int t = lane + i * 64;
        f[i] = rawc[(size_t)t * 1024 + o * 512 + c]; b[i] = rawc[(size_t)t * 1024 + o * 512 + 256 + c];
        s += fabsf(f[i]) + fabsf(b[i]);
      }
      s = wave_sum(s); float inv = 1.f / s;
#pragma unroll
      for (int i = 0; i < 4; ++i) {
        int t = lane + i * 64;
        G[(size_t)u * 512 + 256 + t] = f[i] * inv;
        if (t >= 1) G[(size_t)u * 512 + 256 - t] = b[i] * inv;
      }
      if (lane == 0) G[(size_t)u * 512] = 0.f;
    }
  }
}

DI void ph_ln(const float* __restrict__ src_lat, const float* __restrict__ src_ctx, float* dst_lat, float* dst_ctx,
              const float* __restrict__ ag, const float* __restrict__ ab, bf16_t* U, const float* __restrict__ mod, int sh_off, int nrows) {
  const int lane = my_tid() & 63, wid = my_tid() >> 6;
  const int stride = gridDim.x * 8;
  float4 nv[4];
  {
    const int row = blockIdx.x * 8 + wid;
    if (row < nrows) {
      const float* src = row < ML ? src_lat + (size_t)row * D : src_ctx + (size_t)(row - ML) * D;
#pragma unroll
      for (int i = 0; i < 4; ++i) nv[i] = *(const float4*)(src + i * 256 + lane * 4);
    }
  }
  for (int row = blockIdx.x * 8 + wid; row < nrows; row += stride) {
    float4 v[4];
#pragma unroll
    for (int i = 0; i < 4; ++i) v[i] = nv[i];
    if (row + stride < nrows) {
      const int r2 = row + stride;
      const float* src2 = r2 < ML ? src_lat + (size_t)r2 * D : src_ctx + (size_t)(r2 - ML) * D;
#pragma unroll
      for (int i = 0; i < 4; ++i) nv[i] = *(const float4*)(src2 + i * 256 + lane * 4);
    }
    float s = 0.f;
#pragma unroll
    for (int i = 0; i < 4; ++i) s += v[i].x + v[i].y + v[i].z + v[i].w;
    float mu = wave_sum(s) * (1.f / 1024.f);
    float q = 0.f;
#pragma unroll
    for (int i = 0; i < 4; ++i) { v[i].x -= mu; v[i].y -= mu; v[i].z -= mu; v[i].w -= mu; q += v[i].x * v[i].x + v[i].y * v[i].y + v[i].z * v[i].z + v[i].w * v[i].w; }
    float rs = rsqrtf(wave_sum(q) * (1.f / 1024.f) + 1e-6f);
#pragma unroll
    for (int i = 0; i < 4; ++i) { v[i].x *= rs; v[i].y *= rs; v[i].z *= rs; v[i].w *= rs; }
    if (ag) {
      float* dst = row < ML ? dst_lat + (size_t)row * D : dst_ctx + (size_t)(row - ML) * D;
#pragma unroll
      for (int i = 0; i < 4; ++i) {
        float4 gg = *(const float4*)(ag + i * 256 + lane * 4), bb = *(const float4*)(ab + i * 256 + lane * 4);
        v[i].x = v[i].x * gg.x + bb.x; v[i].y = v[i].y * gg.y + bb.y; v[i].z = v[i].z * gg.z + bb.z; v[i].w = v[i].w * gg.w + bb.w;
        *(float4*)(dst + i * 256 + lane * 4) = v[i];
      }
      if (U) {
        s = 0.f;
#pragma unroll
        for (int i = 0; i < 4; ++i) s += v[i].x + v[i].y + v[i].z + v[i].w;
        mu = wave_sum(s) * (1.f / 1024.f); q = 0.f;
#pragma unroll
        for (int i = 0; i < 4; ++i) { v[i].x -= mu; v[i].y -= mu; v[i].z -= mu; v[i].w -= mu; q += v[i].x * v[i].x + v[i].y * v[i].y + v[i].z * v[i].z + v[i].w * v[i].w; }
        rs = rsqrtf(wave_sum(q) * (1.f / 1024.f) + 1e-6f);
#pragma unroll
        for (int i = 0; i < 4; ++i) { v[i].x *= rs; v[i].y *= rs; v[i].z *= rs; v[i].w *= rs; }
      }
    }
    if (U) {
      const float* m = mod + (size_t)mod_idx(row) * 6144 + sh_off;
#pragma unroll
      for (int i = 0; i < 4; ++i) {
        float4 sh = *(const float4*)(m + i * 256 + lane * 4), sc = *(const float4*)(m + 1024 + i * 256 + lane * 4);
        uint2 o; o.x = pack2(v[i].x * (1.f + sc.x) + sh.x, v[i].y * (1.f + sc.y) + sh.y);
        o.y = pack2(v[i].z * (1.f + sc.z) + sh.z, v[i].w * (1.f + sc.w) + sh.w);
        *(uint2*)(U + (size_t)row * D + i * 256 + lane * 4) = o;
      }
    }
  }
}

DI void ph_inproj(const Params& p, const bf16_t* U, char* smem) {
  const bf16_t* Bt = (const bf16_t*)(p.ws + WB_IN);
  const int lane = my_tid() & 63, wid = my_tid() >> 6, wm = wid >> 2, wn = wid & 3, g = lane >> 4, r16 = lane & 15;
  for (int it = 0;; ++it) {
    int mtile, ntile;
    if (!next_tile(it, 136, 13, mtile, ntile)) break;
    f32x4 acc[8][4]; zero_acc256(acc);
    gemm_glds256(acc, U, 1024, (long)mtile * 256, Bt + (size_t)ntile * 256 * 1024, 1024, 1024, smem);
    int b, key0;
    if (mtile < 128) { b = mtile >> 4; key0 = (mtile & 15) * 256; } else { b = mtile - 128; key0 = SL; }
    const int wc0 = ntile * 256 + wn * 64;
    bf16_t* tbase = nullptr; int tcols = 0, tcol0 = 0;
    if (wc0 < 768) { tbase = (bf16_t*)(p.ws + R_PHY); tcols = 768; tcol0 = wc0; }
    else if (wc0 >= 1152 && wc0 < 1280) { tbase = (bf16_t*)(p.ws + R_VTSW); tcols = 128; tcol0 = wc0 - 1152; }
    else if (wc0 >= 1792 && wc0 < 2048) { tbase = (bf16_t*)(p.ws + R_VTDF); tcols = 256; tcol0 = wc0 - 1792; }
    if (tbase) {
#pragma unroll
      for (int mt = 0; mt < 8; ++mt)
#pragma unroll
        for (int nt = 0; nt < 4; ++nt) {
          int col = tcol0 + r16 * 4 + nt;
          int key = key0 + wm * 128 + mt * 16 + g * 4;
          uint2 o; o.x = pack2(acc[mt][nt][0], acc[mt][nt][1]); o.y = pack2(acc[mt][nt][2], acc[mt][nt][3]);
          *(uint2*)(tbase + ((size_t)b * tcols + col) * KEYS + key) = o;
        }
    } else if (wc0 < 3264) {
      bf16_t* rb; int ld, c0;
      if (wc0 < 1152) { rb = (bf16_t*)(p.ws + R_PSW); ld = 384; c0 = wc0 - 768; }
      else if (wc0 < 1792) { rb = (bf16_t*)(p.ws + R_PDF); ld = 512; c0 = wc0 - 1280; }
      else { rb = (bf16_t*)(p.ws + R_PRW); ld = 1216; c0 = wc0 - 2048; }
      const int col = c0 + r16 * 4;
#pragma unroll
      for (int mt = 0; mt < 8; ++mt)
#pragma unroll
        for (int j = 0; j < 4; ++j) {
          size_t row = (size_t)mtile * 256 + wm * 128 + mt * 16 + g * 4 + j;
          uint2 o; o.x = pack2(acc[mt][0][j], acc[mt][1][j]); o.y = pack2(acc[mt][2][j], acc[mt][3][j]);
          *(uint2*)(rb + row * ld + col) = o;
        }
    }
  }
}

DI float hy_conv3(const bf16_t* __restrict__ P, int t, int len, float w0, float w1, float w2, float bias) {
  float a = t >= 1 ? bf2f(P[t - 1]) : 0.f, b = bf2f(P[t]), c = (t + 1 < len) ? bf2f(P[t + 1]) : 0.f;
  return w0 * a + w1 * b + w2 * c + bias;
}
DI void hy_conv8(const bf16_t* __restrict__ P, int tb, int len, float w0, float w1, float w2, float bias, float (&out)[8]) {
  const uint4 u = *(const uint4*)(P + tb);
  float x[10];
  x[0] = tb >= 1 ? bf2f(P[tb - 1]) : 0.f;
  x[1] = bflo(u.x); x[2] = bfhi(u.x); x[3] = bflo(u.y); x[4] = bfhi(u.y); x[5] = bflo(u.z); x[6] = bfhi(u.z); x[7] = bflo(u.w); x[8] = bfhi(u.w);
  x[9] = (tb + 8 < len) ? bf2f(P[tb + 8]) : 0.f;
#pragma unroll
  for (int i = 0; i < 8; ++i) out[i] = w0 * x[i] + w1 * x[i + 1] + w2 * x[i + 2] + bias;
}
DI void ph_hyena(const Params& p, int l, char* smem) {
  float2* X = (float2*)smem; float2* W = X + 8192;
  const int tid = my_tid();
  const int tb = tid * 8;
  const bf16_t* PT = (const bf16_t*)(p.ws + R_PHY);
  const float2* kf = (const float2*)(p.ws + OFF_KF);
  const float* cw = p.in[7] + (size_t)l * 3 * 768; const float* cb = p.in[8] + (size_t)l * 768;
  const float* hb = p.in[15] + (size_t)l * 512;
  bf16_t* Y = (bf16_t*)(p.ws + R_YHY);
  bool tw = false;
  for (int u = blockIdx.x; u < 1024; u += gridDim.x) {
    if (!tw) { load_twiddles(p, W); tw = true; }
    const int bp = u >> 8, c = u & 255; const int b0 = bp * 2, b1 = b0 + 1;
    const bf16_t* P0 = PT + ((size_t)b0 * 768) * KEYS; const bf16_t* P1 = PT + ((size_t)b1 * 768) * KEYS;
    const float bias0 = hb[c], bias1 = hb[256 + c];
    float va[8], vb[8];
    hy_conv8(P0 + (size_t)c * KEYS, tb, SL, cw[c], cw[768 + c], cw[1536 + c], cb[c], va);
    hy_conv8(P1 + (size_t)c * KEYS, tb, SL, cw[c], cw[768 + c], cw[1536 + c], cb[c], vb);
    __syncthreads();
#pragma unroll
    for (int i = 0; i < 8; ++i) { X[tb + i] = make_float2(va[i], vb[i]); X[tb + i + 4096] = make_float2(0.f, 0.f); }
    fft_dif(X, W);
    {
      const float2* H = kf + (size_t)c * 8192;
#pragma unroll 4
      for (int i = 0; i < 16; ++i) { int q = tid + i * 512; X[q] = cmul(X[q], H[q]); }
    }
    fft_dit_inv(X, W);
    float za[8], zb[8];
    {
      float xa[8], xb[8];
      hy_conv8(P0 + (size_t)(256 + c) * KEYS, tb, SL, cw[256 + c], cw[768 + 256 + c], cw[1536 + 256 + c], cb[256 + c], xa);
      hy_conv8(P1 + (size_t)(256 + c) * KEYS, tb, SL, cw[256 + c], cw[768 + 256 + c], cw[1536 + 256 + c], cb[256 + c], xb);
#pragma unroll
      for (int i = 0; i < 8; ++i) {
        const float2 y = X[tb + i];
        za[i] = xa[i] * (y.x * (1.f / 8192.f) + bias0 * va[i]);
        zb[i] = xb[i] * (y.y * (1.f / 8192.f) + bias0 * vb[i]);
      }
    }
    __syncthreads();
#pragma unroll
    for (int i = 0; i < 8; ++i) { X[tb + i] = make_float2(za[i], zb[i]); X[tb + i + 4096] = make_float2(0.f, 0.f); }
    fft_dif(X, W);
    {
      const float2* H = kf + (size_t)(256 + c) * 8192;
#pragma unroll 4
      for (int i = 0; i < 16; ++i) { int q = tid + i * 512; X[q] = cmul(X[q], H[q]); }
    }
    fft_dit_inv(X, W);
    {
      float xa[8], xb[8];
      hy_conv8(P0 + (size_t)(512 + c) * KEYS, tb, SL, cw[512 + c], cw[768 + 512 + c], cw[1536 + 512 + c], cb[512 + c], xa);
      hy_conv8(P1 + (size_t)(512 + c) * KEYS, tb, SL, cw[512 + c], cw[768 + 512 + c], cw[1536 + 512 + c], cb[512 + c], xb);
#pragma unroll
      for (int i = 0; i < 8; ++i) {
        const float2 y = X[tb + i];
        const float oa = xa[i] * (y.x * (1.f / 8192.f) + bias1 * za[i]);
        const float ob = xb[i] * (y.y * (1.f / 8192.f) + bias1 * zb[i]);
        Y[((size_t)b0 * SL + tb + i) * 256 + c] = (bf16_t)f2bf(oa);
        Y[((size_t)b1 * SL + tb + i) * 256 + c] = (bf16_t)f2bf(ob);
      }
    }
  }
}

DI void ph_hyena_ctx(const Params& p, int l, char* smem) {
  const int tid = my_tid(), lane = tid & 63, wid = tid >> 6;
  float* Zb = (float*)smem + wid * 1024;
  float* Gb = Zb + 256;
  const bf16_t* PT = (const bf16_t*)(p.ws + R_PHY);
  const float* G = (const float*)(p.ws + MISC_GCTX);
  const float* cw = p.in[7] + (size_t)l * 3 * 768; const float* cb = p.in[8] + (size_t)l * 768;
  const float* hb = p.in[15] + (size_t)l * 512;
  bf16_t* Y = (bf16_t*)(p.ws + R_YHY);
  for (int base = blockIdx.x * 8; base < 2048; base += gridDim.x * 8) {
    const int u = base + wid; const int b = u >> 8, c = u & 255;
    const bf16_t* Pb = PT + ((size_t)b * 768) * KEYS + SL;
    float v[4], x1[4], x2[4], zz[4];
#pragma unroll
    for (int i = 0; i < 4; ++i) {
      int t = lane + i * 64;
      v[i] = hy_conv3(Pb + (size_t)c * KEYS, t, CL, cw[c], cw[768 + c], cw[1536 + c], cb[c]);
      x1[i] = hy_conv3(Pb + (size_t)(256 + c) * KEYS, t, CL, cw[256 + c], cw[768 + 256 + c], cw[1536 + 256 + c], cb[256 + c]);
      x2[i] = hy_conv3(Pb + (size_t)(512 + c) * KEYS, t, CL, cw[512 + c], cw[768 + 512 + c], cw[1536 + 512 + c], cb[512 + c]);
    }
    __syncthreads();
#pragma unroll
    for (int i = 0; i < 4; ++i) Zb[lane + i * 64] = v[i];
    for (int i = lane; i < 512; i += 64) Gb[i] = G[(size_t)c * 512 + i];
    __syncthreads();
#pragma unroll
    for (int i = 0; i < 4; ++i) {
      int t = lane + i * 64; float s = 0.f;
      for (int s2 = 0; s2 < 256; ++s2) s += Gb[256 + t - s2] * Zb[s2];
      zz[i] = x1[i] * (s + hb[c] * v[i]);
    }
    __syncthreads();
#pragma unroll
    for (int i = 0; i < 4; ++i) Zb[lane + i * 64] = zz[i];
    for (int i = lane; i < 512; i += 64) Gb[i] = G[(size_t)(256 + c) * 512 + i];
    __syncthreads();
#pragma unroll
    for (int i = 0; i < 4; ++i) {
      int t = lane + i * 64; float s = 0.f;
      for (int s2 = 0; s2 < 256; ++s2) s += Gb[256 + t - s2] * Zb[s2];
      float o = x2[i] * (s + hb[256 + c] * zz[i]);
      Y[((size_t)ML + b * CL + t) * 256 + c] = (bf16_t)f2bf(o);
    }
  }
}

DI void ph_rope(const Params& p, char* smem) {
  float2* T16 = (float2*)smem;
  float2* T8 = T16 + 64 * 16;
  const int tid = my_tid(), lane = tid & 63, wid = tid >> 6;
  __syncthreads();
  for (int i = tid; i < 64 * 16; i += NTHR) {
    int pos = i >> 4, f = i & 15; float inv = powf(10000.f, -(float)f / 16.f); float s, c; sincosf((float)pos * inv, &s, &c);
    T16[i] = make_float2(c, s);
  }
  for (int i = tid; i < 64 * 8; i += NTHR) {
    int pos = i >> 3, f = i & 7; float inv = powf(10000.f, -(float)f / 8.f); float s, c; sincosf((float)pos * inv, &s, &c);
    T8[i] = make_float2(c, s);
  }
  __syncthreads();
  bf16_t* Psw = (bf16_t*)(p.ws + R_PSW); bf16_t* Pdf = (bf16_t*)(p.ws + R_PDF);
  bf16_t* rowbase_ptr; int e1, e2, nf, f0; bool hsel; bool active = lane < 56;
  if (lane < 24) { const int hd = lane >> 2, half = (lane >> 1) & 1, cp = lane & 1; e1 = hd * 64 + half * 32 + cp * 8; e2 = e1 + 16; nf = 16; f0 = cp * 8; hsel = half; }
  else { const int j = lane - 24; const int gi = j >> 1, half = j & 1; e1 = gi * 32 + half * 16; e2 = e1 + 8; nf = 8; f0 = 0; hsel = half; }
  const float2* Tb = (lane < 24) ? T16 : T8;
  for (int row = blockIdx.x * 8 + wid; row < ML; row += gridDim.x * 8) {
    if (active) {
      const int t = row & (SL - 1); const int pos = hsel ? (t & 63) : (t >> 6);
      rowbase_ptr = (lane < 24) ? Psw + (size_t)row * 384 : Pdf + (size_t)row * 512;
      const uint4 u1 = *(const uint4*)(rowbase_ptr + e1), u2 = *(const uint4*)(rowbase_ptr + e2);
      const float4* cs = (const float4*)(Tb + pos * nf + f0);
      const float4 c0 = cs[0], c1 = cs[1], c2 = cs[2], c3 = cs[3];
      const unsigned w1[4] = {u1.x, u1.y, u1.z, u1.w}, w2[4] = {u2.x, u2.y, u2.z, u2.w};
      const float4 cc[4] = {c0, c1, c2, c3};
      unsigned o1[4], o2[4];
#pragma unroll
      for (int i = 0; i < 4; ++i) {
        const float xa = bflo(w1[i]), xb = bfhi(w1[i]), ya = bflo(w2[i]), yb = bfhi(w2[i]);
        o1[i] = pack2(xa * cc[i].x - ya * cc[i].y, xb * cc[i].z - yb * cc[i].w);
        o2[i] = pack2(xa * cc[i].y + ya * cc[i].x, xb * cc[i].w + yb * cc[i].z);
      }
      *(uint4*)(rowbase_ptr + e1) = make_uint4(o1[0], o1[1], o1[2], o1[3]);
      *(uint4*)(rowbase_ptr + e2) = make_uint4(o2[0], o2[1], o2[2], o2[3]);
    }
  }
}

DI float rw_shift(const bf16_t* __restrict__ P, int row, int t, int len, int col, float mu) {
  float c = bf2f(P[(size_t)row * 1216 + col]);
  float a = t >= 1 ? bf2f(P[(size_t)(row - 1) * 1216 + col]) : 0.f;
  float b = t + 1 < len ? bf2f(P[(size_t)(row + 1) * 1216 + col]) : 0.f;
  return c + (0.5f * (a + b) - c) * mu;
}
DI void ph_rwprep(const Params& p, int l, char* smem) {
  constexpr int AST = 912, RST = 1552, ROFF = 32 * AST;
  const int tid = my_tid(), lane = tid & 63, wid = tid >> 6, g = lane >> 4, r16 = lane & 15;
  const int tg = wid >> 2, hd = wid & 3;
  const bf16_t* P = (const bf16_t*)(p.ws + R_PRW);
  const float* mu = p.in[17] + (size_t)l * 1216;
  const float* w0 = p.in[18] + (size_t)l * 512; const float* a0 = p.in[20] + (size_t)l * 256;
  const float* kkw = p.in[23] + (size_t)l * 256; const float* kaw = p.in[24] + (size_t)l * 256;
  bf16_t* S = (bf16_t*)(p.ws + R_STR); bf16_t* Gs = (bf16_t*)(p.ws + R_G);
  const size_t SU = (size_t)MT * 256;
  float w0f[4], w0b[4], a0c[4], kkc[4], kac[4];
#pragma unroll
  for (int nt = 0; nt < 4; ++nt) { int c = hd * 64 + r16 * 4 + nt; w0f[nt] = w0[c]; w0b[nt] = w0[256 + c]; a0c[nt] = a0[c]; kkc[nt] = kkw[c]; kac[nt] = kaw[c]; }
  for (int u = blockIdx.x; u < MT / 32; u += gridDim.x) {
    const int row0 = u * 32; int t0, len;
    if (row0 < ML) { t0 = row0 & (SL - 1); len = SL; } else { t0 = (row0 - ML) & (CL - 1); len = CL; }
    __syncthreads();
    for (int item = tid; item < 32 * 152; item += NTHR) {
      const int tk = item / 152, c8 = item - tk * 152; const int row = row0 + tk, t = t0 + tk;
      const uint4 uc = *(const uint4*)(P + (size_t)row * 1216 + c8 * 8);
      uint4 ua = make_uint4(0, 0, 0, 0), ub = make_uint4(0, 0, 0, 0);
      if (t >= 1) ua = *(const uint4*)(P + (size_t)(row - 1) * 1216 + c8 * 8);
      if (t + 1 < len) ub = *(const uint4*)(P + (size_t)(row + 1) * 1216 + c8 * 8);
      const float4 m0 = *(const float4*)(mu + c8 * 8), m1 = *(const float4*)(mu + c8 * 8 + 4);
      float o[8];
      {
        const unsigned wc[4] = {uc.x, uc.y, uc.z, uc.w}, wa[4] = {ua.x, ua.y, ua.z, ua.w}, wb[4] = {ub.x, ub.y, ub.z, ub.w};
        const float mm[8] = {m0.x, m0.y, m0.z, m0.w, m1.x, m1.y, m1.z, m1.w};
#pragma unroll
        for (int i = 0; i < 4; ++i) {
          float c_lo = bflo(wc[i]), c_hi = bfhi(wc[i]);
          o[2 * i] = c_lo + (0.5f * (bflo(wa[i]) + bflo(wb[i])) - c_lo) * mm[2 * i];
          o[2 * i + 1] = c_hi + (0.5f * (bfhi(wa[i]) + bfhi(wb[i])) - c_hi) * mm[2 * i + 1];
        }
      }
      char* dst;
      if (c8 < 96) dst = smem + ROFF + tk * RST + c8 * 16;
      else {
        const int cc = c8 * 8 - 768;
        if (cc < 128) {
#pragma unroll
          for (int i = 0; i < 8; ++i) o[i] = 1.f - 2.f * __builtin_amdgcn_rcpf(1.f + __expf(2.f * o[i]));
        } else if (cc >= 192) {
#pragma unroll
          for (int i = 0; i < 8; ++i) o[i] = sigmoidf_(o[i]);
        }
        dst = smem + tk * AST + cc * 2;
      }
      uint4 ov; ov.x = pack2(o[0], o[1]); ov.y = pack2(o[2], o[3]); ov.z = pack2(o[4], o[5]); ov.w = pack2(o[6], o[7]);
      *(uint4*)dst = ov;
    }
    __syncthreads();
    f32x4 acc[5][4];
#pragma unroll
    for (int o5 = 0; o5 < 5; ++o5)
#pragma unroll
      for (int nt = 0; nt < 4; ++nt) acc[o5][nt] = (f32x4){0.f, 0.f, 0.f, 0.f};
    const char* Arow = smem + (tg * 16 + r16) * AST + g * 16;
#pragma unroll
    for (int o5 = 0; o5 < 5; ++o5) {
      const int kbase = o5 < 3 ? o5 * 64 : (o5 == 3 ? 192 : 320);
      const int KK = o5 < 3 ? 64 : 128;
      const bf16_t* Wt = (const bf16_t*)(p.ws + (o5 == 0 ? RWW_F : o5 == 1 ? RWW_B : o5 == 2 ? RWW_A : o5 == 3 ? RWW_GF : RWW_GB));
#pragma unroll
      for (int ks = 0; ks < KK / 32; ++ks) {
        const bf16x8 af = *(const bf16x8*)(Arow + (kbase + ks * 32) * 2);
#pragma unroll
        for (int nt = 0; nt < 4; ++nt) {
          const bf16x8 bf = *(const bf16x8*)(Wt + (size_t)(hd * 64 + nt * 16 + r16) * KK + ks * 32 + g * 8);
          acc[o5][nt] = __builtin_amdgcn_mfma_f32_16x16x32_bf16(af, bf, acc[o5][nt], 0, 0, 0);
        }
        if (ks == KK / 32 - 1 && (o5 == 2 || o5 == 4)) asm volatile("" ::: "memory");
      }
    }
#pragma unroll
    for (int j = 0; j < 4; ++j) {
      const int tk = tg * 16 + g * 4 + j; const size_t row = (size_t)row0 + tk;
      const char* rk = smem + ROFF + tk * RST;
      const int c0 = hd * 64 + r16 * 4;
      const uint2 ur = *(const uint2*)(rk + c0 * 2), uk = *(const uint2*)(rk + (256 + c0) * 2), uv = *(const uint2*)(rk + (512 + c0) * 2);
      const float rv[4] = {bflo(ur.x), bfhi(ur.x), bflo(ur.y), bfhi(ur.y)};
      const float kv[4] = {bflo(uk.x), bfhi(uk.x), bflo(uk.y), bfhi(uk.y)};
      const float vv[4] = {bflo(uv.x), bfhi(uv.x), bflo(uv.y), bfhi(uv.y)};
      float n2 = 0.f;
#pragma unroll
      for (int nt = 0; nt < 4; ++nt) { float q = kv[nt] * kkc[nt]; n2 += q * q; }
      n2 = sum16(n2);
      const float inv = __builtin_amdgcn_rsqf(fmaxf(n2, 1e-24f));
      float o_kp[4], o_kk[4], o_b[4], o_df[4], o_db[4];
#pragma unroll
      for (int nt = 0; nt < 4; ++nt) {
        const float k = kv[nt];
        const float a = sigmoidf_(a0c[nt] + acc[2][nt][j]);
        const float kk = k * kkc[nt] * inv;
        o_kp[nt] = k * (1.f + (a - 1.f) * kac[nt]);
        o_kk[nt] = kk; o_b[nt] = kk * a;
        const float xf = -(w0f[nt] + acc[0][nt][j]); const float spf = fmaxf(xf, 0.f) + __logf(1.f + __expf(-fabsf(xf)));
        const float xb = -(w0b[nt] + acc[1][nt][j]); const float spb = fmaxf(xb, 0.f) + __logf(1.f + __expf(-fabsf(xb)));
        const float ef = __expf(-spf - 0.5f), eb = __expf(-spb - 0.5f);
        o_df[nt] = 1.f - __expf(-ef); o_db[nt] = 1.f - __expf(-eb);
      }
      const size_t o = row * 256 + c0;
      uint2 w;
      w.x = pack2(rv[0], rv[1]); w.y = pack2(rv[2], rv[3]); *(uint2*)(S + o) = w;
      w.x = pack2(o_kp[0], o_kp[1]); w.y = pack2(o_kp[2], o_kp[3]); *(uint2*)(S + SU + o) = w;
      w.x = pack2(vv[0], vv[1]); w.y = pack2(vv[2], vv[3]); *(uint2*)(S + 2 * SU + o) = w;
      w.x = pack2(o_kk[0], o_kk[1]); w.y = pack2(o_kk[2], o_kk[3]); *(uint2*)(S + 3 * SU + o) = w;
      w.x = pack2(o_b[0], o_b[1]); w.y = pack2(o_b[2], o_b[3]); *(uint2*)(S + 4 * SU + o) = w;
      w.x = pack2(o_df[0], o_df[1]); w.y = pack2(o_df[2], o_df[3]); *(uint2*)(S + 5 * SU + o) = w;
      w.x = pack2(o_db[0], o_db[1]); w.y = pack2(o_db[2], o_db[3]); *(uint2*)(S + 6 * SU + o) = w;
      w.x = pack2(acc[3][0][j], acc[3][1][j]); w.y = pack2(acc[3][2][j], acc[3][3][j]); *(uint2*)(Gs + o) = w;
      w.x = pack2(acc[4][0][j], acc[4][1][j]); w.y = pack2(acc[4][2][j], acc[4][3][j]); *(uint2*)(Gs + SU + o) = w;
    }
  }
}

DI long scan_row(int b, int dir, int s) {
  if (s < CL) return (long)ML + b * CL + (dir ? (CL - 1 - s) : s);
  int t = s - CL; return (long)b * SL + (dir ? (SL - 1 - t) : t);
}
DI float sum8(float v) {
  v += dpp_mov<0xB1>(v);
  v += dpp_mov<0x4E>(v);
  v += dpp_mov<0x141>(v);
  return v;
}
DI void ph_scan(const Params& p, char* smem) {
  const int tid = my_tid(), lane = tid & 63, wid = tid >> 6;
  const bf16_t* S = (const bf16_t*)(p.ws + R_STR);
  const size_t SU = (size_t)MT * 256;
  constexpr int T = 32, NSTEP = CL + SL, NCH = NSTEP / T;
  typedef float f32x2 __attribute__((ext_vector_type(2)));
  for (int u = blockIdx.x; u < 128; u += gridDim.x) {
    const int chain = u >> 1, rg = u & 1; const int dir = chain & 1, bh = chain >> 1, b = bh >> 2, h = bh & 3;
    bf16_t* O = (bf16_t*)(p.ws + (dir ? R_OB : R_OF));
    uint4 q0, q1, q2;
    auto SC_GLOAD = [&](int ci) {
#pragma unroll
      for (int j = 0; j < 3; ++j) {
        int idx = tid + j * 512; int st = idx >> 8, s = (idx & 255) >> 3, ck = idx & 7;
        long row = scan_row(b, dir, ci * T + s);
        int sid = st < 5 ? st : 5 + dir;
        uint4 v = *(const uint4*)(S + sid * SU + row * 256 + h * 64 + ck * 8);
        if (j == 0) q0 = v; else if (j == 1) q1 = v; else q2 = v;
      }
    };
    auto SC_SSTORE = [&](int buf) {
#pragma unroll
      for (int j = 0; j < 3; ++j) {
        int idx = tid + j * 512; int st = idx >> 8;
        uint4 v = j == 0 ? q0 : (j == 1 ? q1 : q2);
        float4 lo = make_float4(bflo(v.x), bfhi(v.x), bflo(v.y), bfhi(v.y));
        float4 hi = make_float4(bflo(v.z), bfhi(v.z), bflo(v.w), bfhi(v.w));
        if (st == 5) { lo.x = 1.f - lo.x; lo.y = 1.f - lo.y; lo.z = 1.f - lo.z; lo.w = 1.f - lo.w; hi.x = 1.f - hi.x; hi.y = 1.f - hi.y; hi.z = 1.f - hi.z; hi.w = 1.f - hi.w; }
        char* base = smem + buf * 49152 + idx * 32;
        *(float4*)(base) = lo; *(float4*)(base + 16) = hi;
      }
    };
    auto FLUSH = [&](int ci) {
      const int s = tid >> 4, part = tid & 15;
      const float2 v = *(const float2*)(smem + 98304 + (ci & 1) * 4096 + s * 128 + part * 8);
      long row = scan_row(b, dir, ci * T + s);
      *(unsigned*)(O + row * 256 + h * 64 + rg * 32 + part * 2) = pack2(v.x, v.y);
    };
    __syncthreads();
    SC_GLOAD(0);
    SC_SSTORE(0);
    __syncthreads();
    f32x2 st0 = {0.f, 0.f}, st1 = {0.f, 0.f}, st2 = {0.f, 0.f}, st3 = {0.f, 0.f};
    const int rsub = lane >> 3, ks = lane & 7;
    const int lrow = (wid & 3) * 8 + rsub;
    const int vrow = rg * 32 + lrow;
    struct Step { f32x2 r[4], k[4], kk[4], b[4], w[4]; float v; };
    auto LOADSTEP = [&](Step& x, const char* B, int s) {
#pragma unroll
      for (int hh = 0; hh < 2; ++hh) {
        const float4 r = *(const float4*)(B + (0 * T + s) * 256 + ks * 32 + hh * 16);
        const float4 k = *(const float4*)(B + (1 * T + s) * 256 + ks * 32 + hh * 16);
        const float4 kk = *(const float4*)(B + (3 * T + s) * 256 + ks * 32 + hh * 16);
        const float4 bb = *(const float4*)(B + (4 * T + s) * 256 + ks * 32 + hh * 16);
        const float4 w = *(const float4*)(B + (5 * T + s) * 256 + ks * 32 + hh * 16);
        x.r[2 * hh] = (f32x2){r.x, r.y}; x.r[2 * hh + 1] = (f32x2){r.z, r.w};
        x.k[2 * hh] = (f32x2){k.x, k.y}; x.k[2 * hh + 1] = (f32x2){k.z, k.w};
        x.kk[2 * hh] = (f32x2){kk.x, kk.y}; x.kk[2 * hh + 1] = (f32x2){kk.z, kk.w};
        x.b[2 * hh] = (f32x2){bb.x, bb.y}; x.b[2 * hh + 1] = (f32x2){bb.z, bb.w};
        x.w[2 * hh] = (f32x2){w.x, w.y}; x.w[2 * hh + 1] = (f32x2){w.z, w.w};
      }
      x.v = *(const float*)(B + (2 * T + s) * 256 + vrow * 4);
    };
    for (int ci = 0; ci < NCH; ++ci) {
      if (ci + 1 < NCH) { SC_GLOAD(ci + 1); }
      if (ci > 0) FLUSH(ci - 1);
      if (wid < 4) {
        const char* B = smem + (ci & 1) * 49152;
        float* ob = (float*)(smem + 98304 + (ci & 1) * 4096);
        Step nx; LOADSTEP(nx, B, 0);
#pragma unroll 8
        for (int s = 0; s < T; ++s) {
          const Step c = nx;
          LOADSTEP(nx, B, s + 1);
          f32x2 pa = st0 * c.kk[0] + st1 * c.kk[1];
          f32x2 pb = st2 * c.kk[2] + st3 * c.kk[3];
          pa = pa + pb;
          float sa = -(pa.x + pa.y);
          sa = sum8(sa);
          const f32x2 sa2 = {sa, sa}; const f32x2 v2 = {c.v, c.v};
          st0 = st0 * c.w[0] + sa2 * c.b[0] + v2 * c.k[0];
          st1 = st1 * c.w[1] + sa2 * c.b[1] + v2 * c.k[1];
          st2 = st2 * c.w[2] + sa2 * c.b[2] + v2 * c.k[2];
          st3 = st3 * c.w[3] + sa2 * c.b[3] + v2 * c.k[3];
          f32x2 oa = st0 * c.r[0] + st1 * c.r[1];
          f32x2 ob2 = st2 * c.r[2] + st3 * c.r[3];
          oa = oa + ob2;
          float o = sum8(oa.x + oa.y);
          ob[s * 32 + lrow] = o;
        }
      }
      if (ci + 1 < NCH) { SC_SSTORE((ci + 1) & 1); }
      __syncthreads();
    }
    FLUSH(NCH - 1);
  }
}

template <bool DIFF>
DI void attn_unit(const Params& p, int l, int b, int h, int qrow0, int qpos0, int kb_lo, int kb_hi, int kc_lo, char* smem) {
  const int tid = my_tid(), lane = tid & 63, wid = tid >> 6, g = lane >> 4, r16 = lane & 15;
  const bf16_t* QK = (const bf16_t*)(p.ws + (DIFF ? R_PDF : R_PSW));
  const int ldq = DIFF ? 512 : 384;
  const int qc0 = h * 64;
  const int kc0 = 256 + (DIFF ? h * 64 : (h >> 1) * 64);
  const bf16_t* VT = DIFF ? (const bf16_t*)(p.ws + R_VTDF) + ((size_t)b * 256 + h * 64) * KEYS
                          : (const bf16_t*)(p.ws + R_VTSW) + ((size_t)b * 128 + (h >> 1) * 64) * KEYS;
  const int nblk = (kb_hi - kb_lo) + (68 - kc_lo);
  const float sc = (DIFF ? 0.17677669529663687f : 0.125f) * 1.4426950408889634f;
  bf16x8 qf[2];
  {
    const bf16_t* qp = QK + (size_t)(qrow0 + wid * 16 + r16) * ldq + qc0 + g * 8;
    qf[0] = *(const bf16x8*)(qp); qf[1] = *(const bf16x8*)(qp + 32);
  }
  constexpr int NC = DIFF ? 2 : 1;
  float m[NC], lsum[NC];
  f32x4 O[NC][4];
#pragma unroll
  for (int c = 0; c < NC; ++c) {
    if (DIFF) { m[c] = -1e30f; lsum[c] = 0.f; }
    else { m[c] = p.in[16][l * 4 + h] * 1.4426950408889634f; lsum[c] = (g == 0) ? 1.f : 0.f; }
#pragma unroll
    for (int dt = 0; dt < 4; ++dt) O[c][dt] = (f32x4){0.f, 0.f, 0.f, 0.f};
  }
  const int lr = tid >> 3, lc = tid & 7;
  uint4 rkA, rvA, rkB, rvB;
  rkA = make_uint4(0, 0, 0, 0); rvA = rkA; rkB = rkA; rvB = rkA;
  auto AT_GLOAD = [&](int i, uint4& rk, uint4& rv) {
    int kb = i < (kb_hi - kb_lo) ? kb_lo + i : kc_lo + (i - (kb_hi - kb_lo));
    long krow = kb < 64 ? (long)b * SL + kb * 64 + lr : (long)ML + b * CL + (kb - 64) * 64 + lr;
    rk = *(const uint4*)(QK + krow * ldq + kc0 + lc * 8);
    rv = *(const uint4*)(VT + (size_t)lr * KEYS + kb * 64 + lc * 8);
  };
  auto AT_SSTORE = [&](int buf, const uint4& rk, const uint4& rv) {
    *(uint4*)(smem + buf * 18432 + lr * 128 + ((lc ^ (lr & 7)) << 4)) = rk;
    *(uint4*)(smem + buf * 18432 + 9216 + lr * 144 + lc * 16) = rv;
  };
  __syncthreads();
  AT_GLOAD(0, rkA, rvA);
  AT_SSTORE(0, rkA, rvA);
  if (1 < nblk) AT_GLOAD(1, rkA, rvA);
  if (2 < nblk) AT_GLOAD(2, rkB, rvB);
  lds_barrier();
  const int qpos = qpos0 + wid * 16 + r16;
  for (int i = 0; i < nblk; ++i) {
    const int kb = i < (kb_hi - kb_lo) ? kb_lo + i : kc_lo + (i - (kb_hi - kb_lo));
    const bool masked = (!DIFF) && (kb < 64);
    const char* Kt = smem + (i & 1) * 18432; const char* Vt = Kt + 9216;
    f32x4 S[NC][4];
#pragma unroll
    for (int kt = 0; kt < 4; ++kt) {
      bf16x8 k0 = *(const bf16x8*)(Kt + (kt * 16 + r16) * 128 + ((g ^ (r16 & 7)) << 4));
      bf16x8 k1 = *(const bf16x8*)(Kt + (kt * 16 + r16) * 128 + (((4 + g) ^ (r16 & 7)) << 4));
      if (DIFF) {
        S[0][kt] = __builtin_amdgcn_mfma_f32_16x16x32_bf16(k0, qf[0], (f32x4){0.f, 0.f, 0.f, 0.f}, 0, 0, 0);
        S[NC - 1][kt] = __builtin_amdgcn_mfma_f32_16x16x32_bf16(k1, qf[1], (f32x4){0.f, 0.f, 0.f, 0.f}, 0, 0, 0);
      } else {
        f32x4 t = __builtin_amdgcn_mfma_f32_16x16x32_bf16(k0, qf[0], (f32x4){0.f, 0.f, 0.f, 0.f}, 0, 0, 0);
        S[0][kt] = __builtin_amdgcn_mfma_f32_16x16x32_bf16(k1, qf[1], t, 0, 0, 0);
      }
    }
    bf16x8 pf[NC][2];
#pragma unroll
    for (int c = 0; c < NC; ++c) {
      float mx = -1e30f;
#pragma unroll
      for (int kt = 0; kt < 4; ++kt)
#pragma unroll
        for (int j = 0; j < 4; ++j) {
          float v = S[c][kt][j];
          if (masked) { int kpos = kb * 64 + kt * 16 + g * 4 + j; int dd = kpos - qpos; if (dd > 128 || dd < -128) v = -3e38f; S[c][kt][j] = v; }
          mx = fmaxf(mx, v);
        }
      mx *= sc;
      mx = fmaxf(mx, __shfl_xor(mx, 16)); mx = fmaxf(mx, __shfl_xor(mx, 32));
      const float mn = fmaxf(m[c], mx);
      const bool grow = mn > m[c];
      float ps = 0.f;
      unsigned pk[8];
#pragma unroll
      for (int kt = 0; kt < 4; ++kt) {
        float e0 = __builtin_amdgcn_exp2f(fmaf(S[c][kt][0], sc, -mn)), e1 = __builtin_amdgcn_exp2f(fmaf(S[c][kt][1], sc, -mn));
        float e2 = __builtin_amdgcn_exp2f(fmaf(S[c][kt][2], sc, -mn)), e3 = __builtin_amdgcn_exp2f(fmaf(S[c][kt][3], sc, -mn));
        ps += (e0 + e1) + (e2 + e3);
        pk[kt * 2] = pack2(e0, e1); pk[kt * 2 + 1] = pack2(e2, e3);
      }
      if (__builtin_amdgcn_ballot_w64(grow) != 0ull) {
        const float alpha = __builtin_amdgcn_exp2f(m[c] - mn);
        m[c] = mn;
        lsum[c] *= alpha;
#pragma unroll
        for (int dt = 0; dt < 4; ++dt) { O[c][dt][0] *= alpha; O[c][dt][1] *= alpha; O[c][dt][2] *= alpha; O[c][dt][3] *= alpha; }
      }
      lsum[c] += ps;
      union { unsigned u[4]; bf16x8 v; } cv;
      cv.u[0] = pk[0]; cv.u[1] = pk[1]; cv.u[2] = pk[2]; cv.u[3] = pk[3]; pf[c][0] = cv.v;
      cv.u[0] = pk[4]; cv.u[1] = pk[5]; cv.u[2] = pk[6]; cv.u[3] = pk[7]; pf[c][1] = cv.v;
    }
#pragma unroll
    for (int dt = 0; dt < 4; ++dt)
#pragma unroll
      for (int s2 = 0; s2 < 2; ++s2) {
        union { uint2 u[2]; bf16x8 v; } vf;
        vf.u[0] = *(const uint2*)(Vt + (dt * 16 + r16) * 144 + (2 * s2) * 32 + g * 8);
        vf.u[1] = *(const uint2*)(Vt + (dt * 16 + r16) * 144 + (2 * s2 + 1) * 32 + g * 8);
#pragma unroll
        for (int c = 0; c < NC; ++c) O[c][dt] = __builtin_amdgcn_mfma_f32_16x16x32_bf16(vf.v, pf[c][s2], O[c][dt], 0, 0, 0);
      }
    if (i + 1 < nblk) AT_SSTORE((i + 1) & 1, rkA, rvA);
    rkA = rkB; rvA = rvB;
    if (i + 3 < nblk) AT_GLOAD(i + 3, rkB, rvB);
    lds_barrier();
  }
  float linv[NC];
#pragma unroll
  for (int c = 0; c < NC; ++c) { float t = lsum[c]; t += __shfl_xor(t, 16); t += __shfl_xor(t, 32); linv[c] = 1.f / t; }
  const size_t orow = (size_t)(qrow0 + wid * 16 + r16);
  if (!DIFF) {
    bf16_t* Y = (bf16_t*)(p.ws + R_YSW);
#pragma unroll
    for (int dt = 0; dt < 4; ++dt) {
      uint2 o; o.x = pack2(O[0][dt][0] * linv[0], O[0][dt][1] * linv[0]); o.y = pack2(O[0][dt][2] * linv[0], O[0][dt][3] * linv[0]);
      *(uint2*)(Y + orow * 256 + h * 64 + dt * 16 + g * 4) = o;
    }
  } else {
    const float lam_init = 0.8f - 0.6f * __expf(-0.3f * (float)l);
    float d1 = 0.f, d2 = 0.f;
    if (lane < 32) { d1 = p.in[28][l * 32 + lane] * p.in[29][l * 32 + lane]; d2 = p.in[30][l * 32 + lane] * p.in[31][l * 32 + lane]; }
    d1 = wave_sum(d1); d2 = wave_sum(d2);
    const float lam = expf(d1) - expf(d2) + lam_init;
    float ov[4][4]; float ss = 0.f;
#pragma unroll
    for (int dt = 0; dt < 4; ++dt)
#pragma unroll
      for (int j = 0; j < 4; ++j) { float v = O[0][dt][j] * linv[0] - lam * O[NC - 1][dt][j] * linv[NC - 1]; ov[dt][j] = v; ss += v * v; }
    ss += __shfl_xor(ss, 16); ss += __shfl_xor(ss, 32);
    const float rms = rsqrtf(ss * (1.f / 64.f) + 1e-5f) * (1.f - lam_init);
    const float* sg = p.in[32] + l * 64;
    bf16_t* Y = (bf16_t*)(p.ws + R_YDF);
#pragma unroll
    for (int dt = 0; dt < 4; ++dt) {
      const int d0 = dt * 16 + g * 4;
      uint2 o; o.x = pack2(ov[dt][0] * rms * sg[d0], ov[dt][1] * rms * sg[d0 + 1]); o.y = pack2(ov[dt][2] * rms * sg[d0 + 2], ov[dt][3] * rms * sg[d0 + 3]);
      *(uint2*)(Y + orow * 256 + h * 64 + d0) = o;
    }
  }
}

DI void ph_attn(const Params& p, int l, char* smem) {
  const bool need_ctx = (l == 0);
  const int n_sw = 1024 + (need_ctx ? 64 : 0);
  const int n_df = 1024 + (need_ctx ? 64 : 0);
  unsigned* ctr = (unsigned*)(p.ws + MISC_BAR + 64 + 64 * l);
  volatile int* slot = (volatile int*)(smem + 40960);
  for (;;) {
    __syncthreads();
    if (my_tid() == 0) *slot = (int)__hip_atomic_fetch_add(ctr, 1u, __ATOMIC_RELAXED, __HIP_MEMORY_SCOPE_AGENT);
    __syncthreads();
    const int u = *slot;
    if (u >= n_sw + n_df) break;
    if (u < n_df) {
      if (u < 1024) { int b = u >> 7, h = (u >> 5) & 3, n = u & 31; attn_unit<true>(p, l, b, h, b * SL + n * 128, n * 128, 0, 64, 64, smem); }
      else { int v = u - 1024; int b = v >> 3, h = (v >> 1) & 3, n = v & 1; attn_unit<true>(p, l, b, h, ML + b * CL + n * 128, 0, 0, 0, 64, smem); }
    } else {
      int w = u - n_df;
      if (w < 1024) {
        int b = w >> 7, h = (w >> 5) & 3, n = w & 31;
        int lo = (n - 1) * 2; if (lo < 0) lo = 0; int hi = (n + 2) * 2; if (hi > 64) hi = 64;
        attn_unit<false>(p, l, b, h, b * SL + n * 128, n * 128, lo, hi, 64, smem);
      } else { int v = w - 1024; int b = v >> 3, h = (v >> 1) & 3, n = v & 1; attn_unit<false>(p, l, b, h, ML + b * CL + n * 128, 0, 0, 0, 64, smem); }
    }
  }
}

DI void ph_rwout(const Params& p, int l) {
  const int lane = my_tid() & 63, wid = my_tid() >> 6;
  const bf16_t* S = (const bf16_t*)(p.ws + R_STR); const bf16_t* Gs = (const bf16_t*)(p.ws + R_G);
  const bf16_t* OF = (const bf16_t*)(p.ws + R_OF); const bf16_t* OB = (const bf16_t*)(p.ws + R_OB);
  bf16_t* Y = (bf16_t*)(p.ws + R_YRW);
  const size_t SU = (size_t)MT * 256;
  const float4 rk = *(const float4*)(p.in[25] + (size_t)l * 256 + lane * 4);
  const float4 gam = *(const float4*)(p.in[26] + (size_t)l * 256 + lane * 4);
  const float4 bet = *(const float4*)(p.in[27] + (size_t)l * 256 + lane * 4);
  const int nrows = (l == 0) ? MT : ML;
  for (int row = blockIdx.x * 8 + wid; row < nrows; row += gridDim.x * 8) {
    const size_t o = (size_t)row * 256 + lane * 4;
    uint2 ur = *(const uint2*)(S + o), uk = *(const uint2*)(S + SU + o), uv = *(const uint2*)(S + 2 * SU + o);
    uint2 uf = *(const uint2*)(OF + o), ub = *(const uint2*)(OB + o), ugf = *(const uint2*)(Gs + o), ugb = *(const uint2*)(Gs + SU + o);
    float r[4] = {bflo(ur.x), bfhi(ur.x), bflo(ur.y), bfhi(ur.y)};
    float k[4] = {bflo(uk.x), bfhi(uk.x), bflo(uk.y), bfhi(uk.y)};
    float v[4] = {bflo(uv.x), bfhi(uv.x), bflo(uv.y), bfhi(uv.y)};
    float f[4] = {bflo(uf.x), bfhi(uf.x), bflo(uf.y), bfhi(uf.y)};
    float bb[4] = {bflo(ub.x), bfhi(ub.x), bflo(ub.y), bfhi(ub.y)};
    float gf[4] = {bflo(ugf.x), bfhi(ugf.x), bflo(ugf.y), bfhi(ugf.y)};
    float gb[4] = {bflo(ugb.x), bfhi(ugb.x), bflo(ugb.y), bfhi(ugb.y)};
    const float rkv[4] = {rk.x, rk.y, rk.z, rk.w}; const float ga[4] = {gam.x, gam.y, gam.z, gam.w}; const float be[4] = {bet.x, bet.y, bet.z, bet.w};
    float bon = 0.f, sf = 0.f, sb = 0.f;
#pragma unroll
    for (int i = 0; i < 4; ++i) { bon += r[i] * k[i] * rkv[i]; sf += f[i]; sb += bb[i]; }
    bon = sum16(bon); float muf = sum16(sf) * (1.f / 64.f), mub = sum16(sb) * (1.f / 64.f);
    float qf = 0.f, qb = 0.f;
#pragma unroll
    for (int i = 0; i < 4; ++i) { f[i] -= muf; bb[i] -= mub; qf += f[i] * f[i]; qb += bb[i] * bb[i]; }
    float rsf = rsqrtf(sum16(qf) * (1.f / 64.f) + 64e-5f), rsb = rsqrtf(sum16(qb) * (1.f / 64.f) + 64e-5f);
    float y[4];
#pragma unroll
    for (int i = 0; i < 4; ++i) {
      float bn = bon * v[i];
      y[i] = (f[i] * rsf * ga[i] + be[i] + bn) * gf[i] + (bb[i] * rsb * ga[i] + be[i] + bn) * gb[i];
    }
    uint2 oo; oo.x = pack2(y[0], y[1]); oo.y = pack2(y[2], y[3]);
    *(uint2*)(Y + o) = oo;
  }
}

DI void ph_merge(const Params& p, int l, const bf16_t* U, char* smem) {
  const int lane = my_tid() & 63, wid = my_tid() >> 6, wm = wid >> 1, wn = wid & 1, g = lane >> 4, r16 = lane & 15;
  const int mtiles = (l == 0) ? 136 : 128;
  bf16_t* ACC = (bf16_t*)(p.ws + R_ACC);
  for (int it = 0;; ++it) {
    int mtile, ntile;
    if (!next_tile(it, mtiles, 8, mtile, ntile)) break;
    uint2 accS[4][4];
#pragma unroll
    for (int mt = 0; mt < 4; ++mt)
#pragma unroll
      for (int nt = 0; nt < 4; ++nt) accS[mt][nt] = make_uint2(0u, 0u);
    for (int j = 0; j < 4; ++j) {
      uint2 pb[4][4];
      {
        f32x4 accB[4][4]; zero_acc<4>(accB);
        const size_t yoff = (j == 0) ? R_YHY : (j == 1) ? R_YSW : (j == 2) ? R_YRW : R_YDF;
        gemm_glds(accB, (const bf16_t*)(p.ws + yoff), 256, RowPlain{(long)mtile * 256}, (const bf16_t*)(p.ws + WB_BR) + ((size_t)j * 1024 + ntile * 128) * 256, 256, 256, smem, (const bf16_t*)(p.ws + MISC_ZERO));
#pragma unroll
        for (int mt = 0; mt < 4; ++mt)
#pragma unroll
          for (int nt = 0; nt < 4; ++nt) { pb[mt][nt].x = pack2(accB[mt][nt][0], accB[mt][nt][1]); pb[mt][nt].y = pack2(accB[mt][nt][2], accB[mt][nt][3]); }
      }
      f32x4 accG[4][4]; zero_acc<4>(accG);
      gemm_glds(accG, U, 1024, RowPlain{(long)mtile * 256}, (const bf16_t*)(p.ws + WB_GATE) + ((size_t)j * 1024 + ntile * 128) * 1024, 1024, 1024, smem, (const bf16_t*)(p.ws + MISC_ZERO));
#pragma unroll
      for (int mt = 0; mt < 4; ++mt)
#pragma unroll
        for (int nt = 0; nt < 4; ++nt) {
          float v0 = bflo(accS[mt][nt].x) + sigmoidf_(accG[mt][nt][0]) * bflo(pb[mt][nt].x);
          float v1 = bfhi(accS[mt][nt].x) + sigmoidf_(accG[mt][nt][1]) * bfhi(pb[mt][nt].x);
          float v2 = bflo(accS[mt][nt].y) + sigmoidf_(accG[mt][nt][2]) * bflo(pb[mt][nt].y);
          float v3 = bfhi(accS[mt][nt].y) + sigmoidf_(accG[mt][nt][3]) * bfhi(pb[mt][nt].y);
          accS[mt][nt].x = pack2(v0, v1); accS[mt][nt].y = pack2(v2, v3);
        }
    }
#pragma unroll
    for (int mt = 0; mt < 4; ++mt) {
      const int col = ntile * 128 + wn * 64 + r16 * 4;
      const size_t row = (size_t)mtile * 256 + wm * 64 + mt * 16 + g * 4;
      uint2 o;
      o.x = (accS[mt][0].x & 0xffffu) | (accS[mt][1].x << 16); o.y = (accS[mt][2].x & 0xffffu) | (accS[mt][3].x << 16);
      *(uint2*)(ACC + (row + 0) * 1024 + col) = o;
      o.x = (accS[mt][0].x >> 16) | (accS[mt][1].x & 0xffff0000u); o.y = (accS[mt][2].x >> 16) | (accS[mt][3].x & 0xffff0000u);
      *(uint2*)(ACC + (row + 1) * 1024 + col) = o;
      o.x = (accS[mt][0].y & 0xffffu) | (accS[mt][1].y << 16); o.y = (accS[mt][2].y & 0xffffu) | (accS[mt][3].y << 16);
      *(uint2*)(ACC + (row + 2) * 1024 + col) = o;
      o.x = (accS[mt][0].y >> 16) | (accS[mt][1].y & 0xffff0000u); o.y = (accS[mt][2].y >> 16) | (accS[mt][3].y & 0xffff0000u);
      *(uint2*)(ACC + (row + 3) * 1024 + col) = o;
    }
  }
}

DI void ph_resgemm(const Params& p, int l, const bf16_t* A, int K, const bf16_t* Bt, const float* hsrc_lat, const float* hsrc_ctx, int gate_off, char* smem) {
  const int lane = my_tid() & 63, wid = my_tid() >> 6, wm = wid >> 1, wn = wid & 1, g = lane >> 4, r16 = lane & 15;
  const int mtiles = (l == 0) ? 136 : 128;
  const float* mod = (const float*)(p.ws + MISC_MOD) + (size_t)l * 9 * 6144;
  float* hc = (float*)(p.ws + OFF_HC);
  for (int it = 0;; ++it) {
    int mtile, ntile;
    if (!next_tile(it, mtiles, 8, mtile, ntile)) break;
    f32x4 acc[4][4]; zero_acc<4>(acc);
    gemm_glds(acc, A, K, RowPlain{(long)mtile * 256}, Bt + (size_t)ntile * 128 * K, K, K, smem, (const bf16_t*)(p.ws + MISC_ZERO));
    const int b = mtile < 128 ? (mtile >> 4) : 8;
    const float* gt = mod + (size_t)b * 6144 + gate_off;
    const int col = ntile * 128 + wn * 64 + r16 * 4;
    const float4 gv = *(const float4*)(gt + col);
    const float* hs_tile = mtile < 128 ? hsrc_lat + (size_t)mtile * 256 * D : hsrc_ctx + (size_t)(mtile - 128) * 256 * D;
    float* hd_tile = mtile < 128 ? p.out + (size_t)mtile * 256 * D : hc + (size_t)(mtile - 128) * 256 * D;
#pragma unroll
    for (int mt = 0; mt < 4; ++mt)
#pragma unroll
      for (int e = 0; e < 4; ++e) {
        const size_t o = (size_t)(wm * 64 + mt * 16 + g * 4 + e) * D + col;
        const float* hs = hs_tile + o; float* hd = hd_tile + o;
        const float4 h = *(const float4*)hs;
        float4 r;
        r.x = DN_ALPHA * h.x + gv.x * acc[mt][0][e]; r.y = DN_ALPHA * h.y + gv.y * acc[mt][1][e];
        r.z = DN_ALPHA * h.z + gv.z * acc[mt][2][e]; r.w = DN_ALPHA * h.w + gv.w * acc[mt][3][e];
        *(float4*)hd = r;
      }
  }
}

DI void ph_ffnup(const Params& p, int l, char* smem) {
  const bf16_t* U = (const bf16_t*)(p.ws + R_U);
  const bf16_t* Bt = (const bf16_t*)(p.ws + WB_UP);
  bf16_t* HID = (bf16_t*)(p.ws + R_HID);
  const float* cw = p.in[38] + (size_t)l * 3 * 5632; const float* cb = p.in[39] + (size_t)l * 5632;
  const int tid = my_tid(), lane = tid & 63, wid = tid >> 6, wm = wid >> 2, wn = wid & 3, g = lane >> 4, r16 = lane & 15;
  const int mtiles = (l == 0) ? 144 : 136;
  constexpr int TS = 528;
  for (int it = 0;; ++it) {
    int mtile, ntile;
    if (!next_tile(it, mtiles, 22, mtile, ntile)) break;
    long rowbase; int t0, len, r0, r1;
    if (mtile < 136) { int b = mtile / 17; int tt = mtile % 17; len = SL; rowbase = (long)b * SL; t0 = tt * 254 - 1; r0 = 1; r1 = 254; }
    else { int b = mtile - 136; len = CL; rowbase = (long)ML + b * CL; t0 = 0; r0 = 0; r1 = 255; }
    f32x4 acc[8][4]; zero_acc256(acc);
    gemm_glds256(acc, U, 1024, rowbase + t0, Bt + (size_t)ntile * 256 * 1024, 1024, 1024, smem);
#pragma unroll
    for (int mt = 0; mt < 8; ++mt)
#pragma unroll
      for (int e = 0; e < 4; ++e) {
        uint2 o; o.x = pack2(acc[mt][0][e], acc[mt][1][e]); o.y = pack2(acc[mt][2][e], acc[mt][3][e]);
        *(uint2*)(smem + (wm * 128 + mt * 16 + g * 4 + e) * TS + (wn * 64 + r16 * 4) * 2) = o;
      }
    __syncthreads();
    {
      const int ch = (tid & 31) * 4, rgp = tid >> 5; const int ca = ntile * 128 + ch, cbx = 2816 + ca;
      const float4 wa0 = *(const float4*)(cw + ca), wa1 = *(const float4*)(cw + 5632 + ca), wa2 = *(const float4*)(cw + 2 * 5632 + ca), wab = *(const float4*)(cb + ca);
      const float4 wb0 = *(const float4*)(cw + cbx), wb1 = *(const float4*)(cw + 5632 + cbx), wb2 = *(const float4*)(cw + 2 * 5632 + cbx), wbb = *(const float4*)(cb + cbx);
      for (int r = r0 + rgp; r <= r1; r += 16) {
        const int tok = t0 + r;
        if (tok < len) {
          const char* Tr = smem + r * TS + ch * 2;
          const uint2 z2 = make_uint2(0u, 0u);
          const uint2 ua = *(const uint2*)(Tr), ub = *(const uint2*)(Tr + 256);
          const uint2 pa = tok >= 1 ? *(const uint2*)(Tr - TS) : z2, pb_ = tok >= 1 ? *(const uint2*)(Tr - TS + 256) : z2;
          const uint2 na = tok + 1 < len ? *(const uint2*)(Tr + TS) : z2, nb = tok + 1 < len ? *(const uint2*)(Tr + TS + 256) : z2;
          const float av0 = wa0.x * bflo(pa.x) + wa1.x * bflo(ua.x) + wa2.x * bflo(na.x) + wab.x;
          const float av1 = wa0.y * bfhi(pa.x) + wa1.y * bfhi(ua.x) + wa2.y * bfhi(na.x) + wab.y;
          const float av2 = wa0.z * bflo(pa.y) + wa1.z * bflo(ua.y) + wa2.z * bflo(na.y) + wab.z;
          const float av3 = wa0.w * bfhi(pa.y) + wa1.w * bfhi(ua.y) + wa2.w * bfhi(na.y) + wab.w;
          const float bv0 = wb0.x * bflo(pb_.x) + wb1.x * bflo(ub.x) + wb2.x * bflo(nb.x) + wbb.x;
          const float bv1 = wb0.y * bfhi(pb_.x) + wb1.y * bfhi(ub.x) + wb2.y * bfhi(nb.x) + wbb.y;
          const float bv2 = wb0.z * bflo(pb_.y) + wb1.z * bflo(ub.y) + wb2.z * bflo(nb.y) + wbb.z;
          const float bv3 = wb0.w * bfhi(pb_.y) + wb1.w * bfhi(ub.y) + wb2.w * bfhi(nb.y) + wbb.w;
          uint2 o; o.x = pack2(siluf_(av0) * bv0, siluf_(av1) * bv1); o.y = pack2(siluf_(av2) * bv2, siluf_(av3) * bv3);
          *(uint2*)(HID + (size_t)(rowbase + tok) * 2816 + ca) = o;
        }
      }
    }
  }
}

#ifndef REP_PREP
#define REP_PREP 1
#endif
#ifndef REP_GEMM
#define REP_GEMM 1
#endif
#ifndef REP_HY
#define REP_HY 1
#endif
#ifndef REP_RWP
#define REP_RWP 1
#endif
#ifndef REP_SCAN
#define REP_SCAN 1
#endif
#ifndef REP_ATTN
#define REP_ATTN 1
#endif
#ifndef PH_END
#define PH_END 24
#endif
#define XB_TMO      128
#define XB_XCNT(j)  (256  + 64 * (j))
#define XB_XSUB(j)  (1280 + 64 * (j))
#define XB_XGEN(j)  (2304 + 64 * (j))
#define XB_TOP      3328
#define XB_TOPGEN   3392
#define XCD_BAR_WORDS 3456
#define XB_SPIN_CAP (1u << 22)
DI unsigned xb_ld(unsigned* p) { return __hip_atomic_load(p, __ATOMIC_RELAXED, __HIP_MEMORY_SCOPE_AGENT); }
DI unsigned xb_add(unsigned* p, unsigned v) { return __hip_atomic_fetch_add(p, v, __ATOMIC_RELAXED, __HIP_MEMORY_SCOPE_AGENT); }
DI unsigned xb_xcc_id() { return (unsigned)__builtin_amdgcn_s_getreg((3 << 11) | 20) & 0xFu; }
#define XB_SPIN(cond, bar) do { unsigned _sp = 0; while (cond) { __builtin_amdgcn_s_sleep(1); \
    if ((++_sp & 255u) == 0u) { if (xb_ld(&(bar)[XB_TMO])) break; if (_sp > XB_SPIN_CAP) { atomicAdd(&(bar)[XB_TMO], 1u); break; } } } } while (0)
DI void xcd_barrier_complete(unsigned* bar, unsigned x, unsigned& nloc, unsigned& nx) {
  const unsigned G = gridDim.x;
  unsigned sum, cnt, mine, sp = 0u;
  for (;;) {
    sum = 0u; cnt = 0u; mine = 0u;
#pragma unroll
    for (unsigned j = 0; j < 16; ++j) { const unsigned c = xb_ld(&bar[XB_XCNT(j)]); sum += c; cnt += (c > 0u) ? 1u : 0u; mine = (j == x) ? c : mine; }
    if (sum == G) break;
    __builtin_amdgcn_s_sleep(1);
    if ((++sp & 255u) == 0u) { if (xb_ld(&bar[XB_TMO])) break; if (sp > XB_SPIN_CAP) { atomicAdd(&bar[XB_TMO], 1u); break; } }
  }
  nloc = mine > 0u ? mine : 1u; nx = cnt > 0u ? cnt : 1u;
}
DI void grid_barrier(unsigned* bar, volatile unsigned* st) {
  asm volatile("s_waitcnt vmcnt(0)" ::: "memory");
  __syncthreads();
  if (my_tid() == 0) {
    const unsigned x = xb_xcc_id();
    __builtin_amdgcn_s_waitcnt(0);
    unsigned nloc = st[0], nx = st[1];
    if (nloc == 0u) { xcd_barrier_complete(bar, x, nloc, nx); st[0] = nloc; st[1] = nx; }
    const unsigned old = xb_add(&bar[XB_XSUB(x)], 1u);
    const unsigned gen = old / nloc;
    if (old + 1u == (gen + 1u) * nloc) {
      __builtin_amdgcn_fence(__ATOMIC_RELEASE, "agent");
      asm volatile("s_waitcnt vmcnt(0)" ::: "memory");
      const unsigned og = xb_add(&bar[XB_TOP], 1u);
      const unsigned tg = og / nx;
      if (og + 1u == (tg + 1u) * nx) xb_add(&bar[XB_TOPGEN], 1u);
      else XB_SPIN(xb_ld(&bar[XB_TOPGEN]) == tg, bar);
      __builtin_amdgcn_fence(__ATOMIC_ACQUIRE, "agent");
      xb_add(&bar[XB_XGEN(x)], 1u);
      asm volatile("s_waitcnt vmcnt(0)" ::: "memory");
    } else {
      XB_SPIN(xb_ld(&bar[XB_XGEN(x)]) == gen, bar);
      __builtin_amdgcn_fence(__ATOMIC_ACQUIRE, "agent");
      asm volatile("s_waitcnt vmcnt(0)" ::: "memory");
    }
  }
  __syncthreads();
}
#define SYNC_OR_RET(idx) do { if ((idx) + 1 >= PH_END) return; if ((idx) == 0) { grid.sync(); if (my_tid() == 0) (void)xb_add(&((unsigned*)(p.ws + MISC_XBAR))[XB_XCNT(xb_xcc_id())], 1u); } else grid_barrier((unsigned*)(p.ws + MISC_XBAR), (volatile unsigned*)(smem + 144 * 1024)); } while (0)
template <int l>
DI void run_layer(const Params& p, cg::grid_group& grid, char* smem, unsigned& epoch) {
  const float* mod = (const float*)(p.ws + MISC_MOD) + (size_t)l * 9 * 6144;
  float* hc = (float*)(p.ws + OFF_HC);
  const float* hl_src = (l == 0) ? p.in[0] : p.out;
  const float* hc_src = (l == 0) ? p.in[2] : hc;
  constexpr int B0 = l * 12;
  if (l == 0) {
    ph_convert(p, 0, smem);
    ph_ada(p, smem);
    hy_rawfilter(p, 0, SL, (float*)(p.ws + R_RAWF), smem);
    hy_rawfilter(p, 0, CL, (float*)(p.ws + MISC_RAWC), smem);
    SYNC_OR_RET(B0 + 0);
    ph_kf(p, 0, smem);
    ph_ln(hl_src, hc_src, nullptr, nullptr, nullptr, nullptr, (bf16_t*)p.out, mod, 0, MT);
    SYNC_OR_RET(B0 + 1);
  }
  for (int rep = 0; rep < REP_GEMM; ++rep) ph_inproj(p, l == 0 ? (const bf16_t*)p.out : (const bf16_t*)(p.ws + R_U), smem);
  SYNC_OR_RET(B0 + 2);
  for (int rep = 0; rep < REP_HY; ++rep) {
  if (blockIdx.x == 0 && my_tid() == 0) *(unsigned*)(p.ws + MISC_BAR + 64 + 64 * l) = 0u;
  ph_hyena(p, l, smem);
  if (l == 0) ph_hyena_ctx(p, l, smem);
  }
  ph_rope(p, smem);
  for (int rep = 0; rep < REP_RWP; ++rep) ph_rwprep(p, l, smem);
  SYNC_OR_RET(B0 + 3);
  for (int rep = 0; rep < REP_SCAN; ++rep) ph_scan(p, smem);
  for (int rep = 0; rep < REP_ATTN; ++rep) ph_attn(p, l, smem);
  SYNC_OR_RET(B0 + 4);
  ph_rwout(p, l);
  if (l != 0) ph_ln(hl_src, hc_src, nullptr, nullptr, nullptr, nullptr, (bf16_t*)(p.ws + R_URE), mod, 0, ML);
  SYNC_OR_RET(B0 + 5);
  for (int rep = 0; rep < REP_GEMM; ++rep) ph_merge(p, l, l == 0 ? (const bf16_t*)p.out : (const bf16_t*)(p.ws + R_URE), smem);
  SYNC_OR_RET(B0 + 6);
  ph_resgemm(p, l, (const bf16_t*)(p.ws + R_ACC), 1024, (const bf16_t*)(p.ws + WB_OUT), hl_src, hc_src, 2048, smem);
  if (l == 0) hy_rawfilter(p, 1, SL, (float*)(p.ws + R_RAWF), smem);
  SYNC_OR_RET(B0 + 7);
  ph_ln(p.out, hc, p.out, hc, p.in[35] + (size_t)l * D, p.in[36] + (size_t)l * D, (bf16_t*)(p.ws + R_U), mod, 3072, l == 0 ? MT : ML);
  if (l == 0) ph_kf(p, 1, smem);
  SYNC_OR_RET(B0 + 8);
  for (int rep = 0; rep < REP_GEMM; ++rep) ph_ffnup(p, l, smem);
  SYNC_OR_RET(B0 + 9);
  ph_resgemm(p, l, (const bf16_t*)(p.ws + R_HID), 2816, (const bf16_t*)(p.ws + WB_DOWN), p.out, hc, 5120, smem);
  SYNC_OR_RET(B0 + 10);
  if (l == 0) {
    ph_ln(p.out, hc, p.out, hc, p.in[41], p.in[42], (bf16_t*)(p.ws + R_U), mod + 9 * 6144, 0, MT);
    ph_convert(p, 1, smem);
  } else {
    ph_ln(p.out, hc, p.out, hc, p.in[41] + (size_t)l * D, p.in[42] + (size_t)l * D, nullptr, mod, 0, ML);
  }
  SYNC_OR_RET(B0 + 11);
}

__global__ void __launch_bounds__(NTHR) mega(Params p) {
  extern __shared__ __attribute__((aligned(16))) char smem[];
  cg::grid_group grid = cg::this_grid();
  unsigned epoch = 0;
  if (blockIdx.x == 0) for (int i = my_tid(); i < XCD_BAR_WORDS; i += NTHR) ((unsigned*)(p.ws + MISC_XBAR))[i] = 0u;
  if (my_tid() < 2) ((volatile unsigned*)(smem + 144 * 1024))[my_tid()] = 0u;
  if (blockIdx.x == 0 && my_tid() < 64) *(unsigned*)(p.ws + MISC_ZERO + my_tid() * 4) = 0u;
  run_layer<0>(p, grid, smem, epoch);
  if (PH_END > 12) run_layer<1>(p, grid, smem, epoch);
}

extern "C" void kernel_launch(void* const* d_in, const int* in_sizes, int n_in, void* d_out, int out_size,
                              void* d_ws, size_t ws_size, hipStream_t stream) {
  static int grid_blocks = 0;
  if (!grid_blocks) {
    int dev = 0, cus = 0, per_cu = 0;
    (void)hipGetDevice(&dev);
    (void)hipDeviceGetAttribute(&cus, hipDeviceAttributeMultiprocessorCount, dev);
    (void)hipFuncSetAttribute((const void*)mega, hipFuncAttributeMaxDynamicSharedMemorySize, SMEM_BYTES);
    (void)hipOccupancyMaxActiveBlocksPerMultiprocessor(&per_cu, mega, NTHR, SMEM_BYTES);
    if (per_cu < 1) per_cu = 1;
    if (per_cu > 1) per_cu = 1;
    grid_blocks = cus * per_cu;
  }
  Params p{};
  for (int i = 0; i < 43; ++i) p.in[i] = (const float*)d_in[i];
  p.out = (float*)d_out; p.ws = (char*)d_ws;
  void* args[] = {&p};
  hipError_t e = hipLaunchCooperativeKernel((void*)mega, dim3(grid_blocks), dim3(NTHR), args, SMEM_BYTES, stream);
  if (e != hipSuccess) fprintf(stderr, "cooperative launch failed: %s (grid %d)\n", hipGetErrorString(e), grid_blocks);
}
```
